# Optimizing an MI355X kernel written in HIP

```python
import math
import jax
import jax.numpy as jnp
from jax import lax
import numpy as np

D_MODEL = 1024
BATCH = 2
SEQ = 16384
DEPTH = 2

GRID_W = 64
CTX_LEN = 256
D_CONV = 512
CONV_K = 31
D_SSD = 512
SSD_HEADDIM = 64
SSD_HEADS = D_SSD // SSD_HEADDIM
SSD_GROUPS = 2
SSD_STATE = 128
SSD_CONV_K = 5
SSD_CHUNK = 128
D_BC = SSD_GROUPS * SSD_STATE
D_XBC = D_SSD + 2 * D_BC
D_MIX = D_CONV + D_SSD
D_IN = 2 * D_CONV + D_SSD + D_XBC + 2 * SSD_HEADS
MOE_GROUPS = 4
MOE_PER_GROUP = 4
N_EXPERTS = MOE_GROUPS * MOE_PER_GROUP
MOE_TOPK = 2
EXPERT_FF = 256
RMS_EPS = 1e-6
LN_EPS = 1e-5

kernel_name = "hymba_conformer_ssd_hmoe_prefix_dit"


def rms_norm(x, g):
    xf = x.astype(jnp.float32)
    y = xf * lax.rsqrt(jnp.mean(jnp.square(xf), axis=-1, keepdims=True) + RMS_EPS)
    return (y * g.astype(jnp.float32)).astype(x.dtype)


def layer_norm(x, g, b):
    xf = x.astype(jnp.float32)
    mu = jnp.mean(xf, axis=-1, keepdims=True)
    var = jnp.mean(jnp.square(xf - mu), axis=-1, keepdims=True)
    y = (xf - mu) * lax.rsqrt(var + LN_EPS)
    return (y * g.astype(jnp.float32) + b.astype(jnp.float32)).astype(x.dtype)


def modulate(h, shift, scale):
    return h * (1.0 + scale) + shift


def ada_mod(cvec, w_ada, b_ada, n):
    m = jax.nn.silu(cvec) @ w_ada[:, :n * D_MODEL] + b_ada[:n * D_MODEL]
    return jnp.split(m, n, axis=-1)


def dwconv_seq(v, w):
    k, ch = w.shape
    return lax.conv_general_dilated(
        v, w[:, None, :].astype(v.dtype), (1,), [(k // 2, k // 2)],
        dimension_numbers=("NWC", "WIO", "NWC"), feature_group_count=ch)


def dwconv_grid(v, w, axis):
    k, ch = w.shape
    if axis == 1:
        taps, pad = w[:, None, None, :], [(k // 2, k // 2), (0, 0)]
    else:
        taps, pad = w[None, :, None, :], [(0, 0), (k // 2, k // 2)]
    return lax.conv_general_dilated(
        v, taps.astype(v.dtype), (1, 1), pad,
        dimension_numbers=("NHWC", "HWIO", "NHWC"), feature_group_count=ch)


def split_proj(proj):
    o1, o2, o3, o4 = D_CONV, 2 * D_CONV, 2 * D_CONV + D_SSD, 2 * D_CONV + D_SSD + D_XBC
    return proj[..., :o1], proj[..., o1:o2], proj[..., o2:o3], proj[..., o3:o4], proj[..., o4:]


def conformer_conv(u, gate, p, rows):
    v = u * jax.nn.sigmoid(gate)
    if rows is None:
        y = dwconv_seq(v, p["conv_w"])
    else:
        b, l, ch = v.shape
        half = ch // 2
        vg = v.reshape(b, rows, GRID_W, ch)
        y = jnp.concatenate([dwconv_grid(vg[..., :half], p["conv_w"][:, :half], 2),
                             dwconv_grid(vg[..., half:], p["conv_w"][:, half:], 1)],
                            axis=-1).reshape(b, l, ch)
    return jax.nn.silu(layer_norm(y + p["conv_b"], p["conv_ln_g"], p["conv_ln_b"]))


def group_to_heads(v):
    b, l, _ = v.shape
    return jnp.repeat(v.reshape(b, l, SSD_GROUPS, SSD_STATE), SSD_HEADS // SSD_GROUPS, axis=2)


def ssd_scan_inputs(xbc_raw, dt_raw, p):
    b, l, ch = xbc_raw.shape
    xbc = jax.nn.silu(dwconv_seq(xbc_raw, p["ssd_conv_w"][:, :ch]) + p["ssd_conv_b"][:ch])
    xs = xbc[..., :D_SSD].reshape(b, l, SSD_HEADS, SSD_HEADDIM)
    bm = group_to_heads(xbc[..., D_SSD:D_SSD + D_BC])
    cm = group_to_heads(xbc[..., D_SSD + D_BC:]) if ch == D_XBC else None
    dt = jax.nn.softplus(dt_raw.astype(jnp.float32).reshape(b, l, 2, SSD_HEADS)
                         + p["dt_bias"].astype(jnp.float32))
    return xs, bm, cm, dt


def flip_seq(t):
    return jnp.flip(t, axis=1)


def ssd_chunked(xs, dt, a, bm, cm, h0):
    b, l, nh, hp = xs.shape
    n = bm.shape[-1]
    nc = l // SSD_CHUNK
    a_cum = jnp.cumsum((dt * a).reshape(b, nc, SSD_CHUNK, nh), axis=2)
    xdt = (xs * dt[..., None]).reshape(b, nc, SSD_CHUNK, nh, hp)
    bc = bm.reshape(b, nc, SSD_CHUNK, nh, n)
    cc = cm.reshape(b, nc, SSD_CHUNK, nh, n)
    causal = jnp.tril(jnp.ones((SSD_CHUNK, SSD_CHUNK), dtype=bool))
    seg = a_cum[:, :, :, None, :] - a_cum[:, :, None, :, :]
    decay_ls = jnp.exp(jnp.where(causal[None, None, :, :, None], seg, -jnp.inf))
    scores = jnp.einsum("bclhn,bcshn->bclsh", cc, bc) * decay_ls
    y_diag = jnp.einsum("bclsh,bcshp->bclhp", scores, xdt)
    decay_to_end = jnp.exp(a_cum[:, :, -1:, :] - a_cum)
    chunk_states = jnp.einsum("bclh,bclhn,bclhp->bchpn", decay_to_end, bc, xdt)
    chunk_decay = jnp.exp(a_cum[:, :, -1, :])

    def step(h, inp):
        s, d = inp
        return h * d[:, :, None, None] + s, h

    _, h_prev = lax.scan(step, h0.astype(chunk_states.dtype),
                         (jnp.swapaxes(chunk_states, 0, 1), jnp.swapaxes(chunk_decay, 0, 1)))
    h_prev = jnp.swapaxes(h_prev, 0, 1)
    y_off = jnp.einsum("bclhn,bchpn,bclh->bclhp", cc, h_prev, jnp.exp(a_cum))
    return (y_diag + y_off).reshape(b, l, nh, hp)


def ssd_final_state(xs, dt, a, bm):
    la = jnp.cumsum(dt * a, axis=1)
    w = jnp.exp(la[:, -1:, :] - la) * dt
    return jnp.einsum("blh,blhn,blhp->bhpn", w, bm, xs)


def context_states(xs, bm, dt, a):
    hf = ssd_final_state(xs, dt[:, :, 0], a[0], bm)
    hb = ssd_final_state(flip_seq(xs), flip_seq(dt[:, :, 1]), a[1], flip_seq(bm))
    return hf, hb


def mixer_output(u, gate, z, xs, bm, cm, dt, a, h0_f, h0_b, p, rows):
    conv_out = conformer_conv(u, gate, p, rows)
    y_f = ssd_chunked(xs, dt[:, :, 0], a[0], bm, cm, h0_f)
    y_b = flip_seq(ssd_chunked(flip_seq(xs), flip_seq(dt[:, :, 1]), a[1],
                               flip_seq(bm), flip_seq(cm), h0_b))
    y = y_f + y_b + p["d_skip"][:, None] * xs
    b, l = xs.shape[:2]
    ssd_out = rms_norm(y.reshape(b, l, D_SSD) * jax.nn.silu(z), p["ssd_norm_g"])
    return jnp.concatenate([conv_out, ssd_out], axis=-1) @ p["w_out"]


def hier_moe(h, p):
    b, l, d = h.shape
    t = h.reshape(b * l, d)
    g_logits = (t @ p["w_rg"] + p["b_rg"]).astype(jnp.float32)
    g_sel = jnp.argmax(g_logits, axis=-1)
    g_prob = jnp.take_along_axis(jax.nn.softmax(g_logits, axis=-1), g_sel[:, None], axis=-1)
    e_logits = (t @ p["w_re"] + p["b_re"]).astype(jnp.float32).reshape(-1, MOE_GROUPS, MOE_PER_GROUP)
    e_logits = jnp.take_along_axis(e_logits, g_sel[:, None, None], axis=1)[:, 0]
    top_v, top_i = lax.top_k(jax.nn.softmax(e_logits, axis=-1), MOE_TOPK)
    w_sel = g_prob * top_v / jnp.sum(top_v, axis=-1, keepdims=True)
    e_id = g_sel[:, None] * MOE_PER_GROUP + top_i
    comb = jnp.einsum("tk,tke->et", w_sel, jax.nn.one_hot(e_id, N_EXPERTS, dtype=jnp.float32))

    def expert(acc, ew):
        wg, wu, wd, cw = ew
        hid = jax.nn.silu(t @ wg) * (t @ wu)
        return acc + (cw[:, None] * (hid @ wd)).astype(acc.dtype), None

    out, _ = lax.scan(expert, jnp.zeros(t.shape, jnp.float32),
                      (p["w_gate"], p["w_up"], p["w_down"], comb))
    return out.reshape(b, l, d)


def setup_inputs(seed: int = 0) -> dict:
    key = jax.random.key(seed)
    ks = iter(jax.random.split(key, 40))
    f32 = jnp.float32

    def nrm(shape, scale):
        return scale * jax.random.normal(next(ks), shape, f32)

    def gain(shape):
        return 1.0 + nrm(shape, 0.02)

    dt0 = jnp.exp(jax.random.uniform(next(ks), (DEPTH, 2, SSD_HEADS), f32,
                                     math.log(1e-3), math.log(1e-1)))
    return {
        "x": nrm((BATCH, SEQ, D_MODEL), 1.0),
        "c": nrm((BATCH, D_MODEL), 1.0),
        "ctx": nrm((BATCH, CTX_LEN, D_MODEL), 1.0),
        "c_ctx": nrm((D_MODEL,), 1.0),
        "w_ada": nrm((DEPTH, D_MODEL, 6 * D_MODEL), 0.5 * D_MODEL ** -0.5),
        "b_ada": nrm((DEPTH, 6 * D_MODEL), 0.02),
        "g_mix": gain((DEPTH, D_MODEL)),
        "g_ffn": gain((DEPTH, D_MODEL)),
        "w_in": nrm((DEPTH, D_MODEL, D_IN), D_MODEL ** -0.5),
        "conv_w": nrm((DEPTH, CONV_K, D_CONV), CONV_K ** -0.5),
        "conv_b": nrm((DEPTH, D_CONV), 0.02),
        "conv_ln_g": gain((DEPTH, D_CONV)),
        "conv_ln_b": nrm((DEPTH, D_CONV), 0.02),
        "ssd_conv_w": nrm((DEPTH, SSD_CONV_K, D_XBC), SSD_CONV_K ** -0.5),
        "ssd_conv_b": nrm((DEPTH, D_XBC), 0.02),
        "dt_bias": dt0 + jnp.log(-jnp.expm1(-dt0)),
        "a_log": jnp.log(jax.random.uniform(next(ks), (DEPTH, 2, SSD_HEADS), f32, 1.0, 16.0)),
        "d_skip": gain((DEPTH, SSD_HEADS)),
        "ssd_norm_g": gain((DEPTH, D_SSD)),
        "w_out": nrm((DEPTH, D_MIX, D_MODEL), D_MIX ** -0.5),
        "w_router_group": nrm((DEPTH, D_MODEL, MOE_GROUPS), D_MODEL ** -0.5),
        "b_router_group": nrm((DEPTH, MOE_GROUPS), 0.01),
        "w_router_expert": nrm((DEPTH, D_MODEL, N_EXPERTS), D_MODEL ** -0.5),
        "b_router_expert": nrm((DEPTH, N_EXPERTS), 0.01),
        "w_gate": nrm((DEPTH, N_EXPERTS, D_MODEL, EXPERT_FF), D_MODEL ** -0.5),
        "w_up": nrm((DEPTH, N_EXPERTS, D_MODEL, EXPERT_FF), D_MODEL ** -0.5),
        "w_down": nrm((DEPTH, N_EXPERTS, EXPERT_FF, D_MODEL), EXPERT_FF ** -0.5),
        "g_final": gain((D_MODEL,)),
    }


def reference(x, c, ctx, c_ctx, w_ada, b_ada, g_mix, g_ffn, w_in, conv_w, conv_b, conv_ln_g,
              conv_ln_b, ssd_conv_w, ssd_conv_b, dt_bias, a_log, d_skip, ssd_norm_g, w_out,
              w_router_group, b_router_group, w_router_expert, b_router_expert,
              w_gate, w_up, w_down, g_final):
    rows = x.shape[1] // GRID_W
    h_x, h_c = x, ctx
    lo = 2 * D_CONV + D_SSD
    for l in range(DEPTH):
        last = l == DEPTH - 1
        p = {"w_in": w_in[l], "conv_w": conv_w[l], "conv_b": conv_b[l], "conv_ln_g": conv_ln_g[l],
             "conv_ln_b": conv_ln_b[l], "ssd_conv_w": ssd_conv_w[l], "ssd_conv_b": ssd_conv_b[l],
             "dt_bias": dt_bias[l], "d_skip": d_skip[l], "ssd_norm_g": ssd_norm_g[l],
             "w_out": w_out[l], "w_rg": w_router_group[l], "b_rg": b_router_group[l],
             "w_re": w_router_expert[l], "b_re": b_router_expert[l],
             "w_gate": w_gate[l], "w_up": w_up[l], "w_down": w_down[l]}
        a = -jnp.exp(a_log[l].astype(jnp.float32))
        sh1, sc1, gt1, sh2, sc2, gt2 = [m[:, None, :] for m in ada_mod(c, w_ada[l], b_ada[l], 6)]

        if last:
            csh1, csc1 = ada_mod(c_ctx, w_ada[l], b_ada[l], 2)
            hc = modulate(rms_norm(h_c, g_mix[l]), csh1, csc1)
            w_xb_dt = jnp.concatenate([p["w_in"][:, lo:lo + D_SSD + D_BC], p["w_in"][:, lo + D_XBC:]], axis=1)
            proj_c = hc @ w_xb_dt
            xs_c, bm_c, _, dt_c = ssd_scan_inputs(proj_c[..., :D_SSD + D_BC], proj_c[..., D_SSD + D_BC:], p)
        else:
            csh1, csc1, cgt1, csh2, csc2, cgt2 = ada_mod(c_ctx, w_ada[l], b_ada[l], 6)
            hc = modulate(rms_norm(h_c, g_mix[l]), csh1, csc1)
            uc, gc, zc, xbc_c, dtr_c = split_proj(hc @ p["w_in"])
            xs_c, bm_c, cm_c, dt_c = ssd_scan_inputs(xbc_c, dtr_c, p)
        hf0, hb0 = context_states(xs_c, bm_c, dt_c, a)

        hx = modulate(rms_norm(h_x, g_mix[l]), sh1, sc1)
        u, gate, z, xbc, dt_raw = split_proj(hx @ p["w_in"])
        xs, bm, cm, dt = ssd_scan_inputs(xbc, dt_raw, p)
        h_x = h_x + gt1 * mixer_output(u, gate, z, xs, bm, cm, dt, a, hf0, hb0, p, rows)
        h_x = h_x + gt2 * hier_moe(modulate(rms_norm(h_x, g_ffn[l]), sh2, sc2), p)

        if not last:
            zero = jnp.zeros_like(hf0)
            h_c = h_c + cgt1 * mixer_output(uc, gc, zc, xs_c, bm_c, cm_c, dt_c, a, zero, zero, p, None)
            h_c = h_c + cgt2 * hier_moe(modulate(rms_norm(h_c, g_ffn[l]), csh2, csc2), p)

    return rms_norm(h_x, g_final).astype(x.dtype)
```

```cpp
#include <hip/hip_runtime.h>
#include <hip/hip_cooperative_groups.h>
#include <cstdio>
namespace cg = cooperative_groups;

#ifndef PER_PHASE_LAUNCH
#define PER_PHASE_LAUNCH 0
#endif

#define LAS __attribute__((address_space(3)))
typedef unsigned short bf16_t;
typedef short bf16x8 __attribute__((ext_vector_type(8)));
typedef float f32x4 __attribute__((ext_vector_type(4)));
typedef unsigned u32x4 __attribute__((ext_vector_type(4)));
typedef unsigned u32x2 __attribute__((ext_vector_type(2)));

constexpr int D = 1024, NB = 2, SEQ = 16384, CTXL = 256, SEG = SEQ + CTXL, R = NB * SEG, DEPTH = 2;
constexpr int NPROJ = 2560, DIN = 2576;
constexpr int NTHREADS = 512;
constexpr int LDS_BYTES = 147456;
constexpr int MISC_OFF = 131072;
constexpr int NCLS = 24;

constexpr size_t al256(size_t x) { return (x + 255) & ~size_t(255); }
constexpr size_t WS_CTL = 0;
constexpr size_t WS_MOD = 4096;
constexpr size_t WS_WTIN = WS_MOD + al256((size_t)2 * 3 * 6144 * 4);
constexpr size_t WS_WTOUT = WS_WTIN + al256((size_t)2 * DIN * 1024 * 2);
constexpr size_t WS_WTGU = WS_WTOUT + al256((size_t)2 * 1024 * 1024 * 2);
constexpr size_t WS_WTD = WS_WTGU + al256((size_t)2 * 16 * 512 * 1024 * 2);
constexpr size_t WS_HC = WS_WTD + al256((size_t)2 * 16 * 1024 * 256 * 2);
constexpr size_t WS_HX = WS_HC + al256((size_t)512 * 1024 * 4);
constexpr size_t WS_PROJ = WS_HX + al256((size_t)R * 1024 * 2);
constexpr size_t WS_DT = WS_PROJ + al256((size_t)R * NPROJ * 2);
constexpr size_t WS_POS = WS_DT + al256((size_t)R * 16 * 4);
constexpr size_t WS_LIST = WS_POS + al256((size_t)2 * R * 4);
constexpr size_t WS_CWLA = WS_LIST + al256((size_t)NCLS * R * 4);
constexpr size_t WS_CWLB = WS_CWLA + al256((size_t)NCLS * R * 4);
constexpr size_t WS_BIG = WS_CWLB + al256((size_t)NCLS * R * 4);
constexpr size_t WS_Y = WS_PROJ;
constexpr size_t WS_XBC = WS_BIG;
constexpr size_t WS_YF = WS_XBC + al256((size_t)R * 1024 * 2);
constexpr size_t WS_YB = WS_YF + al256((size_t)R * 512 * 4);
constexpr size_t WS_HID = WS_YF;
constexpr size_t WS_END = WS_YB + al256((size_t)R * 512 * 4);
static_assert((size_t)(R + NCLS * 256) * 512 * 2 <= (size_t)R * 512 * 4 * 2, "hid alias");
static_assert(WS_END <= (size_t)512 * 1024 * 1024, "workspace");

struct Params {
    const float *x, *c, *ctx, *c_ctx, *w_ada, *b_ada, *g_mix, *g_ffn, *w_in, *conv_w, *conv_b, *conv_ln_g, *conv_ln_b, *ssd_conv_w, *ssd_conv_b,
        *dt_bias, *a_log, *d_skip, *ssd_norm_g, *w_out, *w_rg, *b_rg, *w_re, *b_re, *w_gate, *w_up, *w_down, *g_final;
    float* out; unsigned char* ws;
};
struct Args { Params p; int lo, hi; };
typedef const __attribute__((address_space(4))) Params* CP;
__device__ __forceinline__ CP launder(CP p) { asm volatile("" : "+s"(p)); return p; }
__device__ __forceinline__ int launder_tid() { int t = threadIdx.x; asm volatile("" : "+v"(t)); return t; }

__device__ __forceinline__ unsigned cvt_pk_bf16(float lo, float hi) { unsigned r; asm volatile("v_cvt_pk_bf16_f32 %0, %1, %2" : "=v"(r) : "v"(lo), "v"(hi)); return r; }
__device__ __forceinline__ float bf2f(unsigned b) { return __uint_as_float(b << 16); }
__device__ __forceinline__ float bflo(unsigned w) { return __uint_as_float(w << 16); }
__device__ __forceinline__ float bfhi(unsigned w) { return __uint_as_float(w & 0xffff0000u); }
__device__ __forceinline__ bf16_t f2bf(float f) { return (bf16_t)(cvt_pk_bf16(f, 0.f) & 0xffffu); }
__device__ __forceinline__ float wave_sum(float v) {
#pragma unroll
    for (int o = 1; o < 64; o <<= 1) v += __shfl_xor(v, o);
    return v;
}
__device__ __forceinline__ float sigmoidf_(float x) { return 1.f / (1.f + __expf(-x)); }
__device__ __forceinline__ float siluf_(float x) { return x / (1.f + __expf(-x)); }
__device__ __forceinline__ float softplusf_(float x) { return fmaxf(x, 0.f) + log1pf(expf(-fabsf(x))); }

__device__ __forceinline__ int row_b(int r) { return r >= SEG ? 1 : 0; }
__device__ __forceinline__ int row_i(int r) { return r >= SEG ? r - SEG : r; }
__device__ __forceinline__ int row_v(int r) { const int i = row_i(r); return i < CTXL ? 2 : row_b(r); }
__device__ __forceinline__ float* hptr2(float* hc, float* out, int r) {
    const int b = row_b(r), i = row_i(r);
    return i < CTXL ? hc + (size_t)(b * CTXL + i) * D : out + (size_t)(b * SEQ + i - CTXL) * D;
}
__device__ __forceinline__ float* hptr(CP p, int r) { return hptr2((float*)(p->ws + WS_HC), p->out, r); }
__device__ __forceinline__ const float* hin_ptr(CP p, int l, int r) {
    if (l == 0) return hptr2((float*)p->ctx, (float*)p->x, r);
    return hptr(p, r);
}

namespace pg8 {
constexpr int BM = 256, BK = 64, HALF = 128, HTB = HALF * BK * 2, STAGE_BYTES = 8 * HTB, NXCD = 8, WGM = 8;
__device__ __forceinline__ int lds_byte(int r, int c) { const int st = (r >> 4) * 2 + (c >> 5), rr = r & 15, cc = c & 31, ob = rr * 64 + cc * 2; return st * 1024 + (ob ^ (((ob >> 9) & 1) << 5)); }
__device__ __forceinline__ void stage_rc(int b, int& Rr, int& Cc) { const int st = b / 1024, sb = b % 1024, swz = sb ^ (((sb >> 9) & 1) << 5); Rr = (st >> 1) * 16 + swz / 64; Cc = (st & 1) * 32 + (swz % 64) / 2; }
__device__ __forceinline__ int perm32(int rho) { const int n = rho >> 4, i = rho & 15; return 8 * (i >> 2) + 4 * n + (i & 3); }

struct Unit {
    const char* a0;
    const char* b0;
    const char* b1;
    int i0, i1, i2, i3, i4, pad;
};

template <class Epi, class Sched, bool GATHER>
__device__ __forceinline__ void gemm_phase(LAS unsigned char* lds, const int lda, const int ldb, const int K, const Sched& S, const Epi& E) {
    const int tid = launder_tid(); const int wid = __builtin_amdgcn_readfirstlane(tid >> 6), lane = tid & 63, wr = wid >> 2, wc = wid & 3, fr = lane & 15, fq = lane >> 4;
    const int nt = K / BK, ks = nt >> 1;
    int Rr[2], Cc[2];
    unsigned voffB[2];
#pragma unroll
    for (int i = 0; i < 2; ++i) { stage_rc(tid * 16 + i * 8192, Rr[i], Cc[i]); const int Rb = Epi::PERM ? ((Rr[i] & ~31) + perm32(Rr[i] & 31)) : Rr[i];
        voffB[i] = (unsigned)(Rb * ldb + Cc[i]) * 2u; }
    const size_t kstep = (size_t)(BK * 2);
    const size_t hstepB = (size_t)HALF * ldb * 2;
    const unsigned ldsw = (unsigned)wid * 1024u;
    const unsigned ldsbase = (unsigned)(unsigned long)lds;
    const int aoff = lds_byte(wr * 64 + fr, fq * 8), boff = lds_byte(wc * 32 + fr, fq * 8);
#define PG8_SA(b, h) (((b) * 2 + (h)) * HTB)
#define PG8_SB(b, h) ((4 + (b) * 2 + (h)) * HTB)
#define PG8_STAGE2(bufoff, gbase, v0, v1) do { unsigned keep_; \
        asm volatile("s_mov_b32 %0, m0\n\ts_mov_b32 m0, %1\n\ts_nop 4\n\tglobal_load_lds_dwordx4 %2, %4\n\ts_add_u32 m0, m0, 0x2000\n\ts_nop 0\n\tglobal_load_lds_dwordx4 %3, %4\n\ts_mov_b32 m0, %0" \
            : "=&s"(keep_) : "s"(ldsbase + (unsigned)(bufoff) + ldsw), "v"(v0), "v"(v1), "s"(gbase) : "memory", "scc"); } while (0)
#define PG8_LDA(dst, b, h) do { _Pragma("unroll") for (int m = 0; m < 4; ++m) _Pragma("unroll") for (int k = 0; k < 2; ++k) dst[m][k] = *(const LAS bf16x8*)(lds + PG8_SA(b, h) + aoff + m * 2048 + k * 1024); } while (0)
#define PG8_LDB(dst, b, h) do { _Pragma("unroll") for (int n = 0; n < 2; ++n) _Pragma("unroll") for (int k = 0; k < 2; ++k) dst[n][k] = *(const LAS bf16x8*)(lds + PG8_SB(b, h) + boff + n * 2048 + k * 1024); } while (0)
#define PG8_MMA(ai, bj, At, Bt) do { __builtin_amdgcn_s_setprio(1); _Pragma("unroll") for (int m = 0; m < 4; ++m) _Pragma("unroll") for (int n = 0; n < 2; ++n) _Pragma("unroll") for (int k = 0; k < 2; ++k) \
        acc[ai][bj][m][n] = __builtin_amdgcn_mfma_f32_16x16x32_bf16(Bt[n][k], At[m][k], acc[ai][bj][m][n], 0, 0, 0); __builtin_amdgcn_s_setprio(0); } while (0)
#define PG8_WAIT_V(n) asm volatile("s_waitcnt vmcnt(" #n ")" ::: "memory")
#define PG8_WAIT_L(n) asm volatile("s_waitcnt lgkmcnt(" #n ")" ::: "memory")
#define PG8_BAR __builtin_amdgcn_s_barrier()
#define PG8_SCHED __builtin_amdgcn_sched_barrier(0)
#define PG8_BP(u, tt) ((tt) < ks ? (u).b0 + (size_t)(tt) * kstep : (u).b1 + (size_t)((tt) - ks) * kstep)
    Unit cur, nxt; int ui = 0;
    if (!S.get(0, cur)) return;
    unsigned c00, c01, c10, c11, n00, n01, n10, n11;
    if (GATHER) {
        c00 = (unsigned)(S.arow(cur, Rr[0]) * lda + Cc[0]) * 2u; c01 = (unsigned)(S.arow(cur, Rr[1]) * lda + Cc[1]) * 2u;
        c10 = (unsigned)(S.arow(cur, HALF + Rr[0]) * lda + Cc[0]) * 2u; c11 = (unsigned)(S.arow(cur, HALF + Rr[1]) * lda + Cc[1]) * 2u;
    } else {
        c00 = (unsigned)(Rr[0] * lda + Cc[0]) * 2u; c01 = (unsigned)(Rr[1] * lda + Cc[1]) * 2u;
        c10 = (unsigned)((HALF + Rr[0]) * lda + Cc[0]) * 2u; c11 = (unsigned)((HALF + Rr[1]) * lda + Cc[1]) * 2u;
    }
    n00 = c00; n01 = c01; n10 = c10; n11 = c11;
    f32x4 acc[2][2][4][2];
#pragma unroll
    for (int a = 0; a < 2; ++a)
#pragma unroll
        for (int b = 0; b < 2; ++b)
#pragma unroll
            for (int m = 0; m < 4; ++m)
#pragma unroll
                for (int n = 0; n < 2; ++n) acc[a][b][m][n] = (f32x4){0.f, 0.f, 0.f, 0.f};
    bf16x8 At[4][2], B0[2][2], B1[2][2];
    const char* cA = cur.a0;
    {
        const char* pb0 = PG8_BP(cur, 0); const char* pb1 = PG8_BP(cur, 1);
        PG8_STAGE2(PG8_SB(0, 0), pb0, voffB[0], voffB[1]); PG8_STAGE2(PG8_SA(0, 0), cA, c00, c01);
        PG8_STAGE2(PG8_SB(0, 1), pb0 + hstepB, voffB[0], voffB[1]); PG8_STAGE2(PG8_SA(0, 1), cA, c10, c11);
        if (wr == 1) PG8_BAR;
        PG8_WAIT_V(4); PG8_BAR;
        PG8_STAGE2(PG8_SB(1, 0), pb1, voffB[0], voffB[1]); PG8_STAGE2(PG8_SA(1, 0), cA + kstep, c00, c01);
        PG8_STAGE2(PG8_SB(1, 1), pb1 + hstepB, voffB[0], voffB[1]);
        PG8_WAIT_V(6); PG8_BAR;
    }
    for (;;) {
        const bool has_next = S.get(ui + 1, nxt);
        if (!has_next) nxt = cur;
        if (GATHER) {
            if (has_next) {
                n00 = (unsigned)(S.arow(nxt, Rr[0]) * lda + Cc[0]) * 2u; n01 = (unsigned)(S.arow(nxt, Rr[1]) * lda + Cc[1]) * 2u;
                n10 = (unsigned)(S.arow(nxt, HALF + Rr[0]) * lda + Cc[0]) * 2u; n11 = (unsigned)(S.arow(nxt, HALF + Rr[1]) * lda + Cc[1]) * 2u;
            } else { n00 = c00; n01 = c01; n10 = c10; n11 = c11; }
        }
        const char* nA = nxt.a0;
        for (int t = 0; t < nt; t += 2) {
            const bool last = (t == nt - 2);
            const char* a1 = cA + (size_t)(t + 1) * kstep;
            const char* a2 = last ? nA : cA + (size_t)(t + 2) * kstep;
            const char* a3 = a2 + kstep;
            const char* b2 = last ? PG8_BP(nxt, 0) : PG8_BP(cur, t + 2);
            const char* b3 = last ? PG8_BP(nxt, 1) : PG8_BP(cur, t + 3);
            const unsigned s00 = last ? n00 : c00, s01 = last ? n01 : c01, s10 = last ? n10 : c10, s11 = last ? n11 : c11;
            PG8_LDB(B0, 0, 0); PG8_SCHED; PG8_LDA(At, 0, 0); PG8_STAGE2(PG8_SA(1, 1), a1, c10, c11);
            PG8_WAIT_L(8); PG8_BAR; PG8_WAIT_L(0); PG8_MMA(0, 0, At, B0); PG8_BAR; PG8_SCHED;
            PG8_LDB(B1, 0, 1); PG8_STAGE2(PG8_SB(0, 0), b2, voffB[0], voffB[1]);
            PG8_BAR; PG8_WAIT_L(0); PG8_MMA(0, 1, At, B1); PG8_BAR;
            PG8_LDA(At, 0, 1); PG8_STAGE2(PG8_SA(0, 0), a2, s00, s01);
            PG8_BAR; PG8_WAIT_L(0); PG8_MMA(1, 0, At, B0); PG8_BAR; PG8_SCHED;
            PG8_STAGE2(PG8_SB(0, 1), b2 + hstepB, voffB[0], voffB[1]);
            PG8_WAIT_V(6); PG8_BAR; PG8_MMA(1, 1, At, B1); PG8_BAR;
            PG8_LDB(B0, 1, 0); PG8_SCHED; PG8_LDA(At, 1, 0); PG8_STAGE2(PG8_SA(0, 1), a2, s10, s11);
            PG8_WAIT_L(8); PG8_BAR; PG8_WAIT_L(0); PG8_MMA(0, 0, At, B0); PG8_BAR; PG8_SCHED;
            PG8_LDB(B1, 1, 1); PG8_STAGE2(PG8_SB(1, 0), b3, voffB[0], voffB[1]);
            PG8_BAR; PG8_WAIT_L(0); PG8_MMA(0, 1, At, B1); PG8_BAR;
            PG8_LDA(At, 1, 1); PG8_STAGE2(PG8_SA(1, 0), a3, s00, s01);
            PG8_BAR; PG8_WAIT_L(0); PG8_MMA(1, 0, At, B0); PG8_BAR; PG8_SCHED;
            PG8_STAGE2(PG8_SB(1, 1), b3 + hstepB, voffB[0], voffB[1]);
            PG8_WAIT_V(6); PG8_BAR; PG8_MMA(1, 1, At, B1); PG8_BAR;
        }
        E(acc, cur, wr, wc, fr, fq);
        if (!has_next) break;
#pragma unroll
        for (int a = 0; a < 2; ++a)
#pragma unroll
            for (int b = 0; b < 2; ++b)
#pragma unroll
                for (int m = 0; m < 4; ++m)
#pragma unroll
                    for (int n = 0; n < 2; ++n) acc[a][b][m][n] = (f32x4){0.f, 0.f, 0.f, 0.f};
        cur = nxt; cA = nA; ++ui; c00 = n00; c01 = n01; c10 = n10; c11 = n11;
    }
    PG8_WAIT_V(0);
    if (wr == 0) PG8_BAR;
    PG8_BAR;
#undef PG8_SA
#undef PG8_SB
#undef PG8_STAGE2
#undef PG8_LDA
#undef PG8_LDB
#undef PG8_MMA
#undef PG8_WAIT_V
#undef PG8_WAIT_L
#undef PG8_BAR
#undef PG8_SCHED
#undef PG8_BP
}

struct DenseSched {
    const char* A; const char* Bt; int lda, ldb, K; int nM, nN, nwg, G, c;
    __device__ __forceinline__ void init(const void* A_, const void* Bt_, int M, int N, int K_, int lda_, int ldb_, int G_, int c_) {
        A = (const char*)A_; Bt = (const char*)Bt_; lda = lda_; ldb = ldb_; K = K_; nM = M / BM; nN = N / BM; nwg = nM * nN; G = G_; c = c_; }
    __device__ __forceinline__ bool get(int i, Unit& u) const {
        const long L = (long)i * G + c; if (L >= nwg) return false;
        int wgid = (int)L; { const int q = nwg / NXCD, r = nwg % NXCD, xcd = wgid % NXCD, off = wgid / NXCD; wgid = (xcd < r ? xcd * (q + 1) : r * (q + 1) + (xcd - r) * q) + off; }
        const int nig = WGM * nN, gid = wgid / nig, fm = gid * WGM, gsz = (nM - fm) < WGM ? (nM - fm) : WGM;
        const int pm = fm + ((wgid % nig) % gsz), pn = (wgid % nig) / gsz;
        u.a0 = A + (size_t)pm * BM * lda * 2; u.b0 = Bt + (size_t)pn * BM * ldb * 2; u.b1 = u.b0 + (size_t)(K / BK / 2) * BK * 2;
        u.i0 = pm; u.i1 = pn; u.i2 = 0; u.i3 = 0; u.i4 = 0; u.pad = 0; return true;
    }
    __device__ __forceinline__ int arow(const Unit&, int rl) const { return rl; }
};
}

struct EpiProj {
    static constexpr bool PERM = true;
    bf16_t* O;
    __device__ __forceinline__ void operator()(const f32x4 (&acc)[2][2][4][2], const pg8::Unit& u, int wr, int wc, int fr, int fq) const {
        const int row0 = u.i0 * 256 + wr * 64 + fr, col0 = u.i1 * 256 + wc * 32 + 8 * fq;
#pragma unroll
        for (int ai = 0; ai < 2; ++ai)
#pragma unroll
            for (int m = 0; m < 4; ++m) { bf16_t* rowp = O + (size_t)(row0 + ai * 128 + m * 16) * NPROJ + col0;
#pragma unroll
                for (int bj = 0; bj < 2; ++bj) { const f32x4 v0 = acc[ai][bj][m][0], v1 = acc[ai][bj][m][1];
                    u32x4 w; w.x = cvt_pk_bf16(v0[0], v0[1]); w.y = cvt_pk_bf16(v0[2], v0[3]); w.z = cvt_pk_bf16(v1[0], v1[1]); w.w = cvt_pk_bf16(v1[2], v1[3]);
                    *(u32x4*)(rowp + bj * 128) = w; } }
    }
};
struct EpiResid {
    static constexpr bool PERM = false;
    const float* inc; const float* inx; float* hc; float* out; const float* modl;
    __device__ __forceinline__ void operator()(const f32x4 (&acc)[2][2][4][2], const pg8::Unit& u, int wr, int wc, int fr, int fq) const {
        const int r0 = u.i0 * 256;
        const int v = row_v(r0);
        const float* gate = modl + (size_t)v * 6144 + 2 * 1024;
        const float* hin = hptr2((float*)inc, (float*)inx, r0); float* hout = hptr2(hc, out, r0);
        const int rl0 = wr * 64 + fr, col0 = u.i1 * 256 + wc * 32 + 4 * fq;
        f32x4 gv[2][2];
#pragma unroll
        for (int bj = 0; bj < 2; ++bj)
#pragma unroll
            for (int n = 0; n < 2; ++n) gv[bj][n] = *(const f32x4*)(gate + col0 + bj * 128 + n * 16);
#pragma unroll
        for (int ai = 0; ai < 2; ++ai)
#pragma unroll
            for (int m = 0; m < 4; ++m) { const size_t off = (size_t)(rl0 + ai * 128 + m * 16) * D + col0;
#pragma unroll
                for (int bj = 0; bj < 2; ++bj)
#pragma unroll
                    for (int n = 0; n < 2; ++n) { const f32x4 hi = *(const f32x4*)(hin + off + bj * 128 + n * 16);
                        *(f32x4*)(hout + off + bj * 128 + n * 16) = hi + gv[bj][n] * acc[ai][bj][m][n]; }
                asm volatile("" ::: "memory"); }
    }
};

struct MoeSched {
    const LAS int* tab;
    const int* list;
    const char* A; const char* W; int mode  , l, G, c;
    __device__ __forceinline__ bool get(int i, pg8::Unit& u) const {
        const int L = i * G + c; const int total = __builtin_amdgcn_readfirstlane(tab[24]) * 4; if (L >= total) return false;
        const int tl = L >> 2, pn = L & 3;
        int cls = 0;
#pragma unroll 1
        for (int q = 1; q < NCLS; ++q) { const int tq = __builtin_amdgcn_readfirstlane(tab[q]); if (tq <= tl) cls = q; }
        const int j = tl - __builtin_amdgcn_readfirstlane(tab[cls]), cnt = __builtin_amdgcn_readfirstlane(tab[32 + cls]);
        const int g = cls / 6, pidx = cls - g * 6;
        const int ea = (pidx >= 3) + (pidx >= 5), eb = pidx < 3 ? pidx + 1 : (pidx < 5 ? pidx - 1 : 3);
        if (mode == 0) {
            const int e = 4 * g + (pn < 2 ? ea : eb);
            u.a0 = A;
            u.b0 = W + ((size_t)(l * 16 + e) * 512 + (size_t)(pn & 1) * 256) * 1024 * 2; u.b1 = u.b0 + (size_t)8 * 128;
        } else {
            u.a0 = A + (size_t)tl * 256 * 512 * 2;
            u.b0 = W + ((size_t)(l * 16 + 4 * g + ea) * 1024 + (size_t)pn * 256) * 256 * 2;
            u.b1 = W + ((size_t)(l * 16 + 4 * g + eb) * 1024 + (size_t)pn * 256) * 256 * 2;
        }
        u.i0 = cls; u.i1 = j; u.i2 = pn; u.i3 = cnt; u.i4 = tl; u.pad = 0; return true;
    }
    __device__ __forceinline__ int arow(const pg8::Unit& u, int rl) const {
        int idx = u.i1 * 256 + rl; idx = idx < u.i3 ? idx : u.i3 - 1;
        return list[(size_t)u.i0 * R + idx];
    }
};
struct EpiUp {
    static constexpr bool PERM = true;
    bf16_t* hid; const float* cwla; const float* cwlb;
    __device__ __forceinline__ void operator()(const f32x4 (&acc)[2][2][4][2], const pg8::Unit& u, int wr, int wc, int fr, int fq) const {
        const int cls = u.i0, j = u.i1, pn = u.i2, cnt = u.i3, tl = u.i4;
        const float* cw = (pn < 2) ? cwla : cwlb;
        const int colbase = (pn >> 1) * 256 + (pn & 1) * 128 + wc * 32 + 8 * fq;
#pragma unroll
        for (int ai = 0; ai < 2; ++ai)
#pragma unroll
            for (int m = 0; m < 4; ++m) {
                const int rl = ai * 128 + wr * 64 + m * 16 + fr; const int idx = j * 256 + rl; const bool valid = idx < cnt;
                float w = 0.f; if (valid) w = cw[(size_t)cls * R + idx];
                const f32x4 g0 = acc[ai][0][m][0], g1 = acc[ai][0][m][1], u0 = acc[ai][1][m][0], u1 = acc[ai][1][m][1];
                float o[8];
#pragma unroll
                for (int e = 0; e < 4; ++e) { o[e] = w * siluf_(g0[e]) * u0[e]; o[4 + e] = w * siluf_(g1[e]) * u1[e]; }
                if (!valid) {
#pragma unroll
                    for (int e = 0; e < 8; ++e) o[e] = 0.f; }
                u32x4 pk; pk.x = cvt_pk_bf16(o[0], o[1]); pk.y = cvt_pk_bf16(o[2], o[3]); pk.z = cvt_pk_bf16(o[4], o[5]); pk.w = cvt_pk_bf16(o[6], o[7]);
                *(u32x4*)(hid + ((size_t)tl * 256 + rl) * 512 + colbase) = pk;
            }
    }
};
struct EpiY {
    static constexpr bool PERM = true;
    bf16_t* Y;
    __device__ __forceinline__ void operator()(const f32x4 (&acc)[2][2][4][2], const pg8::Unit& u, int wr, int wc, int fr, int fq) const {
        const int row0 = u.i4 * 256 + wr * 64 + fr, col0 = u.i2 * 256 + wc * 32 + 8 * fq;
#pragma unroll
        for (int ai = 0; ai < 2; ++ai)
#pragma unroll
            for (int m = 0; m < 4; ++m) { bf16_t* rowp = Y + (size_t)(row0 + ai * 128 + m * 16) * 1024 + col0;
#pragma unroll
                for (int bj = 0; bj < 2; ++bj) { const f32x4 v0 = acc[ai][bj][m][0], v1 = acc[ai][bj][m][1];
                    u32x4 w; w.x = cvt_pk_bf16(v0[0], v0[1]); w.y = cvt_pk_bf16(v0[2], v0[3]); w.z = cvt_pk_bf16(v1[0], v1[1]); w.w = cvt_pk_bf16(v1[2], v1[3]);
                    *(u32x4*)(rowp + bj * 128) = w; } }
    }
};

__device__ __forceinline__ void tr_tile(const float* src, int ldn, int k0, int n0, int nvalid, bf16_t* dst, int ldk, int drow0, float* tile) {
    const int tid = launder_tid();
    { const int n = tid & 63; int kk = tid >> 6;
#pragma unroll
      for (int it = 0; it < 8; ++it, kk += 8) tile[kk * 65 + n] = (n < nvalid) ? src[(size_t)(k0 + kk) * ldn + n0 + n] : 0.f; }
    __syncthreads();
    { const int k8 = tid & 7, n = tid >> 3;
      if (n < nvalid) { const float* s = tile + (k8 * 8) * 65 + n;
          u32x4 o; o.x = cvt_pk_bf16(s[0], s[65]); o.y = cvt_pk_bf16(s[2 * 65], s[3 * 65]); o.z = cvt_pk_bf16(s[4 * 65], s[5 * 65]); o.w = cvt_pk_bf16(s[6 * 65], s[7 * 65]);
          *(u32x4*)(dst + (size_t)(drow0 + n) * ldk + k0 + k8 * 8) = o; } }
    __syncthreads();
}
__device__ __forceinline__ void phase_wprep(CP p, unsigned char* lds, int bid, int nb) {
    float* tile = (float*)lds;
    constexpr int I_IN = 16 * 41, I_OUT = 256, I_G = 1024, I_U = 1024, I_D = 1024, I_L = I_IN + I_OUT + I_G + I_U + I_D;
    for (int it = bid; it < 2 * I_L; it += nb) {
        const int l = it / I_L; int r = it - l * I_L;
        if (r < I_IN) { const int kt = r / 41, ntl = r % 41; const int n0 = ntl * 64; const int nv = (DIN - n0) < 64 ? (DIN - n0) : 64;
            tr_tile(p->w_in + (size_t)l * 1024 * DIN, DIN, kt * 64, n0, nv, (bf16_t*)(p->ws + WS_WTIN) + (size_t)l * DIN * 1024, 1024, n0, tile); continue; }
        r -= I_IN;
        if (r < I_OUT) { const int kt = r >> 4, ntl = r & 15;
            tr_tile(p->w_out + (size_t)l * 1024 * 1024, 1024, kt * 64, ntl * 64, 64, (bf16_t*)(p->ws + WS_WTOUT) + (size_t)l * 1024 * 1024, 1024, ntl * 64, tile); continue; }
        r -= I_OUT;
        if (r < I_G + I_U) { const int up = r >= I_G; if (up) r -= I_G; const int e = r >> 6, q = r & 63, kt = q >> 2, ntl = q & 3; const int n0 = ntl * 64;
            const float* src = (up ? p->w_up : p->w_gate) + (size_t)(l * 16 + e) * 1024 * 256;
            tr_tile(src, 256, kt * 64, n0, 64, (bf16_t*)(p->ws + WS_WTGU) + (size_t)(l * 16 + e) * 512 * 1024, 1024, (n0 >> 7) * 256 + (n0 & 127) + (up ? 128 : 0), tile); continue; }
        r -= I_G + I_U;
        { const int e = r >> 6, q = r & 63, kt = q >> 4, ntl = q & 15;
          tr_tile(p->w_down + (size_t)(l * 16 + e) * 256 * 1024, 1024, kt * 64, ntl * 64, 64, (bf16_t*)(p->ws + WS_WTD) + (size_t)(l * 16 + e) * 1024 * 256, 256, ntl * 64, tile); }
    }
}
__device__ __forceinline__ void phase_adaln(CP p, unsigned char* lds, int bid, int nb) {
    float* sc = (float*)lds;
    float* red = sc + 3 * 1024;
    const int tid = launder_tid();
    for (int idx = tid; idx < 3 * 1024; idx += NTHREADS) { const int v = idx >> 10, k = idx & 1023; const float cv = (v < 2) ? p->c[v * 1024 + k] : p->c_ctx[k]; sc[idx] = siluf_(cv); }
    __syncthreads();
    float* mod = (float*)(p->ws + WS_MOD);
    for (int it = bid; it < 2 * 96; it += nb) {
        const int l = it / 96, n0 = (it % 96) * 64;
        const int c4 = tid & 15, kr = tid >> 4;
        f32x4 a0 = {0, 0, 0, 0}, a1 = {0, 0, 0, 0}, a2 = {0, 0, 0, 0};
        const float* w = p->w_ada + (size_t)l * 1024 * 6144 + n0 + c4 * 4;
#pragma unroll 4
        for (int k = kr; k < 1024; k += 32) { const f32x4 w4 = *(const f32x4*)(w + (size_t)k * 6144); a0 += sc[k] * w4; a1 += sc[1024 + k] * w4; a2 += sc[2048 + k] * w4; }
        *(f32x4*)(red + (kr * 3 + 0) * 64 + c4 * 4) = a0; *(f32x4*)(red + (kr * 3 + 1) * 64 + c4 * 4) = a1; *(f32x4*)(red + (kr * 3 + 2) * 64 + c4 * 4) = a2;
        __syncthreads();
        if (tid < 192) { const int v = tid >> 6, cc = tid & 63; float s = 0.f;
            for (int q = 0; q < 32; ++q) s += red[(q * 3 + v) * 64 + cc];
            mod[((size_t)l * 3 + v) * 6144 + n0 + cc] = s + p->b_ada[l * 6144 + n0 + cc]; }
        __syncthreads();
    }
}
__device__ __forceinline__ void moe_table(CP p, int l, LAS int* tab) {
    const int* gcount = (const int*)(p->ws + WS_CTL) + l * 32;
    if (threadIdx.x == 0) { int acc = 0; for (int q = 0; q < NCLS; ++q) { const int cn = gcount[q]; tab[q] = acc; tab[32 + q] = cn; acc += (cn + 255) >> 8; } tab[24] = acc; }
    __syncthreads();
}
__device__ __forceinline__ void moe_apply(CP p, int lm, int r, int v, int lane, const LAS int* tab, f32x4 (&xv)[4]) {
    const int pos = ((const int*)(p->ws + WS_POS))[(size_t)lm * R + r];
    const int slot = tab[pos >> 16] * 256 + (pos & 0xffff);
    const bf16_t* y = (const bf16_t*)(p->ws + WS_Y) + (size_t)slot * 1024;
    const float* gate = (const float*)(p->ws + WS_MOD) + ((size_t)lm * 3 + v) * 6144 + 5 * 1024;
#pragma unroll
    for (int j = 0; j < 4; ++j) { const int k = 4 * lane + 256 * j; const u32x2 yv = *(const u32x2*)(y + k); const f32x4 g4 = *(const f32x4*)(gate + k);
        xv[j][0] += g4[0] * bflo(yv.x); xv[j][1] += g4[1] * bfhi(yv.x); xv[j][2] += g4[2] * bflo(yv.y); xv[j][3] += g4[3] * bfhi(yv.y); }
}
__device__ __forceinline__ void phase_r1(CP p, int l, unsigned char* lds, int bid, int nb) {
    float* wdt = (float*)lds;
    float* gm = wdt + 16 * 1024;
    float* sh = gm + 3 * 1024;
    const int tid = launder_tid(); const int lane = tid & 63, wave = tid >> 6;
    const float* mod = (const float*)(p->ws + WS_MOD) + (size_t)l * 3 * 6144;
    const float* win = p->w_in + (size_t)l * 1024 * DIN;
    for (int idx = tid; idx < 16 * 1024; idx += NTHREADS) { const int k = idx >> 4, n = idx & 15; wdt[n * 1024 + k] = win[(size_t)k * DIN + NPROJ + n]; }
    for (int idx = tid; idx < 3 * 1024; idx += NTHREADS) { const int v = idx >> 10, k = idx & 1023; gm[idx] = p->g_mix[l * 1024 + k] * (1.f + mod[v * 6144 + 1024 + k]); sh[idx] = mod[v * 6144 + k]; }
    LAS int* tab = (LAS int*)((LAS unsigned char*)lds + MISC_OFF);
    if (l > 0) moe_table(p, l - 1, tab);
    __syncthreads();
    bf16_t* HX = (bf16_t*)(p->ws + WS_HX); float* DT = (float*)(p->ws + WS_DT);
    for (int r = bid * 8 + wave; r < R; r += nb * 8) {
        const f32x4* hr = (const f32x4*)hin_ptr(p, l, r); const int v = row_v(r);
        f32x4 xv[4]; float ss = 0.f;
#pragma unroll
        for (int j = 0; j < 4; ++j) xv[j] = hr[lane + 64 * j];
        if (l > 0) { moe_apply(p, l - 1, r, v, lane, tab, xv); f32x4* hw = (f32x4*)hptr(p, r);
#pragma unroll
            for (int j = 0; j < 4; ++j) hw[lane + 64 * j] = xv[j]; }
#pragma unroll
        for (int j = 0; j < 4; ++j) ss += xv[j][0] * xv[j][0] + xv[j][1] * xv[j][1] + xv[j][2] * xv[j][2] + xv[j][3] * xv[j][3];
        ss = wave_sum(ss); const float rs = rsqrtf(ss * (1.f / 1024.f) + 1e-6f);
#pragma unroll
        for (int j = 0; j < 4; ++j) { const int k = 4 * lane + 256 * j; const f32x4 g4 = *(const f32x4*)(gm + v * 1024 + k), s4 = *(const f32x4*)(sh + v * 1024 + k);
            xv[j] = xv[j] * rs * g4 + s4;
            u32x2 o; o.x = cvt_pk_bf16(xv[j][0], xv[j][1]); o.y = cvt_pk_bf16(xv[j][2], xv[j][3]);
            *(u32x2*)(HX + (size_t)r * 1024 + k) = o; }
        float mine = 0.f;
#pragma unroll
        for (int n = 0; n < 16; ++n) { float a = 0.f;
#pragma unroll
            for (int j = 0; j < 4; ++j) { const f32x4 w4 = *(const f32x4*)(wdt + n * 1024 + 4 * lane + 256 * j); a += xv[j][0] * w4[0] + xv[j][1] * w4[1] + xv[j][2] * w4[2] + xv[j][3] * w4[3]; }
            a = wave_sum(a); mine = (lane == n) ? a : mine; }
        if (lane < 16) DT[(size_t)r * 16 + lane] = softplusf_(mine + p->dt_bias[l * 16 + lane]);
    }
}
__device__ __forceinline__ void phase_c1_naive(CP p, int l, unsigned char* lds, int bid, int nb) {
    float* red = (float*)lds;
    const int tid = launder_tid(); const int lane = tid & 63, wave = tid >> 6, c = tid;
    const bf16_t* proj = (const bf16_t*)(p->ws + WS_PROJ); bf16_t* mix = (bf16_t*)(p->ws + WS_HX);
    float w[31];
#pragma unroll
    for (int j = 0; j < 31; ++j) w[j] = p->conv_w[((size_t)l * 31 + j) * 512 + c];
    const float cb = p->conv_b[l * 512 + c], lg = p->conv_ln_g[l * 512 + c], lb = p->conv_ln_b[l * 512 + c];
    for (int r = bid; r < R; r += nb) {
        const int i = row_i(r);
        int stride, pos, len;
        if (i < CTXL) { stride = 1; pos = i; len = CTXL; }
        else { const int t = i - CTXL; if (c < 256) { stride = 1; pos = t & 63; len = 64; } else { stride = 64; pos = t >> 6; len = 256; } }
        float y = cb;
#pragma unroll
        for (int j = 0; j < 31; ++j) { const int q = pos + j - 15;
            if (q >= 0 && q < len) { const bf16_t* pr = proj + (size_t)(r + (j - 15) * stride) * NPROJ; const float u = bf2f(pr[c]), g = bf2f(pr[512 + c]); y += w[j] * u * sigmoidf_(g); } }
        float s = wave_sum(y); if (lane == 0) red[wave] = s; __syncthreads();
        float mu = 0.f;
#pragma unroll
        for (int q = 0; q < 8; ++q) mu += red[q];
        mu *= (1.f / 512.f); const float d = y - mu;
        float s2 = wave_sum(d * d); if (lane == 0) red[8 + wave] = s2; __syncthreads();
        float var = 0.f;
#pragma unroll
        for (int q = 0; q < 8; ++q) var += red[8 + q];
        var *= (1.f / 512.f);
        const float yn = d * rsqrtf(var + 1e-5f) * lg + lb;
        mix[(size_t)r * 1024 + c] = f2bf(siluf_(yn));
        __syncthreads();
    }
}
__device__ __forceinline__ void phase_s1_naive(CP p, int l, int bid, int nb) {
    const bf16_t* proj = (const bf16_t*)(p->ws + WS_PROJ); bf16_t* xbc = (bf16_t*)(p->ws + WS_XBC);
    const float* cw = p->ssd_conv_w + (size_t)l * 5 * 1024; const float* cbias = p->ssd_conv_b + (size_t)l * 1024;
    const int tid = launder_tid();
    for (int idx = bid * NTHREADS + tid; idx < R * 128; idx += nb * NTHREADS) {
        const int r = idx >> 7, c0 = (idx & 127) * 8; const int i = row_i(r);
        int pos, len; if (i < CTXL) { pos = i; len = CTXL; } else { pos = i - CTXL; len = SEQ; }
        float a[8];
#pragma unroll
        for (int e = 0; e < 8; ++e) a[e] = cbias[c0 + e];
#pragma unroll
        for (int j = 0; j < 5; ++j) { const int q = pos + j - 2;
            if (q >= 0 && q < len) { const u32x4 xv = *(const u32x4*)(proj + (size_t)(r + j - 2) * NPROJ + 1536 + c0); const float* wj = cw + j * 1024 + c0;
                a[0] += wj[0] * bflo(xv.x); a[1] += wj[1] * bfhi(xv.x); a[2] += wj[2] * bflo(xv.y); a[3] += wj[3] * bfhi(xv.y);
                a[4] += wj[4] * bflo(xv.z); a[5] += wj[5] * bfhi(xv.z); a[6] += wj[6] * bflo(xv.w); a[7] += wj[7] * bfhi(xv.w); } }
        u32x4 o; o.x = cvt_pk_bf16(siluf_(a[0]), siluf_(a[1])); o.y = cvt_pk_bf16(siluf_(a[2]), siluf_(a[3])); o.z = cvt_pk_bf16(siluf_(a[4]), siluf_(a[5])); o.w = cvt_pk_bf16(siluf_(a[6]), siluf_(a[7]));
        *(u32x4*)(xbc + (size_t)r * 1024 + c0) = o;
    }
}
__device__ __forceinline__ void phase_scan_naive(CP p, int l, int bid, int nb) {
    const int tid = launder_tid(); const int lane = tid & 63, wave = tid >> 6;
    const int gw = bid * 8 + wave;
    if (gw < 32) {
        const int b = gw >> 4, dir = (gw >> 3) & 1, h = gw & 7, g = h >> 2;
        const float A = -expf(p->a_log[l * 16 + dir * 8 + h]);
        const bf16_t* xbc = (const bf16_t*)(p->ws + WS_XBC); const float* DT = (const float*)(p->ws + WS_DT);
        float* Y = (float*)(p->ws + (dir ? WS_YB : WS_YF));
        float hs[128];
#pragma unroll
        for (int n = 0; n < 128; ++n) hs[n] = 0.f;
        for (int step = 0; step < SEG; ++step) {
            int i; if (dir == 0) i = step; else i = (step < CTXL) ? (CTXL - 1 - step) : (SEG - 1 - (step - CTXL));
            const int r = b * SEG + i;
            const bf16_t* xr = xbc + (size_t)r * 1024;
            const float x = bf2f(xr[h * 64 + lane]); const float dt = DT[(size_t)r * 16 + dir * 8 + h];
            const float dA = __expf(dt * A), dx = dt * x;
            const u32x4* Bp = (const u32x4*)(xr + 512 + g * 128); const u32x4* Cp = (const u32x4*)(xr + 768 + g * 128);
            float y = 0.f;
#pragma unroll
            for (int q = 0; q < 16; ++q) { const u32x4 bv = Bp[q], cv = Cp[q];
                hs[8 * q + 0] = hs[8 * q + 0] * dA + dx * bflo(bv.x); y += hs[8 * q + 0] * bflo(cv.x);
                hs[8 * q + 1] = hs[8 * q + 1] * dA + dx * bfhi(bv.x); y += hs[8 * q + 1] * bfhi(cv.x);
                hs[8 * q + 2] = hs[8 * q + 2] * dA + dx * bflo(bv.y); y += hs[8 * q + 2] * bflo(cv.y);
                hs[8 * q + 3] = hs[8 * q + 3] * dA + dx * bfhi(bv.y); y += hs[8 * q + 3] * bfhi(cv.y);
                hs[8 * q + 4] = hs[8 * q + 4] * dA + dx * bflo(bv.z); y += hs[8 * q + 4] * bflo(cv.z);
                hs[8 * q + 5] = hs[8 * q + 5] * dA + dx * bfhi(bv.z); y += hs[8 * q + 5] * bfhi(cv.z);
                hs[8 * q + 6] = hs[8 * q + 6] * dA + dx * bflo(bv.w); y += hs[8 * q + 6] * bflo(cv.w);
                hs[8 * q + 7] = hs[8 * q + 7] * dA + dx * bfhi(bv.w); y += hs[8 * q + 7] * bfhi(cv.w); }
            Y[(size_t)r * 512 + h * 64 + lane] = y;
        }
    }
}
__device__ __forceinline__ void phase_s3_naive(CP p, int l, int bid, int nb) {
    const int tid = launder_tid(); const int lane = tid & 63, wave = tid >> 6;
    const bf16_t* xbc = (const bf16_t*)(p->ws + WS_XBC); const bf16_t* proj = (const bf16_t*)(p->ws + WS_PROJ);
    const float* YF = (const float*)(p->ws + WS_YF); const float* YB = (const float*)(p->ws + WS_YB); bf16_t* mix = (bf16_t*)(p->ws + WS_HX);
    const float dsk = p->d_skip[l * 8 + (lane >> 3)];
    for (int r = bid * 8 + wave; r < R; r += nb * 8) {
        const int c0 = lane * 8;
        const u32x4 xv = *(const u32x4*)(xbc + (size_t)r * 1024 + c0); const u32x4 zv = *(const u32x4*)(proj + (size_t)r * NPROJ + 1024 + c0);
        const f32x4 f0 = *(const f32x4*)(YF + (size_t)r * 512 + c0), f1 = *(const f32x4*)(YF + (size_t)r * 512 + c0 + 4);
        const f32x4 b0 = *(const f32x4*)(YB + (size_t)r * 512 + c0), b1 = *(const f32x4*)(YB + (size_t)r * 512 + c0 + 4);
        float xs[8] = {bflo(xv.x), bfhi(xv.x), bflo(xv.y), bfhi(xv.y), bflo(xv.z), bfhi(xv.z), bflo(xv.w), bfhi(xv.w)};
        float zs[8] = {bflo(zv.x), bfhi(zv.x), bflo(zv.y), bfhi(zv.y), bflo(zv.z), bfhi(zv.z), bflo(zv.w), bfhi(zv.w)};
        float val[8]; float ss = 0.f;
#pragma unroll
        for (int e = 0; e < 8; ++e) { const float y = (e < 4 ? f0[e & 3] + b0[e & 3] : f1[e & 3] + b1[e & 3]) + dsk * xs[e]; val[e] = y * siluf_(zs[e]); ss += val[e] * val[e]; }
        ss = wave_sum(ss); const float rs = rsqrtf(ss * (1.f / 512.f) + 1e-6f);
        const float* gn = p->ssd_norm_g + l * 512 + c0;
        u32x4 o; o.x = cvt_pk_bf16(val[0] * rs * gn[0], val[1] * rs * gn[1]); o.y = cvt_pk_bf16(val[2] * rs * gn[2], val[3] * rs * gn[3]);
        o.z = cvt_pk_bf16(val[4] * rs * gn[4], val[5] * rs * gn[5]); o.w = cvt_pk_bf16(val[6] * rs * gn[6], val[7] * rs * gn[7]);
        *(u32x4*)(mix + (size_t)r * 1024 + 512 + c0) = o;
    }
}
__device__ __forceinline__ void phase_r2(CP p, int l, unsigned char* lds, int bid, int nb) {
    float* wrt = (float*)lds;
    float* gm = wrt + 20 * 1024;
    float* sh = gm + 3 * 1024;
    int* lcnt = (int*)(sh + 3 * 1024);
    int* lcls = lcnt + 64;
    int* lrank = lcls + 1024;
    float* lcwa = (float*)(lrank + 1024);
    float* lcwb = lcwa + 1024;
    const int tid = launder_tid(); const int lane = tid & 63, wave = tid >> 6;
    const float* mod = (const float*)(p->ws + WS_MOD) + (size_t)l * 3 * 6144;
    for (int idx = tid; idx < 4 * 1024; idx += NTHREADS) { const int k = idx >> 2, n = idx & 3; wrt[n * 1024 + k] = p->w_rg[(size_t)l * 4096 + idx]; }
    for (int idx = tid; idx < 16 * 1024; idx += NTHREADS) { const int k = idx >> 4, n = idx & 15; wrt[(4 + n) * 1024 + k] = p->w_re[(size_t)l * 16384 + idx]; }
    for (int idx = tid; idx < 3 * 1024; idx += NTHREADS) { const int v = idx >> 10, k = idx & 1023; gm[idx] = p->g_ffn[l * 1024 + k] * (1.f + mod[v * 6144 + 4 * 1024 + k]); sh[idx] = mod[v * 6144 + 3 * 1024 + k]; }
    if (tid < 64) lcnt[tid] = 0;
    __syncthreads();
    bf16_t* HM = (bf16_t*)(p->ws + WS_HX); float* CWLA = (float*)(p->ws + WS_CWLA); float* CWLB = (float*)(p->ws + WS_CWLB); int* POS = (int*)(p->ws + WS_POS) + (size_t)l * R;
    int* gcount = (int*)(p->ws + WS_CTL) + l * 32; int* LIST = (int*)(p->ws + WS_LIST);
    const int rpb = (R + nb - 1) / nb, r0 = bid * rpb, r1 = (r0 + rpb) < R ? (r0 + rpb) : R;
    for (int r = r0 + wave; r < r1; r += 8) {
        const f32x4* hr = (const f32x4*)hptr(p, r); const int v = row_v(r);
        f32x4 xv[4]; float ss = 0.f;
#pragma unroll
        for (int j = 0; j < 4; ++j) { xv[j] = hr[lane + 64 * j]; ss += xv[j][0] * xv[j][0] + xv[j][1] * xv[j][1] + xv[j][2] * xv[j][2] + xv[j][3] * xv[j][3]; }
        ss = wave_sum(ss); const float rs = rsqrtf(ss * (1.f / 1024.f) + 1e-6f);
#pragma unroll
        for (int j = 0; j < 4; ++j) { const int k = 4 * lane + 256 * j; const f32x4 g4 = *(const f32x4*)(gm + v * 1024 + k), s4 = *(const f32x4*)(sh + v * 1024 + k);
            xv[j] = xv[j] * rs * g4 + s4;
            u32x2 o; o.x = cvt_pk_bf16(xv[j][0], xv[j][1]); o.y = cvt_pk_bf16(xv[j][2], xv[j][3]);
            *(u32x2*)(HM + (size_t)r * 1024 + k) = o; }
        float lg[20];
#pragma unroll
        for (int n = 0; n < 20; ++n) { float a = 0.f;
#pragma unroll
            for (int j = 0; j < 4; ++j) { const f32x4 w4 = *(const f32x4*)(wrt + n * 1024 + 4 * lane + 256 * j); a += xv[j][0] * w4[0] + xv[j][1] * w4[1] + xv[j][2] * w4[2] + xv[j][3] * w4[3]; }
            lg[n] = wave_sum(a) + (n < 4 ? p->b_rg[l * 4 + n] : p->b_re[l * 16 + n - 4]); }
        int gsel = 0; float gmax = lg[0];
#pragma unroll
        for (int q = 1; q < 4; ++q) if (lg[q] > gmax) { gmax = lg[q]; gsel = q; }
        float gden = 0.f;
#pragma unroll
        for (int q = 0; q < 4; ++q) gden += __expf(lg[q] - gmax);
        const float gprob = 1.f / gden;
        float el[4];
#pragma unroll
        for (int q = 0; q < 4; ++q) el[q] = gsel == 0 ? lg[4 + q] : (gsel == 1 ? lg[8 + q] : (gsel == 2 ? lg[12 + q] : lg[16 + q]));
        int i0 = 0; float m0 = el[0];
#pragma unroll
        for (int q = 1; q < 4; ++q) if (el[q] > m0) { m0 = el[q]; i0 = q; }
        int i1 = -1; float m1 = -3.0e38f;
#pragma unroll
        for (int q = 0; q < 4; ++q) if (q != i0 && el[q] > m1) { m1 = el[q]; i1 = q; }
        const float w0 = gprob / (1.f + __expf(m1 - m0)), w1 = gprob - w0;
        const int ea = i0 < i1 ? i0 : i1, eb = i0 < i1 ? i1 : i0;
        const float cwa = i0 < i1 ? w0 : w1, cwb = i0 < i1 ? w1 : w0;
        const int pidx = ea == 0 ? eb - 1 : (ea == 1 ? eb + 1 : 5);
        const int cls = gsel * 6 + pidx;
        if (lane == 0) { const int rank = atomicAdd(&lcnt[cls], 1); lcls[r - r0] = cls; lrank[r - r0] = rank; lcwa[r - r0] = cwa; lcwb[r - r0] = cwb; }
    }
    __syncthreads();
    if (tid < NCLS) lcnt[32 + tid] = atomicAdd(&gcount[tid], lcnt[tid]);
    __syncthreads();
    for (int idx = tid; idx < r1 - r0; idx += NTHREADS) { const int cl = lcls[idx]; const int pos = lcnt[32 + cl] + lrank[idx]; const size_t li = (size_t)cl * R + pos;
        LIST[li] = r0 + idx; CWLA[li] = lcwa[idx]; CWLB[li] = lcwb[idx]; POS[r0 + idx] = (cl << 16) | pos; }
    __syncthreads();
}
__device__ __forceinline__ void phase_final(CP p, unsigned char* lds, int bid, int nb) {
    const int tid = launder_tid(); const int lane = tid & 63, wave = tid >> 6;
    LAS int* tab = (LAS int*)((LAS unsigned char*)lds + MISC_OFF);
    moe_table(p, DEPTH - 1, tab);
    for (int q = bid * 8 + wave; q < NB * SEQ; q += nb * 8) {
        const int b = q >= SEQ ? 1 : 0; const int r = b * SEG + CTXL + (q - b * SEQ);
        f32x4* hr = (f32x4*)(p->out + (size_t)q * D);
        f32x4 xv[4]; float ss = 0.f;
#pragma unroll
        for (int j = 0; j < 4; ++j) xv[j] = hr[lane + 64 * j];
        moe_apply(p, DEPTH - 1, r, b, lane, tab, xv);
#pragma unroll
        for (int j = 0; j < 4; ++j) ss += xv[j][0] * xv[j][0] + xv[j][1] * xv[j][1] + xv[j][2] * xv[j][2] + xv[j][3] * xv[j][3];
        ss = wave_sum(ss); const float rs = rsqrtf(ss * (1.f / 1024.f) + 1e-6f);
#pragma unroll
        for (int j = 0; j < 4; ++j) { const f32x4 g4 = *(const f32x4*)(p->g_final + 4 * lane + 256 * j); hr[lane + 64 * j] = xv[j] * rs * g4; }
    }
}

#ifndef PHASE_MASK
#define PHASE_MASK 0xFFFFF
#endif
#define PM(i) ((PHASE_MASK >> (i)) & 1)
constexpr int PH_PER_LAYER = 9, NPHASES = 1 + DEPTH * PH_PER_LAYER + 1;
__global__ void __launch_bounds__(NTHREADS, 2) mk_fwd(Args args) {
    extern __shared__ __attribute__((aligned(16))) unsigned char lds[];
    cg::grid_group grid = cg::this_grid();
    const __attribute__((address_space(4))) Args* ap = (const __attribute__((address_space(4))) Args*)__builtin_amdgcn_kernarg_segment_ptr();
    const int lo = ap->lo, hi = ap->hi;
    const int bid = blockIdx.x, nb = gridDim.x;
    LAS unsigned char* ldsl = (LAS unsigned char*)lds;
    for (int ph = lo; ph < hi; ++ph) {
        CP p = launder(&ap->p);
        if (ph == 0) { if (PM(0)) phase_wprep(p, lds, bid, nb); if (PM(1)) phase_adaln(p, lds, bid, nb); }
        else if (ph == NPHASES - 1) { if (PM(12)) phase_final(p, lds, bid, nb); }
        else {
            const int l = (ph - 1) / PH_PER_LAYER, s = (ph - 1) % PH_PER_LAYER;
            if (s == 0) { if (PM(2)) phase_r1(p, l, lds, bid, nb); }
            else if (s == 1) { if (PM(3)) {
                pg8::DenseSched S; S.init(p->ws + WS_HX, (const bf16_t*)(p->ws + WS_WTIN) + (size_t)l * DIN * 1024, R, NPROJ, 1024, 1024, 1024, nb, bid);
                EpiProj E{(bf16_t*)(p->ws + WS_PROJ)};
                pg8::gemm_phase<EpiProj, pg8::DenseSched, false>(ldsl, 1024, 1024, 1024, S, E);
            } }
            else if (s == 2) { if (PM(4)) phase_c1_naive(p, l, lds, bid, nb); if (PM(5)) phase_s1_naive(p, l, bid, nb); }
            else if (s == 3) { if (PM(6)) phase_scan_naive(p, l, bid, nb); }
            else if (s == 4) { if (PM(7)) phase_s3_naive(p, l, bid, nb); }
            else if (s == 5) { if (PM(8)) {
                pg8::DenseSched S; S.init(p->ws + WS_HX, (const bf16_t*)(p->ws + WS_WTOUT) + (size_t)l * 1024 * 1024, R, 1024, 1024, 1024, 1024, nb, bid);
                EpiResid E{l == 0 ? p->ctx : (const float*)(p->ws + WS_HC), l == 0 ? p->x : (const float*)p->out, (float*)(p->ws + WS_HC), p->out, (const float*)(p->ws + WS_MOD) + (size_t)l * 3 * 6144};
                pg8::gemm_phase<EpiResid, pg8::DenseSched, false>(ldsl, 1024, 1024, 1024, S, E);
            } }
            else if (s == 6) { if (PM(9)) phase_r2(p, l, lds, bid, nb); }
            else if (s == 7) { if (PM(10)) {
                LAS int* tab = (LAS int*)(ldsl + MISC_OFF); moe_table(p, l, tab);
                MoeSched S{tab, (const int*)(p->ws + WS_LIST), (const char*)(p->ws + WS_HX), (const char*)(p->ws + WS_WTGU), 0, l, nb, bid};
                EpiUp E{(bf16_t*)(p->ws + WS_HID), (const float*)(p->ws + WS_CWLA), (const float*)(p->ws + WS_CWLB)};
                pg8::gemm_phase<EpiUp, MoeSched, true>(ldsl, 1024, 1024, 1024, S, E);
            } }
            else { if (PM(11)) {
                LAS int* tab = (LAS int*)(ldsl + MISC_OFF); moe_table(p, l, tab);
                MoeSched S{tab, (const int*)(p->ws + WS_LIST), (const char*)(p->ws + WS_HID), (const char*)(p->ws + WS_WTD), 1, l, nb, bid};
                EpiY E{(bf16_t*)(p->ws + WS_Y)};
                pg8::gemm_phase<EpiY, MoeSched, false>(ldsl, 512, 256, 512, S, E);
            } }
        }
        if (ph + 1 < hi) grid.sync();
    }
}

extern "C" void kernel_launch(void* const* d_in, const int* in_sizes, int n_in, void* d_out, int out_size, void* d_ws, size_t ws_size, hipStream_t stream) {
    static int grid = 0;
    if (grid == 0) {
        if (n_in != 28 || ws_size < WS_END) { fprintf(stderr, "kernel_launch: unexpected n_in %d or ws_size %zu (< %zu)\n", n_in, ws_size, (size_t)WS_END); grid = -1; return; }
        int dev = 0, cus = 0, per_cu = 0;
        hipGetDevice(&dev); hipDeviceGetAttribute(&cus, hipDeviceAttributeMultiprocessorCount, dev);
        if (hipFuncSetAttribute((const void*)mk_fwd, hipFuncAttributeMaxDynamicSharedMemorySize, LDS_BYTES) != hipSuccess) { fprintf(stderr, "kernel_launch: hipFuncSetAttribute failed\n"); grid = -1; return; }
        if (hipOccupancyMaxActiveBlocksPerMultiprocessor(&per_cu, (const void*)mk_fwd, NTHREADS, LDS_BYTES) != hipSuccess || per_cu < 1) { fprintf(stderr, "kernel_launch: occupancy query says %d\n", per_cu); (void)hipGetLastError(); grid = -1; return; }
        grid = cus;
    }
    if (grid < 0) return;
    hipMemsetAsync((char*)d_ws + WS_CTL, 0, 4096, stream);
    Args a{};
    const float** pp = (const float**)&a.p;
    for (int i = 0; i < 28; ++i) pp[i] = (const float*)d_in[i];
    a.p.out = (float*)d_out; a.p.ws = (unsigned char*)d_ws;
#if PER_PHASE_LAUNCH
    for (int ph = 0; ph < NPHASES; ++ph) {
        a.lo = ph; a.hi = ph + 1; void* kargs[] = {&a};
        hipError_t e = hipLaunchCooperativeKernel((const void*)mk_fwd, dim3(grid), dim3(NTHREADS), kargs, LDS_BYTES, stream);
        if (e != hipSuccess) { fprintf(stderr, "kernel_launch: launch of phase %d failed: %s\n", ph, hipGetErrorString(e)); break; }
    }
#else
    a.lo = 0; a.hi = NPHASES; void* kargs[] = {&a};
    hipError_t e = hipLaunchCooperativeKernel((const void*)mk_fwd, dim3(grid), dim3(NTHREADS), kargs, LDS_BYTES, stream);
    if (e != hipSuccess) fprintf(stderr, "kernel_launch: cooperative launch failed: %s (grid %d)\n", hipGetErrorString(e), grid);
#endif
}
```

```cpp
#include <hip/hip_runtime.h>
#include <hip/hip_cooperative_groups.h>
#include <cstdio>
namespace cg = cooperative_groups;

#ifndef PER_PHASE_LAUNCH
#define PER_PHASE_LAUNCH 0
#endif

#define LAS __attribute__((address_space(3)))
typedef unsigned short bf16_t;
typedef short bf16x8 __attribute__((ext_vector_type(8)));
typedef float f32x4 __attribute__((ext_vector_type(4)));
typedef unsigned u32x4 __attribute__((ext_vector_type(4)));
typedef unsigned u32x2 __attribute__((ext_vector_type(2)));

constexpr int D = 1024, NB = 2, SEQ = 16384, CTXL = 256, SEG = SEQ + CTXL, R = NB * SEG, DEPTH = 2;
constexpr int NPROJ = 2560, DIN = 2576;
constexpr int NTHREADS = 512;
constexpr int LDS_BYTES = 147456;
constexpr int MISC_OFF = 131072;
constexpr int NCLS = 24;

constexpr size_t al256(size_t x) { return (x + 255) & ~size_t(255); }
constexpr size_t WS_CTL = 0;
constexpr size_t WS_MOD = 4096;
constexpr size_t WS_WTIN = WS_MOD + al256((size_t)2 * 3 * 6144 * 4);
constexpr size_t WS_WTOUT = WS_WTIN + al256((size_t)2 * DIN * 1024 * 2);
constexpr size_t WS_WTGU = WS_WTOUT + al256((size_t)2 * 1024 * 1024 * 2);
constexpr size_t WS_WTD = WS_WTGU + al256((size_t)2 * 16 * 512 * 1024 * 2);
constexpr size_t WS_HC = WS_WTD + al256((size_t)2 * 16 * 1024 * 256 * 2);
constexpr size_t WS_HX = WS_HC + al256((size_t)512 * 1024 * 4);
constexpr size_t WS_PROJ = WS_HX + al256((size_t)R * 1024 * 2);
constexpr size_t WS_DT = WS_PROJ + al256((size_t)R * NPROJ * 2);
constexpr size_t WS_POS = WS_DT + al256((size_t)R * 16 * 4);
constexpr size_t WS_LIST = WS_POS + al256((size_t)2 * R * 4);
constexpr size_t WS_CWLA = WS_LIST + al256((size_t)NCLS * R * 4);
constexpr size_t WS_CWLB = WS_CWLA + al256((size_t)NCLS * R * 4);
constexpr size_t WS_BIG = WS_CWLB + al256((size_t)NCLS * R * 4);
constexpr size_t WS_Y = WS_PROJ;
constexpr size_t WS_S = WS_BIG;
constexpr size_t WS_HP = WS_S + al256((size_t)2 * 2 * 130 * 8 * 8192 * 4);
constexpr size_t WS_DEC = WS_HP + al256((size_t)2 * 2 * 130 * 8 * 8192 * 2);
constexpr size_t WS_SSQ = WS_DEC + al256((size_t)2 * 2 * 130 * 8 * 4);
constexpr size_t WS_HID = WS_S;
constexpr size_t WS_END = WS_SSQ + al256((size_t)R * 8 * 4);
static_assert((size_t)(R + NCLS * 256) * 512 * 2 <= (size_t)2 * 2 * 130 * 8 * 8192 * 4, "hid alias");
static_assert(WS_END <= (size_t)512 * 1024 * 1024, "workspace");

struct Params {
    const float *x, *c, *ctx, *c_ctx, *w_ada, *b_ada, *g_mix, *g_ffn, *w_in, *conv_w, *conv_b, *conv_ln_g, *conv_ln_b, *ssd_conv_w, *ssd_conv_b,
        *dt_bias, *a_log, *d_skip, *ssd_norm_g, *w_out, *w_rg, *b_rg, *w_re, *b_re, *w_gate, *w_up, *w_down, *g_final;
    float* out; unsigned char* ws;
};
struct Args { Params p; int lo, hi; };
typedef const __attribute__((address_space(4))) Params* CP;
__device__ __forceinline__ CP launder(CP p) { asm volatile("" : "+s"(p)); return p; }
__device__ __forceinline__ int launder_tid() { int t = threadIdx.x; asm volatile("" : "+v"(t)); return t; }

__device__ __forceinline__ unsigned cvt_pk_bf16(float lo, float hi) { unsigned r; asm volatile("v_cvt_pk_bf16_f32 %0, %1, %2" : "=v"(r) : "v"(lo), "v"(hi)); return r; }
__device__ __forceinline__ float bf2f(unsigned b) { return __uint_as_float(b << 16); }
__device__ __forceinline__ float bflo(unsigned w) { return __uint_as_float(w << 16); }
__device__ __forceinline__ float bfhi(unsigned w) { return __uint_as_float(w & 0xffff0000u); }
__device__ __forceinline__ bf16_t f2bf(float f) { return (bf16_t)(cvt_pk_bf16(f, 0.f) & 0xffffu); }
__device__ __forceinline__ float wave_sum(float v) {
#pragma unroll
    for (int o = 1; o < 64; o <<= 1) v += __shfl_xor(v, o);
    return v;
}
__device__ __forceinline__ float sigmoidf_(float x) { return 1.f / (1.f + __expf(-x)); }
__device__ __forceinline__ float siluf_(float x) { return x / (1.f + __expf(-x)); }
__device__ __forceinline__ float softplusf_(float x) { return fmaxf(x, 0.f) + log1pf(expf(-fabsf(x))); }

__device__ __forceinline__ int row_b(int r) { return r >= SEG ? 1 : 0; }
__device__ __forceinline__ int row_i(int r) { return r >= SEG ? r - SEG : r; }
__device__ __forceinline__ int row_v(int r) { const int i = row_i(r); return i < CTXL ? 2 : row_b(r); }
__device__ __forceinline__ float* hptr2(float* hc, float* out, int r) {
    const int b = row_b(r), i = row_i(r);
    return i < CTXL ? hc + (size_t)(b * CTXL + i) * D : out + (size_t)(b * SEQ + i - CTXL) * D;
}
__device__ __forceinline__ float* hptr(CP p, int r) { return hptr2((float*)(p->ws + WS_HC), p->out, r); }
__device__ __forceinline__ const float* hin_ptr(CP p, int l, int r) {
    if (l == 0) return hptr2((float*)p->ctx, (float*)p->x, r);
    return hptr(p, r);
}

namespace pg8 {
constexpr int BM = 256, BK = 64, HALF = 128, HTB = HALF * BK * 2, STAGE_BYTES = 8 * HTB, NXCD = 8, WGM = 8;
__device__ __forceinline__ int lds_byte(int r, int c) { const int st = (r >> 4) * 2 + (c >> 5), rr = r & 15, cc = c & 31, ob = rr * 64 + cc * 2; return st * 1024 + (ob ^ (((ob >> 9) & 1) << 5)); }
__device__ __forceinline__ void stage_rc(int b, int& Rr, int& Cc) { const int st = b / 1024, sb = b % 1024, swz = sb ^ (((sb >> 9) & 1) << 5); Rr = (st >> 1) * 16 + swz / 64; Cc = (st & 1) * 32 + (swz % 64) / 2; }
__device__ __forceinline__ int perm32(int rho) { const int n = rho >> 4, i = rho & 15; return 8 * (i >> 2) + 4 * n + (i & 3); }

struct Unit {
    const char* a0;
    const char* b0;
    const char* b1;
    int i0, i1, i2, i3, i4, pad;
};

template <class Epi, class Sched, bool GATHER>
__device__ __forceinline__ void gemm_phase(LAS unsigned char* lds, const int lda, const int ldb, const int K, const Sched& S, const Epi& E) {
    const int tid = launder_tid(); const int wid = __builtin_amdgcn_readfirstlane(tid >> 6), lane = tid & 63, wr = wid >> 2, wc = wid & 3, fr = lane & 15, fq = lane >> 4;
    const int nt = K / BK, ks = nt >> 1;
    int Rr[2], Cc[2];
    unsigned voffB[2];
#pragma unroll
    for (int i = 0; i < 2; ++i) { stage_rc(tid * 16 + i * 8192, Rr[i], Cc[i]); const int Rb = Epi::PERM ? ((Rr[i] & ~31) + perm32(Rr[i] & 31)) : Rr[i];
        voffB[i] = (unsigned)(Rb * ldb + Cc[i]) * 2u; }
    const size_t kstep = (size_t)(BK * 2);
    const size_t hstepB = (size_t)HALF * ldb * 2;
    const unsigned ldsw = (unsigned)wid * 1024u;
    const unsigned ldsbase = (unsigned)(unsigned long)lds;
    const int aoff = lds_byte(wr * 64 + fr, fq * 8), boff = lds_byte(wc * 32 + fr, fq * 8);
#define PG8_SA(b, h) (((b) * 2 + (h)) * HTB)
#define PG8_SB(b, h) ((4 + (b) * 2 + (h)) * HTB)
#define PG8_STAGE2(bufoff, gbase, v0, v1) do { unsigned keep_; \
        asm volatile("s_mov_b32 %0, m0\n\ts_mov_b32 m0, %1\n\ts_nop 4\n\tglobal_load_lds_dwordx4 %2, %4\n\ts_add_u32 m0, m0, 0x2000\n\ts_nop 0\n\tglobal_load_lds_dwordx4 %3, %4\n\ts_mov_b32 m0, %0" \
            : "=&s"(keep_) : "s"(ldsbase + (unsigned)(bufoff) + ldsw), "v"(v0), "v"(v1), "s"(gbase) : "memory", "scc"); } while (0)
#define PG8_LDA(dst, b, h) do { _Pragma("unroll") for (int m = 0; m < 4; ++m) _Pragma("unroll") for (int k = 0; k < 2; ++k) dst[m][k] = *(const LAS bf16x8*)(lds + PG8_SA(b, h) + aoff + m * 2048 + k * 1024); } while (0)
#define PG8_LDB(dst, b, h) do { _Pragma("unroll") for (int n = 0; n < 2; ++n) _Pragma("unroll") for (int k = 0; k < 2; ++k) dst[n][k] = *(const LAS bf16x8*)(lds + PG8_SB(b, h) + boff + n * 2048 + k * 1024); } while (0)
#define PG8_MMA(ai, bj, At, Bt) do { __builtin_amdgcn_s_setprio(1); _Pragma("unroll") for (int m = 0; m < 4; ++m) _Pragma("unroll") for (int n = 0; n < 2; ++n) _Pragma("unroll") for (int k = 0; k < 2; ++k) \
        acc[ai][bj][m][n] = __builtin_amdgcn_mfma_f32_16x16x32_bf16(Bt[n][k], At[m][k], acc[ai][bj][m][n], 0, 0, 0); __builtin_amdgcn_s_setprio(0); } while (0)
#define PG8_WAIT_V(n) asm volatile("s_waitcnt vmcnt(" #n ")" ::: "memory")
#define PG8_WAIT_L(n) asm volatile("s_waitcnt lgkmcnt(" #n ")" ::: "memory")
#define PG8_BAR __builtin_amdgcn_s_barrier()
#define PG8_SCHED __builtin_amdgcn_sched_barrier(0)
#define PG8_BP(u, tt) ((tt) < ks ? (u).b0 + (size_t)(tt) * kstep : (u).b1 + (size_t)((tt) - ks) * kstep)
    Unit cur, nxt; int ui = 0;
    if (!S.get(0, cur)) return;
    unsigned c00, c01, c10, c11, n00, n01, n10, n11;
    if (GATHER) {
        c00 = (unsigned)(S.arow(cur, Rr[0]) * lda + Cc[0]) * 2u; c01 = (unsigned)(S.arow(cur, Rr[1]) * lda + Cc[1]) * 2u;
        c10 = (unsigned)(S.arow(cur, HALF + Rr[0]) * lda + Cc[0]) * 2u; c11 = (unsigned)(S.arow(cur, HALF + Rr[1]) * lda + Cc[1]) * 2u;
    } else {
        c00 = (unsigned)(Rr[0] * lda + Cc[0]) * 2u; c01 = (unsigned)(Rr[1] * lda + Cc[1]) * 2u;
        c10 = (unsigned)((HALF + Rr[0]) * lda + Cc[0]) * 2u; c11 = (unsigned)((HALF + Rr[1]) * lda + Cc[1]) * 2u;
    }
    n00 = c00; n01 = c01; n10 = c10; n11 = c11;
    f32x4 acc[2][2][4][2];
#pragma unroll
    for (int a = 0; a < 2; ++a)
#pragma unroll
        for (int b = 0; b < 2; ++b)
#pragma unroll
            for (int m = 0; m < 4; ++m)
#pragma unroll
                for (int n = 0; n < 2; ++n) acc[a][b][m][n] = (f32x4){0.f, 0.f, 0.f, 0.f};
    bf16x8 At[4][2], B0[2][2], B1[2][2];
    const char* cA = cur.a0;
    {
        const char* pb0 = PG8_BP(cur, 0); const char* pb1 = PG8_BP(cur, 1);
        PG8_STAGE2(PG8_SB(0, 0), pb0, voffB[0], voffB[1]); PG8_STAGE2(PG8_SA(0, 0), cA, c00, c01);
        PG8_STAGE2(PG8_SB(0, 1), pb0 + hstepB, voffB[0], voffB[1]); PG8_STAGE2(PG8_SA(0, 1), cA, c10, c11);
        if (wr == 1) PG8_BAR;
        PG8_WAIT_V(4); PG8_BAR;
        PG8_STAGE2(PG8_SB(1, 0), pb1, voffB[0], voffB[1]); PG8_STAGE2(PG8_SA(1, 0), cA + kstep, c00, c01);
        PG8_STAGE2(PG8_SB(1, 1), pb1 + hstepB, voffB[0], voffB[1]);
        PG8_WAIT_V(6); PG8_BAR;
    }
    for (;;) {
        const bool has_next = S.get(ui + 1, nxt);
        if (!has_next) nxt = cur;
        if (GATHER) {
            if (has_next) {
                n00 = (unsigned)(S.arow(nxt, Rr[0]) * lda + Cc[0]) * 2u; n01 = (unsigned)(S.arow(nxt, Rr[1]) * lda + Cc[1]) * 2u;
                n10 = (unsigned)(S.arow(nxt, HALF + Rr[0]) * lda + Cc[0]) * 2u; n11 = (unsigned)(S.arow(nxt, HALF + Rr[1]) * lda + Cc[1]) * 2u;
            } else { n00 = c00; n01 = c01; n10 = c10; n11 = c11; }
        }
        const char* nA = nxt.a0;
        for (int t = 0; t < nt; t += 2) {
            const bool last = (t == nt - 2);
            const char* a1 = cA + (size_t)(t + 1) * kstep;
            const char* a2 = last ? nA : cA + (size_t)(t + 2) * kstep;
            const char* a3 = a2 + kstep;
            const char* b2 = last ? PG8_BP(nxt, 0) : PG8_BP(cur, t + 2);
            const char* b3 = last ? PG8_BP(nxt, 1) : PG8_BP(cur, t + 3);
            const unsigned s00 = last ? n00 : c00, s01 = last ? n01 : c01, s10 = last ? n10 : c10, s11 = last ? n11 : c11;
            if constexpr (Epi::MIDSCALE) { if (t == ks) E.midscale(acc, cur, wr, wc, fr, fq); }
            PG8_LDB(B0, 0, 0); PG8_SCHED; PG8_LDA(At, 0, 0); PG8_STAGE2(PG8_SA(1, 1), a1, c10, c11);
            PG8_WAIT_L(8); PG8_BAR; PG8_WAIT_L(0); PG8_MMA(0, 0, At, B0); PG8_BAR; PG8_SCHED;
            PG8_LDB(B1, 0, 1); PG8_STAGE2(PG8_SB(0, 0), b2, voffB[0], voffB[1]);
            PG8_BAR; PG8_WAIT_L(0); PG8_MMA(0, 1, At, B1); PG8_BAR;
            PG8_LDA(At, 0, 1); PG8_STAGE2(PG8_SA(0, 0), a2, s00, s01);
            PG8_BAR; PG8_WAIT_L(0); PG8_MMA(1, 0, At, B0); PG8_BAR; PG8_SCHED;
            PG8_STAGE2(PG8_SB(0, 1), b2 + hstepB, voffB[0], voffB[1]);
            PG8_WAIT_V(6); PG8_BAR; PG8_MMA(1, 1, At, B1); PG8_BAR;
            PG8_LDB(B0, 1, 0); PG8_SCHED; PG8_LDA(At, 1, 0); PG8_STAGE2(PG8_SA(0, 1), a2, s10, s11);
            PG8_WAIT_L(8); PG8_BAR; PG8_WAIT_L(0); PG8_MMA(0, 0, At, B0); PG8_BAR; PG8_SCHED;
            PG8_LDB(B1, 1, 1); PG8_STAGE2(PG8_SB(1, 0), b3, voffB[0], voffB[1]);
            PG8_BAR; PG8_WAIT_L(0); PG8_MMA(0, 1, At, B1); PG8_BAR;
            PG8_LDA(At, 1, 1); PG8_STAGE2(PG8_SA(1, 0), a3, s00, s01);
            PG8_BAR; PG8_WAIT_L(0); PG8_MMA(1, 0, At, B0); PG8_BAR; PG8_SCHED;
            PG8_STAGE2(PG8_SB(1, 1), b3 + hstepB, voffB[0], voffB[1]);
            PG8_WAIT_V(6); PG8_BAR; PG8_MMA(1, 1, At, B1); PG8_BAR;
        }
        E(acc, cur, wr, wc, fr, fq);
        if (!has_next) break;
#pragma unroll
        for (int a = 0; a < 2; ++a)
#pragma unroll
            for (int b = 0; b < 2; ++b)
#pragma unroll
                for (int m = 0; m < 4; ++m)
#pragma unroll
                    for (int n = 0; n < 2; ++n) acc[a][b][m][n] = (f32x4){0.f, 0.f, 0.f, 0.f};
        cur = nxt; cA = nA; ++ui; c00 = n00; c01 = n01; c10 = n10; c11 = n11;
    }
    PG8_WAIT_V(0);
    if (wr == 0) PG8_BAR;
    PG8_BAR;
#undef PG8_SA
#undef PG8_SB
#undef PG8_STAGE2
#undef PG8_LDA
#undef PG8_LDB
#undef PG8_MMA
#undef PG8_WAIT_V
#undef PG8_WAIT_L
#undef PG8_BAR
#undef PG8_SCHED
#undef PG8_BP
}

struct DenseSched {
    const char* A; const char* Bt; int lda, ldb, K; int nM, nN, nwg, G, c;
    __device__ __forceinline__ void init(const void* A_, const void* Bt_, int M, int N, int K_, int lda_, int ldb_, int G_, int c_) {
        A = (const char*)A_; Bt = (const char*)Bt_; lda = lda_; ldb = ldb_; K = K_; nM = M / BM; nN = N / BM; nwg = nM * nN; G = G_; c = c_; }
    __device__ __forceinline__ bool get(int i, Unit& u) const {
        const long L = (long)i * G + c; if (L >= nwg) return false;
        int wgid = (int)L; { const int q = nwg / NXCD, r = nwg % NXCD, xcd = wgid % NXCD, off = wgid / NXCD; wgid = (xcd < r ? xcd * (q + 1) : r * (q + 1) + (xcd - r) * q) + off; }
        const int nig = WGM * nN, gid = wgid / nig, fm = gid * WGM, gsz = (nM - fm) < WGM ? (nM - fm) : WGM;
        const int pm = fm + ((wgid % nig) % gsz), pn = (wgid % nig) / gsz;
        u.a0 = A + (size_t)pm * BM * lda * 2; u.b0 = Bt + (size_t)pn * BM * ldb * 2; u.b1 = u.b0 + (size_t)(K / BK / 2) * BK * 2;
        u.i0 = pm; u.i1 = pn; u.i2 = 0; u.i3 = 0; u.i4 = 0; u.pad = 0; return true;
    }
    __device__ __forceinline__ int arow(const Unit&, int rl) const { return rl; }
};
}

struct EpiProj {
    static constexpr bool PERM = true, MIDSCALE = false;
    bf16_t* O;
    __device__ __forceinline__ void operator()(const f32x4 (&acc)[2][2][4][2], const pg8::Unit& u, int wr, int wc, int fr, int fq) const {
        const int row0 = u.i0 * 256 + wr * 64 + fr, col0 = u.i1 * 256 + wc * 32 + 8 * fq;
#pragma unroll
        for (int ai = 0; ai < 2; ++ai)
#pragma unroll
            for (int m = 0; m < 4; ++m) { bf16_t* rowp = O + (size_t)(row0 + ai * 128 + m * 16) * NPROJ + col0;
#pragma unroll
                for (int bj = 0; bj < 2; ++bj) { const f32x4 v0 = acc[ai][bj][m][0], v1 = acc[ai][bj][m][1];
                    u32x4 w; w.x = cvt_pk_bf16(v0[0], v0[1]); w.y = cvt_pk_bf16(v0[2], v0[3]); w.z = cvt_pk_bf16(v1[0], v1[1]); w.w = cvt_pk_bf16(v1[2], v1[3]);
                    *(u32x4*)(rowp + bj * 128) = w; } }
    }
};
struct EpiResid {
    static constexpr bool PERM = false, MIDSCALE = true;
    const float* inc; const float* inx; float* hc; float* out; const float* modl; const float* ssq;
    __device__ __forceinline__ void midscale(f32x4 (&acc)[2][2][4][2], const pg8::Unit& u, int wr, int wc, int fr, int fq) const {
        const int r0 = u.i0 * 256 + wr * 64 + fr;
#pragma unroll
        for (int ai = 0; ai < 2; ++ai)
#pragma unroll
            for (int m = 0; m < 4; ++m) { const float* sp = ssq + (size_t)(r0 + ai * 128 + m * 16) * 8;
                const f32x4 a = *(const f32x4*)sp, b = *(const f32x4*)(sp + 4);
                const float rs = rsqrtf(((a[0] + a[1]) + (a[2] + a[3]) + (b[0] + b[1]) + (b[2] + b[3])) * (1.f / 512.f) + 1e-6f);
#pragma unroll
                for (int bj = 0; bj < 2; ++bj)
#pragma unroll
                    for (int n = 0; n < 2; ++n) acc[ai][bj][m][n] *= rs; }
    }
    __device__ __forceinline__ void operator()(const f32x4 (&acc)[2][2][4][2], const pg8::Unit& u, int wr, int wc, int fr, int fq) const {
        const int r0 = u.i0 * 256;
        const int v = row_v(r0);
        const float* gate = modl + (size_t)v * 6144 + 2 * 1024;
        const float* hin = hptr2((float*)inc, (float*)inx, r0); float* hout = hptr2(hc, out, r0);
        const int rl0 = wr * 64 + fr, col0 = u.i1 * 256 + wc * 32 + 4 * fq;
        f32x4 gv[2][2];
#pragma unroll
        for (int bj = 0; bj < 2; ++bj)
#pragma unroll
            for (int n = 0; n < 2; ++n) gv[bj][n] = *(const f32x4*)(gate + col0 + bj * 128 + n * 16);
#pragma unroll
        for (int ai = 0; ai < 2; ++ai)
#pragma unroll
            for (int m = 0; m < 4; ++m) { const size_t off = (size_t)(rl0 + ai * 128 + m * 16) * D + col0;
#pragma unroll
                for (int bj = 0; bj < 2; ++bj)
#pragma unroll
                    for (int n = 0; n < 2; ++n) { const f32x4 hi = *(const f32x4*)(hin + off + bj * 128 + n * 16);
                        *(f32x4*)(hout + off + bj * 128 + n * 16) = hi + gv[bj][n] * acc[ai][bj][m][n]; }
                asm volatile("" ::: "memory"); }
    }
};

struct MoeSched {
    const LAS int* tab;
    const int* list;
    const char* A; const char* W; int mode  , l, G, c;
    __device__ __forceinline__ bool get(int i, pg8::Unit& u) const {
        const int L = i * G + c; const int total = __builtin_amdgcn_readfirstlane(tab[24]) * 4; if (L >= total) return false;
        const int tl = L >> 2, pn = L & 3;
        int cls = 0;
#pragma unroll 1
        for (int q = 1; q < NCLS; ++q) { const int tq = __builtin_amdgcn_readfirstlane(tab[q]); if (tq <= tl) cls = q; }
        const int j = tl - __builtin_amdgcn_readfirstlane(tab[cls]), cnt = __builtin_amdgcn_readfirstlane(tab[32 + cls]);
        const int g = cls / 6, pidx = cls - g * 6;
        const int ea = (pidx >= 3) + (pidx >= 5), eb = pidx < 3 ? pidx + 1 : (pidx < 5 ? pidx - 1 : 3);
        if (mode == 0) {
            const int e = 4 * g + (pn < 2 ? ea : eb);
            u.a0 = A;
            u.b0 = W + ((size_t)(l * 16 + e) * 512 + (size_t)(pn & 1) * 256) * 1024 * 2; u.b1 = u.b0 + (size_t)8 * 128;
        } else {
            u.a0 = A + (size_t)tl * 256 * 512 * 2;
            u.b0 = W + ((size_t)(l * 16 + 4 * g + ea) * 1024 + (size_t)pn * 256) * 256 * 2;
            u.b1 = W + ((size_t)(l * 16 + 4 * g + eb) * 1024 + (size_t)pn * 256) * 256 * 2;
        }
        u.i0 = cls; u.i1 = j; u.i2 = pn; u.i3 = cnt; u.i4 = tl; u.pad = 0; return true;
    }
    __device__ __forceinline__ int arow(const pg8::Unit& u, int rl) const {
        int idx = u.i1 * 256 + rl; idx = idx < u.i3 ? idx : u.i3 - 1;
        return list[(size_t)u.i0 * R + idx];
    }
};
struct EpiUp {
    static constexpr bool PERM = true, MIDSCALE = false;
    bf16_t* hid; const float* cwla; const float* cwlb;
    __device__ __forceinline__ void operator()(const f32x4 (&acc)[2][2][4][2], const pg8::Unit& u, int wr, int wc, int fr, int fq) const {
        const int cls = u.i0, j = u.i1, pn = u.i2, cnt = u.i3, tl = u.i4;
        const float* cw = (pn < 2) ? cwla : cwlb;
        const int colbase = (pn >> 1) * 256 + (pn & 1) * 128 + wc * 32 + 8 * fq;
#pragma unroll
        for (int ai = 0; ai < 2; ++ai)
#pragma unroll
            for (int m = 0; m < 4; ++m) {
                const int rl = ai * 128 + wr * 64 + m * 16 + fr; const int idx = j * 256 + rl; const bool valid = idx < cnt;
                float w = 0.f; if (valid) w = cw[(size_t)cls * R + idx];
                const f32x4 g0 = acc[ai][0][m][0], g1 = acc[ai][0][m][1], u0 = acc[ai][1][m][0], u1 = acc[ai][1][m][1];
                float o[8];
#pragma unroll
                for (int e = 0; e < 4; ++e) { o[e] = w * siluf_(g0[e]) * u0[e]; o[4 + e] = w * siluf_(g1[e]) * u1[e]; }
                if (!valid) {
#pragma unroll
                    for (int e = 0; e < 8; ++e) o[e] = 0.f; }
                u32x4 pk; pk.x = cvt_pk_bf16(o[0], o[1]); pk.y = cvt_pk_bf16(o[2], o[3]); pk.z = cvt_pk_bf16(o[4], o[5]); pk.w = cvt_pk_bf16(o[6], o[7]);
                *(u32x4*)(hid + ((size_t)tl * 256 + rl) * 512 + colbase) = pk;
            }
    }
};
struct EpiY {
    static constexpr bool PERM = true, MIDSCALE = false;
    bf16_t* Y;
    __device__ __forceinline__ void operator()(const f32x4 (&acc)[2][2][4][2], const pg8::Unit& u, int wr, int wc, int fr, int fq) const {
        const int row0 = u.i4 * 256 + wr * 64 + fr, col0 = u.i2 * 256 + wc * 32 + 8 * fq;
#pragma unroll
        for (int ai = 0; ai < 2; ++ai)
#pragma unroll
            for (int m = 0; m < 4; ++m) { bf16_t* rowp = Y + (size_t)(row0 + ai * 128 + m * 16) * 1024 + col0;
#pragma unroll
                for (int bj = 0; bj < 2; ++bj) { const f32x4 v0 = acc[ai][bj][m][0], v1 = acc[ai][bj][m][1];
                    u32x4 w; w.x = cvt_pk_bf16(v0[0], v0[1]); w.y = cvt_pk_bf16(v0[2], v0[3]); w.z = cvt_pk_bf16(v1[0], v1[1]); w.w = cvt_pk_bf16(v1[2], v1[3]);
                    *(u32x4*)(rowp + bj * 128) = w; } }
    }
};

__device__ __forceinline__ void tr_tile(const float* src, int ldn, int k0, int n0, int nvalid, bf16_t* dst, int ldk, int drow0, float* tile, int kd0 = -1, const float* kscale = nullptr) {
    const int tid = launder_tid();
    if (kd0 < 0) kd0 = k0;
    { const int n = tid & 63; int kk = tid >> 6;
#pragma unroll
      for (int it = 0; it < 8; ++it, kk += 8) tile[kk * 65 + n] = (n < nvalid) ? src[(size_t)(k0 + kk) * ldn + n0 + n] * (kscale ? kscale[kk] : 1.f) : 0.f; }
    __syncthreads();
    { const int k8 = tid & 7, n = tid >> 3;
      if (n < nvalid) { const float* s = tile + (k8 * 8) * 65 + n;
          u32x4 o; o.x = cvt_pk_bf16(s[0], s[65]); o.y = cvt_pk_bf16(s[2 * 65], s[3 * 65]); o.z = cvt_pk_bf16(s[4 * 65], s[5 * 65]); o.w = cvt_pk_bf16(s[6 * 65], s[7 * 65]);
          *(u32x4*)(dst + (size_t)(drow0 + n) * ldk + kd0 + k8 * 8) = o; } }
    __syncthreads();
}
__device__ __forceinline__ void phase_wprep(CP p, unsigned char* lds, int bid, int nb) {
    float* tile = (float*)lds;
    constexpr int I_IN = 16 * 41, I_OUT = 256, I_G = 1024, I_U = 1024, I_D = 1024, I_L = I_IN + I_OUT + I_G + I_U + I_D;
    for (int it = bid; it < 2 * I_L; it += nb) {
        const int l = it / I_L; int r = it - l * I_L;
        if (r < I_IN) { const int kt = r / 41, ntl = r % 41; const int n0 = ntl * 64; const int nv = (DIN - n0) < 64 ? (DIN - n0) : 64;
            tr_tile(p->w_in + (size_t)l * 1024 * DIN, DIN, kt * 64, n0, nv, (bf16_t*)(p->ws + WS_WTIN) + (size_t)l * DIN * 1024, 1024, n0, tile); continue; }
        r -= I_IN;
        if (r < I_OUT) { const int kt = r >> 4, ntl = r & 15;
            tr_tile(p->w_out + (size_t)l * 1024 * 1024, 1024, kt * 64, ntl * 64, 64, (bf16_t*)(p->ws + WS_WTOUT) + (size_t)l * 1024 * 1024, 1024, ntl * 64, tile,
                    (kt * 64 + 512) & 1023, kt >= 8 ? p->ssd_norm_g + l * 512 + (kt * 64 - 512) : nullptr); continue; }
        r -= I_OUT;
        if (r < I_G + I_U) { const int up = r >= I_G; if (up) r -= I_G; const int e = r >> 6, q = r & 63, kt = q >> 2, ntl = q & 3; const int n0 = ntl * 64;
            const float* src = (up ? p->w_up : p->w_gate) + (size_t)(l * 16 + e) * 1024 * 256;
            tr_tile(src, 256, kt * 64, n0, 64, (bf16_t*)(p->ws + WS_WTGU) + (size_t)(l * 16 + e) * 512 * 1024, 1024, (n0 >> 7) * 256 + (n0 & 127) + (up ? 128 : 0), tile); continue; }
        r -= I_G + I_U;
        { const int e = r >> 6, q = r & 63, kt = q >> 4, ntl = q & 15;
          tr_tile(p->w_down + (size_t)(l * 16 + e) * 256 * 1024, 1024, kt * 64, ntl * 64, 64, (bf16_t*)(p->ws + WS_WTD) + (size_t)(l * 16 + e) * 1024 * 256, 256, ntl * 64, tile); }
    }
}
__device__ __forceinline__ void phase_adaln(CP p, unsigned char* lds, int bid, int nb) {
    float* sc = (float*)lds;
    float* red = sc + 3 * 1024;
    const int tid = launder_tid();
    for (int idx = tid; idx < 3 * 1024; idx += NTHREADS) { const int v = idx >> 10, k = idx & 1023; const float cv = (v < 2) ? p->c[v * 1024 + k] : p->c_ctx[k]; sc[idx] = siluf_(cv); }
    __syncthreads();
    float* mod = (float*)(p->ws + WS_MOD);
    for (int it = bid; it < 2 * 96; it += nb) {
        const int l = it / 96, n0 = (it % 96) * 64;
        const int c4 = tid & 15, kr = tid >> 4;
        f32x4 a0 = {0, 0, 0, 0}, a1 = {0, 0, 0, 0}, a2 = {0, 0, 0, 0};
        const float* w = p->w_ada + (size_t)l * 1024 * 6144 + n0 + c4 * 4;
#pragma unroll 4
        for (int k = kr; k < 1024; k += 32) { const f32x4 w4 = *(const f32x4*)(w + (size_t)k * 6144); a0 += sc[k] * w4; a1 += sc[1024 + k] * w4; a2 += sc[2048 + k] * w4; }
        *(f32x4*)(red + (kr * 3 + 0) * 64 + c4 * 4) = a0; *(f32x4*)(red + (kr * 3 + 1) * 64 + c4 * 4) = a1; *(f32x4*)(red + (kr * 3 + 2) * 64 + c4 * 4) = a2;
        __syncthreads();
        if (tid < 192) { const int v = tid >> 6, cc = tid & 63; float s = 0.f;
            for (int q = 0; q < 32; ++q) s += red[(q * 3 + v) * 64 + cc];
            mod[((size_t)l * 3 + v) * 6144 + n0 + cc] = s + p->b_ada[l * 6144 + n0 + cc]; }
        __syncthreads();
    }
}
__device__ __forceinline__ void moe_table(CP p, int l, LAS int* tab) {
    const int* gcount = (const int*)(p->ws + WS_CTL) + l * 32;
    if (threadIdx.x == 0) { int acc = 0; for (int q = 0; q < NCLS; ++q) { const int cn = gcount[q]; tab[q] = acc; tab[32 + q] = cn; acc += (cn + 255) >> 8; } tab[24] = acc; }
    __syncthreads();
}
__device__ __forceinline__ void moe_apply(CP p, int lm, int r, int v, int lane, const LAS int* tab, f32x4 (&xv)[4]) {
    const int pos = ((const int*)(p->ws + WS_POS))[(size_t)lm * R + r];
    const int slot = tab[pos >> 16] * 256 + (pos & 0xffff);
    const bf16_t* y = (const bf16_t*)(p->ws + WS_Y) + (size_t)slot * 1024;
    const float* gate = (const float*)(p->ws + WS_MOD) + ((size_t)lm * 3 + v) * 6144 + 5 * 1024;
#pragma unroll
    for (int j = 0; j < 4; ++j) { const int k = 4 * lane + 256 * j; const u32x2 yv = *(const u32x2*)(y + k); const f32x4 g4 = *(const f32x4*)(gate + k);
        xv[j][0] += g4[0] * bflo(yv.x); xv[j][1] += g4[1] * bfhi(yv.x); xv[j][2] += g4[2] * bflo(yv.y); xv[j][3] += g4[3] * bfhi(yv.y); }
}
__device__ __forceinline__ void phase_r1(CP p, int l, unsigned char* lds, int bid, int nb) {
    float* wdt = (float*)lds;
    float* gm = wdt + 16 * 1024;
    float* sh = gm + 3 * 1024;
    const int tid = launder_tid(); const int lane = tid & 63, wave = tid >> 6;
    const float* mod = (const float*)(p->ws + WS_MOD) + (size_t)l * 3 * 6144;
    const float* win = p->w_in + (size_t)l * 1024 * DIN;
    for (int idx = tid; idx < 16 * 1024; idx += NTHREADS) { const int k = idx >> 4, n = idx & 15; wdt[n * 1024 + k] = win[(size_t)k * DIN + NPROJ + n]; }
    for (int idx = tid; idx < 3 * 1024; idx += NTHREADS) { const int v = idx >> 10, k = idx & 1023; gm[idx] = p->g_mix[l * 1024 + k] * (1.f + mod[v * 6144 + 1024 + k]); sh[idx] = mod[v * 6144 + k]; }
    LAS int* tab = (LAS int*)((LAS unsigned char*)lds + MISC_OFF);
    if (l > 0) moe_table(p, l - 1, tab);
    __syncthreads();
    bf16_t* HX = (bf16_t*)(p->ws + WS_HX); float* DT = (float*)(p->ws + WS_DT);
    for (int r = bid * 8 + wave; r < R; r += nb * 8) {
        const f32x4* hr = (const f32x4*)hin_ptr(p, l, r); const int v = row_v(r);
        f32x4 xv[4]; float ss = 0.f;
#pragma unroll
        for (int j = 0; j < 4; ++j) xv[j] = hr[lane + 64 * j];
        if (l > 0) { moe_apply(p, l - 1, r, v, lane, tab, xv); f32x4* hw = (f32x4*)hptr(p, r);
#pragma unroll
            for (int j = 0; j < 4; ++j) hw[lane + 64 * j] = xv[j]; }
#pragma unroll
        for (int j = 0; j < 4; ++j) ss += xv[j][0] * xv[j][0] + xv[j][1] * xv[j][1] + xv[j][2] * xv[j][2] + xv[j][3] * xv[j][3];
        ss = wave_sum(ss); const float rs = rsqrtf(ss * (1.f / 1024.f) + 1e-6f);
#pragma unroll
        for (int j = 0; j < 4; ++j) { const int k = 4 * lane + 256 * j; const f32x4 g4 = *(const f32x4*)(gm + v * 1024 + k), s4 = *(const f32x4*)(sh + v * 1024 + k);
            xv[j] = xv[j] * rs * g4 + s4;
            u32x2 o; o.x = cvt_pk_bf16(xv[j][0], xv[j][1]); o.y = cvt_pk_bf16(xv[j][2], xv[j][3]);
            *(u32x2*)(HX + (size_t)r * 1024 + k) = o; }
        float mine = 0.f;
#pragma unroll
        for (int n = 0; n < 16; ++n) { float a = 0.f;
#pragma unroll
            for (int j = 0; j < 4; ++j) { const f32x4 w4 = *(const f32x4*)(wdt + n * 1024 + 4 * lane + 256 * j); a += xv[j][0] * w4[0] + xv[j][1] * w4[1] + xv[j][2] * w4[2] + xv[j][3] * w4[3]; }
            a = wave_sum(a); mine = (lane == n) ? a : mine; }
        if (lane < 16) DT[(size_t)r * 16 + lane] = softplusf_(mine + p->dt_bias[l * 16 + lane]);
    }
}
__device__ __forceinline__ void phase_c1_naive(CP p, int l, unsigned char* lds, int bid, int nb) {
    float* red = (float*)lds;
    const int tid = launder_tid(); const int lane = tid & 63, wave = tid >> 6, c = tid;
    const bf16_t* proj = (const bf16_t*)(p->ws + WS_PROJ); bf16_t* mix = (bf16_t*)(p->ws + WS_HX);
    float w[31];
#pragma unroll
    for (int j = 0; j < 31; ++j) w[j] = p->conv_w[((size_t)l * 31 + j) * 512 + c];
    const float cb = p->conv_b[l * 512 + c], lg = p->conv_ln_g[l * 512 + c], lb = p->conv_ln_b[l * 512 + c];
    for (int r = bid; r < R; r += nb) {
        const int i = row_i(r);
        int stride, pos, len;
        if (i < CTXL) { stride = 1; pos = i; len = CTXL; }
        else { const int t = i - CTXL; if (c < 256) { stride = 1; pos = t & 63; len = 64; } else { stride = 64; pos = t >> 6; len = 256; } }
        float y = cb;
#pragma unroll
        for (int j = 0; j < 31; ++j) { const int q = pos + j - 15;
            if (q >= 0 && q < len) { const bf16_t* pr = proj + (size_t)(r + (j - 15) * stride) * NPROJ; const float u = bf2f(pr[c]), g = bf2f(pr[512 + c]); y += w[j] * u * sigmoidf_(g); } }
        float s = wave_sum(y); if (lane == 0) red[wave] = s; __syncthreads();
        float mu = 0.f;
#pragma unroll
        for (int q = 0; q < 8; ++q) mu += red[q];
        mu *= (1.f / 512.f); const float d = y - mu;
        float s2 = wave_sum(d * d); if (lane == 0) red[8 + wave] = s2; __syncthreads();
        float var = 0.f;
#pragma unroll
        for (int q = 0; q < 8; ++q) var += red[8 + q];
        var *= (1.f / 512.f);
        const float yn = d * rsqrtf(var + 1e-5f) * lg + lb;
        mix[(size_t)r * 1024 + 512 + c] = f2bf(siluf_(yn));
        __syncthreads();
    }
}
typedef float f32x16 __attribute__((ext_vector_type(16)));
typedef short s16x4 __attribute__((ext_vector_type(4)));
constexpr int ST_ROW = 272;
constexpr int ST_TR128 = 320;
constexpr int ST_TR64 = 192;
constexpr int NCHUNK = SEG / 128;

__device__ __forceinline__ float wave_incl_scan(float v, int lane) {
#pragma unroll
    for (int o = 1; o < 64; o <<= 1) { const float t = __shfl_up(v, o); if (lane >= o) v += t; }
    return v;
}
__device__ __forceinline__ bf16x8 row_frag(const LAS unsigned char* tile, int stride, int row0, int k0, int lane) {
    return *(const LAS bf16x8*)(tile + (row0 + (lane & 31)) * stride + (k0 + 8 * (lane >> 5)) * 2);
}
__device__ __forceinline__ bf16x8 tr_frag(const LAS unsigned char* tile, int stride, int k0, int c0, int lane) {
    const int g = lane >> 4, li = lane & 15, q = li >> 2, pp = li & 3;
    const LAS unsigned char* a0 = tile + (k0 + 8 * (g >> 1) + q) * stride + (c0 + 16 * (g & 1) + 4 * pp) * 2;
    const s16x4 lo = __builtin_amdgcn_ds_read_tr16_b64_v4i16((LAS s16x4*)a0);
    const s16x4 hi = __builtin_amdgcn_ds_read_tr16_b64_v4i16((LAS s16x4*)(a0 + 4 * stride));
    return __builtin_shufflevector(lo, hi, 0, 1, 2, 3, 4, 5, 6, 7);
}
__device__ __forceinline__ void conv_item(const bf16_t* proj, int row0, int rq, int xch, bool lo_ok, bool hi_ok, const float* cw, const float* cbias, float (&o)[4][8]) {
    u32x4 raw[8];
#pragma unroll
    for (int j = 0; j < 8; ++j) { const int lr = 4 * rq - 2 + j; const bool ok = (lr >= 0 || lo_ok) && (lr < 128 || hi_ok);
        raw[j] = ok ? *(const u32x4*)(proj + (size_t)(row0 + lr) * NPROJ + 1536 + xch) : (u32x4){0u, 0u, 0u, 0u}; }
    float w[5][8], bs[8];
#pragma unroll
    for (int j = 0; j < 5; ++j) { const f32x4 w0 = *(const f32x4*)(cw + j * 1024 + xch), w1 = *(const f32x4*)(cw + j * 1024 + xch + 4);
        w[j][0] = w0[0]; w[j][1] = w0[1]; w[j][2] = w0[2]; w[j][3] = w0[3]; w[j][4] = w1[0]; w[j][5] = w1[1]; w[j][6] = w1[2]; w[j][7] = w1[3]; }
    { const f32x4 b0 = *(const f32x4*)(cbias + xch), b1 = *(const f32x4*)(cbias + xch + 4); bs[0] = b0[0]; bs[1] = b0[1]; bs[2] = b0[2]; bs[3] = b0[3]; bs[4] = b1[0]; bs[5] = b1[1]; bs[6] = b1[2]; bs[7] = b1[3]; }
#pragma unroll
    for (int i = 0; i < 4; ++i)
#pragma unroll
        for (int e = 0; e < 8; ++e) o[i][e] = bs[e];
#pragma unroll
    for (int j = 0; j < 8; ++j) {
        float xv[8] = {bflo(raw[j].x), bfhi(raw[j].x), bflo(raw[j].y), bfhi(raw[j].y), bflo(raw[j].z), bfhi(raw[j].z), bflo(raw[j].w), bfhi(raw[j].w)};
#pragma unroll
        for (int i = 0; i < 4; ++i) { const int tap = j - i; if (tap >= 0 && tap < 5) {
#pragma unroll
                for (int e = 0; e < 8; ++e) o[i][e] += w[tap][e] * xv[e]; } }
    }
#pragma unroll
    for (int i = 0; i < 4; ++i)
#pragma unroll
        for (int e = 0; e < 8; ++e) o[i][e] = siluf_(o[i][e]);
}
__device__ __forceinline__ u32x4 pack8(const float (&v)[8]) { u32x4 r; r.x = cvt_pk_bf16(v[0], v[1]); r.y = cvt_pk_bf16(v[2], v[3]); r.z = cvt_pk_bf16(v[4], v[5]); r.w = cvt_pk_bf16(v[6], v[7]); return r; }
__device__ __forceinline__ u32x4 pack8s(const float (&v)[8], float sc) { u32x4 r; r.x = cvt_pk_bf16(v[0] * sc, v[1] * sc); r.y = cvt_pk_bf16(v[2] * sc, v[3] * sc); r.z = cvt_pk_bf16(v[4] * sc, v[5] * sc); r.w = cvt_pk_bf16(v[6] * sc, v[7] * sc); return r; }

__device__ __forceinline__ void chunk_cums(CP p, int l, int row0, int h, int wave, int lane, LAS float* vec) {
    if (wave < 2) {
        const int dir = wave; const float A = -expf(p->a_log[l * 16 + dir * 8 + h]);
        const float* DT = (const float*)(p->ws + WS_DT);
        const float d0 = DT[(size_t)(row0 + 2 * lane) * 16 + dir * 8 + h], d1 = DT[(size_t)(row0 + 2 * lane + 1) * 16 + dir * 8 + h];
        const float x0 = d0 * A, x1 = d1 * A;
        const float incl = wave_incl_scan(x0 + x1, lane);
        const float total = __shfl(incl, 63);
        float c0, c1;
        if (dir == 0) { c1 = incl; c0 = incl - x1; } else { c0 = total - (incl - x1 - x0); c1 = total - (incl - x1); }
        vec[dir * 128 + 2 * lane] = c0; vec[dir * 128 + 2 * lane + 1] = c1;
        vec[256 + dir * 128 + 2 * lane] = d0; vec[256 + dir * 128 + 2 * lane + 1] = d1;
        if (lane == 0) vec[512 + dir] = total;
    }
}

__device__ __forceinline__ void phase_s1(CP p, int l, unsigned char* lds_, int bid, int nb) {
    LAS unsigned char* lds = (LAS unsigned char*)lds_;
    LAS unsigned char* Bs = lds;
    LAS unsigned char* Xf = lds + 128 * ST_TR128;
    LAS unsigned char* Xb = Xf + 128 * ST_TR64;
    LAS float* vec = (LAS float*)(Xb + 128 * ST_TR64);
    const int tid = launder_tid(); const int lane = tid & 63, wave = __builtin_amdgcn_readfirstlane(tid >> 6);
    const bf16_t* proj = (const bf16_t*)(p->ws + WS_PROJ);
    const float* cw = p->ssd_conv_w + (size_t)l * 5 * 1024; const float* cbias = p->ssd_conv_b + (size_t)l * 1024;
    float* Sg = (float*)(p->ws + WS_S); float* DEC = (float*)(p->ws + WS_DEC);
    for (int u = bid; u < NB * NCHUNK * 8; u += nb) {
        const int h = u & 7, c = (u >> 3) % NCHUNK, b = (u >> 3) / NCHUNK, g = h >> 2;
        const int row0 = b * SEG + c * 128;
        const bool lo_ok = !(c == 0 || c == 2), hi_ok = !(c == 1 || c == NCHUNK - 1);
        chunk_cums(p, l, row0, h, wave, lane, vec);
        __syncthreads();
        if (tid < 2) DEC[((size_t)(b * 2 + tid) * NCHUNK + c) * 8 + h] = __expf(vec[512 + tid]);
        for (int it = tid; it < 32 * 24; it += NTHREADS) {
            const int rq = it / 24, cg = it % 24;
            float o[4][8];
            if (cg < 16) {
                conv_item(proj, row0, rq, 512 + g * 128 + cg * 8, lo_ok, hi_ok, cw, cbias, o);
#pragma unroll
                for (int i = 0; i < 4; ++i) *(LAS u32x4*)(Bs + (4 * rq + i) * ST_TR128 + cg * 16) = pack8(o[i]);
            } else {
                const int xc = cg - 16;
                conv_item(proj, row0, rq, h * 64 + xc * 8, lo_ok, hi_ok, cw, cbias, o);
                const float tf = vec[512], tb = vec[513];
#pragma unroll
                for (int i = 0; i < 4; ++i) { const int lr = 4 * rq + i;
                    const float wf = __expf(tf - vec[lr]) * vec[256 + lr];
                    const float wb = __expf(tb - vec[128 + lr]) * vec[384 + lr];
                    *(LAS u32x4*)(Xf + lr * ST_TR64 + xc * 16) = pack8s(o[i], wf);
                    *(LAS u32x4*)(Xb + lr * ST_TR64 + xc * 16) = pack8s(o[i], wb); }
            }
        }
        __syncthreads();
        {
            const int dir = wave >> 2, nq = wave & 3;
            const LAS unsigned char* Xd = dir ? Xb : Xf;
            f32x16 acc[2];
#pragma unroll
            for (int t = 0; t < 2; ++t)
#pragma unroll
                for (int e = 0; e < 16; ++e) acc[t][e] = 0.f;
#pragma unroll
            for (int kk = 0; kk < 8; ++kk) {
                const bf16x8 bf = tr_frag(Bs, ST_TR128, 16 * kk, 32 * nq, lane);
#pragma unroll
                for (int t = 0; t < 2; ++t) { const bf16x8 af = tr_frag(Xd, ST_TR64, 16 * kk, 32 * t, lane);
                    acc[t] = __builtin_amdgcn_mfma_f32_32x32x16_bf16(af, bf, acc[t], 0, 0, 0); }
            }
            float* So = Sg + ((size_t)((b * 2 + dir) * NCHUNK + c) * 8 + h) * 8192 + 32 * nq + (lane & 31);
#pragma unroll
            for (int t = 0; t < 2; ++t)
#pragma unroll
                for (int e = 0; e < 16; ++e) { const int pr = 32 * t + (e & 3) + 8 * (e >> 2) + 4 * (lane >> 5); So[(size_t)pr * 128] = acc[t][e]; }
        }
        __syncthreads();
    }
}
__device__ __forceinline__ void phase_s2(CP p, int bid, int nb) {
    const int tid = launder_tid();
    const float* Sg = (const float*)(p->ws + WS_S); const float* DEC = (const float*)(p->ws + WS_DEC); bf16_t* HP = (bf16_t*)(p->ws + WS_HP);
    for (int idx = bid * NTHREADS + tid; idx < 2 * 2 * 8 * 64 * 64; idx += nb * NTHREADS) {
        const int n2 = idx & 63, pr = (idx >> 6) & 63, h = (idx >> 12) & 7, dir = (idx >> 15) & 1, b = idx >> 16;
        const size_t inner = (size_t)h * 8192 + pr * 128 + 2 * n2;
        const size_t cbase = (size_t)(b * 2 + dir) * NCHUNK;
        float s0 = 0.f, s1 = 0.f;
#pragma unroll 5
        for (int step = 0; step < NCHUNK; ++step) {
            const int c = dir == 0 ? step : (step < 2 ? 1 - step : NCHUNK + 1 - step);
            const size_t off = (cbase + c) * 65536 + inner;
            const float2 sv = *(const float2*)(Sg + off); const float d = DEC[(cbase + c) * 8 + h];
            *(unsigned*)(HP + off) = cvt_pk_bf16(s0, s1);
            s0 = s0 * d + sv.x; s1 = s1 * d + sv.y;
        }
    }
}
__device__ __forceinline__ void phase_s3(CP p, int l, unsigned char* lds_, int bid, int nb) {
    LAS unsigned char* lds = (LAS unsigned char*)lds_;
    LAS unsigned char* Cs = lds;
    LAS unsigned char* Bs = Cs + 128 * ST_ROW;
    LAS unsigned char* Mt = Bs;
    LAS unsigned char* Xs = Bs + 128 * ST_TR128;
    LAS unsigned char* Hf = Xs + 128 * ST_TR64;
    LAS unsigned char* Hb = Hf + 64 * ST_ROW;
    LAS float* vec = (LAS float*)(Hb + 64 * ST_ROW);
    LAS float* ssq = vec + 520;
    const int tid = launder_tid(); const int lane = tid & 63, wave = __builtin_amdgcn_readfirstlane(tid >> 6);
    const bf16_t* proj = (const bf16_t*)(p->ws + WS_PROJ); bf16_t* mix = (bf16_t*)(p->ws + WS_HX);
    const float* cw = p->ssd_conv_w + (size_t)l * 5 * 1024; const float* cbias = p->ssd_conv_b + (size_t)l * 1024;
    const bf16_t* HP = (const bf16_t*)(p->ws + WS_HP); float* SSQ = (float*)(p->ws + WS_SSQ);
    for (int u = bid; u < NB * NCHUNK * 8; u += nb) {
        const int h = u & 7, c = (u >> 3) % NCHUNK, b = (u >> 3) / NCHUNK, g = h >> 2;
        const int row0 = b * SEG + c * 128;
        const bool lo_ok = !(c == 0 || c == 2), hi_ok = !(c == 1 || c == NCHUNK - 1);
        chunk_cums(p, l, row0, h, wave, lane, vec);
        if (tid < 128) ssq[tid] = 0.f;
        for (int it = tid; it < 32 * 40; it += NTHREADS) {
            const int rq = it / 40, cg = it % 40;
            float o[4][8];
            if (cg < 32) { const int isB = cg >= 16, cc = cg & 15;
                conv_item(proj, row0, rq, (isB ? 512 : 768) + g * 128 + cc * 8, lo_ok, hi_ok, cw, cbias, o);
                LAS unsigned char* dst = (isB ? Bs : Cs);
#pragma unroll
                for (int i = 0; i < 4; ++i) *(LAS u32x4*)(dst + (4 * rq + i) * ST_ROW + cc * 16) = pack8(o[i]);
            } else { const int xc = cg - 32;
                conv_item(proj, row0, rq, h * 64 + xc * 8, lo_ok, hi_ok, cw, cbias, o);
#pragma unroll
                for (int i = 0; i < 4; ++i) *(LAS u32x4*)(Xs + (4 * rq + i) * ST_TR64 + xc * 16) = pack8(o[i]);
            }
        }
        for (int it = tid; it < 2048; it += NTHREADS) { const int dir = it >> 10, q = it & 1023, pr = q >> 4, ch = q & 15;
            const u32x4 v = *(const u32x4*)(HP + ((size_t)((b * 2 + dir) * NCHUNK + c) * 8 + h) * 8192 + pr * 128 + ch * 8);
            *(LAS u32x4*)((dir ? Hb : Hf) + pr * ST_ROW + ch * 16) = v; }
        __syncthreads();
        const int lb = wave >> 1, hs = wave & 1;
        {
            f32x16 gacc[2];
#pragma unroll
            for (int t = 0; t < 2; ++t)
#pragma unroll
                for (int e = 0; e < 16; ++e) gacc[t][e] = 0.f;
#pragma unroll
            for (int kk = 0; kk < 8; ++kk) { const bf16x8 af = row_frag(Cs, ST_ROW, 32 * lb, 16 * kk, lane);
#pragma unroll
                for (int t = 0; t < 2; ++t) { const bf16x8 bf = row_frag(Bs, ST_ROW, 64 * hs + 32 * t, 16 * kk, lane);
                    gacc[t] = __builtin_amdgcn_mfma_f32_32x32x16_bf16(af, bf, gacc[t], 0, 0, 0); } }
            __syncthreads();
#pragma unroll
            for (int t = 0; t < 2; ++t) {
                const int sc = 64 * hs + 32 * t + (lane & 31);
                const float cfs = vec[sc], cbs = vec[128 + sc], dfs = vec[256 + sc], dbs = vec[384 + sc];
#pragma unroll
                for (int rg = 0; rg < 4; ++rg) {
                    const int l0 = 32 * lb + 8 * rg + 4 * (lane >> 5);
                    const f32x4 cfl = *(const LAS f32x4*)(vec + l0), cbl = *(const LAS f32x4*)(vec + 128 + l0);
                    float m[4];
#pragma unroll
                    for (int e = 0; e < 4; ++e) { const int lr = l0 + e;
                        const float ff = lr >= sc ? __expf(cfl[e] - cfs) * dfs : 0.f;
                        const float fb = lr <= sc ? __expf(cbl[e] - cbs) * dbs : 0.f;
                        m[e] = gacc[t][4 * rg + e] * (ff + fb); }
                    u32x2 pk; pk.x = cvt_pk_bf16(m[0], m[1]); pk.y = cvt_pk_bf16(m[2], m[3]);
                    *(LAS u32x2*)(Mt + sc * ST_TR128 + l0 * 2) = pk;
                }
            }
        }
        __syncthreads();
        {
            const int ph = hs;
            f32x16 ad, af_, ab_;
#pragma unroll
            for (int e = 0; e < 16; ++e) { ad[e] = 0.f; af_[e] = 0.f; ab_[e] = 0.f; }
#pragma unroll
            for (int kk = 0; kk < 8; ++kk) {
                const bf16x8 am = tr_frag(Mt, ST_TR128, 16 * kk, 32 * lb, lane);
                const bf16x8 bx = tr_frag(Xs, ST_TR64, 16 * kk, 32 * ph, lane);
                ad = __builtin_amdgcn_mfma_f32_32x32x16_bf16(am, bx, ad, 0, 0, 0);
                const bf16x8 ac = row_frag(Cs, ST_ROW, 32 * lb, 16 * kk, lane);
                const bf16x8 bhf = row_frag(Hf, ST_ROW, 32 * ph, 16 * kk, lane);
                const bf16x8 bhb = row_frag(Hb, ST_ROW, 32 * ph, 16 * kk, lane);
                af_ = __builtin_amdgcn_mfma_f32_32x32x16_bf16(ac, bhf, af_, 0, 0, 0);
                ab_ = __builtin_amdgcn_mfma_f32_32x32x16_bf16(ac, bhb, ab_, 0, 0, 0);
            }
            const int pc = 32 * ph + (lane & 31);
            const float dsk = p->d_skip[l * 8 + h];
#pragma unroll
            for (int rg = 0; rg < 4; ++rg) {
                const int l0 = 32 * lb + 8 * rg + 4 * (lane >> 5);
                const f32x4 cfl = *(const LAS f32x4*)(vec + l0), cbl = *(const LAS f32x4*)(vec + 128 + l0);
#pragma unroll
                for (int e = 0; e < 4; ++e) { const int lr = l0 + e; const int ri = 4 * rg + e;
                    const float xs = bf2f(*(const LAS bf16_t*)(Xs + lr * ST_TR64 + pc * 2));
                    const float y = ad[ri] + __expf(cfl[e]) * af_[ri] + __expf(cbl[e]) * ab_[ri] + dsk * xs;
                    const float z = bf2f(proj[(size_t)(row0 + lr) * NPROJ + 1024 + h * 64 + pc]);
                    const float val = y * siluf_(z);
                    mix[(size_t)(row0 + lr) * 1024 + h * 64 + pc] = f2bf(val);
                    float sq = val * val;
                    sq += __shfl_xor(sq, 1); sq += __shfl_xor(sq, 2); sq += __shfl_xor(sq, 4); sq += __shfl_xor(sq, 8); sq += __shfl_xor(sq, 16);
                    if ((lane & 31) == 0) atomicAdd((float*)(ssq + lr), sq);
                }
            }
        }
        __syncthreads();
        if (tid < 128) SSQ[(size_t)(row0 + tid) * 8 + h] = ssq[tid];
        __syncthreads();
    }
}
__device__ __forceinline__ void phase_r2(CP p, int l, unsigned char* lds, int bid, int nb) {
    float* wrt = (float*)lds;
    float* gm = wrt + 20 * 1024;
    float* sh = gm + 3 * 1024;
    int* lcnt = (int*)(sh + 3 * 1024);
    int* lcls = lcnt + 64;
    int* lrank = lcls + 1024;
    float* lcwa = (float*)(lrank + 1024);
    float* lcwb = lcwa + 1024;
    const int tid = launder_tid(); const int lane = tid & 63, wave = tid >> 6;
    const float* mod = (const float*)(p->ws + WS_MOD) + (size_t)l * 3 * 6144;
    for (int idx = tid; idx < 4 * 1024; idx += NTHREADS) { const int k = idx >> 2, n = idx & 3; wrt[n * 1024 + k] = p->w_rg[(size_t)l * 4096 + idx]; }
    for (int idx = tid; idx < 16 * 1024; idx += NTHREADS) { const int k = idx >> 4, n = idx & 15; wrt[(4 + n) * 1024 + k] = p->w_re[(size_t)l * 16384 + idx]; }
    for (int idx = tid; idx < 3 * 1024; idx += NTHREADS) { const int v = idx >> 10, k = idx & 1023; gm[idx] = p->g_ffn[l * 1024 + k] * (1.f + mod[v * 6144 + 4 * 1024 + k]); sh[idx] = mod[v * 6144 + 3 * 1024 + k]; }
    if (tid < 64) lcnt[tid] = 0;
    __syncthreads();
    bf16_t* HM = (bf16_t*)(p->ws + WS_HX); float* CWLA = (float*)(p->ws + WS_CWLA); float* CWLB = (float*)(p->ws + WS_CWLB); int* POS = (int*)(p->ws + WS_POS) + (size_t)l * R;
    int* gcount = (int*)(p->ws + WS_CTL) + l * 32; int* LIST = (int*)(p->ws + WS_LIST);
    const int rpb = (R + nb - 1) / nb, r0 = bid * rpb, r1 = (r0 + rpb) < R ? (r0 + rpb) : R;
    for (int r = r0 + wave; r < r1; r += 8) {
        const f32x4* hr = (const f32x4*)hptr(p, r); const int v = row_v(r);
        f32x4 xv[4]; float ss = 0.f;
#pragma unroll
        for (int j = 0; j < 4; ++j) { xv[j] = hr[lane + 64 * j]; ss += xv[j][0] * xv[j][0] + xv[j][1] * xv[j][1] + xv[j][2] * xv[j][2] + xv[j][3] * xv[j][3]; }
        ss = wave_sum(ss); const float rs = rsqrtf(ss * (1.f / 1024.f) + 1e-6f);
#pragma unroll
        for (int j = 0; j < 4; ++j) { const int k = 4 * lane + 256 * j; const f32x4 g4 = *(const f32x4*)(gm + v * 1024 + k), s4 = *(const f32x4*)(sh + v * 1024 + k);
            xv[j] = xv[j] * rs * g4 + s4;
            u32x2 o; o.x = cvt_pk_bf16(xv[j][0], xv[j][1]); o.y = cvt_pk_bf16(xv[j][2], xv[j][3]);
            *(u32x2*)(HM + (size_t)r * 1024 + k) = o; }
        float lg[20];
#pragma unroll
        for (int n = 0; n < 20; ++n) { float a = 0.f;
#pragma unroll
            for (int j = 0; j < 4; ++j) { const f32x4 w4 = *(const f32x4*)(wrt + n * 1024 + 4 * lane + 256 * j); a += xv[j][0] * w4[0] + xv[j][1] * w4[1] + xv[j][2] * w4[2] + xv[j][3] * w4[3]; }
            lg[n] = wave_sum(a) + (n < 4 ? p->b_rg[l * 4 + n] : p->b_re[l * 16 + n - 4]); }
        int gsel = 0; float gmax = lg[0];
#pragma unroll
        for (int q = 1; q < 4; ++q) if (lg[q] > gmax) { gmax = lg[q]; gsel = q; }
        float gden = 0.f;
#pragma unroll
        for (int q = 0; q < 4; ++q) gden += __expf(lg[q] - gmax);
        const float gprob = 1.f / gden;
        float el[4];
#pragma unroll
        for (int q = 0; q < 4; ++q) el[q] = gsel == 0 ? lg[4 + q] : (gsel == 1 ? lg[8 + q] : (gsel == 2 ? lg[12 + q] : lg[16 + q]));
        int i0 = 0; float m0 = el[0];
#pragma unroll
        for (int q = 1; q < 4; ++q) if (el[q] > m0) { m0 = el[q]; i0 = q; }
        int i1 = -1; float m1 = -3.0e38f;
#pragma unroll
        for (int q = 0; q < 4; ++q) if (q != i0 && el[q] > m1) { m1 = el[q]; i1 = q; }
        const float w0 = gprob / (1.f + __expf(m1 - m0)), w1 = gprob - w0;
        const int ea = i0 < i1 ? i0 : i1, eb = i0 < i1 ? i1 : i0;
        const float cwa = i0 < i1 ? w0 : w1, cwb = i0 < i1 ? w1 : w0;
        const int pidx = ea == 0 ? eb - 1 : (ea == 1 ? eb + 1 : 5);
        const int cls = gsel * 6 + pidx;
        if (lane == 0) { const int rank = atomicAdd(&lcnt[cls], 1); lcls[r - r0] = cls; lrank[r - r0] = rank; lcwa[r - r0] = cwa; lcwb[r - r0] = cwb; }
    }
    __syncthreads();
    if (tid < NCLS) lcnt[32 + tid] = atomicAdd(&gcount[tid], lcnt[tid]);
    __syncthreads();
    for (int idx = tid; idx < r1 - r0; idx += NTHREADS) { const int cl = lcls[idx]; const int pos = lcnt[32 + cl] + lrank[idx]; const size_t li = (size_t)cl * R + pos;
        LIST[li] = r0 + idx; CWLA[li] = lcwa[idx]; CWLB[li] = lcwb[idx]; POS[r0 + idx] = (cl << 16) | pos; }
    __syncthreads();
}
__device__ __forceinline__ void phase_final(CP p, unsigned char* lds, int bid, int nb) {
    const int tid = launder_tid(); const int lane = tid & 63, wave = tid >> 6;
    LAS int* tab = (LAS int*)((LAS unsigned char*)lds + MISC_OFF);
    moe_table(p, DEPTH - 1, tab);
    for (int q = bid * 8 + wave; q < NB * SEQ; q += nb * 8) {
        const int b = q >= SEQ ? 1 : 0; const int r = b * SEG + CTXL + (q - b * SEQ);
        f32x4* hr = (f32x4*)(p->out + (size_t)q * D);
        f32x4 xv[4]; float ss = 0.f;
#pragma unroll
        for (int j = 0; j < 4; ++j) xv[j] = hr[lane + 64 * j];
        moe_apply(p, DEPTH - 1, r, b, lane, tab, xv);
#pragma unroll
        for (int j = 0; j < 4; ++j) ss += xv[j][0] * xv[j][0] + xv[j][1] * xv[j][1] + xv[j][2] * xv[j][2] + xv[j][3] * xv[j][3];
        ss = wave_sum(ss); const float rs = rsqrtf(ss * (1.f / 1024.f) + 1e-6f);
#pragma unroll
        for (int j = 0; j < 4; ++j) { const f32x4 g4 = *(const f32x4*)(p->g_final + 4 * lane + 256 * j); hr[lane + 64 * j] = xv[j] * rs * g4; }
    }
}

#ifndef PHASE_MASK
#define PHASE_MASK 0xFFFFF
#endif
#define PM(i) ((PHASE_MASK >> (i)) & 1)
constexpr int PH_PER_LAYER = 9, NPHASES = 1 + DEPTH * PH_PER_LAYER + 1;
__global__ void __launch_bounds__(NTHREADS, 2) mk_fwd(Args args) {
    extern __shared__ __attribute__((aligned(16))) unsigned char lds[];
    cg::grid_group grid = cg::this_grid();
    const __attribute__((address_space(4))) Args* ap = (const __attribute__((address_space(4))) Args*)__builtin_amdgcn_kernarg_segment_ptr();
    const int lo = ap->lo, hi = ap->hi;
    const int bid = blockIdx.x, nb = gridDim.x;
    LAS unsigned char* ldsl = (LAS unsigned char*)lds;
    for (int ph = lo; ph < hi; ++ph) {
        CP p = launder(&ap->p);
        if (ph == 0) { if (PM(0)) phase_wprep(p, lds, bid, nb); if (PM(1)) phase_adaln(p, lds, bid, nb); }
        else if (ph == NPHASES - 1) { if (PM(12)) phase_final(p, lds, bid, nb); }
        else {
            const int l = (ph - 1) / PH_PER_LAYER, s = (ph - 1) % PH_PER_LAYER;
            if (s == 0) { if (PM(2)) phase_r1(p, l, lds, bid, nb); }
            else if (s == 1) { if (PM(3)) {
                pg8::DenseSched S; S.init(p->ws + WS_HX, (const bf16_t*)(p->ws + WS_WTIN) + (size_t)l * DIN * 1024, R, NPROJ, 1024, 1024, 1024, nb, bid);
                EpiProj E{(bf16_t*)(p->ws + WS_PROJ)};
                pg8::gemm_phase<EpiProj, pg8::DenseSched, false>(ldsl, 1024, 1024, 1024, S, E);
            } }
            else if (s == 2) { if (PM(4)) phase_c1_naive(p, l, lds, bid, nb); if (PM(5)) phase_s1(p, l, lds, bid, nb); }
            else if (s == 3) { if (PM(6)) phase_s2(p, bid, nb); }
            else if (s == 4) { if (PM(7)) phase_s3(p, l, lds, bid, nb); }
            else if (s == 5) { if (PM(8)) {
                pg8::DenseSched S; S.init(p->ws + WS_HX, (const bf16_t*)(p->ws + WS_WTOUT) + (size_t)l * 1024 * 1024, R, 1024, 1024, 1024, 1024, nb, bid);
                EpiResid E{l == 0 ? p->ctx : (const float*)(p->ws + WS_HC), l == 0 ? p->x : (const float*)p->out, (float*)(p->ws + WS_HC), p->out, (const float*)(p->ws + WS_MOD) + (size_t)l * 3 * 6144, (const float*)(p->ws + WS_SSQ)};
                pg8::gemm_phase<EpiResid, pg8::DenseSched, false>(ldsl, 1024, 1024, 1024, S, E);
            } }
            else if (s == 6) { if (PM(9)) phase_r2(p, l, lds, bid, nb); }
            else if (s == 7) { if (PM(10)) {
                LAS int* tab = (LAS int*)(ldsl + MISC_OFF); moe_table(p, l, tab);
                MoeSched S{tab, (const int*)(p->ws + WS_LIST), (const char*)(p->ws + WS_HX), (const char*)(p->ws + WS_WTGU), 0, l, nb, bid};
                EpiUp E{(bf16_t*)(p->ws + WS_HID), (const float*)(p->ws + WS_CWLA), (const float*)(p->ws + WS_CWLB)};
                pg8::gemm_phase<EpiUp, MoeSched, true>(ldsl, 1024, 1024, 1024, S, E);
            } }
            else { if (PM(11)) {
                LAS int* tab = (LAS int*)(ldsl + MISC_OFF); moe_table(p, l, tab);
                MoeSched S{tab, (const int*)(p->ws + WS_LIST), (const char*)(p->ws + WS_HID), (const char*)(p->ws + WS_WTD), 1, l, nb, bid};
                EpiY E{(bf16_t*)(p->ws + WS_Y)};
                pg8::gemm_phase<EpiY, MoeSched, false>(ldsl, 512, 256, 512, S, E);
            } }
        }
        if (ph + 1 < hi) grid.sync();
    }
}

extern "C" void kernel_launch(void* const* d_in, const int* in_sizes, int n_in, void* d_out, int out_size, void* d_ws, size_t ws_size, hipStream_t stream) {
    static int grid = 0;
    if (grid == 0) {
        if (n_in != 28 || ws_size < WS_END) { fprintf(stderr, "kernel_launch: unexpected n_in %d or ws_size %zu (< %zu)\n", n_in, ws_size, (size_t)WS_END); grid = -1; return; }
        int dev = 0, cus = 0, per_cu = 0;
        hipGetDevice(&dev); hipDeviceGetAttribute(&cus, hipDeviceAttributeMultiprocessorCount, dev);
        if (hipFuncSetAttribute((const void*)mk_fwd, hipFuncAttributeMaxDynamicSharedMemorySize, LDS_BYTES) != hipSuccess) { fprintf(stderr, "kernel_launch: hipFuncSetAttribute failed\n"); grid = -1; return; }
        if (hipOccupancyMaxActiveBlocksPerMultiprocessor(&per_cu, (const void*)mk_fwd, NTHREADS, LDS_BYTES) != hipSuccess || per_cu < 1) { fprintf(stderr, "kernel_launch: occupancy query says %d\n", per_cu); (void)hipGetLastError(); grid = -1; return; }
        grid = cus;
    }
    if (grid < 0) return;
    hipMemsetAsync((char*)d_ws + WS_CTL, 0, 4096, stream);
    Args a{};
    const float** pp = (const float**)&a.p;
    for (int i = 0; i < 28; ++i) pp[i] = (const float*)d_in[i];
    a.p.out = (float*)d_out; a.p.ws = (unsigned char*)d_ws;
#if PER_PHASE_LAUNCH
    for (int ph = 0; ph < NPHASES; ++ph) {
        a.lo = ph; a.hi = ph + 1; void* kargs[] = {&a};
        hipError_t e = hipLaunchCooperativeKernel((const void*)mk_fwd, dim3(grid), dim3(NTHREADS), kargs, LDS_BYTES, stream);
        if (e != hipSuccess) { fprintf(stderr, "kernel_launch: launch of phase %d failed: %s\n", ph, hipGetErrorString(e)); break; }
    }
#else
    a.lo = 0; a.hi = NPHASES; void* kargs[] = {&a};
    hipError_t e = hipLaunchCooperativeKernel((const void*)mk_fwd, dim3(grid), dim3(NTHREADS), kargs, LDS_BYTES, stream);
    if (e != hipSuccess) fprintf(stderr, "kernel_launch: cooperative launch failed: %s (grid %d)\n", hipGetErrorString(e), grid);
#endif
}
```

```cpp
#include <hip/hip_runtime.h>
#include <hip/hip_cooperative_groups.h>
#include <cstdio>
namespace cg = cooperative_groups;

#ifndef PER_PHASE_LAUNCH
#define PER_PHASE_LAUNCH 0
#endif

#define LAS __attribute__((address_space(3)))
typedef unsigned short bf16_t;
typedef short bf16x8 __attribute__((ext_vector_type(8)));
typedef float f32x4 __attribute__((ext_vector_type(4)));
typedef unsigned u32x4 __attribute__((ext_vector_type(4)));
typedef unsigned u32x2 __attribute__((ext_vector_type(2)));

constexpr int D = 1024, NB = 2, SEQ = 16384, CTXL = 256, SEG = SEQ + CTXL, R = NB * SEG, DEPTH = 2;
constexpr int NPROJ = 2560, DIN = 2576;
constexpr int NTHREADS = 512;
constexpr int LDS_BYTES = 147456;
constexpr int MISC_OFF = 131072;
constexpr int NCLS = 24;

constexpr size_t al256(size_t x) { return (x + 255) & ~size_t(255); }
constexpr size_t WS_CTL = 0;
constexpr size_t WS_MOD = 4096;
constexpr size_t WS_WTIN = WS_MOD + al256((size_t)2 * 3 * 6144 * 4);
constexpr size_t WS_WTOUT = WS_WTIN + al256((size_t)2 * DIN * 1024 * 2);
constexpr size_t WS_WTGU = WS_WTOUT + al256((size_t)2 * 1024 * 1024 * 2);
constexpr size_t WS_WTD = WS_WTGU + al256((size_t)2 * 16 * 512 * 1024 * 2);
constexpr size_t WS_HC = WS_WTD + al256((size_t)2 * 16 * 1024 * 256 * 2);
constexpr size_t WS_HX = WS_HC + al256((size_t)512 * 1024 * 4);
constexpr size_t WS_PROJ = WS_HX + al256((size_t)R * 1024 * 2);
constexpr size_t WS_DT = WS_PROJ + al256((size_t)R * NPROJ * 2);
constexpr size_t WS_POS = WS_DT + al256((size_t)R * 16 * 4);
constexpr size_t WS_LIST = WS_POS + al256((size_t)2 * R * 4);
constexpr size_t WS_CWLA = WS_LIST + al256((size_t)NCLS * R * 4);
constexpr size_t WS_CWLB = WS_CWLA + al256((size_t)NCLS * R * 4);
constexpr size_t WS_BIG = WS_CWLB + al256((size_t)NCLS * R * 4);
constexpr size_t WS_Y = WS_PROJ;
constexpr size_t WS_S = WS_BIG;
constexpr size_t WS_HP = WS_S + al256((size_t)2 * 2 * 130 * 8 * 8192 * 4);
constexpr size_t WS_DEC = WS_HP + al256((size_t)2 * 2 * 130 * 8 * 8192 * 2);
constexpr size_t WS_SSQ = WS_DEC + al256((size_t)2 * 2 * 130 * 8 * 4);
constexpr size_t WS_HID = WS_S;
constexpr size_t WS_END = WS_SSQ + al256((size_t)R * 8 * 4);
static_assert((size_t)(R + NCLS * 256) * 512 * 2 <= (size_t)2 * 2 * 130 * 8 * 8192 * 4, "hid alias");
static_assert(WS_END <= (size_t)512 * 1024 * 1024, "workspace");

struct Params {
    const float *x, *c, *ctx, *c_ctx, *w_ada, *b_ada, *g_mix, *g_ffn, *w_in, *conv_w, *conv_b, *conv_ln_g, *conv_ln_b, *ssd_conv_w, *ssd_conv_b,
        *dt_bias, *a_log, *d_skip, *ssd_norm_g, *w_out, *w_rg, *b_rg, *w_re, *b_re, *w_gate, *w_up, *w_down, *g_final;
    float* out; unsigned char* ws;
};
struct Args { Params p; int lo, hi; };
typedef const __attribute__((address_space(4))) Params* CP;
__device__ __forceinline__ CP launder(CP p) { asm volatile("" : "+s"(p)); return p; }
__device__ __forceinline__ int launder_tid() { int t = threadIdx.x; asm volatile("" : "+v"(t)); return t; }

__device__ __forceinline__ unsigned cvt_pk_bf16(float lo, float hi) { unsigned r; asm volatile("v_cvt_pk_bf16_f32 %0, %1, %2" : "=v"(r) : "v"(lo), "v"(hi)); return r; }
__device__ __forceinline__ float bf2f(unsigned b) { return __uint_as_float(b << 16); }
__device__ __forceinline__ float bflo(unsigned w) { return __uint_as_float(w << 16); }
__device__ __forceinline__ float bfhi(unsigned w) { return __uint_as_float(w & 0xffff0000u); }
__device__ __forceinline__ bf16_t f2bf(float f) { return (bf16_t)(cvt_pk_bf16(f, 0.f) & 0xffffu); }
__device__ __forceinline__ float wave_sum(float v) {
#pragma unroll
    for (int o = 1; o < 64; o <<= 1) v += __shfl_xor(v, o);
    return v;
}
__device__ __forceinline__ float sigmoidf_(float x) { return 1.f / (1.f + __expf(-x)); }
__device__ __forceinline__ float siluf_(float x) { return x / (1.f + __expf(-x)); }
__device__ __forceinline__ float softplusf_(float x) { return fmaxf(x, 0.f) + log1pf(expf(-fabsf(x))); }

__device__ __forceinline__ int row_b(int r) { return r >= SEG ? 1 : 0; }
__device__ __forceinline__ int row_i(int r) { return r >= SEG ? r - SEG : r; }
__device__ __forceinline__ int row_v(int r) { const int i = row_i(r); return i < CTXL ? 2 : row_b(r); }
__device__ __forceinline__ float* hptr2(float* hc, float* out, int r) {
    const int b = row_b(r), i = row_i(r);
    return i < CTXL ? hc + (size_t)(b * CTXL + i) * D : out + (size_t)(b * SEQ + i - CTXL) * D;
}
__device__ __forceinline__ float* hptr(CP p, int r) { return hptr2((float*)(p->ws + WS_HC), p->out, r); }
__device__ __forceinline__ const float* hin_ptr(CP p, int l, int r) {
    if (l == 0) return hptr2((float*)p->ctx, (float*)p->x, r);
    return hptr(p, r);
}

namespace pg8 {
constexpr int BM = 256, BK = 64, HALF = 128, HTB = HALF * BK * 2, STAGE_BYTES = 8 * HTB, NXCD = 8, WGM = 8;
__device__ __forceinline__ int lds_byte(int r, int c) { const int st = (r >> 4) * 2 + (c >> 5), rr = r & 15, cc = c & 31, ob = rr * 64 + cc * 2; return st * 1024 + (ob ^ (((ob >> 9) & 1) << 5)); }
__device__ __forceinline__ void stage_rc(int b, int& Rr, int& Cc) { const int st = b / 1024, sb = b % 1024, swz = sb ^ (((sb >> 9) & 1) << 5); Rr = (st >> 1) * 16 + swz / 64; Cc = (st & 1) * 32 + (swz % 64) / 2; }
__device__ __forceinline__ int perm32(int rho) { const int n = rho >> 4, i = rho & 15; return 8 * (i >> 2) + 4 * n + (i & 3); }

struct Unit {
    const char* a0;
    const char* b0;
    const char* b1;
    int i0, i1, i2, i3, i4, pad;
};

template <class Epi, class Sched, bool GATHER>
__device__ __forceinline__ void gemm_phase(LAS unsigned char* lds, const int lda, const int ldb, const int K, const Sched& S, const Epi& E) {
    const int tid = launder_tid(); const int wid = __builtin_amdgcn_readfirstlane(tid >> 6), lane = tid & 63, wr = wid >> 2, wc = wid & 3, fr = lane & 15, fq = lane >> 4;
    const int nt = K / BK, ks = nt >> 1;
    int Rr[2], Cc[2];
    unsigned voffB[2];
#pragma unroll
    for (int i = 0; i < 2; ++i) { stage_rc(tid * 16 + i * 8192, Rr[i], Cc[i]); const int Rb = Epi::PERM ? ((Rr[i] & ~31) + perm32(Rr[i] & 31)) : Rr[i];
        voffB[i] = (unsigned)(Rb * ldb + Cc[i]) * 2u; }
    const size_t kstep = (size_t)(BK * 2);
    const size_t hstepB = (size_t)HALF * ldb * 2;
    const unsigned ldsw = (unsigned)wid * 1024u;
    const unsigned ldsbase = (unsigned)(unsigned long)lds;
    const int aoff = lds_byte(wr * 64 + fr, fq * 8), boff = lds_byte(wc * 32 + fr, fq * 8);
#define PG8_SA(b, h) (((b) * 2 + (h)) * HTB)
#define PG8_SB(b, h) ((4 + (b) * 2 + (h)) * HTB)
#define PG8_STAGE2(bufoff, gbase, v0, v1) do { unsigned keep_; \
        asm volatile("s_mov_b32 %0, m0\n\ts_mov_b32 m0, %1\n\ts_nop 4\n\tglobal_load_lds_dwordx4 %2, %4\n\ts_add_u32 m0, m0, 0x2000\n\ts_nop 0\n\tglobal_load_lds_dwordx4 %3, %4\n\ts_mov_b32 m0, %0" \
            : "=&s"(keep_) : "s"(ldsbase + (unsigned)(bufoff) + ldsw), "v"(v0), "v"(v1), "s"(gbase) : "memory", "scc"); } while (0)
#define PG8_LDA(dst, b, h) do { _Pragma("unroll") for (int m = 0; m < 4; ++m) _Pragma("unroll") for (int k = 0; k < 2; ++k) dst[m][k] = *(const LAS bf16x8*)(lds + PG8_SA(b, h) + aoff + m * 2048 + k * 1024); } while (0)
#define PG8_LDB(dst, b, h) do { _Pragma("unroll") for (int n = 0; n < 2; ++n) _Pragma("unroll") for (int k = 0; k < 2; ++k) dst[n][k] = *(const LAS bf16x8*)(lds + PG8_SB(b, h) + boff + n * 2048 + k * 1024); } while (0)
#define PG8_MMA(ai, bj, At, Bt) do { __builtin_amdgcn_s_setprio(1); _Pragma("unroll") for (int m = 0; m < 4; ++m) _Pragma("unroll") for (int n = 0; n < 2; ++n) _Pragma("unroll") for (int k = 0; k < 2; ++k) \
        acc[ai][bj][m][n] = __builtin_amdgcn_mfma_f32_16x16x32_bf16(Bt[n][k], At[m][k], acc[ai][bj][m][n], 0, 0, 0); __builtin_amdgcn_s_setprio(0); } while (0)
#define PG8_WAIT_V(n) asm volatile("s_waitcnt vmcnt(" #n ")" ::: "memory")
#define PG8_WAIT_L(n) asm volatile("s_waitcnt lgkmcnt(" #n ")" ::: "memory")
#define PG8_BAR __builtin_amdgcn_s_barrier()
#define PG8_SCHED __builtin_amdgcn_sched_barrier(0)
#define PG8_BP(u, tt) ((tt) < ks ? (u).b0 + (size_t)(tt) * kstep : (u).b1 + (size_t)((tt) - ks) * kstep)
    Unit cur, nxt; int ui = 0;
    if (!S.get(0, cur)) return;
    unsigned c00, c01, c10, c11, n00, n01, n10, n11;
    if (GATHER) {
        c00 = (unsigned)(S.arow(cur, Rr[0]) * lda + Cc[0]) * 2u; c01 = (unsigned)(S.arow(cur, Rr[1]) * lda + Cc[1]) * 2u;
        c10 = (unsigned)(S.arow(cur, HALF + Rr[0]) * lda + Cc[0]) * 2u; c11 = (unsigned)(S.arow(cur, HALF + Rr[1]) * lda + Cc[1]) * 2u;
    } else {
        c00 = (unsigned)(Rr[0] * lda + Cc[0]) * 2u; c01 = (unsigned)(Rr[1] * lda + Cc[1]) * 2u;
        c10 = (unsigned)((HALF + Rr[0]) * lda + Cc[0]) * 2u; c11 = (unsigned)((HALF + Rr[1]) * lda + Cc[1]) * 2u;
    }
    n00 = c00; n01 = c01; n10 = c10; n11 = c11;
    f32x4 acc[2][2][4][2];
    float zr; asm volatile("v_mov_b32 %0, 0" : "=v"(zr));
#pragma unroll
    for (int a = 0; a < 2; ++a)
#pragma unroll
        for (int b = 0; b < 2; ++b)
#pragma unroll
            for (int m = 0; m < 4; ++m)
#pragma unroll
                for (int n = 0; n < 2; ++n) acc[a][b][m][n] = (f32x4){zr, zr, zr, zr};
    bf16x8 At[4][2], B0[2][2], B1[2][2];
    const char* cA = cur.a0;
    {
        const char* pb0 = PG8_BP(cur, 0); const char* pb1 = PG8_BP(cur, 1);
        PG8_STAGE2(PG8_SB(0, 0), pb0, voffB[0], voffB[1]); PG8_STAGE2(PG8_SA(0, 0), cA, c00, c01);
        PG8_STAGE2(PG8_SB(0, 1), pb0 + hstepB, voffB[0], voffB[1]); PG8_STAGE2(PG8_SA(0, 1), cA, c10, c11);
        if (wr == 1) PG8_BAR;
        PG8_WAIT_V(4); PG8_BAR;
        PG8_STAGE2(PG8_SB(1, 0), pb1, voffB[0], voffB[1]); PG8_STAGE2(PG8_SA(1, 0), cA + kstep, c00, c01);
        PG8_STAGE2(PG8_SB(1, 1), pb1 + hstepB, voffB[0], voffB[1]);
        PG8_WAIT_V(6); PG8_BAR;
    }
    for (;;) {
        const bool has_next = S.get(ui + 1, nxt);
        if (!has_next) nxt = cur;
        if (GATHER) {
            if (has_next) {
                n00 = (unsigned)(S.arow(nxt, Rr[0]) * lda + Cc[0]) * 2u; n01 = (unsigned)(S.arow(nxt, Rr[1]) * lda + Cc[1]) * 2u;
                n10 = (unsigned)(S.arow(nxt, HALF + Rr[0]) * lda + Cc[0]) * 2u; n11 = (unsigned)(S.arow(nxt, HALF + Rr[1]) * lda + Cc[1]) * 2u;
            } else { n00 = c00; n01 = c01; n10 = c10; n11 = c11; }
        }
        const char* nA = nxt.a0;
        for (int t = 0; t < nt; t += 2) {
            const bool last = (t == nt - 2);
            const char* a1 = cA + (size_t)(t + 1) * kstep;
            const char* a2 = last ? nA : cA + (size_t)(t + 2) * kstep;
            const char* a3 = a2 + kstep;
            const char* b2 = last ? PG8_BP(nxt, 0) : PG8_BP(cur, t + 2);
            const char* b3 = last ? PG8_BP(nxt, 1) : PG8_BP(cur, t + 3);
            const unsigned s00 = last ? n00 : c00, s01 = last ? n01 : c01, s10 = last ? n10 : c10, s11 = last ? n11 : c11;
            if constexpr (Epi::MIDSCALE) { if (t == ks) E.midscale(acc, cur, wr, wc, fr, fq); }
            PG8_LDB(B0, 0, 0); PG8_SCHED; PG8_LDA(At, 0, 0); PG8_STAGE2(PG8_SA(1, 1), a1, c10, c11);
            PG8_WAIT_L(8); PG8_BAR; PG8_WAIT_L(0); PG8_MMA(0, 0, At, B0); PG8_BAR; PG8_SCHED;
            PG8_LDB(B1, 0, 1); PG8_STAGE2(PG8_SB(0, 0), b2, voffB[0], voffB[1]);
            PG8_BAR; PG8_WAIT_L(0); PG8_MMA(0, 1, At, B1); PG8_BAR;
            PG8_LDA(At, 0, 1); PG8_STAGE2(PG8_SA(0, 0), a2, s00, s01);
            PG8_BAR; PG8_WAIT_L(0); PG8_MMA(1, 0, At, B0); PG8_BAR; PG8_SCHED;
            PG8_STAGE2(PG8_SB(0, 1), b2 + hstepB, voffB[0], voffB[1]);
            PG8_WAIT_V(6); PG8_BAR; PG8_MMA(1, 1, At, B1); PG8_BAR;
            PG8_LDB(B0, 1, 0); PG8_SCHED; PG8_LDA(At, 1, 0); PG8_STAGE2(PG8_SA(0, 1), a2, s10, s11);
            PG8_WAIT_L(8); PG8_BAR; PG8_WAIT_L(0); PG8_MMA(0, 0, At, B0); PG8_BAR; PG8_SCHED;
            PG8_LDB(B1, 1, 1); PG8_STAGE2(PG8_SB(1, 0), b3, voffB[0], voffB[1]);
            PG8_BAR; PG8_WAIT_L(0); PG8_MMA(0, 1, At, B1); PG8_BAR;
            PG8_LDA(At, 1, 1); PG8_STAGE2(PG8_SA(1, 0), a3, s00, s01);
            PG8_BAR; PG8_WAIT_L(0); PG8_MMA(1, 0, At, B0); PG8_BAR; PG8_SCHED;
            PG8_STAGE2(PG8_SB(1, 1), b3 + hstepB, voffB[0], voffB[1]);
            PG8_WAIT_V(6); PG8_BAR; PG8_MMA(1, 1, At, B1); PG8_BAR;
        }
        E(acc, cur, wr, wc, fr, fq);
        if (!has_next) break;
        asm volatile("v_mov_b32 %0, 0" : "=v"(zr));
#pragma unroll
        for (int a = 0; a < 2; ++a)
#pragma unroll
            for (int b = 0; b < 2; ++b)
#pragma unroll
                for (int m = 0; m < 4; ++m)
#pragma unroll
                    for (int n = 0; n < 2; ++n) acc[a][b][m][n] = (f32x4){zr, zr, zr, zr};
        cur = nxt; cA = nA; ++ui; c00 = n00; c01 = n01; c10 = n10; c11 = n11;
    }
    PG8_WAIT_V(0);
    if (wr == 0) PG8_BAR;
    PG8_BAR;
#undef PG8_SA
#undef PG8_SB
#undef PG8_STAGE2
#undef PG8_LDA
#undef PG8_LDB
#undef PG8_MMA
#undef PG8_WAIT_V
#undef PG8_WAIT_L
#undef PG8_BAR
#undef PG8_SCHED
#undef PG8_BP
}

struct DenseSched {
    const char* A; const char* Bt; int lda, ldb, K; int nM, nN, nwg, G, c;
    __device__ __forceinline__ void init(const void* A_, const void* Bt_, int M, int N, int K_, int lda_, int ldb_, int G_, int c_) {
        A = (const char*)A_; Bt = (const char*)Bt_; lda = lda_; ldb = ldb_; K = K_; nM = M / BM; nN = N / BM; nwg = nM * nN; G = G_; c = c_; }
    __device__ __forceinline__ bool get(int i, Unit& u) const {
        const long L = (long)i * G + c; if (L >= nwg) return false;
        int wgid = (int)L; { const int q = nwg / NXCD, r = nwg % NXCD, xcd = wgid % NXCD, off = wgid / NXCD; wgid = (xcd < r ? xcd * (q + 1) : r * (q + 1) + (xcd - r) * q) + off; }
        const int nig = WGM * nN, gid = wgid / nig, fm = gid * WGM, gsz = (nM - fm) < WGM ? (nM - fm) : WGM;
        const int pm = fm + ((wgid % nig) % gsz), pn = (wgid % nig) / gsz;
        u.a0 = A + (size_t)pm * BM * lda * 2; u.b0 = Bt + (size_t)pn * BM * ldb * 2; u.b1 = u.b0 + (size_t)(K / BK / 2) * BK * 2;
        u.i0 = pm; u.i1 = pn; u.i2 = 0; u.i3 = 0; u.i4 = 0; u.pad = 0; return true;
    }
    __device__ __forceinline__ int arow(const Unit&, int rl) const { return rl; }
};
}

struct EpiProj {
    static constexpr bool PERM = true, MIDSCALE = false;
    bf16_t* O;
    __device__ __forceinline__ void operator()(const f32x4 (&acc)[2][2][4][2], const pg8::Unit& u, int wr, int wc, int fr, int fq) const {
        const int row0 = u.i0 * 256 + wr * 64 + fr, col0 = u.i1 * 256 + wc * 32 + 8 * fq;
#pragma unroll
        for (int ai = 0; ai < 2; ++ai)
#pragma unroll
            for (int m = 0; m < 4; ++m) { bf16_t* rowp = O + (size_t)(row0 + ai * 128 + m * 16) * NPROJ + col0;
#pragma unroll
                for (int bj = 0; bj < 2; ++bj) { const f32x4 v0 = acc[ai][bj][m][0], v1 = acc[ai][bj][m][1];
                    u32x4 w; w.x = cvt_pk_bf16(v0[0], v0[1]); w.y = cvt_pk_bf16(v0[2], v0[3]); w.z = cvt_pk_bf16(v1[0], v1[1]); w.w = cvt_pk_bf16(v1[2], v1[3]);
                    *(u32x4*)(rowp + bj * 128) = w; } }
    }
};
struct EpiResid {
    static constexpr bool PERM = false, MIDSCALE = true;
    const float* inc; const float* inx; float* hc; float* out; const float* modl; const float* ssq;
    __device__ __forceinline__ void midscale(f32x4 (&acc)[2][2][4][2], const pg8::Unit& u, int wr, int wc, int fr, int fq) const {
        const int r0 = u.i0 * 256 + wr * 64 + fr;
#pragma unroll
        for (int ai = 0; ai < 2; ++ai)
#pragma unroll
            for (int m = 0; m < 4; ++m) { const float* sp = ssq + (size_t)(r0 + ai * 128 + m * 16) * 8;
                const f32x4 a = *(const f32x4*)sp, b = *(const f32x4*)(sp + 4);
                const float rs = rsqrtf(((a[0] + a[1]) + (a[2] + a[3]) + (b[0] + b[1]) + (b[2] + b[3])) * (1.f / 512.f) + 1e-6f);
#pragma unroll
                for (int bj = 0; bj < 2; ++bj)
#pragma unroll
                    for (int n = 0; n < 2; ++n) acc[ai][bj][m][n] *= rs; }
    }
    __device__ __forceinline__ void operator()(const f32x4 (&acc)[2][2][4][2], const pg8::Unit& u, int wr, int wc, int fr, int fq) const {
        const int r0 = u.i0 * 256;
        const int v = row_v(r0);
        const float* gate = modl + (size_t)v * 6144 + 2 * 1024;
        const float* hin = hptr2((float*)inc, (float*)inx, r0); float* hout = hptr2(hc, out, r0);
        const int rl0 = wr * 64 + fr, col0 = u.i1 * 256 + wc * 32 + 4 * fq;
        f32x4 gv[2][2];
#pragma unroll
        for (int bj = 0; bj < 2; ++bj)
#pragma unroll
            for (int n = 0; n < 2; ++n) gv[bj][n] = *(const f32x4*)(gate + col0 + bj * 128 + n * 16);
#pragma unroll
        for (int ai = 0; ai < 2; ++ai)
#pragma unroll
            for (int m = 0; m < 4; ++m) { const size_t off = (size_t)(rl0 + ai * 128 + m * 16) * D + col0;
#pragma unroll
                for (int bj = 0; bj < 2; ++bj)
#pragma unroll
                    for (int n = 0; n < 2; ++n) { const f32x4 hi = *(const f32x4*)(hin + off + bj * 128 + n * 16);
                        *(f32x4*)(hout + off + bj * 128 + n * 16) = hi + gv[bj][n] * acc[ai][bj][m][n]; }
                asm volatile("" ::: "memory"); }
    }
};

struct MoeSched {
    const LAS int* tab;
    const int* list;
    const char* A; const char* W; int mode  , l, G, c;
    __device__ __forceinline__ bool get(int i, pg8::Unit& u) const {
        const int L = i * G + c; const int total = __builtin_amdgcn_readfirstlane(tab[24]) * 4; if (L >= total) return false;
        const int tl = L >> 2, pn = L & 3;
        int cls = 0;
#pragma unroll 1
        for (int q = 1; q < NCLS; ++q) { const int tq = __builtin_amdgcn_readfirstlane(tab[q]); if (tq <= tl) cls = q; }
        const int j = tl - __builtin_amdgcn_readfirstlane(tab[cls]), cnt = __builtin_amdgcn_readfirstlane(tab[32 + cls]);
        const int g = cls / 6, pidx = cls - g * 6;
        const int ea = (pidx >= 3) + (pidx >= 5), eb = pidx < 3 ? pidx + 1 : (pidx < 5 ? pidx - 1 : 3);
        if (mode == 0) {
            const int e = 4 * g + (pn < 2 ? ea : eb);
            u.a0 = A;
            u.b0 = W + ((size_t)(l * 16 + e) * 512 + (size_t)(pn & 1) * 256) * 1024 * 2; u.b1 = u.b0 + (size_t)8 * 128;
        } else {
            u.a0 = A + (size_t)tl * 256 * 512 * 2;
            u.b0 = W + ((size_t)(l * 16 + 4 * g + ea) * 1024 + (size_t)pn * 256) * 256 * 2;
            u.b1 = W + ((size_t)(l * 16 + 4 * g + eb) * 1024 + (size_t)pn * 256) * 256 * 2;
        }
        u.i0 = cls; u.i1 = j; u.i2 = pn; u.i3 = cnt; u.i4 = tl; u.pad = 0; return true;
    }
    __device__ __forceinline__ int arow(const pg8::Unit& u, int rl) const {
        int idx = u.i1 * 256 + rl; idx = idx < u.i3 ? idx : u.i3 - 1;
        return list[(size_t)u.i0 * R + idx];
    }
};
struct EpiUp {
    static constexpr bool PERM = true, MIDSCALE = false;
    bf16_t* hid; const float* cwla; const float* cwlb;
    __device__ __forceinline__ void operator()(const f32x4 (&acc)[2][2][4][2], const pg8::Unit& u, int wr, int wc, int fr, int fq) const {
        const int cls = u.i0, j = u.i1, pn = u.i2, cnt = u.i3, tl = u.i4;
        const float* cw = (pn < 2) ? cwla : cwlb;
        const int colbase = (pn >> 1) * 256 + (pn & 1) * 128 + wc * 32 + 8 * fq;
#pragma unroll
        for (int ai = 0; ai < 2; ++ai)
#pragma unroll
            for (int m = 0; m < 4; ++m) {
                const int rl = ai * 128 + wr * 64 + m * 16 + fr; const int idx = j * 256 + rl; const bool valid = idx < cnt;
                float w = 0.f; if (valid) w = cw[(size_t)cls * R + idx];
                const f32x4 g0 = acc[ai][0][m][0], g1 = acc[ai][0][m][1], u0 = acc[ai][1][m][0], u1 = acc[ai][1][m][1];
                float o[8];
#pragma unroll
                for (int e = 0; e < 4; ++e) { o[e] = w * siluf_(g0[e]) * u0[e]; o[4 + e] = w * siluf_(g1[e]) * u1[e]; }
                if (!valid) {
#pragma unroll
                    for (int e = 0; e < 8; ++e) o[e] = 0.f; }
                u32x4 pk; pk.x = cvt_pk_bf16(o[0], o[1]); pk.y = cvt_pk_bf16(o[2], o[3]); pk.z = cvt_pk_bf16(o[4], o[5]); pk.w = cvt_pk_bf16(o[6], o[7]);
                *(u32x4*)(hid + ((size_t)tl * 256 + rl) * 512 + colbase) = pk;
            }
    }
};
struct EpiY {
    static constexpr bool PERM = true, MIDSCALE = false;
    bf16_t* Y;
    __device__ __forceinline__ void operator()(const f32x4 (&acc)[2][2][4][2], const pg8::Unit& u, int wr, int wc, int fr, int fq) const {
        const int row0 = u.i4 * 256 + wr * 64 + fr, col0 = u.i2 * 256 + wc * 32 + 8 * fq;
#pragma unroll
        for (int ai = 0; ai < 2; ++ai)
#pragma unroll
            for (int m = 0; m < 4; ++m) { bf16_t* rowp = Y + (size_t)(row0 + ai * 128 + m * 16) * 1024 + col0;
#pragma unroll
                for (int bj = 0; bj < 2; ++bj) { const f32x4 v0 = acc[ai][bj][m][0], v1 = acc[ai][bj][m][1];
                    u32x4 w; w.x = cvt_pk_bf16(v0[0], v0[1]); w.y = cvt_pk_bf16(v0[2], v0[3]); w.z = cvt_pk_bf16(v1[0], v1[1]); w.w = cvt_pk_bf16(v1[2], v1[3]);
                    *(u32x4*)(rowp + bj * 128) = w; } }
    }
};

__device__ __forceinline__ void tr_tile(const float* src, int ldn, int k0, int n0, int nvalid, bf16_t* dst, int ldk, int drow0, float* tile, int kd0 = -1, const float* kscale = nullptr) {
    const int tid = launder_tid();
    if (kd0 < 0) kd0 = k0;
    { const int n = tid & 63; int kk = tid >> 6;
#pragma unroll
      for (int it = 0; it < 8; ++it, kk += 8) tile[kk * 65 + n] = (n < nvalid) ? src[(size_t)(k0 + kk) * ldn + n0 + n] * (kscale ? kscale[kk] : 1.f) : 0.f; }
    __syncthreads();
    { const int k8 = tid & 7, n = tid >> 3;
      if (n < nvalid) { const float* s = tile + (k8 * 8) * 65 + n;
          u32x4 o; o.x = cvt_pk_bf16(s[0], s[65]); o.y = cvt_pk_bf16(s[2 * 65], s[3 * 65]); o.z = cvt_pk_bf16(s[4 * 65], s[5 * 65]); o.w = cvt_pk_bf16(s[6 * 65], s[7 * 65]);
          *(u32x4*)(dst + (size_t)(drow0 + n) * ldk + kd0 + k8 * 8) = o; } }
    __syncthreads();
}
__device__ __forceinline__ void phase_wprep(CP p, unsigned char* lds, int bid, int nb) {
    float* tile = (float*)lds;
    constexpr int I_IN = 16 * 41, I_OUT = 256, I_G = 1024, I_U = 1024, I_D = 1024, I_L = I_IN + I_OUT + I_G + I_U + I_D;
    for (int it = bid; it < 2 * I_L; it += nb) {
        const int l = it / I_L; int r = it - l * I_L;
        if (r < I_IN) { const int kt = r / 41, ntl = r % 41; const int n0 = ntl * 64; const int nv = (DIN - n0) < 64 ? (DIN - n0) : 64;
            tr_tile(p->w_in + (size_t)l * 1024 * DIN, DIN, kt * 64, n0, nv, (bf16_t*)(p->ws + WS_WTIN) + (size_t)l * DIN * 1024, 1024, n0, tile); continue; }
        r -= I_IN;
        if (r < I_OUT) { const int kt = r >> 4, ntl = r & 15;
            tr_tile(p->w_out + (size_t)l * 1024 * 1024, 1024, kt * 64, ntl * 64, 64, (bf16_t*)(p->ws + WS_WTOUT) + (size_t)l * 1024 * 1024, 1024, ntl * 64, tile,
                    (kt * 64 + 512) & 1023, kt >= 8 ? p->ssd_norm_g + l * 512 + (kt * 64 - 512) : nullptr); continue; }
        r -= I_OUT;
        if (r < I_G + I_U) { const int up = r >= I_G; if (up) r -= I_G; const int e = r >> 6, q = r & 63, kt = q >> 2, ntl = q & 3; const int n0 = ntl * 64;
            const float* src = (up ? p->w_up : p->w_gate) + (size_t)(l * 16 + e) * 1024 * 256;
            tr_tile(src, 256, kt * 64, n0, 64, (bf16_t*)(p->ws + WS_WTGU) + (size_t)(l * 16 + e) * 512 * 1024, 1024, (n0 >> 7) * 256 + (n0 & 127) + (up ? 128 : 0), tile); continue; }
        r -= I_G + I_U;
        { const int e = r >> 6, q = r & 63, kt = q >> 4, ntl = q & 15;
          tr_tile(p->w_down + (size_t)(l * 16 + e) * 256 * 1024, 1024, kt * 64, ntl * 64, 64, (bf16_t*)(p->ws + WS_WTD) + (size_t)(l * 16 + e) * 1024 * 256, 256, ntl * 64, tile); }
    }
}
__device__ __forceinline__ void phase_adaln(CP p, unsigned char* lds, int bid, int nb) {
    float* sc = (float*)lds;
    float* red = sc + 3 * 1024;
    const int tid = launder_tid();
    for (int idx = tid; idx < 3 * 1024; idx += NTHREADS) { const int v = idx >> 10, k = idx & 1023; const float cv = (v < 2) ? p->c[v * 1024 + k] : p->c_ctx[k]; sc[idx] = siluf_(cv); }
    __syncthreads();
    float* mod = (float*)(p->ws + WS_MOD);
    for (int it = bid; it < 2 * 96; it += nb) {
        const int l = it / 96, n0 = (it % 96) * 64;
        const int c4 = tid & 15, kr = tid >> 4;
        f32x4 a0 = {0, 0, 0, 0}, a1 = {0, 0, 0, 0}, a2 = {0, 0, 0, 0};
        const float* w = p->w_ada + (size_t)l * 1024 * 6144 + n0 + c4 * 4;
#pragma unroll 4
        for (int k = kr; k < 1024; k += 32) { const f32x4 w4 = *(const f32x4*)(w + (size_t)k * 6144); a0 += sc[k] * w4; a1 += sc[1024 + k] * w4; a2 += sc[2048 + k] * w4; }
        *(f32x4*)(red + (kr * 3 + 0) * 64 + c4 * 4) = a0; *(f32x4*)(red + (kr * 3 + 1) * 64 + c4 * 4) = a1; *(f32x4*)(red + (kr * 3 + 2) * 64 + c4 * 4) = a2;
        __syncthreads();
        if (tid < 192) { const int v = tid >> 6, cc = tid & 63; float s = 0.f;
            for (int q = 0; q < 32; ++q) s += red[(q * 3 + v) * 64 + cc];
            mod[((size_t)l * 3 + v) * 6144 + n0 + cc] = s + p->b_ada[l * 6144 + n0 + cc]; }
        __syncthreads();
    }
}
__device__ __forceinline__ void moe_table(CP p, int l, LAS int* tab) {
    const int* gcount = (const int*)(p->ws + WS_CTL) + l * 32;
    if (threadIdx.x == 0) { int acc = 0; for (int q = 0; q < NCLS; ++q) { const int cn = gcount[q]; tab[q] = acc; tab[32 + q] = cn; acc += (cn + 255) >> 8; } tab[24] = acc; }
    __syncthreads();
}
__device__ __forceinline__ void moe_apply(CP p, int lm, int r, int v, int lane, const LAS int* tab, f32x4 (&xv)[4]) {
    const int pos = ((const int*)(p->ws + WS_POS))[(size_t)lm * R + r];
    const int slot = tab[pos >> 16] * 256 + (pos & 0xffff);
    const bf16_t* y = (const bf16_t*)(p->ws + WS_Y) + (size_t)slot * 1024;
    const float* gate = (const float*)(p->ws + WS_MOD) + ((size_t)lm * 3 + v) * 6144 + 5 * 1024;
#pragma unroll
    for (int j = 0; j < 4; ++j) { const int k = 4 * lane + 256 * j; const u32x2 yv = *(const u32x2*)(y + k); const f32x4 g4 = *(const f32x4*)(gate + k);
        xv[j][0] += g4[0] * bflo(yv.x); xv[j][1] += g4[1] * bfhi(yv.x); xv[j][2] += g4[2] * bflo(yv.y); xv[j][3] += g4[3] * bfhi(yv.y); }
}
__device__ __forceinline__ void phase_r1(CP p, int l, unsigned char* lds, int bid, int nb) {
    float* wdt = (float*)lds;
    float* gm = wdt + 16 * 1024;
    float* sh = gm + 3 * 1024;
    const int tid = launder_tid(); const int lane = tid & 63, wave = tid >> 6;
    const float* mod = (const float*)(p->ws + WS_MOD) + (size_t)l * 3 * 6144;
    const float* win = p->w_in + (size_t)l * 1024 * DIN;
    for (int idx = tid; idx < 16 * 1024; idx += NTHREADS) { const int k = idx >> 4, n = idx & 15; wdt[n * 1024 + k] = win[(size_t)k * DIN + NPROJ + n]; }
    for (int idx = tid; idx < 3 * 1024; idx += NTHREADS) { const int v = idx >> 10, k = idx & 1023; gm[idx] = p->g_mix[l * 1024 + k] * (1.f + mod[v * 6144 + 1024 + k]); sh[idx] = mod[v * 6144 + k]; }
    LAS int* tab = (LAS int*)((LAS unsigned char*)lds + MISC_OFF);
    if (l > 0) moe_table(p, l - 1, tab);
    __syncthreads();
    bf16_t* HX = (bf16_t*)(p->ws + WS_HX); float* DT = (float*)(p->ws + WS_DT);
    for (int r = bid * 8 + wave; r < R; r += nb * 8) {
        const f32x4* hr = (const f32x4*)hin_ptr(p, l, r); const int v = row_v(r);
        f32x4 xv[4]; float ss = 0.f;
#pragma unroll
        for (int j = 0; j < 4; ++j) xv[j] = hr[lane + 64 * j];
        if (l > 0) { moe_apply(p, l - 1, r, v, lane, tab, xv); f32x4* hw = (f32x4*)hptr(p, r);
#pragma unroll
            for (int j = 0; j < 4; ++j) hw[lane + 64 * j] = xv[j]; }
#pragma unroll
        for (int j = 0; j < 4; ++j) ss += xv[j][0] * xv[j][0] + xv[j][1] * xv[j][1] + xv[j][2] * xv[j][2] + xv[j][3] * xv[j][3];
        ss = wave_sum(ss); const float rs = rsqrtf(ss * (1.f / 1024.f) + 1e-6f);
#pragma unroll
        for (int j = 0; j < 4; ++j) { const int k = 4 * lane + 256 * j; const f32x4 g4 = *(const f32x4*)(gm + v * 1024 + k), s4 = *(const f32x4*)(sh + v * 1024 + k);
            xv[j] = xv[j] * rs * g4 + s4;
            u32x2 o; o.x = cvt_pk_bf16(xv[j][0], xv[j][1]); o.y = cvt_pk_bf16(xv[j][2], xv[j][3]);
            *(u32x2*)(HX + (size_t)r * 1024 + k) = o; }
        float mine = 0.f;
#pragma unroll
        for (int n = 0; n < 16; ++n) { float a = 0.f;
#pragma unroll
            for (int j = 0; j < 4; ++j) { const f32x4 w4 = *(const f32x4*)(wdt + n * 1024 + 4 * lane + 256 * j); a += xv[j][0] * w4[0] + xv[j][1] * w4[1] + xv[j][2] * w4[2] + xv[j][3] * w4[3]; }
            a = wave_sum(a); mine = (lane == n) ? a : mine; }
        if (lane < 16) DT[(size_t)r * 16 + lane] = softplusf_(mine + p->dt_bias[l * 16 + lane]);
    }
}
typedef float f32x16 __attribute__((ext_vector_type(16)));
typedef short s16x4 __attribute__((ext_vector_type(4)));
constexpr int ST_ROW = 272;
constexpr int ST_TR128 = 320;
constexpr int ST_TR64 = 192;
constexpr int NCHUNK = SEG / 128;

__device__ __forceinline__ float wave_incl_scan(float v, int lane) {
#pragma unroll
    for (int o = 1; o < 64; o <<= 1) { const float t = __shfl_up(v, o); if (lane >= o) v += t; }
    return v;
}
__device__ __forceinline__ bf16x8 row_frag(const LAS unsigned char* tile, int stride, int row0, int k0, int lane) {
    return *(const LAS bf16x8*)(tile + (row0 + (lane & 31)) * stride + (k0 + 8 * (lane >> 5)) * 2);
}
__device__ __forceinline__ bf16x8 tr_frag(const LAS unsigned char* tile, int stride, int k0, int c0, int lane) {
    const int g = lane >> 4, li = lane & 15, q = li >> 2, pp = li & 3;
    const LAS unsigned char* a0 = tile + (k0 + 8 * (g >> 1) + q) * stride + (c0 + 16 * (g & 1) + 4 * pp) * 2;
    const s16x4 lo = __builtin_amdgcn_ds_read_tr16_b64_v4i16((LAS s16x4*)a0);
    const s16x4 hi = __builtin_amdgcn_ds_read_tr16_b64_v4i16((LAS s16x4*)(a0 + 4 * stride));
    return __builtin_shufflevector(lo, hi, 0, 1, 2, 3, 4, 5, 6, 7);
}
__device__ __forceinline__ void conv_item(const bf16_t* proj, int row0, int rq, int xch, bool lo_ok, bool hi_ok, const float* cw, const float* cbias, float (&o)[4][8]) {
    u32x4 raw[8];
    unsigned zz; asm volatile("v_mov_b32 %0, 0" : "=v"(zz));
#pragma unroll
    for (int j = 0; j < 8; ++j) { const int lr = 4 * rq - 2 + j; const bool ok = (lr >= 0 || lo_ok) && (lr < 128 || hi_ok);
        raw[j] = ok ? *(const u32x4*)(proj + (size_t)(row0 + lr) * NPROJ + 1536 + xch) : (u32x4){zz, zz, zz, zz}; }
    float w[5][8], bs[8];
#pragma unroll
    for (int j = 0; j < 5; ++j) { const f32x4 w0 = *(const f32x4*)(cw + j * 1024 + xch), w1 = *(const f32x4*)(cw + j * 1024 + xch + 4);
        w[j][0] = w0[0]; w[j][1] = w0[1]; w[j][2] = w0[2]; w[j][3] = w0[3]; w[j][4] = w1[0]; w[j][5] = w1[1]; w[j][6] = w1[2]; w[j][7] = w1[3]; }
    { const f32x4 b0 = *(const f32x4*)(cbias + xch), b1 = *(const f32x4*)(cbias + xch + 4); bs[0] = b0[0]; bs[1] = b0[1]; bs[2] = b0[2]; bs[3] = b0[3]; bs[4] = b1[0]; bs[5] = b1[1]; bs[6] = b1[2]; bs[7] = b1[3]; }
#pragma unroll
    for (int i = 0; i < 4; ++i)
#pragma unroll
        for (int e = 0; e < 8; ++e) o[i][e] = bs[e];
#pragma unroll
    for (int j = 0; j < 8; ++j) {
        float xv[8] = {bflo(raw[j].x), bfhi(raw[j].x), bflo(raw[j].y), bfhi(raw[j].y), bflo(raw[j].z), bfhi(raw[j].z), bflo(raw[j].w), bfhi(raw[j].w)};
#pragma unroll
        for (int i = 0; i < 4; ++i) { const int tap = j - i; if (tap >= 0 && tap < 5) {
#pragma unroll
                for (int e = 0; e < 8; ++e) o[i][e] += w[tap][e] * xv[e]; } }
    }
#pragma unroll
    for (int i = 0; i < 4; ++i)
#pragma unroll
        for (int e = 0; e < 8; ++e) o[i][e] = siluf_(o[i][e]);
}
__device__ __forceinline__ u32x4 pack8(const float (&v)[8]) { u32x4 r; r.x = cvt_pk_bf16(v[0], v[1]); r.y = cvt_pk_bf16(v[2], v[3]); r.z = cvt_pk_bf16(v[4], v[5]); r.w = cvt_pk_bf16(v[6], v[7]); return r; }
__device__ __forceinline__ u32x4 pack8s(const float (&v)[8], float sc) { u32x4 r; r.x = cvt_pk_bf16(v[0] * sc, v[1] * sc); r.y = cvt_pk_bf16(v[2] * sc, v[3] * sc); r.z = cvt_pk_bf16(v[4] * sc, v[5] * sc); r.w = cvt_pk_bf16(v[6] * sc, v[7] * sc); return r; }

__device__ __forceinline__ void chunk_cums(CP p, int l, int row0, int h, int wave, int lane, LAS float* vec) {
    if (wave < 2) {
        const int dir = wave; const float A = -expf(p->a_log[l * 16 + dir * 8 + h]);
        const float* DT = (const float*)(p->ws + WS_DT);
        const float d0 = DT[(size_t)(row0 + 2 * lane) * 16 + dir * 8 + h], d1 = DT[(size_t)(row0 + 2 * lane + 1) * 16 + dir * 8 + h];
        const float x0 = d0 * A, x1 = d1 * A;
        const float incl = wave_incl_scan(x0 + x1, lane);
        const float total = __shfl(incl, 63);
        float c0, c1;
        if (dir == 0) { c1 = incl; c0 = incl - x1; } else { c0 = total - (incl - x1 - x0); c1 = total - (incl - x1); }
        vec[dir * 128 + 2 * lane] = c0; vec[dir * 128 + 2 * lane + 1] = c1;
        vec[256 + dir * 128 + 2 * lane] = d0; vec[256 + dir * 128 + 2 * lane + 1] = d1;
        if (lane == 0) vec[512 + dir] = total;
    }
}

__device__ __forceinline__ void phase_c1(CP p, int l, unsigned char* lds_, int bid, int nb) {
    LAS unsigned char* lds = (LAS unsigned char*)lds_;
    LAS unsigned char* tile = lds;
    LAS float* wl = (LAS float*)(lds + 73216);
    const int tid = launder_tid();
    const bf16_t* proj = (const bf16_t*)(p->ws + WS_PROJ); bf16_t* mix = (bf16_t*)(p->ws + WS_HX);
#pragma unroll 1
    for (int u = bid; u < 256 + 512 + 16; u += nb) {
        int S, LEN, pstride, sstride, tok0, ch0;
        if (u < 256) { const int b = u >> 7, cs = (u >> 2) & 31, cc = u & 3; S = 2; LEN = 256; pstride = 64; sstride = 1; tok0 = b * SEG + CTXL + 2 * cs; ch0 = 256 + 64 * cc; }
        else if (u < 768) { const int v = u - 256; const int b = v >> 8, rg = (v >> 2) & 63, cc = v & 3; S = 4; LEN = 64; pstride = 1; sstride = 64; tok0 = b * SEG + CTXL + 256 * rg; ch0 = 64 * cc; }
        else { const int v = u - 768; const int b = v >> 3, cc = v & 7; S = 1; LEN = 256; pstride = 1; sstride = 0; tok0 = b * SEG; ch0 = 64 * cc; }
        const int LP = LEN + 30;
        for (int i = tid; i < 32 * 64; i += NTHREADS) { const int j = i >> 6, c = i & 63; wl[i] = j < 31 ? p->conv_w[((size_t)l * 31 + j) * 512 + ch0 + c] : p->conv_b[l * 512 + ch0 + c]; }
        for (int i = tid; i < S * 30 * 8; i += NTHREADS) { const int pc = i & 7, q = (i >> 3) % 30, sq = (i >> 3) / 30; const int pos = q < 15 ? q : LEN + q;
            unsigned zz; asm volatile("v_mov_b32 %0, 0" : "=v"(zz));
            *(LAS u32x4*)(tile + ((sq * LP + pos) * 64 + pc * 8) * 2) = (u32x4){zz, zz, zz, zz}; }
        for (int i = tid; i < S * LEN * 8; i += NTHREADS) { const int pc = i & 7, t = i >> 3; const int sq = t / LEN, pos = t - sq * LEN;
            const bf16_t* src = proj + (size_t)(tok0 + sq * sstride + pos * pstride) * NPROJ + ch0 + pc * 8;
            const u32x4 uv = *(const u32x4*)src, gv = *(const u32x4*)(src + 512);
            u32x4 o;
            o.x = cvt_pk_bf16(bflo(uv.x) * sigmoidf_(bflo(gv.x)), bfhi(uv.x) * sigmoidf_(bfhi(gv.x)));
            o.y = cvt_pk_bf16(bflo(uv.y) * sigmoidf_(bflo(gv.y)), bfhi(uv.y) * sigmoidf_(bfhi(gv.y)));
            o.z = cvt_pk_bf16(bflo(uv.z) * sigmoidf_(bflo(gv.z)), bfhi(uv.z) * sigmoidf_(bfhi(gv.z)));
            o.w = cvt_pk_bf16(bflo(uv.w) * sigmoidf_(bflo(gv.w)), bfhi(uv.w) * sigmoidf_(bfhi(gv.w)));
            *(LAS u32x4*)(tile + ((sq * LP + 15 + pos) * 64 + pc * 8) * 2) = o; }
        __syncthreads();
        const int noct = S * LEN / 8;
#pragma unroll 1
        for (int it = tid; it < noct * 32; it += NTHREADS) {
            const int cp = it & 31, oc = it >> 5; const int sq = oc / (LEN / 8), p0 = (oc - sq * (LEN / 8)) * 8;
            const LAS unsigned* base = (const LAS unsigned*)(tile + ((sq * LP + p0) * 64) * 2) + cp;
            float i0[38], i1[38];
#pragma unroll
            for (int k = 0; k < 38; ++k) { const unsigned w = base[k * 32]; i0[k] = bflo(w); i1[k] = bfhi(w); }
            float a0[8], a1[8];
            { const float b0 = wl[31 * 64 + 2 * cp], b1 = wl[31 * 64 + 2 * cp + 1];
#pragma unroll
              for (int i = 0; i < 8; ++i) { a0[i] = b0; a1[i] = b1; } }
#pragma unroll
            for (int j = 0; j < 31; ++j) { const float w0 = wl[j * 64 + 2 * cp], w1 = wl[j * 64 + 2 * cp + 1];
#pragma unroll
                for (int i = 0; i < 8; ++i) { a0[i] += w0 * i0[i + j]; a1[i] += w1 * i1[i + j]; } }
#pragma unroll
            for (int i = 0; i < 8; ++i) { const int tok = tok0 + sq * sstride + (p0 + i) * pstride;
                *(unsigned*)(mix + (size_t)tok * 1024 + 512 + ch0 + 2 * cp) = cvt_pk_bf16(a0[i], a1[i]); }
        }
        __syncthreads();
    }
}
__device__ __forceinline__ void phase_c1_ln(CP p, int l, int bid, int nb) {
    const int tid = launder_tid(); const int lane = tid & 63, wave = tid >> 6;
    bf16_t* mix = (bf16_t*)(p->ws + WS_HX);
    const f32x4 g0 = *(const f32x4*)(p->conv_ln_g + l * 512 + lane * 8), g1 = *(const f32x4*)(p->conv_ln_g + l * 512 + lane * 8 + 4);
    const f32x4 b0 = *(const f32x4*)(p->conv_ln_b + l * 512 + lane * 8), b1 = *(const f32x4*)(p->conv_ln_b + l * 512 + lane * 8 + 4);
    const float gg[8] = {g0[0], g0[1], g0[2], g0[3], g1[0], g1[1], g1[2], g1[3]}, bb[8] = {b0[0], b0[1], b0[2], b0[3], b1[0], b1[1], b1[2], b1[3]};
    for (int r = bid * 8 + wave; r < R; r += nb * 8) {
        u32x4* ptr = (u32x4*)(mix + (size_t)r * 1024 + 512 + lane * 8);
        const u32x4 v = *ptr;
        float y[8] = {bflo(v.x), bfhi(v.x), bflo(v.y), bfhi(v.y), bflo(v.z), bfhi(v.z), bflo(v.w), bfhi(v.w)};
        float s = 0.f;
#pragma unroll
        for (int e = 0; e < 8; ++e) s += y[e];
        const float mu = wave_sum(s) * (1.f / 512.f);
        float q = 0.f;
#pragma unroll
        for (int e = 0; e < 8; ++e) { y[e] -= mu; q += y[e] * y[e]; }
        const float rstd = rsqrtf(wave_sum(q) * (1.f / 512.f) + 1e-5f);
        float o[8];
#pragma unroll
        for (int e = 0; e < 8; ++e) o[e] = siluf_(y[e] * rstd * gg[e] + bb[e]);
        *ptr = pack8(o);
    }
}
__device__ __forceinline__ void phase_s1(CP p, int l, unsigned char* lds_, int bid, int nb) {
    LAS unsigned char* lds = (LAS unsigned char*)lds_;
    LAS unsigned char* Bs = lds;
    LAS unsigned char* Xf = lds + 128 * ST_TR128;
    LAS unsigned char* Xb = Xf + 128 * ST_TR64;
    LAS float* vec = (LAS float*)(Xb + 128 * ST_TR64);
    const int tid = launder_tid(); const int lane = tid & 63, wave = __builtin_amdgcn_readfirstlane(tid >> 6);
    const bf16_t* proj = (const bf16_t*)(p->ws + WS_PROJ);
    const float* cw = p->ssd_conv_w + (size_t)l * 5 * 1024; const float* cbias = p->ssd_conv_b + (size_t)l * 1024;
    float* Sg = (float*)(p->ws + WS_S); float* DEC = (float*)(p->ws + WS_DEC);
#pragma unroll 1
    for (int u = bid; u < NB * NCHUNK * 8; u += nb) {
        const int h = u & 7, c = (u >> 3) % NCHUNK, b = (u >> 3) / NCHUNK, g = h >> 2;
        const int row0 = b * SEG + c * 128;
        const bool lo_ok = !(c == 0 || c == 2), hi_ok = !(c == 1 || c == NCHUNK - 1);
        chunk_cums(p, l, row0, h, wave, lane, vec);
        __syncthreads();
        if (tid < 2) DEC[((size_t)(b * 2 + tid) * NCHUNK + c) * 8 + h] = __expf(vec[512 + tid]);
#pragma unroll 1
        for (int it = tid; it < 32 * 24; it += NTHREADS) {
            const int rq = it / 24, cg = it % 24;
            float o[4][8];
            if (cg < 16) {
                conv_item(proj, row0, rq, 512 + g * 128 + cg * 8, lo_ok, hi_ok, cw, cbias, o);
#pragma unroll
                for (int i = 0; i < 4; ++i) *(LAS u32x4*)(Bs + (4 * rq + i) * ST_TR128 + cg * 16) = pack8(o[i]);
            } else {
                const int xc = cg - 16;
                conv_item(proj, row0, rq, h * 64 + xc * 8, lo_ok, hi_ok, cw, cbias, o);
                const float tf = vec[512], tb = vec[513];
#pragma unroll
                for (int i = 0; i < 4; ++i) { const int lr = 4 * rq + i;
                    const float wf = __expf(tf - vec[lr]) * vec[256 + lr];
                    const float wb = __expf(tb - vec[128 + lr]) * vec[384 + lr];
                    *(LAS u32x4*)(Xf + lr * ST_TR64 + xc * 16) = pack8s(o[i], wf);
                    *(LAS u32x4*)(Xb + lr * ST_TR64 + xc * 16) = pack8s(o[i], wb); }
            }
        }
        __syncthreads();
        {
            const int dir = wave >> 2, nq = wave & 3;
            const LAS unsigned char* Xd = dir ? Xb : Xf;
            f32x16 acc[2];
#pragma unroll
            for (int t = 0; t < 2; ++t)
#pragma unroll
                for (int e = 0; e < 16; ++e) acc[t][e] = 0.f;
#pragma unroll
            for (int kk = 0; kk < 8; ++kk) {
                const bf16x8 bf = tr_frag(Bs, ST_TR128, 16 * kk, 32 * nq, lane);
#pragma unroll
                for (int t = 0; t < 2; ++t) { const bf16x8 af = tr_frag(Xd, ST_TR64, 16 * kk, 32 * t, lane);
                    acc[t] = __builtin_amdgcn_mfma_f32_32x32x16_bf16(af, bf, acc[t], 0, 0, 0); }
            }
            float* So = Sg + ((size_t)((b * 2 + dir) * NCHUNK + c) * 8 + h) * 8192 + 32 * nq + (lane & 31);
#pragma unroll
            for (int t = 0; t < 2; ++t)
#pragma unroll
                for (int e = 0; e < 16; ++e) { const int pr = 32 * t + (e & 3) + 8 * (e >> 2) + 4 * (lane >> 5); So[(size_t)pr * 128] = acc[t][e]; }
        }
        __syncthreads();
    }
}
__device__ __forceinline__ void phase_s2(CP p, int bid, int nb) {
    const int tid = launder_tid();
    const float* Sg = (const float*)(p->ws + WS_S); const float* DEC = (const float*)(p->ws + WS_DEC); bf16_t* HP = (bf16_t*)(p->ws + WS_HP);
    for (int idx = bid * NTHREADS + tid; idx < 2 * 2 * 8 * 64 * 64; idx += nb * NTHREADS) {
        const int n2 = idx & 63, pr = (idx >> 6) & 63, h = (idx >> 12) & 7, dir = (idx >> 15) & 1, b = idx >> 16;
        const size_t inner = (size_t)h * 8192 + pr * 128 + 2 * n2;
        const size_t cbase = (size_t)(b * 2 + dir) * NCHUNK;
        float s0 = 0.f, s1 = 0.f;
#pragma unroll 5
        for (int step = 0; step < NCHUNK; ++step) {
            const int c = dir == 0 ? step : (step < 2 ? 1 - step : NCHUNK + 1 - step);
            const size_t off = (cbase + c) * 65536 + inner;
            const float2 sv = *(const float2*)(Sg + off); const float d = DEC[(cbase + c) * 8 + h];
            *(unsigned*)(HP + off) = cvt_pk_bf16(s0, s1);
            s0 = s0 * d + sv.x; s1 = s1 * d + sv.y;
        }
    }
}
__device__ __forceinline__ void phase_s3(CP p, int l, unsigned char* lds_, int bid, int nb) {
    LAS unsigned char* lds = (LAS unsigned char*)lds_;
    LAS unsigned char* Cs = lds;
    LAS unsigned char* Bs = Cs + 128 * ST_ROW;
    LAS unsigned char* Mt = Bs;
    LAS unsigned char* Xs = Bs + 128 * ST_TR128;
    LAS unsigned char* Hf = Xs + 128 * ST_TR64;
    LAS unsigned char* Hb = Hf + 64 * ST_ROW;
    LAS float* vec = (LAS float*)(Hb + 64 * ST_ROW);
    LAS float* ssq = vec + 520;
    const int tid = launder_tid(); const int lane = tid & 63, wave = __builtin_amdgcn_readfirstlane(tid >> 6);
    const bf16_t* proj = (const bf16_t*)(p->ws + WS_PROJ); bf16_t* mix = (bf16_t*)(p->ws + WS_HX);
    const float* cw = p->ssd_conv_w + (size_t)l * 5 * 1024; const float* cbias = p->ssd_conv_b + (size_t)l * 1024;
    const bf16_t* HP = (const bf16_t*)(p->ws + WS_HP); float* SSQ = (float*)(p->ws + WS_SSQ);
#pragma unroll 1
    for (int u = bid; u < NB * NCHUNK * 8; u += nb) {
        const int h = u & 7, c = (u >> 3) % NCHUNK, b = (u >> 3) / NCHUNK, g = h >> 2;
        const int row0 = b * SEG + c * 128;
        const bool lo_ok = !(c == 0 || c == 2), hi_ok = !(c == 1 || c == NCHUNK - 1);
        chunk_cums(p, l, row0, h, wave, lane, vec);
        if (tid < 128) ssq[tid] = 0.f;
#pragma unroll 1
        for (int it = tid; it < 32 * 40; it += NTHREADS) {
            const int rq = it / 40, cg = it % 40;
            float o[4][8];
            if (cg < 32) { const int isB = cg >= 16, cc = cg & 15;
                conv_item(proj, row0, rq, (isB ? 512 : 768) + g * 128 + cc * 8, lo_ok, hi_ok, cw, cbias, o);
                LAS unsigned char* dst = (isB ? Bs : Cs);
#pragma unroll
                for (int i = 0; i < 4; ++i) *(LAS u32x4*)(dst + (4 * rq + i) * ST_ROW + cc * 16) = pack8(o[i]);
            } else { const int xc = cg - 32;
                conv_item(proj, row0, rq, h * 64 + xc * 8, lo_ok, hi_ok, cw, cbias, o);
#pragma unroll
                for (int i = 0; i < 4; ++i) *(LAS u32x4*)(Xs + (4 * rq + i) * ST_TR64 + xc * 16) = pack8(o[i]);
            }
        }
#pragma unroll 1
        for (int it = tid; it < 2048; it += NTHREADS) { const int dir = it >> 10, q = it & 1023, pr = q >> 4, ch = q & 15;
            const u32x4 v = *(const u32x4*)(HP + ((size_t)((b * 2 + dir) * NCHUNK + c) * 8 + h) * 8192 + pr * 128 + ch * 8);
            *(LAS u32x4*)((dir ? Hb : Hf) + pr * ST_ROW + ch * 16) = v; }
        __syncthreads();
        const int lb = wave >> 1, hs = wave & 1;
        int ln = lane; asm volatile("" : "+v"(ln));
        {
            f32x16 gacc[2];
#pragma unroll
            for (int t = 0; t < 2; ++t)
#pragma unroll
                for (int e = 0; e < 16; ++e) gacc[t][e] = 0.f;
#pragma unroll
            for (int kk = 0; kk < 8; ++kk) { const bf16x8 af = row_frag(Cs, ST_ROW, 32 * lb, 16 * kk, lane);
#pragma unroll
                for (int t = 0; t < 2; ++t) { const bf16x8 bf = row_frag(Bs, ST_ROW, 64 * hs + 32 * t, 16 * kk, lane);
                    gacc[t] = __builtin_amdgcn_mfma_f32_32x32x16_bf16(af, bf, gacc[t], 0, 0, 0); } }
            __syncthreads();
#pragma unroll
            for (int t = 0; t < 2; ++t) {
                const int sc = 64 * hs + 32 * t + (ln & 31);
                const float cfs = vec[sc], cbs = vec[128 + sc], dfs = vec[256 + sc], dbs = vec[384 + sc];
#pragma unroll
                for (int rg = 0; rg < 4; ++rg) {
                    const int l0 = 32 * lb + 8 * rg + 4 * (ln >> 5);
                    const f32x4 cfl = *(const LAS f32x4*)(vec + l0), cbl = *(const LAS f32x4*)(vec + 128 + l0);
                    float m[4];
#pragma unroll
                    for (int e = 0; e < 4; ++e) { const int lr = l0 + e;
                        const float ff = lr >= sc ? __expf(cfl[e] - cfs) * dfs : 0.f;
                        const float fb = lr <= sc ? __expf(cbl[e] - cbs) * dbs : 0.f;
                        m[e] = gacc[t][4 * rg + e] * (ff + fb); }
                    u32x2 pk; pk.x = cvt_pk_bf16(m[0], m[1]); pk.y = cvt_pk_bf16(m[2], m[3]);
                    *(LAS u32x2*)(Mt + sc * ST_TR128 + l0 * 2) = pk;
                }
            }
        }
        __syncthreads();
        {
            const int ph = hs;
            f32x16 ad, af_, ab_;
#pragma unroll
            for (int e = 0; e < 16; ++e) { ad[e] = 0.f; af_[e] = 0.f; ab_[e] = 0.f; }
#pragma unroll
            for (int kk = 0; kk < 8; ++kk) {
                const bf16x8 am = tr_frag(Mt, ST_TR128, 16 * kk, 32 * lb, lane);
                const bf16x8 bx = tr_frag(Xs, ST_TR64, 16 * kk, 32 * ph, lane);
                ad = __builtin_amdgcn_mfma_f32_32x32x16_bf16(am, bx, ad, 0, 0, 0);
                const bf16x8 ac = row_frag(Cs, ST_ROW, 32 * lb, 16 * kk, lane);
                const bf16x8 bhf = row_frag(Hf, ST_ROW, 32 * ph, 16 * kk, lane);
                const bf16x8 bhb = row_frag(Hb, ST_ROW, 32 * ph, 16 * kk, lane);
                af_ = __builtin_amdgcn_mfma_f32_32x32x16_bf16(ac, bhf, af_, 0, 0, 0);
                ab_ = __builtin_amdgcn_mfma_f32_32x32x16_bf16(ac, bhb, ab_, 0, 0, 0);
            }
            const int pc = 32 * ph + (ln & 31);
            const float dsk = p->d_skip[l * 8 + h];
#pragma unroll
            for (int rg = 0; rg < 4; ++rg) {
                const int l0 = 32 * lb + 8 * rg + 4 * (ln >> 5);
                const f32x4 cfl = *(const LAS f32x4*)(vec + l0), cbl = *(const LAS f32x4*)(vec + 128 + l0);
#pragma unroll
                for (int e = 0; e < 4; ++e) { const int lr = l0 + e; const int ri = 4 * rg + e;
                    const float xs = bf2f(*(const LAS bf16_t*)(Xs + lr * ST_TR64 + pc * 2));
                    const float y = ad[ri] + __expf(cfl[e]) * af_[ri] + __expf(cbl[e]) * ab_[ri] + dsk * xs;
                    const float z = bf2f(proj[(size_t)(row0 + lr) * NPROJ + 1024 + h * 64 + pc]);
                    const float val = y * siluf_(z);
                    mix[(size_t)(row0 + lr) * 1024 + h * 64 + pc] = f2bf(val);
                    float sq = val * val;
                    sq += __shfl_xor(sq, 1); sq += __shfl_xor(sq, 2); sq += __shfl_xor(sq, 4); sq += __shfl_xor(sq, 8); sq += __shfl_xor(sq, 16);
                    if ((ln & 31) == 0) atomicAdd((float*)(ssq + lr), sq);
                }
            }
        }
        __syncthreads();
        if (tid < 128) SSQ[(size_t)(row0 + tid) * 8 + h] = ssq[tid];
        __syncthreads();
    }
}
__device__ __forceinline__ void phase_r2(CP p, int l, unsigned char* lds, int bid, int nb) {
    float* wrt = (float*)lds;
    float* gm = wrt + 20 * 1024;
    float* sh = gm + 3 * 1024;
    int* lcnt = (int*)(sh + 3 * 1024);
    int* lcls = lcnt + 64;
    int* lrank = lcls + 1024;
    float* lcwa = (float*)(lrank + 1024);
    float* lcwb = lcwa + 1024;
    const int tid = launder_tid(); const int lane = tid & 63, wave = tid >> 6;
    const float* mod = (const float*)(p->ws + WS_MOD) + (size_t)l * 3 * 6144;
    for (int idx = tid; idx < 4 * 1024; idx += NTHREADS) { const int k = idx >> 2, n = idx & 3; wrt[n * 1024 + k] = p->w_rg[(size_t)l * 4096 + idx]; }
    for (int idx = tid; idx < 16 * 1024; idx += NTHREADS) { const int k = idx >> 4, n = idx & 15; wrt[(4 + n) * 1024 + k] = p->w_re[(size_t)l * 16384 + idx]; }
    for (int idx = tid; idx < 3 * 1024; idx += NTHREADS) { const int v = idx >> 10, k = idx & 1023; gm[idx] = p->g_ffn[l * 1024 + k] * (1.f + mod[v * 6144 + 4 * 1024 + k]); sh[idx] = mod[v * 6144 + 3 * 1024 + k]; }
    if (tid < 64) lcnt[tid] = 0;
    __syncthreads();
    bf16_t* HM = (bf16_t*)(p->ws + WS_HX); float* CWLA = (float*)(p->ws + WS_CWLA); float* CWLB = (float*)(p->ws + WS_CWLB); int* POS = (int*)(p->ws + WS_POS) + (size_t)l * R;
    int* gcount = (int*)(p->ws + WS_CTL) + l * 32; int* LIST = (int*)(p->ws + WS_LIST);
    const int rpb = (R + nb - 1) / nb, r0 = bid * rpb, r1 = (r0 + rpb) < R ? (r0 + rpb) : R;
    for (int r = r0 + wave; r < r1; r += 8) {
        const f32x4* hr = (const f32x4*)hptr(p, r); const int v = row_v(r);
        f32x4 xv[4]; float ss = 0.f;
#pragma unroll
        for (int j = 0; j < 4; ++j) { xv[j] = hr[lane + 64 * j]; ss += xv[j][0] * xv[j][0] + xv[j][1] * xv[j][1] + xv[j][2] * xv[j][2] + xv[j][3] * xv[j][3]; }
        ss = wave_sum(ss); const float rs = rsqrtf(ss * (1.f / 1024.f) + 1e-6f);
#pragma unroll
        for (int j = 0; j < 4; ++j) { const int k = 4 * lane + 256 * j; const f32x4 g4 = *(const f32x4*)(gm + v * 1024 + k), s4 = *(const f32x4*)(sh + v * 1024 + k);
            xv[j] = xv[j] * rs * g4 + s4;
            u32x2 o; o.x = cvt_pk_bf16(xv[j][0], xv[j][1]); o.y = cvt_pk_bf16(xv[j][2], xv[j][3]);
            *(u32x2*)(HM + (size_t)r * 1024 + k) = o; }
        float lg[20];
#pragma unroll
        for (int n = 0; n < 20; ++n) { float a = 0.f;
#pragma unroll
            for (int j = 0; j < 4; ++j) { const f32x4 w4 = *(const f32x4*)(wrt + n * 1024 + 4 * lane + 256 * j); a += xv[j][0] * w4[0] + xv[j][1] * w4[1] + xv[j][2] * w4[2] + xv[j][3] * w4[3]; }
            lg[n] = wave_sum(a) + (n < 4 ? p->b_rg[l * 4 + n] : p->b_re[l * 16 + n - 4]); }
        int gsel = 0; float gmax = lg[0];
#pragma unroll
        for (int q = 1; q < 4; ++q) if (lg[q] > gmax) { gmax = lg[q]; gsel = q; }
        float gden = 0.f;
#pragma unroll
        for (int q = 0; q < 4; ++q) gden += __expf(lg[q] - gmax);
        const float gprob = 1.f / gden;
        float el[4];
#pragma unroll
        for (int q = 0; q < 4; ++q) el[q] = gsel == 0 ? lg[4 + q] : (gsel == 1 ? lg[8 + q] : (gsel == 2 ? lg[12 + q] : lg[16 + q]));
        int i0 = 0; float m0 = el[0];
#pragma unroll
        for (int q = 1; q < 4; ++q) if (el[q] > m0) { m0 = el[q]; i0 = q; }
        int i1 = -1; float m1 = -3.0e38f;
#pragma unroll
        for (int q = 0; q < 4; ++q) if (q != i0 && el[q] > m1) { m1 = el[q]; i1 = q; }
        const float w0 = gprob / (1.f + __expf(m1 - m0)), w1 = gprob - w0;
        const int ea = i0 < i1 ? i0 : i1, eb = i0 < i1 ? i1 : i0;
        const float cwa = i0 < i1 ? w0 : w1, cwb = i0 < i1 ? w1 : w0;
        const int pidx = ea == 0 ? eb - 1 : (ea == 1 ? eb + 1 : 5);
        const int cls = gsel * 6 + pidx;
        if (lane == 0) { const int rank = atomicAdd(&lcnt[cls], 1); lcls[r - r0] = cls; lrank[r - r0] = rank; lcwa[r - r0] = cwa; lcwb[r - r0] = cwb; }
    }
    __syncthreads();
    if (tid < NCLS) lcnt[32 + tid] = atomicAdd(&gcount[tid], lcnt[tid]);
    __syncthreads();
    for (int idx = tid; idx < r1 - r0; idx += NTHREADS) { const int cl = lcls[idx]; const int pos = lcnt[32 + cl] + lrank[idx]; const size_t li = (size_t)cl * R + pos;
        LIST[li] = r0 + idx; CWLA[li] = lcwa[idx]; CWLB[li] = lcwb[idx]; POS[r0 + idx] = (cl << 16) | pos; }
    __syncthreads();
}
__device__ __forceinline__ void phase_final(CP p, unsigned char* lds, int bid, int nb) {
    const int tid = launder_tid(); const int lane = tid & 63, wave = tid >> 6;
    LAS int* tab = (LAS int*)((LAS unsigned char*)lds + MISC_OFF);
    moe_table(p, DEPTH - 1, tab);
    for (int q = bid * 8 + wave; q < NB * SEQ; q += nb * 8) {
        const int b = q >= SEQ ? 1 : 0; const int r = b * SEG + CTXL + (q - b * SEQ);
        f32x4* hr = (f32x4*)(p->out + (size_t)q * D);
        f32x4 xv[4]; float ss = 0.f;
#pragma unroll
        for (int j = 0; j < 4; ++j) xv[j] = hr[lane + 64 * j];
        moe_apply(p, DEPTH - 1, r, b, lane, tab, xv);
#pragma unroll
        for (int j = 0; j < 4; ++j) ss += xv[j][0] * xv[j][0] + xv[j][1] * xv[j][1] + xv[j][2] * xv[j][2] + xv[j][3] * xv[j][3];
        ss = wave_sum(ss); const float rs = rsqrtf(ss * (1.f / 1024.f) + 1e-6f);
#pragma unroll
        for (int j = 0; j < 4; ++j) { const f32x4 g4 = *(const f32x4*)(p->g_final + 4 * lane + 256 * j); hr[lane + 64 * j] = xv[j] * rs * g4; }
    }
}

#ifndef PHASE_MASK
#define PHASE_MASK 0xFFFFF
#endif
#define PM(i) ((PHASE_MASK >> (i)) & 1)
constexpr int PH_PER_LAYER = 9, NPHASES = 1 + DEPTH * PH_PER_LAYER + 1;
__global__ void __launch_bounds__(NTHREADS, 2) mk_fwd(Args args) {
    extern __shared__ __attribute__((aligned(16))) unsigned char lds[];
    cg::grid_group grid = cg::this_grid();
    const __attribute__((address_space(4))) Args* ap = (const __attribute__((address_space(4))) Args*)__builtin_amdgcn_kernarg_segment_ptr();
    const int lo = ap->lo, hi = ap->hi;
    LAS unsigned char* ldsl = (LAS unsigned char*)lds;
    for (int ph = lo; ph < hi; ++ph) {
        CP p = launder(&ap->p);
        int bid = blockIdx.x, nb = gridDim.x; asm volatile("" : "+s"(bid), "+s"(nb));
        if (ph == 0) { if (PM(0)) phase_wprep(p, lds, bid, nb); if (PM(1)) phase_adaln(p, lds, bid, nb); }
        else if (ph == NPHASES - 1) { if (PM(12)) phase_final(p, lds, bid, nb); }
        else {
            const int l = (ph - 1) / PH_PER_LAYER, s = (ph - 1) % PH_PER_LAYER;
            if (s == 0) { if (PM(2)) phase_r1(p, l, lds, bid, nb); }
            else if (s == 1) { if (PM(3)) {
                pg8::DenseSched S; S.init(p->ws + WS_HX, (const bf16_t*)(p->ws + WS_WTIN) + (size_t)l * DIN * 1024, R, NPROJ, 1024, 1024, 1024, nb, bid);
                EpiProj E{(bf16_t*)(p->ws + WS_PROJ)};
                pg8::gemm_phase<EpiProj, pg8::DenseSched, false>(ldsl, 1024, 1024, 1024, S, E);
            } }
            else if (s == 2) { if (PM(4)) phase_c1(p, l, lds, bid, nb); if (PM(5)) phase_s1(p, l, lds, bid, nb); }
            else if (s == 3) { if (PM(6)) phase_s2(p, bid, nb); if (PM(4)) phase_c1_ln(p, l, bid, nb); }
            else if (s == 4) { if (PM(7)) phase_s3(p, l, lds, bid, nb); }
            else if (s == 5) { if (PM(8)) {
                pg8::DenseSched S; S.init(p->ws + WS_HX, (const bf16_t*)(p->ws + WS_WTOUT) + (size_t)l * 1024 * 1024, R, 1024, 1024, 1024, 1024, nb, bid);
                EpiResid E{l == 0 ? p->ctx : (const float*)(p->ws + WS_HC), l == 0 ? p->x : (const float*)p->out, (float*)(p->ws + WS_HC), p->out, (const float*)(p->ws + WS_MOD) + (size_t)l * 3 * 6144, (const float*)(p->ws + WS_SSQ)};
                pg8::gemm_phase<EpiResid, pg8::DenseSched, false>(ldsl, 1024, 1024, 1024, S, E);
            } }
            else if (s == 6) { if (PM(9)) phase_r2(p, l, lds, bid, nb); }
            else if (s == 7) { if (PM(10)) {
                LAS int* tab = (LAS int*)(ldsl + MISC_OFF); moe_table(p, l, tab);
                MoeSched S{tab, (const int*)(p->ws + WS_LIST), (const char*)(p->ws + WS_HX), (const char*)(p->ws + WS_WTGU), 0, l, nb, bid};
                EpiUp E{(bf16_t*)(p->ws + WS_HID), (const float*)(p->ws + WS_CWLA), (const float*)(p->ws + WS_CWLB)};
                pg8::gemm_phase<EpiUp, MoeSched, true>(ldsl, 1024, 1024, 1024, S, E);
            } }
            else { if (PM(11)) {
                LAS int* tab = (LAS int*)(ldsl + MISC_OFF); moe_table(p, l, tab);
                MoeSched S{tab, (const int*)(p->ws + WS_LIST), (const char*)(p->ws + WS_HID), (const char*)(p->ws + WS_WTD), 1, l, nb, bid};
                EpiY E{(bf16_t*)(p->ws + WS_Y)};
                pg8::gemm_phase<EpiY, MoeSched, false>(ldsl, 512, 256, 512, S, E);
            } }
        }
        if (ph + 1 < hi) grid.sync();
    }
}

extern "C" void kernel_launch(void* const* d_in, const int* in_sizes, int n_in, void* d_out, int out_size, void* d_ws, size_t ws_size, hipStream_t stream) {
    static int grid = 0;
    if (grid == 0) {
        if (n_in != 28 || ws_size < WS_END) { fprintf(stderr, "kernel_launch: unexpected n_in %d or ws_size %zu (< %zu)\n", n_in, ws_size, (size_t)WS_END); grid = -1; return; }
        int dev = 0, cus = 0, per_cu = 0;
        hipGetDevice(&dev); hipDeviceGetAttribute(&cus, hipDeviceAttributeMultiprocessorCount, dev);
        if (hipFuncSetAttribute((const void*)mk_fwd, hipFuncAttributeMaxDynamicSharedMemorySize, LDS_BYTES) != hipSuccess) { fprintf(stderr, "kernel_launch: hipFuncSetAttribute failed\n"); grid = -1; return; }
        if (hipOccupancyMaxActiveBlocksPerMultiprocessor(&per_cu, (const void*)mk_fwd, NTHREADS, LDS_BYTES) != hipSuccess || per_cu < 1) { fprintf(stderr, "kernel_launch: occupancy query says %d\n", per_cu); (void)hipGetLastError(); grid = -1; return; }
        grid = cus;
    }
    if (grid < 0) return;
    hipMemsetAsync((char*)d_ws + WS_CTL, 0, 4096, stream);
    Args a{};
    const float** pp = (const float**)&a.p;
    for (int i = 0; i < 28; ++i) pp[i] = (const float*)d_in[i];
    a.p.out = (float*)d_out; a.p.ws = (unsigned char*)d_ws;
#if PER_PHASE_LAUNCH
    for (int ph = 0; ph < NPHASES; ++ph) {
        a.lo = ph; a.hi = ph + 1; void* kargs[] = {&a};
        hipError_t e = hipLaunchCooperativeKernel((const void*)mk_fwd, dim3(grid), dim3(NTHREADS), kargs, LDS_BYTES, stream);
        if (e != hipSuccess) { fprintf(stderr, "kernel_launch: launch of phase %d failed: %s\n", ph, hipGetErrorString(e)); break; }
    }
#else
    a.lo = 0; a.hi = NPHASES; void* kargs[] = {&a};
    hipError_t e = hipLaunchCooperativeKernel((const void*)mk_fwd, dim3(grid), dim3(NTHREADS), kargs, LDS_BYTES, stream);
    if (e != hipSuccess) fprintf(stderr, "kernel_launch: cooperative launch failed: %s (grid %d)\n", hipGetErrorString(e), grid);
#endif
}
```

```cpp
#include <hip/hip_runtime.h>
#include <hip/hip_cooperative_groups.h>
#include <cstdio>
namespace cg = cooperative_groups;

#ifndef PER_PHASE_LAUNCH
#define PER_PHASE_LAUNCH 0
#endif

#define LAS __attribute__((address_space(3)))
typedef unsigned short bf16_t;
typedef short bf16x8 __attribute__((ext_vector_type(8)));
typedef float f32x4 __attribute__((ext_vector_type(4)));
typedef unsigned u32x4 __attribute__((ext_vector_type(4)));
typedef unsigned u32x2 __attribute__((ext_vector_type(2)));

constexpr int D = 1024, NB = 2, SEQ = 16384, CTXL = 256, SEG = SEQ + CTXL, R = NB * SEG, DEPTH = 2;
constexpr int NPROJ = 2560, DIN = 2576;
constexpr int NTHREADS = 512;
constexpr int LDS_BYTES = 147456;
constexpr int MISC_OFF = 131072;
constexpr int NCLS = 24;

constexpr size_t al256(size_t x) { return (x + 255) & ~size_t(255); }
constexpr size_t WS_CTL = 0;
constexpr size_t WS_BAR = 4096;
constexpr size_t WS_CTL_BYTES = 32768;
constexpr size_t WS_MOD = WS_CTL_BYTES;
constexpr size_t WS_WTIN = WS_MOD + al256((size_t)2 * 3 * 6144 * 4);
constexpr size_t WS_WTOUT = WS_WTIN + al256((size_t)2 * DIN * 1024 * 2);
constexpr size_t WS_WTGU = WS_WTOUT + al256((size_t)2 * 1024 * 1024 * 2);
constexpr size_t WS_WTD = WS_WTGU + al256((size_t)2 * 16 * 512 * 1024 * 2);
constexpr size_t WS_HC = WS_WTD + al256((size_t)2 * 16 * 1024 * 256 * 2);
constexpr size_t WS_HX = WS_HC + al256((size_t)512 * 1024 * 4);
constexpr size_t WS_PROJ = WS_HX + al256((size_t)R * 1024 * 2);
constexpr size_t WS_DT = WS_PROJ + al256((size_t)R * NPROJ * 2);
constexpr size_t WS_POS = WS_DT + al256((size_t)R * 16 * 4);
constexpr size_t WS_LIST = WS_POS + al256((size_t)2 * R * 4);
constexpr size_t WS_CWLA = WS_LIST + al256((size_t)NCLS * R * 4);
constexpr size_t WS_CWLB = WS_CWLA + al256((size_t)NCLS * R * 4);
constexpr size_t WS_BIG = WS_CWLB + al256((size_t)NCLS * R * 4);
constexpr size_t WS_Y = WS_PROJ;
constexpr size_t WS_S = WS_BIG;
constexpr size_t WS_HP = WS_S + al256((size_t)2 * 2 * 130 * 8 * 8192 * 4);
constexpr size_t WS_DEC = WS_HP + al256((size_t)2 * 2 * 130 * 8 * 8192 * 2);
constexpr size_t WS_SSQ = WS_DEC + al256((size_t)2 * 2 * 130 * 8 * 4);
constexpr size_t WS_HID = WS_S;
constexpr size_t WS_END = WS_SSQ + al256((size_t)R * 8 * 4);
static_assert((size_t)(R + NCLS * 256) * 512 * 2 <= (size_t)2 * 2 * 130 * 8 * 8192 * 4, "hid alias");
static_assert(WS_END <= (size_t)512 * 1024 * 1024, "workspace");

struct Params {
    const float *x, *c, *ctx, *c_ctx, *w_ada, *b_ada, *g_mix, *g_ffn, *w_in, *conv_w, *conv_b, *conv_ln_g, *conv_ln_b, *ssd_conv_w, *ssd_conv_b,
        *dt_bias, *a_log, *d_skip, *ssd_norm_g, *w_out, *w_rg, *b_rg, *w_re, *b_re, *w_gate, *w_up, *w_down, *g_final;
    float* out; unsigned char* ws;
};
struct Args { Params p; int lo, hi; };
typedef const __attribute__((address_space(4))) Params* CP;
__device__ __forceinline__ CP launder(CP p) { asm volatile("" : "+s"(p)); return p; }
__device__ __forceinline__ int launder_tid() { int t = threadIdx.x; asm volatile("" : "+v"(t)); return t; }

__device__ __forceinline__ unsigned cvt_pk_bf16(float lo, float hi) { unsigned r; asm volatile("v_cvt_pk_bf16_f32 %0, %1, %2" : "=v"(r) : "v"(lo), "v"(hi)); return r; }
__device__ __forceinline__ float bf2f(unsigned b) { return __uint_as_float(b << 16); }
__device__ __forceinline__ float bflo(unsigned w) { return __uint_as_float(w << 16); }
__device__ __forceinline__ float bfhi(unsigned w) { return __uint_as_float(w & 0xffff0000u); }
__device__ __forceinline__ bf16_t f2bf(float f) { return (bf16_t)(cvt_pk_bf16(f, 0.f) & 0xffffu); }
__device__ __forceinline__ float wave_sum(float v) {
#pragma unroll
    for (int o = 1; o < 64; o <<= 1) v += __shfl_xor(v, o);
    return v;
}
__device__ __forceinline__ float sigmoidf_(float x) { return 1.f / (1.f + __expf(-x)); }
__device__ __forceinline__ float siluf_(float x) { return x / (1.f + __expf(-x)); }
__device__ __forceinline__ float softplusf_(float x) { return fmaxf(x, 0.f) + log1pf(expf(-fabsf(x))); }

__device__ __forceinline__ int row_b(int r) { return r >= SEG ? 1 : 0; }
__device__ __forceinline__ int row_i(int r) { return r >= SEG ? r - SEG : r; }
__device__ __forceinline__ int row_v(int r) { const int i = row_i(r); return i < CTXL ? 2 : row_b(r); }
__device__ __forceinline__ float* hptr2(float* hc, float* out, int r) {
    const int b = row_b(r), i = row_i(r);
    return i < CTXL ? hc + (size_t)(b * CTXL + i) * D : out + (size_t)(b * SEQ + i - CTXL) * D;
}
__device__ __forceinline__ float* hptr(CP p, int r) { return hptr2((float*)(p->ws + WS_HC), p->out, r); }
__device__ __forceinline__ const float* hin_ptr(CP p, int l, int r) {
    if (l == 0) return hptr2((float*)p->ctx, (float*)p->x, r);
    return hptr(p, r);
}

namespace pg8 {
constexpr int BM = 256, BK = 64, HALF = 128, HTB = HALF * BK * 2, STAGE_BYTES = 8 * HTB, NXCD = 8, WGM = 8;
__device__ __forceinline__ int lds_byte(int r, int c) { const int st = (r >> 4) * 2 + (c >> 5), rr = r & 15, cc = c & 31, ob = rr * 64 + cc * 2; return st * 1024 + (ob ^ (((ob >> 9) & 1) << 5)); }
__device__ __forceinline__ void stage_rc(int b, int& Rr, int& Cc) { const int st = b / 1024, sb = b % 1024, swz = sb ^ (((sb >> 9) & 1) << 5); Rr = (st >> 1) * 16 + swz / 64; Cc = (st & 1) * 32 + (swz % 64) / 2; }
__device__ __forceinline__ int perm32(int rho) { const int n = rho >> 4, i = rho & 15; return 8 * (i >> 2) + 4 * n + (i & 3); }

struct Unit {
    const char* a0;
    const char* b0;
    const char* b1;
    int i0, i1, i2, i3, i4, pad;
};

template <class Epi, class Sched, bool GATHER>
__device__ __forceinline__ void gemm_phase(LAS unsigned char* lds, const int lda, const int ldb, const int K, const Sched& S, const Epi& E) {
    const int tid = launder_tid(); const int wid = __builtin_amdgcn_readfirstlane(tid >> 6), lane = tid & 63, wr = wid >> 2, wc = wid & 3, fr = lane & 15, fq = lane >> 4;
    const int nt = K / BK, ks = nt >> 1;
    int Rr[2], Cc[2];
    unsigned voffB[2];
#pragma unroll
    for (int i = 0; i < 2; ++i) { stage_rc(tid * 16 + i * 8192, Rr[i], Cc[i]); const int Rb = Epi::PERM ? ((Rr[i] & ~31) + perm32(Rr[i] & 31)) : Rr[i];
        voffB[i] = (unsigned)(Rb * ldb + Cc[i]) * 2u; }
    const size_t kstep = (size_t)(BK * 2);
    const size_t hstepB = (size_t)HALF * ldb * 2;
    const unsigned ldsw = (unsigned)wid * 1024u;
    const unsigned ldsbase = (unsigned)(unsigned long)lds;
    const int aoff = lds_byte(wr * 64 + fr, fq * 8), boff = lds_byte(wc * 32 + fr, fq * 8);
#define PG8_SA(b, h) (((b) * 2 + (h)) * HTB)
#define PG8_SB(b, h) ((4 + (b) * 2 + (h)) * HTB)
#define PG8_STAGE2(bufoff, gbase, v0, v1) do { unsigned keep_; \
        asm volatile("s_mov_b32 %0, m0\n\ts_mov_b32 m0, %1\n\ts_nop 4\n\tglobal_load_lds_dwordx4 %2, %4\n\ts_add_u32 m0, m0, 0x2000\n\ts_nop 0\n\tglobal_load_lds_dwordx4 %3, %4\n\ts_mov_b32 m0, %0" \
            : "=&s"(keep_) : "s"(ldsbase + (unsigned)(bufoff) + ldsw), "v"(v0), "v"(v1), "s"(gbase) : "memory", "scc"); } while (0)
#define PG8_LDA(dst, b, h) do { _Pragma("unroll") for (int m = 0; m < 4; ++m) _Pragma("unroll") for (int k = 0; k < 2; ++k) dst[m][k] = *(const LAS bf16x8*)(lds + PG8_SA(b, h) + aoff + m * 2048 + k * 1024); } while (0)
#define PG8_LDB(dst, b, h) do { _Pragma("unroll") for (int n = 0; n < 2; ++n) _Pragma("unroll") for (int k = 0; k < 2; ++k) dst[n][k] = *(const LAS bf16x8*)(lds + PG8_SB(b, h) + boff + n * 2048 + k * 1024); } while (0)
#define PG8_MMA(ai, bj, At, Bt) do { __builtin_amdgcn_s_setprio(1); _Pragma("unroll") for (int m = 0; m < 4; ++m) _Pragma("unroll") for (int n = 0; n < 2; ++n) _Pragma("unroll") for (int k = 0; k < 2; ++k) \
        acc[ai][bj][m][n] = __builtin_amdgcn_mfma_f32_16x16x32_bf16(Bt[n][k], At[m][k], acc[ai][bj][m][n], 0, 0, 0); __builtin_amdgcn_s_setprio(0); } while (0)
#define PG8_WAIT_V(n) asm volatile("s_waitcnt vmcnt(" #n ")" ::: "memory")
#define PG8_WAIT_L(n) asm volatile("s_waitcnt lgkmcnt(" #n ")" ::: "memory")
#define PG8_BAR __builtin_amdgcn_s_barrier()
#define PG8_SCHED __builtin_amdgcn_sched_barrier(0)
#define PG8_BP(u, tt) ((tt) < ks ? (u).b0 + (size_t)(tt) * kstep : (u).b1 + (size_t)((tt) - ks) * kstep)
    Unit cur, nxt; int ui = 0;
    if (!S.get(0, cur)) return;
    unsigned c00, c01, c10, c11, n00, n01, n10, n11;
    if (GATHER) {
        c00 = (unsigned)(S.arow(cur, Rr[0]) * lda + Cc[0]) * 2u; c01 = (unsigned)(S.arow(cur, Rr[1]) * lda + Cc[1]) * 2u;
        c10 = (unsigned)(S.arow(cur, HALF + Rr[0]) * lda + Cc[0]) * 2u; c11 = (unsigned)(S.arow(cur, HALF + Rr[1]) * lda + Cc[1]) * 2u;
    } else {
        c00 = (unsigned)(Rr[0] * lda + Cc[0]) * 2u; c01 = (unsigned)(Rr[1] * lda + Cc[1]) * 2u;
        c10 = (unsigned)((HALF + Rr[0]) * lda + Cc[0]) * 2u; c11 = (unsigned)((HALF + Rr[1]) * lda + Cc[1]) * 2u;
    }
    n00 = c00; n01 = c01; n10 = c10; n11 = c11;
    f32x4 acc[2][2][4][2];
    float zr; asm volatile("v_mov_b32 %0, 0" : "=v"(zr));
#pragma unroll
    for (int a = 0; a < 2; ++a)
#pragma unroll
        for (int b = 0; b < 2; ++b)
#pragma unroll
            for (int m = 0; m < 4; ++m)
#pragma unroll
                for (int n = 0; n < 2; ++n) acc[a][b][m][n] = (f32x4){zr, zr, zr, zr};
    bf16x8 At[4][2], B0[2][2], B1[2][2];
    const char* cA = cur.a0;
    {
        const char* pb0 = PG8_BP(cur, 0); const char* pb1 = PG8_BP(cur, 1);
        PG8_STAGE2(PG8_SB(0, 0), pb0, voffB[0], voffB[1]); PG8_STAGE2(PG8_SA(0, 0), cA, c00, c01);
        PG8_STAGE2(PG8_SB(0, 1), pb0 + hstepB, voffB[0], voffB[1]); PG8_STAGE2(PG8_SA(0, 1), cA, c10, c11);
        if (wr == 1) PG8_BAR;
        PG8_WAIT_V(4); PG8_BAR;
        PG8_STAGE2(PG8_SB(1, 0), pb1, voffB[0], voffB[1]); PG8_STAGE2(PG8_SA(1, 0), cA + kstep, c00, c01);
        PG8_STAGE2(PG8_SB(1, 1), pb1 + hstepB, voffB[0], voffB[1]);
        PG8_WAIT_V(6); PG8_BAR;
    }
    for (;;) {
        const bool has_next = S.get(ui + 1, nxt);
        if (!has_next) nxt = cur;
        if (GATHER) {
            if (has_next) {
                n00 = (unsigned)(S.arow(nxt, Rr[0]) * lda + Cc[0]) * 2u; n01 = (unsigned)(S.arow(nxt, Rr[1]) * lda + Cc[1]) * 2u;
                n10 = (unsigned)(S.arow(nxt, HALF + Rr[0]) * lda + Cc[0]) * 2u; n11 = (unsigned)(S.arow(nxt, HALF + Rr[1]) * lda + Cc[1]) * 2u;
            } else { n00 = c00; n01 = c01; n10 = c10; n11 = c11; }
        }
        const char* nA = nxt.a0;
        for (int t = 0; t < nt; t += 2) {
            const bool last = (t == nt - 2);
            const char* a1 = cA + (size_t)(t + 1) * kstep;
            const char* a2 = last ? nA : cA + (size_t)(t + 2) * kstep;
            const char* a3 = a2 + kstep;
            const char* b2 = last ? PG8_BP(nxt, 0) : PG8_BP(cur, t + 2);
            const char* b3 = last ? PG8_BP(nxt, 1) : PG8_BP(cur, t + 3);
            const unsigned s00 = last ? n00 : c00, s01 = last ? n01 : c01, s10 = last ? n10 : c10, s11 = last ? n11 : c11;
            if constexpr (Epi::MIDSCALE) { if (t == ks) E.midscale(acc, cur, wr, wc, fr, fq); }
            PG8_LDB(B0, 0, 0); PG8_SCHED; PG8_LDA(At, 0, 0); PG8_STAGE2(PG8_SA(1, 1), a1, c10, c11);
            PG8_WAIT_L(8); PG8_BAR; PG8_WAIT_L(0); PG8_MMA(0, 0, At, B0); PG8_BAR; PG8_SCHED;
            PG8_LDB(B1, 0, 1); PG8_STAGE2(PG8_SB(0, 0), b2, voffB[0], voffB[1]);
            PG8_BAR; PG8_WAIT_L(0); PG8_MMA(0, 1, At, B1); PG8_BAR;
            PG8_LDA(At, 0, 1); PG8_STAGE2(PG8_SA(0, 0), a2, s00, s01);
            PG8_BAR; PG8_WAIT_L(0); PG8_MMA(1, 0, At, B0); PG8_BAR; PG8_SCHED;
            PG8_STAGE2(PG8_SB(0, 1), b2 + hstepB, voffB[0], voffB[1]);
            PG8_WAIT_V(6); PG8_BAR; PG8_MMA(1, 1, At, B1); PG8_BAR;
            PG8_LDB(B0, 1, 0); PG8_SCHED; PG8_LDA(At, 1, 0); PG8_STAGE2(PG8_SA(0, 1), a2, s10, s11);
            PG8_WAIT_L(8); PG8_BAR; PG8_WAIT_L(0); PG8_MMA(0, 0, At, B0); PG8_BAR; PG8_SCHED;
            PG8_LDB(B1, 1, 1); PG8_STAGE2(PG8_SB(1, 0), b3, voffB[0], voffB[1]);
            PG8_BAR; PG8_WAIT_L(0); PG8_MMA(0, 1, At, B1); PG8_BAR;
            PG8_LDA(At, 1, 1); PG8_STAGE2(PG8_SA(1, 0), a3, s00, s01);
            PG8_BAR; PG8_WAIT_L(0); PG8_MMA(1, 0, At, B0); PG8_BAR; PG8_SCHED;
            PG8_STAGE2(PG8_SB(1, 1), b3 + hstepB, voffB[0], voffB[1]);
            PG8_WAIT_V(6); PG8_BAR; PG8_MMA(1, 1, At, B1); PG8_BAR;
        }
        E(acc, cur, wr, wc, fr, fq);
        if (!has_next) break;
        asm volatile("v_mov_b32 %0, 0" : "=v"(zr));
#pragma unroll
        for (int a = 0; a < 2; ++a)
#pragma unroll
            for (int b = 0; b < 2; ++b)
#pragma unroll
                for (int m = 0; m < 4; ++m)
#pragma unroll
                    for (int n = 0; n < 2; ++n) acc[a][b][m][n] = (f32x4){zr, zr, zr, zr};
        cur = nxt; cA = nA; ++ui; c00 = n00; c01 = n01; c10 = n10; c11 = n11;
    }
    PG8_WAIT_V(0);
    if (wr == 0) PG8_BAR;
    PG8_BAR;
#undef PG8_SA
#undef PG8_SB
#undef PG8_STAGE2
#undef PG8_LDA
#undef PG8_LDB
#undef PG8_MMA
#undef PG8_WAIT_V
#undef PG8_WAIT_L
#undef PG8_BAR
#undef PG8_SCHED
#undef PG8_BP
}

struct DenseSched {
    const char* A; const char* Bt; int lda, ldb, K; int nM, nN, nwg, G, c;
    __device__ __forceinline__ void init(const void* A_, const void* Bt_, int M, int N, int K_, int lda_, int ldb_, int G_, int c_) {
        A = (const char*)A_; Bt = (const char*)Bt_; lda = lda_; ldb = ldb_; K = K_; nM = M / BM; nN = N / BM; nwg = nM * nN; G = G_; c = c_; }
    __device__ __forceinline__ bool get(int i, Unit& u) const {
        const long L = (long)i * G + c; if (L >= nwg) return false;
        int wgid = (int)L; { const int q = nwg / NXCD, r = nwg % NXCD, xcd = wgid % NXCD, off = wgid / NXCD; wgid = (xcd < r ? xcd * (q + 1) : r * (q + 1) + (xcd - r) * q) + off; }
        const int nig = WGM * nN, gid = wgid / nig, fm = gid * WGM, gsz = (nM - fm) < WGM ? (nM - fm) : WGM;
        const int pm = fm + ((wgid % nig) % gsz), pn = (wgid % nig) / gsz;
        u.a0 = A + (size_t)pm * BM * lda * 2; u.b0 = Bt + (size_t)pn * BM * ldb * 2; u.b1 = u.b0 + (size_t)(K / BK / 2) * BK * 2;
        u.i0 = pm; u.i1 = pn; u.i2 = 0; u.i3 = 0; u.i4 = 0; u.pad = 0; return true;
    }
    __device__ __forceinline__ int arow(const Unit&, int rl) const { return rl; }
};
}

struct EpiProj {
    static constexpr bool PERM = true, MIDSCALE = false;
    bf16_t* O;
    __device__ __forceinline__ void operator()(const f32x4 (&acc)[2][2][4][2], const pg8::Unit& u, int wr, int wc, int fr, int fq) const {
        const int row0 = u.i0 * 256 + wr * 64 + fr, col0 = u.i1 * 256 + wc * 32 + 8 * fq;
#pragma unroll
        for (int ai = 0; ai < 2; ++ai)
#pragma unroll
            for (int m = 0; m < 4; ++m) { bf16_t* rowp = O + (size_t)(row0 + ai * 128 + m * 16) * NPROJ + col0;
#pragma unroll
                for (int bj = 0; bj < 2; ++bj) { const f32x4 v0 = acc[ai][bj][m][0], v1 = acc[ai][bj][m][1];
                    u32x4 w; w.x = cvt_pk_bf16(v0[0], v0[1]); w.y = cvt_pk_bf16(v0[2], v0[3]); w.z = cvt_pk_bf16(v1[0], v1[1]); w.w = cvt_pk_bf16(v1[2], v1[3]);
                    *(u32x4*)(rowp + bj * 128) = w; } }
    }
};
struct EpiResid {
    static constexpr bool PERM = false, MIDSCALE = true;
    const float* inc; const float* inx; float* hc; float* out; const float* modl; const float* ssq;
    __device__ __forceinline__ void midscale(f32x4 (&acc)[2][2][4][2], const pg8::Unit& u, int wr, int wc, int fr, int fq) const {
        const int r0 = u.i0 * 256 + wr * 64 + fr;
#pragma unroll
        for (int ai = 0; ai < 2; ++ai)
#pragma unroll
            for (int m = 0; m < 4; ++m) { const float* sp = ssq + (size_t)(r0 + ai * 128 + m * 16) * 8;
                const f32x4 a = *(const f32x4*)sp, b = *(const f32x4*)(sp + 4);
                const float rs = rsqrtf(((a[0] + a[1]) + (a[2] + a[3]) + (b[0] + b[1]) + (b[2] + b[3])) * (1.f / 512.f) + 1e-6f);
#pragma unroll
                for (int bj = 0; bj < 2; ++bj)
#pragma unroll
                    for (int n = 0; n < 2; ++n) acc[ai][bj][m][n] *= rs; }
    }
    __device__ __forceinline__ void operator()(const f32x4 (&acc)[2][2][4][2], const pg8::Unit& u, int wr, int wc, int fr, int fq) const {
        const int r0 = u.i0 * 256;
        const int v = row_v(r0);
        const float* gate = modl + (size_t)v * 6144 + 2 * 1024;
        const float* hin = hptr2((float*)inc, (float*)inx, r0); float* hout = hptr2(hc, out, r0);
        const int rl0 = wr * 64 + fr, col0 = u.i1 * 256 + wc * 32 + 4 * fq;
        f32x4 gv[2][2];
#pragma unroll
        for (int bj = 0; bj < 2; ++bj)
#pragma unroll
            for (int n = 0; n < 2; ++n) gv[bj][n] = *(const f32x4*)(gate + col0 + bj * 128 + n * 16);
#pragma unroll
        for (int ai = 0; ai < 2; ++ai)
#pragma unroll
            for (int m = 0; m < 4; ++m) { const size_t off = (size_t)(rl0 + ai * 128 + m * 16) * D + col0;
#pragma unroll
                for (int bj = 0; bj < 2; ++bj)
#pragma unroll
                    for (int n = 0; n < 2; ++n) { const f32x4 hi = *(const f32x4*)(hin + off + bj * 128 + n * 16);
                        *(f32x4*)(hout + off + bj * 128 + n * 16) = hi + gv[bj][n] * acc[ai][bj][m][n]; }
                asm volatile("" ::: "memory"); }
    }
};

struct MoeSched {
    const LAS int* tab;
    const int* list;
    const char* A; const char* W; int mode  , l, G, c;
    __device__ __forceinline__ bool get(int i, pg8::Unit& u) const {
        const int L = i * G + c; const int total = __builtin_amdgcn_readfirstlane(tab[24]) * 4; if (L >= total) return false;
        const int tl = L >> 2, pn = L & 3;
        int cls = 0;
#pragma unroll 1
        for (int q = 1; q < NCLS; ++q) { const int tq = __builtin_amdgcn_readfirstlane(tab[q]); if (tq <= tl) cls = q; }
        const int j = tl - __builtin_amdgcn_readfirstlane(tab[cls]), cnt = __builtin_amdgcn_readfirstlane(tab[32 + cls]);
        const int g = cls / 6, pidx = cls - g * 6;
        const int ea = (pidx >= 3) + (pidx >= 5), eb = pidx < 3 ? pidx + 1 : (pidx < 5 ? pidx - 1 : 3);
        if (mode == 0) {
            const int e = 4 * g + (pn < 2 ? ea : eb);
            u.a0 = A;
            u.b0 = W + ((size_t)(l * 16 + e) * 512 + (size_t)(pn & 1) * 256) * 1024 * 2; u.b1 = u.b0 + (size_t)8 * 128;
        } else {
            u.a0 = A + (size_t)tl * 256 * 512 * 2;
            u.b0 = W + ((size_t)(l * 16 + 4 * g + ea) * 1024 + (size_t)pn * 256) * 256 * 2;
            u.b1 = W + ((size_t)(l * 16 + 4 * g + eb) * 1024 + (size_t)pn * 256) * 256 * 2;
        }
        u.i0 = cls; u.i1 = j; u.i2 = pn; u.i3 = cnt; u.i4 = tl; u.pad = 0; return true;
    }
    __device__ __forceinline__ int arow(const pg8::Unit& u, int rl) const {
        int idx = u.i1 * 256 + rl; idx = idx < u.i3 ? idx : u.i3 - 1;
        return list[(size_t)u.i0 * R + idx];
    }
};
struct EpiUp {
    static constexpr bool PERM = true, MIDSCALE = false;
    bf16_t* hid; const float* cwla; const float* cwlb;
    __device__ __forceinline__ void operator()(const f32x4 (&acc)[2][2][4][2], const pg8::Unit& u, int wr, int wc, int fr, int fq) const {
        const int cls = u.i0, j = u.i1, pn = u.i2, cnt = u.i3, tl = u.i4;
        const float* cw = (pn < 2) ? cwla : cwlb;
        const int colbase = (pn >> 1) * 256 + (pn & 1) * 128 + wc * 32 + 8 * fq;
#pragma unroll
        for (int ai = 0; ai < 2; ++ai)
#pragma unroll
            for (int m = 0; m < 4; ++m) {
                const int rl = ai * 128 + wr * 64 + m * 16 + fr; const int idx = j * 256 + rl; const bool valid = idx < cnt;
                float w = 0.f; if (valid) w = cw[(size_t)cls * R + idx];
                const f32x4 g0 = acc[ai][0][m][0], g1 = acc[ai][0][m][1], u0 = acc[ai][1][m][0], u1 = acc[ai][1][m][1];
                float o[8];
#pragma unroll
                for (int e = 0; e < 4; ++e) { o[e] = w * siluf_(g0[e]) * u0[e]; o[4 + e] = w * siluf_(g1[e]) * u1[e]; }
                if (!valid) {
#pragma unroll
                    for (int e = 0; e < 8; ++e) o[e] = 0.f; }
                u32x4 pk; pk.x = cvt_pk_bf16(o[0], o[1]); pk.y = cvt_pk_bf16(o[2], o[3]); pk.z = cvt_pk_bf16(o[4], o[5]); pk.w = cvt_pk_bf16(o[6], o[7]);
                *(u32x4*)(hid + ((size_t)tl * 256 + rl) * 512 + colbase) = pk;
            }
    }
};
struct EpiY {
    static constexpr bool PERM = true, MIDSCALE = false;
    bf16_t* Y;
    __device__ __forceinline__ void operator()(const f32x4 (&acc)[2][2][4][2], const pg8::Unit& u, int wr, int wc, int fr, int fq) const {
        const int row0 = u.i4 * 256 + wr * 64 + fr, col0 = u.i2 * 256 + wc * 32 + 8 * fq;
#pragma unroll
        for (int ai = 0; ai < 2; ++ai)
#pragma unroll
            for (int m = 0; m < 4; ++m) { bf16_t* rowp = Y + (size_t)(row0 + ai * 128 + m * 16) * 1024 + col0;
#pragma unroll
                for (int bj = 0; bj < 2; ++bj) { const f32x4 v0 = acc[ai][bj][m][0], v1 = acc[ai][bj][m][1];
                    u32x4 w; w.x = cvt_pk_bf16(v0[0], v0[1]); w.y = cvt_pk_bf16(v0[2], v0[3]); w.z = cvt_pk_bf16(v1[0], v1[1]); w.w = cvt_pk_bf16(v1[2], v1[3]);
                    *(u32x4*)(rowp + bj * 128) = w; } }
    }
};

__device__ __forceinline__ void tr_tile(const float* src, int ldn, int k0, int n0, int nvalid, bf16_t* dst, int ldk, int drow0, float* tile, int kd0 = -1, const float* kscale = nullptr) {
    const int tid = launder_tid();
    if (kd0 < 0) kd0 = k0;
    { const int n = tid & 63; int kk = tid >> 6;
#pragma unroll
      for (int it = 0; it < 8; ++it, kk += 8) tile[kk * 65 + n] = (n < nvalid) ? src[(size_t)(k0 + kk) * ldn + n0 + n] * (kscale ? kscale[kk] : 1.f) : 0.f; }
    __syncthreads();
    { const int k8 = tid & 7, n = tid >> 3;
      if (n < nvalid) { const float* s = tile + (k8 * 8) * 65 + n;
          u32x4 o; o.x = cvt_pk_bf16(s[0], s[65]); o.y = cvt_pk_bf16(s[2 * 65], s[3 * 65]); o.z = cvt_pk_bf16(s[4 * 65], s[5 * 65]); o.w = cvt_pk_bf16(s[6 * 65], s[7 * 65]);
          *(u32x4*)(dst + (size_t)(drow0 + n) * ldk + kd0 + k8 * 8) = o; } }
    __syncthreads();
}
__device__ __forceinline__ void phase_wprep(CP p, unsigned char* lds, int bid, int nb) {
    float* tile = (float*)lds;
    constexpr int I_IN = 16 * 41, I_OUT = 256, I_G = 1024, I_U = 1024, I_D = 1024, I_L = I_IN + I_OUT + I_G + I_U + I_D;
    for (int it = bid; it < 2 * I_L; it += nb) {
        const int l = it / I_L; int r = it - l * I_L;
        if (r < I_IN) { const int kt = r / 41, ntl = r % 41; const int n0 = ntl * 64; const int nv = (DIN - n0) < 64 ? (DIN - n0) : 64;
            tr_tile(p->w_in + (size_t)l * 1024 * DIN, DIN, kt * 64, n0, nv, (bf16_t*)(p->ws + WS_WTIN) + (size_t)l * DIN * 1024, 1024, n0, tile); continue; }
        r -= I_IN;
        if (r < I_OUT) { const int kt = r >> 4, ntl = r & 15;
            tr_tile(p->w_out + (size_t)l * 1024 * 1024, 1024, kt * 64, ntl * 64, 64, (bf16_t*)(p->ws + WS_WTOUT) + (size_t)l * 1024 * 1024, 1024, ntl * 64, tile,
                    (kt * 64 + 512) & 1023, kt >= 8 ? p->ssd_norm_g + l * 512 + (kt * 64 - 512) : nullptr); continue; }
        r -= I_OUT;
        if (r < I_G + I_U) { const int up = r >= I_G; if (up) r -= I_G; const int e = r >> 6, q = r & 63, kt = q >> 2, ntl = q & 3; const int n0 = ntl * 64;
            const float* src = (up ? p->w_up : p->w_gate) + (size_t)(l * 16 + e) * 1024 * 256;
            tr_tile(src, 256, kt * 64, n0, 64, (bf16_t*)(p->ws + WS_WTGU) + (size_t)(l * 16 + e) * 512 * 1024, 1024, (n0 >> 7) * 256 + (n0 & 127) + (up ? 128 : 0), tile); continue; }
        r -= I_G + I_U;
        { const int e = r >> 6, q = r & 63, kt = q >> 4, ntl = q & 15;
          tr_tile(p->w_down + (size_t)(l * 16 + e) * 256 * 1024, 1024, kt * 64, ntl * 64, 64, (bf16_t*)(p->ws + WS_WTD) + (size_t)(l * 16 + e) * 1024 * 256, 256, ntl * 64, tile); }
    }
}
__device__ __forceinline__ void phase_adaln(CP p, unsigned char* lds, int bid, int nb) {
    float* sc = (float*)lds;
    float* red = sc + 3 * 1024;
    const int tid = launder_tid();
    for (int idx = tid; idx < 3 * 1024; idx += NTHREADS) { const int v = idx >> 10, k = idx & 1023; const float cv = (v < 2) ? p->c[v * 1024 + k] : p->c_ctx[k]; sc[idx] = siluf_(cv); }
    __syncthreads();
    float* mod = (float*)(p->ws + WS_MOD);
    for (int it = bid; it < 2 * 96; it += nb) {
        const int l = it / 96, n0 = (it % 96) * 64;
        const int c4 = tid & 15, kr = tid >> 4;
        f32x4 a0 = {0, 0, 0, 0}, a1 = {0, 0, 0, 0}, a2 = {0, 0, 0, 0};
        const float* w = p->w_ada + (size_t)l * 1024 * 6144 + n0 + c4 * 4;
#pragma unroll 4
        for (int k = kr; k < 1024; k += 32) { const f32x4 w4 = *(const f32x4*)(w + (size_t)k * 6144); a0 += sc[k] * w4; a1 += sc[1024 + k] * w4; a2 += sc[2048 + k] * w4; }
        *(f32x4*)(red + (kr * 3 + 0) * 64 + c4 * 4) = a0; *(f32x4*)(red + (kr * 3 + 1) * 64 + c4 * 4) = a1; *(f32x4*)(red + (kr * 3 + 2) * 64 + c4 * 4) = a2;
        __syncthreads();
        if (tid < 192) { const int v = tid >> 6, cc = tid & 63; float s = 0.f;
            for (int q = 0; q < 32; ++q) s += red[(q * 3 + v) * 64 + cc];
            mod[((size_t)l * 3 + v) * 6144 + n0 + cc] = s + p->b_ada[l * 6144 + n0 + cc]; }
        __syncthreads();
    }
}
__device__ __forceinline__ void moe_table(CP p, int l, LAS int* tab) {
    const int* gcount = (const int*)(p->ws + WS_CTL) + l * 32;
    if (threadIdx.x == 0) { int acc = 0; for (int q = 0; q < NCLS; ++q) { const int cn = gcount[q]; tab[q] = acc; tab[32 + q] = cn; acc += (cn + 255) >> 8; } tab[24] = acc; }
    __syncthreads();
}
__device__ __forceinline__ void moe_apply(CP p, int lm, int r, int v, int lane, const LAS int* tab, f32x4 (&xv)[4]) {
    const int pos = ((const int*)(p->ws + WS_POS))[(size_t)lm * R + r];
    const int slot = tab[pos >> 16] * 256 + (pos & 0xffff);
    const bf16_t* y = (const bf16_t*)(p->ws + WS_Y) + (size_t)slot * 1024;
    const float* gate = (const float*)(p->ws + WS_MOD) + ((size_t)lm * 3 + v) * 6144 + 5 * 1024;
#pragma unroll
    for (int j = 0; j < 4; ++j) { const int k = 4 * lane + 256 * j; const u32x2 yv = *(const u32x2*)(y + k); const f32x4 g4 = *(const f32x4*)(gate + k);
        xv[j][0] += g4[0] * bflo(yv.x); xv[j][1] += g4[1] * bfhi(yv.x); xv[j][2] += g4[2] * bflo(yv.y); xv[j][3] += g4[3] * bfhi(yv.y); }
}
__device__ __forceinline__ void phase_r1(CP p, int l, unsigned char* lds, int bid, int nb) {
    float* wdt = (float*)lds;
    float* gm = wdt + 16 * 1024;
    float* sh = gm + 3 * 1024;
    const int tid = launder_tid(); const int lane = tid & 63, wave = tid >> 6;
    const float* mod = (const float*)(p->ws + WS_MOD) + (size_t)l * 3 * 6144;
    const float* win = p->w_in + (size_t)l * 1024 * DIN;
    for (int idx = tid; idx < 16 * 1024; idx += NTHREADS) { const int k = idx >> 4, n = idx & 15; wdt[n * 1024 + k] = win[(size_t)k * DIN + NPROJ + n]; }
    for (int idx = tid; idx < 3 * 1024; idx += NTHREADS) { const int v = idx >> 10, k = idx & 1023; gm[idx] = p->g_mix[l * 1024 + k] * (1.f + mod[v * 6144 + 1024 + k]); sh[idx] = mod[v * 6144 + k]; }
    LAS int* tab = (LAS int*)((LAS unsigned char*)lds + MISC_OFF);
    if (l > 0) moe_table(p, l - 1, tab);
    __syncthreads();
    bf16_t* HX = (bf16_t*)(p->ws + WS_HX); float* DT = (float*)(p->ws + WS_DT);
    for (int r = bid * 8 + wave; r < R; r += nb * 8) {
        const f32x4* hr = (const f32x4*)hin_ptr(p, l, r); const int v = row_v(r);
        f32x4 xv[4]; float ss = 0.f;
#pragma unroll
        for (int j = 0; j < 4; ++j) xv[j] = hr[lane + 64 * j];
        if (l > 0) { moe_apply(p, l - 1, r, v, lane, tab, xv); f32x4* hw = (f32x4*)hptr(p, r);
#pragma unroll
            for (int j = 0; j < 4; ++j) hw[lane + 64 * j] = xv[j]; }
#pragma unroll
        for (int j = 0; j < 4; ++j) ss += xv[j][0] * xv[j][0] + xv[j][1] * xv[j][1] + xv[j][2] * xv[j][2] + xv[j][3] * xv[j][3];
        ss = wave_sum(ss); const float rs = rsqrtf(ss * (1.f / 1024.f) + 1e-6f);
#pragma unroll
        for (int j = 0; j < 4; ++j) { const int k = 4 * lane + 256 * j; const f32x4 g4 = *(const f32x4*)(gm + v * 1024 + k), s4 = *(const f32x4*)(sh + v * 1024 + k);
            xv[j] = xv[j] * rs * g4 + s4;
            u32x2 o; o.x = cvt_pk_bf16(xv[j][0], xv[j][1]); o.y = cvt_pk_bf16(xv[j][2], xv[j][3]);
            *(u32x2*)(HX + (size_t)r * 1024 + k) = o; }
        float mine = 0.f;
#pragma unroll
        for (int n = 0; n < 16; ++n) { float a = 0.f;
#pragma unroll
            for (int j = 0; j < 4; ++j) { const f32x4 w4 = *(const f32x4*)(wdt + n * 1024 + 4 * lane + 256 * j); a += xv[j][0] * w4[0] + xv[j][1] * w4[1] + xv[j][2] * w4[2] + xv[j][3] * w4[3]; }
            a = wave_sum(a); mine = (lane == n) ? a : mine; }
        if (lane < 16) DT[(size_t)r * 16 + lane] = softplusf_(mine + p->dt_bias[l * 16 + lane]);
    }
}
typedef float f32x16 __attribute__((ext_vector_type(16)));
typedef short s16x4 __attribute__((ext_vector_type(4)));
constexpr int ST_ROW = 272;
constexpr int ST_TR128 = 320;
constexpr int ST_TR64 = 192;
constexpr int NCHUNK = SEG / 128;

__device__ __forceinline__ float wave_incl_scan(float v, int lane) {
#pragma unroll
    for (int o = 1; o < 64; o <<= 1) { const float t = __shfl_up(v, o); if (lane >= o) v += t; }
    return v;
}
__device__ __forceinline__ bf16x8 row_frag(const LAS unsigned char* tile, int stride, int row0, int k0, int lane) {
    return *(const LAS bf16x8*)(tile + (row0 + (lane & 31)) * stride + (k0 + 8 * (lane >> 5)) * 2);
}
__device__ __forceinline__ bf16x8 tr_frag(const LAS unsigned char* tile, int stride, int k0, int c0, int lane) {
    const int g = lane >> 4, li = lane & 15, q = li >> 2, pp = li & 3;
    const LAS unsigned char* a0 = tile + (k0 + 8 * (g >> 1) + q) * stride + (c0 + 16 * (g & 1) + 4 * pp) * 2;
    const s16x4 lo = __builtin_amdgcn_ds_read_tr16_b64_v4i16((LAS s16x4*)a0);
    const s16x4 hi = __builtin_amdgcn_ds_read_tr16_b64_v4i16((LAS s16x4*)(a0 + 4 * stride));
    return __builtin_shufflevector(lo, hi, 0, 1, 2, 3, 4, 5, 6, 7);
}
__device__ __forceinline__ void conv_item(const bf16_t* proj, int row0, int rq, int xch, bool lo_ok, bool hi_ok, const float* cw, const float* cbias, float (&o)[4][8]) {
    u32x4 raw[8];
    unsigned zz; asm volatile("v_mov_b32 %0, 0" : "=v"(zz));
#pragma unroll
    for (int j = 0; j < 8; ++j) { const int lr = 4 * rq - 2 + j; const bool ok = (lr >= 0 || lo_ok) && (lr < 128 || hi_ok);
        raw[j] = ok ? *(const u32x4*)(proj + (size_t)(row0 + lr) * NPROJ + 1536 + xch) : (u32x4){zz, zz, zz, zz}; }
    float w[5][8], bs[8];
#pragma unroll
    for (int j = 0; j < 5; ++j) { const f32x4 w0 = *(const f32x4*)(cw + j * 1024 + xch), w1 = *(const f32x4*)(cw + j * 1024 + xch + 4);
        w[j][0] = w0[0]; w[j][1] = w0[1]; w[j][2] = w0[2]; w[j][3] = w0[3]; w[j][4] = w1[0]; w[j][5] = w1[1]; w[j][6] = w1[2]; w[j][7] = w1[3]; }
    { const f32x4 b0 = *(const f32x4*)(cbias + xch), b1 = *(const f32x4*)(cbias + xch + 4); bs[0] = b0[0]; bs[1] = b0[1]; bs[2] = b0[2]; bs[3] = b0[3]; bs[4] = b1[0]; bs[5] = b1[1]; bs[6] = b1[2]; bs[7] = b1[3]; }
#pragma unroll
    for (int i = 0; i < 4; ++i)
#pragma unroll
        for (int e = 0; e < 8; ++e) o[i][e] = bs[e];
#pragma unroll
    for (int j = 0; j < 8; ++j) {
        float xv[8] = {bflo(raw[j].x), bfhi(raw[j].x), bflo(raw[j].y), bfhi(raw[j].y), bflo(raw[j].z), bfhi(raw[j].z), bflo(raw[j].w), bfhi(raw[j].w)};
#pragma unroll
        for (int i = 0; i < 4; ++i) { const int tap = j - i; if (tap >= 0 && tap < 5) {
#pragma unroll
                for (int e = 0; e < 8; ++e) o[i][e] += w[tap][e] * xv[e]; } }
    }
#pragma unroll
    for (int i = 0; i < 4; ++i)
#pragma unroll
        for (int e = 0; e < 8; ++e) o[i][e] = siluf_(o[i][e]);
}
__device__ __forceinline__ u32x4 pack8(const float (&v)[8]) { u32x4 r; r.x = cvt_pk_bf16(v[0], v[1]); r.y = cvt_pk_bf16(v[2], v[3]); r.z = cvt_pk_bf16(v[4], v[5]); r.w = cvt_pk_bf16(v[6], v[7]); return r; }
__device__ __forceinline__ u32x4 pack8s(const float (&v)[8], float sc) { u32x4 r; r.x = cvt_pk_bf16(v[0] * sc, v[1] * sc); r.y = cvt_pk_bf16(v[2] * sc, v[3] * sc); r.z = cvt_pk_bf16(v[4] * sc, v[5] * sc); r.w = cvt_pk_bf16(v[6] * sc, v[7] * sc); return r; }

__device__ __forceinline__ void chunk_cums(CP p, int l, int row0, int h, int wave, int lane, LAS float* vec) {
    if (wave < 2) {
        const int dir = wave; const float A = -expf(p->a_log[l * 16 + dir * 8 + h]);
        const float* DT = (const float*)(p->ws + WS_DT);
        const float d0 = DT[(size_t)(row0 + 2 * lane) * 16 + dir * 8 + h], d1 = DT[(size_t)(row0 + 2 * lane + 1) * 16 + dir * 8 + h];
        const float x0 = d0 * A, x1 = d1 * A;
        const float incl = wave_incl_scan(x0 + x1, lane);
        const float total = __shfl(incl, 63);
        float c0, c1;
        if (dir == 0) { c1 = incl; c0 = incl - x1; } else { c0 = total - (incl - x1 - x0); c1 = total - (incl - x1); }
        vec[dir * 128 + 2 * lane] = c0; vec[dir * 128 + 2 * lane + 1] = c1;
        vec[256 + dir * 128 + 2 * lane] = d0; vec[256 + dir * 128 + 2 * lane + 1] = d1;
        if (lane == 0) vec[512 + dir] = total;
    }
}

__device__ __forceinline__ void phase_c1(CP p, int l, unsigned char* lds_, int bid, int nb) {
    LAS unsigned char* lds = (LAS unsigned char*)lds_;
    LAS unsigned char* tile = lds;
    LAS float* wl = (LAS float*)(lds + 73216);
    const int tid = launder_tid();
    const bf16_t* proj = (const bf16_t*)(p->ws + WS_PROJ); bf16_t* mix = (bf16_t*)(p->ws + WS_HX);
#pragma unroll 1
    for (int u = bid; u < 256 + 512 + 16; u += nb) {
        int S, LEN, pstride, sstride, tok0, ch0;
        if (u < 256) { const int b = u >> 7, cs = (u >> 2) & 31, cc = u & 3; S = 2; LEN = 256; pstride = 64; sstride = 1; tok0 = b * SEG + CTXL + 2 * cs; ch0 = 256 + 64 * cc; }
        else if (u < 768) { const int v = u - 256; const int b = v >> 8, rg = (v >> 2) & 63, cc = v & 3; S = 4; LEN = 64; pstride = 1; sstride = 64; tok0 = b * SEG + CTXL + 256 * rg; ch0 = 64 * cc; }
        else { const int v = u - 768; const int b = v >> 3, cc = v & 7; S = 1; LEN = 256; pstride = 1; sstride = 0; tok0 = b * SEG; ch0 = 64 * cc; }
        const int LP = LEN + 30;
        for (int i = tid; i < 32 * 64; i += NTHREADS) { const int j = i >> 6, c = i & 63; wl[i] = j < 31 ? p->conv_w[((size_t)l * 31 + j) * 512 + ch0 + c] : p->conv_b[l * 512 + ch0 + c]; }
        for (int i = tid; i < S * 30 * 8; i += NTHREADS) { const int pc = i & 7, q = (i >> 3) % 30, sq = (i >> 3) / 30; const int pos = q < 15 ? q : LEN + q;
            unsigned zz; asm volatile("v_mov_b32 %0, 0" : "=v"(zz));
            *(LAS u32x4*)(tile + ((sq * LP + pos) * 64 + pc * 8) * 2) = (u32x4){zz, zz, zz, zz}; }
        for (int i = tid; i < S * LEN * 8; i += NTHREADS) { const int pc = i & 7, t = i >> 3; const int sq = t / LEN, pos = t - sq * LEN;
            const bf16_t* src = proj + (size_t)(tok0 + sq * sstride + pos * pstride) * NPROJ + ch0 + pc * 8;
            const u32x4 uv = *(const u32x4*)src, gv = *(const u32x4*)(src + 512);
            u32x4 o;
            o.x = cvt_pk_bf16(bflo(uv.x) * sigmoidf_(bflo(gv.x)), bfhi(uv.x) * sigmoidf_(bfhi(gv.x)));
            o.y = cvt_pk_bf16(bflo(uv.y) * sigmoidf_(bflo(gv.y)), bfhi(uv.y) * sigmoidf_(bfhi(gv.y)));
            o.z = cvt_pk_bf16(bflo(uv.z) * sigmoidf_(bflo(gv.z)), bfhi(uv.z) * sigmoidf_(bfhi(gv.z)));
            o.w = cvt_pk_bf16(bflo(uv.w) * sigmoidf_(bflo(gv.w)), bfhi(uv.w) * sigmoidf_(bfhi(gv.w)));
            *(LAS u32x4*)(tile + ((sq * LP + 15 + pos) * 64 + pc * 8) * 2) = o; }
        __syncthreads();
        const int noct = S * LEN / 8;
#pragma unroll 1
        for (int it = tid; it < noct * 32; it += NTHREADS) {
            const int cp = it & 31, oc = it >> 5; const int sq = oc / (LEN / 8), p0 = (oc - sq * (LEN / 8)) * 8;
            const LAS unsigned* base = (const LAS unsigned*)(tile + ((sq * LP + p0) * 64) * 2) + cp;
            float i0[38], i1[38];
#pragma unroll
            for (int k = 0; k < 38; ++k) { const unsigned w = base[k * 32]; i0[k] = bflo(w); i1[k] = bfhi(w); }
            float a0[8], a1[8];
            { const float b0 = wl[31 * 64 + 2 * cp], b1 = wl[31 * 64 + 2 * cp + 1];
#pragma unroll
              for (int i = 0; i < 8; ++i) { a0[i] = b0; a1[i] = b1; } }
#pragma unroll
            for (int j = 0; j < 31; ++j) { const float w0 = wl[j * 64 + 2 * cp], w1 = wl[j * 64 + 2 * cp + 1];
#pragma unroll
                for (int i = 0; i < 8; ++i) { a0[i] += w0 * i0[i + j]; a1[i] += w1 * i1[i + j]; } }
#pragma unroll
            for (int i = 0; i < 8; ++i) { const int tok = tok0 + sq * sstride + (p0 + i) * pstride;
                *(unsigned*)(mix + (size_t)tok * 1024 + 512 + ch0 + 2 * cp) = cvt_pk_bf16(a0[i], a1[i]); }
        }
        __syncthreads();
    }
}
__device__ __forceinline__ void phase_c1_ln(CP p, int l, int bid, int nb) {
    const int tid = launder_tid(); const int lane = tid & 63, wave = tid >> 6;
    bf16_t* mix = (bf16_t*)(p->ws + WS_HX);
    const f32x4 g0 = *(const f32x4*)(p->conv_ln_g + l * 512 + lane * 8), g1 = *(const f32x4*)(p->conv_ln_g + l * 512 + lane * 8 + 4);
    const f32x4 b0 = *(const f32x4*)(p->conv_ln_b + l * 512 + lane * 8), b1 = *(const f32x4*)(p->conv_ln_b + l * 512 + lane * 8 + 4);
    const float gg[8] = {g0[0], g0[1], g0[2], g0[3], g1[0], g1[1], g1[2], g1[3]}, bb[8] = {b0[0], b0[1], b0[2], b0[3], b1[0], b1[1], b1[2], b1[3]};
    for (int r = bid * 8 + wave; r < R; r += nb * 8) {
        u32x4* ptr = (u32x4*)(mix + (size_t)r * 1024 + 512 + lane * 8);
        const u32x4 v = *ptr;
        float y[8] = {bflo(v.x), bfhi(v.x), bflo(v.y), bfhi(v.y), bflo(v.z), bfhi(v.z), bflo(v.w), bfhi(v.w)};
        float s = 0.f;
#pragma unroll
        for (int e = 0; e < 8; ++e) s += y[e];
        const float mu = wave_sum(s) * (1.f / 512.f);
        float q = 0.f;
#pragma unroll
        for (int e = 0; e < 8; ++e) { y[e] -= mu; q += y[e] * y[e]; }
        const float rstd = rsqrtf(wave_sum(q) * (1.f / 512.f) + 1e-5f);
        float o[8];
#pragma unroll
        for (int e = 0; e < 8; ++e) o[e] = siluf_(y[e] * rstd * gg[e] + bb[e]);
        *ptr = pack8(o);
    }
}
__device__ __forceinline__ void phase_s1(CP p, int l, unsigned char* lds_, int bid, int nb) {
    LAS unsigned char* lds = (LAS unsigned char*)lds_;
    LAS unsigned char* Bs = lds;
    LAS unsigned char* Xf = lds + 128 * ST_TR128;
    LAS unsigned char* Xb = Xf + 128 * ST_TR64;
    LAS float* vec = (LAS float*)(Xb + 128 * ST_TR64);
    const int tid = launder_tid(); const int lane = tid & 63, wave = __builtin_amdgcn_readfirstlane(tid >> 6);
    const bf16_t* proj = (const bf16_t*)(p->ws + WS_PROJ);
    const float* cw = p->ssd_conv_w + (size_t)l * 5 * 1024; const float* cbias = p->ssd_conv_b + (size_t)l * 1024;
    float* Sg = (float*)(p->ws + WS_S); float* DEC = (float*)(p->ws + WS_DEC);
#pragma unroll 1
    for (int u = bid; u < NB * NCHUNK * 8; u += nb) {
        const int h = u & 7, c = (u >> 3) % NCHUNK, b = (u >> 3) / NCHUNK, g = h >> 2;
        const int row0 = b * SEG + c * 128;
        const bool lo_ok = !(c == 0 || c == 2), hi_ok = !(c == 1 || c == NCHUNK - 1);
        chunk_cums(p, l, row0, h, wave, lane, vec);
        __syncthreads();
        if (tid < 2) DEC[((size_t)(b * 2 + tid) * NCHUNK + c) * 8 + h] = __expf(vec[512 + tid]);
#pragma unroll 1
        for (int it = tid; it < 32 * 24; it += NTHREADS) {
            const int rq = it / 24, cg = it % 24;
            float o[4][8];
            if (cg < 16) {
                conv_item(proj, row0, rq, 512 + g * 128 + cg * 8, lo_ok, hi_ok, cw, cbias, o);
#pragma unroll
                for (int i = 0; i < 4; ++i) *(LAS u32x4*)(Bs + (4 * rq + i) * ST_TR128 + cg * 16) = pack8(o[i]);
            } else {
                const int xc = cg - 16;
                conv_item(proj, row0, rq, h * 64 + xc * 8, lo_ok, hi_ok, cw, cbias, o);
                const float tf = vec[512], tb = vec[513];
#pragma unroll
                for (int i = 0; i < 4; ++i) { const int lr = 4 * rq + i;
                    const float wf = __expf(tf - vec[lr]) * vec[256 + lr];
                    const float wb = __expf(tb - vec[128 + lr]) * vec[384 + lr];
                    *(LAS u32x4*)(Xf + lr * ST_TR64 + xc * 16) = pack8s(o[i], wf);
                    *(LAS u32x4*)(Xb + lr * ST_TR64 + xc * 16) = pack8s(o[i], wb); }
            }
        }
        __syncthreads();
        {
            const int dir = wave >> 2, nq = wave & 3;
            const LAS unsigned char* Xd = dir ? Xb : Xf;
            f32x16 acc[2];
#pragma unroll
            for (int t = 0; t < 2; ++t)
#pragma unroll
                for (int e = 0; e < 16; ++e) acc[t][e] = 0.f;
#pragma unroll
            for (int kk = 0; kk < 8; ++kk) {
                const bf16x8 bf = tr_frag(Bs, ST_TR128, 16 * kk, 32 * nq, lane);
#pragma unroll
                for (int t = 0; t < 2; ++t) { const bf16x8 af = tr_frag(Xd, ST_TR64, 16 * kk, 32 * t, lane);
                    acc[t] = __builtin_amdgcn_mfma_f32_32x32x16_bf16(af, bf, acc[t], 0, 0, 0); }
            }
            float* So = Sg + ((size_t)((b * 2 + dir) * NCHUNK + c) * 8 + h) * 8192 + 32 * nq + (lane & 31);
#pragma unroll
            for (int t = 0; t < 2; ++t)
#pragma unroll
                for (int e = 0; e < 16; ++e) { const int pr = 32 * t + (e & 3) + 8 * (e >> 2) + 4 * (lane >> 5); So[(size_t)pr * 128] = acc[t][e]; }
        }
        __syncthreads();
    }
}
__device__ __forceinline__ void phase_s2(CP p, int bid, int nb) {
    const int tid = launder_tid();
    const float* Sg = (const float*)(p->ws + WS_S); const float* DEC = (const float*)(p->ws + WS_DEC); bf16_t* HP = (bf16_t*)(p->ws + WS_HP);
    for (int idx = bid * NTHREADS + tid; idx < 2 * 2 * 8 * 64 * 64; idx += nb * NTHREADS) {
        const int n2 = idx & 63, pr = (idx >> 6) & 63, h = (idx >> 12) & 7, dir = (idx >> 15) & 1, b = idx >> 16;
        const size_t inner = (size_t)h * 8192 + pr * 128 + 2 * n2;
        const size_t cbase = (size_t)(b * 2 + dir) * NCHUNK;
        float s0 = 0.f, s1 = 0.f;
#pragma unroll 5
        for (int step = 0; step < NCHUNK; ++step) {
            const int c = dir == 0 ? step : (step < 2 ? 1 - step : NCHUNK + 1 - step);
            const size_t off = (cbase + c) * 65536 + inner;
            const float2 sv = *(const float2*)(Sg + off); const float d = DEC[(cbase + c) * 8 + h];
            *(unsigned*)(HP + off) = cvt_pk_bf16(s0, s1);
            s0 = s0 * d + sv.x; s1 = s1 * d + sv.y;
        }
    }
}
__device__ __forceinline__ void phase_s3(CP p, int l, unsigned char* lds_, int bid, int nb) {
    LAS unsigned char* lds = (LAS unsigned char*)lds_;
    LAS unsigned char* Cs = lds;
    LAS unsigned char* Bs = Cs + 128 * ST_ROW;
    LAS unsigned char* Mt = Bs;
    LAS unsigned char* Xs = Bs + 128 * ST_TR128;
    LAS unsigned char* Hf = Xs + 128 * ST_TR64;
    LAS unsigned char* Hb = Hf + 64 * ST_ROW;
    LAS float* vec = (LAS float*)(Hb + 64 * ST_ROW);
    LAS float* ssq = vec + 520;
    const int tid = launder_tid(); const int lane = tid & 63, wave = __builtin_amdgcn_readfirstlane(tid >> 6);
    const bf16_t* proj = (const bf16_t*)(p->ws + WS_PROJ); bf16_t* mix = (bf16_t*)(p->ws + WS_HX);
    const float* cw = p->ssd_conv_w + (size_t)l * 5 * 1024; const float* cbias = p->ssd_conv_b + (size_t)l * 1024;
    const bf16_t* HP = (const bf16_t*)(p->ws + WS_HP); float* SSQ = (float*)(p->ws + WS_SSQ);
#pragma unroll 1
    for (int u = bid; u < NB * NCHUNK * 8; u += nb) {
        const int h = u & 7, c = (u >> 3) % NCHUNK, b = (u >> 3) / NCHUNK, g = h >> 2;
        const int row0 = b * SEG + c * 128;
        const bool lo_ok = !(c == 0 || c == 2), hi_ok = !(c == 1 || c == NCHUNK - 1);
        chunk_cums(p, l, row0, h, wave, lane, vec);
        if (tid < 128) ssq[tid] = 0.f;
#pragma unroll 1
        for (int it = tid; it < 32 * 40; it += NTHREADS) {
            const int rq = it / 40, cg = it % 40;
            float o[4][8];
            if (cg < 32) { const int isB = cg >= 16, cc = cg & 15;
                conv_item(proj, row0, rq, (isB ? 512 : 768) + g * 128 + cc * 8, lo_ok, hi_ok, cw, cbias, o);
                LAS unsigned char* dst = (isB ? Bs : Cs);
#pragma unroll
                for (int i = 0; i < 4; ++i) *(LAS u32x4*)(dst + (4 * rq + i) * ST_ROW + cc * 16) = pack8(o[i]);
            } else { const int xc = cg - 32;
                conv_item(proj, row0, rq, h * 64 + xc * 8, lo_ok, hi_ok, cw, cbias, o);
#pragma unroll
                for (int i = 0; i < 4; ++i) *(LAS u32x4*)(Xs + (4 * rq + i) * ST_TR64 + xc * 16) = pack8(o[i]);
            }
        }
#pragma unroll 1
        for (int it = tid; it < 2048; it += NTHREADS) { const int dir = it >> 10, q = it & 1023, pr = q >> 4, ch = q & 15;
            const u32x4 v = *(const u32x4*)(HP + ((size_t)((b * 2 + dir) * NCHUNK + c) * 8 + h) * 8192 + pr * 128 + ch * 8);
            *(LAS u32x4*)((dir ? Hb : Hf) + pr * ST_ROW + ch * 16) = v; }
        __syncthreads();
        const int lb = wave >> 1, hs = wave & 1;
        int ln = lane; asm volatile("" : "+v"(ln));
        {
            f32x16 gacc[2];
#pragma unroll
            for (int t = 0; t < 2; ++t)
#pragma unroll
                for (int e = 0; e < 16; ++e) gacc[t][e] = 0.f;
#pragma unroll
            for (int kk = 0; kk < 8; ++kk) { const bf16x8 af = row_frag(Cs, ST_ROW, 32 * lb, 16 * kk, lane);
#pragma unroll
                for (int t = 0; t < 2; ++t) { const bf16x8 bf = row_frag(Bs, ST_ROW, 64 * hs + 32 * t, 16 * kk, lane);
                    gacc[t] = __builtin_amdgcn_mfma_f32_32x32x16_bf16(af, bf, gacc[t], 0, 0, 0); } }
            __syncthreads();
#pragma unroll
            for (int t = 0; t < 2; ++t) {
                const int sc = 64 * hs + 32 * t + (ln & 31);
                const float cfs = vec[sc], cbs = vec[128 + sc], dfs = vec[256 + sc], dbs = vec[384 + sc];
#pragma unroll
                for (int rg = 0; rg < 4; ++rg) {
                    const int l0 = 32 * lb + 8 * rg + 4 * (ln >> 5);
                    const f32x4 cfl = *(const LAS f32x4*)(vec + l0), cbl = *(const LAS f32x4*)(vec + 128 + l0);
                    float m[4];
#pragma unroll
                    for (int e = 0; e < 4; ++e) { const int lr = l0 + e;
                        const float ff = lr >= sc ? __expf(cfl[e] - cfs) * dfs : 0.f;
                        const float fb = lr <= sc ? __expf(cbl[e] - cbs) * dbs : 0.f;
                        m[e] = gacc[t][4 * rg + e] * (ff + fb); }
                    u32x2 pk; pk.x = cvt_pk_bf16(m[0], m[1]); pk.y = cvt_pk_bf16(m[2], m[3]);
                    *(LAS u32x2*)(Mt + sc * ST_TR128 + l0 * 2) = pk;
                }
            }
        }
        __syncthreads();
        {
            const int ph = hs;
            f32x16 ad, af_, ab_;
#pragma unroll
            for (int e = 0; e < 16; ++e) { ad[e] = 0.f; af_[e] = 0.f; ab_[e] = 0.f; }
#pragma unroll
            for (int kk = 0; kk < 8; ++kk) {
                const bf16x8 am = tr_frag(Mt, ST_TR128, 16 * kk, 32 * lb, lane);
                const bf16x8 bx = tr_frag(Xs, ST_TR64, 16 * kk, 32 * ph, lane);
                ad = __builtin_amdgcn_mfma_f32_32x32x16_bf16(am, bx, ad, 0, 0, 0);
                const bf16x8 ac = row_frag(Cs, ST_ROW, 32 * lb, 16 * kk, lane);
                const bf16x8 bhf = row_frag(Hf, ST_ROW, 32 * ph, 16 * kk, lane);
                const bf16x8 bhb = row_frag(Hb, ST_ROW, 32 * ph, 16 * kk, lane);
                af_ = __builtin_amdgcn_mfma_f32_32x32x16_bf16(ac, bhf, af_, 0, 0, 0);
                ab_ = __builtin_amdgcn_mfma_f32_32x32x16_bf16(ac, bhb, ab_, 0, 0, 0);
            }
            const int pc = 32 * ph + (ln & 31);
            const float dsk = p->d_skip[l * 8 + h];
#pragma unroll
            for (int rg = 0; rg < 4; ++rg) {
                const int l0 = 32 * lb + 8 * rg + 4 * (ln >> 5);
                const f32x4 cfl = *(const LAS f32x4*)(vec + l0), cbl = *(const LAS f32x4*)(vec + 128 + l0);
#pragma unroll
                for (int e = 0; e < 4; ++e) { const int lr = l0 + e; const int ri = 4 * rg + e;
                    const float xs = bf2f(*(const LAS bf16_t*)(Xs + lr * ST_TR64 + pc * 2));
                    const float y = ad[ri] + __expf(cfl[e]) * af_[ri] + __expf(cbl[e]) * ab_[ri] + dsk * xs;
                    const float z = bf2f(proj[(size_t)(row0 + lr) * NPROJ + 1024 + h * 64 + pc]);
                    const float val = y * siluf_(z);
                    mix[(size_t)(row0 + lr) * 1024 + h * 64 + pc] = f2bf(val);
                    float sq = val * val;
                    sq += __shfl_xor(sq, 1); sq += __shfl_xor(sq, 2); sq += __shfl_xor(sq, 4); sq += __shfl_xor(sq, 8); sq += __shfl_xor(sq, 16);
                    if ((ln & 31) == 0) atomicAdd((float*)(ssq + lr), sq);
                }
            }
        }
        __syncthreads();
        if (tid < 128) SSQ[(size_t)(row0 + tid) * 8 + h] = ssq[tid];
        __syncthreads();
    }
}
__device__ __forceinline__ void phase_r2(CP p, int l, unsigned char* lds, int bid, int nb) {
    float* wrt = (float*)lds;
    float* gm = wrt + 20 * 1024;
    float* sh = gm + 3 * 1024;
    int* lcnt = (int*)(sh + 3 * 1024);
    int* lcls = lcnt + 64;
    int* lrank = lcls + 1024;
    float* lcwa = (float*)(lrank + 1024);
    float* lcwb = lcwa + 1024;
    const int tid = launder_tid(); const int lane = tid & 63, wave = tid >> 6;
    const float* mod = (const float*)(p->ws + WS_MOD) + (size_t)l * 3 * 6144;
    for (int idx = tid; idx < 4 * 1024; idx += NTHREADS) { const int k = idx >> 2, n = idx & 3; wrt[n * 1024 + k] = p->w_rg[(size_t)l * 4096 + idx]; }
    for (int idx = tid; idx < 16 * 1024; idx += NTHREADS) { const int k = idx >> 4, n = idx & 15; wrt[(4 + n) * 1024 + k] = p->w_re[(size_t)l * 16384 + idx]; }
    for (int idx = tid; idx < 3 * 1024; idx += NTHREADS) { const int v = idx >> 10, k = idx & 1023; gm[idx] = p->g_ffn[l * 1024 + k] * (1.f + mod[v * 6144 + 4 * 1024 + k]); sh[idx] = mod[v * 6144 + 3 * 1024 + k]; }
    if (tid < 64) lcnt[tid] = 0;
    __syncthreads();
    bf16_t* HM = (bf16_t*)(p->ws + WS_HX); float* CWLA = (float*)(p->ws + WS_CWLA); float* CWLB = (float*)(p->ws + WS_CWLB); int* POS = (int*)(p->ws + WS_POS) + (size_t)l * R;
    int* gcount = (int*)(p->ws + WS_CTL) + l * 32; int* LIST = (int*)(p->ws + WS_LIST);
    const int rpb = (R + nb - 1) / nb, r0 = bid * rpb, r1 = (r0 + rpb) < R ? (r0 + rpb) : R;
    for (int r = r0 + wave; r < r1; r += 8) {
        const f32x4* hr = (const f32x4*)hptr(p, r); const int v = row_v(r);
        f32x4 xv[4]; float ss = 0.f;
#pragma unroll
        for (int j = 0; j < 4; ++j) { xv[j] = hr[lane + 64 * j]; ss += xv[j][0] * xv[j][0] + xv[j][1] * xv[j][1] + xv[j][2] * xv[j][2] + xv[j][3] * xv[j][3]; }
        ss = wave_sum(ss); const float rs = rsqrtf(ss * (1.f / 1024.f) + 1e-6f);
#pragma unroll
        for (int j = 0; j < 4; ++j) { const int k = 4 * lane + 256 * j; const f32x4 g4 = *(const f32x4*)(gm + v * 1024 + k), s4 = *(const f32x4*)(sh + v * 1024 + k);
            xv[j] = xv[j] * rs * g4 + s4;
            u32x2 o; o.x = cvt_pk_bf16(xv[j][0], xv[j][1]); o.y = cvt_pk_bf16(xv[j][2], xv[j][3]);
            *(u32x2*)(HM + (size_t)r * 1024 + k) = o; }
        float lg[20];
#pragma unroll
        for (int n = 0; n < 20; ++n) { float a = 0.f;
#pragma unroll
            for (int j = 0; j < 4; ++j) { const f32x4 w4 = *(const f32x4*)(wrt + n * 1024 + 4 * lane + 256 * j); a += xv[j][0] * w4[0] + xv[j][1] * w4[1] + xv[j][2] * w4[2] + xv[j][3] * w4[3]; }
            lg[n] = wave_sum(a) + (n < 4 ? p->b_rg[l * 4 + n] : p->b_re[l * 16 + n - 4]); }
        int gsel = 0; float gmax = lg[0];
#pragma unroll
        for (int q = 1; q < 4; ++q) if (lg[q] > gmax) { gmax = lg[q]; gsel = q; }
        float gden = 0.f;
#pragma unroll
        for (int q = 0; q < 4; ++q) gden += __expf(lg[q] - gmax);
        const float gprob = 1.f / gden;
        float el[4];
#pragma unroll
        for (int q = 0; q < 4; ++q) el[q] = gsel == 0 ? lg[4 + q] : (gsel == 1 ? lg[8 + q] : (gsel == 2 ? lg[12 + q] : lg[16 + q]));
        int i0 = 0; float m0 = el[0];
#pragma unroll
        for (int q = 1; q < 4; ++q) if (el[q] > m0) { m0 = el[q]; i0 = q; }
        int i1 = -1; float m1 = -3.0e38f;
#pragma unroll
        for (int q = 0; q < 4; ++q) if (q != i0 && el[q] > m1) { m1 = el[q]; i1 = q; }
        const float w0 = gprob / (1.f + __expf(m1 - m0)), w1 = gprob - w0;
        const int ea = i0 < i1 ? i0 : i1, eb = i0 < i1 ? i1 : i0;
        const float cwa = i0 < i1 ? w0 : w1, cwb = i0 < i1 ? w1 : w0;
        const int pidx = ea == 0 ? eb - 1 : (ea == 1 ? eb + 1 : 5);
        const int cls = gsel * 6 + pidx;
        if (lane == 0) { const int rank = atomicAdd(&lcnt[cls], 1); lcls[r - r0] = cls; lrank[r - r0] = rank; lcwa[r - r0] = cwa; lcwb[r - r0] = cwb; }
    }
    __syncthreads();
    if (tid < NCLS) lcnt[32 + tid] = atomicAdd(&gcount[tid], lcnt[tid]);
    __syncthreads();
    for (int idx = tid; idx < r1 - r0; idx += NTHREADS) { const int cl = lcls[idx]; const int pos = lcnt[32 + cl] + lrank[idx]; const size_t li = (size_t)cl * R + pos;
        LIST[li] = r0 + idx; CWLA[li] = lcwa[idx]; CWLB[li] = lcwb[idx]; POS[r0 + idx] = (cl << 16) | pos; }
    __syncthreads();
}
__device__ __forceinline__ void phase_final(CP p, unsigned char* lds, int bid, int nb) {
    const int tid = launder_tid(); const int lane = tid & 63, wave = tid >> 6;
    LAS int* tab = (LAS int*)((LAS unsigned char*)lds + MISC_OFF);
    moe_table(p, DEPTH - 1, tab);
    for (int q = bid * 8 + wave; q < NB * SEQ; q += nb * 8) {
        const int b = q >= SEQ ? 1 : 0; const int r = b * SEG + CTXL + (q - b * SEQ);
        f32x4* hr = (f32x4*)(p->out + (size_t)q * D);
        f32x4 xv[4]; float ss = 0.f;
#pragma unroll
        for (int j = 0; j < 4; ++j) xv[j] = hr[lane + 64 * j];
        moe_apply(p, DEPTH - 1, r, b, lane, tab, xv);
#pragma unroll
        for (int j = 0; j < 4; ++j) ss += xv[j][0] * xv[j][0] + xv[j][1] * xv[j][1] + xv[j][2] * xv[j][2] + xv[j][3] * xv[j][3];
        ss = wave_sum(ss); const float rs = rsqrtf(ss * (1.f / 1024.f) + 1e-6f);
#pragma unroll
        for (int j = 0; j < 4; ++j) { const f32x4 g4 = *(const f32x4*)(p->g_final + 4 * lane + 256 * j); hr[lane + 64 * j] = xv[j] * rs * g4; }
    }
}


#define XB_TMO      128
#define XB_XCNT(j)  (256  + 64 * (j))
#define XB_XSUB(j)  (1280 + 64 * (j))
#define XB_XGEN(j)  (2304 + 64 * (j))
#define XB_TOP      3328
#define XB_TOPGEN   3392
#define XCD_BAR_WORDS 3456
#define XB_SPIN_CAP (1u << 22)
__device__ __forceinline__ unsigned xb_ld(unsigned* p) { return __hip_atomic_load(p, __ATOMIC_RELAXED, __HIP_MEMORY_SCOPE_AGENT); }
__device__ __forceinline__ unsigned xb_add(unsigned* p, unsigned v) { return __hip_atomic_fetch_add(p, v, __ATOMIC_RELAXED, __HIP_MEMORY_SCOPE_AGENT); }
__device__ __forceinline__ unsigned xb_xcc_id() { return (unsigned)__builtin_amdgcn_s_getreg((3 << 11) | 20) & 0xFu; }
#define XB_SPIN(cond, bar) do { unsigned _sp = 0; while (cond) { __builtin_amdgcn_s_sleep(1); \
    if ((++_sp & 255u) == 0u) { if (xb_ld(&(bar)[XB_TMO])) break; if (_sp > XB_SPIN_CAP) { atomicAdd(&(bar)[XB_TMO], 1u); break; } } } } while (0)
struct XcdBarrier { unsigned* bar; unsigned x; volatile LAS unsigned* st; };
__device__ __forceinline__ XcdBarrier xcd_barrier_post(unsigned* bar, volatile LAS unsigned* st) {
    XcdBarrier b; b.bar = bar; b.x = xb_xcc_id(); b.st = st;
    if (threadIdx.x == 0) (void)xb_add(&bar[XB_XCNT(b.x)], 1u);
    return b;
}
__device__ __forceinline__ void xcd_barrier_complete(unsigned* bar, unsigned x, unsigned& nloc, unsigned& nx) {
    const unsigned G = gridDim.x * gridDim.y * gridDim.z;
    unsigned sum, cnt, mine, sp = 0u;
    for (;;) {
        sum = 0u; cnt = 0u; mine = 0u;
#pragma unroll
        for (unsigned j = 0; j < 16; ++j) { const unsigned c = xb_ld(&bar[XB_XCNT(j)]); sum += c; cnt += (c > 0u) ? 1u : 0u; mine = (j == x) ? c : mine; }
        if (sum == G) break;
        __builtin_amdgcn_s_sleep(1);
        if ((++sp & 255u) == 0u) { if (xb_ld(&bar[XB_TMO])) break; if (sp > XB_SPIN_CAP) { atomicAdd(&bar[XB_TMO], 1u); break; } }
    }
    nloc = mine > 0u ? mine : 1u; nx = cnt > 0u ? cnt : 1u;
}
__device__ __forceinline__ void xcd_barrier(const XcdBarrier& b) {
    asm volatile("s_waitcnt vmcnt(0)" ::: "memory");
    __syncthreads();
    if (threadIdx.x == 0) {
        unsigned* bar = b.bar;
        __builtin_amdgcn_s_waitcnt(0);
        unsigned nloc = b.st[0], nx = b.st[1];
        if (nloc == 0u) { xcd_barrier_complete(bar, b.x, nloc, nx); b.st[0] = nloc; b.st[1] = nx; }
        const unsigned old = xb_add(&bar[XB_XSUB(b.x)], 1u);
        const unsigned gen = old / nloc;
        if (old + 1u == (gen + 1u) * nloc) {
            __builtin_amdgcn_fence(__ATOMIC_RELEASE, "agent");
            asm volatile("s_waitcnt vmcnt(0)" ::: "memory");
            const unsigned og = xb_add(&bar[XB_TOP], 1u);
            const unsigned tg = og / nx;
            if (og + 1u == (tg + 1u) * nx) xb_add(&bar[XB_TOPGEN], 1u);
            else XB_SPIN(xb_ld(&bar[XB_TOPGEN]) == tg, bar);
            __builtin_amdgcn_fence(__ATOMIC_ACQUIRE, "agent");
            xb_add(&bar[XB_XGEN(b.x)], 1u);
            asm volatile("s_waitcnt vmcnt(0)" ::: "memory");
        } else {
            XB_SPIN(xb_ld(&bar[XB_XGEN(b.x)]) == gen, bar);
            __builtin_amdgcn_fence(__ATOMIC_ACQUIRE, "agent");
            asm volatile("s_waitcnt vmcnt(0)" ::: "memory");
        }
    }
    __syncthreads();
}

#ifndef PHASE_MASK
#define PHASE_MASK 0xFFFFF
#endif
#define PM(i) ((PHASE_MASK >> (i)) & 1)
constexpr int PH_PER_LAYER = 9, NPHASES = 1 + DEPTH * PH_PER_LAYER + 1;
__global__ void __launch_bounds__(NTHREADS, 2) mk_fwd(Args args) {
    extern __shared__ __attribute__((aligned(16))) unsigned char lds[];
    cg::grid_group grid = cg::this_grid();
    const __attribute__((address_space(4))) Args* ap = (const __attribute__((address_space(4))) Args*)__builtin_amdgcn_kernarg_segment_ptr();
    const int lo = ap->lo, hi = ap->hi;
    LAS unsigned char* ldsl = (LAS unsigned char*)lds;
    volatile LAS unsigned* xbst = (volatile LAS unsigned*)(ldsl + LDS_BYTES - 16);
    if (threadIdx.x < 4) xbst[threadIdx.x] = 0u;
    __syncthreads();
    (void)xcd_barrier_post((unsigned*)(ap->p.ws + WS_BAR), xbst);
    for (int ph = lo; ph < hi; ++ph) {
        CP p = launder(&ap->p);
        int bid = blockIdx.x, nb = gridDim.x; asm volatile("" : "+s"(bid), "+s"(nb));
        if (ph == 0) { if (PM(0)) phase_wprep(p, lds, bid, nb); if (PM(1)) phase_adaln(p, lds, bid, nb); }
        else if (ph == NPHASES - 1) { if (PM(12)) phase_final(p, lds, bid, nb); }
        else {
            const int l = (ph - 1) / PH_PER_LAYER, s = (ph - 1) % PH_PER_LAYER;
            if (s == 0) { if (PM(2)) phase_r1(p, l, lds, bid, nb); }
            else if (s == 1) { if (PM(3)) {
                pg8::DenseSched S; S.init(p->ws + WS_HX, (const bf16_t*)(p->ws + WS_WTIN) + (size_t)l * DIN * 1024, R, NPROJ, 1024, 1024, 1024, nb, bid);
                EpiProj E{(bf16_t*)(p->ws + WS_PROJ)};
                pg8::gemm_phase<EpiProj, pg8::DenseSched, false>(ldsl, 1024, 1024, 1024, S, E);
            } }
            else if (s == 2) { if (PM(4)) phase_c1(p, l, lds, bid, nb); if (PM(5)) phase_s1(p, l, lds, bid, nb); }
            else if (s == 3) { if (PM(6)) phase_s2(p, bid, nb); if (PM(4)) phase_c1_ln(p, l, bid, nb); }
            else if (s == 4) { if (PM(7)) phase_s3(p, l, lds, bid, nb); }
            else if (s == 5) { if (PM(8)) {
                pg8::DenseSched S; S.init(p->ws + WS_HX, (const bf16_t*)(p->ws + WS_WTOUT) + (size_t)l * 1024 * 1024, R, 1024, 1024, 1024, 1024, nb, bid);
                EpiResid E{l == 0 ? p->ctx : (const float*)(p->ws + WS_HC), l == 0 ? p->x : (const float*)p->out, (float*)(p->ws + WS_HC), p->out, (const float*)(p->ws + WS_MOD) + (size_t)l * 3 * 6144, (const float*)(p->ws + WS_SSQ)};
                pg8::gemm_phase<EpiResid, pg8::DenseSched, false>(ldsl, 1024, 1024, 1024, S, E);
            } }
            else if (s == 6) { if (PM(9)) phase_r2(p, l, lds, bid, nb); }
            else if (s == 7) { if (PM(10)) {
                LAS int* tab = (LAS int*)(ldsl + MISC_OFF); moe_table(p, l, tab);
                MoeSched S{tab, (const int*)(p->ws + WS_LIST), (const char*)(p->ws + WS_HX), (const char*)(p->ws + WS_WTGU), 0, l, nb, bid};
                EpiUp E{(bf16_t*)(p->ws + WS_HID), (const float*)(p->ws + WS_CWLA), (const float*)(p->ws + WS_CWLB)};
                pg8::gemm_phase<EpiUp, MoeSched, true>(ldsl, 1024, 1024, 1024, S, E);
            } }
            else { if (PM(11)) {
                LAS int* tab = (LAS int*)(ldsl + MISC_OFF); moe_table(p, l, tab);
                MoeSched S{tab, (const int*)(p->ws + WS_LIST), (const char*)(p->ws + WS_HID), (const char*)(p->ws + WS_WTD), 1, l, nb, bid};
                EpiY E{(bf16_t*)(p->ws + WS_Y)};
                pg8::gemm_phase<EpiY, MoeSched, false>(ldsl, 512, 256, 512, S, E);
            } }
        }
        if (ph + 1 < hi) { if (ph == lo) grid.sync(); else { XcdBarrier xb; xb.bar = (unsigned*)(launder(&ap->p)->ws + WS_BAR); xb.x = xb_xcc_id(); xb.st = (volatile LAS unsigned*)(ldsl + LDS_BYTES - 16); xcd_barrier(xb); } }
    }
}

extern "C" void kernel_launch(void* const* d_in, const int* in_sizes, int n_in, void* d_out, int out_size, void* d_ws, size_t ws_size, hipStream_t stream) {
    static int grid = 0;
    if (grid == 0) {
        if (n_in != 28 || ws_size < WS_END) { fprintf(stderr, "kernel_launch: unexpected n_in %d or ws_size %zu (< %zu)\n", n_in, ws_size, (size_t)WS_END); grid = -1; return; }
        int dev = 0, cus = 0, per_cu = 0;
        hipGetDevice(&dev); hipDeviceGetAttribute(&cus, hipDeviceAttributeMultiprocessorCount, dev);
        if (hipFuncSetAttribute((const void*)mk_fwd, hipFuncAttributeMaxDynamicSharedMemorySize, LDS_BYTES) != hipSuccess) { fprintf(stderr, "kernel_launch: hipFuncSetAttribute failed\n"); grid = -1; return; }
        if (hipOccupancyMaxActiveBlocksPerMultiprocessor(&per_cu, (const void*)mk_fwd, NTHREADS, LDS_BYTES) != hipSuccess || per_cu < 1) { fprintf(stderr, "kernel_launch: occupancy query says %d\n", per_cu); (void)hipGetLastError(); grid = -1; return; }
        grid = cus;
    }
    if (grid < 0) return;
    (void)hipMemsetAsync((char*)d_ws + WS_CTL, 0, WS_CTL_BYTES, stream);
    Args a{};
    const float** pp = (const float**)&a.p;
    for (int i = 0; i < 28; ++i) pp[i] = (const float*)d_in[i];
    a.p.out = (float*)d_out; a.p.ws = (unsigned char*)d_ws;
#if PER_PHASE_LAUNCH
    for (int ph = 0; ph < NPHASES; ++ph) {
        a.lo = ph; a.hi = ph + 1; void* kargs[] = {&a};
        hipError_t e = hipLaunchCooperativeKernel((const void*)mk_fwd, dim3(grid), dim3(NTHREADS), kargs, LDS_BYTES, stream);
        if (e != hipSuccess) { fprintf(stderr, "kernel_launch: launch of phase %d failed: %s\n", ph, hipGetErrorString(e)); break; }
    }
#else
    a.lo = 0; a.hi = NPHASES; void* kargs[] = {&a};
    hipError_t e = hipLaunchCooperativeKernel((const void*)mk_fwd, dim3(grid), dim3(NTHREADS), kargs, LDS_BYTES, stream);
    if (e != hipSuccess) fprintf(stderr, "kernel_launch: cooperative launch failed: %s (grid %d)\n", hipGetErrorString(e), grid);
#endif
}
```

```cpp
#include <hip/hip_runtime.h>
#include <hip/hip_cooperative_groups.h>
#include <cstdio>
namespace cg = cooperative_groups;

#ifndef PER_PHASE_LAUNCH
#define PER_PHASE_LAUNCH 0
#endif

#define LAS __attribute__((address_space(3)))
typedef unsigned short bf16_t;
typedef short bf16x8 __attribute__((ext_vector_type(8)));
typedef float f32x4 __attribute__((ext_vector_type(4)));
typedef unsigned u32x4 __attribute__((ext_vector_type(4)));
typedef unsigned u32x2 __attribute__((ext_vector_type(2)));

constexpr int D = 1024, NB = 2, SEQ = 16384, CTXL = 256, SEG = SEQ + CTXL, R = NB * SEG, DEPTH = 2;
constexpr int NPROJ = 2560, DIN = 2576;
constexpr int NTHREADS = 512;
constexpr int LDS_BYTES = 147456;
constexpr int MISC_OFF = 131072;
constexpr int NCLS = 24;

constexpr size_t al256(size_t x) { return (x + 255) & ~size_t(255); }
constexpr size_t WS_CTL = 0;
constexpr size_t WS_BAR = 4096;
constexpr size_t WS_CTL_BYTES = 32768;
constexpr size_t WS_MOD = WS_CTL_BYTES;
constexpr size_t WS_WTIN = WS_MOD + al256((size_t)2 * 3 * 6144 * 4);
constexpr size_t WS_WTOUT = WS_WTIN + al256((size_t)2 * DIN * 1024 * 2);
constexpr size_t WS_WTGU = WS_WTOUT + al256((size_t)2 * 1024 * 1024 * 2);
constexpr size_t WS_WTD = WS_WTGU + al256((size_t)2 * 16 * 512 * 1024 * 2);
constexpr size_t WS_HC = WS_WTD + al256((size_t)2 * 16 * 1024 * 256 * 2);
constexpr size_t WS_HX = WS_HC + al256((size_t)512 * 1024 * 4);
constexpr size_t WS_PROJ = WS_HX + al256((size_t)R * 1024 * 2);
constexpr size_t WS_DT = WS_PROJ + al256((size_t)R * NPROJ * 2);
constexpr size_t WS_POS = WS_DT + al256((size_t)R * 16 * 4);
constexpr size_t WS_LIST = WS_POS + al256((size_t)2 * R * 4);
constexpr size_t WS_CWLA = WS_LIST + al256((size_t)NCLS * R * 4);
constexpr size_t WS_CWLB = WS_CWLA + al256((size_t)NCLS * R * 4);
constexpr size_t WS_BIG = WS_CWLB + al256((size_t)NCLS * R * 4);
constexpr size_t WS_Y = WS_PROJ;
constexpr size_t WS_S = WS_BIG;
constexpr size_t WS_HP = WS_S + al256((size_t)2 * 2 * 130 * 8 * 8192 * 4);
constexpr size_t WS_DEC = WS_HP + al256((size_t)2 * 2 * 130 * 8 * 8192 * 2);
constexpr size_t WS_SSQ = WS_DEC + al256((size_t)2 * 2 * 130 * 8 * 4);
constexpr size_t WS_HID = WS_S;
constexpr size_t WS_END = WS_SSQ + al256((size_t)R * 8 * 4);
static_assert((size_t)(R + NCLS * 256) * 512 * 2 <= (size_t)2 * 2 * 130 * 8 * 8192 * 4, "hid alias");
static_assert(WS_END <= (size_t)512 * 1024 * 1024, "workspace");

struct Params {
    const float *x, *c, *ctx, *c_ctx, *w_ada, *b_ada, *g_mix, *g_ffn, *w_in, *conv_w, *conv_b, *conv_ln_g, *conv_ln_b, *ssd_conv_w, *ssd_conv_b,
        *dt_bias, *a_log, *d_skip, *ssd_norm_g, *w_out, *w_rg, *b_rg, *w_re, *b_re, *w_gate, *w_up, *w_down, *g_final;
    float* out; unsigned char* ws;
};
struct Args { Params p; int lo, hi; };
typedef const __attribute__((address_space(4))) Params* CP;
__device__ __forceinline__ CP launder(CP p) { asm volatile("" : "+s"(p)); return p; }
__device__ __forceinline__ int launder_tid() { int t = threadIdx.x; asm volatile("" : "+v"(t)); return t; }

__device__ __forceinline__ unsigned cvt_pk_bf16(float lo, float hi) { unsigned r; asm("v_cvt_pk_bf16_f32 %0, %1, %2" : "=v"(r) : "v"(lo), "v"(hi)); return r; }
__device__ __forceinline__ float bf2f(unsigned b) { return __uint_as_float(b << 16); }
__device__ __forceinline__ float bflo(unsigned w) { return __uint_as_float(w << 16); }
__device__ __forceinline__ float bfhi(unsigned w) { return __uint_as_float(w & 0xffff0000u); }
__device__ __forceinline__ bf16_t f2bf(float f) { return (bf16_t)(cvt_pk_bf16(f, 0.f) & 0xffffu); }
__device__ __forceinline__ float wave_sum(float v) {
#pragma unroll
    for (int o = 1; o < 64; o <<= 1) v += __shfl_xor(v, o);
    return v;
}
__device__ __forceinline__ float sigmoidf_(float x) { return 1.f / (1.f + __expf(-x)); }
__device__ __forceinline__ float siluf_(float x) { return x / (1.f + __expf(-x)); }
__device__ __forceinline__ float softplusf_(float x) { return fmaxf(x, 0.f) + log1pf(expf(-fabsf(x))); }

__device__ __forceinline__ int row_b(int r) { return r >= SEG ? 1 : 0; }
__device__ __forceinline__ int row_i(int r) { return r >= SEG ? r - SEG : r; }
__device__ __forceinline__ int row_v(int r) { const int i = row_i(r); return i < CTXL ? 2 : row_b(r); }
__device__ __forceinline__ float* hptr2(float* hc, float* out, int r) {
    const int b = row_b(r), i = row_i(r);
    return i < CTXL ? hc + (size_t)(b * CTXL + i) * D : out + (size_t)(b * SEQ + i - CTXL) * D;
}
__device__ __forceinline__ float* hptr(CP p, int r) { return hptr2((float*)(p->ws + WS_HC), p->out, r); }
__device__ __forceinline__ const float* hin_ptr(CP p, int l, int r) {
    if (l == 0) return hptr2((float*)p->ctx, (float*)p->x, r);
    return hptr(p, r);
}

namespace pg8 {
constexpr int BM = 256, BK = 64, HALF = 128, HTB = HALF * BK * 2, STAGE_BYTES = 8 * HTB, NXCD = 8, WGM = 8;
__device__ __forceinline__ int lds_byte(int r, int c) { const int st = (r >> 4) * 2 + (c >> 5), rr = r & 15, cc = c & 31, ob = rr * 64 + cc * 2; return st * 1024 + (ob ^ (((ob >> 9) & 1) << 5)); }
__device__ __forceinline__ void stage_rc(int b, int& Rr, int& Cc) { const int st = b / 1024, sb = b % 1024, swz = sb ^ (((sb >> 9) & 1) << 5); Rr = (st >> 1) * 16 + swz / 64; Cc = (st & 1) * 32 + (swz % 64) / 2; }
__device__ __forceinline__ int perm32(int rho) { const int n = rho >> 4, i = rho & 15; return 8 * (i >> 2) + 4 * n + (i & 3); }

struct Unit {
    const char* a0;
    const char* b0;
    const char* b1;
    int i0, i1, i2, i3, i4, pad;
};

template <class Epi, class Sched, bool GATHER>
__device__ __forceinline__ void gemm_phase(LAS unsigned char* lds, const int lda, const int ldb, const int K, const Sched& S, const Epi& E) {
    const int tid = launder_tid(); const int wid = __builtin_amdgcn_readfirstlane(tid >> 6), lane = tid & 63, wr = wid >> 2, wc = wid & 3, fr = lane & 15, fq = lane >> 4;
    const int nt = K / BK, ks = nt >> 1;
    int Rr[2], Cc[2];
    unsigned voffB[2];
#pragma unroll
    for (int i = 0; i < 2; ++i) { stage_rc(tid * 16 + i * 8192, Rr[i], Cc[i]); const int Rb = Epi::PERM ? ((Rr[i] & ~31) + perm32(Rr[i] & 31)) : Rr[i];
        voffB[i] = (unsigned)(Rb * ldb + Cc[i]) * 2u; }
    const size_t kstep = (size_t)(BK * 2);
    const size_t hstepB = (size_t)HALF * ldb * 2;
    const unsigned ldsw = (unsigned)wid * 1024u;
    const unsigned ldsbase = (unsigned)(unsigned long)lds;
    const int aoff = lds_byte(wr * 64 + fr, fq * 8), boff = lds_byte(wc * 32 + fr, fq * 8);
#define PG8_SA(b, h) (((b) * 2 + (h)) * HTB)
#define PG8_SB(b, h) ((4 + (b) * 2 + (h)) * HTB)
#define PG8_STAGE2(bufoff, gbase, v0, v1) do { unsigned keep_; \
        asm volatile("s_mov_b32 %0, m0\n\ts_mov_b32 m0, %1\n\ts_nop 4\n\tglobal_load_lds_dwordx4 %2, %4\n\ts_add_u32 m0, m0, 0x2000\n\ts_nop 0\n\tglobal_load_lds_dwordx4 %3, %4\n\ts_mov_b32 m0, %0" \
            : "=&s"(keep_) : "s"(ldsbase + (unsigned)(bufoff) + ldsw), "v"(v0), "v"(v1), "s"(gbase) : "memory", "scc"); } while (0)
#define PG8_LDA(dst, b, h) do { _Pragma("unroll") for (int m = 0; m < 4; ++m) _Pragma("unroll") for (int k = 0; k < 2; ++k) dst[m][k] = *(const LAS bf16x8*)(lds + PG8_SA(b, h) + aoff + m * 2048 + k * 1024); } while (0)
#define PG8_LDB(dst, b, h) do { _Pragma("unroll") for (int n = 0; n < 2; ++n) _Pragma("unroll") for (int k = 0; k < 2; ++k) dst[n][k] = *(const LAS bf16x8*)(lds + PG8_SB(b, h) + boff + n * 2048 + k * 1024); } while (0)
#define PG8_MMA(ai, bj, At, Bt) do { __builtin_amdgcn_s_setprio(1); _Pragma("unroll") for (int m = 0; m < 4; ++m) _Pragma("unroll") for (int n = 0; n < 2; ++n) _Pragma("unroll") for (int k = 0; k < 2; ++k) \
        acc[ai][bj][m][n] = __builtin_amdgcn_mfma_f32_16x16x32_bf16(Bt[n][k], At[m][k], acc[ai][bj][m][n], 0, 0, 0); __builtin_amdgcn_s_setprio(0); } while (0)
#define PG8_WAIT_V(n) asm volatile("s_waitcnt vmcnt(" #n ")" ::: "memory")
#define PG8_WAIT_L(n) asm volatile("s_waitcnt lgkmcnt(" #n ")" ::: "memory")
#define PG8_BAR __builtin_amdgcn_s_barrier()
#define PG8_SCHED __builtin_amdgcn_sched_barrier(0)
#define PG8_BP(u, tt) ((tt) < ks ? (u).b0 + (size_t)(tt) * kstep : (u).b1 + (size_t)((tt) - ks) * kstep)
    Unit cur, nxt; int ui = 0;
    if (!S.get(0, cur)) return;
    unsigned c00, c01, c10, c11, n00, n01, n10, n11;
    if (GATHER) {
        c00 = (unsigned)(S.arow(cur, Rr[0]) * lda + Cc[0]) * 2u; c01 = (unsigned)(S.arow(cur, Rr[1]) * lda + Cc[1]) * 2u;
        c10 = (unsigned)(S.arow(cur, HALF + Rr[0]) * lda + Cc[0]) * 2u; c11 = (unsigned)(S.arow(cur, HALF + Rr[1]) * lda + Cc[1]) * 2u;
    } else {
        c00 = (unsigned)(Rr[0] * lda + Cc[0]) * 2u; c01 = (unsigned)(Rr[1] * lda + Cc[1]) * 2u;
        c10 = (unsigned)((HALF + Rr[0]) * lda + Cc[0]) * 2u; c11 = (unsigned)((HALF + Rr[1]) * lda + Cc[1]) * 2u;
    }
    n00 = c00; n01 = c01; n10 = c10; n11 = c11;
    f32x4 acc[2][2][4][2];
    float zr; asm volatile("v_mov_b32 %0, 0" : "=v"(zr));
#pragma unroll
    for (int a = 0; a < 2; ++a)
#pragma unroll
        for (int b = 0; b < 2; ++b)
#pragma unroll
            for (int m = 0; m < 4; ++m)
#pragma unroll
                for (int n = 0; n < 2; ++n) acc[a][b][m][n] = (f32x4){zr, zr, zr, zr};
    bf16x8 At[4][2], B0[2][2], B1[2][2];
    const char* cA = cur.a0;
    {
        const char* pb0 = PG8_BP(cur, 0); const char* pb1 = PG8_BP(cur, 1);
        PG8_STAGE2(PG8_SB(0, 0), pb0, voffB[0], voffB[1]); PG8_STAGE2(PG8_SA(0, 0), cA, c00, c01);
        PG8_STAGE2(PG8_SB(0, 1), pb0 + hstepB, voffB[0], voffB[1]); PG8_STAGE2(PG8_SA(0, 1), cA, c10, c11);
        if (wr == 1) PG8_BAR;
        PG8_WAIT_V(4); PG8_BAR;
        PG8_STAGE2(PG8_SB(1, 0), pb1, voffB[0], voffB[1]); PG8_STAGE2(PG8_SA(1, 0), cA + kstep, c00, c01);
        PG8_STAGE2(PG8_SB(1, 1), pb1 + hstepB, voffB[0], voffB[1]);
        PG8_WAIT_V(6); PG8_BAR;
    }
    for (;;) {
        const bool has_next = S.get(ui + 1, nxt);
        if (!has_next) nxt = cur;
        if (GATHER) {
            if (has_next) {
                n00 = (unsigned)(S.arow(nxt, Rr[0]) * lda + Cc[0]) * 2u; n01 = (unsigned)(S.arow(nxt, Rr[1]) * lda + Cc[1]) * 2u;
                n10 = (unsigned)(S.arow(nxt, HALF + Rr[0]) * lda + Cc[0]) * 2u; n11 = (unsigned)(S.arow(nxt, HALF + Rr[1]) * lda + Cc[1]) * 2u;
            } else { n00 = c00; n01 = c01; n10 = c10; n11 = c11; }
        }
        const char* nA = nxt.a0;
#pragma unroll 1
        for (int t = 0; t < nt; t += 2) {
            const bool last = (t == nt - 2);
            const char* a1 = cA + (size_t)(t + 1) * kstep;
            const char* a2 = last ? nA : cA + (size_t)(t + 2) * kstep;
            const char* a3 = a2 + kstep;
            const char* b2 = last ? PG8_BP(nxt, 0) : PG8_BP(cur, t + 2);
            const char* b3 = last ? PG8_BP(nxt, 1) : PG8_BP(cur, t + 3);
            const unsigned s00 = last ? n00 : c00, s01 = last ? n01 : c01, s10 = last ? n10 : c10, s11 = last ? n11 : c11;
            if constexpr (Epi::MIDSCALE) { if (t == ks) E.midscale(acc, cur, wr, wc, fr, fq); }
            PG8_LDB(B0, 0, 0); PG8_SCHED; PG8_LDA(At, 0, 0); PG8_STAGE2(PG8_SA(1, 1), a1, c10, c11);
            PG8_WAIT_L(8); PG8_BAR; PG8_WAIT_L(0); PG8_MMA(0, 0, At, B0); PG8_BAR; PG8_SCHED;
            PG8_LDB(B1, 0, 1); PG8_STAGE2(PG8_SB(0, 0), b2, voffB[0], voffB[1]);
            PG8_BAR; PG8_WAIT_L(0); PG8_MMA(0, 1, At, B1); PG8_BAR;
            PG8_LDA(At, 0, 1); PG8_STAGE2(PG8_SA(0, 0), a2, s00, s01);
            PG8_BAR; PG8_WAIT_L(0); PG8_MMA(1, 0, At, B0); PG8_BAR; PG8_SCHED;
            PG8_STAGE2(PG8_SB(0, 1), b2 + hstepB, voffB[0], voffB[1]);
            PG8_WAIT_V(6); PG8_BAR; PG8_MMA(1, 1, At, B1); PG8_BAR;
            PG8_LDB(B0, 1, 0); PG8_SCHED; PG8_LDA(At, 1, 0); PG8_STAGE2(PG8_SA(0, 1), a2, s10, s11);
            PG8_WAIT_L(8); PG8_BAR; PG8_WAIT_L(0); PG8_MMA(0, 0, At, B0); PG8_BAR; PG8_SCHED;
            PG8_LDB(B1, 1, 1); PG8_STAGE2(PG8_SB(1, 0), b3, voffB[0], voffB[1]);
            PG8_BAR; PG8_WAIT_L(0); PG8_MMA(0, 1, At, B1); PG8_BAR;
            PG8_LDA(At, 1, 1); PG8_STAGE2(PG8_SA(1, 0), a3, s00, s01);
            PG8_BAR; PG8_WAIT_L(0); PG8_MMA(1, 0, At, B0); PG8_BAR; PG8_SCHED;
            PG8_STAGE2(PG8_SB(1, 1), b3 + hstepB, voffB[0], voffB[1]);
            PG8_WAIT_V(6); PG8_BAR; PG8_MMA(1, 1, At, B1); PG8_BAR;
        }
        E(acc, cur, wr, wc, fr, fq);
        if (!has_next) break;
        asm volatile("v_mov_b32 %0, 0" : "=v"(zr));
#pragma unroll
        for (int a = 0; a < 2; ++a)
#pragma unroll
            for (int b = 0; b < 2; ++b)
#pragma unroll
                for (int m = 0; m < 4; ++m)
#pragma unroll
                    for (int n = 0; n < 2; ++n) acc[a][b][m][n] = (f32x4){zr, zr, zr, zr};
        cur = nxt; cA = nA; ++ui; c00 = n00; c01 = n01; c10 = n10; c11 = n11;
    }
    PG8_WAIT_V(0);
    if (wr == 0) PG8_BAR;
    PG8_BAR;
#undef PG8_SA
#undef PG8_SB
#undef PG8_STAGE2
#undef PG8_LDA
#undef PG8_LDB
#undef PG8_MMA
#undef PG8_WAIT_V
#undef PG8_WAIT_L
#undef PG8_BAR
#undef PG8_SCHED
#undef PG8_BP
}

struct DenseSched {
    const char* A; const char* Bt; int lda, ldb, K; int nM, nN, nwg, G, c;
    __device__ __forceinline__ void init(const void* A_, const void* Bt_, int M, int N, int K_, int lda_, int ldb_, int G_, int c_) {
        A = (const char*)A_; Bt = (const char*)Bt_; lda = lda_; ldb = ldb_; K = K_; nM = M / BM; nN = N / BM; nwg = nM * nN; G = G_; c = c_; }
    __device__ __forceinline__ bool get(int i, Unit& u) const {
        const long L = (long)i * G + c; if (L >= nwg) return false;
        int wgid = (int)L; { const int q = nwg / NXCD, r = nwg % NXCD, xcd = wgid % NXCD, off = wgid / NXCD; wgid = (xcd < r ? xcd * (q + 1) : r * (q + 1) + (xcd - r) * q) + off; }
        const int nig = WGM * nN, gid = wgid / nig, fm = gid * WGM, gsz = (nM - fm) < WGM ? (nM - fm) : WGM;
        const int pm = fm + ((wgid % nig) % gsz), pn = (wgid % nig) / gsz;
        u.a0 = A + (size_t)pm * BM * lda * 2; u.b0 = Bt + (size_t)pn * BM * ldb * 2; u.b1 = u.b0 + (size_t)(K / BK / 2) * BK * 2;
        u.i0 = pm; u.i1 = pn; u.i2 = 0; u.i3 = 0; u.i4 = 0; u.pad = 0; return true;
    }
    __device__ __forceinline__ int arow(const Unit&, int rl) const { return rl; }
};
}

struct EpiProj {
    static constexpr bool PERM = true, MIDSCALE = false;
    bf16_t* O;
    __device__ __forceinline__ void operator()(const f32x4 (&acc)[2][2][4][2], const pg8::Unit& u, int wr, int wc, int fr, int fq) const {
        const int row0 = u.i0 * 256 + wr * 64 + fr, col0 = u.i1 * 256 + wc * 32 + 8 * fq;
#pragma unroll
        for (int ai = 0; ai < 2; ++ai)
#pragma unroll
            for (int m = 0; m < 4; ++m) { bf16_t* rowp = O + (size_t)(row0 + ai * 128 + m * 16) * NPROJ + col0;
#pragma unroll
                for (int bj = 0; bj < 2; ++bj) { const f32x4 v0 = acc[ai][bj][m][0], v1 = acc[ai][bj][m][1];
                    u32x4 w; w.x = cvt_pk_bf16(v0[0], v0[1]); w.y = cvt_pk_bf16(v0[2], v0[3]); w.z = cvt_pk_bf16(v1[0], v1[1]); w.w = cvt_pk_bf16(v1[2], v1[3]);
                    *(u32x4*)(rowp + bj * 128) = w; } }
    }
};
struct EpiResid {
    static constexpr bool PERM = false, MIDSCALE = true;
    const float* inc; const float* inx; float* hc; float* out; const float* modl; const float* ssq;
    __device__ __forceinline__ void midscale(f32x4 (&acc)[2][2][4][2], const pg8::Unit& u, int wr, int wc, int fr, int fq) const {
        const int r0 = u.i0 * 256 + wr * 64 + fr;
#pragma unroll
        for (int ai = 0; ai < 2; ++ai)
#pragma unroll
            for (int m = 0; m < 4; ++m) { const float* sp = ssq + (size_t)(r0 + ai * 128 + m * 16) * 8;
                const f32x4 a = *(const f32x4*)sp, b = *(const f32x4*)(sp + 4);
                const float rs = rsqrtf(((a[0] + a[1]) + (a[2] + a[3]) + (b[0] + b[1]) + (b[2] + b[3])) * (1.f / 512.f) + 1e-6f);
#pragma unroll
                for (int bj = 0; bj < 2; ++bj)
#pragma unroll
                    for (int n = 0; n < 2; ++n) acc[ai][bj][m][n] *= rs;
                asm volatile("" ::: "memory"); }
    }
    __device__ __forceinline__ void operator()(const f32x4 (&acc)[2][2][4][2], const pg8::Unit& u, int wr, int wc, int fr, int fq) const {
        const int r0 = u.i0 * 256;
        const int v = row_v(r0);
        const float* gate = modl + (size_t)v * 6144 + 2 * 1024;
        const float* hin = hptr2((float*)inc, (float*)inx, r0); float* hout = hptr2(hc, out, r0);
        const int rl0 = wr * 64 + fr, col0 = u.i1 * 256 + wc * 32 + 4 * fq;
        f32x4 gv[2][2];
#pragma unroll
        for (int bj = 0; bj < 2; ++bj)
#pragma unroll
            for (int n = 0; n < 2; ++n) gv[bj][n] = *(const f32x4*)(gate + col0 + bj * 128 + n * 16);
#pragma unroll
        for (int ai = 0; ai < 2; ++ai)
#pragma unroll
            for (int m = 0; m < 4; ++m) { const size_t off = (size_t)(rl0 + ai * 128 + m * 16) * D + col0;
#pragma unroll
                for (int bj = 0; bj < 2; ++bj)
#pragma unroll
                    for (int n = 0; n < 2; ++n) { const f32x4 hi = *(const f32x4*)(hin + off + bj * 128 + n * 16);
                        *(f32x4*)(hout + off + bj * 128 + n * 16) = hi + gv[bj][n] * acc[ai][bj][m][n]; }
                asm volatile("" ::: "memory"); }
    }
};

struct MoeSched {
    const LAS int* tab;
    const int* list;
    const char* A; const char* W; int mode  , l, G, c;
    __device__ __forceinline__ bool get(int i, pg8::Unit& u) const {
        const int L = i * G + c; const int total = __builtin_amdgcn_readfirstlane(tab[24]) * 4; if (L >= total) return false;
        const int tl = L >> 2, pn = L & 3;
        int cls = 0;
#pragma unroll 1
        for (int q = 1; q < NCLS; ++q) { const int tq = __builtin_amdgcn_readfirstlane(tab[q]); if (tq <= tl) cls = q; }
        const int j = tl - __builtin_amdgcn_readfirstlane(tab[cls]), cnt = __builtin_amdgcn_readfirstlane(tab[32 + cls]);
        const int g = cls / 6, pidx = cls - g * 6;
        const int ea = (pidx >= 3) + (pidx >= 5), eb = pidx < 3 ? pidx + 1 : (pidx < 5 ? pidx - 1 : 3);
        if (mode == 0) {
            const int e = 4 * g + (pn < 2 ? ea : eb);
            u.a0 = A;
            u.b0 = W + ((size_t)(l * 16 + e) * 512 + (size_t)(pn & 1) * 256) * 1024 * 2; u.b1 = u.b0 + (size_t)8 * 128;
        } else {
            u.a0 = A + (size_t)tl * 256 * 512 * 2;
            u.b0 = W + ((size_t)(l * 16 + 4 * g + ea) * 1024 + (size_t)pn * 256) * 256 * 2;
            u.b1 = W + ((size_t)(l * 16 + 4 * g + eb) * 1024 + (size_t)pn * 256) * 256 * 2;
        }
        u.i0 = cls; u.i1 = j; u.i2 = pn; u.i3 = cnt; u.i4 = tl; u.pad = 0; return true;
    }
    __device__ __forceinline__ int arow(const pg8::Unit& u, int rl) const {
        int idx = u.i1 * 256 + rl; idx = idx < u.i3 ? idx : u.i3 - 1;
        return list[(size_t)u.i0 * R + idx];
    }
};
struct EpiUp {
    static constexpr bool PERM = true, MIDSCALE = false;
    bf16_t* hid; const float* cwla; const float* cwlb;
    __device__ __forceinline__ void operator()(const f32x4 (&acc)[2][2][4][2], const pg8::Unit& u, int wr, int wc, int fr, int fq) const {
        const int cls = u.i0, j = u.i1, pn = u.i2, cnt = u.i3, tl = u.i4;
        const float* cw = (pn < 2) ? cwla : cwlb;
        const int colbase = (pn >> 1) * 256 + (pn & 1) * 128 + wc * 32 + 8 * fq;
#pragma unroll
        for (int ai = 0; ai < 2; ++ai)
#pragma unroll
            for (int m = 0; m < 4; ++m) {
                const int rl = ai * 128 + wr * 64 + m * 16 + fr; const int idx = j * 256 + rl; const bool valid = idx < cnt;
                float w = 0.f; if (valid) w = cw[(size_t)cls * R + idx];
                const f32x4 g0 = acc[ai][0][m][0], g1 = acc[ai][0][m][1], u0 = acc[ai][1][m][0], u1 = acc[ai][1][m][1];
                float o[8];
#pragma unroll
                for (int e = 0; e < 4; ++e) { o[e] = w * siluf_(g0[e]) * u0[e]; o[4 + e] = w * siluf_(g1[e]) * u1[e]; }
                if (!valid) {
#pragma unroll
                    for (int e = 0; e < 8; ++e) o[e] = 0.f; }
                u32x4 pk; pk.x = cvt_pk_bf16(o[0], o[1]); pk.y = cvt_pk_bf16(o[2], o[3]); pk.z = cvt_pk_bf16(o[4], o[5]); pk.w = cvt_pk_bf16(o[6], o[7]);
                *(u32x4*)(hid + ((size_t)tl * 256 + rl) * 512 + colbase) = pk;
                asm volatile("" ::: "memory");
            }
    }
};
struct EpiY {
    static constexpr bool PERM = true, MIDSCALE = false;
    bf16_t* Y;
    __device__ __forceinline__ void operator()(const f32x4 (&acc)[2][2][4][2], const pg8::Unit& u, int wr, int wc, int fr, int fq) const {
        const int row0 = u.i4 * 256 + wr * 64 + fr, col0 = u.i2 * 256 + wc * 32 + 8 * fq;
#pragma unroll
        for (int ai = 0; ai < 2; ++ai)
#pragma unroll
            for (int m = 0; m < 4; ++m) { bf16_t* rowp = Y + (size_t)(row0 + ai * 128 + m * 16) * 1024 + col0;
#pragma unroll
                for (int bj = 0; bj < 2; ++bj) { const f32x4 v0 = acc[ai][bj][m][0], v1 = acc[ai][bj][m][1];
                    u32x4 w; w.x = cvt_pk_bf16(v0[0], v0[1]); w.y = cvt_pk_bf16(v0[2], v0[3]); w.z = cvt_pk_bf16(v1[0], v1[1]); w.w = cvt_pk_bf16(v1[2], v1[3]);
                    *(u32x4*)(rowp + bj * 128) = w; } }
    }
};

__device__ __forceinline__ void tr_tile(const float* src, int ldn, int k0, int n0, int nvalid, bf16_t* dst, int ldk, int drow0, float* tile, int kd0 = -1, const float* kscale = nullptr) {
    const int tid = launder_tid();
    if (kd0 < 0) kd0 = k0;
    { const int n = tid & 63; int kk = tid >> 6;
#pragma unroll
      for (int it = 0; it < 8; ++it, kk += 8) tile[kk * 65 + n] = (n < nvalid) ? src[(size_t)(k0 + kk) * ldn + n0 + n] * (kscale ? kscale[kk] : 1.f) : 0.f; }
    __syncthreads();
    { const int k8 = tid & 7, n = tid >> 3;
      if (n < nvalid) { const float* s = tile + (k8 * 8) * 65 + n;
          u32x4 o; o.x = cvt_pk_bf16(s[0], s[65]); o.y = cvt_pk_bf16(s[2 * 65], s[3 * 65]); o.z = cvt_pk_bf16(s[4 * 65], s[5 * 65]); o.w = cvt_pk_bf16(s[6 * 65], s[7 * 65]);
          *(u32x4*)(dst + (size_t)(drow0 + n) * ldk + kd0 + k8 * 8) = o; } }
    __syncthreads();
}
__device__ __forceinline__ void phase_wprep(CP p, unsigned char* lds, int bid, int nb) {
    float* tile = (float*)lds;
    constexpr int I_IN = 16 * 41, I_OUT = 256, I_G = 1024, I_U = 1024, I_D = 1024, I_L = I_IN + I_OUT + I_G + I_U + I_D;
    for (int it = bid; it < 2 * I_L; it += nb) {
        const int l = it / I_L; int r = it - l * I_L;
        if (r < I_IN) { const int kt = r / 41, ntl = r % 41; const int n0 = ntl * 64; const int nv = (DIN - n0) < 64 ? (DIN - n0) : 64;
            tr_tile(p->w_in + (size_t)l * 1024 * DIN, DIN, kt * 64, n0, nv, (bf16_t*)(p->ws + WS_WTIN) + (size_t)l * DIN * 1024, 1024, n0, tile); continue; }
        r -= I_IN;
        if (r < I_OUT) { const int kt = r >> 4, ntl = r & 15;
            tr_tile(p->w_out + (size_t)l * 1024 * 1024, 1024, kt * 64, ntl * 64, 64, (bf16_t*)(p->ws + WS_WTOUT) + (size_t)l * 1024 * 1024, 1024, ntl * 64, tile,
                    (kt * 64 + 512) & 1023, kt >= 8 ? p->ssd_norm_g + l * 512 + (kt * 64 - 512) : nullptr); continue; }
        r -= I_OUT;
        if (r < I_G + I_U) { const int up = r >= I_G; if (up) r -= I_G; const int e = r >> 6, q = r & 63, kt = q >> 2, ntl = q & 3; const int n0 = ntl * 64;
            const float* src = (up ? p->w_up : p->w_gate) + (size_t)(l * 16 + e) * 1024 * 256;
            tr_tile(src, 256, kt * 64, n0, 64, (bf16_t*)(p->ws + WS_WTGU) + (size_t)(l * 16 + e) * 512 * 1024, 1024, (n0 >> 7) * 256 + (n0 & 127) + (up ? 128 : 0), tile); continue; }
        r -= I_G + I_U;
        { const int e = r >> 6, q = r & 63, kt = q >> 4, ntl = q & 15;
          tr_tile(p->w_down + (size_t)(l * 16 + e) * 256 * 1024, 1024, kt * 64, ntl * 64, 64, (bf16_t*)(p->ws + WS_WTD) + (size_t)(l * 16 + e) * 1024 * 256, 256, ntl * 64, tile); }
    }
}
__device__ __forceinline__ void phase_adaln(CP p, unsigned char* lds, int bid, int nb) {
    float* sc = (float*)lds;
    float* red = sc + 3 * 1024;
    const int tid = launder_tid();
    for (int idx = tid; idx < 3 * 1024; idx += NTHREADS) { const int v = idx >> 10, k = idx & 1023; const float cv = (v < 2) ? p->c[v * 1024 + k] : p->c_ctx[k]; sc[idx] = siluf_(cv); }
    __syncthreads();
    float* mod = (float*)(p->ws + WS_MOD);
    for (int it = bid; it < 2 * 96; it += nb) {
        const int l = it / 96, n0 = (it % 96) * 64;
        const int c4 = tid & 15, kr = tid >> 4;
        f32x4 a0 = {0, 0, 0, 0}, a1 = {0, 0, 0, 0}, a2 = {0, 0, 0, 0};
        const float* w = p->w_ada + (size_t)l * 1024 * 6144 + n0 + c4 * 4;
#pragma unroll 4
        for (int k = kr; k < 1024; k += 32) { const f32x4 w4 = *(const f32x4*)(w + (size_t)k * 6144); a0 += sc[k] * w4; a1 += sc[1024 + k] * w4; a2 += sc[2048 + k] * w4; }
        *(f32x4*)(red + (kr * 3 + 0) * 64 + c4 * 4) = a0; *(f32x4*)(red + (kr * 3 + 1) * 64 + c4 * 4) = a1; *(f32x4*)(red + (kr * 3 + 2) * 64 + c4 * 4) = a2;
        __syncthreads();
        if (tid < 192) { const int v = tid >> 6, cc = tid & 63; float s = 0.f;
            for (int q = 0; q < 32; ++q) s += red[(q * 3 + v) * 64 + cc];
            mod[((size_t)l * 3 + v) * 6144 + n0 + cc] = s + p->b_ada[l * 6144 + n0 + cc]; }
        __syncthreads();
    }
}
__device__ __forceinline__ void moe_table(CP p, int l, LAS int* tab) {
    const int* gcount = (const int*)(p->ws + WS_CTL) + l * 32;
    if (threadIdx.x == 0) { int acc = 0; for (int q = 0; q < NCLS; ++q) { const int cn = gcount[q]; tab[q] = acc; tab[32 + q] = cn; acc += (cn + 255) >> 8; } tab[24] = acc; }
    __syncthreads();
}
__device__ __forceinline__ void moe_apply(CP p, int lm, int r, int v, int lane, const LAS int* tab, f32x4 (&xv)[4]) {
    const int pos = ((const int*)(p->ws + WS_POS))[(size_t)lm * R + r];
    const int slot = tab[pos >> 16] * 256 + (pos & 0xffff);
    const bf16_t* y = (const bf16_t*)(p->ws + WS_Y) + (size_t)slot * 1024;
    const float* gate = (const float*)(p->ws + WS_MOD) + ((size_t)lm * 3 + v) * 6144 + 5 * 1024;
#pragma unroll
    for (int j = 0; j < 4; ++j) { const int k = 4 * lane + 256 * j; const u32x2 yv = *(const u32x2*)(y + k); const f32x4 g4 = *(const f32x4*)(gate + k);
        xv[j][0] += g4[0] * bflo(yv.x); xv[j][1] += g4[1] * bfhi(yv.x); xv[j][2] += g4[2] * bflo(yv.y); xv[j][3] += g4[3] * bfhi(yv.y); }
}
__device__ __forceinline__ void phase_r1(CP p, int l, unsigned char* lds, int bid, int nb) {
    float* wdt = (float*)lds;
    float* gm = wdt + 16 * 1024;
    float* sh = gm + 3 * 1024;
    const int tid = launder_tid(); const int lane = tid & 63, wave = tid >> 6;
    const float* mod = (const float*)(p->ws + WS_MOD) + (size_t)l * 3 * 6144;
    const float* win = p->w_in + (size_t)l * 1024 * DIN;
    for (int idx = tid; idx < 16 * 1024; idx += NTHREADS) { const int k = idx >> 4, n = idx & 15; wdt[n * 1024 + k] = win[(size_t)k * DIN + NPROJ + n]; }
    for (int idx = tid; idx < 3 * 1024; idx += NTHREADS) { const int v = idx >> 10, k = idx & 1023; gm[idx] = p->g_mix[l * 1024 + k] * (1.f + mod[v * 6144 + 1024 + k]); sh[idx] = mod[v * 6144 + k]; }
    LAS int* tab = (LAS int*)((LAS unsigned char*)lds + MISC_OFF);
    if (l > 0) moe_table(p, l - 1, tab);
    __syncthreads();
    bf16_t* HX = (bf16_t*)(p->ws + WS_HX); float* DT = (float*)(p->ws + WS_DT);
    for (int r = bid * 8 + wave; r < R; r += nb * 8) {
        const f32x4* hr = (const f32x4*)hin_ptr(p, l, r); const int v = row_v(r);
        f32x4 xv[4]; float ss = 0.f;
#pragma unroll
        for (int j = 0; j < 4; ++j) xv[j] = hr[lane + 64 * j];
        if (l > 0) { moe_apply(p, l - 1, r, v, lane, tab, xv); f32x4* hw = (f32x4*)hptr(p, r);
#pragma unroll
            for (int j = 0; j < 4; ++j) hw[lane + 64 * j] = xv[j]; }
#pragma unroll
        for (int j = 0; j < 4; ++j) ss += xv[j][0] * xv[j][0] + xv[j][1] * xv[j][1] + xv[j][2] * xv[j][2] + xv[j][3] * xv[j][3];
        ss = wave_sum(ss); const float rs = rsqrtf(ss * (1.f / 1024.f) + 1e-6f);
#pragma unroll
        for (int j = 0; j < 4; ++j) { const int k = 4 * lane + 256 * j; const f32x4 g4 = *(const f32x4*)(gm + v * 1024 + k), s4 = *(const f32x4*)(sh + v * 1024 + k);
            xv[j] = xv[j] * rs * g4 + s4;
            u32x2 o; o.x = cvt_pk_bf16(xv[j][0], xv[j][1]); o.y = cvt_pk_bf16(xv[j][2], xv[j][3]);
            *(u32x2*)(HX + (size_t)r * 1024 + k) = o; }
        float mine = 0.f;
#pragma unroll
        for (int n = 0; n < 16; ++n) { float a = 0.f;
#pragma unroll
            for (int j = 0; j < 4; ++j) { const f32x4 w4 = *(const f32x4*)(wdt + n * 1024 + 4 * lane + 256 * j); a += xv[j][0] * w4[0] + xv[j][1] * w4[1] + xv[j][2] * w4[2] + xv[j][3] * w4[3]; }
            a = wave_sum(a); mine = (lane == n) ? a : mine; }
        if (lane < 16) DT[(size_t)r * 16 + lane] = softplusf_(mine + p->dt_bias[l * 16 + lane]);
    }
}
typedef float f32x16 __attribute__((ext_vector_type(16)));
typedef short s16x4 __attribute__((ext_vector_type(4)));
constexpr int ST_ROW = 272;
constexpr int ST_TR128 = 320;
constexpr int ST_TR64 = 192;
constexpr int NCHUNK = SEG / 128;

__device__ __forceinline__ float wave_incl_scan(float v, int lane) {
#pragma unroll
    for (int o = 1; o < 64; o <<= 1) { const float t = __shfl_up(v, o); if (lane >= o) v += t; }
    return v;
}
__device__ __forceinline__ bf16x8 row_frag(const LAS unsigned char* tile, int stride, int row0, int k0, int lane) {
    return *(const LAS bf16x8*)(tile + (row0 + (lane & 31)) * stride + (k0 + 8 * (lane >> 5)) * 2);
}
__device__ __forceinline__ bf16x8 tr_frag(const LAS unsigned char* tile, int stride, int k0, int c0, int lane) {
    const int g = lane >> 4, li = lane & 15, q = li >> 2, pp = li & 3;
    const LAS unsigned char* a0 = tile + (k0 + 8 * (g >> 1) + q) * stride + (c0 + 16 * (g & 1) + 4 * pp) * 2;
    const s16x4 lo = __builtin_amdgcn_ds_read_tr16_b64_v4i16((LAS s16x4*)a0);
    const s16x4 hi = __builtin_amdgcn_ds_read_tr16_b64_v4i16((LAS s16x4*)(a0 + 4 * stride));
    return __builtin_shufflevector(lo, hi, 0, 1, 2, 3, 4, 5, 6, 7);
}
__device__ __forceinline__ u32x4 pack8(const float (&v)[8]) { u32x4 r; r.x = cvt_pk_bf16(v[0], v[1]); r.y = cvt_pk_bf16(v[2], v[3]); r.z = cvt_pk_bf16(v[4], v[5]); r.w = cvt_pk_bf16(v[6], v[7]); return r; }
__device__ __forceinline__ u32x4 pack8s(const float (&v)[8], float sc) { u32x4 r; r.x = cvt_pk_bf16(v[0] * sc, v[1] * sc); r.y = cvt_pk_bf16(v[2] * sc, v[3] * sc); r.z = cvt_pk_bf16(v[4] * sc, v[5] * sc); r.w = cvt_pk_bf16(v[6] * sc, v[7] * sc); return r; }

__device__ __forceinline__ void conv_load(const bf16_t* proj, int row0, int rq, int xch, bool lo_ok, bool hi_ok, u32x4 (&raw)[8]) {
    unsigned zz; asm volatile("v_mov_b32 %0, 0" : "=v"(zz));
#pragma unroll
    for (int j = 0; j < 8; ++j) { const int lr = 4 * rq - 2 + j; const bool ok = (lr >= 0 || lo_ok) && (lr < 128 || hi_ok);
        raw[j] = ok ? *(const u32x4*)(proj + (size_t)(row0 + lr) * NPROJ + 1536 + xch) : (u32x4){zz, zz, zz, zz}; }
}
__device__ __forceinline__ void conv_compute(const u32x4 (&raw)[8], const LAS float* wl, int nchl, int wch, float (&o)[4][8]) {
    float w[5][8], bs[8];
#pragma unroll
    for (int j = 0; j < 5; ++j) { const f32x4 w0 = *(const LAS f32x4*)(wl + j * nchl + wch), w1 = *(const LAS f32x4*)(wl + j * nchl + wch + 4);
        w[j][0] = w0[0]; w[j][1] = w0[1]; w[j][2] = w0[2]; w[j][3] = w0[3]; w[j][4] = w1[0]; w[j][5] = w1[1]; w[j][6] = w1[2]; w[j][7] = w1[3]; }
    { const f32x4 b0 = *(const LAS f32x4*)(wl + 5 * nchl + wch), b1 = *(const LAS f32x4*)(wl + 5 * nchl + wch + 4); bs[0] = b0[0]; bs[1] = b0[1]; bs[2] = b0[2]; bs[3] = b0[3]; bs[4] = b1[0]; bs[5] = b1[1]; bs[6] = b1[2]; bs[7] = b1[3]; }
#pragma unroll
    for (int i = 0; i < 4; ++i)
#pragma unroll
        for (int e = 0; e < 8; ++e) o[i][e] = bs[e];
#pragma unroll
    for (int j = 0; j < 8; ++j) {
        float xv[8] = {bflo(raw[j].x), bfhi(raw[j].x), bflo(raw[j].y), bfhi(raw[j].y), bflo(raw[j].z), bfhi(raw[j].z), bflo(raw[j].w), bfhi(raw[j].w)};
#pragma unroll
        for (int i = 0; i < 4; ++i) { const int tap = j - i; if (tap >= 0 && tap < 5) {
#pragma unroll
                for (int e = 0; e < 8; ++e) o[i][e] += w[tap][e] * xv[e]; } }
    }
#pragma unroll
    for (int i = 0; i < 4; ++i)
#pragma unroll
        for (int e = 0; e < 8; ++e) o[i][e] = siluf_(o[i][e]);
}
__device__ __forceinline__ void head_cums(CP p, int l, int row0, int h, int dir, int lane, LAS float* hv) {
    const float A = -expf(p->a_log[l * 16 + dir * 8 + h]);
    const float* DT = (const float*)(p->ws + WS_DT);
    const float d0 = DT[(size_t)(row0 + 2 * lane) * 16 + dir * 8 + h], d1 = DT[(size_t)(row0 + 2 * lane + 1) * 16 + dir * 8 + h];
    const float x0 = d0 * A, x1 = d1 * A;
    const float incl = wave_incl_scan(x0 + x1, lane);
    const float total = __shfl(incl, 63);
    float c0, c1;
    if (dir == 0) { c1 = incl; c0 = incl - x1; } else { c0 = total - (incl - x1 - x0); c1 = total - (incl - x1); }
    hv[dir * 128 + 2 * lane] = c0; hv[dir * 128 + 2 * lane + 1] = c1;
    hv[256 + dir * 128 + 2 * lane] = d0; hv[256 + dir * 128 + 2 * lane + 1] = d1;
    if (lane == 0) hv[512 + dir] = total;
}
__device__ __forceinline__ bf16x8 scale_frag(bf16x8 f, const f32x4 w0, const f32x4 w1) {
    const u32x4 u = __builtin_bit_cast(u32x4, f);
    u32x4 r;
    r.x = cvt_pk_bf16(bflo(u.x) * w0[0], bfhi(u.x) * w0[1]); r.y = cvt_pk_bf16(bflo(u.y) * w0[2], bfhi(u.y) * w0[3]);
    r.z = cvt_pk_bf16(bflo(u.z) * w1[0], bfhi(u.z) * w1[1]); r.w = cvt_pk_bf16(bflo(u.w) * w1[2], bfhi(u.w) * w1[3]);
    return __builtin_bit_cast(bf16x8, r);
}
constexpr int ST_X256 = 576;

__device__ __forceinline__ void phase_c1(CP p, int l, unsigned char* lds_, int bid, int nb) {
    LAS unsigned char* lds = (LAS unsigned char*)lds_;
    LAS unsigned char* tile = lds;
    LAS float* wl = (LAS float*)(lds + 73216);
    const int tid = launder_tid();
    const bf16_t* proj = (const bf16_t*)(p->ws + WS_PROJ); bf16_t* mix = (bf16_t*)(p->ws + WS_HX);
#pragma unroll 1
    for (int u = bid; u < 256 + 512 + 16; u += nb) {
        int S, LEN, pstride, sstride, tok0, ch0;
        if (u < 256) { const int b = u >> 7, cs = (u >> 2) & 31, cc = u & 3; S = 2; LEN = 256; pstride = 64; sstride = 1; tok0 = b * SEG + CTXL + 2 * cs; ch0 = 256 + 64 * cc; }
        else if (u < 768) { const int v = u - 256; const int b = v >> 8, rg = (v >> 2) & 63, cc = v & 3; S = 4; LEN = 64; pstride = 1; sstride = 64; tok0 = b * SEG + CTXL + 256 * rg; ch0 = 64 * cc; }
        else { const int v = u - 768; const int b = v >> 3, cc = v & 7; S = 1; LEN = 256; pstride = 1; sstride = 0; tok0 = b * SEG; ch0 = 64 * cc; }
        const int LP = LEN + 30;
        for (int i = tid; i < 32 * 64; i += NTHREADS) { const int j = i >> 6, c = i & 63; wl[i] = j < 31 ? p->conv_w[((size_t)l * 31 + j) * 512 + ch0 + c] : p->conv_b[l * 512 + ch0 + c]; }
        for (int i = tid; i < S * 30 * 8; i += NTHREADS) { const int pc = i & 7, q = (i >> 3) % 30, sq = (i >> 3) / 30; const int pos = q < 15 ? q : LEN + q;
            unsigned zz; asm volatile("v_mov_b32 %0, 0" : "=v"(zz));
            *(LAS u32x4*)(tile + ((sq * LP + pos) * 64 + pc * 8) * 2) = (u32x4){zz, zz, zz, zz}; }
        for (int i = tid; i < S * LEN * 8; i += NTHREADS) { const int pc = i & 7, t = i >> 3; const int sq = t / LEN, pos = t - sq * LEN;
            const bf16_t* src = proj + (size_t)(tok0 + sq * sstride + pos * pstride) * NPROJ + ch0 + pc * 8;
            const u32x4 uv = *(const u32x4*)src, gv = *(const u32x4*)(src + 512);
            u32x4 o;
            o.x = cvt_pk_bf16(bflo(uv.x) * sigmoidf_(bflo(gv.x)), bfhi(uv.x) * sigmoidf_(bfhi(gv.x)));
            o.y = cvt_pk_bf16(bflo(uv.y) * sigmoidf_(bflo(gv.y)), bfhi(uv.y) * sigmoidf_(bfhi(gv.y)));
            o.z = cvt_pk_bf16(bflo(uv.z) * sigmoidf_(bflo(gv.z)), bfhi(uv.z) * sigmoidf_(bfhi(gv.z)));
            o.w = cvt_pk_bf16(bflo(uv.w) * sigmoidf_(bflo(gv.w)), bfhi(uv.w) * sigmoidf_(bfhi(gv.w)));
            *(LAS u32x4*)(tile + ((sq * LP + 15 + pos) * 64 + pc * 8) * 2) = o; }
        __syncthreads();
        const int noct = S * LEN / 8;
#pragma unroll 1
        for (int it = tid; it < noct * 32; it += NTHREADS) {
            const int cp = it & 31, oc = it >> 5; const int sq = oc / (LEN / 8), p0 = (oc - sq * (LEN / 8)) * 8;
            const LAS unsigned* base = (const LAS unsigned*)(tile + ((sq * LP + p0) * 64) * 2) + cp;
            float i0[38], i1[38];
#pragma unroll
            for (int k = 0; k < 38; ++k) { const unsigned w = base[k * 32]; i0[k] = bflo(w); i1[k] = bfhi(w); }
            float a0[8], a1[8];
            { const float b0 = wl[31 * 64 + 2 * cp], b1 = wl[31 * 64 + 2 * cp + 1];
#pragma unroll
              for (int i = 0; i < 8; ++i) { a0[i] = b0; a1[i] = b1; } }
#pragma unroll
            for (int j = 0; j < 31; ++j) { const float w0 = wl[j * 64 + 2 * cp], w1 = wl[j * 64 + 2 * cp + 1];
#pragma unroll
                for (int i = 0; i < 8; ++i) { a0[i] += w0 * i0[i + j]; a1[i] += w1 * i1[i + j]; } }
#pragma unroll
            for (int i = 0; i < 8; ++i) { const int tok = tok0 + sq * sstride + (p0 + i) * pstride;
                *(unsigned*)(mix + (size_t)tok * 1024 + 512 + ch0 + 2 * cp) = cvt_pk_bf16(a0[i], a1[i]); }
        }
        __syncthreads();
    }
}
__device__ __forceinline__ void phase_c1_ln(CP p, int l, int bid, int nb) {
    const int tid = launder_tid(); const int lane = tid & 63, wave = tid >> 6;
    bf16_t* mix = (bf16_t*)(p->ws + WS_HX);
    const f32x4 g0 = *(const f32x4*)(p->conv_ln_g + l * 512 + lane * 8), g1 = *(const f32x4*)(p->conv_ln_g + l * 512 + lane * 8 + 4);
    const f32x4 b0 = *(const f32x4*)(p->conv_ln_b + l * 512 + lane * 8), b1 = *(const f32x4*)(p->conv_ln_b + l * 512 + lane * 8 + 4);
    const float gg[8] = {g0[0], g0[1], g0[2], g0[3], g1[0], g1[1], g1[2], g1[3]}, bb[8] = {b0[0], b0[1], b0[2], b0[3], b1[0], b1[1], b1[2], b1[3]};
    for (int r = bid * 8 + wave; r < R; r += nb * 8) {
        u32x4* ptr = (u32x4*)(mix + (size_t)r * 1024 + 512 + lane * 8);
        const u32x4 v = *ptr;
        float y[8] = {bflo(v.x), bfhi(v.x), bflo(v.y), bfhi(v.y), bflo(v.z), bfhi(v.z), bflo(v.w), bfhi(v.w)};
        float s = 0.f;
#pragma unroll
        for (int e = 0; e < 8; ++e) s += y[e];
        const float mu = wave_sum(s) * (1.f / 512.f);
        float q = 0.f;
#pragma unroll
        for (int e = 0; e < 8; ++e) { y[e] -= mu; q += y[e] * y[e]; }
        const float rstd = rsqrtf(wave_sum(q) * (1.f / 512.f) + 1e-5f);
        float o[8];
#pragma unroll
        for (int e = 0; e < 8; ++e) o[e] = siluf_(y[e] * rstd * gg[e] + bb[e]);
        *ptr = pack8(o);
    }
}
__device__ __forceinline__ void phase_s1(CP p, int l, unsigned char* lds_, int bid, int nb) {
    LAS unsigned char* lds = (LAS unsigned char*)lds_;
    LAS unsigned char* Bs = lds;
    LAS unsigned char* Xs = lds + 128 * ST_TR128;
    LAS float* wv = (LAS float*)(Xs + 128 * ST_X256);
    LAS float* hvs = wv + 8 * 128;
    LAS float* cwl = hvs + 4 * 520;
    const int tid = launder_tid(); const int lane = tid & 63, wave = __builtin_amdgcn_readfirstlane(tid >> 6);
    const bf16_t* proj = (const bf16_t*)(p->ws + WS_PROJ);
    const float* cw = p->ssd_conv_w + (size_t)l * 5 * 1024; const float* cbias = p->ssd_conv_b + (size_t)l * 1024;
    float* Sg = (float*)(p->ws + WS_S); float* DEC = (float*)(p->ws + WS_DEC);
    int cur_g = -1;
#pragma unroll 1
    for (int u = bid; u < NB * NCHUNK * 2; u += nb) {
        const int g = u & 1, c = (u >> 1) % NCHUNK, b = (u >> 1) / NCHUNK;
        const int row0 = b * SEG + c * 128;
        const bool lo_ok = !(c == 0 || c == 2), hi_ok = !(c == 1 || c == NCHUNK - 1);
        if (g != cur_g) { cur_g = g;
            for (int i = tid; i < 6 * 384; i += NTHREADS) { const int j = i / 384, lc = i - j * 384; const int gch = lc < 128 ? 512 + g * 128 + lc : g * 256 + (lc - 128);
                cwl[i] = j < 5 ? cw[j * 1024 + gch] : cbias[gch]; } }
        const int hh = wave >> 1, dir = wave & 1, h = 4 * g + hh;
        u32x4 rb[8], rx0[8], rx1[8];
        conv_load(proj, row0, tid >> 4, 512 + g * 128 + (tid & 15) * 8, lo_ok, hi_ok, rb);
        conv_load(proj, row0, tid >> 5, g * 256 + (tid & 31) * 8, lo_ok, hi_ok, rx0);
        conv_load(proj, row0, (tid >> 5) + 16, g * 256 + (tid & 31) * 8, lo_ok, hi_ok, rx1);
        head_cums(p, l, row0, h, dir, lane, hvs + hh * 520);
        __syncthreads();
        {
            const LAS float* hv = hvs + hh * 520; const float tot = hv[512 + dir];
#pragma unroll
            for (int q = 0; q < 2; ++q) { const int lr = lane + 64 * q; wv[wave * 128 + lr] = __expf(tot - hv[dir * 128 + lr]) * hv[256 + dir * 128 + lr]; }
            if (lane == 0) DEC[((size_t)(b * 2 + dir) * NCHUNK + c) * 8 + h] = __expf(tot);
        }
        { float o[4][8];
          conv_compute(rb, cwl, 384, (tid & 15) * 8, o);
#pragma unroll
          for (int i = 0; i < 4; ++i) *(LAS u32x4*)(Bs + (4 * (tid >> 4) + i) * ST_TR128 + (tid & 15) * 16) = pack8(o[i]);
          conv_compute(rx0, cwl, 384, 128 + (tid & 31) * 8, o);
#pragma unroll
          for (int i = 0; i < 4; ++i) *(LAS u32x4*)(Xs + (4 * (tid >> 5) + i) * ST_X256 + (tid & 31) * 16) = pack8(o[i]);
          conv_compute(rx1, cwl, 384, 128 + (tid & 31) * 8, o);
#pragma unroll
          for (int i = 0; i < 4; ++i) *(LAS u32x4*)(Xs + (4 * ((tid >> 5) + 16) + i) * ST_X256 + (tid & 31) * 16) = pack8(o[i]); }
        __syncthreads();
        {
            f32x16 acc[2][4];
#pragma unroll
            for (int t = 0; t < 2; ++t)
#pragma unroll
                for (int q = 0; q < 4; ++q)
#pragma unroll
                    for (int e = 0; e < 16; ++e) acc[t][q][e] = 0.f;
#pragma unroll 2
            for (int kk = 0; kk < 8; ++kk) {
                const LAS float* wp = wv + wave * 128 + 16 * kk + 8 * (lane >> 5);
                const f32x4 w0 = *(const LAS f32x4*)wp, w1 = *(const LAS f32x4*)(wp + 4);
                bf16x8 af[2];
#pragma unroll
                for (int t = 0; t < 2; ++t) af[t] = scale_frag(tr_frag(Xs, ST_X256, 16 * kk, hh * 64 + 32 * t, lane), w0, w1);
#pragma unroll
                for (int q = 0; q < 4; ++q) { const bf16x8 bf = tr_frag(Bs, ST_TR128, 16 * kk, 32 * q, lane);
#pragma unroll
                    for (int t = 0; t < 2; ++t) acc[t][q] = __builtin_amdgcn_mfma_f32_32x32x16_bf16(af[t], bf, acc[t][q], 0, 0, 0); }
            }
            float* So = Sg + ((size_t)((b * 2 + dir) * NCHUNK + c) * 8 + h) * 8192 + (lane & 31);
#pragma unroll
            for (int t = 0; t < 2; ++t)
#pragma unroll
                for (int q = 0; q < 4; ++q)
#pragma unroll
                    for (int e = 0; e < 16; ++e) { const int pr = 32 * t + (e & 3) + 8 * (e >> 2) + 4 * (lane >> 5); So[(size_t)pr * 128 + 32 * q] = acc[t][q][e]; }
        }
        __syncthreads();
    }
}
__device__ __forceinline__ void phase_s2(CP p, int bid, int nb) {
    const int tid = launder_tid();
    const float* Sg = (const float*)(p->ws + WS_S); const float* DEC = (const float*)(p->ws + WS_DEC); bf16_t* HP = (bf16_t*)(p->ws + WS_HP);
    for (int idx = bid * NTHREADS + tid; idx < 2 * 2 * 8 * 64 * 64; idx += nb * NTHREADS) {
        const int n2 = idx & 63, pr = (idx >> 6) & 63, h = (idx >> 12) & 7, dir = (idx >> 15) & 1, b = idx >> 16;
        const size_t inner = (size_t)h * 8192 + pr * 128 + 2 * n2;
        const size_t cbase = (size_t)(b * 2 + dir) * NCHUNK;
        float s0 = 0.f, s1 = 0.f;
#pragma unroll 5
        for (int step = 0; step < NCHUNK; ++step) {
            const int c = dir == 0 ? step : (step < 2 ? 1 - step : NCHUNK + 1 - step);
            const size_t off = (cbase + c) * 65536 + inner;
            const float2 sv = *(const float2*)(Sg + off); const float d = DEC[(cbase + c) * 8 + h];
            *(unsigned*)(HP + off) = cvt_pk_bf16(s0, s1);
            s0 = s0 * d + sv.x; s1 = s1 * d + sv.y;
        }
    }
}
__device__ __forceinline__ void phase_s3(CP p, int l, unsigned char* lds_, int bid, int nb) {
    LAS unsigned char* lds = (LAS unsigned char*)lds_;
    LAS unsigned char* Cs = lds;
    LAS unsigned char* Bs = Cs + 128 * ST_ROW;
    LAS unsigned char* Mt = Bs;
    LAS unsigned char* Xs = Bs + 128 * ST_TR128;
    LAS float* hvs = (LAS float*)(Xs + 128 * ST_TR128);
    LAS float* ssqp = hvs + 4 * 520;
    LAS float* cwl = ssqp + 256;
    const int tid = launder_tid(); const int lane = tid & 63, wave = __builtin_amdgcn_readfirstlane(tid >> 6);
    const bf16_t* proj = (const bf16_t*)(p->ws + WS_PROJ); bf16_t* mix = (bf16_t*)(p->ws + WS_HX);
    const float* cw = p->ssd_conv_w + (size_t)l * 5 * 1024; const float* cbias = p->ssd_conv_b + (size_t)l * 1024;
    const bf16_t* HP = (const bf16_t*)(p->ws + WS_HP); float* SSQ = (float*)(p->ws + WS_SSQ);
    int cur_g = -1;
#pragma unroll 1
    for (int u = bid; u < NB * NCHUNK * 2; u += nb) {
        const int g = u & 1, c = (u >> 1) % NCHUNK, b = (u >> 1) / NCHUNK;
        if (l == DEPTH - 1 && c < 2) continue;
        const int row0 = b * SEG + c * 128;
        const bool lo_ok = !(c == 0 || c == 2), hi_ok = !(c == 1 || c == NCHUNK - 1);
        if (g != cur_g) { cur_g = g;
            for (int i = tid; i < 6 * 512; i += NTHREADS) { const int j = i >> 9, lc = i & 511; const int gch = lc < 128 ? 768 + g * 128 + lc : (lc < 256 ? 512 + g * 128 + (lc - 128) : g * 256 + (lc - 256));
                cwl[i] = j < 5 ? cw[j * 1024 + gch] : cbias[gch]; } }
        {
            u32x4 r0[8], r1[8], r2[8];
            const int cg = tid & 31; const int gch = (cg < 16 ? 768 : 512) + g * 128 + (cg & 15) * 8;
            conv_load(proj, row0, tid >> 5, gch, lo_ok, hi_ok, r0);
            conv_load(proj, row0, (tid >> 5) + 16, gch, lo_ok, hi_ok, r1);
            conv_load(proj, row0, tid >> 4, g * 256 + (tid & 15) * 8, lo_ok, hi_ok, r2);
            head_cums(p, l, row0, 4 * g + (wave >> 1), wave & 1, lane, hvs + (wave >> 1) * 520);
            __syncthreads();
            float o[4][8];
            LAS unsigned char* dst = (cg < 16 ? Cs : Bs) + (cg & 15) * 16;
            conv_compute(r0, cwl, 512, cg * 8, o);
#pragma unroll
            for (int i = 0; i < 4; ++i) *(LAS u32x4*)(dst + (4 * (tid >> 5) + i) * ST_ROW) = pack8(o[i]);
            conv_compute(r1, cwl, 512, cg * 8, o);
#pragma unroll
            for (int i = 0; i < 4; ++i) *(LAS u32x4*)(dst + (4 * ((tid >> 5) + 16) + i) * ST_ROW) = pack8(o[i]);
            conv_compute(r2, cwl, 512, 256 + (tid & 15) * 8, o);
#pragma unroll
            for (int i = 0; i < 4; ++i) *(LAS u32x4*)(Xs + (4 * (tid >> 4) + i) * ST_TR128 + (tid & 15) * 16) = pack8(o[i]);
        }
        __syncthreads();
        const int lb = wave >> 1, hs = wave & 1;
        int ln = lane; asm volatile("" : "+v"(ln));
        f32x16 gacc[2];
#pragma unroll
        for (int t = 0; t < 2; ++t)
#pragma unroll
            for (int e = 0; e < 16; ++e) gacc[t][e] = 0.f;
#pragma unroll
        for (int kk = 0; kk < 8; ++kk) { const bf16x8 af = row_frag(Cs, ST_ROW, 32 * lb, 16 * kk, lane);
#pragma unroll
            for (int t = 0; t < 2; ++t) { const bf16x8 bf = row_frag(Bs, ST_ROW, 64 * hs + 32 * t, 16 * kk, lane);
                gacc[t] = __builtin_amdgcn_mfma_f32_32x32x16_bf16(af, bf, gacc[t], 0, 0, 0); } }
        __syncthreads();
#pragma unroll 1
        for (int hh = 0; hh < 4; ++hh) {
            const int h = 4 * g + hh; const LAS float* hv = hvs + hh * 520;
            asm volatile("" : "+v"(ln));
            const int ph = hs, pc = 32 * ph + (ln & 31);
            if (hh == 2) {
                u32x4 r2[8]; float o[4][8];
                conv_load(proj, row0, tid >> 4, g * 256 + 128 + (tid & 15) * 8, lo_ok, hi_ok, r2);
                conv_compute(r2, cwl, 512, 256 + 128 + (tid & 15) * 8, o);
#pragma unroll
                for (int i = 0; i < 4; ++i) *(LAS u32x4*)(Xs + (4 * (tid >> 4) + i) * ST_TR128 + (tid & 15) * 16) = pack8(o[i]);
                asm volatile("" ::: "memory");
            }
            const bf16_t* hpf = HP + ((size_t)((b * 2 + 0) * NCHUNK + c) * 8 + h) * 8192 + (size_t)(32 * ph + (lane & 31)) * 128 + 8 * (lane >> 5);
            const bf16_t* hpb = hpf + (size_t)NCHUNK * 8 * 8192;
            bf16x8 bhf[8], bhb[8];
#pragma unroll
            for (int kk = 0; kk < 8; ++kk) { bhf[kk] = *(const bf16x8*)(hpf + 16 * kk); bhb[kk] = *(const bf16x8*)(hpb + 16 * kk); }
#pragma unroll
            for (int t = 0; t < 2; ++t) {
                const int sc = 64 * hs + 32 * t + (ln & 31);
                const float cfs = hv[sc], cbs = hv[128 + sc], dfs = hv[256 + sc], dbs = hv[384 + sc];
#pragma unroll
                for (int rg = 0; rg < 4; ++rg) {
                    const int l0 = 32 * lb + 8 * rg + 4 * (ln >> 5);
                    const f32x4 cfl = *(const LAS f32x4*)(hv + l0), cbl = *(const LAS f32x4*)(hv + 128 + l0);
                    float m[4];
#pragma unroll
                    for (int e = 0; e < 4; ++e) { const int lr = l0 + e;
                        const float ff = lr >= sc ? __expf(cfl[e] - cfs) * dfs : 0.f;
                        const float fb = lr <= sc ? __expf(cbl[e] - cbs) * dbs : 0.f;
                        m[e] = gacc[t][4 * rg + e] * (ff + fb); }
                    u32x2 pk; pk.x = cvt_pk_bf16(m[0], m[1]); pk.y = cvt_pk_bf16(m[2], m[3]);
                    *(LAS u32x2*)(Mt + sc * ST_TR128 + l0 * 2) = pk;
                }
            }
            __syncthreads();
            f32x16 ad, af_, ab_;
#pragma unroll
            for (int e = 0; e < 16; ++e) { ad[e] = 0.f; af_[e] = 0.f; ab_[e] = 0.f; }
            const int xcol = (hh & 1) * 64 + 32 * ph;
#pragma unroll
            for (int kk = 0; kk < 8; ++kk) {
                const bf16x8 am = tr_frag(Mt, ST_TR128, 16 * kk, 32 * lb, lane);
                const bf16x8 bx = tr_frag(Xs, ST_TR128, 16 * kk, xcol, lane);
                ad = __builtin_amdgcn_mfma_f32_32x32x16_bf16(am, bx, ad, 0, 0, 0);
                const bf16x8 ac = row_frag(Cs, ST_ROW, 32 * lb, 16 * kk, lane);
                af_ = __builtin_amdgcn_mfma_f32_32x32x16_bf16(ac, bhf[kk], af_, 0, 0, 0);
                ab_ = __builtin_amdgcn_mfma_f32_32x32x16_bf16(ac, bhb[kk], ab_, 0, 0, 0);
            }
            const float dsk = p->d_skip[l * 8 + h];
#pragma unroll
            for (int rg = 0; rg < 4; ++rg) {
                const int l0 = 32 * lb + 8 * rg + 4 * (ln >> 5);
                const f32x4 cfl = *(const LAS f32x4*)(hv + l0), cbl = *(const LAS f32x4*)(hv + 128 + l0);
#pragma unroll
                for (int e = 0; e < 4; ++e) { const int lr = l0 + e; const int ri = 4 * rg + e;
                    const float xs = bf2f(*(const LAS bf16_t*)(Xs + lr * ST_TR128 + ((hh & 1) * 64 + pc) * 2));
                    const float y = ad[ri] + __expf(cfl[e]) * af_[ri] + __expf(cbl[e]) * ab_[ri] + dsk * xs;
                    const float z = bf2f(proj[(size_t)(row0 + lr) * NPROJ + 1024 + h * 64 + pc]);
                    const float val = y * siluf_(z);
                    mix[(size_t)(row0 + lr) * 1024 + h * 64 + pc] = f2bf(val);
                    float sq = val * val;
                    sq += __shfl_xor(sq, 1); sq += __shfl_xor(sq, 2); sq += __shfl_xor(sq, 4); sq += __shfl_xor(sq, 8); sq += __shfl_xor(sq, 16);
                    if ((ln & 31) == 0) ssqp[ph * 128 + lr] = sq;
                }
            }
            __syncthreads();
            if (tid < 128) SSQ[(size_t)(row0 + tid) * 8 + h] = ssqp[tid] + ssqp[128 + tid];
        }
        __syncthreads();
    }
}
__device__ __forceinline__ void phase_r2(CP p, int l, unsigned char* lds, int bid, int nb) {
    float* wrt = (float*)lds;
    float* gm = wrt + 20 * 1024;
    float* sh = gm + 3 * 1024;
    int* lcnt = (int*)(sh + 3 * 1024);
    int* lcls = lcnt + 64;
    int* lrank = lcls + 1024;
    float* lcwa = (float*)(lrank + 1024);
    float* lcwb = lcwa + 1024;
    const int tid = launder_tid(); const int lane = tid & 63, wave = tid >> 6;
    const float* mod = (const float*)(p->ws + WS_MOD) + (size_t)l * 3 * 6144;
    for (int idx = tid; idx < 4 * 1024; idx += NTHREADS) { const int k = idx >> 2, n = idx & 3; wrt[n * 1024 + k] = p->w_rg[(size_t)l * 4096 + idx]; }
    for (int idx = tid; idx < 16 * 1024; idx += NTHREADS) { const int k = idx >> 4, n = idx & 15; wrt[(4 + n) * 1024 + k] = p->w_re[(size_t)l * 16384 + idx]; }
    for (int idx = tid; idx < 3 * 1024; idx += NTHREADS) { const int v = idx >> 10, k = idx & 1023; gm[idx] = p->g_ffn[l * 1024 + k] * (1.f + mod[v * 6144 + 4 * 1024 + k]); sh[idx] = mod[v * 6144 + 3 * 1024 + k]; }
    if (tid < 64) lcnt[tid] = 0;
    __syncthreads();
    bf16_t* HM = (bf16_t*)(p->ws + WS_HX); float* CWLA = (float*)(p->ws + WS_CWLA); float* CWLB = (float*)(p->ws + WS_CWLB); int* POS = (int*)(p->ws + WS_POS) + (size_t)l * R;
    int* gcount = (int*)(p->ws + WS_CTL) + l * 32; int* LIST = (int*)(p->ws + WS_LIST);
    const int rpb = (R + nb - 1) / nb, r0 = bid * rpb, r1 = (r0 + rpb) < R ? (r0 + rpb) : R;
    for (int r = r0 + wave; r < r1; r += 8) {
        const f32x4* hr = (const f32x4*)hptr(p, r); const int v = row_v(r);
        f32x4 xv[4]; float ss = 0.f;
#pragma unroll
        for (int j = 0; j < 4; ++j) { xv[j] = hr[lane + 64 * j]; ss += xv[j][0] * xv[j][0] + xv[j][1] * xv[j][1] + xv[j][2] * xv[j][2] + xv[j][3] * xv[j][3]; }
        ss = wave_sum(ss); const float rs = rsqrtf(ss * (1.f / 1024.f) + 1e-6f);
#pragma unroll
        for (int j = 0; j < 4; ++j) { const int k = 4 * lane + 256 * j; const f32x4 g4 = *(const f32x4*)(gm + v * 1024 + k), s4 = *(const f32x4*)(sh + v * 1024 + k);
            xv[j] = xv[j] * rs * g4 + s4;
            u32x2 o; o.x = cvt_pk_bf16(xv[j][0], xv[j][1]); o.y = cvt_pk_bf16(xv[j][2], xv[j][3]);
            *(u32x2*)(HM + (size_t)r * 1024 + k) = o; }
        float lg[20];
#pragma unroll
        for (int n = 0; n < 20; ++n) { float a = 0.f;
#pragma unroll
            for (int j = 0; j < 4; ++j) { const f32x4 w4 = *(const f32x4*)(wrt + n * 1024 + 4 * lane + 256 * j); a += xv[j][0] * w4[0] + xv[j][1] * w4[1] + xv[j][2] * w4[2] + xv[j][3] * w4[3]; }
            lg[n] = wave_sum(a) + (n < 4 ? p->b_rg[l * 4 + n] : p->b_re[l * 16 + n - 4]); }
        int gsel = 0; float gmax = lg[0];
#pragma unroll
        for (int q = 1; q < 4; ++q) if (lg[q] > gmax) { gmax = lg[q]; gsel = q; }
        float gden = 0.f;
#pragma unroll
        for (int q = 0; q < 4; ++q) gden += __expf(lg[q] - gmax);
        const float gprob = 1.f / gden;
        float el[4];
#pragma unroll
        for (int q = 0; q < 4; ++q) el[q] = gsel == 0 ? lg[4 + q] : (gsel == 1 ? lg[8 + q] : (gsel == 2 ? lg[12 + q] : lg[16 + q]));
        int i0 = 0; float m0 = el[0];
#pragma unroll
        for (int q = 1; q < 4; ++q) if (el[q] > m0) { m0 = el[q]; i0 = q; }
        int i1 = -1; float m1 = -3.0e38f;
#pragma unroll
        for (int q = 0; q < 4; ++q) if (q != i0 && el[q] > m1) { m1 = el[q]; i1 = q; }
        const float w0 = gprob / (1.f + __expf(m1 - m0)), w1 = gprob - w0;
        const int ea = i0 < i1 ? i0 : i1, eb = i0 < i1 ? i1 : i0;
        const float cwa = i0 < i1 ? w0 : w1, cwb = i0 < i1 ? w1 : w0;
        const int pidx = ea == 0 ? eb - 1 : (ea == 1 ? eb + 1 : 5);
        const int cls = gsel * 6 + pidx;
        if (lane == 0) { const int rank = atomicAdd(&lcnt[cls], 1); lcls[r - r0] = cls; lrank[r - r0] = rank; lcwa[r - r0] = cwa; lcwb[r - r0] = cwb; }
    }
    __syncthreads();
    if (tid < NCLS) lcnt[32 + tid] = atomicAdd(&gcount[tid], lcnt[tid]);
    __syncthreads();
    for (int idx = tid; idx < r1 - r0; idx += NTHREADS) { const int cl = lcls[idx]; const int pos = lcnt[32 + cl] + lrank[idx]; const size_t li = (size_t)cl * R + pos;
        LIST[li] = r0 + idx; CWLA[li] = lcwa[idx]; CWLB[li] = lcwb[idx]; POS[r0 + idx] = (cl << 16) | pos; }
    __syncthreads();
}
__device__ __forceinline__ void phase_final(CP p, unsigned char* lds, int bid, int nb) {
    const int tid = launder_tid(); const int lane = tid & 63, wave = tid >> 6;
    LAS int* tab = (LAS int*)((LAS unsigned char*)lds + MISC_OFF);
    moe_table(p, DEPTH - 1, tab);
    for (int q = bid * 8 + wave; q < NB * SEQ; q += nb * 8) {
        const int b = q >= SEQ ? 1 : 0; const int r = b * SEG + CTXL + (q - b * SEQ);
        f32x4* hr = (f32x4*)(p->out + (size_t)q * D);
        f32x4 xv[4]; float ss = 0.f;
#pragma unroll
        for (int j = 0; j < 4; ++j) xv[j] = hr[lane + 64 * j];
        moe_apply(p, DEPTH - 1, r, b, lane, tab, xv);
#pragma unroll
        for (int j = 0; j < 4; ++j) ss += xv[j][0] * xv[j][0] + xv[j][1] * xv[j][1] + xv[j][2] * xv[j][2] + xv[j][3] * xv[j][3];
        ss = wave_sum(ss); const float rs = rsqrtf(ss * (1.f / 1024.f) + 1e-6f);
#pragma unroll
        for (int j = 0; j < 4; ++j) { const f32x4 g4 = *(const f32x4*)(p->g_final + 4 * lane + 256 * j); hr[lane + 64 * j] = xv[j] * rs * g4; }
    }
}


#define XB_TMO      128
#define XB_XCNT(j)  (256  + 64 * (j))
#define XB_XSUB(j)  (1280 + 64 * (j))
#define XB_XGEN(j)  (2304 + 64 * (j))
#define XB_TOP      3328
#define XB_TOPGEN   3392
#define XCD_BAR_WORDS 3456
#define XB_SPIN_CAP (1u << 22)
__device__ __forceinline__ unsigned xb_ld(unsigned* p) { return __hip_atomic_load(p, __ATOMIC_RELAXED, __HIP_MEMORY_SCOPE_AGENT); }
__device__ __forceinline__ unsigned xb_add(unsigned* p, unsigned v) { return __hip_atomic_fetch_add(p, v, __ATOMIC_RELAXED, __HIP_MEMORY_SCOPE_AGENT); }
__device__ __forceinline__ unsigned xb_xcc_id() { return (unsigned)__builtin_amdgcn_s_getreg((3 << 11) | 20) & 0xFu; }
#define XB_SPIN(cond, bar) do { unsigned _sp = 0; while (cond) { __builtin_amdgcn_s_sleep(1); \
    if ((++_sp & 255u) == 0u) { if (xb_ld(&(bar)[XB_TMO])) break; if (_sp > XB_SPIN_CAP) { atomicAdd(&(bar)[XB_TMO], 1u); break; } } } } while (0)
struct XcdBarrier { unsigned* bar; unsigned x; volatile LAS unsigned* st; };
__device__ __forceinline__ XcdBarrier xcd_barrier_post(unsigned* bar, volatile LAS unsigned* st) {
    XcdBarrier b; b.bar = bar; b.x = xb_xcc_id(); b.st = st;
    if (threadIdx.x == 0) (void)xb_add(&bar[XB_XCNT(b.x)], 1u);
    return b;
}
__device__ __forceinline__ void xcd_barrier_complete(unsigned* bar, unsigned x, unsigned& nloc, unsigned& nx) {
    const unsigned G = gridDim.x * gridDim.y * gridDim.z;
    unsigned sum, cnt, mine, sp = 0u;
    for (;;) {
        sum = 0u; cnt = 0u; mine = 0u;
#pragma unroll
        for (unsigned j = 0; j < 16; ++j) { const unsigned c = xb_ld(&bar[XB_XCNT(j)]); sum += c; cnt += (c > 0u) ? 1u : 0u; mine = (j == x) ? c : mine; }
        if (sum == G) break;
        __builtin_amdgcn_s_sleep(1);
        if ((++sp & 255u) == 0u) { if (xb_ld(&bar[XB_TMO])) break; if (sp > XB_SPIN_CAP) { atomicAdd(&bar[XB_TMO], 1u); break; } }
    }
    nloc = mine > 0u ? mine : 1u; nx = cnt > 0u ? cnt : 1u;
}
__device__ __forceinline__ void xcd_barrier(const XcdBarrier& b) {
    asm volatile("s_waitcnt vmcnt(0)" ::: "memory");
    __syncthreads();
    if (threadIdx.x == 0) {
        unsigned* bar = b.bar;
        __builtin_amdgcn_s_waitcnt(0);
        unsigned nloc = b.st[0], nx = b.st[1];
        if (nloc == 0u) { xcd_barrier_complete(bar, b.x, nloc, nx); b.st[0] = nloc; b.st[1] = nx; }
        const unsigned old = xb_add(&bar[XB_XSUB(b.x)], 1u);
        const unsigned gen = old / nloc;
        if (old + 1u == (gen + 1u) * nloc) {
            __builtin_amdgcn_fence(__ATOMIC_RELEASE, "agent");
            asm volatile("s_waitcnt vmcnt(0)" ::: "memory");
            const unsigned og = xb_add(&bar[XB_TOP], 1u);
            const unsigned tg = og / nx;
            if (og + 1u == (tg + 1u) * nx) xb_add(&bar[XB_TOPGEN], 1u);
            else XB_SPIN(xb_ld(&bar[XB_TOPGEN]) == tg, bar);
            __builtin_amdgcn_fence(__ATOMIC_ACQUIRE, "agent");
            xb_add(&bar[XB_XGEN(b.x)], 1u);
            asm volatile("s_waitcnt vmcnt(0)" ::: "memory");
        } else {
            XB_SPIN(xb_ld(&bar[XB_XGEN(b.x)]) == gen, bar);
            __builtin_amdgcn_fence(__ATOMIC_ACQUIRE, "agent");
            asm volatile("s_waitcnt vmcnt(0)" ::: "memory");
        }
    }
    __syncthreads();
}

#ifndef PHASE_MASK
#define PHASE_MASK 0xFFFFF
#endif
#define PM(i) ((PHASE_MASK >> (i)) & 1)
#ifndef REPEAT_MASK
#define REPEAT_MASK 0
#endif
#define RP(i) for (int rep_ = 0; rep_ < 1 + ((REPEAT_MASK >> (i)) & 1); ++rep_)
constexpr int PH_PER_LAYER = 9, NPHASES = 1 + DEPTH * PH_PER_LAYER + 1;
__global__ void __launch_bounds__(NTHREADS, 2) mk_fwd(Args args) {
    extern __shared__ __attribute__((aligned(16))) unsigned char lds[];
    cg::grid_group grid = cg::this_grid();
    const __attribute__((address_space(4))) Args* ap = (const __attribute__((address_space(4))) Args*)__builtin_amdgcn_kernarg_segment_ptr();
    const int lo = ap->lo, hi = ap->hi;
    LAS unsigned char* ldsl = (LAS unsigned char*)lds;
    volatile LAS unsigned* xbst = (volatile LAS unsigned*)(ldsl + LDS_BYTES - 16);
    if (threadIdx.x < 4) xbst[threadIdx.x] = 0u;
    __syncthreads();
    (void)xcd_barrier_post((unsigned*)(ap->p.ws + WS_BAR), xbst);
    for (int ph = lo; ph < hi; ++ph) {
        CP p = launder(&ap->p);
        int bid = blockIdx.x, nb = gridDim.x; asm volatile("" : "+s"(bid), "+s"(nb));
        if (ph == 0) { if (PM(0)) RP(0) phase_wprep(p, lds, bid, nb); if (PM(1)) RP(1) phase_adaln(p, lds, bid, nb); }
        else if (ph == NPHASES - 1) { if (PM(12)) phase_final(p, lds, bid, nb); }
        else {
            const int l = (ph - 1) / PH_PER_LAYER, s = (ph - 1) % PH_PER_LAYER;
            if (s == 0) { if (PM(2)) RP(2) { if (rep_ == 0 || l == 0) phase_r1(p, l, lds, bid, nb); } }
            else if (s == 1) { if (PM(3)) RP(3) {
                pg8::DenseSched S; S.init(p->ws + WS_HX, (const bf16_t*)(p->ws + WS_WTIN) + (size_t)l * DIN * 1024, R, NPROJ, 1024, 1024, 1024, nb, bid);
                EpiProj E{(bf16_t*)(p->ws + WS_PROJ)};
                pg8::gemm_phase<EpiProj, pg8::DenseSched, false>(ldsl, 1024, 1024, 1024, S, E);
            } }
            else if (s == 2) { if (PM(4)) RP(4) phase_c1(p, l, lds, bid, nb); if (PM(5)) RP(5) phase_s1(p, l, lds, bid, nb); }
            else if (s == 3) { if (PM(6)) RP(6) phase_s2(p, bid, nb); if (PM(4)) phase_c1_ln(p, l, bid, nb); }
            else if (s == 4) { if (PM(7)) RP(7) phase_s3(p, l, lds, bid, nb); }
            else if (s == 5) { if (PM(8)) RP(8) { if (rep_ == 0 || l == 0) {
                pg8::DenseSched S; S.init(p->ws + WS_HX, (const bf16_t*)(p->ws + WS_WTOUT) + (size_t)l * 1024 * 1024, R, 1024, 1024, 1024, 1024, nb, bid);
                EpiResid E{l == 0 ? p->ctx : (const float*)(p->ws + WS_HC), l == 0 ? p->x : (const float*)p->out, (float*)(p->ws + WS_HC), p->out, (const float*)(p->ws + WS_MOD) + (size_t)l * 3 * 6144, (const float*)(p->ws + WS_SSQ)};
                pg8::gemm_phase<EpiResid, pg8::DenseSched, false>(ldsl, 1024, 1024, 1024, S, E);
            } } }
            else if (s == 6) { if (PM(9)) phase_r2(p, l, lds, bid, nb); }
            else if (s == 7) { if (PM(10)) RP(10) {
                LAS int* tab = (LAS int*)(ldsl + MISC_OFF); moe_table(p, l, tab);
                MoeSched S{tab, (const int*)(p->ws + WS_LIST), (const char*)(p->ws + WS_HX), (const char*)(p->ws + WS_WTGU), 0, l, nb, bid};
                EpiUp E{(bf16_t*)(p->ws + WS_HID), (const float*)(p->ws + WS_CWLA), (const float*)(p->ws + WS_CWLB)};
                pg8::gemm_phase<EpiUp, MoeSched, true>(ldsl, 1024, 1024, 1024, S, E);
            } }
            else { if (PM(11)) RP(11) {
                LAS int* tab = (LAS int*)(ldsl + MISC_OFF); moe_table(p, l, tab);
                MoeSched S{tab, (const int*)(p->ws + WS_LIST), (const char*)(p->ws + WS_HID), (const char*)(p->ws + WS_WTD), 1, l, nb, bid};
                EpiY E{(bf16_t*)(p->ws + WS_Y)};
                pg8::gemm_phase<EpiY, MoeSched, false>(ldsl, 512, 256, 512, S, E);
            } }
        }
        if (ph + 1 < hi) { if (ph == lo) grid.sync(); else { XcdBarrier xb; xb.bar = (unsigned*)(launder(&ap->p)->ws + WS_BAR); xb.x = xb_xcc_id(); xb.st = (volatile LAS unsigned*)(ldsl + LDS_BYTES - 16); xcd_barrier(xb); } }
    }
}

extern "C" void kernel_launch(void* const* d_in, const int* in_sizes, int n_in, void* d_out, int out_size, void* d_ws, size_t ws_size, hipStream_t stream) {
    static int grid = 0;
    if (grid == 0) {
        if (n_in != 28 || ws_size < WS_END) { fprintf(stderr, "kernel_launch: unexpected n_in %d or ws_size %zu (< %zu)\n", n_in, ws_size, (size_t)WS_END); grid = -1; return; }
        int dev = 0, cus = 0, per_cu = 0;
        hipGetDevice(&dev); hipDeviceGetAttribute(&cus, hipDeviceAttributeMultiprocessorCount, dev);
        if (hipFuncSetAttribute((const void*)mk_fwd, hipFuncAttributeMaxDynamicSharedMemorySize, LDS_BYTES) != hipSuccess) { fprintf(stderr, "kernel_launch: hipFuncSetAttribute failed\n"); grid = -1; return; }
        if (hipOccupancyMaxActiveBlocksPerMultiprocessor(&per_cu, (const void*)mk_fwd, NTHREADS, LDS_BYTES) != hipSuccess || per_cu < 1) { fprintf(stderr, "kernel_launch: occupancy query says %d\n", per_cu); (void)hipGetLastError(); grid = -1; return; }
        grid = cus;
    }
    if (grid < 0) return;
    (void)hipMemsetAsync((char*)d_ws + WS_CTL, 0, WS_CTL_BYTES, stream);
    Args a{};
    const float** pp = (const float**)&a.p;
    for (int i = 0; i < 28; ++i) pp[i] = (const float*)d_in[i];
    a.p.out = (float*)d_out; a.p.ws = (unsigned char*)d_ws;
#if PER_PHASE_LAUNCH
    for (int ph = 0; ph < NPHASES; ++ph) {
        a.lo = ph; a.hi = ph + 1; void* kargs[] = {&a};
        hipError_t e = hipLaunchCooperativeKernel((const void*)mk_fwd, dim3(grid), dim3(NTHREADS), kargs, LDS_BYTES, stream);
        if (e != hipSuccess) { fprintf(stderr, "kernel_launch: launch of phase %d failed: %s\n", ph, hipGetErrorString(e)); break; }
    }
#else
    a.lo = 0; a.hi = NPHASES; void* kargs[] = {&a};
    hipError_t e = hipLaunchCooperativeKernel((const void*)mk_fwd, dim3(grid), dim3(NTHREADS), kargs, LDS_BYTES, stream);
    if (e != hipSuccess) fprintf(stderr, "kernel_launch: cooperative launch failed: %s (grid %d)\n", hipGetErrorString(e), grid);
#endif
}
```

```cpp
#include <hip/hip_runtime.h>
#include <hip/hip_cooperative_groups.h>
#include <cstdio>
namespace cg = cooperative_groups;

#ifndef PER_PHASE_LAUNCH
#define PER_PHASE_LAUNCH 0
#endif

#ifndef S3REP
#define S3REP 0
#endif
#define S3R(i) for (int r3_ = 0; r3_ < 1 + ((S3REP >> (i)) & 1); ++r3_)
#define LAS __attribute__((address_space(3)))
typedef unsigned short bf16_t;
typedef short bf16x8 __attribute__((ext_vector_type(8)));
typedef float f32x4 __attribute__((ext_vector_type(4)));
typedef unsigned u32x4 __attribute__((ext_vector_type(4)));
typedef unsigned u32x2 __attribute__((ext_vector_type(2)));

constexpr int D = 1024, NB = 2, SEQ = 16384, CTXL = 256, SEG = SEQ + CTXL, R = NB * SEG, DEPTH = 2;
constexpr int NPROJ = 2560, DIN = 2576;
constexpr int NTHREADS = 512;
constexpr int LDS_BYTES = 163840;
constexpr int MISC_OFF = 131072;
constexpr int NCLS = 24;

constexpr size_t al256(size_t x) { return (x + 255) & ~size_t(255); }
constexpr size_t WS_CTL = 0;
constexpr size_t WS_BAR = 4096;
constexpr size_t WS_CTL_BYTES = 32768;
constexpr size_t WS_MOD = WS_CTL_BYTES;
constexpr size_t WS_WTIN = WS_MOD + al256((size_t)2 * 3 * 6144 * 4);
constexpr size_t WS_WTOUT = WS_WTIN + al256((size_t)2 * DIN * 1024 * 2);
constexpr size_t WS_WTGU = WS_WTOUT + al256((size_t)2 * 1024 * 1024 * 2);
constexpr size_t WS_WTD = WS_WTGU + al256((size_t)2 * 16 * 512 * 1024 * 2);
constexpr size_t WS_HC = WS_WTD + al256((size_t)2 * 16 * 1024 * 256 * 2);
constexpr size_t WS_HX = WS_HC + al256((size_t)512 * 1024 * 4);
constexpr size_t WS_PROJ = WS_HX + al256((size_t)R * 1024 * 2);
constexpr size_t WS_DT = WS_PROJ + al256((size_t)R * NPROJ * 2);
constexpr size_t WS_POS = WS_DT + al256((size_t)R * 16 * 4);
constexpr size_t WS_LIST = WS_POS + al256((size_t)2 * R * 4);
constexpr size_t WS_CWLA = WS_LIST + al256((size_t)NCLS * R * 4);
constexpr size_t WS_CWLB = WS_CWLA + al256((size_t)NCLS * R * 4);
constexpr size_t WS_BIG = WS_CWLB + al256((size_t)NCLS * R * 4);
constexpr size_t WS_Y = WS_PROJ;
constexpr size_t WS_S = WS_BIG;
constexpr size_t WS_HP = WS_S + al256((size_t)2 * 2 * 130 * 8 * 8192 * 4);
constexpr size_t WS_DEC = WS_HP + al256((size_t)2 * 2 * 130 * 8 * 8192 * 2);
constexpr size_t WS_SSQ = WS_DEC + al256((size_t)2 * 2 * 130 * 8 * 4);
constexpr size_t WS_HID = WS_S;
constexpr size_t WS_END = WS_SSQ + al256((size_t)R * 8 * 4);
static_assert((size_t)(R + NCLS * 256) * 512 * 2 <= (size_t)2 * 2 * 130 * 8 * 8192 * 4, "hid alias");
static_assert(WS_END <= (size_t)512 * 1024 * 1024, "workspace");

struct Params {
    const float *x, *c, *ctx, *c_ctx, *w_ada, *b_ada, *g_mix, *g_ffn, *w_in, *conv_w, *conv_b, *conv_ln_g, *conv_ln_b, *ssd_conv_w, *ssd_conv_b,
        *dt_bias, *a_log, *d_skip, *ssd_norm_g, *w_out, *w_rg, *b_rg, *w_re, *b_re, *w_gate, *w_up, *w_down, *g_final;
    float* out; unsigned char* ws;
};
struct Args { Params p; int lo, hi; };
typedef const __attribute__((address_space(4))) Params* CP;
__device__ __forceinline__ CP launder(CP p) { asm volatile("" : "+s"(p)); return p; }
__device__ __forceinline__ int launder_tid() { int t = threadIdx.x; asm volatile("" : "+v"(t)); return t; }

__device__ __forceinline__ unsigned cvt_pk_bf16(float lo, float hi) { unsigned r; asm("v_cvt_pk_bf16_f32 %0, %1, %2" : "=v"(r) : "v"(lo), "v"(hi)); return r; }
__device__ __forceinline__ float bf2f(unsigned b) { return __uint_as_float(b << 16); }
__device__ __forceinline__ float bflo(unsigned w) { return __uint_as_float(w << 16); }
__device__ __forceinline__ float bfhi(unsigned w) { return __uint_as_float(w & 0xffff0000u); }
__device__ __forceinline__ bf16_t f2bf(float f) { return (bf16_t)(cvt_pk_bf16(f, 0.f) & 0xffffu); }
#define DPP_ADD(v, ctrl, rm) ((v) + __builtin_bit_cast(float, __builtin_amdgcn_update_dpp(0, __builtin_bit_cast(int, (v)), (ctrl), (rm), 0xF, true)))
__device__ __forceinline__ float row_sum16(float v) {
    v = DPP_ADD(v, 0xB1, 0xF);
    v = DPP_ADD(v, 0x4E, 0xF);
    v = DPP_ADD(v, 0x141, 0xF);
    v = DPP_ADD(v, 0x140, 0xF);
    return v;
}
__device__ __forceinline__ float half_sum32(float v) { v = row_sum16(v); v = DPP_ADD(v, 0x142, 0xA); return v; }
__device__ __forceinline__ float wave_sum(float v) {
    v = half_sum32(v); v = DPP_ADD(v, 0x143, 0xC);
    return __builtin_bit_cast(float, __builtin_amdgcn_readlane(__builtin_bit_cast(int, v), 63));
}
__device__ __forceinline__ float sigmoidf_(float x) { return 1.f / (1.f + __expf(-x)); }
__device__ __forceinline__ float siluf_(float x) { return x / (1.f + __expf(-x)); }
__device__ __forceinline__ float softplusf_(float x) { return fmaxf(x, 0.f) + log1pf(expf(-fabsf(x))); }

__device__ __forceinline__ int row_b(int r) { return r >= SEG ? 1 : 0; }
__device__ __forceinline__ int row_i(int r) { return r >= SEG ? r - SEG : r; }
__device__ __forceinline__ int row_v(int r) { const int i = row_i(r); return i < CTXL ? 2 : row_b(r); }
__device__ __forceinline__ float* hptr2(float* hc, float* out, int r) {
    const int b = row_b(r), i = row_i(r);
    return i < CTXL ? hc + (size_t)(b * CTXL + i) * D : out + (size_t)(b * SEQ + i - CTXL) * D;
}
__device__ __forceinline__ float* hptr(CP p, int r) { return hptr2((float*)(p->ws + WS_HC), p->out, r); }
__device__ __forceinline__ const float* hin_ptr(CP p, int l, int r) {
    if (l == 0) return hptr2((float*)p->ctx, (float*)p->x, r);
    return hptr(p, r);
}

namespace pg8 {
constexpr int BM = 256, BK = 64, HALF = 128, HTB = HALF * BK * 2, STAGE_BYTES = 8 * HTB, NXCD = 8, WGM = 8;
__device__ __forceinline__ int lds_byte(int r, int c) { const int st = (r >> 4) * 2 + (c >> 5), rr = r & 15, cc = c & 31, ob = rr * 64 + cc * 2; return st * 1024 + (ob ^ (((ob >> 9) & 1) << 5)); }
__device__ __forceinline__ void stage_rc(int b, int& Rr, int& Cc) { const int st = b / 1024, sb = b % 1024, swz = sb ^ (((sb >> 9) & 1) << 5); Rr = (st >> 1) * 16 + swz / 64; Cc = (st & 1) * 32 + (swz % 64) / 2; }
__device__ __forceinline__ int perm32(int rho) { const int n = rho >> 4, i = rho & 15; return 8 * (i >> 2) + 4 * n + (i & 3); }

struct Unit {
    const char* a0;
    const char* b0;
    const char* b1;
    int i0, i1, i2, i3, i4, pad;
};

template <class Epi, class Sched, bool GATHER>
__device__ __forceinline__ void gemm_phase(LAS unsigned char* lds, const int lda, const int ldb, const int K, const Sched& S, const Epi& E) {
    const int tid = launder_tid(); const int wid = __builtin_amdgcn_readfirstlane(tid >> 6), lane = tid & 63, wr = wid >> 2, wc = wid & 3, fr = lane & 15, fq = lane >> 4;
    const int nt = K / BK, ks = nt >> 1;
    int Rr[2], Cc[2];
    unsigned voffB[2];
#pragma unroll
    for (int i = 0; i < 2; ++i) { stage_rc(tid * 16 + i * 8192, Rr[i], Cc[i]); const int Rb = Epi::PERM ? ((Rr[i] & ~31) + perm32(Rr[i] & 31)) : Rr[i];
        voffB[i] = (unsigned)(Rb * ldb + Cc[i]) * 2u; }
    const size_t kstep = (size_t)(BK * 2);
    const size_t hstepB = (size_t)HALF * ldb * 2;
    const unsigned ldsw = (unsigned)wid * 1024u;
    const unsigned ldsbase = (unsigned)(unsigned long)lds;
    const int aoff = lds_byte(wr * 64 + fr, fq * 8), boff = lds_byte(wc * 32 + fr, fq * 8);
#define PG8_SA(b, h) (((b) * 2 + (h)) * HTB)
#define PG8_SB(b, h) ((4 + (b) * 2 + (h)) * HTB)
#define PG8_STAGE2(bufoff, gbase, v0, v1) do { unsigned keep_; \
        asm volatile("s_mov_b32 %0, m0\n\ts_mov_b32 m0, %1\n\ts_nop 4\n\tglobal_load_lds_dwordx4 %2, %4\n\ts_add_u32 m0, m0, 0x2000\n\ts_nop 0\n\tglobal_load_lds_dwordx4 %3, %4\n\ts_mov_b32 m0, %0" \
            : "=&s"(keep_) : "s"(ldsbase + (unsigned)(bufoff) + ldsw), "v"(v0), "v"(v1), "s"(gbase) : "memory", "scc"); } while (0)
#define PG8_LDA(dst, b, h) do { _Pragma("unroll") for (int m = 0; m < 4; ++m) _Pragma("unroll") for (int k = 0; k < 2; ++k) dst[m][k] = *(const LAS bf16x8*)(lds + PG8_SA(b, h) + aoff + m * 2048 + k * 1024); } while (0)
#define PG8_LDB(dst, b, h) do { _Pragma("unroll") for (int n = 0; n < 2; ++n) _Pragma("unroll") for (int k = 0; k < 2; ++k) dst[n][k] = *(const LAS bf16x8*)(lds + PG8_SB(b, h) + boff + n * 2048 + k * 1024); } while (0)
#define PG8_MMA(ai, bj, At, Bt) do { __builtin_amdgcn_s_setprio(1); _Pragma("unroll") for (int m = 0; m < 4; ++m) _Pragma("unroll") for (int n = 0; n < 2; ++n) _Pragma("unroll") for (int k = 0; k < 2; ++k) \
        acc[ai][bj][m][n] = __builtin_amdgcn_mfma_f32_16x16x32_bf16(Bt[n][k], At[m][k], acc[ai][bj][m][n], 0, 0, 0); __builtin_amdgcn_s_setprio(0); } while (0)
#define PG8_WAIT_V(n) asm volatile("s_waitcnt vmcnt(" #n ")" ::: "memory")
#define PG8_WAIT_L(n) asm volatile("s_waitcnt lgkmcnt(" #n ")" ::: "memory")
#define PG8_BAR __builtin_amdgcn_s_barrier()
#define PG8_SCHED __builtin_amdgcn_sched_barrier(0)
#define PG8_BP(u, tt) ((tt) < ks ? (u).b0 + (size_t)(tt) * kstep : (u).b1 + (size_t)((tt) - ks) * kstep)
    Unit cur, nxt; int ui = 0;
    if (!S.get(0, cur)) return;
    unsigned c00, c01, c10, c11, n00, n01, n10, n11;
    if (GATHER) {
        c00 = (unsigned)(S.arow(cur, Rr[0]) * lda + Cc[0]) * 2u; c01 = (unsigned)(S.arow(cur, Rr[1]) * lda + Cc[1]) * 2u;
        c10 = (unsigned)(S.arow(cur, HALF + Rr[0]) * lda + Cc[0]) * 2u; c11 = (unsigned)(S.arow(cur, HALF + Rr[1]) * lda + Cc[1]) * 2u;
    } else {
        c00 = (unsigned)(Rr[0] * lda + Cc[0]) * 2u; c01 = (unsigned)(Rr[1] * lda + Cc[1]) * 2u;
        c10 = (unsigned)((HALF + Rr[0]) * lda + Cc[0]) * 2u; c11 = (unsigned)((HALF + Rr[1]) * lda + Cc[1]) * 2u;
    }
    n00 = c00; n01 = c01; n10 = c10; n11 = c11;
    f32x4 acc[2][2][4][2];
    float zr; asm volatile("v_mov_b32 %0, 0" : "=v"(zr));
#pragma unroll
    for (int a = 0; a < 2; ++a)
#pragma unroll
        for (int b = 0; b < 2; ++b)
#pragma unroll
            for (int m = 0; m < 4; ++m)
#pragma unroll
                for (int n = 0; n < 2; ++n) acc[a][b][m][n] = (f32x4){zr, zr, zr, zr};
    bf16x8 At[4][2], B0[2][2], B1[2][2];
    const char* cA = cur.a0;
    {
        const char* pb0 = PG8_BP(cur, 0); const char* pb1 = PG8_BP(cur, 1);
        PG8_STAGE2(PG8_SB(0, 0), pb0, voffB[0], voffB[1]); PG8_STAGE2(PG8_SA(0, 0), cA, c00, c01);
        PG8_STAGE2(PG8_SB(0, 1), pb0 + hstepB, voffB[0], voffB[1]); PG8_STAGE2(PG8_SA(0, 1), cA, c10, c11);
        if (wr == 1) PG8_BAR;
        PG8_WAIT_V(4); PG8_BAR;
        PG8_STAGE2(PG8_SB(1, 0), pb1, voffB[0], voffB[1]); PG8_STAGE2(PG8_SA(1, 0), cA + kstep, c00, c01);
        PG8_STAGE2(PG8_SB(1, 1), pb1 + hstepB, voffB[0], voffB[1]);
        PG8_WAIT_V(6); PG8_BAR;
    }
    for (;;) {
        const bool has_next = S.get(ui + 1, nxt);
        if (!has_next) nxt = cur;
        if (GATHER) {
            if (has_next) {
                n00 = (unsigned)(S.arow(nxt, Rr[0]) * lda + Cc[0]) * 2u; n01 = (unsigned)(S.arow(nxt, Rr[1]) * lda + Cc[1]) * 2u;
                n10 = (unsigned)(S.arow(nxt, HALF + Rr[0]) * lda + Cc[0]) * 2u; n11 = (unsigned)(S.arow(nxt, HALF + Rr[1]) * lda + Cc[1]) * 2u;
            } else { n00 = c00; n01 = c01; n10 = c10; n11 = c11; }
        }
        const char* nA = nxt.a0;
#pragma unroll 1
        for (int t = 0; t < nt; t += 2) {
            const bool last = (t == nt - 2);
            const char* a1 = cA + (size_t)(t + 1) * kstep;
            const char* a2 = last ? nA : cA + (size_t)(t + 2) * kstep;
            const char* a3 = a2 + kstep;
            const char* b2 = last ? PG8_BP(nxt, 0) : PG8_BP(cur, t + 2);
            const char* b3 = last ? PG8_BP(nxt, 1) : PG8_BP(cur, t + 3);
            const unsigned s00 = last ? n00 : c00, s01 = last ? n01 : c01, s10 = last ? n10 : c10, s11 = last ? n11 : c11;
            if constexpr (Epi::MIDSCALE) { if (t == ks) E.midscale(acc, cur, wr, wc, fr, fq); }
            PG8_LDB(B0, 0, 0); PG8_SCHED; PG8_LDA(At, 0, 0); PG8_STAGE2(PG8_SA(1, 1), a1, c10, c11);
            PG8_WAIT_L(8); PG8_BAR; PG8_WAIT_L(0); PG8_MMA(0, 0, At, B0); PG8_BAR; PG8_SCHED;
            PG8_LDB(B1, 0, 1); PG8_STAGE2(PG8_SB(0, 0), b2, voffB[0], voffB[1]);
            PG8_BAR; PG8_WAIT_L(0); PG8_MMA(0, 1, At, B1); PG8_BAR;
            PG8_LDA(At, 0, 1); PG8_STAGE2(PG8_SA(0, 0), a2, s00, s01);
            PG8_BAR; PG8_WAIT_L(0); PG8_MMA(1, 0, At, B0); PG8_BAR; PG8_SCHED;
            PG8_STAGE2(PG8_SB(0, 1), b2 + hstepB, voffB[0], voffB[1]);
            PG8_WAIT_V(6); PG8_BAR; PG8_MMA(1, 1, At, B1); PG8_BAR;
            PG8_LDB(B0, 1, 0); PG8_SCHED; PG8_LDA(At, 1, 0); PG8_STAGE2(PG8_SA(0, 1), a2, s10, s11);
            PG8_WAIT_L(8); PG8_BAR; PG8_WAIT_L(0); PG8_MMA(0, 0, At, B0); PG8_BAR; PG8_SCHED;
            PG8_LDB(B1, 1, 1); PG8_STAGE2(PG8_SB(1, 0), b3, voffB[0], voffB[1]);
            PG8_BAR; PG8_WAIT_L(0); PG8_MMA(0, 1, At, B1); PG8_BAR;
            PG8_LDA(At, 1, 1); PG8_STAGE2(PG8_SA(1, 0), a3, s00, s01);
            PG8_BAR; PG8_WAIT_L(0); PG8_MMA(1, 0, At, B0); PG8_BAR; PG8_SCHED;
            PG8_STAGE2(PG8_SB(1, 1), b3 + hstepB, voffB[0], voffB[1]);
            PG8_WAIT_V(6); PG8_BAR; PG8_MMA(1, 1, At, B1); PG8_BAR;
        }
        E(acc, cur, wr, wc, fr, fq);
        if (!has_next) break;
        asm volatile("v_mov_b32 %0, 0" : "=v"(zr));
#pragma unroll
        for (int a = 0; a < 2; ++a)
#pragma unroll
            for (int b = 0; b < 2; ++b)
#pragma unroll
                for (int m = 0; m < 4; ++m)
#pragma unroll
                    for (int n = 0; n < 2; ++n) acc[a][b][m][n] = (f32x4){zr, zr, zr, zr};
        cur = nxt; cA = nA; ++ui; c00 = n00; c01 = n01; c10 = n10; c11 = n11;
    }
    PG8_WAIT_V(0);
    if (wr == 0) PG8_BAR;
    PG8_BAR;
#undef PG8_SA
#undef PG8_SB
#undef PG8_STAGE2
#undef PG8_LDA
#undef PG8_LDB
#undef PG8_MMA
#undef PG8_WAIT_V
#undef PG8_WAIT_L
#undef PG8_BAR
#undef PG8_SCHED
#undef PG8_BP
}

struct DenseSched {
    const char* A; const char* Bt; int lda, ldb, K; int nM, nN, nwg, G, c, skipctx;
    __device__ __forceinline__ void init(const void* A_, const void* Bt_, int M, int N, int K_, int lda_, int ldb_, int G_, int c_, int skipctx_ = 0) {
        A = (const char*)A_; Bt = (const char*)Bt_; lda = lda_; ldb = ldb_; K = K_; nM = M / BM - 2 * skipctx_; nN = N / BM; nwg = nM * nN; G = G_; c = c_; skipctx = skipctx_; }
    __device__ __forceinline__ bool get(int i, Unit& u) const {
        const long L = (long)i * G + c; if (L >= nwg) return false;
        int wgid = (int)L; { const int q = nwg / NXCD, r = nwg % NXCD, xcd = wgid % NXCD, off = wgid / NXCD; wgid = (xcd < r ? xcd * (q + 1) : r * (q + 1) + (xcd - r) * q) + off; }
        const int nig = WGM * nN, gid = wgid / nig, fm = gid * WGM, gsz = (nM - fm) < WGM ? (nM - fm) : WGM;
        int pm = fm + ((wgid % nig) % gsz); const int pn = (wgid % nig) / gsz;
        if (skipctx) pm += 1 + (pm >= 64 ? 1 : 0);
        u.a0 = A + (size_t)pm * BM * lda * 2; u.b0 = Bt + (size_t)pn * BM * ldb * 2; u.b1 = u.b0 + (size_t)(K / BK / 2) * BK * 2;
        u.i0 = pm; u.i1 = pn; u.i2 = 0; u.i3 = 0; u.i4 = 0; u.pad = 0; return true;
    }
    __device__ __forceinline__ int arow(const Unit&, int rl) const { return rl; }
};
}

struct EpiProj {
    static constexpr bool PERM = true, MIDSCALE = false;
    bf16_t* O;
    __device__ __forceinline__ void operator()(const f32x4 (&acc)[2][2][4][2], const pg8::Unit& u, int wr, int wc, int fr, int fq) const {
        const int row0 = u.i0 * 256 + wr * 64 + fr, col0 = u.i1 * 256 + wc * 32 + 8 * fq;
#pragma unroll
        for (int ai = 0; ai < 2; ++ai)
#pragma unroll
            for (int m = 0; m < 4; ++m) { bf16_t* rowp = O + (size_t)(row0 + ai * 128 + m * 16) * NPROJ + col0;
#pragma unroll
                for (int bj = 0; bj < 2; ++bj) { const f32x4 v0 = acc[ai][bj][m][0], v1 = acc[ai][bj][m][1];
                    u32x4 w; w.x = cvt_pk_bf16(v0[0], v0[1]); w.y = cvt_pk_bf16(v0[2], v0[3]); w.z = cvt_pk_bf16(v1[0], v1[1]); w.w = cvt_pk_bf16(v1[2], v1[3]);
                    *(u32x4*)(rowp + bj * 128) = w; } }
    }
};
struct EpiResid {
    static constexpr bool PERM = false, MIDSCALE = true;
    const float* inc; const float* inx; float* hc; float* out; const float* modl; const float* ssq;
    __device__ __forceinline__ void midscale(f32x4 (&acc)[2][2][4][2], const pg8::Unit& u, int wr, int wc, int fr, int fq) const {
        const int r0 = u.i0 * 256 + wr * 64 + fr;
#pragma unroll
        for (int ai = 0; ai < 2; ++ai)
#pragma unroll
            for (int m = 0; m < 4; ++m) { const float* sp = ssq + (size_t)(r0 + ai * 128 + m * 16) * 8;
                const f32x4 a = *(const f32x4*)sp, b = *(const f32x4*)(sp + 4);
                const float rs = rsqrtf(((a[0] + a[1]) + (a[2] + a[3]) + (b[0] + b[1]) + (b[2] + b[3])) * (1.f / 512.f) + 1e-6f);
#pragma unroll
                for (int bj = 0; bj < 2; ++bj)
#pragma unroll
                    for (int n = 0; n < 2; ++n) acc[ai][bj][m][n] *= rs;
                asm volatile("" ::: "memory"); }
    }
    __device__ __forceinline__ void operator()(const f32x4 (&acc)[2][2][4][2], const pg8::Unit& u, int wr, int wc, int fr, int fq) const {
        const int r0 = u.i0 * 256;
        const int v = row_v(r0);
        const float* gate = modl + (size_t)v * 6144 + 2 * 1024;
        const float* hin = hptr2((float*)inc, (float*)inx, r0); float* hout = hptr2(hc, out, r0);
        const int rl0 = wr * 64 + fr, col0 = u.i1 * 256 + wc * 32 + 4 * fq;
        f32x4 gv[2][2];
#pragma unroll
        for (int bj = 0; bj < 2; ++bj)
#pragma unroll
            for (int n = 0; n < 2; ++n) gv[bj][n] = *(const f32x4*)(gate + col0 + bj * 128 + n * 16);
#pragma unroll
        for (int ai = 0; ai < 2; ++ai)
#pragma unroll
            for (int m = 0; m < 4; ++m) { const size_t off = (size_t)(rl0 + ai * 128 + m * 16) * D + col0;
#pragma unroll
                for (int bj = 0; bj < 2; ++bj)
#pragma unroll
                    for (int n = 0; n < 2; ++n) { const f32x4 hi = *(const f32x4*)(hin + off + bj * 128 + n * 16);
                        *(f32x4*)(hout + off + bj * 128 + n * 16) = hi + gv[bj][n] * acc[ai][bj][m][n]; }
                if (m & 1) asm volatile("" ::: "memory"); }
    }
};

struct MoeSched {
    const LAS int* tab;
    const int* list;
    const char* A; const char* W; int mode  , l, G, c;
    __device__ __forceinline__ bool get(int i, pg8::Unit& u) const {
        const int L = i * G + c; const int total = __builtin_amdgcn_readfirstlane(tab[24]) * 4; if (L >= total) return false;
        const int tl = L >> 2, pn = L & 3;
        int cls = 0;
#pragma unroll 1
        for (int q = 1; q < NCLS; ++q) { const int tq = __builtin_amdgcn_readfirstlane(tab[q]); if (tq <= tl) cls = q; }
        const int j = tl - __builtin_amdgcn_readfirstlane(tab[cls]), cnt = __builtin_amdgcn_readfirstlane(tab[32 + cls]);
        const int g = cls / 6, pidx = cls - g * 6;
        const int ea = (pidx >= 3) + (pidx >= 5), eb = pidx < 3 ? pidx + 1 : (pidx < 5 ? pidx - 1 : 3);
        if (mode == 0) {
            const int e = 4 * g + (pn < 2 ? ea : eb);
            u.a0 = A;
            u.b0 = W + ((size_t)(l * 16 + e) * 512 + (size_t)(pn & 1) * 256) * 1024 * 2; u.b1 = u.b0 + (size_t)8 * 128;
        } else {
            u.a0 = A + (size_t)tl * 256 * 512 * 2;
            u.b0 = W + ((size_t)(l * 16 + 4 * g + ea) * 1024 + (size_t)pn * 256) * 256 * 2;
            u.b1 = W + ((size_t)(l * 16 + 4 * g + eb) * 1024 + (size_t)pn * 256) * 256 * 2;
        }
        u.i0 = cls; u.i1 = j; u.i2 = pn; u.i3 = cnt; u.i4 = tl; u.pad = 0; return true;
    }
    __device__ __forceinline__ int arow(const pg8::Unit& u, int rl) const {
        int idx = u.i1 * 256 + rl; idx = idx < u.i3 ? idx : u.i3 - 1;
        return list[(size_t)u.i0 * R + idx];
    }
};
struct EpiUp {
    static constexpr bool PERM = true, MIDSCALE = false;
    bf16_t* hid; const float* cwla; const float* cwlb;
    __device__ __forceinline__ void operator()(const f32x4 (&acc)[2][2][4][2], const pg8::Unit& u, int wr, int wc, int fr, int fq) const {
        const int cls = u.i0, j = u.i1, pn = u.i2, cnt = u.i3, tl = u.i4;
        const float* cw = (pn < 2) ? cwla : cwlb;
        const int colbase = (pn >> 1) * 256 + (pn & 1) * 128 + wc * 32 + 8 * fq;
#pragma unroll
        for (int ai = 0; ai < 2; ++ai)
#pragma unroll
            for (int m = 0; m < 4; ++m) {
                const int rl = ai * 128 + wr * 64 + m * 16 + fr; const int idx = j * 256 + rl; const bool valid = idx < cnt;
                float w = 0.f; if (valid) w = cw[(size_t)cls * R + idx];
                const f32x4 g0 = acc[ai][0][m][0], g1 = acc[ai][0][m][1], u0 = acc[ai][1][m][0], u1 = acc[ai][1][m][1];
                float o[8];
#pragma unroll
                for (int e = 0; e < 4; ++e) { o[e] = w * siluf_(g0[e]) * u0[e]; o[4 + e] = w * siluf_(g1[e]) * u1[e]; }
                if (!valid) {
#pragma unroll
                    for (int e = 0; e < 8; ++e) o[e] = 0.f; }
                u32x4 pk; pk.x = cvt_pk_bf16(o[0], o[1]); pk.y = cvt_pk_bf16(o[2], o[3]); pk.z = cvt_pk_bf16(o[4], o[5]); pk.w = cvt_pk_bf16(o[6], o[7]);
                *(u32x4*)(hid + ((size_t)tl * 256 + rl) * 512 + colbase) = pk;
                asm volatile("" ::: "memory");
            }
    }
};
struct EpiY {
    static constexpr bool PERM = true, MIDSCALE = false;
    bf16_t* Y;
    __device__ __forceinline__ void operator()(const f32x4 (&acc)[2][2][4][2], const pg8::Unit& u, int wr, int wc, int fr, int fq) const {
        const int row0 = u.i4 * 256 + wr * 64 + fr, col0 = u.i2 * 256 + wc * 32 + 8 * fq;
#pragma unroll
        for (int ai = 0; ai < 2; ++ai)
#pragma unroll
            for (int m = 0; m < 4; ++m) { bf16_t* rowp = Y + (size_t)(row0 + ai * 128 + m * 16) * 1024 + col0;
#pragma unroll
                for (int bj = 0; bj < 2; ++bj) { const f32x4 v0 = acc[ai][bj][m][0], v1 = acc[ai][bj][m][1];
                    u32x4 w; w.x = cvt_pk_bf16(v0[0], v0[1]); w.y = cvt_pk_bf16(v0[2], v0[3]); w.z = cvt_pk_bf16(v1[0], v1[1]); w.w = cvt_pk_bf16(v1[2], v1[3]);
                    *(u32x4*)(rowp + bj * 128) = w; } }
    }
};

__device__ __forceinline__ void tr_tile(const float* src, int ldn, int k0, int n0, int nvalid, bf16_t* dst, int ldk, int drow0, float* tile, int kd0 = -1, const float* kscale = nullptr) {
    const int tid = launder_tid();
    if (kd0 < 0) kd0 = k0;
    { const int n = tid & 63; int kk = tid >> 6;
#pragma unroll
      for (int it = 0; it < 8; ++it, kk += 8) tile[kk * 65 + n] = (n < nvalid) ? src[(size_t)(k0 + kk) * ldn + n0 + n] * (kscale ? kscale[kk] : 1.f) : 0.f; }
    __syncthreads();
    { const int k8 = tid & 7, n = tid >> 3;
      if (n < nvalid) { const float* s = tile + (k8 * 8) * 65 + n;
          u32x4 o; o.x = cvt_pk_bf16(s[0], s[65]); o.y = cvt_pk_bf16(s[2 * 65], s[3 * 65]); o.z = cvt_pk_bf16(s[4 * 65], s[5 * 65]); o.w = cvt_pk_bf16(s[6 * 65], s[7 * 65]);
          *(u32x4*)(dst + (size_t)(drow0 + n) * ldk + kd0 + k8 * 8) = o; } }
    __syncthreads();
}
__device__ __forceinline__ void phase_wprep(CP p, unsigned char* lds, int bid, int nb) {
    float* tile = (float*)lds;
    constexpr int I_IN = 16 * 41, I_OUT = 256, I_G = 1024, I_U = 1024, I_D = 1024, I_L = I_IN + I_OUT + I_G + I_U + I_D;
    for (int it = bid; it < 2 * I_L; it += nb) {
        const int l = it / I_L; int r = it - l * I_L;
        if (r < I_IN) { const int kt = r / 41, ntl = r % 41; const int n0 = ntl * 64; const int nv = (DIN - n0) < 64 ? (DIN - n0) : 64;
            tr_tile(p->w_in + (size_t)l * 1024 * DIN, DIN, kt * 64, n0, nv, (bf16_t*)(p->ws + WS_WTIN) + (size_t)l * DIN * 1024, 1024, n0, tile); continue; }
        r -= I_IN;
        if (r < I_OUT) { const int kt = r >> 4, ntl = r & 15;
            tr_tile(p->w_out + (size_t)l * 1024 * 1024, 1024, kt * 64, ntl * 64, 64, (bf16_t*)(p->ws + WS_WTOUT) + (size_t)l * 1024 * 1024, 1024, ntl * 64, tile,
                    (kt * 64 + 512) & 1023, kt >= 8 ? p->ssd_norm_g + l * 512 + (kt * 64 - 512) : nullptr); continue; }
        r -= I_OUT;
        if (r < I_G + I_U) { const int up = r >= I_G; if (up) r -= I_G; const int e = r >> 6, q = r & 63, kt = q >> 2, ntl = q & 3; const int n0 = ntl * 64;
            const float* src = (up ? p->w_up : p->w_gate) + (size_t)(l * 16 + e) * 1024 * 256;
            tr_tile(src, 256, kt * 64, n0, 64, (bf16_t*)(p->ws + WS_WTGU) + (size_t)(l * 16 + e) * 512 * 1024, 1024, (n0 >> 7) * 256 + (n0 & 127) + (up ? 128 : 0), tile); continue; }
        r -= I_G + I_U;
        { const int e = r >> 6, q = r & 63, kt = q >> 4, ntl = q & 15;
          tr_tile(p->w_down + (size_t)(l * 16 + e) * 256 * 1024, 1024, kt * 64, ntl * 64, 64, (bf16_t*)(p->ws + WS_WTD) + (size_t)(l * 16 + e) * 1024 * 256, 256, ntl * 64, tile); }
    }
}
__device__ __forceinline__ void phase_adaln(CP p, unsigned char* lds, int bid, int nb) {
    float* sc = (float*)lds;
    float* red = sc + 3 * 1024;
    const int tid = launder_tid();
    for (int idx = tid; idx < 3 * 1024; idx += NTHREADS) { const int v = idx >> 10, k = idx & 1023; const float cv = (v < 2) ? p->c[v * 1024 + k] : p->c_ctx[k]; sc[idx] = siluf_(cv); }
    __syncthreads();
    float* mod = (float*)(p->ws + WS_MOD);
    for (int it = bid; it < 2 * 96; it += nb) {
        const int l = it / 96, n0 = (it % 96) * 64;
        const int c4 = tid & 15, kr = tid >> 4;
        f32x4 a0 = {0, 0, 0, 0}, a1 = {0, 0, 0, 0}, a2 = {0, 0, 0, 0};
        const float* w = p->w_ada + (size_t)l * 1024 * 6144 + n0 + c4 * 4;
#pragma unroll 4
        for (int k = kr; k < 1024; k += 32) { const f32x4 w4 = *(const f32x4*)(w + (size_t)k * 6144); a0 += sc[k] * w4; a1 += sc[1024 + k] * w4; a2 += sc[2048 + k] * w4; }
        *(f32x4*)(red + (kr * 3 + 0) * 64 + c4 * 4) = a0; *(f32x4*)(red + (kr * 3 + 1) * 64 + c4 * 4) = a1; *(f32x4*)(red + (kr * 3 + 2) * 64 + c4 * 4) = a2;
        __syncthreads();
        if (tid < 192) { const int v = tid >> 6, cc = tid & 63; float s = 0.f;
            for (int q = 0; q < 32; ++q) s += red[(q * 3 + v) * 64 + cc];
            mod[((size_t)l * 3 + v) * 6144 + n0 + cc] = s + p->b_ada[l * 6144 + n0 + cc]; }
        __syncthreads();
    }
}
__device__ __forceinline__ void moe_table(CP p, int l, LAS int* tab) {
    const int* gcount = (const int*)(p->ws + WS_CTL) + l * 32;
    if (threadIdx.x == 0) { int acc = 0; for (int q = 0; q < NCLS; ++q) { const int cn = gcount[q]; tab[q] = acc; tab[32 + q] = cn; acc += (cn + 255) >> 8; } tab[24] = acc; }
    __syncthreads();
}
__device__ __forceinline__ void moe_apply(CP p, int lm, int r, int v, int lane, const LAS int* tab, f32x4 (&xv)[4]) {
    const int pos = ((const int*)(p->ws + WS_POS))[(size_t)lm * R + r];
    const int slot = tab[pos >> 16] * 256 + (pos & 0xffff);
    const bf16_t* y = (const bf16_t*)(p->ws + WS_Y) + (size_t)slot * 1024;
    const float* gate = (const float*)(p->ws + WS_MOD) + ((size_t)lm * 3 + v) * 6144 + 5 * 1024;
#pragma unroll
    for (int j = 0; j < 4; ++j) { const int k = 4 * lane + 256 * j; const u32x2 yv = *(const u32x2*)(y + k); const f32x4 g4 = *(const f32x4*)(gate + k);
        xv[j][0] += g4[0] * bflo(yv.x); xv[j][1] += g4[1] * bfhi(yv.x); xv[j][2] += g4[2] * bflo(yv.y); xv[j][3] += g4[3] * bfhi(yv.y); }
}
__device__ __forceinline__ void phase_r1(CP p, int l, unsigned char* lds, int bid, int nb) {
    float* wdt = (float*)lds;
    float* gm = wdt + 16 * 1024;
    float* sh = gm + 3 * 1024;
    const int tid = launder_tid(); const int lane = tid & 63, wave = tid >> 6;
    const float* mod = (const float*)(p->ws + WS_MOD) + (size_t)l * 3 * 6144;
    const float* win = p->w_in + (size_t)l * 1024 * DIN;
    for (int idx = tid; idx < 16 * 1024; idx += NTHREADS) { const int k = idx >> 4, n = idx & 15; wdt[n * 1024 + k] = win[(size_t)k * DIN + NPROJ + n]; }
    for (int idx = tid; idx < 3 * 1024; idx += NTHREADS) { const int v = idx >> 10, k = idx & 1023; gm[idx] = p->g_mix[l * 1024 + k] * (1.f + mod[v * 6144 + 1024 + k]); sh[idx] = mod[v * 6144 + k]; }
    LAS int* tab = (LAS int*)((LAS unsigned char*)lds + MISC_OFF);
    if (l > 0) moe_table(p, l - 1, tab);
    __syncthreads();
    bf16_t* HX = (bf16_t*)(p->ws + WS_HX); float* DT = (float*)(p->ws + WS_DT);
    for (int r = bid * 8 + wave; r < R; r += nb * 8) {
        const f32x4* hr = (const f32x4*)hin_ptr(p, l, r); const int v = row_v(r);
        f32x4 xv[4]; float ss = 0.f;
#pragma unroll
        for (int j = 0; j < 4; ++j) xv[j] = hr[lane + 64 * j];
        if (l > 0) { moe_apply(p, l - 1, r, v, lane, tab, xv); f32x4* hw = (f32x4*)hptr(p, r);
#pragma unroll
            for (int j = 0; j < 4; ++j) hw[lane + 64 * j] = xv[j]; }
#pragma unroll
        for (int j = 0; j < 4; ++j) ss += xv[j][0] * xv[j][0] + xv[j][1] * xv[j][1] + xv[j][2] * xv[j][2] + xv[j][3] * xv[j][3];
        ss = wave_sum(ss); const float rs = rsqrtf(ss * (1.f / 1024.f) + 1e-6f);
#pragma unroll
        for (int j = 0; j < 4; ++j) { const int k = 4 * lane + 256 * j; const f32x4 g4 = *(const f32x4*)(gm + v * 1024 + k), s4 = *(const f32x4*)(sh + v * 1024 + k);
            xv[j] = xv[j] * rs * g4 + s4;
            u32x2 o; o.x = cvt_pk_bf16(xv[j][0], xv[j][1]); o.y = cvt_pk_bf16(xv[j][2], xv[j][3]);
            *(u32x2*)(HX + (size_t)r * 1024 + k) = o; }
        float mine = 0.f;
#pragma unroll
        for (int n = 0; n < 16; ++n) { float a = 0.f;
#pragma unroll
            for (int j = 0; j < 4; ++j) { const f32x4 w4 = *(const f32x4*)(wdt + n * 1024 + 4 * lane + 256 * j); a += xv[j][0] * w4[0] + xv[j][1] * w4[1] + xv[j][2] * w4[2] + xv[j][3] * w4[3]; }
            a = wave_sum(a); mine = (lane == n) ? a : mine; }
        if (lane < 16) DT[(size_t)r * 16 + lane] = softplusf_(mine + p->dt_bias[l * 16 + lane]);
    }
}
typedef float f32x16 __attribute__((ext_vector_type(16)));
typedef short s16x4 __attribute__((ext_vector_type(4)));
constexpr int ST_ROW = 272;
constexpr int ST_TR128 = 320;
constexpr int ST_TR64 = 192;
constexpr int NCHUNK = SEG / 128;

__device__ __forceinline__ float wave_incl_scan(float v, int lane) {
#pragma unroll
    for (int o = 1; o < 64; o <<= 1) { const float t = __shfl_up(v, o); if (lane >= o) v += t; }
    return v;
}
__device__ __forceinline__ bf16x8 row_frag(const LAS unsigned char* tile, int stride, int row0, int k0, int lane) {
    return *(const LAS bf16x8*)(tile + (row0 + (lane & 31)) * stride + (k0 + 8 * (lane >> 5)) * 2);
}
__device__ __forceinline__ bf16x8 tr_frag(const LAS unsigned char* tile, int stride, int k0, int c0, int lane) {
    const int g = lane >> 4, li = lane & 15, q = li >> 2, pp = li & 3;
    const LAS unsigned char* a0 = tile + (k0 + 8 * (g >> 1) + q) * stride + (c0 + 16 * (g & 1) + 4 * pp) * 2;
    const s16x4 lo = __builtin_amdgcn_ds_read_tr16_b64_v4i16((LAS s16x4*)a0);
    const s16x4 hi = __builtin_amdgcn_ds_read_tr16_b64_v4i16((LAS s16x4*)(a0 + 4 * stride));
    return __builtin_shufflevector(lo, hi, 0, 1, 2, 3, 4, 5, 6, 7);
}
__device__ __forceinline__ u32x4 pack8(const float (&v)[8]) { u32x4 r; r.x = cvt_pk_bf16(v[0], v[1]); r.y = cvt_pk_bf16(v[2], v[3]); r.z = cvt_pk_bf16(v[4], v[5]); r.w = cvt_pk_bf16(v[6], v[7]); return r; }
__device__ __forceinline__ u32x4 pack8s(const float (&v)[8], float sc) { u32x4 r; r.x = cvt_pk_bf16(v[0] * sc, v[1] * sc); r.y = cvt_pk_bf16(v[2] * sc, v[3] * sc); r.z = cvt_pk_bf16(v[4] * sc, v[5] * sc); r.w = cvt_pk_bf16(v[6] * sc, v[7] * sc); return r; }

__device__ __forceinline__ void conv_load(const bf16_t* proj, int row0, int rq, int xch, bool lo_ok, bool hi_ok, u32x4 (&raw)[8]) {
    const bf16_t* base = proj + (size_t)(row0 + 4 * rq) * NPROJ + 1536 + xch;
    unsigned zz; asm volatile("v_mov_b32 %0, 0" : "=v"(zz));
#pragma unroll
    for (int j = 0; j < 8; ++j) {
        if (j < 2) { const bool ok = (rq > 0) || lo_ok; const u32x4 v = *(const u32x4*)(ok ? base + (j - 2) * NPROJ : base);
            raw[j].x = ok ? v.x : zz; raw[j].y = ok ? v.y : zz; raw[j].z = ok ? v.z : zz; raw[j].w = ok ? v.w : zz; }
        else if (j >= 6) { const bool ok = (rq < 31) || hi_ok; const u32x4 v = *(const u32x4*)(ok ? base + (j - 2) * NPROJ : base);
            raw[j].x = ok ? v.x : zz; raw[j].y = ok ? v.y : zz; raw[j].z = ok ? v.z : zz; raw[j].w = ok ? v.w : zz; }
        else raw[j] = *(const u32x4*)(base + (j - 2) * NPROJ);
    }
}
__device__ __forceinline__ void conv_compute(const u32x4 (&raw)[8], const LAS float* wl, int nchl, int wch, float (&o)[4][8]) {
    float w[5][8], bs[8];
#pragma unroll
    for (int j = 0; j < 5; ++j) { const f32x4 w0 = *(const LAS f32x4*)(wl + j * nchl + wch), w1 = *(const LAS f32x4*)(wl + j * nchl + wch + 4);
        w[j][0] = w0[0]; w[j][1] = w0[1]; w[j][2] = w0[2]; w[j][3] = w0[3]; w[j][4] = w1[0]; w[j][5] = w1[1]; w[j][6] = w1[2]; w[j][7] = w1[3]; }
    { const f32x4 b0 = *(const LAS f32x4*)(wl + 5 * nchl + wch), b1 = *(const LAS f32x4*)(wl + 5 * nchl + wch + 4); bs[0] = b0[0]; bs[1] = b0[1]; bs[2] = b0[2]; bs[3] = b0[3]; bs[4] = b1[0]; bs[5] = b1[1]; bs[6] = b1[2]; bs[7] = b1[3]; }
#pragma unroll
    for (int i = 0; i < 4; ++i)
#pragma unroll
        for (int e = 0; e < 8; ++e) o[i][e] = bs[e];
#pragma unroll
    for (int j = 0; j < 8; ++j) {
        float xv[8] = {bflo(raw[j].x), bfhi(raw[j].x), bflo(raw[j].y), bfhi(raw[j].y), bflo(raw[j].z), bfhi(raw[j].z), bflo(raw[j].w), bfhi(raw[j].w)};
#pragma unroll
        for (int i = 0; i < 4; ++i) { const int tap = j - i; if (tap >= 0 && tap < 5) {
#pragma unroll
                for (int e = 0; e < 8; ++e) o[i][e] += w[tap][e] * xv[e]; } }
    }
#pragma unroll
    for (int i = 0; i < 4; ++i)
#pragma unroll
        for (int e = 0; e < 8; ++e) o[i][e] = siluf_(o[i][e]);
}
__device__ __forceinline__ void head_cums(CP p, int l, int row0, int h, int dir, int lane, LAS float* hv) {
    const float A = -expf(p->a_log[l * 16 + dir * 8 + h]);
    const float* DT = (const float*)(p->ws + WS_DT);
    const float d0 = DT[(size_t)(row0 + 2 * lane) * 16 + dir * 8 + h], d1 = DT[(size_t)(row0 + 2 * lane + 1) * 16 + dir * 8 + h];
    const float x0 = d0 * A, x1 = d1 * A;
    const float incl = wave_incl_scan(x0 + x1, lane);
    const float total = __shfl(incl, 63);
    float c0, c1;
    if (dir == 0) { c1 = incl; c0 = incl - x1; } else { c0 = total - (incl - x1 - x0); c1 = total - (incl - x1); }
    hv[dir * 128 + 2 * lane] = c0; hv[dir * 128 + 2 * lane + 1] = c1;
    hv[256 + dir * 128 + 2 * lane] = d0; hv[256 + dir * 128 + 2 * lane + 1] = d1;
    if (lane == 0) hv[512 + dir] = total;
}
__device__ __forceinline__ bf16x8 scale_frag(bf16x8 f, const f32x4 w0, const f32x4 w1) {
    const u32x4 u = __builtin_bit_cast(u32x4, f);
    u32x4 r;
    r.x = cvt_pk_bf16(bflo(u.x) * w0[0], bfhi(u.x) * w0[1]); r.y = cvt_pk_bf16(bflo(u.y) * w0[2], bfhi(u.y) * w0[3]);
    r.z = cvt_pk_bf16(bflo(u.z) * w1[0], bfhi(u.z) * w1[1]); r.w = cvt_pk_bf16(bflo(u.w) * w1[2], bfhi(u.w) * w1[3]);
    return __builtin_bit_cast(bf16x8, r);
}
constexpr int ST_X256 = 576;

__device__ __forceinline__ void phase_c1(CP p, int l, unsigned char* lds_, int bid, int nb) {
    LAS unsigned char* lds = (LAS unsigned char*)lds_;
    LAS unsigned char* tile = lds;
    LAS float* wl = (LAS float*)(lds + 73216);
    const int tid = launder_tid();
    const bf16_t* proj = (const bf16_t*)(p->ws + WS_PROJ); bf16_t* mix = (bf16_t*)(p->ws + WS_HX);
#pragma unroll 1
    for (int u = bid; u < 256 + 512 + (l == DEPTH - 1 ? 0 : 16); u += nb) {
        int S, LEN, pstride, sstride, tok0, ch0;
        if (u < 256) { const int b = u >> 7, cs = (u >> 2) & 31, cc = u & 3; S = 2; LEN = 256; pstride = 64; sstride = 1; tok0 = b * SEG + CTXL + 2 * cs; ch0 = 256 + 64 * cc; }
        else if (u < 768) { const int v = u - 256; const int b = v >> 8, rg = (v >> 2) & 63, cc = v & 3; S = 4; LEN = 64; pstride = 1; sstride = 64; tok0 = b * SEG + CTXL + 256 * rg; ch0 = 64 * cc; }
        else { const int v = u - 768; const int b = v >> 3, cc = v & 7; S = 1; LEN = 256; pstride = 1; sstride = 0; tok0 = b * SEG; ch0 = 64 * cc; }
        const int LP = LEN + 30;
        for (int i = tid; i < 32 * 64; i += NTHREADS) { const int j = i >> 6, c = i & 63; wl[i] = j < 31 ? p->conv_w[((size_t)l * 31 + j) * 512 + ch0 + c] : p->conv_b[l * 512 + ch0 + c]; }
        for (int i = tid; i < S * 30 * 8; i += NTHREADS) { const int pc = i & 7, q = (i >> 3) % 30, sq = (i >> 3) / 30; const int pos = q < 15 ? q : LEN + q;
            unsigned zz; asm volatile("v_mov_b32 %0, 0" : "=v"(zz));
            *(LAS u32x4*)(tile + ((sq * LP + pos) * 64 + pc * 8) * 2) = (u32x4){zz, zz, zz, zz}; }
#pragma unroll 4
        for (int i = tid; i < S * LEN * 8; i += NTHREADS) { const int pc = i & 7, t = i >> 3; const int sq = t / LEN, pos = t - sq * LEN;
            const bf16_t* src = proj + (size_t)(tok0 + sq * sstride + pos * pstride) * NPROJ + ch0 + pc * 8;
            const u32x4 uv = *(const u32x4*)src, gv = *(const u32x4*)(src + 512);
            u32x4 o;
            o.x = cvt_pk_bf16(bflo(uv.x) * sigmoidf_(bflo(gv.x)), bfhi(uv.x) * sigmoidf_(bfhi(gv.x)));
            o.y = cvt_pk_bf16(bflo(uv.y) * sigmoidf_(bflo(gv.y)), bfhi(uv.y) * sigmoidf_(bfhi(gv.y)));
            o.z = cvt_pk_bf16(bflo(uv.z) * sigmoidf_(bflo(gv.z)), bfhi(uv.z) * sigmoidf_(bfhi(gv.z)));
            o.w = cvt_pk_bf16(bflo(uv.w) * sigmoidf_(bflo(gv.w)), bfhi(uv.w) * sigmoidf_(bfhi(gv.w)));
            *(LAS u32x4*)(tile + ((sq * LP + 15 + pos) * 64 + pc * 8) * 2) = o; }
        __syncthreads();
        const int noct = S * LEN / 8;
#pragma unroll 1
        for (int it = tid; it < noct * 32; it += NTHREADS) {
            const int cp = it & 31, oc = it >> 5; const int sq = oc / (LEN / 8), p0 = (oc - sq * (LEN / 8)) * 8;
            const LAS unsigned* base = (const LAS unsigned*)(tile + ((sq * LP + p0) * 64) * 2) + cp;
            float i0[38], i1[38];
#pragma unroll
            for (int k = 0; k < 38; ++k) { const unsigned w = base[k * 32]; i0[k] = bflo(w); i1[k] = bfhi(w); }
            float a0[8], a1[8];
            { const float b0 = wl[31 * 64 + 2 * cp], b1 = wl[31 * 64 + 2 * cp + 1];
#pragma unroll
              for (int i = 0; i < 8; ++i) { a0[i] = b0; a1[i] = b1; } }
#pragma unroll
            for (int j = 0; j < 31; ++j) { typedef float f32x2 __attribute__((ext_vector_type(2))); const f32x2 wj = *(const LAS f32x2*)(wl + j * 64 + 2 * cp); const float w0 = wj[0], w1 = wj[1];
#pragma unroll
                for (int i = 0; i < 8; ++i) { a0[i] += w0 * i0[i + j]; a1[i] += w1 * i1[i + j]; } }
#pragma unroll
            for (int i = 0; i < 8; ++i) { const int tok = tok0 + sq * sstride + (p0 + i) * pstride;
                *(unsigned*)(mix + (size_t)tok * 1024 + 512 + ch0 + 2 * cp) = cvt_pk_bf16(a0[i], a1[i]); }
        }
        __syncthreads();
    }
}
__device__ __forceinline__ void phase_c1_ln(CP p, int l, int bid, int nb) {
    const int tid = launder_tid(); const int lane = tid & 63, wave = tid >> 6;
    bf16_t* mix = (bf16_t*)(p->ws + WS_HX);
    const f32x4 g0 = *(const f32x4*)(p->conv_ln_g + l * 512 + lane * 8), g1 = *(const f32x4*)(p->conv_ln_g + l * 512 + lane * 8 + 4);
    const f32x4 b0 = *(const f32x4*)(p->conv_ln_b + l * 512 + lane * 8), b1 = *(const f32x4*)(p->conv_ln_b + l * 512 + lane * 8 + 4);
    const float gg[8] = {g0[0], g0[1], g0[2], g0[3], g1[0], g1[1], g1[2], g1[3]}, bb[8] = {b0[0], b0[1], b0[2], b0[3], b1[0], b1[1], b1[2], b1[3]};
    for (int r = bid * 8 + wave; r < R; r += nb * 8) {
        u32x4* ptr = (u32x4*)(mix + (size_t)r * 1024 + 512 + lane * 8);
        const u32x4 v = *ptr;
        float y[8] = {bflo(v.x), bfhi(v.x), bflo(v.y), bfhi(v.y), bflo(v.z), bfhi(v.z), bflo(v.w), bfhi(v.w)};
        float s = 0.f;
#pragma unroll
        for (int e = 0; e < 8; ++e) s += y[e];
        const float mu = wave_sum(s) * (1.f / 512.f);
        float q = 0.f;
#pragma unroll
        for (int e = 0; e < 8; ++e) { y[e] -= mu; q += y[e] * y[e]; }
        const float rstd = rsqrtf(wave_sum(q) * (1.f / 512.f) + 1e-5f);
        float o[8];
#pragma unroll
        for (int e = 0; e < 8; ++e) o[e] = siluf_(y[e] * rstd * gg[e] + bb[e]);
        *ptr = pack8(o);
    }
}
__device__ __forceinline__ void phase_s1(CP p, int l, unsigned char* lds_, int bid, int nb) {
    LAS unsigned char* lds = (LAS unsigned char*)lds_;
    LAS unsigned char* Bs = lds;
    LAS unsigned char* Xs = lds + 128 * ST_TR128;
    LAS float* wv = (LAS float*)(Xs + 128 * ST_X256);
    LAS float* hvs = wv + 8 * 128;
    LAS float* cwl = hvs + 4 * 520;
    const int tid = launder_tid(); const int lane = tid & 63, wave = __builtin_amdgcn_readfirstlane(tid >> 6);
    const bf16_t* proj = (const bf16_t*)(p->ws + WS_PROJ);
    const float* cw = p->ssd_conv_w + (size_t)l * 5 * 1024; const float* cbias = p->ssd_conv_b + (size_t)l * 1024;
    float* Sg = (float*)(p->ws + WS_S); float* DEC = (float*)(p->ws + WS_DEC);
    int cur_g = -1;
#pragma unroll 1
    for (int u = bid; u < NB * NCHUNK * 2; u += nb) {
        const int g = u & 1, c = (u >> 1) % NCHUNK, b = (u >> 1) / NCHUNK;
        const int row0 = b * SEG + c * 128;
        const bool lo_ok = !(c == 0 || c == 2), hi_ok = !(c == 1 || c == NCHUNK - 1);
        if (g != cur_g) { cur_g = g;
            for (int i = tid; i < 6 * 384; i += NTHREADS) { const int j = i / 384, lc = i - j * 384; const int gch = lc < 128 ? 512 + g * 128 + lc : g * 256 + (lc - 128);
                cwl[i] = j < 5 ? cw[j * 1024 + gch] : cbias[gch]; } }
        const int hh = wave >> 1, dir = wave & 1, h = 4 * g + hh;
        u32x4 rb[8], rx0[8], rx1[8];
        conv_load(proj, row0, tid >> 4, 512 + g * 128 + (tid & 15) * 8, lo_ok, hi_ok, rb);
        conv_load(proj, row0, tid >> 5, g * 256 + (tid & 31) * 8, lo_ok, hi_ok, rx0);
        conv_load(proj, row0, (tid >> 5) + 16, g * 256 + (tid & 31) * 8, lo_ok, hi_ok, rx1);
        head_cums(p, l, row0, h, dir, lane, hvs + hh * 520);
        __syncthreads();
        {
            const LAS float* hv = hvs + hh * 520; const float tot = hv[512 + dir];
#pragma unroll
            for (int q = 0; q < 2; ++q) { const int lr = lane + 64 * q; wv[wave * 128 + lr] = __expf(tot - hv[dir * 128 + lr]) * hv[256 + dir * 128 + lr]; }
            if (lane == 0) DEC[((size_t)(b * 2 + dir) * NCHUNK + c) * 8 + h] = __expf(tot);
        }
        { float o[4][8];
          conv_compute(rb, cwl, 384, (tid & 15) * 8, o);
#pragma unroll
          for (int i = 0; i < 4; ++i) *(LAS u32x4*)(Bs + (4 * (tid >> 4) + i) * ST_TR128 + (tid & 15) * 16) = pack8(o[i]);
          conv_compute(rx0, cwl, 384, 128 + (tid & 31) * 8, o);
#pragma unroll
          for (int i = 0; i < 4; ++i) *(LAS u32x4*)(Xs + (4 * (tid >> 5) + i) * ST_X256 + (tid & 31) * 16) = pack8(o[i]);
          conv_compute(rx1, cwl, 384, 128 + (tid & 31) * 8, o);
#pragma unroll
          for (int i = 0; i < 4; ++i) *(LAS u32x4*)(Xs + (4 * ((tid >> 5) + 16) + i) * ST_X256 + (tid & 31) * 16) = pack8(o[i]); }
        __syncthreads();
        {
            f32x16 acc[2][4];
#pragma unroll
            for (int t = 0; t < 2; ++t)
#pragma unroll
                for (int q = 0; q < 4; ++q)
#pragma unroll
                    for (int e = 0; e < 16; ++e) acc[t][q][e] = 0.f;
#pragma unroll 2
            for (int kk = 0; kk < 8; ++kk) {
                const LAS float* wp = wv + wave * 128 + 16 * kk + 8 * (lane >> 5);
                const f32x4 w0 = *(const LAS f32x4*)wp, w1 = *(const LAS f32x4*)(wp + 4);
                bf16x8 af[2];
#pragma unroll
                for (int t = 0; t < 2; ++t) af[t] = scale_frag(tr_frag(Xs, ST_X256, 16 * kk, hh * 64 + 32 * t, lane), w0, w1);
#pragma unroll
                for (int q = 0; q < 4; ++q) { const bf16x8 bf = tr_frag(Bs, ST_TR128, 16 * kk, 32 * q, lane);
#pragma unroll
                    for (int t = 0; t < 2; ++t) acc[t][q] = __builtin_amdgcn_mfma_f32_32x32x16_bf16(af[t], bf, acc[t][q], 0, 0, 0); }
            }
            float* So = Sg + ((size_t)((b * 2 + dir) * NCHUNK + c) * 8 + h) * 8192 + (lane & 31);
#pragma unroll
            for (int t = 0; t < 2; ++t)
#pragma unroll
                for (int q = 0; q < 4; ++q)
#pragma unroll
                    for (int e = 0; e < 16; ++e) { const int pr = 32 * t + (e & 3) + 8 * (e >> 2) + 4 * (lane >> 5); So[(size_t)pr * 128 + 32 * q] = acc[t][q][e]; }
        }
        __syncthreads();
    }
}
__device__ __forceinline__ void phase_s2(CP p, int bid, int nb) {
    const int tid = launder_tid();
    const float* Sg = (const float*)(p->ws + WS_S); const float* DEC = (const float*)(p->ws + WS_DEC); bf16_t* HP = (bf16_t*)(p->ws + WS_HP);
    for (int idx = bid * NTHREADS + tid; idx < 2 * 2 * 8 * 64 * 64; idx += nb * NTHREADS) {
        const int n2 = idx & 63, pr = (idx >> 6) & 63, h = (idx >> 12) & 7, dir = (idx >> 15) & 1, b = idx >> 16;
        const size_t inner = (size_t)h * 8192 + pr * 128 + 2 * n2;
        const size_t cbase = (size_t)(b * 2 + dir) * NCHUNK;
        float s0 = 0.f, s1 = 0.f;
#pragma unroll 5
        for (int step = 0; step < NCHUNK; ++step) {
            const int c = dir == 0 ? step : (step < 2 ? 1 - step : NCHUNK + 1 - step);
            const size_t off = (cbase + c) * 65536 + inner;
            const float2 sv = *(const float2*)(Sg + off); const float d = DEC[(cbase + c) * 8 + h];
            *(unsigned*)(HP + off) = cvt_pk_bf16(s0, s1);
            s0 = s0 * d + sv.x; s1 = s1 * d + sv.y;
        }
    }
}
__device__ __forceinline__ void phase_s3(CP p, int l, unsigned char* lds_, int bid, int nb) {
    LAS unsigned char* lds = (LAS unsigned char*)lds_;
    LAS unsigned char* Cs = lds;
    LAS unsigned char* Bs = Cs + 128 * ST_ROW;
    LAS unsigned char* Mt = Bs;
    LAS unsigned char* Xs = Bs + 128 * ST_TR128;
    LAS unsigned char* Hf = Xs + 128 * ST_TR64;
    LAS unsigned char* Hb = Hf + 64 * ST_ROW;
    LAS float* hvs = (LAS float*)(Hb + 64 * ST_ROW);
    LAS float* ssqp = hvs + 4 * 520;
    LAS float* cwl = ssqp + 256;
    const int tid0 = launder_tid(); const int wave = __builtin_amdgcn_readfirstlane(tid0 >> 6);
    const bf16_t* proj = (const bf16_t*)(p->ws + WS_PROJ); bf16_t* mix = (bf16_t*)(p->ws + WS_HX);
    const float* cw = p->ssd_conv_w + (size_t)l * 5 * 1024; const float* cbias = p->ssd_conv_b + (size_t)l * 1024;
    const bf16_t* HP = (const bf16_t*)(p->ws + WS_HP); float* SSQ = (float*)(p->ws + WS_SSQ);
    int cur_g = -1;
#pragma unroll 1
    for (int u = bid; u < NB * NCHUNK * 2; u += nb) {
        const int g = u & 1, c = (u >> 1) % NCHUNK, b = (u >> 1) / NCHUNK;
        if (l == DEPTH - 1 && c < 2) continue;
        int tid = tid0; asm volatile("" : "+v"(tid));
        const int lane = tid & 63;
        const int row0 = b * SEG + c * 128;
        const bool lo_ok = !(c == 0 || c == 2), hi_ok = !(c == 1 || c == NCHUNK - 1);
        if (g != cur_g) { cur_g = g;
            for (int i = tid; i < 6 * 512; i += NTHREADS) { const int j = i >> 9, lc = i & 511; const int gch = lc < 128 ? 768 + g * 128 + lc : (lc < 256 ? 512 + g * 128 + (lc - 128) : g * 256 + (lc - 256));
                cwl[i] = j < 5 ? cw[j * 1024 + gch] : cbias[gch]; } }
        u32x4 rx[8];
        {
            u32x4 r0[8], r1[8];
            const int cg = tid & 31; const int gch = (cg < 16 ? 768 : 512) + g * 128 + (cg & 15) * 8;
            conv_load(proj, row0, tid >> 5, gch, lo_ok, hi_ok, r0);
            conv_load(proj, row0, (tid >> 5) + 16, gch, lo_ok, hi_ok, r1);
            head_cums(p, l, row0, 4 * g + (wave >> 1), wave & 1, lane, hvs + (wave >> 1) * 520);
            __syncthreads();
            float o[4][8];
            LAS unsigned char* dst = (cg < 16 ? Cs : Bs) + (cg & 15) * 16;
            conv_compute(r0, cwl, 512, cg * 8, o);
#pragma unroll
            for (int i = 0; i < 4; ++i) *(LAS u32x4*)(dst + (4 * (tid >> 5) + i) * ST_ROW) = pack8(o[i]);
            asm volatile("" ::: "memory");
            if (tid < 256) conv_load(proj, row0, tid >> 3, g * 256 + (tid & 7) * 8, lo_ok, hi_ok, rx);
            conv_compute(r1, cwl, 512, cg * 8, o);
#pragma unroll
            for (int i = 0; i < 4; ++i) *(LAS u32x4*)(dst + (4 * ((tid >> 5) + 16) + i) * ST_ROW) = pack8(o[i]);
            if (tid < 256) { conv_compute(rx, cwl, 512, 256 + (tid & 7) * 8, o);
#pragma unroll
                for (int i = 0; i < 4; ++i) *(LAS u32x4*)(Xs + (4 * (tid >> 3) + i) * ST_TR64 + (tid & 7) * 16) = pack8(o[i]); }
        }
        __syncthreads();
        const int lb = wave >> 1, hs = wave & 1;
        int ln = lane; asm volatile("" : "+v"(ln));
        f32x16 gacc[2];
#pragma unroll
        for (int t = 0; t < 2; ++t)
#pragma unroll
            for (int e = 0; e < 16; ++e) gacc[t][e] = 0.f;
#pragma unroll
        for (int kk = 0; kk < 8; ++kk) { const bf16x8 af = row_frag(Cs, ST_ROW, 32 * lb, 16 * kk, lane);
#pragma unroll
            for (int t = 0; t < 2; ++t) { const bf16x8 bf = row_frag(Bs, ST_ROW, 64 * hs + 32 * t, 16 * kk, lane);
                gacc[t] = __builtin_amdgcn_mfma_f32_32x32x16_bf16(af, bf, gacc[t], 0, 0, 0); } }
        u32x4 hreg[4];
        { const bf16_t* hp0 = HP + ((size_t)(b * 2 * NCHUNK + c) * 8 + 4 * g) * 8192;
#pragma unroll
          for (int q = 0; q < 4; ++q) { const int it = tid + 512 * q; hreg[q] = *(const u32x4*)(hp0 + (size_t)(it >> 10) * NCHUNK * 8 * 8192 + (it & 1023) * 8); } }
        __syncthreads();
#pragma unroll 1
        for (int hh = 0; hh < 4; ++hh) {
            const int h = 4 * g + hh; const LAS float* hv = hvs + hh * 520;
            asm volatile("" : "+v"(ln));
            const int ph = hs, pc = 32 * ph + (ln & 31);
#pragma unroll
            for (int t = 0; t < 2; ++t) {
                const int sc = 64 * hs + 32 * t + (ln & 31);
                const float cfs = hv[sc], cbs = hv[128 + sc], dfs = hv[256 + sc], dbs = hv[384 + sc];
#pragma unroll
                for (int rg = 0; rg < 4; ++rg) {
                    const int l0 = 32 * lb + 8 * rg + 4 * (ln >> 5);
                    const f32x4 cfl = *(const LAS f32x4*)(hv + l0), cbl = *(const LAS f32x4*)(hv + 128 + l0);
                    float m[4];
#pragma unroll
                    for (int e = 0; e < 4; ++e) { const int lr = l0 + e;
                        const float ff = lr >= sc ? __expf(cfl[e] - cfs) * dfs : 0.f;
                        const float fb = lr <= sc ? __expf(cbl[e] - cbs) * dbs : 0.f;
                        m[e] = gacc[t][4 * rg + e] * (ff + fb); }
                    u32x2 pk; pk.x = cvt_pk_bf16(m[0], m[1]); pk.y = cvt_pk_bf16(m[2], m[3]);
                    *(LAS u32x2*)(Mt + sc * ST_TR128 + l0 * 2) = pk;
                }
            }
#pragma unroll
            for (int q = 0; q < 4; ++q) { const int it = tid + 512 * q; const int q2 = it & 1023;
                *(LAS u32x4*)(((it >> 10) ? Hb : Hf) + (q2 >> 4) * ST_ROW + (q2 & 15) * 16) = hreg[q]; }
            if (hh < 3) {
                const bf16_t* hp0 = HP + ((size_t)(b * 2 * NCHUNK + c) * 8 + h + 1) * 8192;
#pragma unroll
                for (int q = 0; q < 4; ++q) { const int it = tid + 512 * q; hreg[q] = *(const u32x4*)(hp0 + (size_t)(it >> 10) * NCHUNK * 8 * 8192 + (it & 1023) * 8); }
                if (tid < 256) conv_load(proj, row0, tid >> 3, g * 256 + (hh + 1) * 64 + (tid & 7) * 8, lo_ok, hi_ok, rx);
            }
            __syncthreads();
            f32x16 ad, af_, ab_;
#pragma unroll
            for (int e = 0; e < 16; ++e) { ad[e] = 0.f; af_[e] = 0.f; ab_[e] = 0.f; }
#pragma unroll
            for (int kk = 0; kk < 8; ++kk) {
                const bf16x8 am = tr_frag(Mt, ST_TR128, 16 * kk, 32 * lb, lane);
                const bf16x8 bx = tr_frag(Xs, ST_TR64, 16 * kk, 32 * ph, lane);
                ad = __builtin_amdgcn_mfma_f32_32x32x16_bf16(am, bx, ad, 0, 0, 0);
                const bf16x8 ac = row_frag(Cs, ST_ROW, 32 * lb, 16 * kk, lane);
                const bf16x8 bhf = row_frag(Hf, ST_ROW, 32 * ph, 16 * kk, lane);
                const bf16x8 bhb = row_frag(Hb, ST_ROW, 32 * ph, 16 * kk, lane);
                af_ = __builtin_amdgcn_mfma_f32_32x32x16_bf16(ac, bhf, af_, 0, 0, 0);
                ab_ = __builtin_amdgcn_mfma_f32_32x32x16_bf16(ac, bhb, ab_, 0, 0, 0);
            }
            const float dsk = p->d_skip[l * 8 + h];
#pragma unroll
            for (int rg = 0; rg < 4; ++rg) {
                const int l0 = 32 * lb + 8 * rg + 4 * (ln >> 5);
                const f32x4 cfl = *(const LAS f32x4*)(hv + l0), cbl = *(const LAS f32x4*)(hv + 128 + l0);
#pragma unroll
                for (int e = 0; e < 4; ++e) { const int lr = l0 + e; const int ri = 4 * rg + e;
                    const float xs = bf2f(*(const LAS bf16_t*)(Xs + lr * ST_TR64 + pc * 2));
                    const float y = ad[ri] + __expf(cfl[e]) * af_[ri] + __expf(cbl[e]) * ab_[ri] + dsk * xs;
                    const float z = bf2f(proj[(size_t)(row0 + lr) * NPROJ + 1024 + h * 64 + pc]);
                    const float val = y * siluf_(z);
                    mix[(size_t)(row0 + lr) * 1024 + h * 64 + pc] = f2bf(val);
                    const float sq = half_sum32(val * val);
                    if ((ln & 31) == 31) ssqp[ph * 128 + lr] = sq;
                }
            }
            __syncthreads();
            if (tid < 128) SSQ[(size_t)(row0 + tid) * 8 + h] = ssqp[tid] + ssqp[128 + tid];
            if (hh < 3 && tid < 256) { float o[4][8];
                conv_compute(rx, cwl, 512, 256 + (hh + 1) * 64 + (tid & 7) * 8, o);
#pragma unroll
                for (int i = 0; i < 4; ++i) *(LAS u32x4*)(Xs + (4 * (tid >> 3) + i) * ST_TR64 + (tid & 7) * 16) = pack8(o[i]); }
        }
        __syncthreads();
    }
}
__device__ __forceinline__ void phase_r2(CP p, int l, unsigned char* lds, int bid, int nb) {
    float* wrt = (float*)lds;
    float* gm = wrt + 20 * 1024;
    float* sh = gm + 3 * 1024;
    int* lcnt = (int*)(sh + 3 * 1024);
    int* lcls = lcnt + 64;
    int* lrank = lcls + 1024;
    float* lcwa = (float*)(lrank + 1024);
    float* lcwb = lcwa + 1024;
    const int tid = launder_tid(); const int lane = tid & 63, wave = tid >> 6;
    const float* mod = (const float*)(p->ws + WS_MOD) + (size_t)l * 3 * 6144;
    for (int idx = tid; idx < 4 * 1024; idx += NTHREADS) { const int k = idx >> 2, n = idx & 3; wrt[n * 1024 + k] = p->w_rg[(size_t)l * 4096 + idx]; }
    for (int idx = tid; idx < 16 * 1024; idx += NTHREADS) { const int k = idx >> 4, n = idx & 15; wrt[(4 + n) * 1024 + k] = p->w_re[(size_t)l * 16384 + idx]; }
    for (int idx = tid; idx < 3 * 1024; idx += NTHREADS) { const int v = idx >> 10, k = idx & 1023; gm[idx] = p->g_ffn[l * 1024 + k] * (1.f + mod[v * 6144 + 4 * 1024 + k]); sh[idx] = mod[v * 6144 + 3 * 1024 + k]; }
    if (tid < 64) lcnt[tid] = 0;
    __syncthreads();
    bf16_t* HM = (bf16_t*)(p->ws + WS_HX); float* CWLA = (float*)(p->ws + WS_CWLA); float* CWLB = (float*)(p->ws + WS_CWLB); int* POS = (int*)(p->ws + WS_POS) + (size_t)l * R;
    int* gcount = (int*)(p->ws + WS_CTL) + l * 32; int* LIST = (int*)(p->ws + WS_LIST);
    const int rpb = (R + nb - 1) / nb, r0 = bid * rpb, r1 = (r0 + rpb) < R ? (r0 + rpb) : R;
    for (int r = r0 + wave; r < r1; r += 8) {
        const int v = row_v(r);
        if (l == DEPTH - 1 && v == 2) { if (lane == 0) lcls[r - r0] = -1; continue; }
        const f32x4* hr = (const f32x4*)hptr(p, r);
        f32x4 xv[4]; float ss = 0.f;
#pragma unroll
        for (int j = 0; j < 4; ++j) { xv[j] = hr[lane + 64 * j]; ss += xv[j][0] * xv[j][0] + xv[j][1] * xv[j][1] + xv[j][2] * xv[j][2] + xv[j][3] * xv[j][3]; }
        ss = wave_sum(ss); const float rs = rsqrtf(ss * (1.f / 1024.f) + 1e-6f);
#pragma unroll
        for (int j = 0; j < 4; ++j) { const int k = 4 * lane + 256 * j; const f32x4 g4 = *(const f32x4*)(gm + v * 1024 + k), s4 = *(const f32x4*)(sh + v * 1024 + k);
            xv[j] = xv[j] * rs * g4 + s4;
            u32x2 o; o.x = cvt_pk_bf16(xv[j][0], xv[j][1]); o.y = cvt_pk_bf16(xv[j][2], xv[j][3]);
            *(u32x2*)(HM + (size_t)r * 1024 + k) = o; }
        float lg[20];
#pragma unroll
        for (int n = 0; n < 20; ++n) { float a = 0.f;
#pragma unroll
            for (int j = 0; j < 4; ++j) { const f32x4 w4 = *(const f32x4*)(wrt + n * 1024 + 4 * lane + 256 * j); a += xv[j][0] * w4[0] + xv[j][1] * w4[1] + xv[j][2] * w4[2] + xv[j][3] * w4[3]; }
            lg[n] = wave_sum(a) + (n < 4 ? p->b_rg[l * 4 + n] : p->b_re[l * 16 + n - 4]); }
        int gsel = 0; float gmax = lg[0];
#pragma unroll
        for (int q = 1; q < 4; ++q) if (lg[q] > gmax) { gmax = lg[q]; gsel = q; }
        float gden = 0.f;
#pragma unroll
        for (int q = 0; q < 4; ++q) gden += __expf(lg[q] - gmax);
        const float gprob = 1.f / gden;
        float el[4];
#pragma unroll
        for (int q = 0; q < 4; ++q) el[q] = gsel == 0 ? lg[4 + q] : (gsel == 1 ? lg[8 + q] : (gsel == 2 ? lg[12 + q] : lg[16 + q]));
        int i0 = 0; float m0 = el[0];
#pragma unroll
        for (int q = 1; q < 4; ++q) if (el[q] > m0) { m0 = el[q]; i0 = q; }
        int i1 = -1; float m1 = -3.0e38f;
#pragma unroll
        for (int q = 0; q < 4; ++q) if (q != i0 && el[q] > m1) { m1 = el[q]; i1 = q; }
        const float w0 = gprob / (1.f + __expf(m1 - m0)), w1 = gprob - w0;
        const int ea = i0 < i1 ? i0 : i1, eb = i0 < i1 ? i1 : i0;
        const float cwa = i0 < i1 ? w0 : w1, cwb = i0 < i1 ? w1 : w0;
        const int pidx = ea == 0 ? eb - 1 : (ea == 1 ? eb + 1 : 5);
        const int cls = gsel * 6 + pidx;
        if (lane == 0) { const int rank = atomicAdd(&lcnt[cls], 1); lcls[r - r0] = cls; lrank[r - r0] = rank; lcwa[r - r0] = cwa; lcwb[r - r0] = cwb; }
    }
    __syncthreads();
    if (tid < NCLS) lcnt[32 + tid] = atomicAdd(&gcount[tid], lcnt[tid]);
    __syncthreads();
    for (int idx = tid; idx < r1 - r0; idx += NTHREADS) { const int cl = lcls[idx]; if (cl < 0) continue; const int pos = lcnt[32 + cl] + lrank[idx]; const size_t li = (size_t)cl * R + pos;
        LIST[li] = r0 + idx; CWLA[li] = lcwa[idx]; CWLB[li] = lcwb[idx]; POS[r0 + idx] = (cl << 16) | pos; }
    __syncthreads();
}
__device__ __forceinline__ void phase_final(CP p, unsigned char* lds, int bid, int nb) {
    const int tid = launder_tid(); const int lane = tid & 63, wave = tid >> 6;
    LAS int* tab = (LAS int*)((LAS unsigned char*)lds + MISC_OFF);
    moe_table(p, DEPTH - 1, tab);
    for (int q = bid * 8 + wave; q < NB * SEQ; q += nb * 8) {
        const int b = q >= SEQ ? 1 : 0; const int r = b * SEG + CTXL + (q - b * SEQ);
        f32x4* hr = (f32x4*)(p->out + (size_t)q * D);
        f32x4 xv[4]; float ss = 0.f;
#pragma unroll
        for (int j = 0; j < 4; ++j) xv[j] = hr[lane + 64 * j];
        moe_apply(p, DEPTH - 1, r, b, lane, tab, xv);
#pragma unroll
        for (int j = 0; j < 4; ++j) ss += xv[j][0] * xv[j][0] + xv[j][1] * xv[j][1] + xv[j][2] * xv[j][2] + xv[j][3] * xv[j][3];
        ss = wave_sum(ss); const float rs = rsqrtf(ss * (1.f / 1024.f) + 1e-6f);
#pragma unroll
        for (int j = 0; j < 4; ++j) { const f32x4 g4 = *(const f32x4*)(p->g_final + 4 * lane + 256 * j); hr[lane + 64 * j] = xv[j] * rs * g4; }
    }
}


#define XB_TMO      128
#define XB_XCNT(j)  (256  + 64 * (j))
#define XB_XSUB(j)  (1280 + 64 * (j))
#define XB_XGEN(j)  (2304 + 64 * (j))
#define XB_TOP      3328
#define XB_TOPGEN   3392
#define XCD_BAR_WORDS 3456
#define XB_SPIN_CAP (1u << 22)
__device__ __forceinline__ unsigned xb_ld(unsigned* p) { return __hip_atomic_load(p, __ATOMIC_RELAXED, __HIP_MEMORY_SCOPE_AGENT); }
__device__ __forceinline__ unsigned xb_add(unsigned* p, unsigned v) { return __hip_atomic_fetch_add(p, v, __ATOMIC_RELAXED, __HIP_MEMORY_SCOPE_AGENT); }
__device__ __forceinline__ unsigned xb_xcc_id() { return (unsigned)__builtin_amdgcn_s_getreg((3 << 11) | 20) & 0xFu; }
#define XB_SPIN(cond, bar) do { unsigned _sp = 0; while (cond) { __builtin_amdgcn_s_sleep(1); \
    if ((++_sp & 255u) == 0u) { if (xb_ld(&(bar)[XB_TMO])) break; if (_sp > XB_SPIN_CAP) { atomicAdd(&(bar)[XB_TMO], 1u); break; } } } } while (0)
struct XcdBarrier { unsigned* bar; unsigned x; volatile LAS unsigned* st; };
__device__ __forceinline__ XcdBarrier xcd_barrier_post(unsigned* bar, volatile LAS unsigned* st) {
    XcdBarrier b; b.bar = bar; b.x = xb_xcc_id(); b.st = st;
    if (threadIdx.x == 0) (void)xb_add(&bar[XB_XCNT(b.x)], 1u);
    return b;
}
__device__ __forceinline__ void xcd_barrier_complete(unsigned* bar, unsigned x, unsigned& nloc, unsigned& nx) {
    const unsigned G = gridDim.x * gridDim.y * gridDim.z;
    unsigned sum, cnt, mine, sp = 0u;
    for (;;) {
        sum = 0u; cnt = 0u; mine = 0u;
#pragma unroll
        for (unsigned j = 0; j < 16; ++j) { const unsigned c = xb_ld(&bar[XB_XCNT(j)]); sum += c; cnt += (c > 0u) ? 1u : 0u; mine = (j == x) ? c : mine; }
        if (sum == G) break;
        __builtin_amdgcn_s_sleep(1);
        if ((++sp & 255u) == 0u) { if (xb_ld(&bar[XB_TMO])) break; if (sp > XB_SPIN_CAP) { atomicAdd(&bar[XB_TMO], 1u); break; } }
    }
    nloc = mine > 0u ? mine : 1u; nx = cnt > 0u ? cnt : 1u;
}
__device__ __forceinline__ void xcd_barrier(const XcdBarrier& b) {
    asm volatile("s_waitcnt vmcnt(0)" ::: "memory");
    __syncthreads();
    if (threadIdx.x == 0) {
        unsigned* bar = b.bar;
        __builtin_amdgcn_s_waitcnt(0);
        unsigned nloc = b.st[0], nx = b.st[1];
        if (nloc == 0u) { xcd_barrier_complete(bar, b.x, nloc, nx); b.st[0] = nloc; b.st[1] = nx; }
        const unsigned old = xb_add(&bar[XB_XSUB(b.x)], 1u);
        const unsigned gen = old / nloc;
        if (old + 1u == (gen + 1u) * nloc) {
            __builtin_amdgcn_fence(__ATOMIC_RELEASE, "agent");
            asm volatile("s_waitcnt vmcnt(0)" ::: "memory");
            const unsigned og = xb_add(&bar[XB_TOP], 1u);
            const unsigned tg = og / nx;
            if (og + 1u == (tg + 1u) * nx) xb_add(&bar[XB_TOPGEN], 1u);
            else XB_SPIN(xb_ld(&bar[XB_TOPGEN]) == tg, bar);
            __builtin_amdgcn_fence(__ATOMIC_ACQUIRE, "agent");
            xb_add(&bar[XB_XGEN(b.x)], 1u);
            asm volatile("s_waitcnt vmcnt(0)" ::: "memory");
        } else {
            XB_SPIN(xb_ld(&bar[XB_XGEN(b.x)]) == gen, bar);
            __builtin_amdgcn_fence(__ATOMIC_ACQUIRE, "agent");
            asm volatile("s_waitcnt vmcnt(0)" ::: "memory");
        }
    }
    __syncthreads();
}

#ifndef PHASE_MASK
#define PHASE_MASK 0xFFFFF
#endif
#define PM(i) ((PHASE_MASK >> (i)) & 1)
#ifndef REPEAT_MASK
#define REPEAT_MASK 0
#endif
#define RP(i) for (int rep_ = 0; rep_ < 1 + ((REPEAT_MASK >> (i)) & 1); ++rep_)
constexpr int PH_PER_LAYER = 9, NPHASES = 1 + DEPTH * PH_PER_LAYER + 1;
__global__ void __launch_bounds__(NTHREADS, 2) mk_fwd(Args args) {
    extern __shared__ __attribute__((aligned(16))) unsigned char lds[];
    cg::grid_group grid = cg::this_grid();
    const __attribute__((address_space(4))) Args* ap = (const __attribute__((address_space(4))) Args*)__builtin_amdgcn_kernarg_segment_ptr();
    const int lo = ap->lo, hi = ap->hi;
    LAS unsigned char* ldsl = (LAS unsigned char*)lds;
    volatile LAS unsigned* xbst = (volatile LAS unsigned*)(ldsl + LDS_BYTES - 16);
    if (threadIdx.x < 4) xbst[threadIdx.x] = 0u;
    __syncthreads();
    (void)xcd_barrier_post((unsigned*)(ap->p.ws + WS_BAR), xbst);
    for (int ph = lo; ph < hi; ++ph) {
        CP p = launder(&ap->p);
        int bid = blockIdx.x, nb = gridDim.x; asm volatile("" : "+s"(bid), "+s"(nb));
        if (ph == 0) { if (PM(0)) RP(0) phase_wprep(p, lds, bid, nb); if (PM(1)) RP(1) phase_adaln(p, lds, bid, nb); }
        else if (ph == NPHASES - 1) { if (PM(12)) phase_final(p, lds, bid, nb); }
        else {
            const int l = (ph - 1) / PH_PER_LAYER, s = (ph - 1) % PH_PER_LAYER;
            if (s == 0) { if (PM(2)) RP(2) { if (rep_ == 0 || l == 0) phase_r1(p, l, lds, bid, nb); } }
            else if (s == 1) { if (PM(3)) RP(3) {
                pg8::DenseSched S; S.init(p->ws + WS_HX, (const bf16_t*)(p->ws + WS_WTIN) + (size_t)l * DIN * 1024, R, NPROJ, 1024, 1024, 1024, nb, bid);
                EpiProj E{(bf16_t*)(p->ws + WS_PROJ)};
                pg8::gemm_phase<EpiProj, pg8::DenseSched, false>(ldsl, 1024, 1024, 1024, S, E);
            } }
            else if (s == 2) { if (PM(4)) RP(4) phase_c1(p, l, lds, bid, nb); if (PM(5)) RP(5) phase_s1(p, l, lds, bid, nb); }
            else if (s == 3) { if (PM(6)) RP(6) phase_s2(p, bid, nb); if (PM(4)) phase_c1_ln(p, l, bid, nb); }
            else if (s == 4) { if (PM(7)) RP(7) phase_s3(p, l, lds, bid, nb); }
            else if (s == 5) { if (PM(8)) RP(8) { if (rep_ == 0 || l == 0) {
                pg8::DenseSched S; S.init(p->ws + WS_HX, (const bf16_t*)(p->ws + WS_WTOUT) + (size_t)l * 1024 * 1024, R, 1024, 1024, 1024, 1024, nb, bid, l == DEPTH - 1);
                EpiResid E{l == 0 ? p->ctx : (const float*)(p->ws + WS_HC), l == 0 ? p->x : (const float*)p->out, (float*)(p->ws + WS_HC), p->out, (const float*)(p->ws + WS_MOD) + (size_t)l * 3 * 6144, (const float*)(p->ws + WS_SSQ)};
                pg8::gemm_phase<EpiResid, pg8::DenseSched, false>(ldsl, 1024, 1024, 1024, S, E);
            } } }
            else if (s == 6) { if (PM(9)) phase_r2(p, l, lds, bid, nb); }
            else if (s == 7) { if (PM(10)) RP(10) {
                LAS int* tab = (LAS int*)(ldsl + MISC_OFF); moe_table(p, l, tab);
                MoeSched S{tab, (const int*)(p->ws + WS_LIST), (const char*)(p->ws + WS_HX), (const char*)(p->ws + WS_WTGU), 0, l, nb, bid};
                EpiUp E{(bf16_t*)(p->ws + WS_HID), (const float*)(p->ws + WS_CWLA), (const float*)(p->ws + WS_CWLB)};
                pg8::gemm_phase<EpiUp, MoeSched, true>(ldsl, 1024, 1024, 1024, S, E);
            } }
            else { if (PM(11)) RP(11) {
                LAS int* tab = (LAS int*)(ldsl + MISC_OFF); moe_table(p, l, tab);
                MoeSched S{tab, (const int*)(p->ws + WS_LIST), (const char*)(p->ws + WS_HID), (const char*)(p->ws + WS_WTD), 1, l, nb, bid};
                EpiY E{(bf16_t*)(p->ws + WS_Y)};
                pg8::gemm_phase<EpiY, MoeSched, false>(ldsl, 512, 256, 512, S, E);
            } }
        }
        if (ph + 1 < hi) { if (ph == lo) grid.sync(); else { XcdBarrier xb; xb.bar = (unsigned*)(launder(&ap->p)->ws + WS_BAR); xb.x = xb_xcc_id(); xb.st = (volatile LAS unsigned*)(ldsl + LDS_BYTES - 16); xcd_barrier(xb); } }
    }
}

extern "C" void kernel_launch(void* const* d_in, const int* in_sizes, int n_in, void* d_out, int out_size, void* d_ws, size_t ws_size, hipStream_t stream) {
    static int grid = 0;
    if (grid == 0) {
        if (n_in != 28 || ws_size < WS_END) { fprintf(stderr, "kernel_launch: unexpected n_in %d or ws_size %zu (< %zu)\n", n_in, ws_size, (size_t)WS_END); grid = -1; return; }
        int dev = 0, cus = 0, per_cu = 0;
        hipGetDevice(&dev); hipDeviceGetAttribute(&cus, hipDeviceAttributeMultiprocessorCount, dev);
        if (hipFuncSetAttribute((const void*)mk_fwd, hipFuncAttributeMaxDynamicSharedMemorySize, LDS_BYTES) != hipSuccess) { fprintf(stderr, "kernel_launch: hipFuncSetAttribute failed\n"); grid = -1; return; }
        if (hipOccupancyMaxActiveBlocksPerMultiprocessor(&per_cu, (const void*)mk_fwd, NTHREADS, LDS_BYTES) != hipSuccess || per_cu < 1) { fprintf(stderr, "kernel_launch: occupancy query says %d\n", per_cu); (void)hipGetLastError(); grid = -1; return; }
        grid = cus;
    }
    if (grid < 0) return;
    (void)hipMemsetAsync((char*)d_ws + WS_CTL, 0, WS_CTL_BYTES, stream);
    Args a{};
    const float** pp = (const float**)&a.p;
    for (int i = 0; i < 28; ++i) pp[i] = (const float*)d_in[i];
    a.p.out = (float*)d_out; a.p.ws = (unsigned char*)d_ws;
#if PER_PHASE_LAUNCH
    for (int ph = 0; ph < NPHASES; ++ph) {
        a.lo = ph; a.hi = ph + 1; void* kargs[] = {&a};
        hipError_t e = hipLaunchCooperativeKernel((const void*)mk_fwd, dim3(grid), dim3(NTHREADS), kargs, LDS_BYTES, stream);
        if (e != hipSuccess) { fprintf(stderr, "kernel_launch: launch of phase %d failed: %s\n", ph, hipGetErrorString(e)); break; }
    }
#else
    a.lo = 0; a.hi = NPHASES; void* kargs[] = {&a};
    hipError_t e = hipLaunchCooperativeKernel((const void*)mk_fwd, dim3(grid), dim3(NTHREADS), kargs, LDS_BYTES, stream);
    if (e != hipSuccess) fprintf(stderr, "kernel_launch: cooperative launch failed: %s (grid %d)\n", hipGetErrorString(e), grid);
#endif
}
```

```cpp
#include <hip/hip_runtime.h>
#include <hip/hip_cooperative_groups.h>
#include <cstdio>
namespace cg = cooperative_groups;

#ifndef PER_PHASE_LAUNCH
#define PER_PHASE_LAUNCH 0
#endif

#ifndef S3REP
#define S3REP 0
#endif
#define S3R(i) for (int r3_ = 0; r3_ < 1 + ((S3REP >> (i)) & 1); ++r3_)
#define LAS __attribute__((address_space(3)))
typedef unsigned short bf16_t;
typedef short bf16x8 __attribute__((ext_vector_type(8)));
typedef float f32x4 __attribute__((ext_vector_type(4)));
typedef unsigned u32x4 __attribute__((ext_vector_type(4)));
typedef unsigned u32x2 __attribute__((ext_vector_type(2)));

constexpr int D = 1024, NB = 2, SEQ = 16384, CTXL = 256, SEG = SEQ + CTXL, R = NB * SEG, DEPTH = 2;
constexpr int NPROJ = 2560, DIN = 2576;
constexpr int NTHREADS = 512;
constexpr int LDS_BYTES = 163840;
constexpr int MISC_OFF = 131072;
constexpr int NCLS = 24;

constexpr size_t al256(size_t x) { return (x + 255) & ~size_t(255); }
constexpr size_t WS_CTL = 0;
constexpr size_t WS_BAR = 4096;
constexpr size_t WS_CTL_BYTES = 32768;
constexpr size_t WS_MOD = WS_CTL_BYTES;
constexpr size_t WS_WTIN = WS_MOD + al256((size_t)2 * 3 * 6144 * 4);
constexpr size_t WS_WTOUT = WS_WTIN + al256((size_t)2 * DIN * 1024 * 2);
constexpr size_t WS_WTGU = WS_WTOUT + al256((size_t)2 * 1024 * 1024 * 2);
constexpr size_t WS_WTD = WS_WTGU + al256((size_t)2 * 16 * 512 * 1024 * 2);
constexpr size_t WS_HC = WS_WTD + al256((size_t)2 * 16 * 1024 * 256 * 2);
constexpr size_t WS_HX = WS_HC + al256((size_t)512 * 1024 * 4);
constexpr size_t WS_PROJ = WS_HX + al256((size_t)R * 1024 * 2);
constexpr size_t WS_DT = WS_PROJ + al256((size_t)R * NPROJ * 2);
constexpr size_t WS_POS = WS_DT + al256((size_t)R * 16 * 4);
constexpr size_t WS_LIST = WS_POS + al256((size_t)2 * R * 4);
constexpr size_t WS_CWLA = WS_LIST + al256((size_t)NCLS * R * 4);
constexpr size_t WS_CWLB = WS_CWLA + al256((size_t)NCLS * R * 4);
constexpr size_t WS_BIG = WS_CWLB + al256((size_t)NCLS * R * 4);
constexpr size_t WS_Y = WS_PROJ;
constexpr size_t WS_S = WS_BIG;
constexpr size_t WS_HP = WS_S + al256((size_t)2 * 2 * 130 * 8 * 8192 * 4);
constexpr size_t WS_DEC = WS_HP + al256((size_t)2 * 2 * 130 * 8 * 8192 * 2);
constexpr size_t WS_SSQ = WS_DEC + al256((size_t)2 * 2 * 130 * 8 * 4);
constexpr size_t WS_HID = WS_S;
constexpr size_t WS_END = WS_SSQ + al256((size_t)R * 8 * 4);
static_assert((size_t)(R + NCLS * 256) * 512 * 2 <= (size_t)2 * 2 * 130 * 8 * 8192 * 4, "hid alias");
static_assert(WS_END <= (size_t)512 * 1024 * 1024, "workspace");

struct Params {
    const float *x, *c, *ctx, *c_ctx, *w_ada, *b_ada, *g_mix, *g_ffn, *w_in, *conv_w, *conv_b, *conv_ln_g, *conv_ln_b, *ssd_conv_w, *ssd_conv_b,
        *dt_bias, *a_log, *d_skip, *ssd_norm_g, *w_out, *w_rg, *b_rg, *w_re, *b_re, *w_gate, *w_up, *w_down, *g_final;
    float* out; unsigned char* ws;
};
struct Args { Params p; int lo, hi; };
typedef const __attribute__((address_space(4))) Params* CP;
__device__ __forceinline__ CP launder(CP p) { asm volatile("" : "+s"(p)); return p; }
__device__ __forceinline__ int launder_tid() { int t = threadIdx.x; asm volatile("" : "+v"(t)); return t; }

__device__ __forceinline__ unsigned cvt_pk_bf16(float lo, float hi) { unsigned r; asm("v_cvt_pk_bf16_f32 %0, %1, %2" : "=v"(r) : "v"(lo), "v"(hi)); return r; }
__device__ __forceinline__ float bf2f(unsigned b) { return __uint_as_float(b << 16); }
__device__ __forceinline__ float bflo(unsigned w) { return __uint_as_float(w << 16); }
__device__ __forceinline__ float bfhi(unsigned w) { return __uint_as_float(w & 0xffff0000u); }
__device__ __forceinline__ bf16_t f2bf(float f) { return (bf16_t)(cvt_pk_bf16(f, 0.f) & 0xffffu); }
#define DPP_ADD(v, ctrl, rm) ((v) + __builtin_bit_cast(float, __builtin_amdgcn_update_dpp(0, __builtin_bit_cast(int, (v)), (ctrl), (rm), 0xF, true)))
__device__ __forceinline__ float row_sum16(float v) {
    v = DPP_ADD(v, 0xB1, 0xF);
    v = DPP_ADD(v, 0x4E, 0xF);
    v = DPP_ADD(v, 0x141, 0xF);
    v = DPP_ADD(v, 0x140, 0xF);
    return v;
}
__device__ __forceinline__ float half_sum32(float v) { v = row_sum16(v); v = DPP_ADD(v, 0x142, 0xA); return v; }
__device__ __forceinline__ float wave_sum(float v) {
    v = half_sum32(v); v = DPP_ADD(v, 0x143, 0xC);
    return __builtin_bit_cast(float, __builtin_amdgcn_readlane(__builtin_bit_cast(int, v), 63));
}
__device__ __forceinline__ float sigmoidf_(float x) { return 1.f / (1.f + __expf(-x)); }
__device__ __forceinline__ float siluf_(float x) { return x / (1.f + __expf(-x)); }
__device__ __forceinline__ float softplusf_(float x) { return fmaxf(x, 0.f) + log1pf(expf(-fabsf(x))); }

__device__ __forceinline__ int row_b(int r) { return r >= SEG ? 1 : 0; }
__device__ __forceinline__ int row_i(int r) { return r >= SEG ? r - SEG : r; }
__device__ __forceinline__ int row_v(int r) { const int i = row_i(r); return i < CTXL ? 2 : row_b(r); }
__device__ __forceinline__ float* hptr2(float* hc, float* out, int r) {
    const int b = row_b(r), i = row_i(r);
    return i < CTXL ? hc + (size_t)(b * CTXL + i) * D : out + (size_t)(b * SEQ + i - CTXL) * D;
}
__device__ __forceinline__ float* hptr(CP p, int r) { return hptr2((float*)(p->ws + WS_HC), p->out, r); }
__device__ __forceinline__ const float* hin_ptr(CP p, int l, int r) {
    if (l == 0) return hptr2((float*)p->ctx, (float*)p->x, r);
    return hptr(p, r);
}

namespace pg8 {
constexpr int BM = 256, BK = 64, HALF = 128, HTB = HALF * BK * 2, STAGE_BYTES = 8 * HTB, NXCD = 8, WGM = 8;
__device__ __forceinline__ int lds_byte(int r, int c) { const int st = (r >> 4) * 2 + (c >> 5), rr = r & 15, cc = c & 31, ob = rr * 64 + cc * 2; return st * 1024 + (ob ^ (((ob >> 9) & 1) << 5)); }
__device__ __forceinline__ void stage_rc(int b, int& Rr, int& Cc) { const int st = b / 1024, sb = b % 1024, swz = sb ^ (((sb >> 9) & 1) << 5); Rr = (st >> 1) * 16 + swz / 64; Cc = (st & 1) * 32 + (swz % 64) / 2; }
__device__ __forceinline__ int perm32(int rho) { const int n = rho >> 4, i = rho & 15; return 8 * (i >> 2) + 4 * n + (i & 3); }

struct Unit {
    const char* a0;
    const char* b0;
    const char* b1;
    int i0, i1, i2, i3, i4, pad;
};

template <class Epi, class Sched, bool GATHER>
__device__ __forceinline__ void gemm_phase(LAS unsigned char* lds, const int lda, const int ldb, const int K, const Sched& S, const Epi& E) {
    const int tid = launder_tid(); const int wid = __builtin_amdgcn_readfirstlane(tid >> 6), lane = tid & 63, wr = wid >> 2, wc = wid & 3, fr = lane & 15, fq = lane >> 4;
    const int nt = K / BK, ks = nt >> 1;
    int Rr[2], Cc[2];
    unsigned voffB[2];
#pragma unroll
    for (int i = 0; i < 2; ++i) { stage_rc(tid * 16 + i * 8192, Rr[i], Cc[i]); const int Rb = Epi::PERM ? ((Rr[i] & ~31) + perm32(Rr[i] & 31)) : Rr[i];
        voffB[i] = (unsigned)(Rb * ldb + Cc[i]) * 2u; }
    const size_t kstep = (size_t)(BK * 2);
    const size_t hstepB = (size_t)HALF * ldb * 2;
    const unsigned ldsw = (unsigned)wid * 1024u;
    const unsigned ldsbase = (unsigned)(unsigned long)lds;
    const int aoff = lds_byte(wr * 64 + fr, fq * 8), boff = lds_byte(wc * 32 + fr, fq * 8);
#define PG8_SA(b, h) (((b) * 2 + (h)) * HTB)
#define PG8_SB(b, h) ((4 + (b) * 2 + (h)) * HTB)
#define PG8_STAGE2(bufoff, gbase, v0, v1) do { unsigned keep_; \
        asm volatile("s_mov_b32 %0, m0\n\ts_mov_b32 m0, %1\n\ts_nop 4\n\tglobal_load_lds_dwordx4 %2, %4\n\ts_add_u32 m0, m0, 0x2000\n\ts_nop 0\n\tglobal_load_lds_dwordx4 %3, %4\n\ts_mov_b32 m0, %0" \
            : "=&s"(keep_) : "s"(ldsbase + (unsigned)(bufoff) + ldsw), "v"(v0), "v"(v1), "s"(gbase) : "memory", "scc"); } while (0)
#define PG8_LDA(dst, b, h) do { _Pragma("unroll") for (int m = 0; m < 4; ++m) _Pragma("unroll") for (int k = 0; k < 2; ++k) dst[m][k] = *(const LAS bf16x8*)(lds + PG8_SA(b, h) + aoff + m * 2048 + k * 1024); } while (0)
#define PG8_LDB(dst, b, h) do { _Pragma("unroll") for (int n = 0; n < 2; ++n) _Pragma("unroll") for (int k = 0; k < 2; ++k) dst[n][k] = *(const LAS bf16x8*)(lds + PG8_SB(b, h) + boff + n * 2048 + k * 1024); } while (0)
#define PG8_MMA(ai, bj, At, Bt) do { __builtin_amdgcn_s_setprio(1); _Pragma("unroll") for (int m = 0; m < 4; ++m) _Pragma("unroll") for (int n = 0; n < 2; ++n) _Pragma("unroll") for (int k = 0; k < 2; ++k) \
        acc[ai][bj][m][n] = __builtin_amdgcn_mfma_f32_16x16x32_bf16(Bt[n][k], At[m][k], acc[ai][bj][m][n], 0, 0, 0); __builtin_amdgcn_s_setprio(0); } while (0)
#define PG8_WAIT_V(n) asm volatile("s_waitcnt vmcnt(" #n ")" ::: "memory")
#define PG8_WAIT_L(n) asm volatile("s_waitcnt lgkmcnt(" #n ")" ::: "memory")
#define PG8_BAR __builtin_amdgcn_s_barrier()
#define PG8_SCHED __builtin_amdgcn_sched_barrier(0)
#define PG8_BP(u, tt) ((tt) < ks ? (u).b0 + (size_t)(tt) * kstep : (u).b1 + (size_t)((tt) - ks) * kstep)
    Unit cur, nxt; int ui = 0;
    if (!S.get(0, cur)) return;
    unsigned c00, c01, c10, c11, n00, n01, n10, n11;
    if (GATHER) {
        c00 = (unsigned)(S.arow(cur, Rr[0]) * lda + Cc[0]) * 2u; c01 = (unsigned)(S.arow(cur, Rr[1]) * lda + Cc[1]) * 2u;
        c10 = (unsigned)(S.arow(cur, HALF + Rr[0]) * lda + Cc[0]) * 2u; c11 = (unsigned)(S.arow(cur, HALF + Rr[1]) * lda + Cc[1]) * 2u;
    } else {
        c00 = (unsigned)(Rr[0] * lda + Cc[0]) * 2u; c01 = (unsigned)(Rr[1] * lda + Cc[1]) * 2u;
        c10 = (unsigned)((HALF + Rr[0]) * lda + Cc[0]) * 2u; c11 = (unsigned)((HALF + Rr[1]) * lda + Cc[1]) * 2u;
    }
    n00 = c00; n01 = c01; n10 = c10; n11 = c11;
    f32x4 acc[2][2][4][2];
    float zr; asm volatile("v_mov_b32 %0, 0" : "=v"(zr));
#pragma unroll
    for (int a = 0; a < 2; ++a)
#pragma unroll
        for (int b = 0; b < 2; ++b)
#pragma unroll
            for (int m = 0; m < 4; ++m)
#pragma unroll
                for (int n = 0; n < 2; ++n) acc[a][b][m][n] = (f32x4){zr, zr, zr, zr};
    bf16x8 At[4][2], B0[2][2], B1[2][2];
    const char* cA = cur.a0;
    {
        const char* pb0 = PG8_BP(cur, 0); const char* pb1 = PG8_BP(cur, 1);
        PG8_STAGE2(PG8_SB(0, 0), pb0, voffB[0], voffB[1]); PG8_STAGE2(PG8_SA(0, 0), cA, c00, c01);
        PG8_STAGE2(PG8_SB(0, 1), pb0 + hstepB, voffB[0], voffB[1]); PG8_STAGE2(PG8_SA(0, 1), cA, c10, c11);
        if (wr == 1) PG8_BAR;
        PG8_WAIT_V(4); PG8_BAR;
        PG8_STAGE2(PG8_SB(1, 0), pb1, voffB[0], voffB[1]); PG8_STAGE2(PG8_SA(1, 0), cA + kstep, c00, c01);
        PG8_STAGE2(PG8_SB(1, 1), pb1 + hstepB, voffB[0], voffB[1]);
        PG8_WAIT_V(6); PG8_BAR;
    }
    for (;;) {
        const bool has_next = S.get(ui + 1, nxt);
        if (!has_next) nxt = cur;
        if (GATHER) {
            if (has_next) {
                n00 = (unsigned)(S.arow(nxt, Rr[0]) * lda + Cc[0]) * 2u; n01 = (unsigned)(S.arow(nxt, Rr[1]) * lda + Cc[1]) * 2u;
                n10 = (unsigned)(S.arow(nxt, HALF + Rr[0]) * lda + Cc[0]) * 2u; n11 = (unsigned)(S.arow(nxt, HALF + Rr[1]) * lda + Cc[1]) * 2u;
            } else { n00 = c00; n01 = c01; n10 = c10; n11 = c11; }
        }
        const char* nA = nxt.a0;
#pragma unroll 1
        for (int t = 0; t < nt; t += 2) {
            const bool last = (t == nt - 2);
            const char* a1 = cA + (size_t)(t + 1) * kstep;
            const char* a2 = last ? nA : cA + (size_t)(t + 2) * kstep;
            const char* a3 = a2 + kstep;
            const char* b2 = last ? PG8_BP(nxt, 0) : PG8_BP(cur, t + 2);
            const char* b3 = last ? PG8_BP(nxt, 1) : PG8_BP(cur, t + 3);
            const unsigned s00 = last ? n00 : c00, s01 = last ? n01 : c01, s10 = last ? n10 : c10, s11 = last ? n11 : c11;
            if constexpr (Epi::MIDSCALE) { if (t == ks) E.midscale(acc, cur, wr, wc, fr, fq); }
            PG8_LDB(B0, 0, 0); PG8_SCHED; PG8_LDA(At, 0, 0); PG8_STAGE2(PG8_SA(1, 1), a1, c10, c11);
            PG8_WAIT_L(8); PG8_BAR; PG8_WAIT_L(0); PG8_MMA(0, 0, At, B0); PG8_BAR; PG8_SCHED;
            PG8_LDB(B1, 0, 1); PG8_STAGE2(PG8_SB(0, 0), b2, voffB[0], voffB[1]);
            PG8_BAR; PG8_WAIT_L(0); PG8_MMA(0, 1, At, B1); PG8_BAR;
            PG8_LDA(At, 0, 1); PG8_STAGE2(PG8_SA(0, 0), a2, s00, s01);
            PG8_BAR; PG8_WAIT_L(0); PG8_MMA(1, 0, At, B0); PG8_BAR; PG8_SCHED;
            PG8_STAGE2(PG8_SB(0, 1), b2 + hstepB, voffB[0], voffB[1]);
            PG8_WAIT_V(6); PG8_BAR; PG8_MMA(1, 1, At, B1); PG8_BAR;
            PG8_LDB(B0, 1, 0); PG8_SCHED; PG8_LDA(At, 1, 0); PG8_STAGE2(PG8_SA(0, 1), a2, s10, s11);
            PG8_WAIT_L(8); PG8_BAR; PG8_WAIT_L(0); PG8_MMA(0, 0, At, B0); PG8_BAR; PG8_SCHED;
            PG8_LDB(B1, 1, 1); PG8_STAGE2(PG8_SB(1, 0), b3, voffB[0], voffB[1]);
            PG8_BAR; PG8_WAIT_L(0); PG8_MMA(0, 1, At, B1); PG8_BAR;
            PG8_LDA(At, 1, 1); PG8_STAGE2(PG8_SA(1, 0), a3, s00, s01);
            PG8_BAR; PG8_WAIT_L(0); PG8_MMA(1, 0, At, B0); PG8_BAR; PG8_SCHED;
            PG8_STAGE2(PG8_SB(1, 1), b3 + hstepB, voffB[0], voffB[1]);
            PG8_WAIT_V(6); PG8_BAR; PG8_MMA(1, 1, At, B1); PG8_BAR;
        }
        E(acc, cur, wr, wc, fr, fq);
        if (!has_next) break;
        asm volatile("v_mov_b32 %0, 0" : "=v"(zr));
#pragma unroll
        for (int a = 0; a < 2; ++a)
#pragma unroll
            for (int b = 0; b < 2; ++b)
#pragma unroll
                for (int m = 0; m < 4; ++m)
#pragma unroll
                    for (int n = 0; n < 2; ++n) acc[a][b][m][n] = (f32x4){zr, zr, zr, zr};
        cur = nxt; cA = nA; ++ui; c00 = n00; c01 = n01; c10 = n10; c11 = n11;
    }
    PG8_WAIT_V(0);
    if (wr == 0) PG8_BAR;
    PG8_BAR;
#undef PG8_SA
#undef PG8_SB
#undef PG8_STAGE2
#undef PG8_LDA
#undef PG8_LDB
#undef PG8_MMA
#undef PG8_WAIT_V
#undef PG8_WAIT_L
#undef PG8_BAR
#undef PG8_SCHED
#undef PG8_BP
}

struct DenseSched {
    const char* A; const char* Bt; int lda, ldb, K; int nM, nN, nwg, G, c, skipctx;
    __device__ __forceinline__ void init(const void* A_, const void* Bt_, int M, int N, int K_, int lda_, int ldb_, int G_, int c_, int skipctx_ = 0) {
        A = (const char*)A_; Bt = (const char*)Bt_; lda = lda_; ldb = ldb_; K = K_; nM = M / BM - 2 * skipctx_; nN = N / BM; nwg = nM * nN; G = G_; c = c_; skipctx = skipctx_; }
    __device__ __forceinline__ bool get(int i, Unit& u) const {
        const long L = (long)i * G + c; if (L >= nwg) return false;
        int wgid = (int)L; { const int q = nwg / NXCD, r = nwg % NXCD, xcd = wgid % NXCD, off = wgid / NXCD; wgid = (xcd < r ? xcd * (q + 1) : r * (q + 1) + (xcd - r) * q) + off; }
        const int nig = WGM * nN, gid = wgid / nig, fm = gid * WGM, gsz = (nM - fm) < WGM ? (nM - fm) : WGM;
        int pm = fm + ((wgid % nig) % gsz); const int pn = (wgid % nig) / gsz;
        if (skipctx) pm += 1 + (pm >= 64 ? 1 : 0);
        u.a0 = A + (size_t)pm * BM * lda * 2; u.b0 = Bt + (size_t)pn * BM * ldb * 2; u.b1 = u.b0 + (size_t)(K / BK / 2) * BK * 2;
        u.i0 = pm; u.i1 = pn; u.i2 = 0; u.i3 = 0; u.i4 = 0; u.pad = 0; return true;
    }
    __device__ __forceinline__ int arow(const Unit&, int rl) const { return rl; }
};
}

struct EpiProj {
    static constexpr bool PERM = true, MIDSCALE = false;
    bf16_t* O;
    __device__ __forceinline__ void operator()(const f32x4 (&acc)[2][2][4][2], const pg8::Unit& u, int wr, int wc, int fr, int fq) const {
        const int row0 = u.i0 * 256 + wr * 64 + fr, col0 = u.i1 * 256 + wc * 32 + 8 * fq;
#pragma unroll
        for (int ai = 0; ai < 2; ++ai)
#pragma unroll
            for (int m = 0; m < 4; ++m) { bf16_t* rowp = O + (size_t)(row0 + ai * 128 + m * 16) * NPROJ + col0;
#pragma unroll
                for (int bj = 0; bj < 2; ++bj) { const f32x4 v0 = acc[ai][bj][m][0], v1 = acc[ai][bj][m][1];
                    u32x4 w; w.x = cvt_pk_bf16(v0[0], v0[1]); w.y = cvt_pk_bf16(v0[2], v0[3]); w.z = cvt_pk_bf16(v1[0], v1[1]); w.w = cvt_pk_bf16(v1[2], v1[3]);
                    *(u32x4*)(rowp + bj * 128) = w; } }
    }
};
struct EpiResid {
    static constexpr bool PERM = false, MIDSCALE = true;
    const float* inc; const float* inx; float* hc; float* out; const float* modl; const float* ssq;
    __device__ __forceinline__ void midscale(f32x4 (&acc)[2][2][4][2], const pg8::Unit& u, int wr, int wc, int fr, int fq) const {
        const int r0 = u.i0 * 256 + wr * 64 + fr;
#pragma unroll
        for (int ai = 0; ai < 2; ++ai)
#pragma unroll
            for (int m = 0; m < 4; ++m) { const float* sp = ssq + (size_t)(r0 + ai * 128 + m * 16) * 8;
                const f32x4 a = *(const f32x4*)sp, b = *(const f32x4*)(sp + 4);
                const float rs = rsqrtf(((a[0] + a[1]) + (a[2] + a[3]) + (b[0] + b[1]) + (b[2] + b[3])) * (1.f / 512.f) + 1e-6f);
#pragma unroll
                for (int bj = 0; bj < 2; ++bj)
#pragma unroll
                    for (int n = 0; n < 2; ++n) acc[ai][bj][m][n] *= rs;
                asm volatile("" ::: "memory"); }
    }
    __device__ __forceinline__ void operator()(const f32x4 (&acc)[2][2][4][2], const pg8::Unit& u, int wr, int wc, int fr, int fq) const {
        const int r0 = u.i0 * 256;
        const int v = row_v(r0);
        const float* gate = modl + (size_t)v * 6144 + 2 * 1024;
        const float* hin = hptr2((float*)inc, (float*)inx, r0); float* hout = hptr2(hc, out, r0);
        const int rl0 = wr * 64 + fr, col0 = u.i1 * 256 + wc * 32 + 4 * fq;
        f32x4 gv[2][2];
#pragma unroll
        for (int bj = 0; bj < 2; ++bj)
#pragma unroll
            for (int n = 0; n < 2; ++n) gv[bj][n] = *(const f32x4*)(gate + col0 + bj * 128 + n * 16);
#pragma unroll
        for (int ai = 0; ai < 2; ++ai)
#pragma unroll
            for (int m = 0; m < 4; ++m) { const size_t off = (size_t)(rl0 + ai * 128 + m * 16) * D + col0;
#pragma unroll
                for (int bj = 0; bj < 2; ++bj)
#pragma unroll
                    for (int n = 0; n < 2; ++n) { const f32x4 hi = *(const f32x4*)(hin + off + bj * 128 + n * 16);
                        *(f32x4*)(hout + off + bj * 128 + n * 16) = hi + gv[bj][n] * acc[ai][bj][m][n]; }
                if (m & 1) asm volatile("" ::: "memory"); }
    }
};

struct MoeSched {
    const LAS int* tab;
    const int* list;
    const char* A; const char* W; int mode  , l, G, c;
    __device__ __forceinline__ bool get(int i, pg8::Unit& u) const {
        const int L = i * G + c; const int total = __builtin_amdgcn_readfirstlane(tab[24]) * 4; if (L >= total) return false;
        const int tl = L >> 2, pn = L & 3;
        int cls = 0;
#pragma unroll 1
        for (int q = 1; q < NCLS; ++q) { const int tq = __builtin_amdgcn_readfirstlane(tab[q]); if (tq <= tl) cls = q; }
        const int j = tl - __builtin_amdgcn_readfirstlane(tab[cls]), cnt = __builtin_amdgcn_readfirstlane(tab[32 + cls]);
        const int g = cls / 6, pidx = cls - g * 6;
        const int ea = (pidx >= 3) + (pidx >= 5), eb = pidx < 3 ? pidx + 1 : (pidx < 5 ? pidx - 1 : 3);
        if (mode == 0) {
            const int e = 4 * g + (pn < 2 ? ea : eb);
            u.a0 = A;
            u.b0 = W + ((size_t)(l * 16 + e) * 512 + (size_t)(pn & 1) * 256) * 1024 * 2; u.b1 = u.b0 + (size_t)8 * 128;
        } else {
            u.a0 = A + (size_t)tl * 256 * 512 * 2;
            u.b0 = W + ((size_t)(l * 16 + 4 * g + ea) * 1024 + (size_t)pn * 256) * 256 * 2;
            u.b1 = W + ((size_t)(l * 16 + 4 * g + eb) * 1024 + (size_t)pn * 256) * 256 * 2;
        }
        u.i0 = cls; u.i1 = j; u.i2 = pn; u.i3 = cnt; u.i4 = tl; u.pad = 0; return true;
    }
    __device__ __forceinline__ int arow(const pg8::Unit& u, int rl) const {
        int idx = u.i1 * 256 + rl; idx = idx < u.i3 ? idx : u.i3 - 1;
        return list[(size_t)u.i0 * R + idx];
    }
};
struct EpiUp {
    static constexpr bool PERM = true, MIDSCALE = false;
    bf16_t* hid; const float* cwla; const float* cwlb;
    __device__ __forceinline__ void operator()(const f32x4 (&acc)[2][2][4][2], const pg8::Unit& u, int wr, int wc, int fr, int fq) const {
        const int cls = u.i0, j = u.i1, pn = u.i2, cnt = u.i3, tl = u.i4;
        const float* cw = (pn < 2) ? cwla : cwlb;
        const int colbase = (pn >> 1) * 256 + (pn & 1) * 128 + wc * 32 + 8 * fq;
#pragma unroll
        for (int ai = 0; ai < 2; ++ai)
#pragma unroll
            for (int m = 0; m < 4; ++m) {
                const int rl = ai * 128 + wr * 64 + m * 16 + fr; const int idx = j * 256 + rl; const bool valid = idx < cnt;
                float w = 0.f; if (valid) w = cw[(size_t)cls * R + idx];
                const f32x4 g0 = acc[ai][0][m][0], g1 = acc[ai][0][m][1], u0 = acc[ai][1][m][0], u1 = acc[ai][1][m][1];
                float o[8];
#pragma unroll
                for (int e = 0; e < 4; ++e) { o[e] = w * siluf_(g0[e]) * u0[e]; o[4 + e] = w * siluf_(g1[e]) * u1[e]; }
                if (!valid) {
#pragma unroll
                    for (int e = 0; e < 8; ++e) o[e] = 0.f; }
                u32x4 pk; pk.x = cvt_pk_bf16(o[0], o[1]); pk.y = cvt_pk_bf16(o[2], o[3]); pk.z = cvt_pk_bf16(o[4], o[5]); pk.w = cvt_pk_bf16(o[6], o[7]);
                *(u32x4*)(hid + ((size_t)tl * 256 + rl) * 512 + colbase) = pk;
                asm volatile("" ::: "memory");
            }
    }
};
struct EpiY {
    static constexpr bool PERM = true, MIDSCALE = false;
    bf16_t* Y;
    __device__ __forceinline__ void operator()(const f32x4 (&acc)[2][2][4][2], const pg8::Unit& u, int wr, int wc, int fr, int fq) const {
        const int row0 = u.i4 * 256 + wr * 64 + fr, col0 = u.i2 * 256 + wc * 32 + 8 * fq;
#pragma unroll
        for (int ai = 0; ai < 2; ++ai)
#pragma unroll
            for (int m = 0; m < 4; ++m) { bf16_t* rowp = Y + (size_t)(row0 + ai * 128 + m * 16) * 1024 + col0;
#pragma unroll
                for (int bj = 0; bj < 2; ++bj) { const f32x4 v0 = acc[ai][bj][m][0], v1 = acc[ai][bj][m][1];
                    u32x4 w; w.x = cvt_pk_bf16(v0[0], v0[1]); w.y = cvt_pk_bf16(v0[2], v0[3]); w.z = cvt_pk_bf16(v1[0], v1[1]); w.w = cvt_pk_bf16(v1[2], v1[3]);
                    *(u32x4*)(rowp + bj * 128) = w; } }
    }
};

__device__ __forceinline__ void tr_tile(const float* src, int ldn, int k0, int n0, int nvalid, bf16_t* dst, int ldk, int drow0, float* tile, int kd0 = -1, const float* kscale = nullptr) {
    const int tid = launder_tid();
    if (kd0 < 0) kd0 = k0;
    { const int n = tid & 63; int kk = tid >> 6;
#pragma unroll
      for (int it = 0; it < 8; ++it, kk += 8) tile[kk * 65 + n] = (n < nvalid) ? src[(size_t)(k0 + kk) * ldn + n0 + n] * (kscale ? kscale[kk] : 1.f) : 0.f; }
    __syncthreads();
    { const int k8 = tid & 7, n = tid >> 3;
      if (n < nvalid) { const float* s = tile + (k8 * 8) * 65 + n;
          u32x4 o; o.x = cvt_pk_bf16(s[0], s[65]); o.y = cvt_pk_bf16(s[2 * 65], s[3 * 65]); o.z = cvt_pk_bf16(s[4 * 65], s[5 * 65]); o.w = cvt_pk_bf16(s[6 * 65], s[7 * 65]);
          *(u32x4*)(dst + (size_t)(drow0 + n) * ldk + kd0 + k8 * 8) = o; } }
    __syncthreads();
}
__device__ __forceinline__ void phase_wprep(CP p, unsigned char* lds, int bid, int nb) {
    float* tile = (float*)lds;
    constexpr int I_IN = 16 * 41, I_OUT = 256, I_G = 1024, I_U = 1024, I_D = 1024, I_L = I_IN + I_OUT + I_G + I_U + I_D;
    for (int it = bid; it < 2 * I_L; it += nb) {
        const int l = it / I_L; int r = it - l * I_L;
        if (r < I_IN) { const int kt = r / 41, ntl = r % 41; const int n0 = ntl * 64; const int nv = (DIN - n0) < 64 ? (DIN - n0) : 64;
            tr_tile(p->w_in + (size_t)l * 1024 * DIN, DIN, kt * 64, n0, nv, (bf16_t*)(p->ws + WS_WTIN) + (size_t)l * DIN * 1024, 1024, n0, tile); continue; }
        r -= I_IN;
        if (r < I_OUT) { const int kt = r >> 4, ntl = r & 15;
            tr_tile(p->w_out + (size_t)l * 1024 * 1024, 1024, kt * 64, ntl * 64, 64, (bf16_t*)(p->ws + WS_WTOUT) + (size_t)l * 1024 * 1024, 1024, ntl * 64, tile,
                    (kt * 64 + 512) & 1023, kt >= 8 ? p->ssd_norm_g + l * 512 + (kt * 64 - 512) : nullptr); continue; }
        r -= I_OUT;
        if (r < I_G + I_U) { const int up = r >= I_G; if (up) r -= I_G; const int e = r >> 6, q = r & 63, kt = q >> 2, ntl = q & 3; const int n0 = ntl * 64;
            const float* src = (up ? p->w_up : p->w_gate) + (size_t)(l * 16 + e) * 1024 * 256;
            tr_tile(src, 256, kt * 64, n0, 64, (bf16_t*)(p->ws + WS_WTGU) + (size_t)(l * 16 + e) * 512 * 1024, 1024, (n0 >> 7) * 256 + (n0 & 127) + (up ? 128 : 0), tile); continue; }
        r -= I_G + I_U;
        { const int e = r >> 6, q = r & 63, kt = q >> 4, ntl = q & 15;
          tr_tile(p->w_down + (size_t)(l * 16 + e) * 256 * 1024, 1024, kt * 64, ntl * 64, 64, (bf16_t*)(p->ws + WS_WTD) + (size_t)(l * 16 + e) * 1024 * 256, 256, ntl * 64, tile); }
    }
}
__device__ __forceinline__ void phase_adaln(CP p, unsigned char* lds, int bid, int nb) {
    float* sc = (float*)lds;
    float* red = sc + 3 * 1024;
    const int tid = launder_tid();
    for (int idx = tid; idx < 3 * 1024; idx += NTHREADS) { const int v = idx >> 10, k = idx & 1023; const float cv = (v < 2) ? p->c[v * 1024 + k] : p->c_ctx[k]; sc[idx] = siluf_(cv); }
    __syncthreads();
    float* mod = (float*)(p->ws + WS_MOD);
    for (int it = bid; it < 2 * 96; it += nb) {
        const int l = it / 96, n0 = (it % 96) * 64;
        const int c4 = tid & 15, kr = tid >> 4;
        f32x4 a0 = {0, 0, 0, 0}, a1 = {0, 0, 0, 0}, a2 = {0, 0, 0, 0};
        const float* w = p->w_ada + (size_t)l * 1024 * 6144 + n0 + c4 * 4;
#pragma unroll 4
        for (int k = kr; k < 1024; k += 32) { const f32x4 w4 = *(const f32x4*)(w + (size_t)k * 6144); a0 += sc[k] * w4; a1 += sc[1024 + k] * w4; a2 += sc[2048 + k] * w4; }
        *(f32x4*)(red + (kr * 3 + 0) * 64 + c4 * 4) = a0; *(f32x4*)(red + (kr * 3 + 1) * 64 + c4 * 4) = a1; *(f32x4*)(red + (kr * 3 + 2) * 64 + c4 * 4) = a2;
        __syncthreads();
        if (tid < 192) { const int v = tid >> 6, cc = tid & 63; float s = 0.f;
            for (int q = 0; q < 32; ++q) s += red[(q * 3 + v) * 64 + cc];
            mod[((size_t)l * 3 + v) * 6144 + n0 + cc] = s + p->b_ada[l * 6144 + n0 + cc]; }
        __syncthreads();
    }
}
__device__ __forceinline__ void moe_table(CP p, int l, LAS int* tab) {
    const int* gcount = (const int*)(p->ws + WS_CTL) + l * 32;
    if (threadIdx.x == 0) { int acc = 0; for (int q = 0; q < NCLS; ++q) { const int cn = gcount[q]; tab[q] = acc; tab[32 + q] = cn; acc += (cn + 255) >> 8; } tab[24] = acc; }
    __syncthreads();
}
__device__ __forceinline__ void moe_apply(CP p, int lm, int r, int v, int lane, const LAS int* tab, f32x4 (&xv)[4]) {
    const int pos = ((const int*)(p->ws + WS_POS))[(size_t)lm * R + r];
    const int slot = tab[pos >> 16] * 256 + (pos & 0xffff);
    const bf16_t* y = (const bf16_t*)(p->ws + WS_Y) + (size_t)slot * 1024;
    const float* gate = (const float*)(p->ws + WS_MOD) + ((size_t)lm * 3 + v) * 6144 + 5 * 1024;
#pragma unroll
    for (int j = 0; j < 4; ++j) { const int k = 4 * lane + 256 * j; const u32x2 yv = *(const u32x2*)(y + k); const f32x4 g4 = *(const f32x4*)(gate + k);
        xv[j][0] += g4[0] * bflo(yv.x); xv[j][1] += g4[1] * bfhi(yv.x); xv[j][2] += g4[2] * bflo(yv.y); xv[j][3] += g4[3] * bfhi(yv.y); }
}
__device__ __forceinline__ void phase_r1(CP p, int l, unsigned char* lds, int bid, int nb) {
    float* wdt = (float*)lds;
    float* gm = wdt + 16 * 1024;
    float* sh = gm + 3 * 1024;
    const int tid = launder_tid(); const int lane = tid & 63, wave = tid >> 6;
    const float* mod = (const float*)(p->ws + WS_MOD) + (size_t)l * 3 * 6144;
    const float* win = p->w_in + (size_t)l * 1024 * DIN;
    for (int idx = tid; idx < 16 * 1024; idx += NTHREADS) { const int k = idx >> 4, n = idx & 15; wdt[n * 1024 + k] = win[(size_t)k * DIN + NPROJ + n]; }
    for (int idx = tid; idx < 3 * 1024; idx += NTHREADS) { const int v = idx >> 10, k = idx & 1023; gm[idx] = p->g_mix[l * 1024 + k] * (1.f + mod[v * 6144 + 1024 + k]); sh[idx] = mod[v * 6144 + k]; }
    LAS int* tab = (LAS int*)((LAS unsigned char*)lds + MISC_OFF);
    if (l > 0) moe_table(p, l - 1, tab);
    __syncthreads();
    bf16_t* HX = (bf16_t*)(p->ws + WS_HX); float* DT = (float*)(p->ws + WS_DT);
    for (int r = bid * 8 + wave; r < R; r += nb * 8) {
        const f32x4* hr = (const f32x4*)hin_ptr(p, l, r); const int v = row_v(r);
        f32x4 xv[4]; float ss = 0.f;
#pragma unroll
        for (int j = 0; j < 4; ++j) xv[j] = hr[lane + 64 * j];
        if (l > 0) { moe_apply(p, l - 1, r, v, lane, tab, xv); f32x4* hw = (f32x4*)hptr(p, r);
#pragma unroll
            for (int j = 0; j < 4; ++j) hw[lane + 64 * j] = xv[j]; }
#pragma unroll
        for (int j = 0; j < 4; ++j) ss += xv[j][0] * xv[j][0] + xv[j][1] * xv[j][1] + xv[j][2] * xv[j][2] + xv[j][3] * xv[j][3];
        ss = wave_sum(ss); const float rs = rsqrtf(ss * (1.f / 1024.f) + 1e-6f);
#pragma unroll
        for (int j = 0; j < 4; ++j) { const int k = 4 * lane + 256 * j; const f32x4 g4 = *(const f32x4*)(gm + v * 1024 + k), s4 = *(const f32x4*)(sh + v * 1024 + k);
            xv[j] = xv[j] * rs * g4 + s4;
            u32x2 o; o.x = cvt_pk_bf16(xv[j][0], xv[j][1]); o.y = cvt_pk_bf16(xv[j][2], xv[j][3]);
            *(u32x2*)(HX + (size_t)r * 1024 + k) = o; }
        float mine = 0.f;
#pragma unroll
        for (int n = 0; n < 16; ++n) { float a = 0.f;
#pragma unroll
            for (int j = 0; j < 4; ++j) { const f32x4 w4 = *(const f32x4*)(wdt + n * 1024 + 4 * lane + 256 * j); a += xv[j][0] * w4[0] + xv[j][1] * w4[1] + xv[j][2] * w4[2] + xv[j][3] * w4[3]; }
            a = wave_sum(a); mine = (lane == n) ? a : mine; }
        if (lane < 16) DT[(size_t)r * 16 + lane] = softplusf_(mine + p->dt_bias[l * 16 + lane]);
    }
}
typedef float f32x16 __attribute__((ext_vector_type(16)));
typedef short s16x4 __attribute__((ext_vector_type(4)));
constexpr int ST_ROW = 272;
constexpr int ST_TR128 = 320;
constexpr int ST_TR64 = 192;
constexpr int NCHUNK = SEG / 128;

#define DPP_MOV(v, ctrl, rm, bm) __builtin_bit_cast(float, __builtin_amdgcn_update_dpp(0, __builtin_bit_cast(int, (v)), (ctrl), (rm), (bm), true))
__device__ __forceinline__ float wave_incl_scan(float v, int) {
    float s = v + DPP_MOV(v, 0x111, 0xF, 0xF) + DPP_MOV(v, 0x112, 0xF, 0xF) + DPP_MOV(v, 0x113, 0xF, 0xF);
    s += DPP_MOV(s, 0x114, 0xF, 0xE);
    s += DPP_MOV(s, 0x118, 0xF, 0xC);
    s += DPP_MOV(s, 0x142, 0xA, 0xF);
    s += DPP_MOV(s, 0x143, 0xC, 0xF);
    return s;
}
__device__ __forceinline__ bf16x8 row_frag(const LAS unsigned char* tile, int stride, int row0, int k0, int lane) {
    return *(const LAS bf16x8*)(tile + (row0 + (lane & 31)) * stride + (k0 + 8 * (lane >> 5)) * 2);
}
__device__ __forceinline__ bf16x8 tr_frag(const LAS unsigned char* tile, int stride, int k0, int c0, int lane) {
    const int g = lane >> 4, li = lane & 15, q = li >> 2, pp = li & 3;
    const LAS unsigned char* a0 = tile + (k0 + 8 * (g >> 1) + q) * stride + (c0 + 16 * (g & 1) + 4 * pp) * 2;
    const s16x4 lo = __builtin_amdgcn_ds_read_tr16_b64_v4i16((LAS s16x4*)a0);
    const s16x4 hi = __builtin_amdgcn_ds_read_tr16_b64_v4i16((LAS s16x4*)(a0 + 4 * stride));
    return __builtin_shufflevector(lo, hi, 0, 1, 2, 3, 4, 5, 6, 7);
}
__device__ __forceinline__ u32x4 pack8(const float (&v)[8]) { u32x4 r; r.x = cvt_pk_bf16(v[0], v[1]); r.y = cvt_pk_bf16(v[2], v[3]); r.z = cvt_pk_bf16(v[4], v[5]); r.w = cvt_pk_bf16(v[6], v[7]); return r; }
__device__ __forceinline__ u32x4 pack8s(const float (&v)[8], float sc) { u32x4 r; r.x = cvt_pk_bf16(v[0] * sc, v[1] * sc); r.y = cvt_pk_bf16(v[2] * sc, v[3] * sc); r.z = cvt_pk_bf16(v[4] * sc, v[5] * sc); r.w = cvt_pk_bf16(v[6] * sc, v[7] * sc); return r; }

__device__ __forceinline__ void conv_load(const bf16_t* proj, int row0, int rq, int xch, bool lo_ok, bool hi_ok, u32x4 (&raw)[8]) {
    const bf16_t* base = proj + (size_t)(row0 + 4 * rq) * NPROJ + 1536 + xch;
    unsigned zz; asm volatile("v_mov_b32 %0, 0" : "=v"(zz));
#pragma unroll
    for (int j = 0; j < 8; ++j) {
        if (j < 2) { const bool ok = (rq > 0) || lo_ok; const u32x4 v = *(const u32x4*)(ok ? base + (j - 2) * NPROJ : base);
            raw[j].x = ok ? v.x : zz; raw[j].y = ok ? v.y : zz; raw[j].z = ok ? v.z : zz; raw[j].w = ok ? v.w : zz; }
        else if (j >= 6) { const bool ok = (rq < 31) || hi_ok; const u32x4 v = *(const u32x4*)(ok ? base + (j - 2) * NPROJ : base);
            raw[j].x = ok ? v.x : zz; raw[j].y = ok ? v.y : zz; raw[j].z = ok ? v.z : zz; raw[j].w = ok ? v.w : zz; }
        else raw[j] = *(const u32x4*)(base + (j - 2) * NPROJ);
    }
}
__device__ __forceinline__ void conv_compute(const u32x4 (&raw)[8], const LAS float* wl, int nchl, int wch, float (&o)[4][8]) {
    float w[5][8], bs[8];
#pragma unroll
    for (int j = 0; j < 5; ++j) { const f32x4 w0 = *(const LAS f32x4*)(wl + j * nchl + wch), w1 = *(const LAS f32x4*)(wl + j * nchl + wch + 4);
        w[j][0] = w0[0]; w[j][1] = w0[1]; w[j][2] = w0[2]; w[j][3] = w0[3]; w[j][4] = w1[0]; w[j][5] = w1[1]; w[j][6] = w1[2]; w[j][7] = w1[3]; }
    { const f32x4 b0 = *(const LAS f32x4*)(wl + 5 * nchl + wch), b1 = *(const LAS f32x4*)(wl + 5 * nchl + wch + 4); bs[0] = b0[0]; bs[1] = b0[1]; bs[2] = b0[2]; bs[3] = b0[3]; bs[4] = b1[0]; bs[5] = b1[1]; bs[6] = b1[2]; bs[7] = b1[3]; }
#pragma unroll
    for (int i = 0; i < 4; ++i)
#pragma unroll
        for (int e = 0; e < 8; ++e) o[i][e] = bs[e];
#pragma unroll
    for (int j = 0; j < 8; ++j) {
        float xv[8] = {bflo(raw[j].x), bfhi(raw[j].x), bflo(raw[j].y), bfhi(raw[j].y), bflo(raw[j].z), bfhi(raw[j].z), bflo(raw[j].w), bfhi(raw[j].w)};
#pragma unroll
        for (int i = 0; i < 4; ++i) { const int tap = j - i; if (tap >= 0 && tap < 5) {
#pragma unroll
                for (int e = 0; e < 8; ++e) o[i][e] += w[tap][e] * xv[e]; } }
    }
#pragma unroll
    for (int i = 0; i < 4; ++i)
#pragma unroll
        for (int e = 0; e < 8; ++e) o[i][e] = siluf_(o[i][e]);
}
__device__ __forceinline__ void head_cums(CP p, int l, int row0, int h, int dir, int lane, LAS float* hv) {
    const float A = -expf(p->a_log[l * 16 + dir * 8 + h]);
    const float* DT = (const float*)(p->ws + WS_DT);
    const float d0 = DT[(size_t)(row0 + 2 * lane) * 16 + dir * 8 + h], d1 = DT[(size_t)(row0 + 2 * lane + 1) * 16 + dir * 8 + h];
    const float x0 = d0 * A, x1 = d1 * A;
    const float incl = wave_incl_scan(x0 + x1, lane);
    const float total = __builtin_bit_cast(float, __builtin_amdgcn_readlane(__builtin_bit_cast(int, incl), 63));
    float c0, c1;
    if (dir == 0) { c1 = incl; c0 = incl - x1; } else { c0 = total - (incl - x1 - x0); c1 = total - (incl - x1); }
    hv[dir * 128 + 2 * lane] = c0; hv[dir * 128 + 2 * lane + 1] = c1;
    hv[256 + dir * 128 + 2 * lane] = d0; hv[256 + dir * 128 + 2 * lane + 1] = d1;
    if (lane == 0) hv[512 + dir] = total;
}
__device__ __forceinline__ bf16x8 scale_frag(bf16x8 f, const f32x4 w0, const f32x4 w1) {
    const u32x4 u = __builtin_bit_cast(u32x4, f);
    u32x4 r;
    r.x = cvt_pk_bf16(bflo(u.x) * w0[0], bfhi(u.x) * w0[1]); r.y = cvt_pk_bf16(bflo(u.y) * w0[2], bfhi(u.y) * w0[3]);
    r.z = cvt_pk_bf16(bflo(u.z) * w1[0], bfhi(u.z) * w1[1]); r.w = cvt_pk_bf16(bflo(u.w) * w1[2], bfhi(u.w) * w1[3]);
    return __builtin_bit_cast(bf16x8, r);
}
constexpr int ST_X256 = 576;

__device__ __forceinline__ void phase_c1(CP p, int l, unsigned char* lds_, int bid, int nb) {
    LAS unsigned char* lds = (LAS unsigned char*)lds_;
    LAS unsigned char* tile = lds;
    LAS float* wl = (LAS float*)(lds + 73216);
    const int tid = launder_tid();
    const bf16_t* proj = (const bf16_t*)(p->ws + WS_PROJ); bf16_t* mix = (bf16_t*)(p->ws + WS_HX);
#pragma unroll 1
    for (int u = bid; u < 256 + 512 + (l == DEPTH - 1 ? 0 : 16); u += nb) {
        int S, LEN, pstride, sstride, tok0, ch0;
        if (u < 256) { const int b = u >> 7, cs = (u >> 2) & 31, cc = u & 3; S = 2; LEN = 256; pstride = 64; sstride = 1; tok0 = b * SEG + CTXL + 2 * cs; ch0 = 256 + 64 * cc; }
        else if (u < 768) { const int v = u - 256; const int b = v >> 8, rg = (v >> 2) & 63, cc = v & 3; S = 4; LEN = 64; pstride = 1; sstride = 64; tok0 = b * SEG + CTXL + 256 * rg; ch0 = 64 * cc; }
        else { const int v = u - 768; const int b = v >> 3, cc = v & 7; S = 1; LEN = 256; pstride = 1; sstride = 0; tok0 = b * SEG; ch0 = 64 * cc; }
        const int LP = LEN + 30;
        for (int i = tid; i < 32 * 64; i += NTHREADS) { const int j = i >> 6, c = i & 63; wl[i] = j < 31 ? p->conv_w[((size_t)l * 31 + j) * 512 + ch0 + c] : p->conv_b[l * 512 + ch0 + c]; }
        for (int i = tid; i < S * 30 * 8; i += NTHREADS) { const int pc = i & 7, q = (i >> 3) % 30, sq = (i >> 3) / 30; const int pos = q < 15 ? q : LEN + q;
            unsigned zz; asm volatile("v_mov_b32 %0, 0" : "=v"(zz));
            *(LAS u32x4*)(tile + ((sq * LP + pos) * 64 + pc * 8) * 2) = (u32x4){zz, zz, zz, zz}; }
#pragma unroll 4
        for (int i = tid; i < S * LEN * 8; i += NTHREADS) { const int pc = i & 7, t = i >> 3; const int sq = t / LEN, pos = t - sq * LEN;
            const bf16_t* src = proj + (size_t)(tok0 + sq * sstride + pos * pstride) * NPROJ + ch0 + pc * 8;
            const u32x4 uv = *(const u32x4*)src, gv = *(const u32x4*)(src + 512);
            u32x4 o;
            o.x = cvt_pk_bf16(bflo(uv.x) * sigmoidf_(bflo(gv.x)), bfhi(uv.x) * sigmoidf_(bfhi(gv.x)));
            o.y = cvt_pk_bf16(bflo(uv.y) * sigmoidf_(bflo(gv.y)), bfhi(uv.y) * sigmoidf_(bfhi(gv.y)));
            o.z = cvt_pk_bf16(bflo(uv.z) * sigmoidf_(bflo(gv.z)), bfhi(uv.z) * sigmoidf_(bfhi(gv.z)));
            o.w = cvt_pk_bf16(bflo(uv.w) * sigmoidf_(bflo(gv.w)), bfhi(uv.w) * sigmoidf_(bfhi(gv.w)));
            *(LAS u32x4*)(tile + ((sq * LP + 15 + pos) * 64 + pc * 8) * 2) = o; }
        __syncthreads();
        const int noct = S * LEN / 8;
#pragma unroll 1
        for (int it = tid; it < noct * 32; it += NTHREADS) {
            const int cp = it & 31, oc = it >> 5; const int sq = oc / (LEN / 8), p0 = (oc - sq * (LEN / 8)) * 8;
            const LAS unsigned* base = (const LAS unsigned*)(tile + ((sq * LP + p0) * 64) * 2) + cp;
            float i0[38], i1[38];
#pragma unroll
            for (int k = 0; k < 38; ++k) { const unsigned w = base[k * 32]; i0[k] = bflo(w); i1[k] = bfhi(w); }
            float a0[8], a1[8];
            { const float b0 = wl[31 * 64 + 2 * cp], b1 = wl[31 * 64 + 2 * cp + 1];
#pragma unroll
              for (int i = 0; i < 8; ++i) { a0[i] = b0; a1[i] = b1; } }
#pragma unroll
            for (int j = 0; j < 31; ++j) { typedef float f32x2 __attribute__((ext_vector_type(2))); const f32x2 wj = *(const LAS f32x2*)(wl + j * 64 + 2 * cp); const float w0 = wj[0], w1 = wj[1];
#pragma unroll
                for (int i = 0; i < 8; ++i) { a0[i] += w0 * i0[i + j]; a1[i] += w1 * i1[i + j]; } }
#pragma unroll
            for (int i = 0; i < 8; ++i) { const int tok = tok0 + sq * sstride + (p0 + i) * pstride;
                *(unsigned*)(mix + (size_t)tok * 1024 + 512 + ch0 + 2 * cp) = cvt_pk_bf16(a0[i], a1[i]); }
        }
        __syncthreads();
    }
}
__device__ __forceinline__ void phase_c1_ln(CP p, int l, int bid, int nb) {
    const int tid = launder_tid(); const int lane = tid & 63, wave = tid >> 6;
    bf16_t* mix = (bf16_t*)(p->ws + WS_HX);
    const f32x4 g0 = *(const f32x4*)(p->conv_ln_g + l * 512 + lane * 8), g1 = *(const f32x4*)(p->conv_ln_g + l * 512 + lane * 8 + 4);
    const f32x4 b0 = *(const f32x4*)(p->conv_ln_b + l * 512 + lane * 8), b1 = *(const f32x4*)(p->conv_ln_b + l * 512 + lane * 8 + 4);
    const float gg[8] = {g0[0], g0[1], g0[2], g0[3], g1[0], g1[1], g1[2], g1[3]}, bb[8] = {b0[0], b0[1], b0[2], b0[3], b1[0], b1[1], b1[2], b1[3]};
    for (int r = bid * 8 + wave; r < R; r += nb * 8) {
        u32x4* ptr = (u32x4*)(mix + (size_t)r * 1024 + 512 + lane * 8);
        const u32x4 v = *ptr;
        float y[8] = {bflo(v.x), bfhi(v.x), bflo(v.y), bfhi(v.y), bflo(v.z), bfhi(v.z), bflo(v.w), bfhi(v.w)};
        float s = 0.f;
#pragma unroll
        for (int e = 0; e < 8; ++e) s += y[e];
        const float mu = wave_sum(s) * (1.f / 512.f);
        float q = 0.f;
#pragma unroll
        for (int e = 0; e < 8; ++e) { y[e] -= mu; q += y[e] * y[e]; }
        const float rstd = rsqrtf(wave_sum(q) * (1.f / 512.f) + 1e-5f);
        float o[8];
#pragma unroll
        for (int e = 0; e < 8; ++e) o[e] = siluf_(y[e] * rstd * gg[e] + bb[e]);
        *ptr = pack8(o);
    }
}
__device__ __forceinline__ void phase_s1(CP p, int l, unsigned char* lds_, int bid, int nb) {
    LAS unsigned char* lds = (LAS unsigned char*)lds_;
    LAS unsigned char* Bs = lds;
    LAS unsigned char* Xs = lds + 128 * ST_TR128;
    LAS float* wv = (LAS float*)(Xs + 128 * ST_X256);
    LAS float* hvs = wv + 8 * 128;
    LAS float* cwl = hvs + 4 * 520;
    const int tid = launder_tid(); const int lane = tid & 63, wave = __builtin_amdgcn_readfirstlane(tid >> 6);
    const bf16_t* proj = (const bf16_t*)(p->ws + WS_PROJ);
    const float* cw = p->ssd_conv_w + (size_t)l * 5 * 1024; const float* cbias = p->ssd_conv_b + (size_t)l * 1024;
    float* Sg = (float*)(p->ws + WS_S); float* DEC = (float*)(p->ws + WS_DEC);
    int cur_g = -1;
#pragma unroll 1
    for (int u = bid; u < NB * NCHUNK * 2; u += nb) {
        const int g = u & 1, c = (u >> 1) % NCHUNK, b = (u >> 1) / NCHUNK;
        const int row0 = b * SEG + c * 128;
        const bool lo_ok = !(c == 0 || c == 2), hi_ok = !(c == 1 || c == NCHUNK - 1);
        if (g != cur_g) { cur_g = g;
            for (int i = tid; i < 6 * 384; i += NTHREADS) { const int j = i / 384, lc = i - j * 384; const int gch = lc < 128 ? 512 + g * 128 + lc : g * 256 + (lc - 128);
                cwl[i] = j < 5 ? cw[j * 1024 + gch] : cbias[gch]; } }
        const int hh = wave >> 1, dir = wave & 1, h = 4 * g + hh;
        u32x4 rb[8], rx0[8], rx1[8];
        conv_load(proj, row0, tid >> 4, 512 + g * 128 + (tid & 15) * 8, lo_ok, hi_ok, rb);
        conv_load(proj, row0, tid >> 5, g * 256 + (tid & 31) * 8, lo_ok, hi_ok, rx0);
        conv_load(proj, row0, (tid >> 5) + 16, g * 256 + (tid & 31) * 8, lo_ok, hi_ok, rx1);
        head_cums(p, l, row0, h, dir, lane, hvs + hh * 520);
        __syncthreads();
        {
            const LAS float* hv = hvs + hh * 520; const float tot = hv[512 + dir];
#pragma unroll
            for (int q = 0; q < 2; ++q) { const int lr = lane + 64 * q; wv[wave * 128 + lr] = __expf(tot - hv[dir * 128 + lr]) * hv[256 + dir * 128 + lr]; }
            if (lane == 0) DEC[((size_t)(b * 2 + dir) * NCHUNK + c) * 8 + h] = __expf(tot);
        }
        { float o[4][8];
          conv_compute(rb, cwl, 384, (tid & 15) * 8, o);
#pragma unroll
          for (int i = 0; i < 4; ++i) *(LAS u32x4*)(Bs + (4 * (tid >> 4) + i) * ST_TR128 + (tid & 15) * 16) = pack8(o[i]);
          conv_compute(rx0, cwl, 384, 128 + (tid & 31) * 8, o);
#pragma unroll
          for (int i = 0; i < 4; ++i) *(LAS u32x4*)(Xs + (4 * (tid >> 5) + i) * ST_X256 + (tid & 31) * 16) = pack8(o[i]);
          conv_compute(rx1, cwl, 384, 128 + (tid & 31) * 8, o);
#pragma unroll
          for (int i = 0; i < 4; ++i) *(LAS u32x4*)(Xs + (4 * ((tid >> 5) + 16) + i) * ST_X256 + (tid & 31) * 16) = pack8(o[i]); }
        __syncthreads();
        {
            f32x16 acc[2][4];
#pragma unroll
            for (int t = 0; t < 2; ++t)
#pragma unroll
                for (int q = 0; q < 4; ++q)
#pragma unroll
                    for (int e = 0; e < 16; ++e) acc[t][q][e] = 0.f;
#pragma unroll 2
            for (int kk = 0; kk < 8; ++kk) {
                const LAS float* wp = wv + wave * 128 + 16 * kk + 8 * (lane >> 5);
                const f32x4 w0 = *(const LAS f32x4*)wp, w1 = *(const LAS f32x4*)(wp + 4);
                bf16x8 af[2];
#pragma unroll
                for (int t = 0; t < 2; ++t) af[t] = scale_frag(tr_frag(Xs, ST_X256, 16 * kk, hh * 64 + 32 * t, lane), w0, w1);
#pragma unroll
                for (int q = 0; q < 4; ++q) { const bf16x8 bf = tr_frag(Bs, ST_TR128, 16 * kk, 32 * q, lane);
#pragma unroll
                    for (int t = 0; t < 2; ++t) acc[t][q] = __builtin_amdgcn_mfma_f32_32x32x16_bf16(af[t], bf, acc[t][q], 0, 0, 0); }
            }
            float* So = Sg + ((size_t)((b * 2 + dir) * NCHUNK + c) * 8 + h) * 8192 + (lane & 31);
#pragma unroll
            for (int t = 0; t < 2; ++t)
#pragma unroll
                for (int q = 0; q < 4; ++q)
#pragma unroll
                    for (int e = 0; e < 16; ++e) { const int pr = 32 * t + (e & 3) + 8 * (e >> 2) + 4 * (lane >> 5); So[(size_t)pr * 128 + 32 * q] = acc[t][q][e]; }
        }
        __syncthreads();
    }
}
__device__ __forceinline__ void phase_s2(CP p, int bid, int nb) {
    const int tid = launder_tid();
    const float* Sg = (const float*)(p->ws + WS_S); const float* DEC = (const float*)(p->ws + WS_DEC); bf16_t* HP = (bf16_t*)(p->ws + WS_HP);
    for (int idx = bid * NTHREADS + tid; idx < 2 * 2 * 8 * 64 * 64; idx += nb * NTHREADS) {
        const int n2 = idx & 63, pr = (idx >> 6) & 63, h = (idx >> 12) & 7, dir = (idx >> 15) & 1, b = idx >> 16;
        const size_t inner = (size_t)h * 8192 + pr * 128 + 2 * n2;
        const size_t cbase = (size_t)(b * 2 + dir) * NCHUNK;
        float s0 = 0.f, s1 = 0.f;
#pragma unroll 5
        for (int step = 0; step < NCHUNK; ++step) {
            const int c = dir == 0 ? step : (step < 2 ? 1 - step : NCHUNK + 1 - step);
            const size_t off = (cbase + c) * 65536 + inner;
            const float2 sv = *(const float2*)(Sg + off); const float d = DEC[(cbase + c) * 8 + h];
            *(unsigned*)(HP + off) = cvt_pk_bf16(s0, s1);
            s0 = s0 * d + sv.x; s1 = s1 * d + sv.y;
        }
    }
}
__device__ __forceinline__ void phase_s3(CP p, int l, unsigned char* lds_, int bid, int nb) {
    LAS unsigned char* lds = (LAS unsigned char*)lds_;
    LAS unsigned char* Cs = lds;
    LAS unsigned char* Bs = Cs + 128 * ST_ROW;
    LAS unsigned char* Mt = Bs;
    LAS unsigned char* Xs = Bs + 128 * ST_TR128;
    LAS unsigned char* Hf = Xs + 128 * ST_TR64;
    LAS unsigned char* Hb = Hf + 64 * ST_ROW;
    LAS float* hvs = (LAS float*)(Hb + 64 * ST_ROW);
    LAS float* ssqp = hvs + 4 * 520;
    LAS float* cwl = ssqp + 256;
    const int tid0 = launder_tid(); const int wave = __builtin_amdgcn_readfirstlane(tid0 >> 6);
    const bf16_t* proj = (const bf16_t*)(p->ws + WS_PROJ); bf16_t* mix = (bf16_t*)(p->ws + WS_HX);
    const float* cw = p->ssd_conv_w + (size_t)l * 5 * 1024; const float* cbias = p->ssd_conv_b + (size_t)l * 1024;
    const bf16_t* HP = (const bf16_t*)(p->ws + WS_HP); float* SSQ = (float*)(p->ws + WS_SSQ);
    int cur_g = -1;
#pragma unroll 1
    for (int u = bid; u < NB * NCHUNK * 2; u += nb) {
        const int g = u & 1, c = (u >> 1) % NCHUNK, b = (u >> 1) / NCHUNK;
        if (l == DEPTH - 1 && c < 2) continue;
        int tid = tid0; asm volatile("" : "+v"(tid));
        const int lane = tid & 63;
        const int row0 = b * SEG + c * 128;
        const bool lo_ok = !(c == 0 || c == 2), hi_ok = !(c == 1 || c == NCHUNK - 1);
        if (g != cur_g) { cur_g = g;
            for (int i = tid; i < 6 * 512; i += NTHREADS) { const int j = i >> 9, lc = i & 511; const int gch = lc < 128 ? 768 + g * 128 + lc : (lc < 256 ? 512 + g * 128 + (lc - 128) : g * 256 + (lc - 256));
                cwl[i] = j < 5 ? cw[j * 1024 + gch] : cbias[gch]; } }
        u32x4 rx[8];
        {
            u32x4 r0[8], r1[8];
            const int cg = tid & 31; const int gch = (cg < 16 ? 768 : 512) + g * 128 + (cg & 15) * 8;
            conv_load(proj, row0, tid >> 5, gch, lo_ok, hi_ok, r0);
            conv_load(proj, row0, (tid >> 5) + 16, gch, lo_ok, hi_ok, r1);
            head_cums(p, l, row0, 4 * g + (wave >> 1), wave & 1, lane, hvs + (wave >> 1) * 520);
            __syncthreads();
            float o[4][8];
            LAS unsigned char* dst = (cg < 16 ? Cs : Bs) + (cg & 15) * 16;
            conv_compute(r0, cwl, 512, cg * 8, o);
#pragma unroll
            for (int i = 0; i < 4; ++i) *(LAS u32x4*)(dst + (4 * (tid >> 5) + i) * ST_ROW) = pack8(o[i]);
            asm volatile("" ::: "memory");
            if (tid < 256) conv_load(proj, row0, tid >> 3, g * 256 + (tid & 7) * 8, lo_ok, hi_ok, rx);
            conv_compute(r1, cwl, 512, cg * 8, o);
#pragma unroll
            for (int i = 0; i < 4; ++i) *(LAS u32x4*)(dst + (4 * ((tid >> 5) + 16) + i) * ST_ROW) = pack8(o[i]);
            if (tid < 256) { conv_compute(rx, cwl, 512, 256 + (tid & 7) * 8, o);
#pragma unroll
                for (int i = 0; i < 4; ++i) *(LAS u32x4*)(Xs + (4 * (tid >> 3) + i) * ST_TR64 + (tid & 7) * 16) = pack8(o[i]); }
        }
        __syncthreads();
        const int lb = wave >> 1, hs = wave & 1;
        int ln = lane; asm volatile("" : "+v"(ln));
        f32x16 gacc[2];
#pragma unroll
        for (int t = 0; t < 2; ++t)
#pragma unroll
            for (int e = 0; e < 16; ++e) gacc[t][e] = 0.f;
#pragma unroll
        for (int kk = 0; kk < 8; ++kk) { const bf16x8 af = row_frag(Cs, ST_ROW, 32 * lb, 16 * kk, lane);
#pragma unroll
            for (int t = 0; t < 2; ++t) { const bf16x8 bf = row_frag(Bs, ST_ROW, 64 * hs + 32 * t, 16 * kk, lane);
                gacc[t] = __builtin_amdgcn_mfma_f32_32x32x16_bf16(af, bf, gacc[t], 0, 0, 0); } }
        u32x4 hreg[4];
        { const bf16_t* hp0 = HP + ((size_t)(b * 2 * NCHUNK + c) * 8 + 4 * g) * 8192;
#pragma unroll
          for (int q = 0; q < 4; ++q) { const int it = tid + 512 * q; hreg[q] = *(const u32x4*)(hp0 + (size_t)(it >> 10) * NCHUNK * 8 * 8192 + (it & 1023) * 8); } }
        __syncthreads();
#pragma unroll 1
        for (int hh = 0; hh < 4; ++hh) {
            const int h = 4 * g + hh; const LAS float* hv = hvs + hh * 520;
            asm volatile("" : "+v"(ln));
            const int ph = hs, pc = 32 * ph + (ln & 31);
#pragma unroll
            for (int t = 0; t < 2; ++t) {
                const int sc = 64 * hs + 32 * t + (ln & 31);
                const float cfs = hv[sc], cbs = hv[128 + sc], dfs = hv[256 + sc], dbs = hv[384 + sc];
#pragma unroll
                for (int rg = 0; rg < 4; ++rg) {
                    const int l0 = 32 * lb + 8 * rg + 4 * (ln >> 5);
                    const f32x4 cfl = *(const LAS f32x4*)(hv + l0), cbl = *(const LAS f32x4*)(hv + 128 + l0);
                    float m[4];
#pragma unroll
                    for (int e = 0; e < 4; ++e) { const int lr = l0 + e;
                        const float ff = lr >= sc ? __expf(cfl[e] - cfs) * dfs : 0.f;
                        const float fb = lr <= sc ? __expf(cbl[e] - cbs) * dbs : 0.f;
                        m[e] = gacc[t][4 * rg + e] * (ff + fb); }
                    u32x2 pk; pk.x = cvt_pk_bf16(m[0], m[1]); pk.y = cvt_pk_bf16(m[2], m[3]);
                    *(LAS u32x2*)(Mt + sc * ST_TR128 + l0 * 2) = pk;
                }
            }
#pragma unroll
            for (int q = 0; q < 4; ++q) { const int it = tid + 512 * q; const int q2 = it & 1023;
                *(LAS u32x4*)(((it >> 10) ? Hb : Hf) + (q2 >> 4) * ST_ROW + (q2 & 15) * 16) = hreg[q]; }
            if (hh < 3) {
                const bf16_t* hp0 = HP + ((size_t)(b * 2 * NCHUNK + c) * 8 + h + 1) * 8192;
#pragma unroll
                for (int q = 0; q < 4; ++q) { const int it = tid + 512 * q; hreg[q] = *(const u32x4*)(hp0 + (size_t)(it >> 10) * NCHUNK * 8 * 8192 + (it & 1023) * 8); }
                if (tid < 256) conv_load(proj, row0, tid >> 3, g * 256 + (hh + 1) * 64 + (tid & 7) * 8, lo_ok, hi_ok, rx);
            }
            unsigned zraw[8];
#pragma unroll
            for (int ri = 0; ri < 16; ri += 2) { const int lr = 32 * lb + 8 * (ri >> 2) + 4 * (ln >> 5) + (ri & 3);
                const bf16_t* zp = proj + (size_t)(row0 + lr) * NPROJ + 1024 + h * 64 + pc;
                zraw[ri >> 1] = (unsigned)zp[0] | ((unsigned)zp[NPROJ] << 16); }
            __syncthreads();
            f32x16 ad, af_, ab_;
#pragma unroll
            for (int e = 0; e < 16; ++e) { ad[e] = 0.f; af_[e] = 0.f; ab_[e] = 0.f; }
#pragma unroll
            for (int kk = 0; kk < 8; ++kk) {
                const bf16x8 am = tr_frag(Mt, ST_TR128, 16 * kk, 32 * lb, lane);
                const bf16x8 bx = tr_frag(Xs, ST_TR64, 16 * kk, 32 * ph, lane);
                ad = __builtin_amdgcn_mfma_f32_32x32x16_bf16(am, bx, ad, 0, 0, 0);
                const bf16x8 ac = row_frag(Cs, ST_ROW, 32 * lb, 16 * kk, lane);
                const bf16x8 bhf = row_frag(Hf, ST_ROW, 32 * ph, 16 * kk, lane);
                const bf16x8 bhb = row_frag(Hb, ST_ROW, 32 * ph, 16 * kk, lane);
                af_ = __builtin_amdgcn_mfma_f32_32x32x16_bf16(ac, bhf, af_, 0, 0, 0);
                ab_ = __builtin_amdgcn_mfma_f32_32x32x16_bf16(ac, bhb, ab_, 0, 0, 0);
            }
            const float dsk = p->d_skip[l * 8 + h];
#pragma unroll
            for (int rg = 0; rg < 4; ++rg) {
                const int l0 = 32 * lb + 8 * rg + 4 * (ln >> 5);
                const f32x4 cfl = *(const LAS f32x4*)(hv + l0), cbl = *(const LAS f32x4*)(hv + 128 + l0);
#pragma unroll
                for (int e = 0; e < 4; ++e) { const int lr = l0 + e; const int ri = 4 * rg + e;
                    const float xs = bf2f(*(const LAS bf16_t*)(Xs + lr * ST_TR64 + pc * 2));
                    const float y = ad[ri] + __expf(cfl[e]) * af_[ri] + __expf(cbl[e]) * ab_[ri] + dsk * xs;
                    const float z = (ri & 1) ? bfhi(zraw[ri >> 1]) : bflo(zraw[ri >> 1]);
                    const float val = y * siluf_(z);
                    mix[(size_t)(row0 + lr) * 1024 + h * 64 + pc] = f2bf(val);
                    const float sq = half_sum32(val * val);
                    if ((ln & 31) == 31) ssqp[ph * 128 + lr] = sq;
                }
            }
            __syncthreads();
            if (tid < 128) SSQ[(size_t)(row0 + tid) * 8 + h] = ssqp[tid] + ssqp[128 + tid];
            if (hh < 3 && tid < 256) { float o[4][8];
                conv_compute(rx, cwl, 512, 256 + (hh + 1) * 64 + (tid & 7) * 8, o);
#pragma unroll
                for (int i = 0; i < 4; ++i) *(LAS u32x4*)(Xs + (4 * (tid >> 3) + i) * ST_TR64 + (tid & 7) * 16) = pack8(o[i]); }
        }
        __syncthreads();
    }
}
__device__ __forceinline__ void phase_r2(CP p, int l, unsigned char* lds, int bid, int nb) {
    float* wrt = (float*)lds;
    float* gm = wrt + 20 * 1024;
    float* sh = gm + 3 * 1024;
    int* lcnt = (int*)(sh + 3 * 1024);
    int* lcls = lcnt + 64;
    int* lrank = lcls + 1024;
    float* lcwa = (float*)(lrank + 1024);
    float* lcwb = lcwa + 1024;
    const int tid = launder_tid(); const int lane = tid & 63, wave = tid >> 6;
    const float* mod = (const float*)(p->ws + WS_MOD) + (size_t)l * 3 * 6144;
    for (int idx = tid; idx < 4 * 1024; idx += NTHREADS) { const int k = idx >> 2, n = idx & 3; wrt[n * 1024 + k] = p->w_rg[(size_t)l * 4096 + idx]; }
    for (int idx = tid; idx < 16 * 1024; idx += NTHREADS) { const int k = idx >> 4, n = idx & 15; wrt[(4 + n) * 1024 + k] = p->w_re[(size_t)l * 16384 + idx]; }
    for (int idx = tid; idx < 3 * 1024; idx += NTHREADS) { const int v = idx >> 10, k = idx & 1023; gm[idx] = p->g_ffn[l * 1024 + k] * (1.f + mod[v * 6144 + 4 * 1024 + k]); sh[idx] = mod[v * 6144 + 3 * 1024 + k]; }
    if (tid < 64) lcnt[tid] = 0;
    __syncthreads();
    bf16_t* HM = (bf16_t*)(p->ws + WS_HX); float* CWLA = (float*)(p->ws + WS_CWLA); float* CWLB = (float*)(p->ws + WS_CWLB); int* POS = (int*)(p->ws + WS_POS) + (size_t)l * R;
    int* gcount = (int*)(p->ws + WS_CTL) + l * 32; int* LIST = (int*)(p->ws + WS_LIST);
    const int rpb = (R + nb - 1) / nb, r0 = bid * rpb, r1 = (r0 + rpb) < R ? (r0 + rpb) : R;
    for (int r = r0 + wave; r < r1; r += 8) {
        const int v = row_v(r);
        if (l == DEPTH - 1 && v == 2) { if (lane == 0) lcls[r - r0] = -1; continue; }
        const f32x4* hr = (const f32x4*)hptr(p, r);
        f32x4 xv[4]; float ss = 0.f;
#pragma unroll
        for (int j = 0; j < 4; ++j) { xv[j] = hr[lane + 64 * j]; ss += xv[j][0] * xv[j][0] + xv[j][1] * xv[j][1] + xv[j][2] * xv[j][2] + xv[j][3] * xv[j][3]; }
        ss = wave_sum(ss); const float rs = rsqrtf(ss * (1.f / 1024.f) + 1e-6f);
#pragma unroll
        for (int j = 0; j < 4; ++j) { const int k = 4 * lane + 256 * j; const f32x4 g4 = *(const f32x4*)(gm + v * 1024 + k), s4 = *(const f32x4*)(sh + v * 1024 + k);
            xv[j] = xv[j] * rs * g4 + s4;
            u32x2 o; o.x = cvt_pk_bf16(xv[j][0], xv[j][1]); o.y = cvt_pk_bf16(xv[j][2], xv[j][3]);
            *(u32x2*)(HM + (size_t)r * 1024 + k) = o; }
        float lg[20];
#pragma unroll
        for (int n = 0; n < 20; ++n) { float a = 0.f;
#pragma unroll
            for (int j = 0; j < 4; ++j) { const f32x4 w4 = *(const f32x4*)(wrt + n * 1024 + 4 * lane + 256 * j); a += xv[j][0] * w4[0] + xv[j][1] * w4[1] + xv[j][2] * w4[2] + xv[j][3] * w4[3]; }
            lg[n] = wave_sum(a) + (n < 4 ? p->b_rg[l * 4 + n] : p->b_re[l * 16 + n - 4]); }
        int gsel = 0; float gmax = lg[0];
#pragma unroll
        for (int q = 1; q < 4; ++q) if (lg[q] > gmax) { gmax = lg[q]; gsel = q; }
        float gden = 0.f;
#pragma unroll
        for (int q = 0; q < 4; ++q) gden += __expf(lg[q] - gmax);
        const float gprob = 1.f / gden;
        float el[4];
#pragma unroll
        for (int q = 0; q < 4; ++q) el[q] = gsel == 0 ? lg[4 + q] : (gsel == 1 ? lg[8 + q] : (gsel == 2 ? lg[12 + q] : lg[16 + q]));
        int i0 = 0; float m0 = el[0];
#pragma unroll
        for (int q = 1; q < 4; ++q) if (el[q] > m0) { m0 = el[q]; i0 = q; }
        int i1 = -1; float m1 = -3.0e38f;
#pragma unroll
        for (int q = 0; q < 4; ++q) if (q != i0 && el[q] > m1) { m1 = el[q]; i1 = q; }
        const float w0 = gprob / (1.f + __expf(m1 - m0)), w1 = gprob - w0;
        const int ea = i0 < i1 ? i0 : i1, eb = i0 < i1 ? i1 : i0;
        const float cwa = i0 < i1 ? w0 : w1, cwb = i0 < i1 ? w1 : w0;
        const int pidx = ea == 0 ? eb - 1 : (ea == 1 ? eb + 1 : 5);
        const int cls = gsel * 6 + pidx;
        if (lane == 0) { const int rank = atomicAdd(&lcnt[cls], 1); lcls[r - r0] = cls; lrank[r - r0] = rank; lcwa[r - r0] = cwa; lcwb[r - r0] = cwb; }
    }
    __syncthreads();
    if (tid < NCLS) lcnt[32 + tid] = atomicAdd(&gcount[tid], lcnt[tid]);
    __syncthreads();
    for (int idx = tid; idx < r1 - r0; idx += NTHREADS) { const int cl = lcls[idx]; if (cl < 0) continue; const int pos = lcnt[32 + cl] + lrank[idx]; const size_t li = (size_t)cl * R + pos;
        LIST[li] = r0 + idx; CWLA[li] = lcwa[idx]; CWLB[li] = lcwb[idx]; POS[r0 + idx] = (cl << 16) | pos; }
    __syncthreads();
}
__device__ __forceinline__ void phase_final(CP p, unsigned char* lds, int bid, int nb) {
    const int tid = launder_tid(); const int lane = tid & 63, wave = tid >> 6;
    LAS int* tab = (LAS int*)((LAS unsigned char*)lds + MISC_OFF);
    moe_table(p, DEPTH - 1, tab);
    for (int q = bid * 8 + wave; q < NB * SEQ; q += nb * 8) {
        const int b = q >= SEQ ? 1 : 0; const int r = b * SEG + CTXL + (q - b * SEQ);
        f32x4* hr = (f32x4*)(p->out + (size_t)q * D);
        f32x4 xv[4]; float ss = 0.f;
#pragma unroll
        for (int j = 0; j < 4; ++j) xv[j] = hr[lane + 64 * j];
        moe_apply(p, DEPTH - 1, r, b, lane, tab, xv);
#pragma unroll
        for (int j = 0; j < 4; ++j) ss += xv[j][0] * xv[j][0] + xv[j][1] * xv[j][1] + xv[j][2] * xv[j][2] + xv[j][3] * xv[j][3];
        ss = wave_sum(ss); const float rs = rsqrtf(ss * (1.f / 1024.f) + 1e-6f);
#pragma unroll
        for (int j = 0; j < 4; ++j) { const f32x4 g4 = *(const f32x4*)(p->g_final + 4 * lane + 256 * j); hr[lane + 64 * j] = xv[j] * rs * g4; }
    }
}


#define XB_TMO      128
#define XB_XCNT(j)  (256  + 64 * (j))
#define XB_XSUB(j)  (1280 + 64 * (j))
#define XB_XGEN(j)  (2304 + 64 * (j))
#define XB_TOP      3328
#define XB_TOPGEN   3392
#define XCD_BAR_WORDS 3456
#define XB_SPIN_CAP (1u << 22)
__device__ __forceinline__ unsigned xb_ld(unsigned* p) { return __hip_atomic_load(p, __ATOMIC_RELAXED, __HIP_MEMORY_SCOPE_AGENT); }
__device__ __forceinline__ unsigned xb_add(unsigned* p, unsigned v) { return __hip_atomic_fetch_add(p, v, __ATOMIC_RELAXED, __HIP_MEMORY_SCOPE_AGENT); }
__device__ __forceinline__ unsigned xb_xcc_id() { return (unsigned)__builtin_amdgcn_s_getreg((3 << 11) | 20) & 0xFu; }
#define XB_SPIN(cond, bar) do { unsigned _sp = 0; while (cond) { __builtin_amdgcn_s_sleep(1); \
    if ((++_sp & 255u) == 0u) { if (xb_ld(&(bar)[XB_TMO])) break; if (_sp > XB_SPIN_CAP) { atomicAdd(&(bar)[XB_TMO], 1u); break; } } } } while (0)
struct XcdBarrier { unsigned* bar; unsigned x; volatile LAS unsigned* st; };
__device__ __forceinline__ XcdBarrier xcd_barrier_post(unsigned* bar, volatile LAS unsigned* st) {
    XcdBarrier b; b.bar = bar; b.x = xb_xcc_id(); b.st = st;
    if (threadIdx.x == 0) (void)xb_add(&bar[XB_XCNT(b.x)], 1u);
    return b;
}
__device__ __forceinline__ void xcd_barrier_complete(unsigned* bar, unsigned x, unsigned& nloc, unsigned& nx) {
    const unsigned G = gridDim.x * gridDim.y * gridDim.z;
    unsigned sum, cnt, mine, sp = 0u;
    for (;;) {
        sum = 0u; cnt = 0u; mine = 0u;
#pragma unroll
        for (unsigned j = 0; j < 16; ++j) { const unsigned c = xb_ld(&bar[XB_XCNT(j)]); sum += c; cnt += (c > 0u) ? 1u : 0u; mine = (j == x) ? c : mine; }
        if (sum == G) break;
        __builtin_amdgcn_s_sleep(1);
        if ((++sp & 255u) == 0u) { if (xb_ld(&bar[XB_TMO])) break; if (sp > XB_SPIN_CAP) { atomicAdd(&bar[XB_TMO], 1u); break; } }
    }
    nloc = mine > 0u ? mine : 1u; nx = cnt > 0u ? cnt : 1u;
}
__device__ __forceinline__ void xcd_barrier(const XcdBarrier& b) {
    asm volatile("s_waitcnt vmcnt(0)" ::: "memory");
    __syncthreads();
    if (threadIdx.x == 0) {
        unsigned* bar = b.bar;
        __builtin_amdgcn_s_waitcnt(0);
        unsigned nloc = b.st[0], nx = b.st[1];
        if (nloc == 0u) { xcd_barrier_complete(bar, b.x, nloc, nx); b.st[0] = nloc; b.st[1] = nx; }
        const unsigned old = xb_add(&bar[XB_XSUB(b.x)], 1u);
        const unsigned gen = old / nloc;
        if (old + 1u == (gen + 1u) * nloc) {
            __builtin_amdgcn_fence(__ATOMIC_RELEASE, "agent");
            asm volatile("s_waitcnt vmcnt(0)" ::: "memory");
            const unsigned og = xb_add(&bar[XB_TOP], 1u);
            const unsigned tg = og / nx;
            if (og + 1u == (tg + 1u) * nx) xb_add(&bar[XB_TOPGEN], 1u);
            else XB_SPIN(xb_ld(&bar[XB_TOPGEN]) == tg, bar);
            __builtin_amdgcn_fence(__ATOMIC_ACQUIRE, "agent");
            xb_add(&bar[XB_XGEN(b.x)], 1u);
            asm volatile("s_waitcnt vmcnt(0)" ::: "memory");
        } else {
            XB_SPIN(xb_ld(&bar[XB_XGEN(b.x)]) == gen, bar);
            __builtin_amdgcn_fence(__ATOMIC_ACQUIRE, "agent");
            asm volatile("s_waitcnt vmcnt(0)" ::: "memory");
        }
    }
    __syncthreads();
}

#ifndef PHASE_MASK
#define PHASE_MASK 0xFFFFF
#endif
#define PM(i) ((PHASE_MASK >> (i)) & 1)
#ifndef REPEAT_MASK
#define REPEAT_MASK 0
#endif
#define RP(i) for (int rep_ = 0; rep_ < 1 + ((REPEAT_MASK >> (i)) & 1); ++rep_)
constexpr int PH_PER_LAYER = 9, NPHASES = 1 + DEPTH * PH_PER_LAYER + 1;
__global__ void __launch_bounds__(NTHREADS, 2) mk_fwd(Args args) {
    extern __shared__ __attribute__((aligned(16))) unsigned char lds[];
    cg::grid_group grid = cg::this_grid();
    const __attribute__((address_space(4))) Args* ap = (const __attribute__((address_space(4))) Args*)__builtin_amdgcn_kernarg_segment_ptr();
    const int lo = ap->lo, hi = ap->hi;
    LAS unsigned char* ldsl = (LAS unsigned char*)lds;
    volatile LAS unsigned* xbst = (volatile LAS unsigned*)(ldsl + LDS_BYTES - 16);
    if (threadIdx.x < 4) xbst[threadIdx.x] = 0u;
    __syncthreads();
    (void)xcd_barrier_post((unsigned*)(ap->p.ws + WS_BAR), xbst);
    for (int ph = lo; ph < hi; ++ph) {
        CP p = launder(&ap->p);
        int bid = blockIdx.x, nb = gridDim.x; asm volatile("" : "+s"(bid), "+s"(nb));
        if (ph == 0) { if (PM(0)) RP(0) phase_wprep(p, lds, bid, nb); if (PM(1)) RP(1) phase_adaln(p, lds, bid, nb); }
        else if (ph == NPHASES - 1) { if (PM(12)) phase_final(p, lds, bid, nb); }
        else {
            const int l = (ph - 1) / PH_PER_LAYER, s = (ph - 1) % PH_PER_LAYER;
            if (s == 0) { if (PM(2)) RP(2) { if (rep_ == 0 || l == 0) phase_r1(p, l, lds, bid, nb); } }
            else if (s == 1) { if (PM(3)) RP(3) {
                pg8::DenseSched S; S.init(p->ws + WS_HX, (const bf16_t*)(p->ws + WS_WTIN) + (size_t)l * DIN * 1024, R, NPROJ, 1024, 1024, 1024, nb, bid);
                EpiProj E{(bf16_t*)(p->ws + WS_PROJ)};
                pg8::gemm_phase<EpiProj, pg8::DenseSched, false>(ldsl, 1024, 1024, 1024, S, E);
            } }
            else if (s == 2) { if (PM(4)) RP(4) phase_c1(p, l, lds, bid, nb); if (PM(5)) RP(5) phase_s1(p, l, lds, bid, nb); }
            else if (s == 3) { if (PM(6)) RP(6) phase_s2(p, bid, nb); if (PM(4)) phase_c1_ln(p, l, bid, nb); }
            else if (s == 4) { if (PM(7)) RP(7) phase_s3(p, l, lds, bid, nb); }
            else if (s == 5) { if (PM(8)) RP(8) { if (rep_ == 0 || l == 0) {
                pg8::DenseSched S; S.init(p->ws + WS_HX, (const bf16_t*)(p->ws + WS_WTOUT) + (size_t)l * 1024 * 1024, R, 1024, 1024, 1024, 1024, nb, bid, l == DEPTH - 1);
                EpiResid E{l == 0 ? p->ctx : (const float*)(p->ws + WS_HC), l == 0 ? p->x : (const float*)p->out, (float*)(p->ws + WS_HC), p->out, (const float*)(p->ws + WS_MOD) + (size_t)l * 3 * 6144, (const float*)(p->ws + WS_SSQ)};
                pg8::gemm_phase<EpiResid, pg8::DenseSched, false>(ldsl, 1024, 1024, 1024, S, E);
            } } }
            else if (s == 6) { if (PM(9)) phase_r2(p, l, lds, bid, nb); }
            else if (s == 7) { if (PM(10)) RP(10) {
                LAS int* tab = (LAS int*)(ldsl + MISC_OFF); moe_table(p, l, tab);
                MoeSched S{tab, (const int*)(p->ws + WS_LIST), (const char*)(p->ws + WS_HX), (const char*)(p->ws + WS_WTGU), 0, l, nb, bid};
                EpiUp E{(bf16_t*)(p->ws + WS_HID), (const float*)(p->ws + WS_CWLA), (const float*)(p->ws + WS_CWLB)};
                pg8::gemm_phase<EpiUp, MoeSched, true>(ldsl, 1024, 1024, 1024, S, E);
            } }
            else { if (PM(11)) RP(11) {
                LAS int* tab = (LAS int*)(ldsl + MISC_OFF); moe_table(p, l, tab);
                MoeSched S{tab, (const int*)(p->ws + WS_LIST), (const char*)(p->ws + WS_HID), (const char*)(p->ws + WS_WTD), 1, l, nb, bid};
                EpiY E{(bf16_t*)(p->ws + WS_Y)};
                pg8::gemm_phase<EpiY, MoeSched, false>(ldsl, 512, 256, 512, S, E);
            } }
        }
        if (ph + 1 < hi) { if (ph == lo) grid.sync(); else { XcdBarrier xb; xb.bar = (unsigned*)(launder(&ap->p)->ws + WS_BAR); xb.x = xb_xcc_id(); xb.st = (volatile LAS unsigned*)(ldsl + LDS_BYTES - 16); xcd_barrier(xb); } }
    }
}

extern "C" void kernel_launch(void* const* d_in, const int* in_sizes, int n_in, void* d_out, int out_size, void* d_ws, size_t ws_size, hipStream_t stream) {
    static int grid = 0;
    if (grid == 0) {
        if (n_in != 28 || ws_size < WS_END) { fprintf(stderr, "kernel_launch: unexpected n_in %d or ws_size %zu (< %zu)\n", n_in, ws_size, (size_t)WS_END); grid = -1; return; }
        int dev = 0, cus = 0, per_cu = 0;
        hipGetDevice(&dev); hipDeviceGetAttribute(&cus, hipDeviceAttributeMultiprocessorCount, dev);
        if (hipFuncSetAttribute((const void*)mk_fwd, hipFuncAttributeMaxDynamicSharedMemorySize, LDS_BYTES) != hipSuccess) { fprintf(stderr, "kernel_launch: hipFuncSetAttribute failed\n"); grid = -1; return; }
        if (hipOccupancyMaxActiveBlocksPerMultiprocessor(&per_cu, (const void*)mk_fwd, NTHREADS, LDS_BYTES) != hipSuccess || per_cu < 1) { fprintf(stderr, "kernel_launch: occupancy query says %d\n", per_cu); (void)hipGetLastError(); grid = -1; return; }
        grid = cus;
    }
    if (grid < 0) return;
    (void)hipMemsetAsync((char*)d_ws + WS_CTL, 0, WS_CTL_BYTES, stream);
    Args a{};
    const float** pp = (const float**)&a.p;
    for (int i = 0; i < 28; ++i) pp[i] = (const float*)d_in[i];
    a.p.out = (float*)d_out; a.p.ws = (unsigned char*)d_ws;
#if PER_PHASE_LAUNCH
    for (int ph = 0; ph < NPHASES; ++ph) {
        a.lo = ph; a.hi = ph + 1; void* kargs[] = {&a};
        hipError_t e = hipLaunchCooperativeKernel((const void*)mk_fwd, dim3(grid), dim3(NTHREADS), kargs, LDS_BYTES, stream);
        if (e != hipSuccess) { fprintf(stderr, "kernel_launch: launch of phase %d failed: %s\n", ph, hipGetErrorString(e)); break; }
    }
#else
    a.lo = 0; a.hi = NPHASES; void* kargs[] = {&a};
    hipError_t e = hipLaunchCooperativeKernel((const void*)mk_fwd, dim3(grid), dim3(NTHREADS), kargs, LDS_BYTES, stream);
    if (e != hipSuccess) fprintf(stderr, "kernel_launch: cooperative launch failed: %s (grid %d)\n", hipGetErrorString(e), grid);
#endif
}
```

```cpp
#include <hip/hip_runtime.h>
#include <hip/hip_cooperative_groups.h>
#include <cstdio>
namespace cg = cooperative_groups;

#ifndef PER_PHASE_LAUNCH
#define PER_PHASE_LAUNCH 0
#endif

#ifndef S3REP
#define S3REP 0
#endif
#define S3R(i) for (int r3_ = 0; r3_ < 1 + ((S3REP >> (i)) & 1); ++r3_)
#define LAS __attribute__((address_space(3)))
typedef unsigned short bf16_t;
typedef short bf16x8 __attribute__((ext_vector_type(8)));
typedef float f32x4 __attribute__((ext_vector_type(4)));
typedef unsigned u32x4 __attribute__((ext_vector_type(4)));
typedef unsigned u32x2 __attribute__((ext_vector_type(2)));

constexpr int D = 1024, NB = 2, SEQ = 16384, CTXL = 256, SEG = SEQ + CTXL, R = NB * SEG, DEPTH = 2;
constexpr int NPROJ = 2560, DIN = 2576;
constexpr int NTHREADS = 512;
constexpr int LDS_BYTES = 163840;
constexpr int MISC_OFF = 131072;
constexpr int NCLS = 24;

constexpr size_t al256(size_t x) { return (x + 255) & ~size_t(255); }
constexpr size_t WS_CTL = 0;
constexpr size_t WS_BAR = 4096;
constexpr size_t WS_CTL_BYTES = 32768;
constexpr size_t WS_MOD = WS_CTL_BYTES;
constexpr size_t WS_WTIN = WS_MOD + al256((size_t)2 * 3 * 6144 * 4);
constexpr size_t WS_WTOUT = WS_WTIN + al256((size_t)2 * DIN * 1024 * 2);
constexpr size_t WS_WTGU = WS_WTOUT + al256((size_t)2 * 1024 * 1024 * 2);
constexpr size_t WS_WTD = WS_WTGU + al256((size_t)2 * 16 * 512 * 1024 * 2);
constexpr size_t WS_HC = WS_WTD + al256((size_t)2 * 16 * 1024 * 256 * 2);
constexpr size_t WS_HX = WS_HC + al256((size_t)512 * 1024 * 4);
constexpr size_t WS_PROJ = WS_HX + al256((size_t)R * 1024 * 2);
constexpr size_t WS_DT = WS_PROJ + al256((size_t)R * NPROJ * 2);
constexpr size_t WS_POS = WS_DT + al256((size_t)R * 16 * 4);
constexpr size_t WS_LIST = WS_POS + al256((size_t)2 * R * 4);
constexpr size_t WS_CWLA = WS_LIST + al256((size_t)NCLS * R * 4);
constexpr size_t WS_CWLB = WS_CWLA + al256((size_t)NCLS * R * 4);
constexpr size_t WS_BIG = WS_CWLB + al256((size_t)NCLS * R * 4);
constexpr size_t WS_Y = WS_PROJ;
constexpr size_t WS_S = WS_BIG;
constexpr size_t WS_HP = WS_S + al256((size_t)2 * 2 * 130 * 8 * 8192 * 4);
constexpr size_t WS_DEC = WS_HP + al256((size_t)2 * 2 * 130 * 8 * 8192 * 2);
constexpr size_t WS_SSQ = WS_DEC + al256((size_t)2 * 2 * 130 * 8 * 4);
constexpr size_t WS_HID = WS_S;
constexpr size_t WS_END = WS_SSQ + al256((size_t)R * 8 * 4);
static_assert((size_t)(R + NCLS * 256) * 512 * 2 <= (size_t)2 * 2 * 130 * 8 * 8192 * 4, "hid alias");
static_assert(WS_END <= (size_t)512 * 1024 * 1024, "workspace");

struct Params {
    const float *x, *c, *ctx, *c_ctx, *w_ada, *b_ada, *g_mix, *g_ffn, *w_in, *conv_w, *conv_b, *conv_ln_g, *conv_ln_b, *ssd_conv_w, *ssd_conv_b,
        *dt_bias, *a_log, *d_skip, *ssd_norm_g, *w_out, *w_rg, *b_rg, *w_re, *b_re, *w_gate, *w_up, *w_down, *g_final;
    float* out; unsigned char* ws;
};
struct Args { Params p; int lo, hi; };
typedef const __attribute__((address_space(4))) Params* CP;
__device__ __forceinline__ CP launder(CP p) { asm volatile("" : "+s"(p)); return p; }
__device__ __forceinline__ int launder_tid() { int t = threadIdx.x; asm volatile("" : "+v"(t)); return t; }

__device__ __forceinline__ unsigned cvt_pk_bf16(float lo, float hi) { unsigned r; asm("v_cvt_pk_bf16_f32 %0, %1, %2" : "=v"(r) : "v"(lo), "v"(hi)); return r; }
__device__ __forceinline__ float bf2f(unsigned b) { return __uint_as_float(b << 16); }
__device__ __forceinline__ float bflo(unsigned w) { return __uint_as_float(w << 16); }
__device__ __forceinline__ float bfhi(unsigned w) { return __uint_as_float(w & 0xffff0000u); }
__device__ __forceinline__ bf16_t f2bf(float f) { return (bf16_t)(cvt_pk_bf16(f, 0.f) & 0xffffu); }
#define DPP_ADD(v, ctrl, rm) ((v) + __builtin_bit_cast(float, __builtin_amdgcn_update_dpp(0, __builtin_bit_cast(int, (v)), (ctrl), (rm), 0xF, true)))
__device__ __forceinline__ float row_sum16(float v) {
    v = DPP_ADD(v, 0xB1, 0xF);
    v = DPP_ADD(v, 0x4E, 0xF);
    v = DPP_ADD(v, 0x141, 0xF);
    v = DPP_ADD(v, 0x140, 0xF);
    return v;
}
__device__ __forceinline__ float half_sum32(float v) { v = row_sum16(v); v = DPP_ADD(v, 0x142, 0xA); return v; }
__device__ __forceinline__ float wave_sum(float v) {
    v = half_sum32(v); v = DPP_ADD(v, 0x143, 0xC);
    return __builtin_bit_cast(float, __builtin_amdgcn_readlane(__builtin_bit_cast(int, v), 63));
}
__device__ __forceinline__ float sigmoidf_(float x) { return 1.f / (1.f + __expf(-x)); }
__device__ __forceinline__ float siluf_(float x) { return x / (1.f + __expf(-x)); }
__device__ __forceinline__ float softplusf_(float x) { return fmaxf(x, 0.f) + log1pf(expf(-fabsf(x))); }

__device__ __forceinline__ int row_b(int r) { return r >= SEG ? 1 : 0; }
__device__ __forceinline__ int row_i(int r) { return r >= SEG ? r - SEG : r; }
__device__ __forceinline__ int row_v(int r) { const int i = row_i(r); return i < CTXL ? 2 : row_b(r); }
__device__ __forceinline__ float* hptr2(float* hc, float* out, int r) {
    const int b = row_b(r), i = row_i(r);
    return i < CTXL ? hc + (size_t)(b * CTXL + i) * D : out + (size_t)(b * SEQ + i - CTXL) * D;
}
__device__ __forceinline__ float* hptr(CP p, int r) { return hptr2((float*)(p->ws + WS_HC), p->out, r); }
__device__ __forceinline__ const float* hin_ptr(CP p, int l, int r) {
    if (l == 0) return hptr2((float*)p->ctx, (float*)p->x, r);
    return hptr(p, r);
}

namespace pg8 {
constexpr int BM = 256, BK = 64, HALF = 128, HTB = HALF * BK * 2, STAGE_BYTES = 8 * HTB, NXCD = 8, WGM = 8;
__device__ __forceinline__ int lds_byte(int r, int c) { const int st = (r >> 4) * 2 + (c >> 5), rr = r & 15, cc = c & 31, ob = rr * 64 + cc * 2; return st * 1024 + (ob ^ (((ob >> 9) & 1) << 5)); }
__device__ __forceinline__ void stage_rc(int b, int& Rr, int& Cc) { const int st = b / 1024, sb = b % 1024, swz = sb ^ (((sb >> 9) & 1) << 5); Rr = (st >> 1) * 16 + swz / 64; Cc = (st & 1) * 32 + (swz % 64) / 2; }
__device__ __forceinline__ int perm32(int rho) { const int n = rho >> 4, i = rho & 15; return 8 * (i >> 2) + 4 * n + (i & 3); }

struct Unit {
    const char* a0;
    const char* b0;
    const char* b1;
    int i0, i1, i2, i3, i4, pad;
};

template <class Epi, class Sched, bool GATHER>
__device__ __forceinline__ void gemm_phase(LAS unsigned char* lds, const int lda, const int ldb, const int K, const Sched& S, const Epi& E) {
    const int tid = launder_tid(); const int wid = __builtin_amdgcn_readfirstlane(tid >> 6), lane = tid & 63, wr = wid >> 2, wc = wid & 3, fr = lane & 15, fq = lane >> 4;
    const int nt = K / BK, ks = nt >> 1;
    int Rr[2], Cc[2];
    unsigned voffB[2];
#pragma unroll
    for (int i = 0; i < 2; ++i) { stage_rc(tid * 16 + i * 8192, Rr[i], Cc[i]); const int Rb = Epi::PERM ? ((Rr[i] & ~31) + perm32(Rr[i] & 31)) : Rr[i];
        voffB[i] = (unsigned)(Rb * ldb + Cc[i]) * 2u; }
    const size_t kstep = (size_t)(BK * 2);
    const size_t hstepB = (size_t)HALF * ldb * 2;
    const unsigned ldsw = (unsigned)wid * 1024u;
    const unsigned ldsbase = (unsigned)(unsigned long)lds;
    const int aoff = lds_byte(wr * 64 + fr, fq * 8), boff = lds_byte(wc * 32 + fr, fq * 8);
#define PG8_SA(b, h) (((b) * 2 + (h)) * HTB)
#define PG8_SB(b, h) ((4 + (b) * 2 + (h)) * HTB)
#define PG8_STAGE2(bufoff, gbase, v0, v1) do { unsigned keep_; \
        asm volatile("s_mov_b32 %0, m0\n\ts_mov_b32 m0, %1\n\ts_nop 4\n\tglobal_load_lds_dwordx4 %2, %4\n\ts_add_u32 m0, m0, 0x2000\n\ts_nop 0\n\tglobal_load_lds_dwordx4 %3, %4\n\ts_mov_b32 m0, %0" \
            : "=&s"(keep_) : "s"(ldsbase + (unsigned)(bufoff) + ldsw), "v"(v0), "v"(v1), "s"(gbase) : "memory", "scc"); } while (0)
#define PG8_LDA(dst, b, h) do { _Pragma("unroll") for (int m = 0; m < 4; ++m) _Pragma("unroll") for (int k = 0; k < 2; ++k) dst[m][k] = *(const LAS bf16x8*)(lds + PG8_SA(b, h) + aoff + m * 2048 + k * 1024); } while (0)
#define PG8_LDB(dst, b, h) do { _Pragma("unroll") for (int n = 0; n < 2; ++n) _Pragma("unroll") for (int k = 0; k < 2; ++k) dst[n][k] = *(const LAS bf16x8*)(lds + PG8_SB(b, h) + boff + n * 2048 + k * 1024); } while (0)
#define PG8_MMA(ai, bj, At, Bt) do { __builtin_amdgcn_s_setprio(1); _Pragma("unroll") for (int m = 0; m < 4; ++m) _Pragma("unroll") for (int n = 0; n < 2; ++n) _Pragma("unroll") for (int k = 0; k < 2; ++k) \
        acc[ai][bj][m][n] = __builtin_amdgcn_mfma_f32_16x16x32_bf16(Bt[n][k], At[m][k], acc[ai][bj][m][n], 0, 0, 0); __builtin_amdgcn_s_setprio(0); } while (0)
#define PG8_WAIT_V(n) asm volatile("s_waitcnt vmcnt(" #n ")" ::: "memory")
#define PG8_WAIT_L(n) asm volatile("s_waitcnt lgkmcnt(" #n ")" ::: "memory")
#define PG8_BAR __builtin_amdgcn_s_barrier()
#define PG8_SCHED __builtin_amdgcn_sched_barrier(0)
#define PG8_BP(u, tt) ((tt) < ks ? (u).b0 + (size_t)(tt) * kstep : (u).b1 + (size_t)((tt) - ks) * kstep)
    Unit cur, nxt; int ui = 0;
    if (!S.get(0, cur)) return;
    unsigned c00, c01, c10, c11, n00, n01, n10, n11;
    if (GATHER) {
        c00 = (unsigned)(S.arow(cur, Rr[0]) * lda + Cc[0]) * 2u; c01 = (unsigned)(S.arow(cur, Rr[1]) * lda + Cc[1]) * 2u;
        c10 = (unsigned)(S.arow(cur, HALF + Rr[0]) * lda + Cc[0]) * 2u; c11 = (unsigned)(S.arow(cur, HALF + Rr[1]) * lda + Cc[1]) * 2u;
    } else {
        c00 = (unsigned)(Rr[0] * lda + Cc[0]) * 2u; c01 = (unsigned)(Rr[1] * lda + Cc[1]) * 2u;
        c10 = (unsigned)((HALF + Rr[0]) * lda + Cc[0]) * 2u; c11 = (unsigned)((HALF + Rr[1]) * lda + Cc[1]) * 2u;
    }
    n00 = c00; n01 = c01; n10 = c10; n11 = c11;
    f32x4 acc[2][2][4][2];
    float zr; asm volatile("v_mov_b32 %0, 0" : "=v"(zr));
#pragma unroll
    for (int a = 0; a < 2; ++a)
#pragma unroll
        for (int b = 0; b < 2; ++b)
#pragma unroll
            for (int m = 0; m < 4; ++m)
#pragma unroll
                for (int n = 0; n < 2; ++n) acc[a][b][m][n] = (f32x4){zr, zr, zr, zr};
    bf16x8 At[4][2], B0[2][2], B1[2][2];
    const char* cA = cur.a0;
    {
        const char* pb0 = PG8_BP(cur, 0); const char* pb1 = PG8_BP(cur, 1);
        PG8_STAGE2(PG8_SB(0, 0), pb0, voffB[0], voffB[1]); PG8_STAGE2(PG8_SA(0, 0), cA, c00, c01);
        PG8_STAGE2(PG8_SB(0, 1), pb0 + hstepB, voffB[0], voffB[1]); PG8_STAGE2(PG8_SA(0, 1), cA, c10, c11);
        if (wr == 1) PG8_BAR;
        PG8_WAIT_V(4); PG8_BAR;
        PG8_STAGE2(PG8_SB(1, 0), pb1, voffB[0], voffB[1]); PG8_STAGE2(PG8_SA(1, 0), cA + kstep, c00, c01);
        PG8_STAGE2(PG8_SB(1, 1), pb1 + hstepB, voffB[0], voffB[1]);
        PG8_WAIT_V(6); PG8_BAR;
    }
    for (;;) {
        const bool has_next = S.get(ui + 1, nxt);
        if (!has_next) nxt = cur;
        if (GATHER) {
            if (has_next) {
                n00 = (unsigned)(S.arow(nxt, Rr[0]) * lda + Cc[0]) * 2u; n01 = (unsigned)(S.arow(nxt, Rr[1]) * lda + Cc[1]) * 2u;
                n10 = (unsigned)(S.arow(nxt, HALF + Rr[0]) * lda + Cc[0]) * 2u; n11 = (unsigned)(S.arow(nxt, HALF + Rr[1]) * lda + Cc[1]) * 2u;
            } else { n00 = c00; n01 = c01; n10 = c10; n11 = c11; }
        }
        const char* nA = nxt.a0;
#pragma unroll 1
        for (int t = 0; t < nt; t += 2) {
            const bool last = (t == nt - 2);
            const char* a1 = cA + (size_t)(t + 1) * kstep;
            const char* a2 = last ? nA : cA + (size_t)(t + 2) * kstep;
            const char* a3 = a2 + kstep;
            const char* b2 = last ? PG8_BP(nxt, 0) : PG8_BP(cur, t + 2);
            const char* b3 = last ? PG8_BP(nxt, 1) : PG8_BP(cur, t + 3);
            const unsigned s00 = last ? n00 : c00, s01 = last ? n01 : c01, s10 = last ? n10 : c10, s11 = last ? n11 : c11;
            if constexpr (Epi::MIDSCALE) { if (t == ks) E.midscale(acc, cur, wr, wc, fr, fq); }
            PG8_LDB(B0, 0, 0); PG8_SCHED; PG8_LDA(At, 0, 0); PG8_STAGE2(PG8_SA(1, 1), a1, c10, c11);
            PG8_WAIT_L(8); PG8_BAR; PG8_WAIT_L(0); PG8_MMA(0, 0, At, B0); PG8_BAR; PG8_SCHED;
            PG8_LDB(B1, 0, 1); PG8_STAGE2(PG8_SB(0, 0), b2, voffB[0], voffB[1]);
            PG8_BAR; PG8_WAIT_L(0); PG8_MMA(0, 1, At, B1); PG8_BAR;
            PG8_LDA(At, 0, 1); PG8_STAGE2(PG8_SA(0, 0), a2, s00, s01);
            PG8_BAR; PG8_WAIT_L(0); PG8_MMA(1, 0, At, B0); PG8_BAR; PG8_SCHED;
            PG8_STAGE2(PG8_SB(0, 1), b2 + hstepB, voffB[0], voffB[1]);
            PG8_WAIT_V(6); PG8_BAR; PG8_MMA(1, 1, At, B1); PG8_BAR;
            PG8_LDB(B0, 1, 0); PG8_SCHED; PG8_LDA(At, 1, 0); PG8_STAGE2(PG8_SA(0, 1), a2, s10, s11);
            PG8_WAIT_L(8); PG8_BAR; PG8_WAIT_L(0); PG8_MMA(0, 0, At, B0); PG8_BAR; PG8_SCHED;
            PG8_LDB(B1, 1, 1); PG8_STAGE2(PG8_SB(1, 0), b3, voffB[0], voffB[1]);
            PG8_BAR; PG8_WAIT_L(0); PG8_MMA(0, 1, At, B1); PG8_BAR;
            PG8_LDA(At, 1, 1); PG8_STAGE2(PG8_SA(1, 0), a3, s00, s01);
            PG8_BAR; PG8_WAIT_L(0); PG8_MMA(1, 0, At, B0); PG8_BAR; PG8_SCHED;
            PG8_STAGE2(PG8_SB(1, 1), b3 + hstepB, voffB[0], voffB[1]);
            PG8_WAIT_V(6); PG8_BAR; PG8_MMA(1, 1, At, B1); PG8_BAR;
        }
        E(acc, cur, wr, wc, fr, fq);
        if (!has_next) break;
        asm volatile("v_mov_b32 %0, 0" : "=v"(zr));
#pragma unroll
        for (int a = 0; a < 2; ++a)
#pragma unroll
            for (int b = 0; b < 2; ++b)
#pragma unroll
                for (int m = 0; m < 4; ++m)
#pragma unroll
                    for (int n = 0; n < 2; ++n) acc[a][b][m][n] = (f32x4){zr, zr, zr, zr};
        cur = nxt; cA = nA; ++ui; c00 = n00; c01 = n01; c10 = n10; c11 = n11;
    }
    PG8_WAIT_V(0);
    if (wr == 0) PG8_BAR;
    PG8_BAR;
#undef PG8_SA
#undef PG8_SB
#undef PG8_STAGE2
#undef PG8_LDA
#undef PG8_LDB
#undef PG8_MMA
#undef PG8_WAIT_V
#undef PG8_WAIT_L
#undef PG8_BAR
#undef PG8_SCHED
#undef PG8_BP
}

struct DenseSched {
    const char* A; const char* Bt; int lda, ldb, K; int nM, nN, nwg, G, c, skipctx;
    __device__ __forceinline__ void init(const void* A_, const void* Bt_, int M, int N, int K_, int lda_, int ldb_, int G_, int c_, int skipctx_ = 0) {
        A = (const char*)A_; Bt = (const char*)Bt_; lda = lda_; ldb = ldb_; K = K_; nM = M / BM - 2 * skipctx_; nN = N / BM; nwg = nM * nN; G = G_; c = c_; skipctx = skipctx_; }
    __device__ __forceinline__ bool get(int i, Unit& u) const {
        const long L = (long)i * G + c; if (L >= nwg) return false;
        int wgid = (int)L; { const int q = nwg / NXCD, r = nwg % NXCD, xcd = wgid % NXCD, off = wgid / NXCD; wgid = (xcd < r ? xcd * (q + 1) : r * (q + 1) + (xcd - r) * q) + off; }
        const int nig = WGM * nN, gid = wgid / nig, fm = gid * WGM, gsz = (nM - fm) < WGM ? (nM - fm) : WGM;
        int pm = fm + ((wgid % nig) % gsz); const int pn = (wgid % nig) / gsz;
        if (skipctx) pm += 1 + (pm >= 64 ? 1 : 0);
        u.a0 = A + (size_t)pm * BM * lda * 2; u.b0 = Bt + (size_t)pn * BM * ldb * 2; u.b1 = u.b0 + (size_t)(K / BK / 2) * BK * 2;
        u.i0 = pm; u.i1 = pn; u.i2 = 0; u.i3 = 0; u.i4 = 0; u.pad = 0; return true;
    }
    __device__ __forceinline__ int arow(const Unit&, int rl) const { return rl; }
};
}

struct EpiProj {
    static constexpr bool PERM = true, MIDSCALE = false;
    bf16_t* O;
    __device__ __forceinline__ void operator()(const f32x4 (&acc)[2][2][4][2], const pg8::Unit& u, int wr, int wc, int fr, int fq) const {
        const int row0 = u.i0 * 256 + wr * 64 + fr, col0 = u.i1 * 256 + wc * 32 + 8 * fq;
#pragma unroll
        for (int ai = 0; ai < 2; ++ai)
#pragma unroll
            for (int m = 0; m < 4; ++m) { bf16_t* rowp = O + (size_t)(row0 + ai * 128 + m * 16) * NPROJ + col0;
#pragma unroll
                for (int bj = 0; bj < 2; ++bj) { const f32x4 v0 = acc[ai][bj][m][0], v1 = acc[ai][bj][m][1];
                    u32x4 w; w.x = cvt_pk_bf16(v0[0], v0[1]); w.y = cvt_pk_bf16(v0[2], v0[3]); w.z = cvt_pk_bf16(v1[0], v1[1]); w.w = cvt_pk_bf16(v1[2], v1[3]);
                    *(u32x4*)(rowp + bj * 128) = w; } }
    }
};
struct EpiResid {
    static constexpr bool PERM = false, MIDSCALE = true;
    const float* inc; const float* inx; float* hc; float* out; const float* modl; const float* ssq;
    __device__ __forceinline__ void midscale(f32x4 (&acc)[2][2][4][2], const pg8::Unit& u, int wr, int wc, int fr, int fq) const {
        const int r0 = u.i0 * 256 + wr * 64 + fr;
#pragma unroll
        for (int ai = 0; ai < 2; ++ai)
#pragma unroll
            for (int m = 0; m < 4; ++m) { const float* sp = ssq + (size_t)(r0 + ai * 128 + m * 16) * 8;
                const f32x4 a = *(const f32x4*)sp, b = *(const f32x4*)(sp + 4);
                const float rs = rsqrtf(((a[0] + a[1]) + (a[2] + a[3]) + (b[0] + b[1]) + (b[2] + b[3])) * (1.f / 512.f) + 1e-6f);
#pragma unroll
                for (int bj = 0; bj < 2; ++bj)
#pragma unroll
                    for (int n = 0; n < 2; ++n) acc[ai][bj][m][n] *= rs;
                asm volatile("" ::: "memory"); }
    }
    __device__ __forceinline__ void operator()(const f32x4 (&acc)[2][2][4][2], const pg8::Unit& u, int wr, int wc, int fr, int fq) const {
        const int r0 = u.i0 * 256;
        const int v = row_v(r0);
        const float* gate = modl + (size_t)v * 6144 + 2 * 1024;
        const float* hin = hptr2((float*)inc, (float*)inx, r0); float* hout = hptr2(hc, out, r0);
        const int rl0 = wr * 64 + fr, col0 = u.i1 * 256 + wc * 32 + 4 * fq;
        f32x4 gv[2][2];
#pragma unroll
        for (int bj = 0; bj < 2; ++bj)
#pragma unroll
            for (int n = 0; n < 2; ++n) gv[bj][n] = *(const f32x4*)(gate + col0 + bj * 128 + n * 16);
#pragma unroll
        for (int ai = 0; ai < 2; ++ai)
#pragma unroll
            for (int m = 0; m < 4; ++m) { const size_t off = (size_t)(rl0 + ai * 128 + m * 16) * D + col0;
#pragma unroll
                for (int bj = 0; bj < 2; ++bj)
#pragma unroll
                    for (int n = 0; n < 2; ++n) { const f32x4 hi = *(const f32x4*)(hin + off + bj * 128 + n * 16);
                        *(f32x4*)(hout + off + bj * 128 + n * 16) = hi + gv[bj][n] * acc[ai][bj][m][n]; }
                if (m & 1) asm volatile("" ::: "memory"); }
    }
};

struct MoeSched {
    const LAS int* tab;
    const int* list;
    const char* A; const char* W; int mode  , l, G, c;
    __device__ __forceinline__ bool get(int i, pg8::Unit& u) const {
        const int L = i * G + c; const int total = __builtin_amdgcn_readfirstlane(tab[24]) * 4; if (L >= total) return false;
        const int tl = L >> 2, pn = L & 3;
        int cls = 0;
#pragma unroll 1
        for (int q = 1; q < NCLS; ++q) { const int tq = __builtin_amdgcn_readfirstlane(tab[q]); if (tq <= tl) cls = q; }
        const int j = tl - __builtin_amdgcn_readfirstlane(tab[cls]), cnt = __builtin_amdgcn_readfirstlane(tab[32 + cls]);
        const int g = cls / 6, pidx = cls - g * 6;
        const int ea = (pidx >= 3) + (pidx >= 5), eb = pidx < 3 ? pidx + 1 : (pidx < 5 ? pidx - 1 : 3);
        if (mode == 0) {
            const int e = 4 * g + (pn < 2 ? ea : eb);
            u.a0 = A;
            u.b0 = W + ((size_t)(l * 16 + e) * 512 + (size_t)(pn & 1) * 256) * 1024 * 2; u.b1 = u.b0 + (size_t)8 * 128;
        } else {
            u.a0 = A + (size_t)tl * 256 * 512 * 2;
            u.b0 = W + ((size_t)(l * 16 + 4 * g + ea) * 1024 + (size_t)pn * 256) * 256 * 2;
            u.b1 = W + ((size_t)(l * 16 + 4 * g + eb) * 1024 + (size_t)pn * 256) * 256 * 2;
        }
        u.i0 = cls; u.i1 = j; u.i2 = pn; u.i3 = cnt; u.i4 = tl; u.pad = 0; return true;
    }
    __device__ __forceinline__ int arow(const pg8::Unit& u, int rl) const {
        int idx = u.i1 * 256 + rl; idx = idx < u.i3 ? idx : u.i3 - 1;
        return list[(size_t)u.i0 * R + idx];
    }
};
struct EpiUp {
    static constexpr bool PERM = true, MIDSCALE = false;
    bf16_t* hid; const float* cwla; const float* cwlb;
    __device__ __forceinline__ void operator()(const f32x4 (&acc)[2][2][4][2], const pg8::Unit& u, int wr, int wc, int fr, int fq) const {
        const int cls = u.i0, j = u.i1, pn = u.i2, cnt = u.i3, tl = u.i4;
        const float* cw = (pn < 2) ? cwla : cwlb;
        const int colbase = (pn >> 1) * 256 + (pn & 1) * 128 + wc * 32 + 8 * fq;
#pragma unroll
        for (int ai = 0; ai < 2; ++ai)
#pragma unroll
            for (int m = 0; m < 4; ++m) {
                const int rl = ai * 128 + wr * 64 + m * 16 + fr; const int idx = j * 256 + rl; const bool valid = idx < cnt;
                float w = 0.f; if (valid) w = cw[(size_t)cls * R + idx];
                const f32x4 g0 = acc[ai][0][m][0], g1 = acc[ai][0][m][1], u0 = acc[ai][1][m][0], u1 = acc[ai][1][m][1];
                float o[8];
#pragma unroll
                for (int e = 0; e < 4; ++e) { o[e] = w * siluf_(g0[e]) * u0[e]; o[4 + e] = w * siluf_(g1[e]) * u1[e]; }
                if (!valid) {
#pragma unroll
                    for (int e = 0; e < 8; ++e) o[e] = 0.f; }
                u32x4 pk; pk.x = cvt_pk_bf16(o[0], o[1]); pk.y = cvt_pk_bf16(o[2], o[3]); pk.z = cvt_pk_bf16(o[4], o[5]); pk.w = cvt_pk_bf16(o[6], o[7]);
                *(u32x4*)(hid + ((size_t)tl * 256 + rl) * 512 + colbase) = pk;
                asm volatile("" ::: "memory");
            }
    }
};
struct EpiY {
    static constexpr bool PERM = true, MIDSCALE = false;
    bf16_t* Y;
    __device__ __forceinline__ void operator()(const f32x4 (&acc)[2][2][4][2], const pg8::Unit& u, int wr, int wc, int fr, int fq) const {
        const int row0 = u.i4 * 256 + wr * 64 + fr, col0 = u.i2 * 256 + wc * 32 + 8 * fq;
#pragma unroll
        for (int ai = 0; ai < 2; ++ai)
#pragma unroll
            for (int m = 0; m < 4; ++m) { bf16_t* rowp = Y + (size_t)(row0 + ai * 128 + m * 16) * 1024 + col0;
#pragma unroll
                for (int bj = 0; bj < 2; ++bj) { const f32x4 v0 = acc[ai][bj][m][0], v1 = acc[ai][bj][m][1];
                    u32x4 w; w.x = cvt_pk_bf16(v0[0], v0[1]); w.y = cvt_pk_bf16(v0[2], v0[3]); w.z = cvt_pk_bf16(v1[0], v1[1]); w.w = cvt_pk_bf16(v1[2], v1[3]);
                    *(u32x4*)(rowp + bj * 128) = w; } }
    }
};

__device__ __forceinline__ void tr_tile(const float* src, int ldn, int k0, int n0, int nvalid, bf16_t* dst, int ldk, int drow0, float* tile, int kd0 = -1, const float* kscale = nullptr) {
    const int tid = launder_tid();
    if (kd0 < 0) kd0 = k0;
    { const int n = tid & 63; int kk = tid >> 6;
#pragma unroll
      for (int it = 0; it < 8; ++it, kk += 8) tile[kk * 65 + n] = (n < nvalid) ? src[(size_t)(k0 + kk) * ldn + n0 + n] * (kscale ? kscale[kk] : 1.f) : 0.f; }
    __syncthreads();
    { const int k8 = tid & 7, n = tid >> 3;
      if (n < nvalid) { const float* s = tile + (k8 * 8) * 65 + n;
          u32x4 o; o.x = cvt_pk_bf16(s[0], s[65]); o.y = cvt_pk_bf16(s[2 * 65], s[3 * 65]); o.z = cvt_pk_bf16(s[4 * 65], s[5 * 65]); o.w = cvt_pk_bf16(s[6 * 65], s[7 * 65]);
          *(u32x4*)(dst + (size_t)(drow0 + n) * ldk + kd0 + k8 * 8) = o; } }
    __syncthreads();
}
__device__ __forceinline__ void phase_wprep(CP p, unsigned char* lds, int bid, int nb) {
    float* tile = (float*)lds;
    constexpr int I_IN = 16 * 41, I_OUT = 256, I_G = 1024, I_U = 1024, I_D = 1024, I_L = I_IN + I_OUT + I_G + I_U + I_D;
    for (int it = bid; it < 2 * I_L; it += nb) {
        const int l = it / I_L; int r = it - l * I_L;
        if (r < I_IN) { const int kt = r / 41, ntl = r % 41; const int n0 = ntl * 64; const int nv = (DIN - n0) < 64 ? (DIN - n0) : 64;
            tr_tile(p->w_in + (size_t)l * 1024 * DIN, DIN, kt * 64, n0, nv, (bf16_t*)(p->ws + WS_WTIN) + (size_t)l * DIN * 1024, 1024, n0, tile); continue; }
        r -= I_IN;
        if (r < I_OUT) { const int kt = r >> 4, ntl = r & 15;
            tr_tile(p->w_out + (size_t)l * 1024 * 1024, 1024, kt * 64, ntl * 64, 64, (bf16_t*)(p->ws + WS_WTOUT) + (size_t)l * 1024 * 1024, 1024, ntl * 64, tile,
                    (kt * 64 + 512) & 1023, kt >= 8 ? p->ssd_norm_g + l * 512 + (kt * 64 - 512) : nullptr); continue; }
        r -= I_OUT;
        if (r < I_G + I_U) { const int up = r >= I_G; if (up) r -= I_G; const int e = r >> 6, q = r & 63, kt = q >> 2, ntl = q & 3; const int n0 = ntl * 64;
            const float* src = (up ? p->w_up : p->w_gate) + (size_t)(l * 16 + e) * 1024 * 256;
            tr_tile(src, 256, kt * 64, n0, 64, (bf16_t*)(p->ws + WS_WTGU) + (size_t)(l * 16 + e) * 512 * 1024, 1024, (n0 >> 7) * 256 + (n0 & 127) + (up ? 128 : 0), tile); continue; }
        r -= I_G + I_U;
        { const int e = r >> 6, q = r & 63, kt = q >> 4, ntl = q & 15;
          tr_tile(p->w_down + (size_t)(l * 16 + e) * 256 * 1024, 1024, kt * 64, ntl * 64, 64, (bf16_t*)(p->ws + WS_WTD) + (size_t)(l * 16 + e) * 1024 * 256, 256, ntl * 64, tile); }
    }
}
__device__ __forceinline__ void phase_adaln(CP p, unsigned char* lds, int bid, int nb) {
    float* sc = (float*)lds;
    float* red = sc + 3 * 1024;
    const int tid = launder_tid();
    for (int idx = tid; idx < 3 * 1024; idx += NTHREADS) { const int v = idx >> 10, k = idx & 1023; const float cv = (v < 2) ? p->c[v * 1024 + k] : p->c_ctx[k]; sc[idx] = siluf_(cv); }
    __syncthreads();
    float* mod = (float*)(p->ws + WS_MOD);
    for (int it = bid; it < 2 * 96; it += nb) {
        const int l = it / 96, n0 = (it % 96) * 64;
        const int c4 = tid & 15, kr = tid >> 4;
        f32x4 a0 = {0, 0, 0, 0}, a1 = {0, 0, 0, 0}, a2 = {0, 0, 0, 0};
        const float* w = p->w_ada + (size_t)l * 1024 * 6144 + n0 + c4 * 4;
#pragma unroll 4
        for (int k = kr; k < 1024; k += 32) { const f32x4 w4 = *(const f32x4*)(w + (size_t)k * 6144); a0 += sc[k] * w4; a1 += sc[1024 + k] * w4; a2 += sc[2048 + k] * w4; }
        *(f32x4*)(red + (kr * 3 + 0) * 64 + c4 * 4) = a0; *(f32x4*)(red + (kr * 3 + 1) * 64 + c4 * 4) = a1; *(f32x4*)(red + (kr * 3 + 2) * 64 + c4 * 4) = a2;
        __syncthreads();
        if (tid < 192) { const int v = tid >> 6, cc = tid & 63; float s = 0.f;
            for (int q = 0; q < 32; ++q) s += red[(q * 3 + v) * 64 + cc];
            mod[((size_t)l * 3 + v) * 6144 + n0 + cc] = s + p->b_ada[l * 6144 + n0 + cc]; }
        __syncthreads();
    }
}
__device__ __forceinline__ void moe_table(CP p, int l, LAS int* tab) {
    const int* gcount = (const int*)(p->ws + WS_CTL) + l * 32;
    if (threadIdx.x == 0) { int acc = 0; for (int q = 0; q < NCLS; ++q) { const int cn = gcount[q]; tab[q] = acc; tab[32 + q] = cn; acc += (cn + 255) >> 8; } tab[24] = acc; }
    __syncthreads();
}
__device__ __forceinline__ void moe_yload(CP p, int pos, int lane, const LAS int* tab, u32x2 (&yv)[4]) {
    const int slot = tab[pos >> 16] * 256 + (pos & 0xffff);
    const bf16_t* y = (const bf16_t*)(p->ws + WS_Y) + (size_t)slot * 1024;
#pragma unroll
    for (int j = 0; j < 4; ++j) yv[j] = *(const u32x2*)(y + 4 * lane + 256 * j);
}
__device__ __forceinline__ void moe_yadd(CP p, int lm, int v, int lane, const u32x2 (&yv)[4], f32x4 (&xv)[4]) {
    const float* gate = (const float*)(p->ws + WS_MOD) + ((size_t)lm * 3 + v) * 6144 + 5 * 1024;
#pragma unroll
    for (int j = 0; j < 4; ++j) { const int k = 4 * lane + 256 * j; const f32x4 g4 = *(const f32x4*)(gate + k);
        xv[j][0] += g4[0] * bflo(yv[j].x); xv[j][1] += g4[1] * bfhi(yv[j].x); xv[j][2] += g4[2] * bflo(yv[j].y); xv[j][3] += g4[3] * bfhi(yv[j].y); }
}
__device__ __forceinline__ void phase_r1(CP p, int l, unsigned char* lds, int bid, int nb) {
    float* wdt = (float*)lds;
    float* gm = wdt + 16 * 1024;
    float* sh = gm + 3 * 1024;
    const int tid = launder_tid(); const int lane = tid & 63, wave = tid >> 6;
    const float* mod = (const float*)(p->ws + WS_MOD) + (size_t)l * 3 * 6144;
    const float* win = p->w_in + (size_t)l * 1024 * DIN;
#pragma unroll 16
    for (int idx = tid; idx < 16 * 1024; idx += NTHREADS) { const int k = idx >> 4, n = idx & 15; wdt[n * 1024 + k] = win[(size_t)k * DIN + NPROJ + n]; }
#pragma unroll
    for (int idx = tid; idx < 3 * 1024; idx += NTHREADS) { const int v = idx >> 10, k = idx & 1023; gm[idx] = p->g_mix[l * 1024 + k] * (1.f + mod[v * 6144 + 1024 + k]); sh[idx] = mod[v * 6144 + k]; }
    LAS int* tab = (LAS int*)((LAS unsigned char*)lds + MISC_OFF);
    if (l > 0) moe_table(p, l - 1, tab);
    __syncthreads();
    bf16_t* HX = (bf16_t*)(p->ws + WS_HX); float* DT = (float*)(p->ws + WS_DT);
    const int* POS = (const int*)(p->ws + WS_POS) + (size_t)(l > 0 ? l - 1 : 0) * R;
    const int rstep = nb * 8;
    f32x4 xn[4]; u32x2 yn[4]; int posn = 0;
    { const int r = bid * 8 + wave;
      if (r < R) { const f32x4* hr = (const f32x4*)hin_ptr(p, l, r);
#pragma unroll
          for (int j = 0; j < 4; ++j) xn[j] = hr[lane + 64 * j];
          if (l > 0) { moe_yload(p, POS[r], lane, tab, yn); if (r + rstep < R) posn = POS[r + rstep]; } } }
    for (int r = bid * 8 + wave; r < R; r += rstep) {
        const int v = row_v(r);
        f32x4 xv[4]; u32x2 yv[4]; float ss = 0.f;
#pragma unroll
        for (int j = 0; j < 4; ++j) { xv[j] = xn[j]; yv[j] = yn[j]; }
        { const int rn = r + rstep;
          if (rn < R) { const f32x4* hr = (const f32x4*)hin_ptr(p, l, rn);
#pragma unroll
              for (int j = 0; j < 4; ++j) xn[j] = hr[lane + 64 * j];
              if (l > 0) { moe_yload(p, posn, lane, tab, yn); if (rn + rstep < R) posn = POS[rn + rstep]; } } }
        if (l > 0) { moe_yadd(p, l - 1, v, lane, yv, xv); f32x4* hw = (f32x4*)hptr(p, r);
#pragma unroll
            for (int j = 0; j < 4; ++j) hw[lane + 64 * j] = xv[j]; }
#pragma unroll
        for (int j = 0; j < 4; ++j) ss += xv[j][0] * xv[j][0] + xv[j][1] * xv[j][1] + xv[j][2] * xv[j][2] + xv[j][3] * xv[j][3];
        ss = wave_sum(ss); const float rs = rsqrtf(ss * (1.f / 1024.f) + 1e-6f);
#pragma unroll
        for (int j = 0; j < 4; ++j) { const int k = 4 * lane + 256 * j; const f32x4 g4 = *(const f32x4*)(gm + v * 1024 + k), s4 = *(const f32x4*)(sh + v * 1024 + k);
            xv[j] = xv[j] * rs * g4 + s4;
            u32x2 o; o.x = cvt_pk_bf16(xv[j][0], xv[j][1]); o.y = cvt_pk_bf16(xv[j][2], xv[j][3]);
            *(u32x2*)(HX + (size_t)r * 1024 + k) = o; }
        float mine = 0.f;
#pragma unroll
        for (int n = 0; n < 16; ++n) { float a = 0.f;
#pragma unroll
            for (int j = 0; j < 4; ++j) { const f32x4 w4 = *(const f32x4*)(wdt + n * 1024 + 4 * lane + 256 * j); a += xv[j][0] * w4[0] + xv[j][1] * w4[1] + xv[j][2] * w4[2] + xv[j][3] * w4[3]; }
            a = wave_sum(a); mine = (lane == n) ? a : mine; }
        if (lane < 16) DT[(size_t)r * 16 + lane] = softplusf_(mine + p->dt_bias[l * 16 + lane]);
    }
}
typedef float f32x16 __attribute__((ext_vector_type(16)));
typedef short s16x4 __attribute__((ext_vector_type(4)));
constexpr int ST_ROW = 272;
constexpr int ST_TR128 = 320;
constexpr int ST_TR64 = 192;
constexpr int NCHUNK = SEG / 128;

#define DPP_MOV(v, ctrl, rm, bm) __builtin_bit_cast(float, __builtin_amdgcn_update_dpp(0, __builtin_bit_cast(int, (v)), (ctrl), (rm), (bm), true))
__device__ __forceinline__ float wave_incl_scan(float v, int) {
    float s = v + DPP_MOV(v, 0x111, 0xF, 0xF) + DPP_MOV(v, 0x112, 0xF, 0xF) + DPP_MOV(v, 0x113, 0xF, 0xF);
    s += DPP_MOV(s, 0x114, 0xF, 0xE);
    s += DPP_MOV(s, 0x118, 0xF, 0xC);
    s += DPP_MOV(s, 0x142, 0xA, 0xF);
    s += DPP_MOV(s, 0x143, 0xC, 0xF);
    return s;
}
__device__ __forceinline__ bf16x8 row_frag(const LAS unsigned char* tile, int stride, int row0, int k0, int lane) {
    return *(const LAS bf16x8*)(tile + (row0 + (lane & 31)) * stride + (k0 + 8 * (lane >> 5)) * 2);
}
__device__ __forceinline__ bf16x8 tr_frag(const LAS unsigned char* tile, int stride, int k0, int c0, int lane) {
    const int g = lane >> 4, li = lane & 15, q = li >> 2, pp = li & 3;
    const LAS unsigned char* a0 = tile + (k0 + 8 * (g >> 1) + q) * stride + (c0 + 16 * (g & 1) + 4 * pp) * 2;
    const s16x4 lo = __builtin_amdgcn_ds_read_tr16_b64_v4i16((LAS s16x4*)a0);
    const s16x4 hi = __builtin_amdgcn_ds_read_tr16_b64_v4i16((LAS s16x4*)(a0 + 4 * stride));
    return __builtin_shufflevector(lo, hi, 0, 1, 2, 3, 4, 5, 6, 7);
}
__device__ __forceinline__ u32x4 pack8(const float (&v)[8]) { u32x4 r; r.x = cvt_pk_bf16(v[0], v[1]); r.y = cvt_pk_bf16(v[2], v[3]); r.z = cvt_pk_bf16(v[4], v[5]); r.w = cvt_pk_bf16(v[6], v[7]); return r; }
__device__ __forceinline__ u32x4 pack8s(const float (&v)[8], float sc) { u32x4 r; r.x = cvt_pk_bf16(v[0] * sc, v[1] * sc); r.y = cvt_pk_bf16(v[2] * sc, v[3] * sc); r.z = cvt_pk_bf16(v[4] * sc, v[5] * sc); r.w = cvt_pk_bf16(v[6] * sc, v[7] * sc); return r; }

__device__ __forceinline__ void conv_load(const bf16_t* proj, int row0, int rq, int xch, bool lo_ok, bool hi_ok, u32x4 (&raw)[8]) {
    const bf16_t* base = proj + (size_t)(row0 + 4 * rq) * NPROJ + 1536 + xch;
    unsigned zz; asm volatile("v_mov_b32 %0, 0" : "=v"(zz));
#pragma unroll
    for (int j = 0; j < 8; ++j) {
        if (j < 2) { const bool ok = (rq > 0) || lo_ok; const u32x4 v = *(const u32x4*)(ok ? base + (j - 2) * NPROJ : base);
            raw[j].x = ok ? v.x : zz; raw[j].y = ok ? v.y : zz; raw[j].z = ok ? v.z : zz; raw[j].w = ok ? v.w : zz; }
        else if (j >= 6) { const bool ok = (rq < 31) || hi_ok; const u32x4 v = *(const u32x4*)(ok ? base + (j - 2) * NPROJ : base);
            raw[j].x = ok ? v.x : zz; raw[j].y = ok ? v.y : zz; raw[j].z = ok ? v.z : zz; raw[j].w = ok ? v.w : zz; }
        else raw[j] = *(const u32x4*)(base + (j - 2) * NPROJ);
    }
}
__device__ __forceinline__ void conv_compute(const u32x4 (&raw)[8], const LAS float* wl, int nchl, int wch, float (&o)[4][8]) {
    float w[5][8], bs[8];
#pragma unroll
    for (int j = 0; j < 5; ++j) { const f32x4 w0 = *(const LAS f32x4*)(wl + j * nchl + wch), w1 = *(const LAS f32x4*)(wl + j * nchl + wch + 4);
        w[j][0] = w0[0]; w[j][1] = w0[1]; w[j][2] = w0[2]; w[j][3] = w0[3]; w[j][4] = w1[0]; w[j][5] = w1[1]; w[j][6] = w1[2]; w[j][7] = w1[3]; }
    { const f32x4 b0 = *(const LAS f32x4*)(wl + 5 * nchl + wch), b1 = *(const LAS f32x4*)(wl + 5 * nchl + wch + 4); bs[0] = b0[0]; bs[1] = b0[1]; bs[2] = b0[2]; bs[3] = b0[3]; bs[4] = b1[0]; bs[5] = b1[1]; bs[6] = b1[2]; bs[7] = b1[3]; }
#pragma unroll
    for (int i = 0; i < 4; ++i)
#pragma unroll
        for (int e = 0; e < 8; ++e) o[i][e] = bs[e];
#pragma unroll
    for (int j = 0; j < 8; ++j) {
        float xv[8] = {bflo(raw[j].x), bfhi(raw[j].x), bflo(raw[j].y), bfhi(raw[j].y), bflo(raw[j].z), bfhi(raw[j].z), bflo(raw[j].w), bfhi(raw[j].w)};
#pragma unroll
        for (int i = 0; i < 4; ++i) { const int tap = j - i; if (tap >= 0 && tap < 5) {
#pragma unroll
                for (int e = 0; e < 8; ++e) o[i][e] += w[tap][e] * xv[e]; } }
    }
#pragma unroll
    for (int i = 0; i < 4; ++i)
#pragma unroll
        for (int e = 0; e < 8; ++e) o[i][e] = siluf_(o[i][e]);
}
__device__ __forceinline__ void head_cums(CP p, int l, int row0, int h, int dir, int lane, LAS float* hv) {
    const float A = -expf(p->a_log[l * 16 + dir * 8 + h]);
    const float* DT = (const float*)(p->ws + WS_DT);
    const float d0 = DT[(size_t)(row0 + 2 * lane) * 16 + dir * 8 + h], d1 = DT[(size_t)(row0 + 2 * lane + 1) * 16 + dir * 8 + h];
    const float x0 = d0 * A, x1 = d1 * A;
    const float incl = wave_incl_scan(x0 + x1, lane);
    const float total = __builtin_bit_cast(float, __builtin_amdgcn_readlane(__builtin_bit_cast(int, incl), 63));
    float c0, c1;
    if (dir == 0) { c1 = incl; c0 = incl - x1; } else { c0 = total - (incl - x1 - x0); c1 = total - (incl - x1); }
    hv[dir * 128 + 2 * lane] = c0; hv[dir * 128 + 2 * lane + 1] = c1;
    hv[256 + dir * 128 + 2 * lane] = d0; hv[256 + dir * 128 + 2 * lane + 1] = d1;
    if (lane == 0) hv[512 + dir] = total;
}
__device__ __forceinline__ bf16x8 scale_frag(bf16x8 f, const f32x4 w0, const f32x4 w1) {
    const u32x4 u = __builtin_bit_cast(u32x4, f);
    u32x4 r;
    r.x = cvt_pk_bf16(bflo(u.x) * w0[0], bfhi(u.x) * w0[1]); r.y = cvt_pk_bf16(bflo(u.y) * w0[2], bfhi(u.y) * w0[3]);
    r.z = cvt_pk_bf16(bflo(u.z) * w1[0], bfhi(u.z) * w1[1]); r.w = cvt_pk_bf16(bflo(u.w) * w1[2], bfhi(u.w) * w1[3]);
    return __builtin_bit_cast(bf16x8, r);
}
constexpr int ST_X256 = 576;

__device__ __forceinline__ void phase_c1(CP p, int l, unsigned char* lds_, int bid, int nb) {
    LAS unsigned char* lds = (LAS unsigned char*)lds_;
    LAS unsigned char* tile = lds;
    LAS float* wl = (LAS float*)(lds + 73216);
    const int tid = launder_tid();
    const bf16_t* proj = (const bf16_t*)(p->ws + WS_PROJ); bf16_t* mix = (bf16_t*)(p->ws + WS_HX);
#pragma unroll 1
    for (int u = bid; u < 256 + 512 + (l == DEPTH - 1 ? 0 : 16); u += nb) {
        int S, LEN, pstride, sstride, tok0, ch0;
        if (u < 256) { const int b = u >> 7, cs = (u >> 2) & 31, cc = u & 3; S = 2; LEN = 256; pstride = 64; sstride = 1; tok0 = b * SEG + CTXL + 2 * cs; ch0 = 256 + 64 * cc; }
        else if (u < 768) { const int v = u - 256; const int b = v >> 8, rg = (v >> 2) & 63, cc = v & 3; S = 4; LEN = 64; pstride = 1; sstride = 64; tok0 = b * SEG + CTXL + 256 * rg; ch0 = 64 * cc; }
        else { const int v = u - 768; const int b = v >> 3, cc = v & 7; S = 1; LEN = 256; pstride = 1; sstride = 0; tok0 = b * SEG; ch0 = 64 * cc; }
        const int LP = LEN + 30;
#pragma unroll
        for (int i = tid; i < 32 * 64; i += NTHREADS) { const int j = i >> 6, c = i & 63; wl[i] = j < 31 ? p->conv_w[((size_t)l * 31 + j) * 512 + ch0 + c] : p->conv_b[l * 512 + ch0 + c]; }
        for (int i = tid; i < S * 30 * 8; i += NTHREADS) { const int pc = i & 7, q = (i >> 3) % 30, sq = (i >> 3) / 30; const int pos = q < 15 ? q : LEN + q;
            unsigned zz; asm volatile("v_mov_b32 %0, 0" : "=v"(zz));
            *(LAS u32x4*)(tile + ((sq * LP + pos) * 64 + pc * 8) * 2) = (u32x4){zz, zz, zz, zz}; }
#pragma unroll 4
        for (int i = tid; i < S * LEN * 8; i += NTHREADS) { const int pc = i & 7, t = i >> 3; const int sq = t / LEN, pos = t - sq * LEN;
            const bf16_t* src = proj + (size_t)(tok0 + sq * sstride + pos * pstride) * NPROJ + ch0 + pc * 8;
            const u32x4 uv = *(const u32x4*)src, gv = *(const u32x4*)(src + 512);
            u32x4 o;
            o.x = cvt_pk_bf16(bflo(uv.x) * sigmoidf_(bflo(gv.x)), bfhi(uv.x) * sigmoidf_(bfhi(gv.x)));
            o.y = cvt_pk_bf16(bflo(uv.y) * sigmoidf_(bflo(gv.y)), bfhi(uv.y) * sigmoidf_(bfhi(gv.y)));
            o.z = cvt_pk_bf16(bflo(uv.z) * sigmoidf_(bflo(gv.z)), bfhi(uv.z) * sigmoidf_(bfhi(gv.z)));
            o.w = cvt_pk_bf16(bflo(uv.w) * sigmoidf_(bflo(gv.w)), bfhi(uv.w) * sigmoidf_(bfhi(gv.w)));
            *(LAS u32x4*)(tile + ((sq * LP + 15 + pos) * 64 + pc * 8) * 2) = o; }
        __syncthreads();
        const int noct = S * LEN / 8;
#pragma unroll 1
        for (int it = tid; it < noct * 32; it += NTHREADS) {
            const int cp = it & 31, oc = it >> 5; const int sq = oc / (LEN / 8), p0 = (oc - sq * (LEN / 8)) * 8;
            const LAS unsigned* base = (const LAS unsigned*)(tile + ((sq * LP + p0) * 64) * 2) + cp;
            float i0[38], i1[38];
#pragma unroll
            for (int k = 0; k < 38; ++k) { const unsigned w = base[k * 32]; i0[k] = bflo(w); i1[k] = bfhi(w); }
            float a0[8], a1[8];
            { const float b0 = wl[31 * 64 + 2 * cp], b1 = wl[31 * 64 + 2 * cp + 1];
#pragma unroll
              for (int i = 0; i < 8; ++i) { a0[i] = b0; a1[i] = b1; } }
#pragma unroll
            for (int j = 0; j < 31; ++j) { typedef float f32x2 __attribute__((ext_vector_type(2))); const f32x2 wj = *(const LAS f32x2*)(wl + j * 64 + 2 * cp); const float w0 = wj[0], w1 = wj[1];
#pragma unroll
                for (int i = 0; i < 8; ++i) { a0[i] += w0 * i0[i + j]; a1[i] += w1 * i1[i + j]; } }
#pragma unroll
            for (int i = 0; i < 8; ++i) { const int tok = tok0 + sq * sstride + (p0 + i) * pstride;
                *(unsigned*)(mix + (size_t)tok * 1024 + 512 + ch0 + 2 * cp) = cvt_pk_bf16(a0[i], a1[i]); }
        }
        __syncthreads();
    }
}
__device__ __forceinline__ void phase_c1_ln(CP p, int l, int bid, int nb) {
    const int tid = launder_tid(); const int lane = tid & 63, wave = tid >> 6;
    bf16_t* mix = (bf16_t*)(p->ws + WS_HX);
    const f32x4 g0 = *(const f32x4*)(p->conv_ln_g + l * 512 + lane * 8), g1 = *(const f32x4*)(p->conv_ln_g + l * 512 + lane * 8 + 4);
    const f32x4 b0 = *(const f32x4*)(p->conv_ln_b + l * 512 + lane * 8), b1 = *(const f32x4*)(p->conv_ln_b + l * 512 + lane * 8 + 4);
    const float gg[8] = {g0[0], g0[1], g0[2], g0[3], g1[0], g1[1], g1[2], g1[3]}, bb[8] = {b0[0], b0[1], b0[2], b0[3], b1[0], b1[1], b1[2], b1[3]};
    for (int r = bid * 8 + wave; r < R; r += nb * 8) {
        u32x4* ptr = (u32x4*)(mix + (size_t)r * 1024 + 512 + lane * 8);
        const u32x4 v = *ptr;
        float y[8] = {bflo(v.x), bfhi(v.x), bflo(v.y), bfhi(v.y), bflo(v.z), bfhi(v.z), bflo(v.w), bfhi(v.w)};
        float s = 0.f;
#pragma unroll
        for (int e = 0; e < 8; ++e) s += y[e];
        const float mu = wave_sum(s) * (1.f / 512.f);
        float q = 0.f;
#pragma unroll
        for (int e = 0; e < 8; ++e) { y[e] -= mu; q += y[e] * y[e]; }
        const float rstd = rsqrtf(wave_sum(q) * (1.f / 512.f) + 1e-5f);
        float o[8];
#pragma unroll
        for (int e = 0; e < 8; ++e) o[e] = siluf_(y[e] * rstd * gg[e] + bb[e]);
        *ptr = pack8(o);
    }
}
__device__ __forceinline__ void phase_s1(CP p, int l, unsigned char* lds_, int bid, int nb) {
    LAS unsigned char* lds = (LAS unsigned char*)lds_;
    LAS unsigned char* Bs = lds;
    LAS unsigned char* Xs = lds + 128 * ST_TR128;
    LAS float* wv = (LAS float*)(Xs + 128 * ST_X256);
    LAS float* hvs = wv + 8 * 128;
    LAS float* cwl = hvs + 4 * 520;
    const int tid = launder_tid(); const int lane = tid & 63, wave = __builtin_amdgcn_readfirstlane(tid >> 6);
    const bf16_t* proj = (const bf16_t*)(p->ws + WS_PROJ);
    const float* cw = p->ssd_conv_w + (size_t)l * 5 * 1024; const float* cbias = p->ssd_conv_b + (size_t)l * 1024;
    float* Sg = (float*)(p->ws + WS_S); float* DEC = (float*)(p->ws + WS_DEC);
    int cur_g = -1;
#pragma unroll 1
    for (int u = bid; u < NB * NCHUNK * 2; u += nb) {
        const int g = u & 1, c = (u >> 1) % NCHUNK, b = (u >> 1) / NCHUNK;
        const int row0 = b * SEG + c * 128;
        const bool lo_ok = !(c == 0 || c == 2), hi_ok = !(c == 1 || c == NCHUNK - 1);
        if (g != cur_g) { cur_g = g;
#pragma unroll
            for (int i = tid; i < 6 * 384; i += NTHREADS) { const int j = i / 384, lc = i - j * 384; const int gch = lc < 128 ? 512 + g * 128 + lc : g * 256 + (lc - 128);
                cwl[i] = j < 5 ? cw[j * 1024 + gch] : cbias[gch]; } }
        const int hh = wave >> 1, dir = wave & 1, h = 4 * g + hh;
        u32x4 rb[8], rx0[8], rx1[8];
        conv_load(proj, row0, tid >> 4, 512 + g * 128 + (tid & 15) * 8, lo_ok, hi_ok, rb);
        conv_load(proj, row0, tid >> 5, g * 256 + (tid & 31) * 8, lo_ok, hi_ok, rx0);
        conv_load(proj, row0, (tid >> 5) + 16, g * 256 + (tid & 31) * 8, lo_ok, hi_ok, rx1);
        head_cums(p, l, row0, h, dir, lane, hvs + hh * 520);
        __syncthreads();
        {
            const LAS float* hv = hvs + hh * 520; const float tot = hv[512 + dir];
#pragma unroll
            for (int q = 0; q < 2; ++q) { const int lr = lane + 64 * q; wv[wave * 128 + lr] = __expf(tot - hv[dir * 128 + lr]) * hv[256 + dir * 128 + lr]; }
            if (lane == 0) DEC[((size_t)(b * 2 + dir) * NCHUNK + c) * 8 + h] = __expf(tot);
        }
        { float o[4][8];
          conv_compute(rb, cwl, 384, (tid & 15) * 8, o);
#pragma unroll
          for (int i = 0; i < 4; ++i) *(LAS u32x4*)(Bs + (4 * (tid >> 4) + i) * ST_TR128 + (tid & 15) * 16) = pack8(o[i]);
          conv_compute(rx0, cwl, 384, 128 + (tid & 31) * 8, o);
#pragma unroll
          for (int i = 0; i < 4; ++i) *(LAS u32x4*)(Xs + (4 * (tid >> 5) + i) * ST_X256 + (tid & 31) * 16) = pack8(o[i]);
          conv_compute(rx1, cwl, 384, 128 + (tid & 31) * 8, o);
#pragma unroll
          for (int i = 0; i < 4; ++i) *(LAS u32x4*)(Xs + (4 * ((tid >> 5) + 16) + i) * ST_X256 + (tid & 31) * 16) = pack8(o[i]); }
        __syncthreads();
        {
            f32x16 acc[2][4];
#pragma unroll
            for (int t = 0; t < 2; ++t)
#pragma unroll
                for (int q = 0; q < 4; ++q)
#pragma unroll
                    for (int e = 0; e < 16; ++e) acc[t][q][e] = 0.f;
#pragma unroll 2
            for (int kk = 0; kk < 8; ++kk) {
                const LAS float* wp = wv + wave * 128 + 16 * kk + 8 * (lane >> 5);
                const f32x4 w0 = *(const LAS f32x4*)wp, w1 = *(const LAS f32x4*)(wp + 4);
                bf16x8 af[2];
#pragma unroll
                for (int t = 0; t < 2; ++t) af[t] = scale_frag(tr_frag(Xs, ST_X256, 16 * kk, hh * 64 + 32 * t, lane), w0, w1);
#pragma unroll
                for (int q = 0; q < 4; ++q) { const bf16x8 bf = tr_frag(Bs, ST_TR128, 16 * kk, 32 * q, lane);
#pragma unroll
                    for (int t = 0; t < 2; ++t) acc[t][q] = __builtin_amdgcn_mfma_f32_32x32x16_bf16(af[t], bf, acc[t][q], 0, 0, 0); }
            }
            float* So = Sg + ((size_t)((b * 2 + dir) * NCHUNK + c) * 8 + h) * 8192 + (lane & 31);
#pragma unroll
            for (int t = 0; t < 2; ++t)
#pragma unroll
                for (int q = 0; q < 4; ++q)
#pragma unroll
                    for (int e = 0; e < 16; ++e) { const int pr = 32 * t + (e & 3) + 8 * (e >> 2) + 4 * (lane >> 5); So[(size_t)pr * 128 + 32 * q] = acc[t][q][e]; }
        }
        __syncthreads();
    }
}
__device__ __forceinline__ void phase_s2(CP p, int bid, int nb) {
    const int tid = launder_tid();
    const float* Sg = (const float*)(p->ws + WS_S); const float* DEC = (const float*)(p->ws + WS_DEC); bf16_t* HP = (bf16_t*)(p->ws + WS_HP);
    for (int idx = bid * NTHREADS + tid; idx < 2 * 2 * 8 * 64 * 64; idx += nb * NTHREADS) {
        const int n2 = idx & 63, pr = (idx >> 6) & 63, h = (idx >> 12) & 7, dir = (idx >> 15) & 1, b = idx >> 16;
        const size_t inner = (size_t)h * 8192 + pr * 128 + 2 * n2;
        const size_t cbase = (size_t)(b * 2 + dir) * NCHUNK;
        float s0 = 0.f, s1 = 0.f;
#pragma unroll 5
        for (int step = 0; step < NCHUNK; ++step) {
            const int c = dir == 0 ? step : (step < 2 ? 1 - step : NCHUNK + 1 - step);
            const size_t off = (cbase + c) * 65536 + inner;
            const float2 sv = *(const float2*)(Sg + off); const float d = DEC[(cbase + c) * 8 + h];
            *(unsigned*)(HP + off) = cvt_pk_bf16(s0, s1);
            s0 = s0 * d + sv.x; s1 = s1 * d + sv.y;
        }
    }
}
__device__ __forceinline__ void phase_s3(CP p, int l, unsigned char* lds_, int bid, int nb) {
    LAS unsigned char* lds = (LAS unsigned char*)lds_;
    LAS unsigned char* Cs = lds;
    LAS unsigned char* Bs = Cs + 128 * ST_ROW;
    LAS unsigned char* Mt = Bs;
    LAS unsigned char* Xs = Bs + 128 * ST_TR128;
    LAS unsigned char* Hf = Xs + 128 * ST_TR64;
    LAS unsigned char* Hb = Hf + 64 * ST_ROW;
    LAS float* hvs = (LAS float*)(Hb + 64 * ST_ROW);
    LAS float* ssqp = hvs + 4 * 520;
    LAS float* cwl = ssqp + 256;
    const int tid0 = launder_tid(); const int wave = __builtin_amdgcn_readfirstlane(tid0 >> 6);
    const bf16_t* proj = (const bf16_t*)(p->ws + WS_PROJ); bf16_t* mix = (bf16_t*)(p->ws + WS_HX);
    const float* cw = p->ssd_conv_w + (size_t)l * 5 * 1024; const float* cbias = p->ssd_conv_b + (size_t)l * 1024;
    const bf16_t* HP = (const bf16_t*)(p->ws + WS_HP); float* SSQ = (float*)(p->ws + WS_SSQ);
    int cur_g = -1;
#pragma unroll 1
    for (int u = bid; u < NB * NCHUNK * 2; u += nb) {
        const int g = u & 1, c = (u >> 1) % NCHUNK, b = (u >> 1) / NCHUNK;
        if (l == DEPTH - 1 && c < 2) continue;
        int tid = tid0; asm volatile("" : "+v"(tid));
        const int lane = tid & 63;
        const int row0 = b * SEG + c * 128;
        const bool lo_ok = !(c == 0 || c == 2), hi_ok = !(c == 1 || c == NCHUNK - 1);
        if (g != cur_g) { cur_g = g;
#pragma unroll
            for (int i = tid; i < 6 * 512; i += NTHREADS) { const int j = i >> 9, lc = i & 511; const int gch = lc < 128 ? 768 + g * 128 + lc : (lc < 256 ? 512 + g * 128 + (lc - 128) : g * 256 + (lc - 256));
                cwl[i] = j < 5 ? cw[j * 1024 + gch] : cbias[gch]; } }
        u32x4 rx[8];
        {
            u32x4 r0[8], r1[8];
            const int cg = tid & 31; const int gch = (cg < 16 ? 768 : 512) + g * 128 + (cg & 15) * 8;
            conv_load(proj, row0, tid >> 5, gch, lo_ok, hi_ok, r0);
            conv_load(proj, row0, (tid >> 5) + 16, gch, lo_ok, hi_ok, r1);
            head_cums(p, l, row0, 4 * g + (wave >> 1), wave & 1, lane, hvs + (wave >> 1) * 520);
            __syncthreads();
            float o[4][8];
            LAS unsigned char* dst = (cg < 16 ? Cs : Bs) + (cg & 15) * 16;
            conv_compute(r0, cwl, 512, cg * 8, o);
#pragma unroll
            for (int i = 0; i < 4; ++i) *(LAS u32x4*)(dst + (4 * (tid >> 5) + i) * ST_ROW) = pack8(o[i]);
            asm volatile("" ::: "memory");
            if (tid < 256) conv_load(proj, row0, tid >> 3, g * 256 + (tid & 7) * 8, lo_ok, hi_ok, rx);
            conv_compute(r1, cwl, 512, cg * 8, o);
#pragma unroll
            for (int i = 0; i < 4; ++i) *(LAS u32x4*)(dst + (4 * ((tid >> 5) + 16) + i) * ST_ROW) = pack8(o[i]);
            if (tid < 256) { conv_compute(rx, cwl, 512, 256 + (tid & 7) * 8, o);
#pragma unroll
                for (int i = 0; i < 4; ++i) *(LAS u32x4*)(Xs + (4 * (tid >> 3) + i) * ST_TR64 + (tid & 7) * 16) = pack8(o[i]); }
        }
        __syncthreads();
        const int lb = wave >> 1, hs = wave & 1;
        int ln = lane; asm volatile("" : "+v"(ln));
        f32x16 gacc[2];
#pragma unroll
        for (int t = 0; t < 2; ++t)
#pragma unroll
            for (int e = 0; e < 16; ++e) gacc[t][e] = 0.f;
#pragma unroll
        for (int kk = 0; kk < 8; ++kk) { const bf16x8 af = row_frag(Cs, ST_ROW, 32 * lb, 16 * kk, lane);
#pragma unroll
            for (int t = 0; t < 2; ++t) { const bf16x8 bf = row_frag(Bs, ST_ROW, 64 * hs + 32 * t, 16 * kk, lane);
                gacc[t] = __builtin_amdgcn_mfma_f32_32x32x16_bf16(af, bf, gacc[t], 0, 0, 0); } }
        u32x4 hreg[4];
        { const bf16_t* hp0 = HP + ((size_t)(b * 2 * NCHUNK + c) * 8 + 4 * g) * 8192;
#pragma unroll
          for (int q = 0; q < 4; ++q) { const int it = tid + 512 * q; hreg[q] = *(const u32x4*)(hp0 + (size_t)(it >> 10) * NCHUNK * 8 * 8192 + (it & 1023) * 8); } }
        __syncthreads();
#pragma unroll 1
        for (int hh = 0; hh < 4; ++hh) {
            const int h = 4 * g + hh; const LAS float* hv = hvs + hh * 520;
            asm volatile("" : "+v"(ln));
            const int ph = hs, pc = 32 * ph + (ln & 31);
#pragma unroll
            for (int t = 0; t < 2; ++t) {
                const int sc = 64 * hs + 32 * t + (ln & 31);
                const float cfs = hv[sc], cbs = hv[128 + sc], dfs = hv[256 + sc], dbs = hv[384 + sc];
#pragma unroll
                for (int rg = 0; rg < 4; ++rg) {
                    const int l0 = 32 * lb + 8 * rg + 4 * (ln >> 5);
                    const f32x4 cfl = *(const LAS f32x4*)(hv + l0), cbl = *(const LAS f32x4*)(hv + 128 + l0);
                    float m[4];
#pragma unroll
                    for (int e = 0; e < 4; ++e) { const int lr = l0 + e;
                        const float ff = lr >= sc ? __expf(cfl[e] - cfs) * dfs : 0.f;
                        const float fb = lr <= sc ? __expf(cbl[e] - cbs) * dbs : 0.f;
                        m[e] = gacc[t][4 * rg + e] * (ff + fb); }
                    u32x2 pk; pk.x = cvt_pk_bf16(m[0], m[1]); pk.y = cvt_pk_bf16(m[2], m[3]);
                    *(LAS u32x2*)(Mt + sc * ST_TR128 + l0 * 2) = pk;
                }
            }
#pragma unroll
            for (int q = 0; q < 4; ++q) { const int it = tid + 512 * q; const int q2 = it & 1023;
                *(LAS u32x4*)(((it >> 10) ? Hb : Hf) + (q2 >> 4) * ST_ROW + (q2 & 15) * 16) = hreg[q]; }
            if (hh < 3) {
                const bf16_t* hp0 = HP + ((size_t)(b * 2 * NCHUNK + c) * 8 + h + 1) * 8192;
#pragma unroll
                for (int q = 0; q < 4; ++q) { const int it = tid + 512 * q; hreg[q] = *(const u32x4*)(hp0 + (size_t)(it >> 10) * NCHUNK * 8 * 8192 + (it & 1023) * 8); }
                if (tid < 256) conv_load(proj, row0, tid >> 3, g * 256 + (hh + 1) * 64 + (tid & 7) * 8, lo_ok, hi_ok, rx);
            }
            unsigned zraw[8];
#pragma unroll
            for (int ri = 0; ri < 16; ri += 2) { const int lr = 32 * lb + 8 * (ri >> 2) + 4 * (ln >> 5) + (ri & 3);
                const bf16_t* zp = proj + (size_t)(row0 + lr) * NPROJ + 1024 + h * 64 + pc;
                zraw[ri >> 1] = (unsigned)zp[0] | ((unsigned)zp[NPROJ] << 16); }
            __syncthreads();
            f32x16 ad, af_, ab_;
#pragma unroll
            for (int e = 0; e < 16; ++e) { ad[e] = 0.f; af_[e] = 0.f; ab_[e] = 0.f; }
#pragma unroll
            for (int kk = 0; kk < 8; ++kk) {
                const bf16x8 am = tr_frag(Mt, ST_TR128, 16 * kk, 32 * lb, lane);
                const bf16x8 bx = tr_frag(Xs, ST_TR64, 16 * kk, 32 * ph, lane);
                ad = __builtin_amdgcn_mfma_f32_32x32x16_bf16(am, bx, ad, 0, 0, 0);
                const bf16x8 ac = row_frag(Cs, ST_ROW, 32 * lb, 16 * kk, lane);
                const bf16x8 bhf = row_frag(Hf, ST_ROW, 32 * ph, 16 * kk, lane);
                const bf16x8 bhb = row_frag(Hb, ST_ROW, 32 * ph, 16 * kk, lane);
                af_ = __builtin_amdgcn_mfma_f32_32x32x16_bf16(ac, bhf, af_, 0, 0, 0);
                ab_ = __builtin_amdgcn_mfma_f32_32x32x16_bf16(ac, bhb, ab_, 0, 0, 0);
            }
            const float dsk = p->d_skip[l * 8 + h];
#pragma unroll
            for (int rg = 0; rg < 4; ++rg) {
                const int l0 = 32 * lb + 8 * rg + 4 * (ln >> 5);
                const f32x4 cfl = *(const LAS f32x4*)(hv + l0), cbl = *(const LAS f32x4*)(hv + 128 + l0);
#pragma unroll
                for (int e = 0; e < 4; ++e) { const int lr = l0 + e; const int ri = 4 * rg + e;
                    const float xs = bf2f(*(const LAS bf16_t*)(Xs + lr * ST_TR64 + pc * 2));
                    const float y = ad[ri] + __expf(cfl[e]) * af_[ri] + __expf(cbl[e]) * ab_[ri] + dsk * xs;
                    const float z = (ri & 1) ? bfhi(zraw[ri >> 1]) : bflo(zraw[ri >> 1]);
                    const float val = y * siluf_(z);
                    mix[(size_t)(row0 + lr) * 1024 + h * 64 + pc] = f2bf(val);
                    const float sq = half_sum32(val * val);
                    if ((ln & 31) == 31) ssqp[ph * 128 + lr] = sq;
                }
            }
            __syncthreads();
            if (tid < 128) SSQ[(size_t)(row0 + tid) * 8 + h] = ssqp[tid] + ssqp[128 + tid];
            if (hh < 3 && tid < 256) { float o[4][8];
                conv_compute(rx, cwl, 512, 256 + (hh + 1) * 64 + (tid & 7) * 8, o);
#pragma unroll
                for (int i = 0; i < 4; ++i) *(LAS u32x4*)(Xs + (4 * (tid >> 3) + i) * ST_TR64 + (tid & 7) * 16) = pack8(o[i]); }
        }
        __syncthreads();
    }
}
__device__ __forceinline__ void phase_r2(CP p, int l, unsigned char* lds, int bid, int nb) {
    float* wrt = (float*)lds;
    float* gm = wrt + 20 * 1024;
    float* sh = gm + 3 * 1024;
    int* lcnt = (int*)(sh + 3 * 1024);
    int* lcls = lcnt + 64;
    int* lrank = lcls + 1024;
    float* lcwa = (float*)(lrank + 1024);
    float* lcwb = lcwa + 1024;
    const int tid = launder_tid(); const int lane = tid & 63, wave = tid >> 6;
    const float* mod = (const float*)(p->ws + WS_MOD) + (size_t)l * 3 * 6144;
#pragma unroll
    for (int idx = tid; idx < 4 * 1024; idx += NTHREADS) { const int k = idx >> 2, n = idx & 3; wrt[n * 1024 + k] = p->w_rg[(size_t)l * 4096 + idx]; }
#pragma unroll 16
    for (int idx = tid; idx < 16 * 1024; idx += NTHREADS) { const int k = idx >> 4, n = idx & 15; wrt[(4 + n) * 1024 + k] = p->w_re[(size_t)l * 16384 + idx]; }
#pragma unroll
    for (int idx = tid; idx < 3 * 1024; idx += NTHREADS) { const int v = idx >> 10, k = idx & 1023; gm[idx] = p->g_ffn[l * 1024 + k] * (1.f + mod[v * 6144 + 4 * 1024 + k]); sh[idx] = mod[v * 6144 + 3 * 1024 + k]; }
    if (tid < 64) lcnt[tid] = 0;
    __syncthreads();
    bf16_t* HM = (bf16_t*)(p->ws + WS_HX); float* CWLA = (float*)(p->ws + WS_CWLA); float* CWLB = (float*)(p->ws + WS_CWLB); int* POS = (int*)(p->ws + WS_POS) + (size_t)l * R;
    int* gcount = (int*)(p->ws + WS_CTL) + l * 32; int* LIST = (int*)(p->ws + WS_LIST);
    const int rpb = (R + nb - 1) / nb, r0 = bid * rpb, r1 = (r0 + rpb) < R ? (r0 + rpb) : R;
    f32x4 xn[4];
    if (r0 + wave < r1) { const f32x4* hr = (const f32x4*)hptr(p, r0 + wave);
#pragma unroll
        for (int j = 0; j < 4; ++j) xn[j] = hr[lane + 64 * j]; }
    for (int r = r0 + wave; r < r1; r += 8) {
        const int v = row_v(r);
        f32x4 xv[4]; float ss = 0.f;
#pragma unroll
        for (int j = 0; j < 4; ++j) xv[j] = xn[j];
        if (r + 8 < r1) { const f32x4* hr = (const f32x4*)hptr(p, r + 8);
#pragma unroll
            for (int j = 0; j < 4; ++j) xn[j] = hr[lane + 64 * j]; }
        if (l == DEPTH - 1 && v == 2) { if (lane == 0) lcls[r - r0] = -1; continue; }
#pragma unroll
        for (int j = 0; j < 4; ++j) ss += xv[j][0] * xv[j][0] + xv[j][1] * xv[j][1] + xv[j][2] * xv[j][2] + xv[j][3] * xv[j][3];
        ss = wave_sum(ss); const float rs = rsqrtf(ss * (1.f / 1024.f) + 1e-6f);
#pragma unroll
        for (int j = 0; j < 4; ++j) { const int k = 4 * lane + 256 * j; const f32x4 g4 = *(const f32x4*)(gm + v * 1024 + k), s4 = *(const f32x4*)(sh + v * 1024 + k);
            xv[j] = xv[j] * rs * g4 + s4;
            u32x2 o; o.x = cvt_pk_bf16(xv[j][0], xv[j][1]); o.y = cvt_pk_bf16(xv[j][2], xv[j][3]);
            *(u32x2*)(HM + (size_t)r * 1024 + k) = o; }
        float lg[20];
#pragma unroll
        for (int n = 0; n < 20; ++n) { float a = 0.f;
#pragma unroll
            for (int j = 0; j < 4; ++j) { const f32x4 w4 = *(const f32x4*)(wrt + n * 1024 + 4 * lane + 256 * j); a += xv[j][0] * w4[0] + xv[j][1] * w4[1] + xv[j][2] * w4[2] + xv[j][3] * w4[3]; }
            lg[n] = wave_sum(a) + (n < 4 ? p->b_rg[l * 4 + n] : p->b_re[l * 16 + n - 4]); }
        int gsel = 0; float gmax = lg[0];
#pragma unroll
        for (int q = 1; q < 4; ++q) if (lg[q] > gmax) { gmax = lg[q]; gsel = q; }
        float gden = 0.f;
#pragma unroll
        for (int q = 0; q < 4; ++q) gden += __expf(lg[q] - gmax);
        const float gprob = 1.f / gden;
        float el[4];
#pragma unroll
        for (int q = 0; q < 4; ++q) el[q] = gsel == 0 ? lg[4 + q] : (gsel == 1 ? lg[8 + q] : (gsel == 2 ? lg[12 + q] : lg[16 + q]));
        int i0 = 0; float m0 = el[0];
#pragma unroll
        for (int q = 1; q < 4; ++q) if (el[q] > m0) { m0 = el[q]; i0 = q; }
        int i1 = -1; float m1 = -3.0e38f;
#pragma unroll
        for (int q = 0; q < 4; ++q) if (q != i0 && el[q] > m1) { m1 = el[q]; i1 = q; }
        const float w0 = gprob / (1.f + __expf(m1 - m0)), w1 = gprob - w0;
        const int ea = i0 < i1 ? i0 : i1, eb = i0 < i1 ? i1 : i0;
        const float cwa = i0 < i1 ? w0 : w1, cwb = i0 < i1 ? w1 : w0;
        const int pidx = ea == 0 ? eb - 1 : (ea == 1 ? eb + 1 : 5);
        const int cls = gsel * 6 + pidx;
        if (lane == 0) { const int rank = atomicAdd(&lcnt[cls], 1); lcls[r - r0] = cls; lrank[r - r0] = rank; lcwa[r - r0] = cwa; lcwb[r - r0] = cwb; }
    }
    __syncthreads();
    if (tid < NCLS) lcnt[32 + tid] = atomicAdd(&gcount[tid], lcnt[tid]);
    __syncthreads();
    for (int idx = tid; idx < r1 - r0; idx += NTHREADS) { const int cl = lcls[idx]; if (cl < 0) continue; const int pos = lcnt[32 + cl] + lrank[idx]; const size_t li = (size_t)cl * R + pos;
        LIST[li] = r0 + idx; CWLA[li] = lcwa[idx]; CWLB[li] = lcwb[idx]; POS[r0 + idx] = (cl << 16) | pos; }
    __syncthreads();
}
__device__ __forceinline__ void phase_final(CP p, unsigned char* lds, int bid, int nb) {
    const int tid = launder_tid(); const int lane = tid & 63, wave = tid >> 6;
    LAS int* tab = (LAS int*)((LAS unsigned char*)lds + MISC_OFF);
    moe_table(p, DEPTH - 1, tab);
    const int* POS = (const int*)(p->ws + WS_POS) + (size_t)(DEPTH - 1) * R;
    const int qstep = nb * 8;
    f32x4 xn[4]; u32x2 yn[4]; int posn = 0;
    { const int q = bid * 8 + wave;
      if (q < NB * SEQ) { const int b = q >= SEQ ? 1 : 0; const int r = b * SEG + CTXL + (q - b * SEQ); const f32x4* hr = (const f32x4*)(p->out + (size_t)q * D);
#pragma unroll
          for (int j = 0; j < 4; ++j) xn[j] = hr[lane + 64 * j];
          moe_yload(p, POS[r], lane, tab, yn);
          const int qn = q + qstep; if (qn < NB * SEQ) { const int bn = qn >= SEQ ? 1 : 0; posn = POS[bn * SEG + CTXL + (qn - bn * SEQ)]; } } }
    for (int q = bid * 8 + wave; q < NB * SEQ; q += qstep) {
        const int b = q >= SEQ ? 1 : 0;
        f32x4* hr = (f32x4*)(p->out + (size_t)q * D);
        f32x4 xv[4]; u32x2 yv[4]; float ss = 0.f;
#pragma unroll
        for (int j = 0; j < 4; ++j) { xv[j] = xn[j]; yv[j] = yn[j]; }
        { const int qn = q + qstep;
          if (qn < NB * SEQ) { const f32x4* hn = (const f32x4*)(p->out + (size_t)qn * D);
#pragma unroll
              for (int j = 0; j < 4; ++j) xn[j] = hn[lane + 64 * j];
              moe_yload(p, posn, lane, tab, yn);
              const int q2 = qn + qstep; if (q2 < NB * SEQ) { const int b2 = q2 >= SEQ ? 1 : 0; posn = POS[b2 * SEG + CTXL + (q2 - b2 * SEQ)]; } } }
        moe_yadd(p, DEPTH - 1, b, lane, yv, xv);
#pragma unroll
        for (int j = 0; j < 4; ++j) ss += xv[j][0] * xv[j][0] + xv[j][1] * xv[j][1] + xv[j][2] * xv[j][2] + xv[j][3] * xv[j][3];
        ss = wave_sum(ss); const float rs = rsqrtf(ss * (1.f / 1024.f) + 1e-6f);
#pragma unroll
        for (int j = 0; j < 4; ++j) { const f32x4 g4 = *(const f32x4*)(p->g_final + 4 * lane + 256 * j); hr[lane + 64 * j] = xv[j] * rs * g4; }
    }
}


#define XB_TMO      128
#define XB_XCNT(j)  (256  + 64 * (j))
#define XB_XSUB(j)  (1280 + 64 * (j))
#define XB_XGEN(j)  (2304 + 64 * (j))
#define XB_TOP      3328
#define XB_TOPGEN   3392
#define XCD_BAR_WORDS 3456
#define XB_SPIN_CAP (1u << 22)
__device__ __forceinline__ unsigned xb_ld(unsigned* p) { return __hip_atomic_load(p, __ATOMIC_RELAXED, __HIP_MEMORY_SCOPE_AGENT); }
__device__ __forceinline__ unsigned xb_add(unsigned* p, unsigned v) { return __hip_atomic_fetch_add(p, v, __ATOMIC_RELAXED, __HIP_MEMORY_SCOPE_AGENT); }
__device__ __forceinline__ unsigned xb_xcc_id() { return (unsigned)__builtin_amdgcn_s_getreg((3 << 11) | 20) & 0xFu; }
#define XB_SPIN(cond, bar) do { unsigned _sp = 0; while (cond) { __builtin_amdgcn_s_sleep(1); \
    if ((++_sp & 255u) == 0u) { if (xb_ld(&(bar)[XB_TMO])) break; if (_sp > XB_SPIN_CAP) { atomicAdd(&(bar)[XB_TMO], 1u); break; } } } } while (0)
struct XcdBarrier { unsigned* bar; unsigned x; volatile LAS unsigned* st; };
__device__ __forceinline__ XcdBarrier xcd_barrier_post(unsigned* bar, volatile LAS unsigned* st) {
    XcdBarrier b; b.bar = bar; b.x = xb_xcc_id(); b.st = st;
    if (threadIdx.x == 0) (void)xb_add(&bar[XB_XCNT(b.x)], 1u);
    return b;
}
__device__ __forceinline__ void xcd_barrier_complete(unsigned* bar, unsigned x, unsigned& nloc, unsigned& nx) {
    const unsigned G = gridDim.x * gridDim.y * gridDim.z;
    unsigned sum, cnt, mine, sp = 0u;
    for (;;) {
        sum = 0u; cnt = 0u; mine = 0u;
#pragma unroll
        for (unsigned j = 0; j < 16; ++j) { const unsigned c = xb_ld(&bar[XB_XCNT(j)]); sum += c; cnt += (c > 0u) ? 1u : 0u; mine = (j == x) ? c : mine; }
        if (sum == G) break;
        __builtin_amdgcn_s_sleep(1);
        if ((++sp & 255u) == 0u) { if (xb_ld(&bar[XB_TMO])) break; if (sp > XB_SPIN_CAP) { atomicAdd(&bar[XB_TMO], 1u); break; } }
    }
    nloc = mine > 0u ? mine : 1u; nx = cnt > 0u ? cnt : 1u;
}
__device__ __forceinline__ void xcd_barrier(const XcdBarrier& b) {
    asm volatile("s_waitcnt vmcnt(0)" ::: "memory");
    __syncthreads();
    if (threadIdx.x == 0) {
        unsigned* bar = b.bar;
        __builtin_amdgcn_s_waitcnt(0);
        unsigned nloc = b.st[0], nx = b.st[1];
        if (nloc == 0u) { xcd_barrier_complete(bar, b.x, nloc, nx); b.st[0] = nloc; b.st[1] = nx; }
        const unsigned old = xb_add(&bar[XB_XSUB(b.x)], 1u);
        const unsigned gen = old / nloc;
        if (old + 1u == (gen + 1u) * nloc) {
            __builtin_amdgcn_fence(__ATOMIC_RELEASE, "agent");
            asm volatile("s_waitcnt vmcnt(0)" ::: "memory");
            const unsigned og = xb_add(&bar[XB_TOP], 1u);
            const unsigned tg = og / nx;
            if (og + 1u == (tg + 1u) * nx) xb_add(&bar[XB_TOPGEN], 1u);
            else XB_SPIN(xb_ld(&bar[XB_TOPGEN]) == tg, bar);
            __builtin_amdgcn_fence(__ATOMIC_ACQUIRE, "agent");
            xb_add(&bar[XB_XGEN(b.x)], 1u);
            asm volatile("s_waitcnt vmcnt(0)" ::: "memory");
        } else {
            XB_SPIN(xb_ld(&bar[XB_XGEN(b.x)]) == gen, bar);
            __builtin_amdgcn_fence(__ATOMIC_ACQUIRE, "agent");
            asm volatile("s_waitcnt vmcnt(0)" ::: "memory");
        }
    }
    __syncthreads();
}

#ifndef PHASE_MASK
#define PHASE_MASK 0xFFFFF
#endif
#define PM(i) ((PHASE_MASK >> (i)) & 1)
#ifndef REPEAT_MASK
#define REPEAT_MASK 0
#endif
#define RP(i) for (int rep_ = 0; rep_ < 1 + ((REPEAT_MASK >> (i)) & 1); ++rep_)
constexpr int PH_PER_LAYER = 9, NPHASES = 1 + DEPTH * PH_PER_LAYER + 1;
__global__ void __launch_bounds__(NTHREADS, 2) mk_fwd(Args args) {
    extern __shared__ __attribute__((aligned(16))) unsigned char lds[];
    cg::grid_group grid = cg::this_grid();
    const __attribute__((address_space(4))) Args* ap = (const __attribute__((address_space(4))) Args*)__builtin_amdgcn_kernarg_segment_ptr();
    const int lo = ap->lo, hi = ap->hi;
    LAS unsigned char* ldsl = (LAS unsigned char*)lds;
    volatile LAS unsigned* xbst = (volatile LAS unsigned*)(ldsl + LDS_BYTES - 16);
    if (threadIdx.x < 4) xbst[threadIdx.x] = 0u;
    __syncthreads();
    (void)xcd_barrier_post((unsigned*)(ap->p.ws + WS_BAR), xbst);
    for (int ph = lo; ph < hi; ++ph) {
        CP p = launder(&ap->p);
        int bid = blockIdx.x, nb = gridDim.x; asm volatile("" : "+s"(bid), "+s"(nb));
        if (ph == 0) { if (PM(0)) RP(0) phase_wprep(p, lds, bid, nb); if (PM(1)) RP(1) phase_adaln(p, lds, bid, nb); }
        else if (ph == NPHASES - 1) { if (PM(12)) phase_final(p, lds, bid, nb); }
        else {
            const int l = (ph - 1) / PH_PER_LAYER, s = (ph - 1) % PH_PER_LAYER;
            if (s == 0) { if (PM(2)) RP(2) { if (rep_ == 0 || l == 0) phase_r1(p, l, lds, bid, nb); } }
            else if (s == 1) { if (PM(3)) RP(3) {
                pg8::DenseSched S; S.init(p->ws + WS_HX, (const bf16_t*)(p->ws + WS_WTIN) + (size_t)l * DIN * 1024, R, NPROJ, 1024, 1024, 1024, nb, bid);
                EpiProj E{(bf16_t*)(p->ws + WS_PROJ)};
                pg8::gemm_phase<EpiProj, pg8::DenseSched, false>(ldsl, 1024, 1024, 1024, S, E);
            } }
            else if (s == 2) { if (PM(4)) RP(4) phase_c1(p, l, lds, bid, nb); if (PM(5)) RP(5) phase_s1(p, l, lds, bid, nb); }
            else if (s == 3) { if (PM(6)) RP(6) phase_s2(p, bid, nb); if (PM(4)) phase_c1_ln(p, l, bid, nb); }
            else if (s == 4) { if (PM(7)) RP(7) phase_s3(p, l, lds, bid, nb); }
            else if (s == 5) { if (PM(8)) RP(8) { if (rep_ == 0 || l == 0) {
                pg8::DenseSched S; S.init(p->ws + WS_HX, (const bf16_t*)(p->ws + WS_WTOUT) + (size_t)l * 1024 * 1024, R, 1024, 1024, 1024, 1024, nb, bid, l == DEPTH - 1);
                EpiResid E{l == 0 ? p->ctx : (const float*)(p->ws + WS_HC), l == 0 ? p->x : (const float*)p->out, (float*)(p->ws + WS_HC), p->out, (const float*)(p->ws + WS_MOD) + (size_t)l * 3 * 6144, (const float*)(p->ws + WS_SSQ)};
                pg8::gemm_phase<EpiResid, pg8::DenseSched, false>(ldsl, 1024, 1024, 1024, S, E);
            } } }
            else if (s == 6) { if (PM(9)) phase_r2(p, l, lds, bid, nb); }
            else if (s == 7) { if (PM(10)) RP(10) {
                LAS int* tab = (LAS int*)(ldsl + MISC_OFF); moe_table(p, l, tab);
                MoeSched S{tab, (const int*)(p->ws + WS_LIST), (const char*)(p->ws + WS_HX), (const char*)(p->ws + WS_WTGU), 0, l, nb, bid};
                EpiUp E{(bf16_t*)(p->ws + WS_HID), (const float*)(p->ws + WS_CWLA), (const float*)(p->ws + WS_CWLB)};
                pg8::gemm_phase<EpiUp, MoeSched, true>(ldsl, 1024, 1024, 1024, S, E);
            } }
            else { if (PM(11)) RP(11) {
                LAS int* tab = (LAS int*)(ldsl + MISC_OFF); moe_table(p, l, tab);
                MoeSched S{tab, (const int*)(p->ws + WS_LIST), (const char*)(p->ws + WS_HID), (const char*)(p->ws + WS_WTD), 1, l, nb, bid};
                EpiY E{(bf16_t*)(p->ws + WS_Y)};
                pg8::gemm_phase<EpiY, MoeSched, false>(ldsl, 512, 256, 512, S, E);
            } }
        }
        if (ph + 1 < hi) { if (ph == lo) grid.sync(); else { XcdBarrier xb; xb.bar = (unsigned*)(launder(&ap->p)->ws + WS_BAR); xb.x = xb_xcc_id(); xb.st = (volatile LAS unsigned*)(ldsl + LDS_BYTES - 16); xcd_barrier(xb); } }
    }
}

extern "C" void kernel_launch(void* const* d_in, const int* in_sizes, int n_in, void* d_out, int out_size, void* d_ws, size_t ws_size, hipStream_t stream) {
    static int grid = 0;
    if (grid == 0) {
        if (n_in != 28 || ws_size < WS_END) { fprintf(stderr, "kernel_launch: unexpected n_in %d or ws_size %zu (< %zu)\n", n_in, ws_size, (size_t)WS_END); grid = -1; return; }
        int dev = 0, cus = 0, per_cu = 0;
        hipGetDevice(&dev); hipDeviceGetAttribute(&cus, hipDeviceAttributeMultiprocessorCount, dev);
        if (hipFuncSetAttribute((const void*)mk_fwd, hipFuncAttributeMaxDynamicSharedMemorySize, LDS_BYTES) != hipSuccess) { fprintf(stderr, "kernel_launch: hipFuncSetAttribute failed\n"); grid = -1; return; }
        if (hipOccupancyMaxActiveBlocksPerMultiprocessor(&per_cu, (const void*)mk_fwd, NTHREADS, LDS_BYTES) != hipSuccess || per_cu < 1) { fprintf(stderr, "kernel_launch: occupancy query says %d\n", per_cu); (void)hipGetLastError(); grid = -1; return; }
        grid = cus;
    }
    if (grid < 0) return;
    (void)hipMemsetAsync((char*)d_ws + WS_CTL, 0, WS_CTL_BYTES, stream);
    Args a{};
    const float** pp = (const float**)&a.p;
    for (int i = 0; i < 28; ++i) pp[i] = (const float*)d_in[i];
    a.p.out = (float*)d_out; a.p.ws = (unsigned char*)d_ws;
#if PER_PHASE_LAUNCH
    for (int ph = 0; ph < NPHASES; ++ph) {
        a.lo = ph; a.hi = ph + 1; void* kargs[] = {&a};
        hipError_t e = hipLaunchCooperativeKernel((const void*)mk_fwd, dim3(grid), dim3(NTHREADS), kargs, LDS_BYTES, stream);
        if (e != hipSuccess) { fprintf(stderr, "kernel_launch: launch of phase %d failed: %s\n", ph, hipGetErrorString(e)); break; }
    }
#else
    a.lo = 0; a.hi = NPHASES; void* kargs[] = {&a};
    hipError_t e = hipLaunchCooperativeKernel((const void*)mk_fwd, dim3(grid), dim3(NTHREADS), kargs, LDS_BYTES, stream);
    if (e != hipSuccess) fprintf(stderr, "kernel_launch: cooperative launch failed: %s (grid %d)\n", hipGetErrorString(e), grid);
#endif
}
```

```cpp
#include <hip/hip_runtime.h>
#include <hip/hip_cooperative_groups.h>
#include <cstdio>
namespace cg = cooperative_groups;

#ifndef PER_PHASE_LAUNCH
#define PER_PHASE_LAUNCH 0
#endif

#ifndef S3REP
#define S3REP 0
#endif
#define S3R(i) for (int r3_ = 0; r3_ < 1 + ((S3REP >> (i)) & 1); ++r3_)
#define LAS __attribute__((address_space(3)))
typedef unsigned short bf16_t;
typedef short bf16x8 __attribute__((ext_vector_type(8)));
typedef float f32x4 __attribute__((ext_vector_type(4)));
typedef unsigned u32x4 __attribute__((ext_vector_type(4)));
typedef unsigned u32x2 __attribute__((ext_vector_type(2)));

constexpr int D = 1024, NB = 2, SEQ = 16384, CTXL = 256, SEG = SEQ + CTXL, R = NB * SEG, DEPTH = 2;
constexpr int NPROJ = 2560, DIN = 2576;
constexpr int NTHREADS = 512;
constexpr int LDS_BYTES = 163840;
constexpr int MISC_OFF = 131072;
constexpr int NCLS = 24;

constexpr size_t al256(size_t x) { return (x + 255) & ~size_t(255); }
constexpr size_t WS_CTL = 0;
constexpr size_t WS_TS = 2048;
constexpr size_t WS_BAR = 4096;
constexpr size_t WS_CTL_BYTES = 32768;
constexpr size_t WS_MOD = WS_CTL_BYTES;
constexpr size_t WS_WTIN = WS_MOD + al256((size_t)2 * 3 * 6144 * 4);
constexpr size_t WS_WTOUT = WS_WTIN + al256((size_t)2 * DIN * 1024 * 2);
constexpr size_t WS_WTGU = WS_WTOUT + al256((size_t)2 * 1024 * 1024 * 2);
constexpr size_t WS_WTD = WS_WTGU + al256((size_t)2 * 16 * 512 * 1024 * 2);
constexpr size_t WS_HC = WS_WTD + al256((size_t)2 * 16 * 1024 * 256 * 2);
constexpr size_t WS_HX = WS_HC + al256((size_t)512 * 1024 * 4);
constexpr size_t WS_PROJ = WS_HX + al256((size_t)R * 1024 * 2);
constexpr size_t WS_DT = WS_PROJ + al256((size_t)R * NPROJ * 2);
constexpr size_t WS_POS = WS_DT + al256((size_t)R * 16 * 4);
constexpr size_t WS_LIST = WS_POS + al256((size_t)2 * R * 4);
constexpr size_t WS_CWLA = WS_LIST + al256((size_t)NCLS * R * 4);
constexpr size_t WS_CWLB = WS_CWLA + al256((size_t)NCLS * R * 4);
constexpr size_t WS_BIG = WS_CWLB + al256((size_t)NCLS * R * 4);
constexpr size_t WS_Y = WS_PROJ;
constexpr size_t WS_S = WS_BIG;
constexpr size_t WS_HP = WS_S + al256((size_t)2 * 2 * 130 * 8 * 8192 * 4);
constexpr size_t WS_DEC = WS_HP + al256((size_t)2 * 2 * 130 * 8 * 8192 * 2);
constexpr size_t WS_SSQ = WS_DEC + al256((size_t)2 * 2 * 130 * 8 * 4);
constexpr size_t WS_HID = WS_S;
constexpr size_t WS_END = WS_SSQ + al256((size_t)R * 8 * 4);
static_assert((size_t)(R + NCLS * 256) * 512 * 2 <= (size_t)2 * 2 * 130 * 8 * 8192 * 4, "hid alias");
static_assert(WS_END <= (size_t)512 * 1024 * 1024, "workspace");

struct Params {
    const float *x, *c, *ctx, *c_ctx, *w_ada, *b_ada, *g_mix, *g_ffn, *w_in, *conv_w, *conv_b, *conv_ln_g, *conv_ln_b, *ssd_conv_w, *ssd_conv_b,
        *dt_bias, *a_log, *d_skip, *ssd_norm_g, *w_out, *w_rg, *b_rg, *w_re, *b_re, *w_gate, *w_up, *w_down, *g_final;
    float* out; unsigned char* ws;
};
struct Args { Params p; int lo, hi; };
typedef const __attribute__((address_space(4))) Params* CP;
__device__ __forceinline__ CP launder(CP p) { asm volatile("" : "+s"(p)); return p; }
__device__ __forceinline__ int launder_tid() { int t = threadIdx.x; asm volatile("" : "+v"(t)); return t; }

__device__ __forceinline__ unsigned cvt_pk_bf16(float lo, float hi) { unsigned r; asm("v_cvt_pk_bf16_f32 %0, %1, %2" : "=v"(r) : "v"(lo), "v"(hi)); return r; }
__device__ __forceinline__ float bf2f(unsigned b) { return __uint_as_float(b << 16); }
__device__ __forceinline__ float bflo(unsigned w) { return __uint_as_float(w << 16); }
__device__ __forceinline__ float bfhi(unsigned w) { return __uint_as_float(w & 0xffff0000u); }
__device__ __forceinline__ bf16_t f2bf(float f) { return (bf16_t)(cvt_pk_bf16(f, 0.f) & 0xffffu); }
#define DPP_ADD(v, ctrl, rm) ((v) + __builtin_bit_cast(float, __builtin_amdgcn_update_dpp(0, __builtin_bit_cast(int, (v)), (ctrl), (rm), 0xF, true)))
__device__ __forceinline__ float row_sum16(float v) {
    v = DPP_ADD(v, 0xB1, 0xF);
    v = DPP_ADD(v, 0x4E, 0xF);
    v = DPP_ADD(v, 0x141, 0xF);
    v = DPP_ADD(v, 0x140, 0xF);
    return v;
}
__device__ __forceinline__ float half_sum32(float v) { v = row_sum16(v); v = DPP_ADD(v, 0x142, 0xA); return v; }
__device__ __forceinline__ float wave_sum(float v) {
    v = half_sum32(v); v = DPP_ADD(v, 0x143, 0xC);
    return __builtin_bit_cast(float, __builtin_amdgcn_readlane(__builtin_bit_cast(int, v), 63));
}
__device__ __forceinline__ float sigmoidf_(float x) { return 1.f / (1.f + __expf(-x)); }
__device__ __forceinline__ float siluf_(float x) { return x / (1.f + __expf(-x)); }
__device__ __forceinline__ float softplusf_(float x) { return fmaxf(x, 0.f) + log1pf(expf(-fabsf(x))); }

__device__ __forceinline__ int row_b(int r) { return r >= SEG ? 1 : 0; }
__device__ __forceinline__ int row_i(int r) { return r >= SEG ? r - SEG : r; }
__device__ __forceinline__ int row_v(int r) { const int i = row_i(r); return i < CTXL ? 2 : row_b(r); }
__device__ __forceinline__ float* hptr2(float* hc, float* out, int r) {
    const int b = row_b(r), i = row_i(r);
    return i < CTXL ? hc + (size_t)(b * CTXL + i) * D : out + (size_t)(b * SEQ + i - CTXL) * D;
}
__device__ __forceinline__ float* hptr(CP p, int r) { return hptr2((float*)(p->ws + WS_HC), p->out, r); }
__device__ __forceinline__ const float* hin_ptr(CP p, int l, int r) {
    if (l == 0) return hptr2((float*)p->ctx, (float*)p->x, r);
    return hptr(p, r);
}

namespace pg8 {
constexpr int BM = 256, BK = 64, HALF = 128, HTB = HALF * BK * 2, STAGE_BYTES = 8 * HTB, NXCD = 8, WGM = 8;
__device__ __forceinline__ int lds_byte(int r, int c) { const int st = (r >> 4) * 2 + (c >> 5), rr = r & 15, cc = c & 31, ob = rr * 64 + cc * 2; return st * 1024 + (ob ^ (((ob >> 9) & 1) << 5)); }
__device__ __forceinline__ void stage_rc(int b, int& Rr, int& Cc) { const int st = b / 1024, sb = b % 1024, swz = sb ^ (((sb >> 9) & 1) << 5); Rr = (st >> 1) * 16 + swz / 64; Cc = (st & 1) * 32 + (swz % 64) / 2; }
__device__ __forceinline__ int perm32(int rho) { const int n = rho >> 4, i = rho & 15; return 8 * (i >> 2) + 4 * n + (i & 3); }

struct Unit {
    const char* a0;
    const char* b0;
    const char* b1;
    int i0, i1, i2, i3, i4, pad;
};

template <class Epi, class Sched, bool GATHER>
__device__ __forceinline__ void gemm_phase(LAS unsigned char* lds, const int lda, const int ldb, const int K, const Sched& S, const Epi& E) {
    const int tid = launder_tid(); const int wid = __builtin_amdgcn_readfirstlane(tid >> 6), lane = tid & 63, wr = wid >> 2, wc = wid & 3, fr = lane & 15, fq = lane >> 4;
    const int nt = K / BK, ks = nt >> 1;
    int Rr[2], Cc[2];
    unsigned voffB[2];
#pragma unroll
    for (int i = 0; i < 2; ++i) { stage_rc(tid * 16 + i * 8192, Rr[i], Cc[i]); const int Rb = Epi::PERM ? ((Rr[i] & ~31) + perm32(Rr[i] & 31)) : Rr[i];
        voffB[i] = (unsigned)(Rb * ldb + Cc[i]) * 2u; }
    const size_t kstep = (size_t)(BK * 2);
    const size_t hstepB = (size_t)HALF * ldb * 2;
    const unsigned ldsw = (unsigned)wid * 1024u;
    const unsigned ldsbase = (unsigned)(unsigned long)lds;
    const int aoff = lds_byte(wr * 64 + fr, fq * 8), boff = lds_byte(wc * 32 + fr, fq * 8);
#define PG8_SA(b, h) (((b) * 2 + (h)) * HTB)
#define PG8_SB(b, h) ((4 + (b) * 2 + (h)) * HTB)
#define PG8_STAGE2(bufoff, gbase, v0, v1) do { unsigned keep_; \
        asm volatile("s_mov_b32 %0, m0\n\ts_mov_b32 m0, %1\n\ts_nop 4\n\tglobal_load_lds_dwordx4 %2, %4\n\ts_add_u32 m0, m0, 0x2000\n\ts_nop 0\n\tglobal_load_lds_dwordx4 %3, %4\n\ts_mov_b32 m0, %0" \
            : "=&s"(keep_) : "s"(ldsbase + (unsigned)(bufoff) + ldsw), "v"(v0), "v"(v1), "s"(gbase) : "memory", "scc"); } while (0)
#define PG8_LDA(dst, b, h) do { _Pragma("unroll") for (int m = 0; m < 4; ++m) _Pragma("unroll") for (int k = 0; k < 2; ++k) dst[m][k] = *(const LAS bf16x8*)(lds + PG8_SA(b, h) + aoff + m * 2048 + k * 1024); } while (0)
#define PG8_LDB(dst, b, h) do { _Pragma("unroll") for (int n = 0; n < 2; ++n) _Pragma("unroll") for (int k = 0; k < 2; ++k) dst[n][k] = *(const LAS bf16x8*)(lds + PG8_SB(b, h) + boff + n * 2048 + k * 1024); } while (0)
#define PG8_MMA(ai, bj, At, Bt) do { __builtin_amdgcn_s_setprio(1); _Pragma("unroll") for (int m = 0; m < 4; ++m) _Pragma("unroll") for (int n = 0; n < 2; ++n) _Pragma("unroll") for (int k = 0; k < 2; ++k) \
        acc[ai][bj][m][n] = __builtin_amdgcn_mfma_f32_16x16x32_bf16(Bt[n][k], At[m][k], acc[ai][bj][m][n], 0, 0, 0); __builtin_amdgcn_s_setprio(0); } while (0)
#define PG8_WAIT_V(n) asm volatile("s_waitcnt vmcnt(" #n ")" ::: "memory")
#define PG8_WAIT_L(n) asm volatile("s_waitcnt lgkmcnt(" #n ")" ::: "memory")
#define PG8_BAR __builtin_amdgcn_s_barrier()
#define PG8_SCHED __builtin_amdgcn_sched_barrier(0)
#define PG8_BP(u, tt) ((tt) < ks ? (u).b0 + (size_t)(tt) * kstep : (u).b1 + (size_t)((tt) - ks) * kstep)
    Unit cur, nxt; int ui = 0;
    if (!S.get(0, cur)) return;
    unsigned c00, c01, c10, c11, n00, n01, n10, n11;
    if (GATHER) {
        c00 = (unsigned)(S.arow(cur, Rr[0]) * lda + Cc[0]) * 2u; c01 = (unsigned)(S.arow(cur, Rr[1]) * lda + Cc[1]) * 2u;
        c10 = (unsigned)(S.arow(cur, HALF + Rr[0]) * lda + Cc[0]) * 2u; c11 = (unsigned)(S.arow(cur, HALF + Rr[1]) * lda + Cc[1]) * 2u;
    } else {
        c00 = (unsigned)(Rr[0] * lda + Cc[0]) * 2u; c01 = (unsigned)(Rr[1] * lda + Cc[1]) * 2u;
        c10 = (unsigned)((HALF + Rr[0]) * lda + Cc[0]) * 2u; c11 = (unsigned)((HALF + Rr[1]) * lda + Cc[1]) * 2u;
    }
    n00 = c00; n01 = c01; n10 = c10; n11 = c11;
    f32x4 acc[2][2][4][2];
    float zr; asm volatile("v_mov_b32 %0, 0" : "=v"(zr));
#pragma unroll
    for (int a = 0; a < 2; ++a)
#pragma unroll
        for (int b = 0; b < 2; ++b)
#pragma unroll
            for (int m = 0; m < 4; ++m)
#pragma unroll
                for (int n = 0; n < 2; ++n) acc[a][b][m][n] = (f32x4){zr, zr, zr, zr};
    bf16x8 At[4][2], B0[2][2], B1[2][2];
    const char* cA = cur.a0;
    {
        const char* pb0 = PG8_BP(cur, 0); const char* pb1 = PG8_BP(cur, 1);
        PG8_STAGE2(PG8_SB(0, 0), pb0, voffB[0], voffB[1]); PG8_STAGE2(PG8_SA(0, 0), cA, c00, c01);
        PG8_STAGE2(PG8_SB(0, 1), pb0 + hstepB, voffB[0], voffB[1]); PG8_STAGE2(PG8_SA(0, 1), cA, c10, c11);
        if (wr == 1) PG8_BAR;
        PG8_WAIT_V(4); PG8_BAR;
        PG8_STAGE2(PG8_SB(1, 0), pb1, voffB[0], voffB[1]); PG8_STAGE2(PG8_SA(1, 0), cA + kstep, c00, c01);
        PG8_STAGE2(PG8_SB(1, 1), pb1 + hstepB, voffB[0], voffB[1]);
        PG8_WAIT_V(6); PG8_BAR;
    }
    for (;;) {
        const bool has_next = S.get(ui + 1, nxt);
        if (!has_next) nxt = cur;
        LAS int* tokb = (LAS int*)(lds + MISC_OFF + 1024) + ((ui + 1) & 1) * 256;
        if (GATHER) {
            n00 = c00; n01 = c01; n10 = c10; n11 = c11;
            if (has_next && wid == 0) {
                const char* src = (const char*)S.rows_ptr(nxt); unsigned keep_;
                asm volatile("s_mov_b32 %0, m0\n\ts_mov_b32 m0, %1\n\ts_nop 4\n\tglobal_load_lds_dwordx4 %2, %3\n\ts_mov_b32 m0, %0"
                    : "=&s"(keep_) : "s"((unsigned)(unsigned long)tokb), "v"((unsigned)lane * 16u), "s"(src) : "memory");
            }
        }
        const char* nA = nxt.a0;
#pragma unroll 1
        for (int t = 0; t < nt; t += 2) {
            const bool last = (t == nt - 2);
            const char* a1 = cA + (size_t)(t + 1) * kstep;
            const char* a2 = last ? nA : cA + (size_t)(t + 2) * kstep;
            const char* a3 = a2 + kstep;
            const char* b2 = last ? PG8_BP(nxt, 0) : PG8_BP(cur, t + 2);
            const char* b3 = last ? PG8_BP(nxt, 1) : PG8_BP(cur, t + 3);
            if (GATHER) { if (last && has_next) {
                const int lim = S.rows_valid(nxt) - 1;
                const int i0 = Rr[0] < lim ? Rr[0] : lim, i1 = Rr[1] < lim ? Rr[1] : lim, i2 = (HALF + Rr[0]) < lim ? (HALF + Rr[0]) : lim, i3 = (HALF + Rr[1]) < lim ? (HALF + Rr[1]) : lim;
                n00 = (unsigned)(tokb[i0] * lda + Cc[0]) * 2u; n01 = (unsigned)(tokb[i1] * lda + Cc[1]) * 2u;
                n10 = (unsigned)(tokb[i2] * lda + Cc[0]) * 2u; n11 = (unsigned)(tokb[i3] * lda + Cc[1]) * 2u; } }
            const unsigned s00 = last ? n00 : c00, s01 = last ? n01 : c01, s10 = last ? n10 : c10, s11 = last ? n11 : c11;
            if constexpr (Epi::MIDSCALE) { if (t == ks) E.midscale(acc, cur, wr, wc, fr, fq); }
            PG8_LDB(B0, 0, 0); PG8_SCHED; PG8_LDA(At, 0, 0); PG8_STAGE2(PG8_SA(1, 1), a1, c10, c11);
            PG8_WAIT_L(8); PG8_BAR; PG8_WAIT_L(0); PG8_MMA(0, 0, At, B0); PG8_BAR; PG8_SCHED;
            PG8_LDB(B1, 0, 1); PG8_STAGE2(PG8_SB(0, 0), b2, voffB[0], voffB[1]);
            PG8_BAR; PG8_WAIT_L(0); PG8_MMA(0, 1, At, B1); PG8_BAR;
            PG8_LDA(At, 0, 1); PG8_STAGE2(PG8_SA(0, 0), a2, s00, s01);
            PG8_BAR; PG8_WAIT_L(0); PG8_MMA(1, 0, At, B0); PG8_BAR; PG8_SCHED;
            PG8_STAGE2(PG8_SB(0, 1), b2 + hstepB, voffB[0], voffB[1]);
            PG8_WAIT_V(6); PG8_BAR; PG8_MMA(1, 1, At, B1); PG8_BAR;
            PG8_LDB(B0, 1, 0); PG8_SCHED; PG8_LDA(At, 1, 0); PG8_STAGE2(PG8_SA(0, 1), a2, s10, s11);
            PG8_WAIT_L(8); PG8_BAR; PG8_WAIT_L(0); PG8_MMA(0, 0, At, B0); PG8_BAR; PG8_SCHED;
            PG8_LDB(B1, 1, 1); PG8_STAGE2(PG8_SB(1, 0), b3, voffB[0], voffB[1]);
            PG8_BAR; PG8_WAIT_L(0); PG8_MMA(0, 1, At, B1); PG8_BAR;
            PG8_LDA(At, 1, 1); PG8_STAGE2(PG8_SA(1, 0), a3, s00, s01);
            PG8_BAR; PG8_WAIT_L(0); PG8_MMA(1, 0, At, B0); PG8_BAR; PG8_SCHED;
            PG8_STAGE2(PG8_SB(1, 1), b3 + hstepB, voffB[0], voffB[1]);
            PG8_WAIT_V(6); PG8_BAR; PG8_MMA(1, 1, At, B1); PG8_BAR;
        }
        E(acc, cur, wr, wc, fr, fq);
        if (!has_next) break;
        asm volatile("v_mov_b32 %0, 0" : "=v"(zr));
#pragma unroll
        for (int a = 0; a < 2; ++a)
#pragma unroll
            for (int b = 0; b < 2; ++b)
#pragma unroll
                for (int m = 0; m < 4; ++m)
#pragma unroll
                    for (int n = 0; n < 2; ++n) acc[a][b][m][n] = (f32x4){zr, zr, zr, zr};
        cur = nxt; cA = nA; ++ui; c00 = n00; c01 = n01; c10 = n10; c11 = n11;
    }
    PG8_WAIT_V(0);
    if (wr == 0) PG8_BAR;
    PG8_BAR;
#undef PG8_SA
#undef PG8_SB
#undef PG8_STAGE2
#undef PG8_LDA
#undef PG8_LDB
#undef PG8_MMA
#undef PG8_WAIT_V
#undef PG8_WAIT_L
#undef PG8_BAR
#undef PG8_SCHED
#undef PG8_BP
}

struct DenseSched {
    const char* A; const char* Bt; int lda, ldb, K; int nM, nN, nwg, G, c, skipctx;
    __device__ __forceinline__ void init(const void* A_, const void* Bt_, int M, int N, int K_, int lda_, int ldb_, int G_, int c_, int skipctx_ = 0) {
        A = (const char*)A_; Bt = (const char*)Bt_; lda = lda_; ldb = ldb_; K = K_; nM = M / BM - 2 * skipctx_; nN = N / BM; nwg = nM * nN; G = G_; c = c_; skipctx = skipctx_; }
    __device__ __forceinline__ bool get(int i, Unit& u) const {
        const long L = (long)i * G + c; if (L >= nwg) return false;
        int wgid = (int)L; { const int q = nwg / NXCD, r = nwg % NXCD, xcd = wgid % NXCD, off = wgid / NXCD; wgid = (xcd < r ? xcd * (q + 1) : r * (q + 1) + (xcd - r) * q) + off; }
        const int nig = WGM * nN, gid = wgid / nig, fm = gid * WGM, gsz = (nM - fm) < WGM ? (nM - fm) : WGM;
        int pm = fm + ((wgid % nig) % gsz); const int pn = (wgid % nig) / gsz;
        if (skipctx) pm += 1 + (pm >= 64 ? 1 : 0);
        u.a0 = A + (size_t)pm * BM * lda * 2; u.b0 = Bt + (size_t)pn * BM * ldb * 2; u.b1 = u.b0 + (size_t)(K / BK / 2) * BK * 2;
        u.i0 = pm; u.i1 = pn; u.i2 = 0; u.i3 = 0; u.i4 = 0; u.pad = 0; return true;
    }
    __device__ __forceinline__ int arow(const Unit&, int rl) const { return rl; }
    __device__ __forceinline__ const int* rows_ptr(const Unit&) const { return nullptr; }
    __device__ __forceinline__ int rows_valid(const Unit&) const { return 256; }
};
}

struct EpiProj {
    static constexpr bool PERM = true, MIDSCALE = false;
    bf16_t* O;
    __device__ __forceinline__ void operator()(const f32x4 (&acc)[2][2][4][2], const pg8::Unit& u, int wr, int wc, int fr, int fq) const {
        const int row0 = u.i0 * 256 + wr * 64 + fr, col0 = u.i1 * 256 + wc * 32 + 8 * fq;
#pragma unroll
        for (int ai = 0; ai < 2; ++ai)
#pragma unroll
            for (int m = 0; m < 4; ++m) { bf16_t* rowp = O + (size_t)(row0 + ai * 128 + m * 16) * NPROJ + col0;
#pragma unroll
                for (int bj = 0; bj < 2; ++bj) { const f32x4 v0 = acc[ai][bj][m][0], v1 = acc[ai][bj][m][1];
                    u32x4 w; w.x = cvt_pk_bf16(v0[0], v0[1]); w.y = cvt_pk_bf16(v0[2], v0[3]); w.z = cvt_pk_bf16(v1[0], v1[1]); w.w = cvt_pk_bf16(v1[2], v1[3]);
                    *(u32x4*)(rowp + bj * 128) = w; } }
    }
};
struct EpiResid {
    static constexpr bool PERM = false, MIDSCALE = true;
    const float* inc; const float* inx; float* hc; float* out; const float* modl; const float* ssq;
    __device__ __forceinline__ void midscale(f32x4 (&acc)[2][2][4][2], const pg8::Unit& u, int wr, int wc, int fr, int fq) const {
        typedef float f32x2 __attribute__((ext_vector_type(2)));
        const int r0 = u.i0 * 256 + wr * 64 + fr;
        f32x2 part[2][4];
#pragma unroll
        for (int ai = 0; ai < 2; ++ai)
#pragma unroll
            for (int m = 0; m < 4; ++m) part[ai][m] = *(const f32x2*)(ssq + (size_t)(r0 + ai * 128 + m * 16) * 8 + 2 * fq);
#pragma unroll
        for (int ai = 0; ai < 2; ++ai)
#pragma unroll
            for (int m = 0; m < 4; ++m) { float sq = part[ai][m][0] + part[ai][m][1];
                sq += __shfl_xor(sq, 16); sq += __shfl_xor(sq, 32);
                const float rs = rsqrtf(sq * (1.f / 512.f) + 1e-6f);
#pragma unroll
                for (int bj = 0; bj < 2; ++bj)
#pragma unroll
                    for (int n = 0; n < 2; ++n) acc[ai][bj][m][n] *= rs; }
    }
    __device__ __forceinline__ void operator()(const f32x4 (&acc)[2][2][4][2], const pg8::Unit& u, int wr, int wc, int fr, int fq) const {
        const int r0 = u.i0 * 256;
        const int v = row_v(r0);
        const float* gate = modl + (size_t)v * 6144 + 2 * 1024;
        const float* hin = hptr2((float*)inc, (float*)inx, r0); float* hout = hptr2(hc, out, r0);
        const int rl0 = wr * 64 + fr, col0 = u.i1 * 256 + wc * 32 + 4 * fq;
        f32x4 gv[2][2];
#pragma unroll
        for (int bj = 0; bj < 2; ++bj)
#pragma unroll
            for (int n = 0; n < 2; ++n) gv[bj][n] = *(const f32x4*)(gate + col0 + bj * 128 + n * 16);
#pragma unroll
        for (int ai = 0; ai < 2; ++ai)
#pragma unroll
            for (int mp = 0; mp < 2; ++mp) {
                f32x4 hi[2][2][2];
#pragma unroll
                for (int mm = 0; mm < 2; ++mm) { const size_t off = (size_t)(rl0 + ai * 128 + (2 * mp + mm) * 16) * D + col0;
#pragma unroll
                    for (int bj = 0; bj < 2; ++bj)
#pragma unroll
                        for (int n = 0; n < 2; ++n) hi[mm][bj][n] = *(const f32x4*)(hin + off + bj * 128 + n * 16); }
#pragma unroll
                for (int mm = 0; mm < 2; ++mm) { const size_t off = (size_t)(rl0 + ai * 128 + (2 * mp + mm) * 16) * D + col0;
#pragma unroll
                    for (int bj = 0; bj < 2; ++bj)
#pragma unroll
                        for (int n = 0; n < 2; ++n) *(f32x4*)(hout + off + bj * 128 + n * 16) = hi[mm][bj][n] + gv[bj][n] * acc[ai][bj][2 * mp + mm][n]; }
                asm volatile("" ::: "memory"); }
    }
};

struct MoeSched {
    const LAS int* tab;
    const int* list;
    const char* A; const char* W; int mode  , l, G, c;
    __device__ __forceinline__ bool get(int i, pg8::Unit& u) const {
        const int L = i * G + c; const int total = __builtin_amdgcn_readfirstlane(tab[24]) * 4; if (L >= total) return false;
        const int tl = L >> 2, pn = L & 3;
        int cls = 0;
#pragma unroll 1
        for (int q = 1; q < NCLS; ++q) { const int tq = __builtin_amdgcn_readfirstlane(tab[q]); if (tq <= tl) cls = q; }
        const int j = tl - __builtin_amdgcn_readfirstlane(tab[cls]), cnt = __builtin_amdgcn_readfirstlane(tab[32 + cls]);
        const int g = cls / 6, pidx = cls - g * 6;
        const int ea = (pidx >= 3) + (pidx >= 5), eb = pidx < 3 ? pidx + 1 : (pidx < 5 ? pidx - 1 : 3);
        if (mode == 0) {
            const int e = 4 * g + (pn < 2 ? ea : eb);
            u.a0 = A;
            u.b0 = W + ((size_t)(l * 16 + e) * 512 + (size_t)(pn & 1) * 256) * 1024 * 2; u.b1 = u.b0 + (size_t)8 * 128;
        } else {
            u.a0 = A + (size_t)tl * 256 * 512 * 2;
            u.b0 = W + ((size_t)(l * 16 + 4 * g + ea) * 1024 + (size_t)pn * 256) * 256 * 2;
            u.b1 = W + ((size_t)(l * 16 + 4 * g + eb) * 1024 + (size_t)pn * 256) * 256 * 2;
        }
        u.i0 = cls; u.i1 = j; u.i2 = pn; u.i3 = cnt; u.i4 = tl; u.pad = 0; return true;
    }
    __device__ __forceinline__ int arow(const pg8::Unit& u, int rl) const {
        int idx = u.i1 * 256 + rl; idx = idx < u.i3 ? idx : u.i3 - 1;
        return list[(size_t)u.i0 * R + idx];
    }
    __device__ __forceinline__ const int* rows_ptr(const pg8::Unit& u) const { return list + (size_t)u.i0 * R + u.i1 * 256; }
    __device__ __forceinline__ int rows_valid(const pg8::Unit& u) const { return u.i3 - u.i1 * 256; }
};
struct EpiUp {
    static constexpr bool PERM = true, MIDSCALE = false;
    bf16_t* hid; const float* cwla; const float* cwlb;
    __device__ __forceinline__ void operator()(const f32x4 (&acc)[2][2][4][2], const pg8::Unit& u, int wr, int wc, int fr, int fq) const {
        const int cls = u.i0, j = u.i1, pn = u.i2, cnt = u.i3, tl = u.i4;
        const float* cw = (pn < 2) ? cwla : cwlb;
        const int colbase = (pn >> 1) * 256 + (pn & 1) * 128 + wc * 32 + 8 * fq;
        float wrow[2][4];
#pragma unroll
        for (int ai = 0; ai < 2; ++ai)
#pragma unroll
            for (int m = 0; m < 4; ++m) { const int idx = j * 256 + ai * 128 + wr * 64 + m * 16 + fr; wrow[ai][m] = idx < cnt ? cw[(size_t)cls * R + idx] : 0.f; }
#pragma unroll
        for (int ai = 0; ai < 2; ++ai)
#pragma unroll
            for (int m = 0; m < 4; ++m) {
                const int rl = ai * 128 + wr * 64 + m * 16 + fr; const int idx = j * 256 + rl; const bool valid = idx < cnt;
                const float w = wrow[ai][m];
                const f32x4 g0 = acc[ai][0][m][0], g1 = acc[ai][0][m][1], u0 = acc[ai][1][m][0], u1 = acc[ai][1][m][1];
                float o[8];
#pragma unroll
                for (int e = 0; e < 4; ++e) { o[e] = w * siluf_(g0[e]) * u0[e]; o[4 + e] = w * siluf_(g1[e]) * u1[e]; }
                if (!valid) {
#pragma unroll
                    for (int e = 0; e < 8; ++e) o[e] = 0.f; }
                u32x4 pk; pk.x = cvt_pk_bf16(o[0], o[1]); pk.y = cvt_pk_bf16(o[2], o[3]); pk.z = cvt_pk_bf16(o[4], o[5]); pk.w = cvt_pk_bf16(o[6], o[7]);
                *(u32x4*)(hid + ((size_t)tl * 256 + rl) * 512 + colbase) = pk;
                asm volatile("" ::: "memory");
            }
    }
};
struct EpiY {
    static constexpr bool PERM = true, MIDSCALE = false;
    bf16_t* Y;
    __device__ __forceinline__ void operator()(const f32x4 (&acc)[2][2][4][2], const pg8::Unit& u, int wr, int wc, int fr, int fq) const {
        const int row0 = u.i4 * 256 + wr * 64 + fr, col0 = u.i2 * 256 + wc * 32 + 8 * fq;
#pragma unroll
        for (int ai = 0; ai < 2; ++ai)
#pragma unroll
            for (int m = 0; m < 4; ++m) { bf16_t* rowp = Y + (size_t)(row0 + ai * 128 + m * 16) * 1024 + col0;
#pragma unroll
                for (int bj = 0; bj < 2; ++bj) { const f32x4 v0 = acc[ai][bj][m][0], v1 = acc[ai][bj][m][1];
                    u32x4 w; w.x = cvt_pk_bf16(v0[0], v0[1]); w.y = cvt_pk_bf16(v0[2], v0[3]); w.z = cvt_pk_bf16(v1[0], v1[1]); w.w = cvt_pk_bf16(v1[2], v1[3]);
                    *(u32x4*)(rowp + bj * 128) = w; } }
    }
};

__device__ __forceinline__ void tr_tile(const float* src, int ldn, int k0, int n0, int nvalid, bf16_t* dst, int ldk, int drow0, LAS float* tile, int kd0 = -1, const float* kscale = nullptr) {
    const int tid = launder_tid();
    if (kd0 < 0) kd0 = k0;
    { const int n = tid & 63; const int kq = tid >> 6; float tv[8], ts[8];
#pragma unroll
      for (int it = 0; it < 8; ++it) { const int kk = kq + 8 * it; tv[it] = (n < nvalid) ? src[(size_t)(k0 + kk) * ldn + n0 + n] : 0.f; ts[it] = kscale ? kscale[kk] : 1.f; }
#pragma unroll
      for (int it = 0; it < 8; ++it) tile[(kq + 8 * it) * 65 + n] = tv[it] * ts[it]; }
    __syncthreads();
    { const int k8 = tid & 7, n = tid >> 3;
      if (n < nvalid) { const LAS float* s = tile + (k8 * 8) * 65 + n;
          u32x4 o; o.x = cvt_pk_bf16(s[0], s[65]); o.y = cvt_pk_bf16(s[2 * 65], s[3 * 65]); o.z = cvt_pk_bf16(s[4 * 65], s[5 * 65]); o.w = cvt_pk_bf16(s[6 * 65], s[7 * 65]);
          *(u32x4*)(dst + (size_t)(drow0 + n) * ldk + kd0 + k8 * 8) = o; } }
    __syncthreads();
}
__device__ __forceinline__ void phase_wprep(CP p, unsigned char* lds, int bid, int nb) {
    LAS float* tile = (LAS float*)(LAS unsigned char*)lds;
    constexpr int I_IN = 16 * 41, I_OUT = 256, I_G = 1024, I_U = 1024, I_D = 1024, I_L = I_IN + I_OUT + I_G + I_U + I_D;
    for (int it = bid; it < 2 * I_L; it += nb) {
        const int l = it / I_L; int r = it - l * I_L;
        if (r < I_IN) { const int kt = r / 41, ntl = r % 41; const int n0 = ntl * 64; const int nv = (DIN - n0) < 64 ? (DIN - n0) : 64;
            tr_tile(p->w_in + (size_t)l * 1024 * DIN, DIN, kt * 64, n0, nv, (bf16_t*)(p->ws + WS_WTIN) + (size_t)l * DIN * 1024, 1024, n0, tile); continue; }
        r -= I_IN;
        if (r < I_OUT) { const int kt = r >> 4, ntl = r & 15;
            tr_tile(p->w_out + (size_t)l * 1024 * 1024, 1024, kt * 64, ntl * 64, 64, (bf16_t*)(p->ws + WS_WTOUT) + (size_t)l * 1024 * 1024, 1024, ntl * 64, tile,
                    (kt * 64 + 512) & 1023, kt >= 8 ? p->ssd_norm_g + l * 512 + (kt * 64 - 512) : nullptr); continue; }
        r -= I_OUT;
        if (r < I_G + I_U) { const int up = r >= I_G; if (up) r -= I_G; const int e = r >> 6, q = r & 63, kt = q >> 2, ntl = q & 3; const int n0 = ntl * 64;
            const float* src = (up ? p->w_up : p->w_gate) + (size_t)(l * 16 + e) * 1024 * 256;
            tr_tile(src, 256, kt * 64, n0, 64, (bf16_t*)(p->ws + WS_WTGU) + (size_t)(l * 16 + e) * 512 * 1024, 1024, (n0 >> 7) * 256 + (n0 & 127) + (up ? 128 : 0), tile); continue; }
        r -= I_G + I_U;
        { const int e = r >> 6, q = r & 63, kt = q >> 4, ntl = q & 15;
          tr_tile(p->w_down + (size_t)(l * 16 + e) * 256 * 1024, 1024, kt * 64, ntl * 64, 64, (bf16_t*)(p->ws + WS_WTD) + (size_t)(l * 16 + e) * 1024 * 256, 256, ntl * 64, tile); }
    }
}
__device__ __forceinline__ void phase_adaln(CP p, unsigned char* lds, int bid, int nb) {
    LAS float* sc = (LAS float*)(LAS unsigned char*)lds;
    LAS float* red = sc + 3 * 1024;
    const int tid = launder_tid();
    for (int idx = tid; idx < 3 * 1024; idx += NTHREADS) { const int v = idx >> 10, k = idx & 1023; const float cv = (v < 2) ? p->c[v * 1024 + k] : p->c_ctx[k]; sc[idx] = siluf_(cv); }
    __syncthreads();
    float* mod = (float*)(p->ws + WS_MOD);
    for (int it = bid; it < 2 * 96; it += nb) {
        const int l = it / 96, n0 = (it % 96) * 64;
        const int c4 = tid & 15, kr = tid >> 4;
        f32x4 a0 = {0, 0, 0, 0}, a1 = {0, 0, 0, 0}, a2 = {0, 0, 0, 0};
        const float* w = p->w_ada + (size_t)l * 1024 * 6144 + n0 + c4 * 4;
#pragma unroll 4
        for (int k = kr; k < 1024; k += 32) { const f32x4 w4 = *(const f32x4*)(w + (size_t)k * 6144); a0 += sc[k] * w4; a1 += sc[1024 + k] * w4; a2 += sc[2048 + k] * w4; }
        *(LAS f32x4*)(red + (kr * 3 + 0) * 64 + c4 * 4) = a0; *(LAS f32x4*)(red + (kr * 3 + 1) * 64 + c4 * 4) = a1; *(LAS f32x4*)(red + (kr * 3 + 2) * 64 + c4 * 4) = a2;
        __syncthreads();
        if (tid < 192) { const int v = tid >> 6, cc = tid & 63; float s = 0.f;
            for (int q = 0; q < 32; ++q) s += red[(q * 3 + v) * 64 + cc];
            mod[((size_t)l * 3 + v) * 6144 + n0 + cc] = s + p->b_ada[l * 6144 + n0 + cc]; }
        __syncthreads();
    }
}
__device__ __forceinline__ void moe_table(CP p, int l, LAS int* tab) {
    const int* gcount = (const int*)(p->ws + WS_CTL) + l * 32;
    if (threadIdx.x == 0) { int acc = 0; for (int q = 0; q < NCLS; ++q) { const int cn = gcount[q]; tab[q] = acc; tab[32 + q] = cn; acc += (cn + 255) >> 8; } tab[24] = acc; }
    __syncthreads();
}
__device__ __forceinline__ void moe_yload(CP p, int pos, int lane, const LAS int* tab, u32x2 (&yv)[4]) {
    const int slot = tab[pos >> 16] * 256 + (pos & 0xffff);
    const bf16_t* y = (const bf16_t*)(p->ws + WS_Y) + (size_t)slot * 1024;
#pragma unroll
    for (int j = 0; j < 4; ++j) yv[j] = *(const u32x2*)(y + 4 * lane + 256 * j);
}
__device__ __forceinline__ void moe_yadd(CP p, int lm, int v, int lane, const u32x2 (&yv)[4], f32x4 (&xv)[4]) {
    const float* gate = (const float*)(p->ws + WS_MOD) + ((size_t)lm * 3 + v) * 6144 + 5 * 1024;
#pragma unroll
    for (int j = 0; j < 4; ++j) { const int k = 4 * lane + 256 * j; const f32x4 g4 = *(const f32x4*)(gate + k);
        xv[j][0] += g4[0] * bflo(yv[j].x); xv[j][1] += g4[1] * bfhi(yv[j].x); xv[j][2] += g4[2] * bflo(yv[j].y); xv[j][3] += g4[3] * bfhi(yv[j].y); }
}
__device__ __forceinline__ void phase_r1(CP p, int l, unsigned char* lds, int bid, int nb) {
    LAS float* wdt = (LAS float*)(LAS unsigned char*)lds;
    LAS float* gm = wdt + 16 * 1024;
    LAS float* sh = gm + 3 * 1024;
    const int tid = launder_tid(); const int lane = tid & 63, wave = tid >> 6;
    const float* mod = (const float*)(p->ws + WS_MOD) + (size_t)l * 3 * 6144;
    const float* win = p->w_in + (size_t)l * 1024 * DIN;
#pragma unroll
    for (int hb = 0; hb < 2; ++hb) { float tmp[16];
#pragma unroll
        for (int it = 0; it < 16; ++it) { const int idx = tid + NTHREADS * (16 * hb + it); tmp[it] = win[(size_t)(idx >> 4) * DIN + NPROJ + (idx & 15)]; }
#pragma unroll
        for (int it = 0; it < 16; ++it) { const int idx = tid + NTHREADS * (16 * hb + it); wdt[(idx & 15) * 1024 + (idx >> 4)] = tmp[it]; } }
    { float t0[6], t1[6], t2[6];
#pragma unroll
      for (int it = 0; it < 6; ++it) { const int idx = tid + NTHREADS * it; const int v = idx >> 10, k = idx & 1023; t0[it] = p->g_mix[l * 1024 + k]; t1[it] = mod[v * 6144 + 1024 + k]; t2[it] = mod[v * 6144 + k]; }
#pragma unroll
      for (int it = 0; it < 6; ++it) { const int idx = tid + NTHREADS * it; gm[idx] = t0[it] * (1.f + t1[it]); sh[idx] = t2[it]; } }
    LAS int* tab = (LAS int*)((LAS unsigned char*)lds + MISC_OFF);
    if (l > 0) moe_table(p, l - 1, tab);
    __syncthreads();
    bf16_t* HX = (bf16_t*)(p->ws + WS_HX); float* DT = (float*)(p->ws + WS_DT);
    const int* POS = (const int*)(p->ws + WS_POS) + (size_t)(l > 0 ? l - 1 : 0) * R;
    const int rstep = nb * 8;
    f32x4 xn[4]; u32x2 yn[4]; int posn = 0;
    { const int r = bid * 8 + wave;
      if (r < R) { const f32x4* hr = (const f32x4*)hin_ptr(p, l, r);
#pragma unroll
          for (int j = 0; j < 4; ++j) xn[j] = hr[lane + 64 * j];
          if (l > 0) { moe_yload(p, POS[r], lane, tab, yn); if (r + rstep < R) posn = POS[r + rstep]; } } }
    for (int r = bid * 8 + wave; r < R; r += rstep) {
        const int v = row_v(r);
        f32x4 xv[4]; u32x2 yv[4]; float ss = 0.f;
#pragma unroll
        for (int j = 0; j < 4; ++j) { xv[j] = xn[j]; yv[j] = yn[j]; }
        { const int rn = r + rstep;
          if (rn < R) { const f32x4* hr = (const f32x4*)hin_ptr(p, l, rn);
#pragma unroll
              for (int j = 0; j < 4; ++j) xn[j] = hr[lane + 64 * j];
              if (l > 0) { moe_yload(p, posn, lane, tab, yn); if (rn + rstep < R) posn = POS[rn + rstep]; } } }
        if (l > 0) { moe_yadd(p, l - 1, v, lane, yv, xv); f32x4* hw = (f32x4*)hptr(p, r);
#pragma unroll
            for (int j = 0; j < 4; ++j) hw[lane + 64 * j] = xv[j]; }
#pragma unroll
        for (int j = 0; j < 4; ++j) ss += xv[j][0] * xv[j][0] + xv[j][1] * xv[j][1] + xv[j][2] * xv[j][2] + xv[j][3] * xv[j][3];
        ss = wave_sum(ss); const float rs = rsqrtf(ss * (1.f / 1024.f) + 1e-6f);
#pragma unroll
        for (int j = 0; j < 4; ++j) { const int k = 4 * lane + 256 * j; const f32x4 g4 = *(const LAS f32x4*)(gm + v * 1024 + k), s4 = *(const LAS f32x4*)(sh + v * 1024 + k);
            xv[j] = xv[j] * rs * g4 + s4;
            u32x2 o; o.x = cvt_pk_bf16(xv[j][0], xv[j][1]); o.y = cvt_pk_bf16(xv[j][2], xv[j][3]);
            *(u32x2*)(HX + (size_t)r * 1024 + k) = o; }
        float mine = 0.f;
#pragma unroll
        for (int n = 0; n < 16; ++n) { float a = 0.f;
#pragma unroll
            for (int j = 0; j < 4; ++j) { const f32x4 w4 = *(const LAS f32x4*)(wdt + n * 1024 + 4 * lane + 256 * j); a += xv[j][0] * w4[0] + xv[j][1] * w4[1] + xv[j][2] * w4[2] + xv[j][3] * w4[3]; }
            a = wave_sum(a); mine = (lane == n) ? a : mine; }
        if (lane < 16) DT[(size_t)r * 16 + lane] = softplusf_(mine + p->dt_bias[l * 16 + lane]);
    }
}
typedef float f32x16 __attribute__((ext_vector_type(16)));
typedef short s16x4 __attribute__((ext_vector_type(4)));
constexpr int ST_ROW = 272;
constexpr int ST_TR128 = 320;
constexpr int ST_TR64 = 192;
constexpr int NCHUNK = SEG / 128;

#define DPP_MOV(v, ctrl, rm, bm) __builtin_bit_cast(float, __builtin_amdgcn_update_dpp(0, __builtin_bit_cast(int, (v)), (ctrl), (rm), (bm), true))
__device__ __forceinline__ float wave_incl_scan(float v, int) {
    float s = v + DPP_MOV(v, 0x111, 0xF, 0xF) + DPP_MOV(v, 0x112, 0xF, 0xF) + DPP_MOV(v, 0x113, 0xF, 0xF);
    s += DPP_MOV(s, 0x114, 0xF, 0xE);
    s += DPP_MOV(s, 0x118, 0xF, 0xC);
    s += DPP_MOV(s, 0x142, 0xA, 0xF);
    s += DPP_MOV(s, 0x143, 0xC, 0xF);
    return s;
}
__device__ __forceinline__ bf16x8 row_frag(const LAS unsigned char* tile, int stride, int row0, int k0, int lane) {
    return *(const LAS bf16x8*)(tile + (row0 + (lane & 31)) * stride + (k0 + 8 * (lane >> 5)) * 2);
}
__device__ __forceinline__ bf16x8 tr_frag(const LAS unsigned char* tile, int stride, int k0, int c0, int lane) {
    const int g = lane >> 4, li = lane & 15, q = li >> 2, pp = li & 3;
    const LAS unsigned char* a0 = tile + (k0 + 8 * (g >> 1) + q) * stride + (c0 + 16 * (g & 1) + 4 * pp) * 2;
    const s16x4 lo = __builtin_amdgcn_ds_read_tr16_b64_v4i16((LAS s16x4*)a0);
    const s16x4 hi = __builtin_amdgcn_ds_read_tr16_b64_v4i16((LAS s16x4*)(a0 + 4 * stride));
    return __builtin_shufflevector(lo, hi, 0, 1, 2, 3, 4, 5, 6, 7);
}
__device__ __forceinline__ u32x4 pack8(const float (&v)[8]) { u32x4 r; r.x = cvt_pk_bf16(v[0], v[1]); r.y = cvt_pk_bf16(v[2], v[3]); r.z = cvt_pk_bf16(v[4], v[5]); r.w = cvt_pk_bf16(v[6], v[7]); return r; }
__device__ __forceinline__ u32x4 pack8s(const float (&v)[8], float sc) { u32x4 r; r.x = cvt_pk_bf16(v[0] * sc, v[1] * sc); r.y = cvt_pk_bf16(v[2] * sc, v[3] * sc); r.z = cvt_pk_bf16(v[4] * sc, v[5] * sc); r.w = cvt_pk_bf16(v[6] * sc, v[7] * sc); return r; }

__device__ __forceinline__ void conv_load(const bf16_t* proj, int row0, int rq, int xch, bool lo_ok, bool hi_ok, u32x4 (&raw)[8]) {
    const bf16_t* base = proj + (size_t)(row0 + 4 * rq) * NPROJ + 1536 + xch;
    unsigned zz; asm volatile("v_mov_b32 %0, 0" : "=v"(zz));
#pragma unroll
    for (int j = 0; j < 8; ++j) {
        if (j < 2) { const bool ok = (rq > 0) || lo_ok; const u32x4 v = *(const u32x4*)(ok ? base + (j - 2) * NPROJ : base);
            raw[j].x = ok ? v.x : zz; raw[j].y = ok ? v.y : zz; raw[j].z = ok ? v.z : zz; raw[j].w = ok ? v.w : zz; }
        else if (j >= 6) { const bool ok = (rq < 31) || hi_ok; const u32x4 v = *(const u32x4*)(ok ? base + (j - 2) * NPROJ : base);
            raw[j].x = ok ? v.x : zz; raw[j].y = ok ? v.y : zz; raw[j].z = ok ? v.z : zz; raw[j].w = ok ? v.w : zz; }
        else raw[j] = *(const u32x4*)(base + (j - 2) * NPROJ);
    }
}
__device__ __forceinline__ void conv_compute(const u32x4 (&raw)[8], const LAS float* wl, int nchl, int wch, float (&o)[4][8]) {
    float w[5][8], bs[8];
#pragma unroll
    for (int j = 0; j < 5; ++j) { const f32x4 w0 = *(const LAS f32x4*)(wl + j * nchl + wch), w1 = *(const LAS f32x4*)(wl + j * nchl + wch + 4);
        w[j][0] = w0[0]; w[j][1] = w0[1]; w[j][2] = w0[2]; w[j][3] = w0[3]; w[j][4] = w1[0]; w[j][5] = w1[1]; w[j][6] = w1[2]; w[j][7] = w1[3]; }
    { const f32x4 b0 = *(const LAS f32x4*)(wl + 5 * nchl + wch), b1 = *(const LAS f32x4*)(wl + 5 * nchl + wch + 4); bs[0] = b0[0]; bs[1] = b0[1]; bs[2] = b0[2]; bs[3] = b0[3]; bs[4] = b1[0]; bs[5] = b1[1]; bs[6] = b1[2]; bs[7] = b1[3]; }
#pragma unroll
    for (int i = 0; i < 4; ++i)
#pragma unroll
        for (int e = 0; e < 8; ++e) o[i][e] = bs[e];
#pragma unroll
    for (int j = 0; j < 8; ++j) {
        float xv[8] = {bflo(raw[j].x), bfhi(raw[j].x), bflo(raw[j].y), bfhi(raw[j].y), bflo(raw[j].z), bfhi(raw[j].z), bflo(raw[j].w), bfhi(raw[j].w)};
#pragma unroll
        for (int i = 0; i < 4; ++i) { const int tap = j - i; if (tap >= 0 && tap < 5) {
#pragma unroll
                for (int e = 0; e < 8; ++e) o[i][e] += w[tap][e] * xv[e]; } }
    }
#pragma unroll
    for (int i = 0; i < 4; ++i)
#pragma unroll
        for (int e = 0; e < 8; ++e) o[i][e] = siluf_(o[i][e]);
}
__device__ __forceinline__ void head_cums(CP p, int l, int row0, int h, int dir, int lane, LAS float* hv) {
    const float A = -expf(p->a_log[l * 16 + dir * 8 + h]);
    const float* DT = (const float*)(p->ws + WS_DT);
    const float d0 = DT[(size_t)(row0 + 2 * lane) * 16 + dir * 8 + h], d1 = DT[(size_t)(row0 + 2 * lane + 1) * 16 + dir * 8 + h];
    const float x0 = d0 * A, x1 = d1 * A;
    const float incl = wave_incl_scan(x0 + x1, lane);
    const float total = __builtin_bit_cast(float, __builtin_amdgcn_readlane(__builtin_bit_cast(int, incl), 63));
    float c0, c1;
    if (dir == 0) { c1 = incl; c0 = incl - x1; } else { c0 = total - (incl - x1 - x0); c1 = total - (incl - x1); }
    hv[dir * 128 + 2 * lane] = c0; hv[dir * 128 + 2 * lane + 1] = c1;
    hv[256 + dir * 128 + 2 * lane] = d0; hv[256 + dir * 128 + 2 * lane + 1] = d1;
    if (lane == 0) hv[512 + dir] = total;
}
__device__ __forceinline__ bf16x8 scale_frag(bf16x8 f, const f32x4 w0, const f32x4 w1) {
    const u32x4 u = __builtin_bit_cast(u32x4, f);
    u32x4 r;
    r.x = cvt_pk_bf16(bflo(u.x) * w0[0], bfhi(u.x) * w0[1]); r.y = cvt_pk_bf16(bflo(u.y) * w0[2], bfhi(u.y) * w0[3]);
    r.z = cvt_pk_bf16(bflo(u.z) * w1[0], bfhi(u.z) * w1[1]); r.w = cvt_pk_bf16(bflo(u.w) * w1[2], bfhi(u.w) * w1[3]);
    return __builtin_bit_cast(bf16x8, r);
}
constexpr int ST_X256 = 576;

__device__ __forceinline__ void phase_c1(CP p, int l, unsigned char* lds_, int bid, int nb) {
    LAS unsigned char* lds = (LAS unsigned char*)lds_;
    LAS unsigned char* tile = lds;
    LAS float* wl = (LAS float*)(lds + 73216);
    const int tid = launder_tid();
    const bf16_t* proj = (const bf16_t*)(p->ws + WS_PROJ); bf16_t* mix = (bf16_t*)(p->ws + WS_HX);
#pragma unroll 1
    for (int u = bid; u < 256 + 512 + (l == DEPTH - 1 ? 0 : 16); u += nb) {
        int S, LEN, pstride, sstride, tok0, ch0;
        if (u < 256) { const int b = u >> 7, cs = (u >> 2) & 31, cc = u & 3; S = 2; LEN = 256; pstride = 64; sstride = 1; tok0 = b * SEG + CTXL + 2 * cs; ch0 = 256 + 64 * cc; }
        else if (u < 768) { const int v = u - 256; const int b = v >> 8, rg = (v >> 2) & 63, cc = v & 3; S = 4; LEN = 64; pstride = 1; sstride = 64; tok0 = b * SEG + CTXL + 256 * rg; ch0 = 64 * cc; }
        else { const int v = u - 768; const int b = v >> 3, cc = v & 7; S = 1; LEN = 256; pstride = 1; sstride = 0; tok0 = b * SEG; ch0 = 64 * cc; }
        const int LP = LEN + 30;
        { float tw[4];
#pragma unroll
          for (int it = 0; it < 4; ++it) { const int i = tid + NTHREADS * it; const int j = i >> 6, c = i & 63; tw[it] = j < 31 ? p->conv_w[((size_t)l * 31 + j) * 512 + ch0 + c] : p->conv_b[l * 512 + ch0 + c]; }
#pragma unroll
          for (int it = 0; it < 4; ++it) wl[tid + NTHREADS * it] = tw[it]; }
        for (int i = tid; i < S * 30 * 8; i += NTHREADS) { const int pc = i & 7, q = (i >> 3) % 30, sq = (i >> 3) / 30; const int pos = q < 15 ? q : LEN + q;
            unsigned zz; asm volatile("v_mov_b32 %0, 0" : "=v"(zz));
            *(LAS u32x4*)(tile + ((sq * LP + pos) * 64 + pc * 8) * 2) = (u32x4){zz, zz, zz, zz}; }
#pragma unroll 4
        for (int i = tid; i < S * LEN * 8; i += NTHREADS) { const int pc = i & 7, t = i >> 3; const int sq = t / LEN, pos = t - sq * LEN;
            const bf16_t* src = proj + (size_t)(tok0 + sq * sstride + pos * pstride) * NPROJ + ch0 + pc * 8;
            const u32x4 uv = *(const u32x4*)src, gv = *(const u32x4*)(src + 512);
            u32x4 o;
            o.x = cvt_pk_bf16(bflo(uv.x) * sigmoidf_(bflo(gv.x)), bfhi(uv.x) * sigmoidf_(bfhi(gv.x)));
            o.y = cvt_pk_bf16(bflo(uv.y) * sigmoidf_(bflo(gv.y)), bfhi(uv.y) * sigmoidf_(bfhi(gv.y)));
            o.z = cvt_pk_bf16(bflo(uv.z) * sigmoidf_(bflo(gv.z)), bfhi(uv.z) * sigmoidf_(bfhi(gv.z)));
            o.w = cvt_pk_bf16(bflo(uv.w) * sigmoidf_(bflo(gv.w)), bfhi(uv.w) * sigmoidf_(bfhi(gv.w)));
            *(LAS u32x4*)(tile + ((sq * LP + 15 + pos) * 64 + pc * 8) * 2) = o; }
        __syncthreads();
        const int noct = S * LEN / 8;
#pragma unroll 1
        for (int it = tid; it < noct * 32; it += NTHREADS) {
            const int cp = it & 31, oc = it >> 5; const int sq = oc / (LEN / 8), p0 = (oc - sq * (LEN / 8)) * 8;
            const LAS unsigned* base = (const LAS unsigned*)(tile + ((sq * LP + p0) * 64) * 2) + cp;
            float i0[38], i1[38];
#pragma unroll
            for (int k = 0; k < 38; ++k) { const unsigned w = base[k * 32]; i0[k] = bflo(w); i1[k] = bfhi(w); }
            float a0[8], a1[8];
            { const float b0 = wl[31 * 64 + 2 * cp], b1 = wl[31 * 64 + 2 * cp + 1];
#pragma unroll
              for (int i = 0; i < 8; ++i) { a0[i] = b0; a1[i] = b1; } }
#pragma unroll
            for (int j = 0; j < 31; ++j) { typedef float f32x2 __attribute__((ext_vector_type(2))); const f32x2 wj = *(const LAS f32x2*)(wl + j * 64 + 2 * cp); const float w0 = wj[0], w1 = wj[1];
#pragma unroll
                for (int i = 0; i < 8; ++i) { a0[i] += w0 * i0[i + j]; a1[i] += w1 * i1[i + j]; } }
#pragma unroll
            for (int i = 0; i < 8; ++i) { const int tok = tok0 + sq * sstride + (p0 + i) * pstride;
                *(unsigned*)(mix + (size_t)tok * 1024 + 512 + ch0 + 2 * cp) = cvt_pk_bf16(a0[i], a1[i]); }
        }
        __syncthreads();
    }
}
__device__ __forceinline__ void phase_c1_ln(CP p, int l, int bid, int nb) {
    const int tid = launder_tid(); const int lane = tid & 63, wave = tid >> 6;
    bf16_t* mix = (bf16_t*)(p->ws + WS_HX);
    const f32x4 g0 = *(const f32x4*)(p->conv_ln_g + l * 512 + lane * 8), g1 = *(const f32x4*)(p->conv_ln_g + l * 512 + lane * 8 + 4);
    const f32x4 b0 = *(const f32x4*)(p->conv_ln_b + l * 512 + lane * 8), b1 = *(const f32x4*)(p->conv_ln_b + l * 512 + lane * 8 + 4);
    const float gg[8] = {g0[0], g0[1], g0[2], g0[3], g1[0], g1[1], g1[2], g1[3]}, bb[8] = {b0[0], b0[1], b0[2], b0[3], b1[0], b1[1], b1[2], b1[3]};
    for (int r = bid * 8 + wave; r < R; r += nb * 8) {
        u32x4* ptr = (u32x4*)(mix + (size_t)r * 1024 + 512 + lane * 8);
        const u32x4 v = *ptr;
        float y[8] = {bflo(v.x), bfhi(v.x), bflo(v.y), bfhi(v.y), bflo(v.z), bfhi(v.z), bflo(v.w), bfhi(v.w)};
        float s = 0.f;
#pragma unroll
        for (int e = 0; e < 8; ++e) s += y[e];
        const float mu = wave_sum(s) * (1.f / 512.f);
        float q = 0.f;
#pragma unroll
        for (int e = 0; e < 8; ++e) { y[e] -= mu; q += y[e] * y[e]; }
        const float rstd = rsqrtf(wave_sum(q) * (1.f / 512.f) + 1e-5f);
        float o[8];
#pragma unroll
        for (int e = 0; e < 8; ++e) o[e] = siluf_(y[e] * rstd * gg[e] + bb[e]);
        *ptr = pack8(o);
    }
}
__device__ __forceinline__ void phase_s1(CP p, int l, unsigned char* lds_, int bid, int nb) {
    LAS unsigned char* lds = (LAS unsigned char*)lds_;
    LAS unsigned char* Bs = lds;
    LAS unsigned char* Xs = lds + 128 * ST_TR128;
    LAS float* wv = (LAS float*)(Xs + 128 * ST_X256);
    LAS float* hvs = wv + 8 * 128;
    LAS float* cwl = hvs + 4 * 520;
    const int tid = launder_tid(); const int lane = tid & 63, wave = __builtin_amdgcn_readfirstlane(tid >> 6);
    const bf16_t* proj = (const bf16_t*)(p->ws + WS_PROJ);
    const float* cw = p->ssd_conv_w + (size_t)l * 5 * 1024; const float* cbias = p->ssd_conv_b + (size_t)l * 1024;
    float* Sg = (float*)(p->ws + WS_S); float* DEC = (float*)(p->ws + WS_DEC);
    int cur_g = -1;
#pragma unroll 1
    for (int u = bid; u < NB * NCHUNK * 2; u += nb) {
        const int g = u & 1, c = (u >> 1) % NCHUNK, b = (u >> 1) / NCHUNK;
        const int row0 = b * SEG + c * 128;
        const bool lo_ok = !(c == 0 || c == 2), hi_ok = !(c == 1 || c == NCHUNK - 1);
        if (g != cur_g) { cur_g = g;
            float tw[5];
#pragma unroll
            for (int it = 0; it < 5; ++it) { const int i = tid + NTHREADS * it; const int j = i / 384, lc = i - j * 384; const int gch = lc < 128 ? 512 + g * 128 + lc : g * 256 + (lc - 128);
                tw[it] = i < 6 * 384 ? (j < 5 ? cw[j * 1024 + gch] : cbias[gch]) : 0.f; }
#pragma unroll
            for (int it = 0; it < 5; ++it) { const int i = tid + NTHREADS * it; if (i < 6 * 384) cwl[i] = tw[it]; } }
        const int hh = wave >> 1, dir = wave & 1, h = 4 * g + hh;
        u32x4 rb[8], rx0[8], rx1[8];
        conv_load(proj, row0, tid >> 4, 512 + g * 128 + (tid & 15) * 8, lo_ok, hi_ok, rb);
        conv_load(proj, row0, tid >> 5, g * 256 + (tid & 31) * 8, lo_ok, hi_ok, rx0);
        conv_load(proj, row0, (tid >> 5) + 16, g * 256 + (tid & 31) * 8, lo_ok, hi_ok, rx1);
        head_cums(p, l, row0, h, dir, lane, hvs + hh * 520);
        __syncthreads();
        {
            const LAS float* hv = hvs + hh * 520; const float tot = hv[512 + dir];
#pragma unroll
            for (int q = 0; q < 2; ++q) { const int lr = lane + 64 * q; wv[wave * 128 + lr] = __expf(tot - hv[dir * 128 + lr]) * hv[256 + dir * 128 + lr]; }
            if (lane == 0) DEC[((size_t)(b * 2 + dir) * NCHUNK + c) * 8 + h] = __expf(tot);
        }
        { float o[4][8];
          conv_compute(rb, cwl, 384, (tid & 15) * 8, o);
#pragma unroll
          for (int i = 0; i < 4; ++i) *(LAS u32x4*)(Bs + (4 * (tid >> 4) + i) * ST_TR128 + (tid & 15) * 16) = pack8(o[i]);
          conv_compute(rx0, cwl, 384, 128 + (tid & 31) * 8, o);
#pragma unroll
          for (int i = 0; i < 4; ++i) *(LAS u32x4*)(Xs + (4 * (tid >> 5) + i) * ST_X256 + (tid & 31) * 16) = pack8(o[i]);
          conv_compute(rx1, cwl, 384, 128 + (tid & 31) * 8, o);
#pragma unroll
          for (int i = 0; i < 4; ++i) *(LAS u32x4*)(Xs + (4 * ((tid >> 5) + 16) + i) * ST_X256 + (tid & 31) * 16) = pack8(o[i]); }
        __syncthreads();
        {
            f32x16 acc[2][4];
#pragma unroll
            for (int t = 0; t < 2; ++t)
#pragma unroll
                for (int q = 0; q < 4; ++q)
#pragma unroll
                    for (int e = 0; e < 16; ++e) acc[t][q][e] = 0.f;
#pragma unroll 2
            for (int kk = 0; kk < 8; ++kk) {
                const LAS float* wp = wv + wave * 128 + 16 * kk + 8 * (lane >> 5);
                const f32x4 w0 = *(const LAS f32x4*)wp, w1 = *(const LAS f32x4*)(wp + 4);
                bf16x8 af[2];
#pragma unroll
                for (int t = 0; t < 2; ++t) af[t] = scale_frag(tr_frag(Xs, ST_X256, 16 * kk, hh * 64 + 32 * t, lane), w0, w1);
#pragma unroll
                for (int q = 0; q < 4; ++q) { const bf16x8 bf = tr_frag(Bs, ST_TR128, 16 * kk, 32 * q, lane);
#pragma unroll
                    for (int t = 0; t < 2; ++t) acc[t][q] = __builtin_amdgcn_mfma_f32_32x32x16_bf16(af[t], bf, acc[t][q], 0, 0, 0); }
            }
            float* So = Sg + ((size_t)((b * 2 + dir) * NCHUNK + c) * 8 + h) * 8192 + (lane & 31);
#pragma unroll
            for (int t = 0; t < 2; ++t)
#pragma unroll
                for (int q = 0; q < 4; ++q)
#pragma unroll
                    for (int e = 0; e < 16; ++e) { const int pr = 32 * t + (e & 3) + 8 * (e >> 2) + 4 * (lane >> 5); So[(size_t)pr * 128 + 32 * q] = acc[t][q][e]; }
        }
        __syncthreads();
    }
}
__device__ __forceinline__ void phase_s2(CP p, int bid, int nb) {
    const int tid = launder_tid();
    const float* Sg = (const float*)(p->ws + WS_S); const float* DEC = (const float*)(p->ws + WS_DEC); bf16_t* HP = (bf16_t*)(p->ws + WS_HP);
    for (int idx = bid * NTHREADS + tid; idx < 2 * 2 * 8 * 64 * 64; idx += nb * NTHREADS) {
        const int n2 = idx & 63, pr = (idx >> 6) & 63, h = (idx >> 12) & 7, dir = (idx >> 15) & 1, b = idx >> 16;
        const size_t inner = (size_t)h * 8192 + pr * 128 + 2 * n2;
        const size_t cbase = (size_t)(b * 2 + dir) * NCHUNK;
        float s0 = 0.f, s1 = 0.f;
#pragma unroll 5
        for (int step = 0; step < NCHUNK; ++step) {
            const int c = dir == 0 ? step : (step < 2 ? 1 - step : NCHUNK + 1 - step);
            const size_t off = (cbase + c) * 65536 + inner;
            const float2 sv = *(const float2*)(Sg + off); const float d = DEC[(cbase + c) * 8 + h];
            *(unsigned*)(HP + off) = cvt_pk_bf16(s0, s1);
            s0 = s0 * d + sv.x; s1 = s1 * d + sv.y;
        }
    }
}
__device__ __forceinline__ void phase_s3(CP p, int l, unsigned char* lds_, int bid, int nb) {
    LAS unsigned char* lds = (LAS unsigned char*)lds_;
    LAS unsigned char* Cs = lds;
    LAS unsigned char* Bs = Cs + 128 * ST_ROW;
    LAS unsigned char* Mt = Bs;
    LAS unsigned char* Xs = Bs + 128 * ST_TR128;
    LAS unsigned char* Hf = Xs + 128 * ST_TR64;
    LAS unsigned char* Hb = Hf + 64 * ST_ROW;
    LAS float* hvs = (LAS float*)(Hb + 64 * ST_ROW);
    LAS float* ssqp = hvs + 4 * 520;
    LAS float* cwl = ssqp + 256;
    const int tid0 = launder_tid(); const int wave = __builtin_amdgcn_readfirstlane(tid0 >> 6);
    const bf16_t* proj = (const bf16_t*)(p->ws + WS_PROJ); bf16_t* mix = (bf16_t*)(p->ws + WS_HX);
    const float* cw = p->ssd_conv_w + (size_t)l * 5 * 1024; const float* cbias = p->ssd_conv_b + (size_t)l * 1024;
    const bf16_t* HP = (const bf16_t*)(p->ws + WS_HP); float* SSQ = (float*)(p->ws + WS_SSQ);
    int cur_g = -1;
#pragma unroll 1
    for (int u = bid; u < NB * NCHUNK * 2; u += nb) {
        const int g = u & 1, c = (u >> 1) % NCHUNK, b = (u >> 1) / NCHUNK;
        if (l == DEPTH - 1 && c < 2) continue;
        int tid = tid0; asm volatile("" : "+v"(tid));
        const int lane = tid & 63;
        const int row0 = b * SEG + c * 128;
        const bool lo_ok = !(c == 0 || c == 2), hi_ok = !(c == 1 || c == NCHUNK - 1);
        if (g != cur_g) { cur_g = g;
            float tw[6];
#pragma unroll
            for (int it = 0; it < 6; ++it) { const int i = tid + NTHREADS * it; const int j = i >> 9, lc = i & 511; const int gch = lc < 128 ? 768 + g * 128 + lc : (lc < 256 ? 512 + g * 128 + (lc - 128) : g * 256 + (lc - 256));
                tw[it] = j < 5 ? cw[j * 1024 + gch] : cbias[gch]; }
#pragma unroll
            for (int it = 0; it < 6; ++it) cwl[tid + NTHREADS * it] = tw[it]; }
        u32x4 rx[8];
        {
            u32x4 r0[8], r1[8];
            const int cg = tid & 31; const int gch = (cg < 16 ? 768 : 512) + g * 128 + (cg & 15) * 8;
            conv_load(proj, row0, tid >> 5, gch, lo_ok, hi_ok, r0);
            conv_load(proj, row0, (tid >> 5) + 16, gch, lo_ok, hi_ok, r1);
            head_cums(p, l, row0, 4 * g + (wave >> 1), wave & 1, lane, hvs + (wave >> 1) * 520);
            __syncthreads();
            float o[4][8];
            LAS unsigned char* dst = (cg < 16 ? Cs : Bs) + (cg & 15) * 16;
            conv_compute(r0, cwl, 512, cg * 8, o);
#pragma unroll
            for (int i = 0; i < 4; ++i) *(LAS u32x4*)(dst + (4 * (tid >> 5) + i) * ST_ROW) = pack8(o[i]);
            asm volatile("" ::: "memory");
            if (tid < 256) conv_load(proj, row0, tid >> 3, g * 256 + (tid & 7) * 8, lo_ok, hi_ok, rx);
            conv_compute(r1, cwl, 512, cg * 8, o);
#pragma unroll
            for (int i = 0; i < 4; ++i) *(LAS u32x4*)(dst + (4 * ((tid >> 5) + 16) + i) * ST_ROW) = pack8(o[i]);
            if (tid < 256) { conv_compute(rx, cwl, 512, 256 + (tid & 7) * 8, o);
#pragma unroll
                for (int i = 0; i < 4; ++i) *(LAS u32x4*)(Xs + (4 * (tid >> 3) + i) * ST_TR64 + (tid & 7) * 16) = pack8(o[i]); }
        }
        __syncthreads();
        const int lb = wave >> 1, hs = wave & 1;
        int ln = lane; asm volatile("" : "+v"(ln));
        f32x16 gacc[2];
#pragma unroll
        for (int t = 0; t < 2; ++t)
#pragma unroll
            for (int e = 0; e < 16; ++e) gacc[t][e] = 0.f;
#pragma unroll
        for (int kk = 0; kk < 8; ++kk) { const bf16x8 af = row_frag(Cs, ST_ROW, 32 * lb, 16 * kk, lane);
#pragma unroll
            for (int t = 0; t < 2; ++t) { const bf16x8 bf = row_frag(Bs, ST_ROW, 64 * hs + 32 * t, 16 * kk, lane);
                gacc[t] = __builtin_amdgcn_mfma_f32_32x32x16_bf16(af, bf, gacc[t], 0, 0, 0); } }
        u32x4 hreg[4];
        { const bf16_t* hp0 = HP + ((size_t)(b * 2 * NCHUNK + c) * 8 + 4 * g) * 8192;
#pragma unroll
          for (int q = 0; q < 4; ++q) { const int it = tid + 512 * q; hreg[q] = *(const u32x4*)(hp0 + (size_t)(it >> 10) * NCHUNK * 8 * 8192 + (it & 1023) * 8); } }
        __syncthreads();
#pragma unroll 1
        for (int hh = 0; hh < 4; ++hh) {
            const int h = 4 * g + hh; const LAS float* hv = hvs + hh * 520;
            asm volatile("" : "+v"(ln));
            const int ph = hs, pc = 32 * ph + (ln & 31);
#pragma unroll
            for (int t = 0; t < 2; ++t) {
                const int sc = 64 * hs + 32 * t + (ln & 31);
                const float cfs = hv[sc], cbs = hv[128 + sc], dfs = hv[256 + sc], dbs = hv[384 + sc];
#pragma unroll
                for (int rg = 0; rg < 4; ++rg) {
                    const int l0 = 32 * lb + 8 * rg + 4 * (ln >> 5);
                    const f32x4 cfl = *(const LAS f32x4*)(hv + l0), cbl = *(const LAS f32x4*)(hv + 128 + l0);
                    float m[4];
#pragma unroll
                    for (int e = 0; e < 4; ++e) { const int lr = l0 + e;
                        const float ff = lr >= sc ? __expf(cfl[e] - cfs) * dfs : 0.f;
                        const float fb = lr <= sc ? __expf(cbl[e] - cbs) * dbs : 0.f;
                        m[e] = gacc[t][4 * rg + e] * (ff + fb); }
                    u32x2 pk; pk.x = cvt_pk_bf16(m[0], m[1]); pk.y = cvt_pk_bf16(m[2], m[3]);
                    *(LAS u32x2*)(Mt + sc * ST_TR128 + l0 * 2) = pk;
                }
            }
#pragma unroll
            for (int q = 0; q < 4; ++q) { const int it = tid + 512 * q; const int q2 = it & 1023;
                *(LAS u32x4*)(((it >> 10) ? Hb : Hf) + (q2 >> 4) * ST_ROW + (q2 & 15) * 16) = hreg[q]; }
            if (hh < 3) {
                const bf16_t* hp0 = HP + ((size_t)(b * 2 * NCHUNK + c) * 8 + h + 1) * 8192;
#pragma unroll
                for (int q = 0; q < 4; ++q) { const int it = tid + 512 * q; hreg[q] = *(const u32x4*)(hp0 + (size_t)(it >> 10) * NCHUNK * 8 * 8192 + (it & 1023) * 8); }
                if (tid < 256) conv_load(proj, row0, tid >> 3, g * 256 + (hh + 1) * 64 + (tid & 7) * 8, lo_ok, hi_ok, rx);
            }
            unsigned zraw[8];
#pragma unroll
            for (int ri = 0; ri < 16; ri += 2) { const int lr = 32 * lb + 8 * (ri >> 2) + 4 * (ln >> 5) + (ri & 3);
                const bf16_t* zp = proj + (size_t)(row0 + lr) * NPROJ + 1024 + h * 64 + pc;
                zraw[ri >> 1] = (unsigned)zp[0] | ((unsigned)zp[NPROJ] << 16); }
            __syncthreads();
            f32x16 ad, af_, ab_;
#pragma unroll
            for (int e = 0; e < 16; ++e) { ad[e] = 0.f; af_[e] = 0.f; ab_[e] = 0.f; }
#pragma unroll
            for (int kk = 0; kk < 8; ++kk) {
                const bf16x8 am = tr_frag(Mt, ST_TR128, 16 * kk, 32 * lb, lane);
                const bf16x8 bx = tr_frag(Xs, ST_TR64, 16 * kk, 32 * ph, lane);
                ad = __builtin_amdgcn_mfma_f32_32x32x16_bf16(am, bx, ad, 0, 0, 0);
                const bf16x8 ac = row_frag(Cs, ST_ROW, 32 * lb, 16 * kk, lane);
                const bf16x8 bhf = row_frag(Hf, ST_ROW, 32 * ph, 16 * kk, lane);
                const bf16x8 bhb = row_frag(Hb, ST_ROW, 32 * ph, 16 * kk, lane);
                af_ = __builtin_amdgcn_mfma_f32_32x32x16_bf16(ac, bhf, af_, 0, 0, 0);
                ab_ = __builtin_amdgcn_mfma_f32_32x32x16_bf16(ac, bhb, ab_, 0, 0, 0);
            }
            const float dsk = p->d_skip[l * 8 + h];
#pragma unroll
            for (int rg = 0; rg < 4; ++rg) {
                const int l0 = 32 * lb + 8 * rg + 4 * (ln >> 5);
                const f32x4 cfl = *(const LAS f32x4*)(hv + l0), cbl = *(const LAS f32x4*)(hv + 128 + l0);
#pragma unroll
                for (int e = 0; e < 4; ++e) { const int lr = l0 + e; const int ri = 4 * rg + e;
                    const float xs = bf2f(*(const LAS bf16_t*)(Xs + lr * ST_TR64 + pc * 2));
                    const float y = ad[ri] + __expf(cfl[e]) * af_[ri] + __expf(cbl[e]) * ab_[ri] + dsk * xs;
                    const float z = (ri & 1) ? bfhi(zraw[ri >> 1]) : bflo(zraw[ri >> 1]);
                    const float val = y * siluf_(z);
                    mix[(size_t)(row0 + lr) * 1024 + h * 64 + pc] = f2bf(val);
                    const float sq = half_sum32(val * val);
                    if ((ln & 31) == 31) ssqp[ph * 128 + lr] = sq;
                }
            }
            __syncthreads();
            if (tid < 128) SSQ[(size_t)(row0 + tid) * 8 + h] = ssqp[tid] + ssqp[128 + tid];
            if (hh < 3 && tid < 256) { float o[4][8];
                conv_compute(rx, cwl, 512, 256 + (hh + 1) * 64 + (tid & 7) * 8, o);
#pragma unroll
                for (int i = 0; i < 4; ++i) *(LAS u32x4*)(Xs + (4 * (tid >> 3) + i) * ST_TR64 + (tid & 7) * 16) = pack8(o[i]); }
        }
        __syncthreads();
    }
}
__device__ __forceinline__ void phase_r2(CP p, int l, unsigned char* lds, int bid, int nb) {
    LAS float* wrt = (LAS float*)(LAS unsigned char*)lds;
    LAS float* gm = wrt + 20 * 1024;
    LAS float* sh = gm + 3 * 1024;
    LAS int* lcnt = (LAS int*)(sh + 3 * 1024);
    LAS int* lcls = lcnt + 64;
    LAS int* lrank = lcls + 1024;
    LAS float* lcwa = (LAS float*)(lrank + 1024);
    LAS float* lcwb = lcwa + 1024;
    const int tid = launder_tid(); const int lane = tid & 63, wave = tid >> 6;
    const float* mod = (const float*)(p->ws + WS_MOD) + (size_t)l * 3 * 6144;
    { float tmp[8];
#pragma unroll
      for (int it = 0; it < 8; ++it) tmp[it] = p->w_rg[(size_t)l * 4096 + tid + NTHREADS * it];
#pragma unroll
      for (int it = 0; it < 8; ++it) { const int idx = tid + NTHREADS * it; wrt[(idx & 3) * 1024 + (idx >> 2)] = tmp[it]; } }
#pragma unroll
    for (int hb = 0; hb < 2; ++hb) { float tmp[16];
#pragma unroll
        for (int it = 0; it < 16; ++it) tmp[it] = p->w_re[(size_t)l * 16384 + tid + NTHREADS * (16 * hb + it)];
#pragma unroll
        for (int it = 0; it < 16; ++it) { const int idx = tid + NTHREADS * (16 * hb + it); wrt[(4 + (idx & 15)) * 1024 + (idx >> 4)] = tmp[it]; } }
    { float t0[6], t1[6], t2[6];
#pragma unroll
      for (int it = 0; it < 6; ++it) { const int idx = tid + NTHREADS * it; const int v = idx >> 10, k = idx & 1023; t0[it] = p->g_ffn[l * 1024 + k]; t1[it] = mod[v * 6144 + 4 * 1024 + k]; t2[it] = mod[v * 6144 + 3 * 1024 + k]; }
#pragma unroll
      for (int it = 0; it < 6; ++it) { const int idx = tid + NTHREADS * it; gm[idx] = t0[it] * (1.f + t1[it]); sh[idx] = t2[it]; } }
    if (tid < 64) lcnt[tid] = 0;
    __syncthreads();
    bf16_t* HM = (bf16_t*)(p->ws + WS_HX); float* CWLA = (float*)(p->ws + WS_CWLA); float* CWLB = (float*)(p->ws + WS_CWLB); int* POS = (int*)(p->ws + WS_POS) + (size_t)l * R;
    int* gcount = (int*)(p->ws + WS_CTL) + l * 32; int* LIST = (int*)(p->ws + WS_LIST);
    const int rpb = (R + nb - 1) / nb, r0 = bid * rpb, r1 = (r0 + rpb) < R ? (r0 + rpb) : R;
    f32x4 xn[4];
    if (r0 + wave < r1) { const f32x4* hr = (const f32x4*)hptr(p, r0 + wave);
#pragma unroll
        for (int j = 0; j < 4; ++j) xn[j] = hr[lane + 64 * j]; }
    for (int r = r0 + wave; r < r1; r += 8) {
        const int v = row_v(r);
        f32x4 xv[4]; float ss = 0.f;
#pragma unroll
        for (int j = 0; j < 4; ++j) xv[j] = xn[j];
        if (r + 8 < r1) { const f32x4* hr = (const f32x4*)hptr(p, r + 8);
#pragma unroll
            for (int j = 0; j < 4; ++j) xn[j] = hr[lane + 64 * j]; }
        if (l == DEPTH - 1 && v == 2) { if (lane == 0) lcls[r - r0] = -1; continue; }
#pragma unroll
        for (int j = 0; j < 4; ++j) ss += xv[j][0] * xv[j][0] + xv[j][1] * xv[j][1] + xv[j][2] * xv[j][2] + xv[j][3] * xv[j][3];
        ss = wave_sum(ss); const float rs = rsqrtf(ss * (1.f / 1024.f) + 1e-6f);
#pragma unroll
        for (int j = 0; j < 4; ++j) { const int k = 4 * lane + 256 * j; const f32x4 g4 = *(const LAS f32x4*)(gm + v * 1024 + k), s4 = *(const LAS f32x4*)(sh + v * 1024 + k);
            xv[j] = xv[j] * rs * g4 + s4;
            u32x2 o; o.x = cvt_pk_bf16(xv[j][0], xv[j][1]); o.y = cvt_pk_bf16(xv[j][2], xv[j][3]);
            *(u32x2*)(HM + (size_t)r * 1024 + k) = o; }
        float lg[20];
#pragma unroll
        for (int n = 0; n < 20; ++n) { float a = 0.f;
#pragma unroll
            for (int j = 0; j < 4; ++j) { const f32x4 w4 = *(const LAS f32x4*)(wrt + n * 1024 + 4 * lane + 256 * j); a += xv[j][0] * w4[0] + xv[j][1] * w4[1] + xv[j][2] * w4[2] + xv[j][3] * w4[3]; }
            lg[n] = wave_sum(a) + (n < 4 ? p->b_rg[l * 4 + n] : p->b_re[l * 16 + n - 4]); }
        int gsel = 0; float gmax = lg[0];
#pragma unroll
        for (int q = 1; q < 4; ++q) if (lg[q] > gmax) { gmax = lg[q]; gsel = q; }
        float gden = 0.f;
#pragma unroll
        for (int q = 0; q < 4; ++q) gden += __expf(lg[q] - gmax);
        const float gprob = 1.f / gden;
        float el[4];
#pragma unroll
        for (int q = 0; q < 4; ++q) el[q] = gsel == 0 ? lg[4 + q] : (gsel == 1 ? lg[8 + q] : (gsel == 2 ? lg[12 + q] : lg[16 + q]));
        int i0 = 0; float m0 = el[0];
#pragma unroll
        for (int q = 1; q < 4; ++q) if (el[q] > m0) { m0 = el[q]; i0 = q; }
        int i1 = -1; float m1 = -3.0e38f;
#pragma unroll
        for (int q = 0; q < 4; ++q) if (q != i0 && el[q] > m1) { m1 = el[q]; i1 = q; }
        const float w0 = gprob / (1.f + __expf(m1 - m0)), w1 = gprob - w0;
        const int ea = i0 < i1 ? i0 : i1, eb = i0 < i1 ? i1 : i0;
        const float cwa = i0 < i1 ? w0 : w1, cwb = i0 < i1 ? w1 : w0;
        const int pidx = ea == 0 ? eb - 1 : (ea == 1 ? eb + 1 : 5);
        const int cls = gsel * 6 + pidx;
        if (lane == 0) { const int rank = __hip_atomic_fetch_add(&lcnt[cls], 1, __ATOMIC_RELAXED, __HIP_MEMORY_SCOPE_WORKGROUP); lcls[r - r0] = cls; lrank[r - r0] = rank; lcwa[r - r0] = cwa; lcwb[r - r0] = cwb; }
    }
    __syncthreads();
    if (tid < NCLS) lcnt[32 + tid] = atomicAdd(&gcount[tid], lcnt[tid]);
    __syncthreads();
    for (int idx = tid; idx < r1 - r0; idx += NTHREADS) { const int cl = lcls[idx]; if (cl < 0) continue; const int pos = lcnt[32 + cl] + lrank[idx]; const size_t li = (size_t)cl * R + pos;
        LIST[li] = r0 + idx; CWLA[li] = lcwa[idx]; CWLB[li] = lcwb[idx]; POS[r0 + idx] = (cl << 16) | pos; }
    __syncthreads();
}
__device__ __forceinline__ void phase_final(CP p, unsigned char* lds, int bid, int nb) {
    const int tid = launder_tid(); const int lane = tid & 63, wave = tid >> 6;
    LAS int* tab = (LAS int*)((LAS unsigned char*)lds + MISC_OFF);
    moe_table(p, DEPTH - 1, tab);
    const int* POS = (const int*)(p->ws + WS_POS) + (size_t)(DEPTH - 1) * R;
    const int qstep = nb * 8;
    f32x4 xn[4]; u32x2 yn[4]; int posn = 0;
    { const int q = bid * 8 + wave;
      if (q < NB * SEQ) { const int b = q >= SEQ ? 1 : 0; const int r = b * SEG + CTXL + (q - b * SEQ); const f32x4* hr = (const f32x4*)(p->out + (size_t)q * D);
#pragma unroll
          for (int j = 0; j < 4; ++j) xn[j] = hr[lane + 64 * j];
          moe_yload(p, POS[r], lane, tab, yn);
          const int qn = q + qstep; if (qn < NB * SEQ) { const int bn = qn >= SEQ ? 1 : 0; posn = POS[bn * SEG + CTXL + (qn - bn * SEQ)]; } } }
    for (int q = bid * 8 + wave; q < NB * SEQ; q += qstep) {
        const int b = q >= SEQ ? 1 : 0;
        f32x4* hr = (f32x4*)(p->out + (size_t)q * D);
        f32x4 xv[4]; u32x2 yv[4]; float ss = 0.f;
#pragma unroll
        for (int j = 0; j < 4; ++j) { xv[j] = xn[j]; yv[j] = yn[j]; }
        { const int qn = q + qstep;
          if (qn < NB * SEQ) { const f32x4* hn = (const f32x4*)(p->out + (size_t)qn * D);
#pragma unroll
              for (int j = 0; j < 4; ++j) xn[j] = hn[lane + 64 * j];
              moe_yload(p, posn, lane, tab, yn);
              const int q2 = qn + qstep; if (q2 < NB * SEQ) { const int b2 = q2 >= SEQ ? 1 : 0; posn = POS[b2 * SEG + CTXL + (q2 - b2 * SEQ)]; } } }
        moe_yadd(p, DEPTH - 1, b, lane, yv, xv);
#pragma unroll
        for (int j = 0; j < 4; ++j) ss += xv[j][0] * xv[j][0] + xv[j][1] * xv[j][1] + xv[j][2] * xv[j][2] + xv[j][3] * xv[j][3];
        ss = wave_sum(ss); const float rs = rsqrtf(ss * (1.f / 1024.f) + 1e-6f);
#pragma unroll
        for (int j = 0; j < 4; ++j) { const f32x4 g4 = *(const f32x4*)(p->g_final + 4 * lane + 256 * j); hr[lane + 64 * j] = xv[j] * rs * g4; }
    }
}


#define XB_TMO      128
#define XB_XCNT(j)  (256  + 64 * (j))
#define XB_XSUB(j)  (1280 + 64 * (j))
#define XB_XGEN(j)  (2304 + 64 * (j))
#define XB_TOP      3328
#define XB_TOPGEN   3392
#define XCD_BAR_WORDS 3456
#define XB_SPIN_CAP (1u << 22)
__device__ __forceinline__ unsigned xb_ld(unsigned* p) { return __hip_atomic_load(p, __ATOMIC_RELAXED, __HIP_MEMORY_SCOPE_AGENT); }
__device__ __forceinline__ unsigned xb_add(unsigned* p, unsigned v) { return __hip_atomic_fetch_add(p, v, __ATOMIC_RELAXED, __HIP_MEMORY_SCOPE_AGENT); }
__device__ __forceinline__ unsigned xb_xcc_id() { return (unsigned)__builtin_amdgcn_s_getreg((3 << 11) | 20) & 0xFu; }
#define XB_SPIN(cond, bar) do { unsigned _sp = 0; while (cond) { __builtin_amdgcn_s_sleep(1); \
    if ((++_sp & 255u) == 0u) { if (xb_ld(&(bar)[XB_TMO])) break; if (_sp > XB_SPIN_CAP) { atomicAdd(&(bar)[XB_TMO], 1u); break; } } } } while (0)
struct XcdBarrier { unsigned* bar; unsigned x; volatile LAS unsigned* st; };
__device__ __forceinline__ XcdBarrier xcd_barrier_post(unsigned* bar, volatile LAS unsigned* st) {
    XcdBarrier b; b.bar = bar; b.x = xb_xcc_id(); b.st = st;
    if (threadIdx.x == 0) (void)xb_add(&bar[XB_XCNT(b.x)], 1u);
    return b;
}
__device__ __forceinline__ void xcd_barrier_complete(unsigned* bar, unsigned x, unsigned& nloc, unsigned& nx) {
    const unsigned G = gridDim.x * gridDim.y * gridDim.z;
    unsigned sum, cnt, mine, sp = 0u;
    for (;;) {
        sum = 0u; cnt = 0u; mine = 0u;
#pragma unroll
        for (unsigned j = 0; j < 16; ++j) { const unsigned c = xb_ld(&bar[XB_XCNT(j)]); sum += c; cnt += (c > 0u) ? 1u : 0u; mine = (j == x) ? c : mine; }
        if (sum == G) break;
        __builtin_amdgcn_s_sleep(1);
        if ((++sp & 255u) == 0u) { if (xb_ld(&bar[XB_TMO])) break; if (sp > XB_SPIN_CAP) { atomicAdd(&bar[XB_TMO], 1u); break; } }
    }
    nloc = mine > 0u ? mine : 1u; nx = cnt > 0u ? cnt : 1u;
}
__device__ __forceinline__ void xcd_barrier(const XcdBarrier& b) {
    asm volatile("s_waitcnt vmcnt(0)" ::: "memory");
    __syncthreads();
    if (threadIdx.x == 0) {
        unsigned* bar = b.bar;
        __builtin_amdgcn_s_waitcnt(0);
        unsigned nloc = b.st[0], nx = b.st[1];
        if (nloc == 0u) { xcd_barrier_complete(bar, b.x, nloc, nx); b.st[0] = nloc; b.st[1] = nx; }
        const unsigned old = xb_add(&bar[XB_XSUB(b.x)], 1u);
        const unsigned gen = old / nloc;
        if (old + 1u == (gen + 1u) * nloc) {
            __builtin_amdgcn_fence(__ATOMIC_RELEASE, "agent");
            asm volatile("s_waitcnt vmcnt(0)" ::: "memory");
            const unsigned og = xb_add(&bar[XB_TOP], 1u);
            const unsigned tg = og / nx;
            if (og + 1u == (tg + 1u) * nx) xb_add(&bar[XB_TOPGEN], 1u);
            else XB_SPIN(xb_ld(&bar[XB_TOPGEN]) == tg, bar);
            __builtin_amdgcn_fence(__ATOMIC_ACQUIRE, "agent");
            xb_add(&bar[XB_XGEN(b.x)], 1u);
            asm volatile("s_waitcnt vmcnt(0)" ::: "memory");
        } else {
            XB_SPIN(xb_ld(&bar[XB_XGEN(b.x)]) == gen, bar);
            __builtin_amdgcn_fence(__ATOMIC_ACQUIRE, "agent");
            asm volatile("s_waitcnt vmcnt(0)" ::: "memory");
        }
    }
    __syncthreads();
}

#ifndef TIMING_A
#define TIMING_A -1
#endif
#ifndef TIMING_B
#define TIMING_B -1
#endif
#ifndef PHASE_MASK
#define PHASE_MASK 0xFFFFF
#endif
#define PM(i) ((PHASE_MASK >> (i)) & 1)
#ifndef REPEAT_MASK
#define REPEAT_MASK 0
#endif
#define RP(i) for (int rep_ = 0; rep_ < 1 + ((REPEAT_MASK >> (i)) & 1); ++rep_)
constexpr int PH_PER_LAYER = 9, NPHASES = 1 + DEPTH * PH_PER_LAYER + 1;
__global__ void __launch_bounds__(NTHREADS, 2) mk_fwd(Args args) {
    extern __shared__ __attribute__((aligned(16))) unsigned char lds[];
    cg::grid_group grid = cg::this_grid();
    const __attribute__((address_space(4))) Args* ap = (const __attribute__((address_space(4))) Args*)__builtin_amdgcn_kernarg_segment_ptr();
    const int lo = ap->lo, hi = ap->hi;
    LAS unsigned char* ldsl = (LAS unsigned char*)lds;
    volatile LAS unsigned* xbst = (volatile LAS unsigned*)(ldsl + LDS_BYTES - 16);
    if (threadIdx.x < 4) xbst[threadIdx.x] = 0u;
    __syncthreads();
    (void)xcd_barrier_post((unsigned*)(ap->p.ws + WS_BAR), xbst);
    if (TIMING_A >= 0 && blockIdx.x == 0 && threadIdx.x == 0) ((unsigned long long*)(ap->p.ws + WS_TS))[lo] = __builtin_amdgcn_s_memrealtime();
    for (int ph = lo; ph < hi; ++ph) {
        CP p = launder(&ap->p);
        int bid = blockIdx.x, nb = gridDim.x; asm volatile("" : "+s"(bid), "+s"(nb));
        if (ph == 0) { if (PM(0)) RP(0) phase_wprep(p, lds, bid, nb); if (PM(1)) RP(1) phase_adaln(p, lds, bid, nb); }
        else if (ph == NPHASES - 1) { if (PM(12)) phase_final(p, lds, bid, nb); }
        else {
            const int l = (ph - 1) / PH_PER_LAYER, s = (ph - 1) % PH_PER_LAYER;
            if (s == 0) { if (PM(2)) RP(2) { if (rep_ == 0 || l == 0) phase_r1(p, l, lds, bid, nb); } }
            else if (s == 1) { if (PM(3)) RP(3) {
                pg8::DenseSched S; S.init(p->ws + WS_HX, (const bf16_t*)(p->ws + WS_WTIN) + (size_t)l * DIN * 1024, R, NPROJ, 1024, 1024, 1024, nb, bid);
                EpiProj E{(bf16_t*)(p->ws + WS_PROJ)};
                pg8::gemm_phase<EpiProj, pg8::DenseSched, false>(ldsl, 1024, 1024, 1024, S, E);
            } }
            else if (s == 2) { if (PM(4)) RP(4) phase_c1(p, l, lds, bid, nb); if (PM(5)) RP(5) phase_s1(p, l, lds, bid, nb); }
            else if (s == 3) { if (PM(6)) RP(6) phase_s2(p, bid, nb); if (PM(4)) phase_c1_ln(p, l, bid, nb); }
            else if (s == 4) { if (PM(7)) RP(7) phase_s3(p, l, lds, bid, nb); }
            else if (s == 5) { if (PM(8)) RP(8) { if (rep_ == 0 || l == 0) {
                pg8::DenseSched S; S.init(p->ws + WS_HX, (const bf16_t*)(p->ws + WS_WTOUT) + (size_t)l * 1024 * 1024, R, 1024, 1024, 1024, 1024, nb, bid, l == DEPTH - 1);
                EpiResid E{l == 0 ? p->ctx : (const float*)(p->ws + WS_HC), l == 0 ? p->x : (const float*)p->out, (float*)(p->ws + WS_HC), p->out, (const float*)(p->ws + WS_MOD) + (size_t)l * 3 * 6144, (const float*)(p->ws + WS_SSQ)};
                pg8::gemm_phase<EpiResid, pg8::DenseSched, false>(ldsl, 1024, 1024, 1024, S, E);
            } } }
            else if (s == 6) { if (PM(9)) phase_r2(p, l, lds, bid, nb); }
            else if (s == 7) { if (PM(10)) RP(10) {
                LAS int* tab = (LAS int*)(ldsl + MISC_OFF); moe_table(p, l, tab);
                MoeSched S{tab, (const int*)(p->ws + WS_LIST), (const char*)(p->ws + WS_HX), (const char*)(p->ws + WS_WTGU), 0, l, nb, bid};
                EpiUp E{(bf16_t*)(p->ws + WS_HID), (const float*)(p->ws + WS_CWLA), (const float*)(p->ws + WS_CWLB)};
                pg8::gemm_phase<EpiUp, MoeSched, true>(ldsl, 1024, 1024, 1024, S, E);
            } }
            else { if (PM(11)) RP(11) {
                LAS int* tab = (LAS int*)(ldsl + MISC_OFF); moe_table(p, l, tab);
                MoeSched S{tab, (const int*)(p->ws + WS_LIST), (const char*)(p->ws + WS_HID), (const char*)(p->ws + WS_WTD), 1, l, nb, bid};
                EpiY E{(bf16_t*)(p->ws + WS_Y)};
                pg8::gemm_phase<EpiY, MoeSched, false>(ldsl, 512, 256, 512, S, E);
            } }
        }
        if (ph + 1 < hi) { if (ph == lo) grid.sync(); else { XcdBarrier xb; xb.bar = (unsigned*)(launder(&ap->p)->ws + WS_BAR); xb.x = xb_xcc_id(); xb.st = (volatile LAS unsigned*)(ldsl + LDS_BYTES - 16); xcd_barrier(xb); }
            if (TIMING_A >= 0 && blockIdx.x == 0 && threadIdx.x == 0) ((unsigned long long*)(launder(&ap->p)->ws + WS_TS))[ph + 1] = __builtin_amdgcn_s_memrealtime(); }
    }
#if TIMING_A >= 0
    {
        XcdBarrier xb; xb.bar = (unsigned*)(launder(&ap->p)->ws + WS_BAR); xb.x = xb_xcc_id(); xb.st = (volatile LAS unsigned*)(ldsl + LDS_BYTES - 16); xcd_barrier(xb);
        if (blockIdx.x == 0 && threadIdx.x == 0) ((unsigned long long*)(launder(&ap->p)->ws + WS_TS))[hi] = __builtin_amdgcn_s_memrealtime();
        xcd_barrier(xb);
        const unsigned long long* ts = (const unsigned long long*)(launder(&ap->p)->ws + WS_TS);
        const float ta = (float)(ts[TIMING_A + 1] - ts[TIMING_A]) * 0.01f, tb = (float)(ts[TIMING_B + 1] - ts[TIMING_B]) * 0.01f;
        float* o = launder(&ap->p)->out; const float sc = 1.f + ta * 0.001f;
        for (size_t i = (size_t)blockIdx.x * NTHREADS + threadIdx.x; i < (size_t)NB * SEQ * D; i += (size_t)gridDim.x * NTHREADS) o[i] = o[i] * sc + (i == 0 ? tb * 0.1f : 0.f);
    }
#endif
}

extern "C" void kernel_launch(void* const* d_in, const int* in_sizes, int n_in, void* d_out, int out_size, void* d_ws, size_t ws_size, hipStream_t stream) {
    static int grid = 0;
    if (grid == 0) {
        if (n_in != 28 || ws_size < WS_END) { fprintf(stderr, "kernel_launch: unexpected n_in %d or ws_size %zu (< %zu)\n", n_in, ws_size, (size_t)WS_END); grid = -1; return; }
        int dev = 0, cus = 0, per_cu = 0;
        hipGetDevice(&dev); hipDeviceGetAttribute(&cus, hipDeviceAttributeMultiprocessorCount, dev);
        if (hipFuncSetAttribute((const void*)mk_fwd, hipFuncAttributeMaxDynamicSharedMemorySize, LDS_BYTES) != hipSuccess) { fprintf(stderr, "kernel_launch: hipFuncSetAttribute failed\n"); grid = -1; return; }
        if (hipOccupancyMaxActiveBlocksPerMultiprocessor(&per_cu, (const void*)mk_fwd, NTHREADS, LDS_BYTES) != hipSuccess || per_cu < 1) { fprintf(stderr, "kernel_launch: occupancy query says %d\n", per_cu); (void)hipGetLastError(); grid = -1; return; }
        grid = cus;
    }
    if (grid < 0) return;
    (void)hipMemsetAsync((char*)d_ws + WS_CTL, 0, WS_CTL_BYTES, stream);
    Args a{};
    const float** pp = (const float**)&a.p;
    for (int i = 0; i < 28; ++i) pp[i] = (const float*)d_in[i];
    a.p.out = (float*)d_out; a.p.ws = (unsigned char*)d_ws;
#if PER_PHASE_LAUNCH
    for (int ph = 0; ph < NPHASES; ++ph) {
        a.lo = ph; a.hi = ph + 1; void* kargs[] = {&a};
        hipError_t e = hipLaunchCooperativeKernel((const void*)mk_fwd, dim3(grid), dim3(NTHREADS), kargs, LDS_BYTES, stream);
        if (e != hipSuccess) { fprintf(stderr, "kernel_launch: launch of phase %d failed: %s\n", ph, hipGetErrorString(e)); break; }
    }
#else
    a.lo = 0; a.hi = NPHASES; void* kargs[] = {&a};
    hipError_t e = hipLaunchCooperativeKernel((const void*)mk_fwd, dim3(grid), dim3(NTHREADS), kargs, LDS_BYTES, stream);
    if (e != hipSuccess) fprintf(stderr, "kernel_launch: cooperative launch failed: %s (grid %d)\n", hipGetErrorString(e), grid);
#endif
}
```

```cpp
#include <hip/hip_runtime.h>
#include <hip/hip_cooperative_groups.h>
#include <cstdio>
namespace cg = cooperative_groups;

#ifndef PER_PHASE_LAUNCH
#define PER_PHASE_LAUNCH 0
#endif

#ifndef S3REP
#define S3REP 0
#endif
#define S3R(i) for (int r3_ = 0; r3_ < 1 + ((S3REP >> (i)) & 1); ++r3_)
#define LAS __attribute__((address_space(3)))
typedef unsigned short bf16_t;
typedef short bf16x8 __attribute__((ext_vector_type(8)));
typedef float f32x4 __attribute__((ext_vector_type(4)));
typedef unsigned u32x4 __attribute__((ext_vector_type(4)));
typedef unsigned u32x2 __attribute__((ext_vector_type(2)));

constexpr int D = 1024, NB = 2, SEQ = 16384, CTXL = 256, SEG = SEQ + CTXL, R = NB * SEG, DEPTH = 2;
constexpr int NPROJ = 2560, DIN = 2576;
constexpr int NTHREADS = 512;
constexpr int LDS_BYTES = 163840;
constexpr int MISC_OFF = 131072;
constexpr int NCLS = 24;

constexpr size_t al256(size_t x) { return (x + 255) & ~size_t(255); }
constexpr size_t WS_CTL = 0;
constexpr size_t WS_TS = 2048;
constexpr size_t WS_BAR = 4096;
constexpr size_t WS_CTL_BYTES = 32768;
constexpr size_t WS_MOD = WS_CTL_BYTES;
constexpr size_t WS_WTIN = WS_MOD + al256((size_t)2 * 3 * 6144 * 4);
constexpr size_t WS_WTOUT = WS_WTIN + al256((size_t)2 * DIN * 1024 * 2);
constexpr size_t WS_WTGU = WS_WTOUT + al256((size_t)2 * 1024 * 1024 * 2);
constexpr size_t WS_WTD = WS_WTGU + al256((size_t)2 * 16 * 512 * 1024 * 2);
constexpr size_t WS_HC = WS_WTD + al256((size_t)2 * 16 * 1024 * 256 * 2);
constexpr size_t WS_HX = WS_HC + al256((size_t)512 * 1024 * 4);
constexpr size_t WS_PROJ = WS_HX + al256((size_t)R * 1024 * 2);
constexpr size_t WS_DT = WS_PROJ + al256((size_t)R * NPROJ * 2);
constexpr size_t WS_POS = WS_DT + al256((size_t)R * 16 * 4);
constexpr size_t WS_LIST = WS_POS + al256((size_t)2 * R * 4);
constexpr size_t WS_CWLA = WS_LIST + al256((size_t)NCLS * R * 4);
constexpr size_t WS_CWLB = WS_CWLA + al256((size_t)NCLS * R * 4);
constexpr size_t WS_BIG = WS_CWLB + al256((size_t)NCLS * R * 4);
constexpr size_t WS_Y = WS_PROJ;
constexpr size_t WS_S = WS_BIG;
constexpr size_t WS_HP = WS_S + al256((size_t)2 * 2 * 130 * 8 * 8192 * 4);
constexpr size_t WS_DEC = WS_HP + al256((size_t)2 * 2 * 130 * 8 * 8192 * 2);
constexpr size_t WS_SSQ = WS_DEC + al256((size_t)2 * 2 * 130 * 8 * 4);
constexpr size_t WS_HID = WS_S;
constexpr size_t WS_END = WS_SSQ + al256((size_t)R * 8 * 4);
static_assert((size_t)(R + NCLS * 256) * 512 * 2 <= (size_t)2 * 2 * 130 * 8 * 8192 * 4, "hid alias");
static_assert(WS_END <= (size_t)512 * 1024 * 1024, "workspace");

struct Params {
    const float *x, *c, *ctx, *c_ctx, *w_ada, *b_ada, *g_mix, *g_ffn, *w_in, *conv_w, *conv_b, *conv_ln_g, *conv_ln_b, *ssd_conv_w, *ssd_conv_b,
        *dt_bias, *a_log, *d_skip, *ssd_norm_g, *w_out, *w_rg, *b_rg, *w_re, *b_re, *w_gate, *w_up, *w_down, *g_final;
    float* out; unsigned char* ws;
};
struct Args { Params p; int lo, hi; };
typedef const __attribute__((address_space(4))) Params* CP;
__device__ __forceinline__ CP launder(CP p) { asm volatile("" : "+s"(p)); return p; }
__device__ __forceinline__ int launder_tid() { int t = threadIdx.x; asm volatile("" : "+v"(t)); return t; }

__device__ __forceinline__ unsigned cvt_pk_bf16(float lo, float hi) { unsigned r; asm("v_cvt_pk_bf16_f32 %0, %1, %2" : "=v"(r) : "v"(lo), "v"(hi)); return r; }
__device__ __forceinline__ float bf2f(unsigned b) { return __uint_as_float(b << 16); }
__device__ __forceinline__ float bflo(unsigned w) { return __uint_as_float(w << 16); }
__device__ __forceinline__ float bfhi(unsigned w) { return __uint_as_float(w & 0xffff0000u); }
__device__ __forceinline__ bf16_t f2bf(float f) { return (bf16_t)(cvt_pk_bf16(f, 0.f) & 0xffffu); }
#define DPP_ADD(v, ctrl, rm) ((v) + __builtin_bit_cast(float, __builtin_amdgcn_update_dpp(0, __builtin_bit_cast(int, (v)), (ctrl), (rm), 0xF, true)))
__device__ __forceinline__ float row_sum16(float v) {
    v = DPP_ADD(v, 0xB1, 0xF);
    v = DPP_ADD(v, 0x4E, 0xF);
    v = DPP_ADD(v, 0x141, 0xF);
    v = DPP_ADD(v, 0x140, 0xF);
    return v;
}
__device__ __forceinline__ float half_sum32(float v) { v = row_sum16(v); v = DPP_ADD(v, 0x142, 0xA); return v; }
__device__ __forceinline__ float wave_sum(float v) {
    v = half_sum32(v); v = DPP_ADD(v, 0x143, 0xC);
    return __builtin_bit_cast(float, __builtin_amdgcn_readlane(__builtin_bit_cast(int, v), 63));
}
__device__ __forceinline__ float sigmoidf_(float x) { return 1.f / (1.f + __expf(-x)); }
__device__ __forceinline__ float siluf_(float x) { return x / (1.f + __expf(-x)); }
__device__ __forceinline__ float softplusf_(float x) { return fmaxf(x, 0.f) + log1pf(expf(-fabsf(x))); }

__device__ __forceinline__ int row_b(int r) { return r >= SEG ? 1 : 0; }
__device__ __forceinline__ int row_i(int r) { return r >= SEG ? r - SEG : r; }
__device__ __forceinline__ int row_v(int r) { const int i = row_i(r); return i < CTXL ? 2 : row_b(r); }
__device__ __forceinline__ float* hptr2(float* hc, float* out, int r) {
    const int b = row_b(r), i = row_i(r);
    return i < CTXL ? hc + (size_t)(b * CTXL + i) * D : out + (size_t)(b * SEQ + i - CTXL) * D;
}
__device__ __forceinline__ float* hptr(CP p, int r) { return hptr2((float*)(p->ws + WS_HC), p->out, r); }
__device__ __forceinline__ const float* hin_ptr(CP p, int l, int r) {
    if (l == 0) return hptr2((float*)p->ctx, (float*)p->x, r);
    return hptr(p, r);
}

namespace pg8 {
constexpr int BM = 256, BK = 64, HALF = 128, HTB = HALF * BK * 2, STAGE_BYTES = 8 * HTB, NXCD = 8, WGM = 8;
__device__ __forceinline__ int lds_byte(int r, int c) { const int st = (r >> 4) * 2 + (c >> 5), rr = r & 15, cc = c & 31, ob = rr * 64 + cc * 2; return st * 1024 + (ob ^ (((ob >> 9) & 1) << 5)); }
__device__ __forceinline__ void stage_rc(int b, int& Rr, int& Cc) { const int st = b / 1024, sb = b % 1024, swz = sb ^ (((sb >> 9) & 1) << 5); Rr = (st >> 1) * 16 + swz / 64; Cc = (st & 1) * 32 + (swz % 64) / 2; }
__device__ __forceinline__ int perm32(int rho) { const int n = rho >> 4, i = rho & 15; return 8 * (i >> 2) + 4 * n + (i & 3); }

struct Unit {
    const char* a0;
    const char* b0;
    const char* b1;
    int i0, i1, i2, i3, i4, pad;
};

template <class Epi, class Sched, bool GATHER>
__device__ __forceinline__ void gemm_phase(LAS unsigned char* lds, const int lda, const int ldb, const int K, const Sched& S, const Epi& E) {
    const int tid = launder_tid(); const int wid = __builtin_amdgcn_readfirstlane(tid >> 6), lane = tid & 63, wr = wid >> 2, wc = wid & 3, fr = lane & 15, fq = lane >> 4;
    const int nt = K / BK, ks = nt >> 1;
    int Rr[2], Cc[2];
    unsigned voffB[2];
#pragma unroll
    for (int i = 0; i < 2; ++i) { stage_rc(tid * 16 + i * 8192, Rr[i], Cc[i]); const int Rb = Epi::PERM ? ((Rr[i] & ~31) + perm32(Rr[i] & 31)) : Rr[i];
        voffB[i] = (unsigned)(Rb * ldb + Cc[i]) * 2u; }
    const size_t kstep = (size_t)(BK * 2);
    const size_t hstepB = (size_t)HALF * ldb * 2;
    const unsigned ldsw = (unsigned)wid * 1024u;
    const unsigned ldsbase = (unsigned)(unsigned long)lds;
    const int aoff = lds_byte(wr * 64 + fr, fq * 8), boff = lds_byte(wc * 32 + fr, fq * 8);
#define PG8_SA(b, h) (((b) * 2 + (h)) * HTB)
#define PG8_SB(b, h) ((4 + (b) * 2 + (h)) * HTB)
#define PG8_STAGE2(bufoff, gbase, v0, v1) do { unsigned keep_; \
        asm volatile("s_mov_b32 %0, m0\n\ts_mov_b32 m0, %1\n\ts_nop 4\n\tglobal_load_lds_dwordx4 %2, %4\n\ts_add_u32 m0, m0, 0x2000\n\ts_nop 0\n\tglobal_load_lds_dwordx4 %3, %4\n\ts_mov_b32 m0, %0" \
            : "=&s"(keep_) : "s"(ldsbase + (unsigned)(bufoff) + ldsw), "v"(v0), "v"(v1), "s"(gbase) : "memory", "scc"); } while (0)
#define PG8_LDA(dst, b, h) do { _Pragma("unroll") for (int m = 0; m < 4; ++m) _Pragma("unroll") for (int k = 0; k < 2; ++k) dst[m][k] = *(const LAS bf16x8*)(lds + PG8_SA(b, h) + aoff + m * 2048 + k * 1024); } while (0)
#define PG8_LDB(dst, b, h) do { _Pragma("unroll") for (int n = 0; n < 2; ++n) _Pragma("unroll") for (int k = 0; k < 2; ++k) dst[n][k] = *(const LAS bf16x8*)(lds + PG8_SB(b, h) + boff + n * 2048 + k * 1024); } while (0)
#define PG8_MMA(ai, bj, At, Bt) do { __builtin_amdgcn_s_setprio(1); _Pragma("unroll") for (int m = 0; m < 4; ++m) _Pragma("unroll") for (int n = 0; n < 2; ++n) _Pragma("unroll") for (int k = 0; k < 2; ++k) \
        acc[ai][bj][m][n] = __builtin_amdgcn_mfma_f32_16x16x32_bf16(Bt[n][k], At[m][k], acc[ai][bj][m][n], 0, 0, 0); __builtin_amdgcn_s_setprio(0); } while (0)
#define PG8_WAIT_V(n) asm volatile("s_waitcnt vmcnt(" #n ")" ::: "memory")
#define PG8_WAIT_L(n) asm volatile("s_waitcnt lgkmcnt(" #n ")" ::: "memory")
#define PG8_BAR __builtin_amdgcn_s_barrier()
#define PG8_SCHED __builtin_amdgcn_sched_barrier(0)
#define PG8_BP(u, tt) ((tt) < ks ? (u).b0 + (size_t)(tt) * kstep : (u).b1 + (size_t)((tt) - ks) * kstep)
    Unit cur, nxt; int ui = 0;
    if (!S.get(0, cur)) return;
    unsigned c00, c01, c10, c11, n00, n01, n10, n11;
    if (GATHER) {
        c00 = (unsigned)(S.arow(cur, Rr[0]) * lda + Cc[0]) * 2u; c01 = (unsigned)(S.arow(cur, Rr[1]) * lda + Cc[1]) * 2u;
        c10 = (unsigned)(S.arow(cur, HALF + Rr[0]) * lda + Cc[0]) * 2u; c11 = (unsigned)(S.arow(cur, HALF + Rr[1]) * lda + Cc[1]) * 2u;
    } else {
        c00 = (unsigned)(Rr[0] * lda + Cc[0]) * 2u; c01 = (unsigned)(Rr[1] * lda + Cc[1]) * 2u;
        c10 = (unsigned)((HALF + Rr[0]) * lda + Cc[0]) * 2u; c11 = (unsigned)((HALF + Rr[1]) * lda + Cc[1]) * 2u;
    }
    n00 = c00; n01 = c01; n10 = c10; n11 = c11;
    f32x4 acc[2][2][4][2];
    float zr; asm volatile("v_mov_b32 %0, 0" : "=v"(zr));
#pragma unroll
    for (int a = 0; a < 2; ++a)
#pragma unroll
        for (int b = 0; b < 2; ++b)
#pragma unroll
            for (int m = 0; m < 4; ++m)
#pragma unroll
                for (int n = 0; n < 2; ++n) acc[a][b][m][n] = (f32x4){zr, zr, zr, zr};
    bf16x8 At[4][2], B0[2][2], B1[2][2];
    const char* cA = cur.a0;
    {
        const char* pb0 = PG8_BP(cur, 0); const char* pb1 = PG8_BP(cur, 1);
        PG8_STAGE2(PG8_SB(0, 0), pb0, voffB[0], voffB[1]); PG8_STAGE2(PG8_SA(0, 0), cA, c00, c01);
        PG8_STAGE2(PG8_SB(0, 1), pb0 + hstepB, voffB[0], voffB[1]); PG8_STAGE2(PG8_SA(0, 1), cA, c10, c11);
        if (wr == 1) PG8_BAR;
        PG8_WAIT_V(4); PG8_BAR;
        PG8_STAGE2(PG8_SB(1, 0), pb1, voffB[0], voffB[1]); PG8_STAGE2(PG8_SA(1, 0), cA + kstep, c00, c01);
        PG8_STAGE2(PG8_SB(1, 1), pb1 + hstepB, voffB[0], voffB[1]);
        PG8_WAIT_V(6); PG8_BAR;
    }
    for (;;) {
        const bool has_next = S.get(ui + 1, nxt);
        if (!has_next) nxt = cur;
        LAS int* tokb = (LAS int*)(lds + MISC_OFF + 1024) + ((ui + 1) & 1) * 256;
        if (GATHER) {
            n00 = c00; n01 = c01; n10 = c10; n11 = c11;
            if (has_next && wid == 0) {
                const char* src = (const char*)S.rows_ptr(nxt); unsigned keep_;
                asm volatile("s_mov_b32 %0, m0\n\ts_mov_b32 m0, %1\n\ts_nop 4\n\tglobal_load_lds_dwordx4 %2, %3\n\ts_mov_b32 m0, %0"
                    : "=&s"(keep_) : "s"((unsigned)(unsigned long)tokb), "v"((unsigned)lane * 16u), "s"(src) : "memory");
            }
        }
        const char* nA = nxt.a0;
#pragma unroll 1
        for (int t = 0; t < nt; t += 2) {
            const bool last = (t == nt - 2);
            const char* a1 = cA + (size_t)(t + 1) * kstep;
            const char* a2 = last ? nA : cA + (size_t)(t + 2) * kstep;
            const char* a3 = a2 + kstep;
            const char* b2 = last ? PG8_BP(nxt, 0) : PG8_BP(cur, t + 2);
            const char* b3 = last ? PG8_BP(nxt, 1) : PG8_BP(cur, t + 3);
            if (GATHER) { if (last && has_next) {
                const int lim = S.rows_valid(nxt) - 1;
                const int i0 = Rr[0] < lim ? Rr[0] : lim, i1 = Rr[1] < lim ? Rr[1] : lim, i2 = (HALF + Rr[0]) < lim ? (HALF + Rr[0]) : lim, i3 = (HALF + Rr[1]) < lim ? (HALF + Rr[1]) : lim;
                n00 = (unsigned)(tokb[i0] * lda + Cc[0]) * 2u; n01 = (unsigned)(tokb[i1] * lda + Cc[1]) * 2u;
                n10 = (unsigned)(tokb[i2] * lda + Cc[0]) * 2u; n11 = (unsigned)(tokb[i3] * lda + Cc[1]) * 2u; } }
            const unsigned s00 = last ? n00 : c00, s01 = last ? n01 : c01, s10 = last ? n10 : c10, s11 = last ? n11 : c11;
            if constexpr (Epi::MIDSCALE) { if (t == ks) E.midscale(acc, cur, wr, wc, fr, fq); }
            PG8_LDB(B0, 0, 0); PG8_SCHED; PG8_LDA(At, 0, 0); PG8_STAGE2(PG8_SA(1, 1), a1, c10, c11);
            PG8_WAIT_L(8); PG8_BAR; PG8_WAIT_L(0); PG8_MMA(0, 0, At, B0); PG8_BAR; PG8_SCHED;
            PG8_LDB(B1, 0, 1); PG8_STAGE2(PG8_SB(0, 0), b2, voffB[0], voffB[1]);
            PG8_BAR; PG8_WAIT_L(0); PG8_MMA(0, 1, At, B1); PG8_BAR;
            PG8_LDA(At, 0, 1); PG8_STAGE2(PG8_SA(0, 0), a2, s00, s01);
            PG8_BAR; PG8_WAIT_L(0); PG8_MMA(1, 0, At, B0); PG8_BAR; PG8_SCHED;
            PG8_STAGE2(PG8_SB(0, 1), b2 + hstepB, voffB[0], voffB[1]);
            PG8_WAIT_V(6); PG8_BAR; PG8_MMA(1, 1, At, B1); PG8_BAR;
            PG8_LDB(B0, 1, 0); PG8_SCHED; PG8_LDA(At, 1, 0); PG8_STAGE2(PG8_SA(0, 1), a2, s10, s11);
            PG8_WAIT_L(8); PG8_BAR; PG8_WAIT_L(0); PG8_MMA(0, 0, At, B0); PG8_BAR; PG8_SCHED;
            PG8_LDB(B1, 1, 1); PG8_STAGE2(PG8_SB(1, 0), b3, voffB[0], voffB[1]);
            PG8_BAR; PG8_WAIT_L(0); PG8_MMA(0, 1, At, B1); PG8_BAR;
            PG8_LDA(At, 1, 1); PG8_STAGE2(PG8_SA(1, 0), a3, s00, s01);
            PG8_BAR; PG8_WAIT_L(0); PG8_MMA(1, 0, At, B0); PG8_BAR; PG8_SCHED;
            PG8_STAGE2(PG8_SB(1, 1), b3 + hstepB, voffB[0], voffB[1]);
            PG8_WAIT_V(6); PG8_BAR; PG8_MMA(1, 1, At, B1); PG8_BAR;
        }
        E(acc, cur, wr, wc, fr, fq);
        if (!has_next) break;
        asm volatile("v_mov_b32 %0, 0" : "=v"(zr));
#pragma unroll
        for (int a = 0; a < 2; ++a)
#pragma unroll
            for (int b = 0; b < 2; ++b)
#pragma unroll
                for (int m = 0; m < 4; ++m)
#pragma unroll
                    for (int n = 0; n < 2; ++n) acc[a][b][m][n] = (f32x4){zr, zr, zr, zr};
        cur = nxt; cA = nA; ++ui; c00 = n00; c01 = n01; c10 = n10; c11 = n11;
    }
    PG8_WAIT_V(0);
    if (wr == 0) PG8_BAR;
    PG8_BAR;
#undef PG8_SA
#undef PG8_SB
#undef PG8_STAGE2
#undef PG8_LDA
#undef PG8_LDB
#undef PG8_MMA
#undef PG8_WAIT_V
#undef PG8_WAIT_L
#undef PG8_BAR
#undef PG8_SCHED
#undef PG8_BP
}

struct DenseSched {
    const char* A; const char* Bt; int lda, ldb, K; int nM, nN, nwg, G, c, skipctx;
    __device__ __forceinline__ void init(const void* A_, const void* Bt_, int M, int N, int K_, int lda_, int ldb_, int G_, int c_, int skipctx_ = 0) {
        A = (const char*)A_; Bt = (const char*)Bt_; lda = lda_; ldb = ldb_; K = K_; nM = M / BM - 2 * skipctx_; nN = N / BM; nwg = nM * nN; G = G_; c = c_; skipctx = skipctx_; }
    __device__ __forceinline__ bool get(int i, Unit& u) const {
        const long L = (long)i * G + c; if (L >= nwg) return false;
        int wgid = (int)L; { const int q = nwg / NXCD, r = nwg % NXCD, xcd = wgid % NXCD, off = wgid / NXCD; wgid = (xcd < r ? xcd * (q + 1) : r * (q + 1) + (xcd - r) * q) + off; }
        const int nig = WGM * nN, gid = wgid / nig, fm = gid * WGM, gsz = (nM - fm) < WGM ? (nM - fm) : WGM;
        int pm = fm + ((wgid % nig) % gsz); const int pn = (wgid % nig) / gsz;
        if (skipctx) pm += 1 + (pm >= 64 ? 1 : 0);
        u.a0 = A + (size_t)pm * BM * lda * 2; u.b0 = Bt + (size_t)pn * BM * ldb * 2; u.b1 = u.b0 + (size_t)(K / BK / 2) * BK * 2;
        u.i0 = pm; u.i1 = pn; u.i2 = 0; u.i3 = 0; u.i4 = 0; u.pad = 0; return true;
    }
    __device__ __forceinline__ int arow(const Unit&, int rl) const { return rl; }
    __device__ __forceinline__ const int* rows_ptr(const Unit&) const { return nullptr; }
    __device__ __forceinline__ int rows_valid(const Unit&) const { return 256; }
};
}

struct EpiProj {
    static constexpr bool PERM = true, MIDSCALE = false;
    bf16_t* O;
    __device__ __forceinline__ void operator()(const f32x4 (&acc)[2][2][4][2], const pg8::Unit& u, int wr, int wc, int fr, int fq) const {
        const int row0 = u.i0 * 256 + wr * 64 + fr, col0 = u.i1 * 256 + wc * 32 + 8 * fq;
#pragma unroll
        for (int ai = 0; ai < 2; ++ai)
#pragma unroll
            for (int m = 0; m < 4; ++m) { bf16_t* rowp = O + (size_t)(row0 + ai * 128 + m * 16) * NPROJ + col0;
#pragma unroll
                for (int bj = 0; bj < 2; ++bj) { const f32x4 v0 = acc[ai][bj][m][0], v1 = acc[ai][bj][m][1];
                    u32x4 w; w.x = cvt_pk_bf16(v0[0], v0[1]); w.y = cvt_pk_bf16(v0[2], v0[3]); w.z = cvt_pk_bf16(v1[0], v1[1]); w.w = cvt_pk_bf16(v1[2], v1[3]);
                    *(u32x4*)(rowp + bj * 128) = w; } }
    }
};
struct EpiResid {
    static constexpr bool PERM = false, MIDSCALE = true;
    const float* inc; const float* inx; float* hc; float* out; const float* modl; const float* ssq;
    __device__ __forceinline__ void midscale(f32x4 (&acc)[2][2][4][2], const pg8::Unit& u, int wr, int wc, int fr, int fq) const {
        typedef float f32x2 __attribute__((ext_vector_type(2)));
        const int r0 = u.i0 * 256 + wr * 64 + fr;
        f32x2 part[2][4];
#pragma unroll
        for (int ai = 0; ai < 2; ++ai)
#pragma unroll
            for (int m = 0; m < 4; ++m) part[ai][m] = *(const f32x2*)(ssq + (size_t)(r0 + ai * 128 + m * 16) * 8 + 2 * fq);
#pragma unroll
        for (int ai = 0; ai < 2; ++ai)
#pragma unroll
            for (int m = 0; m < 4; ++m) { float sq = part[ai][m][0] + part[ai][m][1];
                sq += __shfl_xor(sq, 16); sq += __shfl_xor(sq, 32);
                const float rs = rsqrtf(sq * (1.f / 512.f) + 1e-6f);
#pragma unroll
                for (int bj = 0; bj < 2; ++bj)
#pragma unroll
                    for (int n = 0; n < 2; ++n) acc[ai][bj][m][n] *= rs; }
    }
    __device__ __forceinline__ void operator()(const f32x4 (&acc)[2][2][4][2], const pg8::Unit& u, int wr, int wc, int fr, int fq) const {
        const int r0 = u.i0 * 256;
        const int v = row_v(r0);
        const float* gate = modl + (size_t)v * 6144 + 2 * 1024;
        const float* hin = hptr2((float*)inc, (float*)inx, r0); float* hout = hptr2(hc, out, r0);
        const int rl0 = wr * 64 + fr, col0 = u.i1 * 256 + wc * 32 + 4 * fq;
        f32x4 gv[2][2];
#pragma unroll
        for (int bj = 0; bj < 2; ++bj)
#pragma unroll
            for (int n = 0; n < 2; ++n) gv[bj][n] = *(const f32x4*)(gate + col0 + bj * 128 + n * 16);
#pragma unroll
        for (int ai = 0; ai < 2; ++ai)
#pragma unroll
            for (int mp = 0; mp < 2; ++mp) {
                f32x4 hi[2][2][2];
#pragma unroll
                for (int mm = 0; mm < 2; ++mm) { const size_t off = (size_t)(rl0 + ai * 128 + (2 * mp + mm) * 16) * D + col0;
#pragma unroll
                    for (int bj = 0; bj < 2; ++bj)
#pragma unroll
                        for (int n = 0; n < 2; ++n) hi[mm][bj][n] = *(const f32x4*)(hin + off + bj * 128 + n * 16); }
#pragma unroll
                for (int mm = 0; mm < 2; ++mm) { const size_t off = (size_t)(rl0 + ai * 128 + (2 * mp + mm) * 16) * D + col0;
#pragma unroll
                    for (int bj = 0; bj < 2; ++bj)
#pragma unroll
                        for (int n = 0; n < 2; ++n) *(f32x4*)(hout + off + bj * 128 + n * 16) = hi[mm][bj][n] + gv[bj][n] * acc[ai][bj][2 * mp + mm][n]; }
                asm volatile("" ::: "memory"); }
    }
};

struct MoeSched {
    const LAS int* tab;
    const int* list;
    const char* A; const char* W; int mode  , l, G, c;
    __device__ __forceinline__ bool get(int i, pg8::Unit& u) const {
        const int L = i * G + c; const int total = __builtin_amdgcn_readfirstlane(tab[24]) * 4; if (L >= total) return false;
        const int tl = L >> 2, pn = L & 3;
        int cls = 0;
#pragma unroll 1
        for (int q = 1; q < NCLS; ++q) { const int tq = __builtin_amdgcn_readfirstlane(tab[q]); if (tq <= tl) cls = q; }
        const int j = tl - __builtin_amdgcn_readfirstlane(tab[cls]), cnt = __builtin_amdgcn_readfirstlane(tab[32 + cls]);
        const int g = cls / 6, pidx = cls - g * 6;
        const int ea = (pidx >= 3) + (pidx >= 5), eb = pidx < 3 ? pidx + 1 : (pidx < 5 ? pidx - 1 : 3);
        if (mode == 0) {
            const int e = 4 * g + (pn < 2 ? ea : eb);
            u.a0 = A;
            u.b0 = W + ((size_t)(l * 16 + e) * 512 + (size_t)(pn & 1) * 256) * 1024 * 2; u.b1 = u.b0 + (size_t)8 * 128;
        } else {
            u.a0 = A + (size_t)tl * 256 * 512 * 2;
            u.b0 = W + ((size_t)(l * 16 + 4 * g + ea) * 1024 + (size_t)pn * 256) * 256 * 2;
            u.b1 = W + ((size_t)(l * 16 + 4 * g + eb) * 1024 + (size_t)pn * 256) * 256 * 2;
        }
        u.i0 = cls; u.i1 = j; u.i2 = pn; u.i3 = cnt; u.i4 = tl; u.pad = 0; return true;
    }
    __device__ __forceinline__ int arow(const pg8::Unit& u, int rl) const {
        int idx = u.i1 * 256 + rl; idx = idx < u.i3 ? idx : u.i3 - 1;
        return list[(size_t)u.i0 * R + idx];
    }
    __device__ __forceinline__ const int* rows_ptr(const pg8::Unit& u) const { return list + (size_t)u.i0 * R + u.i1 * 256; }
    __device__ __forceinline__ int rows_valid(const pg8::Unit& u) const { return u.i3 - u.i1 * 256; }
};
struct EpiUp {
    static constexpr bool PERM = true, MIDSCALE = false;
    bf16_t* hid; const float* cwla; const float* cwlb;
    __device__ __forceinline__ void operator()(const f32x4 (&acc)[2][2][4][2], const pg8::Unit& u, int wr, int wc, int fr, int fq) const {
        const int cls = u.i0, j = u.i1, pn = u.i2, cnt = u.i3, tl = u.i4;
        const float* cw = (pn < 2) ? cwla : cwlb;
        const int colbase = (pn >> 1) * 256 + (pn & 1) * 128 + wc * 32 + 8 * fq;
        float wrow[2][4];
#pragma unroll
        for (int ai = 0; ai < 2; ++ai)
#pragma unroll
            for (int m = 0; m < 4; ++m) { const int idx = j * 256 + ai * 128 + wr * 64 + m * 16 + fr; wrow[ai][m] = idx < cnt ? cw[(size_t)cls * R + idx] : 0.f; }
#pragma unroll
        for (int ai = 0; ai < 2; ++ai)
#pragma unroll
            for (int m = 0; m < 4; ++m) {
                const int rl = ai * 128 + wr * 64 + m * 16 + fr; const int idx = j * 256 + rl; const bool valid = idx < cnt;
                const float w = wrow[ai][m];
                const f32x4 g0 = acc[ai][0][m][0], g1 = acc[ai][0][m][1], u0 = acc[ai][1][m][0], u1 = acc[ai][1][m][1];
                float o[8];
#pragma unroll
                for (int e = 0; e < 4; ++e) { o[e] = w * siluf_(g0[e]) * u0[e]; o[4 + e] = w * siluf_(g1[e]) * u1[e]; }
                if (!valid) {
#pragma unroll
                    for (int e = 0; e < 8; ++e) o[e] = 0.f; }
                u32x4 pk; pk.x = cvt_pk_bf16(o[0], o[1]); pk.y = cvt_pk_bf16(o[2], o[3]); pk.z = cvt_pk_bf16(o[4], o[5]); pk.w = cvt_pk_bf16(o[6], o[7]);
                *(u32x4*)(hid + ((size_t)tl * 256 + rl) * 512 + colbase) = pk;
                asm volatile("" ::: "memory");
            }
    }
};
struct EpiY {
    static constexpr bool PERM = true, MIDSCALE = false;
    bf16_t* Y;
    __device__ __forceinline__ void operator()(const f32x4 (&acc)[2][2][4][2], const pg8::Unit& u, int wr, int wc, int fr, int fq) const {
        const int row0 = u.i4 * 256 + wr * 64 + fr, col0 = u.i2 * 256 + wc * 32 + 8 * fq;
#pragma unroll
        for (int ai = 0; ai < 2; ++ai)
#pragma unroll
            for (int m = 0; m < 4; ++m) { bf16_t* rowp = Y + (size_t)(row0 + ai * 128 + m * 16) * 1024 + col0;
#pragma unroll
                for (int bj = 0; bj < 2; ++bj) { const f32x4 v0 = acc[ai][bj][m][0], v1 = acc[ai][bj][m][1];
                    u32x4 w; w.x = cvt_pk_bf16(v0[0], v0[1]); w.y = cvt_pk_bf16(v0[2], v0[3]); w.z = cvt_pk_bf16(v1[0], v1[1]); w.w = cvt_pk_bf16(v1[2], v1[3]);
                    *(u32x4*)(rowp + bj * 128) = w; } }
    }
};

__device__ __forceinline__ void tr_tile(const float* src, int ldn, int k0, int n0, int nvalid, bf16_t* dst, int ldk, int drow0, LAS float* tile, int kd0 = -1, const float* kscale = nullptr) {
    const int tid = launder_tid();
    if (kd0 < 0) kd0 = k0;
    { const int n = tid & 63; const int kq = tid >> 6; float tv[8], ts[8];
#pragma unroll
      for (int it = 0; it < 8; ++it) { const int kk = kq + 8 * it; tv[it] = (n < nvalid) ? src[(size_t)(k0 + kk) * ldn + n0 + n] : 0.f; ts[it] = kscale ? kscale[kk] : 1.f; }
#pragma unroll
      for (int it = 0; it < 8; ++it) tile[(kq + 8 * it) * 65 + n] = tv[it] * ts[it]; }
    __syncthreads();
    { const int k8 = tid & 7, n = tid >> 3;
      if (n < nvalid) { const LAS float* s = tile + (k8 * 8) * 65 + n;
          u32x4 o; o.x = cvt_pk_bf16(s[0], s[65]); o.y = cvt_pk_bf16(s[2 * 65], s[3 * 65]); o.z = cvt_pk_bf16(s[4 * 65], s[5 * 65]); o.w = cvt_pk_bf16(s[6 * 65], s[7 * 65]);
          *(u32x4*)(dst + (size_t)(drow0 + n) * ldk + kd0 + k8 * 8) = o; } }
    __syncthreads();
}
__device__ __forceinline__ void phase_wprep(CP p, unsigned char* lds, int bid, int nb) {
    LAS float* tile = (LAS float*)(LAS unsigned char*)lds;
    constexpr int I_IN = 16 * 41, I_OUT = 256, I_G = 1024, I_U = 1024, I_D = 1024, I_L = I_IN + I_OUT + I_G + I_U + I_D;
    for (int it = bid; it < 2 * I_L; it += nb) {
        const int l = it / I_L; int r = it - l * I_L;
        if (r < I_IN) { const int kt = r / 41, ntl = r % 41; const int n0 = ntl * 64; const int nv = (DIN - n0) < 64 ? (DIN - n0) : 64;
            tr_tile(p->w_in + (size_t)l * 1024 * DIN, DIN, kt * 64, n0, nv, (bf16_t*)(p->ws + WS_WTIN) + (size_t)l * DIN * 1024, 1024, n0, tile); continue; }
        r -= I_IN;
        if (r < I_OUT) { const int kt = r >> 4, ntl = r & 15;
            tr_tile(p->w_out + (size_t)l * 1024 * 1024, 1024, kt * 64, ntl * 64, 64, (bf16_t*)(p->ws + WS_WTOUT) + (size_t)l * 1024 * 1024, 1024, ntl * 64, tile,
                    (kt * 64 + 512) & 1023, kt >= 8 ? p->ssd_norm_g + l * 512 + (kt * 64 - 512) : nullptr); continue; }
        r -= I_OUT;
        if (r < I_G + I_U) { const int up = r >= I_G; if (up) r -= I_G; const int e = r >> 6, q = r & 63, kt = q >> 2, ntl = q & 3; const int n0 = ntl * 64;
            const float* src = (up ? p->w_up : p->w_gate) + (size_t)(l * 16 + e) * 1024 * 256;
            tr_tile(src, 256, kt * 64, n0, 64, (bf16_t*)(p->ws + WS_WTGU) + (size_t)(l * 16 + e) * 512 * 1024, 1024, (n0 >> 7) * 256 + (n0 & 127) + (up ? 128 : 0), tile); continue; }
        r -= I_G + I_U;
        { const int e = r >> 6, q = r & 63, kt = q >> 4, ntl = q & 15;
          tr_tile(p->w_down + (size_t)(l * 16 + e) * 256 * 1024, 1024, kt * 64, ntl * 64, 64, (bf16_t*)(p->ws + WS_WTD) + (size_t)(l * 16 + e) * 1024 * 256, 256, ntl * 64, tile); }
    }
}
__device__ __forceinline__ void phase_adaln(CP p, unsigned char* lds, int bid, int nb) {
    LAS float* sc = (LAS float*)(LAS unsigned char*)lds;
    LAS float* red = sc + 3 * 1024;
    const int tid = launder_tid();
    for (int idx = tid; idx < 3 * 1024; idx += NTHREADS) { const int v = idx >> 10, k = idx & 1023; const float cv = (v < 2) ? p->c[v * 1024 + k] : p->c_ctx[k]; sc[idx] = siluf_(cv); }
    __syncthreads();
    float* mod = (float*)(p->ws + WS_MOD);
    for (int it = bid; it < 2 * 96; it += nb) {
        const int l = it / 96, n0 = (it % 96) * 64;
        const int c4 = tid & 15, kr = tid >> 4;
        f32x4 a0 = {0, 0, 0, 0}, a1 = {0, 0, 0, 0}, a2 = {0, 0, 0, 0};
        const float* w = p->w_ada + (size_t)l * 1024 * 6144 + n0 + c4 * 4;
#pragma unroll 4
        for (int k = kr; k < 1024; k += 32) { const f32x4 w4 = *(const f32x4*)(w + (size_t)k * 6144); a0 += sc[k] * w4; a1 += sc[1024 + k] * w4; a2 += sc[2048 + k] * w4; }
        *(LAS f32x4*)(red + (kr * 3 + 0) * 64 + c4 * 4) = a0; *(LAS f32x4*)(red + (kr * 3 + 1) * 64 + c4 * 4) = a1; *(LAS f32x4*)(red + (kr * 3 + 2) * 64 + c4 * 4) = a2;
        __syncthreads();
        if (tid < 192) { const int v = tid >> 6, cc = tid & 63; float s = 0.f;
            for (int q = 0; q < 32; ++q) s += red[(q * 3 + v) * 64 + cc];
            mod[((size_t)l * 3 + v) * 6144 + n0 + cc] = s + p->b_ada[l * 6144 + n0 + cc]; }
        __syncthreads();
    }
}
__device__ __forceinline__ void moe_table(CP p, int l, LAS int* tab) {
    const int* gcount = (const int*)(p->ws + WS_CTL) + l * 32;
    if (threadIdx.x == 0) { int acc = 0; for (int q = 0; q < NCLS; ++q) { const int cn = gcount[q]; tab[q] = acc; tab[32 + q] = cn; acc += (cn + 255) >> 8; } tab[24] = acc; }
    __syncthreads();
}
__device__ __forceinline__ void moe_yload(CP p, int pos, int lane, const LAS int* tab, u32x2 (&yv)[4]) {
    const int slot = tab[pos >> 16] * 256 + (pos & 0xffff);
    const bf16_t* y = (const bf16_t*)(p->ws + WS_Y) + (size_t)slot * 1024;
#pragma unroll
    for (int j = 0; j < 4; ++j) yv[j] = *(const u32x2*)(y + 4 * lane + 256 * j);
}
__device__ __forceinline__ void moe_yadd(CP p, int lm, int v, int lane, const u32x2 (&yv)[4], f32x4 (&xv)[4]) {
    const float* gate = (const float*)(p->ws + WS_MOD) + ((size_t)lm * 3 + v) * 6144 + 5 * 1024;
#pragma unroll
    for (int j = 0; j < 4; ++j) { const int k = 4 * lane + 256 * j; const f32x4 g4 = *(const f32x4*)(gate + k);
        xv[j][0] += g4[0] * bflo(yv[j].x); xv[j][1] += g4[1] * bfhi(yv[j].x); xv[j][2] += g4[2] * bflo(yv[j].y); xv[j][3] += g4[3] * bfhi(yv[j].y); }
}
__device__ __forceinline__ void phase_r1(CP p, int l, unsigned char* lds, int bid, int nb) {
    LAS float* wdt = (LAS float*)(LAS unsigned char*)lds;
    LAS float* gm = wdt + 16 * 1024;
    LAS float* sh = gm + 3 * 1024;
    const int tid = launder_tid(); const int lane = tid & 63, wave = tid >> 6;
    const float* mod = (const float*)(p->ws + WS_MOD) + (size_t)l * 3 * 6144;
    const float* win = p->w_in + (size_t)l * 1024 * DIN;
#pragma unroll
    for (int hb = 0; hb < 2; ++hb) { float tmp[16];
#pragma unroll
        for (int it = 0; it < 16; ++it) { const int idx = tid + NTHREADS * (16 * hb + it); tmp[it] = win[(size_t)(idx >> 4) * DIN + NPROJ + (idx & 15)]; }
#pragma unroll
        for (int it = 0; it < 16; ++it) { const int idx = tid + NTHREADS * (16 * hb + it); wdt[(idx & 15) * 1024 + (idx >> 4)] = tmp[it]; } }
    { float t0[6], t1[6], t2[6];
#pragma unroll
      for (int it = 0; it < 6; ++it) { const int idx = tid + NTHREADS * it; const int v = idx >> 10, k = idx & 1023; t0[it] = p->g_mix[l * 1024 + k]; t1[it] = mod[v * 6144 + 1024 + k]; t2[it] = mod[v * 6144 + k]; }
#pragma unroll
      for (int it = 0; it < 6; ++it) { const int idx = tid + NTHREADS * it; gm[idx] = t0[it] * (1.f + t1[it]); sh[idx] = t2[it]; } }
    LAS int* tab = (LAS int*)((LAS unsigned char*)lds + MISC_OFF);
    if (l > 0) moe_table(p, l - 1, tab);
    __syncthreads();
    bf16_t* HX = (bf16_t*)(p->ws + WS_HX); float* DT = (float*)(p->ws + WS_DT);
    const int* POS = (const int*)(p->ws + WS_POS) + (size_t)(l > 0 ? l - 1 : 0) * R;
    const int rstep = nb * 8;
    f32x4 xn[4]; u32x2 yn[4]; int posn = 0;
    { const int r = bid * 8 + wave;
      if (r < R) { const f32x4* hr = (const f32x4*)hin_ptr(p, l, r);
#pragma unroll
          for (int j = 0; j < 4; ++j) xn[j] = hr[lane + 64 * j];
          if (l > 0) { moe_yload(p, POS[r], lane, tab, yn); if (r + rstep < R) posn = POS[r + rstep]; } } }
    for (int r = bid * 8 + wave; r < R; r += rstep) {
        const int v = row_v(r);
        f32x4 xv[4]; u32x2 yv[4]; float ss = 0.f;
#pragma unroll
        for (int j = 0; j < 4; ++j) { xv[j] = xn[j]; yv[j] = yn[j]; }
        { const int rn = r + rstep;
          if (rn < R) { const f32x4* hr = (const f32x4*)hin_ptr(p, l, rn);
#pragma unroll
              for (int j = 0; j < 4; ++j) xn[j] = hr[lane + 64 * j];
              if (l > 0) { moe_yload(p, posn, lane, tab, yn); if (rn + rstep < R) posn = POS[rn + rstep]; } } }
        if (l > 0) { moe_yadd(p, l - 1, v, lane, yv, xv); f32x4* hw = (f32x4*)hptr(p, r);
#pragma unroll
            for (int j = 0; j < 4; ++j) hw[lane + 64 * j] = xv[j]; }
#pragma unroll
        for (int j = 0; j < 4; ++j) ss += xv[j][0] * xv[j][0] + xv[j][1] * xv[j][1] + xv[j][2] * xv[j][2] + xv[j][3] * xv[j][3];
        ss = wave_sum(ss); const float rs = rsqrtf(ss * (1.f / 1024.f) + 1e-6f);
#pragma unroll
        for (int j = 0; j < 4; ++j) { const int k = 4 * lane + 256 * j; const f32x4 g4 = *(const LAS f32x4*)(gm + v * 1024 + k), s4 = *(const LAS f32x4*)(sh + v * 1024 + k);
            xv[j] = xv[j] * rs * g4 + s4;
            u32x2 o; o.x = cvt_pk_bf16(xv[j][0], xv[j][1]); o.y = cvt_pk_bf16(xv[j][2], xv[j][3]);
            *(u32x2*)(HX + (size_t)r * 1024 + k) = o; }
        float mine = 0.f;
#pragma unroll
        for (int n = 0; n < 16; ++n) { float a = 0.f;
#pragma unroll
            for (int j = 0; j < 4; ++j) { const f32x4 w4 = *(const LAS f32x4*)(wdt + n * 1024 + 4 * lane + 256 * j); a += xv[j][0] * w4[0] + xv[j][1] * w4[1] + xv[j][2] * w4[2] + xv[j][3] * w4[3]; }
            a = wave_sum(a); mine = (lane == n) ? a : mine; }
        if (lane < 16) DT[(size_t)r * 16 + lane] = softplusf_(mine + p->dt_bias[l * 16 + lane]);
    }
}
typedef float f32x16 __attribute__((ext_vector_type(16)));
typedef short s16x4 __attribute__((ext_vector_type(4)));
constexpr int ST_ROW = 272;
constexpr int ST_TR128 = 320;
constexpr int ST_TR64 = 192;
constexpr int NCHUNK = SEG / 128;

#define DPP_MOV(v, ctrl, rm, bm) __builtin_bit_cast(float, __builtin_amdgcn_update_dpp(0, __builtin_bit_cast(int, (v)), (ctrl), (rm), (bm), true))
__device__ __forceinline__ float wave_incl_scan(float v, int) {
    float s = v + DPP_MOV(v, 0x111, 0xF, 0xF) + DPP_MOV(v, 0x112, 0xF, 0xF) + DPP_MOV(v, 0x113, 0xF, 0xF);
    s += DPP_MOV(s, 0x114, 0xF, 0xE);
    s += DPP_MOV(s, 0x118, 0xF, 0xC);
    s += DPP_MOV(s, 0x142, 0xA, 0xF);
    s += DPP_MOV(s, 0x143, 0xC, 0xF);
    return s;
}
__device__ __forceinline__ bf16x8 row_frag(const LAS unsigned char* tile, int stride, int row0, int k0, int lane) {
    return *(const LAS bf16x8*)(tile + (row0 + (lane & 31)) * stride + (k0 + 8 * (lane >> 5)) * 2);
}
__device__ __forceinline__ bf16x8 tr_frag(const LAS unsigned char* tile, int stride, int k0, int c0, int lane) {
    const int g = lane >> 4, li = lane & 15, q = li >> 2, pp = li & 3;
    const LAS unsigned char* a0 = tile + (k0 + 8 * (g >> 1) + q) * stride + (c0 + 16 * (g & 1) + 4 * pp) * 2;
    const s16x4 lo = __builtin_amdgcn_ds_read_tr16_b64_v4i16((LAS s16x4*)a0);
    const s16x4 hi = __builtin_amdgcn_ds_read_tr16_b64_v4i16((LAS s16x4*)(a0 + 4 * stride));
    return __builtin_shufflevector(lo, hi, 0, 1, 2, 3, 4, 5, 6, 7);
}
__device__ __forceinline__ u32x4 pack8(const float (&v)[8]) { u32x4 r; r.x = cvt_pk_bf16(v[0], v[1]); r.y = cvt_pk_bf16(v[2], v[3]); r.z = cvt_pk_bf16(v[4], v[5]); r.w = cvt_pk_bf16(v[6], v[7]); return r; }
__device__ __forceinline__ u32x4 pack8s(const float (&v)[8], float sc) { u32x4 r; r.x = cvt_pk_bf16(v[0] * sc, v[1] * sc); r.y = cvt_pk_bf16(v[2] * sc, v[3] * sc); r.z = cvt_pk_bf16(v[4] * sc, v[5] * sc); r.w = cvt_pk_bf16(v[6] * sc, v[7] * sc); return r; }

__device__ __forceinline__ void conv_load(const bf16_t* proj, int row0, int rq, int xch, bool lo_ok, bool hi_ok, u32x4 (&raw)[8]) {
    const bf16_t* base = proj + (size_t)(row0 + 4 * rq) * NPROJ + 1536 + xch;
    unsigned zz; asm volatile("v_mov_b32 %0, 0" : "=v"(zz));
#pragma unroll
    for (int j = 0; j < 8; ++j) {
        if (j < 2) { const bool ok = (rq > 0) || lo_ok; const u32x4 v = *(const u32x4*)(ok ? base + (j - 2) * NPROJ : base);
            raw[j].x = ok ? v.x : zz; raw[j].y = ok ? v.y : zz; raw[j].z = ok ? v.z : zz; raw[j].w = ok ? v.w : zz; }
        else if (j >= 6) { const bool ok = (rq < 31) || hi_ok; const u32x4 v = *(const u32x4*)(ok ? base + (j - 2) * NPROJ : base);
            raw[j].x = ok ? v.x : zz; raw[j].y = ok ? v.y : zz; raw[j].z = ok ? v.z : zz; raw[j].w = ok ? v.w : zz; }
        else raw[j] = *(const u32x4*)(base + (j - 2) * NPROJ);
    }
}
__device__ __forceinline__ void conv_compute(const u32x4 (&raw)[8], const LAS float* wl, int nchl, int wch, float (&o)[4][8]) {
    float w[5][8], bs[8];
#pragma unroll
    for (int j = 0; j < 5; ++j) { const f32x4 w0 = *(const LAS f32x4*)(wl + j * nchl + wch), w1 = *(const LAS f32x4*)(wl + j * nchl + wch + 4);
        w[j][0] = w0[0]; w[j][1] = w0[1]; w[j][2] = w0[2]; w[j][3] = w0[3]; w[j][4] = w1[0]; w[j][5] = w1[1]; w[j][6] = w1[2]; w[j][7] = w1[3]; }
    { const f32x4 b0 = *(const LAS f32x4*)(wl + 5 * nchl + wch), b1 = *(const LAS f32x4*)(wl + 5 * nchl + wch + 4); bs[0] = b0[0]; bs[1] = b0[1]; bs[2] = b0[2]; bs[3] = b0[3]; bs[4] = b1[0]; bs[5] = b1[1]; bs[6] = b1[2]; bs[7] = b1[3]; }
#pragma unroll
    for (int i = 0; i < 4; ++i)
#pragma unroll
        for (int e = 0; e < 8; ++e) o[i][e] = bs[e];
#pragma unroll
    for (int j = 0; j < 8; ++j) {
        float xv[8] = {bflo(raw[j].x), bfhi(raw[j].x), bflo(raw[j].y), bfhi(raw[j].y), bflo(raw[j].z), bfhi(raw[j].z), bflo(raw[j].w), bfhi(raw[j].w)};
#pragma unroll
        for (int i = 0; i < 4; ++i) { const int tap = j - i; if (tap >= 0 && tap < 5) {
#pragma unroll
                for (int e = 0; e < 8; ++e) o[i][e] += w[tap][e] * xv[e]; } }
    }
#pragma unroll
    for (int i = 0; i < 4; ++i)
#pragma unroll
        for (int e = 0; e < 8; ++e) o[i][e] = siluf_(o[i][e]);
}
__device__ __forceinline__ void head_cums(CP p, int l, int row0, int h, int dir, int lane, LAS float* hv) {
    const float A = -expf(p->a_log[l * 16 + dir * 8 + h]);
    const float* DT = (const float*)(p->ws + WS_DT);
    const float d0 = DT[(size_t)(row0 + 2 * lane) * 16 + dir * 8 + h], d1 = DT[(size_t)(row0 + 2 * lane + 1) * 16 + dir * 8 + h];
    const float x0 = d0 * A, x1 = d1 * A;
    const float incl = wave_incl_scan(x0 + x1, lane);
    const float total = __builtin_bit_cast(float, __builtin_amdgcn_readlane(__builtin_bit_cast(int, incl), 63));
    float c0, c1;
    if (dir == 0) { c1 = incl; c0 = incl - x1; } else { c0 = total - (incl - x1 - x0); c1 = total - (incl - x1); }
    hv[dir * 128 + 2 * lane] = c0; hv[dir * 128 + 2 * lane + 1] = c1;
    hv[256 + dir * 128 + 2 * lane] = d0; hv[256 + dir * 128 + 2 * lane + 1] = d1;
    if (lane == 0) hv[512 + dir] = total;
}
__device__ __forceinline__ bf16x8 scale_frag(bf16x8 f, const f32x4 w0, const f32x4 w1) {
    const u32x4 u = __builtin_bit_cast(u32x4, f);
    u32x4 r;
    r.x = cvt_pk_bf16(bflo(u.x) * w0[0], bfhi(u.x) * w0[1]); r.y = cvt_pk_bf16(bflo(u.y) * w0[2], bfhi(u.y) * w0[3]);
    r.z = cvt_pk_bf16(bflo(u.z) * w1[0], bfhi(u.z) * w1[1]); r.w = cvt_pk_bf16(bflo(u.w) * w1[2], bfhi(u.w) * w1[3]);
    return __builtin_bit_cast(bf16x8, r);
}
constexpr int ST_X256 = 576;

__device__ __forceinline__ void phase_c1(CP p, int l, unsigned char* lds_, int bid, int nb) {
    LAS unsigned char* lds = (LAS unsigned char*)lds_;
    LAS unsigned char* tile = lds;
    LAS float* wl = (LAS float*)(lds + 73216);
    const int tid = launder_tid();
    const bf16_t* proj = (const bf16_t*)(p->ws + WS_PROJ); bf16_t* mix = (bf16_t*)(p->ws + WS_HX);
#pragma unroll 1
    for (int u = bid; u < 256 + 512 + (l == DEPTH - 1 ? 0 : 16); u += nb) {
        int S, LEN, pstride, sstride, tok0, ch0;
        if (u < 256) { const int b = u >> 7, cs = (u >> 2) & 31, cc = u & 3; S = 2; LEN = 256; pstride = 64; sstride = 1; tok0 = b * SEG + CTXL + 2 * cs; ch0 = 256 + 64 * cc; }
        else if (u < 768) { const int v = u - 256; const int b = v >> 8, rg = (v >> 2) & 63, cc = v & 3; S = 4; LEN = 64; pstride = 1; sstride = 64; tok0 = b * SEG + CTXL + 256 * rg; ch0 = 64 * cc; }
        else { const int v = u - 768; const int b = v >> 3, cc = v & 7; S = 1; LEN = 256; pstride = 1; sstride = 0; tok0 = b * SEG; ch0 = 64 * cc; }
        const int LP = LEN + 30;
        { float tw[4];
#pragma unroll
          for (int it = 0; it < 4; ++it) { const int i = tid + NTHREADS * it; const int j = i >> 6, c = i & 63; tw[it] = j < 31 ? p->conv_w[((size_t)l * 31 + j) * 512 + ch0 + c] : p->conv_b[l * 512 + ch0 + c]; }
#pragma unroll
          for (int it = 0; it < 4; ++it) wl[tid + NTHREADS * it] = tw[it]; }
        for (int i = tid; i < S * 30 * 8; i += NTHREADS) { const int pc = i & 7, q = (i >> 3) % 30, sq = (i >> 3) / 30; const int pos = q < 15 ? q : LEN + q;
            unsigned zz; asm volatile("v_mov_b32 %0, 0" : "=v"(zz));
            *(LAS u32x4*)(tile + ((sq * LP + pos) * 64 + pc * 8) * 2) = (u32x4){zz, zz, zz, zz}; }
#pragma unroll 4
        for (int i = tid; i < S * LEN * 8; i += NTHREADS) { const int pc = i & 7, t = i >> 3; const int sq = t / LEN, pos = t - sq * LEN;
            const bf16_t* src = proj + (size_t)(tok0 + sq * sstride + pos * pstride) * NPROJ + ch0 + pc * 8;
            const u32x4 uv = *(const u32x4*)src, gv = *(const u32x4*)(src + 512);
            u32x4 o;
            o.x = cvt_pk_bf16(bflo(uv.x) * sigmoidf_(bflo(gv.x)), bfhi(uv.x) * sigmoidf_(bfhi(gv.x)));
            o.y = cvt_pk_bf16(bflo(uv.y) * sigmoidf_(bflo(gv.y)), bfhi(uv.y) * sigmoidf_(bfhi(gv.y)));
            o.z = cvt_pk_bf16(bflo(uv.z) * sigmoidf_(bflo(gv.z)), bfhi(uv.z) * sigmoidf_(bfhi(gv.z)));
            o.w = cvt_pk_bf16(bflo(uv.w) * sigmoidf_(bflo(gv.w)), bfhi(uv.w) * sigmoidf_(bfhi(gv.w)));
            *(LAS u32x4*)(tile + ((sq * LP + 15 + pos) * 64 + pc * 8) * 2) = o; }
        __syncthreads();
        const int noct = S * LEN / 8;
#pragma unroll 1
        for (int it = tid; it < noct * 32; it += NTHREADS) {
            const int cp = it & 31, oc = it >> 5; const int sq = oc / (LEN / 8), p0 = (oc - sq * (LEN / 8)) * 8;
            const LAS unsigned* base = (const LAS unsigned*)(tile + ((sq * LP + p0) * 64) * 2) + cp;
            float i0[38], i1[38];
#pragma unroll
            for (int k = 0; k < 38; ++k) { const unsigned w = base[k * 32]; i0[k] = bflo(w); i1[k] = bfhi(w); }
            float a0[8], a1[8];
            { const float b0 = wl[31 * 64 + 2 * cp], b1 = wl[31 * 64 + 2 * cp + 1];
#pragma unroll
              for (int i = 0; i < 8; ++i) { a0[i] = b0; a1[i] = b1; } }
#pragma unroll
            for (int j = 0; j < 31; ++j) { typedef float f32x2 __attribute__((ext_vector_type(2))); const f32x2 wj = *(const LAS f32x2*)(wl + j * 64 + 2 * cp); const float w0 = wj[0], w1 = wj[1];
#pragma unroll
                for (int i = 0; i < 8; ++i) { a0[i] += w0 * i0[i + j]; a1[i] += w1 * i1[i + j]; } }
#pragma unroll
            for (int i = 0; i < 8; ++i) { const int tok = tok0 + sq * sstride + (p0 + i) * pstride;
                *(unsigned*)(mix + (size_t)tok * 1024 + 512 + ch0 + 2 * cp) = cvt_pk_bf16(a0[i], a1[i]); }
        }
        __syncthreads();
    }
}
__device__ __forceinline__ void phase_c1_ln(CP p, int l, int bid, int nb) {
    const int tid = launder_tid(); const int lane = tid & 63, wave = tid >> 6;
    bf16_t* mix = (bf16_t*)(p->ws + WS_HX);
    const f32x4 g0 = *(const f32x4*)(p->conv_ln_g + l * 512 + lane * 8), g1 = *(const f32x4*)(p->conv_ln_g + l * 512 + lane * 8 + 4);
    const f32x4 b0 = *(const f32x4*)(p->conv_ln_b + l * 512 + lane * 8), b1 = *(const f32x4*)(p->conv_ln_b + l * 512 + lane * 8 + 4);
    const float gg[8] = {g0[0], g0[1], g0[2], g0[3], g1[0], g1[1], g1[2], g1[3]}, bb[8] = {b0[0], b0[1], b0[2], b0[3], b1[0], b1[1], b1[2], b1[3]};
    for (int r = bid * 8 + wave; r < R; r += nb * 8) {
        u32x4* ptr = (u32x4*)(mix + (size_t)r * 1024 + 512 + lane * 8);
        const u32x4 v = *ptr;
        float y[8] = {bflo(v.x), bfhi(v.x), bflo(v.y), bfhi(v.y), bflo(v.z), bfhi(v.z), bflo(v.w), bfhi(v.w)};
        float s = 0.f;
#pragma unroll
        for (int e = 0; e < 8; ++e) s += y[e];
        const float mu = wave_sum(s) * (1.f / 512.f);
        float q = 0.f;
#pragma unroll
        for (int e = 0; e < 8; ++e) { y[e] -= mu; q += y[e] * y[e]; }
        const float rstd = rsqrtf(wave_sum(q) * (1.f / 512.f) + 1e-5f);
        float o[8];
#pragma unroll
        for (int e = 0; e < 8; ++e) o[e] = siluf_(y[e] * rstd * gg[e] + bb[e]);
        *ptr = pack8(o);
    }
}
__device__ __forceinline__ void phase_s1(CP p, int l, unsigned char* lds_, int bid, int nb) {
    LAS unsigned char* lds = (LAS unsigned char*)lds_;
    LAS unsigned char* Bs = lds;
    LAS unsigned char* Xs = lds + 128 * ST_TR128;
    LAS float* wv = (LAS float*)(Xs + 128 * ST_X256);
    LAS float* hvs = wv + 8 * 128;
    LAS float* cwl = hvs + 4 * 520;
    const int tid = launder_tid(); const int lane = tid & 63, wave = __builtin_amdgcn_readfirstlane(tid >> 6);
    const bf16_t* proj = (const bf16_t*)(p->ws + WS_PROJ);
    const float* cw = p->ssd_conv_w + (size_t)l * 5 * 1024; const float* cbias = p->ssd_conv_b + (size_t)l * 1024;
    bf16_t* Sg = (bf16_t*)(p->ws + WS_S); float* DEC = (float*)(p->ws + WS_DEC);
    int cur_g = -1;
#pragma unroll 1
    for (int u = bid; u < NB * NCHUNK * 2; u += nb) {
        const int g = u & 1, c = (u >> 1) % NCHUNK, b = (u >> 1) / NCHUNK;
        const int row0 = b * SEG + c * 128;
        const bool lo_ok = !(c == 0 || c == 2), hi_ok = !(c == 1 || c == NCHUNK - 1);
        if (g != cur_g) { cur_g = g;
            float tw[5];
#pragma unroll
            for (int it = 0; it < 5; ++it) { const int i = tid + NTHREADS * it; const int j = i / 384, lc = i - j * 384; const int gch = lc < 128 ? 512 + g * 128 + lc : g * 256 + (lc - 128);
                tw[it] = i < 6 * 384 ? (j < 5 ? cw[j * 1024 + gch] : cbias[gch]) : 0.f; }
#pragma unroll
            for (int it = 0; it < 5; ++it) { const int i = tid + NTHREADS * it; if (i < 6 * 384) cwl[i] = tw[it]; } }
        const int hh = wave >> 1, dir = wave & 1, h = 4 * g + hh;
        u32x4 rb[8], rx0[8], rx1[8];
        conv_load(proj, row0, tid >> 4, 512 + g * 128 + (tid & 15) * 8, lo_ok, hi_ok, rb);
        conv_load(proj, row0, tid >> 5, g * 256 + (tid & 31) * 8, lo_ok, hi_ok, rx0);
        conv_load(proj, row0, (tid >> 5) + 16, g * 256 + (tid & 31) * 8, lo_ok, hi_ok, rx1);
        head_cums(p, l, row0, h, dir, lane, hvs + hh * 520);
        __syncthreads();
        {
            const LAS float* hv = hvs + hh * 520; const float tot = hv[512 + dir];
#pragma unroll
            for (int q = 0; q < 2; ++q) { const int lr = lane + 64 * q; wv[wave * 128 + lr] = __expf(tot - hv[dir * 128 + lr]) * hv[256 + dir * 128 + lr]; }
            if (lane == 0) DEC[((size_t)(b * 2 + dir) * NCHUNK + c) * 8 + h] = __expf(tot);
        }
        { float o[4][8];
          conv_compute(rb, cwl, 384, (tid & 15) * 8, o);
#pragma unroll
          for (int i = 0; i < 4; ++i) *(LAS u32x4*)(Bs + (4 * (tid >> 4) + i) * ST_TR128 + (tid & 15) * 16) = pack8(o[i]);
          conv_compute(rx0, cwl, 384, 128 + (tid & 31) * 8, o);
#pragma unroll
          for (int i = 0; i < 4; ++i) *(LAS u32x4*)(Xs + (4 * (tid >> 5) + i) * ST_X256 + (tid & 31) * 16) = pack8(o[i]);
          conv_compute(rx1, cwl, 384, 128 + (tid & 31) * 8, o);
#pragma unroll
          for (int i = 0; i < 4; ++i) *(LAS u32x4*)(Xs + (4 * ((tid >> 5) + 16) + i) * ST_X256 + (tid & 31) * 16) = pack8(o[i]); }
        __syncthreads();
        {
            f32x16 acc[2][4];
#pragma unroll
            for (int t = 0; t < 2; ++t)
#pragma unroll
                for (int q = 0; q < 4; ++q)
#pragma unroll
                    for (int e = 0; e < 16; ++e) acc[t][q][e] = 0.f;
#pragma unroll 2
            for (int kk = 0; kk < 8; ++kk) {
                const LAS float* wp = wv + wave * 128 + 16 * kk + 8 * (lane >> 5);
                const f32x4 w0 = *(const LAS f32x4*)wp, w1 = *(const LAS f32x4*)(wp + 4);
                bf16x8 af[2];
#pragma unroll
                for (int t = 0; t < 2; ++t) af[t] = scale_frag(tr_frag(Xs, ST_X256, 16 * kk, hh * 64 + 32 * t, lane), w0, w1);
#pragma unroll
                for (int q = 0; q < 4; ++q) { const bf16x8 bf = tr_frag(Bs, ST_TR128, 16 * kk, 32 * q, lane);
#pragma unroll
                    for (int t = 0; t < 2; ++t) acc[t][q] = __builtin_amdgcn_mfma_f32_32x32x16_bf16(bf, af[t], acc[t][q], 0, 0, 0); }
            }
            bf16_t* So = Sg + ((size_t)((b * 2 + dir) * NCHUNK + c) * 8 + h) * 8192 + (size_t)(lane & 31) * 128 + 4 * (lane >> 5);
#pragma unroll
            for (int t = 0; t < 2; ++t)
#pragma unroll
                for (int q = 0; q < 4; ++q)
#pragma unroll
                    for (int rg = 0; rg < 4; ++rg) { u32x2 pk; pk.x = cvt_pk_bf16(acc[t][q][4 * rg], acc[t][q][4 * rg + 1]); pk.y = cvt_pk_bf16(acc[t][q][4 * rg + 2], acc[t][q][4 * rg + 3]);
                        *(u32x2*)(So + (size_t)(32 * t) * 128 + 32 * q + 8 * rg) = pk; }
        }
        __syncthreads();
    }
}
__device__ __forceinline__ void phase_s2(CP p, int bid, int nb) {
    const int tid = launder_tid();
    const bf16_t* Sg = (const bf16_t*)(p->ws + WS_S); const float* DEC = (const float*)(p->ws + WS_DEC); bf16_t* HP = (bf16_t*)(p->ws + WS_HP);
    for (int idx = bid * NTHREADS + tid; idx < 2 * 2 * 8 * 64 * 64; idx += nb * NTHREADS) {
        const int n2 = idx & 63, pr = (idx >> 6) & 63, h = (idx >> 12) & 7, dir = (idx >> 15) & 1, b = idx >> 16;
        const size_t inner = (size_t)h * 8192 + pr * 128 + 2 * n2;
        const size_t cbase = (size_t)(b * 2 + dir) * NCHUNK;
        float s0 = 0.f, s1 = 0.f;
#pragma unroll 10
        for (int step = 0; step < NCHUNK; ++step) {
            const int c = dir == 0 ? step : (step < 2 ? 1 - step : NCHUNK + 1 - step);
            const size_t off = (cbase + c) * 65536 + inner;
            const unsigned sv = *(const unsigned*)(Sg + off); const float d = DEC[(cbase + c) * 8 + h];
            *(unsigned*)(HP + off) = cvt_pk_bf16(s0, s1);
            s0 = s0 * d + bflo(sv); s1 = s1 * d + bfhi(sv);
        }
    }
}
__device__ __forceinline__ void phase_s3(CP p, int l, unsigned char* lds_, int bid, int nb) {
    LAS unsigned char* lds = (LAS unsigned char*)lds_;
    LAS unsigned char* Cs = lds;
    LAS unsigned char* Bs = Cs + 128 * ST_ROW;
    LAS unsigned char* Mt = Bs;
    LAS unsigned char* Xs = Bs + 128 * ST_TR128;
    LAS unsigned char* Hf = Xs + 128 * ST_TR64;
    LAS unsigned char* Hb = Hf + 64 * ST_ROW;
    LAS float* hvs = (LAS float*)(Hb + 64 * ST_ROW);
    LAS float* ssqp = hvs + 4 * 520;
    LAS float* cwl = ssqp + 256;
    const int tid0 = launder_tid(); const int wave = __builtin_amdgcn_readfirstlane(tid0 >> 6);
    const bf16_t* proj = (const bf16_t*)(p->ws + WS_PROJ); bf16_t* mix = (bf16_t*)(p->ws + WS_HX);
    const float* cw = p->ssd_conv_w + (size_t)l * 5 * 1024; const float* cbias = p->ssd_conv_b + (size_t)l * 1024;
    const bf16_t* HP = (const bf16_t*)(p->ws + WS_HP); float* SSQ = (float*)(p->ws + WS_SSQ);
    int cur_g = -1;
#pragma unroll 1
    for (int u = bid; u < NB * NCHUNK * 2; u += nb) {
        const int g = u & 1, c = (u >> 1) % NCHUNK, b = (u >> 1) / NCHUNK;
        if (l == DEPTH - 1 && c < 2) continue;
        int tid = tid0; asm volatile("" : "+v"(tid));
        const int lane = tid & 63;
        const int row0 = b * SEG + c * 128;
        const bool lo_ok = !(c == 0 || c == 2), hi_ok = !(c == 1 || c == NCHUNK - 1);
        if (g != cur_g) { cur_g = g;
            float tw[6];
#pragma unroll
            for (int it = 0; it < 6; ++it) { const int i = tid + NTHREADS * it; const int j = i >> 9, lc = i & 511; const int gch = lc < 128 ? 768 + g * 128 + lc : (lc < 256 ? 512 + g * 128 + (lc - 128) : g * 256 + (lc - 256));
                tw[it] = j < 5 ? cw[j * 1024 + gch] : cbias[gch]; }
#pragma unroll
            for (int it = 0; it < 6; ++it) cwl[tid + NTHREADS * it] = tw[it]; }
        u32x4 rx[8];
        {
            u32x4 r0[8], r1[8];
            const int cg = tid & 31; const int gch = (cg < 16 ? 768 : 512) + g * 128 + (cg & 15) * 8;
            conv_load(proj, row0, tid >> 5, gch, lo_ok, hi_ok, r0);
            conv_load(proj, row0, (tid >> 5) + 16, gch, lo_ok, hi_ok, r1);
            head_cums(p, l, row0, 4 * g + (wave >> 1), wave & 1, lane, hvs + (wave >> 1) * 520);
            __syncthreads();
            float o[4][8];
            LAS unsigned char* dst = (cg < 16 ? Cs : Bs) + (cg & 15) * 16;
            conv_compute(r0, cwl, 512, cg * 8, o);
#pragma unroll
            for (int i = 0; i < 4; ++i) *(LAS u32x4*)(dst + (4 * (tid >> 5) + i) * ST_ROW) = pack8(o[i]);
            asm volatile("" ::: "memory");
            if (tid < 256) conv_load(proj, row0, tid >> 3, g * 256 + (tid & 7) * 8, lo_ok, hi_ok, rx);
            conv_compute(r1, cwl, 512, cg * 8, o);
#pragma unroll
            for (int i = 0; i < 4; ++i) *(LAS u32x4*)(dst + (4 * ((tid >> 5) + 16) + i) * ST_ROW) = pack8(o[i]);
            if (tid < 256) { conv_compute(rx, cwl, 512, 256 + (tid & 7) * 8, o);
#pragma unroll
                for (int i = 0; i < 4; ++i) *(LAS u32x4*)(Xs + (4 * (tid >> 3) + i) * ST_TR64 + (tid & 7) * 16) = pack8(o[i]); }
        }
        __syncthreads();
        const int lb = wave >> 1, hs = wave & 1;
        int ln = lane; asm volatile("" : "+v"(ln));
        f32x16 gacc[2];
#pragma unroll
        for (int t = 0; t < 2; ++t)
#pragma unroll
            for (int e = 0; e < 16; ++e) gacc[t][e] = 0.f;
#pragma unroll
        for (int kk = 0; kk < 8; ++kk) { const bf16x8 af = row_frag(Cs, ST_ROW, 32 * lb, 16 * kk, lane);
#pragma unroll
            for (int t = 0; t < 2; ++t) { const bf16x8 bf = row_frag(Bs, ST_ROW, 64 * hs + 32 * t, 16 * kk, lane);
                gacc[t] = __builtin_amdgcn_mfma_f32_32x32x16_bf16(af, bf, gacc[t], 0, 0, 0); } }
        u32x4 hreg[4];
        { const bf16_t* hp0 = HP + ((size_t)(b * 2 * NCHUNK + c) * 8 + 4 * g) * 8192;
#pragma unroll
          for (int q = 0; q < 4; ++q) { const int it = tid + 512 * q; hreg[q] = *(const u32x4*)(hp0 + (size_t)(it >> 10) * NCHUNK * 8 * 8192 + (it & 1023) * 8); } }
        __syncthreads();
#pragma unroll 1
        for (int hh = 0; hh < 4; ++hh) {
            const int h = 4 * g + hh; const LAS float* hv = hvs + hh * 520;
            asm volatile("" : "+v"(ln));
            const int ph = hs, pc = 32 * ph + (ln & 31);
#pragma unroll
            for (int t = 0; t < 2; ++t) {
                const int sc = 64 * hs + 32 * t + (ln & 31);
                const float cfs = hv[sc], cbs = hv[128 + sc], dfs = hv[256 + sc], dbs = hv[384 + sc];
#pragma unroll
                for (int rg = 0; rg < 4; ++rg) {
                    const int l0 = 32 * lb + 8 * rg + 4 * (ln >> 5);
                    const f32x4 cfl = *(const LAS f32x4*)(hv + l0), cbl = *(const LAS f32x4*)(hv + 128 + l0);
                    float m[4];
#pragma unroll
                    for (int e = 0; e < 4; ++e) { const int lr = l0 + e;
                        const float ff = lr >= sc ? __expf(cfl[e] - cfs) * dfs : 0.f;
                        const float fb = lr <= sc ? __expf(cbl[e] - cbs) * dbs : 0.f;
                        m[e] = gacc[t][4 * rg + e] * (ff + fb); }
                    u32x2 pk; pk.x = cvt_pk_bf16(m[0], m[1]); pk.y = cvt_pk_bf16(m[2], m[3]);
                    *(LAS u32x2*)(Mt + sc * ST_TR128 + l0 * 2) = pk;
                }
            }
#pragma unroll
            for (int q = 0; q < 4; ++q) { const int it = tid + 512 * q; const int q2 = it & 1023;
                *(LAS u32x4*)(((it >> 10) ? Hb : Hf) + (q2 >> 4) * ST_ROW + (q2 & 15) * 16) = hreg[q]; }
            if (hh < 3) {
                const bf16_t* hp0 = HP + ((size_t)(b * 2 * NCHUNK + c) * 8 + h + 1) * 8192;
#pragma unroll
                for (int q = 0; q < 4; ++q) { const int it = tid + 512 * q; hreg[q] = *(const u32x4*)(hp0 + (size_t)(it >> 10) * NCHUNK * 8 * 8192 + (it & 1023) * 8); }
                if (tid < 256) conv_load(proj, row0, tid >> 3, g * 256 + (hh + 1) * 64 + (tid & 7) * 8, lo_ok, hi_ok, rx);
            }
            unsigned zraw[8];
#pragma unroll
            for (int ri = 0; ri < 16; ri += 2) { const int lr = 32 * lb + 8 * (ri >> 2) + 4 * (ln >> 5) + (ri & 3);
                const bf16_t* zp = proj + (size_t)(row0 + lr) * NPROJ + 1024 + h * 64 + pc;
                zraw[ri >> 1] = (unsigned)zp[0] | ((unsigned)zp[NPROJ] << 16); }
            __syncthreads();
            f32x16 ad, af_, ab_;
#pragma unroll
            for (int e = 0; e < 16; ++e) { ad[e] = 0.f; af_[e] = 0.f; ab_[e] = 0.f; }
#pragma unroll
            for (int kk = 0; kk < 8; ++kk) {
                const bf16x8 am = tr_frag(Mt, ST_TR128, 16 * kk, 32 * lb, lane);
                const bf16x8 bx = tr_frag(Xs, ST_TR64, 16 * kk, 32 * ph, lane);
                ad = __builtin_amdgcn_mfma_f32_32x32x16_bf16(am, bx, ad, 0, 0, 0);
                const bf16x8 ac = row_frag(Cs, ST_ROW, 32 * lb, 16 * kk, lane);
                const bf16x8 bhf = row_frag(Hf, ST_ROW, 32 * ph, 16 * kk, lane);
                const bf16x8 bhb = row_frag(Hb, ST_ROW, 32 * ph, 16 * kk, lane);
                af_ = __builtin_amdgcn_mfma_f32_32x32x16_bf16(ac, bhf, af_, 0, 0, 0);
                ab_ = __builtin_amdgcn_mfma_f32_32x32x16_bf16(ac, bhb, ab_, 0, 0, 0);
            }
            const float dsk = p->d_skip[l * 8 + h];
#pragma unroll
            for (int rg = 0; rg < 4; ++rg) {
                const int l0 = 32 * lb + 8 * rg + 4 * (ln >> 5);
                const f32x4 cfl = *(const LAS f32x4*)(hv + l0), cbl = *(const LAS f32x4*)(hv + 128 + l0);
#pragma unroll
                for (int e = 0; e < 4; ++e) { const int lr = l0 + e; const int ri = 4 * rg + e;
                    const float xs = bf2f(*(const LAS bf16_t*)(Xs + lr * ST_TR64 + pc * 2));
                    const float y = ad[ri] + __expf(cfl[e]) * af_[ri] + __expf(cbl[e]) * ab_[ri] + dsk * xs;
                    const float z = (ri & 1) ? bfhi(zraw[ri >> 1]) : bflo(zraw[ri >> 1]);
                    const float val = y * siluf_(z);
                    mix[(size_t)(row0 + lr) * 1024 + h * 64 + pc] = f2bf(val);
                    const float sq = half_sum32(val * val);
                    if ((ln & 31) == 31) ssqp[ph * 128 + lr] = sq;
                }
            }
            __syncthreads();
            if (tid < 128) SSQ[(size_t)(row0 + tid) * 8 + h] = ssqp[tid] + ssqp[128 + tid];
            if (hh < 3 && tid < 256) { float o[4][8];
                conv_compute(rx, cwl, 512, 256 + (hh + 1) * 64 + (tid & 7) * 8, o);
#pragma unroll
                for (int i = 0; i < 4; ++i) *(LAS u32x4*)(Xs + (4 * (tid >> 3) + i) * ST_TR64 + (tid & 7) * 16) = pack8(o[i]); }
        }
        __syncthreads();
    }
}
__device__ __forceinline__ void phase_r2(CP p, int l, unsigned char* lds, int bid, int nb) {
    LAS float* wrt = (LAS float*)(LAS unsigned char*)lds;
    LAS float* gm = wrt + 20 * 1024;
    LAS float* sh = gm + 3 * 1024;
    LAS int* lcnt = (LAS int*)(sh + 3 * 1024);
    LAS int* lcls = lcnt + 64;
    LAS int* lrank = lcls + 1024;
    LAS float* lcwa = (LAS float*)(lrank + 1024);
    LAS float* lcwb = lcwa + 1024;
    const int tid = launder_tid(); const int lane = tid & 63, wave = tid >> 6;
    const float* mod = (const float*)(p->ws + WS_MOD) + (size_t)l * 3 * 6144;
    { float tmp[8];
#pragma unroll
      for (int it = 0; it < 8; ++it) tmp[it] = p->w_rg[(size_t)l * 4096 + tid + NTHREADS * it];
#pragma unroll
      for (int it = 0; it < 8; ++it) { const int idx = tid + NTHREADS * it; wrt[(idx & 3) * 1024 + (idx >> 2)] = tmp[it]; } }
#pragma unroll
    for (int hb = 0; hb < 2; ++hb) { float tmp[16];
#pragma unroll
        for (int it = 0; it < 16; ++it) tmp[it] = p->w_re[(size_t)l * 16384 + tid + NTHREADS * (16 * hb + it)];
#pragma unroll
        for (int it = 0; it < 16; ++it) { const int idx = tid + NTHREADS * (16 * hb + it); wrt[(4 + (idx & 15)) * 1024 + (idx >> 4)] = tmp[it]; } }
    { float t0[6], t1[6], t2[6];
#pragma unroll
      for (int it = 0; it < 6; ++it) { const int idx = tid + NTHREADS * it; const int v = idx >> 10, k = idx & 1023; t0[it] = p->g_ffn[l * 1024 + k]; t1[it] = mod[v * 6144 + 4 * 1024 + k]; t2[it] = mod[v * 6144 + 3 * 1024 + k]; }
#pragma unroll
      for (int it = 0; it < 6; ++it) { const int idx = tid + NTHREADS * it; gm[idx] = t0[it] * (1.f + t1[it]); sh[idx] = t2[it]; } }
    if (tid < 64) lcnt[tid] = 0;
    __syncthreads();
    bf16_t* HM = (bf16_t*)(p->ws + WS_HX); float* CWLA = (float*)(p->ws + WS_CWLA); float* CWLB = (float*)(p->ws + WS_CWLB); int* POS = (int*)(p->ws + WS_POS) + (size_t)l * R;
    int* gcount = (int*)(p->ws + WS_CTL) + l * 32; int* LIST = (int*)(p->ws + WS_LIST);
    const int rpb = (R + nb - 1) / nb, r0 = bid * rpb, r1 = (r0 + rpb) < R ? (r0 + rpb) : R;
    f32x4 xn[4];
    if (r0 + wave < r1) { const f32x4* hr = (const f32x4*)hptr(p, r0 + wave);
#pragma unroll
        for (int j = 0; j < 4; ++j) xn[j] = hr[lane + 64 * j]; }
    for (int r = r0 + wave; r < r1; r += 8) {
        const int v = row_v(r);
        f32x4 xv[4]; float ss = 0.f;
#pragma unroll
        for (int j = 0; j < 4; ++j) xv[j] = xn[j];
        if (r + 8 < r1) { const f32x4* hr = (const f32x4*)hptr(p, r + 8);
#pragma unroll
            for (int j = 0; j < 4; ++j) xn[j] = hr[lane + 64 * j]; }
        if (l == DEPTH - 1 && v == 2) { if (lane == 0) lcls[r - r0] = -1; continue; }
#pragma unroll
        for (int j = 0; j < 4; ++j) ss += xv[j][0] * xv[j][0] + xv[j][1] * xv[j][1] + xv[j][2] * xv[j][2] + xv[j][3] * xv[j][3];
        ss = wave_sum(ss); const float rs = rsqrtf(ss * (1.f / 1024.f) + 1e-6f);
#pragma unroll
        for (int j = 0; j < 4; ++j) { const int k = 4 * lane + 256 * j; const f32x4 g4 = *(const LAS f32x4*)(gm + v * 1024 + k), s4 = *(const LAS f32x4*)(sh + v * 1024 + k);
            xv[j] = xv[j] * rs * g4 + s4;
            u32x2 o; o.x = cvt_pk_bf16(xv[j][0], xv[j][1]); o.y = cvt_pk_bf16(xv[j][2], xv[j][3]);
            *(u32x2*)(HM + (size_t)r * 1024 + k) = o; }
        float lg[20];
#pragma unroll
        for (int n = 0; n < 20; ++n) { float a = 0.f;
#pragma unroll
            for (int j = 0; j < 4; ++j) { const f32x4 w4 = *(const LAS f32x4*)(wrt + n * 1024 + 4 * lane + 256 * j); a += xv[j][0] * w4[0] + xv[j][1] * w4[1] + xv[j][2] * w4[2] + xv[j][3] * w4[3]; }
            lg[n] = wave_sum(a) + (n < 4 ? p->b_rg[l * 4 + n] : p->b_re[l * 16 + n - 4]); }
        int gsel = 0; float gmax = lg[0];
#pragma unroll
        for (int q = 1; q < 4; ++q) if (lg[q] > gmax) { gmax = lg[q]; gsel = q; }
        float gden = 0.f;
#pragma unroll
        for (int q = 0; q < 4; ++q) gden += __expf(lg[q] - gmax);
        const float gprob = 1.f / gden;
        float el[4];
#pragma unroll
        for (int q = 0; q < 4; ++q) el[q] = gsel == 0 ? lg[4 + q] : (gsel == 1 ? lg[8 + q] : (gsel == 2 ? lg[12 + q] : lg[16 + q]));
        int i0 = 0; float m0 = el[0];
#pragma unroll
        for (int q = 1; q < 4; ++q) if (el[q] > m0) { m0 = el[q]; i0 = q; }
        int i1 = -1; float m1 = -3.0e38f;
#pragma unroll
        for (int q = 0; q < 4; ++q) if (q != i0 && el[q] > m1) { m1 = el[q]; i1 = q; }
        const float w0 = gprob / (1.f + __expf(m1 - m0)), w1 = gprob - w0;
        const int ea = i0 < i1 ? i0 : i1, eb = i0 < i1 ? i1 : i0;
        const float cwa = i0 < i1 ? w0 : w1, cwb = i0 < i1 ? w1 : w0;
        const int pidx = ea == 0 ? eb - 1 : (ea == 1 ? eb + 1 : 5);
        const int cls = gsel * 6 + pidx;
        if (lane == 0) { const int rank = __hip_atomic_fetch_add(&lcnt[cls], 1, __ATOMIC_RELAXED, __HIP_MEMORY_SCOPE_WORKGROUP); lcls[r - r0] = cls; lrank[r - r0] = rank; lcwa[r - r0] = cwa; lcwb[r - r0] = cwb; }
    }
    __syncthreads();
    if (tid < NCLS) lcnt[32 + tid] = atomicAdd(&gcount[tid], lcnt[tid]);
    __syncthreads();
    for (int idx = tid; idx < r1 - r0; idx += NTHREADS) { const int cl = lcls[idx]; if (cl < 0) continue; const int pos = lcnt[32 + cl] + lrank[idx]; const size_t li = (size_t)cl * R + pos;
        LIST[li] = r0 + idx; CWLA[li] = lcwa[idx]; CWLB[li] = lcwb[idx]; POS[r0 + idx] = (cl << 16) | pos; }
    __syncthreads();
}
__device__ __forceinline__ void phase_final(CP p, unsigned char* lds, int bid, int nb) {
    const int tid = launder_tid(); const int lane = tid & 63, wave = tid >> 6;
    LAS int* tab = (LAS int*)((LAS unsigned char*)lds + MISC_OFF);
    moe_table(p, DEPTH - 1, tab);
    const int* POS = (const int*)(p->ws + WS_POS) + (size_t)(DEPTH - 1) * R;
    const int qstep = nb * 8;
    f32x4 xn[4]; u32x2 yn[4]; int posn = 0;
    { const int q = bid * 8 + wave;
      if (q < NB * SEQ) { const int b = q >= SEQ ? 1 : 0; const int r = b * SEG + CTXL + (q - b * SEQ); const f32x4* hr = (const f32x4*)(p->out + (size_t)q * D);
#pragma unroll
          for (int j = 0; j < 4; ++j) xn[j] = hr[lane + 64 * j];
          moe_yload(p, POS[r], lane, tab, yn);
          const int qn = q + qstep; if (qn < NB * SEQ) { const int bn = qn >= SEQ ? 1 : 0; posn = POS[bn * SEG + CTXL + (qn - bn * SEQ)]; } } }
    for (int q = bid * 8 + wave; q < NB * SEQ; q += qstep) {
        const int b = q >= SEQ ? 1 : 0;
        f32x4* hr = (f32x4*)(p->out + (size_t)q * D);
        f32x4 xv[4]; u32x2 yv[4]; float ss = 0.f;
#pragma unroll
        for (int j = 0; j < 4; ++j) { xv[j] = xn[j]; yv[j] = yn[j]; }
        { const int qn = q + qstep;
          if (qn < NB * SEQ) { const f32x4* hn = (const f32x4*)(p->out + (size_t)qn * D);
#pragma unroll
              for (int j = 0; j < 4; ++j) xn[j] = hn[lane + 64 * j];
              moe_yload(p, posn, lane, tab, yn);
              const int q2 = qn + qstep; if (q2 < NB * SEQ) { const int b2 = q2 >= SEQ ? 1 : 0; posn = POS[b2 * SEG + CTXL + (q2 - b2 * SEQ)]; } } }
        moe_yadd(p, DEPTH - 1, b, lane, yv, xv);
#pragma unroll
        for (int j = 0; j < 4; ++j) ss += xv[j][0] * xv[j][0] + xv[j][1] * xv[j][1] + xv[j][2] * xv[j][2] + xv[j][3] * xv[j][3];
        ss = wave_sum(ss); const float rs = rsqrtf(ss * (1.f / 1024.f) + 1e-6f);
#pragma unroll
        for (int j = 0; j < 4; ++j) { const f32x4 g4 = *(const f32x4*)(p->g_final + 4 * lane + 256 * j); hr[lane + 64 * j] = xv[j] * rs * g4; }
    }
}


#define XB_TMO      128
#define XB_XCNT(j)  (256  + 64 * (j))
#define XB_XSUB(j)  (1280 + 64 * (j))
#define XB_XGEN(j)  (2304 + 64 * (j))
#define XB_TOP      3328
#define XB_TOPGEN   3392
#define XCD_BAR_WORDS 3456
#define XB_SPIN_CAP (1u << 22)
__device__ __forceinline__ unsigned xb_ld(unsigned* p) { return __hip_atomic_load(p, __ATOMIC_RELAXED, __HIP_MEMORY_SCOPE_AGENT); }
__device__ __forceinline__ unsigned xb_add(unsigned* p, unsigned v) { return __hip_atomic_fetch_add(p, v, __ATOMIC_RELAXED, __HIP_MEMORY_SCOPE_AGENT); }
__device__ __forceinline__ unsigned xb_xcc_id() { return (unsigned)__builtin_amdgcn_s_getreg((3 << 11) | 20) & 0xFu; }
#define XB_SPIN(cond, bar) do { unsigned _sp = 0; while (cond) { __builtin_amdgcn_s_sleep(1); \
    if ((++_sp & 255u) == 0u) { if (xb_ld(&(bar)[XB_TMO])) break; if (_sp > XB_SPIN_CAP) { atomicAdd(&(bar)[XB_TMO], 1u); break; } } } } while (0)
struct XcdBarrier { unsigned* bar; unsigned x; volatile LAS unsigned* st; };
__device__ __forceinline__ XcdBarrier xcd_barrier_post(unsigned* bar, volatile LAS unsigned* st) {
    XcdBarrier b; b.bar = bar; b.x = xb_xcc_id(); b.st = st;
    if (threadIdx.x == 0) (void)xb_add(&bar[XB_XCNT(b.x)], 1u);
    return b;
}
__device__ __forceinline__ void xcd_barrier_complete(unsigned* bar, unsigned x, unsigned& nloc, unsigned& nx) {
    const unsigned G = gridDim.x * gridDim.y * gridDim.z;
    unsigned sum, cnt, mine, sp = 0u;
    for (;;) {
        sum = 0u; cnt = 0u; mine = 0u;
#pragma unroll
        for (unsigned j = 0; j < 16; ++j) { const unsigned c = xb_ld(&bar[XB_XCNT(j)]); sum += c; cnt += (c > 0u) ? 1u : 0u; mine = (j == x) ? c : mine; }
        if (sum == G) break;
        __builtin_amdgcn_s_sleep(1);
        if ((++sp & 255u) == 0u) { if (xb_ld(&bar[XB_TMO])) break; if (sp > XB_SPIN_CAP) { atomicAdd(&bar[XB_TMO], 1u); break; } }
    }
    nloc = mine > 0u ? mine : 1u; nx = cnt > 0u ? cnt : 1u;
}
__device__ __forceinline__ void xcd_barrier(const XcdBarrier& b) {
    asm volatile("s_waitcnt vmcnt(0)" ::: "memory");
    __syncthreads();
    if (threadIdx.x == 0) {
        unsigned* bar = b.bar;
        __builtin_amdgcn_s_waitcnt(0);
        unsigned nloc = b.st[0], nx = b.st[1];
        if (nloc == 0u) { xcd_barrier_complete(bar, b.x, nloc, nx); b.st[0] = nloc; b.st[1] = nx; }
        const unsigned old = xb_add(&bar[XB_XSUB(b.x)], 1u);
        const unsigned gen = old / nloc;
        if (old + 1u == (gen + 1u) * nloc) {
            __builtin_amdgcn_fence(__ATOMIC_RELEASE, "agent");
            asm volatile("s_waitcnt vmcnt(0)" ::: "memory");
            const unsigned og = xb_add(&bar[XB_TOP], 1u);
            const unsigned tg = og / nx;
            if (og + 1u == (tg + 1u) * nx) xb_add(&bar[XB_TOPGEN], 1u);
            else XB_SPIN(xb_ld(&bar[XB_TOPGEN]) == tg, bar);
            __builtin_amdgcn_fence(__ATOMIC_ACQUIRE, "agent");
            xb_add(&bar[XB_XGEN(b.x)], 1u);
            asm volatile("s_waitcnt vmcnt(0)" ::: "memory");
        } else {
            XB_SPIN(xb_ld(&bar[XB_XGEN(b.x)]) == gen, bar);
            __builtin_amdgcn_fence(__ATOMIC_ACQUIRE, "agent");
            asm volatile("s_waitcnt vmcnt(0)" ::: "memory");
        }
    }
    __syncthreads();
}

#ifndef TIMING_A
#define TIMING_A -1
#endif
#ifndef TIMING_B
#define TIMING_B -1
#endif
#ifndef PHASE_MASK
#define PHASE_MASK 0xFFFFF
#endif
#define PM(i) ((PHASE_MASK >> (i)) & 1)
#ifndef REPEAT_MASK
#define REPEAT_MASK 0
#endif
#define RP(i) for (int rep_ = 0; rep_ < 1 + ((REPEAT_MASK >> (i)) & 1); ++rep_)
constexpr int PH_PER_LAYER = 9, NPHASES = 1 + DEPTH * PH_PER_LAYER + 1;
__global__ void __launch_bounds__(NTHREADS, 2) mk_fwd(Args args) {
    extern __shared__ __attribute__((aligned(16))) unsigned char lds[];
    cg::grid_group grid = cg::this_grid();
    const __attribute__((address_space(4))) Args* ap = (const __attribute__((address_space(4))) Args*)__builtin_amdgcn_kernarg_segment_ptr();
    const int lo = ap->lo, hi = ap->hi;
    LAS unsigned char* ldsl = (LAS unsigned char*)lds;
    volatile LAS unsigned* xbst = (volatile LAS unsigned*)(ldsl + LDS_BYTES - 16);
    if (threadIdx.x < 4) xbst[threadIdx.x] = 0u;
    __syncthreads();
    (void)xcd_barrier_post((unsigned*)(ap->p.ws + WS_BAR), xbst);
    if (TIMING_A >= 0 && blockIdx.x == 0 && threadIdx.x == 0) ((unsigned long long*)(ap->p.ws + WS_TS))[lo] = __builtin_amdgcn_s_memrealtime();
    for (int ph = lo; ph < hi; ++ph) {
        CP p = launder(&ap->p);
        int bid = blockIdx.x, nb = gridDim.x; asm volatile("" : "+s"(bid), "+s"(nb));
        if (ph == 0) { if (PM(0)) RP(0) phase_wprep(p, lds, bid, nb); if (PM(1)) RP(1) phase_adaln(p, lds, bid, nb); }
        else if (ph == NPHASES - 1) { if (PM(12)) phase_final(p, lds, bid, nb); }
        else {
            const int l = (ph - 1) / PH_PER_LAYER, s = (ph - 1) % PH_PER_LAYER;
            if (s == 0) { if (PM(2)) RP(2) { if (rep_ == 0 || l == 0) phase_r1(p, l, lds, bid, nb); } }
            else if (s == 1) { if (PM(3)) RP(3) {
                pg8::DenseSched S; S.init(p->ws + WS_HX, (const bf16_t*)(p->ws + WS_WTIN) + (size_t)l * DIN * 1024, R, NPROJ, 1024, 1024, 1024, nb, bid);
                EpiProj E{(bf16_t*)(p->ws + WS_PROJ)};
                pg8::gemm_phase<EpiProj, pg8::DenseSched, false>(ldsl, 1024, 1024, 1024, S, E);
            } }
            else if (s == 2) { if (PM(4)) RP(4) phase_c1(p, l, lds, bid, nb); if (PM(5)) RP(5) phase_s1(p, l, lds, bid, nb); }
            else if (s == 3) { if (PM(6)) RP(6) phase_s2(p, bid, nb); if (PM(4)) phase_c1_ln(p, l, bid, nb); }
            else if (s == 4) { if (PM(7)) RP(7) phase_s3(p, l, lds, bid, nb); }
            else if (s == 5) { if (PM(8)) RP(8) { if (rep_ == 0 || l == 0) {
                pg8::DenseSched S; S.init(p->ws + WS_HX, (const bf16_t*)(p->ws + WS_WTOUT) + (size_t)l * 1024 * 1024, R, 1024, 1024, 1024, 1024, nb, bid, l == DEPTH - 1);
                EpiResid E{l == 0 ? p->ctx : (const float*)(p->ws + WS_HC), l == 0 ? p->x : (const float*)p->out, (float*)(p->ws + WS_HC), p->out, (const float*)(p->ws + WS_MOD) + (size_t)l * 3 * 6144, (const float*)(p->ws + WS_SSQ)};
                pg8::gemm_phase<EpiResid, pg8::DenseSched, false>(ldsl, 1024, 1024, 1024, S, E);
            } } }
            else if (s == 6) { if (PM(9)) phase_r2(p, l, lds, bid, nb); }
            else if (s == 7) { if (PM(10)) RP(10) {
                LAS int* tab = (LAS int*)(ldsl + MISC_OFF); moe_table(p, l, tab);
                MoeSched S{tab, (const int*)(p->ws + WS_LIST), (const char*)(p->ws + WS_HX), (const char*)(p->ws + WS_WTGU), 0, l, nb, bid};
                EpiUp E{(bf16_t*)(p->ws + WS_HID), (const float*)(p->ws + WS_CWLA), (const float*)(p->ws + WS_CWLB)};
                pg8::gemm_phase<EpiUp, MoeSched, true>(ldsl, 1024, 1024, 1024, S, E);
            } }
            else { if (PM(11)) RP(11) {
                LAS int* tab = (LAS int*)(ldsl + MISC_OFF); moe_table(p, l, tab);
                MoeSched S{tab, (const int*)(p->ws + WS_LIST), (const char*)(p->ws + WS_HID), (const char*)(p->ws + WS_WTD), 1, l, nb, bid};
                EpiY E{(bf16_t*)(p->ws + WS_Y)};
                pg8::gemm_phase<EpiY, MoeSched, false>(ldsl, 512, 256, 512, S, E);
            } }
        }
        if (ph + 1 < hi) { if (ph == lo) grid.sync(); else { XcdBarrier xb; xb.bar = (unsigned*)(launder(&ap->p)->ws + WS_BAR); xb.x = xb_xcc_id(); xb.st = (volatile LAS unsigned*)(ldsl + LDS_BYTES - 16); xcd_barrier(xb); }
            if (TIMING_A >= 0 && blockIdx.x == 0 && threadIdx.x == 0) ((unsigned long long*)(launder(&ap->p)->ws + WS_TS))[ph + 1] = __builtin_amdgcn_s_memrealtime(); }
    }
#if TIMING_A >= 0
    {
        XcdBarrier xb; xb.bar = (unsigned*)(launder(&ap->p)->ws + WS_BAR); xb.x = xb_xcc_id(); xb.st = (volatile LAS unsigned*)(ldsl + LDS_BYTES - 16); xcd_barrier(xb);
        if (blockIdx.x == 0 && threadIdx.x == 0) ((unsigned long long*)(launder(&ap->p)->ws + WS_TS))[hi] = __builtin_amdgcn_s_memrealtime();
        xcd_barrier(xb);
        const unsigned long long* ts = (const unsigned long long*)(launder(&ap->p)->ws + WS_TS);
        const float ta = (float)(ts[TIMING_A + 1] - ts[TIMING_A]) * 0.01f, tb = (float)(ts[TIMING_B + 1] - ts[TIMING_B]) * 0.01f;
        float* o = launder(&ap->p)->out; const float sc = 1.f + ta * 0.001f;
        for (size_t i = (size_t)blockIdx.x * NTHREADS + threadIdx.x; i < (size_t)NB * SEQ * D; i += (size_t)gridDim.x * NTHREADS) o[i] = o[i] * sc + (i == 0 ? tb * 0.1f : 0.f);
    }
#endif
}

extern "C" void kernel_launch(void* const* d_in, const int* in_sizes, int n_in, void* d_out, int out_size, void* d_ws, size_t ws_size, hipStream_t stream) {
    static int grid = 0;
    if (grid == 0) {
        if (n_in != 28 || ws_size < WS_END) { fprintf(stderr, "kernel_launch: unexpected n_in %d or ws_size %zu (< %zu)\n", n_in, ws_size, (size_t)WS_END); grid = -1; return; }
        int dev = 0, cus = 0, per_cu = 0;
        hipGetDevice(&dev); hipDeviceGetAttribute(&cus, hipDeviceAttributeMultiprocessorCount, dev);
        if (hipFuncSetAttribute((const void*)mk_fwd, hipFuncAttributeMaxDynamicSharedMemorySize, LDS_BYTES) != hipSuccess) { fprintf(stderr, "kernel_launch: hipFuncSetAttribute failed\n"); grid = -1; return; }
        if (hipOccupancyMaxActiveBlocksPerMultiprocessor(&per_cu, (const void*)mk_fwd, NTHREADS, LDS_BYTES) != hipSuccess || per_cu < 1) { fprintf(stderr, "kernel_launch: occupancy query says %d\n", per_cu); (void)hipGetLastError(); grid = -1; return; }
        grid = cus;
    }
    if (grid < 0) return;
    (void)hipMemsetAsync((char*)d_ws + WS_CTL, 0, WS_CTL_BYTES, stream);
    Args a{};
    const float** pp = (const float**)&a.p;
    for (int i = 0; i < 28; ++i) pp[i] = (const float*)d_in[i];
    a.p.out = (float*)d_out; a.p.ws = (unsigned char*)d_ws;
#if PER_PHASE_LAUNCH
    for (int ph = 0; ph < NPHASES; ++ph) {
        a.lo = ph; a.hi = ph + 1; void* kargs[] = {&a};
        hipError_t e = hipLaunchCooperativeKernel((const void*)mk_fwd, dim3(grid), dim3(NTHREADS), kargs, LDS_BYTES, stream);
        if (e != hipSuccess) { fprintf(stderr, "kernel_launch: launch of phase %d failed: %s\n", ph, hipGetErrorString(e)); break; }
    }
#else
    a.lo = 0; a.hi = NPHASES; void* kargs[] = {&a};
    hipError_t e = hipLaunchCooperativeKernel((const void*)mk_fwd, dim3(grid), dim3(NTHREADS), kargs, LDS_BYTES, stream);
    if (e != hipSuccess) fprintf(stderr, "kernel_launch: cooperative launch failed: %s (grid %d)\n", hipGetErrorString(e), grid);
#endif
}
```

```cpp
#include <hip/hip_runtime.h>
#include <hip/hip_cooperative_groups.h>
#include <cstdio>
namespace cg = cooperative_groups;

#ifndef PER_PHASE_LAUNCH
#define PER_PHASE_LAUNCH 0
#endif

#ifndef S3REP
#define S3REP 0
#endif
#define S3R(i) for (int r3_ = 0; r3_ < 1 + ((S3REP >> (i)) & 1); ++r3_)
#define LAS __attribute__((address_space(3)))
typedef unsigned short bf16_t;
typedef short bf16x8 __attribute__((ext_vector_type(8)));
typedef float f32x4 __attribute__((ext_vector_type(4)));
typedef unsigned u32x4 __attribute__((ext_vector_type(4)));
typedef unsigned u32x2 __attribute__((ext_vector_type(2)));

constexpr int D = 1024, NB = 2, SEQ = 16384, CTXL = 256, SEG = SEQ + CTXL, R = NB * SEG, DEPTH = 2;
constexpr int NPROJ = 2560, DIN = 2576;
constexpr int NTHREADS = 512;
constexpr int LDS_BYTES = 163840;
constexpr int MISC_OFF = 131072;
constexpr int NCLS = 24;

constexpr size_t al256(size_t x) { return (x + 255) & ~size_t(255); }
constexpr size_t WS_CTL = 0;
constexpr size_t WS_TS = 2048;
constexpr size_t WS_BAR = 4096;
constexpr size_t WS_CTL_BYTES = 32768;
constexpr size_t WS_MOD = WS_CTL_BYTES;
constexpr size_t WS_WTIN = WS_MOD + al256((size_t)2 * 3 * 6144 * 4);
constexpr size_t WS_WTOUT = WS_WTIN + al256((size_t)2 * DIN * 1024 * 2);
constexpr size_t WS_WTGU = WS_WTOUT + al256((size_t)2 * 1024 * 1024 * 2);
constexpr size_t WS_WTD = WS_WTGU + al256((size_t)2 * 16 * 512 * 1024 * 2);
constexpr size_t WS_H = WS_WTD + al256((size_t)2 * 16 * 1024 * 256 * 2);
constexpr size_t WS_HX = WS_H + al256((size_t)R * 1024 * 2);
constexpr size_t WS_PROJ = WS_HX + al256((size_t)R * 1024 * 2);
constexpr size_t WS_DT = WS_PROJ + al256((size_t)R * NPROJ * 2);
constexpr size_t WS_POS = WS_DT + al256((size_t)R * 16 * 4);
constexpr size_t WS_LIST = WS_POS + al256((size_t)2 * R * 4);
constexpr size_t WS_CWLA = WS_LIST + al256((size_t)NCLS * R * 4);
constexpr size_t WS_CWLB = WS_CWLA + al256((size_t)NCLS * R * 4);
constexpr size_t WS_BIG = WS_CWLB + al256((size_t)NCLS * R * 4);
constexpr size_t WS_Y = WS_PROJ;
constexpr size_t WS_S = WS_BIG;
constexpr size_t WS_HP = WS_S + al256((size_t)2 * 2 * 130 * 8 * 8192 * 2);
constexpr size_t WS_DEC = WS_HP + al256((size_t)2 * 2 * 130 * 8 * 8192 * 2);
constexpr size_t WS_SSQ = WS_DEC + al256((size_t)2 * 2 * 130 * 8 * 4);
constexpr size_t WS_HID = WS_S;
constexpr size_t WS_END = WS_SSQ + al256((size_t)R * 8 * 4);
static_assert((size_t)(R + NCLS * 256) * 512 * 2 <= (size_t)2 * 2 * 130 * 8 * 8192 * 2, "hid alias");
static_assert(WS_END <= (size_t)512 * 1024 * 1024, "workspace");

struct Params {
    const float *x, *c, *ctx, *c_ctx, *w_ada, *b_ada, *g_mix, *g_ffn, *w_in, *conv_w, *conv_b, *conv_ln_g, *conv_ln_b, *ssd_conv_w, *ssd_conv_b,
        *dt_bias, *a_log, *d_skip, *ssd_norm_g, *w_out, *w_rg, *b_rg, *w_re, *b_re, *w_gate, *w_up, *w_down, *g_final;
    float* out; unsigned char* ws;
};
struct Args { Params p; int lo, hi; };
typedef const __attribute__((address_space(4))) Params* CP;
__device__ __forceinline__ CP launder(CP p) { asm volatile("" : "+s"(p)); return p; }
__device__ __forceinline__ int launder_tid() { int t = threadIdx.x; asm volatile("" : "+v"(t)); return t; }

__device__ __forceinline__ unsigned cvt_pk_bf16(float lo, float hi) { unsigned r; asm("v_cvt_pk_bf16_f32 %0, %1, %2" : "=v"(r) : "v"(lo), "v"(hi)); return r; }
__device__ __forceinline__ float bf2f(unsigned b) { return __uint_as_float(b << 16); }
__device__ __forceinline__ float bflo(unsigned w) { return __uint_as_float(w << 16); }
__device__ __forceinline__ float bfhi(unsigned w) { return __uint_as_float(w & 0xffff0000u); }
__device__ __forceinline__ bf16_t f2bf(float f) { return (bf16_t)(cvt_pk_bf16(f, 0.f) & 0xffffu); }
#define DPP_ADD(v, ctrl, rm) ((v) + __builtin_bit_cast(float, __builtin_amdgcn_update_dpp(0, __builtin_bit_cast(int, (v)), (ctrl), (rm), 0xF, true)))
__device__ __forceinline__ float row_sum16(float v) {
    v = DPP_ADD(v, 0xB1, 0xF);
    v = DPP_ADD(v, 0x4E, 0xF);
    v = DPP_ADD(v, 0x141, 0xF);
    v = DPP_ADD(v, 0x140, 0xF);
    return v;
}
__device__ __forceinline__ float half_sum32(float v) { v = row_sum16(v); v = DPP_ADD(v, 0x142, 0xA); return v; }
__device__ __forceinline__ float wave_sum(float v) {
    v = half_sum32(v); v = DPP_ADD(v, 0x143, 0xC);
    return __builtin_bit_cast(float, __builtin_amdgcn_readlane(__builtin_bit_cast(int, v), 63));
}
__device__ __forceinline__ float sigmoidf_(float x) { return 1.f / (1.f + __expf(-x)); }
__device__ __forceinline__ float siluf_(float x) { return x / (1.f + __expf(-x)); }
__device__ __forceinline__ float softplusf_(float x) { return fmaxf(x, 0.f) + log1pf(expf(-fabsf(x))); }

__device__ __forceinline__ int row_b(int r) { return r >= SEG ? 1 : 0; }
__device__ __forceinline__ int row_i(int r) { return r >= SEG ? r - SEG : r; }
__device__ __forceinline__ int row_v(int r) { const int i = row_i(r); return i < CTXL ? 2 : row_b(r); }
__device__ __forceinline__ const float* xin_ptr(const float* ctx, const float* x, int r) {
    const int b = row_b(r), i = row_i(r);
    return i < CTXL ? ctx + (size_t)(b * CTXL + i) * D : x + (size_t)(b * SEQ + i - CTXL) * D;
}
struct RowRaw { f32x4 f[4]; u32x2 h[4]; };
__device__ __forceinline__ void row_load(CP p, int l, int r, int lane, RowRaw& rr) {
    if (l == 0) { const f32x4* hr = (const f32x4*)xin_ptr(p->ctx, p->x, r);
#pragma unroll
        for (int j = 0; j < 4; ++j) rr.f[j] = hr[lane + 64 * j]; }
    else { const u32x2* hr = (const u32x2*)((const bf16_t*)(p->ws + WS_H) + (size_t)r * D);
#pragma unroll
        for (int j = 0; j < 4; ++j) rr.h[j] = hr[lane + 64 * j]; }
}
__device__ __forceinline__ void row_cvt(int l, const RowRaw& rr, f32x4 (&xv)[4]) {
#pragma unroll
    for (int j = 0; j < 4; ++j) xv[j] = l == 0 ? rr.f[j] : (f32x4){bflo(rr.h[j].x), bfhi(rr.h[j].x), bflo(rr.h[j].y), bfhi(rr.h[j].y)};
}
namespace pg8 {
constexpr int BM = 256, BK = 64, HALF = 128, HTB = HALF * BK * 2, STAGE_BYTES = 8 * HTB, NXCD = 8, WGM = 8;
__device__ __forceinline__ int lds_byte(int r, int c) { const int st = (r >> 4) * 2 + (c >> 5), rr = r & 15, cc = c & 31, ob = rr * 64 + cc * 2; return st * 1024 + (ob ^ (((ob >> 9) & 1) << 5)); }
__device__ __forceinline__ void stage_rc(int b, int& Rr, int& Cc) { const int st = b / 1024, sb = b % 1024, swz = sb ^ (((sb >> 9) & 1) << 5); Rr = (st >> 1) * 16 + swz / 64; Cc = (st & 1) * 32 + (swz % 64) / 2; }
__device__ __forceinline__ int perm32(int rho) { const int n = rho >> 4, i = rho & 15; return 8 * (i >> 2) + 4 * n + (i & 3); }

struct Unit {
    const char* a0;
    const char* b0;
    const char* b1;
    int i0, i1, i2, i3, i4, pad;
};

template <class Epi, class Sched, bool GATHER>
__device__ __forceinline__ void gemm_phase(LAS unsigned char* lds, const int lda, const int ldb, const int K, const Sched& S, const Epi& E) {
    const int tid = launder_tid(); const int wid = __builtin_amdgcn_readfirstlane(tid >> 6), lane = tid & 63, wr = wid >> 2, wc = wid & 3, fr = lane & 15, fq = lane >> 4;
    const int nt = K / BK, ks = nt >> 1;
    int Rr[2], Cc[2];
    unsigned voffB[2];
#pragma unroll
    for (int i = 0; i < 2; ++i) { stage_rc(tid * 16 + i * 8192, Rr[i], Cc[i]); const int Rb = Epi::PERM ? ((Rr[i] & ~31) + perm32(Rr[i] & 31)) : Rr[i];
        voffB[i] = (unsigned)(Rb * ldb + Cc[i]) * 2u; }
    const size_t kstep = (size_t)(BK * 2);
    const size_t hstepB = (size_t)HALF * ldb * 2;
    const unsigned ldsw = (unsigned)wid * 1024u;
    const unsigned ldsbase = (unsigned)(unsigned long)lds;
    const int aoff = lds_byte(wr * 64 + fr, fq * 8), boff = lds_byte(wc * 32 + fr, fq * 8);
#define PG8_SA(b, h) (((b) * 2 + (h)) * HTB)
#define PG8_SB(b, h) ((4 + (b) * 2 + (h)) * HTB)
#define PG8_STAGE2(bufoff, gbase, v0, v1) do { unsigned keep_; \
        asm volatile("s_mov_b32 %0, m0\n\ts_mov_b32 m0, %1\n\ts_nop 4\n\tglobal_load_lds_dwordx4 %2, %4\n\ts_add_u32 m0, m0, 0x2000\n\ts_nop 0\n\tglobal_load_lds_dwordx4 %3, %4\n\ts_mov_b32 m0, %0" \
            : "=&s"(keep_) : "s"(ldsbase + (unsigned)(bufoff) + ldsw), "v"(v0), "v"(v1), "s"(gbase) : "memory", "scc"); } while (0)
#define PG8_LDA(dst, b, h) do { _Pragma("unroll") for (int m = 0; m < 4; ++m) _Pragma("unroll") for (int k = 0; k < 2; ++k) dst[m][k] = *(const LAS bf16x8*)(lds + PG8_SA(b, h) + aoff + m * 2048 + k * 1024); } while (0)
#define PG8_LDB(dst, b, h) do { _Pragma("unroll") for (int n = 0; n < 2; ++n) _Pragma("unroll") for (int k = 0; k < 2; ++k) dst[n][k] = *(const LAS bf16x8*)(lds + PG8_SB(b, h) + boff + n * 2048 + k * 1024); } while (0)
#define PG8_MMA(ai, bj, At, Bt) do { __builtin_amdgcn_s_setprio(1); _Pragma("unroll") for (int m = 0; m < 4; ++m) _Pragma("unroll") for (int n = 0; n < 2; ++n) _Pragma("unroll") for (int k = 0; k < 2; ++k) \
        acc[ai][bj][m][n] = __builtin_amdgcn_mfma_f32_16x16x32_bf16(Bt[n][k], At[m][k], acc[ai][bj][m][n], 0, 0, 0); __builtin_amdgcn_s_setprio(0); } while (0)
#define PG8_WAIT_V(n) asm volatile("s_waitcnt vmcnt(" #n ")" ::: "memory")
#define PG8_WAIT_L(n) asm volatile("s_waitcnt lgkmcnt(" #n ")" ::: "memory")
#define PG8_BAR __builtin_amdgcn_s_barrier()
#define PG8_SCHED __builtin_amdgcn_sched_barrier(0)
#define PG8_BP(u, tt) ((tt) < ks ? (u).b0 + (size_t)(tt) * kstep : (u).b1 + (size_t)((tt) - ks) * kstep)
    Unit cur, nxt; int ui = 0;
    if (!S.get(0, cur)) return;
    unsigned c00, c01, c10, c11, n00, n01, n10, n11;
    if (GATHER) {
        c00 = (unsigned)(S.arow(cur, Rr[0]) * lda + Cc[0]) * 2u; c01 = (unsigned)(S.arow(cur, Rr[1]) * lda + Cc[1]) * 2u;
        c10 = (unsigned)(S.arow(cur, HALF + Rr[0]) * lda + Cc[0]) * 2u; c11 = (unsigned)(S.arow(cur, HALF + Rr[1]) * lda + Cc[1]) * 2u;
    } else {
        c00 = (unsigned)(Rr[0] * lda + Cc[0]) * 2u; c01 = (unsigned)(Rr[1] * lda + Cc[1]) * 2u;
        c10 = (unsigned)((HALF + Rr[0]) * lda + Cc[0]) * 2u; c11 = (unsigned)((HALF + Rr[1]) * lda + Cc[1]) * 2u;
    }
    n00 = c00; n01 = c01; n10 = c10; n11 = c11;
    f32x4 acc[2][2][4][2];
    float zr; asm volatile("v_mov_b32 %0, 0" : "=v"(zr));
#pragma unroll
    for (int a = 0; a < 2; ++a)
#pragma unroll
        for (int b = 0; b < 2; ++b)
#pragma unroll
            for (int m = 0; m < 4; ++m)
#pragma unroll
                for (int n = 0; n < 2; ++n) acc[a][b][m][n] = (f32x4){zr, zr, zr, zr};
    bf16x8 At[4][2], B0[2][2], B1[2][2];
    const char* cA = cur.a0;
    {
        const char* pb0 = PG8_BP(cur, 0); const char* pb1 = PG8_BP(cur, 1);
        PG8_STAGE2(PG8_SB(0, 0), pb0, voffB[0], voffB[1]); PG8_STAGE2(PG8_SA(0, 0), cA, c00, c01);
        PG8_STAGE2(PG8_SB(0, 1), pb0 + hstepB, voffB[0], voffB[1]); PG8_STAGE2(PG8_SA(0, 1), cA, c10, c11);
        if (wr == 1) PG8_BAR;
        PG8_WAIT_V(4); PG8_BAR;
        PG8_STAGE2(PG8_SB(1, 0), pb1, voffB[0], voffB[1]); PG8_STAGE2(PG8_SA(1, 0), cA + kstep, c00, c01);
        PG8_STAGE2(PG8_SB(1, 1), pb1 + hstepB, voffB[0], voffB[1]);
        PG8_WAIT_V(6); PG8_BAR;
    }
    for (;;) {
        const bool has_next = S.get(ui + 1, nxt);
        if (!has_next) nxt = cur;
        LAS int* tokb = (LAS int*)(lds + MISC_OFF + 1024) + ((ui + 1) & 1) * 256;
        if (GATHER) {
            n00 = c00; n01 = c01; n10 = c10; n11 = c11;
            if (has_next && wid == 0) {
                const char* src = (const char*)S.rows_ptr(nxt); unsigned keep_;
                asm volatile("s_mov_b32 %0, m0\n\ts_mov_b32 m0, %1\n\ts_nop 4\n\tglobal_load_lds_dwordx4 %2, %3\n\ts_mov_b32 m0, %0"
                    : "=&s"(keep_) : "s"((unsigned)(unsigned long)tokb), "v"((unsigned)lane * 16u), "s"(src) : "memory");
            }
        }
        const char* nA = nxt.a0;
#pragma unroll 1
        for (int t = 0; t < nt; t += 2) {
            const bool last = (t == nt - 2);
            const char* a1 = cA + (size_t)(t + 1) * kstep;
            const char* a2 = last ? nA : cA + (size_t)(t + 2) * kstep;
            const char* a3 = a2 + kstep;
            const char* b2 = last ? PG8_BP(nxt, 0) : PG8_BP(cur, t + 2);
            const char* b3 = last ? PG8_BP(nxt, 1) : PG8_BP(cur, t + 3);
            if (GATHER) { if (last && has_next) {
                const int lim = S.rows_valid(nxt) - 1;
                const int i0 = Rr[0] < lim ? Rr[0] : lim, i1 = Rr[1] < lim ? Rr[1] : lim, i2 = (HALF + Rr[0]) < lim ? (HALF + Rr[0]) : lim, i3 = (HALF + Rr[1]) < lim ? (HALF + Rr[1]) : lim;
                n00 = (unsigned)(tokb[i0] * lda + Cc[0]) * 2u; n01 = (unsigned)(tokb[i1] * lda + Cc[1]) * 2u;
                n10 = (unsigned)(tokb[i2] * lda + Cc[0]) * 2u; n11 = (unsigned)(tokb[i3] * lda + Cc[1]) * 2u; } }
            const unsigned s00 = last ? n00 : c00, s01 = last ? n01 : c01, s10 = last ? n10 : c10, s11 = last ? n11 : c11;
            if constexpr (Epi::MIDSCALE) { if (t == ks) E.midscale(acc, cur, wr, wc, fr, fq); }
            PG8_LDB(B0, 0, 0); PG8_SCHED; PG8_LDA(At, 0, 0); PG8_STAGE2(PG8_SA(1, 1), a1, c10, c11);
            PG8_WAIT_L(8); PG8_BAR; PG8_WAIT_L(0); PG8_MMA(0, 0, At, B0); PG8_BAR; PG8_SCHED;
            PG8_LDB(B1, 0, 1); PG8_STAGE2(PG8_SB(0, 0), b2, voffB[0], voffB[1]);
            PG8_BAR; PG8_WAIT_L(0); PG8_MMA(0, 1, At, B1); PG8_BAR;
            PG8_LDA(At, 0, 1); PG8_STAGE2(PG8_SA(0, 0), a2, s00, s01);
            PG8_BAR; PG8_WAIT_L(0); PG8_MMA(1, 0, At, B0); PG8_BAR; PG8_SCHED;
            PG8_STAGE2(PG8_SB(0, 1), b2 + hstepB, voffB[0], voffB[1]);
            PG8_WAIT_V(6); PG8_BAR; PG8_MMA(1, 1, At, B1); PG8_BAR;
            PG8_LDB(B0, 1, 0); PG8_SCHED; PG8_LDA(At, 1, 0); PG8_STAGE2(PG8_SA(0, 1), a2, s10, s11);
            PG8_WAIT_L(8); PG8_BAR; PG8_WAIT_L(0); PG8_MMA(0, 0, At, B0); PG8_BAR; PG8_SCHED;
            PG8_LDB(B1, 1, 1); PG8_STAGE2(PG8_SB(1, 0), b3, voffB[0], voffB[1]);
            PG8_BAR; PG8_WAIT_L(0); PG8_MMA(0, 1, At, B1); PG8_BAR;
            PG8_LDA(At, 1, 1); PG8_STAGE2(PG8_SA(1, 0), a3, s00, s01);
            PG8_BAR; PG8_WAIT_L(0); PG8_MMA(1, 0, At, B0); PG8_BAR; PG8_SCHED;
            PG8_STAGE2(PG8_SB(1, 1), b3 + hstepB, voffB[0], voffB[1]);
            PG8_WAIT_V(6); PG8_BAR; PG8_MMA(1, 1, At, B1); PG8_BAR;
        }
        E(acc, cur, wr, wc, fr, fq);
        if (!has_next) break;
        asm volatile("v_mov_b32 %0, 0" : "=v"(zr));
#pragma unroll
        for (int a = 0; a < 2; ++a)
#pragma unroll
            for (int b = 0; b < 2; ++b)
#pragma unroll
                for (int m = 0; m < 4; ++m)
#pragma unroll
                    for (int n = 0; n < 2; ++n) acc[a][b][m][n] = (f32x4){zr, zr, zr, zr};
        cur = nxt; cA = nA; ++ui; c00 = n00; c01 = n01; c10 = n10; c11 = n11;
    }
    PG8_WAIT_V(0);
    if (wr == 0) PG8_BAR;
    PG8_BAR;
#undef PG8_SA
#undef PG8_SB
#undef PG8_STAGE2
#undef PG8_LDA
#undef PG8_LDB
#undef PG8_MMA
#undef PG8_WAIT_V
#undef PG8_WAIT_L
#undef PG8_BAR
#undef PG8_SCHED
#undef PG8_BP
}

struct DenseSched {
    const char* A; const char* Bt; int lda, ldb, K; int nM, nN, nwg, G, c, skipctx;
    __device__ __forceinline__ void init(const void* A_, const void* Bt_, int M, int N, int K_, int lda_, int ldb_, int G_, int c_, int skipctx_ = 0) {
        A = (const char*)A_; Bt = (const char*)Bt_; lda = lda_; ldb = ldb_; K = K_; nM = M / BM - 2 * skipctx_; nN = N / BM; nwg = nM * nN; G = G_; c = c_; skipctx = skipctx_; }
    __device__ __forceinline__ bool get(int i, Unit& u) const {
        const long L = (long)i * G + c; if (L >= nwg) return false;
        int wgid = (int)L; { const int q = nwg / NXCD, r = nwg % NXCD, xcd = wgid % NXCD, off = wgid / NXCD; wgid = (xcd < r ? xcd * (q + 1) : r * (q + 1) + (xcd - r) * q) + off; }
        const int nig = WGM * nN, gid = wgid / nig, fm = gid * WGM, gsz = (nM - fm) < WGM ? (nM - fm) : WGM;
        int pm = fm + ((wgid % nig) % gsz); const int pn = (wgid % nig) / gsz;
        if (skipctx) pm += 1 + (pm >= 64 ? 1 : 0);
        u.a0 = A + (size_t)pm * BM * lda * 2; u.b0 = Bt + (size_t)pn * BM * ldb * 2; u.b1 = u.b0 + (size_t)(K / BK / 2) * BK * 2;
        u.i0 = pm; u.i1 = pn; u.i2 = 0; u.i3 = 0; u.i4 = 0; u.pad = 0; return true;
    }
    __device__ __forceinline__ int arow(const Unit&, int rl) const { return rl; }
    __device__ __forceinline__ const int* rows_ptr(const Unit&) const { return nullptr; }
    __device__ __forceinline__ int rows_valid(const Unit&) const { return 256; }
};
}

struct EpiProj {
    static constexpr bool PERM = true, MIDSCALE = false;
    bf16_t* O;
    __device__ __forceinline__ void operator()(const f32x4 (&acc)[2][2][4][2], const pg8::Unit& u, int wr, int wc, int fr, int fq) const {
        const int row0 = u.i0 * 256 + wr * 64 + fr, col0 = u.i1 * 256 + wc * 32 + 8 * fq;
#pragma unroll
        for (int ai = 0; ai < 2; ++ai)
#pragma unroll
            for (int m = 0; m < 4; ++m) { bf16_t* rowp = O + (size_t)(row0 + ai * 128 + m * 16) * NPROJ + col0;
#pragma unroll
                for (int bj = 0; bj < 2; ++bj) { const f32x4 v0 = acc[ai][bj][m][0], v1 = acc[ai][bj][m][1];
                    u32x4 w; w.x = cvt_pk_bf16(v0[0], v0[1]); w.y = cvt_pk_bf16(v0[2], v0[3]); w.z = cvt_pk_bf16(v1[0], v1[1]); w.w = cvt_pk_bf16(v1[2], v1[3]);
                    *(u32x4*)(rowp + bj * 128) = w; } }
    }
};
template <int L0> struct EpiResid {
    static constexpr bool PERM = true, MIDSCALE = true;
    const float* inc; const float* inx; bf16_t* H; const float* modl; const float* ssq;
    __device__ __forceinline__ void midscale(f32x4 (&acc)[2][2][4][2], const pg8::Unit& u, int wr, int wc, int fr, int fq) const {
        typedef float f32x2 __attribute__((ext_vector_type(2)));
        const int r0 = u.i0 * 256 + wr * 64 + fr;
        f32x2 part[2][4];
#pragma unroll
        for (int ai = 0; ai < 2; ++ai)
#pragma unroll
            for (int m = 0; m < 4; ++m) part[ai][m] = *(const f32x2*)(ssq + (size_t)(r0 + ai * 128 + m * 16) * 8 + 2 * fq);
#pragma unroll
        for (int ai = 0; ai < 2; ++ai)
#pragma unroll
            for (int m = 0; m < 4; ++m) { float sq = part[ai][m][0] + part[ai][m][1];
                sq += __shfl_xor(sq, 16); sq += __shfl_xor(sq, 32);
                const float rs = rsqrtf(sq * (1.f / 512.f) + 1e-6f);
#pragma unroll
                for (int bj = 0; bj < 2; ++bj)
#pragma unroll
                    for (int n = 0; n < 2; ++n) acc[ai][bj][m][n] *= rs; }
    }
    __device__ __forceinline__ void operator()(const f32x4 (&acc)[2][2][4][2], const pg8::Unit& u, int wr, int wc, int fr, int fq) const {
        const int r0 = u.i0 * 256;
        const int v = row_v(r0);
        const float* gate = modl + (size_t)v * 6144 + 2 * 1024;
        const float* xin = xin_ptr(inc, inx, r0);
        const int rl0 = wr * 64 + fr, col0 = u.i1 * 256 + wc * 32 + 8 * fq;
        f32x4 gv[2][2];
#pragma unroll
        for (int bj = 0; bj < 2; ++bj)
#pragma unroll
            for (int n = 0; n < 2; ++n) gv[bj][n] = *(const f32x4*)(gate + col0 + bj * 128 + 4 * n);
#pragma unroll
        for (int ai = 0; ai < 2; ++ai)
#pragma unroll
            for (int mp = 0; mp < 2; ++mp) {
                if (L0) {
                    f32x4 hi[2][2][2];
#pragma unroll
                    for (int mm = 0; mm < 2; ++mm) { const size_t off = (size_t)(rl0 + ai * 128 + (2 * mp + mm) * 16) * D + col0;
#pragma unroll
                        for (int bj = 0; bj < 2; ++bj)
#pragma unroll
                            for (int n = 0; n < 2; ++n) hi[mm][bj][n] = *(const f32x4*)(xin + off + bj * 128 + 4 * n); }
#pragma unroll
                    for (int mm = 0; mm < 2; ++mm)
#pragma unroll
                        for (int bj = 0; bj < 2; ++bj) { const f32x4 o0 = hi[mm][bj][0] + gv[bj][0] * acc[ai][bj][2 * mp + mm][0], o1 = hi[mm][bj][1] + gv[bj][1] * acc[ai][bj][2 * mp + mm][1];
                            u32x4 w; w.x = cvt_pk_bf16(o0[0], o0[1]); w.y = cvt_pk_bf16(o0[2], o0[3]); w.z = cvt_pk_bf16(o1[0], o1[1]); w.w = cvt_pk_bf16(o1[2], o1[3]);
                            *(u32x4*)(H + (size_t)(r0 + rl0 + ai * 128 + (2 * mp + mm) * 16) * D + col0 + bj * 128) = w; }
                } else {
                    u32x4 hr[2][2];
#pragma unroll
                    for (int mm = 0; mm < 2; ++mm)
#pragma unroll
                        for (int bj = 0; bj < 2; ++bj) hr[mm][bj] = *(const u32x4*)(H + (size_t)(r0 + rl0 + ai * 128 + (2 * mp + mm) * 16) * D + col0 + bj * 128);
#pragma unroll
                    for (int mm = 0; mm < 2; ++mm)
#pragma unroll
                        for (int bj = 0; bj < 2; ++bj) { const u32x4 hv = hr[mm][bj]; const f32x4 a0 = acc[ai][bj][2 * mp + mm][0], a1 = acc[ai][bj][2 * mp + mm][1]; const f32x4 g0 = gv[bj][0], g1 = gv[bj][1];
                            u32x4 w;
                            w.x = cvt_pk_bf16(bflo(hv.x) + g0[0] * a0[0], bfhi(hv.x) + g0[1] * a0[1]); w.y = cvt_pk_bf16(bflo(hv.y) + g0[2] * a0[2], bfhi(hv.y) + g0[3] * a0[3]);
                            w.z = cvt_pk_bf16(bflo(hv.z) + g1[0] * a1[0], bfhi(hv.z) + g1[1] * a1[1]); w.w = cvt_pk_bf16(bflo(hv.w) + g1[2] * a1[2], bfhi(hv.w) + g1[3] * a1[3]);
                            *(u32x4*)(H + (size_t)(r0 + rl0 + ai * 128 + (2 * mp + mm) * 16) * D + col0 + bj * 128) = w; }
                }
                asm volatile("" ::: "memory"); }
    }
};

struct MoeSched {
    const LAS int* tab;
    const int* list;
    const char* A; const char* W; int mode  , l, G, c;
    __device__ __forceinline__ bool get(int i, pg8::Unit& u) const {
        const int L = i * G + c; const int total = __builtin_amdgcn_readfirstlane(tab[24]) * 4; if (L >= total) return false;
        const int tl = L >> 2, pn = L & 3;
        int cls = 0;
#pragma unroll 1
        for (int q = 1; q < NCLS; ++q) { const int tq = __builtin_amdgcn_readfirstlane(tab[q]); if (tq <= tl) cls = q; }
        const int j = tl - __builtin_amdgcn_readfirstlane(tab[cls]), cnt = __builtin_amdgcn_readfirstlane(tab[32 + cls]);
        const int g = cls / 6, pidx = cls - g * 6;
        const int ea = (pidx >= 3) + (pidx >= 5), eb = pidx < 3 ? pidx + 1 : (pidx < 5 ? pidx - 1 : 3);
        if (mode == 0) {
            const int e = 4 * g + (pn < 2 ? ea : eb);
            u.a0 = A;
            u.b0 = W + ((size_t)(l * 16 + e) * 512 + (size_t)(pn & 1) * 256) * 1024 * 2; u.b1 = u.b0 + (size_t)8 * 128;
        } else {
            u.a0 = A + (size_t)tl * 256 * 512 * 2;
            u.b0 = W + ((size_t)(l * 16 + 4 * g + ea) * 1024 + (size_t)pn * 256) * 256 * 2;
            u.b1 = W + ((size_t)(l * 16 + 4 * g + eb) * 1024 + (size_t)pn * 256) * 256 * 2;
        }
        u.i0 = cls; u.i1 = j; u.i2 = pn; u.i3 = cnt; u.i4 = tl; u.pad = 0; return true;
    }
    __device__ __forceinline__ int arow(const pg8::Unit& u, int rl) const {
        int idx = u.i1 * 256 + rl; idx = idx < u.i3 ? idx : u.i3 - 1;
        return list[(size_t)u.i0 * R + idx];
    }
    __device__ __forceinline__ const int* rows_ptr(const pg8::Unit& u) const { return list + (size_t)u.i0 * R + u.i1 * 256; }
    __device__ __forceinline__ int rows_valid(const pg8::Unit& u) const { return u.i3 - u.i1 * 256; }
};
struct EpiUp {
    static constexpr bool PERM = true, MIDSCALE = false;
    bf16_t* hid; const float* cwla; const float* cwlb;
    __device__ __forceinline__ void operator()(const f32x4 (&acc)[2][2][4][2], const pg8::Unit& u, int wr, int wc, int fr, int fq) const {
        const int cls = u.i0, j = u.i1, pn = u.i2, cnt = u.i3, tl = u.i4;
        const float* cw = (pn < 2) ? cwla : cwlb;
        const int colbase = (pn >> 1) * 256 + (pn & 1) * 128 + wc * 32 + 8 * fq;
        float wrow[2][4];
#pragma unroll
        for (int ai = 0; ai < 2; ++ai)
#pragma unroll
            for (int m = 0; m < 4; ++m) { const int idx = j * 256 + ai * 128 + wr * 64 + m * 16 + fr; wrow[ai][m] = idx < cnt ? cw[(size_t)cls * R + idx] : 0.f; }
#pragma unroll
        for (int ai = 0; ai < 2; ++ai)
#pragma unroll
            for (int m = 0; m < 4; ++m) {
                const int rl = ai * 128 + wr * 64 + m * 16 + fr; const int idx = j * 256 + rl; const bool valid = idx < cnt;
                const float w = wrow[ai][m];
                const f32x4 g0 = acc[ai][0][m][0], g1 = acc[ai][0][m][1], u0 = acc[ai][1][m][0], u1 = acc[ai][1][m][1];
                float o[8];
#pragma unroll
                for (int e = 0; e < 4; ++e) { o[e] = w * siluf_(g0[e]) * u0[e]; o[4 + e] = w * siluf_(g1[e]) * u1[e]; }
                if (!valid) {
#pragma unroll
                    for (int e = 0; e < 8; ++e) o[e] = 0.f; }
                u32x4 pk; pk.x = cvt_pk_bf16(o[0], o[1]); pk.y = cvt_pk_bf16(o[2], o[3]); pk.z = cvt_pk_bf16(o[4], o[5]); pk.w = cvt_pk_bf16(o[6], o[7]);
                *(u32x4*)(hid + ((size_t)tl * 256 + rl) * 512 + colbase) = pk;
                asm volatile("" ::: "memory");
            }
    }
};
struct EpiY {
    static constexpr bool PERM = true, MIDSCALE = false;
    bf16_t* Y;
    __device__ __forceinline__ void operator()(const f32x4 (&acc)[2][2][4][2], const pg8::Unit& u, int wr, int wc, int fr, int fq) const {
        const int row0 = u.i4 * 256 + wr * 64 + fr, col0 = u.i2 * 256 + wc * 32 + 8 * fq;
#pragma unroll
        for (int ai = 0; ai < 2; ++ai)
#pragma unroll
            for (int m = 0; m < 4; ++m) { bf16_t* rowp = Y + (size_t)(row0 + ai * 128 + m * 16) * 1024 + col0;
#pragma unroll
                for (int bj = 0; bj < 2; ++bj) { const f32x4 v0 = acc[ai][bj][m][0], v1 = acc[ai][bj][m][1];
                    u32x4 w; w.x = cvt_pk_bf16(v0[0], v0[1]); w.y = cvt_pk_bf16(v0[2], v0[3]); w.z = cvt_pk_bf16(v1[0], v1[1]); w.w = cvt_pk_bf16(v1[2], v1[3]);
                    *(u32x4*)(rowp + bj * 128) = w; } }
    }
};

__device__ __forceinline__ void tr_tile(const float* src, int ldn, int k0, int n0, int nvalid, bf16_t* dst, int ldk, int drow0, LAS float* tile, int kd0 = -1, const float* kscale = nullptr) {
    const int tid = launder_tid();
    if (kd0 < 0) kd0 = k0;
    { const int n = tid & 63; const int kq = tid >> 6; float tv[8], ts[8];
#pragma unroll
      for (int it = 0; it < 8; ++it) { const int kk = kq + 8 * it; tv[it] = (n < nvalid) ? src[(size_t)(k0 + kk) * ldn + n0 + n] : 0.f; ts[it] = kscale ? kscale[kk] : 1.f; }
#pragma unroll
      for (int it = 0; it < 8; ++it) tile[(kq + 8 * it) * 65 + n] = tv[it] * ts[it]; }
    __syncthreads();
    { const int k8 = tid & 7, n = tid >> 3;
      if (n < nvalid) { const LAS float* s = tile + (k8 * 8) * 65 + n;
          u32x4 o; o.x = cvt_pk_bf16(s[0], s[65]); o.y = cvt_pk_bf16(s[2 * 65], s[3 * 65]); o.z = cvt_pk_bf16(s[4 * 65], s[5 * 65]); o.w = cvt_pk_bf16(s[6 * 65], s[7 * 65]);
          *(u32x4*)(dst + (size_t)(drow0 + n) * ldk + kd0 + k8 * 8) = o; } }
    __syncthreads();
}
__device__ __forceinline__ void phase_wprep(CP p, unsigned char* lds, int bid, int nb) {
    LAS float* tile = (LAS float*)(LAS unsigned char*)lds;
    constexpr int I_IN = 16 * 41, I_OUT = 256, I_G = 1024, I_U = 1024, I_D = 1024, I_L = I_IN + I_OUT + I_G + I_U + I_D;
    for (int it = bid; it < 2 * I_L; it += nb) {
        const int l = it / I_L; int r = it - l * I_L;
        if (r < I_IN) { const int kt = r / 41, ntl = r % 41; const int n0 = ntl * 64; const int nv = (DIN - n0) < 64 ? (DIN - n0) : 64;
            tr_tile(p->w_in + (size_t)l * 1024 * DIN, DIN, kt * 64, n0, nv, (bf16_t*)(p->ws + WS_WTIN) + (size_t)l * DIN * 1024, 1024, n0, tile); continue; }
        r -= I_IN;
        if (r < I_OUT) { const int kt = r >> 4, ntl = r & 15;
            tr_tile(p->w_out + (size_t)l * 1024 * 1024, 1024, kt * 64, ntl * 64, 64, (bf16_t*)(p->ws + WS_WTOUT) + (size_t)l * 1024 * 1024, 1024, ntl * 64, tile,
                    (kt * 64 + 512) & 1023, kt >= 8 ? p->ssd_norm_g + l * 512 + (kt * 64 - 512) : nullptr); continue; }
        r -= I_OUT;
        if (r < I_G + I_U) { const int up = r >= I_G; if (up) r -= I_G; const int e = r >> 6, q = r & 63, kt = q >> 2, ntl = q & 3; const int n0 = ntl * 64;
            const float* src = (up ? p->w_up : p->w_gate) + (size_t)(l * 16 + e) * 1024 * 256;
            tr_tile(src, 256, kt * 64, n0, 64, (bf16_t*)(p->ws + WS_WTGU) + (size_t)(l * 16 + e) * 512 * 1024, 1024, (n0 >> 7) * 256 + (n0 & 127) + (up ? 128 : 0), tile); continue; }
        r -= I_G + I_U;
        { const int e = r >> 6, q = r & 63, kt = q >> 4, ntl = q & 15;
          tr_tile(p->w_down + (size_t)(l * 16 + e) * 256 * 1024, 1024, kt * 64, ntl * 64, 64, (bf16_t*)(p->ws + WS_WTD) + (size_t)(l * 16 + e) * 1024 * 256, 256, ntl * 64, tile); }
    }
}
__device__ __forceinline__ void phase_adaln(CP p, unsigned char* lds, int bid, int nb) {
    LAS float* sc = (LAS float*)(LAS unsigned char*)lds;
    LAS float* red = sc + 3 * 1024;
    const int tid = launder_tid();
    for (int idx = tid; idx < 3 * 1024; idx += NTHREADS) { const int v = idx >> 10, k = idx & 1023; const float cv = (v < 2) ? p->c[v * 1024 + k] : p->c_ctx[k]; sc[idx] = siluf_(cv); }
    __syncthreads();
    float* mod = (float*)(p->ws + WS_MOD);
    for (int it = bid; it < 2 * 96; it += nb) {
        const int l = it / 96, n0 = (it % 96) * 64;
        const int c4 = tid & 15, kr = tid >> 4;
        f32x4 a0 = {0, 0, 0, 0}, a1 = {0, 0, 0, 0}, a2 = {0, 0, 0, 0};
        const float* w = p->w_ada + (size_t)l * 1024 * 6144 + n0 + c4 * 4;
#pragma unroll 4
        for (int k = kr; k < 1024; k += 32) { const f32x4 w4 = *(const f32x4*)(w + (size_t)k * 6144); a0 += sc[k] * w4; a1 += sc[1024 + k] * w4; a2 += sc[2048 + k] * w4; }
        *(LAS f32x4*)(red + (kr * 3 + 0) * 64 + c4 * 4) = a0; *(LAS f32x4*)(red + (kr * 3 + 1) * 64 + c4 * 4) = a1; *(LAS f32x4*)(red + (kr * 3 + 2) * 64 + c4 * 4) = a2;
        __syncthreads();
        if (tid < 192) { const int v = tid >> 6, cc = tid & 63; float s = 0.f;
            for (int q = 0; q < 32; ++q) s += red[(q * 3 + v) * 64 + cc];
            mod[((size_t)l * 3 + v) * 6144 + n0 + cc] = s + p->b_ada[l * 6144 + n0 + cc]; }
        __syncthreads();
    }
}
__device__ __forceinline__ void moe_table(CP p, int l, LAS int* tab) {
    const int* gcount = (const int*)(p->ws + WS_CTL) + l * 32;
    if (threadIdx.x == 0) { int acc = 0; for (int q = 0; q < NCLS; ++q) { const int cn = gcount[q]; tab[q] = acc; tab[32 + q] = cn; acc += (cn + 255) >> 8; } tab[24] = acc; }
    __syncthreads();
}
__device__ __forceinline__ void moe_yload(CP p, int pos, int lane, const LAS int* tab, u32x2 (&yv)[4]) {
    const int slot = tab[pos >> 16] * 256 + (pos & 0xffff);
    const bf16_t* y = (const bf16_t*)(p->ws + WS_Y) + (size_t)slot * 1024;
#pragma unroll
    for (int j = 0; j < 4; ++j) yv[j] = *(const u32x2*)(y + 4 * lane + 256 * j);
}
__device__ __forceinline__ void moe_yadd(CP p, int lm, int v, int lane, const u32x2 (&yv)[4], f32x4 (&xv)[4]) {
    const float* gate = (const float*)(p->ws + WS_MOD) + ((size_t)lm * 3 + v) * 6144 + 5 * 1024;
#pragma unroll
    for (int j = 0; j < 4; ++j) { const int k = 4 * lane + 256 * j; const f32x4 g4 = *(const f32x4*)(gate + k);
        xv[j][0] += g4[0] * bflo(yv[j].x); xv[j][1] += g4[1] * bfhi(yv[j].x); xv[j][2] += g4[2] * bflo(yv[j].y); xv[j][3] += g4[3] * bfhi(yv[j].y); }
}
__device__ __forceinline__ void phase_r1(CP p, int l, unsigned char* lds, int bid, int nb) {
    LAS float* wdt = (LAS float*)(LAS unsigned char*)lds;
    LAS float* gm = wdt + 16 * 1024;
    LAS float* sh = gm + 3 * 1024;
    const int tid = launder_tid(); const int lane = tid & 63, wave = tid >> 6;
    const float* mod = (const float*)(p->ws + WS_MOD) + (size_t)l * 3 * 6144;
    const float* win = p->w_in + (size_t)l * 1024 * DIN;
#pragma unroll
    for (int hb = 0; hb < 2; ++hb) { float tmp[16];
#pragma unroll
        for (int it = 0; it < 16; ++it) { const int idx = tid + NTHREADS * (16 * hb + it); tmp[it] = win[(size_t)(idx >> 4) * DIN + NPROJ + (idx & 15)]; }
#pragma unroll
        for (int it = 0; it < 16; ++it) { const int idx = tid + NTHREADS * (16 * hb + it); wdt[(idx & 15) * 1024 + (idx >> 4)] = tmp[it]; } }
    { float t0[6], t1[6], t2[6];
#pragma unroll
      for (int it = 0; it < 6; ++it) { const int idx = tid + NTHREADS * it; const int v = idx >> 10, k = idx & 1023; t0[it] = p->g_mix[l * 1024 + k]; t1[it] = mod[v * 6144 + 1024 + k]; t2[it] = mod[v * 6144 + k]; }
#pragma unroll
      for (int it = 0; it < 6; ++it) { const int idx = tid + NTHREADS * it; gm[idx] = t0[it] * (1.f + t1[it]); sh[idx] = t2[it]; } }
    LAS int* tab = (LAS int*)((LAS unsigned char*)lds + MISC_OFF);
    if (l > 0) moe_table(p, l - 1, tab);
    __syncthreads();
    bf16_t* HX = (bf16_t*)(p->ws + WS_HX); float* DT = (float*)(p->ws + WS_DT);
    const int* POS = (const int*)(p->ws + WS_POS) + (size_t)(l > 0 ? l - 1 : 0) * R;
    const int rstep = nb * 8;
    RowRaw xn; u32x2 yn[4]; int posn = 0;
    { const int r = bid * 8 + wave;
      if (r < R) { row_load(p, l, r, lane, xn);
          if (l > 0) { moe_yload(p, POS[r], lane, tab, yn); if (r + rstep < R) posn = POS[r + rstep]; } } }
    for (int r = bid * 8 + wave; r < R; r += rstep) {
        const int v = row_v(r);
        f32x4 xv[4]; u32x2 yv[4]; float ss = 0.f;
        row_cvt(l, xn, xv);
#pragma unroll
        for (int j = 0; j < 4; ++j) yv[j] = yn[j];
        { const int rn = r + rstep;
          if (rn < R) { row_load(p, l, rn, lane, xn);
              if (l > 0) { moe_yload(p, posn, lane, tab, yn); if (rn + rstep < R) posn = POS[rn + rstep]; } } }
        if (l > 0) moe_yadd(p, l - 1, v, lane, yv, xv);
        { u32x2* hw = (u32x2*)((bf16_t*)(p->ws + WS_H) + (size_t)r * D);
#pragma unroll
          for (int j = 0; j < 4; ++j) { u32x2 o; o.x = cvt_pk_bf16(xv[j][0], xv[j][1]); o.y = cvt_pk_bf16(xv[j][2], xv[j][3]); hw[lane + 64 * j] = o; } }
#pragma unroll
        for (int j = 0; j < 4; ++j) ss += xv[j][0] * xv[j][0] + xv[j][1] * xv[j][1] + xv[j][2] * xv[j][2] + xv[j][3] * xv[j][3];
        ss = wave_sum(ss); const float rs = rsqrtf(ss * (1.f / 1024.f) + 1e-6f);
#pragma unroll
        for (int j = 0; j < 4; ++j) { const int k = 4 * lane + 256 * j; const f32x4 g4 = *(const LAS f32x4*)(gm + v * 1024 + k), s4 = *(const LAS f32x4*)(sh + v * 1024 + k);
            xv[j] = xv[j] * rs * g4 + s4;
            u32x2 o; o.x = cvt_pk_bf16(xv[j][0], xv[j][1]); o.y = cvt_pk_bf16(xv[j][2], xv[j][3]);
            *(u32x2*)(HX + (size_t)r * 1024 + k) = o; }
        float mine = 0.f;
#pragma unroll
        for (int n = 0; n < 16; ++n) { float a = 0.f;
#pragma unroll
            for (int j = 0; j < 4; ++j) { const f32x4 w4 = *(const LAS f32x4*)(wdt + n * 1024 + 4 * lane + 256 * j); a += xv[j][0] * w4[0] + xv[j][1] * w4[1] + xv[j][2] * w4[2] + xv[j][3] * w4[3]; }
            a = wave_sum(a); mine = (lane == n) ? a : mine; }
        if (lane < 16) DT[(size_t)r * 16 + lane] = softplusf_(mine + p->dt_bias[l * 16 + lane]);
    }
}
typedef float f32x16 __attribute__((ext_vector_type(16)));
typedef short s16x4 __attribute__((ext_vector_type(4)));
constexpr int ST_ROW = 272;
constexpr int ST_TR128 = 320;
constexpr int ST_TR64 = 192;
constexpr int NCHUNK = SEG / 128;

#define DPP_MOV(v, ctrl, rm, bm) __builtin_bit_cast(float, __builtin_amdgcn_update_dpp(0, __builtin_bit_cast(int, (v)), (ctrl), (rm), (bm), true))
__device__ __forceinline__ float wave_incl_scan(float v, int) {
    float s = v + DPP_MOV(v, 0x111, 0xF, 0xF) + DPP_MOV(v, 0x112, 0xF, 0xF) + DPP_MOV(v, 0x113, 0xF, 0xF);
    s += DPP_MOV(s, 0x114, 0xF, 0xE);
    s += DPP_MOV(s, 0x118, 0xF, 0xC);
    s += DPP_MOV(s, 0x142, 0xA, 0xF);
    s += DPP_MOV(s, 0x143, 0xC, 0xF);
    return s;
}
__device__ __forceinline__ bf16x8 row_frag(const LAS unsigned char* tile, int stride, int row0, int k0, int lane) {
    return *(const LAS bf16x8*)(tile + (row0 + (lane & 31)) * stride + (k0 + 8 * (lane >> 5)) * 2);
}
__device__ __forceinline__ bf16x8 tr_frag(const LAS unsigned char* tile, int stride, int k0, int c0, int lane) {
    const int g = lane >> 4, li = lane & 15, q = li >> 2, pp = li & 3;
    const LAS unsigned char* a0 = tile + (k0 + 8 * (g >> 1) + q) * stride + (c0 + 16 * (g & 1) + 4 * pp) * 2;
    const s16x4 lo = __builtin_amdgcn_ds_read_tr16_b64_v4i16((LAS s16x4*)a0);
    const s16x4 hi = __builtin_amdgcn_ds_read_tr16_b64_v4i16((LAS s16x4*)(a0 + 4 * stride));
    return __builtin_shufflevector(lo, hi, 0, 1, 2, 3, 4, 5, 6, 7);
}
__device__ __forceinline__ u32x4 pack8(const float (&v)[8]) { u32x4 r; r.x = cvt_pk_bf16(v[0], v[1]); r.y = cvt_pk_bf16(v[2], v[3]); r.z = cvt_pk_bf16(v[4], v[5]); r.w = cvt_pk_bf16(v[6], v[7]); return r; }
__device__ __forceinline__ u32x4 pack8s(const float (&v)[8], float sc) { u32x4 r; r.x = cvt_pk_bf16(v[0] * sc, v[1] * sc); r.y = cvt_pk_bf16(v[2] * sc, v[3] * sc); r.z = cvt_pk_bf16(v[4] * sc, v[5] * sc); r.w = cvt_pk_bf16(v[6] * sc, v[7] * sc); return r; }

__device__ __forceinline__ void conv_load(const bf16_t* proj, int row0, int rq, int xch, bool lo_ok, bool hi_ok, u32x4 (&raw)[8]) {
    const bf16_t* base = proj + (size_t)(row0 + 4 * rq) * NPROJ + 1536 + xch;
    unsigned zz; asm volatile("v_mov_b32 %0, 0" : "=v"(zz));
#pragma unroll
    for (int j = 0; j < 8; ++j) {
        if (j < 2) { const bool ok = (rq > 0) || lo_ok; const u32x4 v = *(const u32x4*)(ok ? base + (j - 2) * NPROJ : base);
            raw[j].x = ok ? v.x : zz; raw[j].y = ok ? v.y : zz; raw[j].z = ok ? v.z : zz; raw[j].w = ok ? v.w : zz; }
        else if (j >= 6) { const bool ok = (rq < 31) || hi_ok; const u32x4 v = *(const u32x4*)(ok ? base + (j - 2) * NPROJ : base);
            raw[j].x = ok ? v.x : zz; raw[j].y = ok ? v.y : zz; raw[j].z = ok ? v.z : zz; raw[j].w = ok ? v.w : zz; }
        else raw[j] = *(const u32x4*)(base + (j - 2) * NPROJ);
    }
}
__device__ __forceinline__ void conv_compute(const u32x4 (&raw)[8], const LAS float* wl, int nchl, int wch, float (&o)[4][8]) {
    float w[5][8], bs[8];
#pragma unroll
    for (int j = 0; j < 5; ++j) { const f32x4 w0 = *(const LAS f32x4*)(wl + j * nchl + wch), w1 = *(const LAS f32x4*)(wl + j * nchl + wch + 4);
        w[j][0] = w0[0]; w[j][1] = w0[1]; w[j][2] = w0[2]; w[j][3] = w0[3]; w[j][4] = w1[0]; w[j][5] = w1[1]; w[j][6] = w1[2]; w[j][7] = w1[3]; }
    { const f32x4 b0 = *(const LAS f32x4*)(wl + 5 * nchl + wch), b1 = *(const LAS f32x4*)(wl + 5 * nchl + wch + 4); bs[0] = b0[0]; bs[1] = b0[1]; bs[2] = b0[2]; bs[3] = b0[3]; bs[4] = b1[0]; bs[5] = b1[1]; bs[6] = b1[2]; bs[7] = b1[3]; }
#pragma unroll
    for (int i = 0; i < 4; ++i)
#pragma unroll
        for (int e = 0; e < 8; ++e) o[i][e] = bs[e];
#pragma unroll
    for (int j = 0; j < 8; ++j) {
        float xv[8] = {bflo(raw[j].x), bfhi(raw[j].x), bflo(raw[j].y), bfhi(raw[j].y), bflo(raw[j].z), bfhi(raw[j].z), bflo(raw[j].w), bfhi(raw[j].w)};
#pragma unroll
        for (int i = 0; i < 4; ++i) { const int tap = j - i; if (tap >= 0 && tap < 5) {
#pragma unroll
                for (int e = 0; e < 8; ++e) o[i][e] += w[tap][e] * xv[e]; } }
    }
#pragma unroll
    for (int i = 0; i < 4; ++i)
#pragma unroll
        for (int e = 0; e < 8; ++e) o[i][e] = siluf_(o[i][e]);
}
__device__ __forceinline__ void head_cums(CP p, int l, int row0, int h, int dir, int lane, LAS float* hv) {
    const float A = -expf(p->a_log[l * 16 + dir * 8 + h]);
    const float* DT = (const float*)(p->ws + WS_DT);
    const float d0 = DT[(size_t)(row0 + 2 * lane) * 16 + dir * 8 + h], d1 = DT[(size_t)(row0 + 2 * lane + 1) * 16 + dir * 8 + h];
    const float x0 = d0 * A, x1 = d1 * A;
    const float incl = wave_incl_scan(x0 + x1, lane);
    const float total = __builtin_bit_cast(float, __builtin_amdgcn_readlane(__builtin_bit_cast(int, incl), 63));
    float c0, c1;
    if (dir == 0) { c1 = incl; c0 = incl - x1; } else { c0 = total - (incl - x1 - x0); c1 = total - (incl - x1); }
    hv[dir * 128 + 2 * lane] = c0; hv[dir * 128 + 2 * lane + 1] = c1;
    hv[256 + dir * 128 + 2 * lane] = d0; hv[256 + dir * 128 + 2 * lane + 1] = d1;
    if (lane == 0) hv[512 + dir] = total;
}
__device__ __forceinline__ bf16x8 scale_frag(bf16x8 f, const f32x4 w0, const f32x4 w1) {
    const u32x4 u = __builtin_bit_cast(u32x4, f);
    u32x4 r;
    r.x = cvt_pk_bf16(bflo(u.x) * w0[0], bfhi(u.x) * w0[1]); r.y = cvt_pk_bf16(bflo(u.y) * w0[2], bfhi(u.y) * w0[3]);
    r.z = cvt_pk_bf16(bflo(u.z) * w1[0], bfhi(u.z) * w1[1]); r.w = cvt_pk_bf16(bflo(u.w) * w1[2], bfhi(u.w) * w1[3]);
    return __builtin_bit_cast(bf16x8, r);
}
constexpr int ST_X256 = 576;

__device__ __forceinline__ void phase_c1(CP p, int l, unsigned char* lds_, int bid, int nb) {
    LAS unsigned char* lds = (LAS unsigned char*)lds_;
    LAS unsigned char* tile = lds;
    LAS float* wl = (LAS float*)(lds + 73216);
    const int tid = launder_tid();
    const bf16_t* proj = (const bf16_t*)(p->ws + WS_PROJ); bf16_t* mix = (bf16_t*)(p->ws + WS_HX);
#pragma unroll 1
    for (int u = bid; u < 256 + 512 + (l == DEPTH - 1 ? 0 : 16); u += nb) {
        int S, LEN, pstride, sstride, tok0, ch0;
        if (u < 256) { const int b = u >> 7, cs = (u >> 2) & 31, cc = u & 3; S = 2; LEN = 256; pstride = 64; sstride = 1; tok0 = b * SEG + CTXL + 2 * cs; ch0 = 256 + 64 * cc; }
        else if (u < 768) { const int v = u - 256; const int b = v >> 8, rg = (v >> 2) & 63, cc = v & 3; S = 4; LEN = 64; pstride = 1; sstride = 64; tok0 = b * SEG + CTXL + 256 * rg; ch0 = 64 * cc; }
        else { const int v = u - 768; const int b = v >> 3, cc = v & 7; S = 1; LEN = 256; pstride = 1; sstride = 0; tok0 = b * SEG; ch0 = 64 * cc; }
        const int LP = LEN + 30;
        { float tw[4];
#pragma unroll
          for (int it = 0; it < 4; ++it) { const int i = tid + NTHREADS * it; const int j = i >> 6, c = i & 63; tw[it] = j < 31 ? p->conv_w[((size_t)l * 31 + j) * 512 + ch0 + c] : p->conv_b[l * 512 + ch0 + c]; }
#pragma unroll
          for (int it = 0; it < 4; ++it) wl[tid + NTHREADS * it] = tw[it]; }
        for (int i = tid; i < S * 30 * 8; i += NTHREADS) { const int pc = i & 7, q = (i >> 3) % 30, sq = (i >> 3) / 30; const int pos = q < 15 ? q : LEN + q;
            unsigned zz; asm volatile("v_mov_b32 %0, 0" : "=v"(zz));
            *(LAS u32x4*)(tile + ((sq * LP + pos) * 64 + pc * 8) * 2) = (u32x4){zz, zz, zz, zz}; }
#pragma unroll 4
        for (int i = tid; i < S * LEN * 8; i += NTHREADS) { const int pc = i & 7, t = i >> 3; const int sq = t / LEN, pos = t - sq * LEN;
            const bf16_t* src = proj + (size_t)(tok0 + sq * sstride + pos * pstride) * NPROJ + ch0 + pc * 8;
            const u32x4 uv = *(const u32x4*)src, gv = *(const u32x4*)(src + 512);
            u32x4 o;
            o.x = cvt_pk_bf16(bflo(uv.x) * sigmoidf_(bflo(gv.x)), bfhi(uv.x) * sigmoidf_(bfhi(gv.x)));
            o.y = cvt_pk_bf16(bflo(uv.y) * sigmoidf_(bflo(gv.y)), bfhi(uv.y) * sigmoidf_(bfhi(gv.y)));
            o.z = cvt_pk_bf16(bflo(uv.z) * sigmoidf_(bflo(gv.z)), bfhi(uv.z) * sigmoidf_(bfhi(gv.z)));
            o.w = cvt_pk_bf16(bflo(uv.w) * sigmoidf_(bflo(gv.w)), bfhi(uv.w) * sigmoidf_(bfhi(gv.w)));
            *(LAS u32x4*)(tile + ((sq * LP + 15 + pos) * 64 + pc * 8) * 2) = o; }
        __syncthreads();
        const int noct = S * LEN / 8;
#pragma unroll 1
        for (int it = tid; it < noct * 32; it += NTHREADS) {
            const int cp = it & 31, oc = it >> 5; const int sq = oc / (LEN / 8), p0 = (oc - sq * (LEN / 8)) * 8;
            const LAS unsigned* base = (const LAS unsigned*)(tile + ((sq * LP + p0) * 64) * 2) + cp;
            float i0[38], i1[38];
#pragma unroll
            for (int k = 0; k < 38; ++k) { const unsigned w = base[k * 32]; i0[k] = bflo(w); i1[k] = bfhi(w); }
            float a0[8], a1[8];
            { const float b0 = wl[31 * 64 + 2 * cp], b1 = wl[31 * 64 + 2 * cp + 1];
#pragma unroll
              for (int i = 0; i < 8; ++i) { a0[i] = b0; a1[i] = b1; } }
#pragma unroll
            for (int j = 0; j < 31; ++j) { typedef float f32x2 __attribute__((ext_vector_type(2))); const f32x2 wj = *(const LAS f32x2*)(wl + j * 64 + 2 * cp); const float w0 = wj[0], w1 = wj[1];
#pragma unroll
                for (int i = 0; i < 8; ++i) { a0[i] += w0 * i0[i + j]; a1[i] += w1 * i1[i + j]; } }
#pragma unroll
            for (int i = 0; i < 8; ++i) { const int tok = tok0 + sq * sstride + (p0 + i) * pstride;
                *(unsigned*)(mix + (size_t)tok * 1024 + 512 + ch0 + 2 * cp) = cvt_pk_bf16(a0[i], a1[i]); }
        }
        __syncthreads();
    }
}
__device__ __forceinline__ void phase_c1_ln(CP p, int l, int bid, int nb) {
    const int tid = launder_tid(); const int lane = tid & 63, wave = tid >> 6;
    bf16_t* mix = (bf16_t*)(p->ws + WS_HX);
    const f32x4 g0 = *(const f32x4*)(p->conv_ln_g + l * 512 + lane * 8), g1 = *(const f32x4*)(p->conv_ln_g + l * 512 + lane * 8 + 4);
    const f32x4 b0 = *(const f32x4*)(p->conv_ln_b + l * 512 + lane * 8), b1 = *(const f32x4*)(p->conv_ln_b + l * 512 + lane * 8 + 4);
    const float gg[8] = {g0[0], g0[1], g0[2], g0[3], g1[0], g1[1], g1[2], g1[3]}, bb[8] = {b0[0], b0[1], b0[2], b0[3], b1[0], b1[1], b1[2], b1[3]};
    for (int r = bid * 8 + wave; r < R; r += nb * 8) {
        u32x4* ptr = (u32x4*)(mix + (size_t)r * 1024 + 512 + lane * 8);
        const u32x4 v = *ptr;
        float y[8] = {bflo(v.x), bfhi(v.x), bflo(v.y), bfhi(v.y), bflo(v.z), bfhi(v.z), bflo(v.w), bfhi(v.w)};
        float s = 0.f;
#pragma unroll
        for (int e = 0; e < 8; ++e) s += y[e];
        const float mu = wave_sum(s) * (1.f / 512.f);
        float q = 0.f;
#pragma unroll
        for (int e = 0; e < 8; ++e) { y[e] -= mu; q += y[e] * y[e]; }
        const float rstd = rsqrtf(wave_sum(q) * (1.f / 512.f) + 1e-5f);
        float o[8];
#pragma unroll
        for (int e = 0; e < 8; ++e) o[e] = siluf_(y[e] * rstd * gg[e] + bb[e]);
        *ptr = pack8(o);
    }
}
__device__ __forceinline__ void phase_s1(CP p, int l, unsigned char* lds_, int bid, int nb) {
    LAS unsigned char* lds = (LAS unsigned char*)lds_;
    LAS unsigned char* Bs = lds;
    LAS unsigned char* Xs = lds + 128 * ST_TR128;
    LAS float* wv = (LAS float*)(Xs + 128 * ST_X256);
    LAS float* hvs = wv + 8 * 128;
    LAS float* cwl = hvs + 4 * 520;
    const int tid = launder_tid(); const int lane = tid & 63, wave = __builtin_amdgcn_readfirstlane(tid >> 6);
    const bf16_t* proj = (const bf16_t*)(p->ws + WS_PROJ);
    const float* cw = p->ssd_conv_w + (size_t)l * 5 * 1024; const float* cbias = p->ssd_conv_b + (size_t)l * 1024;
    bf16_t* Sg = (bf16_t*)(p->ws + WS_S); float* DEC = (float*)(p->ws + WS_DEC);
    int cur_g = -1;
#pragma unroll 1
    for (int u = bid; u < NB * NCHUNK * 2; u += nb) {
        const int g = u & 1, c = (u >> 1) % NCHUNK, b = (u >> 1) / NCHUNK;
        const int row0 = b * SEG + c * 128;
        const bool lo_ok = !(c == 0 || c == 2), hi_ok = !(c == 1 || c == NCHUNK - 1);
        if (g != cur_g) { cur_g = g;
            float tw[5];
#pragma unroll
            for (int it = 0; it < 5; ++it) { const int i = tid + NTHREADS * it; const int j = i / 384, lc = i - j * 384; const int gch = lc < 128 ? 512 + g * 128 + lc : g * 256 + (lc - 128);
                tw[it] = i < 6 * 384 ? (j < 5 ? cw[j * 1024 + gch] : cbias[gch]) : 0.f; }
#pragma unroll
            for (int it = 0; it < 5; ++it) { const int i = tid + NTHREADS * it; if (i < 6 * 384) cwl[i] = tw[it]; } }
        const int hh = wave >> 1, dir = wave & 1, h = 4 * g + hh;
        u32x4 rb[8], rx0[8], rx1[8];
        conv_load(proj, row0, tid >> 4, 512 + g * 128 + (tid & 15) * 8, lo_ok, hi_ok, rb);
        conv_load(proj, row0, tid >> 5, g * 256 + (tid & 31) * 8, lo_ok, hi_ok, rx0);
        conv_load(proj, row0, (tid >> 5) + 16, g * 256 + (tid & 31) * 8, lo_ok, hi_ok, rx1);
        head_cums(p, l, row0, h, dir, lane, hvs + hh * 520);
        __syncthreads();
        {
            const LAS float* hv = hvs + hh * 520; const float tot = hv[512 + dir];
#pragma unroll
            for (int q = 0; q < 2; ++q) { const int lr = lane + 64 * q; wv[wave * 128 + lr] = __expf(tot - hv[dir * 128 + lr]) * hv[256 + dir * 128 + lr]; }
            if (lane == 0) DEC[((size_t)(b * 2 + dir) * NCHUNK + c) * 8 + h] = __expf(tot);
        }
        { float o[4][8];
          conv_compute(rb, cwl, 384, (tid & 15) * 8, o);
#pragma unroll
          for (int i = 0; i < 4; ++i) *(LAS u32x4*)(Bs + (4 * (tid >> 4) + i) * ST_TR128 + (tid & 15) * 16) = pack8(o[i]);
          conv_compute(rx0, cwl, 384, 128 + (tid & 31) * 8, o);
#pragma unroll
          for (int i = 0; i < 4; ++i) *(LAS u32x4*)(Xs + (4 * (tid >> 5) + i) * ST_X256 + (tid & 31) * 16) = pack8(o[i]);
          conv_compute(rx1, cwl, 384, 128 + (tid & 31) * 8, o);
#pragma unroll
          for (int i = 0; i < 4; ++i) *(LAS u32x4*)(Xs + (4 * ((tid >> 5) + 16) + i) * ST_X256 + (tid & 31) * 16) = pack8(o[i]); }
        __syncthreads();
        {
            f32x16 acc[2][4];
#pragma unroll
            for (int t = 0; t < 2; ++t)
#pragma unroll
                for (int q = 0; q < 4; ++q)
#pragma unroll
                    for (int e = 0; e < 16; ++e) acc[t][q][e] = 0.f;
#pragma unroll 2
            for (int kk = 0; kk < 8; ++kk) {
                const LAS float* wp = wv + wave * 128 + 16 * kk + 8 * (lane >> 5);
                const f32x4 w0 = *(const LAS f32x4*)wp, w1 = *(const LAS f32x4*)(wp + 4);
                bf16x8 af[2];
#pragma unroll
                for (int t = 0; t < 2; ++t) af[t] = scale_frag(tr_frag(Xs, ST_X256, 16 * kk, hh * 64 + 32 * t, lane), w0, w1);
#pragma unroll
                for (int q = 0; q < 4; ++q) { const bf16x8 bf = tr_frag(Bs, ST_TR128, 16 * kk, 32 * q, lane);
#pragma unroll
                    for (int t = 0; t < 2; ++t) acc[t][q] = __builtin_amdgcn_mfma_f32_32x32x16_bf16(bf, af[t], acc[t][q], 0, 0, 0); }
            }
            bf16_t* So = Sg + ((size_t)((b * 2 + dir) * NCHUNK + c) * 8 + h) * 8192 + (size_t)(lane & 31) * 128 + 4 * (lane >> 5);
#pragma unroll
            for (int t = 0; t < 2; ++t)
#pragma unroll
                for (int q = 0; q < 4; ++q)
#pragma unroll
                    for (int rg = 0; rg < 4; ++rg) { u32x2 pk; pk.x = cvt_pk_bf16(acc[t][q][4 * rg], acc[t][q][4 * rg + 1]); pk.y = cvt_pk_bf16(acc[t][q][4 * rg + 2], acc[t][q][4 * rg + 3]);
                        *(u32x2*)(So + (size_t)(32 * t) * 128 + 32 * q + 8 * rg) = pk; }
        }
        __syncthreads();
    }
}
__device__ __forceinline__ void phase_s2(CP p, int bid, int nb) {
    const int tid = launder_tid();
    const bf16_t* Sg = (const bf16_t*)(p->ws + WS_S); const float* DEC = (const float*)(p->ws + WS_DEC); bf16_t* HP = (bf16_t*)(p->ws + WS_HP);
    for (int idx = bid * NTHREADS + tid; idx < 2 * 2 * 8 * 64 * 64; idx += nb * NTHREADS) {
        const int n2 = idx & 63, pr = (idx >> 6) & 63, h = (idx >> 12) & 7, dir = (idx >> 15) & 1, b = idx >> 16;
        const size_t inner = (size_t)h * 8192 + pr * 128 + 2 * n2;
        const size_t cbase = (size_t)(b * 2 + dir) * NCHUNK;
        float s0 = 0.f, s1 = 0.f;
#pragma unroll 10
        for (int step = 0; step < NCHUNK; ++step) {
            const int c = dir == 0 ? step : (step < 2 ? 1 - step : NCHUNK + 1 - step);
            const size_t off = (cbase + c) * 65536 + inner;
            const unsigned sv = *(const unsigned*)(Sg + off); const float d = DEC[(cbase + c) * 8 + h];
            *(unsigned*)(HP + off) = cvt_pk_bf16(s0, s1);
            s0 = s0 * d + bflo(sv); s1 = s1 * d + bfhi(sv);
        }
    }
}
__device__ __forceinline__ void phase_s3(CP p, int l, unsigned char* lds_, int bid, int nb) {
    LAS unsigned char* lds = (LAS unsigned char*)lds_;
    LAS unsigned char* Cs = lds;
    LAS unsigned char* Bs = Cs + 128 * ST_ROW;
    LAS unsigned char* Mt = Bs;
    LAS unsigned char* Xs = Bs + 128 * ST_TR128;
    LAS unsigned char* Hf = Xs + 128 * ST_TR64;
    LAS unsigned char* Hb = Hf + 64 * ST_ROW;
    LAS float* hvs = (LAS float*)(Hb + 64 * ST_ROW);
    LAS float* ssqp = hvs + 4 * 520;
    LAS float* cwl = ssqp + 256;
    const int tid0 = launder_tid(); const int wave = __builtin_amdgcn_readfirstlane(tid0 >> 6);
    const bf16_t* proj = (const bf16_t*)(p->ws + WS_PROJ); bf16_t* mix = (bf16_t*)(p->ws + WS_HX);
    const float* cw = p->ssd_conv_w + (size_t)l * 5 * 1024; const float* cbias = p->ssd_conv_b + (size_t)l * 1024;
    const bf16_t* HP = (const bf16_t*)(p->ws + WS_HP); float* SSQ = (float*)(p->ws + WS_SSQ);
    int cur_g = -1;
#pragma unroll 1
    for (int u = bid; u < NB * NCHUNK * 2; u += nb) {
        const int g = u & 1, c = (u >> 1) % NCHUNK, b = (u >> 1) / NCHUNK;
        if (l == DEPTH - 1 && c < 2) continue;
        int tid = tid0; asm volatile("" : "+v"(tid));
        const int lane = tid & 63;
        const int row0 = b * SEG + c * 128;
        const bool lo_ok = !(c == 0 || c == 2), hi_ok = !(c == 1 || c == NCHUNK - 1);
        if (g != cur_g) { cur_g = g;
            float tw[6];
#pragma unroll
            for (int it = 0; it < 6; ++it) { const int i = tid + NTHREADS * it; const int j = i >> 9, lc = i & 511; const int gch = lc < 128 ? 768 + g * 128 + lc : (lc < 256 ? 512 + g * 128 + (lc - 128) : g * 256 + (lc - 256));
                tw[it] = j < 5 ? cw[j * 1024 + gch] : cbias[gch]; }
#pragma unroll
            for (int it = 0; it < 6; ++it) cwl[tid + NTHREADS * it] = tw[it]; }
        u32x4 rx[8];
        {
            u32x4 r0[8], r1[8];
            const int cg = tid & 31; const int gch = (cg < 16 ? 768 : 512) + g * 128 + (cg & 15) * 8;
            conv_load(proj, row0, tid >> 5, gch, lo_ok, hi_ok, r0);
            conv_load(proj, row0, (tid >> 5) + 16, gch, lo_ok, hi_ok, r1);
            head_cums(p, l, row0, 4 * g + (wave >> 1), wave & 1, lane, hvs + (wave >> 1) * 520);
            __syncthreads();
            float o[4][8];
            LAS unsigned char* dst = (cg < 16 ? Cs : Bs) + (cg & 15) * 16;
            conv_compute(r0, cwl, 512, cg * 8, o);
#pragma unroll
            for (int i = 0; i < 4; ++i) *(LAS u32x4*)(dst + (4 * (tid >> 5) + i) * ST_ROW) = pack8(o[i]);
            asm volatile("" ::: "memory");
            if (tid < 256) conv_load(proj, row0, tid >> 3, g * 256 + (tid & 7) * 8, lo_ok, hi_ok, rx);
            conv_compute(r1, cwl, 512, cg * 8, o);
#pragma unroll
            for (int i = 0; i < 4; ++i) *(LAS u32x4*)(dst + (4 * ((tid >> 5) + 16) + i) * ST_ROW) = pack8(o[i]);
            if (tid < 256) { conv_compute(rx, cwl, 512, 256 + (tid & 7) * 8, o);
#pragma unroll
                for (int i = 0; i < 4; ++i) *(LAS u32x4*)(Xs + (4 * (tid >> 3) + i) * ST_TR64 + (tid & 7) * 16) = pack8(o[i]); }
        }
        __syncthreads();
        const int lb = wave >> 1, hs = wave & 1;
        int ln = lane; asm volatile("" : "+v"(ln));
        f32x16 gacc[2];
#pragma unroll
        for (int t = 0; t < 2; ++t)
#pragma unroll
            for (int e = 0; e < 16; ++e) gacc[t][e] = 0.f;
#pragma unroll
        for (int kk = 0; kk < 8; ++kk) { const bf16x8 af = row_frag(Cs, ST_ROW, 32 * lb, 16 * kk, lane);
#pragma unroll
            for (int t = 0; t < 2; ++t) { const bf16x8 bf = row_frag(Bs, ST_ROW, 64 * hs + 32 * t, 16 * kk, lane);
                gacc[t] = __builtin_amdgcn_mfma_f32_32x32x16_bf16(af, bf, gacc[t], 0, 0, 0); } }
        u32x4 hreg[4];
        { const bf16_t* hp0 = HP + ((size_t)(b * 2 * NCHUNK + c) * 8 + 4 * g) * 8192;
#pragma unroll
          for (int q = 0; q < 4; ++q) { const int it = tid + 512 * q; hreg[q] = *(const u32x4*)(hp0 + (size_t)(it >> 10) * NCHUNK * 8 * 8192 + (it & 1023) * 8); } }
        __syncthreads();
#pragma unroll 1
        for (int hh = 0; hh < 4; ++hh) {
            const int h = 4 * g + hh; const LAS float* hv = hvs + hh * 520;
            asm volatile("" : "+v"(ln));
            const int ph = hs, pc = 32 * ph + (ln & 31);
#pragma unroll
            for (int t = 0; t < 2; ++t) {
                const int sc = 64 * hs + 32 * t + (ln & 31);
                const float cfs = hv[sc], cbs = hv[128 + sc], dfs = hv[256 + sc], dbs = hv[384 + sc];
#pragma unroll
                for (int rg = 0; rg < 4; ++rg) {
                    const int l0 = 32 * lb + 8 * rg + 4 * (ln >> 5);
                    const f32x4 cfl = *(const LAS f32x4*)(hv + l0), cbl = *(const LAS f32x4*)(hv + 128 + l0);
                    float m[4];
#pragma unroll
                    for (int e = 0; e < 4; ++e) { const int lr = l0 + e;
                        const float ff = lr >= sc ? __expf(cfl[e] - cfs) * dfs : 0.f;
                        const float fb = lr <= sc ? __expf(cbl[e] - cbs) * dbs : 0.f;
                        m[e] = gacc[t][4 * rg + e] * (ff + fb); }
                    u32x2 pk; pk.x = cvt_pk_bf16(m[0], m[1]); pk.y = cvt_pk_bf16(m[2], m[3]);
                    *(LAS u32x2*)(Mt + sc * ST_TR128 + l0 * 2) = pk;
                }
            }
#pragma unroll
            for (int q = 0; q < 4; ++q) { const int it = tid + 512 * q; const int q2 = it & 1023;
                *(LAS u32x4*)(((it >> 10) ? Hb : Hf) + (q2 >> 4) * ST_ROW + (q2 & 15) * 16) = hreg[q]; }
            if (hh < 3) {
                const bf16_t* hp0 = HP + ((size_t)(b * 2 * NCHUNK + c) * 8 + h + 1) * 8192;
#pragma unroll
                for (int q = 0; q < 4; ++q) { const int it = tid + 512 * q; hreg[q] = *(const u32x4*)(hp0 + (size_t)(it >> 10) * NCHUNK * 8 * 8192 + (it & 1023) * 8); }
                if (tid < 256) conv_load(proj, row0, tid >> 3, g * 256 + (hh + 1) * 64 + (tid & 7) * 8, lo_ok, hi_ok, rx);
            }
            unsigned zraw[8];
#pragma unroll
            for (int ri = 0; ri < 16; ri += 2) { const int lr = 32 * lb + 8 * (ri >> 2) + 4 * (ln >> 5) + (ri & 3);
                const bf16_t* zp = proj + (size_t)(row0 + lr) * NPROJ + 1024 + h * 64 + pc;
                zraw[ri >> 1] = (unsigned)zp[0] | ((unsigned)zp[NPROJ] << 16); }
            __syncthreads();
            f32x16 ad, af_, ab_;
#pragma unroll
            for (int e = 0; e < 16; ++e) { ad[e] = 0.f; af_[e] = 0.f; ab_[e] = 0.f; }
#pragma unroll
            for (int kk = 0; kk < 8; ++kk) {
                const bf16x8 am = tr_frag(Mt, ST_TR128, 16 * kk, 32 * lb, lane);
                const bf16x8 bx = tr_frag(Xs, ST_TR64, 16 * kk, 32 * ph, lane);
                ad = __builtin_amdgcn_mfma_f32_32x32x16_bf16(am, bx, ad, 0, 0, 0);
                const bf16x8 ac = row_frag(Cs, ST_ROW, 32 * lb, 16 * kk, lane);
                const bf16x8 bhf = row_frag(Hf, ST_ROW, 32 * ph, 16 * kk, lane);
                const bf16x8 bhb = row_frag(Hb, ST_ROW, 32 * ph, 16 * kk, lane);
                af_ = __builtin_amdgcn_mfma_f32_32x32x16_bf16(ac, bhf, af_, 0, 0, 0);
                ab_ = __builtin_amdgcn_mfma_f32_32x32x16_bf16(ac, bhb, ab_, 0, 0, 0);
            }
            const float dsk = p->d_skip[l * 8 + h];
#pragma unroll
            for (int rg = 0; rg < 4; ++rg) {
                const int l0 = 32 * lb + 8 * rg + 4 * (ln >> 5);
                const f32x4 cfl = *(const LAS f32x4*)(hv + l0), cbl = *(const LAS f32x4*)(hv + 128 + l0);
#pragma unroll
                for (int e = 0; e < 4; ++e) { const int lr = l0 + e; const int ri = 4 * rg + e;
                    const float xs = bf2f(*(const LAS bf16_t*)(Xs + lr * ST_TR64 + pc * 2));
                    const float y = ad[ri] + __expf(cfl[e]) * af_[ri] + __expf(cbl[e]) * ab_[ri] + dsk * xs;
                    const float z = (ri & 1) ? bfhi(zraw[ri >> 1]) : bflo(zraw[ri >> 1]);
                    const float val = y * siluf_(z);
                    mix[(size_t)(row0 + lr) * 1024 + h * 64 + pc] = f2bf(val);
                    const float sq = half_sum32(val * val);
                    if ((ln & 31) == 31) ssqp[ph * 128 + lr] = sq;
                }
            }
            __syncthreads();
            if (tid < 128) SSQ[(size_t)(row0 + tid) * 8 + h] = ssqp[tid] + ssqp[128 + tid];
            if (hh < 3 && tid < 256) { float o[4][8];
                conv_compute(rx, cwl, 512, 256 + (hh + 1) * 64 + (tid & 7) * 8, o);
#pragma unroll
                for (int i = 0; i < 4; ++i) *(LAS u32x4*)(Xs + (4 * (tid >> 3) + i) * ST_TR64 + (tid & 7) * 16) = pack8(o[i]); }
        }
        __syncthreads();
    }
}
__device__ __forceinline__ void phase_r2(CP p, int l, unsigned char* lds, int bid, int nb) {
    LAS float* wrt = (LAS float*)(LAS unsigned char*)lds;
    LAS float* gm = wrt + 20 * 1024;
    LAS float* sh = gm + 3 * 1024;
    LAS int* lcnt = (LAS int*)(sh + 3 * 1024);
    LAS int* lcls = lcnt + 64;
    LAS int* lrank = lcls + 1024;
    LAS float* lcwa = (LAS float*)(lrank + 1024);
    LAS float* lcwb = lcwa + 1024;
    const int tid = launder_tid(); const int lane = tid & 63, wave = tid >> 6;
    const float* mod = (const float*)(p->ws + WS_MOD) + (size_t)l * 3 * 6144;
    { float tmp[8];
#pragma unroll
      for (int it = 0; it < 8; ++it) tmp[it] = p->w_rg[(size_t)l * 4096 + tid + NTHREADS * it];
#pragma unroll
      for (int it = 0; it < 8; ++it) { const int idx = tid + NTHREADS * it; wrt[(idx & 3) * 1024 + (idx >> 2)] = tmp[it]; } }
#pragma unroll
    for (int hb = 0; hb < 2; ++hb) { float tmp[16];
#pragma unroll
        for (int it = 0; it < 16; ++it) tmp[it] = p->w_re[(size_t)l * 16384 + tid + NTHREADS * (16 * hb + it)];
#pragma unroll
        for (int it = 0; it < 16; ++it) { const int idx = tid + NTHREADS * (16 * hb + it); wrt[(4 + (idx & 15)) * 1024 + (idx >> 4)] = tmp[it]; } }
    { float t0[6], t1[6], t2[6];
#pragma unroll
      for (int it = 0; it < 6; ++it) { const int idx = tid + NTHREADS * it; const int v = idx >> 10, k = idx & 1023; t0[it] = p->g_ffn[l * 1024 + k]; t1[it] = mod[v * 6144 + 4 * 1024 + k]; t2[it] = mod[v * 6144 + 3 * 1024 + k]; }
#pragma unroll
      for (int it = 0; it < 6; ++it) { const int idx = tid + NTHREADS * it; gm[idx] = t0[it] * (1.f + t1[it]); sh[idx] = t2[it]; } }
    if (tid < 64) lcnt[tid] = 0;
    __syncthreads();
    bf16_t* HM = (bf16_t*)(p->ws + WS_HX); float* CWLA = (float*)(p->ws + WS_CWLA); float* CWLB = (float*)(p->ws + WS_CWLB); int* POS = (int*)(p->ws + WS_POS) + (size_t)l * R;
    int* gcount = (int*)(p->ws + WS_CTL) + l * 32; int* LIST = (int*)(p->ws + WS_LIST);
    const int rpb = (R + nb - 1) / nb, r0 = bid * rpb, r1 = (r0 + rpb) < R ? (r0 + rpb) : R;
    RowRaw xn;
    if (r0 + wave < r1) row_load(p, 1, r0 + wave, lane, xn);
    for (int r = r0 + wave; r < r1; r += 8) {
        const int v = row_v(r);
        f32x4 xv[4]; float ss = 0.f;
        row_cvt(1, xn, xv);
        if (r + 8 < r1) row_load(p, 1, r + 8, lane, xn);
        if (l == DEPTH - 1 && v == 2) { if (lane == 0) lcls[r - r0] = -1; continue; }
#pragma unroll
        for (int j = 0; j < 4; ++j) ss += xv[j][0] * xv[j][0] + xv[j][1] * xv[j][1] + xv[j][2] * xv[j][2] + xv[j][3] * xv[j][3];
        ss = wave_sum(ss); const float rs = rsqrtf(ss * (1.f / 1024.f) + 1e-6f);
#pragma unroll
        for (int j = 0; j < 4; ++j) { const int k = 4 * lane + 256 * j; const f32x4 g4 = *(const LAS f32x4*)(gm + v * 1024 + k), s4 = *(const LAS f32x4*)(sh + v * 1024 + k);
            xv[j] = xv[j] * rs * g4 + s4;
            u32x2 o; o.x = cvt_pk_bf16(xv[j][0], xv[j][1]); o.y = cvt_pk_bf16(xv[j][2], xv[j][3]);
            *(u32x2*)(HM + (size_t)r * 1024 + k) = o; }
        float lg[20];
#pragma unroll
        for (int n = 0; n < 20; ++n) { float a = 0.f;
#pragma unroll
            for (int j = 0; j < 4; ++j) { const f32x4 w4 = *(const LAS f32x4*)(wrt + n * 1024 + 4 * lane + 256 * j); a += xv[j][0] * w4[0] + xv[j][1] * w4[1] + xv[j][2] * w4[2] + xv[j][3] * w4[3]; }
            lg[n] = wave_sum(a) + (n < 4 ? p->b_rg[l * 4 + n] : p->b_re[l * 16 + n - 4]); }
        int gsel = 0; float gmax = lg[0];
#pragma unroll
        for (int q = 1; q < 4; ++q) if (lg[q] > gmax) { gmax = lg[q]; gsel = q; }
        float gden = 0.f;
#pragma unroll
        for (int q = 0; q < 4; ++q) gden += __expf(lg[q] - gmax);
        const float gprob = 1.f / gden;
        float el[4];
#pragma unroll
        for (int q = 0; q < 4; ++q) el[q] = gsel == 0 ? lg[4 + q] : (gsel == 1 ? lg[8 + q] : (gsel == 2 ? lg[12 + q] : lg[16 + q]));
        int i0 = 0; float m0 = el[0];
#pragma unroll
        for (int q = 1; q < 4; ++q) if (el[q] > m0) { m0 = el[q]; i0 = q; }
        int i1 = -1; float m1 = -3.0e38f;
#pragma unroll
        for (int q = 0; q < 4; ++q) if (q != i0 && el[q] > m1) { m1 = el[q]; i1 = q; }
        const float w0 = gprob / (1.f + __expf(m1 - m0)), w1 = gprob - w0;
        const int ea = i0 < i1 ? i0 : i1, eb = i0 < i1 ? i1 : i0;
        const float cwa = i0 < i1 ? w0 : w1, cwb = i0 < i1 ? w1 : w0;
        const int pidx = ea == 0 ? eb - 1 : (ea == 1 ? eb + 1 : 5);
        const int cls = gsel * 6 + pidx;
        if (lane == 0) { const int rank = __hip_atomic_fetch_add(&lcnt[cls], 1, __ATOMIC_RELAXED, __HIP_MEMORY_SCOPE_WORKGROUP); lcls[r - r0] = cls; lrank[r - r0] = rank; lcwa[r - r0] = cwa; lcwb[r - r0] = cwb; }
    }
    __syncthreads();
    if (tid < NCLS) lcnt[32 + tid] = atomicAdd(&gcount[tid], lcnt[tid]);
    __syncthreads();
    for (int idx = tid; idx < r1 - r0; idx += NTHREADS) { const int cl = lcls[idx]; if (cl < 0) continue; const int pos = lcnt[32 + cl] + lrank[idx]; const size_t li = (size_t)cl * R + pos;
        LIST[li] = r0 + idx; CWLA[li] = lcwa[idx]; CWLB[li] = lcwb[idx]; POS[r0 + idx] = (cl << 16) | pos; }
    __syncthreads();
}
__device__ __forceinline__ void phase_final(CP p, unsigned char* lds, int bid, int nb) {
    const int tid = launder_tid(); const int lane = tid & 63, wave = tid >> 6;
    LAS int* tab = (LAS int*)((LAS unsigned char*)lds + MISC_OFF);
    moe_table(p, DEPTH - 1, tab);
    const int* POS = (const int*)(p->ws + WS_POS) + (size_t)(DEPTH - 1) * R;
    const int qstep = nb * 8;
    RowRaw xn; u32x2 yn[4]; int posn = 0;
    { const int q = bid * 8 + wave;
      if (q < NB * SEQ) { const int b = q >= SEQ ? 1 : 0; const int r = b * SEG + CTXL + (q - b * SEQ);
          row_load(p, 1, r, lane, xn);
          moe_yload(p, POS[r], lane, tab, yn);
          const int qn = q + qstep; if (qn < NB * SEQ) { const int bn = qn >= SEQ ? 1 : 0; posn = POS[bn * SEG + CTXL + (qn - bn * SEQ)]; } } }
    for (int q = bid * 8 + wave; q < NB * SEQ; q += qstep) {
        const int b = q >= SEQ ? 1 : 0;
        f32x4* hr = (f32x4*)(p->out + (size_t)q * D);
        f32x4 xv[4]; u32x2 yv[4]; float ss = 0.f;
        row_cvt(1, xn, xv);
#pragma unroll
        for (int j = 0; j < 4; ++j) yv[j] = yn[j];
        { const int qn = q + qstep;
          if (qn < NB * SEQ) { const int bn = qn >= SEQ ? 1 : 0;
              row_load(p, 1, bn * SEG + CTXL + (qn - bn * SEQ), lane, xn);
              moe_yload(p, posn, lane, tab, yn);
              const int q2 = qn + qstep; if (q2 < NB * SEQ) { const int b2 = q2 >= SEQ ? 1 : 0; posn = POS[b2 * SEG + CTXL + (q2 - b2 * SEQ)]; } } }
        moe_yadd(p, DEPTH - 1, b, lane, yv, xv);
#pragma unroll
        for (int j = 0; j < 4; ++j) ss += xv[j][0] * xv[j][0] + xv[j][1] * xv[j][1] + xv[j][2] * xv[j][2] + xv[j][3] * xv[j][3];
        ss = wave_sum(ss); const float rs = rsqrtf(ss * (1.f / 1024.f) + 1e-6f);
#pragma unroll
        for (int j = 0; j < 4; ++j) { const f32x4 g4 = *(const f32x4*)(p->g_final + 4 * lane + 256 * j); hr[lane + 64 * j] = xv[j] * rs * g4; }
    }
}


#define XB_TMO      128
#define XB_XCNT(j)  (256  + 64 * (j))
#define XB_XSUB(j)  (1280 + 64 * (j))
#define XB_XGEN(j)  (2304 + 64 * (j))
#define XB_TOP      3328
#define XB_TOPGEN   3392
#define XCD_BAR_WORDS 3456
#define XB_SPIN_CAP (1u << 22)
__device__ __forceinline__ unsigned xb_ld(unsigned* p) { return __hip_atomic_load(p, __ATOMIC_RELAXED, __HIP_MEMORY_SCOPE_AGENT); }
__device__ __forceinline__ unsigned xb_add(unsigned* p, unsigned v) { return __hip_atomic_fetch_add(p, v, __ATOMIC_RELAXED, __HIP_MEMORY_SCOPE_AGENT); }
__device__ __forceinline__ unsigned xb_xcc_id() { return (unsigned)__builtin_amdgcn_s_getreg((3 << 11) | 20) & 0xFu; }
#define XB_SPIN(cond, bar) do { unsigned _sp = 0; while (cond) { __builtin_amdgcn_s_sleep(1); \
    if ((++_sp & 255u) == 0u) { if (xb_ld(&(bar)[XB_TMO])) break; if (_sp > XB_SPIN_CAP) { atomicAdd(&(bar)[XB_TMO], 1u); break; } } } } while (0)
struct XcdBarrier { unsigned* bar; unsigned x; volatile LAS unsigned* st; };
__device__ __forceinline__ XcdBarrier xcd_barrier_post(unsigned* bar, volatile LAS unsigned* st) {
    XcdBarrier b; b.bar = bar; b.x = xb_xcc_id(); b.st = st;
    if (threadIdx.x == 0) (void)xb_add(&bar[XB_XCNT(b.x)], 1u);
    return b;
}
__device__ __forceinline__ void xcd_barrier_complete(unsigned* bar, unsigned x, unsigned& nloc, unsigned& nx) {
    const unsigned G = gridDim.x * gridDim.y * gridDim.z;
    unsigned sum, cnt, mine, sp = 0u;
    for (;;) {
        sum = 0u; cnt = 0u; mine = 0u;
#pragma unroll
        for (unsigned j = 0; j < 16; ++j) { const unsigned c = xb_ld(&bar[XB_XCNT(j)]); sum += c; cnt += (c > 0u) ? 1u : 0u; mine = (j == x) ? c : mine; }
        if (sum == G) break;
        __builtin_amdgcn_s_sleep(1);
        if ((++sp & 255u) == 0u) { if (xb_ld(&bar[XB_TMO])) break; if (sp > XB_SPIN_CAP) { atomicAdd(&bar[XB_TMO], 1u); break; } }
    }
    nloc = mine > 0u ? mine : 1u; nx = cnt > 0u ? cnt : 1u;
}
__device__ __forceinline__ void xcd_barrier(const XcdBarrier& b) {
    asm volatile("s_waitcnt vmcnt(0)" ::: "memory");
    __syncthreads();
    if (threadIdx.x == 0) {
        unsigned* bar = b.bar;
        __builtin_amdgcn_s_waitcnt(0);
        unsigned nloc = b.st[0], nx = b.st[1];
        if (nloc == 0u) { xcd_barrier_complete(bar, b.x, nloc, nx); b.st[0] = nloc; b.st[1] = nx; }
        const unsigned old = xb_add(&bar[XB_XSUB(b.x)], 1u);
        const unsigned gen = old / nloc;
        if (old + 1u == (gen + 1u) * nloc) {
            __builtin_amdgcn_fence(__ATOMIC_RELEASE, "agent");
            asm volatile("s_waitcnt vmcnt(0)" ::: "memory");
            const unsigned og = xb_add(&bar[XB_TOP], 1u);
            const unsigned tg = og / nx;
            if (og + 1u == (tg + 1u) * nx) xb_add(&bar[XB_TOPGEN], 1u);
            else XB_SPIN(xb_ld(&bar[XB_TOPGEN]) == tg, bar);
            __builtin_amdgcn_fence(__ATOMIC_ACQUIRE, "agent");
            xb_add(&bar[XB_XGEN(b.x)], 1u);
            asm volatile("s_waitcnt vmcnt(0)" ::: "memory");
        } else {
            XB_SPIN(xb_ld(&bar[XB_XGEN(b.x)]) == gen, bar);
            __builtin_amdgcn_fence(__ATOMIC_ACQUIRE, "agent");
            asm volatile("s_waitcnt vmcnt(0)" ::: "memory");
        }
    }
    __syncthreads();
}

#ifndef TIMING_A
#define TIMING_A -1
#endif
#ifndef TIMING_B
#define TIMING_B -1
#endif
#ifndef PHASE_MASK
#define PHASE_MASK 0xFFFFF
#endif
#define PM(i) ((PHASE_MASK >> (i)) & 1)
#ifndef REPEAT_MASK
#define REPEAT_MASK 0
#endif
#define RP(i) for (int rep_ = 0; rep_ < 1 + ((REPEAT_MASK >> (i)) & 1); ++rep_)
constexpr int PH_PER_LAYER = 9, NPHASES = 1 + DEPTH * PH_PER_LAYER + 1;
__global__ void __launch_bounds__(NTHREADS, 2) mk_fwd(Args args) {
    extern __shared__ __attribute__((aligned(16))) unsigned char lds[];
    cg::grid_group grid = cg::this_grid();
    const __attribute__((address_space(4))) Args* ap = (const __attribute__((address_space(4))) Args*)__builtin_amdgcn_kernarg_segment_ptr();
    const int lo = ap->lo, hi = ap->hi;
    LAS unsigned char* ldsl = (LAS unsigned char*)lds;
    volatile LAS unsigned* xbst = (volatile LAS unsigned*)(ldsl + LDS_BYTES - 16);
    if (threadIdx.x < 4) xbst[threadIdx.x] = 0u;
    __syncthreads();
    (void)xcd_barrier_post((unsigned*)(ap->p.ws + WS_BAR), xbst);
    if (TIMING_A >= 0 && blockIdx.x == 0 && threadIdx.x == 0) ((unsigned long long*)(ap->p.ws + WS_TS))[lo] = __builtin_amdgcn_s_memrealtime();
    for (int ph = lo; ph < hi; ++ph) {
        CP p = launder(&ap->p);
        int bid = blockIdx.x, nb = gridDim.x; asm volatile("" : "+s"(bid), "+s"(nb));
        if (ph == 0) { if (PM(0)) RP(0) phase_wprep(p, lds, bid, nb); if (PM(1)) RP(1) phase_adaln(p, lds, bid, nb); }
        else if (ph == NPHASES - 1) { if (PM(12)) phase_final(p, lds, bid, nb); }
        else {
            const int l = (ph - 1) / PH_PER_LAYER, s = (ph - 1) % PH_PER_LAYER;
            if (s == 0) { if (PM(2)) RP(2) { if (rep_ == 0 || l == 0) phase_r1(p, l, lds, bid, nb); } }
            else if (s == 1) { if (PM(3)) RP(3) {
                pg8::DenseSched S; S.init(p->ws + WS_HX, (const bf16_t*)(p->ws + WS_WTIN) + (size_t)l * DIN * 1024, R, NPROJ, 1024, 1024, 1024, nb, bid);
                EpiProj E{(bf16_t*)(p->ws + WS_PROJ)};
                pg8::gemm_phase<EpiProj, pg8::DenseSched, false>(ldsl, 1024, 1024, 1024, S, E);
            } }
            else if (s == 2) { if (PM(4)) RP(4) phase_c1(p, l, lds, bid, nb); if (PM(5)) RP(5) phase_s1(p, l, lds, bid, nb); }
            else if (s == 3) { if (PM(6)) RP(6) phase_s2(p, bid, nb); if (PM(4)) phase_c1_ln(p, l, bid, nb); }
            else if (s == 4) { if (PM(7)) RP(7) phase_s3(p, l, lds, bid, nb); }
            else if (s == 5) { if (PM(8)) RP(8) { if (rep_ == 0 || l == 0) {
                pg8::DenseSched S; S.init(p->ws + WS_HX, (const bf16_t*)(p->ws + WS_WTOUT) + (size_t)l * 1024 * 1024, R, 1024, 1024, 1024, 1024, nb, bid, l == DEPTH - 1);
                EpiResid<0> E{p->ctx, p->x, (bf16_t*)(p->ws + WS_H), (const float*)(p->ws + WS_MOD) + (size_t)l * 3 * 6144, (const float*)(p->ws + WS_SSQ)};
                pg8::gemm_phase<EpiResid<0>, pg8::DenseSched, false>(ldsl, 1024, 1024, 1024, S, E);
            } } }
            else if (s == 6) { if (PM(9)) phase_r2(p, l, lds, bid, nb); }
            else if (s == 7) { if (PM(10)) RP(10) {
                LAS int* tab = (LAS int*)(ldsl + MISC_OFF); moe_table(p, l, tab);
                MoeSched S{tab, (const int*)(p->ws + WS_LIST), (const char*)(p->ws + WS_HX), (const char*)(p->ws + WS_WTGU), 0, l, nb, bid};
                EpiUp E{(bf16_t*)(p->ws + WS_HID), (const float*)(p->ws + WS_CWLA), (const float*)(p->ws + WS_CWLB)};
                pg8::gemm_phase<EpiUp, MoeSched, true>(ldsl, 1024, 1024, 1024, S, E);
            } }
            else { if (PM(11)) RP(11) {
                LAS int* tab = (LAS int*)(ldsl + MISC_OFF); moe_table(p, l, tab);
                MoeSched S{tab, (const int*)(p->ws + WS_LIST), (const char*)(p->ws + WS_HID), (const char*)(p->ws + WS_WTD), 1, l, nb, bid};
                EpiY E{(bf16_t*)(p->ws + WS_Y)};
                pg8::gemm_phase<EpiY, MoeSched, false>(ldsl, 512, 256, 512, S, E);
            } }
        }
        if (ph + 1 < hi) { if (ph == lo) grid.sync(); else { XcdBarrier xb; xb.bar = (unsigned*)(launder(&ap->p)->ws + WS_BAR); xb.x = xb_xcc_id(); xb.st = (volatile LAS unsigned*)(ldsl + LDS_BYTES - 16); xcd_barrier(xb); }
            if (TIMING_A >= 0 && blockIdx.x == 0 && threadIdx.x == 0) ((unsigned long long*)(launder(&ap->p)->ws + WS_TS))[ph + 1] = __builtin_amdgcn_s_memrealtime(); }
    }
#if TIMING_A >= 0
    {
        XcdBarrier xb; xb.bar = (unsigned*)(launder(&ap->p)->ws + WS_BAR); xb.x = xb_xcc_id(); xb.st = (volatile LAS unsigned*)(ldsl + LDS_BYTES - 16); xcd_barrier(xb);
        if (blockIdx.x == 0 && threadIdx.x == 0) ((unsigned long long*)(launder(&ap->p)->ws + WS_TS))[hi] = __builtin_amdgcn_s_memrealtime();
        xcd_barrier(xb);
        const unsigned long long* ts = (const unsigned long long*)(launder(&ap->p)->ws + WS_TS);
        const float ta = (float)(ts[TIMING_A + 1] - ts[TIMING_A]) * 0.01f, tb = (float)(ts[TIMING_B + 1] - ts[TIMING_B]) * 0.01f;
        float* o = launder(&ap->p)->out; const float sc = 1.f + ta * 0.001f;
        for (size_t i = (size_t)blockIdx.x * NTHREADS + threadIdx.x; i < (size_t)NB * SEQ * D; i += (size_t)gridDim.x * NTHREADS) o[i] = o[i] * sc + (i == 0 ? tb * 0.1f : 0.f);
    }
#endif
}

extern "C" void kernel_launch(void* const* d_in, const int* in_sizes, int n_in, void* d_out, int out_size, void* d_ws, size_t ws_size, hipStream_t stream) {
    static int grid = 0;
    if (grid == 0) {
        if (n_in != 28 || ws_size < WS_END) { fprintf(stderr, "kernel_launch: unexpected n_in %d or ws_size %zu (< %zu)\n", n_in, ws_size, (size_t)WS_END); grid = -1; return; }
        int dev = 0, cus = 0, per_cu = 0;
        hipGetDevice(&dev); hipDeviceGetAttribute(&cus, hipDeviceAttributeMultiprocessorCount, dev);
        if (hipFuncSetAttribute((const void*)mk_fwd, hipFuncAttributeMaxDynamicSharedMemorySize, LDS_BYTES) != hipSuccess) { fprintf(stderr, "kernel_launch: hipFuncSetAttribute failed\n"); grid = -1; return; }
        if (hipOccupancyMaxActiveBlocksPerMultiprocessor(&per_cu, (const void*)mk_fwd, NTHREADS, LDS_BYTES) != hipSuccess || per_cu < 1) { fprintf(stderr, "kernel_launch: occupancy query says %d\n", per_cu); (void)hipGetLastError(); grid = -1; return; }
        grid = cus;
    }
    if (grid < 0) return;
    (void)hipMemsetAsync((char*)d_ws + WS_CTL, 0, WS_CTL_BYTES, stream);
    Args a{};
    const float** pp = (const float**)&a.p;
    for (int i = 0; i < 28; ++i) pp[i] = (const float*)d_in[i];
    a.p.out = (float*)d_out; a.p.ws = (unsigned char*)d_ws;
#if PER_PHASE_LAUNCH
    for (int ph = 0; ph < NPHASES; ++ph) {
        a.lo = ph; a.hi = ph + 1; void* kargs[] = {&a};
        hipError_t e = hipLaunchCooperativeKernel((const void*)mk_fwd, dim3(grid), dim3(NTHREADS), kargs, LDS_BYTES, stream);
        if (e != hipSuccess) { fprintf(stderr, "kernel_launch: launch of phase %d failed: %s\n", ph, hipGetErrorString(e)); break; }
    }
#else
    a.lo = 0; a.hi = NPHASES; void* kargs[] = {&a};
    hipError_t e = hipLaunchCooperativeKernel((const void*)mk_fwd, dim3(grid), dim3(NTHREADS), kargs, LDS_BYTES, stream);
    if (e != hipSuccess) fprintf(stderr, "kernel_launch: cooperative launch failed: %s (grid %d)\n", hipGetErrorString(e), grid);
#endif
}
```

```cpp
#include <hip/hip_runtime.h>
#include <hip/hip_cooperative_groups.h>
#include <cstdio>
namespace cg = cooperative_groups;

#ifndef PER_PHASE_LAUNCH
#define PER_PHASE_LAUNCH 0
#endif

#ifndef S3REP
#define S3REP 0
#endif
#define S3R(i) for (int r3_ = 0; r3_ < 1 + ((S3REP >> (i)) & 1); ++r3_)
#define LAS __attribute__((address_space(3)))
typedef unsigned short bf16_t;
typedef short bf16x8 __attribute__((ext_vector_type(8)));
typedef float f32x4 __attribute__((ext_vector_type(4)));
typedef unsigned u32x4 __attribute__((ext_vector_type(4)));
typedef unsigned u32x2 __attribute__((ext_vector_type(2)));

constexpr int D = 1024, NB = 2, SEQ = 16384, CTXL = 256, SEG = SEQ + CTXL, R = NB * SEG, DEPTH = 2;
constexpr int NPROJ = 2560, DIN = 2576;
constexpr int NTHREADS = 512;
constexpr int LDS_BYTES = 163840;
constexpr int MISC_OFF = 131072;
constexpr int NCLS = 24;

constexpr size_t al256(size_t x) { return (x + 255) & ~size_t(255); }
constexpr size_t WS_CTL = 0;
constexpr size_t WS_TS = 2048;
constexpr size_t WS_BAR = 4096;
constexpr size_t WS_CTL_BYTES = 32768;
constexpr size_t WS_MOD = WS_CTL_BYTES;
constexpr size_t WS_WTIN = WS_MOD + al256((size_t)2 * 3 * 6144 * 4);
constexpr size_t WS_WTOUT = WS_WTIN + al256((size_t)2 * DIN * 1024 * 2);
constexpr size_t WS_WTGU = WS_WTOUT + al256((size_t)2 * 1024 * 1024 * 2);
constexpr size_t WS_WTD = WS_WTGU + al256((size_t)2 * 16 * 512 * 1024 * 2);
constexpr size_t WS_H = WS_WTD + al256((size_t)2 * 16 * 1024 * 256 * 2);
constexpr size_t WS_HX = WS_H + al256((size_t)R * 1024 * 2);
constexpr size_t WS_PROJ = WS_HX + al256((size_t)R * 1024 * 2);
constexpr size_t WS_DT = WS_PROJ + al256((size_t)R * NPROJ * 2);
constexpr size_t WS_POS = WS_DT + al256((size_t)R * 16 * 4);
constexpr size_t WS_LIST = WS_POS + al256((size_t)2 * R * 4);
constexpr size_t WS_CWLA = WS_LIST + al256((size_t)NCLS * R * 4);
constexpr size_t WS_CWLB = WS_CWLA + al256((size_t)NCLS * R * 4);
constexpr size_t WS_BIG = WS_CWLB + al256((size_t)NCLS * R * 4);
constexpr size_t WS_Y = WS_PROJ;
constexpr size_t WS_S = WS_BIG;
constexpr size_t WS_HP = WS_S + al256((size_t)2 * 2 * 130 * 8 * 8192 * 2);
constexpr size_t WS_DEC = WS_HP + al256((size_t)2 * 2 * 130 * 8 * 8192 * 2);
constexpr size_t WS_SSQ = WS_DEC + al256((size_t)2 * 2 * 130 * 8 * 4);
constexpr size_t WS_HID = WS_S;
constexpr size_t WS_END = WS_SSQ + al256((size_t)R * 8 * 4);
static_assert((size_t)(R + NCLS * 256) * 512 * 2 <= (size_t)2 * 2 * 130 * 8 * 8192 * 2, "hid alias");
static_assert(WS_END <= (size_t)512 * 1024 * 1024, "workspace");

struct Params {
    const float *x, *c, *ctx, *c_ctx, *w_ada, *b_ada, *g_mix, *g_ffn, *w_in, *conv_w, *conv_b, *conv_ln_g, *conv_ln_b, *ssd_conv_w, *ssd_conv_b,
        *dt_bias, *a_log, *d_skip, *ssd_norm_g, *w_out, *w_rg, *b_rg, *w_re, *b_re, *w_gate, *w_up, *w_down, *g_final;
    float* out; unsigned char* ws;
};
struct Args { Params p; int lo, hi; };
typedef const __attribute__((address_space(4))) Params* CP;
__device__ __forceinline__ CP launder(CP p) { asm volatile("" : "+s"(p)); return p; }
__device__ __forceinline__ int launder_tid() { int t = threadIdx.x; asm volatile("" : "+v"(t)); return t; }

__device__ __forceinline__ unsigned cvt_pk_bf16(float lo, float hi) { unsigned r; asm("v_cvt_pk_bf16_f32 %0, %1, %2" : "=v"(r) : "v"(lo), "v"(hi)); return r; }
__device__ __forceinline__ float bf2f(unsigned b) { return __uint_as_float(b << 16); }
__device__ __forceinline__ float bflo(unsigned w) { return __uint_as_float(w << 16); }
__device__ __forceinline__ float bfhi(unsigned w) { return __uint_as_float(w & 0xffff0000u); }
__device__ __forceinline__ bf16_t f2bf(float f) { return (bf16_t)(cvt_pk_bf16(f, 0.f) & 0xffffu); }
#define DPP_ADD(v, ctrl, rm) ((v) + __builtin_bit_cast(float, __builtin_amdgcn_update_dpp(0, __builtin_bit_cast(int, (v)), (ctrl), (rm), 0xF, true)))
__device__ __forceinline__ float row_sum16(float v) {
    v = DPP_ADD(v, 0xB1, 0xF);
    v = DPP_ADD(v, 0x4E, 0xF);
    v = DPP_ADD(v, 0x141, 0xF);
    v = DPP_ADD(v, 0x140, 0xF);
    return v;
}
__device__ __forceinline__ float half_sum32(float v) { v = row_sum16(v); v = DPP_ADD(v, 0x142, 0xA); return v; }
__device__ __forceinline__ float wave_sum(float v) {
    v = half_sum32(v); v = DPP_ADD(v, 0x143, 0xC);
    return __builtin_bit_cast(float, __builtin_amdgcn_readlane(__builtin_bit_cast(int, v), 63));
}
__device__ __forceinline__ float sigmoidf_(float x) { return 1.f / (1.f + __expf(-x)); }
__device__ __forceinline__ float siluf_(float x) { return x / (1.f + __expf(-x)); }
__device__ __forceinline__ float softplusf_(float x) { return fmaxf(x, 0.f) + log1pf(expf(-fabsf(x))); }

__device__ __forceinline__ int row_b(int r) { return r >= SEG ? 1 : 0; }
__device__ __forceinline__ int row_i(int r) { return r >= SEG ? r - SEG : r; }
__device__ __forceinline__ int row_v(int r) { const int i = row_i(r); return i < CTXL ? 2 : row_b(r); }
__device__ __forceinline__ const float* xin_ptr(const float* ctx, const float* x, int r) {
    const int b = row_b(r), i = row_i(r);
    return i < CTXL ? ctx + (size_t)(b * CTXL + i) * D : x + (size_t)(b * SEQ + i - CTXL) * D;
}
struct RowRaw { f32x4 f[4]; u32x2 h[4]; };
__device__ __forceinline__ void row_load(CP p, int l, int r, int lane, RowRaw& rr) {
    if (l == 0) { const f32x4* hr = (const f32x4*)xin_ptr(p->ctx, p->x, r);
#pragma unroll
        for (int j = 0; j < 4; ++j) rr.f[j] = hr[lane + 64 * j]; }
    else { const u32x2* hr = (const u32x2*)((const bf16_t*)(p->ws + WS_H) + (size_t)r * D);
#pragma unroll
        for (int j = 0; j < 4; ++j) rr.h[j] = hr[lane + 64 * j]; }
}
__device__ __forceinline__ void row_cvt(int l, const RowRaw& rr, f32x4 (&xv)[4]) {
#pragma unroll
    for (int j = 0; j < 4; ++j) xv[j] = l == 0 ? rr.f[j] : (f32x4){bflo(rr.h[j].x), bfhi(rr.h[j].x), bflo(rr.h[j].y), bfhi(rr.h[j].y)};
}
namespace pg8 {
constexpr int BM = 256, BK = 64, HALF = 128, HTB = HALF * BK * 2, STAGE_BYTES = 8 * HTB, NXCD = 8, WGM = 8;
__device__ __forceinline__ int lds_byte(int r, int c) { const int st = (r >> 4) * 2 + (c >> 5), rr = r & 15, cc = c & 31, ob = rr * 64 + cc * 2; return st * 1024 + (ob ^ (((ob >> 9) & 1) << 5)); }
__device__ __forceinline__ void stage_rc(int b, int& Rr, int& Cc) { const int st = b / 1024, sb = b % 1024, swz = sb ^ (((sb >> 9) & 1) << 5); Rr = (st >> 1) * 16 + swz / 64; Cc = (st & 1) * 32 + (swz % 64) / 2; }
__device__ __forceinline__ int perm32(int rho) { const int n = rho >> 4, i = rho & 15; return 8 * (i >> 2) + 4 * n + (i & 3); }

struct Unit {
    const char* a0;
    const char* b0;
    const char* b1;
    int i0, i1, i2, i3, i4, pad;
};

template <class Epi, class Sched, bool GATHER>
__device__ __forceinline__ void gemm_phase(LAS unsigned char* lds, const int lda, const int ldb, const int K, const Sched& S, const Epi& E) {
    const int tid = launder_tid(); const int wid = __builtin_amdgcn_readfirstlane(tid >> 6), lane = tid & 63, wr = wid >> 2, wc = wid & 3, fr = lane & 15, fq = lane >> 4;
    const int nt = K / BK, ks = nt >> 1;
    int Rr[2], Cc[2];
    unsigned voffB[2];
#pragma unroll
    for (int i = 0; i < 2; ++i) { stage_rc(tid * 16 + i * 8192, Rr[i], Cc[i]); const int Rb = Epi::PERM ? ((Rr[i] & ~31) + perm32(Rr[i] & 31)) : Rr[i];
        voffB[i] = (unsigned)(Rb * ldb + Cc[i]) * 2u; }
    const size_t kstep = (size_t)(BK * 2);
    const size_t hstepB = (size_t)HALF * ldb * 2;
    const unsigned ldsw = (unsigned)wid * 1024u;
    const unsigned ldsbase = (unsigned)(unsigned long)lds;
    const int aoff = lds_byte(wr * 64 + fr, fq * 8), boff = lds_byte(wc * 32 + fr, fq * 8);
#define PG8_SA(b, h) (((b) * 2 + (h)) * HTB)
#define PG8_SB(b, h) ((4 + (b) * 2 + (h)) * HTB)
#define PG8_STAGE2(bufoff, gbase, v0, v1) do { unsigned keep_; \
        asm volatile("s_mov_b32 %0, m0\n\ts_mov_b32 m0, %1\n\ts_nop 4\n\tglobal_load_lds_dwordx4 %2, %4\n\ts_add_u32 m0, m0, 0x2000\n\ts_nop 0\n\tglobal_load_lds_dwordx4 %3, %4\n\ts_mov_b32 m0, %0" \
            : "=&s"(keep_) : "s"(ldsbase + (unsigned)(bufoff) + ldsw), "v"(v0), "v"(v1), "s"(gbase) : "memory", "scc"); } while (0)
#define PG8_LDA(dst, b, h) do { _Pragma("unroll") for (int m = 0; m < 4; ++m) _Pragma("unroll") for (int k = 0; k < 2; ++k) dst[m][k] = *(const LAS bf16x8*)(lds + PG8_SA(b, h) + aoff + m * 2048 + k * 1024); } while (0)
#define PG8_LDB(dst, b, h) do { _Pragma("unroll") for (int n = 0; n < 2; ++n) _Pragma("unroll") for (int k = 0; k < 2; ++k) dst[n][k] = *(const LAS bf16x8*)(lds + PG8_SB(b, h) + boff + n * 2048 + k * 1024); } while (0)
#define PG8_MMA(ai, bj, At, Bt) do { __builtin_amdgcn_s_setprio(1); _Pragma("unroll") for (int m = 0; m < 4; ++m) _Pragma("unroll") for (int n = 0; n < 2; ++n) _Pragma("unroll") for (int k = 0; k < 2; ++k) \
        acc[ai][bj][m][n] = __builtin_amdgcn_mfma_f32_16x16x32_bf16(Bt[n][k], At[m][k], acc[ai][bj][m][n], 0, 0, 0); __builtin_amdgcn_s_setprio(0); } while (0)
#define PG8_WAIT_V(n) asm volatile("s_waitcnt vmcnt(" #n ")" ::: "memory")
#define PG8_WAIT_L(n) asm volatile("s_waitcnt lgkmcnt(" #n ")" ::: "memory")
#define PG8_BAR __builtin_amdgcn_s_barrier()
#define PG8_SCHED __builtin_amdgcn_sched_barrier(0)
#define PG8_BP(u, tt) ((tt) < ks ? (u).b0 + (size_t)(tt) * kstep : (u).b1 + (size_t)((tt) - ks) * kstep)
    Unit cur, nxt; int ui = 0;
    if (!S.get(0, cur)) return;
    unsigned c00, c01, c10, c11, n00, n01, n10, n11;
    if (GATHER) {
        c00 = (unsigned)(S.arow(cur, Rr[0]) * lda + Cc[0]) * 2u; c01 = (unsigned)(S.arow(cur, Rr[1]) * lda + Cc[1]) * 2u;
        c10 = (unsigned)(S.arow(cur, HALF + Rr[0]) * lda + Cc[0]) * 2u; c11 = (unsigned)(S.arow(cur, HALF + Rr[1]) * lda + Cc[1]) * 2u;
    } else {
        c00 = (unsigned)(Rr[0] * lda + Cc[0]) * 2u; c01 = (unsigned)(Rr[1] * lda + Cc[1]) * 2u;
        c10 = (unsigned)((HALF + Rr[0]) * lda + Cc[0]) * 2u; c11 = (unsigned)((HALF + Rr[1]) * lda + Cc[1]) * 2u;
    }
    n00 = c00; n01 = c01; n10 = c10; n11 = c11;
    f32x4 acc[2][2][4][2];
    float zr; asm volatile("v_mov_b32 %0, 0" : "=v"(zr));
#pragma unroll
    for (int a = 0; a < 2; ++a)
#pragma unroll
        for (int b = 0; b < 2; ++b)
#pragma unroll
            for (int m = 0; m < 4; ++m)
#pragma unroll
                for (int n = 0; n < 2; ++n) acc[a][b][m][n] = (f32x4){zr, zr, zr, zr};
    bf16x8 At[4][2], B0[2][2], B1[2][2];
    const char* cA = cur.a0;
    {
        const char* pb0 = PG8_BP(cur, 0); const char* pb1 = PG8_BP(cur, 1);
        PG8_STAGE2(PG8_SB(0, 0), pb0, voffB[0], voffB[1]); PG8_STAGE2(PG8_SA(0, 0), cA, c00, c01);
        PG8_STAGE2(PG8_SB(0, 1), pb0 + hstepB, voffB[0], voffB[1]); PG8_STAGE2(PG8_SA(0, 1), cA, c10, c11);
        if (wr == 1) PG8_BAR;
        PG8_WAIT_V(4); PG8_BAR;
        PG8_STAGE2(PG8_SB(1, 0), pb1, voffB[0], voffB[1]); PG8_STAGE2(PG8_SA(1, 0), cA + kstep, c00, c01);
        PG8_STAGE2(PG8_SB(1, 1), pb1 + hstepB, voffB[0], voffB[1]);
        PG8_WAIT_V(6); PG8_BAR;
    }
    for (;;) {
        const bool has_next = S.get(ui + 1, nxt);
        if (!has_next) nxt = cur;
        LAS int* tokb = (LAS int*)(lds + MISC_OFF + 1024) + ((ui + 1) & 1) * 256;
        if (GATHER) {
            n00 = c00; n01 = c01; n10 = c10; n11 = c11;
            if (has_next && wid == 0) {
                const char* src = (const char*)S.rows_ptr(nxt); unsigned keep_;
                asm volatile("s_mov_b32 %0, m0\n\ts_mov_b32 m0, %1\n\ts_nop 4\n\tglobal_load_lds_dwordx4 %2, %3\n\ts_mov_b32 m0, %0"
                    : "=&s"(keep_) : "s"((unsigned)(unsigned long)tokb), "v"((unsigned)lane * 16u), "s"(src) : "memory");
            }
        }
        const char* nA = nxt.a0;
#pragma unroll 1
        for (int t = 0; t < nt; t += 2) {
            const bool last = (t == nt - 2);
            const char* a1 = cA + (size_t)(t + 1) * kstep;
            const char* a2 = last ? nA : cA + (size_t)(t + 2) * kstep;
            const char* a3 = a2 + kstep;
            const char* b2 = last ? PG8_BP(nxt, 0) : PG8_BP(cur, t + 2);
            const char* b3 = last ? PG8_BP(nxt, 1) : PG8_BP(cur, t + 3);
            if (GATHER) { if (last && has_next) {
                const int lim = S.rows_valid(nxt) - 1;
                const int i0 = Rr[0] < lim ? Rr[0] : lim, i1 = Rr[1] < lim ? Rr[1] : lim, i2 = (HALF + Rr[0]) < lim ? (HALF + Rr[0]) : lim, i3 = (HALF + Rr[1]) < lim ? (HALF + Rr[1]) : lim;
                n00 = (unsigned)(tokb[i0] * lda + Cc[0]) * 2u; n01 = (unsigned)(tokb[i1] * lda + Cc[1]) * 2u;
                n10 = (unsigned)(tokb[i2] * lda + Cc[0]) * 2u; n11 = (unsigned)(tokb[i3] * lda + Cc[1]) * 2u; } }
            const unsigned s00 = last ? n00 : c00, s01 = last ? n01 : c01, s10 = last ? n10 : c10, s11 = last ? n11 : c11;
            if constexpr (Epi::MIDSCALE) { if (t == ks) E.midscale(acc, cur, wr, wc, fr, fq); }
            PG8_LDB(B0, 0, 0); PG8_SCHED; PG8_LDA(At, 0, 0); PG8_STAGE2(PG8_SA(1, 1), a1, c10, c11);
            PG8_WAIT_L(8); PG8_BAR; PG8_WAIT_L(0); PG8_MMA(0, 0, At, B0); PG8_BAR; PG8_SCHED;
            PG8_LDB(B1, 0, 1); PG8_STAGE2(PG8_SB(0, 0), b2, voffB[0], voffB[1]);
            PG8_BAR; PG8_WAIT_L(0); PG8_MMA(0, 1, At, B1); PG8_BAR;
            PG8_LDA(At, 0, 1); PG8_STAGE2(PG8_SA(0, 0), a2, s00, s01);
            PG8_BAR; PG8_WAIT_L(0); PG8_MMA(1, 0, At, B0); PG8_BAR; PG8_SCHED;
            PG8_STAGE2(PG8_SB(0, 1), b2 + hstepB, voffB[0], voffB[1]);
            PG8_WAIT_V(6); PG8_BAR; PG8_MMA(1, 1, At, B1); PG8_BAR;
            PG8_LDB(B0, 1, 0); PG8_SCHED; PG8_LDA(At, 1, 0); PG8_STAGE2(PG8_SA(0, 1), a2, s10, s11);
            PG8_WAIT_L(8); PG8_BAR; PG8_WAIT_L(0); PG8_MMA(0, 0, At, B0); PG8_BAR; PG8_SCHED;
            PG8_LDB(B1, 1, 1); PG8_STAGE2(PG8_SB(1, 0), b3, voffB[0], voffB[1]);
            PG8_BAR; PG8_WAIT_L(0); PG8_MMA(0, 1, At, B1); PG8_BAR;
            PG8_LDA(At, 1, 1); PG8_STAGE2(PG8_SA(1, 0), a3, s00, s01);
            PG8_BAR; PG8_WAIT_L(0); PG8_MMA(1, 0, At, B0); PG8_BAR; PG8_SCHED;
            PG8_STAGE2(PG8_SB(1, 1), b3 + hstepB, voffB[0], voffB[1]);
            PG8_WAIT_V(6); PG8_BAR; PG8_MMA(1, 1, At, B1); PG8_BAR;
        }
        E(acc, cur, wr, wc, fr, fq);
        if (!has_next) break;
        asm volatile("v_mov_b32 %0, 0" : "=v"(zr));
#pragma unroll
        for (int a = 0; a < 2; ++a)
#pragma unroll
            for (int b = 0; b < 2; ++b)
#pragma unroll
                for (int m = 0; m < 4; ++m)
#pragma unroll
                    for (int n = 0; n < 2; ++n) acc[a][b][m][n] = (f32x4){zr, zr, zr, zr};
        cur = nxt; cA = nA; ++ui; c00 = n00; c01 = n01; c10 = n10; c11 = n11;
    }
    PG8_WAIT_V(0);
    if (wr == 0) PG8_BAR;
    PG8_BAR;
#undef PG8_SA
#undef PG8_SB
#undef PG8_STAGE2
#undef PG8_LDA
#undef PG8_LDB
#undef PG8_MMA
#undef PG8_WAIT_V
#undef PG8_WAIT_L
#undef PG8_BAR
#undef PG8_SCHED
#undef PG8_BP
}

struct DenseSched {
    const char* A; const char* Bt; int lda, ldb, K; int nM, nN, nwg, G, c, skipctx;
    __device__ __forceinline__ void init(const void* A_, const void* Bt_, int M, int N, int K_, int lda_, int ldb_, int G_, int c_, int skipctx_ = 0) {
        A = (const char*)A_; Bt = (const char*)Bt_; lda = lda_; ldb = ldb_; K = K_; nM = M / BM - 2 * skipctx_; nN = N / BM; nwg = nM * nN; G = G_; c = c_; skipctx = skipctx_; }
    __device__ __forceinline__ bool get(int i, Unit& u) const {
        const long L = (long)i * G + c; if (L >= nwg) return false;
        int wgid = (int)L; { const int q = nwg / NXCD, r = nwg % NXCD, xcd = wgid % NXCD, off = wgid / NXCD; wgid = (xcd < r ? xcd * (q + 1) : r * (q + 1) + (xcd - r) * q) + off; }
        const int nig = WGM * nN, gid = wgid / nig, fm = gid * WGM, gsz = (nM - fm) < WGM ? (nM - fm) : WGM;
        int pm = fm + ((wgid % nig) % gsz); const int pn = (wgid % nig) / gsz;
        if (skipctx) pm += 1 + (pm >= 64 ? 1 : 0);
        u.a0 = A + (size_t)pm * BM * lda * 2; u.b0 = Bt + (size_t)pn * BM * ldb * 2; u.b1 = u.b0 + (size_t)(K / BK / 2) * BK * 2;
        u.i0 = pm; u.i1 = pn; u.i2 = 0; u.i3 = 0; u.i4 = 0; u.pad = 0; return true;
    }
    __device__ __forceinline__ int arow(const Unit&, int rl) const { return rl; }
    __device__ __forceinline__ const int* rows_ptr(const Unit&) const { return nullptr; }
    __device__ __forceinline__ int rows_valid(const Unit&) const { return 256; }
};
}

struct EpiProj {
    static constexpr bool PERM = true, MIDSCALE = false;
    bf16_t* O;
    __device__ __forceinline__ void operator()(const f32x4 (&acc)[2][2][4][2], const pg8::Unit& u, int wr, int wc, int fr, int fq) const {
        const int row0 = u.i0 * 256 + wr * 64 + fr, col0 = u.i1 * 256 + wc * 32 + 8 * fq;
#pragma unroll
        for (int ai = 0; ai < 2; ++ai)
#pragma unroll
            for (int m = 0; m < 4; ++m) { bf16_t* rowp = O + (size_t)(row0 + ai * 128 + m * 16) * NPROJ + col0;
#pragma unroll
                for (int bj = 0; bj < 2; ++bj) { const f32x4 v0 = acc[ai][bj][m][0], v1 = acc[ai][bj][m][1];
                    u32x4 w; w.x = cvt_pk_bf16(v0[0], v0[1]); w.y = cvt_pk_bf16(v0[2], v0[3]); w.z = cvt_pk_bf16(v1[0], v1[1]); w.w = cvt_pk_bf16(v1[2], v1[3]);
                    *(u32x4*)(rowp + bj * 128) = w; } }
    }
};
template <int L0> struct EpiResid {
    static constexpr bool PERM = true, MIDSCALE = true;
    const float* inc; const float* inx; bf16_t* H; const float* modl; const float* ssq;
    __device__ __forceinline__ void midscale(f32x4 (&acc)[2][2][4][2], const pg8::Unit& u, int wr, int wc, int fr, int fq) const {
        typedef float f32x2 __attribute__((ext_vector_type(2)));
        const int r0 = u.i0 * 256 + wr * 64 + fr;
        f32x2 part[2][4];
#pragma unroll
        for (int ai = 0; ai < 2; ++ai)
#pragma unroll
            for (int m = 0; m < 4; ++m) part[ai][m] = *(const f32x2*)(ssq + (size_t)(r0 + ai * 128 + m * 16) * 8 + 2 * fq);
#pragma unroll
        for (int ai = 0; ai < 2; ++ai)
#pragma unroll
            for (int m = 0; m < 4; ++m) { float sq = part[ai][m][0] + part[ai][m][1];
                sq += __shfl_xor(sq, 16); sq += __shfl_xor(sq, 32);
                const float rs = rsqrtf(sq * (1.f / 512.f) + 1e-6f);
#pragma unroll
                for (int bj = 0; bj < 2; ++bj)
#pragma unroll
                    for (int n = 0; n < 2; ++n) acc[ai][bj][m][n] *= rs; }
    }
    __device__ __forceinline__ void operator()(const f32x4 (&acc)[2][2][4][2], const pg8::Unit& u, int wr, int wc, int fr, int fq) const {
        const int r0 = u.i0 * 256;
        const int v = row_v(r0);
        const float* gate = modl + (size_t)v * 6144 + 2 * 1024;
        const float* xin = xin_ptr(inc, inx, r0);
        const int rl0 = wr * 64 + fr, col0 = u.i1 * 256 + wc * 32 + 8 * fq;
        f32x4 gv[2][2];
#pragma unroll
        for (int bj = 0; bj < 2; ++bj)
#pragma unroll
            for (int n = 0; n < 2; ++n) gv[bj][n] = *(const f32x4*)(gate + col0 + bj * 128 + 4 * n);
#pragma unroll
        for (int ai = 0; ai < 2; ++ai)
#pragma unroll
            for (int mp = 0; mp < 2; ++mp) {
                if (L0) {
                    f32x4 hi[2][2][2];
#pragma unroll
                    for (int mm = 0; mm < 2; ++mm) { const size_t off = (size_t)(rl0 + ai * 128 + (2 * mp + mm) * 16) * D + col0;
#pragma unroll
                        for (int bj = 0; bj < 2; ++bj)
#pragma unroll
                            for (int n = 0; n < 2; ++n) hi[mm][bj][n] = *(const f32x4*)(xin + off + bj * 128 + 4 * n); }
#pragma unroll
                    for (int mm = 0; mm < 2; ++mm)
#pragma unroll
                        for (int bj = 0; bj < 2; ++bj) { const f32x4 o0 = hi[mm][bj][0] + gv[bj][0] * acc[ai][bj][2 * mp + mm][0], o1 = hi[mm][bj][1] + gv[bj][1] * acc[ai][bj][2 * mp + mm][1];
                            u32x4 w; w.x = cvt_pk_bf16(o0[0], o0[1]); w.y = cvt_pk_bf16(o0[2], o0[3]); w.z = cvt_pk_bf16(o1[0], o1[1]); w.w = cvt_pk_bf16(o1[2], o1[3]);
                            *(u32x4*)(H + (size_t)(r0 + rl0 + ai * 128 + (2 * mp + mm) * 16) * D + col0 + bj * 128) = w; }
                } else {
                    u32x4 hr[2][2];
#pragma unroll
                    for (int mm = 0; mm < 2; ++mm)
#pragma unroll
                        for (int bj = 0; bj < 2; ++bj) hr[mm][bj] = *(const u32x4*)(H + (size_t)(r0 + rl0 + ai * 128 + (2 * mp + mm) * 16) * D + col0 + bj * 128);
#pragma unroll
                    for (int mm = 0; mm < 2; ++mm)
#pragma unroll
                        for (int bj = 0; bj < 2; ++bj) { const u32x4 hv = hr[mm][bj]; const f32x4 a0 = acc[ai][bj][2 * mp + mm][0], a1 = acc[ai][bj][2 * mp + mm][1]; const f32x4 g0 = gv[bj][0], g1 = gv[bj][1];
                            u32x4 w;
                            w.x = cvt_pk_bf16(bflo(hv.x) + g0[0] * a0[0], bfhi(hv.x) + g0[1] * a0[1]); w.y = cvt_pk_bf16(bflo(hv.y) + g0[2] * a0[2], bfhi(hv.y) + g0[3] * a0[3]);
                            w.z = cvt_pk_bf16(bflo(hv.z) + g1[0] * a1[0], bfhi(hv.z) + g1[1] * a1[1]); w.w = cvt_pk_bf16(bflo(hv.w) + g1[2] * a1[2], bfhi(hv.w) + g1[3] * a1[3]);
                            *(u32x4*)(H + (size_t)(r0 + rl0 + ai * 128 + (2 * mp + mm) * 16) * D + col0 + bj * 128) = w; }
                }
                asm volatile("" ::: "memory"); }
    }
};

struct MoeSched {
    const LAS int* tab;
    const int* list;
    const char* A; const char* W; int mode  , l, G, c;
    __device__ __forceinline__ bool get(int i, pg8::Unit& u) const {
        const int L = i * G + c; const int total = __builtin_amdgcn_readfirstlane(tab[24]) * 4; if (L >= total) return false;
        const int tl = L >> 2, pn = L & 3;
        int cls = 0;
#pragma unroll 1
        for (int q = 1; q < NCLS; ++q) { const int tq = __builtin_amdgcn_readfirstlane(tab[q]); if (tq <= tl) cls = q; }
        const int j = tl - __builtin_amdgcn_readfirstlane(tab[cls]), cnt = __builtin_amdgcn_readfirstlane(tab[32 + cls]);
        const int g = cls / 6, pidx = cls - g * 6;
        const int ea = (pidx >= 3) + (pidx >= 5), eb = pidx < 3 ? pidx + 1 : (pidx < 5 ? pidx - 1 : 3);
        if (mode == 0) {
            const int e = 4 * g + (pn < 2 ? ea : eb);
            u.a0 = A;
            u.b0 = W + ((size_t)(l * 16 + e) * 512 + (size_t)(pn & 1) * 256) * 1024 * 2; u.b1 = u.b0 + (size_t)8 * 128;
        } else {
            u.a0 = A + (size_t)tl * 256 * 512 * 2;
            u.b0 = W + ((size_t)(l * 16 + 4 * g + ea) * 1024 + (size_t)pn * 256) * 256 * 2;
            u.b1 = W + ((size_t)(l * 16 + 4 * g + eb) * 1024 + (size_t)pn * 256) * 256 * 2;
        }
        u.i0 = cls; u.i1 = j; u.i2 = pn; u.i3 = cnt; u.i4 = tl; u.pad = 0; return true;
    }
    __device__ __forceinline__ int arow(const pg8::Unit& u, int rl) const {
        int idx = u.i1 * 256 + rl; idx = idx < u.i3 ? idx : u.i3 - 1;
        return list[(size_t)u.i0 * R + idx];
    }
    __device__ __forceinline__ const int* rows_ptr(const pg8::Unit& u) const { return list + (size_t)u.i0 * R + u.i1 * 256; }
    __device__ __forceinline__ int rows_valid(const pg8::Unit& u) const { return u.i3 - u.i1 * 256; }
};
struct EpiUp {
    static constexpr bool PERM = true, MIDSCALE = false;
    bf16_t* hid; const float* cwla; const float* cwlb;
    __device__ __forceinline__ void operator()(const f32x4 (&acc)[2][2][4][2], const pg8::Unit& u, int wr, int wc, int fr, int fq) const {
        const int cls = u.i0, j = u.i1, pn = u.i2, cnt = u.i3, tl = u.i4;
        const float* cw = (pn < 2) ? cwla : cwlb;
        const int colbase = (pn >> 1) * 256 + (pn & 1) * 128 + wc * 32 + 8 * fq;
        float wrow[2][4];
#pragma unroll
        for (int ai = 0; ai < 2; ++ai)
#pragma unroll
            for (int m = 0; m < 4; ++m) { const int idx = j * 256 + ai * 128 + wr * 64 + m * 16 + fr; wrow[ai][m] = idx < cnt ? cw[(size_t)cls * R + idx] : 0.f; }
#pragma unroll
        for (int ai = 0; ai < 2; ++ai)
#pragma unroll
            for (int m = 0; m < 4; ++m) {
                const int rl = ai * 128 + wr * 64 + m * 16 + fr; const int idx = j * 256 + rl; const bool valid = idx < cnt;
                const float w = wrow[ai][m];
                const f32x4 g0 = acc[ai][0][m][0], g1 = acc[ai][0][m][1], u0 = acc[ai][1][m][0], u1 = acc[ai][1][m][1];
                float o[8];
#pragma unroll
                for (int e = 0; e < 4; ++e) { o[e] = w * siluf_(g0[e]) * u0[e]; o[4 + e] = w * siluf_(g1[e]) * u1[e]; }
                if (!valid) {
#pragma unroll
                    for (int e = 0; e < 8; ++e) o[e] = 0.f; }
                u32x4 pk; pk.x = cvt_pk_bf16(o[0], o[1]); pk.y = cvt_pk_bf16(o[2], o[3]); pk.z = cvt_pk_bf16(o[4], o[5]); pk.w = cvt_pk_bf16(o[6], o[7]);
                *(u32x4*)(hid + ((size_t)tl * 256 + rl) * 512 + colbase) = pk;
                asm volatile("" ::: "memory");
            }
    }
};
struct EpiY {
    static constexpr bool PERM = true, MIDSCALE = false;
    bf16_t* Y;
    __device__ __forceinline__ void operator()(const f32x4 (&acc)[2][2][4][2], const pg8::Unit& u, int wr, int wc, int fr, int fq) const {
        const int row0 = u.i4 * 256 + wr * 64 + fr, col0 = u.i2 * 256 + wc * 32 + 8 * fq;
#pragma unroll
        for (int ai = 0; ai < 2; ++ai)
#pragma unroll
            for (int m = 0; m < 4; ++m) { bf16_t* rowp = Y + (size_t)(row0 + ai * 128 + m * 16) * 1024 + col0;
#pragma unroll
                for (int bj = 0; bj < 2; ++bj) { const f32x4 v0 = acc[ai][bj][m][0], v1 = acc[ai][bj][m][1];
                    u32x4 w; w.x = cvt_pk_bf16(v0[0], v0[1]); w.y = cvt_pk_bf16(v0[2], v0[3]); w.z = cvt_pk_bf16(v1[0], v1[1]); w.w = cvt_pk_bf16(v1[2], v1[3]);
                    *(u32x4*)(rowp + bj * 128) = w; } }
    }
};

__device__ __forceinline__ void tr_tile(const float* src, int ldn, int k0, int n0, int nvalid, bf16_t* dst, int ldk, int drow0, LAS float* tile, int kd0 = -1, const float* kscale = nullptr) {
    const int tid = launder_tid();
    if (kd0 < 0) kd0 = k0;
    { const int n = tid & 63; const int kq = tid >> 6; float tv[8], ts[8];
#pragma unroll
      for (int it = 0; it < 8; ++it) { const int kk = kq + 8 * it; tv[it] = (n < nvalid) ? src[(size_t)(k0 + kk) * ldn + n0 + n] : 0.f; ts[it] = kscale ? kscale[kk] : 1.f; }
#pragma unroll
      for (int it = 0; it < 8; ++it) tile[(kq + 8 * it) * 65 + n] = tv[it] * ts[it]; }
    __syncthreads();
    { const int k8 = tid & 7, n = tid >> 3;
      if (n < nvalid) { const LAS float* s = tile + (k8 * 8) * 65 + n;
          u32x4 o; o.x = cvt_pk_bf16(s[0], s[65]); o.y = cvt_pk_bf16(s[2 * 65], s[3 * 65]); o.z = cvt_pk_bf16(s[4 * 65], s[5 * 65]); o.w = cvt_pk_bf16(s[6 * 65], s[7 * 65]);
          *(u32x4*)(dst + (size_t)(drow0 + n) * ldk + kd0 + k8 * 8) = o; } }
    __syncthreads();
}
__device__ __forceinline__ void phase_wprep(CP p, unsigned char* lds, int bid, int nb) {
    LAS float* tile = (LAS float*)(LAS unsigned char*)lds;
    constexpr int I_IN = 16 * 41, I_OUT = 256, I_G = 1024, I_U = 1024, I_D = 1024, I_L = I_IN + I_OUT + I_G + I_U + I_D;
    for (int it = bid; it < 2 * I_L; it += nb) {
        const int l = it / I_L; int r = it - l * I_L;
        if (r < I_IN) { const int kt = r / 41, ntl = r % 41; const int n0 = ntl * 64; const int nv = (DIN - n0) < 64 ? (DIN - n0) : 64;
            tr_tile(p->w_in + (size_t)l * 1024 * DIN, DIN, kt * 64, n0, nv, (bf16_t*)(p->ws + WS_WTIN) + (size_t)l * DIN * 1024, 1024, n0, tile); continue; }
        r -= I_IN;
        if (r < I_OUT) { const int kt = r >> 4, ntl = r & 15;
            tr_tile(p->w_out + (size_t)l * 1024 * 1024, 1024, kt * 64, ntl * 64, 64, (bf16_t*)(p->ws + WS_WTOUT) + (size_t)l * 1024 * 1024, 1024, ntl * 64, tile,
                    (kt * 64 + 512) & 1023, kt >= 8 ? p->ssd_norm_g + l * 512 + (kt * 64 - 512) : nullptr); continue; }
        r -= I_OUT;
        if (r < I_G + I_U) { const int up = r >= I_G; if (up) r -= I_G; const int e = r >> 6, q = r & 63, kt = q >> 2, ntl = q & 3; const int n0 = ntl * 64;
            const float* src = (up ? p->w_up : p->w_gate) + (size_t)(l * 16 + e) * 1024 * 256;
            tr_tile(src, 256, kt * 64, n0, 64, (bf16_t*)(p->ws + WS_WTGU) + (size_t)(l * 16 + e) * 512 * 1024, 1024, (n0 >> 7) * 256 + (n0 & 127) + (up ? 128 : 0), tile); continue; }
        r -= I_G + I_U;
        { const int e = r >> 6, q = r & 63, kt = q >> 4, ntl = q & 15;
          tr_tile(p->w_down + (size_t)(l * 16 + e) * 256 * 1024, 1024, kt * 64, ntl * 64, 64, (bf16_t*)(p->ws + WS_WTD) + (size_t)(l * 16 + e) * 1024 * 256, 256, ntl * 64, tile); }
    }
}
__device__ __forceinline__ void phase_adaln(CP p, unsigned char* lds, int bid, int nb) {
    LAS float* sc = (LAS float*)(LAS unsigned char*)lds;
    LAS float* red = sc + 3 * 1024;
    const int tid = launder_tid();
    for (int idx = tid; idx < 3 * 1024; idx += NTHREADS) { const int v = idx >> 10, k = idx & 1023; const float cv = (v < 2) ? p->c[v * 1024 + k] : p->c_ctx[k]; sc[idx] = siluf_(cv); }
    __syncthreads();
    float* mod = (float*)(p->ws + WS_MOD);
    for (int it = bid; it < 2 * 96; it += nb) {
        const int l = it / 96, n0 = (it % 96) * 64;
        const int c4 = tid & 15, kr = tid >> 4;
        f32x4 a0 = {0, 0, 0, 0}, a1 = {0, 0, 0, 0}, a2 = {0, 0, 0, 0};
        const float* w = p->w_ada + (size_t)l * 1024 * 6144 + n0 + c4 * 4;
#pragma unroll 4
        for (int k = kr; k < 1024; k += 32) { const f32x4 w4 = *(const f32x4*)(w + (size_t)k * 6144); a0 += sc[k] * w4; a1 += sc[1024 + k] * w4; a2 += sc[2048 + k] * w4; }
        *(LAS f32x4*)(red + (kr * 3 + 0) * 64 + c4 * 4) = a0; *(LAS f32x4*)(red + (kr * 3 + 1) * 64 + c4 * 4) = a1; *(LAS f32x4*)(red + (kr * 3 + 2) * 64 + c4 * 4) = a2;
        __syncthreads();
        if (tid < 192) { const int v = tid >> 6, cc = tid & 63; float s = 0.f;
            for (int q = 0; q < 32; ++q) s += red[(q * 3 + v) * 64 + cc];
            mod[((size_t)l * 3 + v) * 6144 + n0 + cc] = s + p->b_ada[l * 6144 + n0 + cc]; }
        __syncthreads();
    }
}
__device__ __forceinline__ void moe_table(CP p, int l, LAS int* tab) {
    const int* gcount = (const int*)(p->ws + WS_CTL) + l * 32;
    if (threadIdx.x == 0) { int acc = 0; for (int q = 0; q < NCLS; ++q) { const int cn = gcount[q]; tab[q] = acc; tab[32 + q] = cn; acc += (cn + 255) >> 8; } tab[24] = acc; }
    __syncthreads();
}
__device__ __forceinline__ void moe_yload(CP p, int pos, int lane, const LAS int* tab, u32x2 (&yv)[4]) {
    const int slot = tab[pos >> 16] * 256 + (pos & 0xffff);
    const bf16_t* y = (const bf16_t*)(p->ws + WS_Y) + (size_t)slot * 1024;
#pragma unroll
    for (int j = 0; j < 4; ++j) yv[j] = *(const u32x2*)(y + 4 * lane + 256 * j);
}
__device__ __forceinline__ void moe_yadd(CP p, int lm, int v, int lane, const u32x2 (&yv)[4], f32x4 (&xv)[4]) {
    const float* gate = (const float*)(p->ws + WS_MOD) + ((size_t)lm * 3 + v) * 6144 + 5 * 1024;
#pragma unroll
    for (int j = 0; j < 4; ++j) { const int k = 4 * lane + 256 * j; const f32x4 g4 = *(const f32x4*)(gate + k);
        xv[j][0] += g4[0] * bflo(yv[j].x); xv[j][1] += g4[1] * bfhi(yv[j].x); xv[j][2] += g4[2] * bflo(yv[j].y); xv[j][3] += g4[3] * bfhi(yv[j].y); }
}
__device__ __forceinline__ void phase_r1(CP p, int l, unsigned char* lds, int bid, int nb) {
    LAS float* wdt = (LAS float*)(LAS unsigned char*)lds;
    LAS float* gm = wdt + 16 * 1024;
    LAS float* sh = gm + 3 * 1024;
    const int tid = launder_tid(); const int lane = tid & 63, wave = tid >> 6;
    const float* mod = (const float*)(p->ws + WS_MOD) + (size_t)l * 3 * 6144;
    const float* win = p->w_in + (size_t)l * 1024 * DIN;
#pragma unroll
    for (int hb = 0; hb < 2; ++hb) { float tmp[16];
#pragma unroll
        for (int it = 0; it < 16; ++it) { const int idx = tid + NTHREADS * (16 * hb + it); tmp[it] = win[(size_t)(idx >> 4) * DIN + NPROJ + (idx & 15)]; }
#pragma unroll
        for (int it = 0; it < 16; ++it) { const int idx = tid + NTHREADS * (16 * hb + it); wdt[(idx & 15) * 1024 + (idx >> 4)] = tmp[it]; } }
    { float t0[6], t1[6], t2[6];
#pragma unroll
      for (int it = 0; it < 6; ++it) { const int idx = tid + NTHREADS * it; const int v = idx >> 10, k = idx & 1023; t0[it] = p->g_mix[l * 1024 + k]; t1[it] = mod[v * 6144 + 1024 + k]; t2[it] = mod[v * 6144 + k]; }
#pragma unroll
      for (int it = 0; it < 6; ++it) { const int idx = tid + NTHREADS * it; gm[idx] = t0[it] * (1.f + t1[it]); sh[idx] = t2[it]; } }
    LAS int* tab = (LAS int*)((LAS unsigned char*)lds + MISC_OFF);
    if (l > 0) moe_table(p, l - 1, tab);
    __syncthreads();
    bf16_t* HX = (bf16_t*)(p->ws + WS_HX); float* DT = (float*)(p->ws + WS_DT);
    const int* POS = (const int*)(p->ws + WS_POS) + (size_t)(l > 0 ? l - 1 : 0) * R;
    const int rstep = nb * 8;
    RowRaw xn; u32x2 yn[4]; int posn = 0;
    { const int r = bid * 8 + wave;
      if (r < R) { row_load(p, l, r, lane, xn);
          if (l > 0) { moe_yload(p, POS[r], lane, tab, yn); if (r + rstep < R) posn = POS[r + rstep]; } } }
    for (int r = bid * 8 + wave; r < R; r += rstep) {
        const int v = row_v(r);
        f32x4 xv[4]; u32x2 yv[4]; float ss = 0.f;
        row_cvt(l, xn, xv);
#pragma unroll
        for (int j = 0; j < 4; ++j) yv[j] = yn[j];
        { const int rn = r + rstep;
          if (rn < R) { row_load(p, l, rn, lane, xn);
              if (l > 0) { moe_yload(p, posn, lane, tab, yn); if (rn + rstep < R) posn = POS[rn + rstep]; } } }
        if (l > 0) moe_yadd(p, l - 1, v, lane, yv, xv);
        { u32x2* hw = (u32x2*)((bf16_t*)(p->ws + WS_H) + (size_t)r * D);
#pragma unroll
          for (int j = 0; j < 4; ++j) { u32x2 o; o.x = cvt_pk_bf16(xv[j][0], xv[j][1]); o.y = cvt_pk_bf16(xv[j][2], xv[j][3]); hw[lane + 64 * j] = o; } }
#pragma unroll
        for (int j = 0; j < 4; ++j) ss += xv[j][0] * xv[j][0] + xv[j][1] * xv[j][1] + xv[j][2] * xv[j][2] + xv[j][3] * xv[j][3];
        ss = wave_sum(ss); const float rs = rsqrtf(ss * (1.f / 1024.f) + 1e-6f);
#pragma unroll
        for (int j = 0; j < 4; ++j) { const int k = 4 * lane + 256 * j; const f32x4 g4 = *(const LAS f32x4*)(gm + v * 1024 + k), s4 = *(const LAS f32x4*)(sh + v * 1024 + k);
            xv[j] = xv[j] * rs * g4 + s4;
            u32x2 o; o.x = cvt_pk_bf16(xv[j][0], xv[j][1]); o.y = cvt_pk_bf16(xv[j][2], xv[j][3]);
            *(u32x2*)(HX + (size_t)r * 1024 + k) = o; }
        float mine = 0.f;
#pragma unroll
        for (int n = 0; n < 16; ++n) { float a = 0.f;
#pragma unroll
            for (int j = 0; j < 4; ++j) { const f32x4 w4 = *(const LAS f32x4*)(wdt + n * 1024 + 4 * lane + 256 * j); a += xv[j][0] * w4[0] + xv[j][1] * w4[1] + xv[j][2] * w4[2] + xv[j][3] * w4[3]; }
            a = wave_sum(a); mine = (lane == n) ? a : mine; }
        if (lane < 16) DT[(size_t)r * 16 + lane] = softplusf_(mine + p->dt_bias[l * 16 + lane]);
    }
}
typedef float f32x16 __attribute__((ext_vector_type(16)));
typedef short s16x4 __attribute__((ext_vector_type(4)));
constexpr int ST_ROW = 272;
constexpr int ST_TR128 = 320;
constexpr int ST_TR64 = 192;
constexpr int NCHUNK = SEG / 128;

#define DPP_MOV(v, ctrl, rm, bm) __builtin_bit_cast(float, __builtin_amdgcn_update_dpp(0, __builtin_bit_cast(int, (v)), (ctrl), (rm), (bm), true))
__device__ __forceinline__ float wave_incl_scan(float v, int) {
    float s = v + DPP_MOV(v, 0x111, 0xF, 0xF) + DPP_MOV(v, 0x112, 0xF, 0xF) + DPP_MOV(v, 0x113, 0xF, 0xF);
    s += DPP_MOV(s, 0x114, 0xF, 0xE);
    s += DPP_MOV(s, 0x118, 0xF, 0xC);
    s += DPP_MOV(s, 0x142, 0xA, 0xF);
    s += DPP_MOV(s, 0x143, 0xC, 0xF);
    return s;
}
__device__ __forceinline__ bf16x8 row_frag(const LAS unsigned char* tile, int stride, int row0, int k0, int lane) {
    return *(const LAS bf16x8*)(tile + (row0 + (lane & 31)) * stride + (k0 + 8 * (lane >> 5)) * 2);
}
__device__ __forceinline__ bf16x8 tr_frag(const LAS unsigned char* tile, int stride, int k0, int c0, int lane) {
    const int g = lane >> 4, li = lane & 15, q = li >> 2, pp = li & 3;
    const LAS unsigned char* a0 = tile + (k0 + 8 * (g >> 1) + q) * stride + (c0 + 16 * (g & 1) + 4 * pp) * 2;
    const s16x4 lo = __builtin_amdgcn_ds_read_tr16_b64_v4i16((LAS s16x4*)a0);
    const s16x4 hi = __builtin_amdgcn_ds_read_tr16_b64_v4i16((LAS s16x4*)(a0 + 4 * stride));
    return __builtin_shufflevector(lo, hi, 0, 1, 2, 3, 4, 5, 6, 7);
}
__device__ __forceinline__ u32x4 pack8(const float (&v)[8]) { u32x4 r; r.x = cvt_pk_bf16(v[0], v[1]); r.y = cvt_pk_bf16(v[2], v[3]); r.z = cvt_pk_bf16(v[4], v[5]); r.w = cvt_pk_bf16(v[6], v[7]); return r; }
__device__ __forceinline__ u32x4 pack8s(const float (&v)[8], float sc) { u32x4 r; r.x = cvt_pk_bf16(v[0] * sc, v[1] * sc); r.y = cvt_pk_bf16(v[2] * sc, v[3] * sc); r.z = cvt_pk_bf16(v[4] * sc, v[5] * sc); r.w = cvt_pk_bf16(v[6] * sc, v[7] * sc); return r; }

__device__ __forceinline__ void conv_load(const bf16_t* proj, int row0, int rq, int xch, bool lo_ok, bool hi_ok, u32x4 (&raw)[8]) {
    const bf16_t* base = proj + (size_t)(row0 + 4 * rq) * NPROJ + 1536 + xch;
    unsigned zz; asm volatile("v_mov_b32 %0, 0" : "=v"(zz));
#pragma unroll
    for (int j = 0; j < 8; ++j) {
        if (j < 2) { const bool ok = (rq > 0) || lo_ok; const u32x4 v = *(const u32x4*)(ok ? base + (j - 2) * NPROJ : base);
            raw[j].x = ok ? v.x : zz; raw[j].y = ok ? v.y : zz; raw[j].z = ok ? v.z : zz; raw[j].w = ok ? v.w : zz; }
        else if (j >= 6) { const bool ok = (rq < 31) || hi_ok; const u32x4 v = *(const u32x4*)(ok ? base + (j - 2) * NPROJ : base);
            raw[j].x = ok ? v.x : zz; raw[j].y = ok ? v.y : zz; raw[j].z = ok ? v.z : zz; raw[j].w = ok ? v.w : zz; }
        else raw[j] = *(const u32x4*)(base + (j - 2) * NPROJ);
    }
}
__device__ __forceinline__ void conv_compute(const u32x4 (&raw)[8], const LAS float* wl, int nchl, int wch, float (&o)[4][8]) {
    float w[5][8], bs[8];
#pragma unroll
    for (int j = 0; j < 5; ++j) { const f32x4 w0 = *(const LAS f32x4*)(wl + j * nchl + wch), w1 = *(const LAS f32x4*)(wl + j * nchl + wch + 4);
        w[j][0] = w0[0]; w[j][1] = w0[1]; w[j][2] = w0[2]; w[j][3] = w0[3]; w[j][4] = w1[0]; w[j][5] = w1[1]; w[j][6] = w1[2]; w[j][7] = w1[3]; }
    { const f32x4 b0 = *(const LAS f32x4*)(wl + 5 * nchl + wch), b1 = *(const LAS f32x4*)(wl + 5 * nchl + wch + 4); bs[0] = b0[0]; bs[1] = b0[1]; bs[2] = b0[2]; bs[3] = b0[3]; bs[4] = b1[0]; bs[5] = b1[1]; bs[6] = b1[2]; bs[7] = b1[3]; }
#pragma unroll
    for (int i = 0; i < 4; ++i)
#pragma unroll
        for (int e = 0; e < 8; ++e) o[i][e] = bs[e];
#pragma unroll
    for (int j = 0; j < 8; ++j) {
        float xv[8] = {bflo(raw[j].x), bfhi(raw[j].x), bflo(raw[j].y), bfhi(raw[j].y), bflo(raw[j].z), bfhi(raw[j].z), bflo(raw[j].w), bfhi(raw[j].w)};
#pragma unroll
        for (int i = 0; i < 4; ++i) { const int tap = j - i; if (tap >= 0 && tap < 5) {
#pragma unroll
                for (int e = 0; e < 8; ++e) o[i][e] += w[tap][e] * xv[e]; } }
    }
#pragma unroll
    for (int i = 0; i < 4; ++i)
#pragma unroll
        for (int e = 0; e < 8; ++e) o[i][e] = siluf_(o[i][e]);
}
__device__ __forceinline__ void head_cums(CP p, int l, int row0, int h, int dir, int lane, LAS float* hv) {
    const float A = -expf(p->a_log[l * 16 + dir * 8 + h]);
    const float* DT = (const float*)(p->ws + WS_DT);
    const float d0 = DT[(size_t)(row0 + 2 * lane) * 16 + dir * 8 + h], d1 = DT[(size_t)(row0 + 2 * lane + 1) * 16 + dir * 8 + h];
    const float x0 = d0 * A, x1 = d1 * A;
    const float incl = wave_incl_scan(x0 + x1, lane);
    const float total = __builtin_bit_cast(float, __builtin_amdgcn_readlane(__builtin_bit_cast(int, incl), 63));
    float c0, c1;
    if (dir == 0) { c1 = incl; c0 = incl - x1; } else { c0 = total - (incl - x1 - x0); c1 = total - (incl - x1); }
    hv[dir * 128 + 2 * lane] = c0; hv[dir * 128 + 2 * lane + 1] = c1;
    hv[256 + dir * 128 + 2 * lane] = d0; hv[256 + dir * 128 + 2 * lane + 1] = d1;
    if (lane == 0) hv[512 + dir] = total;
}
__device__ __forceinline__ bf16x8 scale_frag(bf16x8 f, const f32x4 w0, const f32x4 w1) {
    const u32x4 u = __builtin_bit_cast(u32x4, f);
    u32x4 r;
    r.x = cvt_pk_bf16(bflo(u.x) * w0[0], bfhi(u.x) * w0[1]); r.y = cvt_pk_bf16(bflo(u.y) * w0[2], bfhi(u.y) * w0[3]);
    r.z = cvt_pk_bf16(bflo(u.z) * w1[0], bfhi(u.z) * w1[1]); r.w = cvt_pk_bf16(bflo(u.w) * w1[2], bfhi(u.w) * w1[3]);
    return __builtin_bit_cast(bf16x8, r);
}
constexpr int ST_X256 = 576;

__device__ __forceinline__ void phase_c1(CP p, int l, unsigned char* lds_, int bid, int nb) {
    LAS unsigned char* lds = (LAS unsigned char*)lds_;
    LAS unsigned char* tile = lds;
    LAS float* wl = (LAS float*)(lds + 73216);
    const int tid = launder_tid();
    const bf16_t* proj = (const bf16_t*)(p->ws + WS_PROJ); bf16_t* mix = (bf16_t*)(p->ws + WS_HX);
#pragma unroll 1
    for (int u = bid; u < 256 + 512 + (l == DEPTH - 1 ? 0 : 16); u += nb) {
        int S, LEN, pstride, sstride, tok0, ch0;
        if (u < 256) { const int b = u >> 7, cs = (u >> 2) & 31, cc = u & 3; S = 2; LEN = 256; pstride = 64; sstride = 1; tok0 = b * SEG + CTXL + 2 * cs; ch0 = 256 + 64 * cc; }
        else if (u < 768) { const int v = u - 256; const int b = v >> 8, rg = (v >> 2) & 63, cc = v & 3; S = 4; LEN = 64; pstride = 1; sstride = 64; tok0 = b * SEG + CTXL + 256 * rg; ch0 = 64 * cc; }
        else { const int v = u - 768; const int b = v >> 3, cc = v & 7; S = 1; LEN = 256; pstride = 1; sstride = 0; tok0 = b * SEG; ch0 = 64 * cc; }
        const int LP = LEN + 30;
        { float tw[4];
#pragma unroll
          for (int it = 0; it < 4; ++it) { const int i = tid + NTHREADS * it; const int j = i >> 6, c = i & 63; tw[it] = j < 31 ? p->conv_w[((size_t)l * 31 + j) * 512 + ch0 + c] : p->conv_b[l * 512 + ch0 + c]; }
#pragma unroll
          for (int it = 0; it < 4; ++it) wl[tid + NTHREADS * it] = tw[it]; }
        for (int i = tid; i < S * 30 * 8; i += NTHREADS) { const int pc = i & 7, q = (i >> 3) % 30, sq = (i >> 3) / 30; const int pos = q < 15 ? q : LEN + q;
            unsigned zz; asm volatile("v_mov_b32 %0, 0" : "=v"(zz));
            *(LAS u32x4*)(tile + ((sq * LP + pos) * 64 + pc * 8) * 2) = (u32x4){zz, zz, zz, zz}; }
#pragma unroll 4
        for (int i = tid; i < S * LEN * 8; i += NTHREADS) { const int pc = i & 7, t = i >> 3; const int sq = t / LEN, pos = t - sq * LEN;
            const bf16_t* src = proj + (size_t)(tok0 + sq * sstride + pos * pstride) * NPROJ + ch0 + pc * 8;
            const u32x4 uv = *(const u32x4*)src, gv = *(const u32x4*)(src + 512);
            u32x4 o;
            o.x = cvt_pk_bf16(bflo(uv.x) * sigmoidf_(bflo(gv.x)), bfhi(uv.x) * sigmoidf_(bfhi(gv.x)));
            o.y = cvt_pk_bf16(bflo(uv.y) * sigmoidf_(bflo(gv.y)), bfhi(uv.y) * sigmoidf_(bfhi(gv.y)));
            o.z = cvt_pk_bf16(bflo(uv.z) * sigmoidf_(bflo(gv.z)), bfhi(uv.z) * sigmoidf_(bfhi(gv.z)));
            o.w = cvt_pk_bf16(bflo(uv.w) * sigmoidf_(bflo(gv.w)), bfhi(uv.w) * sigmoidf_(bfhi(gv.w)));
            *(LAS u32x4*)(tile + ((sq * LP + 15 + pos) * 64 + pc * 8) * 2) = o; }
        __syncthreads();
        const int noct = S * LEN / 8;
#pragma unroll 1
        for (int it = tid; it < noct * 32; it += NTHREADS) {
            const int cp = it & 31, oc = it >> 5; const int sq = oc / (LEN / 8), p0 = (oc - sq * (LEN / 8)) * 8;
            const LAS unsigned* base = (const LAS unsigned*)(tile + ((sq * LP + p0) * 64) * 2) + cp;
            float i0[38], i1[38];
#pragma unroll
            for (int k = 0; k < 38; ++k) { const unsigned w = base[k * 32]; i0[k] = bflo(w); i1[k] = bfhi(w); }
            float a0[8], a1[8];
            { const float b0 = wl[31 * 64 + 2 * cp], b1 = wl[31 * 64 + 2 * cp + 1];
#pragma unroll
              for (int i = 0; i < 8; ++i) { a0[i] = b0; a1[i] = b1; } }
#pragma unroll
            for (int j = 0; j < 31; ++j) { typedef float f32x2 __attribute__((ext_vector_type(2))); const f32x2 wj = *(const LAS f32x2*)(wl + j * 64 + 2 * cp); const float w0 = wj[0], w1 = wj[1];
#pragma unroll
                for (int i = 0; i < 8; ++i) { a0[i] += w0 * i0[i + j]; a1[i] += w1 * i1[i + j]; } }
#pragma unroll
            for (int i = 0; i < 8; ++i) { const int tok = tok0 + sq * sstride + (p0 + i) * pstride;
                *(unsigned*)(mix + (size_t)tok * 1024 + 512 + ch0 + 2 * cp) = cvt_pk_bf16(a0[i], a1[i]); }
        }
        __syncthreads();
    }
}
__device__ __forceinline__ void phase_c1_ln(CP p, int l, int bid, int nb) {
    const int tid = launder_tid(); const int lane = tid & 63, wave = tid >> 6;
    bf16_t* mix = (bf16_t*)(p->ws + WS_HX);
    const f32x4 g0 = *(const f32x4*)(p->conv_ln_g + l * 512 + lane * 8), g1 = *(const f32x4*)(p->conv_ln_g + l * 512 + lane * 8 + 4);
    const f32x4 b0 = *(const f32x4*)(p->conv_ln_b + l * 512 + lane * 8), b1 = *(const f32x4*)(p->conv_ln_b + l * 512 + lane * 8 + 4);
    const float gg[8] = {g0[0], g0[1], g0[2], g0[3], g1[0], g1[1], g1[2], g1[3]}, bb[8] = {b0[0], b0[1], b0[2], b0[3], b1[0], b1[1], b1[2], b1[3]};
    for (int r = bid * 8 + wave; r < R; r += nb * 8) {
        u32x4* ptr = (u32x4*)(mix + (size_t)r * 1024 + 512 + lane * 8);
        const u32x4 v = *ptr;
        float y[8] = {bflo(v.x), bfhi(v.x), bflo(v.y), bfhi(v.y), bflo(v.z), bfhi(v.z), bflo(v.w), bfhi(v.w)};
        float s = 0.f;
#pragma unroll
        for (int e = 0; e < 8; ++e) s += y[e];
        const float mu = wave_sum(s) * (1.f / 512.f);
        float q = 0.f;
#pragma unroll
        for (int e = 0; e < 8; ++e) { y[e] -= mu; q += y[e] * y[e]; }
        const float rstd = rsqrtf(wave_sum(q) * (1.f / 512.f) + 1e-5f);
        float o[8];
#pragma unroll
        for (int e = 0; e < 8; ++e) o[e] = siluf_(y[e] * rstd * gg[e] + bb[e]);
        *ptr = pack8(o);
    }
}
__device__ __forceinline__ void phase_s1(CP p, int l, unsigned char* lds_, int bid, int nb) {
    LAS unsigned char* lds = (LAS unsigned char*)lds_;
    LAS unsigned char* Bs = lds;
    LAS unsigned char* Xs = lds + 128 * ST_TR128;
    LAS float* wv = (LAS float*)(Xs + 128 * ST_X256);
    LAS float* hvs = wv + 8 * 128;
    LAS float* cwl = hvs + 4 * 520;
    const int tid = launder_tid(); const int lane = tid & 63, wave = __builtin_amdgcn_readfirstlane(tid >> 6);
    const bf16_t* proj = (const bf16_t*)(p->ws + WS_PROJ);
    const float* cw = p->ssd_conv_w + (size_t)l * 5 * 1024; const float* cbias = p->ssd_conv_b + (size_t)l * 1024;
    bf16_t* Sg = (bf16_t*)(p->ws + WS_S); float* DEC = (float*)(p->ws + WS_DEC);
    int cur_g = -1;
#pragma unroll 1
    for (int u = bid; u < NB * NCHUNK * 2; u += nb) {
        const int g = u & 1, c = (u >> 1) % NCHUNK, b = (u >> 1) / NCHUNK;
        const int row0 = b * SEG + c * 128;
        const bool lo_ok = !(c == 0 || c == 2), hi_ok = !(c == 1 || c == NCHUNK - 1);
        if (g != cur_g) { cur_g = g;
            float tw[5];
#pragma unroll
            for (int it = 0; it < 5; ++it) { const int i = tid + NTHREADS * it; const int j = i / 384, lc = i - j * 384; const int gch = lc < 128 ? 512 + g * 128 + lc : g * 256 + (lc - 128);
                tw[it] = i < 6 * 384 ? (j < 5 ? cw[j * 1024 + gch] : cbias[gch]) : 0.f; }
#pragma unroll
            for (int it = 0; it < 5; ++it) { const int i = tid + NTHREADS * it; if (i < 6 * 384) cwl[i] = tw[it]; } }
        const int hh = wave >> 1, dir = wave & 1, h = 4 * g + hh;
        u32x4 rb[8], rx0[8], rx1[8];
        conv_load(proj, row0, tid >> 4, 512 + g * 128 + (tid & 15) * 8, lo_ok, hi_ok, rb);
        conv_load(proj, row0, tid >> 5, g * 256 + (tid & 31) * 8, lo_ok, hi_ok, rx0);
        conv_load(proj, row0, (tid >> 5) + 16, g * 256 + (tid & 31) * 8, lo_ok, hi_ok, rx1);
        head_cums(p, l, row0, h, dir, lane, hvs + hh * 520);
        __syncthreads();
        {
            const LAS float* hv = hvs + hh * 520; const float tot = hv[512 + dir];
#pragma unroll
            for (int q = 0; q < 2; ++q) { const int lr = lane + 64 * q; wv[wave * 128 + lr] = __expf(tot - hv[dir * 128 + lr]) * hv[256 + dir * 128 + lr]; }
            if (lane == 0) DEC[((size_t)(b * 2 + dir) * NCHUNK + c) * 8 + h] = __expf(tot);
        }
        { float o[4][8];
          conv_compute(rb, cwl, 384, (tid & 15) * 8, o);
#pragma unroll
          for (int i = 0; i < 4; ++i) *(LAS u32x4*)(Bs + (4 * (tid >> 4) + i) * ST_TR128 + (tid & 15) * 16) = pack8(o[i]);
          conv_compute(rx0, cwl, 384, 128 + (tid & 31) * 8, o);
#pragma unroll
          for (int i = 0; i < 4; ++i) *(LAS u32x4*)(Xs + (4 * (tid >> 5) + i) * ST_X256 + (tid & 31) * 16) = pack8(o[i]);
          conv_compute(rx1, cwl, 384, 128 + (tid & 31) * 8, o);
#pragma unroll
          for (int i = 0; i < 4; ++i) *(LAS u32x4*)(Xs + (4 * ((tid >> 5) + 16) + i) * ST_X256 + (tid & 31) * 16) = pack8(o[i]); }
        __syncthreads();
        {
            f32x16 acc[2][4];
#pragma unroll
            for (int t = 0; t < 2; ++t)
#pragma unroll
                for (int q = 0; q < 4; ++q)
#pragma unroll
                    for (int e = 0; e < 16; ++e) acc[t][q][e] = 0.f;
#pragma unroll 2
            for (int kk = 0; kk < 8; ++kk) {
                const LAS float* wp = wv + wave * 128 + 16 * kk + 8 * (lane >> 5);
                const f32x4 w0 = *(const LAS f32x4*)wp, w1 = *(const LAS f32x4*)(wp + 4);
                bf16x8 af[2];
#pragma unroll
                for (int t = 0; t < 2; ++t) af[t] = scale_frag(tr_frag(Xs, ST_X256, 16 * kk, hh * 64 + 32 * t, lane), w0, w1);
#pragma unroll
                for (int q = 0; q < 4; ++q) { const bf16x8 bf = tr_frag(Bs, ST_TR128, 16 * kk, 32 * q, lane);
#pragma unroll
                    for (int t = 0; t < 2; ++t) acc[t][q] = __builtin_amdgcn_mfma_f32_32x32x16_bf16(bf, af[t], acc[t][q], 0, 0, 0); }
            }
            bf16_t* So = Sg + ((size_t)((b * 2 + dir) * NCHUNK + c) * 8 + h) * 8192 + (size_t)(lane & 31) * 128 + 4 * (lane >> 5);
#pragma unroll
            for (int t = 0; t < 2; ++t)
#pragma unroll
                for (int q = 0; q < 4; ++q)
#pragma unroll
                    for (int rg = 0; rg < 4; ++rg) { u32x2 pk; pk.x = cvt_pk_bf16(acc[t][q][4 * rg], acc[t][q][4 * rg + 1]); pk.y = cvt_pk_bf16(acc[t][q][4 * rg + 2], acc[t][q][4 * rg + 3]);
                        *(u32x2*)(So + (size_t)(32 * t) * 128 + 32 * q + 8 * rg) = pk; }
        }
        __syncthreads();
    }
}
__device__ __forceinline__ void phase_s2(CP p, int bid, int nb) {
    const int tid = launder_tid();
    const bf16_t* Sg = (const bf16_t*)(p->ws + WS_S); const float* DEC = (const float*)(p->ws + WS_DEC); bf16_t* HP = (bf16_t*)(p->ws + WS_HP);
    for (int idx = bid * NTHREADS + tid; idx < 2 * 2 * 8 * 64 * 64; idx += nb * NTHREADS) {
        const int n2 = idx & 63, pr = (idx >> 6) & 63, h = (idx >> 12) & 7, dir = (idx >> 15) & 1, b = idx >> 16;
        const size_t inner = (size_t)h * 8192 + pr * 128 + 2 * n2;
        const size_t cbase = (size_t)(b * 2 + dir) * NCHUNK;
        float s0 = 0.f, s1 = 0.f;
#pragma unroll 10
        for (int step = 0; step < NCHUNK; ++step) {
            const int c = dir == 0 ? step : (step < 2 ? 1 - step : NCHUNK + 1 - step);
            const size_t off = (cbase + c) * 65536 + inner;
            const unsigned sv = *(const unsigned*)(Sg + off); const float d = DEC[(cbase + c) * 8 + h];
            *(unsigned*)(HP + off) = cvt_pk_bf16(s0, s1);
            s0 = s0 * d + bflo(sv); s1 = s1 * d + bfhi(sv);
        }
    }
}
__device__ __forceinline__ void phase_s3(CP p, int l, unsigned char* lds_, int bid, int nb) {
    LAS unsigned char* lds = (LAS unsigned char*)lds_;
    LAS unsigned char* Cs = lds;
    LAS unsigned char* Bs = Cs + 128 * ST_ROW;
    LAS unsigned char* Mt = Bs;
    LAS unsigned char* Xs = Bs + 128 * ST_TR128;
    LAS unsigned char* Hf = Xs + 128 * ST_TR64;
    LAS unsigned char* Hb = Hf + 64 * ST_ROW;
    LAS float* hvs = (LAS float*)(Hb + 64 * ST_ROW);
    LAS float* ssqp = hvs + 4 * 520;
    LAS float* cwl = ssqp + 256;
    const int tid0 = launder_tid(); const int wave = __builtin_amdgcn_readfirstlane(tid0 >> 6);
    const bf16_t* proj = (const bf16_t*)(p->ws + WS_PROJ); bf16_t* mix = (bf16_t*)(p->ws + WS_HX);
    const float* cw = p->ssd_conv_w + (size_t)l * 5 * 1024; const float* cbias = p->ssd_conv_b + (size_t)l * 1024;
    const bf16_t* HP = (const bf16_t*)(p->ws + WS_HP); float* SSQ = (float*)(p->ws + WS_SSQ);
    int cur_g = -1;
    const int cskip = (l == DEPTH - 1) ? 2 : 0, cpb = NCHUNK - cskip;
    const int nunits = NB * cpb * 2, nfull = nunits - nunits % nb, nitems = nfull + (nunits - nfull) * 4;
#pragma unroll 1
    for (int it = bid; it < nitems; it += nb) {
        const int u = it < nfull ? it : nfull + ((it - nfull) >> 2);
        const int hh_lo = it < nfull ? 0 : ((it - nfull) & 3), hh_hi = it < nfull ? 4 : hh_lo + 1;
        const int g = u & 1, c = cskip + (u >> 1) % cpb, b = (u >> 1) / cpb;
        int tid = tid0; asm volatile("" : "+v"(tid));
        const int lane = tid & 63;
        const int row0 = b * SEG + c * 128;
        const bool lo_ok = !(c == 0 || c == 2), hi_ok = !(c == 1 || c == NCHUNK - 1);
        if (g != cur_g) { cur_g = g;
            float tw[6];
#pragma unroll
            for (int it = 0; it < 6; ++it) { const int i = tid + NTHREADS * it; const int j = i >> 9, lc = i & 511; const int gch = lc < 128 ? 768 + g * 128 + lc : (lc < 256 ? 512 + g * 128 + (lc - 128) : g * 256 + (lc - 256));
                tw[it] = j < 5 ? cw[j * 1024 + gch] : cbias[gch]; }
#pragma unroll
            for (int it = 0; it < 6; ++it) cwl[tid + NTHREADS * it] = tw[it]; }
        u32x4 rx[8];
        {
            u32x4 r0[8], r1[8];
            const int cg = tid & 31; const int gch = (cg < 16 ? 768 : 512) + g * 128 + (cg & 15) * 8;
            conv_load(proj, row0, tid >> 5, gch, lo_ok, hi_ok, r0);
            conv_load(proj, row0, (tid >> 5) + 16, gch, lo_ok, hi_ok, r1);
            head_cums(p, l, row0, 4 * g + (wave >> 1), wave & 1, lane, hvs + (wave >> 1) * 520);
            __syncthreads();
            float o[4][8];
            LAS unsigned char* dst = (cg < 16 ? Cs : Bs) + (cg & 15) * 16;
            conv_compute(r0, cwl, 512, cg * 8, o);
#pragma unroll
            for (int i = 0; i < 4; ++i) *(LAS u32x4*)(dst + (4 * (tid >> 5) + i) * ST_ROW) = pack8(o[i]);
            asm volatile("" ::: "memory");
            if (tid < 256) conv_load(proj, row0, tid >> 3, g * 256 + hh_lo * 64 + (tid & 7) * 8, lo_ok, hi_ok, rx);
            conv_compute(r1, cwl, 512, cg * 8, o);
#pragma unroll
            for (int i = 0; i < 4; ++i) *(LAS u32x4*)(dst + (4 * ((tid >> 5) + 16) + i) * ST_ROW) = pack8(o[i]);
            if (tid < 256) { conv_compute(rx, cwl, 512, 256 + hh_lo * 64 + (tid & 7) * 8, o);
#pragma unroll
                for (int i = 0; i < 4; ++i) *(LAS u32x4*)(Xs + (4 * (tid >> 3) + i) * ST_TR64 + (tid & 7) * 16) = pack8(o[i]); }
        }
        __syncthreads();
        const int lb = wave >> 1, hs = wave & 1;
        int ln = lane; asm volatile("" : "+v"(ln));
        f32x16 gacc[2];
#pragma unroll
        for (int t = 0; t < 2; ++t)
#pragma unroll
            for (int e = 0; e < 16; ++e) gacc[t][e] = 0.f;
#pragma unroll
        for (int kk = 0; kk < 8; ++kk) { const bf16x8 af = row_frag(Cs, ST_ROW, 32 * lb, 16 * kk, lane);
#pragma unroll
            for (int t = 0; t < 2; ++t) { const bf16x8 bf = row_frag(Bs, ST_ROW, 64 * hs + 32 * t, 16 * kk, lane);
                gacc[t] = __builtin_amdgcn_mfma_f32_32x32x16_bf16(af, bf, gacc[t], 0, 0, 0); } }
        u32x4 hreg[4];
        { const bf16_t* hp0 = HP + ((size_t)(b * 2 * NCHUNK + c) * 8 + 4 * g + hh_lo) * 8192;
#pragma unroll
          for (int q = 0; q < 4; ++q) { const int it = tid + 512 * q; hreg[q] = *(const u32x4*)(hp0 + (size_t)(it >> 10) * NCHUNK * 8 * 8192 + (it & 1023) * 8); } }
        __syncthreads();
#pragma unroll 1
        for (int hh = hh_lo; hh < hh_hi; ++hh) {
            const int h = 4 * g + hh; const LAS float* hv = hvs + hh * 520;
            asm volatile("" : "+v"(ln));
            const int ph = hs, pc = 32 * ph + (ln & 31);
#pragma unroll
            for (int t = 0; t < 2; ++t) {
                const int sc = 64 * hs + 32 * t + (ln & 31);
                const float cfs = hv[sc], cbs = hv[128 + sc], dfs = hv[256 + sc], dbs = hv[384 + sc];
#pragma unroll
                for (int rg = 0; rg < 4; ++rg) {
                    const int l0 = 32 * lb + 8 * rg + 4 * (ln >> 5);
                    const f32x4 cfl = *(const LAS f32x4*)(hv + l0), cbl = *(const LAS f32x4*)(hv + 128 + l0);
                    float m[4];
#pragma unroll
                    for (int e = 0; e < 4; ++e) { const int lr = l0 + e;
                        const float ff = lr >= sc ? __expf(cfl[e] - cfs) * dfs : 0.f;
                        const float fb = lr <= sc ? __expf(cbl[e] - cbs) * dbs : 0.f;
                        m[e] = gacc[t][4 * rg + e] * (ff + fb); }
                    u32x2 pk; pk.x = cvt_pk_bf16(m[0], m[1]); pk.y = cvt_pk_bf16(m[2], m[3]);
                    *(LAS u32x2*)(Mt + sc * ST_TR128 + l0 * 2) = pk;
                }
            }
#pragma unroll
            for (int q = 0; q < 4; ++q) { const int it = tid + 512 * q; const int q2 = it & 1023;
                *(LAS u32x4*)(((it >> 10) ? Hb : Hf) + (q2 >> 4) * ST_ROW + (q2 & 15) * 16) = hreg[q]; }
            if (hh + 1 < hh_hi) {
                const bf16_t* hp0 = HP + ((size_t)(b * 2 * NCHUNK + c) * 8 + h + 1) * 8192;
#pragma unroll
                for (int q = 0; q < 4; ++q) { const int it = tid + 512 * q; hreg[q] = *(const u32x4*)(hp0 + (size_t)(it >> 10) * NCHUNK * 8 * 8192 + (it & 1023) * 8); }
                if (tid < 256) conv_load(proj, row0, tid >> 3, g * 256 + (hh + 1) * 64 + (tid & 7) * 8, lo_ok, hi_ok, rx);
            }
            unsigned zraw[8];
#pragma unroll
            for (int ri = 0; ri < 16; ri += 2) { const int lr = 32 * lb + 8 * (ri >> 2) + 4 * (ln >> 5) + (ri & 3);
                const bf16_t* zp = proj + (size_t)(row0 + lr) * NPROJ + 1024 + h * 64 + pc;
                zraw[ri >> 1] = (unsigned)zp[0] | ((unsigned)zp[NPROJ] << 16); }
            __syncthreads();
            f32x16 ad, af_, ab_;
#pragma unroll
            for (int e = 0; e < 16; ++e) { ad[e] = 0.f; af_[e] = 0.f; ab_[e] = 0.f; }
#pragma unroll
            for (int kk = 0; kk < 8; ++kk) {
                const bf16x8 am = tr_frag(Mt, ST_TR128, 16 * kk, 32 * lb, lane);
                const bf16x8 bx = tr_frag(Xs, ST_TR64, 16 * kk, 32 * ph, lane);
                ad = __builtin_amdgcn_mfma_f32_32x32x16_bf16(am, bx, ad, 0, 0, 0);
                const bf16x8 ac = row_frag(Cs, ST_ROW, 32 * lb, 16 * kk, lane);
                const bf16x8 bhf = row_frag(Hf, ST_ROW, 32 * ph, 16 * kk, lane);
                const bf16x8 bhb = row_frag(Hb, ST_ROW, 32 * ph, 16 * kk, lane);
                af_ = __builtin_amdgcn_mfma_f32_32x32x16_bf16(ac, bhf, af_, 0, 0, 0);
                ab_ = __builtin_amdgcn_mfma_f32_32x32x16_bf16(ac, bhb, ab_, 0, 0, 0);
            }
            const float dsk = p->d_skip[l * 8 + h];
#pragma unroll
            for (int rg = 0; rg < 4; ++rg) {
                const int l0 = 32 * lb + 8 * rg + 4 * (ln >> 5);
                const f32x4 cfl = *(const LAS f32x4*)(hv + l0), cbl = *(const LAS f32x4*)(hv + 128 + l0);
#pragma unroll
                for (int e = 0; e < 4; ++e) { const int lr = l0 + e; const int ri = 4 * rg + e;
                    const float xs = bf2f(*(const LAS bf16_t*)(Xs + lr * ST_TR64 + pc * 2));
                    const float y = ad[ri] + __expf(cfl[e]) * af_[ri] + __expf(cbl[e]) * ab_[ri] + dsk * xs;
                    const float z = (ri & 1) ? bfhi(zraw[ri >> 1]) : bflo(zraw[ri >> 1]);
                    const float val = y * siluf_(z);
                    mix[(size_t)(row0 + lr) * 1024 + h * 64 + pc] = f2bf(val);
                    const float sq = half_sum32(val * val);
                    if ((ln & 31) == 31) ssqp[ph * 128 + lr] = sq;
                }
            }
            __syncthreads();
            if (tid < 128) SSQ[(size_t)(row0 + tid) * 8 + h] = ssqp[tid] + ssqp[128 + tid];
            if (hh + 1 < hh_hi && tid < 256) { float o[4][8];
                conv_compute(rx, cwl, 512, 256 + (hh + 1) * 64 + (tid & 7) * 8, o);
#pragma unroll
                for (int i = 0; i < 4; ++i) *(LAS u32x4*)(Xs + (4 * (tid >> 3) + i) * ST_TR64 + (tid & 7) * 16) = pack8(o[i]); }
        }
        __syncthreads();
    }
}
__device__ __forceinline__ void phase_r2(CP p, int l, unsigned char* lds, int bid, int nb) {
    LAS float* wrt = (LAS float*)(LAS unsigned char*)lds;
    LAS float* gm = wrt + 20 * 1024;
    LAS float* sh = gm + 3 * 1024;
    LAS int* lcnt = (LAS int*)(sh + 3 * 1024);
    LAS int* lcls = lcnt + 64;
    LAS int* lrank = lcls + 1024;
    LAS float* lcwa = (LAS float*)(lrank + 1024);
    LAS float* lcwb = lcwa + 1024;
    const int tid = launder_tid(); const int lane = tid & 63, wave = tid >> 6;
    const float* mod = (const float*)(p->ws + WS_MOD) + (size_t)l * 3 * 6144;
    { float tmp[8];
#pragma unroll
      for (int it = 0; it < 8; ++it) tmp[it] = p->w_rg[(size_t)l * 4096 + tid + NTHREADS * it];
#pragma unroll
      for (int it = 0; it < 8; ++it) { const int idx = tid + NTHREADS * it; wrt[(idx & 3) * 1024 + (idx >> 2)] = tmp[it]; } }
#pragma unroll
    for (int hb = 0; hb < 2; ++hb) { float tmp[16];
#pragma unroll
        for (int it = 0; it < 16; ++it) tmp[it] = p->w_re[(size_t)l * 16384 + tid + NTHREADS * (16 * hb + it)];
#pragma unroll
        for (int it = 0; it < 16; ++it) { const int idx = tid + NTHREADS * (16 * hb + it); wrt[(4 + (idx & 15)) * 1024 + (idx >> 4)] = tmp[it]; } }
    { float t0[6], t1[6], t2[6];
#pragma unroll
      for (int it = 0; it < 6; ++it) { const int idx = tid + NTHREADS * it; const int v = idx >> 10, k = idx & 1023; t0[it] = p->g_ffn[l * 1024 + k]; t1[it] = mod[v * 6144 + 4 * 1024 + k]; t2[it] = mod[v * 6144 + 3 * 1024 + k]; }
#pragma unroll
      for (int it = 0; it < 6; ++it) { const int idx = tid + NTHREADS * it; gm[idx] = t0[it] * (1.f + t1[it]); sh[idx] = t2[it]; } }
    if (tid < 64) lcnt[tid] = 0;
    __syncthreads();
    bf16_t* HM = (bf16_t*)(p->ws + WS_HX); float* CWLA = (float*)(p->ws + WS_CWLA); float* CWLB = (float*)(p->ws + WS_CWLB); int* POS = (int*)(p->ws + WS_POS) + (size_t)l * R;
    int* gcount = (int*)(p->ws + WS_CTL) + l * 32; int* LIST = (int*)(p->ws + WS_LIST);
    const int rpb = (R + nb - 1) / nb, r0 = bid * rpb, r1 = (r0 + rpb) < R ? (r0 + rpb) : R;
    RowRaw xn[2];
#pragma unroll
    for (int q = 0; q < 2; ++q) if (r0 + wave + 8 * q < r1) row_load(p, 1, r0 + wave + 8 * q, lane, xn[q]);
    for (int r = r0 + wave; r < r1; r += 16) {
        f32x4 xv[2][4];
#pragma unroll
        for (int q = 0; q < 2; ++q) row_cvt(1, xn[q], xv[q]);
#pragma unroll
        for (int q = 0; q < 2; ++q) if (r + 16 + 8 * q < r1) row_load(p, 1, r + 16 + 8 * q, lane, xn[q]);
        int vq[2]; bool ok[2];
#pragma unroll
        for (int q = 0; q < 2; ++q) { const int rr = r + 8 * q; ok[q] = rr < r1; vq[q] = row_v(ok[q] ? rr : r); }
#pragma unroll
        for (int q = 0; q < 2; ++q) { float ss = 0.f;
#pragma unroll
            for (int j = 0; j < 4; ++j) ss += xv[q][j][0] * xv[q][j][0] + xv[q][j][1] * xv[q][j][1] + xv[q][j][2] * xv[q][j][2] + xv[q][j][3] * xv[q][j][3];
            ss = wave_sum(ss); const float rs = rsqrtf(ss * (1.f / 1024.f) + 1e-6f);
#pragma unroll
            for (int j = 0; j < 4; ++j) { const int k = 4 * lane + 256 * j; const f32x4 g4 = *(const LAS f32x4*)(gm + vq[q] * 1024 + k), s4 = *(const LAS f32x4*)(sh + vq[q] * 1024 + k);
                xv[q][j] = xv[q][j] * rs * g4 + s4;
                u32x2 o; o.x = cvt_pk_bf16(xv[q][j][0], xv[q][j][1]); o.y = cvt_pk_bf16(xv[q][j][2], xv[q][j][3]);
                if (ok[q]) *(u32x2*)(HM + (size_t)(r + 8 * q) * 1024 + k) = o; } }
        float lg[2][20];
#pragma unroll
        for (int n = 0; n < 20; ++n) { float a0 = 0.f, a1 = 0.f;
#pragma unroll
            for (int j = 0; j < 4; ++j) { const f32x4 w4 = *(const LAS f32x4*)(wrt + n * 1024 + 4 * lane + 256 * j);
                a0 += xv[0][j][0] * w4[0] + xv[0][j][1] * w4[1] + xv[0][j][2] * w4[2] + xv[0][j][3] * w4[3];
                a1 += xv[1][j][0] * w4[0] + xv[1][j][1] * w4[1] + xv[1][j][2] * w4[2] + xv[1][j][3] * w4[3]; }
            const float bias = n < 4 ? p->b_rg[l * 4 + n] : p->b_re[l * 16 + n - 4];
            lg[0][n] = wave_sum(a0) + bias; lg[1][n] = wave_sum(a1) + bias; }
#pragma unroll
        for (int q = 0; q < 2; ++q) {
            const int rr = r + 8 * q;
            if (!ok[q]) continue;
            if (l == DEPTH - 1 && vq[q] == 2) { if (lane == 0) lcls[rr - r0] = -1; continue; }
            int gsel = 0; float gmax = lg[q][0];
#pragma unroll
            for (int t = 1; t < 4; ++t) if (lg[q][t] > gmax) { gmax = lg[q][t]; gsel = t; }
            float gden = 0.f;
#pragma unroll
            for (int t = 0; t < 4; ++t) gden += __expf(lg[q][t] - gmax);
            const float gprob = 1.f / gden;
            float el[4];
#pragma unroll
            for (int t = 0; t < 4; ++t) el[t] = gsel == 0 ? lg[q][4 + t] : (gsel == 1 ? lg[q][8 + t] : (gsel == 2 ? lg[q][12 + t] : lg[q][16 + t]));
            int i0 = 0; float m0 = el[0];
#pragma unroll
            for (int t = 1; t < 4; ++t) if (el[t] > m0) { m0 = el[t]; i0 = t; }
            int i1 = -1; float m1 = -3.0e38f;
#pragma unroll
            for (int t = 0; t < 4; ++t) if (t != i0 && el[t] > m1) { m1 = el[t]; i1 = t; }
            const float w0 = gprob / (1.f + __expf(m1 - m0)), w1 = gprob - w0;
            const int ea = i0 < i1 ? i0 : i1, eb = i0 < i1 ? i1 : i0;
            const float cwa = i0 < i1 ? w0 : w1, cwb = i0 < i1 ? w1 : w0;
            const int pidx = ea == 0 ? eb - 1 : (ea == 1 ? eb + 1 : 5);
            const int cls = gsel * 6 + pidx;
            if (lane == 0) { const int rank = __hip_atomic_fetch_add(&lcnt[cls], 1, __ATOMIC_RELAXED, __HIP_MEMORY_SCOPE_WORKGROUP); lcls[rr - r0] = cls; lrank[rr - r0] = rank; lcwa[rr - r0] = cwa; lcwb[rr - r0] = cwb; }
        }
    }
    __syncthreads();
    if (tid < NCLS) lcnt[32 + tid] = atomicAdd(&gcount[tid], lcnt[tid]);
    __syncthreads();
    for (int idx = tid; idx < r1 - r0; idx += NTHREADS) { const int cl = lcls[idx]; if (cl < 0) continue; const int pos = lcnt[32 + cl] + lrank[idx]; const size_t li = (size_t)cl * R + pos;
        LIST[li] = r0 + idx; CWLA[li] = lcwa[idx]; CWLB[li] = lcwb[idx]; POS[r0 + idx] = (cl << 16) | pos; }
    __syncthreads();
}
__device__ __forceinline__ void phase_final(CP p, unsigned char* lds, int bid, int nb) {
    const int tid = launder_tid(); const int lane = tid & 63, wave = tid >> 6;
    LAS int* tab = (LAS int*)((LAS unsigned char*)lds + MISC_OFF);
    moe_table(p, DEPTH - 1, tab);
    const int* POS = (const int*)(p->ws + WS_POS) + (size_t)(DEPTH - 1) * R;
    const int qstep = nb * 8;
    RowRaw xn; u32x2 yn[4]; int posn = 0;
    { const int q = bid * 8 + wave;
      if (q < NB * SEQ) { const int b = q >= SEQ ? 1 : 0; const int r = b * SEG + CTXL + (q - b * SEQ);
          row_load(p, 1, r, lane, xn);
          moe_yload(p, POS[r], lane, tab, yn);
          const int qn = q + qstep; if (qn < NB * SEQ) { const int bn = qn >= SEQ ? 1 : 0; posn = POS[bn * SEG + CTXL + (qn - bn * SEQ)]; } } }
    for (int q = bid * 8 + wave; q < NB * SEQ; q += qstep) {
        const int b = q >= SEQ ? 1 : 0;
        f32x4* hr = (f32x4*)(p->out + (size_t)q * D);
        f32x4 xv[4]; u32x2 yv[4]; float ss = 0.f;
        row_cvt(1, xn, xv);
#pragma unroll
        for (int j = 0; j < 4; ++j) yv[j] = yn[j];
        { const int qn = q + qstep;
          if (qn < NB * SEQ) { const int bn = qn >= SEQ ? 1 : 0;
              row_load(p, 1, bn * SEG + CTXL + (qn - bn * SEQ), lane, xn);
              moe_yload(p, posn, lane, tab, yn);
              const int q2 = qn + qstep; if (q2 < NB * SEQ) { const int b2 = q2 >= SEQ ? 1 : 0; posn = POS[b2 * SEG + CTXL + (q2 - b2 * SEQ)]; } } }
        moe_yadd(p, DEPTH - 1, b, lane, yv, xv);
#pragma unroll
        for (int j = 0; j < 4; ++j) ss += xv[j][0] * xv[j][0] + xv[j][1] * xv[j][1] + xv[j][2] * xv[j][2] + xv[j][3] * xv[j][3];
        ss = wave_sum(ss); const float rs = rsqrtf(ss * (1.f / 1024.f) + 1e-6f);
#pragma unroll
        for (int j = 0; j < 4; ++j) { const f32x4 g4 = *(const f32x4*)(p->g_final + 4 * lane + 256 * j); hr[lane + 64 * j] = xv[j] * rs * g4; }
    }
}


#define XB_TMO      128
#define XB_XCNT(j)  (256  + 64 * (j))
#define XB_XSUB(j)  (1280 + 64 * (j))
#define XB_XGEN(j)  (2304 + 64 * (j))
#define XB_TOP      3328
#define XB_TOPGEN   3392
#define XCD_BAR_WORDS 3456
#define XB_SPIN_CAP (1u << 22)
__device__ __forceinline__ unsigned xb_ld(unsigned* p) { return __hip_atomic_load(p, __ATOMIC_RELAXED, __HIP_MEMORY_SCOPE_AGENT); }
__device__ __forceinline__ unsigned xb_add(unsigned* p, unsigned v) { return __hip_atomic_fetch_add(p, v, __ATOMIC_RELAXED, __HIP_MEMORY_SCOPE_AGENT); }
__device__ __forceinline__ unsigned xb_xcc_id() { return (unsigned)__builtin_amdgcn_s_getreg((3 << 11) | 20) & 0xFu; }
#define XB_SPIN(cond, bar) do { unsigned _sp = 0; while (cond) { __builtin_amdgcn_s_sleep(1); \
    if ((++_sp & 255u) == 0u) { if (xb_ld(&(bar)[XB_TMO])) break; if (_sp > XB_SPIN_CAP) { atomicAdd(&(bar)[XB_TMO], 1u); break; } } } } while (0)
struct XcdBarrier { unsigned* bar; unsigned x; volatile LAS unsigned* st; };
__device__ __forceinline__ XcdBarrier xcd_barrier_post(unsigned* bar, volatile LAS unsigned* st) {
    XcdBarrier b; b.bar = bar; b.x = xb_xcc_id(); b.st = st;
    if (threadIdx.x == 0) (void)xb_add(&bar[XB_XCNT(b.x)], 1u);
    return b;
}
__device__ __forceinline__ void xcd_barrier_complete(unsigned* bar, unsigned x, unsigned& nloc, unsigned& nx) {
    const unsigned G = gridDim.x * gridDim.y * gridDim.z;
    unsigned sum, cnt, mine, sp = 0u;
    for (;;) {
        sum = 0u; cnt = 0u; mine = 0u;
#pragma unroll
        for (unsigned j = 0; j < 16; ++j) { const unsigned c = xb_ld(&bar[XB_XCNT(j)]); sum += c; cnt += (c > 0u) ? 1u : 0u; mine = (j == x) ? c : mine; }
        if (sum == G) break;
        __builtin_amdgcn_s_sleep(1);
        if ((++sp & 255u) == 0u) { if (xb_ld(&bar[XB_TMO])) break; if (sp > XB_SPIN_CAP) { atomicAdd(&bar[XB_TMO], 1u); break; } }
    }
    nloc = mine > 0u ? mine : 1u; nx = cnt > 0u ? cnt : 1u;
}
__device__ __forceinline__ void xcd_barrier(const XcdBarrier& b) {
    asm volatile("s_waitcnt vmcnt(0)" ::: "memory");
    __syncthreads();
    if (threadIdx.x == 0) {
        unsigned* bar = b.bar;
        __builtin_amdgcn_s_waitcnt(0);
        unsigned nloc = b.st[0], nx = b.st[1];
        if (nloc == 0u) { xcd_barrier_complete(bar, b.x, nloc, nx); b.st[0] = nloc; b.st[1] = nx; }
        const unsigned old = xb_add(&bar[XB_XSUB(b.x)], 1u);
        const unsigned gen = old / nloc;
        if (old + 1u == (gen + 1u) * nloc) {
            __builtin_amdgcn_fence(__ATOMIC_RELEASE, "agent");
            asm volatile("s_waitcnt vmcnt(0)" ::: "memory");
            const unsigned og = xb_add(&bar[XB_TOP], 1u);
            const unsigned tg = og / nx;
            if (og + 1u == (tg + 1u) * nx) xb_add(&bar[XB_TOPGEN], 1u);
            else XB_SPIN(xb_ld(&bar[XB_TOPGEN]) == tg, bar);
            __builtin_amdgcn_fence(__ATOMIC_ACQUIRE, "agent");
            xb_add(&bar[XB_XGEN(b.x)], 1u);
            asm volatile("s_waitcnt vmcnt(0)" ::: "memory");
        } else {
            XB_SPIN(xb_ld(&bar[XB_XGEN(b.x)]) == gen, bar);
            __builtin_amdgcn_fence(__ATOMIC_ACQUIRE, "agent");
            asm volatile("s_waitcnt vmcnt(0)" ::: "memory");
        }
    }
    __syncthreads();
}

#ifndef TIMING_A
#define TIMING_A -1
#endif
#ifndef TIMING_B
#define TIMING_B -1
#endif
#ifndef PHASE_MASK
#define PHASE_MASK 0xFFFFF
#endif
#define PM(i) ((PHASE_MASK >> (i)) & 1)
#ifndef REPEAT_MASK
#define REPEAT_MASK 0
#endif
#define RP(i) for (int rep_ = 0; rep_ < 1 + ((REPEAT_MASK >> (i)) & 1); ++rep_)
constexpr int PH_PER_LAYER = 9, NPHASES = 1 + DEPTH * PH_PER_LAYER + 1;
__global__ void __launch_bounds__(NTHREADS, 2) mk_fwd(Args args) {
    extern __shared__ __attribute__((aligned(16))) unsigned char lds[];
    cg::grid_group grid = cg::this_grid();
    const __attribute__((address_space(4))) Args* ap = (const __attribute__((address_space(4))) Args*)__builtin_amdgcn_kernarg_segment_ptr();
    const int lo = ap->lo, hi = ap->hi;
    LAS unsigned char* ldsl = (LAS unsigned char*)lds;
    volatile LAS unsigned* xbst = (volatile LAS unsigned*)(ldsl + LDS_BYTES - 16);
    if (threadIdx.x < 4) xbst[threadIdx.x] = 0u;
    __syncthreads();
    (void)xcd_barrier_post((unsigned*)(ap->p.ws + WS_BAR), xbst);
    if (TIMING_A >= 0 && blockIdx.x == 0 && threadIdx.x == 0) ((unsigned long long*)(ap->p.ws + WS_TS))[lo] = __builtin_amdgcn_s_memrealtime();
    for (int ph = lo; ph < hi; ++ph) {
        CP p = launder(&ap->p);
        int bid = blockIdx.x, nb = gridDim.x; asm volatile("" : "+s"(bid), "+s"(nb));
        if (ph == 0) { if (PM(0)) RP(0) phase_wprep(p, lds, bid, nb); if (PM(1)) RP(1) phase_adaln(p, lds, bid, nb); }
        else if (ph == NPHASES - 1) { if (PM(12)) phase_final(p, lds, bid, nb); }
        else {
            const int l = (ph - 1) / PH_PER_LAYER, s = (ph - 1) % PH_PER_LAYER;
            if (s == 0) { if (PM(2)) RP(2) { if (rep_ == 0 || l == 0) phase_r1(p, l, lds, bid, nb); } }
            else if (s == 1) { if (PM(3)) RP(3) {
                pg8::DenseSched S; S.init(p->ws + WS_HX, (const bf16_t*)(p->ws + WS_WTIN) + (size_t)l * DIN * 1024, R, NPROJ, 1024, 1024, 1024, nb, bid);
                EpiProj E{(bf16_t*)(p->ws + WS_PROJ)};
                pg8::gemm_phase<EpiProj, pg8::DenseSched, false>(ldsl, 1024, 1024, 1024, S, E);
            } }
            else if (s == 2) { if (PM(4)) RP(4) phase_c1(p, l, lds, bid, nb); if (PM(5)) RP(5) phase_s1(p, l, lds, bid, nb); }
            else if (s == 3) { if (PM(6)) RP(6) phase_s2(p, bid, nb); if (PM(4)) phase_c1_ln(p, l, bid, nb); }
            else if (s == 4) { if (PM(7)) RP(7) phase_s3(p, l, lds, bid, nb); }
            else if (s == 5) { if (PM(8)) RP(8) { if (rep_ == 0 || l == 0) {
                pg8::DenseSched S; S.init(p->ws + WS_HX, (const bf16_t*)(p->ws + WS_WTOUT) + (size_t)l * 1024 * 1024, R, 1024, 1024, 1024, 1024, nb, bid, l == DEPTH - 1);
                EpiResid<0> E{p->ctx, p->x, (bf16_t*)(p->ws + WS_H), (const float*)(p->ws + WS_MOD) + (size_t)l * 3 * 6144, (const float*)(p->ws + WS_SSQ)};
                pg8::gemm_phase<EpiResid<0>, pg8::DenseSched, false>(ldsl, 1024, 1024, 1024, S, E);
            } } }
            else if (s == 6) { if (PM(9)) phase_r2(p, l, lds, bid, nb); }
            else if (s == 7) { if (PM(10)) RP(10) {
                LAS int* tab = (LAS int*)(ldsl + MISC_OFF); moe_table(p, l, tab);
                MoeSched S{tab, (const int*)(p->ws + WS_LIST), (const char*)(p->ws + WS_HX), (const char*)(p->ws + WS_WTGU), 0, l, nb, bid};
                EpiUp E{(bf16_t*)(p->ws + WS_HID), (const float*)(p->ws + WS_CWLA), (const float*)(p->ws + WS_CWLB)};
                pg8::gemm_phase<EpiUp, MoeSched, true>(ldsl, 1024, 1024, 1024, S, E);
            } }
            else { if (PM(11)) RP(11) {
                LAS int* tab = (LAS int*)(ldsl + MISC_OFF); moe_table(p, l, tab);
                MoeSched S{tab, (const int*)(p->ws + WS_LIST), (const char*)(p->ws + WS_HID), (const char*)(p->ws + WS_WTD), 1, l, nb, bid};
                EpiY E{(bf16_t*)(p->ws + WS_Y)};
                pg8::gemm_phase<EpiY, MoeSched, false>(ldsl, 512, 256, 512, S, E);
            } }
        }
        if (ph + 1 < hi) { if (hi < 0) grid.sync();   else { XcdBarrier xb; xb.bar = (unsigned*)(launder(&ap->p)->ws + WS_BAR); xb.x = xb_xcc_id(); xb.st = (volatile LAS unsigned*)(ldsl + LDS_BYTES - 16); xcd_barrier(xb); }
            if (TIMING_A >= 0 && blockIdx.x == 0 && threadIdx.x == 0) ((unsigned long long*)(launder(&ap->p)->ws + WS_TS))[ph + 1] = __builtin_amdgcn_s_memrealtime(); }
    }
#if TIMING_A >= 0
    {
        XcdBarrier xb; xb.bar = (unsigned*)(launder(&ap->p)->ws + WS_BAR); xb.x = xb_xcc_id(); xb.st = (volatile LAS unsigned*)(ldsl + LDS_BYTES - 16); xcd_barrier(xb);
        if (blockIdx.x == 0 && threadIdx.x == 0) ((unsigned long long*)(launder(&ap->p)->ws + WS_TS))[hi] = __builtin_amdgcn_s_memrealtime();
        xcd_barrier(xb);
        const unsigned long long* ts = (const unsigned long long*)(launder(&ap->p)->ws + WS_TS);
        const float ta = (float)(ts[TIMING_A + 1] - ts[TIMING_A]) * 0.01f, tb = (float)(ts[TIMING_B + 1] - ts[TIMING_B]) * 0.01f;
        float* o = launder(&ap->p)->out; const float sc = 1.f + ta * 0.001f;
        for (size_t i = (size_t)blockIdx.x * NTHREADS + threadIdx.x; i < (size_t)NB * SEQ * D; i += (size_t)gridDim.x * NTHREADS) o[i] = o[i] * sc + (i == 0 ? tb * 0.1f : 0.f);
    }
#endif
}

extern "C" void kernel_launch(void* const* d_in, const int* in_sizes, int n_in, void* d_out, int out_size, void* d_ws, size_t ws_size, hipStream_t stream) {
    static int grid = 0;
    if (grid == 0) {
        if (n_in != 28 || ws_size < WS_END) { fprintf(stderr, "kernel_launch: unexpected n_in %d or ws_size %zu (< %zu)\n", n_in, ws_size, (size_t)WS_END); grid = -1; return; }
        int dev = 0, cus = 0, per_cu = 0;
        hipGetDevice(&dev); hipDeviceGetAttribute(&cus, hipDeviceAttributeMultiprocessorCount, dev);
        if (hipFuncSetAttribute((const void*)mk_fwd, hipFuncAttributeMaxDynamicSharedMemorySize, LDS_BYTES) != hipSuccess) { fprintf(stderr, "kernel_launch: hipFuncSetAttribute failed\n"); grid = -1; return; }
        if (hipOccupancyMaxActiveBlocksPerMultiprocessor(&per_cu, (const void*)mk_fwd, NTHREADS, LDS_BYTES) != hipSuccess || per_cu < 1) { fprintf(stderr, "kernel_launch: occupancy query says %d\n", per_cu); (void)hipGetLastError(); grid = -1; return; }
        grid = cus;
    }
    if (grid < 0) return;
    (void)hipMemsetAsync((char*)d_ws + WS_CTL, 0, WS_CTL_BYTES, stream);
    Args a{};
    const float** pp = (const float**)&a.p;
    for (int i = 0; i < 28; ++i) pp[i] = (const float*)d_in[i];
    a.p.out = (float*)d_out; a.p.ws = (unsigned char*)d_ws;
#if PER_PHASE_LAUNCH
    for (int ph = 0; ph < NPHASES; ++ph) {
        a.lo = ph; a.hi = ph + 1; void* kargs[] = {&a};
        hipError_t e = hipLaunchCooperativeKernel((const void*)mk_fwd, dim3(grid), dim3(NTHREADS), kargs, LDS_BYTES, stream);
        if (e != hipSuccess) { fprintf(stderr, "kernel_launch: launch of phase %d failed: %s\n", ph, hipGetErrorString(e)); break; }
    }
#else
    a.lo = 0; a.hi = NPHASES; void* kargs[] = {&a};
    hipError_t e = hipLaunchCooperativeKernel((const void*)mk_fwd, dim3(grid), dim3(NTHREADS), kargs, LDS_BYTES, stream);
    if (e != hipSuccess) fprintf(stderr, "kernel_launch: cooperative launch failed: %s (grid %d)\n", hipGetErrorString(e), grid);
#endif
}
```

```cpp
#include <hip/hip_runtime.h>
#include <hip/hip_cooperative_groups.h>
#include <cstdio>
namespace cg = cooperative_groups;

#ifndef PER_PHASE_LAUNCH
#define PER_PHASE_LAUNCH 0
#endif

#ifndef S3REP
#define S3REP 0
#endif
#define S3R(i) for (int r3_ = 0; r3_ < 1 + ((S3REP >> (i)) & 1); ++r3_)
#define LAS __attribute__((address_space(3)))
typedef unsigned short bf16_t;
typedef short bf16x8 __attribute__((ext_vector_type(8)));
typedef float f32x4 __attribute__((ext_vector_type(4)));
typedef unsigned u32x4 __attribute__((ext_vector_type(4)));
typedef unsigned u32x2 __attribute__((ext_vector_type(2)));

constexpr int D = 1024, NB = 2, SEQ = 16384, CTXL = 256, SEG = SEQ + CTXL, R = NB * SEG, DEPTH = 2;
constexpr int NPROJ = 2560, DIN = 2576;
constexpr int NTHREADS = 512;
constexpr int LDS_BYTES = 163840;
constexpr int MISC_OFF = 131072;
constexpr int NCLS = 24;

constexpr size_t al256(size_t x) { return (x + 255) & ~size_t(255); }
constexpr size_t WS_CTL = 0;
constexpr size_t WS_TS = 2048;
constexpr size_t WS_BAR = 4096;
constexpr size_t WS_CTL_BYTES = 32768;
constexpr size_t WS_MOD = WS_CTL_BYTES;
constexpr size_t WS_WTIN = WS_MOD + al256((size_t)2 * 3 * 6144 * 4);
constexpr size_t WS_WTOUT = WS_WTIN + al256((size_t)2 * DIN * 1024 * 2);
constexpr size_t WS_WTGU = WS_WTOUT + al256((size_t)2 * 1024 * 1024 * 2);
constexpr size_t WS_WTD = WS_WTGU + al256((size_t)2 * 16 * 512 * 1024 * 2);
constexpr size_t WS_H = WS_WTD + al256((size_t)2 * 16 * 1024 * 256 * 2);
constexpr size_t WS_HX = WS_H + al256((size_t)R * 1024 * 2);
constexpr size_t WS_PROJ = WS_HX + al256((size_t)R * 1024 * 2);
constexpr size_t WS_DT = WS_PROJ + al256((size_t)R * NPROJ * 2);
constexpr size_t WS_POS = WS_DT + al256((size_t)R * 16 * 4);
constexpr size_t WS_LIST = WS_POS + al256((size_t)2 * R * 4);
constexpr size_t WS_CWLA = WS_LIST + al256((size_t)NCLS * R * 4);
constexpr size_t WS_CWLB = WS_CWLA + al256((size_t)NCLS * R * 4);
constexpr size_t WS_BIG = WS_CWLB + al256((size_t)NCLS * R * 4);
constexpr size_t WS_Y = WS_PROJ;
constexpr size_t WS_S = WS_BIG;
constexpr size_t WS_HP = WS_S + al256((size_t)2 * 2 * 130 * 8 * 8192 * 2);
constexpr size_t WS_DEC = WS_HP + al256((size_t)2 * 2 * 130 * 8 * 8192 * 2);
constexpr size_t WS_SSQ = WS_DEC + al256((size_t)2 * 2 * 130 * 8 * 4);
constexpr size_t WS_HID = WS_S;
constexpr size_t WS_END = WS_SSQ + al256((size_t)R * 8 * 4);
static_assert((size_t)(R + NCLS * 256) * 512 * 2 <= (size_t)2 * 2 * 130 * 8 * 8192 * 2, "hid alias");
static_assert(WS_END <= (size_t)512 * 1024 * 1024, "workspace");

struct Params {
    const float *x, *c, *ctx, *c_ctx, *w_ada, *b_ada, *g_mix, *g_ffn, *w_in, *conv_w, *conv_b, *conv_ln_g, *conv_ln_b, *ssd_conv_w, *ssd_conv_b,
        *dt_bias, *a_log, *d_skip, *ssd_norm_g, *w_out, *w_rg, *b_rg, *w_re, *b_re, *w_gate, *w_up, *w_down, *g_final;
    float* out; unsigned char* ws;
};
struct Args { Params p; int lo, hi; };
typedef const __attribute__((address_space(4))) Params* CP;
__device__ __forceinline__ CP launder(CP p) { asm volatile("" : "+s"(p)); return p; }
__device__ __forceinline__ int launder_tid() { int t = threadIdx.x; asm volatile("" : "+v"(t)); return t; }

__device__ __forceinline__ unsigned cvt_pk_bf16(float lo, float hi) { unsigned r; asm("v_cvt_pk_bf16_f32 %0, %1, %2" : "=v"(r) : "v"(lo), "v"(hi)); return r; }
__device__ __forceinline__ float bf2f(unsigned b) { return __uint_as_float(b << 16); }
__device__ __forceinline__ float bflo(unsigned w) { return __uint_as_float(w << 16); }
__device__ __forceinline__ float bfhi(unsigned w) { return __uint_as_float(w & 0xffff0000u); }
__device__ __forceinline__ bf16_t f2bf(float f) { return (bf16_t)(cvt_pk_bf16(f, 0.f) & 0xffffu); }
#define DPP_ADD(v, ctrl, rm) ((v) + __builtin_bit_cast(float, __builtin_amdgcn_update_dpp(0, __builtin_bit_cast(int, (v)), (ctrl), (rm), 0xF, true)))
__device__ __forceinline__ float row_sum16(float v) {
    v = DPP_ADD(v, 0xB1, 0xF);
    v = DPP_ADD(v, 0x4E, 0xF);
    v = DPP_ADD(v, 0x141, 0xF);
    v = DPP_ADD(v, 0x140, 0xF);
    return v;
}
__device__ __forceinline__ float half_sum32(float v) { v = row_sum16(v); v = DPP_ADD(v, 0x142, 0xA); return v; }
__device__ __forceinline__ float wave_sum(float v) {
    v = half_sum32(v); v = DPP_ADD(v, 0x143, 0xC);
    return __builtin_bit_cast(float, __builtin_amdgcn_readlane(__builtin_bit_cast(int, v), 63));
}
__device__ __forceinline__ float sigmoidf_(float x) { return 1.f / (1.f + __expf(-x)); }
__device__ __forceinline__ float siluf_(float x) { return x / (1.f + __expf(-x)); }
__device__ __forceinline__ float softplusf_(float x) { return fmaxf(x, 0.f) + log1pf(expf(-fabsf(x))); }

__device__ __forceinline__ int row_b(int r) { return r >= SEG ? 1 : 0; }
__device__ __forceinline__ int row_i(int r) { return r >= SEG ? r - SEG : r; }
__device__ __forceinline__ int row_v(int r) { const int i = row_i(r); return i < CTXL ? 2 : row_b(r); }
__device__ __forceinline__ const float* xin_ptr(const float* ctx, const float* x, int r) {
    const int b = row_b(r), i = row_i(r);
    return i < CTXL ? ctx + (size_t)(b * CTXL + i) * D : x + (size_t)(b * SEQ + i - CTXL) * D;
}
struct RowRaw { f32x4 f[4]; u32x2 h[4]; };
__device__ __forceinline__ void row_load(CP p, int l, int r, int lane, RowRaw& rr) {
    if (l == 0) { const f32x4* hr = (const f32x4*)xin_ptr(p->ctx, p->x, r);
#pragma unroll
        for (int j = 0; j < 4; ++j) rr.f[j] = hr[lane + 64 * j]; }
    else { const u32x2* hr = (const u32x2*)((const bf16_t*)(p->ws + WS_H) + (size_t)r * D);
#pragma unroll
        for (int j = 0; j < 4; ++j) rr.h[j] = hr[lane + 64 * j]; }
}
__device__ __forceinline__ void row_cvt(int l, const RowRaw& rr, f32x4 (&xv)[4]) {
#pragma unroll
    for (int j = 0; j < 4; ++j) xv[j] = l == 0 ? rr.f[j] : (f32x4){bflo(rr.h[j].x), bfhi(rr.h[j].x), bflo(rr.h[j].y), bfhi(rr.h[j].y)};
}
namespace pg8 {
constexpr int BM = 256, BK = 64, HALF = 128, HTB = HALF * BK * 2, STAGE_BYTES = 8 * HTB, NXCD = 8, WGM = 8;
__device__ __forceinline__ int lds_byte(int r, int c) { const int st = (r >> 4) * 2 + (c >> 5), rr = r & 15, cc = c & 31, ob = rr * 64 + cc * 2; return st * 1024 + (ob ^ (((ob >> 9) & 1) << 5)); }
__device__ __forceinline__ void stage_rc(int b, int& Rr, int& Cc) { const int st = b / 1024, sb = b % 1024, swz = sb ^ (((sb >> 9) & 1) << 5); Rr = (st >> 1) * 16 + swz / 64; Cc = (st & 1) * 32 + (swz % 64) / 2; }
__device__ __forceinline__ int perm32(int rho) { const int n = rho >> 4, i = rho & 15; return 8 * (i >> 2) + 4 * n + (i & 3); }

struct Unit {
    const char* a0;
    const char* b0;
    const char* b1;
    int i0, i1, i2, i3, i4, pad;
};

template <class Epi, class Sched, bool GATHER>
__device__ __forceinline__ void gemm_phase(LAS unsigned char* lds, const int lda, const int ldb, const int K, const Sched& S, const Epi& E) {
    const int tid = launder_tid(); const int wid = __builtin_amdgcn_readfirstlane(tid >> 6), lane = tid & 63, wr = wid >> 2, wc = wid & 3, fr = lane & 15, fq = lane >> 4;
    const int nt = K / BK, ks = nt >> 1;
    int Rr[2], Cc[2];
    unsigned voffB[2];
#pragma unroll
    for (int i = 0; i < 2; ++i) { stage_rc(tid * 16 + i * 8192, Rr[i], Cc[i]); const int Rb = Epi::PERM ? ((Rr[i] & ~31) + perm32(Rr[i] & 31)) : Rr[i];
        voffB[i] = (unsigned)(Rb * ldb + Cc[i]) * 2u; }
    const size_t kstep = (size_t)(BK * 2);
    const size_t hstepB = (size_t)HALF * ldb * 2;
    const unsigned ldsw = (unsigned)wid * 1024u;
    const unsigned ldsbase = (unsigned)(unsigned long)lds;
    const int aoff = lds_byte(wr * 64 + fr, fq * 8), boff = lds_byte(wc * 32 + fr, fq * 8);
#define PG8_SA(b, h) (((b) * 2 + (h)) * HTB)
#define PG8_SB(b, h) ((4 + (b) * 2 + (h)) * HTB)
#define PG8_STAGE2(bufoff, gbase, v0, v1) do { unsigned keep_; \
        asm volatile("s_mov_b32 %0, m0\n\ts_mov_b32 m0, %1\n\ts_nop 4\n\tglobal_load_lds_dwordx4 %2, %4\n\ts_add_u32 m0, m0, 0x2000\n\ts_nop 0\n\tglobal_load_lds_dwordx4 %3, %4\n\ts_mov_b32 m0, %0" \
            : "=&s"(keep_) : "s"(ldsbase + (unsigned)(bufoff) + ldsw), "v"(v0), "v"(v1), "s"(gbase) : "memory", "scc"); } while (0)
#define PG8_LDA(dst, b, h) do { _Pragma("unroll") for (int m = 0; m < 4; ++m) _Pragma("unroll") for (int k = 0; k < 2; ++k) dst[m][k] = *(const LAS bf16x8*)(lds + PG8_SA(b, h) + aoff + m * 2048 + k * 1024); } while (0)
#define PG8_LDB(dst, b, h) do { _Pragma("unroll") for (int n = 0; n < 2; ++n) _Pragma("unroll") for (int k = 0; k < 2; ++k) dst[n][k] = *(const LAS bf16x8*)(lds + PG8_SB(b, h) + boff + n * 2048 + k * 1024); } while (0)
#define PG8_MMA(ai, bj, At, Bt) do { __builtin_amdgcn_s_setprio(1); _Pragma("unroll") for (int m = 0; m < 4; ++m) _Pragma("unroll") for (int n = 0; n < 2; ++n) _Pragma("unroll") for (int k = 0; k < 2; ++k) \
        acc[ai][bj][m][n] = __builtin_amdgcn_mfma_f32_16x16x32_bf16(Bt[n][k], At[m][k], acc[ai][bj][m][n], 0, 0, 0); __builtin_amdgcn_s_setprio(0); } while (0)
#define PG8_WAIT_V(n) asm volatile("s_waitcnt vmcnt(" #n ")" ::: "memory")
#define PG8_WAIT_L(n) asm volatile("s_waitcnt lgkmcnt(" #n ")" ::: "memory")
#define PG8_BAR __builtin_amdgcn_s_barrier()
#define PG8_SCHED __builtin_amdgcn_sched_barrier(0)
#define PG8_BP(u, tt) ((tt) < ks ? (u).b0 + (size_t)(tt) * kstep : (u).b1 + (size_t)((tt) - ks) * kstep)
    Unit cur, nxt; int ui = 0;
    if (!S.get(0, cur)) return;
    unsigned c00, c01, c10, c11, n00, n01, n10, n11;
    if (GATHER) {
        c00 = (unsigned)(S.arow(cur, Rr[0]) * lda + Cc[0]) * 2u; c01 = (unsigned)(S.arow(cur, Rr[1]) * lda + Cc[1]) * 2u;
        c10 = (unsigned)(S.arow(cur, HALF + Rr[0]) * lda + Cc[0]) * 2u; c11 = (unsigned)(S.arow(cur, HALF + Rr[1]) * lda + Cc[1]) * 2u;
    } else {
        c00 = (unsigned)(Rr[0] * lda + Cc[0]) * 2u; c01 = (unsigned)(Rr[1] * lda + Cc[1]) * 2u;
        c10 = (unsigned)((HALF + Rr[0]) * lda + Cc[0]) * 2u; c11 = (unsigned)((HALF + Rr[1]) * lda + Cc[1]) * 2u;
    }
    n00 = c00; n01 = c01; n10 = c10; n11 = c11;
    f32x4 acc[2][2][4][2];
    float zr; asm volatile("v_mov_b32 %0, 0" : "=v"(zr));
#pragma unroll
    for (int a = 0; a < 2; ++a)
#pragma unroll
        for (int b = 0; b < 2; ++b)
#pragma unroll
            for (int m = 0; m < 4; ++m)
#pragma unroll
                for (int n = 0; n < 2; ++n) acc[a][b][m][n] = (f32x4){zr, zr, zr, zr};
    bf16x8 At[4][2], B0[2][2], B1[2][2];
    const char* cA = cur.a0;
    {
        const char* pb0 = PG8_BP(cur, 0); const char* pb1 = PG8_BP(cur, 1);
        PG8_STAGE2(PG8_SB(0, 0), pb0, voffB[0], voffB[1]); PG8_STAGE2(PG8_SA(0, 0), cA, c00, c01);
        PG8_STAGE2(PG8_SB(0, 1), pb0 + hstepB, voffB[0], voffB[1]); PG8_STAGE2(PG8_SA(0, 1), cA, c10, c11);
        if (wr == 1) PG8_BAR;
        PG8_WAIT_V(4); PG8_BAR;
        PG8_STAGE2(PG8_SB(1, 0), pb1, voffB[0], voffB[1]); PG8_STAGE2(PG8_SA(1, 0), cA + kstep, c00, c01);
        PG8_STAGE2(PG8_SB(1, 1), pb1 + hstepB, voffB[0], voffB[1]);
        PG8_WAIT_V(6); PG8_BAR;
    }
    for (;;) {
        const bool has_next = S.get(ui + 1, nxt);
        if (!has_next) nxt = cur;
        LAS int* tokb = (LAS int*)(lds + MISC_OFF + 1024) + ((ui + 1) & 1) * 256;
        if (GATHER) {
            n00 = c00; n01 = c01; n10 = c10; n11 = c11;
            if (has_next && wid == 0) {
                const char* src = (const char*)S.rows_ptr(nxt); unsigned keep_;
                asm volatile("s_mov_b32 %0, m0\n\ts_mov_b32 m0, %1\n\ts_nop 4\n\tglobal_load_lds_dwordx4 %2, %3\n\ts_mov_b32 m0, %0"
                    : "=&s"(keep_) : "s"((unsigned)(unsigned long)tokb), "v"((unsigned)lane * 16u), "s"(src) : "memory");
            }
        }
        const char* nA = nxt.a0;
#pragma unroll 1
        for (int t = 0; t < nt; t += 2) {
            const bool last = (t == nt - 2);
            const char* a1 = cA + (size_t)(t + 1) * kstep;
            const char* a2 = last ? nA : cA + (size_t)(t + 2) * kstep;
            const char* a3 = a2 + kstep;
            const char* b2 = last ? PG8_BP(nxt, 0) : PG8_BP(cur, t + 2);
            const char* b3 = last ? PG8_BP(nxt, 1) : PG8_BP(cur, t + 3);
            if (GATHER) { if (last && has_next) {
                const int lim = S.rows_valid(nxt) - 1;
                const int i0 = Rr[0] < lim ? Rr[0] : lim, i1 = Rr[1] < lim ? Rr[1] : lim, i2 = (HALF + Rr[0]) < lim ? (HALF + Rr[0]) : lim, i3 = (HALF + Rr[1]) < lim ? (HALF + Rr[1]) : lim;
                n00 = (unsigned)(tokb[i0] * lda + Cc[0]) * 2u; n01 = (unsigned)(tokb[i1] * lda + Cc[1]) * 2u;
                n10 = (unsigned)(tokb[i2] * lda + Cc[0]) * 2u; n11 = (unsigned)(tokb[i3] * lda + Cc[1]) * 2u; } }
            const unsigned s00 = last ? n00 : c00, s01 = last ? n01 : c01, s10 = last ? n10 : c10, s11 = last ? n11 : c11;
            if constexpr (Epi::MIDSCALE) { if (t == ks) E.midscale(acc, cur, wr, wc, fr, fq); }
            PG8_LDB(B0, 0, 0); PG8_SCHED; PG8_LDA(At, 0, 0); PG8_STAGE2(PG8_SA(1, 1), a1, c10, c11);
            PG8_WAIT_L(8); PG8_BAR; PG8_WAIT_L(0); PG8_MMA(0, 0, At, B0); PG8_BAR; PG8_SCHED;
            PG8_LDB(B1, 0, 1); PG8_STAGE2(PG8_SB(0, 0), b2, voffB[0], voffB[1]);
            PG8_BAR; PG8_WAIT_L(0); PG8_MMA(0, 1, At, B1); PG8_BAR;
            PG8_LDA(At, 0, 1); PG8_STAGE2(PG8_SA(0, 0), a2, s00, s01);
            PG8_BAR; PG8_WAIT_L(0); PG8_MMA(1, 0, At, B0); PG8_BAR; PG8_SCHED;
            PG8_STAGE2(PG8_SB(0, 1), b2 + hstepB, voffB[0], voffB[1]);
            PG8_WAIT_V(6); PG8_BAR; PG8_MMA(1, 1, At, B1); PG8_BAR;
            PG8_LDB(B0, 1, 0); PG8_SCHED; PG8_LDA(At, 1, 0); PG8_STAGE2(PG8_SA(0, 1), a2, s10, s11);
            PG8_WAIT_L(8); PG8_BAR; PG8_WAIT_L(0); PG8_MMA(0, 0, At, B0); PG8_BAR; PG8_SCHED;
            PG8_LDB(B1, 1, 1); PG8_STAGE2(PG8_SB(1, 0), b3, voffB[0], voffB[1]);
            PG8_BAR; PG8_WAIT_L(0); PG8_MMA(0, 1, At, B1); PG8_BAR;
            PG8_LDA(At, 1, 1); PG8_STAGE2(PG8_SA(1, 0), a3, s00, s01);
            PG8_BAR; PG8_WAIT_L(0); PG8_MMA(1, 0, At, B0); PG8_BAR; PG8_SCHED;
            PG8_STAGE2(PG8_SB(1, 1), b3 + hstepB, voffB[0], voffB[1]);
            PG8_WAIT_V(6); PG8_BAR; PG8_MMA(1, 1, At, B1); PG8_BAR;
        }
        E(acc, cur, wr, wc, fr, fq);
        if (!has_next) break;
        asm volatile("v_mov_b32 %0, 0" : "=v"(zr));
#pragma unroll
        for (int a = 0; a < 2; ++a)
#pragma unroll
            for (int b = 0; b < 2; ++b)
#pragma unroll
                for (int m = 0; m < 4; ++m)
#pragma unroll
                    for (int n = 0; n < 2; ++n) acc[a][b][m][n] = (f32x4){zr, zr, zr, zr};
        cur = nxt; cA = nA; ++ui; c00 = n00; c01 = n01; c10 = n10; c11 = n11;
    }
    PG8_WAIT_V(0);
    if (wr == 0) PG8_BAR;
    PG8_BAR;
#undef PG8_SA
#undef PG8_SB
#undef PG8_STAGE2
#undef PG8_LDA
#undef PG8_LDB
#undef PG8_MMA
#undef PG8_WAIT_V
#undef PG8_WAIT_L
#undef PG8_BAR
#undef PG8_SCHED
#undef PG8_BP
}

struct DenseSched {
    const char* A; const char* Bt; int lda, ldb, K; int nM, nN, nwg, G, c, skipctx;
    __device__ __forceinline__ void init(const void* A_, const void* Bt_, int M, int N, int K_, int lda_, int ldb_, int G_, int c_, int skipctx_ = 0) {
        A = (const char*)A_; Bt = (const char*)Bt_; lda = lda_; ldb = ldb_; K = K_; nM = M / BM - 2 * skipctx_; nN = N / BM; nwg = nM * nN; G = G_; c = c_; skipctx = skipctx_; }
    __device__ __forceinline__ bool get(int i, Unit& u) const {
        const long L = (long)i * G + c; if (L >= nwg) return false;
        int wgid = (int)L; { const int q = nwg / NXCD, r = nwg % NXCD, xcd = wgid % NXCD, off = wgid / NXCD; wgid = (xcd < r ? xcd * (q + 1) : r * (q + 1) + (xcd - r) * q) + off; }
        const int nig = WGM * nN, gid = wgid / nig, fm = gid * WGM, gsz = (nM - fm) < WGM ? (nM - fm) : WGM;
        int pm = fm + ((wgid % nig) % gsz); const int pn = (wgid % nig) / gsz;
        if (skipctx) pm += 1 + (pm >= 64 ? 1 : 0);
        u.a0 = A + (size_t)pm * BM * lda * 2; u.b0 = Bt + (size_t)pn * BM * ldb * 2; u.b1 = u.b0 + (size_t)(K / BK / 2) * BK * 2;
        u.i0 = pm; u.i1 = pn; u.i2 = 0; u.i3 = 0; u.i4 = 0; u.pad = 0; return true;
    }
    __device__ __forceinline__ int arow(const Unit&, int rl) const { return rl; }
    __device__ __forceinline__ const int* rows_ptr(const Unit&) const { return nullptr; }
    __device__ __forceinline__ int rows_valid(const Unit&) const { return 256; }
};
}

struct EpiProj {
    static constexpr bool PERM = true, MIDSCALE = false;
    bf16_t* O;
    __device__ __forceinline__ void operator()(const f32x4 (&acc)[2][2][4][2], const pg8::Unit& u, int wr, int wc, int fr, int fq) const {
        const int row0 = u.i0 * 256 + wr * 64 + fr, col0 = u.i1 * 256 + wc * 32 + 8 * fq;
#pragma unroll
        for (int ai = 0; ai < 2; ++ai)
#pragma unroll
            for (int m = 0; m < 4; ++m) { bf16_t* rowp = O + (size_t)(row0 + ai * 128 + m * 16) * NPROJ + col0;
#pragma unroll
                for (int bj = 0; bj < 2; ++bj) { const f32x4 v0 = acc[ai][bj][m][0], v1 = acc[ai][bj][m][1];
                    u32x4 w; w.x = cvt_pk_bf16(v0[0], v0[1]); w.y = cvt_pk_bf16(v0[2], v0[3]); w.z = cvt_pk_bf16(v1[0], v1[1]); w.w = cvt_pk_bf16(v1[2], v1[3]);
                    *(u32x4*)(rowp + bj * 128) = w; } }
    }
};
template <int L0> struct EpiResid {
    static constexpr bool PERM = true, MIDSCALE = true;
    const float* inc; const float* inx; bf16_t* H; const float* modl; const float* ssq;
    __device__ __forceinline__ void midscale(f32x4 (&acc)[2][2][4][2], const pg8::Unit& u, int wr, int wc, int fr, int fq) const {
        typedef float f32x2 __attribute__((ext_vector_type(2)));
        const int r0 = u.i0 * 256 + wr * 64 + fr;
        f32x2 part[2][4];
#pragma unroll
        for (int ai = 0; ai < 2; ++ai)
#pragma unroll
            for (int m = 0; m < 4; ++m) part[ai][m] = *(const f32x2*)(ssq + (size_t)(r0 + ai * 128 + m * 16) * 8 + 2 * fq);
#pragma unroll
        for (int ai = 0; ai < 2; ++ai)
#pragma unroll
            for (int m = 0; m < 4; ++m) { float sq = part[ai][m][0] + part[ai][m][1];
                sq += __shfl_xor(sq, 16); sq += __shfl_xor(sq, 32);
                const float rs = rsqrtf(sq * (1.f / 512.f) + 1e-6f);
#pragma unroll
                for (int bj = 0; bj < 2; ++bj)
#pragma unroll
                    for (int n = 0; n < 2; ++n) acc[ai][bj][m][n] *= rs; }
    }
    __device__ __forceinline__ void operator()(const f32x4 (&acc)[2][2][4][2], const pg8::Unit& u, int wr, int wc, int fr, int fq) const {
        const int r0 = u.i0 * 256;
        const int v = row_v(r0);
        const float* gate = modl + (size_t)v * 6144 + 2 * 1024;
        const float* xin = xin_ptr(inc, inx, r0);
        const int rl0 = wr * 64 + fr, col0 = u.i1 * 256 + wc * 32 + 8 * fq;
        f32x4 gv[2][2];
#pragma unroll
        for (int bj = 0; bj < 2; ++bj)
#pragma unroll
            for (int n = 0; n < 2; ++n) gv[bj][n] = *(const f32x4*)(gate + col0 + bj * 128 + 4 * n);
#pragma unroll
        for (int ai = 0; ai < 2; ++ai)
#pragma unroll
            for (int mp = 0; mp < 2; ++mp) {
                if (L0) {
                    f32x4 hi[2][2][2];
#pragma unroll
                    for (int mm = 0; mm < 2; ++mm) { const size_t off = (size_t)(rl0 + ai * 128 + (2 * mp + mm) * 16) * D + col0;
#pragma unroll
                        for (int bj = 0; bj < 2; ++bj)
#pragma unroll
                            for (int n = 0; n < 2; ++n) hi[mm][bj][n] = *(const f32x4*)(xin + off + bj * 128 + 4 * n); }
#pragma unroll
                    for (int mm = 0; mm < 2; ++mm)
#pragma unroll
                        for (int bj = 0; bj < 2; ++bj) { const f32x4 o0 = hi[mm][bj][0] + gv[bj][0] * acc[ai][bj][2 * mp + mm][0], o1 = hi[mm][bj][1] + gv[bj][1] * acc[ai][bj][2 * mp + mm][1];
                            u32x4 w; w.x = cvt_pk_bf16(o0[0], o0[1]); w.y = cvt_pk_bf16(o0[2], o0[3]); w.z = cvt_pk_bf16(o1[0], o1[1]); w.w = cvt_pk_bf16(o1[2], o1[3]);
                            *(u32x4*)(H + (size_t)(r0 + rl0 + ai * 128 + (2 * mp + mm) * 16) * D + col0 + bj * 128) = w; }
                } else {
                    u32x4 hr[2][2];
#pragma unroll
                    for (int mm = 0; mm < 2; ++mm)
#pragma unroll
                        for (int bj = 0; bj < 2; ++bj) hr[mm][bj] = *(const u32x4*)(H + (size_t)(r0 + rl0 + ai * 128 + (2 * mp + mm) * 16) * D + col0 + bj * 128);
#pragma unroll
                    for (int mm = 0; mm < 2; ++mm)
#pragma unroll
                        for (int bj = 0; bj < 2; ++bj) { const u32x4 hv = hr[mm][bj]; const f32x4 a0 = acc[ai][bj][2 * mp + mm][0], a1 = acc[ai][bj][2 * mp + mm][1]; const f32x4 g0 = gv[bj][0], g1 = gv[bj][1];
                            u32x4 w;
                            w.x = cvt_pk_bf16(bflo(hv.x) + g0[0] * a0[0], bfhi(hv.x) + g0[1] * a0[1]); w.y = cvt_pk_bf16(bflo(hv.y) + g0[2] * a0[2], bfhi(hv.y) + g0[3] * a0[3]);
                            w.z = cvt_pk_bf16(bflo(hv.z) + g1[0] * a1[0], bfhi(hv.z) + g1[1] * a1[1]); w.w = cvt_pk_bf16(bflo(hv.w) + g1[2] * a1[2], bfhi(hv.w) + g1[3] * a1[3]);
                            *(u32x4*)(H + (size_t)(r0 + rl0 + ai * 128 + (2 * mp + mm) * 16) * D + col0 + bj * 128) = w; }
                }
                asm volatile("" ::: "memory"); }
    }
};

struct MoeSched {
    const LAS int* tab;
    const int* list;
    const char* A; const char* W; int mode  , l, G, c;
    __device__ __forceinline__ bool get(int i, pg8::Unit& u) const {
        const int L = i * G + c; const int total = __builtin_amdgcn_readfirstlane(tab[24]) * 4; if (L >= total) return false;
        const int tl = L >> 2, pn = L & 3;
        int cls = 0;
#pragma unroll 1
        for (int q = 1; q < NCLS; ++q) { const int tq = __builtin_amdgcn_readfirstlane(tab[q]); if (tq <= tl) cls = q; }
        const int j = tl - __builtin_amdgcn_readfirstlane(tab[cls]), cnt = __builtin_amdgcn_readfirstlane(tab[32 + cls]);
        const int g = cls / 6, pidx = cls - g * 6;
        const int ea = (pidx >= 3) + (pidx >= 5), eb = pidx < 3 ? pidx + 1 : (pidx < 5 ? pidx - 1 : 3);
        if (mode == 0) {
            const int e = 4 * g + (pn < 2 ? ea : eb);
            u.a0 = A;
            u.b0 = W + ((size_t)(l * 16 + e) * 512 + (size_t)(pn & 1) * 256) * 1024 * 2; u.b1 = u.b0 + (size_t)8 * 128;
        } else {
            u.a0 = A + (size_t)tl * 256 * 512 * 2;
            u.b0 = W + ((size_t)(l * 16 + 4 * g + ea) * 1024 + (size_t)pn * 256) * 256 * 2;
            u.b1 = W + ((size_t)(l * 16 + 4 * g + eb) * 1024 + (size_t)pn * 256) * 256 * 2;
        }
        u.i0 = cls; u.i1 = j; u.i2 = pn; u.i3 = cnt; u.i4 = tl; u.pad = 0; return true;
    }
    __device__ __forceinline__ int arow(const pg8::Unit& u, int rl) const {
        int idx = u.i1 * 256 + rl; idx = idx < u.i3 ? idx : u.i3 - 1;
        return list[(size_t)u.i0 * R + idx];
    }
    __device__ __forceinline__ const int* rows_ptr(const pg8::Unit& u) const { return list + (size_t)u.i0 * R + u.i1 * 256; }
    __device__ __forceinline__ int rows_valid(const pg8::Unit& u) const { return u.i3 - u.i1 * 256; }
};
struct EpiUp {
    static constexpr bool PERM = true, MIDSCALE = false;
    bf16_t* hid; const float* cwla; const float* cwlb;
    __device__ __forceinline__ void operator()(const f32x4 (&acc)[2][2][4][2], const pg8::Unit& u, int wr, int wc, int fr, int fq) const {
        const int cls = u.i0, j = u.i1, pn = u.i2, cnt = u.i3, tl = u.i4;
        const float* cw = (pn < 2) ? cwla : cwlb;
        const int colbase = (pn >> 1) * 256 + (pn & 1) * 128 + wc * 32 + 8 * fq;
        float wrow[2][4];
#pragma unroll
        for (int ai = 0; ai < 2; ++ai)
#pragma unroll
            for (int m = 0; m < 4; ++m) { const int idx = j * 256 + ai * 128 + wr * 64 + m * 16 + fr; wrow[ai][m] = idx < cnt ? cw[(size_t)cls * R + idx] : 0.f; }
#pragma unroll
        for (int ai = 0; ai < 2; ++ai)
#pragma unroll
            for (int m = 0; m < 4; ++m) {
                const int rl = ai * 128 + wr * 64 + m * 16 + fr; const int idx = j * 256 + rl; const bool valid = idx < cnt;
                const float w = wrow[ai][m];
                const f32x4 g0 = acc[ai][0][m][0], g1 = acc[ai][0][m][1], u0 = acc[ai][1][m][0], u1 = acc[ai][1][m][1];
                float o[8];
#pragma unroll
                for (int e = 0; e < 4; ++e) { o[e] = w * siluf_(g0[e]) * u0[e]; o[4 + e] = w * siluf_(g1[e]) * u1[e]; }
                if (!valid) {
#pragma unroll
                    for (int e = 0; e < 8; ++e) o[e] = 0.f; }
                u32x4 pk; pk.x = cvt_pk_bf16(o[0], o[1]); pk.y = cvt_pk_bf16(o[2], o[3]); pk.z = cvt_pk_bf16(o[4], o[5]); pk.w = cvt_pk_bf16(o[6], o[7]);
                *(u32x4*)(hid + ((size_t)tl * 256 + rl) * 512 + colbase) = pk;
                asm volatile("" ::: "memory");
            }
    }
};
struct EpiDown {
    static constexpr bool PERM = true, MIDSCALE = false;
    bf16_t* H; const int* list; const float* modl;
    __device__ __forceinline__ void operator()(const f32x4 (&acc)[2][2][4][2], const pg8::Unit& u, int wr, int wc, int fr, int fq) const {
        const int cls = u.i0, j = u.i1, pn = u.i2, cnt = u.i3;
        const int col0 = pn * 256 + wc * 32 + 8 * fq;
        int tok[2][4];
#pragma unroll
        for (int ai = 0; ai < 2; ++ai)
#pragma unroll
            for (int m = 0; m < 4; ++m) { const int idx = j * 256 + ai * 128 + wr * 64 + m * 16 + fr; tok[ai][m] = idx < cnt ? list[(size_t)cls * R + idx] : -1; }
#pragma unroll
        for (int ai = 0; ai < 2; ++ai)
#pragma unroll
            for (int mp = 0; mp < 2; ++mp) {
                u32x4 hr[2][2]; f32x4 gv[2][2][2];
#pragma unroll
                for (int mm = 0; mm < 2; ++mm) { const int t = tok[ai][2 * mp + mm]; const int tt = t < 0 ? 0 : t;
                    const bf16_t* hp = H + (size_t)tt * D + col0; const float* gp = modl + (size_t)row_v(tt) * 6144 + col0;
#pragma unroll
                    for (int bj = 0; bj < 2; ++bj) { hr[mm][bj] = *(const u32x4*)(hp + bj * 128); gv[mm][bj][0] = *(const f32x4*)(gp + bj * 128); gv[mm][bj][1] = *(const f32x4*)(gp + bj * 128 + 4); } }
#pragma unroll
                for (int mm = 0; mm < 2; ++mm) { const int t = tok[ai][2 * mp + mm];
                    if (t >= 0) {
#pragma unroll
                        for (int bj = 0; bj < 2; ++bj) { const u32x4 hv = hr[mm][bj]; const f32x4 a0 = acc[ai][bj][2 * mp + mm][0], a1 = acc[ai][bj][2 * mp + mm][1]; const f32x4 g0 = gv[mm][bj][0], g1 = gv[mm][bj][1];
                            u32x4 w;
                            w.x = cvt_pk_bf16(bflo(hv.x) + g0[0] * a0[0], bfhi(hv.x) + g0[1] * a0[1]); w.y = cvt_pk_bf16(bflo(hv.y) + g0[2] * a0[2], bfhi(hv.y) + g0[3] * a0[3]);
                            w.z = cvt_pk_bf16(bflo(hv.z) + g1[0] * a1[0], bfhi(hv.z) + g1[1] * a1[1]); w.w = cvt_pk_bf16(bflo(hv.w) + g1[2] * a1[2], bfhi(hv.w) + g1[3] * a1[3]);
                            *(u32x4*)(H + (size_t)t * D + col0 + bj * 128) = w; } } }
                asm volatile("" ::: "memory"); }
    }
};

__device__ __forceinline__ void tr_tile(const float* src, int ldn, int k0, int n0, int nvalid, bf16_t* dst, int ldk, int drow0, LAS float* tile, int kd0 = -1, const float* kscale = nullptr) {
    const int tid = launder_tid();
    if (kd0 < 0) kd0 = k0;
    { const int n = tid & 63; const int kq = tid >> 6; float tv[8], ts[8];
#pragma unroll
      for (int it = 0; it < 8; ++it) { const int kk = kq + 8 * it; tv[it] = (n < nvalid) ? src[(size_t)(k0 + kk) * ldn + n0 + n] : 0.f; ts[it] = kscale ? kscale[kk] : 1.f; }
#pragma unroll
      for (int it = 0; it < 8; ++it) tile[(kq + 8 * it) * 65 + n] = tv[it] * ts[it]; }
    __syncthreads();
    { const int k8 = tid & 7, n = tid >> 3;
      if (n < nvalid) { const LAS float* s = tile + (k8 * 8) * 65 + n;
          u32x4 o; o.x = cvt_pk_bf16(s[0], s[65]); o.y = cvt_pk_bf16(s[2 * 65], s[3 * 65]); o.z = cvt_pk_bf16(s[4 * 65], s[5 * 65]); o.w = cvt_pk_bf16(s[6 * 65], s[7 * 65]);
          *(u32x4*)(dst + (size_t)(drow0 + n) * ldk + kd0 + k8 * 8) = o; } }
    __syncthreads();
}
__device__ __forceinline__ void phase_wprep(CP p, unsigned char* lds, int bid, int nb) {
    LAS float* tile = (LAS float*)(LAS unsigned char*)lds;
    constexpr int I_IN = 16 * 41, I_OUT = 256, I_G = 1024, I_U = 1024, I_D = 1024, I_L = I_IN + I_OUT + I_G + I_U + I_D;
    for (int it = bid; it < 2 * I_L; it += nb) {
        const int l = it / I_L; int r = it - l * I_L;
        if (r < I_IN) { const int kt = r / 41, ntl = r % 41; const int n0 = ntl * 64; const int nv = (DIN - n0) < 64 ? (DIN - n0) : 64;
            tr_tile(p->w_in + (size_t)l * 1024 * DIN, DIN, kt * 64, n0, nv, (bf16_t*)(p->ws + WS_WTIN) + (size_t)l * DIN * 1024, 1024, n0, tile); continue; }
        r -= I_IN;
        if (r < I_OUT) { const int kt = r >> 4, ntl = r & 15;
            tr_tile(p->w_out + (size_t)l * 1024 * 1024, 1024, kt * 64, ntl * 64, 64, (bf16_t*)(p->ws + WS_WTOUT) + (size_t)l * 1024 * 1024, 1024, ntl * 64, tile,
                    (kt * 64 + 512) & 1023, kt >= 8 ? p->ssd_norm_g + l * 512 + (kt * 64 - 512) : nullptr); continue; }
        r -= I_OUT;
        if (r < I_G + I_U) { const int up = r >= I_G; if (up) r -= I_G; const int e = r >> 6, q = r & 63, kt = q >> 2, ntl = q & 3; const int n0 = ntl * 64;
            const float* src = (up ? p->w_up : p->w_gate) + (size_t)(l * 16 + e) * 1024 * 256;
            tr_tile(src, 256, kt * 64, n0, 64, (bf16_t*)(p->ws + WS_WTGU) + (size_t)(l * 16 + e) * 512 * 1024, 1024, (n0 >> 7) * 256 + (n0 & 127) + (up ? 128 : 0), tile); continue; }
        r -= I_G + I_U;
        { const int e = r >> 6, q = r & 63, kt = q >> 4, ntl = q & 15;
          tr_tile(p->w_down + (size_t)(l * 16 + e) * 256 * 1024, 1024, kt * 64, ntl * 64, 64, (bf16_t*)(p->ws + WS_WTD) + (size_t)(l * 16 + e) * 1024 * 256, 256, ntl * 64, tile); }
    }
}
__device__ __forceinline__ void phase_adaln(CP p, unsigned char* lds, int bid, int nb) {
    LAS float* sc = (LAS float*)(LAS unsigned char*)lds;
    LAS float* red = sc + 3 * 1024;
    const int tid = launder_tid();
    for (int idx = tid; idx < 3 * 1024; idx += NTHREADS) { const int v = idx >> 10, k = idx & 1023; const float cv = (v < 2) ? p->c[v * 1024 + k] : p->c_ctx[k]; sc[idx] = siluf_(cv); }
    __syncthreads();
    float* mod = (float*)(p->ws + WS_MOD);
    for (int it = bid; it < 2 * 96; it += nb) {
        const int l = it / 96, n0 = (it % 96) * 64;
        const int c4 = tid & 15, kr = tid >> 4;
        f32x4 a0 = {0, 0, 0, 0}, a1 = {0, 0, 0, 0}, a2 = {0, 0, 0, 0};
        const float* w = p->w_ada + (size_t)l * 1024 * 6144 + n0 + c4 * 4;
#pragma unroll 4
        for (int k = kr; k < 1024; k += 32) { const f32x4 w4 = *(const f32x4*)(w + (size_t)k * 6144); a0 += sc[k] * w4; a1 += sc[1024 + k] * w4; a2 += sc[2048 + k] * w4; }
        *(LAS f32x4*)(red + (kr * 3 + 0) * 64 + c4 * 4) = a0; *(LAS f32x4*)(red + (kr * 3 + 1) * 64 + c4 * 4) = a1; *(LAS f32x4*)(red + (kr * 3 + 2) * 64 + c4 * 4) = a2;
        __syncthreads();
        if (tid < 192) { const int v = tid >> 6, cc = tid & 63; float s = 0.f;
            for (int q = 0; q < 32; ++q) s += red[(q * 3 + v) * 64 + cc];
            mod[((size_t)l * 3 + v) * 6144 + n0 + cc] = s + p->b_ada[l * 6144 + n0 + cc]; }
        __syncthreads();
    }
}
__device__ __forceinline__ void moe_table(CP p, int l, LAS int* tab) {
    const int* gcount = (const int*)(p->ws + WS_CTL) + l * 32;
    if (threadIdx.x == 0) { int acc = 0; for (int q = 0; q < NCLS; ++q) { const int cn = gcount[q]; tab[q] = acc; tab[32 + q] = cn; acc += (cn + 255) >> 8; } tab[24] = acc; }
    __syncthreads();
}
__device__ __forceinline__ void moe_yload(CP p, int pos, int lane, const LAS int* tab, u32x2 (&yv)[4]) {
    const int slot = tab[pos >> 16] * 256 + (pos & 0xffff);
    const bf16_t* y = (const bf16_t*)(p->ws + WS_Y) + (size_t)slot * 1024;
#pragma unroll
    for (int j = 0; j < 4; ++j) yv[j] = *(const u32x2*)(y + 4 * lane + 256 * j);
}
__device__ __forceinline__ void moe_yadd(CP p, int lm, int v, int lane, const u32x2 (&yv)[4], f32x4 (&xv)[4]) {
    const float* gate = (const float*)(p->ws + WS_MOD) + ((size_t)lm * 3 + v) * 6144 + 5 * 1024;
#pragma unroll
    for (int j = 0; j < 4; ++j) { const int k = 4 * lane + 256 * j; const f32x4 g4 = *(const f32x4*)(gate + k);
        xv[j][0] += g4[0] * bflo(yv[j].x); xv[j][1] += g4[1] * bfhi(yv[j].x); xv[j][2] += g4[2] * bflo(yv[j].y); xv[j][3] += g4[3] * bfhi(yv[j].y); }
}
typedef _Float16 f16x8 __attribute__((ext_vector_type(8)));
typedef _Float16 f16x2 __attribute__((ext_vector_type(2)));
constexpr int ST_H16 = 2064;
__device__ __forceinline__ unsigned pack_f16(float a, float b) { f16x2 h; h[0] = (_Float16)a; h[1] = (_Float16)b; return __builtin_bit_cast(unsigned, h); }
__device__ __forceinline__ void phase_r1(CP p, int l, unsigned char* lds_, int bid, int nb) {
    LAS unsigned char* lds = (LAS unsigned char*)lds_;
    LAS unsigned char* Wh = lds;
    LAS unsigned char* Xh = Wh + 16 * ST_H16;
    LAS float* gm = (LAS float*)(Xh + 16 * ST_H16);
    LAS float* sh = gm + 3 * 1024;
    LAS float* part = sh + 3 * 1024;
    const int tid = launder_tid(); const int lane = tid & 63, wave = __builtin_amdgcn_readfirstlane(tid >> 6);
    const float* mod = (const float*)(p->ws + WS_MOD) + (size_t)l * 3 * 6144;
    const float* win = p->w_in + (size_t)l * 1024 * DIN;
#pragma unroll
    for (int hb = 0; hb < 2; ++hb) { float tmp[16];
#pragma unroll
        for (int it = 0; it < 16; ++it) { const int idx = tid + NTHREADS * (16 * hb + it); tmp[it] = win[(size_t)(idx >> 4) * DIN + NPROJ + (idx & 15)]; }
#pragma unroll
        for (int it = 0; it < 16; ++it) { const int idx = tid + NTHREADS * (16 * hb + it); *(LAS _Float16*)(Wh + (idx & 15) * ST_H16 + (idx >> 4) * 2) = (_Float16)tmp[it]; } }
    { float t0[6], t1[6], t2[6];
#pragma unroll
      for (int it = 0; it < 6; ++it) { const int idx = tid + NTHREADS * it; const int v = idx >> 10, k = idx & 1023; t0[it] = p->g_mix[l * 1024 + k]; t1[it] = mod[v * 6144 + 1024 + k]; t2[it] = mod[v * 6144 + k]; }
#pragma unroll
      for (int it = 0; it < 6; ++it) { const int idx = tid + NTHREADS * it; gm[idx] = t0[it] * (1.f + t1[it]); sh[idx] = t2[it]; } }
    __syncthreads();
    bf16_t* HX = (bf16_t*)(p->ws + WS_HX); float* DT = (float*)(p->ws + WS_DT);
    const int rpb = (R + nb - 1) / nb, r0 = bid * rpb, r1 = (r0 + rpb) < R ? (r0 + rpb) : R;
    RowRaw xn[2];
#pragma unroll
    for (int q = 0; q < 2; ++q) if (r0 + 2 * wave + q < r1) row_load(p, l, r0 + 2 * wave + q, lane, xn[q]);
#pragma unroll 1
    for (int t0r = r0; t0r < r1; t0r += 16) {
        f32x4 xv[2][4];
#pragma unroll
        for (int q = 0; q < 2; ++q) row_cvt(l, xn[q], xv[q]);
#pragma unroll
        for (int q = 0; q < 2; ++q) if (t0r + 16 + 2 * wave + q < r1) row_load(p, l, t0r + 16 + 2 * wave + q, lane, xn[q]);
#pragma unroll
        for (int q = 0; q < 2; ++q) { const int rr = t0r + 2 * wave + q; const bool ok = rr < r1; const int v = row_v(ok ? rr : r0);
            if (l == 0 && ok) { u32x2* hw = (u32x2*)((bf16_t*)(p->ws + WS_H) + (size_t)rr * D);
#pragma unroll
                for (int j = 0; j < 4; ++j) { u32x2 o; o.x = cvt_pk_bf16(xv[q][j][0], xv[q][j][1]); o.y = cvt_pk_bf16(xv[q][j][2], xv[q][j][3]); hw[lane + 64 * j] = o; } }
            float ss = 0.f;
#pragma unroll
            for (int j = 0; j < 4; ++j) ss += xv[q][j][0] * xv[q][j][0] + xv[q][j][1] * xv[q][j][1] + xv[q][j][2] * xv[q][j][2] + xv[q][j][3] * xv[q][j][3];
            ss = wave_sum(ss); const float rs = ok ? rsqrtf(ss * (1.f / 1024.f) + 1e-6f) : 0.f;
#pragma unroll
            for (int j = 0; j < 4; ++j) { const int k = 4 * lane + 256 * j; const f32x4 g4 = *(const LAS f32x4*)(gm + v * 1024 + k), s4 = *(const LAS f32x4*)(sh + v * 1024 + k);
                f32x4 hv = xv[q][j] * rs * g4 + s4; if (!ok) hv = hv * 0.f;
                u32x2 o; o.x = cvt_pk_bf16(hv[0], hv[1]); o.y = cvt_pk_bf16(hv[2], hv[3]);
                if (ok) *(u32x2*)(HX + (size_t)rr * 1024 + k) = o;
                u32x2 h16; h16.x = pack_f16(hv[0], hv[1]); h16.y = pack_f16(hv[2], hv[3]);
                *(LAS u32x2*)(Xh + (2 * wave + q) * ST_H16 + k * 2) = h16; } }
        __syncthreads();
        {
            f32x4 acc0 = {0.f, 0.f, 0.f, 0.f};
#pragma unroll
            for (int s4 = 0; s4 < 4; ++s4) { const int kb = (128 * wave + 32 * s4 + 8 * (lane >> 4)) * 2;
                const f16x8 a = *(const LAS f16x8*)(Xh + (lane & 15) * ST_H16 + kb);
                const f16x8 b0 = *(const LAS f16x8*)(Wh + (lane & 15) * ST_H16 + kb);
                acc0 = __builtin_amdgcn_mfma_f32_16x16x32_f16(a, b0, acc0, 0, 0, 0); }
#pragma unroll
            for (int e = 0; e < 4; ++e) part[(wave * 16 + 4 * (lane >> 4) + e) * 16 + (lane & 15)] = acc0[e];
        }
        __syncthreads();
        if (tid < 256) { const int row = tid >> 4, n = tid & 15; const int rr = t0r + row;
            float sacc = p->dt_bias[l * 16 + n];
#pragma unroll
            for (int w = 0; w < 8; ++w) sacc += part[(w * 16 + row) * 16 + n];
            if (rr < r1) DT[(size_t)rr * 16 + n] = softplusf_(sacc); }
    }
    __syncthreads();
}
typedef float f32x16 __attribute__((ext_vector_type(16)));
typedef short s16x4 __attribute__((ext_vector_type(4)));
constexpr int ST_ROW = 272;
constexpr int ST_TR128 = 320;
constexpr int ST_TR64 = 192;
constexpr int NCHUNK = SEG / 128;

#define DPP_MOV(v, ctrl, rm, bm) __builtin_bit_cast(float, __builtin_amdgcn_update_dpp(0, __builtin_bit_cast(int, (v)), (ctrl), (rm), (bm), true))
__device__ __forceinline__ float wave_incl_scan(float v, int) {
    float s = v + DPP_MOV(v, 0x111, 0xF, 0xF) + DPP_MOV(v, 0x112, 0xF, 0xF) + DPP_MOV(v, 0x113, 0xF, 0xF);
    s += DPP_MOV(s, 0x114, 0xF, 0xE);
    s += DPP_MOV(s, 0x118, 0xF, 0xC);
    s += DPP_MOV(s, 0x142, 0xA, 0xF);
    s += DPP_MOV(s, 0x143, 0xC, 0xF);
    return s;
}
__device__ __forceinline__ bf16x8 row_frag(const LAS unsigned char* tile, int stride, int row0, int k0, int lane) {
    return *(const LAS bf16x8*)(tile + (row0 + (lane & 31)) * stride + (k0 + 8 * (lane >> 5)) * 2);
}
__device__ __forceinline__ bf16x8 tr_frag(const LAS unsigned char* tile, int stride, int k0, int c0, int lane) {
    const int g = lane >> 4, li = lane & 15, q = li >> 2, pp = li & 3;
    const LAS unsigned char* a0 = tile + (k0 + 8 * (g >> 1) + q) * stride + (c0 + 16 * (g & 1) + 4 * pp) * 2;
    const s16x4 lo = __builtin_amdgcn_ds_read_tr16_b64_v4i16((LAS s16x4*)a0);
    const s16x4 hi = __builtin_amdgcn_ds_read_tr16_b64_v4i16((LAS s16x4*)(a0 + 4 * stride));
    return __builtin_shufflevector(lo, hi, 0, 1, 2, 3, 4, 5, 6, 7);
}
__device__ __forceinline__ u32x4 pack8(const float (&v)[8]) { u32x4 r; r.x = cvt_pk_bf16(v[0], v[1]); r.y = cvt_pk_bf16(v[2], v[3]); r.z = cvt_pk_bf16(v[4], v[5]); r.w = cvt_pk_bf16(v[6], v[7]); return r; }
__device__ __forceinline__ u32x4 pack8s(const float (&v)[8], float sc) { u32x4 r; r.x = cvt_pk_bf16(v[0] * sc, v[1] * sc); r.y = cvt_pk_bf16(v[2] * sc, v[3] * sc); r.z = cvt_pk_bf16(v[4] * sc, v[5] * sc); r.w = cvt_pk_bf16(v[6] * sc, v[7] * sc); return r; }

__device__ __forceinline__ void conv_load(const bf16_t* proj, int row0, int rq, int xch, bool lo_ok, bool hi_ok, u32x4 (&raw)[8]) {
    const bf16_t* base = proj + (size_t)(row0 + 4 * rq) * NPROJ + 1536 + xch;
    unsigned zz; asm volatile("v_mov_b32 %0, 0" : "=v"(zz));
#pragma unroll
    for (int j = 0; j < 8; ++j) {
        if (j < 2) { const bool ok = (rq > 0) || lo_ok; const u32x4 v = *(const u32x4*)(ok ? base + (j - 2) * NPROJ : base);
            raw[j].x = ok ? v.x : zz; raw[j].y = ok ? v.y : zz; raw[j].z = ok ? v.z : zz; raw[j].w = ok ? v.w : zz; }
        else if (j >= 6) { const bool ok = (rq < 31) || hi_ok; const u32x4 v = *(const u32x4*)(ok ? base + (j - 2) * NPROJ : base);
            raw[j].x = ok ? v.x : zz; raw[j].y = ok ? v.y : zz; raw[j].z = ok ? v.z : zz; raw[j].w = ok ? v.w : zz; }
        else raw[j] = *(const u32x4*)(base + (j - 2) * NPROJ);
    }
}
__device__ __forceinline__ void conv_compute(const u32x4 (&raw)[8], const LAS float* wl, int nchl, int wch, float (&o)[4][8]) {
    float w[5][8], bs[8];
#pragma unroll
    for (int j = 0; j < 5; ++j) { const f32x4 w0 = *(const LAS f32x4*)(wl + j * nchl + wch), w1 = *(const LAS f32x4*)(wl + j * nchl + wch + 4);
        w[j][0] = w0[0]; w[j][1] = w0[1]; w[j][2] = w0[2]; w[j][3] = w0[3]; w[j][4] = w1[0]; w[j][5] = w1[1]; w[j][6] = w1[2]; w[j][7] = w1[3]; }
    { const f32x4 b0 = *(const LAS f32x4*)(wl + 5 * nchl + wch), b1 = *(const LAS f32x4*)(wl + 5 * nchl + wch + 4); bs[0] = b0[0]; bs[1] = b0[1]; bs[2] = b0[2]; bs[3] = b0[3]; bs[4] = b1[0]; bs[5] = b1[1]; bs[6] = b1[2]; bs[7] = b1[3]; }
#pragma unroll
    for (int i = 0; i < 4; ++i)
#pragma unroll
        for (int e = 0; e < 8; ++e) o[i][e] = bs[e];
#pragma unroll
    for (int j = 0; j < 8; ++j) {
        float xv[8] = {bflo(raw[j].x), bfhi(raw[j].x), bflo(raw[j].y), bfhi(raw[j].y), bflo(raw[j].z), bfhi(raw[j].z), bflo(raw[j].w), bfhi(raw[j].w)};
#pragma unroll
        for (int i = 0; i < 4; ++i) { const int tap = j - i; if (tap >= 0 && tap < 5) {
#pragma unroll
                for (int e = 0; e < 8; ++e) o[i][e] += w[tap][e] * xv[e]; } }
    }
#pragma unroll
    for (int i = 0; i < 4; ++i)
#pragma unroll
        for (int e = 0; e < 8; ++e) o[i][e] = siluf_(o[i][e]);
}
__device__ __forceinline__ void head_cums(CP p, int l, int row0, int h, int dir, int lane, LAS float* hv) {
    const float A = -expf(p->a_log[l * 16 + dir * 8 + h]);
    const float* DT = (const float*)(p->ws + WS_DT);
    const float d0 = DT[(size_t)(row0 + 2 * lane) * 16 + dir * 8 + h], d1 = DT[(size_t)(row0 + 2 * lane + 1) * 16 + dir * 8 + h];
    const float x0 = d0 * A, x1 = d1 * A;
    const float incl = wave_incl_scan(x0 + x1, lane);
    const float total = __builtin_bit_cast(float, __builtin_amdgcn_readlane(__builtin_bit_cast(int, incl), 63));
    float c0, c1;
    if (dir == 0) { c1 = incl; c0 = incl - x1; } else { c0 = total - (incl - x1 - x0); c1 = total - (incl - x1); }
    hv[dir * 128 + 2 * lane] = c0; hv[dir * 128 + 2 * lane + 1] = c1;
    hv[256 + dir * 128 + 2 * lane] = d0; hv[256 + dir * 128 + 2 * lane + 1] = d1;
    if (lane == 0) hv[512 + dir] = total;
}
__device__ __forceinline__ bf16x8 scale_frag(bf16x8 f, const f32x4 w0, const f32x4 w1) {
    const u32x4 u = __builtin_bit_cast(u32x4, f);
    u32x4 r;
    r.x = cvt_pk_bf16(bflo(u.x) * w0[0], bfhi(u.x) * w0[1]); r.y = cvt_pk_bf16(bflo(u.y) * w0[2], bfhi(u.y) * w0[3]);
    r.z = cvt_pk_bf16(bflo(u.z) * w1[0], bfhi(u.z) * w1[1]); r.w = cvt_pk_bf16(bflo(u.w) * w1[2], bfhi(u.w) * w1[3]);
    return __builtin_bit_cast(bf16x8, r);
}
constexpr int ST_X256 = 576;

__device__ __forceinline__ void phase_c1(CP p, int l, unsigned char* lds_, int bid, int nb) {
    LAS unsigned char* lds = (LAS unsigned char*)lds_;
    LAS unsigned char* tile = lds;
    LAS float* wl = (LAS float*)(lds + 73216);
    const int tid = launder_tid();
    const bf16_t* proj = (const bf16_t*)(p->ws + WS_PROJ); bf16_t* mix = (bf16_t*)(p->ws + WS_HX);
#pragma unroll 1
    for (int u = bid; u < 256 + 512 + (l == DEPTH - 1 ? 0 : 16); u += nb) {
        int S, LEN, pstride, sstride, tok0, ch0;
        if (u < 256) { const int b = u >> 7, cs = (u >> 2) & 31, cc = u & 3; S = 2; LEN = 256; pstride = 64; sstride = 1; tok0 = b * SEG + CTXL + 2 * cs; ch0 = 256 + 64 * cc; }
        else if (u < 768) { const int v = u - 256; const int b = v >> 8, rg = (v >> 2) & 63, cc = v & 3; S = 4; LEN = 64; pstride = 1; sstride = 64; tok0 = b * SEG + CTXL + 256 * rg; ch0 = 64 * cc; }
        else { const int v = u - 768; const int b = v >> 3, cc = v & 7; S = 1; LEN = 256; pstride = 1; sstride = 0; tok0 = b * SEG; ch0 = 64 * cc; }
        const int LP = LEN + 30;
        { float tw[4];
#pragma unroll
          for (int it = 0; it < 4; ++it) { const int i = tid + NTHREADS * it; const int j = i >> 6, c = i & 63; tw[it] = j < 31 ? p->conv_w[((size_t)l * 31 + j) * 512 + ch0 + c] : p->conv_b[l * 512 + ch0 + c]; }
#pragma unroll
          for (int it = 0; it < 4; ++it) wl[tid + NTHREADS * it] = tw[it]; }
        for (int i = tid; i < S * 30 * 8; i += NTHREADS) { const int pc = i & 7, q = (i >> 3) % 30, sq = (i >> 3) / 30; const int pos = q < 15 ? q : LEN + q;
            unsigned zz; asm volatile("v_mov_b32 %0, 0" : "=v"(zz));
            *(LAS u32x4*)(tile + ((sq * LP + pos) * 64 + pc * 8) * 2) = (u32x4){zz, zz, zz, zz}; }
#pragma unroll 4
        for (int i = tid; i < S * LEN * 8; i += NTHREADS) { const int pc = i & 7, t = i >> 3; const int sq = t / LEN, pos = t - sq * LEN;
            const bf16_t* src = proj + (size_t)(tok0 + sq * sstride + pos * pstride) * NPROJ + ch0 + pc * 8;
            const u32x4 uv = *(const u32x4*)src, gv = *(const u32x4*)(src + 512);
            u32x4 o;
            o.x = cvt_pk_bf16(bflo(uv.x) * sigmoidf_(bflo(gv.x)), bfhi(uv.x) * sigmoidf_(bfhi(gv.x)));
            o.y = cvt_pk_bf16(bflo(uv.y) * sigmoidf_(bflo(gv.y)), bfhi(uv.y) * sigmoidf_(bfhi(gv.y)));
            o.z = cvt_pk_bf16(bflo(uv.z) * sigmoidf_(bflo(gv.z)), bfhi(uv.z) * sigmoidf_(bfhi(gv.z)));
            o.w = cvt_pk_bf16(bflo(uv.w) * sigmoidf_(bflo(gv.w)), bfhi(uv.w) * sigmoidf_(bfhi(gv.w)));
            *(LAS u32x4*)(tile + ((sq * LP + 15 + pos) * 64 + pc * 8) * 2) = o; }
        __syncthreads();
        const int noct = S * LEN / 8;
#pragma unroll 1
        for (int it = tid; it < noct * 32; it += NTHREADS) {
            const int cp = it & 31, oc = it >> 5; const int sq = oc / (LEN / 8), p0 = (oc - sq * (LEN / 8)) * 8;
            const LAS unsigned* base = (const LAS unsigned*)(tile + ((sq * LP + p0) * 64) * 2) + cp;
            float i0[38], i1[38];
#pragma unroll
            for (int k = 0; k < 38; ++k) { const unsigned w = base[k * 32]; i0[k] = bflo(w); i1[k] = bfhi(w); }
            float a0[8], a1[8];
            { const float b0 = wl[31 * 64 + 2 * cp], b1 = wl[31 * 64 + 2 * cp + 1];
#pragma unroll
              for (int i = 0; i < 8; ++i) { a0[i] = b0; a1[i] = b1; } }
#pragma unroll
            for (int j = 0; j < 31; ++j) { typedef float f32x2 __attribute__((ext_vector_type(2))); const f32x2 wj = *(const LAS f32x2*)(wl + j * 64 + 2 * cp); const float w0 = wj[0], w1 = wj[1];
#pragma unroll
                for (int i = 0; i < 8; ++i) { a0[i] += w0 * i0[i + j]; a1[i] += w1 * i1[i + j]; } }
#pragma unroll
            for (int i = 0; i < 8; ++i) { const int tok = tok0 + sq * sstride + (p0 + i) * pstride;
                *(unsigned*)(mix + (size_t)tok * 1024 + 512 + ch0 + 2 * cp) = cvt_pk_bf16(a0[i], a1[i]); }
        }
        __syncthreads();
    }
}
__device__ __forceinline__ void phase_c1_ln(CP p, int l, int bid, int nb) {
    const int tid = launder_tid(); const int lane = tid & 63, wave = tid >> 6;
    bf16_t* mix = (bf16_t*)(p->ws + WS_HX);
    const f32x4 g0 = *(const f32x4*)(p->conv_ln_g + l * 512 + lane * 8), g1 = *(const f32x4*)(p->conv_ln_g + l * 512 + lane * 8 + 4);
    const f32x4 b0 = *(const f32x4*)(p->conv_ln_b + l * 512 + lane * 8), b1 = *(const f32x4*)(p->conv_ln_b + l * 512 + lane * 8 + 4);
    const float gg[8] = {g0[0], g0[1], g0[2], g0[3], g1[0], g1[1], g1[2], g1[3]}, bb[8] = {b0[0], b0[1], b0[2], b0[3], b1[0], b1[1], b1[2], b1[3]};
    for (int r = bid * 8 + wave; r < R; r += nb * 8) {
        u32x4* ptr = (u32x4*)(mix + (size_t)r * 1024 + 512 + lane * 8);
        const u32x4 v = *ptr;
        float y[8] = {bflo(v.x), bfhi(v.x), bflo(v.y), bfhi(v.y), bflo(v.z), bfhi(v.z), bflo(v.w), bfhi(v.w)};
        float s = 0.f;
#pragma unroll
        for (int e = 0; e < 8; ++e) s += y[e];
        const float mu = wave_sum(s) * (1.f / 512.f);
        float q = 0.f;
#pragma unroll
        for (int e = 0; e < 8; ++e) { y[e] -= mu; q += y[e] * y[e]; }
        const float rstd = rsqrtf(wave_sum(q) * (1.f / 512.f) + 1e-5f);
        float o[8];
#pragma unroll
        for (int e = 0; e < 8; ++e) o[e] = siluf_(y[e] * rstd * gg[e] + bb[e]);
        *ptr = pack8(o);
    }
}
__device__ __forceinline__ void phase_s1(CP p, int l, unsigned char* lds_, int bid, int nb) {
    LAS unsigned char* lds = (LAS unsigned char*)lds_;
    LAS unsigned char* Bs = lds;
    LAS unsigned char* Xs = lds + 128 * ST_TR128;
    LAS float* wv = (LAS float*)(Xs + 128 * ST_X256);
    LAS float* hvs = wv + 8 * 128;
    LAS float* cwl = hvs + 4 * 520;
    const int tid = launder_tid(); const int lane = tid & 63, wave = __builtin_amdgcn_readfirstlane(tid >> 6);
    const bf16_t* proj = (const bf16_t*)(p->ws + WS_PROJ);
    const float* cw = p->ssd_conv_w + (size_t)l * 5 * 1024; const float* cbias = p->ssd_conv_b + (size_t)l * 1024;
    bf16_t* Sg = (bf16_t*)(p->ws + WS_S); float* DEC = (float*)(p->ws + WS_DEC);
    int cur_g = -1;
#pragma unroll 1
    for (int u = bid; u < NB * NCHUNK * 2; u += nb) {
        const int g = u & 1, c = (u >> 1) % NCHUNK, b = (u >> 1) / NCHUNK;
        const int row0 = b * SEG + c * 128;
        const bool lo_ok = !(c == 0 || c == 2), hi_ok = !(c == 1 || c == NCHUNK - 1);
        if (g != cur_g) { cur_g = g;
            float tw[5];
#pragma unroll
            for (int it = 0; it < 5; ++it) { const int i = tid + NTHREADS * it; const int j = i / 384, lc = i - j * 384; const int gch = lc < 128 ? 512 + g * 128 + lc : g * 256 + (lc - 128);
                tw[it] = i < 6 * 384 ? (j < 5 ? cw[j * 1024 + gch] : cbias[gch]) : 0.f; }
#pragma unroll
            for (int it = 0; it < 5; ++it) { const int i = tid + NTHREADS * it; if (i < 6 * 384) cwl[i] = tw[it]; } }
        const int hh = wave >> 1, dir = wave & 1, h = 4 * g + hh;
        u32x4 rb[8], rx0[8], rx1[8];
        conv_load(proj, row0, tid >> 4, 512 + g * 128 + (tid & 15) * 8, lo_ok, hi_ok, rb);
        conv_load(proj, row0, tid >> 5, g * 256 + (tid & 31) * 8, lo_ok, hi_ok, rx0);
        conv_load(proj, row0, (tid >> 5) + 16, g * 256 + (tid & 31) * 8, lo_ok, hi_ok, rx1);
        head_cums(p, l, row0, h, dir, lane, hvs + hh * 520);
        __syncthreads();
        {
            const LAS float* hv = hvs + hh * 520; const float tot = hv[512 + dir];
#pragma unroll
            for (int q = 0; q < 2; ++q) { const int lr = lane + 64 * q; wv[wave * 128 + lr] = __expf(tot - hv[dir * 128 + lr]) * hv[256 + dir * 128 + lr]; }
            if (lane == 0) DEC[((size_t)(b * 2 + dir) * NCHUNK + c) * 8 + h] = __expf(tot);
        }
        { float o[4][8];
          conv_compute(rb, cwl, 384, (tid & 15) * 8, o);
#pragma unroll
          for (int i = 0; i < 4; ++i) *(LAS u32x4*)(Bs + (4 * (tid >> 4) + i) * ST_TR128 + (tid & 15) * 16) = pack8(o[i]);
          conv_compute(rx0, cwl, 384, 128 + (tid & 31) * 8, o);
#pragma unroll
          for (int i = 0; i < 4; ++i) *(LAS u32x4*)(Xs + (4 * (tid >> 5) + i) * ST_X256 + (tid & 31) * 16) = pack8(o[i]);
          conv_compute(rx1, cwl, 384, 128 + (tid & 31) * 8, o);
#pragma unroll
          for (int i = 0; i < 4; ++i) *(LAS u32x4*)(Xs + (4 * ((tid >> 5) + 16) + i) * ST_X256 + (tid & 31) * 16) = pack8(o[i]); }
        __syncthreads();
        {
            f32x16 acc[2][4];
#pragma unroll
            for (int t = 0; t < 2; ++t)
#pragma unroll
                for (int q = 0; q < 4; ++q)
#pragma unroll
                    for (int e = 0; e < 16; ++e) acc[t][q][e] = 0.f;
#pragma unroll 2
            for (int kk = 0; kk < 8; ++kk) {
                const LAS float* wp = wv + wave * 128 + 16 * kk + 8 * (lane >> 5);
                const f32x4 w0 = *(const LAS f32x4*)wp, w1 = *(const LAS f32x4*)(wp + 4);
                bf16x8 af[2];
#pragma unroll
                for (int t = 0; t < 2; ++t) af[t] = scale_frag(tr_frag(Xs, ST_X256, 16 * kk, hh * 64 + 32 * t, lane), w0, w1);
#pragma unroll
                for (int q = 0; q < 4; ++q) { const bf16x8 bf = tr_frag(Bs, ST_TR128, 16 * kk, 32 * q, lane);
#pragma unroll
                    for (int t = 0; t < 2; ++t) acc[t][q] = __builtin_amdgcn_mfma_f32_32x32x16_bf16(bf, af[t], acc[t][q], 0, 0, 0); }
            }
            bf16_t* So = Sg + ((size_t)((b * 2 + dir) * NCHUNK + c) * 8 + h) * 8192 + (size_t)(lane & 31) * 128 + 4 * (lane >> 5);
#pragma unroll
            for (int t = 0; t < 2; ++t)
#pragma unroll
                for (int q = 0; q < 4; ++q)
#pragma unroll
                    for (int rg = 0; rg < 4; ++rg) { u32x2 pk; pk.x = cvt_pk_bf16(acc[t][q][4 * rg], acc[t][q][4 * rg + 1]); pk.y = cvt_pk_bf16(acc[t][q][4 * rg + 2], acc[t][q][4 * rg + 3]);
                        *(u32x2*)(So + (size_t)(32 * t) * 128 + 32 * q + 8 * rg) = pk; }
        }
        __syncthreads();
    }
}
__device__ __forceinline__ void phase_s2(CP p, int bid, int nb) {
    const int tid = launder_tid();
    const bf16_t* Sg = (const bf16_t*)(p->ws + WS_S); const float* DEC = (const float*)(p->ws + WS_DEC); bf16_t* HP = (bf16_t*)(p->ws + WS_HP);
    for (int idx = bid * NTHREADS + tid; idx < 2 * 2 * 8 * 64 * 64; idx += nb * NTHREADS) {
        const int n2 = idx & 63, pr = (idx >> 6) & 63, h = (idx >> 12) & 7, dir = (idx >> 15) & 1, b = idx >> 16;
        const size_t inner = (size_t)h * 8192 + pr * 128 + 2 * n2;
        const size_t cbase = (size_t)(b * 2 + dir) * NCHUNK;
        float s0 = 0.f, s1 = 0.f;
#pragma unroll 10
        for (int step = 0; step < NCHUNK; ++step) {
            const int c = dir == 0 ? step : (step < 2 ? 1 - step : NCHUNK + 1 - step);
            const size_t off = (cbase + c) * 65536 + inner;
            const unsigned sv = *(const unsigned*)(Sg + off); const float d = DEC[(cbase + c) * 8 + h];
            *(unsigned*)(HP + off) = cvt_pk_bf16(s0, s1);
            s0 = s0 * d + bflo(sv); s1 = s1 * d + bfhi(sv);
        }
    }
}
__device__ __forceinline__ void phase_s3(CP p, int l, unsigned char* lds_, int bid, int nb) {
    LAS unsigned char* lds = (LAS unsigned char*)lds_;
    LAS unsigned char* Cs = lds;
    LAS unsigned char* Bs = Cs + 128 * ST_ROW;
    LAS unsigned char* Mt = Bs;
    LAS unsigned char* Xs = Bs + 128 * ST_TR128;
    LAS unsigned char* Hf = Xs + 128 * ST_TR64;
    LAS unsigned char* Hb = Hf + 64 * ST_ROW;
    LAS float* hvs = (LAS float*)(Hb + 64 * ST_ROW);
    LAS float* ssqp = hvs + 4 * 520;
    LAS float* cwl = ssqp + 256;
    const int tid0 = launder_tid(); const int wave = __builtin_amdgcn_readfirstlane(tid0 >> 6);
    const bf16_t* proj = (const bf16_t*)(p->ws + WS_PROJ); bf16_t* mix = (bf16_t*)(p->ws + WS_HX);
    const float* cw = p->ssd_conv_w + (size_t)l * 5 * 1024; const float* cbias = p->ssd_conv_b + (size_t)l * 1024;
    const bf16_t* HP = (const bf16_t*)(p->ws + WS_HP); float* SSQ = (float*)(p->ws + WS_SSQ);
    int cur_g = -1;
    const int cskip = (l == DEPTH - 1) ? 2 : 0, cpb = NCHUNK - cskip;
    const int nunits = NB * cpb * 2, nfull = nunits - nunits % nb, nitems = nfull + (nunits - nfull) * 4;
#pragma unroll 1
    for (int it = bid; it < nitems; it += nb) {
        const int u = it < nfull ? it : nfull + ((it - nfull) >> 2);
        const int hh_lo = it < nfull ? 0 : ((it - nfull) & 3), hh_hi = it < nfull ? 4 : hh_lo + 1;
        const int g = u & 1, c = cskip + (u >> 1) % cpb, b = (u >> 1) / cpb;
        int tid = tid0; asm volatile("" : "+v"(tid));
        const int lane = tid & 63;
        const int row0 = b * SEG + c * 128;
        const bool lo_ok = !(c == 0 || c == 2), hi_ok = !(c == 1 || c == NCHUNK - 1);
        if (g != cur_g) { cur_g = g;
            float tw[6];
#pragma unroll
            for (int it = 0; it < 6; ++it) { const int i = tid + NTHREADS * it; const int j = i >> 9, lc = i & 511; const int gch = lc < 128 ? 768 + g * 128 + lc : (lc < 256 ? 512 + g * 128 + (lc - 128) : g * 256 + (lc - 256));
                tw[it] = j < 5 ? cw[j * 1024 + gch] : cbias[gch]; }
#pragma unroll
            for (int it = 0; it < 6; ++it) cwl[tid + NTHREADS * it] = tw[it]; }
        u32x4 rx[8];
        {
            u32x4 r0[8], r1[8];
            const int cg = tid & 31; const int gch = (cg < 16 ? 768 : 512) + g * 128 + (cg & 15) * 8;
            conv_load(proj, row0, tid >> 5, gch, lo_ok, hi_ok, r0);
            conv_load(proj, row0, (tid >> 5) + 16, gch, lo_ok, hi_ok, r1);
            head_cums(p, l, row0, 4 * g + (wave >> 1), wave & 1, lane, hvs + (wave >> 1) * 520);
            __syncthreads();
            float o[4][8];
            LAS unsigned char* dst = (cg < 16 ? Cs : Bs) + (cg & 15) * 16;
            conv_compute(r0, cwl, 512, cg * 8, o);
#pragma unroll
            for (int i = 0; i < 4; ++i) *(LAS u32x4*)(dst + (4 * (tid >> 5) + i) * ST_ROW) = pack8(o[i]);
            asm volatile("" ::: "memory");
            if (tid < 256) conv_load(proj, row0, tid >> 3, g * 256 + hh_lo * 64 + (tid & 7) * 8, lo_ok, hi_ok, rx);
            conv_compute(r1, cwl, 512, cg * 8, o);
#pragma unroll
            for (int i = 0; i < 4; ++i) *(LAS u32x4*)(dst + (4 * ((tid >> 5) + 16) + i) * ST_ROW) = pack8(o[i]);
            if (tid < 256) { conv_compute(rx, cwl, 512, 256 + hh_lo * 64 + (tid & 7) * 8, o);
#pragma unroll
                for (int i = 0; i < 4; ++i) *(LAS u32x4*)(Xs + (4 * (tid >> 3) + i) * ST_TR64 + (tid & 7) * 16) = pack8(o[i]); }
        }
        __syncthreads();
        const int lb = wave >> 1, hs = wave & 1;
        int ln = lane; asm volatile("" : "+v"(ln));
        f32x16 gacc[2];
#pragma unroll
        for (int t = 0; t < 2; ++t)
#pragma unroll
            for (int e = 0; e < 16; ++e) gacc[t][e] = 0.f;
#pragma unroll
        for (int kk = 0; kk < 8; ++kk) { const bf16x8 af = row_frag(Cs, ST_ROW, 32 * lb, 16 * kk, lane);
#pragma unroll
            for (int t = 0; t < 2; ++t) { const bf16x8 bf = row_frag(Bs, ST_ROW, 64 * hs + 32 * t, 16 * kk, lane);
                gacc[t] = __builtin_amdgcn_mfma_f32_32x32x16_bf16(af, bf, gacc[t], 0, 0, 0); } }
        u32x4 hreg[4];
        { const bf16_t* hp0 = HP + ((size_t)(b * 2 * NCHUNK + c) * 8 + 4 * g + hh_lo) * 8192;
#pragma unroll
          for (int q = 0; q < 4; ++q) { const int it = tid + 512 * q; hreg[q] = *(const u32x4*)(hp0 + (size_t)(it >> 10) * NCHUNK * 8 * 8192 + (it & 1023) * 8); } }
        __syncthreads();
#pragma unroll 1
        for (int hh = hh_lo; hh < hh_hi; ++hh) {
            const int h = 4 * g + hh; const LAS float* hv = hvs + hh * 520;
            asm volatile("" : "+v"(ln));
            const int ph = hs, pc = 32 * ph + (ln & 31);
#pragma unroll
            for (int t = 0; t < 2; ++t) {
                const int sc = 64 * hs + 32 * t + (ln & 31);
                const float cfs = hv[sc], cbs = hv[128 + sc], dfs = hv[256 + sc], dbs = hv[384 + sc];
#pragma unroll
                for (int rg = 0; rg < 4; ++rg) {
                    const int l0 = 32 * lb + 8 * rg + 4 * (ln >> 5);
                    const f32x4 cfl = *(const LAS f32x4*)(hv + l0), cbl = *(const LAS f32x4*)(hv + 128 + l0);
                    float m[4];
#pragma unroll
                    for (int e = 0; e < 4; ++e) { const int lr = l0 + e;
                        const float ff = lr >= sc ? __expf(cfl[e] - cfs) * dfs : 0.f;
                        const float fb = lr <= sc ? __expf(cbl[e] - cbs) * dbs : 0.f;
                        m[e] = gacc[t][4 * rg + e] * (ff + fb); }
                    u32x2 pk; pk.x = cvt_pk_bf16(m[0], m[1]); pk.y = cvt_pk_bf16(m[2], m[3]);
                    *(LAS u32x2*)(Mt + sc * ST_TR128 + l0 * 2) = pk;
                }
            }
#pragma unroll
            for (int q = 0; q < 4; ++q) { const int it = tid + 512 * q; const int q2 = it & 1023;
                *(LAS u32x4*)(((it >> 10) ? Hb : Hf) + (q2 >> 4) * ST_ROW + (q2 & 15) * 16) = hreg[q]; }
            if (hh + 1 < hh_hi) {
                const bf16_t* hp0 = HP + ((size_t)(b * 2 * NCHUNK + c) * 8 + h + 1) * 8192;
#pragma unroll
                for (int q = 0; q < 4; ++q) { const int it = tid + 512 * q; hreg[q] = *(const u32x4*)(hp0 + (size_t)(it >> 10) * NCHUNK * 8 * 8192 + (it & 1023) * 8); }
                if (tid < 256) conv_load(proj, row0, tid >> 3, g * 256 + (hh + 1) * 64 + (tid & 7) * 8, lo_ok, hi_ok, rx);
            }
            unsigned zraw[8];
#pragma unroll
            for (int ri = 0; ri < 16; ri += 2) { const int lr = 32 * lb + 8 * (ri >> 2) + 4 * (ln >> 5) + (ri & 3);
                const bf16_t* zp = proj + (size_t)(row0 + lr) * NPROJ + 1024 + h * 64 + pc;
                zraw[ri >> 1] = (unsigned)zp[0] | ((unsigned)zp[NPROJ] << 16); }
            __syncthreads();
            f32x16 ad, af_, ab_;
#pragma unroll
            for (int e = 0; e < 16; ++e) { ad[e] = 0.f; af_[e] = 0.f; ab_[e] = 0.f; }
#pragma unroll
            for (int kk = 0; kk < 8; ++kk) {
                const bf16x8 am = tr_frag(Mt, ST_TR128, 16 * kk, 32 * lb, lane);
                const bf16x8 bx = tr_frag(Xs, ST_TR64, 16 * kk, 32 * ph, lane);
                ad = __builtin_amdgcn_mfma_f32_32x32x16_bf16(am, bx, ad, 0, 0, 0);
                const bf16x8 ac = row_frag(Cs, ST_ROW, 32 * lb, 16 * kk, lane);
                const bf16x8 bhf = row_frag(Hf, ST_ROW, 32 * ph, 16 * kk, lane);
                const bf16x8 bhb = row_frag(Hb, ST_ROW, 32 * ph, 16 * kk, lane);
                af_ = __builtin_amdgcn_mfma_f32_32x32x16_bf16(ac, bhf, af_, 0, 0, 0);
                ab_ = __builtin_amdgcn_mfma_f32_32x32x16_bf16(ac, bhb, ab_, 0, 0, 0);
            }
            const float dsk = p->d_skip[l * 8 + h];
#pragma unroll
            for (int rg = 0; rg < 4; ++rg) {
                const int l0 = 32 * lb + 8 * rg + 4 * (ln >> 5);
                const f32x4 cfl = *(const LAS f32x4*)(hv + l0), cbl = *(const LAS f32x4*)(hv + 128 + l0);
#pragma unroll
                for (int e = 0; e < 4; ++e) { const int lr = l0 + e; const int ri = 4 * rg + e;
                    const float xs = bf2f(*(const LAS bf16_t*)(Xs + lr * ST_TR64 + pc * 2));
                    const float y = ad[ri] + __expf(cfl[e]) * af_[ri] + __expf(cbl[e]) * ab_[ri] + dsk * xs;
                    const float z = (ri & 1) ? bfhi(zraw[ri >> 1]) : bflo(zraw[ri >> 1]);
                    const float val = y * siluf_(z);
                    mix[(size_t)(row0 + lr) * 1024 + h * 64 + pc] = f2bf(val);
                    const float sq = half_sum32(val * val);
                    if ((ln & 31) == 31) ssqp[ph * 128 + lr] = sq;
                }
            }
            __syncthreads();
            if (tid < 128) SSQ[(size_t)(row0 + tid) * 8 + h] = ssqp[tid] + ssqp[128 + tid];
            if (hh + 1 < hh_hi && tid < 256) { float o[4][8];
                conv_compute(rx, cwl, 512, 256 + (hh + 1) * 64 + (tid & 7) * 8, o);
#pragma unroll
                for (int i = 0; i < 4; ++i) *(LAS u32x4*)(Xs + (4 * (tid >> 3) + i) * ST_TR64 + (tid & 7) * 16) = pack8(o[i]); }
        }
        __syncthreads();
    }
}
__device__ __forceinline__ void phase_r2(CP p, int l, unsigned char* lds_, int bid, int nb) {
    LAS unsigned char* lds = (LAS unsigned char*)lds_;
    LAS unsigned char* Wh = lds;
    LAS unsigned char* Xh = Wh + 32 * ST_H16;
    LAS float* gm = (LAS float*)(Xh + 16 * ST_H16);
    LAS float* sh = gm + 3 * 1024;
    LAS float* part = sh + 3 * 1024;
    LAS float* lgs = part + 8 * 16 * 32;
    LAS int* lcnt = (LAS int*)(lgs + 16 * 32);
    LAS int* lcls = lcnt + 64;
    LAS int* lrank = lcls + 512;
    LAS float* lcwa = (LAS float*)(lrank + 512);
    LAS float* lcwb = lcwa + 512;
    const int tid = launder_tid(); const int lane = tid & 63, wave = __builtin_amdgcn_readfirstlane(tid >> 6);
    const float* mod = (const float*)(p->ws + WS_MOD) + (size_t)l * 3 * 6144;
    {
        float tmp[8];
#pragma unroll
        for (int it = 0; it < 8; ++it) tmp[it] = p->w_rg[(size_t)l * 4096 + tid + NTHREADS * it];
#pragma unroll
        for (int it = 0; it < 8; ++it) { const int idx = tid + NTHREADS * it; *(LAS _Float16*)(Wh + (idx & 3) * ST_H16 + (idx >> 2) * 2) = (_Float16)tmp[it]; } }
#pragma unroll
    for (int hb = 0; hb < 2; ++hb) { float tmp[16];
#pragma unroll
        for (int it = 0; it < 16; ++it) tmp[it] = p->w_re[(size_t)l * 16384 + tid + NTHREADS * (16 * hb + it)];
#pragma unroll
        for (int it = 0; it < 16; ++it) { const int idx = tid + NTHREADS * (16 * hb + it); *(LAS _Float16*)(Wh + (4 + (idx & 15)) * ST_H16 + (idx >> 4) * 2) = (_Float16)tmp[it]; } }
    { unsigned zz; asm volatile("v_mov_b32 %0, 0" : "=v"(zz));
      for (int i = tid; i < 12 * 128; i += NTHREADS) { const int rw = 20 + i / 128, c16 = i % 128; *(LAS u32x4*)(Wh + rw * ST_H16 + c16 * 16) = (u32x4){zz, zz, zz, zz}; } }
    { float t0[6], t1[6], t2[6];
#pragma unroll
      for (int it = 0; it < 6; ++it) { const int idx = tid + NTHREADS * it; const int v = idx >> 10, k = idx & 1023; t0[it] = p->g_ffn[l * 1024 + k]; t1[it] = mod[v * 6144 + 4 * 1024 + k]; t2[it] = mod[v * 6144 + 3 * 1024 + k]; }
#pragma unroll
      for (int it = 0; it < 6; ++it) { const int idx = tid + NTHREADS * it; gm[idx] = t0[it] * (1.f + t1[it]); sh[idx] = t2[it]; } }
    if (tid < 64) lcnt[tid] = 0;
    __syncthreads();
    bf16_t* HM = (bf16_t*)(p->ws + WS_HX); float* CWLA = (float*)(p->ws + WS_CWLA); float* CWLB = (float*)(p->ws + WS_CWLB);
    int* gcount = (int*)(p->ws + WS_CTL) + l * 32; int* LIST = (int*)(p->ws + WS_LIST);
    const int rpb = (R + nb - 1) / nb, r0 = bid * rpb, r1 = (r0 + rpb) < R ? (r0 + rpb) : R;
    RowRaw xn[2];
#pragma unroll
    for (int q = 0; q < 2; ++q) if (r0 + 2 * wave + q < r1) row_load(p, 1, r0 + 2 * wave + q, lane, xn[q]);
#pragma unroll 1
    for (int t0r = r0; t0r < r1; t0r += 16) {
        f32x4 xv[2][4];
#pragma unroll
        for (int q = 0; q < 2; ++q) row_cvt(1, xn[q], xv[q]);
#pragma unroll
        for (int q = 0; q < 2; ++q) if (t0r + 16 + 2 * wave + q < r1) row_load(p, 1, t0r + 16 + 2 * wave + q, lane, xn[q]);
#pragma unroll
        for (int q = 0; q < 2; ++q) { const int rr = t0r + 2 * wave + q; const bool ok = rr < r1; const int v = row_v(ok ? rr : r0);
            float ss = 0.f;
#pragma unroll
            for (int j = 0; j < 4; ++j) ss += xv[q][j][0] * xv[q][j][0] + xv[q][j][1] * xv[q][j][1] + xv[q][j][2] * xv[q][j][2] + xv[q][j][3] * xv[q][j][3];
            ss = wave_sum(ss); const float rs = ok ? rsqrtf(ss * (1.f / 1024.f) + 1e-6f) : 0.f;
#pragma unroll
            for (int j = 0; j < 4; ++j) { const int k = 4 * lane + 256 * j; const f32x4 g4 = *(const LAS f32x4*)(gm + v * 1024 + k), s4 = *(const LAS f32x4*)(sh + v * 1024 + k);
                f32x4 hv = xv[q][j] * rs * g4 + s4; if (!ok) hv = hv * 0.f;
                u32x2 o; o.x = cvt_pk_bf16(hv[0], hv[1]); o.y = cvt_pk_bf16(hv[2], hv[3]);
                if (ok) *(u32x2*)(HM + (size_t)rr * 1024 + k) = o;
                u32x2 h16; h16.x = pack_f16(hv[0], hv[1]); h16.y = pack_f16(hv[2], hv[3]);
                *(LAS u32x2*)(Xh + (2 * wave + q) * ST_H16 + k * 2) = h16; } }
        __syncthreads();
        {
            f32x4 acc0 = {0.f, 0.f, 0.f, 0.f}, acc1 = {0.f, 0.f, 0.f, 0.f};
#pragma unroll
            for (int s4 = 0; s4 < 4; ++s4) { const int kb = (128 * wave + 32 * s4 + 8 * (lane >> 4)) * 2;
                const f16x8 a = *(const LAS f16x8*)(Xh + (lane & 15) * ST_H16 + kb);
                const f16x8 b0 = *(const LAS f16x8*)(Wh + (lane & 15) * ST_H16 + kb), b1 = *(const LAS f16x8*)(Wh + (16 + (lane & 15)) * ST_H16 + kb);
                acc0 = __builtin_amdgcn_mfma_f32_16x16x32_f16(a, b0, acc0, 0, 0, 0);
                acc1 = __builtin_amdgcn_mfma_f32_16x16x32_f16(a, b1, acc1, 0, 0, 0); }
#pragma unroll
            for (int e = 0; e < 4; ++e) { const int row = 4 * (lane >> 4) + e; part[(wave * 16 + row) * 32 + (lane & 15)] = acc0[e]; part[(wave * 16 + row) * 32 + 16 + (lane & 15)] = acc1[e]; }
        }
        __syncthreads();
        if (tid < 320) { const int row = tid / 20, n = tid - row * 20; float sacc = n < 4 ? p->b_rg[l * 4 + n] : p->b_re[l * 16 + n - 4];
#pragma unroll
            for (int w = 0; w < 8; ++w) sacc += part[(w * 16 + row) * 32 + n];
            lgs[row * 32 + n] = sacc; }
        __syncthreads();
        if (tid < 16) { const int rr = t0r + tid;
            if (rr < r1) {
                if (l == DEPTH - 1 && row_v(rr) == 2) lcls[rr - r0] = -1;
                else {
                    float lg[20];
#pragma unroll
                    for (int n = 0; n < 20; ++n) lg[n] = lgs[tid * 32 + n];
                    int gsel = 0; float gmax = lg[0];
#pragma unroll
                    for (int t = 1; t < 4; ++t) if (lg[t] > gmax) { gmax = lg[t]; gsel = t; }
                    float gden = 0.f;
#pragma unroll
                    for (int t = 0; t < 4; ++t) gden += __expf(lg[t] - gmax);
                    const float gprob = 1.f / gden;
                    float el[4];
#pragma unroll
                    for (int t = 0; t < 4; ++t) el[t] = gsel == 0 ? lg[4 + t] : (gsel == 1 ? lg[8 + t] : (gsel == 2 ? lg[12 + t] : lg[16 + t]));
                    int i0 = 0; float m0 = el[0];
#pragma unroll
                    for (int t = 1; t < 4; ++t) if (el[t] > m0) { m0 = el[t]; i0 = t; }
                    int i1 = -1; float m1 = -3.0e38f;
#pragma unroll
                    for (int t = 0; t < 4; ++t) if (t != i0 && el[t] > m1) { m1 = el[t]; i1 = t; }
                    const float w0 = gprob / (1.f + __expf(m1 - m0)), w1 = gprob - w0;
                    const int ea = i0 < i1 ? i0 : i1, eb = i0 < i1 ? i1 : i0;
                    const float cwa = i0 < i1 ? w0 : w1, cwb = i0 < i1 ? w1 : w0;
                    const int pidx = ea == 0 ? eb - 1 : (ea == 1 ? eb + 1 : 5);
                    const int cls = gsel * 6 + pidx;
                    const int rank = __hip_atomic_fetch_add(&lcnt[cls], 1, __ATOMIC_RELAXED, __HIP_MEMORY_SCOPE_WORKGROUP);
                    lcls[rr - r0] = cls; lrank[rr - r0] = rank; lcwa[rr - r0] = cwa; lcwb[rr - r0] = cwb;
                } } }
    }
    __syncthreads();
    if (tid < NCLS) lcnt[32 + tid] = atomicAdd(&gcount[tid], lcnt[tid]);
    __syncthreads();
    for (int idx = tid; idx < r1 - r0; idx += NTHREADS) { const int cl = lcls[idx]; if (cl < 0) continue; const int pos = lcnt[32 + cl] + lrank[idx]; const size_t li = (size_t)cl * R + pos;
        LIST[li] = r0 + idx; CWLA[li] = lcwa[idx]; CWLB[li] = lcwb[idx]; }
    __syncthreads();
}
__device__ __forceinline__ void phase_final(CP p, unsigned char* lds, int bid, int nb) {
    const int tid = launder_tid(); const int lane = tid & 63, wave = tid >> 6;
    const int qstep = nb * 8;
    RowRaw xn;
    { const int q = bid * 8 + wave; if (q < NB * SEQ) { const int b = q >= SEQ ? 1 : 0; row_load(p, 1, b * SEG + CTXL + (q - b * SEQ), lane, xn); } }
    for (int q = bid * 8 + wave; q < NB * SEQ; q += qstep) {
        f32x4* hr = (f32x4*)(p->out + (size_t)q * D);
        f32x4 xv[4]; float ss = 0.f;
        row_cvt(1, xn, xv);
        { const int qn = q + qstep; if (qn < NB * SEQ) { const int bn = qn >= SEQ ? 1 : 0; row_load(p, 1, bn * SEG + CTXL + (qn - bn * SEQ), lane, xn); } }
#pragma unroll
        for (int j = 0; j < 4; ++j) ss += xv[j][0] * xv[j][0] + xv[j][1] * xv[j][1] + xv[j][2] * xv[j][2] + xv[j][3] * xv[j][3];
        ss = wave_sum(ss); const float rs = rsqrtf(ss * (1.f / 1024.f) + 1e-6f);
#pragma unroll
        for (int j = 0; j < 4; ++j) { const f32x4 g4 = *(const f32x4*)(p->g_final + 4 * lane + 256 * j); hr[lane + 64 * j] = xv[j] * rs * g4; }
    }
}


#define XB_TMO      128
#define XB_XCNT(j)  (256  + 64 * (j))
#define XB_XSUB(j)  (1280 + 64 * (j))
#define XB_XGEN(j)  (2304 + 64 * (j))
#define XB_TOP      3328
#define XB_TOPGEN   3392
#define XCD_BAR_WORDS 3456
#define XB_SPIN_CAP (1u << 22)
__device__ __forceinline__ unsigned xb_ld(unsigned* p) { return __hip_atomic_load(p, __ATOMIC_RELAXED, __HIP_MEMORY_SCOPE_AGENT); }
__device__ __forceinline__ unsigned xb_add(unsigned* p, unsigned v) { return __hip_atomic_fetch_add(p, v, __ATOMIC_RELAXED, __HIP_MEMORY_SCOPE_AGENT); }
__device__ __forceinline__ unsigned xb_xcc_id() { return (unsigned)__builtin_amdgcn_s_getreg((3 << 11) | 20) & 0xFu; }
#define XB_SPIN(cond, bar) do { unsigned _sp = 0; while (cond) { __builtin_amdgcn_s_sleep(1); \
    if ((++_sp & 255u) == 0u) { if (xb_ld(&(bar)[XB_TMO])) break; if (_sp > XB_SPIN_CAP) { atomicAdd(&(bar)[XB_TMO], 1u); break; } } } } while (0)
struct XcdBarrier { unsigned* bar; unsigned x; volatile LAS unsigned* st; };
__device__ __forceinline__ XcdBarrier xcd_barrier_post(unsigned* bar, volatile LAS unsigned* st) {
    XcdBarrier b; b.bar = bar; b.x = xb_xcc_id(); b.st = st;
    if (threadIdx.x == 0) (void)xb_add(&bar[XB_XCNT(b.x)], 1u);
    return b;
}
__device__ __forceinline__ void xcd_barrier_complete(unsigned* bar, unsigned x, unsigned& nloc, unsigned& nx) {
    const unsigned G = gridDim.x * gridDim.y * gridDim.z;
    unsigned sum, cnt, mine, sp = 0u;
    for (;;) {
        sum = 0u; cnt = 0u; mine = 0u;
#pragma unroll
        for (unsigned j = 0; j < 16; ++j) { const unsigned c = xb_ld(&bar[XB_XCNT(j)]); sum += c; cnt += (c > 0u) ? 1u : 0u; mine = (j == x) ? c : mine; }
        if (sum == G) break;
        __builtin_amdgcn_s_sleep(1);
        if ((++sp & 255u) == 0u) { if (xb_ld(&bar[XB_TMO])) break; if (sp > XB_SPIN_CAP) { atomicAdd(&bar[XB_TMO], 1u); break; } }
    }
    nloc = mine > 0u ? mine : 1u; nx = cnt > 0u ? cnt : 1u;
}
__device__ __forceinline__ void xcd_barrier(const XcdBarrier& b) {
    asm volatile("s_waitcnt vmcnt(0)" ::: "memory");
    __syncthreads();
    if (threadIdx.x == 0) {
        unsigned* bar = b.bar;
        __builtin_amdgcn_s_waitcnt(0);
        unsigned nloc = b.st[0], nx = b.st[1];
        if (nloc == 0u) { xcd_barrier_complete(bar, b.x, nloc, nx); b.st[0] = nloc; b.st[1] = nx; }
        const unsigned old = xb_add(&bar[XB_XSUB(b.x)], 1u);
        const unsigned gen = old / nloc;
        if (old + 1u == (gen + 1u) * nloc) {
            __builtin_amdgcn_fence(__ATOMIC_RELEASE, "agent");
            asm volatile("s_waitcnt vmcnt(0)" ::: "memory");
            const unsigned og = xb_add(&bar[XB_TOP], 1u);
            const unsigned tg = og / nx;
            if (og + 1u == (tg + 1u) * nx) xb_add(&bar[XB_TOPGEN], 1u);
            else XB_SPIN(xb_ld(&bar[XB_TOPGEN]) == tg, bar);
            __builtin_amdgcn_fence(__ATOMIC_ACQUIRE, "agent");
            xb_add(&bar[XB_XGEN(b.x)], 1u);
            asm volatile("s_waitcnt vmcnt(0)" ::: "memory");
        } else {
            XB_SPIN(xb_ld(&bar[XB_XGEN(b.x)]) == gen, bar);
            __builtin_amdgcn_fence(__ATOMIC_ACQUIRE, "agent");
            asm volatile("s_waitcnt vmcnt(0)" ::: "memory");
        }
    }
    __syncthreads();
}

#ifndef TIMING_A
#define TIMING_A -1
#endif
#ifndef TIMING_B
#define TIMING_B -1
#endif
#ifndef PHASE_MASK
#define PHASE_MASK 0xFFFFF
#endif
#define PM(i) ((PHASE_MASK >> (i)) & 1)
#ifndef REPEAT_MASK
#define REPEAT_MASK 0
#endif
#define RP(i) for (int rep_ = 0; rep_ < 1 + ((REPEAT_MASK >> (i)) & 1); ++rep_)
constexpr int PH_PER_LAYER = 9, NPHASES = 1 + DEPTH * PH_PER_LAYER + 1;
__global__ void __launch_bounds__(NTHREADS, 2) mk_fwd(Args args) {
    extern __shared__ __attribute__((aligned(16))) unsigned char lds[];
    cg::grid_group grid = cg::this_grid();
    const __attribute__((address_space(4))) Args* ap = (const __attribute__((address_space(4))) Args*)__builtin_amdgcn_kernarg_segment_ptr();
    const int lo = ap->lo, hi = ap->hi;
    LAS unsigned char* ldsl = (LAS unsigned char*)lds;
    volatile LAS unsigned* xbst = (volatile LAS unsigned*)(ldsl + LDS_BYTES - 16);
    if (threadIdx.x < 4) xbst[threadIdx.x] = 0u;
    __syncthreads();
    (void)xcd_barrier_post((unsigned*)(ap->p.ws + WS_BAR), xbst);
    if (TIMING_A >= 0 && blockIdx.x == 0 && threadIdx.x == 0) ((unsigned long long*)(ap->p.ws + WS_TS))[lo] = __builtin_amdgcn_s_memrealtime();
    for (int ph = lo; ph < hi; ++ph) {
        CP p = launder(&ap->p);
        int bid = blockIdx.x, nb = gridDim.x; asm volatile("" : "+s"(bid), "+s"(nb));
        if (ph == 0) { if (PM(0)) RP(0) phase_wprep(p, lds, bid, nb); if (PM(1)) RP(1) phase_adaln(p, lds, bid, nb); }
        else if (ph == NPHASES - 1) { if (PM(12)) phase_final(p, lds, bid, nb); }
        else {
            const int l = (ph - 1) / PH_PER_LAYER, s = (ph - 1) % PH_PER_LAYER;
            if (s == 0) { if (PM(2)) RP(2) { if (rep_ == 0 || l == 0) phase_r1(p, l, lds, bid, nb); } }
            else if (s == 1) { if (PM(3)) RP(3) {
                pg8::DenseSched S; S.init(p->ws + WS_HX, (const bf16_t*)(p->ws + WS_WTIN) + (size_t)l * DIN * 1024, R, NPROJ, 1024, 1024, 1024, nb, bid);
                EpiProj E{(bf16_t*)(p->ws + WS_PROJ)};
                pg8::gemm_phase<EpiProj, pg8::DenseSched, false>(ldsl, 1024, 1024, 1024, S, E);
            } }
            else if (s == 2) { if (PM(4)) RP(4) phase_c1(p, l, lds, bid, nb); if (PM(5)) RP(5) phase_s1(p, l, lds, bid, nb); }
            else if (s == 3) { if (PM(6)) RP(6) phase_s2(p, bid, nb); if (PM(4)) phase_c1_ln(p, l, bid, nb); }
            else if (s == 4) { if (PM(7)) RP(7) phase_s3(p, l, lds, bid, nb); }
            else if (s == 5) { if (PM(8)) RP(8) { if (rep_ == 0 || l == 0) {
                pg8::DenseSched S; S.init(p->ws + WS_HX, (const bf16_t*)(p->ws + WS_WTOUT) + (size_t)l * 1024 * 1024, R, 1024, 1024, 1024, 1024, nb, bid, l == DEPTH - 1);
                EpiResid<0> E{p->ctx, p->x, (bf16_t*)(p->ws + WS_H), (const float*)(p->ws + WS_MOD) + (size_t)l * 3 * 6144, (const float*)(p->ws + WS_SSQ)};
                pg8::gemm_phase<EpiResid<0>, pg8::DenseSched, false>(ldsl, 1024, 1024, 1024, S, E);
            } } }
            else if (s == 6) { if (PM(9)) phase_r2(p, l, lds, bid, nb); }
            else if (s == 7) { if (PM(10)) RP(10) {
                LAS int* tab = (LAS int*)(ldsl + MISC_OFF); moe_table(p, l, tab);
                MoeSched S{tab, (const int*)(p->ws + WS_LIST), (const char*)(p->ws + WS_HX), (const char*)(p->ws + WS_WTGU), 0, l, nb, bid};
                EpiUp E{(bf16_t*)(p->ws + WS_HID), (const float*)(p->ws + WS_CWLA), (const float*)(p->ws + WS_CWLB)};
                pg8::gemm_phase<EpiUp, MoeSched, true>(ldsl, 1024, 1024, 1024, S, E);
            } }
            else { if (PM(11)) RP(11) {
                LAS int* tab = (LAS int*)(ldsl + MISC_OFF); moe_table(p, l, tab);
                MoeSched S{tab, (const int*)(p->ws + WS_LIST), (const char*)(p->ws + WS_HID), (const char*)(p->ws + WS_WTD), 1, l, nb, bid};
                EpiDown E{(bf16_t*)(p->ws + WS_H), (const int*)(p->ws + WS_LIST), (const float*)(p->ws + WS_MOD) + (size_t)l * 3 * 6144 + 5 * 1024};
                pg8::gemm_phase<EpiDown, MoeSched, false>(ldsl, 512, 256, 512, S, E);
            } }
        }
        if (ph + 1 < hi) { if (hi < 0) grid.sync();   else { XcdBarrier xb; xb.bar = (unsigned*)(launder(&ap->p)->ws + WS_BAR); xb.x = xb_xcc_id(); xb.st = (volatile LAS unsigned*)(ldsl + LDS_BYTES - 16); xcd_barrier(xb); }
            if (TIMING_A >= 0 && blockIdx.x == 0 && threadIdx.x == 0) ((unsigned long long*)(launder(&ap->p)->ws + WS_TS))[ph + 1] = __builtin_amdgcn_s_memrealtime(); }
    }
#if TIMING_A >= 0
    {
        XcdBarrier xb; xb.bar = (unsigned*)(launder(&ap->p)->ws + WS_BAR); xb.x = xb_xcc_id(); xb.st = (volatile LAS unsigned*)(ldsl + LDS_BYTES - 16); xcd_barrier(xb);
        if (blockIdx.x == 0 && threadIdx.x == 0) ((unsigned long long*)(launder(&ap->p)->ws + WS_TS))[hi] = __builtin_amdgcn_s_memrealtime();
        xcd_barrier(xb);
        const unsigned long long* ts = (const unsigned long long*)(launder(&ap->p)->ws + WS_TS);
        const float ta = (float)(ts[TIMING_A + 1] - ts[TIMING_A]) * 0.01f, tb = (float)(ts[TIMING_B + 1] - ts[TIMING_B]) * 0.01f;
        float* o = launder(&ap->p)->out; const float sc = 1.f + ta * 0.001f;
        for (size_t i = (size_t)blockIdx.x * NTHREADS + threadIdx.x; i < (size_t)NB * SEQ * D; i += (size_t)gridDim.x * NTHREADS) o[i] = o[i] * sc + (i == 0 ? tb * 0.1f : 0.f);
    }
#endif
}

extern "C" void kernel_launch(void* const* d_in, const int* in_sizes, int n_in, void* d_out, int out_size, void* d_ws, size_t ws_size, hipStream_t stream) {
    static int grid = 0;
    if (grid == 0) {
        if (n_in != 28 || ws_size < WS_END) { fprintf(stderr, "kernel_launch: unexpected n_in %d or ws_size %zu (< %zu)\n", n_in, ws_size, (size_t)WS_END); grid = -1; return; }
        int dev = 0, cus = 0, per_cu = 0;
        hipGetDevice(&dev); hipDeviceGetAttribute(&cus, hipDeviceAttributeMultiprocessorCount, dev);
        if (hipFuncSetAttribute((const void*)mk_fwd, hipFuncAttributeMaxDynamicSharedMemorySize, LDS_BYTES) != hipSuccess) { fprintf(stderr, "kernel_launch: hipFuncSetAttribute failed\n"); grid = -1; return; }
        if (hipOccupancyMaxActiveBlocksPerMultiprocessor(&per_cu, (const void*)mk_fwd, NTHREADS, LDS_BYTES) != hipSuccess || per_cu < 1) { fprintf(stderr, "kernel_launch: occupancy query says %d\n", per_cu); (void)hipGetLastError(); grid = -1; return; }
        grid = cus;
    }
    if (grid < 0) return;
    (void)hipMemsetAsync((char*)d_ws + WS_CTL, 0, WS_CTL_BYTES, stream);
    Args a{};
    const float** pp = (const float**)&a.p;
    for (int i = 0; i < 28; ++i) pp[i] = (const float*)d_in[i];
    a.p.out = (float*)d_out; a.p.ws = (unsigned char*)d_ws;
#if PER_PHASE_LAUNCH
    for (int ph = 0; ph < NPHASES; ++ph) {
        a.lo = ph; a.hi = ph + 1; void* kargs[] = {&a};
        hipError_t e = hipLaunchCooperativeKernel((const void*)mk_fwd, dim3(grid), dim3(NTHREADS), kargs, LDS_BYTES, stream);
        if (e != hipSuccess) { fprintf(stderr, "kernel_launch: launch of phase %d failed: %s\n", ph, hipGetErrorString(e)); break; }
    }
#else
    a.lo = 0; a.hi = NPHASES; void* kargs[] = {&a};
    hipError_t e = hipLaunchCooperativeKernel((const void*)mk_fwd, dim3(grid), dim3(NTHREADS), kargs, LDS_BYTES, stream);
    if (e != hipSuccess) fprintf(stderr, "kernel_launch: cooperative launch failed: %s (grid %d)\n", hipGetErrorString(e), grid);
#endif
}
```

```cpp
#include <hip/hip_runtime.h>
#include <hip/hip_cooperative_groups.h>
#include <cstdio>
namespace cg = cooperative_groups;

#ifndef PER_PHASE_LAUNCH
#define PER_PHASE_LAUNCH 0
#endif

#ifndef S3REP
#define S3REP 0
#endif
#define S3R(i) for (int r3_ = 0; r3_ < 1 + ((S3REP >> (i)) & 1); ++r3_)
#define LAS __attribute__((address_space(3)))
typedef unsigned short bf16_t;
typedef short bf16x8 __attribute__((ext_vector_type(8)));
typedef float f32x4 __attribute__((ext_vector_type(4)));
typedef unsigned u32x4 __attribute__((ext_vector_type(4)));
typedef unsigned u32x2 __attribute__((ext_vector_type(2)));

constexpr int D = 1024, NB = 2, SEQ = 16384, CTXL = 256, SEG = SEQ + CTXL, R = NB * SEG, DEPTH = 2;
constexpr int NPROJ = 2560, DIN = 2576;
constexpr int NTHREADS = 512;
constexpr int LDS_BYTES = 163840;
constexpr int MISC_OFF = 131072;
constexpr int NCLS = 24;

constexpr size_t al256(size_t x) { return (x + 255) & ~size_t(255); }
constexpr size_t WS_CTL = 0;
constexpr size_t WS_TS = 2048;
constexpr size_t WS_BAR = 4096;
constexpr size_t WS_CTL_BYTES = 32768;
constexpr size_t WS_MOD = WS_CTL_BYTES;
constexpr size_t WS_WTIN = WS_MOD + al256((size_t)2 * 3 * 6144 * 4);
constexpr size_t WS_WTOUT = WS_WTIN + al256((size_t)2 * DIN * 1024 * 2);
constexpr size_t WS_WTGU = WS_WTOUT + al256((size_t)2 * 1024 * 1024 * 2);
constexpr size_t WS_WTD = WS_WTGU + al256((size_t)2 * 16 * 512 * 1024 * 2);
constexpr size_t WS_H = WS_WTD + al256((size_t)2 * 16 * 1024 * 256 * 2);
constexpr size_t WS_HX = WS_H + al256((size_t)R * 1024 * 2);
constexpr size_t WS_PROJ = WS_HX + al256((size_t)R * 1024 * 2);
constexpr size_t WS_DT = WS_PROJ + al256((size_t)R * NPROJ * 2);
constexpr size_t WS_POS = WS_DT + al256((size_t)R * 16 * 4);
constexpr size_t WS_LIST = WS_POS + al256((size_t)2 * R * 4);
constexpr size_t WS_CWLA = WS_LIST + al256((size_t)NCLS * R * 4);
constexpr size_t WS_CWLB = WS_CWLA + al256((size_t)NCLS * R * 4);
constexpr size_t WS_BIG = WS_CWLB + al256((size_t)NCLS * R * 4);
constexpr size_t WS_Y = WS_PROJ;
constexpr size_t WS_S = WS_BIG;
constexpr size_t WS_HP = WS_S + al256((size_t)2 * 2 * 130 * 8 * 8192 * 2);
constexpr size_t WS_DEC = WS_HP + al256((size_t)2 * 2 * 130 * 8 * 8192 * 2);
constexpr size_t WS_SSQ = WS_DEC + al256((size_t)2 * 2 * 130 * 8 * 4);
constexpr size_t WS_HID = WS_S;
constexpr size_t WS_END = WS_SSQ + al256((size_t)R * 8 * 4);
static_assert((size_t)(R + NCLS * 256) * 512 * 2 <= (size_t)2 * 2 * 130 * 8 * 8192 * 2, "hid alias");
static_assert(WS_END <= (size_t)512 * 1024 * 1024, "workspace");

struct Params {
    const float *x, *c, *ctx, *c_ctx, *w_ada, *b_ada, *g_mix, *g_ffn, *w_in, *conv_w, *conv_b, *conv_ln_g, *conv_ln_b, *ssd_conv_w, *ssd_conv_b,
        *dt_bias, *a_log, *d_skip, *ssd_norm_g, *w_out, *w_rg, *b_rg, *w_re, *b_re, *w_gate, *w_up, *w_down, *g_final;
    float* out; unsigned char* ws;
};
struct Args { Params p; int lo, hi; };
typedef const __attribute__((address_space(4))) Params* CP;
__device__ __forceinline__ CP launder(CP p) { asm volatile("" : "+s"(p)); return p; }
__device__ __forceinline__ int launder_tid() { int t = threadIdx.x; asm volatile("" : "+v"(t)); return t; }

__device__ __forceinline__ unsigned cvt_pk_bf16(float lo, float hi) { unsigned r; asm("v_cvt_pk_bf16_f32 %0, %1, %2" : "=v"(r) : "v"(lo), "v"(hi)); return r; }
__device__ __forceinline__ float bf2f(unsigned b) { return __uint_as_float(b << 16); }
__device__ __forceinline__ float bflo(unsigned w) { return __uint_as_float(w << 16); }
__device__ __forceinline__ float bfhi(unsigned w) { return __uint_as_float(w & 0xffff0000u); }
__device__ __forceinline__ bf16_t f2bf(float f) { return (bf16_t)(cvt_pk_bf16(f, 0.f) & 0xffffu); }
#define DPP_ADD(v, ctrl, rm) ((v) + __builtin_bit_cast(float, __builtin_amdgcn_update_dpp(0, __builtin_bit_cast(int, (v)), (ctrl), (rm), 0xF, true)))
__device__ __forceinline__ float row_sum16(float v) {
    v = DPP_ADD(v, 0xB1, 0xF);
    v = DPP_ADD(v, 0x4E, 0xF);
    v = DPP_ADD(v, 0x141, 0xF);
    v = DPP_ADD(v, 0x140, 0xF);
    return v;
}
__device__ __forceinline__ float half_sum32(float v) { v = row_sum16(v); v = DPP_ADD(v, 0x142, 0xA); return v; }
__device__ __forceinline__ float wave_sum(float v) {
    v = half_sum32(v); v = DPP_ADD(v, 0x143, 0xC);
    return __builtin_bit_cast(float, __builtin_amdgcn_readlane(__builtin_bit_cast(int, v), 63));
}
__device__ __forceinline__ float sigmoidf_(float x) { return 1.f / (1.f + __expf(-x)); }
__device__ __forceinline__ float siluf_(float x) { return x / (1.f + __expf(-x)); }
__device__ __forceinline__ float softplusf_(float x) { return fmaxf(x, 0.f) + log1pf(expf(-fabsf(x))); }

__device__ __forceinline__ int row_b(int r) { return r >= SEG ? 1 : 0; }
__device__ __forceinline__ int row_i(int r) { return r >= SEG ? r - SEG : r; }
__device__ __forceinline__ int row_v(int r) { const int i = row_i(r); return i < CTXL ? 2 : row_b(r); }
__device__ __forceinline__ const float* xin_ptr(const float* ctx, const float* x, int r) {
    const int b = row_b(r), i = row_i(r);
    return i < CTXL ? ctx + (size_t)(b * CTXL + i) * D : x + (size_t)(b * SEQ + i - CTXL) * D;
}
struct RowRaw { f32x4 f[4]; u32x2 h[4]; };
__device__ __forceinline__ void row_load(CP p, int l, int r, int lane, RowRaw& rr) {
    if (l == 0) { const f32x4* hr = (const f32x4*)xin_ptr(p->ctx, p->x, r);
#pragma unroll
        for (int j = 0; j < 4; ++j) rr.f[j] = hr[lane + 64 * j]; }
    else { const u32x2* hr = (const u32x2*)((const bf16_t*)(p->ws + WS_H) + (size_t)r * D);
#pragma unroll
        for (int j = 0; j < 4; ++j) rr.h[j] = hr[lane + 64 * j]; }
}
__device__ __forceinline__ void row_cvt(int l, const RowRaw& rr, f32x4 (&xv)[4]) {
#pragma unroll
    for (int j = 0; j < 4; ++j) xv[j] = l == 0 ? rr.f[j] : (f32x4){bflo(rr.h[j].x), bfhi(rr.h[j].x), bflo(rr.h[j].y), bfhi(rr.h[j].y)};
}
namespace pg8 {
constexpr int BM = 256, BK = 64, HALF = 128, HTB = HALF * BK * 2, STAGE_BYTES = 8 * HTB, NXCD = 8, WGM = 8;
__device__ __forceinline__ int lds_byte(int r, int c) { const int st = (r >> 4) * 2 + (c >> 5), rr = r & 15, cc = c & 31, ob = rr * 64 + cc * 2; return st * 1024 + (ob ^ (((ob >> 9) & 1) << 5)); }
__device__ __forceinline__ void stage_rc(int b, int& Rr, int& Cc) { const int st = b / 1024, sb = b % 1024, swz = sb ^ (((sb >> 9) & 1) << 5); Rr = (st >> 1) * 16 + swz / 64; Cc = (st & 1) * 32 + (swz % 64) / 2; }
__device__ __forceinline__ int perm32(int rho) { const int n = rho >> 4, i = rho & 15; return 8 * (i >> 2) + 4 * n + (i & 3); }

struct Unit {
    const char* a0;
    const char* b0;
    const char* b1;
    int i0, i1, i2, i3, i4, pad;
};

template <class Epi, class Sched, bool GATHER>
__device__ __forceinline__ void gemm_phase(LAS unsigned char* lds, const int lda, const int ldb, const int K, const Sched& S, const Epi& E) {
    const int tid = launder_tid(); const int wid = __builtin_amdgcn_readfirstlane(tid >> 6), lane = tid & 63, wr = wid >> 2, wc = wid & 3, fr = lane & 15, fq = lane >> 4;
    const int nt = K / BK, ks = nt >> 1;
    int Rr[2], Cc[2];
    unsigned voffB[2];
#pragma unroll
    for (int i = 0; i < 2; ++i) { stage_rc(tid * 16 + i * 8192, Rr[i], Cc[i]); const int Rb = Epi::PERM ? ((Rr[i] & ~31) + perm32(Rr[i] & 31)) : Rr[i];
        voffB[i] = (unsigned)(Rb * ldb + Cc[i]) * 2u; }
    const size_t kstep = (size_t)(BK * 2);
    const size_t hstepB = (size_t)HALF * ldb * 2;
    const unsigned ldsw = (unsigned)wid * 1024u;
    const unsigned ldsbase = (unsigned)(unsigned long)lds;
    const int aoff = lds_byte(wr * 64 + fr, fq * 8), boff = lds_byte(wc * 32 + fr, fq * 8);
#define PG8_SA(b, h) (((b) * 2 + (h)) * HTB)
#define PG8_SB(b, h) ((4 + (b) * 2 + (h)) * HTB)
#define PG8_STAGE2(bufoff, gbase, v0, v1) do { unsigned keep_; \
        asm volatile("s_mov_b32 %0, m0\n\ts_mov_b32 m0, %1\n\ts_nop 4\n\tglobal_load_lds_dwordx4 %2, %4\n\ts_add_u32 m0, m0, 0x2000\n\ts_nop 0\n\tglobal_load_lds_dwordx4 %3, %4\n\ts_mov_b32 m0, %0" \
            : "=&s"(keep_) : "s"(ldsbase + (unsigned)(bufoff) + ldsw), "v"(v0), "v"(v1), "s"(gbase) : "memory", "scc"); } while (0)
#define PG8_LDA(dst, b, h) do { _Pragma("unroll") for (int m = 0; m < 4; ++m) _Pragma("unroll") for (int k = 0; k < 2; ++k) dst[m][k] = *(const LAS bf16x8*)(lds + PG8_SA(b, h) + aoff + m * 2048 + k * 1024); } while (0)
#define PG8_LDB(dst, b, h) do { _Pragma("unroll") for (int n = 0; n < 2; ++n) _Pragma("unroll") for (int k = 0; k < 2; ++k) dst[n][k] = *(const LAS bf16x8*)(lds + PG8_SB(b, h) + boff + n * 2048 + k * 1024); } while (0)
#define PG8_MMA(ai, bj, At, Bt) do { __builtin_amdgcn_s_setprio(1); _Pragma("unroll") for (int m = 0; m < 4; ++m) _Pragma("unroll") for (int n = 0; n < 2; ++n) _Pragma("unroll") for (int k = 0; k < 2; ++k) \
        acc[ai][bj][m][n] = __builtin_amdgcn_mfma_f32_16x16x32_bf16(Bt[n][k], At[m][k], acc[ai][bj][m][n], 0, 0, 0); __builtin_amdgcn_s_setprio(0); } while (0)
#define PG8_WAIT_V(n) asm volatile("s_waitcnt vmcnt(" #n ")" ::: "memory")
#define PG8_WAIT_L(n) asm volatile("s_waitcnt lgkmcnt(" #n ")" ::: "memory")
#define PG8_BAR __builtin_amdgcn_s_barrier()
#define PG8_SCHED __builtin_amdgcn_sched_barrier(0)
#define PG8_BP(u, tt) ((tt) < ks ? (u).b0 + (size_t)(tt) * kstep : (u).b1 + (size_t)((tt) - ks) * kstep)
    Unit cur, nxt; int ui = 0;
    if (!S.get(0, cur)) return;
    unsigned c00, c01, c10, c11, n00, n01, n10, n11;
    if (GATHER) {
        c00 = (unsigned)(S.arow(cur, Rr[0]) * lda + Cc[0]) * 2u; c01 = (unsigned)(S.arow(cur, Rr[1]) * lda + Cc[1]) * 2u;
        c10 = (unsigned)(S.arow(cur, HALF + Rr[0]) * lda + Cc[0]) * 2u; c11 = (unsigned)(S.arow(cur, HALF + Rr[1]) * lda + Cc[1]) * 2u;
    } else {
        c00 = (unsigned)(Rr[0] * lda + Cc[0]) * 2u; c01 = (unsigned)(Rr[1] * lda + Cc[1]) * 2u;
        c10 = (unsigned)((HALF + Rr[0]) * lda + Cc[0]) * 2u; c11 = (unsigned)((HALF + Rr[1]) * lda + Cc[1]) * 2u;
    }
    n00 = c00; n01 = c01; n10 = c10; n11 = c11;
    f32x4 acc[2][2][4][2];
    float zr; asm volatile("v_mov_b32 %0, 0" : "=v"(zr));
#pragma unroll
    for (int a = 0; a < 2; ++a)
#pragma unroll
        for (int b = 0; b < 2; ++b)
#pragma unroll
            for (int m = 0; m < 4; ++m)
#pragma unroll
                for (int n = 0; n < 2; ++n) acc[a][b][m][n] = (f32x4){zr, zr, zr, zr};
    bf16x8 At[4][2], B0[2][2], B1[2][2];
    const char* cA = cur.a0;
    {
        const char* pb0 = PG8_BP(cur, 0); const char* pb1 = PG8_BP(cur, 1);
        PG8_STAGE2(PG8_SB(0, 0), pb0, voffB[0], voffB[1]); PG8_STAGE2(PG8_SA(0, 0), cA, c00, c01);
        PG8_STAGE2(PG8_SB(0, 1), pb0 + hstepB, voffB[0], voffB[1]); PG8_STAGE2(PG8_SA(0, 1), cA, c10, c11);
        if (wr == 1) PG8_BAR;
        PG8_WAIT_V(4); PG8_BAR;
        PG8_STAGE2(PG8_SB(1, 0), pb1, voffB[0], voffB[1]); PG8_STAGE2(PG8_SA(1, 0), cA + kstep, c00, c01);
        PG8_STAGE2(PG8_SB(1, 1), pb1 + hstepB, voffB[0], voffB[1]);
        PG8_WAIT_V(6); PG8_BAR;
    }
    for (;;) {
        const bool has_next = S.get(ui + 1, nxt);
        if (!has_next) nxt = cur;
        LAS int* tokb = (LAS int*)(lds + MISC_OFF + 1024) + ((ui + 1) & 1) * 256;
        if (GATHER) {
            n00 = c00; n01 = c01; n10 = c10; n11 = c11;
            if (has_next && wid == 0) {
                const char* src = (const char*)S.rows_ptr(nxt); unsigned keep_;
                asm volatile("s_mov_b32 %0, m0\n\ts_mov_b32 m0, %1\n\ts_nop 4\n\tglobal_load_lds_dwordx4 %2, %3\n\ts_mov_b32 m0, %0"
                    : "=&s"(keep_) : "s"((unsigned)(unsigned long)tokb), "v"((unsigned)lane * 16u), "s"(src) : "memory");
            }
        }
        const char* nA = nxt.a0;
#pragma unroll 1
        for (int t = 0; t < nt; t += 2) {
            const bool last = (t == nt - 2);
            const char* a1 = cA + (size_t)(t + 1) * kstep;
            const char* a2 = last ? nA : cA + (size_t)(t + 2) * kstep;
            const char* a3 = a2 + kstep;
            const char* b2 = last ? PG8_BP(nxt, 0) : PG8_BP(cur, t + 2);
            const char* b3 = last ? PG8_BP(nxt, 1) : PG8_BP(cur, t + 3);
            if (GATHER) { if (last && has_next) {
                const int lim = S.rows_valid(nxt) - 1;
                const int i0 = Rr[0] < lim ? Rr[0] : lim, i1 = Rr[1] < lim ? Rr[1] : lim, i2 = (HALF + Rr[0]) < lim ? (HALF + Rr[0]) : lim, i3 = (HALF + Rr[1]) < lim ? (HALF + Rr[1]) : lim;
                n00 = (unsigned)(tokb[i0] * lda + Cc[0]) * 2u; n01 = (unsigned)(tokb[i1] * lda + Cc[1]) * 2u;
                n10 = (unsigned)(tokb[i2] * lda + Cc[0]) * 2u; n11 = (unsigned)(tokb[i3] * lda + Cc[1]) * 2u; } }
            const unsigned s00 = last ? n00 : c00, s01 = last ? n01 : c01, s10 = last ? n10 : c10, s11 = last ? n11 : c11;
            if constexpr (Epi::MIDSCALE) { if (t == ks) E.midscale(acc, cur, wr, wc, fr, fq); }
            PG8_LDB(B0, 0, 0); PG8_SCHED; PG8_LDA(At, 0, 0); PG8_STAGE2(PG8_SA(1, 1), a1, c10, c11);
            PG8_WAIT_L(8); PG8_BAR; PG8_WAIT_L(0); PG8_MMA(0, 0, At, B0); PG8_BAR; PG8_SCHED;
            PG8_LDB(B1, 0, 1); PG8_STAGE2(PG8_SB(0, 0), b2, voffB[0], voffB[1]);
            PG8_BAR; PG8_WAIT_L(0); PG8_MMA(0, 1, At, B1); PG8_BAR;
            PG8_LDA(At, 0, 1); PG8_STAGE2(PG8_SA(0, 0), a2, s00, s01);
            PG8_BAR; PG8_WAIT_L(0); PG8_MMA(1, 0, At, B0); PG8_BAR; PG8_SCHED;
            PG8_STAGE2(PG8_SB(0, 1), b2 + hstepB, voffB[0], voffB[1]);
            PG8_WAIT_V(6); PG8_BAR; PG8_MMA(1, 1, At, B1); PG8_BAR;
            PG8_LDB(B0, 1, 0); PG8_SCHED; PG8_LDA(At, 1, 0); PG8_STAGE2(PG8_SA(0, 1), a2, s10, s11);
            PG8_WAIT_L(8); PG8_BAR; PG8_WAIT_L(0); PG8_MMA(0, 0, At, B0); PG8_BAR; PG8_SCHED;
            PG8_LDB(B1, 1, 1); PG8_STAGE2(PG8_SB(1, 0), b3, voffB[0], voffB[1]);
            PG8_BAR; PG8_WAIT_L(0); PG8_MMA(0, 1, At, B1); PG8_BAR;
            PG8_LDA(At, 1, 1); PG8_STAGE2(PG8_SA(1, 0), a3, s00, s01);
            PG8_BAR; PG8_WAIT_L(0); PG8_MMA(1, 0, At, B0); PG8_BAR; PG8_SCHED;
            PG8_STAGE2(PG8_SB(1, 1), b3 + hstepB, voffB[0], voffB[1]);
            PG8_WAIT_V(6); PG8_BAR; PG8_MMA(1, 1, At, B1); PG8_BAR;
        }
        E(acc, cur, wr, wc, fr, fq);
        if (!has_next) break;
        asm volatile("v_mov_b32 %0, 0" : "=v"(zr));
#pragma unroll
        for (int a = 0; a < 2; ++a)
#pragma unroll
            for (int b = 0; b < 2; ++b)
#pragma unroll
                for (int m = 0; m < 4; ++m)
#pragma unroll
                    for (int n = 0; n < 2; ++n) acc[a][b][m][n] = (f32x4){zr, zr, zr, zr};
        cur = nxt; cA = nA; ++ui; c00 = n00; c01 = n01; c10 = n10; c11 = n11;
    }
    PG8_WAIT_V(0);
    if (wr == 0) PG8_BAR;
    PG8_BAR;
#undef PG8_SA
#undef PG8_SB
#undef PG8_STAGE2
#undef PG8_LDA
#undef PG8_LDB
#undef PG8_MMA
#undef PG8_WAIT_V
#undef PG8_WAIT_L
#undef PG8_BAR
#undef PG8_SCHED
#undef PG8_BP
}

struct DenseSched {
    const char* A; const char* Bt; int lda, ldb, K; int nM, nN, nwg, G, c, skipctx;
    __device__ __forceinline__ void init(const void* A_, const void* Bt_, int M, int N, int K_, int lda_, int ldb_, int G_, int c_, int skipctx_ = 0) {
        A = (const char*)A_; Bt = (const char*)Bt_; lda = lda_; ldb = ldb_; K = K_; nM = M / BM - 2 * skipctx_; nN = N / BM; nwg = nM * nN; G = G_; c = c_; skipctx = skipctx_; }
    __device__ __forceinline__ bool get(int i, Unit& u) const {
        const long L = (long)i * G + c; if (L >= nwg) return false;
        int wgid = (int)L; { const int q = nwg / NXCD, r = nwg % NXCD, xcd = wgid % NXCD, off = wgid / NXCD; wgid = (xcd < r ? xcd * (q + 1) : r * (q + 1) + (xcd - r) * q) + off; }
        const int nig = WGM * nN, gid = wgid / nig, fm = gid * WGM, gsz = (nM - fm) < WGM ? (nM - fm) : WGM;
        int pm = fm + ((wgid % nig) % gsz); const int pn = (wgid % nig) / gsz;
        if (skipctx) pm += 1 + (pm >= 64 ? 1 : 0);
        u.a0 = A + (size_t)pm * BM * lda * 2; u.b0 = Bt + (size_t)pn * BM * ldb * 2; u.b1 = u.b0 + (size_t)(K / BK / 2) * BK * 2;
        u.i0 = pm; u.i1 = pn; u.i2 = 0; u.i3 = 0; u.i4 = 0; u.pad = 0; return true;
    }
    __device__ __forceinline__ int arow(const Unit&, int rl) const { return rl; }
    __device__ __forceinline__ const int* rows_ptr(const Unit&) const { return nullptr; }
    __device__ __forceinline__ int rows_valid(const Unit&) const { return 256; }
};
}

struct EpiProj {
    static constexpr bool PERM = true, MIDSCALE = false;
    bf16_t* O;
    __device__ __forceinline__ void operator()(const f32x4 (&acc)[2][2][4][2], const pg8::Unit& u, int wr, int wc, int fr, int fq) const {
        const int row0 = u.i0 * 256 + wr * 64 + fr, col0 = u.i1 * 256 + wc * 32 + 8 * fq;
#pragma unroll
        for (int ai = 0; ai < 2; ++ai)
#pragma unroll
            for (int m = 0; m < 4; ++m) { bf16_t* rowp = O + (size_t)(row0 + ai * 128 + m * 16) * NPROJ + col0;
#pragma unroll
                for (int bj = 0; bj < 2; ++bj) { const f32x4 v0 = acc[ai][bj][m][0], v1 = acc[ai][bj][m][1];
                    u32x4 w; w.x = cvt_pk_bf16(v0[0], v0[1]); w.y = cvt_pk_bf16(v0[2], v0[3]); w.z = cvt_pk_bf16(v1[0], v1[1]); w.w = cvt_pk_bf16(v1[2], v1[3]);
                    *(u32x4*)(rowp + bj * 128) = w; } }
    }
};
template <int L0> struct EpiResid {
    static constexpr bool PERM = true, MIDSCALE = true;
    const float* inc; const float* inx; bf16_t* H; const float* modl; const float* ssq;
    __device__ __forceinline__ void midscale(f32x4 (&acc)[2][2][4][2], const pg8::Unit& u, int wr, int wc, int fr, int fq) const {
        typedef float f32x2 __attribute__((ext_vector_type(2)));
        const int r0 = u.i0 * 256 + wr * 64 + fr;
        f32x2 part[2][4];
#pragma unroll
        for (int ai = 0; ai < 2; ++ai)
#pragma unroll
            for (int m = 0; m < 4; ++m) part[ai][m] = *(const f32x2*)(ssq + (size_t)(r0 + ai * 128 + m * 16) * 8 + 2 * fq);
#pragma unroll
        for (int ai = 0; ai < 2; ++ai)
#pragma unroll
            for (int m = 0; m < 4; ++m) { float sq = part[ai][m][0] + part[ai][m][1];
                sq += __shfl_xor(sq, 16); sq += __shfl_xor(sq, 32);
                const float rs = rsqrtf(sq * (1.f / 512.f) + 1e-6f);
#pragma unroll
                for (int bj = 0; bj < 2; ++bj)
#pragma unroll
                    for (int n = 0; n < 2; ++n) acc[ai][bj][m][n] *= rs; }
    }
    __device__ __forceinline__ void operator()(const f32x4 (&acc)[2][2][4][2], const pg8::Unit& u, int wr, int wc, int fr, int fq) const {
        const int r0 = u.i0 * 256;
        const int v = row_v(r0);
        const float* gate = modl + (size_t)v * 6144 + 2 * 1024;
        const float* xin = xin_ptr(inc, inx, r0);
        const int rl0 = wr * 64 + fr, col0 = u.i1 * 256 + wc * 32 + 8 * fq;
        f32x4 gv[2][2];
#pragma unroll
        for (int bj = 0; bj < 2; ++bj)
#pragma unroll
            for (int n = 0; n < 2; ++n) gv[bj][n] = *(const f32x4*)(gate + col0 + bj * 128 + 4 * n);
#pragma unroll
        for (int ai = 0; ai < 2; ++ai)
#pragma unroll
            for (int mp = 0; mp < 2; ++mp) {
                if (L0) {
                    f32x4 hi[2][2][2];
#pragma unroll
                    for (int mm = 0; mm < 2; ++mm) { const size_t off = (size_t)(rl0 + ai * 128 + (2 * mp + mm) * 16) * D + col0;
#pragma unroll
                        for (int bj = 0; bj < 2; ++bj)
#pragma unroll
                            for (int n = 0; n < 2; ++n) hi[mm][bj][n] = *(const f32x4*)(xin + off + bj * 128 + 4 * n); }
#pragma unroll
                    for (int mm = 0; mm < 2; ++mm)
#pragma unroll
                        for (int bj = 0; bj < 2; ++bj) { const f32x4 o0 = hi[mm][bj][0] + gv[bj][0] * acc[ai][bj][2 * mp + mm][0], o1 = hi[mm][bj][1] + gv[bj][1] * acc[ai][bj][2 * mp + mm][1];
                            u32x4 w; w.x = cvt_pk_bf16(o0[0], o0[1]); w.y = cvt_pk_bf16(o0[2], o0[3]); w.z = cvt_pk_bf16(o1[0], o1[1]); w.w = cvt_pk_bf16(o1[2], o1[3]);
                            *(u32x4*)(H + (size_t)(r0 + rl0 + ai * 128 + (2 * mp + mm) * 16) * D + col0 + bj * 128) = w; }
                } else {
                    u32x4 hr[2][2];
#pragma unroll
                    for (int mm = 0; mm < 2; ++mm)
#pragma unroll
                        for (int bj = 0; bj < 2; ++bj) hr[mm][bj] = *(const u32x4*)(H + (size_t)(r0 + rl0 + ai * 128 + (2 * mp + mm) * 16) * D + col0 + bj * 128);
#pragma unroll
                    for (int mm = 0; mm < 2; ++mm)
#pragma unroll
                        for (int bj = 0; bj < 2; ++bj) { const u32x4 hv = hr[mm][bj]; const f32x4 a0 = acc[ai][bj][2 * mp + mm][0], a1 = acc[ai][bj][2 * mp + mm][1]; const f32x4 g0 = gv[bj][0], g1 = gv[bj][1];
                            u32x4 w;
                            w.x = cvt_pk_bf16(bflo(hv.x) + g0[0] * a0[0], bfhi(hv.x) + g0[1] * a0[1]); w.y = cvt_pk_bf16(bflo(hv.y) + g0[2] * a0[2], bfhi(hv.y) + g0[3] * a0[3]);
                            w.z = cvt_pk_bf16(bflo(hv.z) + g1[0] * a1[0], bfhi(hv.z) + g1[1] * a1[1]); w.w = cvt_pk_bf16(bflo(hv.w) + g1[2] * a1[2], bfhi(hv.w) + g1[3] * a1[3]);
                            *(u32x4*)(H + (size_t)(r0 + rl0 + ai * 128 + (2 * mp + mm) * 16) * D + col0 + bj * 128) = w; }
                }
                asm volatile("" ::: "memory"); }
    }
};

struct MoeSched {
    const LAS int* tab;
    const int* list;
    const char* A; const char* W; int mode  , l, G, c;
    __device__ __forceinline__ bool get(int i, pg8::Unit& u) const {
        const int L = i * G + c; const int total = __builtin_amdgcn_readfirstlane(tab[24]) * 4; if (L >= total) return false;
        const int tl = L >> 2, pn = L & 3;
        int cls = 0;
#pragma unroll 1
        for (int q = 1; q < NCLS; ++q) { const int tq = __builtin_amdgcn_readfirstlane(tab[q]); if (tq <= tl) cls = q; }
        const int j = tl - __builtin_amdgcn_readfirstlane(tab[cls]), cnt = __builtin_amdgcn_readfirstlane(tab[32 + cls]);
        const int g = cls / 6, pidx = cls - g * 6;
        const int ea = (pidx >= 3) + (pidx >= 5), eb = pidx < 3 ? pidx + 1 : (pidx < 5 ? pidx - 1 : 3);
        if (mode == 0) {
            const int e = 4 * g + (pn < 2 ? ea : eb);
            u.a0 = A;
            u.b0 = W + ((size_t)(l * 16 + e) * 512 + (size_t)(pn & 1) * 256) * 1024 * 2; u.b1 = u.b0 + (size_t)8 * 128;
        } else {
            u.a0 = A + (size_t)tl * 256 * 512 * 2;
            u.b0 = W + ((size_t)(l * 16 + 4 * g + ea) * 1024 + (size_t)pn * 256) * 256 * 2;
            u.b1 = W + ((size_t)(l * 16 + 4 * g + eb) * 1024 + (size_t)pn * 256) * 256 * 2;
        }
        u.i0 = cls; u.i1 = j; u.i2 = pn; u.i3 = cnt; u.i4 = tl; u.pad = 0; return true;
    }
    __device__ __forceinline__ int arow(const pg8::Unit& u, int rl) const {
        int idx = u.i1 * 256 + rl; idx = idx < u.i3 ? idx : u.i3 - 1;
        return list[(size_t)u.i0 * R + idx];
    }
    __device__ __forceinline__ const int* rows_ptr(const pg8::Unit& u) const { return list + (size_t)u.i0 * R + u.i1 * 256; }
    __device__ __forceinline__ int rows_valid(const pg8::Unit& u) const { return u.i3 - u.i1 * 256; }
};
struct EpiUp {
    static constexpr bool PERM = true, MIDSCALE = false;
    bf16_t* hid; const float* cwla; const float* cwlb;
    __device__ __forceinline__ void operator()(const f32x4 (&acc)[2][2][4][2], const pg8::Unit& u, int wr, int wc, int fr, int fq) const {
        const int cls = u.i0, j = u.i1, pn = u.i2, cnt = u.i3, tl = u.i4;
        const float* cw = (pn < 2) ? cwla : cwlb;
        const int colbase = (pn >> 1) * 256 + (pn & 1) * 128 + wc * 32 + 8 * fq;
        float wrow[2][4];
#pragma unroll
        for (int ai = 0; ai < 2; ++ai)
#pragma unroll
            for (int m = 0; m < 4; ++m) { const int idx = j * 256 + ai * 128 + wr * 64 + m * 16 + fr; wrow[ai][m] = idx < cnt ? cw[(size_t)cls * R + idx] : 0.f; }
#pragma unroll
        for (int ai = 0; ai < 2; ++ai)
#pragma unroll
            for (int m = 0; m < 4; ++m) {
                const int rl = ai * 128 + wr * 64 + m * 16 + fr; const int idx = j * 256 + rl; const bool valid = idx < cnt;
                const float w = wrow[ai][m];
                const f32x4 g0 = acc[ai][0][m][0], g1 = acc[ai][0][m][1], u0 = acc[ai][1][m][0], u1 = acc[ai][1][m][1];
                float o[8];
#pragma unroll
                for (int e = 0; e < 4; ++e) { o[e] = w * siluf_(g0[e]) * u0[e]; o[4 + e] = w * siluf_(g1[e]) * u1[e]; }
                if (!valid) {
#pragma unroll
                    for (int e = 0; e < 8; ++e) o[e] = 0.f; }
                u32x4 pk; pk.x = cvt_pk_bf16(o[0], o[1]); pk.y = cvt_pk_bf16(o[2], o[3]); pk.z = cvt_pk_bf16(o[4], o[5]); pk.w = cvt_pk_bf16(o[6], o[7]);
                *(u32x4*)(hid + ((size_t)tl * 256 + rl) * 512 + colbase) = pk;
                asm volatile("" ::: "memory");
            }
    }
};
struct EpiDown {
    static constexpr bool PERM = true, MIDSCALE = false;
    bf16_t* H; const int* list; const float* modl;
    __device__ __forceinline__ void operator()(const f32x4 (&acc)[2][2][4][2], const pg8::Unit& u, int wr, int wc, int fr, int fq) const {
        const int cls = u.i0, j = u.i1, pn = u.i2, cnt = u.i3;
        const int col0 = pn * 256 + wc * 32 + 8 * fq;
        int tok[2][4];
#pragma unroll
        for (int ai = 0; ai < 2; ++ai)
#pragma unroll
            for (int m = 0; m < 4; ++m) { const int idx = j * 256 + ai * 128 + wr * 64 + m * 16 + fr; tok[ai][m] = idx < cnt ? list[(size_t)cls * R + idx] : -1; }
#pragma unroll
        for (int ai = 0; ai < 2; ++ai)
#pragma unroll
            for (int mp = 0; mp < 2; ++mp) {
                u32x4 hr[2][2]; f32x4 gv[2][2][2];
#pragma unroll
                for (int mm = 0; mm < 2; ++mm) { const int t = tok[ai][2 * mp + mm]; const int tt = t < 0 ? 0 : t;
                    const bf16_t* hp = H + (size_t)tt * D + col0; const float* gp = modl + (size_t)row_v(tt) * 6144 + col0;
#pragma unroll
                    for (int bj = 0; bj < 2; ++bj) { hr[mm][bj] = *(const u32x4*)(hp + bj * 128); gv[mm][bj][0] = *(const f32x4*)(gp + bj * 128); gv[mm][bj][1] = *(const f32x4*)(gp + bj * 128 + 4); } }
#pragma unroll
                for (int mm = 0; mm < 2; ++mm) { const int t = tok[ai][2 * mp + mm];
                    if (t >= 0) {
#pragma unroll
                        for (int bj = 0; bj < 2; ++bj) { const u32x4 hv = hr[mm][bj]; const f32x4 a0 = acc[ai][bj][2 * mp + mm][0], a1 = acc[ai][bj][2 * mp + mm][1]; const f32x4 g0 = gv[mm][bj][0], g1 = gv[mm][bj][1];
                            u32x4 w;
                            w.x = cvt_pk_bf16(bflo(hv.x) + g0[0] * a0[0], bfhi(hv.x) + g0[1] * a0[1]); w.y = cvt_pk_bf16(bflo(hv.y) + g0[2] * a0[2], bfhi(hv.y) + g0[3] * a0[3]);
                            w.z = cvt_pk_bf16(bflo(hv.z) + g1[0] * a1[0], bfhi(hv.z) + g1[1] * a1[1]); w.w = cvt_pk_bf16(bflo(hv.w) + g1[2] * a1[2], bfhi(hv.w) + g1[3] * a1[3]);
                            *(u32x4*)(H + (size_t)t * D + col0 + bj * 128) = w; } } }
                asm volatile("" ::: "memory"); }
    }
};

__device__ __forceinline__ void tr_tile(const float* src, int ldn, int k0, int n0, int nvalid, bf16_t* dst, int ldk, int drow0, LAS float* tile, int kd0 = -1, const float* kscale = nullptr) {
    const int tid = launder_tid();
    if (kd0 < 0) kd0 = k0;
    { const int n = tid & 63; const int kq = tid >> 6; float tv[8], ts[8];
#pragma unroll
      for (int it = 0; it < 8; ++it) { const int kk = kq + 8 * it; tv[it] = (n < nvalid) ? src[(size_t)(k0 + kk) * ldn + n0 + n] : 0.f; ts[it] = kscale ? kscale[kk] : 1.f; }
#pragma unroll
      for (int it = 0; it < 8; ++it) tile[(kq + 8 * it) * 65 + n] = tv[it] * ts[it]; }
    __syncthreads();
    { const int k8 = tid & 7, n = tid >> 3;
      if (n < nvalid) { const LAS float* s = tile + (k8 * 8) * 65 + n;
          u32x4 o; o.x = cvt_pk_bf16(s[0], s[65]); o.y = cvt_pk_bf16(s[2 * 65], s[3 * 65]); o.z = cvt_pk_bf16(s[4 * 65], s[5 * 65]); o.w = cvt_pk_bf16(s[6 * 65], s[7 * 65]);
          *(u32x4*)(dst + (size_t)(drow0 + n) * ldk + kd0 + k8 * 8) = o; } }
    __syncthreads();
}
constexpr int WPREP_ITEMS_PER_LAYER = 16 * 41 + 256 + 1024 + 1024 + 1024;
__device__ __forceinline__ void phase_wprep(CP p, unsigned char* lds, int it0, int it1, int bidx, int nblk) {
    LAS float* tile = (LAS float*)(LAS unsigned char*)lds;
    constexpr int I_IN = 16 * 41, I_OUT = 256, I_G = 1024, I_U = 1024, I_D = 1024, I_L = I_IN + I_OUT + I_G + I_U + I_D;
    for (int it = it0 + bidx; it < it1; it += nblk) {
        const int l = it / I_L; int r = it - l * I_L;
        if (r < I_IN) { const int kt = r / 41, ntl = r % 41; const int n0 = ntl * 64; const int nv = (DIN - n0) < 64 ? (DIN - n0) : 64;
            tr_tile(p->w_in + (size_t)l * 1024 * DIN, DIN, kt * 64, n0, nv, (bf16_t*)(p->ws + WS_WTIN) + (size_t)l * DIN * 1024, 1024, n0, tile); continue; }
        r -= I_IN;
        if (r < I_OUT) { const int kt = r >> 4, ntl = r & 15;
            tr_tile(p->w_out + (size_t)l * 1024 * 1024, 1024, kt * 64, ntl * 64, 64, (bf16_t*)(p->ws + WS_WTOUT) + (size_t)l * 1024 * 1024, 1024, ntl * 64, tile,
                    (kt * 64 + 512) & 1023, kt >= 8 ? p->ssd_norm_g + l * 512 + (kt * 64 - 512) : nullptr); continue; }
        r -= I_OUT;
        if (r < I_G + I_U) { const int up = r >= I_G; if (up) r -= I_G; const int e = r >> 6, q = r & 63, kt = q >> 2, ntl = q & 3; const int n0 = ntl * 64;
            const float* src = (up ? p->w_up : p->w_gate) + (size_t)(l * 16 + e) * 1024 * 256;
            tr_tile(src, 256, kt * 64, n0, 64, (bf16_t*)(p->ws + WS_WTGU) + (size_t)(l * 16 + e) * 512 * 1024, 1024, (n0 >> 7) * 256 + (n0 & 127) + (up ? 128 : 0), tile); continue; }
        r -= I_G + I_U;
        { const int e = r >> 6, q = r & 63, kt = q >> 4, ntl = q & 15;
          tr_tile(p->w_down + (size_t)(l * 16 + e) * 256 * 1024, 1024, kt * 64, ntl * 64, 64, (bf16_t*)(p->ws + WS_WTD) + (size_t)(l * 16 + e) * 1024 * 256, 256, ntl * 64, tile); }
    }
}
__device__ __forceinline__ void phase_adaln(CP p, unsigned char* lds, int bid, int nb) {
    LAS float* sc = (LAS float*)(LAS unsigned char*)lds;
    LAS float* red = sc + 3 * 1024;
    const int tid = launder_tid();
    for (int idx = tid; idx < 3 * 1024; idx += NTHREADS) { const int v = idx >> 10, k = idx & 1023; const float cv = (v < 2) ? p->c[v * 1024 + k] : p->c_ctx[k]; sc[idx] = siluf_(cv); }
    __syncthreads();
    float* mod = (float*)(p->ws + WS_MOD);
    for (int it = bid; it < 2 * 96; it += nb) {
        const int l = it / 96, n0 = (it % 96) * 64;
        const int c4 = tid & 15, kr = tid >> 4;
        f32x4 a0 = {0, 0, 0, 0}, a1 = {0, 0, 0, 0}, a2 = {0, 0, 0, 0};
        const float* w = p->w_ada + (size_t)l * 1024 * 6144 + n0 + c4 * 4;
#pragma unroll 4
        for (int k = kr; k < 1024; k += 32) { const f32x4 w4 = *(const f32x4*)(w + (size_t)k * 6144); a0 += sc[k] * w4; a1 += sc[1024 + k] * w4; a2 += sc[2048 + k] * w4; }
        *(LAS f32x4*)(red + (kr * 3 + 0) * 64 + c4 * 4) = a0; *(LAS f32x4*)(red + (kr * 3 + 1) * 64 + c4 * 4) = a1; *(LAS f32x4*)(red + (kr * 3 + 2) * 64 + c4 * 4) = a2;
        __syncthreads();
        if (tid < 192) { const int v = tid >> 6, cc = tid & 63; float s = 0.f;
            for (int q = 0; q < 32; ++q) s += red[(q * 3 + v) * 64 + cc];
            mod[((size_t)l * 3 + v) * 6144 + n0 + cc] = s + p->b_ada[l * 6144 + n0 + cc]; }
        __syncthreads();
    }
}
__device__ __forceinline__ void moe_table(CP p, int l, LAS int* tab) {
    const int* gcount = (const int*)(p->ws + WS_CTL) + l * 32;
    if (threadIdx.x == 0) { int acc = 0; for (int q = 0; q < NCLS; ++q) { const int cn = gcount[q]; tab[q] = acc; tab[32 + q] = cn; acc += (cn + 255) >> 8; } tab[24] = acc; }
    __syncthreads();
}
__device__ __forceinline__ void moe_yload(CP p, int pos, int lane, const LAS int* tab, u32x2 (&yv)[4]) {
    const int slot = tab[pos >> 16] * 256 + (pos & 0xffff);
    const bf16_t* y = (const bf16_t*)(p->ws + WS_Y) + (size_t)slot * 1024;
#pragma unroll
    for (int j = 0; j < 4; ++j) yv[j] = *(const u32x2*)(y + 4 * lane + 256 * j);
}
__device__ __forceinline__ void moe_yadd(CP p, int lm, int v, int lane, const u32x2 (&yv)[4], f32x4 (&xv)[4]) {
    const float* gate = (const float*)(p->ws + WS_MOD) + ((size_t)lm * 3 + v) * 6144 + 5 * 1024;
#pragma unroll
    for (int j = 0; j < 4; ++j) { const int k = 4 * lane + 256 * j; const f32x4 g4 = *(const f32x4*)(gate + k);
        xv[j][0] += g4[0] * bflo(yv[j].x); xv[j][1] += g4[1] * bfhi(yv[j].x); xv[j][2] += g4[2] * bflo(yv[j].y); xv[j][3] += g4[3] * bfhi(yv[j].y); }
}
typedef _Float16 f16x8 __attribute__((ext_vector_type(8)));
typedef _Float16 f16x2 __attribute__((ext_vector_type(2)));
constexpr int ST_H16 = 2064;
__device__ __forceinline__ unsigned pack_f16(float a, float b) { f16x2 h; h[0] = (_Float16)a; h[1] = (_Float16)b; return __builtin_bit_cast(unsigned, h); }
__device__ __forceinline__ void phase_r1(CP p, int l, unsigned char* lds_, int bid, int nb) {
    LAS unsigned char* lds = (LAS unsigned char*)lds_;
    LAS unsigned char* Wh = lds;
    LAS unsigned char* Xh = Wh + 16 * ST_H16;
    LAS float* gm = (LAS float*)(Xh + 16 * ST_H16);
    LAS float* sh = gm + 3 * 1024;
    LAS float* part = sh + 3 * 1024;
    const int tid = launder_tid(); const int lane = tid & 63, wave = __builtin_amdgcn_readfirstlane(tid >> 6);
    const float* mod = (const float*)(p->ws + WS_MOD) + (size_t)l * 3 * 6144;
    const float* win = p->w_in + (size_t)l * 1024 * DIN;
#pragma unroll
    for (int hb = 0; hb < 2; ++hb) { float tmp[16];
#pragma unroll
        for (int it = 0; it < 16; ++it) { const int idx = tid + NTHREADS * (16 * hb + it); tmp[it] = win[(size_t)(idx >> 4) * DIN + NPROJ + (idx & 15)]; }
#pragma unroll
        for (int it = 0; it < 16; ++it) { const int idx = tid + NTHREADS * (16 * hb + it); *(LAS _Float16*)(Wh + (idx & 15) * ST_H16 + (idx >> 4) * 2) = (_Float16)tmp[it]; } }
    { float t0[6], t1[6], t2[6];
#pragma unroll
      for (int it = 0; it < 6; ++it) { const int idx = tid + NTHREADS * it; const int v = idx >> 10, k = idx & 1023; t0[it] = p->g_mix[l * 1024 + k]; t1[it] = mod[v * 6144 + 1024 + k]; t2[it] = mod[v * 6144 + k]; }
#pragma unroll
      for (int it = 0; it < 6; ++it) { const int idx = tid + NTHREADS * it; gm[idx] = t0[it] * (1.f + t1[it]); sh[idx] = t2[it]; } }
    __syncthreads();
    bf16_t* HX = (bf16_t*)(p->ws + WS_HX); float* DT = (float*)(p->ws + WS_DT);
    const int rpb = (R + nb - 1) / nb, r0 = bid * rpb, r1 = (r0 + rpb) < R ? (r0 + rpb) : R;
    RowRaw xn[2];
#pragma unroll
    for (int q = 0; q < 2; ++q) if (r0 + 2 * wave + q < r1) row_load(p, l, r0 + 2 * wave + q, lane, xn[q]);
#pragma unroll 1
    for (int t0r = r0; t0r < r1; t0r += 16) {
        f32x4 xv[2][4];
#pragma unroll
        for (int q = 0; q < 2; ++q) row_cvt(l, xn[q], xv[q]);
#pragma unroll
        for (int q = 0; q < 2; ++q) if (t0r + 16 + 2 * wave + q < r1) row_load(p, l, t0r + 16 + 2 * wave + q, lane, xn[q]);
#pragma unroll
        for (int q = 0; q < 2; ++q) { const int rr = t0r + 2 * wave + q; const bool ok = rr < r1; const int v = row_v(ok ? rr : r0);
            if (l == 0 && ok) { u32x2* hw = (u32x2*)((bf16_t*)(p->ws + WS_H) + (size_t)rr * D);
#pragma unroll
                for (int j = 0; j < 4; ++j) { u32x2 o; o.x = cvt_pk_bf16(xv[q][j][0], xv[q][j][1]); o.y = cvt_pk_bf16(xv[q][j][2], xv[q][j][3]); hw[lane + 64 * j] = o; } }
            float ss = 0.f;
#pragma unroll
            for (int j = 0; j < 4; ++j) ss += xv[q][j][0] * xv[q][j][0] + xv[q][j][1] * xv[q][j][1] + xv[q][j][2] * xv[q][j][2] + xv[q][j][3] * xv[q][j][3];
            ss = wave_sum(ss); const float rs = ok ? rsqrtf(ss * (1.f / 1024.f) + 1e-6f) : 0.f;
#pragma unroll
            for (int j = 0; j < 4; ++j) { const int k = 4 * lane + 256 * j; const f32x4 g4 = *(const LAS f32x4*)(gm + v * 1024 + k), s4 = *(const LAS f32x4*)(sh + v * 1024 + k);
                f32x4 hv = xv[q][j] * rs * g4 + s4; if (!ok) hv = hv * 0.f;
                u32x2 o; o.x = cvt_pk_bf16(hv[0], hv[1]); o.y = cvt_pk_bf16(hv[2], hv[3]);
                if (ok) *(u32x2*)(HX + (size_t)rr * 1024 + k) = o;
                u32x2 h16; h16.x = pack_f16(hv[0], hv[1]); h16.y = pack_f16(hv[2], hv[3]);
                *(LAS u32x2*)(Xh + (2 * wave + q) * ST_H16 + k * 2) = h16; } }
        __syncthreads();
        {
            f32x4 acc0 = {0.f, 0.f, 0.f, 0.f};
#pragma unroll
            for (int s4 = 0; s4 < 4; ++s4) { const int kb = (128 * wave + 32 * s4 + 8 * (lane >> 4)) * 2;
                const f16x8 a = *(const LAS f16x8*)(Xh + (lane & 15) * ST_H16 + kb);
                const f16x8 b0 = *(const LAS f16x8*)(Wh + (lane & 15) * ST_H16 + kb);
                acc0 = __builtin_amdgcn_mfma_f32_16x16x32_f16(a, b0, acc0, 0, 0, 0); }
#pragma unroll
            for (int e = 0; e < 4; ++e) part[(wave * 16 + 4 * (lane >> 4) + e) * 16 + (lane & 15)] = acc0[e];
        }
        __syncthreads();
        if (tid < 256) { const int row = tid >> 4, n = tid & 15; const int rr = t0r + row;
            float sacc = p->dt_bias[l * 16 + n];
#pragma unroll
            for (int w = 0; w < 8; ++w) sacc += part[(w * 16 + row) * 16 + n];
            if (rr < r1) DT[(size_t)rr * 16 + n] = softplusf_(sacc); }
    }
    __syncthreads();
}
typedef float f32x16 __attribute__((ext_vector_type(16)));
typedef short s16x4 __attribute__((ext_vector_type(4)));
constexpr int ST_ROW = 272;
constexpr int ST_TR128 = 320;
constexpr int ST_TR64 = 192;
constexpr int NCHUNK = SEG / 128;

#define DPP_MOV(v, ctrl, rm, bm) __builtin_bit_cast(float, __builtin_amdgcn_update_dpp(0, __builtin_bit_cast(int, (v)), (ctrl), (rm), (bm), true))
__device__ __forceinline__ float wave_incl_scan(float v, int) {
    float s = v + DPP_MOV(v, 0x111, 0xF, 0xF) + DPP_MOV(v, 0x112, 0xF, 0xF) + DPP_MOV(v, 0x113, 0xF, 0xF);
    s += DPP_MOV(s, 0x114, 0xF, 0xE);
    s += DPP_MOV(s, 0x118, 0xF, 0xC);
    s += DPP_MOV(s, 0x142, 0xA, 0xF);
    s += DPP_MOV(s, 0x143, 0xC, 0xF);
    return s;
}
__device__ __forceinline__ bf16x8 row_frag(const LAS unsigned char* tile, int stride, int row0, int k0, int lane) {
    return *(const LAS bf16x8*)(tile + (row0 + (lane & 31)) * stride + (k0 + 8 * (lane >> 5)) * 2);
}
__device__ __forceinline__ bf16x8 tr_frag(const LAS unsigned char* tile, int stride, int k0, int c0, int lane) {
    const int g = lane >> 4, li = lane & 15, q = li >> 2, pp = li & 3;
    const LAS unsigned char* a0 = tile + (k0 + 8 * (g >> 1) + q) * stride + (c0 + 16 * (g & 1) + 4 * pp) * 2;
    const s16x4 lo = __builtin_amdgcn_ds_read_tr16_b64_v4i16((LAS s16x4*)a0);
    const s16x4 hi = __builtin_amdgcn_ds_read_tr16_b64_v4i16((LAS s16x4*)(a0 + 4 * stride));
    return __builtin_shufflevector(lo, hi, 0, 1, 2, 3, 4, 5, 6, 7);
}
__device__ __forceinline__ u32x4 pack8(const float (&v)[8]) { u32x4 r; r.x = cvt_pk_bf16(v[0], v[1]); r.y = cvt_pk_bf16(v[2], v[3]); r.z = cvt_pk_bf16(v[4], v[5]); r.w = cvt_pk_bf16(v[6], v[7]); return r; }
__device__ __forceinline__ u32x4 pack8s(const float (&v)[8], float sc) { u32x4 r; r.x = cvt_pk_bf16(v[0] * sc, v[1] * sc); r.y = cvt_pk_bf16(v[2] * sc, v[3] * sc); r.z = cvt_pk_bf16(v[4] * sc, v[5] * sc); r.w = cvt_pk_bf16(v[6] * sc, v[7] * sc); return r; }

__device__ __forceinline__ void conv_load(const bf16_t* proj, int row0, int rq, int xch, bool lo_ok, bool hi_ok, u32x4 (&raw)[8]) {
    const bf16_t* base = proj + (size_t)(row0 + 4 * rq) * NPROJ + 1536 + xch;
    unsigned zz; asm volatile("v_mov_b32 %0, 0" : "=v"(zz));
#pragma unroll
    for (int j = 0; j < 8; ++j) {
        if (j < 2) { const bool ok = (rq > 0) || lo_ok; const u32x4 v = *(const u32x4*)(ok ? base + (j - 2) * NPROJ : base);
            raw[j].x = ok ? v.x : zz; raw[j].y = ok ? v.y : zz; raw[j].z = ok ? v.z : zz; raw[j].w = ok ? v.w : zz; }
        else if (j >= 6) { const bool ok = (rq < 31) || hi_ok; const u32x4 v = *(const u32x4*)(ok ? base + (j - 2) * NPROJ : base);
            raw[j].x = ok ? v.x : zz; raw[j].y = ok ? v.y : zz; raw[j].z = ok ? v.z : zz; raw[j].w = ok ? v.w : zz; }
        else raw[j] = *(const u32x4*)(base + (j - 2) * NPROJ);
    }
}
__device__ __forceinline__ void conv_compute(const u32x4 (&raw)[8], const LAS float* wl, int nchl, int wch, float (&o)[4][8]) {
    float w[5][8], bs[8];
#pragma unroll
    for (int j = 0; j < 5; ++j) { const f32x4 w0 = *(const LAS f32x4*)(wl + j * nchl + wch), w1 = *(const LAS f32x4*)(wl + j * nchl + wch + 4);
        w[j][0] = w0[0]; w[j][1] = w0[1]; w[j][2] = w0[2]; w[j][3] = w0[3]; w[j][4] = w1[0]; w[j][5] = w1[1]; w[j][6] = w1[2]; w[j][7] = w1[3]; }
    { const f32x4 b0 = *(const LAS f32x4*)(wl + 5 * nchl + wch), b1 = *(const LAS f32x4*)(wl + 5 * nchl + wch + 4); bs[0] = b0[0]; bs[1] = b0[1]; bs[2] = b0[2]; bs[3] = b0[3]; bs[4] = b1[0]; bs[5] = b1[1]; bs[6] = b1[2]; bs[7] = b1[3]; }
#pragma unroll
    for (int i = 0; i < 4; ++i)
#pragma unroll
        for (int e = 0; e < 8; ++e) o[i][e] = bs[e];
#pragma unroll
    for (int j = 0; j < 8; ++j) {
        float xv[8] = {bflo(raw[j].x), bfhi(raw[j].x), bflo(raw[j].y), bfhi(raw[j].y), bflo(raw[j].z), bfhi(raw[j].z), bflo(raw[j].w), bfhi(raw[j].w)};
#pragma unroll
        for (int i = 0; i < 4; ++i) { const int tap = j - i; if (tap >= 0 && tap < 5) {
#pragma unroll
                for (int e = 0; e < 8; ++e) o[i][e] += w[tap][e] * xv[e]; } }
    }
#pragma unroll
    for (int i = 0; i < 4; ++i)
#pragma unroll
        for (int e = 0; e < 8; ++e) o[i][e] = siluf_(o[i][e]);
}
__device__ __forceinline__ void head_cums(CP p, int l, int row0, int h, int dir, int lane, LAS float* hv) {
    const float A = -expf(p->a_log[l * 16 + dir * 8 + h]);
    const float* DT = (const float*)(p->ws + WS_DT);
    const float d0 = DT[(size_t)(row0 + 2 * lane) * 16 + dir * 8 + h], d1 = DT[(size_t)(row0 + 2 * lane + 1) * 16 + dir * 8 + h];
    const float x0 = d0 * A, x1 = d1 * A;
    const float incl = wave_incl_scan(x0 + x1, lane);
    const float total = __builtin_bit_cast(float, __builtin_amdgcn_readlane(__builtin_bit_cast(int, incl), 63));
    float c0, c1;
    if (dir == 0) { c1 = incl; c0 = incl - x1; } else { c0 = total - (incl - x1 - x0); c1 = total - (incl - x1); }
    hv[dir * 128 + 2 * lane] = c0; hv[dir * 128 + 2 * lane + 1] = c1;
    hv[256 + dir * 128 + 2 * lane] = d0; hv[256 + dir * 128 + 2 * lane + 1] = d1;
    if (lane == 0) hv[512 + dir] = total;
}
__device__ __forceinline__ bf16x8 scale_frag(bf16x8 f, const f32x4 w0, const f32x4 w1) {
    const u32x4 u = __builtin_bit_cast(u32x4, f);
    u32x4 r;
    r.x = cvt_pk_bf16(bflo(u.x) * w0[0], bfhi(u.x) * w0[1]); r.y = cvt_pk_bf16(bflo(u.y) * w0[2], bfhi(u.y) * w0[3]);
    r.z = cvt_pk_bf16(bflo(u.z) * w1[0], bfhi(u.z) * w1[1]); r.w = cvt_pk_bf16(bflo(u.w) * w1[2], bfhi(u.w) * w1[3]);
    return __builtin_bit_cast(bf16x8, r);
}
constexpr int ST_X256 = 576;

__device__ __forceinline__ void phase_c1(CP p, int l, unsigned char* lds_, int bid, int nb) {
    LAS unsigned char* lds = (LAS unsigned char*)lds_;
    LAS unsigned char* tile = lds;
    LAS float* wl = (LAS float*)(lds + 73216);
    const int tid = launder_tid();
    const bf16_t* proj = (const bf16_t*)(p->ws + WS_PROJ); bf16_t* mix = (bf16_t*)(p->ws + WS_HX);
#pragma unroll 1
    for (int u = bid; u < 256 + 512 + (l == DEPTH - 1 ? 0 : 16); u += nb) {
        int S, LEN, pstride, sstride, tok0, ch0;
        if (u < 256) { const int b = u >> 7, cs = (u >> 2) & 31, cc = u & 3; S = 2; LEN = 256; pstride = 64; sstride = 1; tok0 = b * SEG + CTXL + 2 * cs; ch0 = 256 + 64 * cc; }
        else if (u < 768) { const int v = u - 256; const int b = v >> 8, rg = (v >> 2) & 63, cc = v & 3; S = 4; LEN = 64; pstride = 1; sstride = 64; tok0 = b * SEG + CTXL + 256 * rg; ch0 = 64 * cc; }
        else { const int v = u - 768; const int b = v >> 3, cc = v & 7; S = 1; LEN = 256; pstride = 1; sstride = 0; tok0 = b * SEG; ch0 = 64 * cc; }
        const int LP = LEN + 30;
        { float tw[4];
#pragma unroll
          for (int it = 0; it < 4; ++it) { const int i = tid + NTHREADS * it; const int j = i >> 6, c = i & 63; tw[it] = j < 31 ? p->conv_w[((size_t)l * 31 + j) * 512 + ch0 + c] : p->conv_b[l * 512 + ch0 + c]; }
#pragma unroll
          for (int it = 0; it < 4; ++it) wl[tid + NTHREADS * it] = tw[it]; }
        for (int i = tid; i < S * 30 * 8; i += NTHREADS) { const int pc = i & 7, q = (i >> 3) % 30, sq = (i >> 3) / 30; const int pos = q < 15 ? q : LEN + q;
            unsigned zz; asm volatile("v_mov_b32 %0, 0" : "=v"(zz));
            *(LAS u32x4*)(tile + ((sq * LP + pos) * 64 + pc * 8) * 2) = (u32x4){zz, zz, zz, zz}; }
#pragma unroll 8
        for (int i = tid; i < S * LEN * 8; i += NTHREADS) { const int pc = i & 7, t = i >> 3; const int sq = t / LEN, pos = t - sq * LEN;
            const bf16_t* src = proj + (size_t)(tok0 + sq * sstride + pos * pstride) * NPROJ + ch0 + pc * 8;
            const u32x4 uv = *(const u32x4*)src, gv = *(const u32x4*)(src + 512);
            u32x4 o;
            o.x = cvt_pk_bf16(bflo(uv.x) * sigmoidf_(bflo(gv.x)), bfhi(uv.x) * sigmoidf_(bfhi(gv.x)));
            o.y = cvt_pk_bf16(bflo(uv.y) * sigmoidf_(bflo(gv.y)), bfhi(uv.y) * sigmoidf_(bfhi(gv.y)));
            o.z = cvt_pk_bf16(bflo(uv.z) * sigmoidf_(bflo(gv.z)), bfhi(uv.z) * sigmoidf_(bfhi(gv.z)));
            o.w = cvt_pk_bf16(bflo(uv.w) * sigmoidf_(bflo(gv.w)), bfhi(uv.w) * sigmoidf_(bfhi(gv.w)));
            *(LAS u32x4*)(tile + ((sq * LP + 15 + pos) * 64 + pc * 8) * 2) = o; }
        __syncthreads();
        const int noct = S * LEN / 8;
#pragma unroll 1
        for (int it = tid; it < noct * 32; it += NTHREADS) {
            const int cp = it & 31, oc = it >> 5; const int sq = oc / (LEN / 8), p0 = (oc - sq * (LEN / 8)) * 8;
            const LAS unsigned* base = (const LAS unsigned*)(tile + ((sq * LP + p0) * 64) * 2) + cp;
            float i0[38], i1[38];
#pragma unroll
            for (int k = 0; k < 38; ++k) { const unsigned w = base[k * 32]; i0[k] = bflo(w); i1[k] = bfhi(w); }
            float a0[8], a1[8];
            { const float b0 = wl[31 * 64 + 2 * cp], b1 = wl[31 * 64 + 2 * cp + 1];
#pragma unroll
              for (int i = 0; i < 8; ++i) { a0[i] = b0; a1[i] = b1; } }
#pragma unroll
            for (int j = 0; j < 31; ++j) { typedef float f32x2 __attribute__((ext_vector_type(2))); const f32x2 wj = *(const LAS f32x2*)(wl + j * 64 + 2 * cp); const float w0 = wj[0], w1 = wj[1];
#pragma unroll
                for (int i = 0; i < 8; ++i) { a0[i] += w0 * i0[i + j]; a1[i] += w1 * i1[i + j]; } }
#pragma unroll
            for (int i = 0; i < 8; ++i) { const int tok = tok0 + sq * sstride + (p0 + i) * pstride;
                *(unsigned*)(mix + (size_t)tok * 1024 + 512 + ch0 + 2 * cp) = cvt_pk_bf16(a0[i], a1[i]); }
        }
        __syncthreads();
    }
}
__device__ __forceinline__ void phase_c1_ln(CP p, int l, int bid, int nb) {
    const int tid = launder_tid(); const int lane = tid & 63, wave = tid >> 6;
    bf16_t* mix = (bf16_t*)(p->ws + WS_HX);
    const f32x4 g0 = *(const f32x4*)(p->conv_ln_g + l * 512 + lane * 8), g1 = *(const f32x4*)(p->conv_ln_g + l * 512 + lane * 8 + 4);
    const f32x4 b0 = *(const f32x4*)(p->conv_ln_b + l * 512 + lane * 8), b1 = *(const f32x4*)(p->conv_ln_b + l * 512 + lane * 8 + 4);
    const float gg[8] = {g0[0], g0[1], g0[2], g0[3], g1[0], g1[1], g1[2], g1[3]}, bb[8] = {b0[0], b0[1], b0[2], b0[3], b1[0], b1[1], b1[2], b1[3]};
    for (int r = bid * 8 + wave; r < R; r += nb * 8) {
        u32x4* ptr = (u32x4*)(mix + (size_t)r * 1024 + 512 + lane * 8);
        const u32x4 v = *ptr;
        float y[8] = {bflo(v.x), bfhi(v.x), bflo(v.y), bfhi(v.y), bflo(v.z), bfhi(v.z), bflo(v.w), bfhi(v.w)};
        float s = 0.f;
#pragma unroll
        for (int e = 0; e < 8; ++e) s += y[e];
        const float mu = wave_sum(s) * (1.f / 512.f);
        float q = 0.f;
#pragma unroll
        for (int e = 0; e < 8; ++e) { y[e] -= mu; q += y[e] * y[e]; }
        const float rstd = rsqrtf(wave_sum(q) * (1.f / 512.f) + 1e-5f);
        float o[8];
#pragma unroll
        for (int e = 0; e < 8; ++e) o[e] = siluf_(y[e] * rstd * gg[e] + bb[e]);
        *ptr = pack8(o);
    }
}
__device__ __forceinline__ void phase_s1(CP p, int l, unsigned char* lds_, int bid, int nb) {
    LAS unsigned char* lds = (LAS unsigned char*)lds_;
    LAS unsigned char* Bs = lds;
    LAS unsigned char* Xs = lds + 128 * ST_TR128;
    LAS float* wv = (LAS float*)(Xs + 128 * ST_X256);
    LAS float* hvs = wv + 8 * 128;
    LAS float* cwl = hvs + 4 * 520;
    const int tid = launder_tid(); const int lane = tid & 63, wave = __builtin_amdgcn_readfirstlane(tid >> 6);
    const bf16_t* proj = (const bf16_t*)(p->ws + WS_PROJ);
    const float* cw = p->ssd_conv_w + (size_t)l * 5 * 1024; const float* cbias = p->ssd_conv_b + (size_t)l * 1024;
    bf16_t* Sg = (bf16_t*)(p->ws + WS_S); float* DEC = (float*)(p->ws + WS_DEC);
    int cur_g = -1;
#pragma unroll 1
    for (int u = bid; u < NB * NCHUNK * 2; u += nb) {
        const int g = u & 1, c = (u >> 1) % NCHUNK, b = (u >> 1) / NCHUNK;
        const int row0 = b * SEG + c * 128;
        const bool lo_ok = !(c == 0 || c == 2), hi_ok = !(c == 1 || c == NCHUNK - 1);
        if (g != cur_g) { cur_g = g;
            float tw[5];
#pragma unroll
            for (int it = 0; it < 5; ++it) { const int i = tid + NTHREADS * it; const int j = i / 384, lc = i - j * 384; const int gch = lc < 128 ? 512 + g * 128 + lc : g * 256 + (lc - 128);
                tw[it] = i < 6 * 384 ? (j < 5 ? cw[j * 1024 + gch] : cbias[gch]) : 0.f; }
#pragma unroll
            for (int it = 0; it < 5; ++it) { const int i = tid + NTHREADS * it; if (i < 6 * 384) cwl[i] = tw[it]; } }
        const int hh = wave >> 1, dir = wave & 1, h = 4 * g + hh;
        u32x4 rb[8], rx0[8], rx1[8];
        conv_load(proj, row0, tid >> 4, 512 + g * 128 + (tid & 15) * 8, lo_ok, hi_ok, rb);
        conv_load(proj, row0, tid >> 5, g * 256 + (tid & 31) * 8, lo_ok, hi_ok, rx0);
        conv_load(proj, row0, (tid >> 5) + 16, g * 256 + (tid & 31) * 8, lo_ok, hi_ok, rx1);
        head_cums(p, l, row0, h, dir, lane, hvs + hh * 520);
        __syncthreads();
        {
            const LAS float* hv = hvs + hh * 520; const float tot = hv[512 + dir];
#pragma unroll
            for (int q = 0; q < 2; ++q) { const int lr = lane + 64 * q; wv[wave * 128 + lr] = __expf(tot - hv[dir * 128 + lr]) * hv[256 + dir * 128 + lr]; }
            if (lane == 0) DEC[((size_t)(b * 2 + dir) * NCHUNK + c) * 8 + h] = __expf(tot);
        }
        { float o[4][8];
          conv_compute(rb, cwl, 384, (tid & 15) * 8, o);
#pragma unroll
          for (int i = 0; i < 4; ++i) *(LAS u32x4*)(Bs + (4 * (tid >> 4) + i) * ST_TR128 + (tid & 15) * 16) = pack8(o[i]);
          conv_compute(rx0, cwl, 384, 128 + (tid & 31) * 8, o);
#pragma unroll
          for (int i = 0; i < 4; ++i) *(LAS u32x4*)(Xs + (4 * (tid >> 5) + i) * ST_X256 + (tid & 31) * 16) = pack8(o[i]);
          conv_compute(rx1, cwl, 384, 128 + (tid & 31) * 8, o);
#pragma unroll
          for (int i = 0; i < 4; ++i) *(LAS u32x4*)(Xs + (4 * ((tid >> 5) + 16) + i) * ST_X256 + (tid & 31) * 16) = pack8(o[i]); }
        __syncthreads();
        {
            f32x16 acc[2][4];
#pragma unroll
            for (int t = 0; t < 2; ++t)
#pragma unroll
                for (int q = 0; q < 4; ++q)
#pragma unroll
                    for (int e = 0; e < 16; ++e) acc[t][q][e] = 0.f;
#pragma unroll 2
            for (int kk = 0; kk < 8; ++kk) {
                const LAS float* wp = wv + wave * 128 + 16 * kk + 8 * (lane >> 5);
                const f32x4 w0 = *(const LAS f32x4*)wp, w1 = *(const LAS f32x4*)(wp + 4);
                bf16x8 af[2];
#pragma unroll
                for (int t = 0; t < 2; ++t) af[t] = scale_frag(tr_frag(Xs, ST_X256, 16 * kk, hh * 64 + 32 * t, lane), w0, w1);
#pragma unroll
                for (int q = 0; q < 4; ++q) { const bf16x8 bf = tr_frag(Bs, ST_TR128, 16 * kk, 32 * q, lane);
#pragma unroll
                    for (int t = 0; t < 2; ++t) acc[t][q] = __builtin_amdgcn_mfma_f32_32x32x16_bf16(bf, af[t], acc[t][q], 0, 0, 0); }
            }
            bf16_t* So = Sg + ((size_t)((b * 2 + dir) * NCHUNK + c) * 8 + h) * 8192 + (size_t)(lane & 31) * 128 + 4 * (lane >> 5);
#pragma unroll
            for (int t = 0; t < 2; ++t)
#pragma unroll
                for (int q = 0; q < 4; ++q)
#pragma unroll
                    for (int rg = 0; rg < 4; ++rg) { u32x2 pk; pk.x = cvt_pk_bf16(acc[t][q][4 * rg], acc[t][q][4 * rg + 1]); pk.y = cvt_pk_bf16(acc[t][q][4 * rg + 2], acc[t][q][4 * rg + 3]);
                        *(u32x2*)(So + (size_t)(32 * t) * 128 + 32 * q + 8 * rg) = pk; }
        }
        __syncthreads();
    }
}
__device__ __forceinline__ void phase_s2(CP p, int bid, int nb) {
    const int tid = launder_tid();
    const bf16_t* Sg = (const bf16_t*)(p->ws + WS_S); const float* DEC = (const float*)(p->ws + WS_DEC); bf16_t* HP = (bf16_t*)(p->ws + WS_HP);
    for (int idx = bid * NTHREADS + tid; idx < 2 * 2 * 8 * 64 * 64; idx += nb * NTHREADS) {
        const int n2 = idx & 63, pr = (idx >> 6) & 63, h = (idx >> 12) & 7, dir = (idx >> 15) & 1, b = idx >> 16;
        const size_t inner = (size_t)h * 8192 + pr * 128 + 2 * n2;
        const size_t cbase = (size_t)(b * 2 + dir) * NCHUNK;
        float s0 = 0.f, s1 = 0.f;
#pragma unroll 26
        for (int step = 0; step < NCHUNK; ++step) {
            const int c = dir == 0 ? step : (step < 2 ? 1 - step : NCHUNK + 1 - step);
            const size_t off = (cbase + c) * 65536 + inner;
            const unsigned sv = *(const unsigned*)(Sg + off); const float d = DEC[(cbase + c) * 8 + h];
            *(unsigned*)(HP + off) = cvt_pk_bf16(s0, s1);
            s0 = s0 * d + bflo(sv); s1 = s1 * d + bfhi(sv);
        }
    }
}
__device__ __forceinline__ void phase_s3(CP p, int l, unsigned char* lds_, int bid, int nb) {
    LAS unsigned char* lds = (LAS unsigned char*)lds_;
    LAS unsigned char* Cs = lds;
    LAS unsigned char* Bs = Cs + 128 * ST_ROW;
    LAS unsigned char* Mt = Bs;
    LAS unsigned char* Xs = Bs + 128 * ST_TR128;
    LAS unsigned char* Hf = Xs + 128 * ST_TR64;
    LAS unsigned char* Hb = Hf + 64 * ST_ROW;
    LAS float* hvs = (LAS float*)(Hb + 64 * ST_ROW);
    LAS float* ssqp = hvs + 4 * 520;
    LAS float* cwl = ssqp + 256;
    const int tid0 = launder_tid(); const int wave = __builtin_amdgcn_readfirstlane(tid0 >> 6);
    const bf16_t* proj = (const bf16_t*)(p->ws + WS_PROJ); bf16_t* mix = (bf16_t*)(p->ws + WS_HX);
    const float* cw = p->ssd_conv_w + (size_t)l * 5 * 1024; const float* cbias = p->ssd_conv_b + (size_t)l * 1024;
    const bf16_t* HP = (const bf16_t*)(p->ws + WS_HP); float* SSQ = (float*)(p->ws + WS_SSQ);
    int cur_g = -1;
    const int cskip = (l == DEPTH - 1) ? 2 : 0, cpb = NCHUNK - cskip;
    const int nunits = NB * cpb * 2, nfull = nunits - nunits % nb, nitems = nfull + (nunits - nfull) * 4;
#pragma unroll 1
    for (int it = bid; it < nitems; it += nb) {
        const int u = it < nfull ? it : nfull + ((it - nfull) >> 2);
        const int hh_lo = it < nfull ? 0 : ((it - nfull) & 3), hh_hi = it < nfull ? 4 : hh_lo + 1;
        const int g = u & 1, c = cskip + (u >> 1) % cpb, b = (u >> 1) / cpb;
        int tid = tid0; asm volatile("" : "+v"(tid));
        const int lane = tid & 63;
        const int row0 = b * SEG + c * 128;
        const bool lo_ok = !(c == 0 || c == 2), hi_ok = !(c == 1 || c == NCHUNK - 1);
        if (g != cur_g) { cur_g = g;
            float tw[6];
#pragma unroll
            for (int it = 0; it < 6; ++it) { const int i = tid + NTHREADS * it; const int j = i >> 9, lc = i & 511; const int gch = lc < 128 ? 768 + g * 128 + lc : (lc < 256 ? 512 + g * 128 + (lc - 128) : g * 256 + (lc - 256));
                tw[it] = j < 5 ? cw[j * 1024 + gch] : cbias[gch]; }
#pragma unroll
            for (int it = 0; it < 6; ++it) cwl[tid + NTHREADS * it] = tw[it]; }
        u32x4 rx[8];
        {
            u32x4 r0[8], r1[8];
            const int cg = tid & 31; const int gch = (cg < 16 ? 768 : 512) + g * 128 + (cg & 15) * 8;
            conv_load(proj, row0, tid >> 5, gch, lo_ok, hi_ok, r0);
            conv_load(proj, row0, (tid >> 5) + 16, gch, lo_ok, hi_ok, r1);
            head_cums(p, l, row0, 4 * g + (wave >> 1), wave & 1, lane, hvs + (wave >> 1) * 520);
            __syncthreads();
            float o[4][8];
            LAS unsigned char* dst = (cg < 16 ? Cs : Bs) + (cg & 15) * 16;
            conv_compute(r0, cwl, 512, cg * 8, o);
#pragma unroll
            for (int i = 0; i < 4; ++i) *(LAS u32x4*)(dst + (4 * (tid >> 5) + i) * ST_ROW) = pack8(o[i]);
            asm volatile("" ::: "memory");
            if (tid < 256) conv_load(proj, row0, tid >> 3, g * 256 + hh_lo * 64 + (tid & 7) * 8, lo_ok, hi_ok, rx);
            conv_compute(r1, cwl, 512, cg * 8, o);
#pragma unroll
            for (int i = 0; i < 4; ++i) *(LAS u32x4*)(dst + (4 * ((tid >> 5) + 16) + i) * ST_ROW) = pack8(o[i]);
            if (tid < 256) { conv_compute(rx, cwl, 512, 256 + hh_lo * 64 + (tid & 7) * 8, o);
#pragma unroll
                for (int i = 0; i < 4; ++i) *(LAS u32x4*)(Xs + (4 * (tid >> 3) + i) * ST_TR64 + (tid & 7) * 16) = pack8(o[i]); }
        }
        __syncthreads();
        const int lb = wave >> 1, hs = wave & 1;
        int ln = lane; asm volatile("" : "+v"(ln));
        f32x16 gacc[2];
#pragma unroll
        for (int t = 0; t < 2; ++t)
#pragma unroll
            for (int e = 0; e < 16; ++e) gacc[t][e] = 0.f;
#pragma unroll
        for (int kk = 0; kk < 8; ++kk) { const bf16x8 af = row_frag(Cs, ST_ROW, 32 * lb, 16 * kk, lane);
#pragma unroll
            for (int t = 0; t < 2; ++t) { const bf16x8 bf = row_frag(Bs, ST_ROW, 64 * hs + 32 * t, 16 * kk, lane);
                gacc[t] = __builtin_amdgcn_mfma_f32_32x32x16_bf16(af, bf, gacc[t], 0, 0, 0); } }
        u32x4 hreg[4];
        { const bf16_t* hp0 = HP + ((size_t)(b * 2 * NCHUNK + c) * 8 + 4 * g + hh_lo) * 8192;
#pragma unroll
          for (int q = 0; q < 4; ++q) { const int it = tid + 512 * q; hreg[q] = *(const u32x4*)(hp0 + (size_t)(it >> 10) * NCHUNK * 8 * 8192 + (it & 1023) * 8); } }
        __syncthreads();
#pragma unroll 1
        for (int hh = hh_lo; hh < hh_hi; ++hh) {
            const int h = 4 * g + hh; const LAS float* hv = hvs + hh * 520;
            asm volatile("" : "+v"(ln));
            const int ph = hs, pc = 32 * ph + (ln & 31);
#pragma unroll
            for (int t = 0; t < 2; ++t) {
                const int sc = 64 * hs + 32 * t + (ln & 31);
                const float cfs = hv[sc], cbs = hv[128 + sc], dfs = hv[256 + sc], dbs = hv[384 + sc];
#pragma unroll
                for (int rg = 0; rg < 4; ++rg) {
                    const int l0 = 32 * lb + 8 * rg + 4 * (ln >> 5);
                    const f32x4 cfl = *(const LAS f32x4*)(hv + l0), cbl = *(const LAS f32x4*)(hv + 128 + l0);
                    float m[4];
#pragma unroll
                    for (int e = 0; e < 4; ++e) { const int lr = l0 + e;
                        const float ff = lr >= sc ? __expf(cfl[e] - cfs) * dfs : 0.f;
                        const float fb = lr <= sc ? __expf(cbl[e] - cbs) * dbs : 0.f;
                        m[e] = gacc[t][4 * rg + e] * (ff + fb); }
                    u32x2 pk; pk.x = cvt_pk_bf16(m[0], m[1]); pk.y = cvt_pk_bf16(m[2], m[3]);
                    *(LAS u32x2*)(Mt + sc * ST_TR128 + l0 * 2) = pk;
                }
            }
#pragma unroll
            for (int q = 0; q < 4; ++q) { const int it = tid + 512 * q; const int q2 = it & 1023;
                *(LAS u32x4*)(((it >> 10) ? Hb : Hf) + (q2 >> 4) * ST_ROW + (q2 & 15) * 16) = hreg[q]; }
            if (hh + 1 < hh_hi) {
                const bf16_t* hp0 = HP + ((size_t)(b * 2 * NCHUNK + c) * 8 + h + 1) * 8192;
#pragma unroll
                for (int q = 0; q < 4; ++q) { const int it = tid + 512 * q; hreg[q] = *(const u32x4*)(hp0 + (size_t)(it >> 10) * NCHUNK * 8 * 8192 + (it & 1023) * 8); }
                if (tid < 256) conv_load(proj, row0, tid >> 3, g * 256 + (hh + 1) * 64 + (tid & 7) * 8, lo_ok, hi_ok, rx);
            }
            unsigned zraw[8];
#pragma unroll
            for (int ri = 0; ri < 16; ri += 2) { const int lr = 32 * lb + 8 * (ri >> 2) + 4 * (ln >> 5) + (ri & 3);
                const bf16_t* zp = proj + (size_t)(row0 + lr) * NPROJ + 1024 + h * 64 + pc;
                zraw[ri >> 1] = (unsigned)zp[0] | ((unsigned)zp[NPROJ] << 16); }
            __syncthreads();
            f32x16 ad, af_, ab_;
#pragma unroll
            for (int e = 0; e < 16; ++e) { ad[e] = 0.f; af_[e] = 0.f; ab_[e] = 0.f; }
#pragma unroll
            for (int kk = 0; kk < 8; ++kk) {
                const bf16x8 am = tr_frag(Mt, ST_TR128, 16 * kk, 32 * lb, lane);
                const bf16x8 bx = tr_frag(Xs, ST_TR64, 16 * kk, 32 * ph, lane);
                ad = __builtin_amdgcn_mfma_f32_32x32x16_bf16(am, bx, ad, 0, 0, 0);
                const bf16x8 ac = row_frag(Cs, ST_ROW, 32 * lb, 16 * kk, lane);
                const bf16x8 bhf = row_frag(Hf, ST_ROW, 32 * ph, 16 * kk, lane);
                const bf16x8 bhb = row_frag(Hb, ST_ROW, 32 * ph, 16 * kk, lane);
                af_ = __builtin_amdgcn_mfma_f32_32x32x16_bf16(ac, bhf, af_, 0, 0, 0);
                ab_ = __builtin_amdgcn_mfma_f32_32x32x16_bf16(ac, bhb, ab_, 0, 0, 0);
            }
            const float dsk = p->d_skip[l * 8 + h];
#pragma unroll
            for (int rg = 0; rg < 4; ++rg) {
                const int l0 = 32 * lb + 8 * rg + 4 * (ln >> 5);
                const f32x4 cfl = *(const LAS f32x4*)(hv + l0), cbl = *(const LAS f32x4*)(hv + 128 + l0);
#pragma unroll
                for (int e = 0; e < 4; ++e) { const int lr = l0 + e; const int ri = 4 * rg + e;
                    const float xs = bf2f(*(const LAS bf16_t*)(Xs + lr * ST_TR64 + pc * 2));
                    const float y = ad[ri] + __expf(cfl[e]) * af_[ri] + __expf(cbl[e]) * ab_[ri] + dsk * xs;
                    const float z = (ri & 1) ? bfhi(zraw[ri >> 1]) : bflo(zraw[ri >> 1]);
                    const float val = y * siluf_(z);
                    mix[(size_t)(row0 + lr) * 1024 + h * 64 + pc] = f2bf(val);
                    const float sq = half_sum32(val * val);
                    if ((ln & 31) == 31) ssqp[ph * 128 + lr] = sq;
                }
            }
            __syncthreads();
            if (tid < 128) SSQ[(size_t)(row0 + tid) * 8 + h] = ssqp[tid] + ssqp[128 + tid];
            if (hh + 1 < hh_hi && tid < 256) { float o[4][8];
                conv_compute(rx, cwl, 512, 256 + (hh + 1) * 64 + (tid & 7) * 8, o);
#pragma unroll
                for (int i = 0; i < 4; ++i) *(LAS u32x4*)(Xs + (4 * (tid >> 3) + i) * ST_TR64 + (tid & 7) * 16) = pack8(o[i]); }
        }
        __syncthreads();
    }
}
__device__ __forceinline__ void phase_r2(CP p, int l, unsigned char* lds_, int bid, int nb) {
    LAS unsigned char* lds = (LAS unsigned char*)lds_;
    LAS unsigned char* Wh = lds;
    LAS unsigned char* Xh = Wh + 32 * ST_H16;
    LAS float* gm = (LAS float*)(Xh + 16 * ST_H16);
    LAS float* sh = gm + 3 * 1024;
    LAS float* part = sh + 3 * 1024;
    LAS float* lgs = part + 8 * 16 * 32;
    LAS int* lcnt = (LAS int*)(lgs + 16 * 32);
    LAS int* lcls = lcnt + 64;
    LAS int* lrank = lcls + 512;
    LAS float* lcwa = (LAS float*)(lrank + 512);
    LAS float* lcwb = lcwa + 512;
    const int tid = launder_tid(); const int lane = tid & 63, wave = __builtin_amdgcn_readfirstlane(tid >> 6);
    const float* mod = (const float*)(p->ws + WS_MOD) + (size_t)l * 3 * 6144;
    {
        float tmp[8];
#pragma unroll
        for (int it = 0; it < 8; ++it) tmp[it] = p->w_rg[(size_t)l * 4096 + tid + NTHREADS * it];
#pragma unroll
        for (int it = 0; it < 8; ++it) { const int idx = tid + NTHREADS * it; *(LAS _Float16*)(Wh + (idx & 3) * ST_H16 + (idx >> 2) * 2) = (_Float16)tmp[it]; } }
#pragma unroll
    for (int hb = 0; hb < 2; ++hb) { float tmp[16];
#pragma unroll
        for (int it = 0; it < 16; ++it) tmp[it] = p->w_re[(size_t)l * 16384 + tid + NTHREADS * (16 * hb + it)];
#pragma unroll
        for (int it = 0; it < 16; ++it) { const int idx = tid + NTHREADS * (16 * hb + it); *(LAS _Float16*)(Wh + (4 + (idx & 15)) * ST_H16 + (idx >> 4) * 2) = (_Float16)tmp[it]; } }
    { unsigned zz; asm volatile("v_mov_b32 %0, 0" : "=v"(zz));
      for (int i = tid; i < 12 * 128; i += NTHREADS) { const int rw = 20 + i / 128, c16 = i % 128; *(LAS u32x4*)(Wh + rw * ST_H16 + c16 * 16) = (u32x4){zz, zz, zz, zz}; } }
    { float t0[6], t1[6], t2[6];
#pragma unroll
      for (int it = 0; it < 6; ++it) { const int idx = tid + NTHREADS * it; const int v = idx >> 10, k = idx & 1023; t0[it] = p->g_ffn[l * 1024 + k]; t1[it] = mod[v * 6144 + 4 * 1024 + k]; t2[it] = mod[v * 6144 + 3 * 1024 + k]; }
#pragma unroll
      for (int it = 0; it < 6; ++it) { const int idx = tid + NTHREADS * it; gm[idx] = t0[it] * (1.f + t1[it]); sh[idx] = t2[it]; } }
    if (tid < 64) lcnt[tid] = 0;
    __syncthreads();
    bf16_t* HM = (bf16_t*)(p->ws + WS_HX); float* CWLA = (float*)(p->ws + WS_CWLA); float* CWLB = (float*)(p->ws + WS_CWLB);
    int* gcount = (int*)(p->ws + WS_CTL) + l * 32; int* LIST = (int*)(p->ws + WS_LIST);
    const int rpb = (R + nb - 1) / nb, r0 = bid * rpb, r1 = (r0 + rpb) < R ? (r0 + rpb) : R;
    RowRaw xn[2];
#pragma unroll
    for (int q = 0; q < 2; ++q) if (r0 + 2 * wave + q < r1) row_load(p, 1, r0 + 2 * wave + q, lane, xn[q]);
#pragma unroll 1
    for (int t0r = r0; t0r < r1; t0r += 16) {
        f32x4 xv[2][4];
#pragma unroll
        for (int q = 0; q < 2; ++q) row_cvt(1, xn[q], xv[q]);
#pragma unroll
        for (int q = 0; q < 2; ++q) if (t0r + 16 + 2 * wave + q < r1) row_load(p, 1, t0r + 16 + 2 * wave + q, lane, xn[q]);
#pragma unroll
        for (int q = 0; q < 2; ++q) { const int rr = t0r + 2 * wave + q; const bool ok = rr < r1; const int v = row_v(ok ? rr : r0);
            float ss = 0.f;
#pragma unroll
            for (int j = 0; j < 4; ++j) ss += xv[q][j][0] * xv[q][j][0] + xv[q][j][1] * xv[q][j][1] + xv[q][j][2] * xv[q][j][2] + xv[q][j][3] * xv[q][j][3];
            ss = wave_sum(ss); const float rs = ok ? rsqrtf(ss * (1.f / 1024.f) + 1e-6f) : 0.f;
#pragma unroll
            for (int j = 0; j < 4; ++j) { const int k = 4 * lane + 256 * j; const f32x4 g4 = *(const LAS f32x4*)(gm + v * 1024 + k), s4 = *(const LAS f32x4*)(sh + v * 1024 + k);
                f32x4 hv = xv[q][j] * rs * g4 + s4; if (!ok) hv = hv * 0.f;
                u32x2 o; o.x = cvt_pk_bf16(hv[0], hv[1]); o.y = cvt_pk_bf16(hv[2], hv[3]);
                if (ok) *(u32x2*)(HM + (size_t)rr * 1024 + k) = o;
                u32x2 h16; h16.x = pack_f16(hv[0], hv[1]); h16.y = pack_f16(hv[2], hv[3]);
                *(LAS u32x2*)(Xh + (2 * wave + q) * ST_H16 + k * 2) = h16; } }
        __syncthreads();
        {
            f32x4 acc0 = {0.f, 0.f, 0.f, 0.f}, acc1 = {0.f, 0.f, 0.f, 0.f};
#pragma unroll
            for (int s4 = 0; s4 < 4; ++s4) { const int kb = (128 * wave + 32 * s4 + 8 * (lane >> 4)) * 2;
                const f16x8 a = *(const LAS f16x8*)(Xh + (lane & 15) * ST_H16 + kb);
                const f16x8 b0 = *(const LAS f16x8*)(Wh + (lane & 15) * ST_H16 + kb), b1 = *(const LAS f16x8*)(Wh + (16 + (lane & 15)) * ST_H16 + kb);
                acc0 = __builtin_amdgcn_mfma_f32_16x16x32_f16(a, b0, acc0, 0, 0, 0);
                acc1 = __builtin_amdgcn_mfma_f32_16x16x32_f16(a, b1, acc1, 0, 0, 0); }
#pragma unroll
            for (int e = 0; e < 4; ++e) { const int row = 4 * (lane >> 4) + e; part[(wave * 16 + row) * 32 + (lane & 15)] = acc0[e]; part[(wave * 16 + row) * 32 + 16 + (lane & 15)] = acc1[e]; }
        }
        __syncthreads();
        if (tid < 320) { const int row = tid / 20, n = tid - row * 20; float sacc = n < 4 ? p->b_rg[l * 4 + n] : p->b_re[l * 16 + n - 4];
#pragma unroll
            for (int w = 0; w < 8; ++w) sacc += part[(w * 16 + row) * 32 + n];
            lgs[row * 32 + n] = sacc; }
        __syncthreads();
        if (tid < 16) { const int rr = t0r + tid;
            if (rr < r1) {
                if (l == DEPTH - 1 && row_v(rr) == 2) lcls[rr - r0] = -1;
                else {
                    float lg[20];
#pragma unroll
                    for (int n = 0; n < 20; ++n) lg[n] = lgs[tid * 32 + n];
                    int gsel = 0; float gmax = lg[0];
#pragma unroll
                    for (int t = 1; t < 4; ++t) if (lg[t] > gmax) { gmax = lg[t]; gsel = t; }
                    float gden = 0.f;
#pragma unroll
                    for (int t = 0; t < 4; ++t) gden += __expf(lg[t] - gmax);
                    const float gprob = 1.f / gden;
                    float el[4];
#pragma unroll
                    for (int t = 0; t < 4; ++t) el[t] = gsel == 0 ? lg[4 + t] : (gsel == 1 ? lg[8 + t] : (gsel == 2 ? lg[12 + t] : lg[16 + t]));
                    int i0 = 0; float m0 = el[0];
#pragma unroll
                    for (int t = 1; t < 4; ++t) if (el[t] > m0) { m0 = el[t]; i0 = t; }
                    int i1 = -1; float m1 = -3.0e38f;
#pragma unroll
                    for (int t = 0; t < 4; ++t) if (t != i0 && el[t] > m1) { m1 = el[t]; i1 = t; }
                    const float w0 = gprob / (1.f + __expf(m1 - m0)), w1 = gprob - w0;
                    const int ea = i0 < i1 ? i0 : i1, eb = i0 < i1 ? i1 : i0;
                    const float cwa = i0 < i1 ? w0 : w1, cwb = i0 < i1 ? w1 : w0;
                    const int pidx = ea == 0 ? eb - 1 : (ea == 1 ? eb + 1 : 5);
                    const int cls = gsel * 6 + pidx;
                    const int rank = __hip_atomic_fetch_add(&lcnt[cls], 1, __ATOMIC_RELAXED, __HIP_MEMORY_SCOPE_WORKGROUP);
                    lcls[rr - r0] = cls; lrank[rr - r0] = rank; lcwa[rr - r0] = cwa; lcwb[rr - r0] = cwb;
                } } }
    }
    __syncthreads();
    if (tid < NCLS) lcnt[32 + tid] = atomicAdd(&gcount[tid], lcnt[tid]);
    __syncthreads();
    for (int idx = tid; idx < r1 - r0; idx += NTHREADS) { const int cl = lcls[idx]; if (cl < 0) continue; const int pos = lcnt[32 + cl] + lrank[idx]; const size_t li = (size_t)cl * R + pos;
        LIST[li] = r0 + idx; CWLA[li] = lcwa[idx]; CWLB[li] = lcwb[idx]; }
    __syncthreads();
}
__device__ __forceinline__ void phase_final(CP p, unsigned char* lds, int bid, int nb) {
    const int tid = launder_tid(); const int lane = tid & 63, wave = tid >> 6;
    const int qstep = nb * 8;
    RowRaw xn;
    { const int q = bid * 8 + wave; if (q < NB * SEQ) { const int b = q >= SEQ ? 1 : 0; row_load(p, 1, b * SEG + CTXL + (q - b * SEQ), lane, xn); } }
    for (int q = bid * 8 + wave; q < NB * SEQ; q += qstep) {
        f32x4* hr = (f32x4*)(p->out + (size_t)q * D);
        f32x4 xv[4]; float ss = 0.f;
        row_cvt(1, xn, xv);
        { const int qn = q + qstep; if (qn < NB * SEQ) { const int bn = qn >= SEQ ? 1 : 0; row_load(p, 1, bn * SEG + CTXL + (qn - bn * SEQ), lane, xn); } }
#pragma unroll
        for (int j = 0; j < 4; ++j) ss += xv[j][0] * xv[j][0] + xv[j][1] * xv[j][1] + xv[j][2] * xv[j][2] + xv[j][3] * xv[j][3];
        ss = wave_sum(ss); const float rs = rsqrtf(ss * (1.f / 1024.f) + 1e-6f);
#pragma unroll
        for (int j = 0; j < 4; ++j) { const f32x4 g4 = *(const f32x4*)(p->g_final + 4 * lane + 256 * j); hr[lane + 64 * j] = xv[j] * rs * g4; }
    }
}


#define XB_TMO      128
#define XB_XCNT(j)  (256  + 64 * (j))
#define XB_XSUB(j)  (1280 + 64 * (j))
#define XB_XGEN(j)  (2304 + 64 * (j))
#define XB_TOP      3328
#define XB_TOPGEN   3392
#define XCD_BAR_WORDS 3456
#define XB_SPIN_CAP (1u << 22)
__device__ __forceinline__ unsigned xb_ld(unsigned* p) { return __hip_atomic_load(p, __ATOMIC_RELAXED, __HIP_MEMORY_SCOPE_AGENT); }
__device__ __forceinline__ unsigned xb_add(unsigned* p, unsigned v) { return __hip_atomic_fetch_add(p, v, __ATOMIC_RELAXED, __HIP_MEMORY_SCOPE_AGENT); }
__device__ __forceinline__ unsigned xb_xcc_id() { return (unsigned)__builtin_amdgcn_s_getreg((3 << 11) | 20) & 0xFu; }
#define XB_SPIN(cond, bar) do { unsigned _sp = 0; while (cond) { __builtin_amdgcn_s_sleep(1); \
    if ((++_sp & 255u) == 0u) { if (xb_ld(&(bar)[XB_TMO])) break; if (_sp > XB_SPIN_CAP) { atomicAdd(&(bar)[XB_TMO], 1u); break; } } } } while (0)
struct XcdBarrier { unsigned* bar; unsigned x; volatile LAS unsigned* st; };
__device__ __forceinline__ XcdBarrier xcd_barrier_post(unsigned* bar, volatile LAS unsigned* st) {
    XcdBarrier b; b.bar = bar; b.x = xb_xcc_id(); b.st = st;
    if (threadIdx.x == 0) (void)xb_add(&bar[XB_XCNT(b.x)], 1u);
    return b;
}
__device__ __forceinline__ void xcd_barrier_complete(unsigned* bar, unsigned x, unsigned& nloc, unsigned& nx) {
    const unsigned G = gridDim.x * gridDim.y * gridDim.z;
    unsigned sum, cnt, mine, sp = 0u;
    for (;;) {
        sum = 0u; cnt = 0u; mine = 0u;
#pragma unroll
        for (unsigned j = 0; j < 16; ++j) { const unsigned c = xb_ld(&bar[XB_XCNT(j)]); sum += c; cnt += (c > 0u) ? 1u : 0u; mine = (j == x) ? c : mine; }
        if (sum == G) break;
        __builtin_amdgcn_s_sleep(1);
        if ((++sp & 255u) == 0u) { if (xb_ld(&bar[XB_TMO])) break; if (sp > XB_SPIN_CAP) { atomicAdd(&bar[XB_TMO], 1u); break; } }
    }
    nloc = mine > 0u ? mine : 1u; nx = cnt > 0u ? cnt : 1u;
}
__device__ __forceinline__ void xcd_barrier(const XcdBarrier& b) {
    asm volatile("s_waitcnt vmcnt(0)" ::: "memory");
    __syncthreads();
    if (threadIdx.x == 0) {
        unsigned* bar = b.bar;
        __builtin_amdgcn_s_waitcnt(0);
        unsigned nloc = b.st[0], nx = b.st[1];
        if (nloc == 0u) { xcd_barrier_complete(bar, b.x, nloc, nx); b.st[0] = nloc; b.st[1] = nx; }
        const unsigned old = xb_add(&bar[XB_XSUB(b.x)], 1u);
        const unsigned gen = old / nloc;
        if (old + 1u == (gen + 1u) * nloc) {
            __builtin_amdgcn_fence(__ATOMIC_RELEASE, "agent");
            asm volatile("s_waitcnt vmcnt(0)" ::: "memory");
            const unsigned og = xb_add(&bar[XB_TOP], 1u);
            const unsigned tg = og / nx;
            if (og + 1u == (tg + 1u) * nx) xb_add(&bar[XB_TOPGEN], 1u);
            else XB_SPIN(xb_ld(&bar[XB_TOPGEN]) == tg, bar);
            __builtin_amdgcn_fence(__ATOMIC_ACQUIRE, "agent");
            xb_add(&bar[XB_XGEN(b.x)], 1u);
            asm volatile("s_waitcnt vmcnt(0)" ::: "memory");
        } else {
            XB_SPIN(xb_ld(&bar[XB_XGEN(b.x)]) == gen, bar);
            __builtin_amdgcn_fence(__ATOMIC_ACQUIRE, "agent");
            asm volatile("s_waitcnt vmcnt(0)" ::: "memory");
        }
    }
    __syncthreads();
}

#ifndef TIMING_A
#define TIMING_A -1
#endif
#ifndef TIMING_B
#define TIMING_B -1
#endif
#ifndef PHASE_MASK
#define PHASE_MASK 0xFFFFF
#endif
#define PM(i) ((PHASE_MASK >> (i)) & 1)
#ifndef REPEAT_MASK
#define REPEAT_MASK 0
#endif
#define RP(i) for (int rep_ = 0; rep_ < 1 + ((REPEAT_MASK >> (i)) & 1); ++rep_)
constexpr int PH_PER_LAYER = 9, NPHASES = 1 + DEPTH * PH_PER_LAYER + 1;
__global__ void __launch_bounds__(NTHREADS, 2) mk_fwd(Args args) {
    extern __shared__ __attribute__((aligned(16))) unsigned char lds[];
    cg::grid_group grid = cg::this_grid();
    const __attribute__((address_space(4))) Args* ap = (const __attribute__((address_space(4))) Args*)__builtin_amdgcn_kernarg_segment_ptr();
    const int lo = ap->lo, hi = ap->hi;
    LAS unsigned char* ldsl = (LAS unsigned char*)lds;
    volatile LAS unsigned* xbst = (volatile LAS unsigned*)(ldsl + LDS_BYTES - 16);
    if (threadIdx.x < 4) xbst[threadIdx.x] = 0u;
    __syncthreads();
    (void)xcd_barrier_post((unsigned*)(ap->p.ws + WS_BAR), xbst);
    if (TIMING_A >= 0 && blockIdx.x == 0 && threadIdx.x == 0) ((unsigned long long*)(ap->p.ws + WS_TS))[lo] = __builtin_amdgcn_s_memrealtime();
    for (int ph = lo; ph < hi; ++ph) {
        CP p = launder(&ap->p);
        int bid = blockIdx.x, nb = gridDim.x; asm volatile("" : "+s"(bid), "+s"(nb));
        if (ph == 0) { if (PM(0)) RP(0) phase_wprep(p, lds, 0, WPREP_ITEMS_PER_LAYER, bid, nb); if (PM(1)) RP(1) phase_adaln(p, lds, bid, nb); }
        else if (ph == NPHASES - 1) { if (PM(12)) phase_final(p, lds, bid, nb); }
        else {
            const int l = (ph - 1) / PH_PER_LAYER, s = (ph - 1) % PH_PER_LAYER;
            if (s == 0) { if (PM(2)) RP(2) { if (rep_ == 0 || l == 0) phase_r1(p, l, lds, bid, nb); } }
            else if (s == 1) { if (PM(3)) RP(3) {
                pg8::DenseSched S; S.init(p->ws + WS_HX, (const bf16_t*)(p->ws + WS_WTIN) + (size_t)l * DIN * 1024, R, NPROJ, 1024, 1024, 1024, nb, bid);
                EpiProj E{(bf16_t*)(p->ws + WS_PROJ)};
                pg8::gemm_phase<EpiProj, pg8::DenseSched, false>(ldsl, 1024, 1024, 1024, S, E);
                if (l == 0 && DEPTH > 1) { const int extra = S.nwg % nb;
                    if (extra > 0 && bid >= extra) phase_wprep(p, lds, WPREP_ITEMS_PER_LAYER, WPREP_ITEMS_PER_LAYER + 1800, bid - extra, nb - extra);
                    else if (extra == 0) phase_wprep(p, lds, WPREP_ITEMS_PER_LAYER, WPREP_ITEMS_PER_LAYER + 1800, bid, nb); }
            } }
            else if (s == 2) { if (PM(4)) RP(4) phase_c1(p, l, lds, bid, nb); if (PM(5)) RP(5) phase_s1(p, l, lds, bid, nb); }
            else if (s == 3) { if (PM(6)) RP(6) phase_s2(p, bid, nb); if (PM(4)) phase_c1_ln(p, l, bid, nb); }
            else if (s == 4) { if (PM(7)) RP(7) phase_s3(p, l, lds, bid, nb); }
            else if (s == 5) { if (PM(8)) RP(8) { if (rep_ == 0 || l == 0) {
                pg8::DenseSched S; S.init(p->ws + WS_HX, (const bf16_t*)(p->ws + WS_WTOUT) + (size_t)l * 1024 * 1024, R, 1024, 1024, 1024, 1024, nb, bid, l == DEPTH - 1);
                EpiResid<0> E{p->ctx, p->x, (bf16_t*)(p->ws + WS_H), (const float*)(p->ws + WS_MOD) + (size_t)l * 3 * 6144, (const float*)(p->ws + WS_SSQ)};
                pg8::gemm_phase<EpiResid<0>, pg8::DenseSched, false>(ldsl, 1024, 1024, 1024, S, E);
                if (l == 0 && DEPTH > 1 && rep_ == 0) { const int extra = S.nwg % nb;
                    if (extra > 0 && bid >= extra) phase_wprep(p, lds, WPREP_ITEMS_PER_LAYER + 1800, 2 * WPREP_ITEMS_PER_LAYER, bid - extra, nb - extra);
                    else if (extra == 0) phase_wprep(p, lds, WPREP_ITEMS_PER_LAYER + 1800, 2 * WPREP_ITEMS_PER_LAYER, bid, nb); }
            } } }
            else if (s == 6) { if (PM(9)) phase_r2(p, l, lds, bid, nb); }
            else if (s == 7) { if (PM(10)) RP(10) {
                LAS int* tab = (LAS int*)(ldsl + MISC_OFF); moe_table(p, l, tab);
                MoeSched S{tab, (const int*)(p->ws + WS_LIST), (const char*)(p->ws + WS_HX), (const char*)(p->ws + WS_WTGU), 0, l, nb, bid};
                EpiUp E{(bf16_t*)(p->ws + WS_HID), (const float*)(p->ws + WS_CWLA), (const float*)(p->ws + WS_CWLB)};
                pg8::gemm_phase<EpiUp, MoeSched, true>(ldsl, 1024, 1024, 1024, S, E);
            } }
            else { if (PM(11)) RP(11) {
                LAS int* tab = (LAS int*)(ldsl + MISC_OFF); moe_table(p, l, tab);
                MoeSched S{tab, (const int*)(p->ws + WS_LIST), (const char*)(p->ws + WS_HID), (const char*)(p->ws + WS_WTD), 1, l, nb, bid};
                EpiDown E{(bf16_t*)(p->ws + WS_H), (const int*)(p->ws + WS_LIST), (const float*)(p->ws + WS_MOD) + (size_t)l * 3 * 6144 + 5 * 1024};
                pg8::gemm_phase<EpiDown, MoeSched, false>(ldsl, 512, 256, 512, S, E);
            } }
        }
        if (ph + 1 < hi) { if (hi < 0) grid.sync();   else { XcdBarrier xb; xb.bar = (unsigned*)(launder(&ap->p)->ws + WS_BAR); xb.x = xb_xcc_id(); xb.st = (volatile LAS unsigned*)(ldsl + LDS_BYTES - 16); xcd_barrier(xb); }
            if (TIMING_A >= 0 && blockIdx.x == 0 && threadIdx.x == 0) ((unsigned long long*)(launder(&ap->p)->ws + WS_TS))[ph + 1] = __builtin_amdgcn_s_memrealtime(); }
    }
#if TIMING_A >= 0
    {
        XcdBarrier xb; xb.bar = (unsigned*)(launder(&ap->p)->ws + WS_BAR); xb.x = xb_xcc_id(); xb.st = (volatile LAS unsigned*)(ldsl + LDS_BYTES - 16); xcd_barrier(xb);
        if (blockIdx.x == 0 && threadIdx.x == 0) ((unsigned long long*)(launder(&ap->p)->ws + WS_TS))[hi] = __builtin_amdgcn_s_memrealtime();
        xcd_barrier(xb);
        const unsigned long long* ts = (const unsigned long long*)(launder(&ap->p)->ws + WS_TS);
        const float ta = (float)(ts[TIMING_A + 1] - ts[TIMING_A]) * 0.01f, tb = (float)(ts[TIMING_B + 1] - ts[TIMING_B]) * 0.01f;
        float* o = launder(&ap->p)->out; const float sc = 1.f + ta * 0.001f;
        for (size_t i = (size_t)blockIdx.x * NTHREADS + threadIdx.x; i < (size_t)NB * SEQ * D; i += (size_t)gridDim.x * NTHREADS) o[i] = o[i] * sc + (i == 0 ? tb * 0.1f : 0.f);
    }
#endif
}

extern "C" void kernel_launch(void* const* d_in, const int* in_sizes, int n_in, void* d_out, int out_size, void* d_ws, size_t ws_size, hipStream_t stream) {
    static int grid = 0;
    if (grid == 0) {
        if (n_in != 28 || ws_size < WS_END) { fprintf(stderr, "kernel_launch: unexpected n_in %d or ws_size %zu (< %zu)\n", n_in, ws_size, (size_t)WS_END); grid = -1; return; }
        int dev = 0, cus = 0, per_cu = 0;
        hipGetDevice(&dev); hipDeviceGetAttribute(&cus, hipDeviceAttributeMultiprocessorCount, dev);
        if (hipFuncSetAttribute((const void*)mk_fwd, hipFuncAttributeMaxDynamicSharedMemorySize, LDS_BYTES) != hipSuccess) { fprintf(stderr, "kernel_launch: hipFuncSetAttribute failed\n"); grid = -1; return; }
        if (hipOccupancyMaxActiveBlocksPerMultiprocessor(&per_cu, (const void*)mk_fwd, NTHREADS, LDS_BYTES) != hipSuccess || per_cu < 1) { fprintf(stderr, "kernel_launch: occupancy query says %d\n", per_cu); (void)hipGetLastError(); grid = -1; return; }
        grid = cus;
    }
    if (grid < 0) return;
    (void)hipMemsetAsync((char*)d_ws + WS_CTL, 0, WS_CTL_BYTES, stream);
    Args a{};
    const float** pp = (const float**)&a.p;
    for (int i = 0; i < 28; ++i) pp[i] = (const float*)d_in[i];
    a.p.out = (float*)d_out; a.p.ws = (unsigned char*)d_ws;
#if PER_PHASE_LAUNCH
    for (int ph = 0; ph < NPHASES; ++ph) {
        a.lo = ph; a.hi = ph + 1; void* kargs[] = {&a};
        hipError_t e = hipLaunchCooperativeKernel((const void*)mk_fwd, dim3(grid), dim3(NTHREADS), kargs, LDS_BYTES, stream);
        if (e != hipSuccess) { fprintf(stderr, "kernel_launch: launch of phase %d failed: %s\n", ph, hipGetErrorString(e)); break; }
    }
#else
    a.lo = 0; a.hi = NPHASES; void* kargs[] = {&a};
    hipError_t e = hipLaunchCooperativeKernel((const void*)mk_fwd, dim3(grid), dim3(NTHREADS), kargs, LDS_BYTES, stream);
    if (e != hipSuccess) fprintf(stderr, "kernel_launch: cooperative launch failed: %s (grid %d)\n", hipGetErrorString(e), grid);
#endif
}
```

```cpp
#include <hip/hip_runtime.h>
#include <hip/hip_cooperative_groups.h>
#include <cstdio>
namespace cg = cooperative_groups;

#ifndef PER_PHASE_LAUNCH
#define PER_PHASE_LAUNCH 0
#endif

#ifndef S3REP
#define S3REP 0
#endif
#define S3R(i) for (int r3_ = 0; r3_ < 1 + ((S3REP >> (i)) & 1); ++r3_)
#define LAS __attribute__((address_space(3)))
typedef unsigned short bf16_t;
typedef short bf16x8 __attribute__((ext_vector_type(8)));
typedef float f32x4 __attribute__((ext_vector_type(4)));
typedef unsigned u32x4 __attribute__((ext_vector_type(4)));
typedef unsigned u32x2 __attribute__((ext_vector_type(2)));

constexpr int D = 1024, NB = 2, SEQ = 16384, CTXL = 256, SEG = SEQ + CTXL, R = NB * SEG, DEPTH = 2;
constexpr int NPROJ = 2560, DIN = 2576;
constexpr int NTHREADS = 512;
constexpr int LDS_BYTES = 163840;
constexpr int MISC_OFF = 131072;
constexpr int NCLS = 24;

constexpr size_t al256(size_t x) { return (x + 255) & ~size_t(255); }
constexpr size_t WS_CTL = 0;
constexpr size_t WS_TS = 2048;
constexpr size_t WS_BAR = 4096;
constexpr size_t WS_CTL_BYTES = 32768;
constexpr size_t WS_MOD = WS_CTL_BYTES;
constexpr size_t WS_WTIN = WS_MOD + al256((size_t)2 * 3 * 6144 * 4);
constexpr size_t WS_WTOUT = WS_WTIN + al256((size_t)2 * DIN * 1024 * 2);
constexpr size_t WS_WTGU = WS_WTOUT + al256((size_t)2 * 1024 * 1024 * 2);
constexpr size_t WS_WTD = WS_WTGU + al256((size_t)2 * 16 * 512 * 1024 * 2);
constexpr size_t WS_H = WS_WTD + al256((size_t)2 * 16 * 1024 * 256 * 2);
constexpr size_t WS_HX = WS_H + al256((size_t)R * 1024 * 2);
constexpr size_t WS_PROJ = WS_HX + al256((size_t)R * 1024 * 2);
constexpr size_t WS_DT = WS_PROJ + al256((size_t)R * NPROJ * 2);
constexpr size_t WS_POS = WS_DT + al256((size_t)R * 16 * 4);
constexpr size_t WS_LIST = WS_POS + al256((size_t)2 * R * 4);
constexpr size_t WS_CWLA = WS_LIST + al256((size_t)NCLS * R * 4);
constexpr size_t WS_CWLB = WS_CWLA + al256((size_t)NCLS * R * 4);
constexpr size_t WS_BIG = WS_CWLB + al256((size_t)NCLS * R * 4);
constexpr size_t WS_Y = WS_PROJ;
constexpr size_t WS_S = WS_BIG;
constexpr size_t WS_HP = WS_S + al256((size_t)2 * 2 * 130 * 8 * 8192 * 2);
constexpr size_t WS_DEC = WS_HP + al256((size_t)2 * 2 * 130 * 8 * 8192 * 2);
constexpr size_t WS_SSQ = WS_DEC + al256((size_t)2 * 2 * 130 * 8 * 4);
constexpr size_t WS_HID = WS_S;
constexpr size_t WS_END = WS_SSQ + al256((size_t)R * 8 * 4);
static_assert((size_t)(R + NCLS * 256) * 512 * 2 <= (size_t)2 * 2 * 130 * 8 * 8192 * 2, "hid alias");
static_assert(WS_END <= (size_t)512 * 1024 * 1024, "workspace");

struct Params {
    const float *x, *c, *ctx, *c_ctx, *w_ada, *b_ada, *g_mix, *g_ffn, *w_in, *conv_w, *conv_b, *conv_ln_g, *conv_ln_b, *ssd_conv_w, *ssd_conv_b,
        *dt_bias, *a_log, *d_skip, *ssd_norm_g, *w_out, *w_rg, *b_rg, *w_re, *b_re, *w_gate, *w_up, *w_down, *g_final;
    float* out; unsigned char* ws;
};
struct Args { Params p; int lo, hi; };
typedef const __attribute__((address_space(4))) Params* CP;
__device__ __forceinline__ CP launder(CP p) { asm volatile("" : "+s"(p)); return p; }
__device__ __forceinline__ int launder_tid() { int t = threadIdx.x; asm volatile("" : "+v"(t)); return t; }

__device__ __forceinline__ unsigned cvt_pk_bf16(float lo, float hi) { unsigned r; asm("v_cvt_pk_bf16_f32 %0, %1, %2" : "=v"(r) : "v"(lo), "v"(hi)); return r; }
__device__ __forceinline__ float bf2f(unsigned b) { return __uint_as_float(b << 16); }
__device__ __forceinline__ float bflo(unsigned w) { return __uint_as_float(w << 16); }
__device__ __forceinline__ float bfhi(unsigned w) { return __uint_as_float(w & 0xffff0000u); }
__device__ __forceinline__ bf16_t f2bf(float f) { return (bf16_t)(cvt_pk_bf16(f, 0.f) & 0xffffu); }
#define DPP_ADD(v, ctrl, rm) ((v) + __builtin_bit_cast(float, __builtin_amdgcn_update_dpp(0, __builtin_bit_cast(int, (v)), (ctrl), (rm), 0xF, true)))
__device__ __forceinline__ float row_sum16(float v) {
    v = DPP_ADD(v, 0xB1, 0xF);
    v = DPP_ADD(v, 0x4E, 0xF);
    v = DPP_ADD(v, 0x141, 0xF);
    v = DPP_ADD(v, 0x140, 0xF);
    return v;
}
__device__ __forceinline__ float half_sum32(float v) { v = row_sum16(v); v = DPP_ADD(v, 0x142, 0xA); return v; }
__device__ __forceinline__ float wave_sum(float v) {
    v = half_sum32(v); v = DPP_ADD(v, 0x143, 0xC);
    return __builtin_bit_cast(float, __builtin_amdgcn_readlane(__builtin_bit_cast(int, v), 63));
}
__device__ __forceinline__ float sigmoidf_(float x) { return 1.f / (1.f + __expf(-x)); }
__device__ __forceinline__ float siluf_(float x) { return x / (1.f + __expf(-x)); }
__device__ __forceinline__ float softplusf_(float x) { return fmaxf(x, 0.f) + log1pf(expf(-fabsf(x))); }

__device__ __forceinline__ int row_b(int r) { return r >= SEG ? 1 : 0; }
__device__ __forceinline__ int row_i(int r) { return r >= SEG ? r - SEG : r; }
__device__ __forceinline__ int row_v(int r) { const int i = row_i(r); return i < CTXL ? 2 : row_b(r); }
__device__ __forceinline__ const float* xin_ptr(const float* ctx, const float* x, int r) {
    const int b = row_b(r), i = row_i(r);
    return i < CTXL ? ctx + (size_t)(b * CTXL + i) * D : x + (size_t)(b * SEQ + i - CTXL) * D;
}
struct RowRaw { f32x4 f[4]; u32x2 h[4]; };
__device__ __forceinline__ void row_load(CP p, int l, int r, int lane, RowRaw& rr) {
    if (l == 0) { const f32x4* hr = (const f32x4*)xin_ptr(p->ctx, p->x, r);
#pragma unroll
        for (int j = 0; j < 4; ++j) rr.f[j] = hr[lane + 64 * j]; }
    else { const u32x2* hr = (const u32x2*)((const bf16_t*)(p->ws + WS_H) + (size_t)r * D);
#pragma unroll
        for (int j = 0; j < 4; ++j) rr.h[j] = hr[lane + 64 * j]; }
}
__device__ __forceinline__ void row_cvt(int l, const RowRaw& rr, f32x4 (&xv)[4]) {
#pragma unroll
    for (int j = 0; j < 4; ++j) xv[j] = l == 0 ? rr.f[j] : (f32x4){bflo(rr.h[j].x), bfhi(rr.h[j].x), bflo(rr.h[j].y), bfhi(rr.h[j].y)};
}
namespace pg8 {
constexpr int BM = 256, BK = 64, HALF = 128, HTB = HALF * BK * 2, STAGE_BYTES = 8 * HTB, NXCD = 8, WGM = 8;
__device__ __forceinline__ int lds_byte(int r, int c) { const int st = (r >> 4) * 2 + (c >> 5), rr = r & 15, cc = c & 31, ob = rr * 64 + cc * 2; return st * 1024 + (ob ^ (((ob >> 9) & 1) << 5)); }
__device__ __forceinline__ void stage_rc(int b, int& Rr, int& Cc) { const int st = b / 1024, sb = b % 1024, swz = sb ^ (((sb >> 9) & 1) << 5); Rr = (st >> 1) * 16 + swz / 64; Cc = (st & 1) * 32 + (swz % 64) / 2; }
__device__ __forceinline__ int perm32(int rho) { const int n = rho >> 4, i = rho & 15; return 8 * (i >> 2) + 4 * n + (i & 3); }

struct Unit {
    const char* a0;
    const char* b0;
    const char* b1;
    int i0, i1, i2, i3, i4, pad;
};

template <class Epi, class Sched, bool GATHER>
__device__ __forceinline__ void gemm_phase(LAS unsigned char* lds, const int lda, const int ldb, const int K, const Sched& S, const Epi& E) {
    const int tid = launder_tid(); const int wid = __builtin_amdgcn_readfirstlane(tid >> 6), lane = tid & 63, wr = wid >> 2, wc = wid & 3, fr = lane & 15, fq = lane >> 4;
    const int nt = K / BK, ks = nt >> 1;
    int Rr[2], Cc[2];
    unsigned voffB[2];
#pragma unroll
    for (int i = 0; i < 2; ++i) { stage_rc(tid * 16 + i * 8192, Rr[i], Cc[i]); const int Rb = Epi::PERM ? ((Rr[i] & ~31) + perm32(Rr[i] & 31)) : Rr[i];
        voffB[i] = (unsigned)(Rb * ldb + Cc[i]) * 2u; }
    const size_t kstep = (size_t)(BK * 2);
    const size_t hstepB = (size_t)HALF * ldb * 2;
    const unsigned ldsw = (unsigned)wid * 1024u;
    const unsigned ldsbase = (unsigned)(unsigned long)lds;
    const int aoff = lds_byte(wr * 64 + fr, fq * 8), boff = lds_byte(wc * 32 + fr, fq * 8);
#define PG8_SA(b, h) (((b) * 2 + (h)) * HTB)
#define PG8_SB(b, h) ((4 + (b) * 2 + (h)) * HTB)
#define PG8_STAGE2(bufoff, gbase, v0, v1) do { unsigned keep_; \
        asm volatile("s_mov_b32 %0, m0\n\ts_mov_b32 m0, %1\n\ts_nop 4\n\tglobal_load_lds_dwordx4 %2, %4\n\ts_add_u32 m0, m0, 0x2000\n\ts_nop 0\n\tglobal_load_lds_dwordx4 %3, %4\n\ts_mov_b32 m0, %0" \
            : "=&s"(keep_) : "s"(ldsbase + (unsigned)(bufoff) + ldsw), "v"(v0), "v"(v1), "s"(gbase) : "memory", "scc"); } while (0)
#define PG8_LDA(dst, b, h) do { _Pragma("unroll") for (int m = 0; m < 4; ++m) _Pragma("unroll") for (int k = 0; k < 2; ++k) dst[m][k] = *(const LAS bf16x8*)(lds + PG8_SA(b, h) + aoff + m * 2048 + k * 1024); } while (0)
#define PG8_LDB(dst, b, h) do { _Pragma("unroll") for (int n = 0; n < 2; ++n) _Pragma("unroll") for (int k = 0; k < 2; ++k) dst[n][k] = *(const LAS bf16x8*)(lds + PG8_SB(b, h) + boff + n * 2048 + k * 1024); } while (0)
#define PG8_MMA(ai, bj, At, Bt) do { __builtin_amdgcn_s_setprio(1); _Pragma("unroll") for (int m = 0; m < 4; ++m) _Pragma("unroll") for (int n = 0; n < 2; ++n) _Pragma("unroll") for (int k = 0; k < 2; ++k) \
        acc[ai][bj][m][n] = __builtin_amdgcn_mfma_f32_16x16x32_bf16(Bt[n][k], At[m][k], acc[ai][bj][m][n], 0, 0, 0); __builtin_amdgcn_s_setprio(0); } while (0)
#define PG8_WAIT_V(n) asm volatile("s_waitcnt vmcnt(" #n ")" ::: "memory")
#define PG8_WAIT_L(n) asm volatile("s_waitcnt lgkmcnt(" #n ")" ::: "memory")
#define PG8_BAR __builtin_amdgcn_s_barrier()
#define PG8_SCHED __builtin_amdgcn_sched_barrier(0)
#define PG8_BP(u, tt) ((tt) < ks ? (u).b0 + (size_t)(tt) * kstep : (u).b1 + (size_t)((tt) - ks) * kstep)
    Unit cur, nxt; int ui = 0;
    if (!S.get(0, cur)) return;
    unsigned c00, c01, c10, c11, n00, n01, n10, n11;
    if (GATHER) {
        c00 = (unsigned)(S.arow(cur, Rr[0]) * lda + Cc[0]) * 2u; c01 = (unsigned)(S.arow(cur, Rr[1]) * lda + Cc[1]) * 2u;
        c10 = (unsigned)(S.arow(cur, HALF + Rr[0]) * lda + Cc[0]) * 2u; c11 = (unsigned)(S.arow(cur, HALF + Rr[1]) * lda + Cc[1]) * 2u;
    } else {
        c00 = (unsigned)(Rr[0] * lda + Cc[0]) * 2u; c01 = (unsigned)(Rr[1] * lda + Cc[1]) * 2u;
        c10 = (unsigned)((HALF + Rr[0]) * lda + Cc[0]) * 2u; c11 = (unsigned)((HALF + Rr[1]) * lda + Cc[1]) * 2u;
    }
    n00 = c00; n01 = c01; n10 = c10; n11 = c11;
    f32x4 acc[2][2][4][2];
    float zr; asm volatile("v_mov_b32 %0, 0" : "=v"(zr));
#pragma unroll
    for (int a = 0; a < 2; ++a)
#pragma unroll
        for (int b = 0; b < 2; ++b)
#pragma unroll
            for (int m = 0; m < 4; ++m)
#pragma unroll
                for (int n = 0; n < 2; ++n) acc[a][b][m][n] = (f32x4){zr, zr, zr, zr};
    bf16x8 At[4][2], B0[2][2], B1[2][2];
    const char* cA = cur.a0;
    {
        const char* pb0 = PG8_BP(cur, 0); const char* pb1 = PG8_BP(cur, 1);
        PG8_STAGE2(PG8_SB(0, 0), pb0, voffB[0], voffB[1]); PG8_STAGE2(PG8_SA(0, 0), cA, c00, c01);
        PG8_STAGE2(PG8_SB(0, 1), pb0 + hstepB, voffB[0], voffB[1]); PG8_STAGE2(PG8_SA(0, 1), cA, c10, c11);
        if (wr == 1) PG8_BAR;
        PG8_WAIT_V(4); PG8_BAR;
        PG8_STAGE2(PG8_SB(1, 0), pb1, voffB[0], voffB[1]); PG8_STAGE2(PG8_SA(1, 0), cA + kstep, c00, c01);
        PG8_STAGE2(PG8_SB(1, 1), pb1 + hstepB, voffB[0], voffB[1]);
        PG8_WAIT_V(6); PG8_BAR;
    }
    for (;;) {
        const bool has_next = S.get(ui + 1, nxt);
        if (!has_next) nxt = cur;
        LAS int* tokb = (LAS int*)(lds + MISC_OFF + 1024) + ((ui + 1) & 1) * 256;
        if (GATHER) {
            n00 = c00; n01 = c01; n10 = c10; n11 = c11;
            if (has_next && wid == 0) {
                const char* src = (const char*)S.rows_ptr(nxt); unsigned keep_;
                asm volatile("s_mov_b32 %0, m0\n\ts_mov_b32 m0, %1\n\ts_nop 4\n\tglobal_load_lds_dwordx4 %2, %3\n\ts_mov_b32 m0, %0"
                    : "=&s"(keep_) : "s"((unsigned)(unsigned long)tokb), "v"((unsigned)lane * 16u), "s"(src) : "memory");
            }
        }
        const char* nA = nxt.a0;
#pragma unroll 1
        for (int t = 0; t < nt; t += 2) {
            const bool last = (t == nt - 2);
            const char* a1 = cA + (size_t)(t + 1) * kstep;
            const char* a2 = last ? nA : cA + (size_t)(t + 2) * kstep;
            const char* a3 = a2 + kstep;
            const char* b2 = last ? PG8_BP(nxt, 0) : PG8_BP(cur, t + 2);
            const char* b3 = last ? PG8_BP(nxt, 1) : PG8_BP(cur, t + 3);
            if (GATHER) { if (last && has_next) {
                const int lim = S.rows_valid(nxt) - 1;
                const int i0 = Rr[0] < lim ? Rr[0] : lim, i1 = Rr[1] < lim ? Rr[1] : lim, i2 = (HALF + Rr[0]) < lim ? (HALF + Rr[0]) : lim, i3 = (HALF + Rr[1]) < lim ? (HALF + Rr[1]) : lim;
                n00 = (unsigned)(tokb[i0] * lda + Cc[0]) * 2u; n01 = (unsigned)(tokb[i1] * lda + Cc[1]) * 2u;
                n10 = (unsigned)(tokb[i2] * lda + Cc[0]) * 2u; n11 = (unsigned)(tokb[i3] * lda + Cc[1]) * 2u; } }
            const unsigned s00 = last ? n00 : c00, s01 = last ? n01 : c01, s10 = last ? n10 : c10, s11 = last ? n11 : c11;
            if constexpr (Epi::MIDSCALE) { if (t == ks) E.midscale(acc, cur, wr, wc, fr, fq); }
            PG8_LDB(B0, 0, 0); PG8_SCHED; PG8_LDA(At, 0, 0); PG8_STAGE2(PG8_SA(1, 1), a1, c10, c11);
            PG8_WAIT_L(8); PG8_BAR; PG8_WAIT_L(0); PG8_MMA(0, 0, At, B0); PG8_BAR; PG8_SCHED;
            PG8_LDB(B1, 0, 1); PG8_STAGE2(PG8_SB(0, 0), b2, voffB[0], voffB[1]);
            PG8_BAR; PG8_WAIT_L(0); PG8_MMA(0, 1, At, B1); PG8_BAR;
            PG8_LDA(At, 0, 1); PG8_STAGE2(PG8_SA(0, 0), a2, s00, s01);
            PG8_BAR; PG8_WAIT_L(0); PG8_MMA(1, 0, At, B0); PG8_BAR; PG8_SCHED;
            PG8_STAGE2(PG8_SB(0, 1), b2 + hstepB, voffB[0], voffB[1]);
            PG8_WAIT_V(6); PG8_BAR; PG8_MMA(1, 1, At, B1); PG8_BAR;
            PG8_LDB(B0, 1, 0); PG8_SCHED; PG8_LDA(At, 1, 0); PG8_STAGE2(PG8_SA(0, 1), a2, s10, s11);
            PG8_WAIT_L(8); PG8_BAR; PG8_WAIT_L(0); PG8_MMA(0, 0, At, B0); PG8_BAR; PG8_SCHED;
            PG8_LDB(B1, 1, 1); PG8_STAGE2(PG8_SB(1, 0), b3, voffB[0], voffB[1]);
            PG8_BAR; PG8_WAIT_L(0); PG8_MMA(0, 1, At, B1); PG8_BAR;
            PG8_LDA(At, 1, 1); PG8_STAGE2(PG8_SA(1, 0), a3, s00, s01);
            PG8_BAR; PG8_WAIT_L(0); PG8_MMA(1, 0, At, B0); PG8_BAR; PG8_SCHED;
            PG8_STAGE2(PG8_SB(1, 1), b3 + hstepB, voffB[0], voffB[1]);
            PG8_WAIT_V(6); PG8_BAR; PG8_MMA(1, 1, At, B1); PG8_BAR;
        }
        E(acc, cur, wr, wc, fr, fq);
        if (!has_next) break;
        asm volatile("v_mov_b32 %0, 0" : "=v"(zr));
#pragma unroll
        for (int a = 0; a < 2; ++a)
#pragma unroll
            for (int b = 0; b < 2; ++b)
#pragma unroll
                for (int m = 0; m < 4; ++m)
#pragma unroll
                    for (int n = 0; n < 2; ++n) acc[a][b][m][n] = (f32x4){zr, zr, zr, zr};
        cur = nxt; cA = nA; ++ui; c00 = n00; c01 = n01; c10 = n10; c11 = n11;
    }
    PG8_WAIT_V(0);
    if (wr == 0) PG8_BAR;
    PG8_BAR;
#undef PG8_SA
#undef PG8_SB
#undef PG8_STAGE2
#undef PG8_LDA
#undef PG8_LDB
#undef PG8_MMA
#undef PG8_WAIT_V
#undef PG8_WAIT_L
#undef PG8_BAR
#undef PG8_SCHED
#undef PG8_BP
}

struct DenseSched {
    const char* A; const char* Bt; int lda, ldb, K; int nM, nN, nwg, G, c, skipctx;
    __device__ __forceinline__ void init(const void* A_, const void* Bt_, int M, int N, int K_, int lda_, int ldb_, int G_, int c_, int skipctx_ = 0) {
        A = (const char*)A_; Bt = (const char*)Bt_; lda = lda_; ldb = ldb_; K = K_; nM = M / BM - 2 * skipctx_; nN = N / BM; nwg = nM * nN; G = G_; c = c_; skipctx = skipctx_; }
    __device__ __forceinline__ bool get(int i, Unit& u) const {
        const long L = (long)i * G + c; if (L >= nwg) return false;
        int wgid = (int)L; { const int q = nwg / NXCD, r = nwg % NXCD, xcd = wgid % NXCD, off = wgid / NXCD; wgid = (xcd < r ? xcd * (q + 1) : r * (q + 1) + (xcd - r) * q) + off; }
        const int nig = WGM * nN, gid = wgid / nig, fm = gid * WGM, gsz = (nM - fm) < WGM ? (nM - fm) : WGM;
        int pm = fm + ((wgid % nig) % gsz); const int pn = (wgid % nig) / gsz;
        if (skipctx) pm += 1 + (pm >= 64 ? 1 : 0);
        u.a0 = A + (size_t)pm * BM * lda * 2; u.b0 = Bt + (size_t)pn * BM * ldb * 2; u.b1 = u.b0 + (size_t)(K / BK / 2) * BK * 2;
        u.i0 = pm; u.i1 = pn; u.i2 = 0; u.i3 = 0; u.i4 = 0; u.pad = 0; return true;
    }
    __device__ __forceinline__ int arow(const Unit&, int rl) const { return rl; }
    __device__ __forceinline__ const int* rows_ptr(const Unit&) const { return nullptr; }
    __device__ __forceinline__ int rows_valid(const Unit&) const { return 256; }
};
}

struct EpiProj {
    static constexpr bool PERM = true, MIDSCALE = false;
    bf16_t* O;
    __device__ __forceinline__ void operator()(const f32x4 (&acc)[2][2][4][2], const pg8::Unit& u, int wr, int wc, int fr, int fq) const {
        const int row0 = u.i0 * 256 + wr * 64 + fr, col0 = u.i1 * 256 + wc * 32 + 8 * fq;
#pragma unroll
        for (int ai = 0; ai < 2; ++ai)
#pragma unroll
            for (int m = 0; m < 4; ++m) { bf16_t* rowp = O + (size_t)(row0 + ai * 128 + m * 16) * NPROJ + col0;
#pragma unroll
                for (int bj = 0; bj < 2; ++bj) { const f32x4 v0 = acc[ai][bj][m][0], v1 = acc[ai][bj][m][1];
                    u32x4 w; w.x = cvt_pk_bf16(v0[0], v0[1]); w.y = cvt_pk_bf16(v0[2], v0[3]); w.z = cvt_pk_bf16(v1[0], v1[1]); w.w = cvt_pk_bf16(v1[2], v1[3]);
                    *(u32x4*)(rowp + bj * 128) = w; } }
    }
};
template <int L0> struct EpiResid {
    static constexpr bool PERM = true, MIDSCALE = true;
    const float* inc; const float* inx; bf16_t* H; const float* modl; const float* ssq;
    __device__ __forceinline__ void midscale(f32x4 (&acc)[2][2][4][2], const pg8::Unit& u, int wr, int wc, int fr, int fq) const {
        typedef float f32x2 __attribute__((ext_vector_type(2)));
        const int r0 = u.i0 * 256 + wr * 64 + fr;
        f32x2 part[2][4];
#pragma unroll
        for (int ai = 0; ai < 2; ++ai)
#pragma unroll
            for (int m = 0; m < 4; ++m) part[ai][m] = *(const f32x2*)(ssq + (size_t)(r0 + ai * 128 + m * 16) * 8 + 2 * fq);
#pragma unroll
        for (int ai = 0; ai < 2; ++ai)
#pragma unroll
            for (int m = 0; m < 4; ++m) { float sq = part[ai][m][0] + part[ai][m][1];
                sq += __shfl_xor(sq, 16); sq += __shfl_xor(sq, 32);
                const float rs = rsqrtf(sq * (1.f / 512.f) + 1e-6f);
#pragma unroll
                for (int bj = 0; bj < 2; ++bj)
#pragma unroll
                    for (int n = 0; n < 2; ++n) acc[ai][bj][m][n] *= rs; }
    }
    __device__ __forceinline__ void operator()(const f32x4 (&acc)[2][2][4][2], const pg8::Unit& u, int wr, int wc, int fr, int fq) const {
        const int r0 = u.i0 * 256;
        const int v = row_v(r0);
        const float* gate = modl + (size_t)v * 6144 + 2 * 1024;
        const float* xin = xin_ptr(inc, inx, r0);
        const int rl0 = wr * 64 + fr, col0 = u.i1 * 256 + wc * 32 + 8 * fq;
        f32x4 gv[2][2];
#pragma unroll
        for (int bj = 0; bj < 2; ++bj)
#pragma unroll
            for (int n = 0; n < 2; ++n) gv[bj][n] = *(const f32x4*)(gate + col0 + bj * 128 + 4 * n);
#pragma unroll
        for (int ai = 0; ai < 2; ++ai)
#pragma unroll
            for (int mp = 0; mp < 2; ++mp) {
                if (L0) {
                    f32x4 hi[2][2][2];
#pragma unroll
                    for (int mm = 0; mm < 2; ++mm) { const size_t off = (size_t)(rl0 + ai * 128 + (2 * mp + mm) * 16) * D + col0;
#pragma unroll
                        for (int bj = 0; bj < 2; ++bj)
#pragma unroll
                            for (int n = 0; n < 2; ++n) hi[mm][bj][n] = *(const f32x4*)(xin + off + bj * 128 + 4 * n); }
#pragma unroll
                    for (int mm = 0; mm < 2; ++mm)
#pragma unroll
                        for (int bj = 0; bj < 2; ++bj) { const f32x4 o0 = hi[mm][bj][0] + gv[bj][0] * acc[ai][bj][2 * mp + mm][0], o1 = hi[mm][bj][1] + gv[bj][1] * acc[ai][bj][2 * mp + mm][1];
                            u32x4 w; w.x = cvt_pk_bf16(o0[0], o0[1]); w.y = cvt_pk_bf16(o0[2], o0[3]); w.z = cvt_pk_bf16(o1[0], o1[1]); w.w = cvt_pk_bf16(o1[2], o1[3]);
                            *(u32x4*)(H + (size_t)(r0 + rl0 + ai * 128 + (2 * mp + mm) * 16) * D + col0 + bj * 128) = w; }
                } else {
                    u32x4 hr[2][2];
#pragma unroll
                    for (int mm = 0; mm < 2; ++mm)
#pragma unroll
                        for (int bj = 0; bj < 2; ++bj) hr[mm][bj] = *(const u32x4*)(H + (size_t)(r0 + rl0 + ai * 128 + (2 * mp + mm) * 16) * D + col0 + bj * 128);
#pragma unroll
                    for (int mm = 0; mm < 2; ++mm)
#pragma unroll
                        for (int bj = 0; bj < 2; ++bj) { const u32x4 hv = hr[mm][bj]; const f32x4 a0 = acc[ai][bj][2 * mp + mm][0], a1 = acc[ai][bj][2 * mp + mm][1]; const f32x4 g0 = gv[bj][0], g1 = gv[bj][1];
                            u32x4 w;
                            w.x = cvt_pk_bf16(bflo(hv.x) + g0[0] * a0[0], bfhi(hv.x) + g0[1] * a0[1]); w.y = cvt_pk_bf16(bflo(hv.y) + g0[2] * a0[2], bfhi(hv.y) + g0[3] * a0[3]);
                            w.z = cvt_pk_bf16(bflo(hv.z) + g1[0] * a1[0], bfhi(hv.z) + g1[1] * a1[1]); w.w = cvt_pk_bf16(bflo(hv.w) + g1[2] * a1[2], bfhi(hv.w) + g1[3] * a1[3]);
                            *(u32x4*)(H + (size_t)(r0 + rl0 + ai * 128 + (2 * mp + mm) * 16) * D + col0 + bj * 128) = w; }
                }
                asm volatile("" ::: "memory"); }
    }
};

struct MoeSched {
    const LAS int* tab;
    const int* list;
    const char* A; const char* W; int mode  , l, G, c;
    __device__ __forceinline__ bool get(int i, pg8::Unit& u) const {
        const int L = i * G + c; const int total = __builtin_amdgcn_readfirstlane(tab[24]) * 4; if (L >= total) return false;
        const int tl = L >> 2, pn = L & 3;
        int cls = 0;
#pragma unroll 1
        for (int q = 1; q < NCLS; ++q) { const int tq = __builtin_amdgcn_readfirstlane(tab[q]); if (tq <= tl) cls = q; }
        const int j = tl - __builtin_amdgcn_readfirstlane(tab[cls]), cnt = __builtin_amdgcn_readfirstlane(tab[32 + cls]);
        const int g = cls / 6, pidx = cls - g * 6;
        const int ea = (pidx >= 3) + (pidx >= 5), eb = pidx < 3 ? pidx + 1 : (pidx < 5 ? pidx - 1 : 3);
        if (mode == 0) {
            const int e = 4 * g + (pn < 2 ? ea : eb);
            u.a0 = A;
            u.b0 = W + ((size_t)(l * 16 + e) * 512 + (size_t)(pn & 1) * 256) * 1024 * 2; u.b1 = u.b0 + (size_t)8 * 128;
        } else {
            u.a0 = A + (size_t)tl * 256 * 512 * 2;
            u.b0 = W + ((size_t)(l * 16 + 4 * g + ea) * 1024 + (size_t)pn * 256) * 256 * 2;
            u.b1 = W + ((size_t)(l * 16 + 4 * g + eb) * 1024 + (size_t)pn * 256) * 256 * 2;
        }
        u.i0 = cls; u.i1 = j; u.i2 = pn; u.i3 = cnt; u.i4 = tl; u.pad = 0; return true;
    }
    __device__ __forceinline__ int arow(const pg8::Unit& u, int rl) const {
        int idx = u.i1 * 256 + rl; idx = idx < u.i3 ? idx : u.i3 - 1;
        return list[(size_t)u.i0 * R + idx];
    }
    __device__ __forceinline__ const int* rows_ptr(const pg8::Unit& u) const { return list + (size_t)u.i0 * R + u.i1 * 256; }
    __device__ __forceinline__ int rows_valid(const pg8::Unit& u) const { return u.i3 - u.i1 * 256; }
};
struct EpiUp {
    static constexpr bool PERM = true, MIDSCALE = false;
    bf16_t* hid; const float* cwla; const float* cwlb;
    __device__ __forceinline__ void operator()(const f32x4 (&acc)[2][2][4][2], const pg8::Unit& u, int wr, int wc, int fr, int fq) const {
        const int cls = u.i0, j = u.i1, pn = u.i2, cnt = u.i3, tl = u.i4;
        const float* cw = (pn < 2) ? cwla : cwlb;
        const int colbase = (pn >> 1) * 256 + (pn & 1) * 128 + wc * 32 + 8 * fq;
        float wrow[2][4];
#pragma unroll
        for (int ai = 0; ai < 2; ++ai)
#pragma unroll
            for (int m = 0; m < 4; ++m) { const int idx = j * 256 + ai * 128 + wr * 64 + m * 16 + fr; wrow[ai][m] = idx < cnt ? cw[(size_t)cls * R + idx] : 0.f; }
#pragma unroll
        for (int ai = 0; ai < 2; ++ai)
#pragma unroll
            for (int m = 0; m < 4; ++m) {
                const int rl = ai * 128 + wr * 64 + m * 16 + fr; const int idx = j * 256 + rl; const bool valid = idx < cnt;
                const float w = wrow[ai][m];
                const f32x4 g0 = acc[ai][0][m][0], g1 = acc[ai][0][m][1], u0 = acc[ai][1][m][0], u1 = acc[ai][1][m][1];
                float o[8];
#pragma unroll
                for (int e = 0; e < 4; ++e) { o[e] = w * siluf_(g0[e]) * u0[e]; o[4 + e] = w * siluf_(g1[e]) * u1[e]; }
                if (!valid) {
#pragma unroll
                    for (int e = 0; e < 8; ++e) o[e] = 0.f; }
                u32x4 pk; pk.x = cvt_pk_bf16(o[0], o[1]); pk.y = cvt_pk_bf16(o[2], o[3]); pk.z = cvt_pk_bf16(o[4], o[5]); pk.w = cvt_pk_bf16(o[6], o[7]);
                *(u32x4*)(hid + ((size_t)tl * 256 + rl) * 512 + colbase) = pk;
                asm volatile("" ::: "memory");
            }
    }
};
struct EpiDown {
    static constexpr bool PERM = true, MIDSCALE = false;
    bf16_t* H; const int* list; const float* modl;
    __device__ __forceinline__ void operator()(const f32x4 (&acc)[2][2][4][2], const pg8::Unit& u, int wr, int wc, int fr, int fq) const {
        const int cls = u.i0, j = u.i1, pn = u.i2, cnt = u.i3;
        const int col0 = pn * 256 + wc * 32 + 8 * fq;
        int tok[2][4];
#pragma unroll
        for (int ai = 0; ai < 2; ++ai)
#pragma unroll
            for (int m = 0; m < 4; ++m) { const int idx = j * 256 + ai * 128 + wr * 64 + m * 16 + fr; tok[ai][m] = idx < cnt ? list[(size_t)cls * R + idx] : -1; }
#pragma unroll
        for (int ai = 0; ai < 2; ++ai)
#pragma unroll
            for (int mp = 0; mp < 2; ++mp) {
                u32x4 hr[2][2]; f32x4 gv[2][2][2];
#pragma unroll
                for (int mm = 0; mm < 2; ++mm) { const int t = tok[ai][2 * mp + mm]; const int tt = t < 0 ? 0 : t;
                    const bf16_t* hp = H + (size_t)tt * D + col0; const float* gp = modl + (size_t)row_v(tt) * 6144 + col0;
#pragma unroll
                    for (int bj = 0; bj < 2; ++bj) { hr[mm][bj] = *(const u32x4*)(hp + bj * 128); gv[mm][bj][0] = *(const f32x4*)(gp + bj * 128); gv[mm][bj][1] = *(const f32x4*)(gp + bj * 128 + 4); } }
#pragma unroll
                for (int mm = 0; mm < 2; ++mm) { const int t = tok[ai][2 * mp + mm];
                    if (t >= 0) {
#pragma unroll
                        for (int bj = 0; bj < 2; ++bj) { const u32x4 hv = hr[mm][bj]; const f32x4 a0 = acc[ai][bj][2 * mp + mm][0], a1 = acc[ai][bj][2 * mp + mm][1]; const f32x4 g0 = gv[mm][bj][0], g1 = gv[mm][bj][1];
                            u32x4 w;
                            w.x = cvt_pk_bf16(bflo(hv.x) + g0[0] * a0[0], bfhi(hv.x) + g0[1] * a0[1]); w.y = cvt_pk_bf16(bflo(hv.y) + g0[2] * a0[2], bfhi(hv.y) + g0[3] * a0[3]);
                            w.z = cvt_pk_bf16(bflo(hv.z) + g1[0] * a1[0], bfhi(hv.z) + g1[1] * a1[1]); w.w = cvt_pk_bf16(bflo(hv.w) + g1[2] * a1[2], bfhi(hv.w) + g1[3] * a1[3]);
                            *(u32x4*)(H + (size_t)t * D + col0 + bj * 128) = w; } } }
                asm volatile("" ::: "memory"); }
    }
};

__device__ __forceinline__ void tr_tile(const float* src, int ldn, int k0, int n0, int nvalid, bf16_t* dst, int ldk, int drow0, LAS float* tile, int kd0 = -1, const float* kscale = nullptr) {
    const int tid = launder_tid();
    if (kd0 < 0) kd0 = k0;
    { const int n = tid & 63; const int kq = tid >> 6; float tv[8], ts[8];
#pragma unroll
      for (int it = 0; it < 8; ++it) { const int kk = kq + 8 * it; tv[it] = (n < nvalid) ? src[(size_t)(k0 + kk) * ldn + n0 + n] : 0.f; ts[it] = kscale ? kscale[kk] : 1.f; }
#pragma unroll
      for (int it = 0; it < 8; ++it) tile[(kq + 8 * it) * 65 + n] = tv[it] * ts[it]; }
    __syncthreads();
    { const int k8 = tid & 7, n = tid >> 3;
      if (n < nvalid) { const LAS float* s = tile + (k8 * 8) * 65 + n;
          u32x4 o; o.x = cvt_pk_bf16(s[0], s[65]); o.y = cvt_pk_bf16(s[2 * 65], s[3 * 65]); o.z = cvt_pk_bf16(s[4 * 65], s[5 * 65]); o.w = cvt_pk_bf16(s[6 * 65], s[7 * 65]);
          *(u32x4*)(dst + (size_t)(drow0 + n) * ldk + kd0 + k8 * 8) = o; } }
    __syncthreads();
}
constexpr int WPREP_ITEMS_PER_LAYER = 16 * 41 + 256 + 1024 + 1024 + 1024;
__device__ __forceinline__ void phase_wprep(CP p, unsigned char* lds, int it0, int it1, int bidx, int nblk) {
    LAS float* tile = (LAS float*)(LAS unsigned char*)lds;
    constexpr int I_IN = 16 * 41, I_OUT = 256, I_G = 1024, I_U = 1024, I_D = 1024, I_L = I_IN + I_OUT + I_G + I_U + I_D;
    for (int it = it0 + bidx; it < it1; it += nblk) {
        const int l = it / I_L; int r = it - l * I_L;
        if (r < I_IN) { const int kt = r / 41, ntl = r % 41; const int n0 = ntl * 64; const int nv = (DIN - n0) < 64 ? (DIN - n0) : 64;
            tr_tile(p->w_in + (size_t)l * 1024 * DIN, DIN, kt * 64, n0, nv, (bf16_t*)(p->ws + WS_WTIN) + (size_t)l * DIN * 1024, 1024, n0, tile); continue; }
        r -= I_IN;
        if (r < I_OUT) { const int kt = r >> 4, ntl = r & 15;
            tr_tile(p->w_out + (size_t)l * 1024 * 1024, 1024, kt * 64, ntl * 64, 64, (bf16_t*)(p->ws + WS_WTOUT) + (size_t)l * 1024 * 1024, 1024, ntl * 64, tile,
                    (kt * 64 + 512) & 1023, kt >= 8 ? p->ssd_norm_g + l * 512 + (kt * 64 - 512) : nullptr); continue; }
        r -= I_OUT;
        if (r < I_G + I_U) { const int up = r >= I_G; if (up) r -= I_G; const int e = r >> 6, q = r & 63, kt = q >> 2, ntl = q & 3; const int n0 = ntl * 64;
            const float* src = (up ? p->w_up : p->w_gate) + (size_t)(l * 16 + e) * 1024 * 256;
            tr_tile(src, 256, kt * 64, n0, 64, (bf16_t*)(p->ws + WS_WTGU) + (size_t)(l * 16 + e) * 512 * 1024, 1024, (n0 >> 7) * 256 + (n0 & 127) + (up ? 128 : 0), tile); continue; }
        r -= I_G + I_U;
        { const int e = r >> 6, q = r & 63, kt = q >> 4, ntl = q & 15;
          tr_tile(p->w_down + (size_t)(l * 16 + e) * 256 * 1024, 1024, kt * 64, ntl * 64, 64, (bf16_t*)(p->ws + WS_WTD) + (size_t)(l * 16 + e) * 1024 * 256, 256, ntl * 64, tile); }
    }
}
__device__ __forceinline__ void phase_adaln(CP p, unsigned char* lds, int bid, int nb) {
    LAS float* sc = (LAS float*)(LAS unsigned char*)lds;
    LAS float* red = sc + 3 * 1024;
    const int tid = launder_tid();
    for (int idx = tid; idx < 3 * 1024; idx += NTHREADS) { const int v = idx >> 10, k = idx & 1023; const float cv = (v < 2) ? p->c[v * 1024 + k] : p->c_ctx[k]; sc[idx] = siluf_(cv); }
    __syncthreads();
    float* mod = (float*)(p->ws + WS_MOD);
    for (int it = bid; it < 2 * 96; it += nb) {
        const int l = it / 96, n0 = (it % 96) * 64;
        const int c4 = tid & 15, kr = tid >> 4;
        f32x4 a0 = {0, 0, 0, 0}, a1 = {0, 0, 0, 0}, a2 = {0, 0, 0, 0};
        const float* w = p->w_ada + (size_t)l * 1024 * 6144 + n0 + c4 * 4;
#pragma unroll 4
        for (int k = kr; k < 1024; k += 32) { const f32x4 w4 = *(const f32x4*)(w + (size_t)k * 6144); a0 += sc[k] * w4; a1 += sc[1024 + k] * w4; a2 += sc[2048 + k] * w4; }
        *(LAS f32x4*)(red + (kr * 3 + 0) * 64 + c4 * 4) = a0; *(LAS f32x4*)(red + (kr * 3 + 1) * 64 + c4 * 4) = a1; *(LAS f32x4*)(red + (kr * 3 + 2) * 64 + c4 * 4) = a2;
        __syncthreads();
        if (tid < 192) { const int v = tid >> 6, cc = tid & 63; float s = 0.f;
            for (int q = 0; q < 32; ++q) s += red[(q * 3 + v) * 64 + cc];
            mod[((size_t)l * 3 + v) * 6144 + n0 + cc] = s + p->b_ada[l * 6144 + n0 + cc]; }
        __syncthreads();
    }
}
__device__ __forceinline__ void moe_table(CP p, int l, LAS int* tab) {
    const int* gcount = (const int*)(p->ws + WS_CTL) + l * 32;
    if (threadIdx.x == 0) { int acc = 0; for (int q = 0; q < NCLS; ++q) { const int cn = gcount[q]; tab[q] = acc; tab[32 + q] = cn; acc += (cn + 255) >> 8; } tab[24] = acc; }
    __syncthreads();
}
__device__ __forceinline__ void moe_yload(CP p, int pos, int lane, const LAS int* tab, u32x2 (&yv)[4]) {
    const int slot = tab[pos >> 16] * 256 + (pos & 0xffff);
    const bf16_t* y = (const bf16_t*)(p->ws + WS_Y) + (size_t)slot * 1024;
#pragma unroll
    for (int j = 0; j < 4; ++j) yv[j] = *(const u32x2*)(y + 4 * lane + 256 * j);
}
__device__ __forceinline__ void moe_yadd(CP p, int lm, int v, int lane, const u32x2 (&yv)[4], f32x4 (&xv)[4]) {
    const float* gate = (const float*)(p->ws + WS_MOD) + ((size_t)lm * 3 + v) * 6144 + 5 * 1024;
#pragma unroll
    for (int j = 0; j < 4; ++j) { const int k = 4 * lane + 256 * j; const f32x4 g4 = *(const f32x4*)(gate + k);
        xv[j][0] += g4[0] * bflo(yv[j].x); xv[j][1] += g4[1] * bfhi(yv[j].x); xv[j][2] += g4[2] * bflo(yv[j].y); xv[j][3] += g4[3] * bfhi(yv[j].y); }
}
typedef _Float16 f16x8 __attribute__((ext_vector_type(8)));
typedef _Float16 f16x2 __attribute__((ext_vector_type(2)));
constexpr int ST_H16 = 2064;
__device__ __forceinline__ unsigned pack_f16(float a, float b) { f16x2 h; h[0] = (_Float16)a; h[1] = (_Float16)b; return __builtin_bit_cast(unsigned, h); }
__device__ __forceinline__ void phase_r1(CP p, int l, unsigned char* lds_, int bid, int nb) {
    LAS unsigned char* lds = (LAS unsigned char*)lds_;
    LAS unsigned char* Wh = lds;
    LAS unsigned char* Xh = Wh + 16 * ST_H16;
    LAS float* gm = (LAS float*)(Xh + 16 * ST_H16);
    LAS float* sh = gm + 3 * 1024;
    LAS float* part = sh + 3 * 1024;
    const int tid = launder_tid(); const int lane = tid & 63, wave = __builtin_amdgcn_readfirstlane(tid >> 6);
    const float* mod = (const float*)(p->ws + WS_MOD) + (size_t)l * 3 * 6144;
    const float* win = p->w_in + (size_t)l * 1024 * DIN;
#pragma unroll
    for (int hb = 0; hb < 2; ++hb) { float tmp[16];
#pragma unroll
        for (int it = 0; it < 16; ++it) { const int idx = tid + NTHREADS * (16 * hb + it); tmp[it] = win[(size_t)(idx >> 4) * DIN + NPROJ + (idx & 15)]; }
#pragma unroll
        for (int it = 0; it < 16; ++it) { const int idx = tid + NTHREADS * (16 * hb + it); *(LAS _Float16*)(Wh + (idx & 15) * ST_H16 + (idx >> 4) * 2) = (_Float16)tmp[it]; } }
    { float t0[6], t1[6], t2[6];
#pragma unroll
      for (int it = 0; it < 6; ++it) { const int idx = tid + NTHREADS * it; const int v = idx >> 10, k = idx & 1023; t0[it] = p->g_mix[l * 1024 + k]; t1[it] = mod[v * 6144 + 1024 + k]; t2[it] = mod[v * 6144 + k]; }
#pragma unroll
      for (int it = 0; it < 6; ++it) { const int idx = tid + NTHREADS * it; gm[idx] = t0[it] * (1.f + t1[it]); sh[idx] = t2[it]; } }
    __syncthreads();
    bf16_t* HX = (bf16_t*)(p->ws + WS_HX); float* DT = (float*)(p->ws + WS_DT);
    const int rpb = (R + nb - 1) / nb, r0 = bid * rpb, r1 = (r0 + rpb) < R ? (r0 + rpb) : R;
    RowRaw xn[2];
#pragma unroll
    for (int q = 0; q < 2; ++q) if (r0 + 2 * wave + q < r1) row_load(p, l, r0 + 2 * wave + q, lane, xn[q]);
#pragma unroll 1
    for (int t0r = r0; t0r < r1; t0r += 16) {
        f32x4 xv[2][4];
#pragma unroll
        for (int q = 0; q < 2; ++q) row_cvt(l, xn[q], xv[q]);
#pragma unroll
        for (int q = 0; q < 2; ++q) if (t0r + 16 + 2 * wave + q < r1) row_load(p, l, t0r + 16 + 2 * wave + q, lane, xn[q]);
#pragma unroll
        for (int q = 0; q < 2; ++q) { const int rr = t0r + 2 * wave + q; const bool ok = rr < r1; const int v = row_v(ok ? rr : r0);
            if (l == 0 && ok) { u32x2* hw = (u32x2*)((bf16_t*)(p->ws + WS_H) + (size_t)rr * D);
#pragma unroll
                for (int j = 0; j < 4; ++j) { u32x2 o; o.x = cvt_pk_bf16(xv[q][j][0], xv[q][j][1]); o.y = cvt_pk_bf16(xv[q][j][2], xv[q][j][3]); hw[lane + 64 * j] = o; } }
            float ss = 0.f;
#pragma unroll
            for (int j = 0; j < 4; ++j) ss += xv[q][j][0] * xv[q][j][0] + xv[q][j][1] * xv[q][j][1] + xv[q][j][2] * xv[q][j][2] + xv[q][j][3] * xv[q][j][3];
            ss = wave_sum(ss); const float rs = ok ? rsqrtf(ss * (1.f / 1024.f) + 1e-6f) : 0.f;
#pragma unroll
            for (int j = 0; j < 4; ++j) { const int k = 4 * lane + 256 * j; const f32x4 g4 = *(const LAS f32x4*)(gm + v * 1024 + k), s4 = *(const LAS f32x4*)(sh + v * 1024 + k);
                f32x4 hv = xv[q][j] * rs * g4 + s4; if (!ok) hv = hv * 0.f;
                u32x2 o; o.x = cvt_pk_bf16(hv[0], hv[1]); o.y = cvt_pk_bf16(hv[2], hv[3]);
                if (ok) *(u32x2*)(HX + (size_t)rr * 1024 + k) = o;
                u32x2 h16; h16.x = pack_f16(hv[0], hv[1]); h16.y = pack_f16(hv[2], hv[3]);
                *(LAS u32x2*)(Xh + (2 * wave + q) * ST_H16 + k * 2) = h16; } }
        __syncthreads();
        {
            f32x4 acc0 = {0.f, 0.f, 0.f, 0.f};
#pragma unroll
            for (int s4 = 0; s4 < 4; ++s4) { const int kb = (128 * wave + 32 * s4 + 8 * (lane >> 4)) * 2;
                const f16x8 a = *(const LAS f16x8*)(Xh + (lane & 15) * ST_H16 + kb);
                const f16x8 b0 = *(const LAS f16x8*)(Wh + (lane & 15) * ST_H16 + kb);
                acc0 = __builtin_amdgcn_mfma_f32_16x16x32_f16(a, b0, acc0, 0, 0, 0); }
#pragma unroll
            for (int e = 0; e < 4; ++e) part[(wave * 16 + 4 * (lane >> 4) + e) * 16 + (lane & 15)] = acc0[e];
        }
        __syncthreads();
        if (tid < 256) { const int row = tid >> 4, n = tid & 15; const int rr = t0r + row;
            float sacc = p->dt_bias[l * 16 + n];
#pragma unroll
            for (int w = 0; w < 8; ++w) sacc += part[(w * 16 + row) * 16 + n];
            if (rr < r1) DT[(size_t)rr * 16 + n] = softplusf_(sacc); }
    }
    __syncthreads();
}
typedef float f32x16 __attribute__((ext_vector_type(16)));
typedef short s16x4 __attribute__((ext_vector_type(4)));
constexpr int ST_ROW = 272;
constexpr int ST_TR128 = 320;
constexpr int ST_TR64 = 192;
constexpr int ST_MT = 328;
constexpr int NCHUNK = SEG / 128;

#define DPP_MOV(v, ctrl, rm, bm) __builtin_bit_cast(float, __builtin_amdgcn_update_dpp(0, __builtin_bit_cast(int, (v)), (ctrl), (rm), (bm), true))
__device__ __forceinline__ float wave_incl_scan(float v, int) {
    float s = v + DPP_MOV(v, 0x111, 0xF, 0xF) + DPP_MOV(v, 0x112, 0xF, 0xF) + DPP_MOV(v, 0x113, 0xF, 0xF);
    s += DPP_MOV(s, 0x114, 0xF, 0xE);
    s += DPP_MOV(s, 0x118, 0xF, 0xC);
    s += DPP_MOV(s, 0x142, 0xA, 0xF);
    s += DPP_MOV(s, 0x143, 0xC, 0xF);
    return s;
}
__device__ __forceinline__ bf16x8 row_frag(const LAS unsigned char* tile, int stride, int row0, int k0, int lane) {
    return *(const LAS bf16x8*)(tile + (row0 + (lane & 31)) * stride + (k0 + 8 * (lane >> 5)) * 2);
}
__device__ __forceinline__ bf16x8 tr_frag(const LAS unsigned char* tile, int stride, int k0, int c0, int lane) {
    const int g = lane >> 4, li = lane & 15, q = li >> 2, pp = li & 3;
    const LAS unsigned char* a0 = tile + (k0 + 8 * (g >> 1) + q) * stride + (c0 + 16 * (g & 1) + 4 * pp) * 2;
    const s16x4 lo = __builtin_amdgcn_ds_read_tr16_b64_v4i16((LAS s16x4*)a0);
    const s16x4 hi = __builtin_amdgcn_ds_read_tr16_b64_v4i16((LAS s16x4*)(a0 + 4 * stride));
    return __builtin_shufflevector(lo, hi, 0, 1, 2, 3, 4, 5, 6, 7);
}
__device__ __forceinline__ u32x4 pack8(const float (&v)[8]) { u32x4 r; r.x = cvt_pk_bf16(v[0], v[1]); r.y = cvt_pk_bf16(v[2], v[3]); r.z = cvt_pk_bf16(v[4], v[5]); r.w = cvt_pk_bf16(v[6], v[7]); return r; }
__device__ __forceinline__ u32x4 pack8s(const float (&v)[8], float sc) { u32x4 r; r.x = cvt_pk_bf16(v[0] * sc, v[1] * sc); r.y = cvt_pk_bf16(v[2] * sc, v[3] * sc); r.z = cvt_pk_bf16(v[4] * sc, v[5] * sc); r.w = cvt_pk_bf16(v[6] * sc, v[7] * sc); return r; }

__device__ __forceinline__ void conv_load(const bf16_t* proj, int row0, int rq, int xch, bool lo_ok, bool hi_ok, u32x4 (&raw)[8]) {
    const bf16_t* base = proj + (size_t)(row0 + 4 * rq) * NPROJ + 1536 + xch;
    unsigned zz; asm volatile("v_mov_b32 %0, 0" : "=v"(zz));
#pragma unroll
    for (int j = 0; j < 8; ++j) {
        if (j < 2) { const bool ok = (rq > 0) || lo_ok; const u32x4 v = *(const u32x4*)(ok ? base + (j - 2) * NPROJ : base);
            raw[j].x = ok ? v.x : zz; raw[j].y = ok ? v.y : zz; raw[j].z = ok ? v.z : zz; raw[j].w = ok ? v.w : zz; }
        else if (j >= 6) { const bool ok = (rq < 31) || hi_ok; const u32x4 v = *(const u32x4*)(ok ? base + (j - 2) * NPROJ : base);
            raw[j].x = ok ? v.x : zz; raw[j].y = ok ? v.y : zz; raw[j].z = ok ? v.z : zz; raw[j].w = ok ? v.w : zz; }
        else raw[j] = *(const u32x4*)(base + (j - 2) * NPROJ);
    }
}
__device__ __forceinline__ void conv_compute(const u32x4 (&raw)[8], const LAS float* wl, int nchl, int wch, float (&o)[4][8]) {
    float w[5][8], bs[8];
#pragma unroll
    for (int j = 0; j < 5; ++j) { const f32x4 w0 = *(const LAS f32x4*)(wl + j * nchl + wch), w1 = *(const LAS f32x4*)(wl + j * nchl + wch + 4);
        w[j][0] = w0[0]; w[j][1] = w0[1]; w[j][2] = w0[2]; w[j][3] = w0[3]; w[j][4] = w1[0]; w[j][5] = w1[1]; w[j][6] = w1[2]; w[j][7] = w1[3]; }
    { const f32x4 b0 = *(const LAS f32x4*)(wl + 5 * nchl + wch), b1 = *(const LAS f32x4*)(wl + 5 * nchl + wch + 4); bs[0] = b0[0]; bs[1] = b0[1]; bs[2] = b0[2]; bs[3] = b0[3]; bs[4] = b1[0]; bs[5] = b1[1]; bs[6] = b1[2]; bs[7] = b1[3]; }
#pragma unroll
    for (int i = 0; i < 4; ++i)
#pragma unroll
        for (int e = 0; e < 8; ++e) o[i][e] = bs[e];
#pragma unroll
    for (int j = 0; j < 8; ++j) {
        float xv[8] = {bflo(raw[j].x), bfhi(raw[j].x), bflo(raw[j].y), bfhi(raw[j].y), bflo(raw[j].z), bfhi(raw[j].z), bflo(raw[j].w), bfhi(raw[j].w)};
#pragma unroll
        for (int i = 0; i < 4; ++i) { const int tap = j - i; if (tap >= 0 && tap < 5) {
#pragma unroll
                for (int e = 0; e < 8; ++e) o[i][e] += w[tap][e] * xv[e]; } }
    }
#pragma unroll
    for (int i = 0; i < 4; ++i)
#pragma unroll
        for (int e = 0; e < 8; ++e) o[i][e] = siluf_(o[i][e]);
}
__device__ __forceinline__ void head_cums(CP p, int l, int row0, int h, int dir, int lane, LAS float* hv) {
    const float A = -expf(p->a_log[l * 16 + dir * 8 + h]);
    const float* DT = (const float*)(p->ws + WS_DT);
    const float d0 = DT[(size_t)(row0 + 2 * lane) * 16 + dir * 8 + h], d1 = DT[(size_t)(row0 + 2 * lane + 1) * 16 + dir * 8 + h];
    const float x0 = d0 * A, x1 = d1 * A;
    const float incl = wave_incl_scan(x0 + x1, lane);
    const float total = __builtin_bit_cast(float, __builtin_amdgcn_readlane(__builtin_bit_cast(int, incl), 63));
    float c0, c1;
    if (dir == 0) { c1 = incl; c0 = incl - x1; } else { c0 = total - (incl - x1 - x0); c1 = total - (incl - x1); }
    hv[dir * 128 + 2 * lane] = c0; hv[dir * 128 + 2 * lane + 1] = c1;
    hv[256 + dir * 128 + 2 * lane] = d0; hv[256 + dir * 128 + 2 * lane + 1] = d1;
    if (lane == 0) hv[512 + dir] = total;
}
__device__ __forceinline__ bf16x8 scale_frag(bf16x8 f, const f32x4 w0, const f32x4 w1) {
    const u32x4 u = __builtin_bit_cast(u32x4, f);
    u32x4 r;
    r.x = cvt_pk_bf16(bflo(u.x) * w0[0], bfhi(u.x) * w0[1]); r.y = cvt_pk_bf16(bflo(u.y) * w0[2], bfhi(u.y) * w0[3]);
    r.z = cvt_pk_bf16(bflo(u.z) * w1[0], bfhi(u.z) * w1[1]); r.w = cvt_pk_bf16(bflo(u.w) * w1[2], bfhi(u.w) * w1[3]);
    return __builtin_bit_cast(bf16x8, r);
}
constexpr int ST_X256 = 576;

__device__ __forceinline__ void phase_c1(CP p, int l, unsigned char* lds_, int bid, int nb) {
    LAS unsigned char* lds = (LAS unsigned char*)lds_;
    LAS unsigned char* tile = lds;
    LAS float* wl = (LAS float*)(lds + 73216);
    const int tid = launder_tid();
    const bf16_t* proj = (const bf16_t*)(p->ws + WS_PROJ); bf16_t* mix = (bf16_t*)(p->ws + WS_HX);
#pragma unroll 1
    for (int u = bid; u < 256 + 512 + (l == DEPTH - 1 ? 0 : 16); u += nb) {
        int S, LEN, pstride, sstride, tok0, ch0;
        if (u < 256) { const int b = u >> 7, cs = (u >> 2) & 31, cc = u & 3; S = 2; LEN = 256; pstride = 64; sstride = 1; tok0 = b * SEG + CTXL + 2 * cs; ch0 = 256 + 64 * cc; }
        else if (u < 768) { const int v = u - 256; const int b = v >> 8, rg = (v >> 2) & 63, cc = v & 3; S = 4; LEN = 64; pstride = 1; sstride = 64; tok0 = b * SEG + CTXL + 256 * rg; ch0 = 64 * cc; }
        else { const int v = u - 768; const int b = v >> 3, cc = v & 7; S = 1; LEN = 256; pstride = 1; sstride = 0; tok0 = b * SEG; ch0 = 64 * cc; }
        const int LP = LEN + 30;
        { float tw[4];
#pragma unroll
          for (int it = 0; it < 4; ++it) { const int i = tid + NTHREADS * it; const int j = i >> 6, c = i & 63; tw[it] = j < 31 ? p->conv_w[((size_t)l * 31 + j) * 512 + ch0 + c] : p->conv_b[l * 512 + ch0 + c]; }
#pragma unroll
          for (int it = 0; it < 4; ++it) wl[tid + NTHREADS * it] = tw[it]; }
        for (int i = tid; i < S * 30 * 8; i += NTHREADS) { const int pc = i & 7, q = (i >> 3) % 30, sq = (i >> 3) / 30; const int pos = q < 15 ? q : LEN + q;
            unsigned zz; asm volatile("v_mov_b32 %0, 0" : "=v"(zz));
            *(LAS u32x4*)(tile + ((sq * LP + pos) * 64 + pc * 8) * 2) = (u32x4){zz, zz, zz, zz}; }
#pragma unroll 8
        for (int i = tid; i < S * LEN * 8; i += NTHREADS) { const int pc = i & 7, t = i >> 3; const int sq = t / LEN, pos = t - sq * LEN;
            const bf16_t* src = proj + (size_t)(tok0 + sq * sstride + pos * pstride) * NPROJ + ch0 + pc * 8;
            const u32x4 uv = *(const u32x4*)src, gv = *(const u32x4*)(src + 512);
            u32x4 o;
            o.x = cvt_pk_bf16(bflo(uv.x) * sigmoidf_(bflo(gv.x)), bfhi(uv.x) * sigmoidf_(bfhi(gv.x)));
            o.y = cvt_pk_bf16(bflo(uv.y) * sigmoidf_(bflo(gv.y)), bfhi(uv.y) * sigmoidf_(bfhi(gv.y)));
            o.z = cvt_pk_bf16(bflo(uv.z) * sigmoidf_(bflo(gv.z)), bfhi(uv.z) * sigmoidf_(bfhi(gv.z)));
            o.w = cvt_pk_bf16(bflo(uv.w) * sigmoidf_(bflo(gv.w)), bfhi(uv.w) * sigmoidf_(bfhi(gv.w)));
            *(LAS u32x4*)(tile + ((sq * LP + 15 + pos) * 64 + pc * 8) * 2) = o; }
        __syncthreads();
        const int noct = S * LEN / 8;
#pragma unroll 1
        for (int it = tid; it < noct * 32; it += NTHREADS) {
            const int cp = it & 31, oc = it >> 5; const int sq = oc / (LEN / 8), p0 = (oc - sq * (LEN / 8)) * 8;
            const LAS unsigned* base = (const LAS unsigned*)(tile + ((sq * LP + p0) * 64) * 2) + cp;
            float i0[38], i1[38];
#pragma unroll
            for (int k = 0; k < 38; ++k) { const unsigned w = base[k * 32]; i0[k] = bflo(w); i1[k] = bfhi(w); }
            float a0[8], a1[8];
            { const float b0 = wl[31 * 64 + 2 * cp], b1 = wl[31 * 64 + 2 * cp + 1];
#pragma unroll
              for (int i = 0; i < 8; ++i) { a0[i] = b0; a1[i] = b1; } }
#pragma unroll
            for (int j = 0; j < 31; ++j) { typedef float f32x2 __attribute__((ext_vector_type(2))); const f32x2 wj = *(const LAS f32x2*)(wl + j * 64 + 2 * cp); const float w0 = wj[0], w1 = wj[1];
#pragma unroll
                for (int i = 0; i < 8; ++i) { a0[i] += w0 * i0[i + j]; a1[i] += w1 * i1[i + j]; } }
#pragma unroll
            for (int i = 0; i < 8; ++i) { const int tok = tok0 + sq * sstride + (p0 + i) * pstride;
                *(unsigned*)(mix + (size_t)tok * 1024 + 512 + ch0 + 2 * cp) = cvt_pk_bf16(a0[i], a1[i]); }
        }
        __syncthreads();
    }
}
__device__ __forceinline__ void phase_c1_ln(CP p, int l, int bid, int nb) {
    const int tid = launder_tid(); const int lane = tid & 63, wave = tid >> 6;
    bf16_t* mix = (bf16_t*)(p->ws + WS_HX);
    const f32x4 g0 = *(const f32x4*)(p->conv_ln_g + l * 512 + lane * 8), g1 = *(const f32x4*)(p->conv_ln_g + l * 512 + lane * 8 + 4);
    const f32x4 b0 = *(const f32x4*)(p->conv_ln_b + l * 512 + lane * 8), b1 = *(const f32x4*)(p->conv_ln_b + l * 512 + lane * 8 + 4);
    const float gg[8] = {g0[0], g0[1], g0[2], g0[3], g1[0], g1[1], g1[2], g1[3]}, bb[8] = {b0[0], b0[1], b0[2], b0[3], b1[0], b1[1], b1[2], b1[3]};
    for (int r = bid * 8 + wave; r < R; r += nb * 8) {
        u32x4* ptr = (u32x4*)(mix + (size_t)r * 1024 + 512 + lane * 8);
        const u32x4 v = *ptr;
        float y[8] = {bflo(v.x), bfhi(v.x), bflo(v.y), bfhi(v.y), bflo(v.z), bfhi(v.z), bflo(v.w), bfhi(v.w)};
        float s = 0.f;
#pragma unroll
        for (int e = 0; e < 8; ++e) s += y[e];
        const float mu = wave_sum(s) * (1.f / 512.f);
        float q = 0.f;
#pragma unroll
        for (int e = 0; e < 8; ++e) { y[e] -= mu; q += y[e] * y[e]; }
        const float rstd = rsqrtf(wave_sum(q) * (1.f / 512.f) + 1e-5f);
        float o[8];
#pragma unroll
        for (int e = 0; e < 8; ++e) o[e] = siluf_(y[e] * rstd * gg[e] + bb[e]);
        *ptr = pack8(o);
    }
}
__device__ __forceinline__ void phase_s1(CP p, int l, unsigned char* lds_, int bid, int nb) {
    LAS unsigned char* lds = (LAS unsigned char*)lds_;
    LAS unsigned char* Bs = lds;
    LAS unsigned char* Xs = lds + 128 * ST_TR128;
    LAS float* wv = (LAS float*)(Xs + 128 * ST_X256);
    LAS float* hvs = wv + 8 * 128;
    LAS float* cwl = hvs + 4 * 520;
    const int tid = launder_tid(); const int lane = tid & 63, wave = __builtin_amdgcn_readfirstlane(tid >> 6);
    const bf16_t* proj = (const bf16_t*)(p->ws + WS_PROJ);
    const float* cw = p->ssd_conv_w + (size_t)l * 5 * 1024; const float* cbias = p->ssd_conv_b + (size_t)l * 1024;
    bf16_t* Sg = (bf16_t*)(p->ws + WS_S); float* DEC = (float*)(p->ws + WS_DEC);
    int cur_g = -1;
#pragma unroll 1
    for (int u = bid; u < NB * NCHUNK * 2; u += nb) {
        const int g = u & 1, c = (u >> 1) % NCHUNK, b = (u >> 1) / NCHUNK;
        const int row0 = b * SEG + c * 128;
        const bool lo_ok = !(c == 0 || c == 2), hi_ok = !(c == 1 || c == NCHUNK - 1);
        if (g != cur_g) { cur_g = g;
            float tw[5];
#pragma unroll
            for (int it = 0; it < 5; ++it) { const int i = tid + NTHREADS * it; const int j = i / 384, lc = i - j * 384; const int gch = lc < 128 ? 512 + g * 128 + lc : g * 256 + (lc - 128);
                tw[it] = i < 6 * 384 ? (j < 5 ? cw[j * 1024 + gch] : cbias[gch]) : 0.f; }
#pragma unroll
            for (int it = 0; it < 5; ++it) { const int i = tid + NTHREADS * it; if (i < 6 * 384) cwl[i] = tw[it]; } }
        const int hh = wave >> 1, dir = wave & 1, h = 4 * g + hh;
        u32x4 rb[8], rx0[8], rx1[8];
        conv_load(proj, row0, tid >> 4, 512 + g * 128 + (tid & 15) * 8, lo_ok, hi_ok, rb);
        conv_load(proj, row0, tid >> 5, g * 256 + (tid & 31) * 8, lo_ok, hi_ok, rx0);
        conv_load(proj, row0, (tid >> 5) + 16, g * 256 + (tid & 31) * 8, lo_ok, hi_ok, rx1);
        head_cums(p, l, row0, h, dir, lane, hvs + hh * 520);
        __syncthreads();
        {
            const LAS float* hv = hvs + hh * 520; const float tot = hv[512 + dir];
#pragma unroll
            for (int q = 0; q < 2; ++q) { const int lr = lane + 64 * q; wv[wave * 128 + lr] = __expf(tot - hv[dir * 128 + lr]) * hv[256 + dir * 128 + lr]; }
            if (lane == 0) DEC[((size_t)(b * 2 + dir) * NCHUNK + c) * 8 + h] = __expf(tot);
        }
        { float o[4][8];
          conv_compute(rb, cwl, 384, (tid & 15) * 8, o);
#pragma unroll
          for (int i = 0; i < 4; ++i) *(LAS u32x4*)(Bs + (4 * (tid >> 4) + i) * ST_TR128 + (tid & 15) * 16) = pack8(o[i]);
          conv_compute(rx0, cwl, 384, 128 + (tid & 31) * 8, o);
#pragma unroll
          for (int i = 0; i < 4; ++i) *(LAS u32x4*)(Xs + (4 * (tid >> 5) + i) * ST_X256 + (tid & 31) * 16) = pack8(o[i]);
          conv_compute(rx1, cwl, 384, 128 + (tid & 31) * 8, o);
#pragma unroll
          for (int i = 0; i < 4; ++i) *(LAS u32x4*)(Xs + (4 * ((tid >> 5) + 16) + i) * ST_X256 + (tid & 31) * 16) = pack8(o[i]); }
        __syncthreads();
        {
            f32x16 acc[2][4];
#pragma unroll
            for (int t = 0; t < 2; ++t)
#pragma unroll
                for (int q = 0; q < 4; ++q)
#pragma unroll
                    for (int e = 0; e < 16; ++e) acc[t][q][e] = 0.f;
#pragma unroll 2
            for (int kk = 0; kk < 8; ++kk) {
                const LAS float* wp = wv + wave * 128 + 16 * kk + 8 * (lane >> 5);
                const f32x4 w0 = *(const LAS f32x4*)wp, w1 = *(const LAS f32x4*)(wp + 4);
                bf16x8 af[2];
#pragma unroll
                for (int t = 0; t < 2; ++t) af[t] = scale_frag(tr_frag(Xs, ST_X256, 16 * kk, hh * 64 + 32 * t, lane), w0, w1);
#pragma unroll
                for (int q = 0; q < 4; ++q) { const bf16x8 bf = tr_frag(Bs, ST_TR128, 16 * kk, 32 * q, lane);
#pragma unroll
                    for (int t = 0; t < 2; ++t) acc[t][q] = __builtin_amdgcn_mfma_f32_32x32x16_bf16(bf, af[t], acc[t][q], 0, 0, 0); }
            }
            bf16_t* So = Sg + ((size_t)((b * 2 + dir) * NCHUNK + c) * 8 + h) * 8192 + (size_t)(lane & 31) * 128 + 4 * (lane >> 5);
#pragma unroll
            for (int t = 0; t < 2; ++t)
#pragma unroll
                for (int q = 0; q < 4; ++q)
#pragma unroll
                    for (int rg = 0; rg < 4; ++rg) { u32x2 pk; pk.x = cvt_pk_bf16(acc[t][q][4 * rg], acc[t][q][4 * rg + 1]); pk.y = cvt_pk_bf16(acc[t][q][4 * rg + 2], acc[t][q][4 * rg + 3]);
                        *(u32x2*)(So + (size_t)(32 * t) * 128 + 32 * q + 8 * rg) = pk; }
        }
        __syncthreads();
    }
}
__device__ __forceinline__ void phase_s2(CP p, int bid, int nb) {
    const int tid = launder_tid();
    const bf16_t* Sg = (const bf16_t*)(p->ws + WS_S); const float* DEC = (const float*)(p->ws + WS_DEC); bf16_t* HP = (bf16_t*)(p->ws + WS_HP);
    for (int idx = bid * NTHREADS + tid; idx < 2 * 2 * 8 * 64 * 64; idx += nb * NTHREADS) {
        const int n2 = idx & 63, pr = (idx >> 6) & 63, h = (idx >> 12) & 7, dir = (idx >> 15) & 1, b = idx >> 16;
        const size_t inner = (size_t)h * 8192 + pr * 128 + 2 * n2;
        const size_t cbase = (size_t)(b * 2 + dir) * NCHUNK;
        float s0 = 0.f, s1 = 0.f;
#pragma unroll 26
        for (int step = 0; step < NCHUNK; ++step) {
            const int c = dir == 0 ? step : (step < 2 ? 1 - step : NCHUNK + 1 - step);
            const size_t off = (cbase + c) * 65536 + inner;
            const unsigned sv = *(const unsigned*)(Sg + off); const float d = DEC[(cbase + c) * 8 + h];
            *(unsigned*)(HP + off) = cvt_pk_bf16(s0, s1);
            s0 = s0 * d + bflo(sv); s1 = s1 * d + bfhi(sv);
        }
    }
}
__device__ __forceinline__ void phase_s3(CP p, int l, unsigned char* lds_, int bid, int nb) {
    LAS unsigned char* lds = (LAS unsigned char*)lds_;
    LAS unsigned char* Cs = lds;
    LAS unsigned char* Bs = Cs + 128 * ST_ROW;
    LAS unsigned char* Mt = Bs;
    LAS unsigned char* Xs = Bs + 128 * ST_MT;
    LAS unsigned char* Hf = Xs + 128 * ST_TR64;
    LAS unsigned char* Hb = Hf + 64 * ST_ROW;
    LAS float* hvs = (LAS float*)(Hb + 64 * ST_ROW);
    LAS float* ssqp = hvs + 4 * 776;
    LAS float* cwl = ssqp + 256;
    const int tid0 = launder_tid(); const int wave = __builtin_amdgcn_readfirstlane(tid0 >> 6);
    const bf16_t* proj = (const bf16_t*)(p->ws + WS_PROJ); bf16_t* mix = (bf16_t*)(p->ws + WS_HX);
    const float* cw = p->ssd_conv_w + (size_t)l * 5 * 1024; const float* cbias = p->ssd_conv_b + (size_t)l * 1024;
    const bf16_t* HP = (const bf16_t*)(p->ws + WS_HP); float* SSQ = (float*)(p->ws + WS_SSQ);
    int cur_g = -1;
    const int cskip = (l == DEPTH - 1) ? 2 : 0, cpb = NCHUNK - cskip;
    const int nunits = NB * cpb * 2, nfull = nunits - nunits % nb, nitems = nfull + (nunits - nfull) * 4;
#pragma unroll 1
    for (int it = bid; it < nitems; it += nb) {
        const int u = it < nfull ? it : nfull + ((it - nfull) >> 2);
        const int hh_lo = it < nfull ? 0 : ((it - nfull) & 3), hh_hi = it < nfull ? 4 : hh_lo + 1;
        const int g = u & 1, c = cskip + (u >> 1) % cpb, b = (u >> 1) / cpb;
        int tid = tid0; asm volatile("" : "+v"(tid));
        const int lane = tid & 63;
        const int row0 = b * SEG + c * 128;
        const bool lo_ok = !(c == 0 || c == 2), hi_ok = !(c == 1 || c == NCHUNK - 1);
        if (g != cur_g) { cur_g = g;
            float tw[6];
#pragma unroll
            for (int it = 0; it < 6; ++it) { const int i = tid + NTHREADS * it; const int j = i >> 9, lc = i & 511; const int gch = lc < 128 ? 768 + g * 128 + lc : (lc < 256 ? 512 + g * 128 + (lc - 128) : g * 256 + (lc - 256));
                tw[it] = j < 5 ? cw[j * 1024 + gch] : cbias[gch]; }
#pragma unroll
            for (int it = 0; it < 6; ++it) cwl[tid + NTHREADS * it] = tw[it]; }
        u32x4 rx[8];
        {
            u32x4 r0[8], r1[8];
            const int cg = tid & 31; const int gch = (cg < 16 ? 768 : 512) + g * 128 + (cg & 15) * 8;
            conv_load(proj, row0, tid >> 5, gch, lo_ok, hi_ok, r0);
            conv_load(proj, row0, (tid >> 5) + 16, gch, lo_ok, hi_ok, r1);
            head_cums(p, l, row0, 4 * g + (wave >> 1), wave & 1, lane, hvs + (wave >> 1) * 776);
            { LAS float* hvw = hvs + (wave >> 1) * 776; const int dr = wave & 1;
              hvw[520 + dr * 128 + 2 * lane] = __expf(hvw[dr * 128 + 2 * lane]); hvw[520 + dr * 128 + 2 * lane + 1] = __expf(hvw[dr * 128 + 2 * lane + 1]); }
            __syncthreads();
            float o[4][8];
            LAS unsigned char* dst = (cg < 16 ? Cs : Bs) + (cg & 15) * 16;
            conv_compute(r0, cwl, 512, cg * 8, o);
#pragma unroll
            for (int i = 0; i < 4; ++i) *(LAS u32x4*)(dst + (4 * (tid >> 5) + i) * ST_ROW) = pack8(o[i]);
            asm volatile("" ::: "memory");
            if (tid < 256) conv_load(proj, row0, tid >> 3, g * 256 + hh_lo * 64 + (tid & 7) * 8, lo_ok, hi_ok, rx);
            conv_compute(r1, cwl, 512, cg * 8, o);
#pragma unroll
            for (int i = 0; i < 4; ++i) *(LAS u32x4*)(dst + (4 * ((tid >> 5) + 16) + i) * ST_ROW) = pack8(o[i]);
            if (tid < 256) { conv_compute(rx, cwl, 512, 256 + hh_lo * 64 + (tid & 7) * 8, o);
#pragma unroll
                for (int i = 0; i < 4; ++i) *(LAS u32x4*)(Xs + (4 * (tid >> 3) + i) * ST_TR64 + (tid & 7) * 16) = pack8(o[i]); }
        }
        __syncthreads();
        const int lb = wave >> 1, hs = wave & 1;
        int ln = lane; asm volatile("" : "+v"(ln));
        f32x16 gacc[2];
#pragma unroll
        for (int t = 0; t < 2; ++t)
#pragma unroll
            for (int e = 0; e < 16; ++e) gacc[t][e] = 0.f;
#pragma unroll
        for (int kk = 0; kk < 8; ++kk) { const bf16x8 af = row_frag(Cs, ST_ROW, 32 * lb, 16 * kk, lane);
#pragma unroll
            for (int t = 0; t < 2; ++t) { const bf16x8 bf = row_frag(Bs, ST_ROW, 64 * hs + 32 * t, 16 * kk, lane);
                gacc[t] = __builtin_amdgcn_mfma_f32_32x32x16_bf16(af, bf, gacc[t], 0, 0, 0); } }
        u32x4 hreg[4];
        { const bf16_t* hp0 = HP + ((size_t)(b * 2 * NCHUNK + c) * 8 + 4 * g + hh_lo) * 8192;
#pragma unroll
          for (int q = 0; q < 4; ++q) { const int it = tid + 512 * q; hreg[q] = *(const u32x4*)(hp0 + (size_t)(it >> 10) * NCHUNK * 8 * 8192 + (it & 1023) * 8); } }
        __syncthreads();
#pragma unroll 1
        for (int hh = hh_lo; hh < hh_hi; ++hh) {
            const int h = 4 * g + hh; const LAS float* hv = hvs + hh * 776;
            asm volatile("" : "+v"(ln));
            const int ph = hs, pc = 32 * ph + (ln & 31);
#pragma unroll
            for (int t = 0; t < 2; ++t) {
                const int st = 2 * hs + t;
                const int sc = 32 * st + (ln & 31);
                const float cfs = hv[sc], cbs = hv[128 + sc], dfs = hv[256 + sc], dbs = hv[384 + sc];
#pragma unroll
                for (int rg = 0; rg < 4; ++rg) {
                    const int l0 = 32 * lb + 8 * rg + 4 * (ln >> 5);
                    float m[4];
                    if (st < lb) {
                        const f32x4 cfl = *(const LAS f32x4*)(hv + l0);
#pragma unroll
                        for (int e = 0; e < 4; ++e) m[e] = gacc[t][4 * rg + e] * (__expf(cfl[e] - cfs) * dfs);
                    } else if (st > lb) {
                        const f32x4 cbl = *(const LAS f32x4*)(hv + 128 + l0);
#pragma unroll
                        for (int e = 0; e < 4; ++e) m[e] = gacc[t][4 * rg + e] * (__expf(cbl[e] - cbs) * dbs);
                    } else {
                        const f32x4 cfl = *(const LAS f32x4*)(hv + l0), cbl = *(const LAS f32x4*)(hv + 128 + l0);
#pragma unroll
                        for (int e = 0; e < 4; ++e) { const int lr = l0 + e;
                            const float ff = lr >= sc ? __expf(cfl[e] - cfs) * dfs : 0.f;
                            const float fb = lr <= sc ? __expf(cbl[e] - cbs) * dbs : 0.f;
                            m[e] = gacc[t][4 * rg + e] * (ff + fb); }
                    }
                    u32x2 pk; pk.x = cvt_pk_bf16(m[0], m[1]); pk.y = cvt_pk_bf16(m[2], m[3]);
                    *(LAS u32x2*)(Mt + sc * ST_MT + l0 * 2) = pk;
                }
            }
#pragma unroll
            for (int q = 0; q < 4; ++q) { const int it = tid + 512 * q; const int q2 = it & 1023;
                *(LAS u32x4*)(((it >> 10) ? Hb : Hf) + (q2 >> 4) * ST_ROW + (q2 & 15) * 16) = hreg[q]; }
            if (hh + 1 < hh_hi) {
                const bf16_t* hp0 = HP + ((size_t)(b * 2 * NCHUNK + c) * 8 + h + 1) * 8192;
#pragma unroll
                for (int q = 0; q < 4; ++q) { const int it = tid + 512 * q; hreg[q] = *(const u32x4*)(hp0 + (size_t)(it >> 10) * NCHUNK * 8 * 8192 + (it & 1023) * 8); }
                if (tid < 256) conv_load(proj, row0, tid >> 3, g * 256 + (hh + 1) * 64 + (tid & 7) * 8, lo_ok, hi_ok, rx);
            }
            unsigned zraw[8];
#pragma unroll
            for (int ri = 0; ri < 16; ri += 2) { const int lr = 32 * lb + 8 * (ri >> 2) + 4 * (ln >> 5) + (ri & 3);
                const bf16_t* zp = proj + (size_t)(row0 + lr) * NPROJ + 1024 + h * 64 + pc;
                zraw[ri >> 1] = (unsigned)zp[0] | ((unsigned)zp[NPROJ] << 16); }
            __syncthreads();
            f32x16 ad, af_, ab_;
#pragma unroll
            for (int e = 0; e < 16; ++e) { ad[e] = 0.f; af_[e] = 0.f; ab_[e] = 0.f; }
#pragma unroll
            for (int kk = 0; kk < 8; ++kk) {
                const bf16x8 am = tr_frag(Mt, ST_MT, 16 * kk, 32 * lb, lane);
                const bf16x8 bx = tr_frag(Xs, ST_TR64, 16 * kk, 32 * ph, lane);
                ad = __builtin_amdgcn_mfma_f32_32x32x16_bf16(am, bx, ad, 0, 0, 0);
                const bf16x8 ac = row_frag(Cs, ST_ROW, 32 * lb, 16 * kk, lane);
                const bf16x8 bhf = row_frag(Hf, ST_ROW, 32 * ph, 16 * kk, lane);
                const bf16x8 bhb = row_frag(Hb, ST_ROW, 32 * ph, 16 * kk, lane);
                af_ = __builtin_amdgcn_mfma_f32_32x32x16_bf16(ac, bhf, af_, 0, 0, 0);
                ab_ = __builtin_amdgcn_mfma_f32_32x32x16_bf16(ac, bhb, ab_, 0, 0, 0);
            }
            const float dsk = p->d_skip[l * 8 + h];
#pragma unroll
            for (int rg = 0; rg < 4; ++rg) {
                const int l0 = 32 * lb + 8 * rg + 4 * (ln >> 5);
                const f32x4 efl = *(const LAS f32x4*)(hv + 520 + l0), ebl = *(const LAS f32x4*)(hv + 648 + l0);
#pragma unroll
                for (int e = 0; e < 4; ++e) { const int lr = l0 + e; const int ri = 4 * rg + e;
                    const float xs = bf2f(*(const LAS bf16_t*)(Xs + lr * ST_TR64 + pc * 2));
                    const float y = ad[ri] + efl[e] * af_[ri] + ebl[e] * ab_[ri] + dsk * xs;
                    const float z = (ri & 1) ? bfhi(zraw[ri >> 1]) : bflo(zraw[ri >> 1]);
                    const float val = y * siluf_(z);
                    mix[(size_t)(row0 + lr) * 1024 + h * 64 + pc] = f2bf(val);
                    const float sq = half_sum32(val * val);
                    if ((ln & 31) == 31) ssqp[ph * 128 + lr] = sq;
                }
            }
            __syncthreads();
            if (tid < 128) SSQ[(size_t)(row0 + tid) * 8 + h] = ssqp[tid] + ssqp[128 + tid];
            if (hh + 1 < hh_hi && tid < 256) { float o[4][8];
                conv_compute(rx, cwl, 512, 256 + (hh + 1) * 64 + (tid & 7) * 8, o);
#pragma unroll
                for (int i = 0; i < 4; ++i) *(LAS u32x4*)(Xs + (4 * (tid >> 3) + i) * ST_TR64 + (tid & 7) * 16) = pack8(o[i]); }
        }
        __syncthreads();
    }
}
__device__ __forceinline__ void phase_r2(CP p, int l, unsigned char* lds_, int bid, int nb) {
    LAS unsigned char* lds = (LAS unsigned char*)lds_;
    LAS unsigned char* Wh = lds;
    LAS unsigned char* Xh = Wh + 32 * ST_H16;
    LAS float* gm = (LAS float*)(Xh + 16 * ST_H16);
    LAS float* sh = gm + 3 * 1024;
    LAS float* part = sh + 3 * 1024;
    LAS float* lgs = part + 8 * 16 * 32;
    LAS int* lcnt = (LAS int*)(lgs + 16 * 32);
    LAS int* lcls = lcnt + 64;
    LAS int* lrank = lcls + 512;
    LAS float* lcwa = (LAS float*)(lrank + 512);
    LAS float* lcwb = lcwa + 512;
    const int tid = launder_tid(); const int lane = tid & 63, wave = __builtin_amdgcn_readfirstlane(tid >> 6);
    const float* mod = (const float*)(p->ws + WS_MOD) + (size_t)l * 3 * 6144;
    {
        float tmp[8];
#pragma unroll
        for (int it = 0; it < 8; ++it) tmp[it] = p->w_rg[(size_t)l * 4096 + tid + NTHREADS * it];
#pragma unroll
        for (int it = 0; it < 8; ++it) { const int idx = tid + NTHREADS * it; *(LAS _Float16*)(Wh + (idx & 3) * ST_H16 + (idx >> 2) * 2) = (_Float16)tmp[it]; } }
#pragma unroll
    for (int hb = 0; hb < 2; ++hb) { float tmp[16];
#pragma unroll
        for (int it = 0; it < 16; ++it) tmp[it] = p->w_re[(size_t)l * 16384 + tid + NTHREADS * (16 * hb + it)];
#pragma unroll
        for (int it = 0; it < 16; ++it) { const int idx = tid + NTHREADS * (16 * hb + it); *(LAS _Float16*)(Wh + (4 + (idx & 15)) * ST_H16 + (idx >> 4) * 2) = (_Float16)tmp[it]; } }
    { unsigned zz; asm volatile("v_mov_b32 %0, 0" : "=v"(zz));
      for (int i = tid; i < 12 * 128; i += NTHREADS) { const int rw = 20 + i / 128, c16 = i % 128; *(LAS u32x4*)(Wh + rw * ST_H16 + c16 * 16) = (u32x4){zz, zz, zz, zz}; } }
    { float t0[6], t1[6], t2[6];
#pragma unroll
      for (int it = 0; it < 6; ++it) { const int idx = tid + NTHREADS * it; const int v = idx >> 10, k = idx & 1023; t0[it] = p->g_ffn[l * 1024 + k]; t1[it] = mod[v * 6144 + 4 * 1024 + k]; t2[it] = mod[v * 6144 + 3 * 1024 + k]; }
#pragma unroll
      for (int it = 0; it < 6; ++it) { const int idx = tid + NTHREADS * it; gm[idx] = t0[it] * (1.f + t1[it]); sh[idx] = t2[it]; } }
    if (tid < 64) lcnt[tid] = 0;
    __syncthreads();
    bf16_t* HM = (bf16_t*)(p->ws + WS_HX); float* CWLA = (float*)(p->ws + WS_CWLA); float* CWLB = (float*)(p->ws + WS_CWLB);
    int* gcount = (int*)(p->ws + WS_CTL) + l * 32; int* LIST = (int*)(p->ws + WS_LIST);
    const int rpb = (R + nb - 1) / nb, r0 = bid * rpb, r1 = (r0 + rpb) < R ? (r0 + rpb) : R;
    RowRaw xn[2];
#pragma unroll
    for (int q = 0; q < 2; ++q) if (r0 + 2 * wave + q < r1) row_load(p, 1, r0 + 2 * wave + q, lane, xn[q]);
#pragma unroll 1
    for (int t0r = r0; t0r < r1; t0r += 16) {
        f32x4 xv[2][4];
#pragma unroll
        for (int q = 0; q < 2; ++q) row_cvt(1, xn[q], xv[q]);
#pragma unroll
        for (int q = 0; q < 2; ++q) if (t0r + 16 + 2 * wave + q < r1) row_load(p, 1, t0r + 16 + 2 * wave + q, lane, xn[q]);
#pragma unroll
        for (int q = 0; q < 2; ++q) { const int rr = t0r + 2 * wave + q; const bool ok = rr < r1; const int v = row_v(ok ? rr : r0);
            float ss = 0.f;
#pragma unroll
            for (int j = 0; j < 4; ++j) ss += xv[q][j][0] * xv[q][j][0] + xv[q][j][1] * xv[q][j][1] + xv[q][j][2] * xv[q][j][2] + xv[q][j][3] * xv[q][j][3];
            ss = wave_sum(ss); const float rs = ok ? rsqrtf(ss * (1.f / 1024.f) + 1e-6f) : 0.f;
#pragma unroll
            for (int j = 0; j < 4; ++j) { const int k = 4 * lane + 256 * j; const f32x4 g4 = *(const LAS f32x4*)(gm + v * 1024 + k), s4 = *(const LAS f32x4*)(sh + v * 1024 + k);
                f32x4 hv = xv[q][j] * rs * g4 + s4; if (!ok) hv = hv * 0.f;
                u32x2 o; o.x = cvt_pk_bf16(hv[0], hv[1]); o.y = cvt_pk_bf16(hv[2], hv[3]);
                if (ok) *(u32x2*)(HM + (size_t)rr * 1024 + k) = o;
                u32x2 h16; h16.x = pack_f16(hv[0], hv[1]); h16.y = pack_f16(hv[2], hv[3]);
                *(LAS u32x2*)(Xh + (2 * wave + q) * ST_H16 + k * 2) = h16; } }
        __syncthreads();
        {
            f32x4 acc0 = {0.f, 0.f, 0.f, 0.f}, acc1 = {0.f, 0.f, 0.f, 0.f};
#pragma unroll
            for (int s4 = 0; s4 < 4; ++s4) { const int kb = (128 * wave + 32 * s4 + 8 * (lane >> 4)) * 2;
                const f16x8 a = *(const LAS f16x8*)(Xh + (lane & 15) * ST_H16 + kb);
                const f16x8 b0 = *(const LAS f16x8*)(Wh + (lane & 15) * ST_H16 + kb), b1 = *(const LAS f16x8*)(Wh + (16 + (lane & 15)) * ST_H16 + kb);
                acc0 = __builtin_amdgcn_mfma_f32_16x16x32_f16(a, b0, acc0, 0, 0, 0);
                acc1 = __builtin_amdgcn_mfma_f32_16x16x32_f16(a, b1, acc1, 0, 0, 0); }
#pragma unroll
            for (int e = 0; e < 4; ++e) { const int row = 4 * (lane >> 4) + e; part[(wave * 16 + row) * 32 + (lane & 15)] = acc0[e]; part[(wave * 16 + row) * 32 + 16 + (lane & 15)] = acc1[e]; }
        }
        __syncthreads();
        if (tid < 320) { const int row = tid / 20, n = tid - row * 20; float sacc = n < 4 ? p->b_rg[l * 4 + n] : p->b_re[l * 16 + n - 4];
#pragma unroll
            for (int w = 0; w < 8; ++w) sacc += part[(w * 16 + row) * 32 + n];
            lgs[row * 32 + n] = sacc; }
        __syncthreads();
        if (tid < 16) { const int rr = t0r + tid;
            if (rr < r1) {
                if (l == DEPTH - 1 && row_v(rr) == 2) lcls[rr - r0] = -1;
                else {
                    float lg[20];
#pragma unroll
                    for (int n = 0; n < 20; ++n) lg[n] = lgs[tid * 32 + n];
                    int gsel = 0; float gmax = lg[0];
#pragma unroll
                    for (int t = 1; t < 4; ++t) if (lg[t] > gmax) { gmax = lg[t]; gsel = t; }
                    float gden = 0.f;
#pragma unroll
                    for (int t = 0; t < 4; ++t) gden += __expf(lg[t] - gmax);
                    const float gprob = 1.f / gden;
                    float el[4];
#pragma unroll
                    for (int t = 0; t < 4; ++t) el[t] = gsel == 0 ? lg[4 + t] : (gsel == 1 ? lg[8 + t] : (gsel == 2 ? lg[12 + t] : lg[16 + t]));
                    int i0 = 0; float m0 = el[0];
#pragma unroll
                    for (int t = 1; t < 4; ++t) if (el[t] > m0) { m0 = el[t]; i0 = t; }
                    int i1 = -1; float m1 = -3.0e38f;
#pragma unroll
                    for (int t = 0; t < 4; ++t) if (t != i0 && el[t] > m1) { m1 = el[t]; i1 = t; }
                    const float w0 = gprob / (1.f + __expf(m1 - m0)), w1 = gprob - w0;
                    const int ea = i0 < i1 ? i0 : i1, eb = i0 < i1 ? i1 : i0;
                    const float cwa = i0 < i1 ? w0 : w1, cwb = i0 < i1 ? w1 : w0;
                    const int pidx = ea == 0 ? eb - 1 : (ea == 1 ? eb + 1 : 5);
                    const int cls = gsel * 6 + pidx;
                    const int rank = __hip_atomic_fetch_add(&lcnt[cls], 1, __ATOMIC_RELAXED, __HIP_MEMORY_SCOPE_WORKGROUP);
                    lcls[rr - r0] = cls; lrank[rr - r0] = rank; lcwa[rr - r0] = cwa; lcwb[rr - r0] = cwb;
                } } }
    }
    __syncthreads();
    if (tid < NCLS) lcnt[32 + tid] = atomicAdd(&gcount[tid], lcnt[tid]);
    __syncthreads();
    for (int idx = tid; idx < r1 - r0; idx += NTHREADS) { const int cl = lcls[idx]; if (cl < 0) continue; const int pos = lcnt[32 + cl] + lrank[idx]; const size_t li = (size_t)cl * R + pos;
        LIST[li] = r0 + idx; CWLA[li] = lcwa[idx]; CWLB[li] = lcwb[idx]; }
    __syncthreads();
}
__device__ __forceinline__ void phase_final(CP p, unsigned char* lds, int bid, int nb) {
    const int tid = launder_tid(); const int lane = tid & 63, wave = tid >> 6;
    const int qstep = nb * 8;
    RowRaw xn;
    { const int q = bid * 8 + wave; if (q < NB * SEQ) { const int b = q >= SEQ ? 1 : 0; row_load(p, 1, b * SEG + CTXL + (q - b * SEQ), lane, xn); } }
    for (int q = bid * 8 + wave; q < NB * SEQ; q += qstep) {
        f32x4* hr = (f32x4*)(p->out + (size_t)q * D);
        f32x4 xv[4]; float ss = 0.f;
        row_cvt(1, xn, xv);
        { const int qn = q + qstep; if (qn < NB * SEQ) { const int bn = qn >= SEQ ? 1 : 0; row_load(p, 1, bn * SEG + CTXL + (qn - bn * SEQ), lane, xn); } }
#pragma unroll
        for (int j = 0; j < 4; ++j) ss += xv[j][0] * xv[j][0] + xv[j][1] * xv[j][1] + xv[j][2] * xv[j][2] + xv[j][3] * xv[j][3];
        ss = wave_sum(ss); const float rs = rsqrtf(ss * (1.f / 1024.f) + 1e-6f);
#pragma unroll
        for (int j = 0; j < 4; ++j) { const f32x4 g4 = *(const f32x4*)(p->g_final + 4 * lane + 256 * j); hr[lane + 64 * j] = xv[j] * rs * g4; }
    }
}


#define XB_TMO      128
#define XB_XCNT(j)  (256  + 64 * (j))
#define XB_XSUB(j)  (1280 + 64 * (j))
#define XB_XGEN(j)  (2304 + 64 * (j))
#define XB_TOP      3328
#define XB_TOPGEN   3392
#define XCD_BAR_WORDS 3456
#define XB_SPIN_CAP (1u << 22)
__device__ __forceinline__ unsigned xb_ld(unsigned* p) { return __hip_atomic_load(p, __ATOMIC_RELAXED, __HIP_MEMORY_SCOPE_AGENT); }
__device__ __forceinline__ unsigned xb_add(unsigned* p, unsigned v) { return __hip_atomic_fetch_add(p, v, __ATOMIC_RELAXED, __HIP_MEMORY_SCOPE_AGENT); }
__device__ __forceinline__ unsigned xb_xcc_id() { return (unsigned)__builtin_amdgcn_s_getreg((3 << 11) | 20) & 0xFu; }
#define XB_SPIN(cond, bar) do { unsigned _sp = 0; while (cond) { __builtin_amdgcn_s_sleep(1); \
    if ((++_sp & 255u) == 0u) { if (xb_ld(&(bar)[XB_TMO])) break; if (_sp > XB_SPIN_CAP) { atomicAdd(&(bar)[XB_TMO], 1u); break; } } } } while (0)
struct XcdBarrier { unsigned* bar; unsigned x; volatile LAS unsigned* st; };
__device__ __forceinline__ XcdBarrier xcd_barrier_post(unsigned* bar, volatile LAS unsigned* st) {
    XcdBarrier b; b.bar = bar; b.x = xb_xcc_id(); b.st = st;
    if (threadIdx.x == 0) (void)xb_add(&bar[XB_XCNT(b.x)], 1u);
    return b;
}
__device__ __forceinline__ void xcd_barrier_complete(unsigned* bar, unsigned x, unsigned& nloc, unsigned& nx) {
    const unsigned G = gridDim.x * gridDim.y * gridDim.z;
    unsigned sum, cnt, mine, sp = 0u;
    for (;;) {
        sum = 0u; cnt = 0u; mine = 0u;
#pragma unroll
        for (unsigned j = 0; j < 16; ++j) { const unsigned c = xb_ld(&bar[XB_XCNT(j)]); sum += c; cnt += (c > 0u) ? 1u : 0u; mine = (j == x) ? c : mine; }
        if (sum == G) break;
        __builtin_amdgcn_s_sleep(1);
        if ((++sp & 255u) == 0u) { if (xb_ld(&bar[XB_TMO])) break; if (sp > XB_SPIN_CAP) { atomicAdd(&bar[XB_TMO], 1u); break; } }
    }
    nloc = mine > 0u ? mine : 1u; nx = cnt > 0u ? cnt : 1u;
}
__device__ __forceinline__ void xcd_barrier(const XcdBarrier& b) {
    asm volatile("s_waitcnt vmcnt(0)" ::: "memory");
    __syncthreads();
    if (threadIdx.x == 0) {
        unsigned* bar = b.bar;
        __builtin_amdgcn_s_waitcnt(0);
        unsigned nloc = b.st[0], nx = b.st[1];
        if (nloc == 0u) { xcd_barrier_complete(bar, b.x, nloc, nx); b.st[0] = nloc; b.st[1] = nx; }
        const unsigned old = xb_add(&bar[XB_XSUB(b.x)], 1u);
        const unsigned gen = old / nloc;
        if (old + 1u == (gen + 1u) * nloc) {
            __builtin_amdgcn_fence(__ATOMIC_RELEASE, "agent");
            asm volatile("s_waitcnt vmcnt(0)" ::: "memory");
            const unsigned og = xb_add(&bar[XB_TOP], 1u);
            const unsigned tg = og / nx;
            if (og + 1u == (tg + 1u) * nx) xb_add(&bar[XB_TOPGEN], 1u);
            else XB_SPIN(xb_ld(&bar[XB_TOPGEN]) == tg, bar);
            __builtin_amdgcn_fence(__ATOMIC_ACQUIRE, "agent");
            xb_add(&bar[XB_XGEN(b.x)], 1u);
            asm volatile("s_waitcnt vmcnt(0)" ::: "memory");
        } else {
            XB_SPIN(xb_ld(&bar[XB_XGEN(b.x)]) == gen, bar);
            __builtin_amdgcn_fence(__ATOMIC_ACQUIRE, "agent");
            asm volatile("s_waitcnt vmcnt(0)" ::: "memory");
        }
    }
    __syncthreads();
}

#ifndef TIMING_A
#define TIMING_A -1
#endif
#ifndef TIMING_B
#define TIMING_B -1
#endif
#ifndef PHASE_MASK
#define PHASE_MASK 0xFFFFF
#endif
#define PM(i) ((PHASE_MASK >> (i)) & 1)
#ifndef REPEAT_MASK
#define REPEAT_MASK 0
#endif
#define RP(i) for (int rep_ = 0; rep_ < 1 + ((REPEAT_MASK >> (i)) & 1); ++rep_)
constexpr int PH_PER_LAYER = 9, NPHASES = 1 + DEPTH * PH_PER_LAYER + 1;
__global__ void __launch_bounds__(NTHREADS, 2) mk_fwd(Args args) {
    extern __shared__ __attribute__((aligned(16))) unsigned char lds[];
    cg::grid_group grid = cg::this_grid();
    const __attribute__((address_space(4))) Args* ap = (const __attribute__((address_space(4))) Args*)__builtin_amdgcn_kernarg_segment_ptr();
    const int lo = ap->lo, hi = ap->hi;
    LAS unsigned char* ldsl = (LAS unsigned char*)lds;
    volatile LAS unsigned* xbst = (volatile LAS unsigned*)(ldsl + LDS_BYTES - 16);
    if (threadIdx.x < 4) xbst[threadIdx.x] = 0u;
    __syncthreads();
    (void)xcd_barrier_post((unsigned*)(ap->p.ws + WS_BAR), xbst);
    if (TIMING_A >= 0 && blockIdx.x == 0 && threadIdx.x == 0) ((unsigned long long*)(ap->p.ws + WS_TS))[lo] = __builtin_amdgcn_s_memrealtime();
    for (int ph = lo; ph < hi; ++ph) {
        CP p = launder(&ap->p);
        int bid = blockIdx.x, nb = gridDim.x; asm volatile("" : "+s"(bid), "+s"(nb));
        if (ph == 0) { if (PM(0)) RP(0) phase_wprep(p, lds, 0, WPREP_ITEMS_PER_LAYER, bid, nb); if (PM(1)) RP(1) phase_adaln(p, lds, bid, nb); }
        else if (ph == NPHASES - 1) { if (PM(12)) phase_final(p, lds, bid, nb); }
        else {
            const int l = (ph - 1) / PH_PER_LAYER, s = (ph - 1) % PH_PER_LAYER;
            if (s == 0) { if (PM(2)) RP(2) { if (rep_ == 0 || l == 0) phase_r1(p, l, lds, bid, nb); } }
            else if (s == 1) { if (PM(3)) RP(3) {
                pg8::DenseSched S; S.init(p->ws + WS_HX, (const bf16_t*)(p->ws + WS_WTIN) + (size_t)l * DIN * 1024, R, NPROJ, 1024, 1024, 1024, nb, bid);
                EpiProj E{(bf16_t*)(p->ws + WS_PROJ)};
                pg8::gemm_phase<EpiProj, pg8::DenseSched, false>(ldsl, 1024, 1024, 1024, S, E);
                if (l == 0 && DEPTH > 1) { const int extra = S.nwg % nb;
                    if (extra > 0 && bid >= extra) phase_wprep(p, lds, WPREP_ITEMS_PER_LAYER, WPREP_ITEMS_PER_LAYER + 1800, bid - extra, nb - extra);
                    else if (extra == 0) phase_wprep(p, lds, WPREP_ITEMS_PER_LAYER, WPREP_ITEMS_PER_LAYER + 1800, bid, nb); }
            } }
            else if (s == 2) { if (PM(4)) RP(4) phase_c1(p, l, lds, bid, nb); if (PM(5)) RP(5) phase_s1(p, l, lds, bid, nb); }
            else if (s == 3) { if (PM(6)) RP(6) phase_s2(p, bid, nb); if (PM(4)) phase_c1_ln(p, l, bid, nb); }
            else if (s == 4) { if (PM(7)) RP(7) phase_s3(p, l, lds, bid, nb); }
            else if (s == 5) { if (PM(8)) RP(8) { if (rep_ == 0 || l == 0) {
                pg8::DenseSched S; S.init(p->ws + WS_HX, (const bf16_t*)(p->ws + WS_WTOUT) + (size_t)l * 1024 * 1024, R, 1024, 1024, 1024, 1024, nb, bid, l == DEPTH - 1);
                EpiResid<0> E{p->ctx, p->x, (bf16_t*)(p->ws + WS_H), (const float*)(p->ws + WS_MOD) + (size_t)l * 3 * 6144, (const float*)(p->ws + WS_SSQ)};
                pg8::gemm_phase<EpiResid<0>, pg8::DenseSched, false>(ldsl, 1024, 1024, 1024, S, E);
                if (l == 0 && DEPTH > 1 && rep_ == 0) { const int extra = S.nwg % nb;
                    if (extra > 0 && bid >= extra) phase_wprep(p, lds, WPREP_ITEMS_PER_LAYER + 1800, 2 * WPREP_ITEMS_PER_LAYER, bid - extra, nb - extra);
                    else if (extra == 0) phase_wprep(p, lds, WPREP_ITEMS_PER_LAYER + 1800, 2 * WPREP_ITEMS_PER_LAYER, bid, nb); }
            } } }
            else if (s == 6) { if (PM(9)) phase_r2(p, l, lds, bid, nb); }
            else if (s == 7) { if (PM(10)) RP(10) {
                LAS int* tab = (LAS int*)(ldsl + MISC_OFF); moe_table(p, l, tab);
                MoeSched S{tab, (const int*)(p->ws + WS_LIST), (const char*)(p->ws + WS_HX), (const char*)(p->ws + WS_WTGU), 0, l, nb, bid};
                EpiUp E{(bf16_t*)(p->ws + WS_HID), (const float*)(p->ws + WS_CWLA), (const float*)(p->ws + WS_CWLB)};
                pg8::gemm_phase<EpiUp, MoeSched, true>(ldsl, 1024, 1024, 1024, S, E);
            } }
            else { if (PM(11)) RP(11) {
                LAS int* tab = (LAS int*)(ldsl + MISC_OFF); moe_table(p, l, tab);
                MoeSched S{tab, (const int*)(p->ws + WS_LIST), (const char*)(p->ws + WS_HID), (const char*)(p->ws + WS_WTD), 1, l, nb, bid};
                EpiDown E{(bf16_t*)(p->ws + WS_H), (const int*)(p->ws + WS_LIST), (const float*)(p->ws + WS_MOD) + (size_t)l * 3 * 6144 + 5 * 1024};
                pg8::gemm_phase<EpiDown, MoeSched, false>(ldsl, 512, 256, 512, S, E);
            } }
        }
        if (ph + 1 < hi) { if (hi < 0) grid.sync();   else { XcdBarrier xb; xb.bar = (unsigned*)(launder(&ap->p)->ws + WS_BAR); xb.x = xb_xcc_id(); xb.st = (volatile LAS unsigned*)(ldsl + LDS_BYTES - 16); xcd_barrier(xb); }
            if (TIMING_A >= 0 && blockIdx.x == 0 && threadIdx.x == 0) ((unsigned long long*)(launder(&ap->p)->ws + WS_TS))[ph + 1] = __builtin_amdgcn_s_memrealtime(); }
    }
#if TIMING_A >= 0
    {
        XcdBarrier xb; xb.bar = (unsigned*)(launder(&ap->p)->ws + WS_BAR); xb.x = xb_xcc_id(); xb.st = (volatile LAS unsigned*)(ldsl + LDS_BYTES - 16); xcd_barrier(xb);
        if (blockIdx.x == 0 && threadIdx.x == 0) ((unsigned long long*)(launder(&ap->p)->ws + WS_TS))[hi] = __builtin_amdgcn_s_memrealtime();
        xcd_barrier(xb);
        const unsigned long long* ts = (const unsigned long long*)(launder(&ap->p)->ws + WS_TS);
        const float ta = (float)(ts[TIMING_A + 1] - ts[TIMING_A]) * 0.01f, tb = (float)(ts[TIMING_B + 1] - ts[TIMING_B]) * 0.01f;
        float* o = launder(&ap->p)->out; const float sc = 1.f + ta * 0.001f;
        for (size_t i = (size_t)blockIdx.x * NTHREADS + threadIdx.x; i < (size_t)NB * SEQ * D; i += (size_t)gridDim.x * NTHREADS) o[i] = o[i] * sc + (i == 0 ? tb * 0.1f : 0.f);
    }
#endif
}

extern "C" void kernel_launch(void* const* d_in, const int* in_sizes, int n_in, void* d_out, int out_size, void* d_ws, size_t ws_size, hipStream_t stream) {
    static int grid = 0;
    if (grid == 0) {
        if (n_in != 28 || ws_size < WS_END) { fprintf(stderr, "kernel_launch: unexpected n_in %d or ws_size %zu (< %zu)\n", n_in, ws_size, (size_t)WS_END); grid = -1; return; }
        int dev = 0, cus = 0, per_cu = 0;
        hipGetDevice(&dev); hipDeviceGetAttribute(&cus, hipDeviceAttributeMultiprocessorCount, dev);
        if (hipFuncSetAttribute((const void*)mk_fwd, hipFuncAttributeMaxDynamicSharedMemorySize, LDS_BYTES) != hipSuccess) { fprintf(stderr, "kernel_launch: hipFuncSetAttribute failed\n"); grid = -1; return; }
        if (hipOccupancyMaxActiveBlocksPerMultiprocessor(&per_cu, (const void*)mk_fwd, NTHREADS, LDS_BYTES) != hipSuccess || per_cu < 1) { fprintf(stderr, "kernel_launch: occupancy query says %d\n", per_cu); (void)hipGetLastError(); grid = -1; return; }
        grid = cus;
    }
    if (grid < 0) return;
    (void)hipMemsetAsync((char*)d_ws + WS_CTL, 0, WS_CTL_BYTES, stream);
    Args a{};
    const float** pp = (const float**)&a.p;
    for (int i = 0; i < 28; ++i) pp[i] = (const float*)d_in[i];
    a.p.out = (float*)d_out; a.p.ws = (unsigned char*)d_ws;
#if PER_PHASE_LAUNCH
    for (int ph = 0; ph < NPHASES; ++ph) {
        a.lo = ph; a.hi = ph + 1; void* kargs[] = {&a};
        hipError_t e = hipLaunchCooperativeKernel((const void*)mk_fwd, dim3(grid), dim3(NTHREADS), kargs, LDS_BYTES, stream);
        if (e != hipSuccess) { fprintf(stderr, "kernel_launch: launch of phase %d failed: %s\n", ph, hipGetErrorString(e)); break; }
    }
#else
    a.lo = 0; a.hi = NPHASES; void* kargs[] = {&a};
    hipError_t e = hipLaunchCooperativeKernel((const void*)mk_fwd, dim3(grid), dim3(NTHREADS), kargs, LDS_BYTES, stream);
    if (e != hipSuccess) fprintf(stderr, "kernel_launch: cooperative launch failed: %s (grid %d)\n", hipGetErrorString(e), grid);
#endif
}
```

```cpp
#include <hip/hip_runtime.h>
#include <hip/hip_cooperative_groups.h>
#include <cstdio>
namespace cg = cooperative_groups;

#ifndef PER_PHASE_LAUNCH
#define PER_PHASE_LAUNCH 0
#endif

#ifndef S3REP
#define S3REP 0
#endif
#define S3R(i) for (int r3_ = 0; r3_ < 1 + ((S3REP >> (i)) & 1); ++r3_)
#define LAS __attribute__((address_space(3)))
typedef unsigned short bf16_t;
typedef short bf16x8 __attribute__((ext_vector_type(8)));
typedef float f32x4 __attribute__((ext_vector_type(4)));
typedef unsigned u32x4 __attribute__((ext_vector_type(4)));
typedef unsigned u32x2 __attribute__((ext_vector_type(2)));

constexpr int D = 1024, NB = 2, SEQ = 16384, CTXL = 256, SEG = SEQ + CTXL, R = NB * SEG, DEPTH = 2;
constexpr int NPROJ = 2560, DIN = 2576;
constexpr int NTHREADS = 512;
constexpr int LDS_BYTES = 163840;
constexpr int MISC_OFF = 131072;
constexpr int NCLS = 24;

constexpr size_t al256(size_t x) { return (x + 255) & ~size_t(255); }
constexpr size_t WS_CTL = 0;
constexpr size_t WS_M1CNT = 20480;
constexpr size_t WS_TS = 2048;
constexpr size_t WS_BAR = 4096;
constexpr size_t WS_CTL_BYTES = 32768;
constexpr size_t WS_MOD = WS_CTL_BYTES;
constexpr size_t WS_WTIN = WS_MOD + al256((size_t)2 * 3 * 6144 * 4);
constexpr size_t WS_WTOUT = WS_WTIN + al256((size_t)2 * DIN * 1024 * 2);
constexpr size_t WS_WTGU = WS_WTOUT + al256((size_t)2 * 1024 * 1024 * 2);
constexpr size_t WS_WTD = WS_WTGU + al256((size_t)2 * 16 * 512 * 1024 * 2);
constexpr size_t WS_H = WS_WTD + al256((size_t)2 * 16 * 1024 * 256 * 2);
constexpr size_t WS_HX = WS_H + al256((size_t)R * 1024 * 2);
constexpr size_t WS_PROJ = WS_HX + al256((size_t)R * 1024 * 2);
constexpr size_t WS_DT = WS_PROJ + al256((size_t)R * NPROJ * 2);
constexpr size_t WS_POS = WS_DT + al256((size_t)R * 16 * 4);
constexpr size_t WS_LIST = WS_POS + al256((size_t)2 * R * 4);
constexpr size_t WS_CWLA = WS_LIST + al256((size_t)NCLS * R * 4);
constexpr size_t WS_CWLB = WS_CWLA + al256((size_t)NCLS * R * 4);
constexpr size_t WS_BIG = WS_CWLB + al256((size_t)NCLS * R * 4);
constexpr size_t WS_Y = WS_PROJ;
constexpr size_t WS_S = WS_BIG;
constexpr size_t WS_HP = WS_S + al256((size_t)2 * 2 * 130 * 8 * 8192 * 2);
constexpr size_t WS_DEC = WS_HP + al256((size_t)2 * 2 * 130 * 8 * 8192 * 2);
constexpr size_t WS_SSQ = WS_DEC + al256((size_t)2 * 2 * 130 * 8 * 4);
constexpr size_t WS_HID = WS_S;
constexpr size_t WS_END = WS_SSQ + al256((size_t)R * 8 * 4);
static_assert((size_t)(R + NCLS * 256) * 512 * 2 <= (size_t)2 * 2 * 130 * 8 * 8192 * 2, "hid alias");
static_assert(WS_END <= (size_t)512 * 1024 * 1024, "workspace");

struct Params {
    const float *x, *c, *ctx, *c_ctx, *w_ada, *b_ada, *g_mix, *g_ffn, *w_in, *conv_w, *conv_b, *conv_ln_g, *conv_ln_b, *ssd_conv_w, *ssd_conv_b,
        *dt_bias, *a_log, *d_skip, *ssd_norm_g, *w_out, *w_rg, *b_rg, *w_re, *b_re, *w_gate, *w_up, *w_down, *g_final;
    float* out; unsigned char* ws;
};
struct Args { Params p; int lo, hi; };
typedef const __attribute__((address_space(4))) Params* CP;
__device__ __forceinline__ CP launder(CP p) { asm volatile("" : "+s"(p)); return p; }
__device__ __forceinline__ int launder_tid() { int t = threadIdx.x; asm volatile("" : "+v"(t)); return t; }

__device__ __forceinline__ unsigned cvt_pk_bf16(float lo, float hi) { unsigned r; asm("v_cvt_pk_bf16_f32 %0, %1, %2" : "=v"(r) : "v"(lo), "v"(hi)); return r; }
__device__ __forceinline__ float bf2f(unsigned b) { return __uint_as_float(b << 16); }
__device__ __forceinline__ float bflo(unsigned w) { return __uint_as_float(w << 16); }
__device__ __forceinline__ float bfhi(unsigned w) { return __uint_as_float(w & 0xffff0000u); }
__device__ __forceinline__ bf16_t f2bf(float f) { return (bf16_t)(cvt_pk_bf16(f, 0.f) & 0xffffu); }
#define DPP_ADD(v, ctrl, rm) ((v) + __builtin_bit_cast(float, __builtin_amdgcn_update_dpp(0, __builtin_bit_cast(int, (v)), (ctrl), (rm), 0xF, true)))
__device__ __forceinline__ float row_sum16(float v) {
    v = DPP_ADD(v, 0xB1, 0xF);
    v = DPP_ADD(v, 0x4E, 0xF);
    v = DPP_ADD(v, 0x141, 0xF);
    v = DPP_ADD(v, 0x140, 0xF);
    return v;
}
__device__ __forceinline__ float half_sum32(float v) { v = row_sum16(v); v = DPP_ADD(v, 0x142, 0xA); return v; }
__device__ __forceinline__ float wave_sum(float v) {
    v = half_sum32(v); v = DPP_ADD(v, 0x143, 0xC);
    return __builtin_bit_cast(float, __builtin_amdgcn_readlane(__builtin_bit_cast(int, v), 63));
}
__device__ __forceinline__ float sigmoidf_(float x) { return 1.f / (1.f + __expf(-x)); }
__device__ __forceinline__ float siluf_(float x) { return x / (1.f + __expf(-x)); }
__device__ __forceinline__ float softplusf_(float x) { return fmaxf(x, 0.f) + __logf(1.f + __expf(-fabsf(x))); }

__device__ __forceinline__ int row_b(int r) { return r >= SEG ? 1 : 0; }
__device__ __forceinline__ int row_i(int r) { return r >= SEG ? r - SEG : r; }
__device__ __forceinline__ int row_v(int r) { const int i = row_i(r); return i < CTXL ? 2 : row_b(r); }
__device__ __forceinline__ const float* xin_ptr(const float* ctx, const float* x, int r) {
    const int b = row_b(r), i = row_i(r);
    return i < CTXL ? ctx + (size_t)(b * CTXL + i) * D : x + (size_t)(b * SEQ + i - CTXL) * D;
}
struct RowRaw { f32x4 f[4]; u32x2 h[4]; };
__device__ __forceinline__ void row_load(CP p, int l, int r, int lane, RowRaw& rr) {
    if (l == 0) { const f32x4* hr = (const f32x4*)xin_ptr(p->ctx, p->x, r);
#pragma unroll
        for (int j = 0; j < 4; ++j) rr.f[j] = hr[lane + 64 * j]; }
    else { const u32x2* hr = (const u32x2*)((const bf16_t*)(p->ws + WS_H) + (size_t)r * D);
#pragma unroll
        for (int j = 0; j < 4; ++j) rr.h[j] = hr[lane + 64 * j]; }
}
__device__ __forceinline__ void row_cvt(int l, const RowRaw& rr, f32x4 (&xv)[4]) {
#pragma unroll
    for (int j = 0; j < 4; ++j) xv[j] = l == 0 ? rr.f[j] : (f32x4){bflo(rr.h[j].x), bfhi(rr.h[j].x), bflo(rr.h[j].y), bfhi(rr.h[j].y)};
}
namespace pg8 {
constexpr int BM = 256, BK = 64, HALF = 128, HTB = HALF * BK * 2, STAGE_BYTES = 8 * HTB, NXCD = 8, WGM = 8;
__device__ __forceinline__ int lds_byte(int r, int c) { const int st = (r >> 4) * 2 + (c >> 5), rr = r & 15, cc = c & 31, ob = rr * 64 + cc * 2; return st * 1024 + (ob ^ (((ob >> 9) & 1) << 5)); }
__device__ __forceinline__ void stage_rc(int b, int& Rr, int& Cc) { const int st = b / 1024, sb = b % 1024, swz = sb ^ (((sb >> 9) & 1) << 5); Rr = (st >> 1) * 16 + swz / 64; Cc = (st & 1) * 32 + (swz % 64) / 2; }
__device__ __forceinline__ int perm32(int rho) { const int n = rho >> 4, i = rho & 15; return 8 * (i >> 2) + 4 * n + (i & 3); }

struct Unit {
    const char* a0;
    const char* b0;
    const char* b1;
    int i0, i1, i2, i3, i4, pad;
};

template <class Epi, class Sched, bool GATHER>
__device__ __forceinline__ void gemm_phase(LAS unsigned char* lds, const int lda, const int ldb, const int K, const Sched& S, const Epi& E) {
    const int tid = launder_tid(); const int wid = __builtin_amdgcn_readfirstlane(tid >> 6), lane = tid & 63, wr = wid >> 2, wc = wid & 3, fr = lane & 15, fq = lane >> 4;
    const int nt = K / BK, ks = nt >> 1;
    int Rr[2], Cc[2];
    unsigned voffB[2];
#pragma unroll
    for (int i = 0; i < 2; ++i) { stage_rc(tid * 16 + i * 8192, Rr[i], Cc[i]); const int Rb = Epi::PERM ? ((Rr[i] & ~31) + perm32(Rr[i] & 31)) : Rr[i];
        voffB[i] = (unsigned)(Rb * ldb + Cc[i]) * 2u; }
    const size_t kstep = (size_t)(BK * 2);
    const size_t hstepB = (size_t)HALF * ldb * 2;
    const unsigned ldsw = (unsigned)wid * 1024u;
    const unsigned ldsbase = (unsigned)(unsigned long)lds;
    const int aoff = lds_byte(wr * 64 + fr, fq * 8), boff = lds_byte(wc * 32 + fr, fq * 8);
#define PG8_SA(b, h) (((b) * 2 + (h)) * HTB)
#define PG8_SB(b, h) ((4 + (b) * 2 + (h)) * HTB)
#define PG8_STAGE2(bufoff, gbase, v0, v1) do { unsigned keep_; \
        asm volatile("s_mov_b32 %0, m0\n\ts_mov_b32 m0, %1\n\ts_nop 4\n\tglobal_load_lds_dwordx4 %2, %4\n\ts_add_u32 m0, m0, 0x2000\n\ts_nop 0\n\tglobal_load_lds_dwordx4 %3, %4\n\ts_mov_b32 m0, %0" \
            : "=&s"(keep_) : "s"(ldsbase + (unsigned)(bufoff) + ldsw), "v"(v0), "v"(v1), "s"(gbase) : "memory", "scc"); } while (0)
#define PG8_LDA(dst, b, h) do { _Pragma("unroll") for (int m = 0; m < 4; ++m) _Pragma("unroll") for (int k = 0; k < 2; ++k) dst[m][k] = *(const LAS bf16x8*)(lds + PG8_SA(b, h) + aoff + m * 2048 + k * 1024); } while (0)
#define PG8_LDB(dst, b, h) do { _Pragma("unroll") for (int n = 0; n < 2; ++n) _Pragma("unroll") for (int k = 0; k < 2; ++k) dst[n][k] = *(const LAS bf16x8*)(lds + PG8_SB(b, h) + boff + n * 2048 + k * 1024); } while (0)
#define PG8_MMA(ai, bj, At, Bt) do { __builtin_amdgcn_s_setprio(1); _Pragma("unroll") for (int m = 0; m < 4; ++m) _Pragma("unroll") for (int n = 0; n < 2; ++n) _Pragma("unroll") for (int k = 0; k < 2; ++k) \
        acc[ai][bj][m][n] = __builtin_amdgcn_mfma_f32_16x16x32_bf16(Bt[n][k], At[m][k], acc[ai][bj][m][n], 0, 0, 0); __builtin_amdgcn_s_setprio(0); } while (0)
#define PG8_WAIT_V(n) asm volatile("s_waitcnt vmcnt(" #n ")" ::: "memory")
#define PG8_WAIT_L(n) asm volatile("s_waitcnt lgkmcnt(" #n ")" ::: "memory")
#define PG8_BAR __builtin_amdgcn_s_barrier()
#define PG8_SCHED __builtin_amdgcn_sched_barrier(0)
#define PG8_BP(u, tt) ((tt) < ks ? (u).b0 + (size_t)(tt) * kstep : (u).b1 + (size_t)((tt) - ks) * kstep)
    Unit cur, nxt; int ui = 0;
    if (!S.get(0, cur)) return;
    S.a_ready(cur);
    unsigned c00, c01, c10, c11, n00, n01, n10, n11;
    if (GATHER) {
        c00 = (unsigned)(S.arow(cur, Rr[0]) * lda + Cc[0]) * 2u; c01 = (unsigned)(S.arow(cur, Rr[1]) * lda + Cc[1]) * 2u;
        c10 = (unsigned)(S.arow(cur, HALF + Rr[0]) * lda + Cc[0]) * 2u; c11 = (unsigned)(S.arow(cur, HALF + Rr[1]) * lda + Cc[1]) * 2u;
    } else {
        c00 = (unsigned)(Rr[0] * lda + Cc[0]) * 2u; c01 = (unsigned)(Rr[1] * lda + Cc[1]) * 2u;
        c10 = (unsigned)((HALF + Rr[0]) * lda + Cc[0]) * 2u; c11 = (unsigned)((HALF + Rr[1]) * lda + Cc[1]) * 2u;
    }
    n00 = c00; n01 = c01; n10 = c10; n11 = c11;
    f32x4 acc[2][2][4][2];
    float zr; asm volatile("v_mov_b32 %0, 0" : "=v"(zr));
#pragma unroll
    for (int a = 0; a < 2; ++a)
#pragma unroll
        for (int b = 0; b < 2; ++b)
#pragma unroll
            for (int m = 0; m < 4; ++m)
#pragma unroll
                for (int n = 0; n < 2; ++n) acc[a][b][m][n] = (f32x4){zr, zr, zr, zr};
    bf16x8 At[4][2], B0[2][2], B1[2][2];
    const char* cA = cur.a0;
    {
        const char* pb0 = PG8_BP(cur, 0); const char* pb1 = PG8_BP(cur, 1);
        PG8_STAGE2(PG8_SB(0, 0), pb0, voffB[0], voffB[1]); PG8_STAGE2(PG8_SA(0, 0), cA, c00, c01);
        PG8_STAGE2(PG8_SB(0, 1), pb0 + hstepB, voffB[0], voffB[1]); PG8_STAGE2(PG8_SA(0, 1), cA, c10, c11);
        if (wr == 1) PG8_BAR;
        PG8_WAIT_V(4); PG8_BAR;
        PG8_STAGE2(PG8_SB(1, 0), pb1, voffB[0], voffB[1]); PG8_STAGE2(PG8_SA(1, 0), cA + kstep, c00, c01);
        PG8_STAGE2(PG8_SB(1, 1), pb1 + hstepB, voffB[0], voffB[1]);
        PG8_WAIT_V(6); PG8_BAR;
    }
    for (;;) {
        const bool has_next = S.get(ui + 1, nxt);
        if (!has_next) nxt = cur;
        LAS int* tokb = (LAS int*)(lds + MISC_OFF + 1024) + ((ui + 1) & 1) * 256;
        if (GATHER) {
            n00 = c00; n01 = c01; n10 = c10; n11 = c11;
            if (has_next && wid == 0) {
                const char* src = (const char*)S.rows_ptr(nxt); unsigned keep_;
                asm volatile("s_mov_b32 %0, m0\n\ts_mov_b32 m0, %1\n\ts_nop 4\n\tglobal_load_lds_dwordx4 %2, %3\n\ts_mov_b32 m0, %0"
                    : "=&s"(keep_) : "s"((unsigned)(unsigned long)tokb), "v"((unsigned)lane * 16u), "s"(src) : "memory");
            }
        }
        const char* nA = nxt.a0;
#pragma unroll 1
        for (int t = 0; t < nt; t += 2) {
            const bool last = (t == nt - 2);
            if (last && has_next) S.a_ready(nxt);
            const char* a1 = cA + (size_t)(t + 1) * kstep;
            const char* a2 = last ? nA : cA + (size_t)(t + 2) * kstep;
            const char* a3 = a2 + kstep;
            const char* b2 = last ? PG8_BP(nxt, 0) : PG8_BP(cur, t + 2);
            const char* b3 = last ? PG8_BP(nxt, 1) : PG8_BP(cur, t + 3);
            if (GATHER) { if (last && has_next) {
                const int lim = S.rows_valid(nxt) - 1;
                const int i0 = Rr[0] < lim ? Rr[0] : lim, i1 = Rr[1] < lim ? Rr[1] : lim, i2 = (HALF + Rr[0]) < lim ? (HALF + Rr[0]) : lim, i3 = (HALF + Rr[1]) < lim ? (HALF + Rr[1]) : lim;
                n00 = (unsigned)(tokb[i0] * lda + Cc[0]) * 2u; n01 = (unsigned)(tokb[i1] * lda + Cc[1]) * 2u;
                n10 = (unsigned)(tokb[i2] * lda + Cc[0]) * 2u; n11 = (unsigned)(tokb[i3] * lda + Cc[1]) * 2u; } }
            const unsigned s00 = last ? n00 : c00, s01 = last ? n01 : c01, s10 = last ? n10 : c10, s11 = last ? n11 : c11;
            if constexpr (Epi::MIDSCALE) { if (t == ks) E.midscale(acc, cur, wr, wc, fr, fq); }
            PG8_LDB(B0, 0, 0); PG8_SCHED; PG8_LDA(At, 0, 0); PG8_STAGE2(PG8_SA(1, 1), a1, c10, c11);
            PG8_WAIT_L(8); PG8_BAR; PG8_WAIT_L(0); PG8_MMA(0, 0, At, B0); PG8_BAR; PG8_SCHED;
            PG8_LDB(B1, 0, 1); PG8_STAGE2(PG8_SB(0, 0), b2, voffB[0], voffB[1]);
            PG8_BAR; PG8_WAIT_L(0); PG8_MMA(0, 1, At, B1); PG8_BAR;
            PG8_LDA(At, 0, 1); PG8_STAGE2(PG8_SA(0, 0), a2, s00, s01);
            PG8_BAR; PG8_WAIT_L(0); PG8_MMA(1, 0, At, B0); PG8_BAR; PG8_SCHED;
            PG8_STAGE2(PG8_SB(0, 1), b2 + hstepB, voffB[0], voffB[1]);
            PG8_WAIT_V(6); PG8_BAR; PG8_MMA(1, 1, At, B1); PG8_BAR;
            PG8_LDB(B0, 1, 0); PG8_SCHED; PG8_LDA(At, 1, 0); PG8_STAGE2(PG8_SA(0, 1), a2, s10, s11);
            PG8_WAIT_L(8); PG8_BAR; PG8_WAIT_L(0); PG8_MMA(0, 0, At, B0); PG8_BAR; PG8_SCHED;
            PG8_LDB(B1, 1, 1); PG8_STAGE2(PG8_SB(1, 0), b3, voffB[0], voffB[1]);
            PG8_BAR; PG8_WAIT_L(0); PG8_MMA(0, 1, At, B1); PG8_BAR;
            PG8_LDA(At, 1, 1); PG8_STAGE2(PG8_SA(1, 0), a3, s00, s01);
            PG8_BAR; PG8_WAIT_L(0); PG8_MMA(1, 0, At, B0); PG8_BAR; PG8_SCHED;
            PG8_STAGE2(PG8_SB(1, 1), b3 + hstepB, voffB[0], voffB[1]);
            PG8_WAIT_V(6); PG8_BAR; PG8_MMA(1, 1, At, B1); PG8_BAR;
        }
        E(acc, cur, wr, wc, fr, fq);
        if (!has_next) break;
        asm volatile("v_mov_b32 %0, 0" : "=v"(zr));
#pragma unroll
        for (int a = 0; a < 2; ++a)
#pragma unroll
            for (int b = 0; b < 2; ++b)
#pragma unroll
                for (int m = 0; m < 4; ++m)
#pragma unroll
                    for (int n = 0; n < 2; ++n) acc[a][b][m][n] = (f32x4){zr, zr, zr, zr};
        cur = nxt; cA = nA; ++ui; c00 = n00; c01 = n01; c10 = n10; c11 = n11;
    }
    PG8_WAIT_V(0);
    if (wr == 0) PG8_BAR;
    PG8_BAR;
#undef PG8_SA
#undef PG8_SB
#undef PG8_STAGE2
#undef PG8_LDA
#undef PG8_LDB
#undef PG8_MMA
#undef PG8_WAIT_V
#undef PG8_WAIT_L
#undef PG8_BAR
#undef PG8_SCHED
#undef PG8_BP
}

struct DenseSched {
    const char* A; const char* Bt; int lda, ldb, K; int nM, nN, nwg, G, c, skipctx;
    __device__ __forceinline__ void init(const void* A_, const void* Bt_, int M, int N, int K_, int lda_, int ldb_, int G_, int c_, int skipctx_ = 0) {
        A = (const char*)A_; Bt = (const char*)Bt_; lda = lda_; ldb = ldb_; K = K_; nM = M / BM - 2 * skipctx_; nN = N / BM; nwg = nM * nN; G = G_; c = c_; skipctx = skipctx_; }
    __device__ __forceinline__ bool get(int i, Unit& u) const {
        const long L = (long)i * G + c; if (L >= nwg) return false;
        int wgid = (int)L; { const int q = nwg / NXCD, r = nwg % NXCD, xcd = wgid % NXCD, off = wgid / NXCD; wgid = (xcd < r ? xcd * (q + 1) : r * (q + 1) + (xcd - r) * q) + off; }
        const int nig = WGM * nN, gid = wgid / nig, fm = gid * WGM, gsz = (nM - fm) < WGM ? (nM - fm) : WGM;
        int pm = fm + ((wgid % nig) % gsz); const int pn = (wgid % nig) / gsz;
        if (skipctx) pm += 1 + (pm >= 64 ? 1 : 0);
        u.a0 = A + (size_t)pm * BM * lda * 2; u.b0 = Bt + (size_t)pn * BM * ldb * 2; u.b1 = u.b0 + (size_t)(K / BK / 2) * BK * 2;
        u.i0 = pm; u.i1 = pn; u.i2 = 0; u.i3 = 0; u.i4 = 0; u.pad = 0; return true;
    }
    __device__ __forceinline__ void a_ready(const Unit&) const {}
    __device__ __forceinline__ int arow(const Unit&, int rl) const { return rl; }
    __device__ __forceinline__ const int* rows_ptr(const Unit&) const { return nullptr; }
    __device__ __forceinline__ int rows_valid(const Unit&) const { return 256; }
};
}

struct EpiProj {
    static constexpr bool PERM = true, MIDSCALE = false;
    bf16_t* O;
    __device__ __forceinline__ void operator()(const f32x4 (&acc)[2][2][4][2], const pg8::Unit& u, int wr, int wc, int fr, int fq) const {
        const int row0 = u.i0 * 256 + wr * 64 + fr, col0 = u.i1 * 256 + wc * 32 + 8 * fq;
#pragma unroll
        for (int ai = 0; ai < 2; ++ai)
#pragma unroll
            for (int m = 0; m < 4; ++m) { bf16_t* rowp = O + (size_t)(row0 + ai * 128 + m * 16) * NPROJ + col0;
#pragma unroll
                for (int bj = 0; bj < 2; ++bj) { const f32x4 v0 = acc[ai][bj][m][0], v1 = acc[ai][bj][m][1];
                    u32x4 w; w.x = cvt_pk_bf16(v0[0], v0[1]); w.y = cvt_pk_bf16(v0[2], v0[3]); w.z = cvt_pk_bf16(v1[0], v1[1]); w.w = cvt_pk_bf16(v1[2], v1[3]);
                    *(u32x4*)(rowp + bj * 128) = w; } }
    }
};
template <int L0> struct EpiResid {
    static constexpr bool PERM = true, MIDSCALE = true;
    const float* inc; const float* inx; bf16_t* H; const float* modl; const float* ssq;
    __device__ __forceinline__ void midscale(f32x4 (&acc)[2][2][4][2], const pg8::Unit& u, int wr, int wc, int fr, int fq) const {
        typedef float f32x2 __attribute__((ext_vector_type(2)));
        const int r0 = u.i0 * 256 + wr * 64 + fr;
        f32x2 part[2][4];
#pragma unroll
        for (int ai = 0; ai < 2; ++ai)
#pragma unroll
            for (int m = 0; m < 4; ++m) part[ai][m] = *(const f32x2*)(ssq + (size_t)(r0 + ai * 128 + m * 16) * 8 + 2 * fq);
#pragma unroll
        for (int ai = 0; ai < 2; ++ai)
#pragma unroll
            for (int m = 0; m < 4; ++m) { float sq = part[ai][m][0] + part[ai][m][1];
                sq += __shfl_xor(sq, 16); sq += __shfl_xor(sq, 32);
                const float rs = rsqrtf(sq * (1.f / 512.f) + 1e-6f);
#pragma unroll
                for (int bj = 0; bj < 2; ++bj)
#pragma unroll
                    for (int n = 0; n < 2; ++n) acc[ai][bj][m][n] *= rs; }
    }
    __device__ __forceinline__ void operator()(const f32x4 (&acc)[2][2][4][2], const pg8::Unit& u, int wr, int wc, int fr, int fq) const {
        const int r0 = u.i0 * 256;
        const int v = row_v(r0);
        const float* gate = modl + (size_t)v * 6144 + 2 * 1024;
        const float* xin = xin_ptr(inc, inx, r0);
        const int rl0 = wr * 64 + fr, col0 = u.i1 * 256 + wc * 32 + 8 * fq;
        f32x4 gv[2][2];
#pragma unroll
        for (int bj = 0; bj < 2; ++bj)
#pragma unroll
            for (int n = 0; n < 2; ++n) gv[bj][n] = *(const f32x4*)(gate + col0 + bj * 128 + 4 * n);
#pragma unroll
        for (int ai = 0; ai < 2; ++ai)
#pragma unroll
            for (int mp = 0; mp < 2; ++mp) {
                if (L0) {
                    f32x4 hi[2][2][2];
#pragma unroll
                    for (int mm = 0; mm < 2; ++mm) { const size_t off = (size_t)(rl0 + ai * 128 + (2 * mp + mm) * 16) * D + col0;
#pragma unroll
                        for (int bj = 0; bj < 2; ++bj)
#pragma unroll
                            for (int n = 0; n < 2; ++n) hi[mm][bj][n] = *(const f32x4*)(xin + off + bj * 128 + 4 * n); }
#pragma unroll
                    for (int mm = 0; mm < 2; ++mm)
#pragma unroll
                        for (int bj = 0; bj < 2; ++bj) { const f32x4 o0 = hi[mm][bj][0] + gv[bj][0] * acc[ai][bj][2 * mp + mm][0], o1 = hi[mm][bj][1] + gv[bj][1] * acc[ai][bj][2 * mp + mm][1];
                            u32x4 w; w.x = cvt_pk_bf16(o0[0], o0[1]); w.y = cvt_pk_bf16(o0[2], o0[3]); w.z = cvt_pk_bf16(o1[0], o1[1]); w.w = cvt_pk_bf16(o1[2], o1[3]);
                            *(u32x4*)(H + (size_t)(r0 + rl0 + ai * 128 + (2 * mp + mm) * 16) * D + col0 + bj * 128) = w; }
                } else {
                    u32x4 hr[2][2];
#pragma unroll
                    for (int mm = 0; mm < 2; ++mm)
#pragma unroll
                        for (int bj = 0; bj < 2; ++bj) hr[mm][bj] = *(const u32x4*)(H + (size_t)(r0 + rl0 + ai * 128 + (2 * mp + mm) * 16) * D + col0 + bj * 128);
#pragma unroll
                    for (int mm = 0; mm < 2; ++mm)
#pragma unroll
                        for (int bj = 0; bj < 2; ++bj) { const u32x4 hv = hr[mm][bj]; const f32x4 a0 = acc[ai][bj][2 * mp + mm][0], a1 = acc[ai][bj][2 * mp + mm][1]; const f32x4 g0 = gv[bj][0], g1 = gv[bj][1];
                            u32x4 w;
                            w.x = cvt_pk_bf16(bflo(hv.x) + g0[0] * a0[0], bfhi(hv.x) + g0[1] * a0[1]); w.y = cvt_pk_bf16(bflo(hv.y) + g0[2] * a0[2], bfhi(hv.y) + g0[3] * a0[3]);
                            w.z = cvt_pk_bf16(bflo(hv.z) + g1[0] * a1[0], bfhi(hv.z) + g1[1] * a1[1]); w.w = cvt_pk_bf16(bflo(hv.w) + g1[2] * a1[2], bfhi(hv.w) + g1[3] * a1[3]);
                            *(u32x4*)(H + (size_t)(r0 + rl0 + ai * 128 + (2 * mp + mm) * 16) * D + col0 + bj * 128) = w; }
                }
                asm volatile("" ::: "memory"); }
    }
};

__device__ __forceinline__ const char* uniform_ptr(const char* q) {
    const unsigned long long v = (unsigned long long)q;
    const unsigned lo = __builtin_amdgcn_readfirstlane((unsigned)v), hi = __builtin_amdgcn_readfirstlane((unsigned)(v >> 32));
    return (const char*)(((unsigned long long)hi << 32) | lo);
}
struct MoeSched {
    const LAS int* tab;
    const int* list;
    const char* A; const char* W; int mode  , l, G, c;
    unsigned* ready;
    __device__ __forceinline__ void a_ready(const pg8::Unit& u) const {
        if (mode == 0) return;
        if (threadIdx.x < 64) {
            unsigned* w = ready + u.i4; unsigned spins = 0;
            while ((unsigned)__builtin_amdgcn_readfirstlane((int)__hip_atomic_load(w, __ATOMIC_RELAXED, __HIP_MEMORY_SCOPE_AGENT)) < 32u) {
                __builtin_amdgcn_s_sleep(2); if (++spins > (1u << 22)) break; }
            __builtin_amdgcn_fence(__ATOMIC_ACQUIRE, "agent");
            asm volatile("s_waitcnt vmcnt(0)" ::: "memory");
        }
        asm volatile("" ::: "memory"); __builtin_amdgcn_s_barrier(); asm volatile("" ::: "memory");
    }
    __device__ __forceinline__ bool get(int i, pg8::Unit& u) const {
        const int L = i * G + c; const int total = __builtin_amdgcn_readfirstlane(tab[24]) * 4; if (L >= total) return false;
        const int tl = L >> 2, pn = L & 3;
        int cls = 0;
#pragma unroll 1
        for (int q = 1; q < NCLS; ++q) { const int tq = __builtin_amdgcn_readfirstlane(tab[q]); if (tq <= tl) cls = q; }
        const int j = tl - __builtin_amdgcn_readfirstlane(tab[cls]), cnt = __builtin_amdgcn_readfirstlane(tab[32 + cls]);
        const int g = cls / 6, pidx = cls - g * 6;
        const int ea = (pidx >= 3) + (pidx >= 5), eb = pidx < 3 ? pidx + 1 : (pidx < 5 ? pidx - 1 : 3);
        if (mode == 0) {
            const int e = 4 * g + (pn < 2 ? ea : eb);
            u.a0 = A;
            u.b0 = W + ((size_t)(l * 16 + e) * 512 + (size_t)(pn & 1) * 256) * 1024 * 2; u.b1 = u.b0 + (size_t)8 * 128;
        } else {
            u.a0 = A + (size_t)tl * 256 * 512 * 2;
            u.b0 = W + ((size_t)(l * 16 + 4 * g + ea) * 1024 + (size_t)pn * 256) * 256 * 2;
            u.b1 = W + ((size_t)(l * 16 + 4 * g + eb) * 1024 + (size_t)pn * 256) * 256 * 2;
        }
        u.a0 = uniform_ptr(u.a0); u.b0 = uniform_ptr(u.b0); u.b1 = uniform_ptr(u.b1);
        u.i0 = cls; u.i1 = j; u.i2 = pn; u.i3 = cnt; u.i4 = tl; u.pad = 0; return true;
    }
    __device__ __forceinline__ int arow(const pg8::Unit& u, int rl) const {
        int idx = u.i1 * 256 + rl; idx = idx < u.i3 ? idx : u.i3 - 1;
        return list[(size_t)u.i0 * R + idx];
    }
    __device__ __forceinline__ const int* rows_ptr(const pg8::Unit& u) const { return list + (size_t)u.i0 * R + u.i1 * 256; }
    __device__ __forceinline__ int rows_valid(const pg8::Unit& u) const { return u.i3 - u.i1 * 256; }
};
struct EpiUp {
    static constexpr bool PERM = true, MIDSCALE = false;
    bf16_t* hid; const float* cwla; const float* cwlb; unsigned* ready;
    __device__ __forceinline__ void operator()(const f32x4 (&acc)[2][2][4][2], const pg8::Unit& u, int wr, int wc, int fr, int fq) const {
        const int cls = u.i0, j = u.i1, pn = u.i2, cnt = u.i3, tl = u.i4;
        const float* cw = (pn < 2) ? cwla : cwlb;
        const int colbase = (pn >> 1) * 256 + (pn & 1) * 128 + wc * 32 + 8 * fq;
        float wrow[2][4];
#pragma unroll
        for (int ai = 0; ai < 2; ++ai)
#pragma unroll
            for (int m = 0; m < 4; ++m) { const int idx = j * 256 + ai * 128 + wr * 64 + m * 16 + fr; wrow[ai][m] = idx < cnt ? cw[(size_t)cls * R + idx] : 0.f; }
#pragma unroll
        for (int ai = 0; ai < 2; ++ai)
#pragma unroll
            for (int m = 0; m < 4; ++m) {
                const int rl = ai * 128 + wr * 64 + m * 16 + fr; const int idx = j * 256 + rl; const bool valid = idx < cnt;
                const float w = wrow[ai][m];
                const f32x4 g0 = acc[ai][0][m][0], g1 = acc[ai][0][m][1], u0 = acc[ai][1][m][0], u1 = acc[ai][1][m][1];
                float o[8];
#pragma unroll
                for (int e = 0; e < 4; ++e) { o[e] = w * siluf_(g0[e]) * u0[e]; o[4 + e] = w * siluf_(g1[e]) * u1[e]; }
                if (!valid) {
#pragma unroll
                    for (int e = 0; e < 8; ++e) o[e] = 0.f; }
                u32x4 pk; pk.x = cvt_pk_bf16(o[0], o[1]); pk.y = cvt_pk_bf16(o[2], o[3]); pk.z = cvt_pk_bf16(o[4], o[5]); pk.w = cvt_pk_bf16(o[6], o[7]);
                { bf16_t* dstp = hid + ((size_t)tl * 256 + rl) * 512 + colbase;
                  asm volatile("global_store_dwordx4 %0, %1, off sc1\n\ts_nop 1" :: "v"(dstp), "v"(pk) : "memory"); }
            }
        asm volatile("s_waitcnt vmcnt(0)" ::: "memory");
        if ((threadIdx.x & 63) == 0) __hip_atomic_fetch_add(ready + tl, 1u, __ATOMIC_RELAXED, __HIP_MEMORY_SCOPE_AGENT);
    }
};
struct EpiDown {
    static constexpr bool PERM = true, MIDSCALE = false;
    bf16_t* H; const int* list; const float* modl;
    __device__ __forceinline__ void operator()(const f32x4 (&acc)[2][2][4][2], const pg8::Unit& u, int wr, int wc, int fr, int fq) const {
        const int cls = u.i0, j = u.i1, pn = u.i2, cnt = u.i3;
        const int col0 = pn * 256 + wc * 32 + 8 * fq;
        int tok[2][4];
#pragma unroll
        for (int ai = 0; ai < 2; ++ai)
#pragma unroll
            for (int m = 0; m < 4; ++m) { const int idx = j * 256 + ai * 128 + wr * 64 + m * 16 + fr; tok[ai][m] = idx < cnt ? list[(size_t)cls * R + idx] : -1; }
#pragma unroll
        for (int ai = 0; ai < 2; ++ai)
#pragma unroll
            for (int mp = 0; mp < 2; ++mp) {
                u32x4 hr[2][2]; f32x4 gv[2][2][2];
#pragma unroll
                for (int mm = 0; mm < 2; ++mm) { const int t = tok[ai][2 * mp + mm]; const int tt = t < 0 ? 0 : t;
                    const bf16_t* hp = H + (size_t)tt * D + col0; const float* gp = modl + (size_t)row_v(tt) * 6144 + col0;
#pragma unroll
                    for (int bj = 0; bj < 2; ++bj) { hr[mm][bj] = *(const u32x4*)(hp + bj * 128); gv[mm][bj][0] = *(const f32x4*)(gp + bj * 128); gv[mm][bj][1] = *(const f32x4*)(gp + bj * 128 + 4); } }
#pragma unroll
                for (int mm = 0; mm < 2; ++mm) { const int t = tok[ai][2 * mp + mm];
                    if (t >= 0) {
#pragma unroll
                        for (int bj = 0; bj < 2; ++bj) { const u32x4 hv = hr[mm][bj]; const f32x4 a0 = acc[ai][bj][2 * mp + mm][0], a1 = acc[ai][bj][2 * mp + mm][1]; const f32x4 g0 = gv[mm][bj][0], g1 = gv[mm][bj][1];
                            u32x4 w;
                            w.x = cvt_pk_bf16(bflo(hv.x) + g0[0] * a0[0], bfhi(hv.x) + g0[1] * a0[1]); w.y = cvt_pk_bf16(bflo(hv.y) + g0[2] * a0[2], bfhi(hv.y) + g0[3] * a0[3]);
                            w.z = cvt_pk_bf16(bflo(hv.z) + g1[0] * a1[0], bfhi(hv.z) + g1[1] * a1[1]); w.w = cvt_pk_bf16(bflo(hv.w) + g1[2] * a1[2], bfhi(hv.w) + g1[3] * a1[3]);
                            *(u32x4*)(H + (size_t)t * D + col0 + bj * 128) = w; } } }
                asm volatile("" ::: "memory"); }
    }
};

__device__ __forceinline__ void tr_tile(const float* src, int ldn, int k0, int n0, int nvalid, bf16_t* dst, int ldk, int drow0, LAS float* tile, int kd0 = -1, const float* kscale = nullptr) {
    const int tid = launder_tid();
    if (kd0 < 0) kd0 = k0;
    { const int n = tid & 63; const int kq = tid >> 6; float tv[8], ts[8];
#pragma unroll
      for (int it = 0; it < 8; ++it) { const int kk = kq + 8 * it; tv[it] = (n < nvalid) ? src[(size_t)(k0 + kk) * ldn + n0 + n] : 0.f; ts[it] = kscale ? kscale[kk] : 1.f; }
#pragma unroll
      for (int it = 0; it < 8; ++it) tile[(kq + 8 * it) * 65 + n] = tv[it] * ts[it]; }
    __syncthreads();
    { const int k8 = tid & 7, n = tid >> 3;
      if (n < nvalid) { const LAS float* s = tile + (k8 * 8) * 65 + n;
          u32x4 o; o.x = cvt_pk_bf16(s[0], s[65]); o.y = cvt_pk_bf16(s[2 * 65], s[3 * 65]); o.z = cvt_pk_bf16(s[4 * 65], s[5 * 65]); o.w = cvt_pk_bf16(s[6 * 65], s[7 * 65]);
          *(u32x4*)(dst + (size_t)(drow0 + n) * ldk + kd0 + k8 * 8) = o; } }
    __syncthreads();
}
constexpr int WPREP_ITEMS_PER_LAYER = 16 * 41 + 256 + 1024 + 1024 + 1024;
__device__ __forceinline__ void phase_wprep(CP p, unsigned char* lds, int it0, int it1, int bidx, int nblk) {
    LAS float* tile = (LAS float*)(LAS unsigned char*)lds;
    constexpr int I_IN = 16 * 41, I_OUT = 256, I_G = 1024, I_U = 1024, I_D = 1024, I_L = I_IN + I_OUT + I_G + I_U + I_D;
    for (int it = it0 + bidx; it < it1; it += nblk) {
        const int l = it / I_L; int r = it - l * I_L;
        if (r < I_IN) { const int kt = r / 41, ntl = r % 41; const int n0 = ntl * 64; const int nv = (DIN - n0) < 64 ? (DIN - n0) : 64;
            tr_tile(p->w_in + (size_t)l * 1024 * DIN, DIN, kt * 64, n0, nv, (bf16_t*)(p->ws + WS_WTIN) + (size_t)l * DIN * 1024, 1024, n0, tile); continue; }
        r -= I_IN;
        if (r < I_OUT) { const int kt = r >> 4, ntl = r & 15;
            tr_tile(p->w_out + (size_t)l * 1024 * 1024, 1024, kt * 64, ntl * 64, 64, (bf16_t*)(p->ws + WS_WTOUT) + (size_t)l * 1024 * 1024, 1024, ntl * 64, tile,
                    (kt * 64 + 512) & 1023, kt >= 8 ? p->ssd_norm_g + l * 512 + (kt * 64 - 512) : nullptr); continue; }
        r -= I_OUT;
        if (r < I_G + I_U) { const int up = r >= I_G; if (up) r -= I_G; const int e = r >> 6, q = r & 63, kt = q >> 2, ntl = q & 3; const int n0 = ntl * 64;
            const float* src = (up ? p->w_up : p->w_gate) + (size_t)(l * 16 + e) * 1024 * 256;
            tr_tile(src, 256, kt * 64, n0, 64, (bf16_t*)(p->ws + WS_WTGU) + (size_t)(l * 16 + e) * 512 * 1024, 1024, (n0 >> 7) * 256 + (n0 & 127) + (up ? 128 : 0), tile); continue; }
        r -= I_G + I_U;
        { const int e = r >> 6, q = r & 63, kt = q >> 4, ntl = q & 15;
          tr_tile(p->w_down + (size_t)(l * 16 + e) * 256 * 1024, 1024, kt * 64, ntl * 64, 64, (bf16_t*)(p->ws + WS_WTD) + (size_t)(l * 16 + e) * 1024 * 256, 256, ntl * 64, tile); }
    }
}
__device__ __forceinline__ void phase_adaln(CP p, unsigned char* lds, int bid, int nb) {
    LAS float* sc = (LAS float*)(LAS unsigned char*)lds;
    LAS float* red = sc + 3 * 1024;
    const int tid = launder_tid();
    for (int idx = tid; idx < 3 * 1024; idx += NTHREADS) { const int v = idx >> 10, k = idx & 1023; const float cv = (v < 2) ? p->c[v * 1024 + k] : p->c_ctx[k]; sc[idx] = siluf_(cv); }
    __syncthreads();
    float* mod = (float*)(p->ws + WS_MOD);
    for (int it = bid; it < 2 * 96; it += nb) {
        const int l = it / 96, n0 = (it % 96) * 64;
        const int c4 = tid & 15, kr = tid >> 4;
        f32x4 a0 = {0, 0, 0, 0}, a1 = {0, 0, 0, 0}, a2 = {0, 0, 0, 0};
        const float* w = p->w_ada + (size_t)l * 1024 * 6144 + n0 + c4 * 4;
#pragma unroll 4
        for (int k = kr; k < 1024; k += 32) { const f32x4 w4 = *(const f32x4*)(w + (size_t)k * 6144); a0 += sc[k] * w4; a1 += sc[1024 + k] * w4; a2 += sc[2048 + k] * w4; }
        *(LAS f32x4*)(red + (kr * 3 + 0) * 64 + c4 * 4) = a0; *(LAS f32x4*)(red + (kr * 3 + 1) * 64 + c4 * 4) = a1; *(LAS f32x4*)(red + (kr * 3 + 2) * 64 + c4 * 4) = a2;
        __syncthreads();
        if (tid < 192) { const int v = tid >> 6, cc = tid & 63; float s = 0.f;
            for (int q = 0; q < 32; ++q) s += red[(q * 3 + v) * 64 + cc];
            mod[((size_t)l * 3 + v) * 6144 + n0 + cc] = s + p->b_ada[l * 6144 + n0 + cc]; }
        __syncthreads();
    }
}
__device__ __forceinline__ void moe_table(CP p, int l, LAS int* tab) {
    const int* gcount = (const int*)(p->ws + WS_CTL) + l * 32;
    if (threadIdx.x == 0) { int acc = 0; for (int q = 0; q < NCLS; ++q) { const int cn = gcount[q]; tab[q] = acc; tab[32 + q] = cn; acc += (cn + 255) >> 8; } tab[24] = acc; }
    __syncthreads();
}
__device__ __forceinline__ void moe_yload(CP p, int pos, int lane, const LAS int* tab, u32x2 (&yv)[4]) {
    const int slot = tab[pos >> 16] * 256 + (pos & 0xffff);
    const bf16_t* y = (const bf16_t*)(p->ws + WS_Y) + (size_t)slot * 1024;
#pragma unroll
    for (int j = 0; j < 4; ++j) yv[j] = *(const u32x2*)(y + 4 * lane + 256 * j);
}
__device__ __forceinline__ void moe_yadd(CP p, int lm, int v, int lane, const u32x2 (&yv)[4], f32x4 (&xv)[4]) {
    const float* gate = (const float*)(p->ws + WS_MOD) + ((size_t)lm * 3 + v) * 6144 + 5 * 1024;
#pragma unroll
    for (int j = 0; j < 4; ++j) { const int k = 4 * lane + 256 * j; const f32x4 g4 = *(const f32x4*)(gate + k);
        xv[j][0] += g4[0] * bflo(yv[j].x); xv[j][1] += g4[1] * bfhi(yv[j].x); xv[j][2] += g4[2] * bflo(yv[j].y); xv[j][3] += g4[3] * bfhi(yv[j].y); }
}
typedef _Float16 f16x8 __attribute__((ext_vector_type(8)));
typedef _Float16 f16x2 __attribute__((ext_vector_type(2)));
constexpr int ST_H16 = 2064;
__device__ __forceinline__ unsigned pack_f16(float a, float b) { f16x2 h; h[0] = (_Float16)a; h[1] = (_Float16)b; return __builtin_bit_cast(unsigned, h); }
__device__ __forceinline__ void phase_r1(CP p, int l, unsigned char* lds_, int bid, int nb) {
    LAS unsigned char* lds = (LAS unsigned char*)lds_;
    LAS unsigned char* Wh = lds;
    LAS unsigned char* Xh = Wh + 16 * ST_H16;
    LAS float* gm = (LAS float*)(Xh + 16 * ST_H16);
    LAS float* sh = gm + 3 * 1024;
    LAS float* part = sh + 3 * 1024;
    const int tid = launder_tid(); const int lane = tid & 63, wave = __builtin_amdgcn_readfirstlane(tid >> 6);
    const float* mod = (const float*)(p->ws + WS_MOD) + (size_t)l * 3 * 6144;
    const float* win = p->w_in + (size_t)l * 1024 * DIN;
#pragma unroll
    for (int hb = 0; hb < 2; ++hb) { float tmp[16];
#pragma unroll
        for (int it = 0; it < 16; ++it) { const int idx = tid + NTHREADS * (16 * hb + it); tmp[it] = win[(size_t)(idx >> 4) * DIN + NPROJ + (idx & 15)]; }
#pragma unroll
        for (int it = 0; it < 16; ++it) { const int idx = tid + NTHREADS * (16 * hb + it); *(LAS _Float16*)(Wh + (idx & 15) * ST_H16 + (idx >> 4) * 2) = (_Float16)tmp[it]; } }
    { float t0[6], t1[6], t2[6];
#pragma unroll
      for (int it = 0; it < 6; ++it) { const int idx = tid + NTHREADS * it; const int v = idx >> 10, k = idx & 1023; t0[it] = p->g_mix[l * 1024 + k]; t1[it] = mod[v * 6144 + 1024 + k]; t2[it] = mod[v * 6144 + k]; }
#pragma unroll
      for (int it = 0; it < 6; ++it) { const int idx = tid + NTHREADS * it; gm[idx] = t0[it] * (1.f + t1[it]); sh[idx] = t2[it]; } }
    __syncthreads();
    bf16_t* HX = (bf16_t*)(p->ws + WS_HX); float* DT = (float*)(p->ws + WS_DT);
    const int rpb = (R + nb - 1) / nb, r0 = bid * rpb, r1 = (r0 + rpb) < R ? (r0 + rpb) : R;
    RowRaw xn[2];
#pragma unroll
    for (int q = 0; q < 2; ++q) if (r0 + 2 * wave + q < r1) row_load(p, l, r0 + 2 * wave + q, lane, xn[q]);
#pragma unroll 1
    for (int t0r = r0; t0r < r1; t0r += 16) {
        f32x4 xv[2][4];
#pragma unroll
        for (int q = 0; q < 2; ++q) row_cvt(l, xn[q], xv[q]);
#pragma unroll
        for (int q = 0; q < 2; ++q) if (t0r + 16 + 2 * wave + q < r1) row_load(p, l, t0r + 16 + 2 * wave + q, lane, xn[q]);
#pragma unroll
        for (int q = 0; q < 2; ++q) { const int rr = t0r + 2 * wave + q; const bool ok = rr < r1; const int v = row_v(ok ? rr : r0);
            if (l == 0 && ok) { u32x2* hw = (u32x2*)((bf16_t*)(p->ws + WS_H) + (size_t)rr * D);
#pragma unroll
                for (int j = 0; j < 4; ++j) { u32x2 o; o.x = cvt_pk_bf16(xv[q][j][0], xv[q][j][1]); o.y = cvt_pk_bf16(xv[q][j][2], xv[q][j][3]); hw[lane + 64 * j] = o; } }
            float ss = 0.f;
#pragma unroll
            for (int j = 0; j < 4; ++j) ss += xv[q][j][0] * xv[q][j][0] + xv[q][j][1] * xv[q][j][1] + xv[q][j][2] * xv[q][j][2] + xv[q][j][3] * xv[q][j][3];
            ss = wave_sum(ss); const float rs = ok ? rsqrtf(ss * (1.f / 1024.f) + 1e-6f) : 0.f;
#pragma unroll
            for (int j = 0; j < 4; ++j) { const int k = 4 * lane + 256 * j; const f32x4 g4 = *(const LAS f32x4*)(gm + v * 1024 + k), s4 = *(const LAS f32x4*)(sh + v * 1024 + k);
                f32x4 hv = xv[q][j] * rs * g4 + s4; if (!ok) hv = hv * 0.f;
                u32x2 o; o.x = cvt_pk_bf16(hv[0], hv[1]); o.y = cvt_pk_bf16(hv[2], hv[3]);
                if (ok) *(u32x2*)(HX + (size_t)rr * 1024 + k) = o;
                u32x2 h16; h16.x = pack_f16(hv[0], hv[1]); h16.y = pack_f16(hv[2], hv[3]);
                *(LAS u32x2*)(Xh + (2 * wave + q) * ST_H16 + k * 2) = h16; } }
        __syncthreads();
        {
            f32x4 acc0 = {0.f, 0.f, 0.f, 0.f};
#pragma unroll
            for (int s4 = 0; s4 < 4; ++s4) { const int kb = (128 * wave + 32 * s4 + 8 * (lane >> 4)) * 2;
                const f16x8 a = *(const LAS f16x8*)(Xh + (lane & 15) * ST_H16 + kb);
                const f16x8 b0 = *(const LAS f16x8*)(Wh + (lane & 15) * ST_H16 + kb);
                acc0 = __builtin_amdgcn_mfma_f32_16x16x32_f16(a, b0, acc0, 0, 0, 0); }
#pragma unroll
            for (int e = 0; e < 4; ++e) part[(wave * 16 + 4 * (lane >> 4) + e) * 16 + (lane & 15)] = acc0[e];
        }
        __syncthreads();
        if (tid < 256) { const int row = tid >> 4, n = tid & 15; const int rr = t0r + row;
            float sacc = p->dt_bias[l * 16 + n];
#pragma unroll
            for (int w = 0; w < 8; ++w) sacc += part[(w * 16 + row) * 16 + n];
            if (rr < r1) DT[(size_t)rr * 16 + n] = softplusf_(sacc); }
    }
    __syncthreads();
}
typedef float f32x16 __attribute__((ext_vector_type(16)));
typedef short s16x4 __attribute__((ext_vector_type(4)));
constexpr int ST_ROW = 272;
constexpr int ST_TR128 = 320;
constexpr int ST_TR64 = 192;
constexpr int ST_MT = 328;
constexpr int NCHUNK = SEG / 128;

#define DPP_MOV(v, ctrl, rm, bm) __builtin_bit_cast(float, __builtin_amdgcn_update_dpp(0, __builtin_bit_cast(int, (v)), (ctrl), (rm), (bm), true))
__device__ __forceinline__ float wave_incl_scan(float v, int) {
    float s = v + DPP_MOV(v, 0x111, 0xF, 0xF) + DPP_MOV(v, 0x112, 0xF, 0xF) + DPP_MOV(v, 0x113, 0xF, 0xF);
    s += DPP_MOV(s, 0x114, 0xF, 0xE);
    s += DPP_MOV(s, 0x118, 0xF, 0xC);
    s += DPP_MOV(s, 0x142, 0xA, 0xF);
    s += DPP_MOV(s, 0x143, 0xC, 0xF);
    return s;
}
__device__ __forceinline__ bf16x8 row_frag(const LAS unsigned char* tile, int stride, int row0, int k0, int lane) {
    return *(const LAS bf16x8*)(tile + (row0 + (lane & 31)) * stride + (k0 + 8 * (lane >> 5)) * 2);
}
__device__ __forceinline__ bf16x8 tr_frag(const LAS unsigned char* tile, int stride, int k0, int c0, int lane) {
    const int g = lane >> 4, li = lane & 15, q = li >> 2, pp = li & 3;
    const LAS unsigned char* a0 = tile + (k0 + 8 * (g >> 1) + q) * stride + (c0 + 16 * (g & 1) + 4 * pp) * 2;
    const s16x4 lo = __builtin_amdgcn_ds_read_tr16_b64_v4i16((LAS s16x4*)a0);
    const s16x4 hi = __builtin_amdgcn_ds_read_tr16_b64_v4i16((LAS s16x4*)(a0 + 4 * stride));
    return __builtin_shufflevector(lo, hi, 0, 1, 2, 3, 4, 5, 6, 7);
}
__device__ __forceinline__ u32x4 pack8(const float (&v)[8]) { u32x4 r; r.x = cvt_pk_bf16(v[0], v[1]); r.y = cvt_pk_bf16(v[2], v[3]); r.z = cvt_pk_bf16(v[4], v[5]); r.w = cvt_pk_bf16(v[6], v[7]); return r; }
__device__ __forceinline__ u32x4 pack8s(const float (&v)[8], float sc) { u32x4 r; r.x = cvt_pk_bf16(v[0] * sc, v[1] * sc); r.y = cvt_pk_bf16(v[2] * sc, v[3] * sc); r.z = cvt_pk_bf16(v[4] * sc, v[5] * sc); r.w = cvt_pk_bf16(v[6] * sc, v[7] * sc); return r; }

__device__ __forceinline__ void conv_load(const bf16_t* proj, int row0, int rq, int xch, bool lo_ok, bool hi_ok, u32x4 (&raw)[8]) {
    const bf16_t* base = proj + (size_t)(row0 + 4 * rq) * NPROJ + 1536 + xch;
    unsigned zz; asm volatile("v_mov_b32 %0, 0" : "=v"(zz));
#pragma unroll
    for (int j = 0; j < 8; ++j) {
        if (j < 2) { const bool ok = (rq > 0) || lo_ok; const u32x4 v = *(const u32x4*)(ok ? base + (j - 2) * NPROJ : base);
            raw[j].x = ok ? v.x : zz; raw[j].y = ok ? v.y : zz; raw[j].z = ok ? v.z : zz; raw[j].w = ok ? v.w : zz; }
        else if (j >= 6) { const bool ok = (rq < 31) || hi_ok; const u32x4 v = *(const u32x4*)(ok ? base + (j - 2) * NPROJ : base);
            raw[j].x = ok ? v.x : zz; raw[j].y = ok ? v.y : zz; raw[j].z = ok ? v.z : zz; raw[j].w = ok ? v.w : zz; }
        else raw[j] = *(const u32x4*)(base + (j - 2) * NPROJ);
    }
}
__device__ __forceinline__ void conv_compute(const u32x4 (&raw)[8], const LAS float* wl, int nchl, int wch, float (&o)[4][8]) {
    float w[5][8], bs[8];
#pragma unroll
    for (int j = 0; j < 5; ++j) { const f32x4 w0 = *(const LAS f32x4*)(wl + j * nchl + wch), w1 = *(const LAS f32x4*)(wl + j * nchl + wch + 4);
        w[j][0] = w0[0]; w[j][1] = w0[1]; w[j][2] = w0[2]; w[j][3] = w0[3]; w[j][4] = w1[0]; w[j][5] = w1[1]; w[j][6] = w1[2]; w[j][7] = w1[3]; }
    { const f32x4 b0 = *(const LAS f32x4*)(wl + 5 * nchl + wch), b1 = *(const LAS f32x4*)(wl + 5 * nchl + wch + 4); bs[0] = b0[0]; bs[1] = b0[1]; bs[2] = b0[2]; bs[3] = b0[3]; bs[4] = b1[0]; bs[5] = b1[1]; bs[6] = b1[2]; bs[7] = b1[3]; }
#pragma unroll
    for (int i = 0; i < 4; ++i)
#pragma unroll
        for (int e = 0; e < 8; ++e) o[i][e] = bs[e];
#pragma unroll
    for (int j = 0; j < 8; ++j) {
        float xv[8] = {bflo(raw[j].x), bfhi(raw[j].x), bflo(raw[j].y), bfhi(raw[j].y), bflo(raw[j].z), bfhi(raw[j].z), bflo(raw[j].w), bfhi(raw[j].w)};
#pragma unroll
        for (int i = 0; i < 4; ++i) { const int tap = j - i; if (tap >= 0 && tap < 5) {
#pragma unroll
                for (int e = 0; e < 8; ++e) o[i][e] += w[tap][e] * xv[e]; } }
    }
#pragma unroll
    for (int i = 0; i < 4; ++i)
#pragma unroll
        for (int e = 0; e < 8; ++e) o[i][e] = siluf_(o[i][e]);
}
__device__ __forceinline__ void head_cums(CP p, int l, int row0, int h, int dir, int lane, LAS float* hv) {
    const float A = -expf(p->a_log[l * 16 + dir * 8 + h]);
    const float* DT = (const float*)(p->ws + WS_DT);
    const float d0 = DT[(size_t)(row0 + 2 * lane) * 16 + dir * 8 + h], d1 = DT[(size_t)(row0 + 2 * lane + 1) * 16 + dir * 8 + h];
    const float x0 = d0 * A, x1 = d1 * A;
    const float incl = wave_incl_scan(x0 + x1, lane);
    const float total = __builtin_bit_cast(float, __builtin_amdgcn_readlane(__builtin_bit_cast(int, incl), 63));
    float c0, c1;
    if (dir == 0) { c1 = incl; c0 = incl - x1; } else { c0 = total - (incl - x1 - x0); c1 = total - (incl - x1); }
    hv[dir * 128 + 2 * lane] = c0; hv[dir * 128 + 2 * lane + 1] = c1;
    hv[256 + dir * 128 + 2 * lane] = d0; hv[256 + dir * 128 + 2 * lane + 1] = d1;
    if (lane == 0) hv[512 + dir] = total;
}
__device__ __forceinline__ bf16x8 scale_frag(bf16x8 f, const f32x4 w0, const f32x4 w1) {
    const u32x4 u = __builtin_bit_cast(u32x4, f);
    u32x4 r;
    r.x = cvt_pk_bf16(bflo(u.x) * w0[0], bfhi(u.x) * w0[1]); r.y = cvt_pk_bf16(bflo(u.y) * w0[2], bfhi(u.y) * w0[3]);
    r.z = cvt_pk_bf16(bflo(u.z) * w1[0], bfhi(u.z) * w1[1]); r.w = cvt_pk_bf16(bflo(u.w) * w1[2], bfhi(u.w) * w1[3]);
    return __builtin_bit_cast(bf16x8, r);
}
constexpr int ST_X256 = 576;

__device__ __forceinline__ void phase_c1(CP p, int l, unsigned char* lds_, int bid, int nb) {
    LAS unsigned char* lds = (LAS unsigned char*)lds_;
    LAS unsigned char* tile = lds;
    LAS float* wl = (LAS float*)(lds + 73216);
    const int tid = launder_tid();
    const bf16_t* proj = (const bf16_t*)(p->ws + WS_PROJ); bf16_t* mix = (bf16_t*)(p->ws + WS_HX);
#pragma unroll 1
    for (int u = bid; u < 256 + 512 + (l == DEPTH - 1 ? 0 : 16); u += nb) {
        int S, LEN, pstride, sstride, tok0, ch0;
        if (u < 256) { const int b = u >> 7, cs = (u >> 2) & 31, cc = u & 3; S = 2; LEN = 256; pstride = 64; sstride = 1; tok0 = b * SEG + CTXL + 2 * cs; ch0 = 256 + 64 * cc; }
        else if (u < 768) { const int v = u - 256; const int b = v >> 8, rg = (v >> 2) & 63, cc = v & 3; S = 4; LEN = 64; pstride = 1; sstride = 64; tok0 = b * SEG + CTXL + 256 * rg; ch0 = 64 * cc; }
        else { const int v = u - 768; const int b = v >> 3, cc = v & 7; S = 1; LEN = 256; pstride = 1; sstride = 0; tok0 = b * SEG; ch0 = 64 * cc; }
        const int LP = LEN + 30;
        { float tw[4];
#pragma unroll
          for (int it = 0; it < 4; ++it) { const int i = tid + NTHREADS * it; const int j = i >> 6, c = i & 63; tw[it] = j < 31 ? p->conv_w[((size_t)l * 31 + j) * 512 + ch0 + c] : p->conv_b[l * 512 + ch0 + c]; }
#pragma unroll
          for (int it = 0; it < 4; ++it) wl[tid + NTHREADS * it] = tw[it]; }
        for (int i = tid; i < S * 30 * 8; i += NTHREADS) { const int pc = i & 7, q = (i >> 3) % 30, sq = (i >> 3) / 30; const int pos = q < 15 ? q : LEN + q;
            unsigned zz; asm volatile("v_mov_b32 %0, 0" : "=v"(zz));
            *(LAS u32x4*)(tile + ((sq * LP + pos) * 64 + pc * 8) * 2) = (u32x4){zz, zz, zz, zz}; }
#pragma unroll 8
        for (int i = tid; i < S * LEN * 8; i += NTHREADS) { const int pc = i & 7, t = i >> 3; const int sq = t / LEN, pos = t - sq * LEN;
            const bf16_t* src = proj + (size_t)(tok0 + sq * sstride + pos * pstride) * NPROJ + ch0 + pc * 8;
            const u32x4 uv = *(const u32x4*)src, gv = *(const u32x4*)(src + 512);
            u32x4 o;
            o.x = cvt_pk_bf16(bflo(uv.x) * sigmoidf_(bflo(gv.x)), bfhi(uv.x) * sigmoidf_(bfhi(gv.x)));
            o.y = cvt_pk_bf16(bflo(uv.y) * sigmoidf_(bflo(gv.y)), bfhi(uv.y) * sigmoidf_(bfhi(gv.y)));
            o.z = cvt_pk_bf16(bflo(uv.z) * sigmoidf_(bflo(gv.z)), bfhi(uv.z) * sigmoidf_(bfhi(gv.z)));
            o.w = cvt_pk_bf16(bflo(uv.w) * sigmoidf_(bflo(gv.w)), bfhi(uv.w) * sigmoidf_(bfhi(gv.w)));
            *(LAS u32x4*)(tile + ((sq * LP + 15 + pos) * 64 + pc * 8) * 2) = o; }
        __syncthreads();
        const int noct = S * LEN / 8;
#pragma unroll 1
        for (int it = tid; it < noct * 32; it += NTHREADS) {
            const int cp = it & 31, oc = it >> 5; const int sq = oc / (LEN / 8), p0 = (oc - sq * (LEN / 8)) * 8;
            const LAS unsigned* base = (const LAS unsigned*)(tile + ((sq * LP + p0) * 64) * 2) + cp;
            float i0[38], i1[38];
#pragma unroll
            for (int k = 0; k < 38; ++k) { const unsigned w = base[k * 32]; i0[k] = bflo(w); i1[k] = bfhi(w); }
            float a0[8], a1[8];
            { const float b0 = wl[31 * 64 + 2 * cp], b1 = wl[31 * 64 + 2 * cp + 1];
#pragma unroll
              for (int i = 0; i < 8; ++i) { a0[i] = b0; a1[i] = b1; } }
#pragma unroll
            for (int j = 0; j < 31; ++j) { typedef float f32x2 __attribute__((ext_vector_type(2))); const f32x2 wj = *(const LAS f32x2*)(wl + j * 64 + 2 * cp); const float w0 = wj[0], w1 = wj[1];
#pragma unroll
                for (int i = 0; i < 8; ++i) { a0[i] += w0 * i0[i + j]; a1[i] += w1 * i1[i + j]; } }
#pragma unroll
            for (int i = 0; i < 8; ++i) { const int tok = tok0 + sq * sstride + (p0 + i) * pstride;
                *(unsigned*)(mix + (size_t)tok * 1024 + 512 + ch0 + 2 * cp) = cvt_pk_bf16(a0[i], a1[i]); }
        }
        __syncthreads();
    }
}
__device__ __forceinline__ void phase_c1_ln(CP p, int l, int bid, int nb) {
    const int tid = launder_tid(); const int lane = tid & 63, wave = tid >> 6;
    bf16_t* mix = (bf16_t*)(p->ws + WS_HX);
    const f32x4 g0 = *(const f32x4*)(p->conv_ln_g + l * 512 + lane * 8), g1 = *(const f32x4*)(p->conv_ln_g + l * 512 + lane * 8 + 4);
    const f32x4 b0 = *(const f32x4*)(p->conv_ln_b + l * 512 + lane * 8), b1 = *(const f32x4*)(p->conv_ln_b + l * 512 + lane * 8 + 4);
    const float gg[8] = {g0[0], g0[1], g0[2], g0[3], g1[0], g1[1], g1[2], g1[3]}, bb[8] = {b0[0], b0[1], b0[2], b0[3], b1[0], b1[1], b1[2], b1[3]};
    for (int r = bid * 8 + wave; r < R; r += nb * 8) {
        u32x4* ptr = (u32x4*)(mix + (size_t)r * 1024 + 512 + lane * 8);
        const u32x4 v = *ptr;
        float y[8] = {bflo(v.x), bfhi(v.x), bflo(v.y), bfhi(v.y), bflo(v.z), bfhi(v.z), bflo(v.w), bfhi(v.w)};
        float s = 0.f;
#pragma unroll
        for (int e = 0; e < 8; ++e) s += y[e];
        const float mu = wave_sum(s) * (1.f / 512.f);
        float q = 0.f;
#pragma unroll
        for (int e = 0; e < 8; ++e) { y[e] -= mu; q += y[e] * y[e]; }
        const float rstd = rsqrtf(wave_sum(q) * (1.f / 512.f) + 1e-5f);
        float o[8];
#pragma unroll
        for (int e = 0; e < 8; ++e) o[e] = siluf_(y[e] * rstd * gg[e] + bb[e]);
        *ptr = pack8(o);
    }
}
__device__ __forceinline__ void phase_s1(CP p, int l, unsigned char* lds_, int bid, int nb) {
    LAS unsigned char* lds = (LAS unsigned char*)lds_;
    LAS unsigned char* Bs = lds;
    LAS unsigned char* Xs = lds + 128 * ST_TR128;
    LAS float* wv = (LAS float*)(Xs + 128 * ST_X256);
    LAS float* hvs = wv + 8 * 128;
    LAS float* cwl = hvs + 4 * 520;
    const int tid = launder_tid(); const int lane = tid & 63, wave = __builtin_amdgcn_readfirstlane(tid >> 6);
    const bf16_t* proj = (const bf16_t*)(p->ws + WS_PROJ);
    const float* cw = p->ssd_conv_w + (size_t)l * 5 * 1024; const float* cbias = p->ssd_conv_b + (size_t)l * 1024;
    bf16_t* Sg = (bf16_t*)(p->ws + WS_S); float* DEC = (float*)(p->ws + WS_DEC);
    int cur_g = -1;
#pragma unroll 1
    for (int u = bid; u < NB * NCHUNK * 2; u += nb) {
        const int g = u & 1, c = (u >> 1) % NCHUNK, b = (u >> 1) / NCHUNK;
        const int row0 = b * SEG + c * 128;
        const bool lo_ok = !(c == 0 || c == 2), hi_ok = !(c == 1 || c == NCHUNK - 1);
        if (g != cur_g) { cur_g = g;
            float tw[5];
#pragma unroll
            for (int it = 0; it < 5; ++it) { const int i = tid + NTHREADS * it; const int j = i / 384, lc = i - j * 384; const int gch = lc < 128 ? 512 + g * 128 + lc : g * 256 + (lc - 128);
                tw[it] = i < 6 * 384 ? (j < 5 ? cw[j * 1024 + gch] : cbias[gch]) : 0.f; }
#pragma unroll
            for (int it = 0; it < 5; ++it) { const int i = tid + NTHREADS * it; if (i < 6 * 384) cwl[i] = tw[it]; } }
        const int hh = wave >> 1, dir = wave & 1, h = 4 * g + hh;
        u32x4 rb[8], rx0[8], rx1[8];
        conv_load(proj, row0, tid >> 4, 512 + g * 128 + (tid & 15) * 8, lo_ok, hi_ok, rb);
        conv_load(proj, row0, tid >> 5, g * 256 + (tid & 31) * 8, lo_ok, hi_ok, rx0);
        conv_load(proj, row0, (tid >> 5) + 16, g * 256 + (tid & 31) * 8, lo_ok, hi_ok, rx1);
        head_cums(p, l, row0, h, dir, lane, hvs + hh * 520);
        __syncthreads();
        {
            const LAS float* hv = hvs + hh * 520; const float tot = hv[512 + dir];
#pragma unroll
            for (int q = 0; q < 2; ++q) { const int lr = lane + 64 * q; wv[wave * 128 + lr] = __expf(tot - hv[dir * 128 + lr]) * hv[256 + dir * 128 + lr]; }
            if (lane == 0) DEC[((size_t)(b * 2 + dir) * NCHUNK + c) * 8 + h] = __expf(tot);
        }
        { float o[4][8];
          conv_compute(rb, cwl, 384, (tid & 15) * 8, o);
#pragma unroll
          for (int i = 0; i < 4; ++i) *(LAS u32x4*)(Bs + (4 * (tid >> 4) + i) * ST_TR128 + (tid & 15) * 16) = pack8(o[i]);
          conv_compute(rx0, cwl, 384, 128 + (tid & 31) * 8, o);
#pragma unroll
          for (int i = 0; i < 4; ++i) *(LAS u32x4*)(Xs + (4 * (tid >> 5) + i) * ST_X256 + (tid & 31) * 16) = pack8(o[i]);
          conv_compute(rx1, cwl, 384, 128 + (tid & 31) * 8, o);
#pragma unroll
          for (int i = 0; i < 4; ++i) *(LAS u32x4*)(Xs + (4 * ((tid >> 5) + 16) + i) * ST_X256 + (tid & 31) * 16) = pack8(o[i]); }
        __syncthreads();
        {
            f32x16 acc[2][4];
#pragma unroll
            for (int t = 0; t < 2; ++t)
#pragma unroll
                for (int q = 0; q < 4; ++q)
#pragma unroll
                    for (int e = 0; e < 16; ++e) acc[t][q][e] = 0.f;
#pragma unroll 2
            for (int kk = 0; kk < 8; ++kk) {
                const LAS float* wp = wv + wave * 128 + 16 * kk + 8 * (lane >> 5);
                const f32x4 w0 = *(const LAS f32x4*)wp, w1 = *(const LAS f32x4*)(wp + 4);
                bf16x8 af[2];
#pragma unroll
                for (int t = 0; t < 2; ++t) af[t] = scale_frag(tr_frag(Xs, ST_X256, 16 * kk, hh * 64 + 32 * t, lane), w0, w1);
#pragma unroll
                for (int q = 0; q < 4; ++q) { const bf16x8 bf = tr_frag(Bs, ST_TR128, 16 * kk, 32 * q, lane);
#pragma unroll
                    for (int t = 0; t < 2; ++t) acc[t][q] = __builtin_amdgcn_mfma_f32_32x32x16_bf16(bf, af[t], acc[t][q], 0, 0, 0); }
            }
            bf16_t* So = Sg + ((size_t)((b * 2 + dir) * NCHUNK + c) * 8 + h) * 8192 + (size_t)(lane & 31) * 128 + 4 * (lane >> 5);
#pragma unroll
            for (int t = 0; t < 2; ++t)
#pragma unroll
                for (int q = 0; q < 4; ++q)
#pragma unroll
                    for (int rg = 0; rg < 4; ++rg) { u32x2 pk; pk.x = cvt_pk_bf16(acc[t][q][4 * rg], acc[t][q][4 * rg + 1]); pk.y = cvt_pk_bf16(acc[t][q][4 * rg + 2], acc[t][q][4 * rg + 3]);
                        *(u32x2*)(So + (size_t)(32 * t) * 128 + 32 * q + 8 * rg) = pk; }
        }
        __syncthreads();
    }
}
__device__ __forceinline__ void phase_s2(CP p, int bid, int nb) {
    const int tid = launder_tid();
    const bf16_t* Sg = (const bf16_t*)(p->ws + WS_S); const float* DEC = (const float*)(p->ws + WS_DEC); bf16_t* HP = (bf16_t*)(p->ws + WS_HP);
    for (int idx = bid * NTHREADS + tid; idx < 2 * 2 * 8 * 64 * 64; idx += nb * NTHREADS) {
        const int n2 = idx & 63, pr = (idx >> 6) & 63, h = (idx >> 12) & 7, dir = (idx >> 15) & 1, b = idx >> 16;
        const size_t inner = (size_t)h * 8192 + pr * 128 + 2 * n2;
        const size_t cbase = (size_t)(b * 2 + dir) * NCHUNK;
        float s0 = 0.f, s1 = 0.f;
#pragma unroll 26
        for (int step = 0; step < NCHUNK; ++step) {
            const int c = dir == 0 ? step : (step < 2 ? 1 - step : NCHUNK + 1 - step);
            const size_t off = (cbase + c) * 65536 + inner;
            const unsigned sv = *(const unsigned*)(Sg + off); const float d = DEC[(cbase + c) * 8 + h];
            *(unsigned*)(HP + off) = cvt_pk_bf16(s0, s1);
            s0 = s0 * d + bflo(sv); s1 = s1 * d + bfhi(sv);
        }
    }
}
__device__ __forceinline__ void phase_s3(CP p, int l, unsigned char* lds_, int bid, int nb) {
    LAS unsigned char* lds = (LAS unsigned char*)lds_;
    LAS unsigned char* Cs = lds;
    LAS unsigned char* Bs = Cs + 128 * ST_ROW;
    LAS unsigned char* Mt = Bs;
    LAS unsigned char* Xs = Bs + 128 * ST_MT;
    LAS unsigned char* Hf = Xs + 128 * ST_TR64;
    LAS unsigned char* Hb = Hf + 64 * ST_ROW;
    LAS float* hvs = (LAS float*)(Hb + 64 * ST_ROW);
    LAS float* ssqp = hvs + 4 * 776;
    LAS float* cwl = ssqp + 256;
    const int tid0 = launder_tid(); const int wave = __builtin_amdgcn_readfirstlane(tid0 >> 6);
    const bf16_t* proj = (const bf16_t*)(p->ws + WS_PROJ); bf16_t* mix = (bf16_t*)(p->ws + WS_HX);
    const float* cw = p->ssd_conv_w + (size_t)l * 5 * 1024; const float* cbias = p->ssd_conv_b + (size_t)l * 1024;
    const bf16_t* HP = (const bf16_t*)(p->ws + WS_HP); float* SSQ = (float*)(p->ws + WS_SSQ);
    int cur_g = -1;
    const int cskip = (l == DEPTH - 1) ? 2 : 0, cpb = NCHUNK - cskip;
    const int nunits = NB * cpb * 2, nfull = nunits - nunits % nb, nitems = nfull + (nunits - nfull) * 4;
#pragma unroll 1
    for (int it = bid; it < nitems; it += nb) {
        const int u = it < nfull ? it : nfull + ((it - nfull) >> 2);
        const int hh_lo = it < nfull ? 0 : ((it - nfull) & 3), hh_hi = it < nfull ? 4 : hh_lo + 1;
        const int g = u & 1, c = cskip + (u >> 1) % cpb, b = (u >> 1) / cpb;
        int tid = tid0; asm volatile("" : "+v"(tid));
        const int lane = tid & 63;
        const int row0 = b * SEG + c * 128;
        const bool lo_ok = !(c == 0 || c == 2), hi_ok = !(c == 1 || c == NCHUNK - 1);
        if (g != cur_g) { cur_g = g;
            float tw[6];
#pragma unroll
            for (int it = 0; it < 6; ++it) { const int i = tid + NTHREADS * it; const int j = i >> 9, lc = i & 511; const int gch = lc < 128 ? 768 + g * 128 + lc : (lc < 256 ? 512 + g * 128 + (lc - 128) : g * 256 + (lc - 256));
                tw[it] = j < 5 ? cw[j * 1024 + gch] : cbias[gch]; }
#pragma unroll
            for (int it = 0; it < 6; ++it) cwl[tid + NTHREADS * it] = tw[it]; }
        u32x4 rx[8];
        {
            u32x4 r0[8], r1[8];
            const int cg = tid & 31; const int gch = (cg < 16 ? 768 : 512) + g * 128 + (cg & 15) * 8;
            conv_load(proj, row0, tid >> 5, gch, lo_ok, hi_ok, r0);
            conv_load(proj, row0, (tid >> 5) + 16, gch, lo_ok, hi_ok, r1);
            head_cums(p, l, row0, 4 * g + (wave >> 1), wave & 1, lane, hvs + (wave >> 1) * 776);
            { LAS float* hvw = hvs + (wave >> 1) * 776; const int dr = wave & 1;
              hvw[520 + dr * 128 + 2 * lane] = __expf(hvw[dr * 128 + 2 * lane]); hvw[520 + dr * 128 + 2 * lane + 1] = __expf(hvw[dr * 128 + 2 * lane + 1]); }
            __syncthreads();
            float o[4][8];
            LAS unsigned char* dst = (cg < 16 ? Cs : Bs) + (cg & 15) * 16;
            conv_compute(r0, cwl, 512, cg * 8, o);
#pragma unroll
            for (int i = 0; i < 4; ++i) *(LAS u32x4*)(dst + (4 * (tid >> 5) + i) * ST_ROW) = pack8(o[i]);
            asm volatile("" ::: "memory");
            if (tid < 256) conv_load(proj, row0, tid >> 3, g * 256 + hh_lo * 64 + (tid & 7) * 8, lo_ok, hi_ok, rx);
            conv_compute(r1, cwl, 512, cg * 8, o);
#pragma unroll
            for (int i = 0; i < 4; ++i) *(LAS u32x4*)(dst + (4 * ((tid >> 5) + 16) + i) * ST_ROW) = pack8(o[i]);
            if (tid < 256) { conv_compute(rx, cwl, 512, 256 + hh_lo * 64 + (tid & 7) * 8, o);
#pragma unroll
                for (int i = 0; i < 4; ++i) *(LAS u32x4*)(Xs + (4 * (tid >> 3) + i) * ST_TR64 + (tid & 7) * 16) = pack8(o[i]); }
        }
        __syncthreads();
        const int lb = wave >> 1, hs = wave & 1;
        int ln = lane; asm volatile("" : "+v"(ln));
        f32x16 gacc[2];
#pragma unroll
        for (int t = 0; t < 2; ++t)
#pragma unroll
            for (int e = 0; e < 16; ++e) gacc[t][e] = 0.f;
#pragma unroll
        for (int kk = 0; kk < 8; ++kk) { const bf16x8 af = row_frag(Cs, ST_ROW, 32 * lb, 16 * kk, lane);
#pragma unroll
            for (int t = 0; t < 2; ++t) { const bf16x8 bf = row_frag(Bs, ST_ROW, 64 * hs + 32 * t, 16 * kk, lane);
                gacc[t] = __builtin_amdgcn_mfma_f32_32x32x16_bf16(af, bf, gacc[t], 0, 0, 0); } }
        u32x4 hreg[4];
        { const bf16_t* hp0 = HP + ((size_t)(b * 2 * NCHUNK + c) * 8 + 4 * g + hh_lo) * 8192;
#pragma unroll
          for (int q = 0; q < 4; ++q) { const int it = tid + 512 * q; hreg[q] = *(const u32x4*)(hp0 + (size_t)(it >> 10) * NCHUNK * 8 * 8192 + (it & 1023) * 8); } }
        __syncthreads();
#pragma unroll 1
        for (int hh = hh_lo; hh < hh_hi; ++hh) {
            const int h = 4 * g + hh; const LAS float* hv = hvs + hh * 776;
            asm volatile("" : "+v"(ln));
            const int ph = hs, pc = 32 * ph + (ln & 31);
#pragma unroll
            for (int t = 0; t < 2; ++t) {
                const int st = 2 * hs + t;
                const int sc = 32 * st + (ln & 31);
                const float cfs = hv[sc], cbs = hv[128 + sc], dfs = hv[256 + sc], dbs = hv[384 + sc];
#pragma unroll
                for (int rg = 0; rg < 4; ++rg) {
                    const int l0 = 32 * lb + 8 * rg + 4 * (ln >> 5);
                    float m[4];
                    if (st < lb) {
                        const f32x4 cfl = *(const LAS f32x4*)(hv + l0);
#pragma unroll
                        for (int e = 0; e < 4; ++e) m[e] = gacc[t][4 * rg + e] * (__expf(cfl[e] - cfs) * dfs);
                    } else if (st > lb) {
                        const f32x4 cbl = *(const LAS f32x4*)(hv + 128 + l0);
#pragma unroll
                        for (int e = 0; e < 4; ++e) m[e] = gacc[t][4 * rg + e] * (__expf(cbl[e] - cbs) * dbs);
                    } else {
                        const f32x4 cfl = *(const LAS f32x4*)(hv + l0), cbl = *(const LAS f32x4*)(hv + 128 + l0);
#pragma unroll
                        for (int e = 0; e < 4; ++e) { const int lr = l0 + e;
                            const float ff = lr >= sc ? __expf(cfl[e] - cfs) * dfs : 0.f;
                            const float fb = lr <= sc ? __expf(cbl[e] - cbs) * dbs : 0.f;
                            m[e] = gacc[t][4 * rg + e] * (ff + fb); }
                    }
                    u32x2 pk; pk.x = cvt_pk_bf16(m[0], m[1]); pk.y = cvt_pk_bf16(m[2], m[3]);
                    *(LAS u32x2*)(Mt + sc * ST_MT + l0 * 2) = pk;
                }
            }
#pragma unroll
            for (int q = 0; q < 4; ++q) { const int it = tid + 512 * q; const int q2 = it & 1023;
                *(LAS u32x4*)(((it >> 10) ? Hb : Hf) + (q2 >> 4) * ST_ROW + (q2 & 15) * 16) = hreg[q]; }
            if (hh + 1 < hh_hi) {
                const bf16_t* hp0 = HP + ((size_t)(b * 2 * NCHUNK + c) * 8 + h + 1) * 8192;
#pragma unroll
                for (int q = 0; q < 4; ++q) { const int it = tid + 512 * q; hreg[q] = *(const u32x4*)(hp0 + (size_t)(it >> 10) * NCHUNK * 8 * 8192 + (it & 1023) * 8); }
                if (tid < 256) conv_load(proj, row0, tid >> 3, g * 256 + (hh + 1) * 64 + (tid & 7) * 8, lo_ok, hi_ok, rx);
            }
            unsigned zraw[8];
#pragma unroll
            for (int ri = 0; ri < 16; ri += 2) { const int lr = 32 * lb + 8 * (ri >> 2) + 4 * (ln >> 5) + (ri & 3);
                const bf16_t* zp = proj + (size_t)(row0 + lr) * NPROJ + 1024 + h * 64 + pc;
                zraw[ri >> 1] = (unsigned)zp[0] | ((unsigned)zp[NPROJ] << 16); }
            __syncthreads();
            f32x16 ad, af_, ab_;
#pragma unroll
            for (int e = 0; e < 16; ++e) { ad[e] = 0.f; af_[e] = 0.f; ab_[e] = 0.f; }
#pragma unroll
            for (int kk = 0; kk < 8; ++kk) {
                const bf16x8 am = tr_frag(Mt, ST_MT, 16 * kk, 32 * lb, lane);
                const bf16x8 bx = tr_frag(Xs, ST_TR64, 16 * kk, 32 * ph, lane);
                ad = __builtin_amdgcn_mfma_f32_32x32x16_bf16(am, bx, ad, 0, 0, 0);
                const bf16x8 ac = row_frag(Cs, ST_ROW, 32 * lb, 16 * kk, lane);
                const bf16x8 bhf = row_frag(Hf, ST_ROW, 32 * ph, 16 * kk, lane);
                const bf16x8 bhb = row_frag(Hb, ST_ROW, 32 * ph, 16 * kk, lane);
                af_ = __builtin_amdgcn_mfma_f32_32x32x16_bf16(ac, bhf, af_, 0, 0, 0);
                ab_ = __builtin_amdgcn_mfma_f32_32x32x16_bf16(ac, bhb, ab_, 0, 0, 0);
            }
            const float dsk = p->d_skip[l * 8 + h];
#pragma unroll
            for (int rg = 0; rg < 4; ++rg) {
                const int l0 = 32 * lb + 8 * rg + 4 * (ln >> 5);
                const f32x4 efl = *(const LAS f32x4*)(hv + 520 + l0), ebl = *(const LAS f32x4*)(hv + 648 + l0);
#pragma unroll
                for (int e = 0; e < 4; ++e) { const int lr = l0 + e; const int ri = 4 * rg + e;
                    const float xs = bf2f(*(const LAS bf16_t*)(Xs + lr * ST_TR64 + pc * 2));
                    const float y = ad[ri] + efl[e] * af_[ri] + ebl[e] * ab_[ri] + dsk * xs;
                    const float z = (ri & 1) ? bfhi(zraw[ri >> 1]) : bflo(zraw[ri >> 1]);
                    const float val = y * siluf_(z);
                    mix[(size_t)(row0 + lr) * 1024 + h * 64 + pc] = f2bf(val);
                    const float sq = half_sum32(val * val);
                    if ((ln & 31) == 31) ssqp[ph * 128 + lr] = sq;
                }
            }
            __syncthreads();
            if (tid < 128) SSQ[(size_t)(row0 + tid) * 8 + h] = ssqp[tid] + ssqp[128 + tid];
            if (hh + 1 < hh_hi && tid < 256) { float o[4][8];
                conv_compute(rx, cwl, 512, 256 + (hh + 1) * 64 + (tid & 7) * 8, o);
#pragma unroll
                for (int i = 0; i < 4; ++i) *(LAS u32x4*)(Xs + (4 * (tid >> 3) + i) * ST_TR64 + (tid & 7) * 16) = pack8(o[i]); }
        }
        __syncthreads();
    }
}
__device__ __forceinline__ void phase_r2(CP p, int l, unsigned char* lds_, int bid, int nb) {
    LAS unsigned char* lds = (LAS unsigned char*)lds_;
    LAS unsigned char* Wh = lds;
    LAS unsigned char* Xh = Wh + 32 * ST_H16;
    LAS float* gm = (LAS float*)(Xh + 16 * ST_H16);
    LAS float* sh = gm + 3 * 1024;
    LAS float* part = sh + 3 * 1024;
    LAS float* lgs = part + 8 * 16 * 32;
    LAS int* lcnt = (LAS int*)(lgs + 16 * 32);
    LAS int* lcls = lcnt + 64;
    LAS int* lrank = lcls + 512;
    LAS float* lcwa = (LAS float*)(lrank + 512);
    LAS float* lcwb = lcwa + 512;
    const int tid = launder_tid(); const int lane = tid & 63, wave = __builtin_amdgcn_readfirstlane(tid >> 6);
    const float* mod = (const float*)(p->ws + WS_MOD) + (size_t)l * 3 * 6144;
    {
        float tmp[8];
#pragma unroll
        for (int it = 0; it < 8; ++it) tmp[it] = p->w_rg[(size_t)l * 4096 + tid + NTHREADS * it];
#pragma unroll
        for (int it = 0; it < 8; ++it) { const int idx = tid + NTHREADS * it; *(LAS _Float16*)(Wh + (idx & 3) * ST_H16 + (idx >> 2) * 2) = (_Float16)tmp[it]; } }
#pragma unroll
    for (int hb = 0; hb < 2; ++hb) { float tmp[16];
#pragma unroll
        for (int it = 0; it < 16; ++it) tmp[it] = p->w_re[(size_t)l * 16384 + tid + NTHREADS * (16 * hb + it)];
#pragma unroll
        for (int it = 0; it < 16; ++it) { const int idx = tid + NTHREADS * (16 * hb + it); *(LAS _Float16*)(Wh + (4 + (idx & 15)) * ST_H16 + (idx >> 4) * 2) = (_Float16)tmp[it]; } }
    { unsigned zz; asm volatile("v_mov_b32 %0, 0" : "=v"(zz));
      for (int i = tid; i < 12 * 128; i += NTHREADS) { const int rw = 20 + i / 128, c16 = i % 128; *(LAS u32x4*)(Wh + rw * ST_H16 + c16 * 16) = (u32x4){zz, zz, zz, zz}; } }
    { float t0[6], t1[6], t2[6];
#pragma unroll
      for (int it = 0; it < 6; ++it) { const int idx = tid + NTHREADS * it; const int v = idx >> 10, k = idx & 1023; t0[it] = p->g_ffn[l * 1024 + k]; t1[it] = mod[v * 6144 + 4 * 1024 + k]; t2[it] = mod[v * 6144 + 3 * 1024 + k]; }
#pragma unroll
      for (int it = 0; it < 6; ++it) { const int idx = tid + NTHREADS * it; gm[idx] = t0[it] * (1.f + t1[it]); sh[idx] = t2[it]; } }
    if (tid < 64) lcnt[tid] = 0;
    __syncthreads();
    bf16_t* HM = (bf16_t*)(p->ws + WS_HX); float* CWLA = (float*)(p->ws + WS_CWLA); float* CWLB = (float*)(p->ws + WS_CWLB);
    int* gcount = (int*)(p->ws + WS_CTL) + l * 32; int* LIST = (int*)(p->ws + WS_LIST);
    const int rpb = (R + nb - 1) / nb, r0 = bid * rpb, r1 = (r0 + rpb) < R ? (r0 + rpb) : R;
    RowRaw xn[2];
#pragma unroll
    for (int q = 0; q < 2; ++q) if (r0 + 2 * wave + q < r1) row_load(p, 1, r0 + 2 * wave + q, lane, xn[q]);
#pragma unroll 1
    for (int t0r = r0; t0r < r1; t0r += 16) {
        f32x4 xv[2][4];
#pragma unroll
        for (int q = 0; q < 2; ++q) row_cvt(1, xn[q], xv[q]);
#pragma unroll
        for (int q = 0; q < 2; ++q) if (t0r + 16 + 2 * wave + q < r1) row_load(p, 1, t0r + 16 + 2 * wave + q, lane, xn[q]);
#pragma unroll
        for (int q = 0; q < 2; ++q) { const int rr = t0r + 2 * wave + q; const bool ok = rr < r1; const int v = row_v(ok ? rr : r0);
            float ss = 0.f;
#pragma unroll
            for (int j = 0; j < 4; ++j) ss += xv[q][j][0] * xv[q][j][0] + xv[q][j][1] * xv[q][j][1] + xv[q][j][2] * xv[q][j][2] + xv[q][j][3] * xv[q][j][3];
            ss = wave_sum(ss); const float rs = ok ? rsqrtf(ss * (1.f / 1024.f) + 1e-6f) : 0.f;
#pragma unroll
            for (int j = 0; j < 4; ++j) { const int k = 4 * lane + 256 * j; const f32x4 g4 = *(const LAS f32x4*)(gm + v * 1024 + k), s4 = *(const LAS f32x4*)(sh + v * 1024 + k);
                f32x4 hv = xv[q][j] * rs * g4 + s4; if (!ok) hv = hv * 0.f;
                u32x2 o; o.x = cvt_pk_bf16(hv[0], hv[1]); o.y = cvt_pk_bf16(hv[2], hv[3]);
                if (ok) *(u32x2*)(HM + (size_t)rr * 1024 + k) = o;
                u32x2 h16; h16.x = pack_f16(hv[0], hv[1]); h16.y = pack_f16(hv[2], hv[3]);
                *(LAS u32x2*)(Xh + (2 * wave + q) * ST_H16 + k * 2) = h16; } }
        __syncthreads();
        {
            f32x4 acc0 = {0.f, 0.f, 0.f, 0.f}, acc1 = {0.f, 0.f, 0.f, 0.f};
#pragma unroll
            for (int s4 = 0; s4 < 4; ++s4) { const int kb = (128 * wave + 32 * s4 + 8 * (lane >> 4)) * 2;
                const f16x8 a = *(const LAS f16x8*)(Xh + (lane & 15) * ST_H16 + kb);
                const f16x8 b0 = *(const LAS f16x8*)(Wh + (lane & 15) * ST_H16 + kb), b1 = *(const LAS f16x8*)(Wh + (16 + (lane & 15)) * ST_H16 + kb);
                acc0 = __builtin_amdgcn_mfma_f32_16x16x32_f16(a, b0, acc0, 0, 0, 0);
                acc1 = __builtin_amdgcn_mfma_f32_16x16x32_f16(a, b1, acc1, 0, 0, 0); }
#pragma unroll
            for (int e = 0; e < 4; ++e) { const int row = 4 * (lane >> 4) + e; part[(wave * 16 + row) * 32 + (lane & 15)] = acc0[e]; part[(wave * 16 + row) * 32 + 16 + (lane & 15)] = acc1[e]; }
        }
        __syncthreads();
        if (tid < 320) { const int row = tid / 20, n = tid - row * 20; float sacc = n < 4 ? p->b_rg[l * 4 + n] : p->b_re[l * 16 + n - 4];
#pragma unroll
            for (int w = 0; w < 8; ++w) sacc += part[(w * 16 + row) * 32 + n];
            lgs[row * 32 + n] = sacc; }
        __syncthreads();
        if (tid < 16) { const int rr = t0r + tid;
            if (rr < r1) {
                if (l == DEPTH - 1 && row_v(rr) == 2) lcls[rr - r0] = -1;
                else {
                    float lg[20];
#pragma unroll
                    for (int n = 0; n < 20; ++n) lg[n] = lgs[tid * 32 + n];
                    int gsel = 0; float gmax = lg[0];
#pragma unroll
                    for (int t = 1; t < 4; ++t) if (lg[t] > gmax) { gmax = lg[t]; gsel = t; }
                    float gden = 0.f;
#pragma unroll
                    for (int t = 0; t < 4; ++t) gden += __expf(lg[t] - gmax);
                    const float gprob = 1.f / gden;
                    float el[4];
#pragma unroll
                    for (int t = 0; t < 4; ++t) el[t] = gsel == 0 ? lg[4 + t] : (gsel == 1 ? lg[8 + t] : (gsel == 2 ? lg[12 + t] : lg[16 + t]));
                    int i0 = 0; float m0 = el[0];
#pragma unroll
                    for (int t = 1; t < 4; ++t) if (el[t] > m0) { m0 = el[t]; i0 = t; }
                    int i1 = -1; float m1 = -3.0e38f;
#pragma unroll
                    for (int t = 0; t < 4; ++t) if (t != i0 && el[t] > m1) { m1 = el[t]; i1 = t; }
                    const float w0 = gprob / (1.f + __expf(m1 - m0)), w1 = gprob - w0;
                    const int ea = i0 < i1 ? i0 : i1, eb = i0 < i1 ? i1 : i0;
                    const float cwa = i0 < i1 ? w0 : w1, cwb = i0 < i1 ? w1 : w0;
                    const int pidx = ea == 0 ? eb - 1 : (ea == 1 ? eb + 1 : 5);
                    const int cls = gsel * 6 + pidx;
                    const int rank = __hip_atomic_fetch_add(&lcnt[cls], 1, __ATOMIC_RELAXED, __HIP_MEMORY_SCOPE_WORKGROUP);
                    lcls[rr - r0] = cls; lrank[rr - r0] = rank; lcwa[rr - r0] = cwa; lcwb[rr - r0] = cwb;
                } } }
    }
    __syncthreads();
    if (tid < NCLS) lcnt[32 + tid] = atomicAdd(&gcount[tid], lcnt[tid]);
    __syncthreads();
    for (int idx = tid; idx < r1 - r0; idx += NTHREADS) { const int cl = lcls[idx]; if (cl < 0) continue; const int pos = lcnt[32 + cl] + lrank[idx]; const size_t li = (size_t)cl * R + pos;
        LIST[li] = r0 + idx; CWLA[li] = lcwa[idx]; CWLB[li] = lcwb[idx]; }
    __syncthreads();
}
__device__ __forceinline__ void phase_final(CP p, unsigned char* lds, int bid, int nb) {
    const int tid = launder_tid(); const int lane = tid & 63, wave = tid >> 6;
    const int qstep = nb * 8;
    RowRaw xn;
    { const int q = bid * 8 + wave; if (q < NB * SEQ) { const int b = q >= SEQ ? 1 : 0; row_load(p, 1, b * SEG + CTXL + (q - b * SEQ), lane, xn); } }
    for (int q = bid * 8 + wave; q < NB * SEQ; q += qstep) {
        f32x4* hr = (f32x4*)(p->out + (size_t)q * D);
        f32x4 xv[4]; float ss = 0.f;
        row_cvt(1, xn, xv);
        { const int qn = q + qstep; if (qn < NB * SEQ) { const int bn = qn >= SEQ ? 1 : 0; row_load(p, 1, bn * SEG + CTXL + (qn - bn * SEQ), lane, xn); } }
#pragma unroll
        for (int j = 0; j < 4; ++j) ss += xv[j][0] * xv[j][0] + xv[j][1] * xv[j][1] + xv[j][2] * xv[j][2] + xv[j][3] * xv[j][3];
        ss = wave_sum(ss); const float rs = rsqrtf(ss * (1.f / 1024.f) + 1e-6f);
#pragma unroll
        for (int j = 0; j < 4; ++j) { const f32x4 g4 = *(const f32x4*)(p->g_final + 4 * lane + 256 * j); hr[lane + 64 * j] = xv[j] * rs * g4; }
    }
}


#define XB_TMO      128
#define XB_XCNT(j)  (256  + 64 * (j))
#define XB_XSUB(j)  (1280 + 64 * (j))
#define XB_XGEN(j)  (2304 + 64 * (j))
#define XB_TOP      3328
#define XB_TOPGEN   3392
#define XCD_BAR_WORDS 3456
#define XB_SPIN_CAP (1u << 22)
__device__ __forceinline__ unsigned xb_ld(unsigned* p) { return __hip_atomic_load(p, __ATOMIC_RELAXED, __HIP_MEMORY_SCOPE_AGENT); }
__device__ __forceinline__ unsigned xb_add(unsigned* p, unsigned v) { return __hip_atomic_fetch_add(p, v, __ATOMIC_RELAXED, __HIP_MEMORY_SCOPE_AGENT); }
__device__ __forceinline__ unsigned xb_xcc_id() { return (unsigned)__builtin_amdgcn_s_getreg((3 << 11) | 20) & 0xFu; }
#define XB_SPIN(cond, bar) do { unsigned _sp = 0; while (cond) { __builtin_amdgcn_s_sleep(1); \
    if ((++_sp & 255u) == 0u) { if (xb_ld(&(bar)[XB_TMO])) break; if (_sp > XB_SPIN_CAP) { atomicAdd(&(bar)[XB_TMO], 1u); break; } } } } while (0)
struct XcdBarrier { unsigned* bar; unsigned x; volatile LAS unsigned* st; };
__device__ __forceinline__ XcdBarrier xcd_barrier_post(unsigned* bar, volatile LAS unsigned* st) {
    XcdBarrier b; b.bar = bar; b.x = xb_xcc_id(); b.st = st;
    if (threadIdx.x == 0) (void)xb_add(&bar[XB_XCNT(b.x)], 1u);
    return b;
}
__device__ __forceinline__ void xcd_barrier_complete(unsigned* bar, unsigned x, unsigned& nloc, unsigned& nx) {
    const unsigned G = gridDim.x * gridDim.y * gridDim.z;
    unsigned sum, cnt, mine, sp = 0u;
    for (;;) {
        sum = 0u; cnt = 0u; mine = 0u;
#pragma unroll
        for (unsigned j = 0; j < 16; ++j) { const unsigned c = xb_ld(&bar[XB_XCNT(j)]); sum += c; cnt += (c > 0u) ? 1u : 0u; mine = (j == x) ? c : mine; }
        if (sum == G) break;
        __builtin_amdgcn_s_sleep(1);
        if ((++sp & 255u) == 0u) { if (xb_ld(&bar[XB_TMO])) break; if (sp > XB_SPIN_CAP) { atomicAdd(&bar[XB_TMO], 1u); break; } }
    }
    nloc = mine > 0u ? mine : 1u; nx = cnt > 0u ? cnt : 1u;
}
__device__ __forceinline__ void xcd_barrier(const XcdBarrier& b) {
    asm volatile("s_waitcnt vmcnt(0)" ::: "memory");
    __syncthreads();
    if (threadIdx.x == 0) {
        unsigned* bar = b.bar;
        __builtin_amdgcn_s_waitcnt(0);
        unsigned nloc = b.st[0], nx = b.st[1];
        if (nloc == 0u) { xcd_barrier_complete(bar, b.x, nloc, nx); b.st[0] = nloc; b.st[1] = nx; }
        const unsigned old = xb_add(&bar[XB_XSUB(b.x)], 1u);
        const unsigned gen = old / nloc;
        if (old + 1u == (gen + 1u) * nloc) {
            __builtin_amdgcn_fence(__ATOMIC_RELEASE, "agent");
            asm volatile("s_waitcnt vmcnt(0)" ::: "memory");
            const unsigned og = xb_add(&bar[XB_TOP], 1u);
            const unsigned tg = og / nx;
            if (og + 1u == (tg + 1u) * nx) xb_add(&bar[XB_TOPGEN], 1u);
            else XB_SPIN(xb_ld(&bar[XB_TOPGEN]) == tg, bar);
            __builtin_amdgcn_fence(__ATOMIC_ACQUIRE, "agent");
            xb_add(&bar[XB_XGEN(b.x)], 1u);
            asm volatile("s_waitcnt vmcnt(0)" ::: "memory");
        } else {
            XB_SPIN(xb_ld(&bar[XB_XGEN(b.x)]) == gen, bar);
            __builtin_amdgcn_fence(__ATOMIC_ACQUIRE, "agent");
            asm volatile("s_waitcnt vmcnt(0)" ::: "memory");
        }
    }
    __syncthreads();
}

#ifndef TIMING_A
#define TIMING_A -1
#endif
#ifndef TIMING_B
#define TIMING_B -1
#endif
#ifndef PHASE_MASK
#define PHASE_MASK 0xFFFFF
#endif
#define PM(i) ((PHASE_MASK >> (i)) & 1)
#ifndef REPEAT_MASK
#define REPEAT_MASK 0
#endif
#define RP(i) for (int rep_ = 0; rep_ < 1 + ((REPEAT_MASK >> (i)) & 1); ++rep_)
constexpr int PH_PER_LAYER = 9, NPHASES = 1 + DEPTH * PH_PER_LAYER + 1;
__global__ void __launch_bounds__(NTHREADS, 2) mk_fwd(Args args) {
    extern __shared__ __attribute__((aligned(16))) unsigned char lds[];
    cg::grid_group grid = cg::this_grid();
    const __attribute__((address_space(4))) Args* ap = (const __attribute__((address_space(4))) Args*)__builtin_amdgcn_kernarg_segment_ptr();
    const int lo = ap->lo, hi = ap->hi;
    LAS unsigned char* ldsl = (LAS unsigned char*)lds;
    volatile LAS unsigned* xbst = (volatile LAS unsigned*)(ldsl + LDS_BYTES - 16);
    if (threadIdx.x < 4) xbst[threadIdx.x] = 0u;
    __syncthreads();
    (void)xcd_barrier_post((unsigned*)(ap->p.ws + WS_BAR), xbst);
    if (TIMING_A >= 0 && blockIdx.x == 0 && threadIdx.x == 0) ((unsigned long long*)(ap->p.ws + WS_TS))[lo] = __builtin_amdgcn_s_memrealtime();
    for (int ph = lo; ph < hi; ++ph) {
        CP p = launder(&ap->p);
        int bid = blockIdx.x, nb = gridDim.x; asm volatile("" : "+s"(bid), "+s"(nb));
        if (ph == 0) { if (PM(0)) RP(0) phase_wprep(p, lds, 0, WPREP_ITEMS_PER_LAYER, bid, nb); if (PM(1)) RP(1) phase_adaln(p, lds, bid, nb); }
        else if (ph == NPHASES - 1) { if (PM(12)) phase_final(p, lds, bid, nb); }
        else {
            const int l = (ph - 1) / PH_PER_LAYER, s = (ph - 1) % PH_PER_LAYER;
            if (s == 0) { if (PM(2)) RP(2) { if (rep_ == 0 || l == 0) phase_r1(p, l, lds, bid, nb); } }
            else if (s == 1) { if (PM(3)) RP(3) {
                pg8::DenseSched S; S.init(p->ws + WS_HX, (const bf16_t*)(p->ws + WS_WTIN) + (size_t)l * DIN * 1024, R, NPROJ, 1024, 1024, 1024, nb, bid);
                EpiProj E{(bf16_t*)(p->ws + WS_PROJ)};
                pg8::gemm_phase<EpiProj, pg8::DenseSched, false>(ldsl, 1024, 1024, 1024, S, E);
                if (l == 0 && DEPTH > 1) { const int extra = S.nwg % nb;
                    if (extra > 0 && bid >= extra) phase_wprep(p, lds, WPREP_ITEMS_PER_LAYER, WPREP_ITEMS_PER_LAYER + 1800, bid - extra, nb - extra);
                    else if (extra == 0) phase_wprep(p, lds, WPREP_ITEMS_PER_LAYER, WPREP_ITEMS_PER_LAYER + 1800, bid, nb); }
            } }
            else if (s == 2) { if (PM(4)) RP(4) phase_c1(p, l, lds, bid, nb); if (PM(5)) RP(5) phase_s1(p, l, lds, bid, nb); }
            else if (s == 3) { if (PM(6)) RP(6) phase_s2(p, bid, nb); if (PM(4)) phase_c1_ln(p, l, bid, nb); }
            else if (s == 4) { if (PM(7)) RP(7) phase_s3(p, l, lds, bid, nb); }
            else if (s == 5) { if (PM(8)) RP(8) { if (rep_ == 0 || l == 0) {
                pg8::DenseSched S; S.init(p->ws + WS_HX, (const bf16_t*)(p->ws + WS_WTOUT) + (size_t)l * 1024 * 1024, R, 1024, 1024, 1024, 1024, nb, bid, l == DEPTH - 1);
                EpiResid<0> E{p->ctx, p->x, (bf16_t*)(p->ws + WS_H), (const float*)(p->ws + WS_MOD) + (size_t)l * 3 * 6144, (const float*)(p->ws + WS_SSQ)};
                pg8::gemm_phase<EpiResid<0>, pg8::DenseSched, false>(ldsl, 1024, 1024, 1024, S, E);
                if (l == 0 && DEPTH > 1 && rep_ == 0) { const int extra = S.nwg % nb;
                    if (extra > 0 && bid >= extra) phase_wprep(p, lds, WPREP_ITEMS_PER_LAYER + 1800, 2 * WPREP_ITEMS_PER_LAYER, bid - extra, nb - extra);
                    else if (extra == 0) phase_wprep(p, lds, WPREP_ITEMS_PER_LAYER + 1800, 2 * WPREP_ITEMS_PER_LAYER, bid, nb); }
            } } }
            else if (s == 6) { if (PM(9)) phase_r2(p, l, lds, bid, nb); }
            else if (s == 7) { if (PM(10)) {
                LAS int* tab = (LAS int*)(ldsl + MISC_OFF); moe_table(p, l, tab);
                unsigned* ready = (unsigned*)(p->ws + WS_M1CNT) + l * 192;
                { MoeSched S{tab, (const int*)(p->ws + WS_LIST), (const char*)(p->ws + WS_HX), (const char*)(p->ws + WS_WTGU), 0, l, nb, bid, ready};
                  EpiUp E{(bf16_t*)(p->ws + WS_HID), (const float*)(p->ws + WS_CWLA), (const float*)(p->ws + WS_CWLB), ready};
                  pg8::gemm_phase<EpiUp, MoeSched, true>(ldsl, 1024, 1024, 1024, S, E); }
                { const int total = __builtin_amdgcn_readfirstlane(tab[24]) * 4; const int extra = __builtin_amdgcn_readfirstlane(total % nb);
                  MoeSched S{tab, (const int*)(p->ws + WS_LIST), (const char*)(p->ws + WS_HID), (const char*)(p->ws + WS_WTD), 1, l, nb, __builtin_amdgcn_readfirstlane((bid + nb - extra) % nb), ready};
                  EpiDown E{(bf16_t*)(p->ws + WS_H), (const int*)(p->ws + WS_LIST), (const float*)(p->ws + WS_MOD) + (size_t)l * 3 * 6144 + 5 * 1024};
                  pg8::gemm_phase<EpiDown, MoeSched, false>(ldsl, 512, 256, 512, S, E); }
            } }
            else { }
        }
        if (ph + 1 < hi && !(ph > 0 && ph < NPHASES - 1 && (ph - 1) % PH_PER_LAYER == 7)) { if (hi < 0) grid.sync();   else { XcdBarrier xb; xb.bar = (unsigned*)(launder(&ap->p)->ws + WS_BAR); xb.x = xb_xcc_id(); xb.st = (volatile LAS unsigned*)(ldsl + LDS_BYTES - 16); xcd_barrier(xb); }
            if (TIMING_A >= 0 && blockIdx.x == 0 && threadIdx.x == 0) ((unsigned long long*)(launder(&ap->p)->ws + WS_TS))[ph + 1] = __builtin_amdgcn_s_memrealtime(); }
    }
#if TIMING_A >= 0
    {
        XcdBarrier xb; xb.bar = (unsigned*)(launder(&ap->p)->ws + WS_BAR); xb.x = xb_xcc_id(); xb.st = (volatile LAS unsigned*)(ldsl + LDS_BYTES - 16); xcd_barrier(xb);
        if (blockIdx.x == 0 && threadIdx.x == 0) ((unsigned long long*)(launder(&ap->p)->ws + WS_TS))[hi] = __builtin_amdgcn_s_memrealtime();
        xcd_barrier(xb);
        const unsigned long long* ts = (const unsigned long long*)(launder(&ap->p)->ws + WS_TS);
        const float ta = (float)(ts[TIMING_A + 1] - ts[TIMING_A]) * 0.01f, tb = (float)(ts[TIMING_B + 1] - ts[TIMING_B]) * 0.01f;
        float* o = launder(&ap->p)->out; const float sc = 1.f + ta * 0.001f;
        for (size_t i = (size_t)blockIdx.x * NTHREADS + threadIdx.x; i < (size_t)NB * SEQ * D; i += (size_t)gridDim.x * NTHREADS) o[i] = o[i] * sc + (i == 0 ? tb * 0.1f : 0.f);
    }
#endif
}

extern "C" void kernel_launch(void* const* d_in, const int* in_sizes, int n_in, void* d_out, int out_size, void* d_ws, size_t ws_size, hipStream_t stream) {
    static int grid = 0;
    if (grid == 0) {
        if (n_in != 28 || ws_size < WS_END) { fprintf(stderr, "kernel_launch: unexpected n_in %d or ws_size %zu (< %zu)\n", n_in, ws_size, (size_t)WS_END); grid = -1; return; }
        int dev = 0, cus = 0, per_cu = 0;
        hipGetDevice(&dev); hipDeviceGetAttribute(&cus, hipDeviceAttributeMultiprocessorCount, dev);
        if (hipFuncSetAttribute((const void*)mk_fwd, hipFuncAttributeMaxDynamicSharedMemorySize, LDS_BYTES) != hipSuccess) { fprintf(stderr, "kernel_launch: hipFuncSetAttribute failed\n"); grid = -1; return; }
        if (hipOccupancyMaxActiveBlocksPerMultiprocessor(&per_cu, (const void*)mk_fwd, NTHREADS, LDS_BYTES) != hipSuccess || per_cu < 1) { fprintf(stderr, "kernel_launch: occupancy query says %d\n", per_cu); (void)hipGetLastError(); grid = -1; return; }
        grid = cus;
    }
    if (grid < 0) return;
    (void)hipMemsetAsync((char*)d_ws + WS_CTL, 0, WS_CTL_BYTES, stream);
    Args a{};
    const float** pp = (const float**)&a.p;
    for (int i = 0; i < 28; ++i) pp[i] = (const float*)d_in[i];
    a.p.out = (float*)d_out; a.p.ws = (unsigned char*)d_ws;
#if PER_PHASE_LAUNCH
    for (int ph = 0; ph < NPHASES; ++ph) {
        a.lo = ph; a.hi = ph + 1; void* kargs[] = {&a};
        hipError_t e = hipLaunchCooperativeKernel((const void*)mk_fwd, dim3(grid), dim3(NTHREADS), kargs, LDS_BYTES, stream);
        if (e != hipSuccess) { fprintf(stderr, "kernel_launch: launch of phase %d failed: %s\n", ph, hipGetErrorString(e)); break; }
    }
#else
    a.lo = 0; a.hi = NPHASES; void* kargs[] = {&a};
    hipError_t e = hipLaunchCooperativeKernel((const void*)mk_fwd, dim3(grid), dim3(NTHREADS), kargs, LDS_BYTES, stream);
    if (e != hipSuccess) fprintf(stderr, "kernel_launch: cooperative launch failed: %s (grid %d)\n", hipGetErrorString(e), grid);
#endif
}
```

```cpp
#include <hip/hip_runtime.h>
#include <hip/hip_cooperative_groups.h>
#include <cstdio>
namespace cg = cooperative_groups;

#ifndef PER_PHASE_LAUNCH
#define PER_PHASE_LAUNCH 0
#endif

#ifndef S3REP
#define S3REP 0
#endif
#define S3R(i) for (int r3_ = 0; r3_ < 1 + ((S3REP >> (i)) & 1); ++r3_)
#define LAS __attribute__((address_space(3)))
typedef unsigned short bf16_t;
typedef short bf16x8 __attribute__((ext_vector_type(8)));
typedef float f32x4 __attribute__((ext_vector_type(4)));
typedef unsigned u32x4 __attribute__((ext_vector_type(4)));
typedef unsigned u32x2 __attribute__((ext_vector_type(2)));

constexpr int D = 1024, NB = 2, SEQ = 16384, CTXL = 256, SEG = SEQ + CTXL, R = NB * SEG, DEPTH = 2;
constexpr int NPROJ = 2560, DIN = 2576;
constexpr int NTHREADS = 512;
constexpr int LDS_BYTES = 163840;
constexpr int MISC_OFF = 131072;
constexpr int NCLS = 24;

constexpr size_t al256(size_t x) { return (x + 255) & ~size_t(255); }
constexpr size_t WS_CTL = 0;
constexpr size_t WS_M1CNT = 20480;
constexpr size_t WS_TS = 2048;
constexpr size_t WS_BAR = 4096;
constexpr size_t WS_CTL_BYTES = 32768;
constexpr size_t WS_MOD = WS_CTL_BYTES;
constexpr size_t WS_WTIN = WS_MOD + al256((size_t)2 * 3 * 6144 * 4);
constexpr size_t WS_WTOUT = WS_WTIN + al256((size_t)2 * DIN * 1024 * 2);
constexpr size_t WS_WTGU = WS_WTOUT + al256((size_t)2 * 1024 * 1024 * 2);
constexpr size_t WS_WTD = WS_WTGU + al256((size_t)2 * 16 * 512 * 1024 * 2);
constexpr size_t WS_H = WS_WTD + al256((size_t)2 * 16 * 1024 * 256 * 2);
constexpr size_t WS_HX = WS_H + al256((size_t)R * 1024 * 2);
constexpr size_t WS_PROJ = WS_HX + al256((size_t)R * 1024 * 2);
constexpr size_t WS_DT = WS_PROJ + al256((size_t)R * NPROJ * 2);
constexpr size_t WS_POS = WS_DT + al256((size_t)R * 16 * 4);
constexpr size_t WS_LIST = WS_POS + al256((size_t)2 * R * 4);
constexpr size_t WS_CWLA = WS_LIST + al256((size_t)NCLS * R * 4);
constexpr size_t WS_CWLB = WS_CWLA + al256((size_t)NCLS * R * 4);
constexpr size_t WS_BIG = WS_CWLB + al256((size_t)NCLS * R * 4);
constexpr size_t WS_Y = WS_PROJ;
constexpr size_t WS_S = WS_BIG;
constexpr size_t WS_HP = WS_S + al256((size_t)2 * 2 * 130 * 8 * 8192 * 2);
constexpr size_t WS_DEC = WS_HP + al256((size_t)2 * 2 * 130 * 8 * 8192 * 2);
constexpr size_t WS_SSQ = WS_DEC + al256((size_t)2 * 2 * 130 * 8 * 4);
constexpr size_t WS_HID = WS_S;
constexpr size_t WS_END = WS_SSQ + al256((size_t)R * 8 * 4);
static_assert((size_t)(R + NCLS * 256) * 512 * 2 <= (size_t)2 * 2 * 130 * 8 * 8192 * 2, "hid alias");
static_assert(WS_END <= (size_t)512 * 1024 * 1024, "workspace");

struct Params {
    const float *x, *c, *ctx, *c_ctx, *w_ada, *b_ada, *g_mix, *g_ffn, *w_in, *conv_w, *conv_b, *conv_ln_g, *conv_ln_b, *ssd_conv_w, *ssd_conv_b,
        *dt_bias, *a_log, *d_skip, *ssd_norm_g, *w_out, *w_rg, *b_rg, *w_re, *b_re, *w_gate, *w_up, *w_down, *g_final;
    float* out; unsigned char* ws;
};
struct Args { Params p; int lo, hi; };
typedef const __attribute__((address_space(4))) Params* CP;
__device__ __forceinline__ CP launder(CP p) { asm volatile("" : "+s"(p)); return p; }
__device__ __forceinline__ int launder_tid() { int t = threadIdx.x; asm volatile("" : "+v"(t)); return t; }

__device__ __forceinline__ unsigned cvt_pk_bf16(float lo, float hi) { unsigned r; asm("v_cvt_pk_bf16_f32 %0, %1, %2" : "=v"(r) : "v"(lo), "v"(hi)); return r; }
__device__ __forceinline__ float bf2f(unsigned b) { return __uint_as_float(b << 16); }
__device__ __forceinline__ float bflo(unsigned w) { return __uint_as_float(w << 16); }
__device__ __forceinline__ float bfhi(unsigned w) { return __uint_as_float(w & 0xffff0000u); }
__device__ __forceinline__ bf16_t f2bf(float f) { return (bf16_t)(cvt_pk_bf16(f, 0.f) & 0xffffu); }
#define DPP_ADD(v, ctrl, rm) ((v) + __builtin_bit_cast(float, __builtin_amdgcn_update_dpp(0, __builtin_bit_cast(int, (v)), (ctrl), (rm), 0xF, true)))
__device__ __forceinline__ float row_sum16(float v) {
    v = DPP_ADD(v, 0xB1, 0xF);
    v = DPP_ADD(v, 0x4E, 0xF);
    v = DPP_ADD(v, 0x141, 0xF);
    v = DPP_ADD(v, 0x140, 0xF);
    return v;
}
__device__ __forceinline__ float half_sum32(float v) { v = row_sum16(v); v = DPP_ADD(v, 0x142, 0xA); return v; }
__device__ __forceinline__ float wave_sum(float v) {
    v = half_sum32(v); v = DPP_ADD(v, 0x143, 0xC);
    return __builtin_bit_cast(float, __builtin_amdgcn_readlane(__builtin_bit_cast(int, v), 63));
}
__device__ __forceinline__ float sigmoidf_(float x) { return 1.f / (1.f + __expf(-x)); }
__device__ __forceinline__ float siluf_(float x) { return x / (1.f + __expf(-x)); }
__device__ __forceinline__ float softplusf_(float x) { return fmaxf(x, 0.f) + __logf(1.f + __expf(-fabsf(x))); }

__device__ __forceinline__ int row_b(int r) { return r >= SEG ? 1 : 0; }
__device__ __forceinline__ int row_i(int r) { return r >= SEG ? r - SEG : r; }
__device__ __forceinline__ int row_v(int r) { const int i = row_i(r); return i < CTXL ? 2 : row_b(r); }
__device__ __forceinline__ const float* xin_ptr(const float* ctx, const float* x, int r) {
    const int b = row_b(r), i = row_i(r);
    return i < CTXL ? ctx + (size_t)(b * CTXL + i) * D : x + (size_t)(b * SEQ + i - CTXL) * D;
}
struct RowRaw { f32x4 f[4]; u32x2 h[4]; };
__device__ __forceinline__ void row_load(CP p, int l, int r, int lane, RowRaw& rr) {
    if (l == 0) { const f32x4* hr = (const f32x4*)xin_ptr(p->ctx, p->x, r);
#pragma unroll
        for (int j = 0; j < 4; ++j) rr.f[j] = hr[lane + 64 * j]; }
    else { const u32x2* hr = (const u32x2*)((const bf16_t*)(p->ws + WS_H) + (size_t)r * D);
#pragma unroll
        for (int j = 0; j < 4; ++j) rr.h[j] = hr[lane + 64 * j]; }
}
__device__ __forceinline__ void row_cvt(int l, const RowRaw& rr, f32x4 (&xv)[4]) {
#pragma unroll
    for (int j = 0; j < 4; ++j) xv[j] = l == 0 ? rr.f[j] : (f32x4){bflo(rr.h[j].x), bfhi(rr.h[j].x), bflo(rr.h[j].y), bfhi(rr.h[j].y)};
}
namespace pg8 {
constexpr int BM = 256, BK = 64, HALF = 128, HTB = HALF * BK * 2, STAGE_BYTES = 8 * HTB, NXCD = 8, WGM = 8;
__device__ __forceinline__ int lds_byte(int r, int c) { const int st = (r >> 4) * 2 + (c >> 5), rr = r & 15, cc = c & 31, ob = rr * 64 + cc * 2; return st * 1024 + (ob ^ (((ob >> 9) & 1) << 5)); }
__device__ __forceinline__ void stage_rc(int b, int& Rr, int& Cc) { const int st = b / 1024, sb = b % 1024, swz = sb ^ (((sb >> 9) & 1) << 5); Rr = (st >> 1) * 16 + swz / 64; Cc = (st & 1) * 32 + (swz % 64) / 2; }
__device__ __forceinline__ int perm32(int rho) { const int n = rho >> 4, i = rho & 15; return 8 * (i >> 2) + 4 * n + (i & 3); }

struct Unit {
    const char* a0;
    const char* b0;
    const char* b1;
    int i0, i1, i2, i3, i4, pad;
};

template <class Epi, class Sched, bool GATHER>
__device__ __forceinline__ void gemm_phase(LAS unsigned char* lds, const int lda, const int ldb, const int K, const Sched& S, const Epi& E) {
    const int tid = launder_tid(); const int wid = __builtin_amdgcn_readfirstlane(tid >> 6), lane = tid & 63, wr = wid >> 2, wc = wid & 3, fr = lane & 15, fq = lane >> 4;
    const int nt = K / BK, ks = nt >> 1;
    int Rr[2], Cc[2];
    unsigned voffB[2];
#pragma unroll
    for (int i = 0; i < 2; ++i) { stage_rc(tid * 16 + i * 8192, Rr[i], Cc[i]); const int Rb = Epi::PERM ? ((Rr[i] & ~31) + perm32(Rr[i] & 31)) : Rr[i];
        voffB[i] = (unsigned)(Rb * ldb + Cc[i]) * 2u; }
    const size_t kstep = (size_t)(BK * 2);
    const size_t hstepB = (size_t)HALF * ldb * 2;
    const unsigned ldsw = (unsigned)wid * 1024u;
    const unsigned ldsbase = (unsigned)(unsigned long)lds;
    const int aoff = lds_byte(wr * 64 + fr, fq * 8), boff = lds_byte(wc * 32 + fr, fq * 8);
#define PG8_SA(b, h) (((b) * 2 + (h)) * HTB)
#define PG8_SB(b, h) ((4 + (b) * 2 + (h)) * HTB)
#define PG8_STAGE2(bufoff, gbase, v0, v1) do { unsigned keep_; \
        asm volatile("s_mov_b32 %0, m0\n\ts_mov_b32 m0, %1\n\ts_nop 4\n\tglobal_load_lds_dwordx4 %2, %4\n\ts_add_u32 m0, m0, 0x2000\n\ts_nop 0\n\tglobal_load_lds_dwordx4 %3, %4\n\ts_mov_b32 m0, %0" \
            : "=&s"(keep_) : "s"(ldsbase + (unsigned)(bufoff) + ldsw), "v"(v0), "v"(v1), "s"(gbase) : "memory", "scc"); } while (0)
#define PG8_LDA(dst, b, h) do { _Pragma("unroll") for (int m = 0; m < 4; ++m) _Pragma("unroll") for (int k = 0; k < 2; ++k) dst[m][k] = *(const LAS bf16x8*)(lds + PG8_SA(b, h) + aoff + m * 2048 + k * 1024); } while (0)
#define PG8_LDB(dst, b, h) do { _Pragma("unroll") for (int n = 0; n < 2; ++n) _Pragma("unroll") for (int k = 0; k < 2; ++k) dst[n][k] = *(const LAS bf16x8*)(lds + PG8_SB(b, h) + boff + n * 2048 + k * 1024); } while (0)
#define PG8_MMA(ai, bj, At, Bt) do { __builtin_amdgcn_s_setprio(1); _Pragma("unroll") for (int m = 0; m < 4; ++m) _Pragma("unroll") for (int n = 0; n < 2; ++n) _Pragma("unroll") for (int k = 0; k < 2; ++k) \
        acc[ai][bj][m][n] = __builtin_amdgcn_mfma_f32_16x16x32_bf16(Bt[n][k], At[m][k], acc[ai][bj][m][n], 0, 0, 0); __builtin_amdgcn_s_setprio(0); } while (0)
#define PG8_WAIT_V(n) asm volatile("s_waitcnt vmcnt(" #n ")" ::: "memory")
#define PG8_WAIT_L(n) asm volatile("s_waitcnt lgkmcnt(" #n ")" ::: "memory")
#define PG8_BAR __builtin_amdgcn_s_barrier()
#define PG8_SCHED __builtin_amdgcn_sched_barrier(0)
#define PG8_BP(u, tt) ((tt) < ks ? (u).b0 + (size_t)(tt) * kstep : (u).b1 + (size_t)((tt) - ks) * kstep)
    Unit cur, nxt; int ui = 0;
    if (!S.get(0, cur)) return;
    S.a_ready(cur);
    unsigned c00, c01, c10, c11, n00, n01, n10, n11;
    if (GATHER) {
        c00 = (unsigned)(S.arow(cur, Rr[0]) * lda + Cc[0]) * 2u; c01 = (unsigned)(S.arow(cur, Rr[1]) * lda + Cc[1]) * 2u;
        c10 = (unsigned)(S.arow(cur, HALF + Rr[0]) * lda + Cc[0]) * 2u; c11 = (unsigned)(S.arow(cur, HALF + Rr[1]) * lda + Cc[1]) * 2u;
    } else {
        c00 = (unsigned)(Rr[0] * lda + Cc[0]) * 2u; c01 = (unsigned)(Rr[1] * lda + Cc[1]) * 2u;
        c10 = (unsigned)((HALF + Rr[0]) * lda + Cc[0]) * 2u; c11 = (unsigned)((HALF + Rr[1]) * lda + Cc[1]) * 2u;
    }
    n00 = c00; n01 = c01; n10 = c10; n11 = c11;
    f32x4 acc[2][2][4][2];
    float zr; asm volatile("v_mov_b32 %0, 0" : "=v"(zr));
#pragma unroll
    for (int a = 0; a < 2; ++a)
#pragma unroll
        for (int b = 0; b < 2; ++b)
#pragma unroll
            for (int m = 0; m < 4; ++m)
#pragma unroll
                for (int n = 0; n < 2; ++n) acc[a][b][m][n] = (f32x4){zr, zr, zr, zr};
    bf16x8 At[4][2], B0[2][2], B1[2][2];
    const char* cA = cur.a0;
    {
        const char* pb0 = PG8_BP(cur, 0); const char* pb1 = PG8_BP(cur, 1);
        PG8_STAGE2(PG8_SB(0, 0), pb0, voffB[0], voffB[1]); PG8_STAGE2(PG8_SA(0, 0), cA, c00, c01);
        PG8_STAGE2(PG8_SB(0, 1), pb0 + hstepB, voffB[0], voffB[1]); PG8_STAGE2(PG8_SA(0, 1), cA, c10, c11);
        if (wr == 1) PG8_BAR;
        PG8_WAIT_V(4); PG8_BAR;
        PG8_STAGE2(PG8_SB(1, 0), pb1, voffB[0], voffB[1]); PG8_STAGE2(PG8_SA(1, 0), cA + kstep, c00, c01);
        PG8_STAGE2(PG8_SB(1, 1), pb1 + hstepB, voffB[0], voffB[1]);
        PG8_WAIT_V(6); PG8_BAR;
    }
    for (;;) {
        const bool has_next = S.get(ui + 1, nxt);
        if (!has_next) nxt = cur;
        LAS int* tokb = (LAS int*)(lds + MISC_OFF + 1024) + ((ui + 1) & 1) * 256;
        if (GATHER) {
            n00 = c00; n01 = c01; n10 = c10; n11 = c11;
            if (has_next && wid == 0) {
                const char* src = (const char*)S.rows_ptr(nxt); unsigned keep_;
                asm volatile("s_mov_b32 %0, m0\n\ts_mov_b32 m0, %1\n\ts_nop 4\n\tglobal_load_lds_dwordx4 %2, %3\n\ts_mov_b32 m0, %0"
                    : "=&s"(keep_) : "s"((unsigned)(unsigned long)tokb), "v"((unsigned)lane * 16u), "s"(src) : "memory");
            }
        }
        const char* nA = nxt.a0;
#pragma unroll 1
        for (int t = 0; t < nt; t += 2) {
            const bool last = (t == nt - 2);
            if (last && has_next) S.a_ready(nxt);
            const char* a1 = cA + (size_t)(t + 1) * kstep;
            const char* a2 = last ? nA : cA + (size_t)(t + 2) * kstep;
            const char* a3 = a2 + kstep;
            const char* b2 = last ? PG8_BP(nxt, 0) : PG8_BP(cur, t + 2);
            const char* b3 = last ? PG8_BP(nxt, 1) : PG8_BP(cur, t + 3);
            if (GATHER) { if (last && has_next) {
                const int lim = S.rows_valid(nxt) - 1;
                const int i0 = Rr[0] < lim ? Rr[0] : lim, i1 = Rr[1] < lim ? Rr[1] : lim, i2 = (HALF + Rr[0]) < lim ? (HALF + Rr[0]) : lim, i3 = (HALF + Rr[1]) < lim ? (HALF + Rr[1]) : lim;
                n00 = (unsigned)(tokb[i0] * lda + Cc[0]) * 2u; n01 = (unsigned)(tokb[i1] * lda + Cc[1]) * 2u;
                n10 = (unsigned)(tokb[i2] * lda + Cc[0]) * 2u; n11 = (unsigned)(tokb[i3] * lda + Cc[1]) * 2u; } }
            const unsigned s00 = last ? n00 : c00, s01 = last ? n01 : c01, s10 = last ? n10 : c10, s11 = last ? n11 : c11;
            if constexpr (Epi::MIDSCALE) { if (t == ks) E.midscale(acc, cur, wr, wc, fr, fq); }
            PG8_LDB(B0, 0, 0); PG8_SCHED; PG8_LDA(At, 0, 0); PG8_STAGE2(PG8_SA(1, 1), a1, c10, c11);
            PG8_WAIT_L(8); PG8_BAR; PG8_WAIT_L(0); PG8_MMA(0, 0, At, B0); PG8_BAR; PG8_SCHED;
            PG8_LDB(B1, 0, 1); PG8_STAGE2(PG8_SB(0, 0), b2, voffB[0], voffB[1]);
            PG8_BAR; PG8_WAIT_L(0); PG8_MMA(0, 1, At, B1); PG8_BAR;
            PG8_LDA(At, 0, 1); PG8_STAGE2(PG8_SA(0, 0), a2, s00, s01);
            PG8_BAR; PG8_WAIT_L(0); PG8_MMA(1, 0, At, B0); PG8_BAR; PG8_SCHED;
            PG8_STAGE2(PG8_SB(0, 1), b2 + hstepB, voffB[0], voffB[1]);
            PG8_WAIT_V(6); PG8_BAR; PG8_MMA(1, 1, At, B1); PG8_BAR;
            PG8_LDB(B0, 1, 0); PG8_SCHED; PG8_LDA(At, 1, 0); PG8_STAGE2(PG8_SA(0, 1), a2, s10, s11);
            PG8_WAIT_L(8); PG8_BAR; PG8_WAIT_L(0); PG8_MMA(0, 0, At, B0); PG8_BAR; PG8_SCHED;
            PG8_LDB(B1, 1, 1); PG8_STAGE2(PG8_SB(1, 0), b3, voffB[0], voffB[1]);
            PG8_BAR; PG8_WAIT_L(0); PG8_MMA(0, 1, At, B1); PG8_BAR;
            PG8_LDA(At, 1, 1); PG8_STAGE2(PG8_SA(1, 0), a3, s00, s01);
            PG8_BAR; PG8_WAIT_L(0); PG8_MMA(1, 0, At, B0); PG8_BAR; PG8_SCHED;
            PG8_STAGE2(PG8_SB(1, 1), b3 + hstepB, voffB[0], voffB[1]);
            PG8_WAIT_V(6); PG8_BAR; PG8_MMA(1, 1, At, B1); PG8_BAR;
        }
        E(acc, cur, wr, wc, fr, fq);
        if (!has_next) break;
        asm volatile("v_mov_b32 %0, 0" : "=v"(zr));
#pragma unroll
        for (int a = 0; a < 2; ++a)
#pragma unroll
            for (int b = 0; b < 2; ++b)
#pragma unroll
                for (int m = 0; m < 4; ++m)
#pragma unroll
                    for (int n = 0; n < 2; ++n) acc[a][b][m][n] = (f32x4){zr, zr, zr, zr};
        cur = nxt; cA = nA; ++ui; c00 = n00; c01 = n01; c10 = n10; c11 = n11;
    }
    PG8_WAIT_V(0);
    if (wr == 0) PG8_BAR;
    PG8_BAR;
#undef PG8_SA
#undef PG8_SB
#undef PG8_STAGE2
#undef PG8_LDA
#undef PG8_LDB
#undef PG8_MMA
#undef PG8_WAIT_V
#undef PG8_WAIT_L
#undef PG8_BAR
#undef PG8_SCHED
#undef PG8_BP
}

struct DenseSched {
    const char* A; const char* Bt; int lda, ldb, K; int nM, nN, nwg, G, c, skipctx;
    __device__ __forceinline__ void init(const void* A_, const void* Bt_, int M, int N, int K_, int lda_, int ldb_, int G_, int c_, int skipctx_ = 0) {
        A = (const char*)A_; Bt = (const char*)Bt_; lda = lda_; ldb = ldb_; K = K_; nM = M / BM - 2 * skipctx_; nN = N / BM; nwg = nM * nN; G = G_; c = c_; skipctx = skipctx_; }
    __device__ __forceinline__ bool get(int i, Unit& u) const {
        const long L = (long)i * G + c; if (L >= nwg) return false;
        int wgid = (int)L; { const int q = nwg / NXCD, r = nwg % NXCD, xcd = wgid % NXCD, off = wgid / NXCD; wgid = (xcd < r ? xcd * (q + 1) : r * (q + 1) + (xcd - r) * q) + off; }
        const int nig = WGM * nN, gid = wgid / nig, fm = gid * WGM, gsz = (nM - fm) < WGM ? (nM - fm) : WGM;
        int pm = fm + ((wgid % nig) % gsz); const int pn = (wgid % nig) / gsz;
        if (skipctx) pm += 1 + (pm >= 64 ? 1 : 0);
        u.a0 = A + (size_t)pm * BM * lda * 2; u.b0 = Bt + (size_t)pn * BM * ldb * 2; u.b1 = u.b0 + (size_t)(K / BK / 2) * BK * 2;
        u.i0 = pm; u.i1 = pn; u.i2 = 0; u.i3 = 0; u.i4 = 0; u.pad = 0; return true;
    }
    __device__ __forceinline__ void a_ready(const Unit&) const {}
    __device__ __forceinline__ int arow(const Unit&, int rl) const { return rl; }
    __device__ __forceinline__ const int* rows_ptr(const Unit&) const { return nullptr; }
    __device__ __forceinline__ int rows_valid(const Unit&) const { return 256; }
};
}

struct EpiProj {
    static constexpr bool PERM = true, MIDSCALE = false;
    bf16_t* O;
    __device__ __forceinline__ void operator()(const f32x4 (&acc)[2][2][4][2], const pg8::Unit& u, int wr, int wc, int fr, int fq) const {
        const int row0 = u.i0 * 256 + wr * 64 + fr, col0 = u.i1 * 256 + wc * 32 + 8 * fq;
#pragma unroll
        for (int ai = 0; ai < 2; ++ai)
#pragma unroll
            for (int m = 0; m < 4; ++m) { bf16_t* rowp = O + (size_t)(row0 + ai * 128 + m * 16) * NPROJ + col0;
#pragma unroll
                for (int bj = 0; bj < 2; ++bj) { const f32x4 v0 = acc[ai][bj][m][0], v1 = acc[ai][bj][m][1];
                    u32x4 w; w.x = cvt_pk_bf16(v0[0], v0[1]); w.y = cvt_pk_bf16(v0[2], v0[3]); w.z = cvt_pk_bf16(v1[0], v1[1]); w.w = cvt_pk_bf16(v1[2], v1[3]);
                    *(u32x4*)(rowp + bj * 128) = w; } }
    }
};
template <int L0> struct EpiResid {
    static constexpr bool PERM = true, MIDSCALE = true;
    const float* inc; const float* inx; bf16_t* H; const float* modl; const float* ssq;
    __device__ __forceinline__ void midscale(f32x4 (&acc)[2][2][4][2], const pg8::Unit& u, int wr, int wc, int fr, int fq) const {
        typedef float f32x2 __attribute__((ext_vector_type(2)));
        const int r0 = u.i0 * 256 + wr * 64 + fr;
        f32x2 part[2][4];
#pragma unroll
        for (int ai = 0; ai < 2; ++ai)
#pragma unroll
            for (int m = 0; m < 4; ++m) part[ai][m] = *(const f32x2*)(ssq + (size_t)(r0 + ai * 128 + m * 16) * 8 + 2 * fq);
#pragma unroll
        for (int ai = 0; ai < 2; ++ai)
#pragma unroll
            for (int m = 0; m < 4; ++m) { float sq = part[ai][m][0] + part[ai][m][1];
                sq += __shfl_xor(sq, 16); sq += __shfl_xor(sq, 32);
                const float rs = rsqrtf(sq * (1.f / 512.f) + 1e-6f);
#pragma unroll
                for (int bj = 0; bj < 2; ++bj)
#pragma unroll
                    for (int n = 0; n < 2; ++n) acc[ai][bj][m][n] *= rs; }
    }
    __device__ __forceinline__ void operator()(const f32x4 (&acc)[2][2][4][2], const pg8::Unit& u, int wr, int wc, int fr, int fq) const {
        const int r0 = u.i0 * 256;
        const int v = row_v(r0);
        const float* gate = modl + (size_t)v * 6144 + 2 * 1024;
        const float* xin = xin_ptr(inc, inx, r0);
        const int rl0 = wr * 64 + fr, col0 = u.i1 * 256 + wc * 32 + 8 * fq;
        f32x4 gv[2][2];
#pragma unroll
        for (int bj = 0; bj < 2; ++bj)
#pragma unroll
            for (int n = 0; n < 2; ++n) gv[bj][n] = *(const f32x4*)(gate + col0 + bj * 128 + 4 * n);
#pragma unroll
        for (int ai = 0; ai < 2; ++ai)
#pragma unroll
            for (int mp = 0; mp < 2; ++mp) {
                if (L0) {
                    f32x4 hi[2][2][2];
#pragma unroll
                    for (int mm = 0; mm < 2; ++mm) { const size_t off = (size_t)(rl0 + ai * 128 + (2 * mp + mm) * 16) * D + col0;
#pragma unroll
                        for (int bj = 0; bj < 2; ++bj)
#pragma unroll
                            for (int n = 0; n < 2; ++n) hi[mm][bj][n] = *(const f32x4*)(xin + off + bj * 128 + 4 * n); }
#pragma unroll
                    for (int mm = 0; mm < 2; ++mm)
#pragma unroll
                        for (int bj = 0; bj < 2; ++bj) { const f32x4 o0 = hi[mm][bj][0] + gv[bj][0] * acc[ai][bj][2 * mp + mm][0], o1 = hi[mm][bj][1] + gv[bj][1] * acc[ai][bj][2 * mp + mm][1];
                            u32x4 w; w.x = cvt_pk_bf16(o0[0], o0[1]); w.y = cvt_pk_bf16(o0[2], o0[3]); w.z = cvt_pk_bf16(o1[0], o1[1]); w.w = cvt_pk_bf16(o1[2], o1[3]);
                            *(u32x4*)(H + (size_t)(r0 + rl0 + ai * 128 + (2 * mp + mm) * 16) * D + col0 + bj * 128) = w; }
                } else {
                    u32x4 hr[2][2];
#pragma unroll
                    for (int mm = 0; mm < 2; ++mm)
#pragma unroll
                        for (int bj = 0; bj < 2; ++bj) hr[mm][bj] = *(const u32x4*)(H + (size_t)(r0 + rl0 + ai * 128 + (2 * mp + mm) * 16) * D + col0 + bj * 128);
#pragma unroll
                    for (int mm = 0; mm < 2; ++mm)
#pragma unroll
                        for (int bj = 0; bj < 2; ++bj) { const u32x4 hv = hr[mm][bj]; const f32x4 a0 = acc[ai][bj][2 * mp + mm][0], a1 = acc[ai][bj][2 * mp + mm][1]; const f32x4 g0 = gv[bj][0], g1 = gv[bj][1];
                            u32x4 w;
                            w.x = cvt_pk_bf16(bflo(hv.x) + g0[0] * a0[0], bfhi(hv.x) + g0[1] * a0[1]); w.y = cvt_pk_bf16(bflo(hv.y) + g0[2] * a0[2], bfhi(hv.y) + g0[3] * a0[3]);
                            w.z = cvt_pk_bf16(bflo(hv.z) + g1[0] * a1[0], bfhi(hv.z) + g1[1] * a1[1]); w.w = cvt_pk_bf16(bflo(hv.w) + g1[2] * a1[2], bfhi(hv.w) + g1[3] * a1[3]);
                            *(u32x4*)(H + (size_t)(r0 + rl0 + ai * 128 + (2 * mp + mm) * 16) * D + col0 + bj * 128) = w; }
                }
                asm volatile("" ::: "memory"); }
    }
};

__device__ __forceinline__ const char* uniform_ptr(const char* q) {
    const unsigned long long v = (unsigned long long)q;
    const unsigned lo = __builtin_amdgcn_readfirstlane((unsigned)v), hi = __builtin_amdgcn_readfirstlane((unsigned)(v >> 32));
    return (const char*)(((unsigned long long)hi << 32) | lo);
}
struct MoeSched {
    const LAS int* tab;
    const int* list;
    const char* A; const char* W; int mode  , l, G, c;
    unsigned* ready;
    __device__ __forceinline__ void a_ready(const pg8::Unit& u) const {
        if (mode == 0) return;
        if (threadIdx.x < 64) {
            unsigned* w = ready + u.i4; unsigned spins = 0;
            while ((unsigned)__builtin_amdgcn_readfirstlane((int)__hip_atomic_load(w, __ATOMIC_RELAXED, __HIP_MEMORY_SCOPE_AGENT)) < 32u) {
                __builtin_amdgcn_s_sleep(2); if (++spins > (1u << 22)) break; }
            __builtin_amdgcn_fence(__ATOMIC_ACQUIRE, "agent");
            asm volatile("s_waitcnt vmcnt(0)" ::: "memory");
        }
        asm volatile("" ::: "memory"); __builtin_amdgcn_s_barrier(); asm volatile("" ::: "memory");
    }
    int late;
    __device__ __forceinline__ bool get(int i, pg8::Unit& u) const {
        const int total = __builtin_amdgcn_readfirstlane(tab[24]) * 4;
        int L;
        if (mode == 0 || late == 0) L = i * G + c;
        else if (c < late) { if (i > 0) return false; L = c; }
        else L = late + (c - late) + i * (G - late);
        if (L >= total) return false;
        const int tl = L >> 2, pn = L & 3;
        int cls = 0;
#pragma unroll 1
        for (int q = 1; q < NCLS; ++q) { const int tq = __builtin_amdgcn_readfirstlane(tab[q]); if (tq <= tl) cls = q; }
        const int j = tl - __builtin_amdgcn_readfirstlane(tab[cls]), cnt = __builtin_amdgcn_readfirstlane(tab[32 + cls]);
        const int g = cls / 6, pidx = cls - g * 6;
        const int ea = (pidx >= 3) + (pidx >= 5), eb = pidx < 3 ? pidx + 1 : (pidx < 5 ? pidx - 1 : 3);
        if (mode == 0) {
            const int e = 4 * g + (pn < 2 ? ea : eb);
            u.a0 = A;
            u.b0 = W + ((size_t)(l * 16 + e) * 512 + (size_t)(pn & 1) * 256) * 1024 * 2; u.b1 = u.b0 + (size_t)8 * 128;
        } else {
            u.a0 = A + (size_t)tl * 256 * 512 * 2;
            u.b0 = W + ((size_t)(l * 16 + 4 * g + ea) * 1024 + (size_t)pn * 256) * 256 * 2;
            u.b1 = W + ((size_t)(l * 16 + 4 * g + eb) * 1024 + (size_t)pn * 256) * 256 * 2;
        }
        u.a0 = uniform_ptr(u.a0); u.b0 = uniform_ptr(u.b0); u.b1 = uniform_ptr(u.b1);
        u.i0 = cls; u.i1 = j; u.i2 = pn; u.i3 = cnt; u.i4 = tl; u.pad = 0; return true;
    }
    __device__ __forceinline__ int arow(const pg8::Unit& u, int rl) const {
        int idx = u.i1 * 256 + rl; idx = idx < u.i3 ? idx : u.i3 - 1;
        return list[(size_t)u.i0 * R + idx];
    }
    __device__ __forceinline__ const int* rows_ptr(const pg8::Unit& u) const { return list + (size_t)u.i0 * R + u.i1 * 256; }
    __device__ __forceinline__ int rows_valid(const pg8::Unit& u) const { return u.i3 - u.i1 * 256; }
};
struct EpiUp {
    static constexpr bool PERM = true, MIDSCALE = false;
    bf16_t* hid; const float* cwla; const float* cwlb; unsigned* ready;
    __device__ __forceinline__ void operator()(const f32x4 (&acc)[2][2][4][2], const pg8::Unit& u, int wr, int wc, int fr, int fq) const {
        const int cls = u.i0, j = u.i1, pn = u.i2, cnt = u.i3, tl = u.i4;
        const float* cw = (pn < 2) ? cwla : cwlb;
        const int colbase = (pn >> 1) * 256 + (pn & 1) * 128 + wc * 32 + 8 * fq;
        float wrow[2][4];
#pragma unroll
        for (int ai = 0; ai < 2; ++ai)
#pragma unroll
            for (int m = 0; m < 4; ++m) { const int idx = j * 256 + ai * 128 + wr * 64 + m * 16 + fr; wrow[ai][m] = idx < cnt ? cw[(size_t)cls * R + idx] : 0.f; }
#pragma unroll
        for (int ai = 0; ai < 2; ++ai)
#pragma unroll
            for (int m = 0; m < 4; ++m) {
                const int rl = ai * 128 + wr * 64 + m * 16 + fr; const int idx = j * 256 + rl; const bool valid = idx < cnt;
                const float w = wrow[ai][m];
                const f32x4 g0 = acc[ai][0][m][0], g1 = acc[ai][0][m][1], u0 = acc[ai][1][m][0], u1 = acc[ai][1][m][1];
                float o[8];
#pragma unroll
                for (int e = 0; e < 4; ++e) { o[e] = w * siluf_(g0[e]) * u0[e]; o[4 + e] = w * siluf_(g1[e]) * u1[e]; }
                if (!valid) {
#pragma unroll
                    for (int e = 0; e < 8; ++e) o[e] = 0.f; }
                u32x4 pk; pk.x = cvt_pk_bf16(o[0], o[1]); pk.y = cvt_pk_bf16(o[2], o[3]); pk.z = cvt_pk_bf16(o[4], o[5]); pk.w = cvt_pk_bf16(o[6], o[7]);
                { bf16_t* dstp = hid + ((size_t)tl * 256 + rl) * 512 + colbase;
                  asm volatile("global_store_dwordx4 %0, %1, off sc1\n\ts_nop 1" :: "v"(dstp), "v"(pk) : "memory"); }
            }
        asm volatile("s_waitcnt vmcnt(0)" ::: "memory");
        if ((threadIdx.x & 63) == 0) __hip_atomic_fetch_add(ready + tl, 1u, __ATOMIC_RELAXED, __HIP_MEMORY_SCOPE_AGENT);
    }
};
struct EpiDown {
    static constexpr bool PERM = true, MIDSCALE = false;
    bf16_t* H; const int* list; const float* modl;
    __device__ __forceinline__ void operator()(const f32x4 (&acc)[2][2][4][2], const pg8::Unit& u, int wr, int wc, int fr, int fq) const {
        const int cls = u.i0, j = u.i1, pn = u.i2, cnt = u.i3;
        const int col0 = pn * 256 + wc * 32 + 8 * fq;
        int tok[2][4];
#pragma unroll
        for (int ai = 0; ai < 2; ++ai)
#pragma unroll
            for (int m = 0; m < 4; ++m) { const int idx = j * 256 + ai * 128 + wr * 64 + m * 16 + fr; tok[ai][m] = idx < cnt ? list[(size_t)cls * R + idx] : -1; }
#pragma unroll
        for (int ai = 0; ai < 2; ++ai)
#pragma unroll
            for (int mp = 0; mp < 2; ++mp) {
                u32x4 hr[2][2]; f32x4 gv[2][2][2];
#pragma unroll
                for (int mm = 0; mm < 2; ++mm) { const int t = tok[ai][2 * mp + mm]; const int tt = t < 0 ? 0 : t;
                    const bf16_t* hp = H + (size_t)tt * D + col0; const float* gp = modl + (size_t)row_v(tt) * 6144 + col0;
#pragma unroll
                    for (int bj = 0; bj < 2; ++bj) { hr[mm][bj] = *(const u32x4*)(hp + bj * 128); gv[mm][bj][0] = *(const f32x4*)(gp + bj * 128); gv[mm][bj][1] = *(const f32x4*)(gp + bj * 128 + 4); } }
#pragma unroll
                for (int mm = 0; mm < 2; ++mm) { const int t = tok[ai][2 * mp + mm];
                    if (t >= 0) {
#pragma unroll
                        for (int bj = 0; bj < 2; ++bj) { const u32x4 hv = hr[mm][bj]; const f32x4 a0 = acc[ai][bj][2 * mp + mm][0], a1 = acc[ai][bj][2 * mp + mm][1]; const f32x4 g0 = gv[mm][bj][0], g1 = gv[mm][bj][1];
                            u32x4 w;
                            w.x = cvt_pk_bf16(bflo(hv.x) + g0[0] * a0[0], bfhi(hv.x) + g0[1] * a0[1]); w.y = cvt_pk_bf16(bflo(hv.y) + g0[2] * a0[2], bfhi(hv.y) + g0[3] * a0[3]);
                            w.z = cvt_pk_bf16(bflo(hv.z) + g1[0] * a1[0], bfhi(hv.z) + g1[1] * a1[1]); w.w = cvt_pk_bf16(bflo(hv.w) + g1[2] * a1[2], bfhi(hv.w) + g1[3] * a1[3]);
                            *(u32x4*)(H + (size_t)t * D + col0 + bj * 128) = w; } } }
                asm volatile("" ::: "memory"); }
    }
};

__device__ __forceinline__ void tr_tile(const float* src, int ldn, int k0, int n0, int nvalid, bf16_t* dst, int ldk, int drow0, LAS float* tile, int kd0 = -1, const float* kscale = nullptr) {
    const int tid = launder_tid();
    if (kd0 < 0) kd0 = k0;
    { const int n = tid & 63; const int kq = tid >> 6; float tv[8], ts[8];
#pragma unroll
      for (int it = 0; it < 8; ++it) { const int kk = kq + 8 * it; tv[it] = (n < nvalid) ? src[(size_t)(k0 + kk) * ldn + n0 + n] : 0.f; ts[it] = kscale ? kscale[kk] : 1.f; }
#pragma unroll
      for (int it = 0; it < 8; ++it) tile[(kq + 8 * it) * 65 + n] = tv[it] * ts[it]; }
    __syncthreads();
    { const int k8 = tid & 7, n = tid >> 3;
      if (n < nvalid) { const LAS float* s = tile + (k8 * 8) * 65 + n;
          u32x4 o; o.x = cvt_pk_bf16(s[0], s[65]); o.y = cvt_pk_bf16(s[2 * 65], s[3 * 65]); o.z = cvt_pk_bf16(s[4 * 65], s[5 * 65]); o.w = cvt_pk_bf16(s[6 * 65], s[7 * 65]);
          *(u32x4*)(dst + (size_t)(drow0 + n) * ldk + kd0 + k8 * 8) = o; } }
    __syncthreads();
}
constexpr int WPREP_ITEMS_PER_LAYER = 16 * 41 + 256 + 1024 + 1024 + 1024;
__device__ __forceinline__ void phase_wprep(CP p, unsigned char* lds, int it0, int it1, int bidx, int nblk) {
    LAS float* tile = (LAS float*)(LAS unsigned char*)lds;
    constexpr int I_IN = 16 * 41, I_OUT = 256, I_G = 1024, I_U = 1024, I_D = 1024, I_L = I_IN + I_OUT + I_G + I_U + I_D;
    for (int it = it0 + bidx; it < it1; it += nblk) {
        const int l = it / I_L; int r = it - l * I_L;
        if (r < I_IN) { const int kt = r / 41, ntl = r % 41; const int n0 = ntl * 64; const int nv = (DIN - n0) < 64 ? (DIN - n0) : 64;
            tr_tile(p->w_in + (size_t)l * 1024 * DIN, DIN, kt * 64, n0, nv, (bf16_t*)(p->ws + WS_WTIN) + (size_t)l * DIN * 1024, 1024, n0, tile); continue; }
        r -= I_IN;
        if (r < I_OUT) { const int kt = r >> 4, ntl = r & 15;
            tr_tile(p->w_out + (size_t)l * 1024 * 1024, 1024, kt * 64, ntl * 64, 64, (bf16_t*)(p->ws + WS_WTOUT) + (size_t)l * 1024 * 1024, 1024, ntl * 64, tile,
                    (kt * 64 + 512) & 1023, kt >= 8 ? p->ssd_norm_g + l * 512 + (kt * 64 - 512) : nullptr); continue; }
        r -= I_OUT;
        if (r < I_G + I_U) { const int up = r >= I_G; if (up) r -= I_G; const int e = r >> 6, q = r & 63, kt = q >> 2, ntl = q & 3; const int n0 = ntl * 64;
            const float* src = (up ? p->w_up : p->w_gate) + (size_t)(l * 16 + e) * 1024 * 256;
            tr_tile(src, 256, kt * 64, n0, 64, (bf16_t*)(p->ws + WS_WTGU) + (size_t)(l * 16 + e) * 512 * 1024, 1024, (n0 >> 7) * 256 + (n0 & 127) + (up ? 128 : 0), tile); continue; }
        r -= I_G + I_U;
        { const int e = r >> 6, q = r & 63, kt = q >> 4, ntl = q & 15;
          tr_tile(p->w_down + (size_t)(l * 16 + e) * 256 * 1024, 1024, kt * 64, ntl * 64, 64, (bf16_t*)(p->ws + WS_WTD) + (size_t)(l * 16 + e) * 1024 * 256, 256, ntl * 64, tile); }
    }
}
__device__ __forceinline__ void phase_adaln(CP p, unsigned char* lds, int bid, int nb) {
    LAS float* sc = (LAS float*)(LAS unsigned char*)lds;
    LAS float* red = sc + 3 * 1024;
    const int tid = launder_tid();
    for (int idx = tid; idx < 3 * 1024; idx += NTHREADS) { const int v = idx >> 10, k = idx & 1023; const float cv = (v < 2) ? p->c[v * 1024 + k] : p->c_ctx[k]; sc[idx] = siluf_(cv); }
    __syncthreads();
    float* mod = (float*)(p->ws + WS_MOD);
    for (int it = bid; it < 2 * 96; it += nb) {
        const int l = it / 96, n0 = (it % 96) * 64;
        const int c4 = tid & 15, kr = tid >> 4;
        f32x4 a0 = {0, 0, 0, 0}, a1 = {0, 0, 0, 0}, a2 = {0, 0, 0, 0};
        const float* w = p->w_ada + (size_t)l * 1024 * 6144 + n0 + c4 * 4;
#pragma unroll 4
        for (int k = kr; k < 1024; k += 32) { const f32x4 w4 = *(const f32x4*)(w + (size_t)k * 6144); a0 += sc[k] * w4; a1 += sc[1024 + k] * w4; a2 += sc[2048 + k] * w4; }
        *(LAS f32x4*)(red + (kr * 3 + 0) * 64 + c4 * 4) = a0; *(LAS f32x4*)(red + (kr * 3 + 1) * 64 + c4 * 4) = a1; *(LAS f32x4*)(red + (kr * 3 + 2) * 64 + c4 * 4) = a2;
        __syncthreads();
        if (tid < 192) { const int v = tid >> 6, cc = tid & 63; float s = 0.f;
            for (int q = 0; q < 32; ++q) s += red[(q * 3 + v) * 64 + cc];
            mod[((size_t)l * 3 + v) * 6144 + n0 + cc] = s + p->b_ada[l * 6144 + n0 + cc]; }
        __syncthreads();
    }
}
__device__ __forceinline__ void moe_table(CP p, int l, LAS int* tab) {
    const int* gcount = (const int*)(p->ws + WS_CTL) + l * 32;
    if (threadIdx.x == 0) { int acc = 0; for (int q = 0; q < NCLS; ++q) { const int cn = gcount[q]; tab[q] = acc; tab[32 + q] = cn; acc += (cn + 255) >> 8; } tab[24] = acc; }
    __syncthreads();
}
__device__ __forceinline__ void moe_yload(CP p, int pos, int lane, const LAS int* tab, u32x2 (&yv)[4]) {
    const int slot = tab[pos >> 16] * 256 + (pos & 0xffff);
    const bf16_t* y = (const bf16_t*)(p->ws + WS_Y) + (size_t)slot * 1024;
#pragma unroll
    for (int j = 0; j < 4; ++j) yv[j] = *(const u32x2*)(y + 4 * lane + 256 * j);
}
__device__ __forceinline__ void moe_yadd(CP p, int lm, int v, int lane, const u32x2 (&yv)[4], f32x4 (&xv)[4]) {
    const float* gate = (const float*)(p->ws + WS_MOD) + ((size_t)lm * 3 + v) * 6144 + 5 * 1024;
#pragma unroll
    for (int j = 0; j < 4; ++j) { const int k = 4 * lane + 256 * j; const f32x4 g4 = *(const f32x4*)(gate + k);
        xv[j][0] += g4[0] * bflo(yv[j].x); xv[j][1] += g4[1] * bfhi(yv[j].x); xv[j][2] += g4[2] * bflo(yv[j].y); xv[j][3] += g4[3] * bfhi(yv[j].y); }
}
typedef _Float16 f16x8 __attribute__((ext_vector_type(8)));
typedef _Float16 f16x2 __attribute__((ext_vector_type(2)));
constexpr int ST_H16 = 2064;
__device__ __forceinline__ unsigned pack_f16(float a, float b) { f16x2 h; h[0] = (_Float16)a; h[1] = (_Float16)b; return __builtin_bit_cast(unsigned, h); }
__device__ __forceinline__ void phase_r1(CP p, int l, unsigned char* lds_, int bid, int nb) {
    LAS unsigned char* lds = (LAS unsigned char*)lds_;
    LAS unsigned char* Wh = lds;
    LAS unsigned char* Xh = Wh + 16 * ST_H16;
    LAS float* gm = (LAS float*)(Xh + 16 * ST_H16);
    LAS float* sh = gm + 3 * 1024;
    LAS float* part = sh + 3 * 1024;
    const int tid = launder_tid(); const int lane = tid & 63, wave = __builtin_amdgcn_readfirstlane(tid >> 6);
    const float* mod = (const float*)(p->ws + WS_MOD) + (size_t)l * 3 * 6144;
    const float* win = p->w_in + (size_t)l * 1024 * DIN;
#pragma unroll
    for (int hb = 0; hb < 2; ++hb) { float tmp[16];
#pragma unroll
        for (int it = 0; it < 16; ++it) { const int idx = tid + NTHREADS * (16 * hb + it); tmp[it] = win[(size_t)(idx >> 4) * DIN + NPROJ + (idx & 15)]; }
#pragma unroll
        for (int it = 0; it < 16; ++it) { const int idx = tid + NTHREADS * (16 * hb + it); *(LAS _Float16*)(Wh + (idx & 15) * ST_H16 + (idx >> 4) * 2) = (_Float16)tmp[it]; } }
    { float t0[6], t1[6], t2[6];
#pragma unroll
      for (int it = 0; it < 6; ++it) { const int idx = tid + NTHREADS * it; const int v = idx >> 10, k = idx & 1023; t0[it] = p->g_mix[l * 1024 + k]; t1[it] = mod[v * 6144 + 1024 + k]; t2[it] = mod[v * 6144 + k]; }
#pragma unroll
      for (int it = 0; it < 6; ++it) { const int idx = tid + NTHREADS * it; gm[idx] = t0[it] * (1.f + t1[it]); sh[idx] = t2[it]; } }
    __syncthreads();
    bf16_t* HX = (bf16_t*)(p->ws + WS_HX); float* DT = (float*)(p->ws + WS_DT);
    const int rpb = (R + nb - 1) / nb, r0 = bid * rpb, r1 = (r0 + rpb) < R ? (r0 + rpb) : R;
    RowRaw xn[2];
#pragma unroll
    for (int q = 0; q < 2; ++q) if (r0 + 2 * wave + q < r1) row_load(p, l, r0 + 2 * wave + q, lane, xn[q]);
#pragma unroll 1
    for (int t0r = r0; t0r < r1; t0r += 16) {
        f32x4 xv[2][4];
#pragma unroll
        for (int q = 0; q < 2; ++q) row_cvt(l, xn[q], xv[q]);
#pragma unroll
        for (int q = 0; q < 2; ++q) if (t0r + 16 + 2 * wave + q < r1) row_load(p, l, t0r + 16 + 2 * wave + q, lane, xn[q]);
#pragma unroll
        for (int q = 0; q < 2; ++q) { const int rr = t0r + 2 * wave + q; const bool ok = rr < r1; const int v = row_v(ok ? rr : r0);
            if (l == 0 && ok) { u32x2* hw = (u32x2*)((bf16_t*)(p->ws + WS_H) + (size_t)rr * D);
#pragma unroll
                for (int j = 0; j < 4; ++j) { u32x2 o; o.x = cvt_pk_bf16(xv[q][j][0], xv[q][j][1]); o.y = cvt_pk_bf16(xv[q][j][2], xv[q][j][3]); hw[lane + 64 * j] = o; } }
            float ss = 0.f;
#pragma unroll
            for (int j = 0; j < 4; ++j) ss += xv[q][j][0] * xv[q][j][0] + xv[q][j][1] * xv[q][j][1] + xv[q][j][2] * xv[q][j][2] + xv[q][j][3] * xv[q][j][3];
            ss = wave_sum(ss); const float rs = ok ? rsqrtf(ss * (1.f / 1024.f) + 1e-6f) : 0.f;
#pragma unroll
            for (int j = 0; j < 4; ++j) { const int k = 4 * lane + 256 * j; const f32x4 g4 = *(const LAS f32x4*)(gm + v * 1024 + k), s4 = *(const LAS f32x4*)(sh + v * 1024 + k);
                f32x4 hv = xv[q][j] * rs * g4 + s4; if (!ok) hv = hv * 0.f;
                u32x2 o; o.x = cvt_pk_bf16(hv[0], hv[1]); o.y = cvt_pk_bf16(hv[2], hv[3]);
                if (ok) *(u32x2*)(HX + (size_t)rr * 1024 + k) = o;
                u32x2 h16; h16.x = pack_f16(hv[0], hv[1]); h16.y = pack_f16(hv[2], hv[3]);
                *(LAS u32x2*)(Xh + (2 * wave + q) * ST_H16 + k * 2) = h16; } }
        __syncthreads();
        {
            f32x4 acc0 = {0.f, 0.f, 0.f, 0.f};
#pragma unroll
            for (int s4 = 0; s4 < 4; ++s4) { const int kb = (128 * wave + 32 * s4 + 8 * (lane >> 4)) * 2;
                const f16x8 a = *(const LAS f16x8*)(Xh + (lane & 15) * ST_H16 + kb);
                const f16x8 b0 = *(const LAS f16x8*)(Wh + (lane & 15) * ST_H16 + kb);
                acc0 = __builtin_amdgcn_mfma_f32_16x16x32_f16(a, b0, acc0, 0, 0, 0); }
#pragma unroll
            for (int e = 0; e < 4; ++e) part[(wave * 16 + 4 * (lane >> 4) + e) * 16 + (lane & 15)] = acc0[e];
        }
        __syncthreads();
        if (tid < 256) { const int row = tid >> 4, n = tid & 15; const int rr = t0r + row;
            float sacc = p->dt_bias[l * 16 + n];
#pragma unroll
            for (int w = 0; w < 8; ++w) sacc += part[(w * 16 + row) * 16 + n];
            if (rr < r1) DT[(size_t)rr * 16 + n] = softplusf_(sacc); }
    }
    __syncthreads();
}
typedef float f32x16 __attribute__((ext_vector_type(16)));
typedef short s16x4 __attribute__((ext_vector_type(4)));
constexpr int ST_ROW = 272;
constexpr int ST_TR128 = 320;
constexpr int ST_TR64 = 192;
constexpr int ST_MT = 328;
constexpr int NCHUNK = SEG / 128;

#define DPP_MOV(v, ctrl, rm, bm) __builtin_bit_cast(float, __builtin_amdgcn_update_dpp(0, __builtin_bit_cast(int, (v)), (ctrl), (rm), (bm), true))
__device__ __forceinline__ float wave_incl_scan(float v, int) {
    float s = v + DPP_MOV(v, 0x111, 0xF, 0xF) + DPP_MOV(v, 0x112, 0xF, 0xF) + DPP_MOV(v, 0x113, 0xF, 0xF);
    s += DPP_MOV(s, 0x114, 0xF, 0xE);
    s += DPP_MOV(s, 0x118, 0xF, 0xC);
    s += DPP_MOV(s, 0x142, 0xA, 0xF);
    s += DPP_MOV(s, 0x143, 0xC, 0xF);
    return s;
}
__device__ __forceinline__ bf16x8 row_frag(const LAS unsigned char* tile, int stride, int row0, int k0, int lane) {
    return *(const LAS bf16x8*)(tile + (row0 + (lane & 31)) * stride + (k0 + 8 * (lane >> 5)) * 2);
}
__device__ __forceinline__ bf16x8 tr_frag(const LAS unsigned char* tile, int stride, int k0, int c0, int lane) {
    const int g = lane >> 4, li = lane & 15, q = li >> 2, pp = li & 3;
    const LAS unsigned char* a0 = tile + (k0 + 8 * (g >> 1) + q) * stride + (c0 + 16 * (g & 1) + 4 * pp) * 2;
    const s16x4 lo = __builtin_amdgcn_ds_read_tr16_b64_v4i16((LAS s16x4*)a0);
    const s16x4 hi = __builtin_amdgcn_ds_read_tr16_b64_v4i16((LAS s16x4*)(a0 + 4 * stride));
    return __builtin_shufflevector(lo, hi, 0, 1, 2, 3, 4, 5, 6, 7);
}
__device__ __forceinline__ u32x4 pack8(const float (&v)[8]) { u32x4 r; r.x = cvt_pk_bf16(v[0], v[1]); r.y = cvt_pk_bf16(v[2], v[3]); r.z = cvt_pk_bf16(v[4], v[5]); r.w = cvt_pk_bf16(v[6], v[7]); return r; }
__device__ __forceinline__ u32x4 pack8s(const float (&v)[8], float sc) { u32x4 r; r.x = cvt_pk_bf16(v[0] * sc, v[1] * sc); r.y = cvt_pk_bf16(v[2] * sc, v[3] * sc); r.z = cvt_pk_bf16(v[4] * sc, v[5] * sc); r.w = cvt_pk_bf16(v[6] * sc, v[7] * sc); return r; }

__device__ __forceinline__ void conv_load(const bf16_t* proj, int row0, int rq, int xch, bool lo_ok, bool hi_ok, u32x4 (&raw)[8]) {
    const bf16_t* base = proj + (size_t)(row0 + 4 * rq) * NPROJ + 1536 + xch;
    unsigned zz; asm volatile("v_mov_b32 %0, 0" : "=v"(zz));
#pragma unroll
    for (int j = 0; j < 8; ++j) {
        if (j < 2) { const bool ok = (rq > 0) || lo_ok; const u32x4 v = *(const u32x4*)(ok ? base + (j - 2) * NPROJ : base);
            raw[j].x = ok ? v.x : zz; raw[j].y = ok ? v.y : zz; raw[j].z = ok ? v.z : zz; raw[j].w = ok ? v.w : zz; }
        else if (j >= 6) { const bool ok = (rq < 31) || hi_ok; const u32x4 v = *(const u32x4*)(ok ? base + (j - 2) * NPROJ : base);
            raw[j].x = ok ? v.x : zz; raw[j].y = ok ? v.y : zz; raw[j].z = ok ? v.z : zz; raw[j].w = ok ? v.w : zz; }
        else raw[j] = *(const u32x4*)(base + (j - 2) * NPROJ);
    }
}
__device__ __forceinline__ void conv_compute(const u32x4 (&raw)[8], const LAS float* wl, int nchl, int wch, float (&o)[4][8]) {
    float w[5][8], bs[8];
#pragma unroll
    for (int j = 0; j < 5; ++j) { const f32x4 w0 = *(const LAS f32x4*)(wl + j * nchl + wch), w1 = *(const LAS f32x4*)(wl + j * nchl + wch + 4);
        w[j][0] = w0[0]; w[j][1] = w0[1]; w[j][2] = w0[2]; w[j][3] = w0[3]; w[j][4] = w1[0]; w[j][5] = w1[1]; w[j][6] = w1[2]; w[j][7] = w1[3]; }
    { const f32x4 b0 = *(const LAS f32x4*)(wl + 5 * nchl + wch), b1 = *(const LAS f32x4*)(wl + 5 * nchl + wch + 4); bs[0] = b0[0]; bs[1] = b0[1]; bs[2] = b0[2]; bs[3] = b0[3]; bs[4] = b1[0]; bs[5] = b1[1]; bs[6] = b1[2]; bs[7] = b1[3]; }
#pragma unroll
    for (int i = 0; i < 4; ++i)
#pragma unroll
        for (int e = 0; e < 8; ++e) o[i][e] = bs[e];
#pragma unroll
    for (int j = 0; j < 8; ++j) {
        float xv[8] = {bflo(raw[j].x), bfhi(raw[j].x), bflo(raw[j].y), bfhi(raw[j].y), bflo(raw[j].z), bfhi(raw[j].z), bflo(raw[j].w), bfhi(raw[j].w)};
#pragma unroll
        for (int i = 0; i < 4; ++i) { const int tap = j - i; if (tap >= 0 && tap < 5) {
#pragma unroll
                for (int e = 0; e < 8; ++e) o[i][e] += w[tap][e] * xv[e]; } }
    }
#pragma unroll
    for (int i = 0; i < 4; ++i)
#pragma unroll
        for (int e = 0; e < 8; ++e) o[i][e] = siluf_(o[i][e]);
}
__device__ __forceinline__ void head_cums(CP p, int l, int row0, int h, int dir, int lane, LAS float* hv) {
    const float A = -expf(p->a_log[l * 16 + dir * 8 + h]);
    const float* DT = (const float*)(p->ws + WS_DT);
    const float d0 = DT[(size_t)(row0 + 2 * lane) * 16 + dir * 8 + h], d1 = DT[(size_t)(row0 + 2 * lane + 1) * 16 + dir * 8 + h];
    const float x0 = d0 * A, x1 = d1 * A;
    const float incl = wave_incl_scan(x0 + x1, lane);
    const float total = __builtin_bit_cast(float, __builtin_amdgcn_readlane(__builtin_bit_cast(int, incl), 63));
    float c0, c1;
    if (dir == 0) { c1 = incl; c0 = incl - x1; } else { c0 = total - (incl - x1 - x0); c1 = total - (incl - x1); }
    hv[dir * 128 + 2 * lane] = c0; hv[dir * 128 + 2 * lane + 1] = c1;
    hv[256 + dir * 128 + 2 * lane] = d0; hv[256 + dir * 128 + 2 * lane + 1] = d1;
    if (lane == 0) hv[512 + dir] = total;
}
__device__ __forceinline__ bf16x8 scale_frag(bf16x8 f, const f32x4 w0, const f32x4 w1) {
    const u32x4 u = __builtin_bit_cast(u32x4, f);
    u32x4 r;
    r.x = cvt_pk_bf16(bflo(u.x) * w0[0], bfhi(u.x) * w0[1]); r.y = cvt_pk_bf16(bflo(u.y) * w0[2], bfhi(u.y) * w0[3]);
    r.z = cvt_pk_bf16(bflo(u.z) * w1[0], bfhi(u.z) * w1[1]); r.w = cvt_pk_bf16(bflo(u.w) * w1[2], bfhi(u.w) * w1[3]);
    return __builtin_bit_cast(bf16x8, r);
}
constexpr int ST_X256 = 576;

__device__ __forceinline__ void phase_c1(CP p, int l, unsigned char* lds_, int bid, int nb) {
    LAS unsigned char* lds = (LAS unsigned char*)lds_;
    LAS unsigned char* tile = lds;
    LAS float* wl = (LAS float*)(lds + 73216);
    const int tid = launder_tid();
    const bf16_t* proj = (const bf16_t*)(p->ws + WS_PROJ); bf16_t* mix = (bf16_t*)(p->ws + WS_HX);
#pragma unroll 1
    for (int u = bid; u < 256 + 512 + (l == DEPTH - 1 ? 0 : 16); u += nb) {
        int S, LEN, pstride, sstride, tok0, ch0;
        if (u < 256) { const int b = u >> 7, cs = (u >> 2) & 31, cc = u & 3; S = 2; LEN = 256; pstride = 64; sstride = 1; tok0 = b * SEG + CTXL + 2 * cs; ch0 = 256 + 64 * cc; }
        else if (u < 768) { const int v = u - 256; const int b = v >> 8, rg = (v >> 2) & 63, cc = v & 3; S = 4; LEN = 64; pstride = 1; sstride = 64; tok0 = b * SEG + CTXL + 256 * rg; ch0 = 64 * cc; }
        else { const int v = u - 768; const int b = v >> 3, cc = v & 7; S = 1; LEN = 256; pstride = 1; sstride = 0; tok0 = b * SEG; ch0 = 64 * cc; }
        const int LP = LEN + 30;
        { float tw[4];
#pragma unroll
          for (int it = 0; it < 4; ++it) { const int i = tid + NTHREADS * it; const int j = i >> 6, c = i & 63; tw[it] = j < 31 ? p->conv_w[((size_t)l * 31 + j) * 512 + ch0 + c] : p->conv_b[l * 512 + ch0 + c]; }
#pragma unroll
          for (int it = 0; it < 4; ++it) wl[tid + NTHREADS * it] = tw[it]; }
        for (int i = tid; i < S * 30 * 8; i += NTHREADS) { const int pc = i & 7, q = (i >> 3) % 30, sq = (i >> 3) / 30; const int pos = q < 15 ? q : LEN + q;
            unsigned zz; asm volatile("v_mov_b32 %0, 0" : "=v"(zz));
            *(LAS u32x4*)(tile + ((sq * LP + pos) * 64 + pc * 8) * 2) = (u32x4){zz, zz, zz, zz}; }
        for (int ib = 0; ib < S * LEN * 8; ib += 4 * NTHREADS) {
            u32x4 uv[4], gv[4];
#pragma unroll
            for (int q = 0; q < 4; ++q) { const int i = ib + tid + NTHREADS * q; const int pc = i & 7, t = i >> 3; const int sq = t / LEN, pos = t - sq * LEN;
                const bf16_t* src = proj + (size_t)(tok0 + sq * sstride + pos * pstride) * NPROJ + ch0 + pc * 8;
                uv[q] = *(const u32x4*)src; gv[q] = *(const u32x4*)(src + 512); }
#pragma unroll
            for (int q = 0; q < 4; ++q) { const int i = ib + tid + NTHREADS * q; const int pc = i & 7, t = i >> 3; const int sq = t / LEN, pos = t - sq * LEN;
                u32x4 o;
                o.x = cvt_pk_bf16(bflo(uv[q].x) * sigmoidf_(bflo(gv[q].x)), bfhi(uv[q].x) * sigmoidf_(bfhi(gv[q].x)));
                o.y = cvt_pk_bf16(bflo(uv[q].y) * sigmoidf_(bflo(gv[q].y)), bfhi(uv[q].y) * sigmoidf_(bfhi(gv[q].y)));
                o.z = cvt_pk_bf16(bflo(uv[q].z) * sigmoidf_(bflo(gv[q].z)), bfhi(uv[q].z) * sigmoidf_(bfhi(gv[q].z)));
                o.w = cvt_pk_bf16(bflo(uv[q].w) * sigmoidf_(bflo(gv[q].w)), bfhi(uv[q].w) * sigmoidf_(bfhi(gv[q].w)));
                *(LAS u32x4*)(tile + ((sq * LP + 15 + pos) * 64 + pc * 8) * 2) = o; }
        }
        __syncthreads();
        const int noct = S * LEN / 8;
#pragma unroll 1
        for (int it = tid; it < noct * 32; it += NTHREADS) {
            const int cp = it & 31, oc = it >> 5; const int sq = oc / (LEN / 8), p0 = (oc - sq * (LEN / 8)) * 8;
            const LAS unsigned* base = (const LAS unsigned*)(tile + ((sq * LP + p0) * 64) * 2) + cp;
            float i0[38], i1[38];
#pragma unroll
            for (int k = 0; k < 38; ++k) { const unsigned w = base[k * 32]; i0[k] = bflo(w); i1[k] = bfhi(w); }
            float a0[8], a1[8];
            { const float b0 = wl[31 * 64 + 2 * cp], b1 = wl[31 * 64 + 2 * cp + 1];
#pragma unroll
              for (int i = 0; i < 8; ++i) { a0[i] = b0; a1[i] = b1; } }
#pragma unroll
            for (int j = 0; j < 31; ++j) { typedef float f32x2 __attribute__((ext_vector_type(2))); const f32x2 wj = *(const LAS f32x2*)(wl + j * 64 + 2 * cp); const float w0 = wj[0], w1 = wj[1];
#pragma unroll
                for (int i = 0; i < 8; ++i) { a0[i] += w0 * i0[i + j]; a1[i] += w1 * i1[i + j]; } }
#pragma unroll
            for (int i = 0; i < 8; ++i) { const int tok = tok0 + sq * sstride + (p0 + i) * pstride;
                *(unsigned*)(mix + (size_t)tok * 1024 + 512 + ch0 + 2 * cp) = cvt_pk_bf16(a0[i], a1[i]); }
        }
        __syncthreads();
    }
}
__device__ __forceinline__ void phase_c1_ln(CP p, int l, int bid, int nb) {
    const int tid = launder_tid(); const int lane = tid & 63, wave = tid >> 6;
    bf16_t* mix = (bf16_t*)(p->ws + WS_HX);
    const f32x4 g0 = *(const f32x4*)(p->conv_ln_g + l * 512 + lane * 8), g1 = *(const f32x4*)(p->conv_ln_g + l * 512 + lane * 8 + 4);
    const f32x4 b0 = *(const f32x4*)(p->conv_ln_b + l * 512 + lane * 8), b1 = *(const f32x4*)(p->conv_ln_b + l * 512 + lane * 8 + 4);
    const float gg[8] = {g0[0], g0[1], g0[2], g0[3], g1[0], g1[1], g1[2], g1[3]}, bb[8] = {b0[0], b0[1], b0[2], b0[3], b1[0], b1[1], b1[2], b1[3]};
    u32x4 vn = {0u, 0u, 0u, 0u};
    if (bid * 8 + wave < R) vn = *(const u32x4*)(mix + (size_t)(bid * 8 + wave) * 1024 + 512 + lane * 8);
    for (int r = bid * 8 + wave; r < R; r += nb * 8) {
        u32x4* ptr = (u32x4*)(mix + (size_t)r * 1024 + 512 + lane * 8);
        const u32x4 v = vn;
        if (r + nb * 8 < R) vn = *(const u32x4*)(mix + (size_t)(r + nb * 8) * 1024 + 512 + lane * 8);
        float y[8] = {bflo(v.x), bfhi(v.x), bflo(v.y), bfhi(v.y), bflo(v.z), bfhi(v.z), bflo(v.w), bfhi(v.w)};
        float s = 0.f;
#pragma unroll
        for (int e = 0; e < 8; ++e) s += y[e];
        const float mu = wave_sum(s) * (1.f / 512.f);
        float q = 0.f;
#pragma unroll
        for (int e = 0; e < 8; ++e) { y[e] -= mu; q += y[e] * y[e]; }
        const float rstd = rsqrtf(wave_sum(q) * (1.f / 512.f) + 1e-5f);
        float o[8];
#pragma unroll
        for (int e = 0; e < 8; ++e) o[e] = siluf_(y[e] * rstd * gg[e] + bb[e]);
        *ptr = pack8(o);
    }
}
__device__ __forceinline__ void phase_s1(CP p, int l, unsigned char* lds_, int bid, int nb) {
    LAS unsigned char* lds = (LAS unsigned char*)lds_;
    LAS unsigned char* Bs = lds;
    LAS unsigned char* Xs = lds + 128 * ST_TR128;
    LAS float* wv = (LAS float*)(Xs + 128 * ST_X256);
    LAS float* hvs = wv + 8 * 128;
    LAS float* cwl = hvs + 4 * 520;
    const int tid = launder_tid(); const int lane = tid & 63, wave = __builtin_amdgcn_readfirstlane(tid >> 6);
    const bf16_t* proj = (const bf16_t*)(p->ws + WS_PROJ);
    const float* cw = p->ssd_conv_w + (size_t)l * 5 * 1024; const float* cbias = p->ssd_conv_b + (size_t)l * 1024;
    bf16_t* Sg = (bf16_t*)(p->ws + WS_S); float* DEC = (float*)(p->ws + WS_DEC);
    int cur_g = -1;
#pragma unroll 1
    for (int u = bid; u < NB * NCHUNK * 2; u += nb) {
        const int g = u & 1, c = (u >> 1) % NCHUNK, b = (u >> 1) / NCHUNK;
        const int row0 = b * SEG + c * 128;
        const bool lo_ok = !(c == 0 || c == 2), hi_ok = !(c == 1 || c == NCHUNK - 1);
        if (g != cur_g) { cur_g = g;
            float tw[5];
#pragma unroll
            for (int it = 0; it < 5; ++it) { const int i = tid + NTHREADS * it; const int j = i / 384, lc = i - j * 384; const int gch = lc < 128 ? 512 + g * 128 + lc : g * 256 + (lc - 128);
                tw[it] = i < 6 * 384 ? (j < 5 ? cw[j * 1024 + gch] : cbias[gch]) : 0.f; }
#pragma unroll
            for (int it = 0; it < 5; ++it) { const int i = tid + NTHREADS * it; if (i < 6 * 384) cwl[i] = tw[it]; } }
        const int hh = wave >> 1, dir = wave & 1, h = 4 * g + hh;
        u32x4 rb[8], rx0[8], rx1[8];
        conv_load(proj, row0, tid >> 4, 512 + g * 128 + (tid & 15) * 8, lo_ok, hi_ok, rb);
        conv_load(proj, row0, tid >> 5, g * 256 + (tid & 31) * 8, lo_ok, hi_ok, rx0);
        conv_load(proj, row0, (tid >> 5) + 16, g * 256 + (tid & 31) * 8, lo_ok, hi_ok, rx1);
        head_cums(p, l, row0, h, dir, lane, hvs + hh * 520);
        __syncthreads();
        {
            const LAS float* hv = hvs + hh * 520; const float tot = hv[512 + dir];
#pragma unroll
            for (int q = 0; q < 2; ++q) { const int lr = lane + 64 * q; wv[wave * 128 + lr] = __expf(tot - hv[dir * 128 + lr]) * hv[256 + dir * 128 + lr]; }
            if (lane == 0) DEC[((size_t)(b * 2 + dir) * NCHUNK + c) * 8 + h] = __expf(tot);
        }
        { float o[4][8];
          conv_compute(rb, cwl, 384, (tid & 15) * 8, o);
#pragma unroll
          for (int i = 0; i < 4; ++i) *(LAS u32x4*)(Bs + (4 * (tid >> 4) + i) * ST_TR128 + (tid & 15) * 16) = pack8(o[i]);
          conv_compute(rx0, cwl, 384, 128 + (tid & 31) * 8, o);
#pragma unroll
          for (int i = 0; i < 4; ++i) *(LAS u32x4*)(Xs + (4 * (tid >> 5) + i) * ST_X256 + (tid & 31) * 16) = pack8(o[i]);
          conv_compute(rx1, cwl, 384, 128 + (tid & 31) * 8, o);
#pragma unroll
          for (int i = 0; i < 4; ++i) *(LAS u32x4*)(Xs + (4 * ((tid >> 5) + 16) + i) * ST_X256 + (tid & 31) * 16) = pack8(o[i]); }
        __syncthreads();
        {
            f32x16 acc[2][4];
#pragma unroll
            for (int t = 0; t < 2; ++t)
#pragma unroll
                for (int q = 0; q < 4; ++q)
#pragma unroll
                    for (int e = 0; e < 16; ++e) acc[t][q][e] = 0.f;
#pragma unroll 2
            for (int kk = 0; kk < 8; ++kk) {
                const LAS float* wp = wv + wave * 128 + 16 * kk + 8 * (lane >> 5);
                const f32x4 w0 = *(const LAS f32x4*)wp, w1 = *(const LAS f32x4*)(wp + 4);
                bf16x8 af[2];
#pragma unroll
                for (int t = 0; t < 2; ++t) af[t] = scale_frag(tr_frag(Xs, ST_X256, 16 * kk, hh * 64 + 32 * t, lane), w0, w1);
#pragma unroll
                for (int q = 0; q < 4; ++q) { const bf16x8 bf = tr_frag(Bs, ST_TR128, 16 * kk, 32 * q, lane);
#pragma unroll
                    for (int t = 0; t < 2; ++t) acc[t][q] = __builtin_amdgcn_mfma_f32_32x32x16_bf16(bf, af[t], acc[t][q], 0, 0, 0); }
            }
            bf16_t* So = Sg + ((size_t)((b * 2 + dir) * NCHUNK + c) * 8 + h) * 8192 + (size_t)(lane & 31) * 128 + 4 * (lane >> 5);
#pragma unroll
            for (int t = 0; t < 2; ++t)
#pragma unroll
                for (int q = 0; q < 4; ++q)
#pragma unroll
                    for (int rg = 0; rg < 4; ++rg) { u32x2 pk; pk.x = cvt_pk_bf16(acc[t][q][4 * rg], acc[t][q][4 * rg + 1]); pk.y = cvt_pk_bf16(acc[t][q][4 * rg + 2], acc[t][q][4 * rg + 3]);
                        *(u32x2*)(So + (size_t)(32 * t) * 128 + 32 * q + 8 * rg) = pk; }
        }
        __syncthreads();
    }
}
__device__ __forceinline__ void phase_s2(CP p, int bid, int nb) {
    const int tid = launder_tid();
    const bf16_t* Sg = (const bf16_t*)(p->ws + WS_S); const float* DEC = (const float*)(p->ws + WS_DEC); bf16_t* HP = (bf16_t*)(p->ws + WS_HP);
    for (int idx = bid * NTHREADS + tid; idx < 2 * 2 * 8 * 64 * 64; idx += nb * NTHREADS) {
        const int n2 = idx & 63, pr = (idx >> 6) & 63, h = (idx >> 12) & 7, dir = (idx >> 15) & 1, b = idx >> 16;
        const size_t inner = (size_t)h * 8192 + pr * 128 + 2 * n2;
        const size_t cbase = (size_t)(b * 2 + dir) * NCHUNK;
        float s0 = 0.f, s1 = 0.f;
#pragma unroll 26
        for (int step = 0; step < NCHUNK; ++step) {
            const int c = dir == 0 ? step : (step < 2 ? 1 - step : NCHUNK + 1 - step);
            const size_t off = (cbase + c) * 65536 + inner;
            const unsigned sv = *(const unsigned*)(Sg + off); const float d = DEC[(cbase + c) * 8 + h];
            *(unsigned*)(HP + off) = cvt_pk_bf16(s0, s1);
            s0 = s0 * d + bflo(sv); s1 = s1 * d + bfhi(sv);
        }
    }
}
__device__ __forceinline__ void phase_s3(CP p, int l, unsigned char* lds_, int bid, int nb) {
    LAS unsigned char* lds = (LAS unsigned char*)lds_;
    LAS unsigned char* Cs = lds;
    LAS unsigned char* Bs = Cs + 128 * ST_ROW;
    LAS unsigned char* Mt = Bs;
    LAS unsigned char* Xs = Bs + 128 * ST_MT;
    LAS unsigned char* Hf = Xs + 128 * ST_TR64;
    LAS unsigned char* Hb = Hf + 64 * ST_ROW;
    LAS float* hvs = (LAS float*)(Hb + 64 * ST_ROW);
    LAS float* ssqp = hvs + 4 * 776;
    LAS float* cwl = ssqp + 256;
    const int tid0 = launder_tid(); const int wave = __builtin_amdgcn_readfirstlane(tid0 >> 6);
    const bf16_t* proj = (const bf16_t*)(p->ws + WS_PROJ); bf16_t* mix = (bf16_t*)(p->ws + WS_HX);
    const float* cw = p->ssd_conv_w + (size_t)l * 5 * 1024; const float* cbias = p->ssd_conv_b + (size_t)l * 1024;
    const bf16_t* HP = (const bf16_t*)(p->ws + WS_HP); float* SSQ = (float*)(p->ws + WS_SSQ);
    int cur_g = -1;
    const int cskip = (l == DEPTH - 1) ? 2 : 0, cpb = NCHUNK - cskip;
    const int nunits = NB * cpb * 2, nfull = nunits - nunits % nb, nitems = nfull + (nunits - nfull) * 4;
#pragma unroll 1
    for (int it = bid; it < nitems; it += nb) {
        const int u = it < nfull ? it : nfull + ((it - nfull) >> 2);
        const int hh_lo = it < nfull ? 0 : ((it - nfull) & 3), hh_hi = it < nfull ? 4 : hh_lo + 1;
        const int g = u & 1, c = cskip + (u >> 1) % cpb, b = (u >> 1) / cpb;
        int tid = tid0; asm volatile("" : "+v"(tid));
        const int lane = tid & 63;
        const int row0 = b * SEG + c * 128;
        const bool lo_ok = !(c == 0 || c == 2), hi_ok = !(c == 1 || c == NCHUNK - 1);
        if (g != cur_g) { cur_g = g;
            float tw[6];
#pragma unroll
            for (int it = 0; it < 6; ++it) { const int i = tid + NTHREADS * it; const int j = i >> 9, lc = i & 511; const int gch = lc < 128 ? 768 + g * 128 + lc : (lc < 256 ? 512 + g * 128 + (lc - 128) : g * 256 + (lc - 256));
                tw[it] = j < 5 ? cw[j * 1024 + gch] : cbias[gch]; }
#pragma unroll
            for (int it = 0; it < 6; ++it) cwl[tid + NTHREADS * it] = tw[it]; }
        u32x4 rx[8];
        {
            u32x4 r0[8], r1[8];
            const int cg = tid & 31; const int gch = (cg < 16 ? 768 : 512) + g * 128 + (cg & 15) * 8;
            conv_load(proj, row0, tid >> 5, gch, lo_ok, hi_ok, r0);
            conv_load(proj, row0, (tid >> 5) + 16, gch, lo_ok, hi_ok, r1);
            head_cums(p, l, row0, 4 * g + (wave >> 1), wave & 1, lane, hvs + (wave >> 1) * 776);
            { LAS float* hvw = hvs + (wave >> 1) * 776; const int dr = wave & 1;
              hvw[520 + dr * 128 + 2 * lane] = __expf(hvw[dr * 128 + 2 * lane]); hvw[520 + dr * 128 + 2 * lane + 1] = __expf(hvw[dr * 128 + 2 * lane + 1]); }
            __syncthreads();
            float o[4][8];
            LAS unsigned char* dst = (cg < 16 ? Cs : Bs) + (cg & 15) * 16;
            conv_compute(r0, cwl, 512, cg * 8, o);
#pragma unroll
            for (int i = 0; i < 4; ++i) *(LAS u32x4*)(dst + (4 * (tid >> 5) + i) * ST_ROW) = pack8(o[i]);
            asm volatile("" ::: "memory");
            if (tid < 256) conv_load(proj, row0, tid >> 3, g * 256 + hh_lo * 64 + (tid & 7) * 8, lo_ok, hi_ok, rx);
            conv_compute(r1, cwl, 512, cg * 8, o);
#pragma unroll
            for (int i = 0; i < 4; ++i) *(LAS u32x4*)(dst + (4 * ((tid >> 5) + 16) + i) * ST_ROW) = pack8(o[i]);
            if (tid < 256) { conv_compute(rx, cwl, 512, 256 + hh_lo * 64 + (tid & 7) * 8, o);
#pragma unroll
                for (int i = 0; i < 4; ++i) *(LAS u32x4*)(Xs + (4 * (tid >> 3) + i) * ST_TR64 + (tid & 7) * 16) = pack8(o[i]); }
        }
        __syncthreads();
        const int lb = wave >> 1, hs = wave & 1;
        int ln = lane; asm volatile("" : "+v"(ln));
        f32x16 gacc[2];
#pragma unroll
        for (int t = 0; t < 2; ++t)
#pragma unroll
            for (int e = 0; e < 16; ++e) gacc[t][e] = 0.f;
#pragma unroll
        for (int kk = 0; kk < 8; ++kk) { const bf16x8 af = row_frag(Cs, ST_ROW, 32 * lb, 16 * kk, lane);
#pragma unroll
            for (int t = 0; t < 2; ++t) { const bf16x8 bf = row_frag(Bs, ST_ROW, 64 * hs + 32 * t, 16 * kk, lane);
                gacc[t] = __builtin_amdgcn_mfma_f32_32x32x16_bf16(af, bf, gacc[t], 0, 0, 0); } }
        u32x4 hreg[4];
        { const bf16_t* hp0 = HP + ((size_t)(b * 2 * NCHUNK + c) * 8 + 4 * g + hh_lo) * 8192;
#pragma unroll
          for (int q = 0; q < 4; ++q) { const int it = tid + 512 * q; hreg[q] = *(const u32x4*)(hp0 + (size_t)(it >> 10) * NCHUNK * 8 * 8192 + (it & 1023) * 8); } }
        __syncthreads();
#pragma unroll 1
        for (int hh = hh_lo; hh < hh_hi; ++hh) {
            const int h = 4 * g + hh; const LAS float* hv = hvs + hh * 776;
            asm volatile("" : "+v"(ln));
            const int ph = hs, pc = 32 * ph + (ln & 31);
#pragma unroll
            for (int t = 0; t < 2; ++t) {
                const int st = 2 * hs + t;
                const int sc = 32 * st + (ln & 31);
                const float cfs = hv[sc], cbs = hv[128 + sc], dfs = hv[256 + sc], dbs = hv[384 + sc];
#pragma unroll
                for (int rg = 0; rg < 4; ++rg) {
                    const int l0 = 32 * lb + 8 * rg + 4 * (ln >> 5);
                    float m[4];
                    if (st < lb) {
                        const f32x4 cfl = *(const LAS f32x4*)(hv + l0);
#pragma unroll
                        for (int e = 0; e < 4; ++e) m[e] = gacc[t][4 * rg + e] * (__expf(cfl[e] - cfs) * dfs);
                    } else if (st > lb) {
                        const f32x4 cbl = *(const LAS f32x4*)(hv + 128 + l0);
#pragma unroll
                        for (int e = 0; e < 4; ++e) m[e] = gacc[t][4 * rg + e] * (__expf(cbl[e] - cbs) * dbs);
                    } else {
                        const f32x4 cfl = *(const LAS f32x4*)(hv + l0), cbl = *(const LAS f32x4*)(hv + 128 + l0);
#pragma unroll
                        for (int e = 0; e < 4; ++e) { const int lr = l0 + e;
                            const float ff = lr >= sc ? __expf(cfl[e] - cfs) * dfs : 0.f;
                            const float fb = lr <= sc ? __expf(cbl[e] - cbs) * dbs : 0.f;
                            m[e] = gacc[t][4 * rg + e] * (ff + fb); }
                    }
                    u32x2 pk; pk.x = cvt_pk_bf16(m[0], m[1]); pk.y = cvt_pk_bf16(m[2], m[3]);
                    *(LAS u32x2*)(Mt + sc * ST_MT + l0 * 2) = pk;
                }
            }
#pragma unroll
            for (int q = 0; q < 4; ++q) { const int it = tid + 512 * q; const int q2 = it & 1023;
                *(LAS u32x4*)(((it >> 10) ? Hb : Hf) + (q2 >> 4) * ST_ROW + (q2 & 15) * 16) = hreg[q]; }
            if (hh + 1 < hh_hi) {
                const bf16_t* hp0 = HP + ((size_t)(b * 2 * NCHUNK + c) * 8 + h + 1) * 8192;
#pragma unroll
                for (int q = 0; q < 4; ++q) { const int it = tid + 512 * q; hreg[q] = *(const u32x4*)(hp0 + (size_t)(it >> 10) * NCHUNK * 8 * 8192 + (it & 1023) * 8); }
                if (tid < 256) conv_load(proj, row0, tid >> 3, g * 256 + (hh + 1) * 64 + (tid & 7) * 8, lo_ok, hi_ok, rx);
            }
            unsigned zraw[8];
#pragma unroll
            for (int ri = 0; ri < 16; ri += 2) { const int lr = 32 * lb + 8 * (ri >> 2) + 4 * (ln >> 5) + (ri & 3);
                const bf16_t* zp = proj + (size_t)(row0 + lr) * NPROJ + 1024 + h * 64 + pc;
                zraw[ri >> 1] = (unsigned)zp[0] | ((unsigned)zp[NPROJ] << 16); }
            __syncthreads();
            f32x16 ad, af_, ab_;
#pragma unroll
            for (int e = 0; e < 16; ++e) { ad[e] = 0.f; af_[e] = 0.f; ab_[e] = 0.f; }
#pragma unroll
            for (int kk = 0; kk < 8; ++kk) {
                const bf16x8 am = tr_frag(Mt, ST_MT, 16 * kk, 32 * lb, lane);
                const bf16x8 bx = tr_frag(Xs, ST_TR64, 16 * kk, 32 * ph, lane);
                ad = __builtin_amdgcn_mfma_f32_32x32x16_bf16(am, bx, ad, 0, 0, 0);
                const bf16x8 ac = row_frag(Cs, ST_ROW, 32 * lb, 16 * kk, lane);
                const bf16x8 bhf = row_frag(Hf, ST_ROW, 32 * ph, 16 * kk, lane);
                const bf16x8 bhb = row_frag(Hb, ST_ROW, 32 * ph, 16 * kk, lane);
                af_ = __builtin_amdgcn_mfma_f32_32x32x16_bf16(ac, bhf, af_, 0, 0, 0);
                ab_ = __builtin_amdgcn_mfma_f32_32x32x16_bf16(ac, bhb, ab_, 0, 0, 0);
            }
            const float dsk = p->d_skip[l * 8 + h];
#pragma unroll
            for (int rg = 0; rg < 4; ++rg) {
                const int l0 = 32 * lb + 8 * rg + 4 * (ln >> 5);
                const f32x4 efl = *(const LAS f32x4*)(hv + 520 + l0), ebl = *(const LAS f32x4*)(hv + 648 + l0);
#pragma unroll
                for (int e = 0; e < 4; ++e) { const int lr = l0 + e; const int ri = 4 * rg + e;
                    const float xs = bf2f(*(const LAS bf16_t*)(Xs + lr * ST_TR64 + pc * 2));
                    const float y = ad[ri] + efl[e] * af_[ri] + ebl[e] * ab_[ri] + dsk * xs;
                    const float z = (ri & 1) ? bfhi(zraw[ri >> 1]) : bflo(zraw[ri >> 1]);
                    const float val = y * siluf_(z);
                    mix[(size_t)(row0 + lr) * 1024 + h * 64 + pc] = f2bf(val);
                    const float sq = half_sum32(val * val);
                    if ((ln & 31) == 31) ssqp[ph * 128 + lr] = sq;
                }
            }
            __syncthreads();
            if (tid < 128) SSQ[(size_t)(row0 + tid) * 8 + h] = ssqp[tid] + ssqp[128 + tid];
            if (hh + 1 < hh_hi && tid < 256) { float o[4][8];
                conv_compute(rx, cwl, 512, 256 + (hh + 1) * 64 + (tid & 7) * 8, o);
#pragma unroll
                for (int i = 0; i < 4; ++i) *(LAS u32x4*)(Xs + (4 * (tid >> 3) + i) * ST_TR64 + (tid & 7) * 16) = pack8(o[i]); }
        }
        __syncthreads();
    }
}
__device__ __forceinline__ void phase_r2(CP p, int l, unsigned char* lds_, int bid, int nb) {
    LAS unsigned char* lds = (LAS unsigned char*)lds_;
    LAS unsigned char* Wh = lds;
    LAS unsigned char* Xh = Wh + 32 * ST_H16;
    LAS float* gm = (LAS float*)(Xh + 16 * ST_H16);
    LAS float* sh = gm + 3 * 1024;
    LAS float* part = sh + 3 * 1024;
    LAS float* lgs = part + 8 * 16 * 32;
    LAS int* lcnt = (LAS int*)(lgs + 16 * 32);
    LAS int* lcls = lcnt + 64;
    LAS int* lrank = lcls + 512;
    LAS float* lcwa = (LAS float*)(lrank + 512);
    LAS float* lcwb = lcwa + 512;
    const int tid = launder_tid(); const int lane = tid & 63, wave = __builtin_amdgcn_readfirstlane(tid >> 6);
    const float* mod = (const float*)(p->ws + WS_MOD) + (size_t)l * 3 * 6144;
    {
        float tmp[8];
#pragma unroll
        for (int it = 0; it < 8; ++it) tmp[it] = p->w_rg[(size_t)l * 4096 + tid + NTHREADS * it];
#pragma unroll
        for (int it = 0; it < 8; ++it) { const int idx = tid + NTHREADS * it; *(LAS _Float16*)(Wh + (idx & 3) * ST_H16 + (idx >> 2) * 2) = (_Float16)tmp[it]; } }
#pragma unroll
    for (int hb = 0; hb < 2; ++hb) { float tmp[16];
#pragma unroll
        for (int it = 0; it < 16; ++it) tmp[it] = p->w_re[(size_t)l * 16384 + tid + NTHREADS * (16 * hb + it)];
#pragma unroll
        for (int it = 0; it < 16; ++it) { const int idx = tid + NTHREADS * (16 * hb + it); *(LAS _Float16*)(Wh + (4 + (idx & 15)) * ST_H16 + (idx >> 4) * 2) = (_Float16)tmp[it]; } }
    { unsigned zz; asm volatile("v_mov_b32 %0, 0" : "=v"(zz));
      for (int i = tid; i < 12 * 128; i += NTHREADS) { const int rw = 20 + i / 128, c16 = i % 128; *(LAS u32x4*)(Wh + rw * ST_H16 + c16 * 16) = (u32x4){zz, zz, zz, zz}; } }
    { float t0[6], t1[6], t2[6];
#pragma unroll
      for (int it = 0; it < 6; ++it) { const int idx = tid + NTHREADS * it; const int v = idx >> 10, k = idx & 1023; t0[it] = p->g_ffn[l * 1024 + k]; t1[it] = mod[v * 6144 + 4 * 1024 + k]; t2[it] = mod[v * 6144 + 3 * 1024 + k]; }
#pragma unroll
      for (int it = 0; it < 6; ++it) { const int idx = tid + NTHREADS * it; gm[idx] = t0[it] * (1.f + t1[it]); sh[idx] = t2[it]; } }
    if (tid < 64) lcnt[tid] = 0;
    __syncthreads();
    bf16_t* HM = (bf16_t*)(p->ws + WS_HX); float* CWLA = (float*)(p->ws + WS_CWLA); float* CWLB = (float*)(p->ws + WS_CWLB);
    int* gcount = (int*)(p->ws + WS_CTL) + l * 32; int* LIST = (int*)(p->ws + WS_LIST);
    const int rpb = (R + nb - 1) / nb, r0 = bid * rpb, r1 = (r0 + rpb) < R ? (r0 + rpb) : R;
    RowRaw xn[2];
#pragma unroll
    for (int q = 0; q < 2; ++q) if (r0 + 2 * wave + q < r1) row_load(p, 1, r0 + 2 * wave + q, lane, xn[q]);
#pragma unroll 1
    for (int t0r = r0; t0r < r1; t0r += 16) {
        f32x4 xv[2][4];
#pragma unroll
        for (int q = 0; q < 2; ++q) row_cvt(1, xn[q], xv[q]);
#pragma unroll
        for (int q = 0; q < 2; ++q) if (t0r + 16 + 2 * wave + q < r1) row_load(p, 1, t0r + 16 + 2 * wave + q, lane, xn[q]);
#pragma unroll
        for (int q = 0; q < 2; ++q) { const int rr = t0r + 2 * wave + q; const bool ok = rr < r1; const int v = row_v(ok ? rr : r0);
            float ss = 0.f;
#pragma unroll
            for (int j = 0; j < 4; ++j) ss += xv[q][j][0] * xv[q][j][0] + xv[q][j][1] * xv[q][j][1] + xv[q][j][2] * xv[q][j][2] + xv[q][j][3] * xv[q][j][3];
            ss = wave_sum(ss); const float rs = ok ? rsqrtf(ss * (1.f / 1024.f) + 1e-6f) : 0.f;
#pragma unroll
            for (int j = 0; j < 4; ++j) { const int k = 4 * lane + 256 * j; const f32x4 g4 = *(const LAS f32x4*)(gm + v * 1024 + k), s4 = *(const LAS f32x4*)(sh + v * 1024 + k);
                f32x4 hv = xv[q][j] * rs * g4 + s4; if (!ok) hv = hv * 0.f;
                u32x2 o; o.x = cvt_pk_bf16(hv[0], hv[1]); o.y = cvt_pk_bf16(hv[2], hv[3]);
                if (ok) *(u32x2*)(HM + (size_t)rr * 1024 + k) = o;
                u32x2 h16; h16.x = pack_f16(hv[0], hv[1]); h16.y = pack_f16(hv[2], hv[3]);
                *(LAS u32x2*)(Xh + (2 * wave + q) * ST_H16 + k * 2) = h16; } }
        __syncthreads();
        {
            f32x4 acc0 = {0.f, 0.f, 0.f, 0.f}, acc1 = {0.f, 0.f, 0.f, 0.f};
#pragma unroll
            for (int s4 = 0; s4 < 4; ++s4) { const int kb = (128 * wave + 32 * s4 + 8 * (lane >> 4)) * 2;
                const f16x8 a = *(const LAS f16x8*)(Xh + (lane & 15) * ST_H16 + kb);
                const f16x8 b0 = *(const LAS f16x8*)(Wh + (lane & 15) * ST_H16 + kb), b1 = *(const LAS f16x8*)(Wh + (16 + (lane & 15)) * ST_H16 + kb);
                acc0 = __builtin_amdgcn_mfma_f32_16x16x32_f16(a, b0, acc0, 0, 0, 0);
                acc1 = __builtin_amdgcn_mfma_f32_16x16x32_f16(a, b1, acc1, 0, 0, 0); }
#pragma unroll
            for (int e = 0; e < 4; ++e) { const int row = 4 * (lane >> 4) + e; part[(wave * 16 + row) * 32 + (lane & 15)] = acc0[e]; part[(wave * 16 + row) * 32 + 16 + (lane & 15)] = acc1[e]; }
        }
        __syncthreads();
        if (tid < 320) { const int row = tid / 20, n = tid - row * 20; float sacc = n < 4 ? p->b_rg[l * 4 + n] : p->b_re[l * 16 + n - 4];
#pragma unroll
            for (int w = 0; w < 8; ++w) sacc += part[(w * 16 + row) * 32 + n];
            lgs[row * 32 + n] = sacc; }
        __syncthreads();
        if (tid < 16) { const int rr = t0r + tid;
            if (rr < r1) {
                if (l == DEPTH - 1 && row_v(rr) == 2) lcls[rr - r0] = -1;
                else {
                    float lg[20];
#pragma unroll
                    for (int n = 0; n < 20; ++n) lg[n] = lgs[tid * 32 + n];
                    int gsel = 0; float gmax = lg[0];
#pragma unroll
                    for (int t = 1; t < 4; ++t) if (lg[t] > gmax) { gmax = lg[t]; gsel = t; }
                    float gden = 0.f;
#pragma unroll
                    for (int t = 0; t < 4; ++t) gden += __expf(lg[t] - gmax);
                    const float gprob = 1.f / gden;
                    float el[4];
#pragma unroll
                    for (int t = 0; t < 4; ++t) el[t] = gsel == 0 ? lg[4 + t] : (gsel == 1 ? lg[8 + t] : (gsel == 2 ? lg[12 + t] : lg[16 + t]));
                    int i0 = 0; float m0 = el[0];
#pragma unroll
                    for (int t = 1; t < 4; ++t) if (el[t] > m0) { m0 = el[t]; i0 = t; }
                    int i1 = -1; float m1 = -3.0e38f;
#pragma unroll
                    for (int t = 0; t < 4; ++t) if (t != i0 && el[t] > m1) { m1 = el[t]; i1 = t; }
                    const float w0 = gprob / (1.f + __expf(m1 - m0)), w1 = gprob - w0;
                    const int ea = i0 < i1 ? i0 : i1, eb = i0 < i1 ? i1 : i0;
                    const float cwa = i0 < i1 ? w0 : w1, cwb = i0 < i1 ? w1 : w0;
                    const int pidx = ea == 0 ? eb - 1 : (ea == 1 ? eb + 1 : 5);
                    const int cls = gsel * 6 + pidx;
                    const int rank = __hip_atomic_fetch_add(&lcnt[cls], 1, __ATOMIC_RELAXED, __HIP_MEMORY_SCOPE_WORKGROUP);
                    lcls[rr - r0] = cls; lrank[rr - r0] = rank; lcwa[rr - r0] = cwa; lcwb[rr - r0] = cwb;
                } } }
    }
    __syncthreads();
    if (tid < NCLS) lcnt[32 + tid] = atomicAdd(&gcount[tid], lcnt[tid]);
    __syncthreads();
    for (int idx = tid; idx < r1 - r0; idx += NTHREADS) { const int cl = lcls[idx]; if (cl < 0) continue; const int pos = lcnt[32 + cl] + lrank[idx]; const size_t li = (size_t)cl * R + pos;
        LIST[li] = r0 + idx; CWLA[li] = lcwa[idx]; CWLB[li] = lcwb[idx]; }
    __syncthreads();
}
__device__ __forceinline__ void phase_final(CP p, unsigned char* lds, int bid, int nb) {
    const int tid = launder_tid(); const int lane = tid & 63, wave = tid >> 6;
    const int qstep = nb * 8;
    RowRaw xn;
    { const int q = bid * 8 + wave; if (q < NB * SEQ) { const int b = q >= SEQ ? 1 : 0; row_load(p, 1, b * SEG + CTXL + (q - b * SEQ), lane, xn); } }
    for (int q = bid * 8 + wave; q < NB * SEQ; q += qstep) {
        f32x4* hr = (f32x4*)(p->out + (size_t)q * D);
        f32x4 xv[4]; float ss = 0.f;
        row_cvt(1, xn, xv);
        { const int qn = q + qstep; if (qn < NB * SEQ) { const int bn = qn >= SEQ ? 1 : 0; row_load(p, 1, bn * SEG + CTXL + (qn - bn * SEQ), lane, xn); } }
#pragma unroll
        for (int j = 0; j < 4; ++j) ss += xv[j][0] * xv[j][0] + xv[j][1] * xv[j][1] + xv[j][2] * xv[j][2] + xv[j][3] * xv[j][3];
        ss = wave_sum(ss); const float rs = rsqrtf(ss * (1.f / 1024.f) + 1e-6f);
#pragma unroll
        for (int j = 0; j < 4; ++j) { const f32x4 g4 = *(const f32x4*)(p->g_final + 4 * lane + 256 * j); hr[lane + 64 * j] = xv[j] * rs * g4; }
    }
}


#define XB_TMO      128
#define XB_XCNT(j)  (256  + 64 * (j))
#define XB_XSUB(j)  (1280 + 64 * (j))
#define XB_XGEN(j)  (2304 + 64 * (j))
#define XB_TOP      3328
#define XB_TOPGEN   3392
#define XCD_BAR_WORDS 3456
#define XB_SPIN_CAP (1u << 22)
__device__ __forceinline__ unsigned xb_ld(unsigned* p) { return __hip_atomic_load(p, __ATOMIC_RELAXED, __HIP_MEMORY_SCOPE_AGENT); }
__device__ __forceinline__ unsigned xb_add(unsigned* p, unsigned v) { return __hip_atomic_fetch_add(p, v, __ATOMIC_RELAXED, __HIP_MEMORY_SCOPE_AGENT); }
__device__ __forceinline__ unsigned xb_xcc_id() { return (unsigned)__builtin_amdgcn_s_getreg((3 << 11) | 20) & 0xFu; }
#define XB_SPIN(cond, bar) do { unsigned _sp = 0; while (cond) { __builtin_amdgcn_s_sleep(1); \
    if ((++_sp & 255u) == 0u) { if (xb_ld(&(bar)[XB_TMO])) break; if (_sp > XB_SPIN_CAP) { atomicAdd(&(bar)[XB_TMO], 1u); break; } } } } while (0)
struct XcdBarrier { unsigned* bar; unsigned x; volatile LAS unsigned* st; };
__device__ __forceinline__ XcdBarrier xcd_barrier_post(unsigned* bar, volatile LAS unsigned* st) {
    XcdBarrier b; b.bar = bar; b.x = xb_xcc_id(); b.st = st;
    if (threadIdx.x == 0) (void)xb_add(&bar[XB_XCNT(b.x)], 1u);
    return b;
}
__device__ __forceinline__ void xcd_barrier_complete(unsigned* bar, unsigned x, unsigned& nloc, unsigned& nx) {
    const unsigned G = gridDim.x * gridDim.y * gridDim.z;
    unsigned sum, cnt, mine, sp = 0u;
    for (;;) {
        sum = 0u; cnt = 0u; mine = 0u;
#pragma unroll
        for (unsigned j = 0; j < 16; ++j) { const unsigned c = xb_ld(&bar[XB_XCNT(j)]); sum += c; cnt += (c > 0u) ? 1u : 0u; mine = (j == x) ? c : mine; }
        if (sum == G) break;
        __builtin_amdgcn_s_sleep(1);
        if ((++sp & 255u) == 0u) { if (xb_ld(&bar[XB_TMO])) break; if (sp > XB_SPIN_CAP) { atomicAdd(&bar[XB_TMO], 1u); break; } }
    }
    nloc = mine > 0u ? mine : 1u; nx = cnt > 0u ? cnt : 1u;
}
__device__ __forceinline__ void xcd_barrier(const XcdBarrier& b) {
    asm volatile("s_waitcnt vmcnt(0)" ::: "memory");
    __syncthreads();
    if (threadIdx.x == 0) {
        unsigned* bar = b.bar;
        __builtin_amdgcn_s_waitcnt(0);
        unsigned nloc = b.st[0], nx = b.st[1];
        if (nloc == 0u) { xcd_barrier_complete(bar, b.x, nloc, nx); b.st[0] = nloc; b.st[1] = nx; }
        const unsigned old = xb_add(&bar[XB_XSUB(b.x)], 1u);
        const unsigned gen = old / nloc;
        if (old + 1u == (gen + 1u) * nloc) {
            __builtin_amdgcn_fence(__ATOMIC_RELEASE, "agent");
            asm volatile("s_waitcnt vmcnt(0)" ::: "memory");
            const unsigned og = xb_add(&bar[XB_TOP], 1u);
            const unsigned tg = og / nx;
            if (og + 1u == (tg + 1u) * nx) xb_add(&bar[XB_TOPGEN], 1u);
            else XB_SPIN(xb_ld(&bar[XB_TOPGEN]) == tg, bar);
            __builtin_amdgcn_fence(__ATOMIC_ACQUIRE, "agent");
            xb_add(&bar[XB_XGEN(b.x)], 1u);
            asm volatile("s_waitcnt vmcnt(0)" ::: "memory");
        } else {
            XB_SPIN(xb_ld(&bar[XB_XGEN(b.x)]) == gen, bar);
            __builtin_amdgcn_fence(__ATOMIC_ACQUIRE, "agent");
            asm volatile("s_waitcnt vmcnt(0)" ::: "memory");
        }
    }
    __syncthreads();
}

#ifndef TIMING_A
#define TIMING_A -1
#endif
#ifndef TIMING_B
#define TIMING_B -1
#endif
#ifndef PHASE_MASK
#define PHASE_MASK 0xFFFFF
#endif
#define PM(i) ((PHASE_MASK >> (i)) & 1)
#ifndef REPEAT_MASK
#define REPEAT_MASK 0
#endif
#define RP(i) for (int rep_ = 0; rep_ < 1 + ((REPEAT_MASK >> (i)) & 1); ++rep_)
constexpr int PH_PER_LAYER = 9, NPHASES = 1 + DEPTH * PH_PER_LAYER + 1;
__global__ void __launch_bounds__(NTHREADS, 2) mk_fwd(Args args) {
    extern __shared__ __attribute__((aligned(16))) unsigned char lds[];
    cg::grid_group grid = cg::this_grid();
    const __attribute__((address_space(4))) Args* ap = (const __attribute__((address_space(4))) Args*)__builtin_amdgcn_kernarg_segment_ptr();
    const int lo = ap->lo, hi = ap->hi;
    LAS unsigned char* ldsl = (LAS unsigned char*)lds;
    volatile LAS unsigned* xbst = (volatile LAS unsigned*)(ldsl + LDS_BYTES - 16);
    if (threadIdx.x < 4) xbst[threadIdx.x] = 0u;
    __syncthreads();
    (void)xcd_barrier_post((unsigned*)(ap->p.ws + WS_BAR), xbst);
    if (TIMING_A >= 0 && blockIdx.x == 0 && threadIdx.x == 0) ((unsigned long long*)(ap->p.ws + WS_TS))[lo] = __builtin_amdgcn_s_memrealtime();
    for (int ph = lo; ph < hi; ++ph) {
        CP p = launder(&ap->p);
        int bid = blockIdx.x, nb = gridDim.x; asm volatile("" : "+s"(bid), "+s"(nb));
        if (ph == 0) { if (PM(0)) RP(0) phase_wprep(p, lds, 0, WPREP_ITEMS_PER_LAYER, bid, nb); if (PM(1)) RP(1) phase_adaln(p, lds, bid, nb); }
        else if (ph == NPHASES - 1) { if (PM(12)) phase_final(p, lds, bid, nb); }
        else {
            const int l = (ph - 1) / PH_PER_LAYER, s = (ph - 1) % PH_PER_LAYER;
            if (s == 0) { if (PM(2)) RP(2) { if (rep_ == 0 || l == 0) phase_r1(p, l, lds, bid, nb); } }
            else if (s == 1) { if (PM(3)) RP(3) {
                pg8::DenseSched S; S.init(p->ws + WS_HX, (const bf16_t*)(p->ws + WS_WTIN) + (size_t)l * DIN * 1024, R, NPROJ, 1024, 1024, 1024, nb, bid);
                EpiProj E{(bf16_t*)(p->ws + WS_PROJ)};
                pg8::gemm_phase<EpiProj, pg8::DenseSched, false>(ldsl, 1024, 1024, 1024, S, E);
                if (l == 0 && DEPTH > 1) { const int extra = S.nwg % nb;
                    if (extra > 0 && bid >= extra) phase_wprep(p, lds, WPREP_ITEMS_PER_LAYER, WPREP_ITEMS_PER_LAYER + 1800, bid - extra, nb - extra);
                    else if (extra == 0) phase_wprep(p, lds, WPREP_ITEMS_PER_LAYER, WPREP_ITEMS_PER_LAYER + 1800, bid, nb); }
            } }
            else if (s == 2) { if (PM(4)) RP(4) phase_c1(p, l, lds, bid, nb); if (PM(5)) RP(5) phase_s1(p, l, lds, bid, nb); }
            else if (s == 3) { if (PM(6)) RP(6) phase_s2(p, bid, nb); }
            else if (s == 4) { if (PM(7)) RP(7) phase_s3(p, l, lds, bid, nb);
                if (PM(4)) {
                    const int cpb = NCHUNK - ((l == DEPTH - 1) ? 2 : 0), nunits = NB * cpb * 2, tail = (nunits % nb) * 4;
                    if (tail > 0 && tail < nb) { if (bid >= tail) phase_c1_ln(p, l, bid - tail, nb - tail); } else phase_c1_ln(p, l, bid, nb); } }
            else if (s == 5) { if (PM(8)) RP(8) { if (rep_ == 0 || l == 0) {
                pg8::DenseSched S; S.init(p->ws + WS_HX, (const bf16_t*)(p->ws + WS_WTOUT) + (size_t)l * 1024 * 1024, R, 1024, 1024, 1024, 1024, nb, bid, l == DEPTH - 1);
                EpiResid<0> E{p->ctx, p->x, (bf16_t*)(p->ws + WS_H), (const float*)(p->ws + WS_MOD) + (size_t)l * 3 * 6144, (const float*)(p->ws + WS_SSQ)};
                pg8::gemm_phase<EpiResid<0>, pg8::DenseSched, false>(ldsl, 1024, 1024, 1024, S, E);
                if (l == 0 && DEPTH > 1 && rep_ == 0) { const int extra = S.nwg % nb;
                    if (extra > 0 && bid >= extra) phase_wprep(p, lds, WPREP_ITEMS_PER_LAYER + 1800, 2 * WPREP_ITEMS_PER_LAYER, bid - extra, nb - extra);
                    else if (extra == 0) phase_wprep(p, lds, WPREP_ITEMS_PER_LAYER + 1800, 2 * WPREP_ITEMS_PER_LAYER, bid, nb); }
            } } }
            else if (s == 6) { if (PM(9)) phase_r2(p, l, lds, bid, nb); }
            else if (s == 7) { if (PM(10)) {
                LAS int* tab = (LAS int*)(ldsl + MISC_OFF); moe_table(p, l, tab);
                unsigned* ready = (unsigned*)(p->ws + WS_M1CNT) + l * 192;
                { MoeSched S{tab, (const int*)(p->ws + WS_LIST), (const char*)(p->ws + WS_HX), (const char*)(p->ws + WS_WTGU), 0, l, nb, bid, ready, 0};
                  EpiUp E{(bf16_t*)(p->ws + WS_HID), (const float*)(p->ws + WS_CWLA), (const float*)(p->ws + WS_CWLB), ready};
                  pg8::gemm_phase<EpiUp, MoeSched, true>(ldsl, 1024, 1024, 1024, S, E); }
                { const int total = __builtin_amdgcn_readfirstlane(tab[24]) * 4; const int extra = __builtin_amdgcn_readfirstlane(total % nb);
                  MoeSched S{tab, (const int*)(p->ws + WS_LIST), (const char*)(p->ws + WS_HID), (const char*)(p->ws + WS_WTD), 1, l, nb, bid, ready, (total >= nb && total - extra >= nb) ? extra : 0};
                  EpiDown E{(bf16_t*)(p->ws + WS_H), (const int*)(p->ws + WS_LIST), (const float*)(p->ws + WS_MOD) + (size_t)l * 3 * 6144 + 5 * 1024};
                  pg8::gemm_phase<EpiDown, MoeSched, false>(ldsl, 512, 256, 512, S, E); }
            } }
            else { }
        }
        if (ph + 1 < hi && !(ph > 0 && ph < NPHASES - 1 && (ph - 1) % PH_PER_LAYER == 7)) { if (hi < 0) grid.sync();   else { XcdBarrier xb; xb.bar = (unsigned*)(launder(&ap->p)->ws + WS_BAR); xb.x = xb_xcc_id(); xb.st = (volatile LAS unsigned*)(ldsl + LDS_BYTES - 16); xcd_barrier(xb); }
            if (TIMING_A >= 0 && blockIdx.x == 0 && threadIdx.x == 0) ((unsigned long long*)(launder(&ap->p)->ws + WS_TS))[ph + 1] = __builtin_amdgcn_s_memrealtime(); }
    }
#if TIMING_A >= 0
    {
        XcdBarrier xb; xb.bar = (unsigned*)(launder(&ap->p)->ws + WS_BAR); xb.x = xb_xcc_id(); xb.st = (volatile LAS unsigned*)(ldsl + LDS_BYTES - 16); xcd_barrier(xb);
        if (blockIdx.x == 0 && threadIdx.x == 0) ((unsigned long long*)(launder(&ap->p)->ws + WS_TS))[hi] = __builtin_amdgcn_s_memrealtime();
        xcd_barrier(xb);
        const unsigned long long* ts = (const unsigned long long*)(launder(&ap->p)->ws + WS_TS);
        const float ta = (float)(ts[TIMING_A + 1] - ts[TIMING_A]) * 0.01f, tb = (float)(ts[TIMING_B + 1] - ts[TIMING_B]) * 0.01f;
        float* o = launder(&ap->p)->out; const float sc = 1.f + ta * 0.001f;
        for (size_t i = (size_t)blockIdx.x * NTHREADS + threadIdx.x; i < (size_t)NB * SEQ * D; i += (size_t)gridDim.x * NTHREADS) o[i] = o[i] * sc + (i == 0 ? tb * 0.1f : 0.f);
    }
#endif
}

extern "C" void kernel_launch(void* const* d_in, const int* in_sizes, int n_in, void* d_out, int out_size, void* d_ws, size_t ws_size, hipStream_t stream) {
    static int grid = 0;
    if (grid == 0) {
        if (n_in != 28 || ws_size < WS_END) { fprintf(stderr, "kernel_launch: unexpected n_in %d or ws_size %zu (< %zu)\n", n_in, ws_size, (size_t)WS_END); grid = -1; return; }
        int dev = 0, cus = 0, per_cu = 0;
        hipGetDevice(&dev); hipDeviceGetAttribute(&cus, hipDeviceAttributeMultiprocessorCount, dev);
        if (hipFuncSetAttribute((const void*)mk_fwd, hipFuncAttributeMaxDynamicSharedMemorySize, LDS_BYTES) != hipSuccess) { fprintf(stderr, "kernel_launch: hipFuncSetAttribute failed\n"); grid = -1; return; }
        if (hipOccupancyMaxActiveBlocksPerMultiprocessor(&per_cu, (const void*)mk_fwd, NTHREADS, LDS_BYTES) != hipSuccess || per_cu < 1) { fprintf(stderr, "kernel_launch: occupancy query says %d\n", per_cu); (void)hipGetLastError(); grid = -1; return; }
        grid = cus;
    }
    if (grid < 0) return;
    (void)hipMemsetAsync((char*)d_ws + WS_CTL, 0, WS_CTL_BYTES, stream);
    Args a{};
    const float** pp = (const float**)&a.p;
    for (int i = 0; i < 28; ++i) pp[i] = (const float*)d_in[i];
    a.p.out = (float*)d_out; a.p.ws = (unsigned char*)d_ws;
#if PER_PHASE_LAUNCH
    for (int ph = 0; ph < NPHASES; ++ph) {
        a.lo = ph; a.hi = ph + 1; void* kargs[] = {&a};
        hipError_t e = hipLaunchCooperativeKernel((const void*)mk_fwd, dim3(grid), dim3(NTHREADS), kargs, LDS_BYTES, stream);
        if (e != hipSuccess) { fprintf(stderr, "kernel_launch: launch of phase %d failed: %s\n", ph, hipGetErrorString(e)); break; }
    }
#else
    a.lo = 0; a.hi = NPHASES; void* kargs[] = {&a};
    hipError_t e = hipLaunchCooperativeKernel((const void*)mk_fwd, dim3(grid), dim3(NTHREADS), kargs, LDS_BYTES, stream);
    if (e != hipSuccess) fprintf(stderr, "kernel_launch: cooperative launch failed: %s (grid %d)\n", hipGetErrorString(e), grid);
#endif
}
```

```cpp
#include <hip/hip_runtime.h>
#include <hip/hip_cooperative_groups.h>
#include <cstdio>
namespace cg = cooperative_groups;

#ifndef PER_PHASE_LAUNCH
#define PER_PHASE_LAUNCH 0
#endif

#ifndef S3REP
#define S3REP 0
#endif
#define S3R(i) for (int r3_ = 0; r3_ < 1 + ((S3REP >> (i)) & 1); ++r3_)
#define LAS __attribute__((address_space(3)))
typedef unsigned short bf16_t;
typedef short bf16x8 __attribute__((ext_vector_type(8)));
typedef float f32x4 __attribute__((ext_vector_type(4)));
typedef unsigned u32x4 __attribute__((ext_vector_type(4)));
typedef unsigned u32x2 __attribute__((ext_vector_type(2)));

constexpr int D = 1024, NB = 2, SEQ = 16384, CTXL = 256, SEG = SEQ + CTXL, R = NB * SEG, DEPTH = 2;
constexpr int NPROJ = 2560, DIN = 2576;
constexpr int NTHREADS = 512;
constexpr int LDS_BYTES = 163840;
constexpr int MISC_OFF = 131072;
constexpr int NCLS = 24;

constexpr size_t al256(size_t x) { return (x + 255) & ~size_t(255); }
constexpr size_t WS_CTL = 0;
constexpr size_t WS_M1CNT = 20480;
constexpr size_t WS_TS = 2048;
constexpr size_t WS_BAR = 4096;
constexpr size_t WS_CTL_BYTES = 32768;
constexpr size_t WS_MOD = WS_CTL_BYTES;
constexpr size_t WS_WTIN = WS_MOD + al256((size_t)2 * 3 * 6144 * 4);
constexpr size_t WS_WTOUT = WS_WTIN + al256((size_t)2 * DIN * 1024 * 2);
constexpr size_t WS_WTGU = WS_WTOUT + al256((size_t)2 * 1024 * 1024 * 2);
constexpr size_t WS_WTD = WS_WTGU + al256((size_t)2 * 16 * 512 * 1024 * 2);
constexpr size_t WS_H = WS_WTD + al256((size_t)2 * 16 * 1024 * 256 * 2);
constexpr size_t WS_HX = WS_H + al256((size_t)R * 1024 * 2);
constexpr size_t WS_PROJ = WS_HX + al256((size_t)R * 1024 * 2);
constexpr size_t WS_DT = WS_PROJ + al256((size_t)R * NPROJ * 2);
constexpr size_t WS_POS = WS_DT + al256((size_t)R * 16 * 4);
constexpr size_t WS_LIST = WS_POS + al256((size_t)2 * R * 4);
constexpr size_t WS_CWLA = WS_LIST + al256((size_t)NCLS * R * 4);
constexpr size_t WS_CWLB = WS_CWLA + al256((size_t)NCLS * R * 4);
constexpr size_t WS_BIG = WS_CWLB + al256((size_t)NCLS * R * 4);
constexpr size_t WS_Y = WS_PROJ;
constexpr size_t WS_S = WS_BIG;
constexpr size_t WS_HP = WS_S + al256((size_t)2 * 2 * 130 * 8 * 8192 * 2);
constexpr size_t WS_DEC = WS_HP + al256((size_t)2 * 2 * 130 * 8 * 8192 * 2);
constexpr size_t WS_SSQ = WS_DEC + al256((size_t)2 * 2 * 130 * 8 * 4);
constexpr size_t WS_HID = WS_S;
constexpr size_t WS_END = WS_SSQ + al256((size_t)R * 8 * 4);
static_assert((size_t)(R + NCLS * 256) * 512 * 2 <= (size_t)2 * 2 * 130 * 8 * 8192 * 2, "hid alias");
static_assert(WS_END <= (size_t)512 * 1024 * 1024, "workspace");

struct Params {
    const float *x, *c, *ctx, *c_ctx, *w_ada, *b_ada, *g_mix, *g_ffn, *w_in, *conv_w, *conv_b, *conv_ln_g, *conv_ln_b, *ssd_conv_w, *ssd_conv_b,
        *dt_bias, *a_log, *d_skip, *ssd_norm_g, *w_out, *w_rg, *b_rg, *w_re, *b_re, *w_gate, *w_up, *w_down, *g_final;
    float* out; unsigned char* ws;
};
struct Args { Params p; int lo, hi; };
typedef const __attribute__((address_space(4))) Params* CP;
__device__ __forceinline__ CP launder(CP p) { asm volatile("" : "+s"(p)); return p; }
__device__ __forceinline__ int launder_tid() { int t = threadIdx.x; asm volatile("" : "+v"(t)); return t; }

__device__ __forceinline__ unsigned cvt_pk_bf16(float lo, float hi) { unsigned r; asm("v_cvt_pk_bf16_f32 %0, %1, %2" : "=v"(r) : "v"(lo), "v"(hi)); return r; }
__device__ __forceinline__ float bf2f(unsigned b) { return __uint_as_float(b << 16); }
__device__ __forceinline__ float bflo(unsigned w) { return __uint_as_float(w << 16); }
__device__ __forceinline__ float bfhi(unsigned w) { return __uint_as_float(w & 0xffff0000u); }
__device__ __forceinline__ bf16_t f2bf(float f) { return (bf16_t)(cvt_pk_bf16(f, 0.f) & 0xffffu); }
#define DPP_ADD(v, ctrl, rm) ((v) + __builtin_bit_cast(float, __builtin_amdgcn_update_dpp(0, __builtin_bit_cast(int, (v)), (ctrl), (rm), 0xF, true)))
__device__ __forceinline__ float row_sum16(float v) {
    v = DPP_ADD(v, 0xB1, 0xF);
    v = DPP_ADD(v, 0x4E, 0xF);
    v = DPP_ADD(v, 0x141, 0xF);
    v = DPP_ADD(v, 0x140, 0xF);
    return v;
}
__device__ __forceinline__ float half_sum32(float v) { v = row_sum16(v); v = DPP_ADD(v, 0x142, 0xA); return v; }
__device__ __forceinline__ float wave_sum(float v) {
    v = half_sum32(v); v = DPP_ADD(v, 0x143, 0xC);
    return __builtin_bit_cast(float, __builtin_amdgcn_readlane(__builtin_bit_cast(int, v), 63));
}
__device__ __forceinline__ float sigmoidf_(float x) { return __builtin_amdgcn_rcpf(1.f + __builtin_amdgcn_exp2f(x * -1.44269504089f)); }
__device__ __forceinline__ float siluf_(float x) { return x * __builtin_amdgcn_rcpf(1.f + __builtin_amdgcn_exp2f(x * -1.44269504089f)); }
__device__ __forceinline__ float softplusf_(float x) { return fmaxf(x, 0.f) + __logf(1.f + __expf(-fabsf(x))); }

__device__ __forceinline__ int row_b(int r) { return r >= SEG ? 1 : 0; }
__device__ __forceinline__ int row_i(int r) { return r >= SEG ? r - SEG : r; }
__device__ __forceinline__ int row_v(int r) { const int i = row_i(r); return i < CTXL ? 2 : row_b(r); }
__device__ __forceinline__ const float* xin_ptr(const float* ctx, const float* x, int r) {
    const int b = row_b(r), i = row_i(r);
    return i < CTXL ? ctx + (size_t)(b * CTXL + i) * D : x + (size_t)(b * SEQ + i - CTXL) * D;
}
struct RowRaw { f32x4 f[4]; u32x2 h[4]; };
__device__ __forceinline__ void row_load(CP p, int l, int r, int lane, RowRaw& rr) {
    if (l == 0) { const f32x4* hr = (const f32x4*)xin_ptr(p->ctx, p->x, r);
#pragma unroll
        for (int j = 0; j < 4; ++j) rr.f[j] = hr[lane + 64 * j]; }
    else { const u32x2* hr = (const u32x2*)((const bf16_t*)(p->ws + WS_H) + (size_t)r * D);
#pragma unroll
        for (int j = 0; j < 4; ++j) rr.h[j] = hr[lane + 64 * j]; }
}
__device__ __forceinline__ void row_cvt(int l, const RowRaw& rr, f32x4 (&xv)[4]) {
#pragma unroll
    for (int j = 0; j < 4; ++j) xv[j] = l == 0 ? rr.f[j] : (f32x4){bflo(rr.h[j].x), bfhi(rr.h[j].x), bflo(rr.h[j].y), bfhi(rr.h[j].y)};
}
namespace pg8 {
constexpr int BM = 256, BK = 64, HALF = 128, HTB = HALF * BK * 2, STAGE_BYTES = 8 * HTB, NXCD = 8, WGM = 8;
__device__ __forceinline__ int lds_byte(int r, int c) { const int st = (r >> 4) * 2 + (c >> 5), rr = r & 15, cc = c & 31, ob = rr * 64 + cc * 2; return st * 1024 + (ob ^ (((ob >> 9) & 1) << 5)); }
__device__ __forceinline__ void stage_rc(int b, int& Rr, int& Cc) { const int st = b / 1024, sb = b % 1024, swz = sb ^ (((sb >> 9) & 1) << 5); Rr = (st >> 1) * 16 + swz / 64; Cc = (st & 1) * 32 + (swz % 64) / 2; }
__device__ __forceinline__ int perm32(int rho) { const int n = rho >> 4, i = rho & 15; return 8 * (i >> 2) + 4 * n + (i & 3); }

struct Unit {
    const char* a0;
    const char* b0;
    const char* b1;
    int i0, i1, i2, i3, i4, pad;
};

template <class Epi, class Sched, bool GATHER>
__device__ __forceinline__ void gemm_phase(LAS unsigned char* lds, const int lda, const int ldb, const int K, const Sched& S, const Epi& E) {
    const int tid = launder_tid(); const int wid = __builtin_amdgcn_readfirstlane(tid >> 6), lane = tid & 63, wr = wid >> 2, wc = wid & 3, fr = lane & 15, fq = lane >> 4;
    const int nt = K / BK, ks = nt >> 1;
    int Rr[2], Cc[2];
    unsigned voffB[2];
#pragma unroll
    for (int i = 0; i < 2; ++i) { stage_rc(tid * 16 + i * 8192, Rr[i], Cc[i]); const int Rb = Epi::PERM ? ((Rr[i] & ~31) + perm32(Rr[i] & 31)) : Rr[i];
        voffB[i] = (unsigned)(Rb * ldb + Cc[i]) * 2u; }
    const size_t kstep = (size_t)(BK * 2);
    const size_t hstepB = (size_t)HALF * ldb * 2;
    const unsigned ldsw = (unsigned)wid * 1024u;
    const unsigned ldsbase = (unsigned)(unsigned long)lds;
    const int aoff = lds_byte(wr * 64 + fr, fq * 8), boff = lds_byte(wc * 32 + fr, fq * 8);
#define PG8_SA(b, h) (((b) * 2 + (h)) * HTB)
#define PG8_SB(b, h) ((4 + (b) * 2 + (h)) * HTB)
#define PG8_STAGE2(bufoff, gbase, v0, v1) do { unsigned keep_; \
        asm volatile("s_mov_b32 %0, m0\n\ts_mov_b32 m0, %1\n\ts_nop 4\n\tglobal_load_lds_dwordx4 %2, %4\n\ts_add_u32 m0, m0, 0x2000\n\ts_nop 0\n\tglobal_load_lds_dwordx4 %3, %4\n\ts_mov_b32 m0, %0" \
            : "=&s"(keep_) : "s"(ldsbase + (unsigned)(bufoff) + ldsw), "v"(v0), "v"(v1), "s"(gbase) : "memory", "scc"); } while (0)
#define PG8_LDA(dst, b, h) do { _Pragma("unroll") for (int m = 0; m < 4; ++m) _Pragma("unroll") for (int k = 0; k < 2; ++k) dst[m][k] = *(const LAS bf16x8*)(lds + PG8_SA(b, h) + aoff + m * 2048 + k * 1024); } while (0)
#define PG8_LDB(dst, b, h) do { _Pragma("unroll") for (int n = 0; n < 2; ++n) _Pragma("unroll") for (int k = 0; k < 2; ++k) dst[n][k] = *(const LAS bf16x8*)(lds + PG8_SB(b, h) + boff + n * 2048 + k * 1024); } while (0)
#define PG8_MMA(ai, bj, At, Bt) do { __builtin_amdgcn_s_setprio(1); _Pragma("unroll") for (int m = 0; m < 4; ++m) _Pragma("unroll") for (int n = 0; n < 2; ++n) _Pragma("unroll") for (int k = 0; k < 2; ++k) \
        acc[ai][bj][m][n] = __builtin_amdgcn_mfma_f32_16x16x32_bf16(Bt[n][k], At[m][k], acc[ai][bj][m][n], 0, 0, 0); __builtin_amdgcn_s_setprio(0); } while (0)
#define PG8_WAIT_V(n) asm volatile("s_waitcnt vmcnt(" #n ")" ::: "memory")
#define PG8_WAIT_L(n) asm volatile("s_waitcnt lgkmcnt(" #n ")" ::: "memory")
#define PG8_BAR __builtin_amdgcn_s_barrier()
#define PG8_SCHED __builtin_amdgcn_sched_barrier(0)
#define PG8_BP(u, tt) ((tt) < ks ? (u).b0 + (size_t)(tt) * kstep : (u).b1 + (size_t)((tt) - ks) * kstep)
    Unit cur, nxt; int ui = 0;
    if (!S.get(0, cur)) return;
    S.a_ready(cur);
    unsigned c00, c01, c10, c11, n00, n01, n10, n11;
    if (GATHER) {
        c00 = (unsigned)(S.arow(cur, Rr[0]) * lda + Cc[0]) * 2u; c01 = (unsigned)(S.arow(cur, Rr[1]) * lda + Cc[1]) * 2u;
        c10 = (unsigned)(S.arow(cur, HALF + Rr[0]) * lda + Cc[0]) * 2u; c11 = (unsigned)(S.arow(cur, HALF + Rr[1]) * lda + Cc[1]) * 2u;
    } else {
        c00 = (unsigned)(Rr[0] * lda + Cc[0]) * 2u; c01 = (unsigned)(Rr[1] * lda + Cc[1]) * 2u;
        c10 = (unsigned)((HALF + Rr[0]) * lda + Cc[0]) * 2u; c11 = (unsigned)((HALF + Rr[1]) * lda + Cc[1]) * 2u;
    }
    n00 = c00; n01 = c01; n10 = c10; n11 = c11;
    f32x4 acc[2][2][4][2];
    float zr; asm volatile("v_mov_b32 %0, 0" : "=v"(zr));
#pragma unroll
    for (int a = 0; a < 2; ++a)
#pragma unroll
        for (int b = 0; b < 2; ++b)
#pragma unroll
            for (int m = 0; m < 4; ++m)
#pragma unroll
                for (int n = 0; n < 2; ++n) acc[a][b][m][n] = (f32x4){zr, zr, zr, zr};
    bf16x8 At[4][2], B0[2][2], B1[2][2];
    const char* cA = cur.a0;
    {
        const char* pb0 = PG8_BP(cur, 0); const char* pb1 = PG8_BP(cur, 1);
        PG8_STAGE2(PG8_SB(0, 0), pb0, voffB[0], voffB[1]); PG8_STAGE2(PG8_SA(0, 0), cA, c00, c01);
        PG8_STAGE2(PG8_SB(0, 1), pb0 + hstepB, voffB[0], voffB[1]); PG8_STAGE2(PG8_SA(0, 1), cA, c10, c11);
        if (wr == 1) PG8_BAR;
        PG8_WAIT_V(4); PG8_BAR;
        PG8_STAGE2(PG8_SB(1, 0), pb1, voffB[0], voffB[1]); PG8_STAGE2(PG8_SA(1, 0), cA + kstep, c00, c01);
        PG8_STAGE2(PG8_SB(1, 1), pb1 + hstepB, voffB[0], voffB[1]);
        PG8_WAIT_V(6); PG8_BAR;
    }
    for (;;) {
        const bool has_next = S.get(ui + 1, nxt);
        if (!has_next) nxt = cur;
        LAS int* tokb = (LAS int*)(lds + MISC_OFF + 1024) + ((ui + 1) & 1) * 256;
        if (GATHER) {
            n00 = c00; n01 = c01; n10 = c10; n11 = c11;
            if (has_next && wid == 0) {
                const char* src = (const char*)S.rows_ptr(nxt); unsigned keep_;
                asm volatile("s_mov_b32 %0, m0\n\ts_mov_b32 m0, %1\n\ts_nop 4\n\tglobal_load_lds_dwordx4 %2, %3\n\ts_mov_b32 m0, %0"
                    : "=&s"(keep_) : "s"((unsigned)(unsigned long)tokb), "v"((unsigned)lane * 16u), "s"(src) : "memory");
            }
        }
        const char* nA = nxt.a0;
#pragma unroll 1
        for (int t = 0; t < nt; t += 2) {
            const bool last = (t == nt - 2);
            if (last && has_next) S.a_ready(nxt);
            const char* a1 = cA + (size_t)(t + 1) * kstep;
            const char* a2 = last ? nA : cA + (size_t)(t + 2) * kstep;
            const char* a3 = a2 + kstep;
            const char* b2 = last ? PG8_BP(nxt, 0) : PG8_BP(cur, t + 2);
            const char* b3 = last ? PG8_BP(nxt, 1) : PG8_BP(cur, t + 3);
            if (GATHER) { if (last && has_next) {
                const int lim = S.rows_valid(nxt) - 1;
                const int i0 = Rr[0] < lim ? Rr[0] : lim, i1 = Rr[1] < lim ? Rr[1] : lim, i2 = (HALF + Rr[0]) < lim ? (HALF + Rr[0]) : lim, i3 = (HALF + Rr[1]) < lim ? (HALF + Rr[1]) : lim;
                n00 = (unsigned)(tokb[i0] * lda + Cc[0]) * 2u; n01 = (unsigned)(tokb[i1] * lda + Cc[1]) * 2u;
                n10 = (unsigned)(tokb[i2] * lda + Cc[0]) * 2u; n11 = (unsigned)(tokb[i3] * lda + Cc[1]) * 2u; } }
            const unsigned s00 = last ? n00 : c00, s01 = last ? n01 : c01, s10 = last ? n10 : c10, s11 = last ? n11 : c11;
            if constexpr (Epi::MIDSCALE) { if (t == ks) E.midscale(acc, cur, wr, wc, fr, fq); }
            PG8_LDB(B0, 0, 0); PG8_SCHED; PG8_LDA(At, 0, 0); PG8_STAGE2(PG8_SA(1, 1), a1, c10, c11);
            PG8_WAIT_L(8); PG8_BAR; PG8_WAIT_L(0); PG8_MMA(0, 0, At, B0); PG8_BAR; PG8_SCHED;
            PG8_LDB(B1, 0, 1); PG8_STAGE2(PG8_SB(0, 0), b2, voffB[0], voffB[1]);
            PG8_BAR; PG8_WAIT_L(0); PG8_MMA(0, 1, At, B1); PG8_BAR;
            PG8_LDA(At, 0, 1); PG8_STAGE2(PG8_SA(0, 0), a2, s00, s01);
            PG8_BAR; PG8_WAIT_L(0); PG8_MMA(1, 0, At, B0); PG8_BAR; PG8_SCHED;
            PG8_STAGE2(PG8_SB(0, 1), b2 + hstepB, voffB[0], voffB[1]);
            PG8_WAIT_V(6); PG8_BAR; PG8_MMA(1, 1, At, B1); PG8_BAR;
            PG8_LDB(B0, 1, 0); PG8_SCHED; PG8_LDA(At, 1, 0); PG8_STAGE2(PG8_SA(0, 1), a2, s10, s11);
            PG8_WAIT_L(8); PG8_BAR; PG8_WAIT_L(0); PG8_MMA(0, 0, At, B0); PG8_BAR; PG8_SCHED;
            PG8_LDB(B1, 1, 1); PG8_STAGE2(PG8_SB(1, 0), b3, voffB[0], voffB[1]);
            PG8_BAR; PG8_WAIT_L(0); PG8_MMA(0, 1, At, B1); PG8_BAR;
            PG8_LDA(At, 1, 1); PG8_STAGE2(PG8_SA(1, 0), a3, s00, s01);
            PG8_BAR; PG8_WAIT_L(0); PG8_MMA(1, 0, At, B0); PG8_BAR; PG8_SCHED;
            PG8_STAGE2(PG8_SB(1, 1), b3 + hstepB, voffB[0], voffB[1]);
            PG8_WAIT_V(6); PG8_BAR; PG8_MMA(1, 1, At, B1); PG8_BAR;
        }
        E(acc, cur, wr, wc, fr, fq);
        if (!has_next) break;
        asm volatile("v_mov_b32 %0, 0" : "=v"(zr));
#pragma unroll
        for (int a = 0; a < 2; ++a)
#pragma unroll
            for (int b = 0; b < 2; ++b)
#pragma unroll
                for (int m = 0; m < 4; ++m)
#pragma unroll
                    for (int n = 0; n < 2; ++n) acc[a][b][m][n] = (f32x4){zr, zr, zr, zr};
        cur = nxt; cA = nA; ++ui; c00 = n00; c01 = n01; c10 = n10; c11 = n11;
    }
    PG8_WAIT_V(0);
    if (wr == 0) PG8_BAR;
    PG8_BAR;
#undef PG8_SA
#undef PG8_SB
#undef PG8_STAGE2
#undef PG8_LDA
#undef PG8_LDB
#undef PG8_MMA
#undef PG8_WAIT_V
#undef PG8_WAIT_L
#undef PG8_BAR
#undef PG8_SCHED
#undef PG8_BP
}

struct DenseSched {
    const char* A; const char* Bt; int lda, ldb, K; int nM, nN, nwg, G, c, skipctx;
    __device__ __forceinline__ void init(const void* A_, const void* Bt_, int M, int N, int K_, int lda_, int ldb_, int G_, int c_, int skipctx_ = 0) {
        A = (const char*)A_; Bt = (const char*)Bt_; lda = lda_; ldb = ldb_; K = K_; nM = M / BM - 2 * skipctx_; nN = N / BM; nwg = nM * nN; G = G_; c = c_; skipctx = skipctx_; }
    __device__ __forceinline__ bool get(int i, Unit& u) const {
        const long L = (long)i * G + c; if (L >= nwg) return false;
        int wgid = (int)L; { const int q = nwg / NXCD, r = nwg % NXCD, xcd = wgid % NXCD, off = wgid / NXCD; wgid = (xcd < r ? xcd * (q + 1) : r * (q + 1) + (xcd - r) * q) + off; }
        const int nig = WGM * nN, gid = wgid / nig, fm = gid * WGM, gsz = (nM - fm) < WGM ? (nM - fm) : WGM;
        int pm = fm + ((wgid % nig) % gsz); const int pn = (wgid % nig) / gsz;
        if (skipctx) pm += 1 + (pm >= 64 ? 1 : 0);
        u.a0 = A + (size_t)pm * BM * lda * 2; u.b0 = Bt + (size_t)pn * BM * ldb * 2; u.b1 = u.b0 + (size_t)(K / BK / 2) * BK * 2;
        u.i0 = pm; u.i1 = pn; u.i2 = 0; u.i3 = 0; u.i4 = 0; u.pad = 0; return true;
    }
    __device__ __forceinline__ void a_ready(const Unit&) const {}
    __device__ __forceinline__ int arow(const Unit&, int rl) const { return rl; }
    __device__ __forceinline__ const int* rows_ptr(const Unit&) const { return nullptr; }
    __device__ __forceinline__ int rows_valid(const Unit&) const { return 256; }
};
}

struct EpiProj {
    static constexpr bool PERM = true, MIDSCALE = false;
    bf16_t* O;
    __device__ __forceinline__ void operator()(const f32x4 (&acc)[2][2][4][2], const pg8::Unit& u, int wr, int wc, int fr, int fq) const {
        const int pn = u.i1;
        const int row0 = u.i0 * 256 + wr * 64 + fr;
        if (pn < 4) {
            const int col0 = pn * 128 + wc * 32 + 8 * fq;
#pragma unroll
            for (int ai = 0; ai < 2; ++ai)
#pragma unroll
                for (int m = 0; m < 4; ++m) { const f32x4 u0 = acc[ai][0][m][0], u1 = acc[ai][0][m][1], g0 = acc[ai][1][m][0], g1 = acc[ai][1][m][1];
                    u32x4 w; w.x = cvt_pk_bf16(u0[0] * sigmoidf_(g0[0]), u0[1] * sigmoidf_(g0[1])); w.y = cvt_pk_bf16(u0[2] * sigmoidf_(g0[2]), u0[3] * sigmoidf_(g0[3]));
                    w.z = cvt_pk_bf16(u1[0] * sigmoidf_(g1[0]), u1[1] * sigmoidf_(g1[1])); w.w = cvt_pk_bf16(u1[2] * sigmoidf_(g1[2]), u1[3] * sigmoidf_(g1[3]));
                    *(u32x4*)(O + (size_t)(row0 + ai * 128 + m * 16) * NPROJ + col0) = w; }
        } else {
            const int col0 = pn * 256 + wc * 32 + 8 * fq; const bool sl = pn < 6;
#pragma unroll
            for (int ai = 0; ai < 2; ++ai)
#pragma unroll
                for (int m = 0; m < 4; ++m) { bf16_t* rowp = O + (size_t)(row0 + ai * 128 + m * 16) * NPROJ + col0;
#pragma unroll
                    for (int bj = 0; bj < 2; ++bj) { f32x4 v0 = acc[ai][bj][m][0], v1 = acc[ai][bj][m][1];
                        if (sl) {
#pragma unroll
                            for (int e = 0; e < 4; ++e) { v0[e] = siluf_(v0[e]); v1[e] = siluf_(v1[e]); } }
                        u32x4 w; w.x = cvt_pk_bf16(v0[0], v0[1]); w.y = cvt_pk_bf16(v0[2], v0[3]); w.z = cvt_pk_bf16(v1[0], v1[1]); w.w = cvt_pk_bf16(v1[2], v1[3]);
                        *(u32x4*)(rowp + bj * 128) = w; } }
        }
    }
};
template <int L0> struct EpiResid {
    static constexpr bool PERM = true, MIDSCALE = true;
    const float* inc; const float* inx; bf16_t* H; const float* modl; const float* ssq;
    __device__ __forceinline__ void midscale(f32x4 (&acc)[2][2][4][2], const pg8::Unit& u, int wr, int wc, int fr, int fq) const {
        typedef float f32x2 __attribute__((ext_vector_type(2)));
        const int r0 = u.i0 * 256 + wr * 64 + fr;
        f32x2 part[2][4];
#pragma unroll
        for (int ai = 0; ai < 2; ++ai)
#pragma unroll
            for (int m = 0; m < 4; ++m) part[ai][m] = *(const f32x2*)(ssq + (size_t)(r0 + ai * 128 + m * 16) * 8 + 2 * fq);
#pragma unroll
        for (int ai = 0; ai < 2; ++ai)
#pragma unroll
            for (int m = 0; m < 4; ++m) { float sq = part[ai][m][0] + part[ai][m][1];
                sq += __shfl_xor(sq, 16); sq += __shfl_xor(sq, 32);
                const float rs = rsqrtf(sq * (1.f / 512.f) + 1e-6f);
#pragma unroll
                for (int bj = 0; bj < 2; ++bj)
#pragma unroll
                    for (int n = 0; n < 2; ++n) acc[ai][bj][m][n] *= rs; }
    }
    __device__ __forceinline__ void operator()(const f32x4 (&acc)[2][2][4][2], const pg8::Unit& u, int wr, int wc, int fr, int fq) const {
        const int r0 = u.i0 * 256;
        const int v = row_v(r0);
        const float* gate = modl + (size_t)v * 6144 + 2 * 1024;
        const float* xin = xin_ptr(inc, inx, r0);
        const int rl0 = wr * 64 + fr, col0 = u.i1 * 256 + wc * 32 + 8 * fq;
        f32x4 gv[2][2];
#pragma unroll
        for (int bj = 0; bj < 2; ++bj)
#pragma unroll
            for (int n = 0; n < 2; ++n) gv[bj][n] = *(const f32x4*)(gate + col0 + bj * 128 + 4 * n);
#pragma unroll
        for (int ai = 0; ai < 2; ++ai)
#pragma unroll
            for (int mp = 0; mp < 2; ++mp) {
                if (L0) {
                    f32x4 hi[2][2][2];
#pragma unroll
                    for (int mm = 0; mm < 2; ++mm) { const size_t off = (size_t)(rl0 + ai * 128 + (2 * mp + mm) * 16) * D + col0;
#pragma unroll
                        for (int bj = 0; bj < 2; ++bj)
#pragma unroll
                            for (int n = 0; n < 2; ++n) hi[mm][bj][n] = *(const f32x4*)(xin + off + bj * 128 + 4 * n); }
#pragma unroll
                    for (int mm = 0; mm < 2; ++mm)
#pragma unroll
                        for (int bj = 0; bj < 2; ++bj) { const f32x4 o0 = hi[mm][bj][0] + gv[bj][0] * acc[ai][bj][2 * mp + mm][0], o1 = hi[mm][bj][1] + gv[bj][1] * acc[ai][bj][2 * mp + mm][1];
                            u32x4 w; w.x = cvt_pk_bf16(o0[0], o0[1]); w.y = cvt_pk_bf16(o0[2], o0[3]); w.z = cvt_pk_bf16(o1[0], o1[1]); w.w = cvt_pk_bf16(o1[2], o1[3]);
                            *(u32x4*)(H + (size_t)(r0 + rl0 + ai * 128 + (2 * mp + mm) * 16) * D + col0 + bj * 128) = w; }
                } else {
                    u32x4 hr[2][2];
#pragma unroll
                    for (int mm = 0; mm < 2; ++mm)
#pragma unroll
                        for (int bj = 0; bj < 2; ++bj) hr[mm][bj] = *(const u32x4*)(H + (size_t)(r0 + rl0 + ai * 128 + (2 * mp + mm) * 16) * D + col0 + bj * 128);
#pragma unroll
                    for (int mm = 0; mm < 2; ++mm)
#pragma unroll
                        for (int bj = 0; bj < 2; ++bj) { const u32x4 hv = hr[mm][bj]; const f32x4 a0 = acc[ai][bj][2 * mp + mm][0], a1 = acc[ai][bj][2 * mp + mm][1]; const f32x4 g0 = gv[bj][0], g1 = gv[bj][1];
                            u32x4 w;
                            w.x = cvt_pk_bf16(bflo(hv.x) + g0[0] * a0[0], bfhi(hv.x) + g0[1] * a0[1]); w.y = cvt_pk_bf16(bflo(hv.y) + g0[2] * a0[2], bfhi(hv.y) + g0[3] * a0[3]);
                            w.z = cvt_pk_bf16(bflo(hv.z) + g1[0] * a1[0], bfhi(hv.z) + g1[1] * a1[1]); w.w = cvt_pk_bf16(bflo(hv.w) + g1[2] * a1[2], bfhi(hv.w) + g1[3] * a1[3]);
                            *(u32x4*)(H + (size_t)(r0 + rl0 + ai * 128 + (2 * mp + mm) * 16) * D + col0 + bj * 128) = w; }
                }
                asm volatile("" ::: "memory"); }
    }
};

__device__ __forceinline__ const char* uniform_ptr(const char* q) {
    const unsigned long long v = (unsigned long long)q;
    const unsigned lo = __builtin_amdgcn_readfirstlane((unsigned)v), hi = __builtin_amdgcn_readfirstlane((unsigned)(v >> 32));
    return (const char*)(((unsigned long long)hi << 32) | lo);
}
struct MoeSched {
    const LAS int* tab;
    const int* list;
    const char* A; const char* W; int mode  , l, G, c;
    unsigned* ready;
    __device__ __forceinline__ void a_ready(const pg8::Unit& u) const {
        if (mode == 0) return;
        if (threadIdx.x < 64) {
            unsigned* w = ready + u.i4; unsigned spins = 0;
            while ((unsigned)__builtin_amdgcn_readfirstlane((int)__hip_atomic_load(w, __ATOMIC_RELAXED, __HIP_MEMORY_SCOPE_AGENT)) < 32u) {
                __builtin_amdgcn_s_sleep(2); if (++spins > (1u << 22)) break; }
            __builtin_amdgcn_fence(__ATOMIC_ACQUIRE, "agent");
            asm volatile("s_waitcnt vmcnt(0)" ::: "memory");
        }
        asm volatile("" ::: "memory"); __builtin_amdgcn_s_barrier(); asm volatile("" ::: "memory");
    }
    int late;
    __device__ __forceinline__ bool get(int i, pg8::Unit& u) const {
        const int total = __builtin_amdgcn_readfirstlane(tab[24]) * 4;
        int L;
        if (mode == 0 || late == 0) L = i * G + c;
        else if (c < late) { if (i > 0) return false; L = c; }
        else L = late + (c - late) + i * (G - late);
        if (L >= total) return false;
        const int tl = L >> 2, pn = L & 3;
        int cls = 0;
#pragma unroll 1
        for (int q = 1; q < NCLS; ++q) { const int tq = __builtin_amdgcn_readfirstlane(tab[q]); if (tq <= tl) cls = q; }
        const int j = tl - __builtin_amdgcn_readfirstlane(tab[cls]), cnt = __builtin_amdgcn_readfirstlane(tab[32 + cls]);
        const int g = cls / 6, pidx = cls - g * 6;
        const int ea = (pidx >= 3) + (pidx >= 5), eb = pidx < 3 ? pidx + 1 : (pidx < 5 ? pidx - 1 : 3);
        if (mode == 0) {
            const int e = 4 * g + (pn < 2 ? ea : eb);
            u.a0 = A;
            u.b0 = W + ((size_t)(l * 16 + e) * 512 + (size_t)(pn & 1) * 256) * 1024 * 2; u.b1 = u.b0 + (size_t)8 * 128;
        } else {
            u.a0 = A + (size_t)tl * 256 * 512 * 2;
            u.b0 = W + ((size_t)(l * 16 + 4 * g + ea) * 1024 + (size_t)pn * 256) * 256 * 2;
            u.b1 = W + ((size_t)(l * 16 + 4 * g + eb) * 1024 + (size_t)pn * 256) * 256 * 2;
        }
        u.a0 = uniform_ptr(u.a0); u.b0 = uniform_ptr(u.b0); u.b1 = uniform_ptr(u.b1);
        u.i0 = cls; u.i1 = j; u.i2 = pn; u.i3 = cnt; u.i4 = tl; u.pad = 0; return true;
    }
    __device__ __forceinline__ int arow(const pg8::Unit& u, int rl) const {
        int idx = u.i1 * 256 + rl; idx = idx < u.i3 ? idx : u.i3 - 1;
        return list[(size_t)u.i0 * R + idx];
    }
    __device__ __forceinline__ const int* rows_ptr(const pg8::Unit& u) const { return list + (size_t)u.i0 * R + u.i1 * 256; }
    __device__ __forceinline__ int rows_valid(const pg8::Unit& u) const { return u.i3 - u.i1 * 256; }
};
struct EpiUp {
    static constexpr bool PERM = true, MIDSCALE = false;
    bf16_t* hid; const float* cwla; const float* cwlb; unsigned* ready;
    __device__ __forceinline__ void operator()(const f32x4 (&acc)[2][2][4][2], const pg8::Unit& u, int wr, int wc, int fr, int fq) const {
        const int cls = u.i0, j = u.i1, pn = u.i2, cnt = u.i3, tl = u.i4;
        const float* cw = (pn < 2) ? cwla : cwlb;
        const int colbase = (pn >> 1) * 256 + (pn & 1) * 128 + wc * 32 + 8 * fq;
        float wrow[2][4];
#pragma unroll
        for (int ai = 0; ai < 2; ++ai)
#pragma unroll
            for (int m = 0; m < 4; ++m) { const int idx = j * 256 + ai * 128 + wr * 64 + m * 16 + fr; wrow[ai][m] = idx < cnt ? cw[(size_t)cls * R + idx] : 0.f; }
#pragma unroll
        for (int ai = 0; ai < 2; ++ai)
#pragma unroll
            for (int m = 0; m < 4; ++m) {
                const int rl = ai * 128 + wr * 64 + m * 16 + fr; const int idx = j * 256 + rl; const bool valid = idx < cnt;
                const float w = wrow[ai][m];
                const f32x4 g0 = acc[ai][0][m][0], g1 = acc[ai][0][m][1], u0 = acc[ai][1][m][0], u1 = acc[ai][1][m][1];
                float o[8];
#pragma unroll
                for (int e = 0; e < 4; ++e) { o[e] = w * siluf_(g0[e]) * u0[e]; o[4 + e] = w * siluf_(g1[e]) * u1[e]; }
                if (!valid) {
#pragma unroll
                    for (int e = 0; e < 8; ++e) o[e] = 0.f; }
                u32x4 pk; pk.x = cvt_pk_bf16(o[0], o[1]); pk.y = cvt_pk_bf16(o[2], o[3]); pk.z = cvt_pk_bf16(o[4], o[5]); pk.w = cvt_pk_bf16(o[6], o[7]);
                { bf16_t* dstp = hid + ((size_t)tl * 256 + rl) * 512 + colbase;
                  asm volatile("global_store_dwordx4 %0, %1, off sc1\n\ts_nop 1" :: "v"(dstp), "v"(pk) : "memory"); }
            }
        asm volatile("s_waitcnt vmcnt(0)" ::: "memory");
        if ((threadIdx.x & 63) == 0) __hip_atomic_fetch_add(ready + tl, 1u, __ATOMIC_RELAXED, __HIP_MEMORY_SCOPE_AGENT);
    }
};
struct EpiDown {
    static constexpr bool PERM = true, MIDSCALE = false;
    bf16_t* H; const int* list; const float* modl;
    __device__ __forceinline__ void operator()(const f32x4 (&acc)[2][2][4][2], const pg8::Unit& u, int wr, int wc, int fr, int fq) const {
        const int cls = u.i0, j = u.i1, pn = u.i2, cnt = u.i3;
        const int col0 = pn * 256 + wc * 32 + 8 * fq;
        int tok[2][4];
#pragma unroll
        for (int ai = 0; ai < 2; ++ai)
#pragma unroll
            for (int m = 0; m < 4; ++m) { const int idx = j * 256 + ai * 128 + wr * 64 + m * 16 + fr; tok[ai][m] = idx < cnt ? list[(size_t)cls * R + idx] : -1; }
#pragma unroll
        for (int ai = 0; ai < 2; ++ai)
#pragma unroll
            for (int mp = 0; mp < 2; ++mp) {
                u32x4 hr[2][2]; f32x4 gv[2][2][2];
#pragma unroll
                for (int mm = 0; mm < 2; ++mm) { const int t = tok[ai][2 * mp + mm]; const int tt = t < 0 ? 0 : t;
                    const bf16_t* hp = H + (size_t)tt * D + col0; const float* gp = modl + (size_t)row_v(tt) * 6144 + col0;
#pragma unroll
                    for (int bj = 0; bj < 2; ++bj) { hr[mm][bj] = *(const u32x4*)(hp + bj * 128); gv[mm][bj][0] = *(const f32x4*)(gp + bj * 128); gv[mm][bj][1] = *(const f32x4*)(gp + bj * 128 + 4); } }
#pragma unroll
                for (int mm = 0; mm < 2; ++mm) { const int t = tok[ai][2 * mp + mm];
                    if (t >= 0) {
#pragma unroll
                        for (int bj = 0; bj < 2; ++bj) { const u32x4 hv = hr[mm][bj]; const f32x4 a0 = acc[ai][bj][2 * mp + mm][0], a1 = acc[ai][bj][2 * mp + mm][1]; const f32x4 g0 = gv[mm][bj][0], g1 = gv[mm][bj][1];
                            u32x4 w;
                            w.x = cvt_pk_bf16(bflo(hv.x) + g0[0] * a0[0], bfhi(hv.x) + g0[1] * a0[1]); w.y = cvt_pk_bf16(bflo(hv.y) + g0[2] * a0[2], bfhi(hv.y) + g0[3] * a0[3]);
                            w.z = cvt_pk_bf16(bflo(hv.z) + g1[0] * a1[0], bfhi(hv.z) + g1[1] * a1[1]); w.w = cvt_pk_bf16(bflo(hv.w) + g1[2] * a1[2], bfhi(hv.w) + g1[3] * a1[3]);
                            *(u32x4*)(H + (size_t)t * D + col0 + bj * 128) = w; } } }
                asm volatile("" ::: "memory"); }
    }
};

__device__ __forceinline__ void tr_tile(const float* src, int ldn, int k0, int n0, int nvalid, bf16_t* dst, int ldk, int drow0, LAS float* tile, int kd0 = -1, const float* kscale = nullptr) {
    const int tid = launder_tid();
    if (kd0 < 0) kd0 = k0;
    { const int n = tid & 63; const int kq = tid >> 6; float tv[8], ts[8];
#pragma unroll
      for (int it = 0; it < 8; ++it) { const int kk = kq + 8 * it; tv[it] = (n < nvalid) ? src[(size_t)(k0 + kk) * ldn + n0 + n] : 0.f; ts[it] = kscale ? kscale[kk] : 1.f; }
#pragma unroll
      for (int it = 0; it < 8; ++it) tile[(kq + 8 * it) * 65 + n] = tv[it] * ts[it]; }
    __syncthreads();
    { const int k8 = tid & 7, n = tid >> 3;
      if (n < nvalid) { const LAS float* s = tile + (k8 * 8) * 65 + n;
          u32x4 o; o.x = cvt_pk_bf16(s[0], s[65]); o.y = cvt_pk_bf16(s[2 * 65], s[3 * 65]); o.z = cvt_pk_bf16(s[4 * 65], s[5 * 65]); o.w = cvt_pk_bf16(s[6 * 65], s[7 * 65]);
          *(u32x4*)(dst + (size_t)(drow0 + n) * ldk + kd0 + k8 * 8) = o; } }
    __syncthreads();
}
constexpr int WPREP_ITEMS_PER_LAYER = 16 * 41 + 256 + 1024 + 1024 + 1024;
__device__ __forceinline__ void phase_wprep(CP p, unsigned char* lds, int it0, int it1, int bidx, int nblk) {
    LAS float* tile = (LAS float*)(LAS unsigned char*)lds;
    constexpr int I_IN = 16 * 41, I_OUT = 256, I_G = 1024, I_U = 1024, I_D = 1024, I_L = I_IN + I_OUT + I_G + I_U + I_D;
    for (int it = it0 + bidx; it < it1; it += nblk) {
        const int l = it / I_L; int r = it - l * I_L;
        if (r < I_IN) { const int kt = r / 41, ntl = r % 41; const int n0 = ntl * 64; const int nv = (DIN - n0) < 64 ? (DIN - n0) : 64;
            const int dr = n0 < 512 ? (n0 >> 7) * 256 + (n0 & 127) : (n0 < 1024 ? ((n0 - 512) >> 7) * 256 + 128 + ((n0 - 512) & 127) : n0);
            tr_tile(p->w_in + (size_t)l * 1024 * DIN, DIN, kt * 64, n0, nv, (bf16_t*)(p->ws + WS_WTIN) + (size_t)l * DIN * 1024, 1024, dr, tile); continue; }
        r -= I_IN;
        if (r < I_OUT) { const int kt = r >> 4, ntl = r & 15;
            tr_tile(p->w_out + (size_t)l * 1024 * 1024, 1024, kt * 64, ntl * 64, 64, (bf16_t*)(p->ws + WS_WTOUT) + (size_t)l * 1024 * 1024, 1024, ntl * 64, tile,
                    (kt * 64 + 512) & 1023, kt >= 8 ? p->ssd_norm_g + l * 512 + (kt * 64 - 512) : nullptr); continue; }
        r -= I_OUT;
        if (r < I_G + I_U) { const int up = r >= I_G; if (up) r -= I_G; const int e = r >> 6, q = r & 63, kt = q >> 2, ntl = q & 3; const int n0 = ntl * 64;
            const float* src = (up ? p->w_up : p->w_gate) + (size_t)(l * 16 + e) * 1024 * 256;
            tr_tile(src, 256, kt * 64, n0, 64, (bf16_t*)(p->ws + WS_WTGU) + (size_t)(l * 16 + e) * 512 * 1024, 1024, (n0 >> 7) * 256 + (n0 & 127) + (up ? 128 : 0), tile); continue; }
        r -= I_G + I_U;
        { const int e = r >> 6, q = r & 63, kt = q >> 4, ntl = q & 15;
          tr_tile(p->w_down + (size_t)(l * 16 + e) * 256 * 1024, 1024, kt * 64, ntl * 64, 64, (bf16_t*)(p->ws + WS_WTD) + (size_t)(l * 16 + e) * 1024 * 256, 256, ntl * 64, tile); }
    }
}
__device__ __forceinline__ void phase_adaln(CP p, unsigned char* lds, int bid, int nb) {
    LAS float* sc = (LAS float*)(LAS unsigned char*)lds;
    LAS float* red = sc + 3 * 1024;
    const int tid = launder_tid();
    for (int idx = tid; idx < 3 * 1024; idx += NTHREADS) { const int v = idx >> 10, k = idx & 1023; const float cv = (v < 2) ? p->c[v * 1024 + k] : p->c_ctx[k]; sc[idx] = siluf_(cv); }
    __syncthreads();
    float* mod = (float*)(p->ws + WS_MOD);
    for (int it = bid; it < 2 * 96; it += nb) {
        const int l = it / 96, n0 = (it % 96) * 64;
        const int c4 = tid & 15, kr = tid >> 4;
        f32x4 a0 = {0, 0, 0, 0}, a1 = {0, 0, 0, 0}, a2 = {0, 0, 0, 0};
        const float* w = p->w_ada + (size_t)l * 1024 * 6144 + n0 + c4 * 4;
#pragma unroll 4
        for (int k = kr; k < 1024; k += 32) { const f32x4 w4 = *(const f32x4*)(w + (size_t)k * 6144); a0 += sc[k] * w4; a1 += sc[1024 + k] * w4; a2 += sc[2048 + k] * w4; }
        *(LAS f32x4*)(red + (kr * 3 + 0) * 64 + c4 * 4) = a0; *(LAS f32x4*)(red + (kr * 3 + 1) * 64 + c4 * 4) = a1; *(LAS f32x4*)(red + (kr * 3 + 2) * 64 + c4 * 4) = a2;
        __syncthreads();
        if (tid < 192) { const int v = tid >> 6, cc = tid & 63; float s = 0.f;
            for (int q = 0; q < 32; ++q) s += red[(q * 3 + v) * 64 + cc];
            mod[((size_t)l * 3 + v) * 6144 + n0 + cc] = s + p->b_ada[l * 6144 + n0 + cc]; }
        __syncthreads();
    }
}
__device__ __forceinline__ void moe_table(CP p, int l, LAS int* tab) {
    const int* gcount = (const int*)(p->ws + WS_CTL) + l * 32;
    if (threadIdx.x == 0) { int acc = 0; for (int q = 0; q < NCLS; ++q) { const int cn = gcount[q]; tab[q] = acc; tab[32 + q] = cn; acc += (cn + 255) >> 8; } tab[24] = acc; }
    __syncthreads();
}
__device__ __forceinline__ void moe_yload(CP p, int pos, int lane, const LAS int* tab, u32x2 (&yv)[4]) {
    const int slot = tab[pos >> 16] * 256 + (pos & 0xffff);
    const bf16_t* y = (const bf16_t*)(p->ws + WS_Y) + (size_t)slot * 1024;
#pragma unroll
    for (int j = 0; j < 4; ++j) yv[j] = *(const u32x2*)(y + 4 * lane + 256 * j);
}
__device__ __forceinline__ void moe_yadd(CP p, int lm, int v, int lane, const u32x2 (&yv)[4], f32x4 (&xv)[4]) {
    const float* gate = (const float*)(p->ws + WS_MOD) + ((size_t)lm * 3 + v) * 6144 + 5 * 1024;
#pragma unroll
    for (int j = 0; j < 4; ++j) { const int k = 4 * lane + 256 * j; const f32x4 g4 = *(const f32x4*)(gate + k);
        xv[j][0] += g4[0] * bflo(yv[j].x); xv[j][1] += g4[1] * bfhi(yv[j].x); xv[j][2] += g4[2] * bflo(yv[j].y); xv[j][3] += g4[3] * bfhi(yv[j].y); }
}
typedef _Float16 f16x8 __attribute__((ext_vector_type(8)));
typedef _Float16 f16x2 __attribute__((ext_vector_type(2)));
constexpr int ST_H16 = 2064;
__device__ __forceinline__ unsigned pack_f16(float a, float b) { f16x2 h; h[0] = (_Float16)a; h[1] = (_Float16)b; return __builtin_bit_cast(unsigned, h); }
__device__ __forceinline__ void phase_r1(CP p, int l, unsigned char* lds_, int bid, int nb) {
    LAS unsigned char* lds = (LAS unsigned char*)lds_;
    LAS unsigned char* Wh = lds;
    LAS unsigned char* Xh = Wh + 16 * ST_H16;
    LAS float* gm = (LAS float*)(Xh + 16 * ST_H16);
    LAS float* sh = gm + 3 * 1024;
    LAS float* part = sh + 3 * 1024;
    const int tid = launder_tid(); const int lane = tid & 63, wave = __builtin_amdgcn_readfirstlane(tid >> 6);
    const float* mod = (const float*)(p->ws + WS_MOD) + (size_t)l * 3 * 6144;
    const float* win = p->w_in + (size_t)l * 1024 * DIN;
#pragma unroll
    for (int hb = 0; hb < 2; ++hb) { float tmp[16];
#pragma unroll
        for (int it = 0; it < 16; ++it) { const int idx = tid + NTHREADS * (16 * hb + it); tmp[it] = win[(size_t)(idx >> 4) * DIN + NPROJ + (idx & 15)]; }
#pragma unroll
        for (int it = 0; it < 16; ++it) { const int idx = tid + NTHREADS * (16 * hb + it); *(LAS _Float16*)(Wh + (idx & 15) * ST_H16 + (idx >> 4) * 2) = (_Float16)tmp[it]; } }
    { float t0[6], t1[6], t2[6];
#pragma unroll
      for (int it = 0; it < 6; ++it) { const int idx = tid + NTHREADS * it; const int v = idx >> 10, k = idx & 1023; t0[it] = p->g_mix[l * 1024 + k]; t1[it] = mod[v * 6144 + 1024 + k]; t2[it] = mod[v * 6144 + k]; }
#pragma unroll
      for (int it = 0; it < 6; ++it) { const int idx = tid + NTHREADS * it; gm[idx] = t0[it] * (1.f + t1[it]); sh[idx] = t2[it]; } }
    __syncthreads();
    bf16_t* HX = (bf16_t*)(p->ws + WS_HX); float* DT = (float*)(p->ws + WS_DT);
    const int rpb = (R + nb - 1) / nb, r0 = bid * rpb, r1 = (r0 + rpb) < R ? (r0 + rpb) : R;
    RowRaw xn[2];
#pragma unroll
    for (int q = 0; q < 2; ++q) if (r0 + 2 * wave + q < r1) row_load(p, l, r0 + 2 * wave + q, lane, xn[q]);
#pragma unroll 1
    for (int t0r = r0; t0r < r1; t0r += 16) {
        f32x4 xv[2][4];
#pragma unroll
        for (int q = 0; q < 2; ++q) row_cvt(l, xn[q], xv[q]);
#pragma unroll
        for (int q = 0; q < 2; ++q) if (t0r + 16 + 2 * wave + q < r1) row_load(p, l, t0r + 16 + 2 * wave + q, lane, xn[q]);
#pragma unroll
        for (int q = 0; q < 2; ++q) { const int rr = t0r + 2 * wave + q; const bool ok = rr < r1; const int v = row_v(ok ? rr : r0);
            if (l == 0 && ok) { u32x2* hw = (u32x2*)((bf16_t*)(p->ws + WS_H) + (size_t)rr * D);
#pragma unroll
                for (int j = 0; j < 4; ++j) { u32x2 o; o.x = cvt_pk_bf16(xv[q][j][0], xv[q][j][1]); o.y = cvt_pk_bf16(xv[q][j][2], xv[q][j][3]); hw[lane + 64 * j] = o; } }
            float ss = 0.f;
#pragma unroll
            for (int j = 0; j < 4; ++j) ss += xv[q][j][0] * xv[q][j][0] + xv[q][j][1] * xv[q][j][1] + xv[q][j][2] * xv[q][j][2] + xv[q][j][3] * xv[q][j][3];
            ss = wave_sum(ss); const float rs = ok ? rsqrtf(ss * (1.f / 1024.f) + 1e-6f) : 0.f;
#pragma unroll
            for (int j = 0; j < 4; ++j) { const int k = 4 * lane + 256 * j; const f32x4 g4 = *(const LAS f32x4*)(gm + v * 1024 + k), s4 = *(const LAS f32x4*)(sh + v * 1024 + k);
                f32x4 hv = xv[q][j] * rs * g4 + s4; if (!ok) hv = hv * 0.f;
                u32x2 o; o.x = cvt_pk_bf16(hv[0], hv[1]); o.y = cvt_pk_bf16(hv[2], hv[3]);
                if (ok) *(u32x2*)(HX + (size_t)rr * 1024 + k) = o;
                u32x2 h16; h16.x = pack_f16(hv[0], hv[1]); h16.y = pack_f16(hv[2], hv[3]);
                *(LAS u32x2*)(Xh + (2 * wave + q) * ST_H16 + k * 2) = h16; } }
        __syncthreads();
        {
            f32x4 acc0 = {0.f, 0.f, 0.f, 0.f};
#pragma unroll
            for (int s4 = 0; s4 < 4; ++s4) { const int kb = (128 * wave + 32 * s4 + 8 * (lane >> 4)) * 2;
                const f16x8 a = *(const LAS f16x8*)(Xh + (lane & 15) * ST_H16 + kb);
                const f16x8 b0 = *(const LAS f16x8*)(Wh + (lane & 15) * ST_H16 + kb);
                acc0 = __builtin_amdgcn_mfma_f32_16x16x32_f16(a, b0, acc0, 0, 0, 0); }
#pragma unroll
            for (int e = 0; e < 4; ++e) part[(wave * 16 + 4 * (lane >> 4) + e) * 16 + (lane & 15)] = acc0[e];
        }
        __syncthreads();
        if (tid < 256) { const int row = tid >> 4, n = tid & 15; const int rr = t0r + row;
            float sacc = p->dt_bias[l * 16 + n];
#pragma unroll
            for (int w = 0; w < 8; ++w) sacc += part[(w * 16 + row) * 16 + n];
            if (rr < r1) DT[(size_t)rr * 16 + n] = softplusf_(sacc); }
    }
    __syncthreads();
}
typedef float f32x16 __attribute__((ext_vector_type(16)));
typedef short s16x4 __attribute__((ext_vector_type(4)));
constexpr int ST_ROW = 272;
constexpr int ST_TR128 = 320;
constexpr int ST_TR64 = 192;
constexpr int ST_MT = 328;
constexpr int NCHUNK = SEG / 128;

#define DPP_MOV(v, ctrl, rm, bm) __builtin_bit_cast(float, __builtin_amdgcn_update_dpp(0, __builtin_bit_cast(int, (v)), (ctrl), (rm), (bm), true))
__device__ __forceinline__ float wave_incl_scan(float v, int) {
    float s = v + DPP_MOV(v, 0x111, 0xF, 0xF) + DPP_MOV(v, 0x112, 0xF, 0xF) + DPP_MOV(v, 0x113, 0xF, 0xF);
    s += DPP_MOV(s, 0x114, 0xF, 0xE);
    s += DPP_MOV(s, 0x118, 0xF, 0xC);
    s += DPP_MOV(s, 0x142, 0xA, 0xF);
    s += DPP_MOV(s, 0x143, 0xC, 0xF);
    return s;
}
__device__ __forceinline__ bf16x8 row_frag(const LAS unsigned char* tile, int stride, int row0, int k0, int lane) {
    return *(const LAS bf16x8*)(tile + (row0 + (lane & 31)) * stride + (k0 + 8 * (lane >> 5)) * 2);
}
__device__ __forceinline__ bf16x8 tr_frag(const LAS unsigned char* tile, int stride, int k0, int c0, int lane) {
    const int g = lane >> 4, li = lane & 15, q = li >> 2, pp = li & 3;
    const LAS unsigned char* a0 = tile + (k0 + 8 * (g >> 1) + q) * stride + (c0 + 16 * (g & 1) + 4 * pp) * 2;
    const s16x4 lo = __builtin_amdgcn_ds_read_tr16_b64_v4i16((LAS s16x4*)a0);
    const s16x4 hi = __builtin_amdgcn_ds_read_tr16_b64_v4i16((LAS s16x4*)(a0 + 4 * stride));
    return __builtin_shufflevector(lo, hi, 0, 1, 2, 3, 4, 5, 6, 7);
}
__device__ __forceinline__ u32x4 pack8(const float (&v)[8]) { u32x4 r; r.x = cvt_pk_bf16(v[0], v[1]); r.y = cvt_pk_bf16(v[2], v[3]); r.z = cvt_pk_bf16(v[4], v[5]); r.w = cvt_pk_bf16(v[6], v[7]); return r; }
__device__ __forceinline__ u32x4 pack8s(const float (&v)[8], float sc) { u32x4 r; r.x = cvt_pk_bf16(v[0] * sc, v[1] * sc); r.y = cvt_pk_bf16(v[2] * sc, v[3] * sc); r.z = cvt_pk_bf16(v[4] * sc, v[5] * sc); r.w = cvt_pk_bf16(v[6] * sc, v[7] * sc); return r; }

__device__ __forceinline__ void conv_load(const bf16_t* proj, int row0, int rq, int xch, bool lo_ok, bool hi_ok, u32x4 (&raw)[8]) {
    const bf16_t* base = proj + (size_t)(row0 + 4 * rq) * NPROJ + 1536 + xch;
    unsigned zz; asm volatile("v_mov_b32 %0, 0" : "=v"(zz));
#pragma unroll
    for (int j = 0; j < 8; ++j) {
        if (j < 2) { const bool ok = (rq > 0) || lo_ok; const u32x4 v = *(const u32x4*)(ok ? base + (j - 2) * NPROJ : base);
            raw[j].x = ok ? v.x : zz; raw[j].y = ok ? v.y : zz; raw[j].z = ok ? v.z : zz; raw[j].w = ok ? v.w : zz; }
        else if (j >= 6) { const bool ok = (rq < 31) || hi_ok; const u32x4 v = *(const u32x4*)(ok ? base + (j - 2) * NPROJ : base);
            raw[j].x = ok ? v.x : zz; raw[j].y = ok ? v.y : zz; raw[j].z = ok ? v.z : zz; raw[j].w = ok ? v.w : zz; }
        else raw[j] = *(const u32x4*)(base + (j - 2) * NPROJ);
    }
}
__device__ __forceinline__ void conv_compute(const u32x4 (&raw)[8], const LAS float* wl, int nchl, int wch, float (&o)[4][8]) {
    float w[5][8], bs[8];
#pragma unroll
    for (int j = 0; j < 5; ++j) { const f32x4 w0 = *(const LAS f32x4*)(wl + j * nchl + wch), w1 = *(const LAS f32x4*)(wl + j * nchl + wch + 4);
        w[j][0] = w0[0]; w[j][1] = w0[1]; w[j][2] = w0[2]; w[j][3] = w0[3]; w[j][4] = w1[0]; w[j][5] = w1[1]; w[j][6] = w1[2]; w[j][7] = w1[3]; }
    { const f32x4 b0 = *(const LAS f32x4*)(wl + 5 * nchl + wch), b1 = *(const LAS f32x4*)(wl + 5 * nchl + wch + 4); bs[0] = b0[0]; bs[1] = b0[1]; bs[2] = b0[2]; bs[3] = b0[3]; bs[4] = b1[0]; bs[5] = b1[1]; bs[6] = b1[2]; bs[7] = b1[3]; }
#pragma unroll
    for (int i = 0; i < 4; ++i)
#pragma unroll
        for (int e = 0; e < 8; ++e) o[i][e] = bs[e];
#pragma unroll
    for (int j = 0; j < 8; ++j) {
        float xv[8] = {bflo(raw[j].x), bfhi(raw[j].x), bflo(raw[j].y), bfhi(raw[j].y), bflo(raw[j].z), bfhi(raw[j].z), bflo(raw[j].w), bfhi(raw[j].w)};
#pragma unroll
        for (int i = 0; i < 4; ++i) { const int tap = j - i; if (tap >= 0 && tap < 5) {
#pragma unroll
                for (int e = 0; e < 8; ++e) o[i][e] += w[tap][e] * xv[e]; } }
    }
#pragma unroll
    for (int i = 0; i < 4; ++i)
#pragma unroll
        for (int e = 0; e < 8; ++e) o[i][e] = siluf_(o[i][e]);
}
__device__ __forceinline__ void head_cums(CP p, int l, int row0, int h, int dir, int lane, LAS float* hv) {
    const float A = -expf(p->a_log[l * 16 + dir * 8 + h]);
    const float* DT = (const float*)(p->ws + WS_DT);
    const float d0 = DT[(size_t)(row0 + 2 * lane) * 16 + dir * 8 + h], d1 = DT[(size_t)(row0 + 2 * lane + 1) * 16 + dir * 8 + h];
    const float x0 = d0 * A, x1 = d1 * A;
    const float incl = wave_incl_scan(x0 + x1, lane);
    const float total = __builtin_bit_cast(float, __builtin_amdgcn_readlane(__builtin_bit_cast(int, incl), 63));
    float c0, c1;
    if (dir == 0) { c1 = incl; c0 = incl - x1; } else { c0 = total - (incl - x1 - x0); c1 = total - (incl - x1); }
    hv[dir * 128 + 2 * lane] = c0; hv[dir * 128 + 2 * lane + 1] = c1;
    hv[256 + dir * 128 + 2 * lane] = d0; hv[256 + dir * 128 + 2 * lane + 1] = d1;
    if (lane == 0) hv[512 + dir] = total;
}
__device__ __forceinline__ bf16x8 scale_frag(bf16x8 f, const f32x4 w0, const f32x4 w1) {
    const u32x4 u = __builtin_bit_cast(u32x4, f);
    u32x4 r;
    r.x = cvt_pk_bf16(bflo(u.x) * w0[0], bfhi(u.x) * w0[1]); r.y = cvt_pk_bf16(bflo(u.y) * w0[2], bfhi(u.y) * w0[3]);
    r.z = cvt_pk_bf16(bflo(u.z) * w1[0], bfhi(u.z) * w1[1]); r.w = cvt_pk_bf16(bflo(u.w) * w1[2], bfhi(u.w) * w1[3]);
    return __builtin_bit_cast(bf16x8, r);
}
constexpr int ST_X256 = 576;

__device__ __forceinline__ void phase_c1(CP p, int l, unsigned char* lds_, int bid, int nb) {
    LAS unsigned char* lds = (LAS unsigned char*)lds_;
    LAS unsigned char* tile = lds;
    LAS float* wl = (LAS float*)(lds + 73216);
    const int tid = launder_tid();
    const bf16_t* proj = (const bf16_t*)(p->ws + WS_PROJ); bf16_t* mix = (bf16_t*)(p->ws + WS_HX);
#pragma unroll 1
    for (int u = bid; u < 256 + 512 + (l == DEPTH - 1 ? 0 : 16); u += nb) {
        int S, LEN, pstride, sstride, tok0, ch0;
        if (u < 256) { const int b = u >> 7, cs = (u >> 2) & 31, cc = u & 3; S = 2; LEN = 256; pstride = 64; sstride = 1; tok0 = b * SEG + CTXL + 2 * cs; ch0 = 256 + 64 * cc; }
        else if (u < 768) { const int v = u - 256; const int b = v >> 8, rg = (v >> 2) & 63, cc = v & 3; S = 4; LEN = 64; pstride = 1; sstride = 64; tok0 = b * SEG + CTXL + 256 * rg; ch0 = 64 * cc; }
        else { const int v = u - 768; const int b = v >> 3, cc = v & 7; S = 1; LEN = 256; pstride = 1; sstride = 0; tok0 = b * SEG; ch0 = 64 * cc; }
        const int LP = LEN + 30;
        { float tw[4];
#pragma unroll
          for (int it = 0; it < 4; ++it) { const int i = tid + NTHREADS * it; const int j = i >> 6, c = i & 63; tw[it] = j < 31 ? p->conv_w[((size_t)l * 31 + j) * 512 + ch0 + c] : p->conv_b[l * 512 + ch0 + c]; }
#pragma unroll
          for (int it = 0; it < 4; ++it) wl[tid + NTHREADS * it] = tw[it]; }
        for (int i = tid; i < S * 30 * 8; i += NTHREADS) { const int pc = i & 7, q = (i >> 3) % 30, sq = (i >> 3) / 30; const int pos = q < 15 ? q : LEN + q;
            unsigned zz; asm volatile("v_mov_b32 %0, 0" : "=v"(zz));
            *(LAS u32x4*)(tile + ((sq * LP + pos) * 64 + pc * 8) * 2) = (u32x4){zz, zz, zz, zz}; }
        for (int ib = 0; ib < S * LEN * 8; ib += 4 * NTHREADS) {
            u32x4 uv[4];
#pragma unroll
            for (int q = 0; q < 4; ++q) { const int i = ib + tid + NTHREADS * q; const int pc = i & 7, t = i >> 3; const int sq = t / LEN, pos = t - sq * LEN;
                const bf16_t* src = proj + (size_t)(tok0 + sq * sstride + pos * pstride) * NPROJ + ch0 + pc * 8;
                uv[q] = *(const u32x4*)src; }
#pragma unroll
            for (int q = 0; q < 4; ++q) { const int i = ib + tid + NTHREADS * q; const int pc = i & 7, t = i >> 3; const int sq = t / LEN, pos = t - sq * LEN;
                const u32x4 o = uv[q];
                *(LAS u32x4*)(tile + ((sq * LP + 15 + pos) * 64 + pc * 8) * 2) = o; }
        }
        __syncthreads();
        const int noct = S * LEN / 8;
#pragma unroll 1
        for (int it = tid; it < noct * 32; it += NTHREADS) {
            const int cp = it & 31, oc = it >> 5; const int sq = oc / (LEN / 8), p0 = (oc - sq * (LEN / 8)) * 8;
            const LAS unsigned* base = (const LAS unsigned*)(tile + ((sq * LP + p0) * 64) * 2) + cp;
            float i0[38], i1[38];
#pragma unroll
            for (int k = 0; k < 38; ++k) { const unsigned w = base[k * 32]; i0[k] = bflo(w); i1[k] = bfhi(w); }
            float a0[8], a1[8];
            { const float b0 = wl[31 * 64 + 2 * cp], b1 = wl[31 * 64 + 2 * cp + 1];
#pragma unroll
              for (int i = 0; i < 8; ++i) { a0[i] = b0; a1[i] = b1; } }
#pragma unroll
            for (int j = 0; j < 31; ++j) { typedef float f32x2 __attribute__((ext_vector_type(2))); const f32x2 wj = *(const LAS f32x2*)(wl + j * 64 + 2 * cp); const float w0 = wj[0], w1 = wj[1];
#pragma unroll
                for (int i = 0; i < 8; ++i) { a0[i] += w0 * i0[i + j]; a1[i] += w1 * i1[i + j]; } }
#pragma unroll
            for (int i = 0; i < 8; ++i) { const int tok = tok0 + sq * sstride + (p0 + i) * pstride;
                *(unsigned*)(mix + (size_t)tok * 1024 + 512 + ch0 + 2 * cp) = cvt_pk_bf16(a0[i], a1[i]); }
        }
        __syncthreads();
    }
}
__device__ __forceinline__ void phase_c1_ln(CP p, int l, int bid, int nb) {
    const int tid = launder_tid(); const int lane = tid & 63, wave = tid >> 6;
    bf16_t* mix = (bf16_t*)(p->ws + WS_HX);
    const f32x4 g0 = *(const f32x4*)(p->conv_ln_g + l * 512 + lane * 8), g1 = *(const f32x4*)(p->conv_ln_g + l * 512 + lane * 8 + 4);
    const f32x4 b0 = *(const f32x4*)(p->conv_ln_b + l * 512 + lane * 8), b1 = *(const f32x4*)(p->conv_ln_b + l * 512 + lane * 8 + 4);
    const float gg[8] = {g0[0], g0[1], g0[2], g0[3], g1[0], g1[1], g1[2], g1[3]}, bb[8] = {b0[0], b0[1], b0[2], b0[3], b1[0], b1[1], b1[2], b1[3]};
    u32x4 vn = {0u, 0u, 0u, 0u};
    if (bid * 8 + wave < R) vn = *(const u32x4*)(mix + (size_t)(bid * 8 + wave) * 1024 + 512 + lane * 8);
    for (int r = bid * 8 + wave; r < R; r += nb * 8) {
        u32x4* ptr = (u32x4*)(mix + (size_t)r * 1024 + 512 + lane * 8);
        const u32x4 v = vn;
        if (r + nb * 8 < R) vn = *(const u32x4*)(mix + (size_t)(r + nb * 8) * 1024 + 512 + lane * 8);
        float y[8] = {bflo(v.x), bfhi(v.x), bflo(v.y), bfhi(v.y), bflo(v.z), bfhi(v.z), bflo(v.w), bfhi(v.w)};
        float s = 0.f;
#pragma unroll
        for (int e = 0; e < 8; ++e) s += y[e];
        const float mu = wave_sum(s) * (1.f / 512.f);
        float q = 0.f;
#pragma unroll
        for (int e = 0; e < 8; ++e) { y[e] -= mu; q += y[e] * y[e]; }
        const float rstd = rsqrtf(wave_sum(q) * (1.f / 512.f) + 1e-5f);
        float o[8];
#pragma unroll
        for (int e = 0; e < 8; ++e) o[e] = siluf_(y[e] * rstd * gg[e] + bb[e]);
        *ptr = pack8(o);
    }
}
__device__ __forceinline__ void phase_s1(CP p, int l, unsigned char* lds_, int bid, int nb) {
    LAS unsigned char* lds = (LAS unsigned char*)lds_;
    LAS unsigned char* Bs = lds;
    LAS unsigned char* Xs = lds + 128 * ST_TR128;
    LAS float* wv = (LAS float*)(Xs + 128 * ST_X256);
    LAS float* hvs = wv + 8 * 128;
    LAS float* cwl = hvs + 4 * 520;
    const int tid = launder_tid(); const int lane = tid & 63, wave = __builtin_amdgcn_readfirstlane(tid >> 6);
    const bf16_t* proj = (const bf16_t*)(p->ws + WS_PROJ);
    const float* cw = p->ssd_conv_w + (size_t)l * 5 * 1024; const float* cbias = p->ssd_conv_b + (size_t)l * 1024;
    bf16_t* Sg = (bf16_t*)(p->ws + WS_S); float* DEC = (float*)(p->ws + WS_DEC);
    int cur_g = -1;
#pragma unroll 1
    for (int u = bid; u < NB * NCHUNK * 2; u += nb) {
        const int g = u & 1, c = (u >> 1) % NCHUNK, b = (u >> 1) / NCHUNK;
        const int row0 = b * SEG + c * 128;
        const bool lo_ok = !(c == 0 || c == 2), hi_ok = !(c == 1 || c == NCHUNK - 1);
        if (g != cur_g) { cur_g = g;
            float tw[5];
#pragma unroll
            for (int it = 0; it < 5; ++it) { const int i = tid + NTHREADS * it; const int j = i / 384, lc = i - j * 384; const int gch = lc < 128 ? 512 + g * 128 + lc : g * 256 + (lc - 128);
                tw[it] = i < 6 * 384 ? (j < 5 ? cw[j * 1024 + gch] : cbias[gch]) : 0.f; }
#pragma unroll
            for (int it = 0; it < 5; ++it) { const int i = tid + NTHREADS * it; if (i < 6 * 384) cwl[i] = tw[it]; } }
        const int hh = wave >> 1, dir = wave & 1, h = 4 * g + hh;
        u32x4 rb[8], rx0[8], rx1[8];
        conv_load(proj, row0, tid >> 4, 512 + g * 128 + (tid & 15) * 8, lo_ok, hi_ok, rb);
        conv_load(proj, row0, tid >> 5, g * 256 + (tid & 31) * 8, lo_ok, hi_ok, rx0);
        conv_load(proj, row0, (tid >> 5) + 16, g * 256 + (tid & 31) * 8, lo_ok, hi_ok, rx1);
        head_cums(p, l, row0, h, dir, lane, hvs + hh * 520);
        __syncthreads();
        {
            const LAS float* hv = hvs + hh * 520; const float tot = hv[512 + dir];
#pragma unroll
            for (int q = 0; q < 2; ++q) { const int lr = lane + 64 * q; wv[wave * 128 + lr] = __expf(tot - hv[dir * 128 + lr]) * hv[256 + dir * 128 + lr]; }
            if (lane == 0) DEC[((size_t)(b * 2 + dir) * NCHUNK + c) * 8 + h] = __expf(tot);
        }
        { float o[4][8];
          conv_compute(rb, cwl, 384, (tid & 15) * 8, o);
#pragma unroll
          for (int i = 0; i < 4; ++i) *(LAS u32x4*)(Bs + (4 * (tid >> 4) + i) * ST_TR128 + (tid & 15) * 16) = pack8(o[i]);
          conv_compute(rx0, cwl, 384, 128 + (tid & 31) * 8, o);
#pragma unroll
          for (int i = 0; i < 4; ++i) *(LAS u32x4*)(Xs + (4 * (tid >> 5) + i) * ST_X256 + (tid & 31) * 16) = pack8(o[i]);
          conv_compute(rx1, cwl, 384, 128 + (tid & 31) * 8, o);
#pragma unroll
          for (int i = 0; i < 4; ++i) *(LAS u32x4*)(Xs + (4 * ((tid >> 5) + 16) + i) * ST_X256 + (tid & 31) * 16) = pack8(o[i]); }
        __syncthreads();
        {
            f32x16 acc[2][4];
#pragma unroll
            for (int t = 0; t < 2; ++t)
#pragma unroll
                for (int q = 0; q < 4; ++q)
#pragma unroll
                    for (int e = 0; e < 16; ++e) acc[t][q][e] = 0.f;
#pragma unroll 2
            for (int kk = 0; kk < 8; ++kk) {
                const LAS float* wp = wv + wave * 128 + 16 * kk + 8 * (lane >> 5);
                const f32x4 w0 = *(const LAS f32x4*)wp, w1 = *(const LAS f32x4*)(wp + 4);
                bf16x8 af[2];
#pragma unroll
                for (int t = 0; t < 2; ++t) af[t] = scale_frag(tr_frag(Xs, ST_X256, 16 * kk, hh * 64 + 32 * t, lane), w0, w1);
#pragma unroll
                for (int q = 0; q < 4; ++q) { const bf16x8 bf = tr_frag(Bs, ST_TR128, 16 * kk, 32 * q, lane);
#pragma unroll
                    for (int t = 0; t < 2; ++t) acc[t][q] = __builtin_amdgcn_mfma_f32_32x32x16_bf16(bf, af[t], acc[t][q], 0, 0, 0); }
            }
            bf16_t* So = Sg + ((size_t)((b * 2 + dir) * NCHUNK + c) * 8 + h) * 8192 + (size_t)(lane & 31) * 128 + 4 * (lane >> 5);
#pragma unroll
            for (int t = 0; t < 2; ++t)
#pragma unroll
                for (int q = 0; q < 4; ++q)
#pragma unroll
                    for (int rg = 0; rg < 4; ++rg) { u32x2 pk; pk.x = cvt_pk_bf16(acc[t][q][4 * rg], acc[t][q][4 * rg + 1]); pk.y = cvt_pk_bf16(acc[t][q][4 * rg + 2], acc[t][q][4 * rg + 3]);
                        *(u32x2*)(So + (size_t)(32 * t) * 128 + 32 * q + 8 * rg) = pk; }
        }
        __syncthreads();
    }
}
__device__ __forceinline__ void phase_s2(CP p, int bid, int nb) {
    const int tid = launder_tid();
    const bf16_t* Sg = (const bf16_t*)(p->ws + WS_S); const float* DEC = (const float*)(p->ws + WS_DEC); bf16_t* HP = (bf16_t*)(p->ws + WS_HP);
    for (int idx = bid * NTHREADS + tid; idx < 2 * 2 * 8 * 64 * 64; idx += nb * NTHREADS) {
        const int n2 = idx & 63, pr = (idx >> 6) & 63, h = (idx >> 12) & 7, dir = (idx >> 15) & 1, b = idx >> 16;
        const size_t inner = (size_t)h * 8192 + pr * 128 + 2 * n2;
        const size_t cbase = (size_t)(b * 2 + dir) * NCHUNK;
        float s0 = 0.f, s1 = 0.f;
#pragma unroll 26
        for (int step = 0; step < NCHUNK; ++step) {
            const int c = dir == 0 ? step : (step < 2 ? 1 - step : NCHUNK + 1 - step);
            const size_t off = (cbase + c) * 65536 + inner;
            const unsigned sv = *(const unsigned*)(Sg + off); const float d = DEC[(cbase + c) * 8 + h];
            *(unsigned*)(HP + off) = cvt_pk_bf16(s0, s1);
            s0 = s0 * d + bflo(sv); s1 = s1 * d + bfhi(sv);
        }
    }
}
__device__ __forceinline__ void phase_s3(CP p, int l, unsigned char* lds_, int bid, int nb) {
    LAS unsigned char* lds = (LAS unsigned char*)lds_;
    LAS unsigned char* Cs = lds;
    LAS unsigned char* Bs = Cs + 128 * ST_ROW;
    LAS unsigned char* Mt = Bs;
    LAS unsigned char* Xs = Bs + 128 * ST_MT;
    LAS unsigned char* Hf = Xs + 128 * ST_TR64;
    LAS unsigned char* Hb = Hf + 64 * ST_ROW;
    LAS float* hvs = (LAS float*)(Hb + 64 * ST_ROW);
    LAS float* ssqp = hvs + 4 * 776;
    LAS float* cwl = ssqp + 256;
    const int tid0 = launder_tid(); const int wave = __builtin_amdgcn_readfirstlane(tid0 >> 6);
    const bf16_t* proj = (const bf16_t*)(p->ws + WS_PROJ); bf16_t* mix = (bf16_t*)(p->ws + WS_HX);
    const float* cw = p->ssd_conv_w + (size_t)l * 5 * 1024; const float* cbias = p->ssd_conv_b + (size_t)l * 1024;
    const bf16_t* HP = (const bf16_t*)(p->ws + WS_HP); float* SSQ = (float*)(p->ws + WS_SSQ);
    int cur_g = -1;
    const int cskip = (l == DEPTH - 1) ? 2 : 0, cpb = NCHUNK - cskip;
    const int nunits = NB * cpb * 2, nfull = nunits - nunits % nb, nitems = nfull + (nunits - nfull) * 4;
#pragma unroll 1
    for (int it = bid; it < nitems; it += nb) {
        const int u = it < nfull ? it : nfull + ((it - nfull) >> 2);
        const int hh_lo = it < nfull ? 0 : ((it - nfull) & 3), hh_hi = it < nfull ? 4 : hh_lo + 1;
        const int g = u & 1, c = cskip + (u >> 1) % cpb, b = (u >> 1) / cpb;
        int tid = tid0; asm volatile("" : "+v"(tid));
        const int lane = tid & 63;
        const int row0 = b * SEG + c * 128;
        const bool lo_ok = !(c == 0 || c == 2), hi_ok = !(c == 1 || c == NCHUNK - 1);
        if (g != cur_g) { cur_g = g;
            float tw[6];
#pragma unroll
            for (int it = 0; it < 6; ++it) { const int i = tid + NTHREADS * it; const int j = i >> 9, lc = i & 511; const int gch = lc < 128 ? 768 + g * 128 + lc : (lc < 256 ? 512 + g * 128 + (lc - 128) : g * 256 + (lc - 256));
                tw[it] = j < 5 ? cw[j * 1024 + gch] : cbias[gch]; }
#pragma unroll
            for (int it = 0; it < 6; ++it) cwl[tid + NTHREADS * it] = tw[it]; }
        u32x4 rx[8];
        {
            u32x4 r0[8], r1[8];
            const int cg = tid & 31; const int gch = (cg < 16 ? 768 : 512) + g * 128 + (cg & 15) * 8;
            conv_load(proj, row0, tid >> 5, gch, lo_ok, hi_ok, r0);
            conv_load(proj, row0, (tid >> 5) + 16, gch, lo_ok, hi_ok, r1);
            head_cums(p, l, row0, 4 * g + (wave >> 1), wave & 1, lane, hvs + (wave >> 1) * 776);
            { LAS float* hvw = hvs + (wave >> 1) * 776; const int dr = wave & 1;
              hvw[520 + dr * 128 + 2 * lane] = __expf(hvw[dr * 128 + 2 * lane]); hvw[520 + dr * 128 + 2 * lane + 1] = __expf(hvw[dr * 128 + 2 * lane + 1]); }
            __syncthreads();
            float o[4][8];
            LAS unsigned char* dst = (cg < 16 ? Cs : Bs) + (cg & 15) * 16;
            conv_compute(r0, cwl, 512, cg * 8, o);
#pragma unroll
            for (int i = 0; i < 4; ++i) *(LAS u32x4*)(dst + (4 * (tid >> 5) + i) * ST_ROW) = pack8(o[i]);
            asm volatile("" ::: "memory");
            if (tid < 256) conv_load(proj, row0, tid >> 3, g * 256 + hh_lo * 64 + (tid & 7) * 8, lo_ok, hi_ok, rx);
            conv_compute(r1, cwl, 512, cg * 8, o);
#pragma unroll
            for (int i = 0; i < 4; ++i) *(LAS u32x4*)(dst + (4 * ((tid >> 5) + 16) + i) * ST_ROW) = pack8(o[i]);
            if (tid < 256) { conv_compute(rx, cwl, 512, 256 + hh_lo * 64 + (tid & 7) * 8, o);
#pragma unroll
                for (int i = 0; i < 4; ++i) *(LAS u32x4*)(Xs + (4 * (tid >> 3) + i) * ST_TR64 + (tid & 7) * 16) = pack8(o[i]); }
        }
        __syncthreads();
        const int lb = wave >> 1, hs = wave & 1;
        int ln = lane; asm volatile("" : "+v"(ln));
        f32x16 gacc[2];
#pragma unroll
        for (int t = 0; t < 2; ++t)
#pragma unroll
            for (int e = 0; e < 16; ++e) gacc[t][e] = 0.f;
#pragma unroll
        for (int kk = 0; kk < 8; ++kk) { const bf16x8 af = row_frag(Cs, ST_ROW, 32 * lb, 16 * kk, lane);
#pragma unroll
            for (int t = 0; t < 2; ++t) { const bf16x8 bf = row_frag(Bs, ST_ROW, 64 * hs + 32 * t, 16 * kk, lane);
                gacc[t] = __builtin_amdgcn_mfma_f32_32x32x16_bf16(af, bf, gacc[t], 0, 0, 0); } }
        u32x4 hreg[4];
        { const bf16_t* hp0 = HP + ((size_t)(b * 2 * NCHUNK + c) * 8 + 4 * g + hh_lo) * 8192;
#pragma unroll
          for (int q = 0; q < 4; ++q) { const int it = tid + 512 * q; hreg[q] = *(const u32x4*)(hp0 + (size_t)(it >> 10) * NCHUNK * 8 * 8192 + (it & 1023) * 8); } }
        __syncthreads();
#pragma unroll 1
        for (int hh = hh_lo; hh < hh_hi; ++hh) {
            const int h = 4 * g + hh; const LAS float* hv = hvs + hh * 776;
            asm volatile("" : "+v"(ln));
            const int ph = hs, pc = 32 * ph + (ln & 31);
#pragma unroll
            for (int t = 0; t < 2; ++t) {
                const int st = 2 * hs + t;
                const int sc = 32 * st + (ln & 31);
                const float cfs = hv[sc], cbs = hv[128 + sc], dfs = hv[256 + sc], dbs = hv[384 + sc];
#pragma unroll
                for (int rg = 0; rg < 4; ++rg) {
                    const int l0 = 32 * lb + 8 * rg + 4 * (ln >> 5);
                    float m[4];
                    if (st < lb) {
                        const f32x4 cfl = *(const LAS f32x4*)(hv + l0);
#pragma unroll
                        for (int e = 0; e < 4; ++e) m[e] = gacc[t][4 * rg + e] * (__expf(cfl[e] - cfs) * dfs);
                    } else if (st > lb) {
                        const f32x4 cbl = *(const LAS f32x4*)(hv + 128 + l0);
#pragma unroll
                        for (int e = 0; e < 4; ++e) m[e] = gacc[t][4 * rg + e] * (__expf(cbl[e] - cbs) * dbs);
                    } else {
                        const f32x4 cfl = *(const LAS f32x4*)(hv + l0), cbl = *(const LAS f32x4*)(hv + 128 + l0);
#pragma unroll
                        for (int e = 0; e < 4; ++e) { const int lr = l0 + e;
                            const float ff = lr >= sc ? __expf(cfl[e] - cfs) * dfs : 0.f;
                            const float fb = lr <= sc ? __expf(cbl[e] - cbs) * dbs : 0.f;
                            m[e] = gacc[t][4 * rg + e] * (ff + fb); }
                    }
                    u32x2 pk; pk.x = cvt_pk_bf16(m[0], m[1]); pk.y = cvt_pk_bf16(m[2], m[3]);
                    *(LAS u32x2*)(Mt + sc * ST_MT + l0 * 2) = pk;
                }
            }
#pragma unroll
            for (int q = 0; q < 4; ++q) { const int it = tid + 512 * q; const int q2 = it & 1023;
                *(LAS u32x4*)(((it >> 10) ? Hb : Hf) + (q2 >> 4) * ST_ROW + (q2 & 15) * 16) = hreg[q]; }
            if (hh + 1 < hh_hi) {
                const bf16_t* hp0 = HP + ((size_t)(b * 2 * NCHUNK + c) * 8 + h + 1) * 8192;
#pragma unroll
                for (int q = 0; q < 4; ++q) { const int it = tid + 512 * q; hreg[q] = *(const u32x4*)(hp0 + (size_t)(it >> 10) * NCHUNK * 8 * 8192 + (it & 1023) * 8); }
                if (tid < 256) conv_load(proj, row0, tid >> 3, g * 256 + (hh + 1) * 64 + (tid & 7) * 8, lo_ok, hi_ok, rx);
            }
            unsigned zraw[8];
#pragma unroll
            for (int ri = 0; ri < 16; ri += 2) { const int lr = 32 * lb + 8 * (ri >> 2) + 4 * (ln >> 5) + (ri & 3);
                const bf16_t* zp = proj + (size_t)(row0 + lr) * NPROJ + 1024 + h * 64 + pc;
                zraw[ri >> 1] = (unsigned)zp[0] | ((unsigned)zp[NPROJ] << 16); }
            __syncthreads();
            f32x16 ad, af_, ab_;
#pragma unroll
            for (int e = 0; e < 16; ++e) { ad[e] = 0.f; af_[e] = 0.f; ab_[e] = 0.f; }
#pragma unroll
            for (int kk = 0; kk < 8; ++kk) {
                const bf16x8 am = tr_frag(Mt, ST_MT, 16 * kk, 32 * lb, lane);
                const bf16x8 bx = tr_frag(Xs, ST_TR64, 16 * kk, 32 * ph, lane);
                ad = __builtin_amdgcn_mfma_f32_32x32x16_bf16(am, bx, ad, 0, 0, 0);
                const bf16x8 ac = row_frag(Cs, ST_ROW, 32 * lb, 16 * kk, lane);
                const bf16x8 bhf = row_frag(Hf, ST_ROW, 32 * ph, 16 * kk, lane);
                const bf16x8 bhb = row_frag(Hb, ST_ROW, 32 * ph, 16 * kk, lane);
                af_ = __builtin_amdgcn_mfma_f32_32x32x16_bf16(ac, bhf, af_, 0, 0, 0);
                ab_ = __builtin_amdgcn_mfma_f32_32x32x16_bf16(ac, bhb, ab_, 0, 0, 0);
            }
            const float dsk = p->d_skip[l * 8 + h];
#pragma unroll
            for (int rg = 0; rg < 4; ++rg) {
                const int l0 = 32 * lb + 8 * rg + 4 * (ln >> 5);
                const f32x4 efl = *(const LAS f32x4*)(hv + 520 + l0), ebl = *(const LAS f32x4*)(hv + 648 + l0);
#pragma unroll
                for (int e = 0; e < 4; ++e) { const int lr = l0 + e; const int ri = 4 * rg + e;
                    const float xs = bf2f(*(const LAS bf16_t*)(Xs + lr * ST_TR64 + pc * 2));
                    const float y = ad[ri] + efl[e] * af_[ri] + ebl[e] * ab_[ri] + dsk * xs;
                    const float z = (ri & 1) ? bfhi(zraw[ri >> 1]) : bflo(zraw[ri >> 1]);
                    const float val = y * z;
                    mix[(size_t)(row0 + lr) * 1024 + h * 64 + pc] = f2bf(val);
                    const float sq = half_sum32(val * val);
                    if ((ln & 31) == 31) ssqp[ph * 128 + lr] = sq;
                }
            }
            __syncthreads();
            if (tid < 128) SSQ[(size_t)(row0 + tid) * 8 + h] = ssqp[tid] + ssqp[128 + tid];
            if (hh + 1 < hh_hi && tid < 256) { float o[4][8];
                conv_compute(rx, cwl, 512, 256 + (hh + 1) * 64 + (tid & 7) * 8, o);
#pragma unroll
                for (int i = 0; i < 4; ++i) *(LAS u32x4*)(Xs + (4 * (tid >> 3) + i) * ST_TR64 + (tid & 7) * 16) = pack8(o[i]); }
        }
        __syncthreads();
    }
}
__device__ __forceinline__ void phase_r2(CP p, int l, unsigned char* lds_, int bid, int nb) {
    LAS unsigned char* lds = (LAS unsigned char*)lds_;
    LAS unsigned char* Wh = lds;
    LAS unsigned char* Xh = Wh + 32 * ST_H16;
    LAS float* gm = (LAS float*)(Xh + 16 * ST_H16);
    LAS float* sh = gm + 3 * 1024;
    LAS float* part = sh + 3 * 1024;
    LAS float* lgs = part + 8 * 16 * 32;
    LAS int* lcnt = (LAS int*)(lgs + 16 * 32);
    LAS int* lcls = lcnt + 64;
    LAS int* lrank = lcls + 512;
    LAS float* lcwa = (LAS float*)(lrank + 512);
    LAS float* lcwb = lcwa + 512;
    const int tid = launder_tid(); const int lane = tid & 63, wave = __builtin_amdgcn_readfirstlane(tid >> 6);
    const float* mod = (const float*)(p->ws + WS_MOD) + (size_t)l * 3 * 6144;
    {
        float tmp[8];
#pragma unroll
        for (int it = 0; it < 8; ++it) tmp[it] = p->w_rg[(size_t)l * 4096 + tid + NTHREADS * it];
#pragma unroll
        for (int it = 0; it < 8; ++it) { const int idx = tid + NTHREADS * it; *(LAS _Float16*)(Wh + (idx & 3) * ST_H16 + (idx >> 2) * 2) = (_Float16)tmp[it]; } }
#pragma unroll
    for (int hb = 0; hb < 2; ++hb) { float tmp[16];
#pragma unroll
        for (int it = 0; it < 16; ++it) tmp[it] = p->w_re[(size_t)l * 16384 + tid + NTHREADS * (16 * hb + it)];
#pragma unroll
        for (int it = 0; it < 16; ++it) { const int idx = tid + NTHREADS * (16 * hb + it); *(LAS _Float16*)(Wh + (4 + (idx & 15)) * ST_H16 + (idx >> 4) * 2) = (_Float16)tmp[it]; } }
    { unsigned zz; asm volatile("v_mov_b32 %0, 0" : "=v"(zz));
      for (int i = tid; i < 12 * 128; i += NTHREADS) { const int rw = 20 + i / 128, c16 = i % 128; *(LAS u32x4*)(Wh + rw * ST_H16 + c16 * 16) = (u32x4){zz, zz, zz, zz}; } }
    { float t0[6], t1[6], t2[6];
#pragma unroll
      for (int it = 0; it < 6; ++it) { const int idx = tid + NTHREADS * it; const int v = idx >> 10, k = idx & 1023; t0[it] = p->g_ffn[l * 1024 + k]; t1[it] = mod[v * 6144 + 4 * 1024 + k]; t2[it] = mod[v * 6144 + 3 * 1024 + k]; }
#pragma unroll
      for (int it = 0; it < 6; ++it) { const int idx = tid + NTHREADS * it; gm[idx] = t0[it] * (1.f + t1[it]); sh[idx] = t2[it]; } }
    if (tid < 64) lcnt[tid] = 0;
    __syncthreads();
    bf16_t* HM = (bf16_t*)(p->ws + WS_HX); float* CWLA = (float*)(p->ws + WS_CWLA); float* CWLB = (float*)(p->ws + WS_CWLB);
    int* gcount = (int*)(p->ws + WS_CTL) + l * 32; int* LIST = (int*)(p->ws + WS_LIST);
    const int rpb = (R + nb - 1) / nb, r0 = bid * rpb, r1 = (r0 + rpb) < R ? (r0 + rpb) : R;
    RowRaw xn[2];
#pragma unroll
    for (int q = 0; q < 2; ++q) if (r0 + 2 * wave + q < r1) row_load(p, 1, r0 + 2 * wave + q, lane, xn[q]);
#pragma unroll 1
    for (int t0r = r0; t0r < r1; t0r += 16) {
        f32x4 xv[2][4];
#pragma unroll
        for (int q = 0; q < 2; ++q) row_cvt(1, xn[q], xv[q]);
#pragma unroll
        for (int q = 0; q < 2; ++q) if (t0r + 16 + 2 * wave + q < r1) row_load(p, 1, t0r + 16 + 2 * wave + q, lane, xn[q]);
#pragma unroll
        for (int q = 0; q < 2; ++q) { const int rr = t0r + 2 * wave + q; const bool ok = rr < r1; const int v = row_v(ok ? rr : r0);
            float ss = 0.f;
#pragma unroll
            for (int j = 0; j < 4; ++j) ss += xv[q][j][0] * xv[q][j][0] + xv[q][j][1] * xv[q][j][1] + xv[q][j][2] * xv[q][j][2] + xv[q][j][3] * xv[q][j][3];
            ss = wave_sum(ss); const float rs = ok ? rsqrtf(ss * (1.f / 1024.f) + 1e-6f) : 0.f;
#pragma unroll
            for (int j = 0; j < 4; ++j) { const int k = 4 * lane + 256 * j; const f32x4 g4 = *(const LAS f32x4*)(gm + v * 1024 + k), s4 = *(const LAS f32x4*)(sh + v * 1024 + k);
                f32x4 hv = xv[q][j] * rs * g4 + s4; if (!ok) hv = hv * 0.f;
                u32x2 o; o.x = cvt_pk_bf16(hv[0], hv[1]); o.y = cvt_pk_bf16(hv[2], hv[3]);
                if (ok) *(u32x2*)(HM + (size_t)rr * 1024 + k) = o;
                u32x2 h16; h16.x = pack_f16(hv[0], hv[1]); h16.y = pack_f16(hv[2], hv[3]);
                *(LAS u32x2*)(Xh + (2 * wave + q) * ST_H16 + k * 2) = h16; } }
        __syncthreads();
        {
            f32x4 acc0 = {0.f, 0.f, 0.f, 0.f}, acc1 = {0.f, 0.f, 0.f, 0.f};
#pragma unroll
            for (int s4 = 0; s4 < 4; ++s4) { const int kb = (128 * wave + 32 * s4 + 8 * (lane >> 4)) * 2;
                const f16x8 a = *(const LAS f16x8*)(Xh + (lane & 15) * ST_H16 + kb);
                const f16x8 b0 = *(const LAS f16x8*)(Wh + (lane & 15) * ST_H16 + kb), b1 = *(const LAS f16x8*)(Wh + (16 + (lane & 15)) * ST_H16 + kb);
                acc0 = __builtin_amdgcn_mfma_f32_16x16x32_f16(a, b0, acc0, 0, 0, 0);
                acc1 = __builtin_amdgcn_mfma_f32_16x16x32_f16(a, b1, acc1, 0, 0, 0); }
#pragma unroll
            for (int e = 0; e < 4; ++e) { const int row = 4 * (lane >> 4) + e; part[(wave * 16 + row) * 32 + (lane & 15)] = acc0[e]; part[(wave * 16 + row) * 32 + 16 + (lane & 15)] = acc1[e]; }
        }
        __syncthreads();
        if (tid < 320) { const int row = tid / 20, n = tid - row * 20; float sacc = n < 4 ? p->b_rg[l * 4 + n] : p->b_re[l * 16 + n - 4];
#pragma unroll
            for (int w = 0; w < 8; ++w) sacc += part[(w * 16 + row) * 32 + n];
            lgs[row * 32 + n] = sacc; }
        __syncthreads();
        if (tid < 16) { const int rr = t0r + tid;
            if (rr < r1) {
                if (l == DEPTH - 1 && row_v(rr) == 2) lcls[rr - r0] = -1;
                else {
                    float lg[20];
#pragma unroll
                    for (int n = 0; n < 20; ++n) lg[n] = lgs[tid * 32 + n];
                    int gsel = 0; float gmax = lg[0];
#pragma unroll
                    for (int t = 1; t < 4; ++t) if (lg[t] > gmax) { gmax = lg[t]; gsel = t; }
                    float gden = 0.f;
#pragma unroll
                    for (int t = 0; t < 4; ++t) gden += __expf(lg[t] - gmax);
                    const float gprob = 1.f / gden;
                    float el[4];
#pragma unroll
                    for (int t = 0; t < 4; ++t) el[t] = gsel == 0 ? lg[4 + t] : (gsel == 1 ? lg[8 + t] : (gsel == 2 ? lg[12 + t] : lg[16 + t]));
                    int i0 = 0; float m0 = el[0];
#pragma unroll
                    for (int t = 1; t < 4; ++t) if (el[t] > m0) { m0 = el[t]; i0 = t; }
                    int i1 = -1; float m1 = -3.0e38f;
#pragma unroll
                    for (int t = 0; t < 4; ++t) if (t != i0 && el[t] > m1) { m1 = el[t]; i1 = t; }
                    const float w0 = gprob / (1.f + __expf(m1 - m0)), w1 = gprob - w0;
                    const int ea = i0 < i1 ? i0 : i1, eb = i0 < i1 ? i1 : i0;
                    const float cwa = i0 < i1 ? w0 : w1, cwb = i0 < i1 ? w1 : w0;
                    const int pidx = ea == 0 ? eb - 1 : (ea == 1 ? eb + 1 : 5);
                    const int cls = gsel * 6 + pidx;
                    const int rank = __hip_atomic_fetch_add(&lcnt[cls], 1, __ATOMIC_RELAXED, __HIP_MEMORY_SCOPE_WORKGROUP);
                    lcls[rr - r0] = cls; lrank[rr - r0] = rank; lcwa[rr - r0] = cwa; lcwb[rr - r0] = cwb;
                } } }
    }
    __syncthreads();
    if (tid < NCLS) lcnt[32 + tid] = atomicAdd(&gcount[tid], lcnt[tid]);
    __syncthreads();
    for (int idx = tid; idx < r1 - r0; idx += NTHREADS) { const int cl = lcls[idx]; if (cl < 0) continue; const int pos = lcnt[32 + cl] + lrank[idx]; const size_t li = (size_t)cl * R + pos;
        LIST[li] = r0 + idx; CWLA[li] = lcwa[idx]; CWLB[li] = lcwb[idx]; }
    __syncthreads();
}
__device__ __forceinline__ void phase_final(CP p, unsigned char* lds, int bid, int nb) {
    const int tid = launder_tid(); const int lane = tid & 63, wave = tid >> 6;
    const int qstep = nb * 8;
    RowRaw xn;
    { const int q = bid * 8 + wave; if (q < NB * SEQ) { const int b = q >= SEQ ? 1 : 0; row_load(p, 1, b * SEG + CTXL + (q - b * SEQ), lane, xn); } }
    for (int q = bid * 8 + wave; q < NB * SEQ; q += qstep) {
        f32x4* hr = (f32x4*)(p->out + (size_t)q * D);
        f32x4 xv[4]; float ss = 0.f;
        row_cvt(1, xn, xv);
        { const int qn = q + qstep; if (qn < NB * SEQ) { const int bn = qn >= SEQ ? 1 : 0; row_load(p, 1, bn * SEG + CTXL + (qn - bn * SEQ), lane, xn); } }
#pragma unroll
        for (int j = 0; j < 4; ++j) ss += xv[j][0] * xv[j][0] + xv[j][1] * xv[j][1] + xv[j][2] * xv[j][2] + xv[j][3] * xv[j][3];
        ss = wave_sum(ss); const float rs = rsqrtf(ss * (1.f / 1024.f) + 1e-6f);
#pragma unroll
        for (int j = 0; j < 4; ++j) { const f32x4 g4 = *(const f32x4*)(p->g_final + 4 * lane + 256 * j); hr[lane + 64 * j] = xv[j] * rs * g4; }
    }
}


#define XB_TMO      128
#define XB_XCNT(j)  (256  + 64 * (j))
#define XB_XSUB(j)  (1280 + 64 * (j))
#define XB_XGEN(j)  (2304 + 64 * (j))
#define XB_TOP      3328
#define XB_TOPGEN   3392
#define XCD_BAR_WORDS 3456
#define XB_SPIN_CAP (1u << 22)
__device__ __forceinline__ unsigned xb_ld(unsigned* p) { return __hip_atomic_load(p, __ATOMIC_RELAXED, __HIP_MEMORY_SCOPE_AGENT); }
__device__ __forceinline__ unsigned xb_add(unsigned* p, unsigned v) { return __hip_atomic_fetch_add(p, v, __ATOMIC_RELAXED, __HIP_MEMORY_SCOPE_AGENT); }
__device__ __forceinline__ unsigned xb_xcc_id() { return (unsigned)__builtin_amdgcn_s_getreg((3 << 11) | 20) & 0xFu; }
#define XB_SPIN(cond, bar) do { unsigned _sp = 0; while (cond) { __builtin_amdgcn_s_sleep(1); \
    if ((++_sp & 255u) == 0u) { if (xb_ld(&(bar)[XB_TMO])) break; if (_sp > XB_SPIN_CAP) { atomicAdd(&(bar)[XB_TMO], 1u); break; } } } } while (0)
struct XcdBarrier { unsigned* bar; unsigned x; volatile LAS unsigned* st; };
__device__ __forceinline__ XcdBarrier xcd_barrier_post(unsigned* bar, volatile LAS unsigned* st) {
    XcdBarrier b; b.bar = bar; b.x = xb_xcc_id(); b.st = st;
    if (threadIdx.x == 0) (void)xb_add(&bar[XB_XCNT(b.x)], 1u);
    return b;
}
__device__ __forceinline__ void xcd_barrier_complete(unsigned* bar, unsigned x, unsigned& nloc, unsigned& nx) {
    const unsigned G = gridDim.x * gridDim.y * gridDim.z;
    unsigned sum, cnt, mine, sp = 0u;
    for (;;) {
        sum = 0u; cnt = 0u; mine = 0u;
#pragma unroll
        for (unsigned j = 0; j < 16; ++j) { const unsigned c = xb_ld(&bar[XB_XCNT(j)]); sum += c; cnt += (c > 0u) ? 1u : 0u; mine = (j == x) ? c : mine; }
        if (sum == G) break;
        __builtin_amdgcn_s_sleep(1);
        if ((++sp & 255u) == 0u) { if (xb_ld(&bar[XB_TMO])) break; if (sp > XB_SPIN_CAP) { atomicAdd(&bar[XB_TMO], 1u); break; } }
    }
    nloc = mine > 0u ? mine : 1u; nx = cnt > 0u ? cnt : 1u;
}
__device__ __forceinline__ void xcd_barrier(const XcdBarrier& b) {
    asm volatile("s_waitcnt vmcnt(0)" ::: "memory");
    __syncthreads();
    if (threadIdx.x == 0) {
        unsigned* bar = b.bar;
        __builtin_amdgcn_s_waitcnt(0);
        unsigned nloc = b.st[0], nx = b.st[1];
        if (nloc == 0u) { xcd_barrier_complete(bar, b.x, nloc, nx); b.st[0] = nloc; b.st[1] = nx; }
        const unsigned old = xb_add(&bar[XB_XSUB(b.x)], 1u);
        const unsigned gen = old / nloc;
        if (old + 1u == (gen + 1u) * nloc) {
            __builtin_amdgcn_fence(__ATOMIC_RELEASE, "agent");
            asm volatile("s_waitcnt vmcnt(0)" ::: "memory");
            const unsigned og = xb_add(&bar[XB_TOP], 1u);
            const unsigned tg = og / nx;
            if (og + 1u == (tg + 1u) * nx) xb_add(&bar[XB_TOPGEN], 1u);
            else XB_SPIN(xb_ld(&bar[XB_TOPGEN]) == tg, bar);
            __builtin_amdgcn_fence(__ATOMIC_ACQUIRE, "agent");
            xb_add(&bar[XB_XGEN(b.x)], 1u);
            asm volatile("s_waitcnt vmcnt(0)" ::: "memory");
        } else {
            XB_SPIN(xb_ld(&bar[XB_XGEN(b.x)]) == gen, bar);
            __builtin_amdgcn_fence(__ATOMIC_ACQUIRE, "agent");
            asm volatile("s_waitcnt vmcnt(0)" ::: "memory");
        }
    }
    __syncthreads();
}

#ifndef TIMING_A
#define TIMING_A -1
#endif
#ifndef TIMING_B
#define TIMING_B -1
#endif
#ifndef PHASE_MASK
#define PHASE_MASK 0xFFFFF
#endif
#define PM(i) ((PHASE_MASK >> (i)) & 1)
#ifndef REPEAT_MASK
#define REPEAT_MASK 0
#endif
#define RP(i) for (int rep_ = 0; rep_ < 1 + ((REPEAT_MASK >> (i)) & 1); ++rep_)
constexpr int PH_PER_LAYER = 9, NPHASES = 1 + DEPTH * PH_PER_LAYER + 1;
__global__ void __launch_bounds__(NTHREADS, 2) mk_fwd(Args args) {
    extern __shared__ __attribute__((aligned(16))) unsigned char lds[];
    cg::grid_group grid = cg::this_grid();
    const __attribute__((address_space(4))) Args* ap = (const __attribute__((address_space(4))) Args*)__builtin_amdgcn_kernarg_segment_ptr();
    const int lo = ap->lo, hi = ap->hi;
    LAS unsigned char* ldsl = (LAS unsigned char*)lds;
    volatile LAS unsigned* xbst = (volatile LAS unsigned*)(ldsl + LDS_BYTES - 16);
    if (threadIdx.x < 4) xbst[threadIdx.x] = 0u;
    __syncthreads();
    (void)xcd_barrier_post((unsigned*)(ap->p.ws + WS_BAR), xbst);
    if (TIMING_A >= 0 && blockIdx.x == 0 && threadIdx.x == 0) ((unsigned long long*)(ap->p.ws + WS_TS))[lo] = __builtin_amdgcn_s_memrealtime();
    for (int ph = lo; ph < hi; ++ph) {
        CP p = launder(&ap->p);
        int bid = blockIdx.x, nb = gridDim.x; asm volatile("" : "+s"(bid), "+s"(nb));
        if (ph == 0) { if (PM(0)) RP(0) phase_wprep(p, lds, 0, WPREP_ITEMS_PER_LAYER, bid, nb); if (PM(1)) RP(1) phase_adaln(p, lds, bid, nb); }
        else if (ph == NPHASES - 1) { if (PM(12)) phase_final(p, lds, bid, nb); }
        else {
            const int l = (ph - 1) / PH_PER_LAYER, s = (ph - 1) % PH_PER_LAYER;
            if (s == 0) { if (PM(2)) RP(2) { if (rep_ == 0 || l == 0) phase_r1(p, l, lds, bid, nb); } }
            else if (s == 1) { if (PM(3)) RP(3) {
                pg8::DenseSched S; S.init(p->ws + WS_HX, (const bf16_t*)(p->ws + WS_WTIN) + (size_t)l * DIN * 1024, R, NPROJ, 1024, 1024, 1024, nb, bid);
                EpiProj E{(bf16_t*)(p->ws + WS_PROJ)};
                pg8::gemm_phase<EpiProj, pg8::DenseSched, false>(ldsl, 1024, 1024, 1024, S, E);
                if (l == 0 && DEPTH > 1) { const int extra = S.nwg % nb;
                    if (extra > 0 && bid >= extra) phase_wprep(p, lds, WPREP_ITEMS_PER_LAYER, WPREP_ITEMS_PER_LAYER + 1800, bid - extra, nb - extra);
                    else if (extra == 0) phase_wprep(p, lds, WPREP_ITEMS_PER_LAYER, WPREP_ITEMS_PER_LAYER + 1800, bid, nb); }
            } }
            else if (s == 2) { if (PM(4)) RP(4) phase_c1(p, l, lds, bid, nb); if (PM(5)) RP(5) phase_s1(p, l, lds, bid, nb); }
            else if (s == 3) { if (PM(6)) RP(6) phase_s2(p, bid, nb); }
            else if (s == 4) { if (PM(7)) RP(7) phase_s3(p, l, lds, bid, nb);
                if (PM(4)) {
                    const int cpb = NCHUNK - ((l == DEPTH - 1) ? 2 : 0), nunits = NB * cpb * 2, tail = (nunits % nb) * 4;
                    if (tail > 0 && tail < nb) { if (bid >= tail) phase_c1_ln(p, l, bid - tail, nb - tail); } else phase_c1_ln(p, l, bid, nb); } }
            else if (s == 5) { if (PM(8)) RP(8) { if (rep_ == 0 || l == 0) {
                pg8::DenseSched S; S.init(p->ws + WS_HX, (const bf16_t*)(p->ws + WS_WTOUT) + (size_t)l * 1024 * 1024, R, 1024, 1024, 1024, 1024, nb, bid, l == DEPTH - 1);
                EpiResid<0> E{p->ctx, p->x, (bf16_t*)(p->ws + WS_H), (const float*)(p->ws + WS_MOD) + (size_t)l * 3 * 6144, (const float*)(p->ws + WS_SSQ)};
                pg8::gemm_phase<EpiResid<0>, pg8::DenseSched, false>(ldsl, 1024, 1024, 1024, S, E);
                if (l == 0 && DEPTH > 1 && rep_ == 0) { const int extra = S.nwg % nb;
                    if (extra > 0 && bid >= extra) phase_wprep(p, lds, WPREP_ITEMS_PER_LAYER + 1800, 2 * WPREP_ITEMS_PER_LAYER, bid - extra, nb - extra);
                    else if (extra == 0) phase_wprep(p, lds, WPREP_ITEMS_PER_LAYER + 1800, 2 * WPREP_ITEMS_PER_LAYER, bid, nb); }
            } } }
            else if (s == 6) { if (PM(9)) phase_r2(p, l, lds, bid, nb); }
            else if (s == 7) { if (PM(10)) {
                LAS int* tab = (LAS int*)(ldsl + MISC_OFF); moe_table(p, l, tab);
                unsigned* ready = (unsigned*)(p->ws + WS_M1CNT) + l * 192;
                { MoeSched S{tab, (const int*)(p->ws + WS_LIST), (const char*)(p->ws + WS_HX), (const char*)(p->ws + WS_WTGU), 0, l, nb, bid, ready, 0};
                  EpiUp E{(bf16_t*)(p->ws + WS_HID), (const float*)(p->ws + WS_CWLA), (const float*)(p->ws + WS_CWLB), ready};
                  pg8::gemm_phase<EpiUp, MoeSched, true>(ldsl, 1024, 1024, 1024, S, E); }
                { const int total = __builtin_amdgcn_readfirstlane(tab[24]) * 4; const int extra = __builtin_amdgcn_readfirstlane(total % nb);
                  MoeSched S{tab, (const int*)(p->ws + WS_LIST), (const char*)(p->ws + WS_HID), (const char*)(p->ws + WS_WTD), 1, l, nb, bid, ready, (total >= nb && total - extra >= nb) ? extra : 0};
                  EpiDown E{(bf16_t*)(p->ws + WS_H), (const int*)(p->ws + WS_LIST), (const float*)(p->ws + WS_MOD) + (size_t)l * 3 * 6144 + 5 * 1024};
                  pg8::gemm_phase<EpiDown, MoeSched, false>(ldsl, 512, 256, 512, S, E); }
            } }
            else { }
        }
        if (ph + 1 < hi && !(ph > 0 && ph < NPHASES - 1 && (ph - 1) % PH_PER_LAYER == 7)) { if (hi < 0) grid.sync();   else { XcdBarrier xb; xb.bar = (unsigned*)(launder(&ap->p)->ws + WS_BAR); xb.x = xb_xcc_id(); xb.st = (volatile LAS unsigned*)(ldsl + LDS_BYTES - 16); xcd_barrier(xb); }
            if (TIMING_A >= 0 && blockIdx.x == 0 && threadIdx.x == 0) ((unsigned long long*)(launder(&ap->p)->ws + WS_TS))[ph + 1] = __builtin_amdgcn_s_memrealtime(); }
    }
#if TIMING_A >= 0
    {
        XcdBarrier xb; xb.bar = (unsigned*)(launder(&ap->p)->ws + WS_BAR); xb.x = xb_xcc_id(); xb.st = (volatile LAS unsigned*)(ldsl + LDS_BYTES - 16); xcd_barrier(xb);
        if (blockIdx.x == 0 && threadIdx.x == 0) ((unsigned long long*)(launder(&ap->p)->ws + WS_TS))[hi] = __builtin_amdgcn_s_memrealtime();
        xcd_barrier(xb);
        const unsigned long long* ts = (const unsigned long long*)(launder(&ap->p)->ws + WS_TS);
        const float ta = (float)(ts[TIMING_A + 1] - ts[TIMING_A]) * 0.01f, tb = (float)(ts[TIMING_B + 1] - ts[TIMING_B]) * 0.01f;
        float* o = launder(&ap->p)->out; const float sc = 1.f + ta * 0.001f;
        for (size_t i = (size_t)blockIdx.x * NTHREADS + threadIdx.x; i < (size_t)NB * SEQ * D; i += (size_t)gridDim.x * NTHREADS) o[i] = o[i] * sc + (i == 0 ? tb * 0.1f : 0.f);
    }
#endif
}

extern "C" void kernel_launch(void* const* d_in, const int* in_sizes, int n_in, void* d_out, int out_size, void* d_ws, size_t ws_size, hipStream_t stream) {
    static int grid = 0;
    if (grid == 0) {
        if (n_in != 28 || ws_size < WS_END) { fprintf(stderr, "kernel_launch: unexpected n_in %d or ws_size %zu (< %zu)\n", n_in, ws_size, (size_t)WS_END); grid = -1; return; }
        int dev = 0, cus = 0, per_cu = 0;
        hipGetDevice(&dev); hipDeviceGetAttribute(&cus, hipDeviceAttributeMultiprocessorCount, dev);
        if (hipFuncSetAttribute((const void*)mk_fwd, hipFuncAttributeMaxDynamicSharedMemorySize, LDS_BYTES) != hipSuccess) { fprintf(stderr, "kernel_launch: hipFuncSetAttribute failed\n"); grid = -1; return; }
        if (hipOccupancyMaxActiveBlocksPerMultiprocessor(&per_cu, (const void*)mk_fwd, NTHREADS, LDS_BYTES) != hipSuccess || per_cu < 1) { fprintf(stderr, "kernel_launch: occupancy query says %d\n", per_cu); (void)hipGetLastError(); grid = -1; return; }
        grid = cus;
    }
    if (grid < 0) return;
    (void)hipMemsetAsync((char*)d_ws + WS_CTL, 0, WS_CTL_BYTES, stream);
    Args a{};
    const float** pp = (const float**)&a.p;
    for (int i = 0; i < 28; ++i) pp[i] = (const float*)d_in[i];
    a.p.out = (float*)d_out; a.p.ws = (unsigned char*)d_ws;
#if PER_PHASE_LAUNCH
    for (int ph = 0; ph < NPHASES; ++ph) {
        a.lo = ph; a.hi = ph + 1; void* kargs[] = {&a};
        hipError_t e = hipLaunchCooperativeKernel((const void*)mk_fwd, dim3(grid), dim3(NTHREADS), kargs, LDS_BYTES, stream);
        if (e != hipSuccess) { fprintf(stderr, "kernel_launch: launch of phase %d failed: %s\n", ph, hipGetErrorString(e)); break; }
    }
#else
    a.lo = 0; a.hi = NPHASES; void* kargs[] = {&a};
    hipError_t e = hipLaunchCooperativeKernel((const void*)mk_fwd, dim3(grid), dim3(NTHREADS), kargs, LDS_BYTES, stream);
    if (e != hipSuccess) fprintf(stderr, "kernel_launch: cooperative launch failed: %s (grid %d)\n", hipGetErrorString(e), grid);
#endif
}
```

```cpp
#include <hip/hip_runtime.h>
#include <hip/hip_cooperative_groups.h>
#include <cstdio>
namespace cg = cooperative_groups;

#ifndef PER_PHASE_LAUNCH
#define PER_PHASE_LAUNCH 0
#endif

#ifndef S3REP
#define S3REP 0
#endif
#define S3R(i) for (int r3_ = 0; r3_ < 1 + ((S3REP >> (i)) & 1); ++r3_)
#define LAS __attribute__((address_space(3)))
typedef unsigned short bf16_t;
typedef short bf16x8 __attribute__((ext_vector_type(8)));
typedef float f32x4 __attribute__((ext_vector_type(4)));
typedef unsigned u32x4 __attribute__((ext_vector_type(4)));
typedef unsigned u32x2 __attribute__((ext_vector_type(2)));

constexpr int D = 1024, NB = 2, SEQ = 16384, CTXL = 256, SEG = SEQ + CTXL, R = NB * SEG, DEPTH = 2;
constexpr int NPROJ = 2560, DIN = 2576;
constexpr int NTHREADS = 512;
constexpr int LDS_BYTES = 163840;
constexpr int MISC_OFF = 131072;
constexpr int NCLS = 24;

constexpr size_t al256(size_t x) { return (x + 255) & ~size_t(255); }
constexpr size_t WS_CTL = 0;
constexpr size_t WS_M1CNT = 20480;
constexpr size_t WS_TS = 2048;
constexpr size_t WS_BAR = 4096;
constexpr size_t WS_CTL_BYTES = 32768;
constexpr size_t WS_MOD = WS_CTL_BYTES;
constexpr size_t WS_WTIN = WS_MOD + al256((size_t)2 * 3 * 6144 * 4);
constexpr size_t WS_WTOUT = WS_WTIN + al256((size_t)2 * DIN * 1024 * 2);
constexpr size_t WS_WTGU = WS_WTOUT + al256((size_t)2 * 1024 * 1024 * 2);
constexpr size_t WS_WTD = WS_WTGU + al256((size_t)2 * 16 * 512 * 1024 * 2);
constexpr size_t WS_H = WS_WTD + al256((size_t)2 * 16 * 1024 * 256 * 2);
constexpr size_t WS_HX = WS_H + al256((size_t)R * 1024 * 2);
constexpr size_t WS_PROJ = WS_HX + al256((size_t)R * 1024 * 2);
constexpr size_t WS_DT = WS_PROJ + al256((size_t)R * NPROJ * 2);
constexpr size_t WS_POS = WS_DT + al256((size_t)R * 16 * 4);
constexpr size_t WS_LIST = WS_POS + al256((size_t)2 * R * 4);
constexpr size_t WS_CWLA = WS_LIST + al256((size_t)NCLS * R * 4);
constexpr size_t WS_CWLB = WS_CWLA + al256((size_t)NCLS * R * 4);
constexpr size_t WS_BIG = WS_CWLB + al256((size_t)NCLS * R * 4);
constexpr size_t WS_Y = WS_PROJ;
constexpr size_t WS_S = WS_BIG;
constexpr size_t WS_HP = WS_S + al256((size_t)2 * 2 * 130 * 8 * 8192 * 2);
constexpr size_t WS_DEC = WS_HP + al256((size_t)2 * 2 * 130 * 8 * 8192 * 2);
constexpr size_t WS_SSQ = WS_DEC + al256((size_t)2 * 2 * 130 * 8 * 4);
constexpr size_t WS_HID = WS_S;
constexpr size_t WS_END = WS_SSQ + al256((size_t)R * 8 * 4);
static_assert((size_t)(R + NCLS * 256) * 512 * 2 <= (size_t)2 * 2 * 130 * 8 * 8192 * 2, "hid alias");
static_assert(WS_END <= (size_t)512 * 1024 * 1024, "workspace");

struct Params {
    const float *x, *c, *ctx, *c_ctx, *w_ada, *b_ada, *g_mix, *g_ffn, *w_in, *conv_w, *conv_b, *conv_ln_g, *conv_ln_b, *ssd_conv_w, *ssd_conv_b,
        *dt_bias, *a_log, *d_skip, *ssd_norm_g, *w_out, *w_rg, *b_rg, *w_re, *b_re, *w_gate, *w_up, *w_down, *g_final;
    float* out; unsigned char* ws;
};
struct Args { Params p; int lo, hi; };
typedef const __attribute__((address_space(4))) Params* CP;
__device__ __forceinline__ CP launder(CP p) { asm volatile("" : "+s"(p)); return p; }
__device__ __forceinline__ int launder_tid() { int t = threadIdx.x; asm volatile("" : "+v"(t)); return t; }

__device__ __forceinline__ unsigned cvt_pk_bf16(float lo, float hi) { unsigned r; asm("v_cvt_pk_bf16_f32 %0, %1, %2" : "=v"(r) : "v"(lo), "v"(hi)); return r; }
__device__ __forceinline__ float bf2f(unsigned b) { return __uint_as_float(b << 16); }
__device__ __forceinline__ float bflo(unsigned w) { return __uint_as_float(w << 16); }
__device__ __forceinline__ float bfhi(unsigned w) { return __uint_as_float(w & 0xffff0000u); }
__device__ __forceinline__ bf16_t f2bf(float f) { return (bf16_t)(cvt_pk_bf16(f, 0.f) & 0xffffu); }
#define DPP_ADD(v, ctrl, rm) ((v) + __builtin_bit_cast(float, __builtin_amdgcn_update_dpp(0, __builtin_bit_cast(int, (v)), (ctrl), (rm), 0xF, true)))
__device__ __forceinline__ float row_sum16(float v) {
    v = DPP_ADD(v, 0xB1, 0xF);
    v = DPP_ADD(v, 0x4E, 0xF);
    v = DPP_ADD(v, 0x141, 0xF);
    v = DPP_ADD(v, 0x140, 0xF);
    return v;
}
__device__ __forceinline__ float half_sum32(float v) { v = row_sum16(v); v = DPP_ADD(v, 0x142, 0xA); return v; }
__device__ __forceinline__ float wave_sum(float v) {
    v = half_sum32(v); v = DPP_ADD(v, 0x143, 0xC);
    return __builtin_bit_cast(float, __builtin_amdgcn_readlane(__builtin_bit_cast(int, v), 63));
}
__device__ __forceinline__ float sigmoidf_(float x) { return __builtin_amdgcn_rcpf(1.f + __builtin_amdgcn_exp2f(x * -1.44269504089f)); }
__device__ __forceinline__ float siluf_(float x) { return x * __builtin_amdgcn_rcpf(1.f + __builtin_amdgcn_exp2f(x * -1.44269504089f)); }
__device__ __forceinline__ float softplusf_(float x) { return fmaxf(x, 0.f) + __logf(1.f + __expf(-fabsf(x))); }

__device__ __forceinline__ int row_b(int r) { return r >= SEG ? 1 : 0; }
__device__ __forceinline__ int row_i(int r) { return r >= SEG ? r - SEG : r; }
__device__ __forceinline__ int row_v(int r) { const int i = row_i(r); return i < CTXL ? 2 : row_b(r); }
__device__ __forceinline__ const float* xin_ptr(const float* ctx, const float* x, int r) {
    const int b = row_b(r), i = row_i(r);
    return i < CTXL ? ctx + (size_t)(b * CTXL + i) * D : x + (size_t)(b * SEQ + i - CTXL) * D;
}
struct RowRaw { f32x4 f[4]; u32x2 h[4]; };
__device__ __forceinline__ void row_load(CP p, int l, int r, int lane, RowRaw& rr) {
    if (l == 0) { const f32x4* hr = (const f32x4*)xin_ptr(p->ctx, p->x, r);
#pragma unroll
        for (int j = 0; j < 4; ++j) rr.f[j] = hr[lane + 64 * j]; }
    else { const u32x2* hr = (const u32x2*)((const bf16_t*)(p->ws + WS_H) + (size_t)r * D);
#pragma unroll
        for (int j = 0; j < 4; ++j) rr.h[j] = hr[lane + 64 * j]; }
}
__device__ __forceinline__ void row_cvt(int l, const RowRaw& rr, f32x4 (&xv)[4]) {
#pragma unroll
    for (int j = 0; j < 4; ++j) xv[j] = l == 0 ? rr.f[j] : (f32x4){bflo(rr.h[j].x), bfhi(rr.h[j].x), bflo(rr.h[j].y), bfhi(rr.h[j].y)};
}
namespace pg8 {
constexpr int BM = 256, BK = 64, HALF = 128, HTB = HALF * BK * 2, STAGE_BYTES = 8 * HTB, NXCD = 8, WGM = 8;
__device__ __forceinline__ int lds_byte(int r, int c) { const int st = (r >> 4) * 2 + (c >> 5), rr = r & 15, cc = c & 31, ob = rr * 64 + cc * 2; return st * 1024 + (ob ^ (((ob >> 9) & 1) << 5)); }
__device__ __forceinline__ void stage_rc(int b, int& Rr, int& Cc) { const int st = b / 1024, sb = b % 1024, swz = sb ^ (((sb >> 9) & 1) << 5); Rr = (st >> 1) * 16 + swz / 64; Cc = (st & 1) * 32 + (swz % 64) / 2; }
__device__ __forceinline__ int perm32(int rho) { const int n = rho >> 4, i = rho & 15; return 8 * (i >> 2) + 4 * n + (i & 3); }

struct Unit {
    const char* a0;
    const char* b0;
    const char* b1;
    int i0, i1, i2, i3, i4, pad;
};

template <class Epi, class Sched, bool GATHER>
__device__ __forceinline__ void gemm_phase(LAS unsigned char* lds, const int lda, const int ldb, const int K, const Sched& S, const Epi& E) {
    const int tid = launder_tid(); const int wid = __builtin_amdgcn_readfirstlane(tid >> 6), lane = tid & 63, wr = wid >> 2, wc = wid & 3, fr = lane & 15, fq = lane >> 4;
    const int nt = K / BK, ks = nt >> 1;
    int Rr[2], Cc[2];
    unsigned voffB[2];
#pragma unroll
    for (int i = 0; i < 2; ++i) { stage_rc(tid * 16 + i * 8192, Rr[i], Cc[i]); const int Rb = Epi::PERM ? ((Rr[i] & ~31) + perm32(Rr[i] & 31)) : Rr[i];
        voffB[i] = (unsigned)(Rb * ldb + Cc[i]) * 2u; }
    const size_t kstep = (size_t)(BK * 2);
    const size_t hstepB = (size_t)HALF * ldb * 2;
    const unsigned ldsw = (unsigned)wid * 1024u;
    const unsigned ldsbase = (unsigned)(unsigned long)lds;
    const int aoff = lds_byte(wr * 64 + fr, fq * 8), boff = lds_byte(wc * 32 + fr, fq * 8);
#define PG8_SA(b, h) (((b) * 2 + (h)) * HTB)
#define PG8_SB(b, h) ((4 + (b) * 2 + (h)) * HTB)
#define PG8_STAGE2(bufoff, gbase, v0, v1) do { unsigned keep_; \
        asm volatile("s_mov_b32 %0, m0\n\ts_mov_b32 m0, %1\n\ts_nop 4\n\tglobal_load_lds_dwordx4 %2, %4\n\ts_add_u32 m0, m0, 0x2000\n\ts_nop 0\n\tglobal_load_lds_dwordx4 %3, %4\n\ts_mov_b32 m0, %0" \
            : "=&s"(keep_) : "s"(ldsbase + (unsigned)(bufoff) + ldsw), "v"(v0), "v"(v1), "s"(gbase) : "memory", "scc"); } while (0)
#define PG8_LDA(dst, b, h) do { _Pragma("unroll") for (int m = 0; m < 4; ++m) _Pragma("unroll") for (int k = 0; k < 2; ++k) dst[m][k] = *(const LAS bf16x8*)(lds + PG8_SA(b, h) + aoff + m * 2048 + k * 1024); } while (0)
#define PG8_LDB(dst, b, h) do { _Pragma("unroll") for (int n = 0; n < 2; ++n) _Pragma("unroll") for (int k = 0; k < 2; ++k) dst[n][k] = *(const LAS bf16x8*)(lds + PG8_SB(b, h) + boff + n * 2048 + k * 1024); } while (0)
#define PG8_MMA(ai, bj, At, Bt) do { __builtin_amdgcn_s_setprio(1); _Pragma("unroll") for (int m = 0; m < 4; ++m) _Pragma("unroll") for (int n = 0; n < 2; ++n) _Pragma("unroll") for (int k = 0; k < 2; ++k) \
        acc[ai][bj][m][n] = __builtin_amdgcn_mfma_f32_16x16x32_bf16(Bt[n][k], At[m][k], acc[ai][bj][m][n], 0, 0, 0); __builtin_amdgcn_s_setprio(0); } while (0)
#define PG8_WAIT_V(n) asm volatile("s_waitcnt vmcnt(" #n ")" ::: "memory")
#define PG8_WAIT_L(n) asm volatile("s_waitcnt lgkmcnt(" #n ")" ::: "memory")
#define PG8_BAR __builtin_amdgcn_s_barrier()
#define PG8_SCHED __builtin_amdgcn_sched_barrier(0)
#define PG8_BP(u, tt) ((tt) < ks ? (u).b0 + (size_t)(tt) * kstep : (u).b1 + (size_t)((tt) - ks) * kstep)
    Unit cur, nxt; int ui = 0;
    if (!S.get(0, cur)) return;
    S.a_ready(cur);
    unsigned c00, c01, c10, c11, n00, n01, n10, n11;
    if (GATHER) {
        c00 = (unsigned)(S.arow(cur, Rr[0]) * lda + Cc[0]) * 2u; c01 = (unsigned)(S.arow(cur, Rr[1]) * lda + Cc[1]) * 2u;
        c10 = (unsigned)(S.arow(cur, HALF + Rr[0]) * lda + Cc[0]) * 2u; c11 = (unsigned)(S.arow(cur, HALF + Rr[1]) * lda + Cc[1]) * 2u;
    } else {
        c00 = (unsigned)(Rr[0] * lda + Cc[0]) * 2u; c01 = (unsigned)(Rr[1] * lda + Cc[1]) * 2u;
        c10 = (unsigned)((HALF + Rr[0]) * lda + Cc[0]) * 2u; c11 = (unsigned)((HALF + Rr[1]) * lda + Cc[1]) * 2u;
    }
    n00 = c00; n01 = c01; n10 = c10; n11 = c11;
    f32x4 acc[2][2][4][2];
    float zr; asm volatile("v_mov_b32 %0, 0" : "=v"(zr));
#pragma unroll
    for (int a = 0; a < 2; ++a)
#pragma unroll
        for (int b = 0; b < 2; ++b)
#pragma unroll
            for (int m = 0; m < 4; ++m)
#pragma unroll
                for (int n = 0; n < 2; ++n) acc[a][b][m][n] = (f32x4){zr, zr, zr, zr};
    bf16x8 At[4][2], B0[2][2], B1[2][2];
    const char* cA = cur.a0;
    {
        const char* pb0 = PG8_BP(cur, 0); const char* pb1 = PG8_BP(cur, 1);
        PG8_STAGE2(PG8_SB(0, 0), pb0, voffB[0], voffB[1]); PG8_STAGE2(PG8_SA(0, 0), cA, c00, c01);
        PG8_STAGE2(PG8_SB(0, 1), pb0 + hstepB, voffB[0], voffB[1]); PG8_STAGE2(PG8_SA(0, 1), cA, c10, c11);
        if (wr == 1) PG8_BAR;
        PG8_WAIT_V(4); PG8_BAR;
        PG8_STAGE2(PG8_SB(1, 0), pb1, voffB[0], voffB[1]); PG8_STAGE2(PG8_SA(1, 0), cA + kstep, c00, c01);
        PG8_STAGE2(PG8_SB(1, 1), pb1 + hstepB, voffB[0], voffB[1]);
        PG8_WAIT_V(6); PG8_BAR;
    }
    for (;;) {
        const bool has_next = S.get(ui + 1, nxt);
        if (!has_next) nxt = cur;
        LAS int* tokb = (LAS int*)(lds + MISC_OFF + 1024) + ((ui + 1) & 1) * 256;
        if (GATHER) {
            n00 = c00; n01 = c01; n10 = c10; n11 = c11;
            if (has_next && wid == 0) {
                const char* src = (const char*)S.rows_ptr(nxt); unsigned keep_;
                asm volatile("s_mov_b32 %0, m0\n\ts_mov_b32 m0, %1\n\ts_nop 4\n\tglobal_load_lds_dwordx4 %2, %3\n\ts_mov_b32 m0, %0"
                    : "=&s"(keep_) : "s"((unsigned)(unsigned long)tokb), "v"((unsigned)lane * 16u), "s"(src) : "memory");
            }
        }
        const char* nA = nxt.a0;
#pragma unroll 1
        for (int t = 0; t < nt; t += 2) {
            const bool last = (t == nt - 2);
            if (last && has_next) S.a_ready(nxt);
            const char* a1 = cA + (size_t)(t + 1) * kstep;
            const char* a2 = last ? nA : cA + (size_t)(t + 2) * kstep;
            const char* a3 = a2 + kstep;
            const char* b2 = last ? PG8_BP(nxt, 0) : PG8_BP(cur, t + 2);
            const char* b3 = last ? PG8_BP(nxt, 1) : PG8_BP(cur, t + 3);
            if (GATHER) { if (last && has_next) {
                const int lim = S.rows_valid(nxt) - 1;
                const int i0 = Rr[0] < lim ? Rr[0] : lim, i1 = Rr[1] < lim ? Rr[1] : lim, i2 = (HALF + Rr[0]) < lim ? (HALF + Rr[0]) : lim, i3 = (HALF + Rr[1]) < lim ? (HALF + Rr[1]) : lim;
                n00 = (unsigned)(tokb[i0] * lda + Cc[0]) * 2u; n01 = (unsigned)(tokb[i1] * lda + Cc[1]) * 2u;
                n10 = (unsigned)(tokb[i2] * lda + Cc[0]) * 2u; n11 = (unsigned)(tokb[i3] * lda + Cc[1]) * 2u; } }
            const unsigned s00 = last ? n00 : c00, s01 = last ? n01 : c01, s10 = last ? n10 : c10, s11 = last ? n11 : c11;
            if constexpr (Epi::MIDSCALE) { if (t == ks) E.midscale(acc, cur, wr, wc, fr, fq); }
            PG8_LDB(B0, 0, 0); PG8_SCHED; PG8_LDA(At, 0, 0); PG8_STAGE2(PG8_SA(1, 1), a1, c10, c11);
            PG8_WAIT_L(8); PG8_BAR; PG8_WAIT_L(0); PG8_MMA(0, 0, At, B0); PG8_BAR; PG8_SCHED;
            PG8_LDB(B1, 0, 1); PG8_STAGE2(PG8_SB(0, 0), b2, voffB[0], voffB[1]);
            PG8_BAR; PG8_WAIT_L(0); PG8_MMA(0, 1, At, B1); PG8_BAR;
            PG8_LDA(At, 0, 1); PG8_STAGE2(PG8_SA(0, 0), a2, s00, s01);
            PG8_BAR; PG8_WAIT_L(0); PG8_MMA(1, 0, At, B0); PG8_BAR; PG8_SCHED;
            PG8_STAGE2(PG8_SB(0, 1), b2 + hstepB, voffB[0], voffB[1]);
            PG8_WAIT_V(6); PG8_BAR; PG8_MMA(1, 1, At, B1); PG8_BAR;
            PG8_LDB(B0, 1, 0); PG8_SCHED; PG8_LDA(At, 1, 0); PG8_STAGE2(PG8_SA(0, 1), a2, s10, s11);
            PG8_WAIT_L(8); PG8_BAR; PG8_WAIT_L(0); PG8_MMA(0, 0, At, B0); PG8_BAR; PG8_SCHED;
            PG8_LDB(B1, 1, 1); PG8_STAGE2(PG8_SB(1, 0), b3, voffB[0], voffB[1]);
            PG8_BAR; PG8_WAIT_L(0); PG8_MMA(0, 1, At, B1); PG8_BAR;
            PG8_LDA(At, 1, 1); PG8_STAGE2(PG8_SA(1, 0), a3, s00, s01);
            PG8_BAR; PG8_WAIT_L(0); PG8_MMA(1, 0, At, B0); PG8_BAR; PG8_SCHED;
            PG8_STAGE2(PG8_SB(1, 1), b3 + hstepB, voffB[0], voffB[1]);
            PG8_WAIT_V(6); PG8_BAR; PG8_MMA(1, 1, At, B1); PG8_BAR;
        }
        E(acc, cur, wr, wc, fr, fq);
        if (!has_next) break;
        asm volatile("v_mov_b32 %0, 0" : "=v"(zr));
#pragma unroll
        for (int a = 0; a < 2; ++a)
#pragma unroll
            for (int b = 0; b < 2; ++b)
#pragma unroll
                for (int m = 0; m < 4; ++m)
#pragma unroll
                    for (int n = 0; n < 2; ++n) acc[a][b][m][n] = (f32x4){zr, zr, zr, zr};
        cur = nxt; cA = nA; ++ui; c00 = n00; c01 = n01; c10 = n10; c11 = n11;
    }
    PG8_WAIT_V(0);
    if (wr == 0) PG8_BAR;
    PG8_BAR;
#undef PG8_SA
#undef PG8_SB
#undef PG8_STAGE2
#undef PG8_LDA
#undef PG8_LDB
#undef PG8_MMA
#undef PG8_WAIT_V
#undef PG8_WAIT_L
#undef PG8_BAR
#undef PG8_SCHED
#undef PG8_BP
}

struct DenseSched {
    const char* A; const char* Bt; int lda, ldb, K; int nM, nN, nwg, G, c, skipctx;
    __device__ __forceinline__ void init(const void* A_, const void* Bt_, int M, int N, int K_, int lda_, int ldb_, int G_, int c_, int skipctx_ = 0) {
        A = (const char*)A_; Bt = (const char*)Bt_; lda = lda_; ldb = ldb_; K = K_; nM = M / BM - 2 * skipctx_; nN = N / BM; nwg = nM * nN; G = G_; c = c_; skipctx = skipctx_; }
    __device__ __forceinline__ bool get(int i, Unit& u) const {
        const long L = (long)i * G + c; if (L >= nwg) return false;
        int wgid = (int)L; { const int q = nwg / NXCD, r = nwg % NXCD, xcd = wgid % NXCD, off = wgid / NXCD; wgid = (xcd < r ? xcd * (q + 1) : r * (q + 1) + (xcd - r) * q) + off; }
        const int nig = WGM * nN, gid = wgid / nig, fm = gid * WGM, gsz = (nM - fm) < WGM ? (nM - fm) : WGM;
        int pm = fm + ((wgid % nig) % gsz); const int pn = (wgid % nig) / gsz;
        if (skipctx) pm += 1 + (pm >= 64 ? 1 : 0);
        u.a0 = A + (size_t)pm * BM * lda * 2; u.b0 = Bt + (size_t)pn * BM * ldb * 2; u.b1 = u.b0 + (size_t)(K / BK / 2) * BK * 2;
        u.i0 = pm; u.i1 = pn; u.i2 = 0; u.i3 = 0; u.i4 = 0; u.pad = 0; return true;
    }
    __device__ __forceinline__ void a_ready(const Unit&) const {}
    __device__ __forceinline__ int arow(const Unit&, int rl) const { return rl; }
    __device__ __forceinline__ const int* rows_ptr(const Unit&) const { return nullptr; }
    __device__ __forceinline__ int rows_valid(const Unit&) const { return 256; }
};
}

struct EpiProj {
    static constexpr bool PERM = true, MIDSCALE = false;
    bf16_t* O;
    __device__ __forceinline__ void operator()(const f32x4 (&acc)[2][2][4][2], const pg8::Unit& u, int wr, int wc, int fr, int fq) const {
        const int pn = u.i1;
        const int row0 = u.i0 * 256 + wr * 64 + fr;
        if (pn < 4) {
            const int col0 = pn * 128 + wc * 32 + 8 * fq;
#pragma unroll
            for (int ai = 0; ai < 2; ++ai)
#pragma unroll
                for (int m = 0; m < 4; ++m) { const f32x4 u0 = acc[ai][0][m][0], u1 = acc[ai][0][m][1], g0 = acc[ai][1][m][0], g1 = acc[ai][1][m][1];
                    u32x4 w; w.x = cvt_pk_bf16(u0[0] * sigmoidf_(g0[0]), u0[1] * sigmoidf_(g0[1])); w.y = cvt_pk_bf16(u0[2] * sigmoidf_(g0[2]), u0[3] * sigmoidf_(g0[3]));
                    w.z = cvt_pk_bf16(u1[0] * sigmoidf_(g1[0]), u1[1] * sigmoidf_(g1[1])); w.w = cvt_pk_bf16(u1[2] * sigmoidf_(g1[2]), u1[3] * sigmoidf_(g1[3]));
                    *(u32x4*)(O + (size_t)(row0 + ai * 128 + m * 16) * NPROJ + col0) = w; }
        } else {
            const int col0 = pn * 256 + wc * 32 + 8 * fq; const bool sl = pn < 6;
#pragma unroll
            for (int ai = 0; ai < 2; ++ai)
#pragma unroll
                for (int m = 0; m < 4; ++m) { bf16_t* rowp = O + (size_t)(row0 + ai * 128 + m * 16) * NPROJ + col0;
#pragma unroll
                    for (int bj = 0; bj < 2; ++bj) { f32x4 v0 = acc[ai][bj][m][0], v1 = acc[ai][bj][m][1];
                        if (sl) {
#pragma unroll
                            for (int e = 0; e < 4; ++e) { v0[e] = siluf_(v0[e]); v1[e] = siluf_(v1[e]); } }
                        u32x4 w; w.x = cvt_pk_bf16(v0[0], v0[1]); w.y = cvt_pk_bf16(v0[2], v0[3]); w.z = cvt_pk_bf16(v1[0], v1[1]); w.w = cvt_pk_bf16(v1[2], v1[3]);
                        *(u32x4*)(rowp + bj * 128) = w; } }
        }
    }
};
template <int L0> struct EpiResid {
    static constexpr bool PERM = true, MIDSCALE = true;
    const float* inc; const float* inx; bf16_t* H; const float* modl; const float* ssq;
    __device__ __forceinline__ void midscale(f32x4 (&acc)[2][2][4][2], const pg8::Unit& u, int wr, int wc, int fr, int fq) const {
        typedef float f32x2 __attribute__((ext_vector_type(2)));
        const int r0 = u.i0 * 256 + wr * 64 + fr;
        f32x2 part[2][4];
#pragma unroll
        for (int ai = 0; ai < 2; ++ai)
#pragma unroll
            for (int m = 0; m < 4; ++m) part[ai][m] = *(const f32x2*)(ssq + (size_t)(r0 + ai * 128 + m * 16) * 8 + 2 * fq);
#pragma unroll
        for (int ai = 0; ai < 2; ++ai)
#pragma unroll
            for (int m = 0; m < 4; ++m) { float sq = part[ai][m][0] + part[ai][m][1];
                sq += __shfl_xor(sq, 16); sq += __shfl_xor(sq, 32);
                const float rs = rsqrtf(sq * (1.f / 512.f) + 1e-6f);
#pragma unroll
                for (int bj = 0; bj < 2; ++bj)
#pragma unroll
                    for (int n = 0; n < 2; ++n) acc[ai][bj][m][n] *= rs; }
    }
    __device__ __forceinline__ void operator()(const f32x4 (&acc)[2][2][4][2], const pg8::Unit& u, int wr, int wc, int fr, int fq) const {
        const int r0 = u.i0 * 256;
        const int v = row_v(r0);
        const float* gate = modl + (size_t)v * 6144 + 2 * 1024;
        const float* xin = xin_ptr(inc, inx, r0);
        const int rl0 = wr * 64 + fr, col0 = u.i1 * 256 + wc * 32 + 8 * fq;
        f32x4 gv[2][2];
#pragma unroll
        for (int bj = 0; bj < 2; ++bj)
#pragma unroll
            for (int n = 0; n < 2; ++n) gv[bj][n] = *(const f32x4*)(gate + col0 + bj * 128 + 4 * n);
#pragma unroll
        for (int ai = 0; ai < 2; ++ai)
#pragma unroll
            for (int mp = 0; mp < 2; ++mp) {
                if (L0) {
                    f32x4 hi[2][2][2];
#pragma unroll
                    for (int mm = 0; mm < 2; ++mm) { const size_t off = (size_t)(rl0 + ai * 128 + (2 * mp + mm) * 16) * D + col0;
#pragma unroll
                        for (int bj = 0; bj < 2; ++bj)
#pragma unroll
                            for (int n = 0; n < 2; ++n) hi[mm][bj][n] = *(const f32x4*)(xin + off + bj * 128 + 4 * n); }
#pragma unroll
                    for (int mm = 0; mm < 2; ++mm)
#pragma unroll
                        for (int bj = 0; bj < 2; ++bj) { const f32x4 o0 = hi[mm][bj][0] + gv[bj][0] * acc[ai][bj][2 * mp + mm][0], o1 = hi[mm][bj][1] + gv[bj][1] * acc[ai][bj][2 * mp + mm][1];
                            u32x4 w; w.x = cvt_pk_bf16(o0[0], o0[1]); w.y = cvt_pk_bf16(o0[2], o0[3]); w.z = cvt_pk_bf16(o1[0], o1[1]); w.w = cvt_pk_bf16(o1[2], o1[3]);
                            *(u32x4*)(H + (size_t)(r0 + rl0 + ai * 128 + (2 * mp + mm) * 16) * D + col0 + bj * 128) = w; }
                } else {
                    u32x4 hr[2][2];
#pragma unroll
                    for (int mm = 0; mm < 2; ++mm)
#pragma unroll
                        for (int bj = 0; bj < 2; ++bj) hr[mm][bj] = *(const u32x4*)(H + (size_t)(r0 + rl0 + ai * 128 + (2 * mp + mm) * 16) * D + col0 + bj * 128);
#pragma unroll
                    for (int mm = 0; mm < 2; ++mm)
#pragma unroll
                        for (int bj = 0; bj < 2; ++bj) { const u32x4 hv = hr[mm][bj]; const f32x4 a0 = acc[ai][bj][2 * mp + mm][0], a1 = acc[ai][bj][2 * mp + mm][1]; const f32x4 g0 = gv[bj][0], g1 = gv[bj][1];
                            u32x4 w;
                            w.x = cvt_pk_bf16(bflo(hv.x) + g0[0] * a0[0], bfhi(hv.x) + g0[1] * a0[1]); w.y = cvt_pk_bf16(bflo(hv.y) + g0[2] * a0[2], bfhi(hv.y) + g0[3] * a0[3]);
                            w.z = cvt_pk_bf16(bflo(hv.z) + g1[0] * a1[0], bfhi(hv.z) + g1[1] * a1[1]); w.w = cvt_pk_bf16(bflo(hv.w) + g1[2] * a1[2], bfhi(hv.w) + g1[3] * a1[3]);
                            *(u32x4*)(H + (size_t)(r0 + rl0 + ai * 128 + (2 * mp + mm) * 16) * D + col0 + bj * 128) = w; }
                }
                asm volatile("" ::: "memory"); }
    }
};

__device__ __forceinline__ const char* uniform_ptr(const char* q) {
    const unsigned long long v = (unsigned long long)q;
    const unsigned lo = __builtin_amdgcn_readfirstlane((unsigned)v), hi = __builtin_amdgcn_readfirstlane((unsigned)(v >> 32));
    return (const char*)(((unsigned long long)hi << 32) | lo);
}
struct MoeSched {
    const LAS int* tab;
    const int* list;
    const char* A; const char* W; int mode  , l, G, c;
    unsigned* ready;
    __device__ __forceinline__ void a_ready(const pg8::Unit& u) const {
        if (mode == 0) return;
        if (threadIdx.x < 64) {
            unsigned* w = ready + u.i4; unsigned spins = 0;
            while ((unsigned)__builtin_amdgcn_readfirstlane((int)__hip_atomic_load(w, __ATOMIC_RELAXED, __HIP_MEMORY_SCOPE_AGENT)) < 32u) {
                __builtin_amdgcn_s_sleep(2); if (++spins > (1u << 22)) break; }
            __builtin_amdgcn_fence(__ATOMIC_ACQUIRE, "agent");
            asm volatile("s_waitcnt vmcnt(0)" ::: "memory");
        }
        asm volatile("" ::: "memory"); __builtin_amdgcn_s_barrier(); asm volatile("" ::: "memory");
    }
    int late;
    __device__ __forceinline__ bool get(int i, pg8::Unit& u) const {
        const int total = __builtin_amdgcn_readfirstlane(tab[24]) * 4;
        int L;
        if (mode == 0 || late == 0) L = i * G + c;
        else if (c < late) { if (i > 0) return false; L = c; }
        else L = late + (c - late) + i * (G - late);
        if (L >= total) return false;
        const int tl = L >> 2, pn = L & 3;
        int cls = 0;
#pragma unroll 1
        for (int q = 1; q < NCLS; ++q) { const int tq = __builtin_amdgcn_readfirstlane(tab[q]); if (tq <= tl) cls = q; }
        const int j = tl - __builtin_amdgcn_readfirstlane(tab[cls]), cnt = __builtin_amdgcn_readfirstlane(tab[32 + cls]);
        const int g = cls / 6, pidx = cls - g * 6;
        const int ea = (pidx >= 3) + (pidx >= 5), eb = pidx < 3 ? pidx + 1 : (pidx < 5 ? pidx - 1 : 3);
        if (mode == 0) {
            const int e = 4 * g + (pn < 2 ? ea : eb);
            u.a0 = A;
            u.b0 = W + ((size_t)(l * 16 + e) * 512 + (size_t)(pn & 1) * 256) * 1024 * 2; u.b1 = u.b0 + (size_t)8 * 128;
        } else {
            u.a0 = A + (size_t)tl * 256 * 512 * 2;
            u.b0 = W + ((size_t)(l * 16 + 4 * g + ea) * 1024 + (size_t)pn * 256) * 256 * 2;
            u.b1 = W + ((size_t)(l * 16 + 4 * g + eb) * 1024 + (size_t)pn * 256) * 256 * 2;
        }
        u.a0 = uniform_ptr(u.a0); u.b0 = uniform_ptr(u.b0); u.b1 = uniform_ptr(u.b1);
        u.i0 = cls; u.i1 = j; u.i2 = pn; u.i3 = cnt; u.i4 = tl; u.pad = 0; return true;
    }
    __device__ __forceinline__ int arow(const pg8::Unit& u, int rl) const {
        int idx = u.i1 * 256 + rl; idx = idx < u.i3 ? idx : u.i3 - 1;
        return list[(size_t)u.i0 * R + idx];
    }
    __device__ __forceinline__ const int* rows_ptr(const pg8::Unit& u) const { return list + (size_t)u.i0 * R + u.i1 * 256; }
    __device__ __forceinline__ int rows_valid(const pg8::Unit& u) const { return u.i3 - u.i1 * 256; }
};
struct EpiUp {
    static constexpr bool PERM = true, MIDSCALE = false;
    bf16_t* hid; const float* cwla; const float* cwlb; unsigned* ready;
    __device__ __forceinline__ void operator()(const f32x4 (&acc)[2][2][4][2], const pg8::Unit& u, int wr, int wc, int fr, int fq) const {
        const int cls = u.i0, j = u.i1, pn = u.i2, cnt = u.i3, tl = u.i4;
        const float* cw = (pn < 2) ? cwla : cwlb;
        const int colbase = (pn >> 1) * 256 + (pn & 1) * 128 + wc * 32 + 8 * fq;
        float wrow[2][4];
#pragma unroll
        for (int ai = 0; ai < 2; ++ai)
#pragma unroll
            for (int m = 0; m < 4; ++m) { const int idx = j * 256 + ai * 128 + wr * 64 + m * 16 + fr; wrow[ai][m] = idx < cnt ? cw[(size_t)cls * R + idx] : 0.f; }
#pragma unroll
        for (int ai = 0; ai < 2; ++ai)
#pragma unroll
            for (int m = 0; m < 4; ++m) {
                const int rl = ai * 128 + wr * 64 + m * 16 + fr; const int idx = j * 256 + rl; const bool valid = idx < cnt;
                const float w = wrow[ai][m];
                const f32x4 g0 = acc[ai][0][m][0], g1 = acc[ai][0][m][1], u0 = acc[ai][1][m][0], u1 = acc[ai][1][m][1];
                float o[8];
#pragma unroll
                for (int e = 0; e < 4; ++e) { o[e] = w * siluf_(g0[e]) * u0[e]; o[4 + e] = w * siluf_(g1[e]) * u1[e]; }
                if (!valid) {
#pragma unroll
                    for (int e = 0; e < 8; ++e) o[e] = 0.f; }
                u32x4 pk; pk.x = cvt_pk_bf16(o[0], o[1]); pk.y = cvt_pk_bf16(o[2], o[3]); pk.z = cvt_pk_bf16(o[4], o[5]); pk.w = cvt_pk_bf16(o[6], o[7]);
                { bf16_t* dstp = hid + ((size_t)tl * 256 + rl) * 512 + colbase;
                  asm volatile("global_store_dwordx4 %0, %1, off sc1\n\ts_nop 1" :: "v"(dstp), "v"(pk) : "memory"); }
            }
        asm volatile("s_waitcnt vmcnt(0)" ::: "memory");
        if ((threadIdx.x & 63) == 0) __hip_atomic_fetch_add(ready + tl, 1u, __ATOMIC_RELAXED, __HIP_MEMORY_SCOPE_AGENT);
    }
};
struct EpiDown {
    static constexpr bool PERM = true, MIDSCALE = false;
    bf16_t* H; const int* list; const float* modl;
    __device__ __forceinline__ void operator()(const f32x4 (&acc)[2][2][4][2], const pg8::Unit& u, int wr, int wc, int fr, int fq) const {
        const int cls = u.i0, j = u.i1, pn = u.i2, cnt = u.i3;
        const int col0 = pn * 256 + wc * 32 + 8 * fq;
        int tok[2][4];
#pragma unroll
        for (int ai = 0; ai < 2; ++ai)
#pragma unroll
            for (int m = 0; m < 4; ++m) { const int idx = j * 256 + ai * 128 + wr * 64 + m * 16 + fr; tok[ai][m] = idx < cnt ? list[(size_t)cls * R + idx] : -1; }
#pragma unroll
        for (int ai = 0; ai < 2; ++ai)
#pragma unroll
            for (int mp = 0; mp < 2; ++mp) {
                u32x4 hr[2][2]; f32x4 gv[2][2][2];
#pragma unroll
                for (int mm = 0; mm < 2; ++mm) { const int t = tok[ai][2 * mp + mm]; const int tt = t < 0 ? 0 : t;
                    const bf16_t* hp = H + (size_t)tt * D + col0; const float* gp = modl + (size_t)row_v(tt) * 6144 + col0;
#pragma unroll
                    for (int bj = 0; bj < 2; ++bj) { hr[mm][bj] = *(const u32x4*)(hp + bj * 128); gv[mm][bj][0] = *(const f32x4*)(gp + bj * 128); gv[mm][bj][1] = *(const f32x4*)(gp + bj * 128 + 4); } }
#pragma unroll
                for (int mm = 0; mm < 2; ++mm) { const int t = tok[ai][2 * mp + mm];
                    if (t >= 0) {
#pragma unroll
                        for (int bj = 0; bj < 2; ++bj) { const u32x4 hv = hr[mm][bj]; const f32x4 a0 = acc[ai][bj][2 * mp + mm][0], a1 = acc[ai][bj][2 * mp + mm][1]; const f32x4 g0 = gv[mm][bj][0], g1 = gv[mm][bj][1];
                            u32x4 w;
                            w.x = cvt_pk_bf16(bflo(hv.x) + g0[0] * a0[0], bfhi(hv.x) + g0[1] * a0[1]); w.y = cvt_pk_bf16(bflo(hv.y) + g0[2] * a0[2], bfhi(hv.y) + g0[3] * a0[3]);
                            w.z = cvt_pk_bf16(bflo(hv.z) + g1[0] * a1[0], bfhi(hv.z) + g1[1] * a1[1]); w.w = cvt_pk_bf16(bflo(hv.w) + g1[2] * a1[2], bfhi(hv.w) + g1[3] * a1[3]);
                            *(u32x4*)(H + (size_t)t * D + col0 + bj * 128) = w; } } }
                asm volatile("" ::: "memory"); }
    }
};

__device__ __forceinline__ void tr_tile(const float* src, int ldn, int k0, int n0, int nvalid, bf16_t* dst, int ldk, int drow0, LAS float* tile, int kd0 = -1, const float* kscale = nullptr) {
    const int tid = launder_tid();
    if (kd0 < 0) kd0 = k0;
    { const int n = tid & 63; const int kq = tid >> 6; float tv[8], ts[8];
#pragma unroll
      for (int it = 0; it < 8; ++it) { const int kk = kq + 8 * it; tv[it] = (n < nvalid) ? src[(size_t)(k0 + kk) * ldn + n0 + n] : 0.f; ts[it] = kscale ? kscale[kk] : 1.f; }
#pragma unroll
      for (int it = 0; it < 8; ++it) tile[(kq + 8 * it) * 65 + n] = tv[it] * ts[it]; }
    __syncthreads();
    { const int k8 = tid & 7, n = tid >> 3;
      if (n < nvalid) { const LAS float* s = tile + (k8 * 8) * 65 + n;
          u32x4 o; o.x = cvt_pk_bf16(s[0], s[65]); o.y = cvt_pk_bf16(s[2 * 65], s[3 * 65]); o.z = cvt_pk_bf16(s[4 * 65], s[5 * 65]); o.w = cvt_pk_bf16(s[6 * 65], s[7 * 65]);
          *(u32x4*)(dst + (size_t)(drow0 + n) * ldk + kd0 + k8 * 8) = o; } }
    __syncthreads();
}
constexpr int WPREP_ITEMS_PER_LAYER = 16 * 41 + 256 + 1024 + 1024 + 1024;
__device__ __forceinline__ void phase_wprep(CP p, unsigned char* lds, int it0, int it1, int bidx, int nblk, int b0 = 0, int b1 = 0, int c0 = 0, int c1 = 0) {
    LAS float* tile = (LAS float*)(LAS unsigned char*)lds;
    constexpr int I_IN = 16 * 41, I_OUT = 256, I_G = 1024, I_U = 1024, I_D = 1024, I_L = I_IN + I_OUT + I_G + I_U + I_D;
    const int na = it1 - it0, nbb = b1 - b0, ncc = c1 - c0;
    for (int vi = bidx; vi < na + nbb + ncc; vi += nblk) {
        const int it = vi < na ? it0 + vi : (vi < na + nbb ? b0 + (vi - na) : c0 + (vi - na - nbb));
        const int l = it / I_L; int r = it - l * I_L;
        if (r < I_IN) { const int kt = r / 41, ntl = r % 41; const int n0 = ntl * 64; const int nv = (DIN - n0) < 64 ? (DIN - n0) : 64;
            const int dr = n0 < 512 ? (n0 >> 7) * 256 + (n0 & 127) : (n0 < 1024 ? ((n0 - 512) >> 7) * 256 + 128 + ((n0 - 512) & 127) : n0);
            tr_tile(p->w_in + (size_t)l * 1024 * DIN, DIN, kt * 64, n0, nv, (bf16_t*)(p->ws + WS_WTIN) + (size_t)l * DIN * 1024, 1024, dr, tile); continue; }
        r -= I_IN;
        if (r < I_OUT) { const int kt = r >> 4, ntl = r & 15;
            tr_tile(p->w_out + (size_t)l * 1024 * 1024, 1024, kt * 64, ntl * 64, 64, (bf16_t*)(p->ws + WS_WTOUT) + (size_t)l * 1024 * 1024, 1024, ntl * 64, tile,
                    (kt * 64 + 512) & 1023, kt >= 8 ? p->ssd_norm_g + l * 512 + (kt * 64 - 512) : nullptr); continue; }
        r -= I_OUT;
        if (r < I_G + I_U) { const int up = r >= I_G; if (up) r -= I_G; const int e = r >> 6, q = r & 63, kt = q >> 2, ntl = q & 3; const int n0 = ntl * 64;
            const float* src = (up ? p->w_up : p->w_gate) + (size_t)(l * 16 + e) * 1024 * 256;
            tr_tile(src, 256, kt * 64, n0, 64, (bf16_t*)(p->ws + WS_WTGU) + (size_t)(l * 16 + e) * 512 * 1024, 1024, (n0 >> 7) * 256 + (n0 & 127) + (up ? 128 : 0), tile); continue; }
        r -= I_G + I_U;
        { const int e = r >> 6, q = r & 63, kt = q >> 4, ntl = q & 15;
          tr_tile(p->w_down + (size_t)(l * 16 + e) * 256 * 1024, 1024, kt * 64, ntl * 64, 64, (bf16_t*)(p->ws + WS_WTD) + (size_t)(l * 16 + e) * 1024 * 256, 256, ntl * 64, tile); }
    }
}
__device__ __forceinline__ void phase_adaln(CP p, unsigned char* lds, int bid, int nb) {
    LAS float* sc = (LAS float*)(LAS unsigned char*)lds;
    LAS float* red = sc + 3 * 1024;
    const int tid = launder_tid();
    for (int idx = tid; idx < 3 * 1024; idx += NTHREADS) { const int v = idx >> 10, k = idx & 1023; const float cv = (v < 2) ? p->c[v * 1024 + k] : p->c_ctx[k]; sc[idx] = siluf_(cv); }
    __syncthreads();
    float* mod = (float*)(p->ws + WS_MOD);
    for (int it = bid; it < 2 * 96; it += nb) {
        const int l = it / 96, n0 = (it % 96) * 64;
        const int c4 = tid & 15, kr = tid >> 4;
        f32x4 a0 = {0, 0, 0, 0}, a1 = {0, 0, 0, 0}, a2 = {0, 0, 0, 0};
        const float* w = p->w_ada + (size_t)l * 1024 * 6144 + n0 + c4 * 4;
#pragma unroll 4
        for (int k = kr; k < 1024; k += 32) { const f32x4 w4 = *(const f32x4*)(w + (size_t)k * 6144); a0 += sc[k] * w4; a1 += sc[1024 + k] * w4; a2 += sc[2048 + k] * w4; }
        *(LAS f32x4*)(red + (kr * 3 + 0) * 64 + c4 * 4) = a0; *(LAS f32x4*)(red + (kr * 3 + 1) * 64 + c4 * 4) = a1; *(LAS f32x4*)(red + (kr * 3 + 2) * 64 + c4 * 4) = a2;
        __syncthreads();
        if (tid < 192) { const int v = tid >> 6, cc = tid & 63; float s = 0.f;
            for (int q = 0; q < 32; ++q) s += red[(q * 3 + v) * 64 + cc];
            mod[((size_t)l * 3 + v) * 6144 + n0 + cc] = s + p->b_ada[l * 6144 + n0 + cc]; }
        __syncthreads();
    }
}
__device__ __forceinline__ void moe_table(CP p, int l, LAS int* tab) {
    const int* gcount = (const int*)(p->ws + WS_CTL) + l * 32;
    if (threadIdx.x == 0) { int acc = 0; for (int q = 0; q < NCLS; ++q) { const int cn = gcount[q]; tab[q] = acc; tab[32 + q] = cn; acc += (cn + 255) >> 8; } tab[24] = acc; }
    __syncthreads();
}
__device__ __forceinline__ void moe_yload(CP p, int pos, int lane, const LAS int* tab, u32x2 (&yv)[4]) {
    const int slot = tab[pos >> 16] * 256 + (pos & 0xffff);
    const bf16_t* y = (const bf16_t*)(p->ws + WS_Y) + (size_t)slot * 1024;
#pragma unroll
    for (int j = 0; j < 4; ++j) yv[j] = *(const u32x2*)(y + 4 * lane + 256 * j);
}
__device__ __forceinline__ void moe_yadd(CP p, int lm, int v, int lane, const u32x2 (&yv)[4], f32x4 (&xv)[4]) {
    const float* gate = (const float*)(p->ws + WS_MOD) + ((size_t)lm * 3 + v) * 6144 + 5 * 1024;
#pragma unroll
    for (int j = 0; j < 4; ++j) { const int k = 4 * lane + 256 * j; const f32x4 g4 = *(const f32x4*)(gate + k);
        xv[j][0] += g4[0] * bflo(yv[j].x); xv[j][1] += g4[1] * bfhi(yv[j].x); xv[j][2] += g4[2] * bflo(yv[j].y); xv[j][3] += g4[3] * bfhi(yv[j].y); }
}
typedef _Float16 f16x8 __attribute__((ext_vector_type(8)));
typedef _Float16 f16x2 __attribute__((ext_vector_type(2)));
constexpr int ST_H16 = 2064;
__device__ __forceinline__ unsigned pack_f16(float a, float b) { f16x2 h; h[0] = (_Float16)a; h[1] = (_Float16)b; return __builtin_bit_cast(unsigned, h); }
__device__ __forceinline__ void phase_r1(CP p, int l, unsigned char* lds_, int bid, int nb) {
    LAS unsigned char* lds = (LAS unsigned char*)lds_;
    LAS unsigned char* Wh = lds;
    LAS unsigned char* Xh = Wh + 16 * ST_H16;
    LAS float* gm = (LAS float*)(Xh + 16 * ST_H16);
    LAS float* sh = gm + 3 * 1024;
    LAS float* part = sh + 3 * 1024;
    const int tid = launder_tid(); const int lane = tid & 63, wave = __builtin_amdgcn_readfirstlane(tid >> 6);
    const float* mod = (const float*)(p->ws + WS_MOD) + (size_t)l * 3 * 6144;
    const float* win = p->w_in + (size_t)l * 1024 * DIN;
#pragma unroll
    for (int hb = 0; hb < 2; ++hb) { float tmp[16];
#pragma unroll
        for (int it = 0; it < 16; ++it) { const int idx = tid + NTHREADS * (16 * hb + it); tmp[it] = win[(size_t)(idx >> 4) * DIN + NPROJ + (idx & 15)]; }
#pragma unroll
        for (int it = 0; it < 16; ++it) { const int idx = tid + NTHREADS * (16 * hb + it); *(LAS _Float16*)(Wh + (idx & 15) * ST_H16 + (idx >> 4) * 2) = (_Float16)tmp[it]; } }
    { float t0[6], t1[6], t2[6];
#pragma unroll
      for (int it = 0; it < 6; ++it) { const int idx = tid + NTHREADS * it; const int v = idx >> 10, k = idx & 1023; t0[it] = p->g_mix[l * 1024 + k]; t1[it] = mod[v * 6144 + 1024 + k]; t2[it] = mod[v * 6144 + k]; }
#pragma unroll
      for (int it = 0; it < 6; ++it) { const int idx = tid + NTHREADS * it; gm[idx] = t0[it] * (1.f + t1[it]); sh[idx] = t2[it]; } }
    __syncthreads();
    bf16_t* HX = (bf16_t*)(p->ws + WS_HX); float* DT = (float*)(p->ws + WS_DT);
    const int rpb = (R + nb - 1) / nb, r0 = bid * rpb, r1 = (r0 + rpb) < R ? (r0 + rpb) : R;
    RowRaw xn[2];
#pragma unroll
    for (int q = 0; q < 2; ++q) if (r0 + 2 * wave + q < r1) row_load(p, l, r0 + 2 * wave + q, lane, xn[q]);
#pragma unroll 1
    for (int t0r = r0; t0r < r1; t0r += 16) {
        f32x4 xv[2][4];
#pragma unroll
        for (int q = 0; q < 2; ++q) row_cvt(l, xn[q], xv[q]);
#pragma unroll
        for (int q = 0; q < 2; ++q) if (t0r + 16 + 2 * wave + q < r1) row_load(p, l, t0r + 16 + 2 * wave + q, lane, xn[q]);
#pragma unroll
        for (int q = 0; q < 2; ++q) { const int rr = t0r + 2 * wave + q; const bool ok = rr < r1; const int v = row_v(ok ? rr : r0);
            if (l == 0 && ok) { u32x2* hw = (u32x2*)((bf16_t*)(p->ws + WS_H) + (size_t)rr * D);
#pragma unroll
                for (int j = 0; j < 4; ++j) { u32x2 o; o.x = cvt_pk_bf16(xv[q][j][0], xv[q][j][1]); o.y = cvt_pk_bf16(xv[q][j][2], xv[q][j][3]); hw[lane + 64 * j] = o; } }
            float ss = 0.f;
#pragma unroll
            for (int j = 0; j < 4; ++j) ss += xv[q][j][0] * xv[q][j][0] + xv[q][j][1] * xv[q][j][1] + xv[q][j][2] * xv[q][j][2] + xv[q][j][3] * xv[q][j][3];
            ss = wave_sum(ss); const float rs = ok ? __builtin_amdgcn_rsqf(ss * (1.f / 1024.f) + 1e-6f) : 0.f;
#pragma unroll
            for (int j = 0; j < 4; ++j) { const int k = 4 * lane + 256 * j; const f32x4 g4 = *(const LAS f32x4*)(gm + v * 1024 + k), s4 = *(const LAS f32x4*)(sh + v * 1024 + k);
                f32x4 hv = xv[q][j] * rs * g4 + s4; if (!ok) hv = hv * 0.f;
                u32x2 o; o.x = cvt_pk_bf16(hv[0], hv[1]); o.y = cvt_pk_bf16(hv[2], hv[3]);
                if (ok) *(u32x2*)(HX + (size_t)rr * 1024 + k) = o;
                u32x2 h16; h16.x = pack_f16(hv[0], hv[1]); h16.y = pack_f16(hv[2], hv[3]);
                *(LAS u32x2*)(Xh + (2 * wave + q) * ST_H16 + k * 2) = h16; } }
        __syncthreads();
        {
            f32x4 acc0 = {0.f, 0.f, 0.f, 0.f};
#pragma unroll
            for (int s4 = 0; s4 < 4; ++s4) { const int kb = (128 * wave + 32 * s4 + 8 * (lane >> 4)) * 2;
                const f16x8 a = *(const LAS f16x8*)(Xh + (lane & 15) * ST_H16 + kb);
                const f16x8 b0 = *(const LAS f16x8*)(Wh + (lane & 15) * ST_H16 + kb);
                acc0 = __builtin_amdgcn_mfma_f32_16x16x32_f16(a, b0, acc0, 0, 0, 0); }
#pragma unroll
            for (int e = 0; e < 4; ++e) part[(wave * 16 + 4 * (lane >> 4) + e) * 16 + (lane & 15)] = acc0[e];
        }
        __syncthreads();
        if (tid < 256) { const int row = tid >> 4, n = tid & 15; const int rr = t0r + row;
            float sacc = p->dt_bias[l * 16 + n];
#pragma unroll
            for (int w = 0; w < 8; ++w) sacc += part[(w * 16 + row) * 16 + n];
            if (rr < r1) DT[(size_t)rr * 16 + n] = softplusf_(sacc); }
    }
    __syncthreads();
}
typedef float f32x16 __attribute__((ext_vector_type(16)));
typedef short s16x4 __attribute__((ext_vector_type(4)));
constexpr int ST_ROW = 272;
constexpr int ST_TR128 = 320;
constexpr int ST_TR64 = 192;
constexpr int ST_MT = 328;
constexpr int NCHUNK = SEG / 128;

#define DPP_MOV(v, ctrl, rm, bm) __builtin_bit_cast(float, __builtin_amdgcn_update_dpp(0, __builtin_bit_cast(int, (v)), (ctrl), (rm), (bm), true))
__device__ __forceinline__ float wave_incl_scan(float v, int) {
    float s = v + DPP_MOV(v, 0x111, 0xF, 0xF) + DPP_MOV(v, 0x112, 0xF, 0xF) + DPP_MOV(v, 0x113, 0xF, 0xF);
    s += DPP_MOV(s, 0x114, 0xF, 0xE);
    s += DPP_MOV(s, 0x118, 0xF, 0xC);
    s += DPP_MOV(s, 0x142, 0xA, 0xF);
    s += DPP_MOV(s, 0x143, 0xC, 0xF);
    return s;
}
__device__ __forceinline__ bf16x8 row_frag(const LAS unsigned char* tile, int stride, int row0, int k0, int lane) {
    return *(const LAS bf16x8*)(tile + (row0 + (lane & 31)) * stride + (k0 + 8 * (lane >> 5)) * 2);
}
__device__ __forceinline__ bf16x8 tr_frag(const LAS unsigned char* tile, int stride, int k0, int c0, int lane) {
    const int g = lane >> 4, li = lane & 15, q = li >> 2, pp = li & 3;
    const LAS unsigned char* a0 = tile + (k0 + 8 * (g >> 1) + q) * stride + (c0 + 16 * (g & 1) + 4 * pp) * 2;
    const s16x4 lo = __builtin_amdgcn_ds_read_tr16_b64_v4i16((LAS s16x4*)a0);
    const s16x4 hi = __builtin_amdgcn_ds_read_tr16_b64_v4i16((LAS s16x4*)(a0 + 4 * stride));
    return __builtin_shufflevector(lo, hi, 0, 1, 2, 3, 4, 5, 6, 7);
}
__device__ __forceinline__ u32x4 pack8(const float (&v)[8]) { u32x4 r; r.x = cvt_pk_bf16(v[0], v[1]); r.y = cvt_pk_bf16(v[2], v[3]); r.z = cvt_pk_bf16(v[4], v[5]); r.w = cvt_pk_bf16(v[6], v[7]); return r; }
__device__ __forceinline__ u32x4 pack8s(const float (&v)[8], float sc) { u32x4 r; r.x = cvt_pk_bf16(v[0] * sc, v[1] * sc); r.y = cvt_pk_bf16(v[2] * sc, v[3] * sc); r.z = cvt_pk_bf16(v[4] * sc, v[5] * sc); r.w = cvt_pk_bf16(v[6] * sc, v[7] * sc); return r; }

__device__ __forceinline__ void conv_load(const bf16_t* proj, int row0, int rq, int xch, bool lo_ok, bool hi_ok, u32x4 (&raw)[8]) {
    const bf16_t* base = proj + (size_t)(row0 + 4 * rq) * NPROJ + 1536 + xch;
    unsigned zz; asm volatile("v_mov_b32 %0, 0" : "=v"(zz));
#pragma unroll
    for (int j = 0; j < 8; ++j) {
        if (j < 2) { const bool ok = (rq > 0) || lo_ok; const u32x4 v = *(const u32x4*)(ok ? base + (j - 2) * NPROJ : base);
            raw[j].x = ok ? v.x : zz; raw[j].y = ok ? v.y : zz; raw[j].z = ok ? v.z : zz; raw[j].w = ok ? v.w : zz; }
        else if (j >= 6) { const bool ok = (rq < 31) || hi_ok; const u32x4 v = *(const u32x4*)(ok ? base + (j - 2) * NPROJ : base);
            raw[j].x = ok ? v.x : zz; raw[j].y = ok ? v.y : zz; raw[j].z = ok ? v.z : zz; raw[j].w = ok ? v.w : zz; }
        else raw[j] = *(const u32x4*)(base + (j - 2) * NPROJ);
    }
}
__device__ __forceinline__ void conv_compute(const u32x4 (&raw)[8], const LAS float* wl, int nchl, int wch, float (&o)[4][8]) {
    float w[5][8], bs[8];
#pragma unroll
    for (int j = 0; j < 5; ++j) { const f32x4 w0 = *(const LAS f32x4*)(wl + j * nchl + wch), w1 = *(const LAS f32x4*)(wl + j * nchl + wch + 4);
        w[j][0] = w0[0]; w[j][1] = w0[1]; w[j][2] = w0[2]; w[j][3] = w0[3]; w[j][4] = w1[0]; w[j][5] = w1[1]; w[j][6] = w1[2]; w[j][7] = w1[3]; }
    { const f32x4 b0 = *(const LAS f32x4*)(wl + 5 * nchl + wch), b1 = *(const LAS f32x4*)(wl + 5 * nchl + wch + 4); bs[0] = b0[0]; bs[1] = b0[1]; bs[2] = b0[2]; bs[3] = b0[3]; bs[4] = b1[0]; bs[5] = b1[1]; bs[6] = b1[2]; bs[7] = b1[3]; }
#pragma unroll
    for (int i = 0; i < 4; ++i)
#pragma unroll
        for (int e = 0; e < 8; ++e) o[i][e] = bs[e];
#pragma unroll
    for (int j = 0; j < 8; ++j) {
        float xv[8] = {bflo(raw[j].x), bfhi(raw[j].x), bflo(raw[j].y), bfhi(raw[j].y), bflo(raw[j].z), bfhi(raw[j].z), bflo(raw[j].w), bfhi(raw[j].w)};
#pragma unroll
        for (int i = 0; i < 4; ++i) { const int tap = j - i; if (tap >= 0 && tap < 5) {
#pragma unroll
                for (int e = 0; e < 8; ++e) o[i][e] += w[tap][e] * xv[e]; } }
    }
#pragma unroll
    for (int i = 0; i < 4; ++i)
#pragma unroll
        for (int e = 0; e < 8; ++e) o[i][e] = siluf_(o[i][e]);
}
__device__ __forceinline__ void head_cums(CP p, int l, int row0, int h, int dir, int lane, LAS float* hv) {
    const float A = -expf(p->a_log[l * 16 + dir * 8 + h]);
    const float* DT = (const float*)(p->ws + WS_DT);
    const float d0 = DT[(size_t)(row0 + 2 * lane) * 16 + dir * 8 + h], d1 = DT[(size_t)(row0 + 2 * lane + 1) * 16 + dir * 8 + h];
    const float x0 = d0 * A, x1 = d1 * A;
    const float incl = wave_incl_scan(x0 + x1, lane);
    const float total = __builtin_bit_cast(float, __builtin_amdgcn_readlane(__builtin_bit_cast(int, incl), 63));
    float c0, c1;
    if (dir == 0) { c1 = incl; c0 = incl - x1; } else { c0 = total - (incl - x1 - x0); c1 = total - (incl - x1); }
    hv[dir * 128 + 2 * lane] = c0; hv[dir * 128 + 2 * lane + 1] = c1;
    hv[256 + dir * 128 + 2 * lane] = d0; hv[256 + dir * 128 + 2 * lane + 1] = d1;
    if (lane == 0) hv[512 + dir] = total;
}
__device__ __forceinline__ bf16x8 scale_frag(bf16x8 f, const f32x4 w0, const f32x4 w1) {
    const u32x4 u = __builtin_bit_cast(u32x4, f);
    u32x4 r;
    r.x = cvt_pk_bf16(bflo(u.x) * w0[0], bfhi(u.x) * w0[1]); r.y = cvt_pk_bf16(bflo(u.y) * w0[2], bfhi(u.y) * w0[3]);
    r.z = cvt_pk_bf16(bflo(u.z) * w1[0], bfhi(u.z) * w1[1]); r.w = cvt_pk_bf16(bflo(u.w) * w1[2], bfhi(u.w) * w1[3]);
    return __builtin_bit_cast(bf16x8, r);
}
constexpr int ST_X256 = 576;

__device__ __forceinline__ void phase_c1(CP p, int l, unsigned char* lds_, int bid, int nb) {
    LAS unsigned char* lds = (LAS unsigned char*)lds_;
    LAS unsigned char* tile = lds;
    LAS float* wl = (LAS float*)(lds + 73216);
    const int tid = launder_tid();
    const bf16_t* proj = (const bf16_t*)(p->ws + WS_PROJ); bf16_t* mix = (bf16_t*)(p->ws + WS_HX);
#pragma unroll 1
    for (int u = bid; u < 256 + 512 + (l == DEPTH - 1 ? 0 : 16); u += nb) {
        int S, LEN, LSH, pstride, sstride, tok0, ch0;
        if (u < 256) { const int b = u >> 7, cs = (u >> 2) & 31, cc = u & 3; S = 2; LEN = 256; LSH = 8; pstride = 64; sstride = 1; tok0 = b * SEG + CTXL + 2 * cs; ch0 = 256 + 64 * cc; }
        else if (u < 768) { const int v = u - 256; const int b = v >> 8, rg = (v >> 2) & 63, cc = v & 3; S = 4; LEN = 64; LSH = 6; pstride = 1; sstride = 64; tok0 = b * SEG + CTXL + 256 * rg; ch0 = 64 * cc; }
        else { const int v = u - 768; const int b = v >> 3, cc = v & 7; S = 1; LEN = 256; LSH = 8; pstride = 1; sstride = 0; tok0 = b * SEG; ch0 = 64 * cc; }
        const int LP = LEN + 30;
        { float tw[4];
#pragma unroll
          for (int it = 0; it < 4; ++it) { const int i = tid + NTHREADS * it; const int j = i >> 6, c = i & 63; tw[it] = j < 31 ? p->conv_w[((size_t)l * 31 + j) * 512 + ch0 + c] : p->conv_b[l * 512 + ch0 + c]; }
#pragma unroll
          for (int it = 0; it < 4; ++it) wl[tid + NTHREADS * it] = tw[it]; }
        for (int i = tid; i < S * 30 * 8; i += NTHREADS) { const int pc = i & 7, q = (i >> 3) % 30, sq = (i >> 3) / 30; const int pos = q < 15 ? q : LEN + q;
            unsigned zz; asm volatile("v_mov_b32 %0, 0" : "=v"(zz));
            *(LAS u32x4*)(tile + ((sq * LP + pos) * 64 + pc * 8) * 2) = (u32x4){zz, zz, zz, zz}; }
        for (int ib = 0; ib < S * LEN * 8; ib += 4 * NTHREADS) {
            u32x4 uv[4];
#pragma unroll
            for (int q = 0; q < 4; ++q) { const int i = ib + tid + NTHREADS * q; const int pc = i & 7, t = i >> 3; const int sq = t >> LSH, pos = t & (LEN - 1);
                const bf16_t* src = proj + (size_t)(tok0 + sq * sstride + pos * pstride) * NPROJ + ch0 + pc * 8;
                uv[q] = *(const u32x4*)src; }
#pragma unroll
            for (int q = 0; q < 4; ++q) { const int i = ib + tid + NTHREADS * q; const int pc = i & 7, t = i >> 3; const int sq = t >> LSH, pos = t & (LEN - 1);
                const u32x4 o = uv[q];
                *(LAS u32x4*)(tile + ((sq * LP + 15 + pos) * 64 + pc * 8) * 2) = o; }
        }
        __syncthreads();
        const int noct = S * LEN / 8;
#pragma unroll 1
        for (int it = tid; it < noct * 32; it += NTHREADS) {
            const int cp = it & 31, oc = it >> 5; const int sq = oc >> (LSH - 3), p0 = (oc & ((LEN >> 3) - 1)) * 8;
            const LAS unsigned* base = (const LAS unsigned*)(tile + ((sq * LP + p0) * 64) * 2) + cp;
            float i0[38], i1[38];
#pragma unroll
            for (int k = 0; k < 38; ++k) { const unsigned w = base[k * 32]; i0[k] = bflo(w); i1[k] = bfhi(w); }
            float a0[8], a1[8];
            { const float b0 = wl[31 * 64 + 2 * cp], b1 = wl[31 * 64 + 2 * cp + 1];
#pragma unroll
              for (int i = 0; i < 8; ++i) { a0[i] = b0; a1[i] = b1; } }
#pragma unroll
            for (int j = 0; j < 31; ++j) { typedef float f32x2 __attribute__((ext_vector_type(2))); const f32x2 wj = *(const LAS f32x2*)(wl + j * 64 + 2 * cp); const float w0 = wj[0], w1 = wj[1];
#pragma unroll
                for (int i = 0; i < 8; ++i) { a0[i] += w0 * i0[i + j]; a1[i] += w1 * i1[i + j]; } }
#pragma unroll
            for (int i = 0; i < 8; ++i) { const int tok = tok0 + sq * sstride + (p0 + i) * pstride;
                *(unsigned*)(mix + (size_t)tok * 1024 + 512 + ch0 + 2 * cp) = cvt_pk_bf16(a0[i], a1[i]); }
        }
        __syncthreads();
    }
}
__device__ __forceinline__ void phase_c1_ln(CP p, int l, int bid, int nb) {
    const int tid = launder_tid(); const int lane = tid & 63, wave = tid >> 6;
    bf16_t* mix = (bf16_t*)(p->ws + WS_HX);
    const f32x4 g0 = *(const f32x4*)(p->conv_ln_g + l * 512 + lane * 8), g1 = *(const f32x4*)(p->conv_ln_g + l * 512 + lane * 8 + 4);
    const f32x4 b0 = *(const f32x4*)(p->conv_ln_b + l * 512 + lane * 8), b1 = *(const f32x4*)(p->conv_ln_b + l * 512 + lane * 8 + 4);
    const float gg[8] = {g0[0], g0[1], g0[2], g0[3], g1[0], g1[1], g1[2], g1[3]}, bb[8] = {b0[0], b0[1], b0[2], b0[3], b1[0], b1[1], b1[2], b1[3]};
    u32x4 vn = {0u, 0u, 0u, 0u};
    if (bid * 8 + wave < R) vn = *(const u32x4*)(mix + (size_t)(bid * 8 + wave) * 1024 + 512 + lane * 8);
    for (int r = bid * 8 + wave; r < R; r += nb * 8) {
        u32x4* ptr = (u32x4*)(mix + (size_t)r * 1024 + 512 + lane * 8);
        const u32x4 v = vn;
        if (r + nb * 8 < R) vn = *(const u32x4*)(mix + (size_t)(r + nb * 8) * 1024 + 512 + lane * 8);
        float y[8] = {bflo(v.x), bfhi(v.x), bflo(v.y), bfhi(v.y), bflo(v.z), bfhi(v.z), bflo(v.w), bfhi(v.w)};
        float s = 0.f;
#pragma unroll
        for (int e = 0; e < 8; ++e) s += y[e];
        const float mu = wave_sum(s) * (1.f / 512.f);
        float q = 0.f;
#pragma unroll
        for (int e = 0; e < 8; ++e) { y[e] -= mu; q += y[e] * y[e]; }
        const float rstd = rsqrtf(wave_sum(q) * (1.f / 512.f) + 1e-5f);
        float o[8];
#pragma unroll
        for (int e = 0; e < 8; ++e) o[e] = siluf_(y[e] * rstd * gg[e] + bb[e]);
        *ptr = pack8(o);
    }
}
__device__ __forceinline__ void phase_s1(CP p, int l, unsigned char* lds_, int bid, int nb) {
    LAS unsigned char* lds = (LAS unsigned char*)lds_;
    LAS unsigned char* Bs = lds;
    LAS unsigned char* Xs = lds + 128 * ST_TR128;
    LAS float* wv = (LAS float*)(Xs + 128 * ST_X256);
    LAS float* hvs = wv + 8 * 128;
    LAS float* cwl = hvs + 4 * 520;
    const int tid = launder_tid(); const int lane = tid & 63, wave = __builtin_amdgcn_readfirstlane(tid >> 6);
    const bf16_t* proj = (const bf16_t*)(p->ws + WS_PROJ);
    const float* cw = p->ssd_conv_w + (size_t)l * 5 * 1024; const float* cbias = p->ssd_conv_b + (size_t)l * 1024;
    bf16_t* Sg = (bf16_t*)(p->ws + WS_S); float* DEC = (float*)(p->ws + WS_DEC);
    int cur_g = -1;
#pragma unroll 1
    for (int u = bid; u < NB * NCHUNK * 2; u += nb) {
        const int g = u & 1, c = (u >> 1) % NCHUNK, b = (u >> 1) / NCHUNK;
        const int row0 = b * SEG + c * 128;
        const bool lo_ok = !(c == 0 || c == 2), hi_ok = !(c == 1 || c == NCHUNK - 1);
        if (g != cur_g) { cur_g = g;
            float tw[5];
#pragma unroll
            for (int it = 0; it < 5; ++it) { const int i = tid + NTHREADS * it; const int j = i / 384, lc = i - j * 384; const int gch = lc < 128 ? 512 + g * 128 + lc : g * 256 + (lc - 128);
                tw[it] = i < 6 * 384 ? (j < 5 ? cw[j * 1024 + gch] : cbias[gch]) : 0.f; }
#pragma unroll
            for (int it = 0; it < 5; ++it) { const int i = tid + NTHREADS * it; if (i < 6 * 384) cwl[i] = tw[it]; } }
        const int hh = wave >> 1, dir = wave & 1, h = 4 * g + hh;
        u32x4 rb[8], rx0[8], rx1[8];
        conv_load(proj, row0, tid >> 4, 512 + g * 128 + (tid & 15) * 8, lo_ok, hi_ok, rb);
        conv_load(proj, row0, tid >> 5, g * 256 + (tid & 31) * 8, lo_ok, hi_ok, rx0);
        conv_load(proj, row0, (tid >> 5) + 16, g * 256 + (tid & 31) * 8, lo_ok, hi_ok, rx1);
        head_cums(p, l, row0, h, dir, lane, hvs + hh * 520);
        __syncthreads();
        {
            const LAS float* hv = hvs + hh * 520; const float tot = hv[512 + dir];
#pragma unroll
            for (int q = 0; q < 2; ++q) { const int lr = lane + 64 * q; wv[wave * 128 + lr] = __expf(tot - hv[dir * 128 + lr]) * hv[256 + dir * 128 + lr]; }
            if (lane == 0) DEC[((size_t)(b * 2 + dir) * NCHUNK + c) * 8 + h] = __expf(tot);
        }
        { float o[4][8];
          conv_compute(rb, cwl, 384, (tid & 15) * 8, o);
#pragma unroll
          for (int i = 0; i < 4; ++i) *(LAS u32x4*)(Bs + (4 * (tid >> 4) + i) * ST_TR128 + (tid & 15) * 16) = pack8(o[i]);
          conv_compute(rx0, cwl, 384, 128 + (tid & 31) * 8, o);
#pragma unroll
          for (int i = 0; i < 4; ++i) *(LAS u32x4*)(Xs + (4 * (tid >> 5) + i) * ST_X256 + (tid & 31) * 16) = pack8(o[i]);
          conv_compute(rx1, cwl, 384, 128 + (tid & 31) * 8, o);
#pragma unroll
          for (int i = 0; i < 4; ++i) *(LAS u32x4*)(Xs + (4 * ((tid >> 5) + 16) + i) * ST_X256 + (tid & 31) * 16) = pack8(o[i]); }
        __syncthreads();
        {
            f32x16 acc[2][4];
#pragma unroll
            for (int t = 0; t < 2; ++t)
#pragma unroll
                for (int q = 0; q < 4; ++q)
#pragma unroll
                    for (int e = 0; e < 16; ++e) acc[t][q][e] = 0.f;
#pragma unroll 2
            for (int kk = 0; kk < 8; ++kk) {
                const LAS float* wp = wv + wave * 128 + 16 * kk + 8 * (lane >> 5);
                const f32x4 w0 = *(const LAS f32x4*)wp, w1 = *(const LAS f32x4*)(wp + 4);
                bf16x8 af[2];
#pragma unroll
                for (int t = 0; t < 2; ++t) af[t] = scale_frag(tr_frag(Xs, ST_X256, 16 * kk, hh * 64 + 32 * t, lane), w0, w1);
#pragma unroll
                for (int q = 0; q < 4; ++q) { const bf16x8 bf = tr_frag(Bs, ST_TR128, 16 * kk, 32 * q, lane);
#pragma unroll
                    for (int t = 0; t < 2; ++t) acc[t][q] = __builtin_amdgcn_mfma_f32_32x32x16_bf16(bf, af[t], acc[t][q], 0, 0, 0); }
            }
            bf16_t* So = Sg + ((size_t)((b * 2 + dir) * NCHUNK + c) * 8 + h) * 8192 + (size_t)(lane & 31) * 128 + 4 * (lane >> 5);
#pragma unroll
            for (int t = 0; t < 2; ++t)
#pragma unroll
                for (int q = 0; q < 4; ++q)
#pragma unroll
                    for (int rg = 0; rg < 4; ++rg) { u32x2 pk; pk.x = cvt_pk_bf16(acc[t][q][4 * rg], acc[t][q][4 * rg + 1]); pk.y = cvt_pk_bf16(acc[t][q][4 * rg + 2], acc[t][q][4 * rg + 3]);
                        *(u32x2*)(So + (size_t)(32 * t) * 128 + 32 * q + 8 * rg) = pk; }
        }
        __syncthreads();
    }
}
__device__ __forceinline__ void phase_s2(CP p, int bid, int nb) {
    const int tid = launder_tid();
    const bf16_t* Sg = (const bf16_t*)(p->ws + WS_S); const float* DEC = (const float*)(p->ws + WS_DEC); bf16_t* HP = (bf16_t*)(p->ws + WS_HP);
    for (int idx = bid * NTHREADS + tid; idx < 2 * 2 * 8 * 64 * 64; idx += nb * NTHREADS) {
        const int n2 = idx & 63, pr = (idx >> 6) & 63, h = (idx >> 12) & 7, dir = (idx >> 15) & 1, b = idx >> 16;
        const size_t inner = (size_t)h * 8192 + pr * 128 + 2 * n2;
        const size_t cbase = (size_t)(b * 2 + dir) * NCHUNK;
        float s0 = 0.f, s1 = 0.f;
#pragma unroll 26
        for (int step = 0; step < NCHUNK; ++step) {
            const int c = dir == 0 ? step : (step < 2 ? 1 - step : NCHUNK + 1 - step);
            const size_t off = (cbase + c) * 65536 + inner;
            const unsigned sv = *(const unsigned*)(Sg + off); const float d = DEC[(cbase + c) * 8 + h];
            *(unsigned*)(HP + off) = cvt_pk_bf16(s0, s1);
            s0 = s0 * d + bflo(sv); s1 = s1 * d + bfhi(sv);
        }
    }
}
__device__ __forceinline__ void phase_s3(CP p, int l, unsigned char* lds_, int bid, int nb) {
    LAS unsigned char* lds = (LAS unsigned char*)lds_;
    LAS unsigned char* Cs = lds;
    LAS unsigned char* Bs = Cs + 128 * ST_ROW;
    LAS unsigned char* Mt = Bs;
    LAS unsigned char* Xs = Bs + 128 * ST_MT;
    LAS unsigned char* Hf = Xs + 128 * ST_TR64;
    LAS unsigned char* Hb = Hf + 64 * ST_ROW;
    LAS float* hvs = (LAS float*)(Hb + 64 * ST_ROW);
    LAS float* ssqp = hvs + 4 * 776;
    LAS float* cwl = ssqp + 256;
    const int tid0 = launder_tid(); const int wave = __builtin_amdgcn_readfirstlane(tid0 >> 6);
    const bf16_t* proj = (const bf16_t*)(p->ws + WS_PROJ); bf16_t* mix = (bf16_t*)(p->ws + WS_HX);
    const float* cw = p->ssd_conv_w + (size_t)l * 5 * 1024; const float* cbias = p->ssd_conv_b + (size_t)l * 1024;
    const bf16_t* HP = (const bf16_t*)(p->ws + WS_HP); float* SSQ = (float*)(p->ws + WS_SSQ);
    int cur_g = -1;
    const int cskip = (l == DEPTH - 1) ? 2 : 0, cpb = NCHUNK - cskip;
    const int nunits = NB * cpb * 2, nfull = nunits - nunits % nb, nitems = nfull + (nunits - nfull) * 4;
#pragma unroll 1
    for (int it = bid; it < nitems; it += nb) {
        const int u = it < nfull ? it : nfull + ((it - nfull) >> 2);
        const int hh_lo = it < nfull ? 0 : ((it - nfull) & 3), hh_hi = it < nfull ? 4 : hh_lo + 1;
        const int g = u & 1, c = cskip + (u >> 1) % cpb, b = (u >> 1) / cpb;
        int tid = tid0; asm volatile("" : "+v"(tid));
        const int lane = tid & 63;
        const int row0 = b * SEG + c * 128;
        const bool lo_ok = !(c == 0 || c == 2), hi_ok = !(c == 1 || c == NCHUNK - 1);
        if (g != cur_g) { cur_g = g;
            float tw[6];
#pragma unroll
            for (int it = 0; it < 6; ++it) { const int i = tid + NTHREADS * it; const int j = i >> 9, lc = i & 511; const int gch = lc < 128 ? 768 + g * 128 + lc : (lc < 256 ? 512 + g * 128 + (lc - 128) : g * 256 + (lc - 256));
                tw[it] = j < 5 ? cw[j * 1024 + gch] : cbias[gch]; }
#pragma unroll
            for (int it = 0; it < 6; ++it) cwl[tid + NTHREADS * it] = tw[it]; }
        u32x4 rx[8];
        {
            u32x4 r0[8], r1[8];
            const int cg = tid & 31; const int gch = (cg < 16 ? 768 : 512) + g * 128 + (cg & 15) * 8;
            conv_load(proj, row0, tid >> 5, gch, lo_ok, hi_ok, r0);
            conv_load(proj, row0, (tid >> 5) + 16, gch, lo_ok, hi_ok, r1);
            head_cums(p, l, row0, 4 * g + (wave >> 1), wave & 1, lane, hvs + (wave >> 1) * 776);
            { LAS float* hvw = hvs + (wave >> 1) * 776; const int dr = wave & 1;
              hvw[520 + dr * 128 + 2 * lane] = __expf(hvw[dr * 128 + 2 * lane]); hvw[520 + dr * 128 + 2 * lane + 1] = __expf(hvw[dr * 128 + 2 * lane + 1]); }
            __syncthreads();
            float o[4][8];
            LAS unsigned char* dst = (cg < 16 ? Cs : Bs) + (cg & 15) * 16;
            conv_compute(r0, cwl, 512, cg * 8, o);
#pragma unroll
            for (int i = 0; i < 4; ++i) *(LAS u32x4*)(dst + (4 * (tid >> 5) + i) * ST_ROW) = pack8(o[i]);
            asm volatile("" ::: "memory");
            if (tid < 256) conv_load(proj, row0, tid >> 3, g * 256 + hh_lo * 64 + (tid & 7) * 8, lo_ok, hi_ok, rx);
            conv_compute(r1, cwl, 512, cg * 8, o);
#pragma unroll
            for (int i = 0; i < 4; ++i) *(LAS u32x4*)(dst + (4 * ((tid >> 5) + 16) + i) * ST_ROW) = pack8(o[i]);
            if (tid < 256) { conv_compute(rx, cwl, 512, 256 + hh_lo * 64 + (tid & 7) * 8, o);
#pragma unroll
                for (int i = 0; i < 4; ++i) *(LAS u32x4*)(Xs + (4 * (tid >> 3) + i) * ST_TR64 + (tid & 7) * 16) = pack8(o[i]); }
        }
        __syncthreads();
        const int lb = wave >> 1, hs = wave & 1;
        int ln = lane; asm volatile("" : "+v"(ln));
        f32x16 gacc[2];
#pragma unroll
        for (int t = 0; t < 2; ++t)
#pragma unroll
            for (int e = 0; e < 16; ++e) gacc[t][e] = 0.f;
#pragma unroll
        for (int kk = 0; kk < 8; ++kk) { const bf16x8 af = row_frag(Cs, ST_ROW, 32 * lb, 16 * kk, lane);
#pragma unroll
            for (int t = 0; t < 2; ++t) { const bf16x8 bf = row_frag(Bs, ST_ROW, 64 * hs + 32 * t, 16 * kk, lane);
                gacc[t] = __builtin_amdgcn_mfma_f32_32x32x16_bf16(af, bf, gacc[t], 0, 0, 0); } }
        u32x4 hreg[4];
        { const bf16_t* hp0 = HP + ((size_t)(b * 2 * NCHUNK + c) * 8 + 4 * g + hh_lo) * 8192;
#pragma unroll
          for (int q = 0; q < 4; ++q) { const int it = tid + 512 * q; hreg[q] = *(const u32x4*)(hp0 + (size_t)(it >> 10) * NCHUNK * 8 * 8192 + (it & 1023) * 8); } }
        __syncthreads();
#pragma unroll 1
        for (int hh = hh_lo; hh < hh_hi; ++hh) {
            const int h = 4 * g + hh; const LAS float* hv = hvs + hh * 776;
            asm volatile("" : "+v"(ln));
            const int ph = hs, pc = 32 * ph + (ln & 31);
#pragma unroll
            for (int t = 0; t < 2; ++t) {
                const int st = 2 * hs + t;
                const int sc = 32 * st + (ln & 31);
                const float cfs = hv[sc], cbs = hv[128 + sc], dfs = hv[256 + sc], dbs = hv[384 + sc];
#pragma unroll
                for (int rg = 0; rg < 4; ++rg) {
                    const int l0 = 32 * lb + 8 * rg + 4 * (ln >> 5);
                    float m[4];
                    if (st < lb) {
                        const f32x4 cfl = *(const LAS f32x4*)(hv + l0);
#pragma unroll
                        for (int e = 0; e < 4; ++e) m[e] = gacc[t][4 * rg + e] * (__expf(cfl[e] - cfs) * dfs);
                    } else if (st > lb) {
                        const f32x4 cbl = *(const LAS f32x4*)(hv + 128 + l0);
#pragma unroll
                        for (int e = 0; e < 4; ++e) m[e] = gacc[t][4 * rg + e] * (__expf(cbl[e] - cbs) * dbs);
                    } else {
                        const f32x4 cfl = *(const LAS f32x4*)(hv + l0), cbl = *(const LAS f32x4*)(hv + 128 + l0);
#pragma unroll
                        for (int e = 0; e < 4; ++e) { const int lr = l0 + e;
                            const float ff = lr >= sc ? __expf(cfl[e] - cfs) * dfs : 0.f;
                            const float fb = lr <= sc ? __expf(cbl[e] - cbs) * dbs : 0.f;
                            m[e] = gacc[t][4 * rg + e] * (ff + fb); }
                    }
                    u32x2 pk; pk.x = cvt_pk_bf16(m[0], m[1]); pk.y = cvt_pk_bf16(m[2], m[3]);
                    *(LAS u32x2*)(Mt + sc * ST_MT + l0 * 2) = pk;
                }
            }
#pragma unroll
            for (int q = 0; q < 4; ++q) { const int it = tid + 512 * q; const int q2 = it & 1023;
                *(LAS u32x4*)(((it >> 10) ? Hb : Hf) + (q2 >> 4) * ST_ROW + (q2 & 15) * 16) = hreg[q]; }
            if (hh + 1 < hh_hi) {
                const bf16_t* hp0 = HP + ((size_t)(b * 2 * NCHUNK + c) * 8 + h + 1) * 8192;
#pragma unroll
                for (int q = 0; q < 4; ++q) { const int it = tid + 512 * q; hreg[q] = *(const u32x4*)(hp0 + (size_t)(it >> 10) * NCHUNK * 8 * 8192 + (it & 1023) * 8); }
                if (tid < 256) conv_load(proj, row0, tid >> 3, g * 256 + (hh + 1) * 64 + (tid & 7) * 8, lo_ok, hi_ok, rx);
            }
            unsigned zraw[8];
#pragma unroll
            for (int ri = 0; ri < 16; ri += 2) { const int lr = 32 * lb + 8 * (ri >> 2) + 4 * (ln >> 5) + (ri & 3);
                const bf16_t* zp = proj + (size_t)(row0 + lr) * NPROJ + 1024 + h * 64 + pc;
                zraw[ri >> 1] = (unsigned)zp[0] | ((unsigned)zp[NPROJ] << 16); }
            __syncthreads();
            f32x16 ad, af_, ab_;
#pragma unroll
            for (int e = 0; e < 16; ++e) { ad[e] = 0.f; af_[e] = 0.f; ab_[e] = 0.f; }
#pragma unroll
            for (int kk = 0; kk < 8; ++kk) {
                const bf16x8 am = tr_frag(Mt, ST_MT, 16 * kk, 32 * lb, lane);
                const bf16x8 bx = tr_frag(Xs, ST_TR64, 16 * kk, 32 * ph, lane);
                ad = __builtin_amdgcn_mfma_f32_32x32x16_bf16(am, bx, ad, 0, 0, 0);
                const bf16x8 ac = row_frag(Cs, ST_ROW, 32 * lb, 16 * kk, lane);
                const bf16x8 bhf = row_frag(Hf, ST_ROW, 32 * ph, 16 * kk, lane);
                const bf16x8 bhb = row_frag(Hb, ST_ROW, 32 * ph, 16 * kk, lane);
                af_ = __builtin_amdgcn_mfma_f32_32x32x16_bf16(ac, bhf, af_, 0, 0, 0);
                ab_ = __builtin_amdgcn_mfma_f32_32x32x16_bf16(ac, bhb, ab_, 0, 0, 0);
            }
            const float dsk = p->d_skip[l * 8 + h];
#pragma unroll
            for (int rg = 0; rg < 4; ++rg) {
                const int l0 = 32 * lb + 8 * rg + 4 * (ln >> 5);
                const f32x4 efl = *(const LAS f32x4*)(hv + 520 + l0), ebl = *(const LAS f32x4*)(hv + 648 + l0);
#pragma unroll
                for (int e = 0; e < 4; ++e) { const int lr = l0 + e; const int ri = 4 * rg + e;
                    const float xs = bf2f(*(const LAS bf16_t*)(Xs + lr * ST_TR64 + pc * 2));
                    const float y = ad[ri] + efl[e] * af_[ri] + ebl[e] * ab_[ri] + dsk * xs;
                    const float z = (ri & 1) ? bfhi(zraw[ri >> 1]) : bflo(zraw[ri >> 1]);
                    const float val = y * z;
                    mix[(size_t)(row0 + lr) * 1024 + h * 64 + pc] = f2bf(val);
                    const float sq = half_sum32(val * val);
                    if ((ln & 31) == 31) ssqp[ph * 128 + lr] = sq;
                }
            }
            __syncthreads();
            if (tid < 128) SSQ[(size_t)(row0 + tid) * 8 + h] = ssqp[tid] + ssqp[128 + tid];
            if (hh + 1 < hh_hi && tid < 256) { float o[4][8];
                conv_compute(rx, cwl, 512, 256 + (hh + 1) * 64 + (tid & 7) * 8, o);
#pragma unroll
                for (int i = 0; i < 4; ++i) *(LAS u32x4*)(Xs + (4 * (tid >> 3) + i) * ST_TR64 + (tid & 7) * 16) = pack8(o[i]); }
        }
        __syncthreads();
    }
}
__device__ __forceinline__ void phase_r2(CP p, int l, unsigned char* lds_, int bid, int nb) {
    LAS unsigned char* lds = (LAS unsigned char*)lds_;
    LAS unsigned char* Wh = lds;
    LAS unsigned char* Xh = Wh + 32 * ST_H16;
    LAS float* gm = (LAS float*)(Xh + 16 * ST_H16);
    LAS float* sh = gm + 3 * 1024;
    LAS float* part = sh + 3 * 1024;
    LAS float* lgs = part + 8 * 16 * 32;
    LAS int* lcnt = (LAS int*)(lgs + 16 * 32);
    LAS int* lcls = lcnt + 64;
    LAS int* lrank = lcls + 512;
    LAS float* lcwa = (LAS float*)(lrank + 512);
    LAS float* lcwb = lcwa + 512;
    const int tid = launder_tid(); const int lane = tid & 63, wave = __builtin_amdgcn_readfirstlane(tid >> 6);
    const float* mod = (const float*)(p->ws + WS_MOD) + (size_t)l * 3 * 6144;
    {
        float tmp[8];
#pragma unroll
        for (int it = 0; it < 8; ++it) tmp[it] = p->w_rg[(size_t)l * 4096 + tid + NTHREADS * it];
#pragma unroll
        for (int it = 0; it < 8; ++it) { const int idx = tid + NTHREADS * it; *(LAS _Float16*)(Wh + (idx & 3) * ST_H16 + (idx >> 2) * 2) = (_Float16)tmp[it]; } }
#pragma unroll
    for (int hb = 0; hb < 2; ++hb) { float tmp[16];
#pragma unroll
        for (int it = 0; it < 16; ++it) tmp[it] = p->w_re[(size_t)l * 16384 + tid + NTHREADS * (16 * hb + it)];
#pragma unroll
        for (int it = 0; it < 16; ++it) { const int idx = tid + NTHREADS * (16 * hb + it); *(LAS _Float16*)(Wh + (4 + (idx & 15)) * ST_H16 + (idx >> 4) * 2) = (_Float16)tmp[it]; } }
    { unsigned zz; asm volatile("v_mov_b32 %0, 0" : "=v"(zz));
      for (int i = tid; i < 12 * 128; i += NTHREADS) { const int rw = 20 + i / 128, c16 = i % 128; *(LAS u32x4*)(Wh + rw * ST_H16 + c16 * 16) = (u32x4){zz, zz, zz, zz}; } }
    { float t0[6], t1[6], t2[6];
#pragma unroll
      for (int it = 0; it < 6; ++it) { const int idx = tid + NTHREADS * it; const int v = idx >> 10, k = idx & 1023; t0[it] = p->g_ffn[l * 1024 + k]; t1[it] = mod[v * 6144 + 4 * 1024 + k]; t2[it] = mod[v * 6144 + 3 * 1024 + k]; }
#pragma unroll
      for (int it = 0; it < 6; ++it) { const int idx = tid + NTHREADS * it; gm[idx] = t0[it] * (1.f + t1[it]); sh[idx] = t2[it]; } }
    if (tid < 64) lcnt[tid] = 0;
    __syncthreads();
    bf16_t* HM = (bf16_t*)(p->ws + WS_HX); float* CWLA = (float*)(p->ws + WS_CWLA); float* CWLB = (float*)(p->ws + WS_CWLB);
    int* gcount = (int*)(p->ws + WS_CTL) + l * 32; int* LIST = (int*)(p->ws + WS_LIST);
    const int rpb = (R + nb - 1) / nb, r0 = bid * rpb, r1 = (r0 + rpb) < R ? (r0 + rpb) : R;
    RowRaw xn[2];
#pragma unroll
    for (int q = 0; q < 2; ++q) if (r0 + 2 * wave + q < r1) row_load(p, 1, r0 + 2 * wave + q, lane, xn[q]);
#pragma unroll 1
    for (int t0r = r0; t0r < r1; t0r += 16) {
        f32x4 xv[2][4];
#pragma unroll
        for (int q = 0; q < 2; ++q) row_cvt(1, xn[q], xv[q]);
#pragma unroll
        for (int q = 0; q < 2; ++q) if (t0r + 16 + 2 * wave + q < r1) row_load(p, 1, t0r + 16 + 2 * wave + q, lane, xn[q]);
#pragma unroll
        for (int q = 0; q < 2; ++q) { const int rr = t0r + 2 * wave + q; const bool ok = rr < r1; const int v = row_v(ok ? rr : r0);
            float ss = 0.f;
#pragma unroll
            for (int j = 0; j < 4; ++j) ss += xv[q][j][0] * xv[q][j][0] + xv[q][j][1] * xv[q][j][1] + xv[q][j][2] * xv[q][j][2] + xv[q][j][3] * xv[q][j][3];
            ss = wave_sum(ss); const float rs = ok ? __builtin_amdgcn_rsqf(ss * (1.f / 1024.f) + 1e-6f) : 0.f;
#pragma unroll
            for (int j = 0; j < 4; ++j) { const int k = 4 * lane + 256 * j; const f32x4 g4 = *(const LAS f32x4*)(gm + v * 1024 + k), s4 = *(const LAS f32x4*)(sh + v * 1024 + k);
                f32x4 hv = xv[q][j] * rs * g4 + s4; if (!ok) hv = hv * 0.f;
                u32x2 o; o.x = cvt_pk_bf16(hv[0], hv[1]); o.y = cvt_pk_bf16(hv[2], hv[3]);
                if (ok) *(u32x2*)(HM + (size_t)rr * 1024 + k) = o;
                u32x2 h16; h16.x = pack_f16(hv[0], hv[1]); h16.y = pack_f16(hv[2], hv[3]);
                *(LAS u32x2*)(Xh + (2 * wave + q) * ST_H16 + k * 2) = h16; } }
        __syncthreads();
        {
            f32x4 acc0 = {0.f, 0.f, 0.f, 0.f}, acc1 = {0.f, 0.f, 0.f, 0.f};
#pragma unroll
            for (int s4 = 0; s4 < 4; ++s4) { const int kb = (128 * wave + 32 * s4 + 8 * (lane >> 4)) * 2;
                const f16x8 a = *(const LAS f16x8*)(Xh + (lane & 15) * ST_H16 + kb);
                const f16x8 b0 = *(const LAS f16x8*)(Wh + (lane & 15) * ST_H16 + kb), b1 = *(const LAS f16x8*)(Wh + (16 + (lane & 15)) * ST_H16 + kb);
                acc0 = __builtin_amdgcn_mfma_f32_16x16x32_f16(a, b0, acc0, 0, 0, 0);
                acc1 = __builtin_amdgcn_mfma_f32_16x16x32_f16(a, b1, acc1, 0, 0, 0); }
#pragma unroll
            for (int e = 0; e < 4; ++e) { const int row = 4 * (lane >> 4) + e; part[(wave * 16 + row) * 32 + (lane & 15)] = acc0[e]; part[(wave * 16 + row) * 32 + 16 + (lane & 15)] = acc1[e]; }
        }
        __syncthreads();
        if (tid < 320) { const int row = tid / 20, n = tid - row * 20; float sacc = n < 4 ? p->b_rg[l * 4 + n] : p->b_re[l * 16 + n - 4];
#pragma unroll
            for (int w = 0; w < 8; ++w) sacc += part[(w * 16 + row) * 32 + n];
            lgs[row * 32 + n] = sacc; }
        __syncthreads();
        if (tid < 16) { const int rr = t0r + tid;
            if (rr < r1) {
                if (l == DEPTH - 1 && row_v(rr) == 2) lcls[rr - r0] = -1;
                else {
                    float lg[20];
#pragma unroll
                    for (int n = 0; n < 20; ++n) lg[n] = lgs[tid * 32 + n];
                    int gsel = 0; float gmax = lg[0];
#pragma unroll
                    for (int t = 1; t < 4; ++t) if (lg[t] > gmax) { gmax = lg[t]; gsel = t; }
                    float gden = 0.f;
#pragma unroll
                    for (int t = 0; t < 4; ++t) gden += __expf(lg[t] - gmax);
                    const float gprob = 1.f / gden;
                    float el[4];
#pragma unroll
                    for (int t = 0; t < 4; ++t) el[t] = gsel == 0 ? lg[4 + t] : (gsel == 1 ? lg[8 + t] : (gsel == 2 ? lg[12 + t] : lg[16 + t]));
                    int i0 = 0; float m0 = el[0];
#pragma unroll
                    for (int t = 1; t < 4; ++t) if (el[t] > m0) { m0 = el[t]; i0 = t; }
                    int i1 = -1; float m1 = -3.0e38f;
#pragma unroll
                    for (int t = 0; t < 4; ++t) if (t != i0 && el[t] > m1) { m1 = el[t]; i1 = t; }
                    const float w0 = gprob / (1.f + __expf(m1 - m0)), w1 = gprob - w0;
                    const int ea = i0 < i1 ? i0 : i1, eb = i0 < i1 ? i1 : i0;
                    const float cwa = i0 < i1 ? w0 : w1, cwb = i0 < i1 ? w1 : w0;
                    const int pidx = ea == 0 ? eb - 1 : (ea == 1 ? eb + 1 : 5);
                    const int cls = gsel * 6 + pidx;
                    const int rank = __hip_atomic_fetch_add(&lcnt[cls], 1, __ATOMIC_RELAXED, __HIP_MEMORY_SCOPE_WORKGROUP);
                    lcls[rr - r0] = cls; lrank[rr - r0] = rank; lcwa[rr - r0] = cwa; lcwb[rr - r0] = cwb;
                } } }
    }
    __syncthreads();
    if (tid < NCLS) lcnt[32 + tid] = atomicAdd(&gcount[tid], lcnt[tid]);
    __syncthreads();
    for (int idx = tid; idx < r1 - r0; idx += NTHREADS) { const int cl = lcls[idx]; if (cl < 0) continue; const int pos = lcnt[32 + cl] + lrank[idx]; const size_t li = (size_t)cl * R + pos;
        LIST[li] = r0 + idx; CWLA[li] = lcwa[idx]; CWLB[li] = lcwb[idx]; }
    __syncthreads();
}
__device__ __forceinline__ void phase_final(CP p, unsigned char* lds, int bid, int nb) {
    const int tid = launder_tid(); const int lane = tid & 63, wave = tid >> 6;
    const int qstep = nb * 8;
    RowRaw xn;
    { const int q = bid * 8 + wave; if (q < NB * SEQ) { const int b = q >= SEQ ? 1 : 0; row_load(p, 1, b * SEG + CTXL + (q - b * SEQ), lane, xn); } }
    for (int q = bid * 8 + wave; q < NB * SEQ; q += qstep) {
        f32x4* hr = (f32x4*)(p->out + (size_t)q * D);
        f32x4 xv[4]; float ss = 0.f;
        row_cvt(1, xn, xv);
        { const int qn = q + qstep; if (qn < NB * SEQ) { const int bn = qn >= SEQ ? 1 : 0; row_load(p, 1, bn * SEG + CTXL + (qn - bn * SEQ), lane, xn); } }
#pragma unroll
        for (int j = 0; j < 4; ++j) ss += xv[j][0] * xv[j][0] + xv[j][1] * xv[j][1] + xv[j][2] * xv[j][2] + xv[j][3] * xv[j][3];
        ss = wave_sum(ss); const float rs = rsqrtf(ss * (1.f / 1024.f) + 1e-6f);
#pragma unroll
        for (int j = 0; j < 4; ++j) { const f32x4 g4 = *(const f32x4*)(p->g_final + 4 * lane + 256 * j); hr[lane + 64 * j] = xv[j] * rs * g4; }
    }
}


#define XB_TMO      128
#define XB_XCNT(j)  (256  + 64 * (j))
#define XB_XSUB(j)  (1280 + 64 * (j))
#define XB_XGEN(j)  (2304 + 64 * (j))
#define XB_TOP      3328
#define XB_TOPGEN   3392
#define XCD_BAR_WORDS 3456
#define XB_SPIN_CAP (1u << 22)
__device__ __forceinline__ unsigned xb_ld(unsigned* p) { return __hip_atomic_load(p, __ATOMIC_RELAXED, __HIP_MEMORY_SCOPE_AGENT); }
__device__ __forceinline__ unsigned xb_add(unsigned* p, unsigned v) { return __hip_atomic_fetch_add(p, v, __ATOMIC_RELAXED, __HIP_MEMORY_SCOPE_AGENT); }
__device__ __forceinline__ unsigned xb_xcc_id() { return (unsigned)__builtin_amdgcn_s_getreg((3 << 11) | 20) & 0xFu; }
#define XB_SPIN(cond, bar) do { unsigned _sp = 0; while (cond) { __builtin_amdgcn_s_sleep(1); \
    if ((++_sp & 255u) == 0u) { if (xb_ld(&(bar)[XB_TMO])) break; if (_sp > XB_SPIN_CAP) { atomicAdd(&(bar)[XB_TMO], 1u); break; } } } } while (0)
struct XcdBarrier { unsigned* bar; unsigned x; volatile LAS unsigned* st; };
__device__ __forceinline__ XcdBarrier xcd_barrier_post(unsigned* bar, volatile LAS unsigned* st) {
    XcdBarrier b; b.bar = bar; b.x = xb_xcc_id(); b.st = st;
    if (threadIdx.x == 0) (void)xb_add(&bar[XB_XCNT(b.x)], 1u);
    return b;
}
__device__ __forceinline__ void xcd_barrier_complete(unsigned* bar, unsigned x, unsigned& nloc, unsigned& nx) {
    const unsigned G = gridDim.x * gridDim.y * gridDim.z;
    unsigned sum, cnt, mine, sp = 0u;
    for (;;) {
        sum = 0u; cnt = 0u; mine = 0u;
#pragma unroll
        for (unsigned j = 0; j < 16; ++j) { const unsigned c = xb_ld(&bar[XB_XCNT(j)]); sum += c; cnt += (c > 0u) ? 1u : 0u; mine = (j == x) ? c : mine; }
        if (sum == G) break;
        __builtin_amdgcn_s_sleep(1);
        if ((++sp & 255u) == 0u) { if (xb_ld(&bar[XB_TMO])) break; if (sp > XB_SPIN_CAP) { atomicAdd(&bar[XB_TMO], 1u); break; } }
    }
    nloc = mine > 0u ? mine : 1u; nx = cnt > 0u ? cnt : 1u;
}
__device__ __forceinline__ void xcd_barrier(const XcdBarrier& b) {
    asm volatile("s_waitcnt vmcnt(0)" ::: "memory");
    __syncthreads();
    if (threadIdx.x == 0) {
        unsigned* bar = b.bar;
        __builtin_amdgcn_s_waitcnt(0);
        unsigned nloc = b.st[0], nx = b.st[1];
        if (nloc == 0u) { xcd_barrier_complete(bar, b.x, nloc, nx); b.st[0] = nloc; b.st[1] = nx; }
        const unsigned old = xb_add(&bar[XB_XSUB(b.x)], 1u);
        const unsigned gen = old / nloc;
        if (old + 1u == (gen + 1u) * nloc) {
            __builtin_amdgcn_fence(__ATOMIC_RELEASE, "agent");
            asm volatile("s_waitcnt vmcnt(0)" ::: "memory");
            const unsigned og = xb_add(&bar[XB_TOP], 1u);
            const unsigned tg = og / nx;
            if (og + 1u == (tg + 1u) * nx) xb_add(&bar[XB_TOPGEN], 1u);
            else XB_SPIN(xb_ld(&bar[XB_TOPGEN]) == tg, bar);
            __builtin_amdgcn_fence(__ATOMIC_ACQUIRE, "agent");
            xb_add(&bar[XB_XGEN(b.x)], 1u);
            asm volatile("s_waitcnt vmcnt(0)" ::: "memory");
        } else {
            XB_SPIN(xb_ld(&bar[XB_XGEN(b.x)]) == gen, bar);
            __builtin_amdgcn_fence(__ATOMIC_ACQUIRE, "agent");
            asm volatile("s_waitcnt vmcnt(0)" ::: "memory");
        }
    }
    __syncthreads();
}

#ifndef TIMING_A
#define TIMING_A -1
#endif
#ifndef TIMING_B
#define TIMING_B -1
#endif
#ifndef PHASE_MASK
#define PHASE_MASK 0xFFFFF
#endif
#define PM(i) ((PHASE_MASK >> (i)) & 1)
#ifndef REPEAT_MASK
#define REPEAT_MASK 0
#endif
#define RP(i) for (int rep_ = 0; rep_ < 1 + ((REPEAT_MASK >> (i)) & 1); ++rep_)
constexpr int PH_PER_LAYER = 9, NPHASES = 1 + DEPTH * PH_PER_LAYER + 1;
__global__ void __launch_bounds__(NTHREADS, 2) mk_fwd(Args args) {
    extern __shared__ __attribute__((aligned(16))) unsigned char lds[];
    cg::grid_group grid = cg::this_grid();
    const __attribute__((address_space(4))) Args* ap = (const __attribute__((address_space(4))) Args*)__builtin_amdgcn_kernarg_segment_ptr();
    const int lo = ap->lo, hi = ap->hi;
    LAS unsigned char* ldsl = (LAS unsigned char*)lds;
    volatile LAS unsigned* xbst = (volatile LAS unsigned*)(ldsl + LDS_BYTES - 16);
    if (threadIdx.x < 4) xbst[threadIdx.x] = 0u;
    __syncthreads();
    (void)xcd_barrier_post((unsigned*)(ap->p.ws + WS_BAR), xbst);
    if (TIMING_A >= 0 && blockIdx.x == 0 && threadIdx.x == 0) ((unsigned long long*)(ap->p.ws + WS_TS))[lo] = __builtin_amdgcn_s_memrealtime();
    for (int ph = lo; ph < hi; ++ph) {
        CP p = launder(&ap->p);
        int bid = blockIdx.x, nb = gridDim.x; asm volatile("" : "+s"(bid), "+s"(nb));
        if (ph == 0) { if (PM(0)) RP(0) phase_wprep(p, lds, 0, 912, bid, nb); if (PM(1)) RP(1) phase_adaln(p, lds, bid, nb); }
        else if (ph == NPHASES - 1) { if (PM(12)) phase_final(p, lds, bid, nb); }
        else {
            const int l = (ph - 1) / PH_PER_LAYER, s = (ph - 1) % PH_PER_LAYER;
            if (s == 0) { if (PM(2)) RP(2) { if (rep_ == 0 || l == 0) phase_r1(p, l, lds, bid, nb); } }
            else if (s == 1) { if (PM(3)) RP(3) {
                pg8::DenseSched S; S.init(p->ws + WS_HX, (const bf16_t*)(p->ws + WS_WTIN) + (size_t)l * DIN * 1024, R, NPROJ, 1024, 1024, 1024, nb, bid);
                EpiProj E{(bf16_t*)(p->ws + WS_PROJ)};
                pg8::gemm_phase<EpiProj, pg8::DenseSched, false>(ldsl, 1024, 1024, 1024, S, E);
                {
                    const int extra = S.nwg % nb; const int L1 = WPREP_ITEMS_PER_LAYER;
                    const int a0 = l == 0 ? 912 : L1 + 656, a1 = l == 0 ? 2960 : L1 + 2960;
                    if (l <= 1 && DEPTH == 2) { if (extra > 0 && bid >= extra) phase_wprep(p, lds, a0, a1, bid - extra, nb - extra); else if (extra == 0) phase_wprep(p, lds, a0, a1, bid, nb); } }
            } }
            else if (s == 2) { if (PM(4)) RP(4) phase_c1(p, l, lds, bid, nb); if (PM(5)) RP(5) phase_s1(p, l, lds, bid, nb); }
            else if (s == 3) { if (PM(6)) RP(6) phase_s2(p, bid, nb); }
            else if (s == 4) { if (PM(7)) RP(7) phase_s3(p, l, lds, bid, nb);
                if (PM(4)) {
                    const int cpb = NCHUNK - ((l == DEPTH - 1) ? 2 : 0), nunits = NB * cpb * 2, tail = (nunits % nb) * 4;
                    if (tail > 0 && tail < nb) { if (bid >= tail) phase_c1_ln(p, l, bid - tail, nb - tail); } else phase_c1_ln(p, l, bid, nb); } }
            else if (s == 5) { if (PM(8)) RP(8) { if (rep_ == 0 || l == 0) {
                pg8::DenseSched S; S.init(p->ws + WS_HX, (const bf16_t*)(p->ws + WS_WTOUT) + (size_t)l * 1024 * 1024, R, 1024, 1024, 1024, 1024, nb, bid, l == DEPTH - 1);
                EpiResid<0> E{p->ctx, p->x, (bf16_t*)(p->ws + WS_H), (const float*)(p->ws + WS_MOD) + (size_t)l * 3 * 6144, (const float*)(p->ws + WS_SSQ)};
                pg8::gemm_phase<EpiResid<0>, pg8::DenseSched, false>(ldsl, 1024, 1024, 1024, S, E);
                if (l == 0 && DEPTH == 2 && rep_ == 0) { const int extra = S.nwg % nb; const int L1 = WPREP_ITEMS_PER_LAYER;
                    if (extra > 0 && bid >= extra) phase_wprep(p, lds, 2960, 3984, bid - extra, nb - extra, L1, L1 + 656, L1 + 2960, L1 + 3984);
                    else if (extra == 0) phase_wprep(p, lds, 2960, 3984, bid, nb, L1, L1 + 656, L1 + 2960, L1 + 3984); }
            } } }
            else if (s == 6) { if (PM(9)) phase_r2(p, l, lds, bid, nb); }
            else if (s == 7) { if (PM(10)) {
                LAS int* tab = (LAS int*)(ldsl + MISC_OFF); moe_table(p, l, tab);
                unsigned* ready = (unsigned*)(p->ws + WS_M1CNT) + l * 192;
                { MoeSched S{tab, (const int*)(p->ws + WS_LIST), (const char*)(p->ws + WS_HX), (const char*)(p->ws + WS_WTGU), 0, l, nb, bid, ready, 0};
                  EpiUp E{(bf16_t*)(p->ws + WS_HID), (const float*)(p->ws + WS_CWLA), (const float*)(p->ws + WS_CWLB), ready};
                  pg8::gemm_phase<EpiUp, MoeSched, true>(ldsl, 1024, 1024, 1024, S, E); }
                { const int total = __builtin_amdgcn_readfirstlane(tab[24]) * 4; const int extra = __builtin_amdgcn_readfirstlane(total % nb);
                  MoeSched S{tab, (const int*)(p->ws + WS_LIST), (const char*)(p->ws + WS_HID), (const char*)(p->ws + WS_WTD), 1, l, nb, bid, ready, (total >= nb && total - extra >= nb) ? extra : 0};
                  EpiDown E{(bf16_t*)(p->ws + WS_H), (const int*)(p->ws + WS_LIST), (const float*)(p->ws + WS_MOD) + (size_t)l * 3 * 6144 + 5 * 1024};
                  pg8::gemm_phase<EpiDown, MoeSched, false>(ldsl, 512, 256, 512, S, E); }
            } }
            else { }
        }
        if (ph + 1 < hi && !(ph > 0 && ph < NPHASES - 1 && (ph - 1) % PH_PER_LAYER == 7)) { if (hi < 0) grid.sync();   else { XcdBarrier xb; xb.bar = (unsigned*)(launder(&ap->p)->ws + WS_BAR); xb.x = xb_xcc_id(); xb.st = (volatile LAS unsigned*)(ldsl + LDS_BYTES - 16); xcd_barrier(xb); }
            if (TIMING_A >= 0 && blockIdx.x == 0 && threadIdx.x == 0) ((unsigned long long*)(launder(&ap->p)->ws + WS_TS))[ph + 1] = __builtin_amdgcn_s_memrealtime(); }
    }
#if TIMING_A >= 0
    {
        XcdBarrier xb; xb.bar = (unsigned*)(launder(&ap->p)->ws + WS_BAR); xb.x = xb_xcc_id(); xb.st = (volatile LAS unsigned*)(ldsl + LDS_BYTES - 16); xcd_barrier(xb);
        if (blockIdx.x == 0 && threadIdx.x == 0) ((unsigned long long*)(launder(&ap->p)->ws + WS_TS))[hi] = __builtin_amdgcn_s_memrealtime();
        xcd_barrier(xb);
        const unsigned long long* ts = (const unsigned long long*)(launder(&ap->p)->ws + WS_TS);
        const float ta = (float)(ts[TIMING_A + 1] - ts[TIMING_A]) * 0.01f, tb = (float)(ts[TIMING_B + 1] - ts[TIMING_B]) * 0.01f;
        float* o = launder(&ap->p)->out; const float sc = 1.f + ta * 0.001f;
        for (size_t i = (size_t)blockIdx.x * NTHREADS + threadIdx.x; i < (size_t)NB * SEQ * D; i += (size_t)gridDim.x * NTHREADS) o[i] = o[i] * sc + (i == 0 ? tb * 0.1f : 0.f);
    }
#endif
}

extern "C" void kernel_launch(void* const* d_in, const int* in_sizes, int n_in, void* d_out, int out_size, void* d_ws, size_t ws_size, hipStream_t stream) {
    static int grid = 0;
    if (grid == 0) {
        if (n_in != 28 || ws_size < WS_END) { fprintf(stderr, "kernel_launch: unexpected n_in %d or ws_size %zu (< %zu)\n", n_in, ws_size, (size_t)WS_END); grid = -1; return; }
        int dev = 0, cus = 0, per_cu = 0;
        hipGetDevice(&dev); hipDeviceGetAttribute(&cus, hipDeviceAttributeMultiprocessorCount, dev);
        if (hipFuncSetAttribute((const void*)mk_fwd, hipFuncAttributeMaxDynamicSharedMemorySize, LDS_BYTES) != hipSuccess) { fprintf(stderr, "kernel_launch: hipFuncSetAttribute failed\n"); grid = -1; return; }
        if (hipOccupancyMaxActiveBlocksPerMultiprocessor(&per_cu, (const void*)mk_fwd, NTHREADS, LDS_BYTES) != hipSuccess || per_cu < 1) { fprintf(stderr, "kernel_launch: occupancy query says %d\n", per_cu); (void)hipGetLastError(); grid = -1; return; }
        grid = cus;
    }
    if (grid < 0) return;
    (void)hipMemsetAsync((char*)d_ws + WS_CTL, 0, WS_CTL_BYTES, stream);
    Args a{};
    const float** pp = (const float**)&a.p;
    for (int i = 0; i < 28; ++i) pp[i] = (const float*)d_in[i];
    a.p.out = (float*)d_out; a.p.ws = (unsigned char*)d_ws;
#if PER_PHASE_LAUNCH
    for (int ph = 0; ph < NPHASES; ++ph) {
        a.lo = ph; a.hi = ph + 1; void* kargs[] = {&a};
        hipError_t e = hipLaunchCooperativeKernel((const void*)mk_fwd, dim3(grid), dim3(NTHREADS), kargs, LDS_BYTES, stream);
        if (e != hipSuccess) { fprintf(stderr, "kernel_launch: launch of phase %d failed: %s\n", ph, hipGetErrorString(e)); break; }
    }
#else
    a.lo = 0; a.hi = NPHASES; void* kargs[] = {&a};
    hipError_t e = hipLaunchCooperativeKernel((const void*)mk_fwd, dim3(grid), dim3(NTHREADS), kargs, LDS_BYTES, stream);
    if (e != hipSuccess) fprintf(stderr, "kernel_launch: cooperative launch failed: %s (grid %d)\n", hipGetErrorString(e), grid);
#endif
}
```

```cpp
#include <hip/hip_runtime.h>
#include <hip/hip_cooperative_groups.h>
#include <cstdio>
namespace cg = cooperative_groups;

#ifndef PER_PHASE_LAUNCH
#define PER_PHASE_LAUNCH 0
#endif

#ifndef S3REP
#define S3REP 0
#endif
#define S3R(i) for (int r3_ = 0; r3_ < 1 + ((S3REP >> (i)) & 1); ++r3_)
#define LAS __attribute__((address_space(3)))
typedef unsigned short bf16_t;
typedef short bf16x8 __attribute__((ext_vector_type(8)));
typedef float f32x4 __attribute__((ext_vector_type(4)));
typedef unsigned u32x4 __attribute__((ext_vector_type(4)));
typedef unsigned u32x2 __attribute__((ext_vector_type(2)));

constexpr int D = 1024, NB = 2, SEQ = 16384, CTXL = 256, SEG = SEQ + CTXL, R = NB * SEG, DEPTH = 2;
constexpr int NPROJ = 2560, DIN = 2576;
constexpr int NTHREADS = 512;
constexpr int LDS_BYTES = 163840;
constexpr int MISC_OFF = 131072;
constexpr int NCLS = 24;

constexpr size_t al256(size_t x) { return (x + 255) & ~size_t(255); }
constexpr size_t WS_CTL = 0;
constexpr size_t WS_M1CNT = 20480;
constexpr size_t WS_TS = 2048;
constexpr size_t WS_BAR = 4096;
constexpr size_t WS_CTL_BYTES = 32768;
constexpr size_t WS_MOD = WS_CTL_BYTES;
constexpr size_t WS_WTIN = WS_MOD + al256((size_t)2 * 3 * 6144 * 4);
constexpr size_t WS_WTOUT = WS_WTIN + al256((size_t)2 * DIN * 1024 * 2);
constexpr size_t WS_WTGU = WS_WTOUT + al256((size_t)2 * 1024 * 1024 * 2);
constexpr size_t WS_WTD = WS_WTGU + al256((size_t)2 * 16 * 512 * 1024 * 2);
constexpr size_t WS_H = WS_WTD + al256((size_t)2 * 16 * 1024 * 256 * 2);
constexpr size_t WS_HX = WS_H + al256((size_t)R * 1024 * 2);
constexpr size_t WS_PROJ = WS_HX + al256((size_t)R * 1024 * 2);
constexpr size_t WS_DT = WS_PROJ + al256((size_t)R * NPROJ * 2);
constexpr size_t WS_POS = WS_DT + al256((size_t)R * 16 * 4);
constexpr size_t WS_LIST = WS_POS + al256((size_t)2 * R * 4);
constexpr size_t WS_CWLA = WS_LIST + al256((size_t)NCLS * R * 4);
constexpr size_t WS_CWLB = WS_CWLA + al256((size_t)NCLS * R * 4);
constexpr size_t WS_BIG = WS_CWLB + al256((size_t)NCLS * R * 4);
constexpr size_t WS_Y = WS_PROJ;
constexpr size_t WS_S = WS_BIG;
constexpr size_t WS_HP = WS_S + al256((size_t)2 * 2 * 130 * 8 * 8192 * 2);
constexpr size_t WS_DEC = WS_HP + al256((size_t)2 * 2 * 130 * 8 * 8192 * 2);
constexpr size_t WS_SSQ = WS_DEC + al256((size_t)2 * 2 * 130 * 8 * 4);
constexpr size_t WS_HID = WS_S;
constexpr size_t WS_END = WS_SSQ + al256((size_t)R * 8 * 4);
static_assert((size_t)(R + NCLS * 256) * 512 * 2 <= (size_t)2 * 2 * 130 * 8 * 8192 * 2, "hid alias");
static_assert(WS_END <= (size_t)512 * 1024 * 1024, "workspace");

struct Params {
    const float *x, *c, *ctx, *c_ctx, *w_ada, *b_ada, *g_mix, *g_ffn, *w_in, *conv_w, *conv_b, *conv_ln_g, *conv_ln_b, *ssd_conv_w, *ssd_conv_b,
        *dt_bias, *a_log, *d_skip, *ssd_norm_g, *w_out, *w_rg, *b_rg, *w_re, *b_re, *w_gate, *w_up, *w_down, *g_final;
    float* out; unsigned char* ws;
};
struct Args { Params p; int lo, hi; };
typedef const __attribute__((address_space(4))) Params* CP;
__device__ __forceinline__ CP launder(CP p) { asm volatile("" : "+s"(p)); return p; }
__device__ __forceinline__ int launder_tid() { int t = threadIdx.x; asm volatile("" : "+v"(t)); return t; }

__device__ __forceinline__ unsigned cvt_pk_bf16(float lo, float hi) { unsigned r; asm("v_cvt_pk_bf16_f32 %0, %1, %2" : "=v"(r) : "v"(lo), "v"(hi)); return r; }
__device__ __forceinline__ float bf2f(unsigned b) { return __uint_as_float(b << 16); }
__device__ __forceinline__ float bflo(unsigned w) { return __uint_as_float(w << 16); }
__device__ __forceinline__ float bfhi(unsigned w) { return __uint_as_float(w & 0xffff0000u); }
__device__ __forceinline__ bf16_t f2bf(float f) { return (bf16_t)(cvt_pk_bf16(f, 0.f) & 0xffffu); }
#define DPP_ADD(v, ctrl, rm) ((v) + __builtin_bit_cast(float, __builtin_amdgcn_update_dpp(0, __builtin_bit_cast(int, (v)), (ctrl), (rm), 0xF, true)))
__device__ __forceinline__ float row_sum16(float v) {
    v = DPP_ADD(v, 0xB1, 0xF);
    v = DPP_ADD(v, 0x4E, 0xF);
    v = DPP_ADD(v, 0x141, 0xF);
    v = DPP_ADD(v, 0x140, 0xF);
    return v;
}
__device__ __forceinline__ float half_sum32(float v) { v = row_sum16(v); v = DPP_ADD(v, 0x142, 0xA); return v; }
__device__ __forceinline__ float wave_sum(float v) {
    v = half_sum32(v); v = DPP_ADD(v, 0x143, 0xC);
    return __builtin_bit_cast(float, __builtin_amdgcn_readlane(__builtin_bit_cast(int, v), 63));
}
__device__ __forceinline__ float sigmoidf_(float x) { return __builtin_amdgcn_rcpf(1.f + __builtin_amdgcn_exp2f(x * -1.44269504089f)); }
__device__ __forceinline__ float siluf_(float x) { return x * __builtin_amdgcn_rcpf(1.f + __builtin_amdgcn_exp2f(x * -1.44269504089f)); }
__device__ __forceinline__ float softplusf_(float x) { return fmaxf(x, 0.f) + __logf(1.f + __expf(-fabsf(x))); }

__device__ __forceinline__ int row_b(int r) { return r >= SEG ? 1 : 0; }
__device__ __forceinline__ int row_i(int r) { return r >= SEG ? r - SEG : r; }
__device__ __forceinline__ int row_v(int r) { const int i = row_i(r); return i < CTXL ? 2 : row_b(r); }
__device__ __forceinline__ const float* xin_ptr(const float* ctx, const float* x, int r) {
    const int b = row_b(r), i = row_i(r);
    return i < CTXL ? ctx + (size_t)(b * CTXL + i) * D : x + (size_t)(b * SEQ + i - CTXL) * D;
}
struct RowRaw { f32x4 f[4]; u32x2 h[4]; };
__device__ __forceinline__ void row_load(CP p, int l, int r, int lane, RowRaw& rr) {
    if (l == 0) { const f32x4* hr = (const f32x4*)xin_ptr(p->ctx, p->x, r);
#pragma unroll
        for (int j = 0; j < 4; ++j) rr.f[j] = hr[lane + 64 * j]; }
    else { const u32x2* hr = (const u32x2*)((const bf16_t*)(p->ws + WS_H) + (size_t)r * D);
#pragma unroll
        for (int j = 0; j < 4; ++j) rr.h[j] = hr[lane + 64 * j]; }
}
__device__ __forceinline__ void row_cvt(int l, const RowRaw& rr, f32x4 (&xv)[4]) {
#pragma unroll
    for (int j = 0; j < 4; ++j) xv[j] = l == 0 ? rr.f[j] : (f32x4){bflo(rr.h[j].x), bfhi(rr.h[j].x), bflo(rr.h[j].y), bfhi(rr.h[j].y)};
}
namespace pg8 {
constexpr int BM = 256, BK = 64, HALF = 128, HTB = HALF * BK * 2, STAGE_BYTES = 8 * HTB, NXCD = 8, WGM = 8;
__device__ __forceinline__ int lds_byte(int r, int c) { const int st = (r >> 4) * 2 + (c >> 5), rr = r & 15, cc = c & 31, ob = rr * 64 + cc * 2; return st * 1024 + (ob ^ (((ob >> 9) & 1) << 5)); }
__device__ __forceinline__ void stage_rc(int b, int& Rr, int& Cc) { const int st = b / 1024, sb = b % 1024, swz = sb ^ (((sb >> 9) & 1) << 5); Rr = (st >> 1) * 16 + swz / 64; Cc = (st & 1) * 32 + (swz % 64) / 2; }
__device__ __forceinline__ int perm32(int rho) { const int n = rho >> 4, i = rho & 15; return 8 * (i >> 2) + 4 * n + (i & 3); }

struct Unit {
    const char* a0;
    const char* b0;
    const char* b1;
    int i0, i1, i2, i3, i4, pad;
};

template <class Epi, class Sched, bool GATHER>
__device__ __forceinline__ void gemm_phase(LAS unsigned char* lds, const int lda, const int ldb, const int K, const Sched& S, const Epi& E) {
    const int tid = launder_tid(); const int wid = __builtin_amdgcn_readfirstlane(tid >> 6), lane = tid & 63, wr = wid >> 2, wc = wid & 3, fr = lane & 15, fq = lane >> 4;
    const int nt = K / BK, ks = nt >> 1;
    int Rr[2], Cc[2];
    unsigned voffB[2];
#pragma unroll
    for (int i = 0; i < 2; ++i) { stage_rc(tid * 16 + i * 8192, Rr[i], Cc[i]); const int Rb = Epi::PERM ? ((Rr[i] & ~31) + perm32(Rr[i] & 31)) : Rr[i];
        voffB[i] = (unsigned)(Rb * ldb + Cc[i]) * 2u; }
    const size_t kstep = (size_t)(BK * 2);
    const size_t hstepB = (size_t)HALF * ldb * 2;
    const unsigned ldsw = (unsigned)wid * 1024u;
    const unsigned ldsbase = (unsigned)(unsigned long)lds;
    const int aoff = lds_byte(wr * 64 + fr, fq * 8), boff = lds_byte(wc * 32 + fr, fq * 8);
#define PG8_SA(b, h) (((b) * 2 + (h)) * HTB)
#define PG8_SB(b, h) ((4 + (b) * 2 + (h)) * HTB)
#define PG8_STAGE2(bufoff, gbase, v0, v1) do { unsigned keep_; \
        asm volatile("s_mov_b32 %0, m0\n\ts_mov_b32 m0, %1\n\ts_nop 4\n\tglobal_load_lds_dwordx4 %2, %4\n\ts_add_u32 m0, m0, 0x2000\n\ts_nop 0\n\tglobal_load_lds_dwordx4 %3, %4\n\ts_mov_b32 m0, %0" \
            : "=&s"(keep_) : "s"(ldsbase + (unsigned)(bufoff) + ldsw), "v"(v0), "v"(v1), "s"(gbase) : "memory", "scc"); } while (0)
#define PG8_LDA(dst, b, h) do { _Pragma("unroll") for (int m = 0; m < 4; ++m) _Pragma("unroll") for (int k = 0; k < 2; ++k) dst[m][k] = *(const LAS bf16x8*)(lds + PG8_SA(b, h) + aoff + m * 2048 + k * 1024); } while (0)
#define PG8_LDB(dst, b, h) do { _Pragma("unroll") for (int n = 0; n < 2; ++n) _Pragma("unroll") for (int k = 0; k < 2; ++k) dst[n][k] = *(const LAS bf16x8*)(lds + PG8_SB(b, h) + boff + n * 2048 + k * 1024); } while (0)
#define PG8_MMA(ai, bj, At, Bt) do { __builtin_amdgcn_s_setprio(1); _Pragma("unroll") for (int m = 0; m < 4; ++m) _Pragma("unroll") for (int n = 0; n < 2; ++n) _Pragma("unroll") for (int k = 0; k < 2; ++k) \
        acc[ai][bj][m][n] = __builtin_amdgcn_mfma_f32_16x16x32_bf16(Bt[n][k], At[m][k], acc[ai][bj][m][n], 0, 0, 0); __builtin_amdgcn_s_setprio(0); } while (0)
#define PG8_WAIT_V(n) asm volatile("s_waitcnt vmcnt(" #n ")" ::: "memory")
#define PG8_WAIT_L(n) asm volatile("s_waitcnt lgkmcnt(" #n ")" ::: "memory")
#define PG8_BAR __builtin_amdgcn_s_barrier()
#define PG8_SCHED __builtin_amdgcn_sched_barrier(0)
#define PG8_BP(u, tt) ((tt) < ks ? (u).b0 + (size_t)(tt) * kstep : (u).b1 + (size_t)((tt) - ks) * kstep)
    Unit cur, nxt; int ui = 0;
    if (!S.get(0, cur)) return;
    S.a_ready(cur);
    unsigned c00, c01, c10, c11, n00, n01, n10, n11;
    if (GATHER) {
        c00 = (unsigned)(S.arow(cur, Rr[0]) * lda + Cc[0]) * 2u; c01 = (unsigned)(S.arow(cur, Rr[1]) * lda + Cc[1]) * 2u;
        c10 = (unsigned)(S.arow(cur, HALF + Rr[0]) * lda + Cc[0]) * 2u; c11 = (unsigned)(S.arow(cur, HALF + Rr[1]) * lda + Cc[1]) * 2u;
    } else {
        c00 = (unsigned)(Rr[0] * lda + Cc[0]) * 2u; c01 = (unsigned)(Rr[1] * lda + Cc[1]) * 2u;
        c10 = (unsigned)((HALF + Rr[0]) * lda + Cc[0]) * 2u; c11 = (unsigned)((HALF + Rr[1]) * lda + Cc[1]) * 2u;
    }
    n00 = c00; n01 = c01; n10 = c10; n11 = c11;
    f32x4 acc[2][2][4][2];
    float zr; asm volatile("v_mov_b32 %0, 0" : "=v"(zr));
#pragma unroll
    for (int a = 0; a < 2; ++a)
#pragma unroll
        for (int b = 0; b < 2; ++b)
#pragma unroll
            for (int m = 0; m < 4; ++m)
#pragma unroll
                for (int n = 0; n < 2; ++n) acc[a][b][m][n] = (f32x4){zr, zr, zr, zr};
    bf16x8 At[4][2], B0[2][2], B1[2][2];
    const char* cA = cur.a0;
    {
        const char* pb0 = PG8_BP(cur, 0); const char* pb1 = PG8_BP(cur, 1);
        PG8_STAGE2(PG8_SB(0, 0), pb0, voffB[0], voffB[1]); PG8_STAGE2(PG8_SA(0, 0), cA, c00, c01);
        PG8_STAGE2(PG8_SB(0, 1), pb0 + hstepB, voffB[0], voffB[1]); PG8_STAGE2(PG8_SA(0, 1), cA, c10, c11);
        if (wr == 1) PG8_BAR;
        PG8_WAIT_V(4); PG8_BAR;
        PG8_STAGE2(PG8_SB(1, 0), pb1, voffB[0], voffB[1]); PG8_STAGE2(PG8_SA(1, 0), cA + kstep, c00, c01);
        PG8_STAGE2(PG8_SB(1, 1), pb1 + hstepB, voffB[0], voffB[1]);
        PG8_WAIT_V(6); PG8_BAR;
    }
    for (;;) {
        const bool has_next = S.get(ui + 1, nxt);
        if (!has_next) nxt = cur;
        LAS int* tokb = (LAS int*)(lds + MISC_OFF + 1024) + ((ui + 1) & 1) * 256;
        if (GATHER) {
            n00 = c00; n01 = c01; n10 = c10; n11 = c11;
            if (has_next && wid == 0) {
                const char* src = (const char*)S.rows_ptr(nxt); unsigned keep_;
                asm volatile("s_mov_b32 %0, m0\n\ts_mov_b32 m0, %1\n\ts_nop 4\n\tglobal_load_lds_dwordx4 %2, %3\n\ts_mov_b32 m0, %0"
                    : "=&s"(keep_) : "s"((unsigned)(unsigned long)tokb), "v"((unsigned)lane * 16u), "s"(src) : "memory");
            }
        }
        const char* nA = nxt.a0;
#pragma unroll 1
        for (int t = 0; t < nt; t += 2) {
            const bool last = (t == nt - 2);
            if (last && has_next) S.a_ready(nxt);
            const char* a1 = cA + (size_t)(t + 1) * kstep;
            const char* a2 = last ? nA : cA + (size_t)(t + 2) * kstep;
            const char* a3 = a2 + kstep;
            const char* b2 = last ? PG8_BP(nxt, 0) : PG8_BP(cur, t + 2);
            const char* b3 = last ? PG8_BP(nxt, 1) : PG8_BP(cur, t + 3);
            if (GATHER) { if (last && has_next) {
                const int lim = S.rows_valid(nxt) - 1;
                const int i0 = Rr[0] < lim ? Rr[0] : lim, i1 = Rr[1] < lim ? Rr[1] : lim, i2 = (HALF + Rr[0]) < lim ? (HALF + Rr[0]) : lim, i3 = (HALF + Rr[1]) < lim ? (HALF + Rr[1]) : lim;
                n00 = (unsigned)(tokb[i0] * lda + Cc[0]) * 2u; n01 = (unsigned)(tokb[i1] * lda + Cc[1]) * 2u;
                n10 = (unsigned)(tokb[i2] * lda + Cc[0]) * 2u; n11 = (unsigned)(tokb[i3] * lda + Cc[1]) * 2u; } }
            const unsigned s00 = last ? n00 : c00, s01 = last ? n01 : c01, s10 = last ? n10 : c10, s11 = last ? n11 : c11;
            if constexpr (Epi::MIDSCALE) { if (t == ks) E.midscale(acc, cur, wr, wc, fr, fq); }
            PG8_LDB(B0, 0, 0); PG8_SCHED; PG8_LDA(At, 0, 0); PG8_STAGE2(PG8_SA(1, 1), a1, c10, c11);
            PG8_WAIT_L(8); PG8_BAR; PG8_WAIT_L(0); PG8_MMA(0, 0, At, B0); PG8_BAR; PG8_SCHED;
            PG8_LDB(B1, 0, 1); PG8_STAGE2(PG8_SB(0, 0), b2, voffB[0], voffB[1]);
            PG8_BAR; PG8_WAIT_L(0); PG8_MMA(0, 1, At, B1); PG8_BAR;
            PG8_LDA(At, 0, 1); PG8_STAGE2(PG8_SA(0, 0), a2, s00, s01);
            PG8_BAR; PG8_WAIT_L(0); PG8_MMA(1, 0, At, B0); PG8_BAR; PG8_SCHED;
            PG8_STAGE2(PG8_SB(0, 1), b2 + hstepB, voffB[0], voffB[1]);
            PG8_WAIT_V(6); PG8_BAR; PG8_MMA(1, 1, At, B1); PG8_BAR;
            PG8_LDB(B0, 1, 0); PG8_SCHED; PG8_LDA(At, 1, 0); PG8_STAGE2(PG8_SA(0, 1), a2, s10, s11);
            PG8_WAIT_L(8); PG8_BAR; PG8_WAIT_L(0); PG8_MMA(0, 0, At, B0); PG8_BAR; PG8_SCHED;
            PG8_LDB(B1, 1, 1); PG8_STAGE2(PG8_SB(1, 0), b3, voffB[0], voffB[1]);
            PG8_BAR; PG8_WAIT_L(0); PG8_MMA(0, 1, At, B1); PG8_BAR;
            PG8_LDA(At, 1, 1); PG8_STAGE2(PG8_SA(1, 0), a3, s00, s01);
            PG8_BAR; PG8_WAIT_L(0); PG8_MMA(1, 0, At, B0); PG8_BAR; PG8_SCHED;
            PG8_STAGE2(PG8_SB(1, 1), b3 + hstepB, voffB[0], voffB[1]);
            PG8_WAIT_V(6); PG8_BAR; PG8_MMA(1, 1, At, B1); PG8_BAR;
        }
        E(acc, cur, wr, wc, fr, fq);
        if (!has_next) break;
        asm volatile("v_mov_b32 %0, 0" : "=v"(zr));
#pragma unroll
        for (int a = 0; a < 2; ++a)
#pragma unroll
            for (int b = 0; b < 2; ++b)
#pragma unroll
                for (int m = 0; m < 4; ++m)
#pragma unroll
                    for (int n = 0; n < 2; ++n) acc[a][b][m][n] = (f32x4){zr, zr, zr, zr};
        cur = nxt; cA = nA; ++ui; c00 = n00; c01 = n01; c10 = n10; c11 = n11;
    }
    PG8_WAIT_V(0);
    if (wr == 0) PG8_BAR;
    PG8_BAR;
#undef PG8_SA
#undef PG8_SB
#undef PG8_STAGE2
#undef PG8_LDA
#undef PG8_LDB
#undef PG8_MMA
#undef PG8_WAIT_V
#undef PG8_WAIT_L
#undef PG8_BAR
#undef PG8_SCHED
#undef PG8_BP
}

struct DenseSched {
    const char* A; const char* Bt; int lda, ldb, K; int nM, nN, nwg, G, c, skipctx;
    __device__ __forceinline__ void init(const void* A_, const void* Bt_, int M, int N, int K_, int lda_, int ldb_, int G_, int c_, int skipctx_ = 0) {
        A = (const char*)A_; Bt = (const char*)Bt_; lda = lda_; ldb = ldb_; K = K_; nM = M / BM - 2 * skipctx_; nN = N / BM; nwg = nM * nN; G = G_; c = c_; skipctx = skipctx_; }
    __device__ __forceinline__ bool get(int i, Unit& u) const {
        const long L = (long)i * G + c; if (L >= nwg) return false;
        int wgid = (int)L; { const int q = nwg / NXCD, r = nwg % NXCD, xcd = wgid % NXCD, off = wgid / NXCD; wgid = (xcd < r ? xcd * (q + 1) : r * (q + 1) + (xcd - r) * q) + off; }
        const int nig = WGM * nN, gid = wgid / nig, fm = gid * WGM, gsz = (nM - fm) < WGM ? (nM - fm) : WGM;
        int pm = fm + ((wgid % nig) % gsz); const int pn = (wgid % nig) / gsz;
        if (skipctx) pm += 1 + (pm >= 64 ? 1 : 0);
        u.a0 = A + (size_t)pm * BM * lda * 2; u.b0 = Bt + (size_t)pn * BM * ldb * 2; u.b1 = u.b0 + (size_t)(K / BK / 2) * BK * 2;
        u.i0 = pm; u.i1 = pn; u.i2 = 0; u.i3 = 0; u.i4 = 0; u.pad = 0; return true;
    }
    __device__ __forceinline__ void a_ready(const Unit&) const {}
    __device__ __forceinline__ int arow(const Unit&, int rl) const { return rl; }
    __device__ __forceinline__ const int* rows_ptr(const Unit&) const { return nullptr; }
    __device__ __forceinline__ int rows_valid(const Unit&) const { return 256; }
};
}

struct EpiProj {
    static constexpr bool PERM = true, MIDSCALE = false;
    bf16_t* O;
    __device__ __forceinline__ void operator()(const f32x4 (&acc)[2][2][4][2], const pg8::Unit& u, int wr, int wc, int fr, int fq) const {
        const int pn = u.i1;
        const int row0 = u.i0 * 256 + wr * 64 + fr;
        if (pn < 4) {
            const int col0 = pn * 128 + wc * 32 + 8 * fq;
#pragma unroll
            for (int ai = 0; ai < 2; ++ai)
#pragma unroll
                for (int m = 0; m < 4; ++m) { const f32x4 u0 = acc[ai][0][m][0], u1 = acc[ai][0][m][1], g0 = acc[ai][1][m][0], g1 = acc[ai][1][m][1];
                    u32x4 w; w.x = cvt_pk_bf16(u0[0] * sigmoidf_(g0[0]), u0[1] * sigmoidf_(g0[1])); w.y = cvt_pk_bf16(u0[2] * sigmoidf_(g0[2]), u0[3] * sigmoidf_(g0[3]));
                    w.z = cvt_pk_bf16(u1[0] * sigmoidf_(g1[0]), u1[1] * sigmoidf_(g1[1])); w.w = cvt_pk_bf16(u1[2] * sigmoidf_(g1[2]), u1[3] * sigmoidf_(g1[3]));
                    *(u32x4*)(O + (size_t)(row0 + ai * 128 + m * 16) * NPROJ + col0) = w; }
        } else {
            const int col0 = pn * 256 + wc * 32 + 8 * fq; const bool sl = pn < 6;
#pragma unroll
            for (int ai = 0; ai < 2; ++ai)
#pragma unroll
                for (int m = 0; m < 4; ++m) { bf16_t* rowp = O + (size_t)(row0 + ai * 128 + m * 16) * NPROJ + col0;
#pragma unroll
                    for (int bj = 0; bj < 2; ++bj) { f32x4 v0 = acc[ai][bj][m][0], v1 = acc[ai][bj][m][1];
                        if (sl) {
#pragma unroll
                            for (int e = 0; e < 4; ++e) { v0[e] = siluf_(v0[e]); v1[e] = siluf_(v1[e]); } }
                        u32x4 w; w.x = cvt_pk_bf16(v0[0], v0[1]); w.y = cvt_pk_bf16(v0[2], v0[3]); w.z = cvt_pk_bf16(v1[0], v1[1]); w.w = cvt_pk_bf16(v1[2], v1[3]);
                        *(u32x4*)(rowp + bj * 128) = w; } }
        }
    }
};
template <int L0> struct EpiResid {
    static constexpr bool PERM = true, MIDSCALE = true;
    const float* inc; const float* inx; bf16_t* H; const float* modl; const float* ssq;
    __device__ __forceinline__ void midscale(f32x4 (&acc)[2][2][4][2], const pg8::Unit& u, int wr, int wc, int fr, int fq) const {
        typedef float f32x2 __attribute__((ext_vector_type(2)));
        const int r0 = u.i0 * 256 + wr * 64 + fr;
        f32x2 part[2][4];
#pragma unroll
        for (int ai = 0; ai < 2; ++ai)
#pragma unroll
            for (int m = 0; m < 4; ++m) part[ai][m] = *(const f32x2*)(ssq + (size_t)(r0 + ai * 128 + m * 16) * 8 + 2 * fq);
#pragma unroll
        for (int ai = 0; ai < 2; ++ai)
#pragma unroll
            for (int m = 0; m < 4; ++m) { float sq = part[ai][m][0] + part[ai][m][1];
                sq += __shfl_xor(sq, 16); sq += __shfl_xor(sq, 32);
                const float rs = rsqrtf(sq * (1.f / 512.f) + 1e-6f);
#pragma unroll
                for (int bj = 0; bj < 2; ++bj)
#pragma unroll
                    for (int n = 0; n < 2; ++n) acc[ai][bj][m][n] *= rs; }
    }
    __device__ __forceinline__ void operator()(const f32x4 (&acc)[2][2][4][2], const pg8::Unit& u, int wr, int wc, int fr, int fq) const {
        const int r0 = u.i0 * 256;
        const int v = row_v(r0);
        const float* gate = modl + (size_t)v * 6144 + 2 * 1024;
        const float* xin = xin_ptr(inc, inx, r0);
        const int rl0 = wr * 64 + fr, col0 = u.i1 * 256 + wc * 32 + 8 * fq;
        f32x4 gv[2][2];
#pragma unroll
        for (int bj = 0; bj < 2; ++bj)
#pragma unroll
            for (int n = 0; n < 2; ++n) gv[bj][n] = *(const f32x4*)(gate + col0 + bj * 128 + 4 * n);
#pragma unroll
        for (int ai = 0; ai < 2; ++ai) {
            u32x4 hr[4][2];
#pragma unroll
            for (int m = 0; m < 4; ++m)
#pragma unroll
                for (int bj = 0; bj < 2; ++bj) hr[m][bj] = *(const u32x4*)(H + (size_t)(r0 + rl0 + ai * 128 + m * 16) * D + col0 + bj * 128);
#pragma unroll
            for (int m = 0; m < 4; ++m)
#pragma unroll
                for (int bj = 0; bj < 2; ++bj) { const u32x4 hv = hr[m][bj]; const f32x4 a0 = acc[ai][bj][m][0], a1 = acc[ai][bj][m][1]; const f32x4 g0 = gv[bj][0], g1 = gv[bj][1];
                    u32x4 w;
                    w.x = cvt_pk_bf16(bflo(hv.x) + g0[0] * a0[0], bfhi(hv.x) + g0[1] * a0[1]); w.y = cvt_pk_bf16(bflo(hv.y) + g0[2] * a0[2], bfhi(hv.y) + g0[3] * a0[3]);
                    w.z = cvt_pk_bf16(bflo(hv.z) + g1[0] * a1[0], bfhi(hv.z) + g1[1] * a1[1]); w.w = cvt_pk_bf16(bflo(hv.w) + g1[2] * a1[2], bfhi(hv.w) + g1[3] * a1[3]);
                    *(u32x4*)(H + (size_t)(r0 + rl0 + ai * 128 + m * 16) * D + col0 + bj * 128) = w; }
            asm volatile("" ::: "memory"); }
    }
};

__device__ __forceinline__ const char* uniform_ptr(const char* q) {
    const unsigned long long v = (unsigned long long)q;
    const unsigned lo = __builtin_amdgcn_readfirstlane((unsigned)v), hi = __builtin_amdgcn_readfirstlane((unsigned)(v >> 32));
    return (const char*)(((unsigned long long)hi << 32) | lo);
}
struct MoeSched {
    const LAS int* tab;
    const int* list;
    const char* A; const char* W; int mode  , l, G, c;
    unsigned* ready;
    __device__ __forceinline__ void a_ready(const pg8::Unit& u) const {
        if (mode == 0) return;
        if (threadIdx.x < 64) {
            unsigned* w = ready + u.i4; unsigned spins = 0;
            while ((unsigned)__builtin_amdgcn_readfirstlane((int)__hip_atomic_load(w, __ATOMIC_RELAXED, __HIP_MEMORY_SCOPE_AGENT)) < 32u) {
                __builtin_amdgcn_s_sleep(2); if (++spins > (1u << 22)) break; }
            __builtin_amdgcn_fence(__ATOMIC_ACQUIRE, "agent");
            asm volatile("s_waitcnt vmcnt(0)" ::: "memory");
        }
        asm volatile("" ::: "memory"); __builtin_amdgcn_s_barrier(); asm volatile("" ::: "memory");
    }
    int late;
    __device__ __forceinline__ bool get(int i, pg8::Unit& u) const {
        const int total = __builtin_amdgcn_readfirstlane(tab[24]) * 4;
        int L;
        if (mode == 0 || late == 0) L = i * G + c;
        else if (c < late) { if (i > 0) return false; L = c; }
        else L = late + (c - late) + i * (G - late);
        if (L >= total) return false;
        const int tl = L >> 2, pn = L & 3;
        int cls = 0;
#pragma unroll 1
        for (int q = 1; q < NCLS; ++q) { const int tq = __builtin_amdgcn_readfirstlane(tab[q]); if (tq <= tl) cls = q; }
        const int j = tl - __builtin_amdgcn_readfirstlane(tab[cls]), cnt = __builtin_amdgcn_readfirstlane(tab[32 + cls]);
        const int g = cls / 6, pidx = cls - g * 6;
        const int ea = (pidx >= 3) + (pidx >= 5), eb = pidx < 3 ? pidx + 1 : (pidx < 5 ? pidx - 1 : 3);
        if (mode == 0) {
            const int e = 4 * g + (pn < 2 ? ea : eb);
            u.a0 = A;
            u.b0 = W + ((size_t)(l * 16 + e) * 512 + (size_t)(pn & 1) * 256) * 1024 * 2; u.b1 = u.b0 + (size_t)8 * 128;
        } else {
            u.a0 = A + (size_t)tl * 256 * 512 * 2;
            u.b0 = W + ((size_t)(l * 16 + 4 * g + ea) * 1024 + (size_t)pn * 256) * 256 * 2;
            u.b1 = W + ((size_t)(l * 16 + 4 * g + eb) * 1024 + (size_t)pn * 256) * 256 * 2;
        }
        u.a0 = uniform_ptr(u.a0); u.b0 = uniform_ptr(u.b0); u.b1 = uniform_ptr(u.b1);
        u.i0 = cls; u.i1 = j; u.i2 = pn; u.i3 = cnt; u.i4 = tl; u.pad = 0; return true;
    }
    __device__ __forceinline__ int arow(const pg8::Unit& u, int rl) const {
        int idx = u.i1 * 256 + rl; idx = idx < u.i3 ? idx : u.i3 - 1;
        return list[(size_t)u.i0 * R + idx];
    }
    __device__ __forceinline__ const int* rows_ptr(const pg8::Unit& u) const { return list + (size_t)u.i0 * R + u.i1 * 256; }
    __device__ __forceinline__ int rows_valid(const pg8::Unit& u) const { return u.i3 - u.i1 * 256; }
};
struct EpiUp {
    static constexpr bool PERM = true, MIDSCALE = false;
    bf16_t* hid; const float* cwla; const float* cwlb; unsigned* ready;
    __device__ __forceinline__ void operator()(const f32x4 (&acc)[2][2][4][2], const pg8::Unit& u, int wr, int wc, int fr, int fq) const {
        const int cls = u.i0, j = u.i1, pn = u.i2, cnt = u.i3, tl = u.i4;
        const float* cw = (pn < 2) ? cwla : cwlb;
        const int colbase = (pn >> 1) * 256 + (pn & 1) * 128 + wc * 32 + 8 * fq;
        float wrow[2][4];
#pragma unroll
        for (int ai = 0; ai < 2; ++ai)
#pragma unroll
            for (int m = 0; m < 4; ++m) { const int idx = j * 256 + ai * 128 + wr * 64 + m * 16 + fr; wrow[ai][m] = idx < cnt ? cw[(size_t)cls * R + idx] : 0.f; }
#pragma unroll
        for (int ai = 0; ai < 2; ++ai)
#pragma unroll
            for (int m = 0; m < 4; ++m) {
                const int rl = ai * 128 + wr * 64 + m * 16 + fr; const int idx = j * 256 + rl; const bool valid = idx < cnt;
                const float w = wrow[ai][m];
                const f32x4 g0 = acc[ai][0][m][0], g1 = acc[ai][0][m][1], u0 = acc[ai][1][m][0], u1 = acc[ai][1][m][1];
                float o[8];
#pragma unroll
                for (int e = 0; e < 4; ++e) { o[e] = w * siluf_(g0[e]) * u0[e]; o[4 + e] = w * siluf_(g1[e]) * u1[e]; }
                if (!valid) {
#pragma unroll
                    for (int e = 0; e < 8; ++e) o[e] = 0.f; }
                u32x4 pk; pk.x = cvt_pk_bf16(o[0], o[1]); pk.y = cvt_pk_bf16(o[2], o[3]); pk.z = cvt_pk_bf16(o[4], o[5]); pk.w = cvt_pk_bf16(o[6], o[7]);
                { bf16_t* dstp = hid + ((size_t)tl * 256 + rl) * 512 + colbase;
                  asm volatile("global_store_dwordx4 %0, %1, off sc1\n\ts_nop 1" :: "v"(dstp), "v"(pk) : "memory"); }
            }
        asm volatile("s_waitcnt vmcnt(0)" ::: "memory");
        if ((threadIdx.x & 63) == 0) __hip_atomic_fetch_add(ready + tl, 1u, __ATOMIC_RELAXED, __HIP_MEMORY_SCOPE_AGENT);
    }
};
struct EpiDown {
    static constexpr bool PERM = true, MIDSCALE = false;
    bf16_t* H; const int* list; const float* modl;
    __device__ __forceinline__ void operator()(const f32x4 (&acc)[2][2][4][2], const pg8::Unit& u, int wr, int wc, int fr, int fq) const {
        const int cls = u.i0, j = u.i1, pn = u.i2, cnt = u.i3;
        const int col0 = pn * 256 + wc * 32 + 8 * fq;
        int tok[2][4];
#pragma unroll
        for (int ai = 0; ai < 2; ++ai)
#pragma unroll
            for (int m = 0; m < 4; ++m) { const int idx = j * 256 + ai * 128 + wr * 64 + m * 16 + fr; tok[ai][m] = idx < cnt ? list[(size_t)cls * R + idx] : -1; }
#pragma unroll
        for (int ai = 0; ai < 2; ++ai)
#pragma unroll
            for (int mp = 0; mp < 2; ++mp) {
                u32x4 hr[2][2]; f32x4 gv[2][2][2];
#pragma unroll
                for (int mm = 0; mm < 2; ++mm) { const int t = tok[ai][2 * mp + mm]; const int tt = t < 0 ? 0 : t;
                    const bf16_t* hp = H + (size_t)tt * D + col0; const float* gp = modl + (size_t)row_v(tt) * 6144 + col0;
#pragma unroll
                    for (int bj = 0; bj < 2; ++bj) { hr[mm][bj] = *(const u32x4*)(hp + bj * 128); gv[mm][bj][0] = *(const f32x4*)(gp + bj * 128); gv[mm][bj][1] = *(const f32x4*)(gp + bj * 128 + 4); } }
#pragma unroll
                for (int mm = 0; mm < 2; ++mm) { const int t = tok[ai][2 * mp + mm];
                    if (t >= 0) {
#pragma unroll
                        for (int bj = 0; bj < 2; ++bj) { const u32x4 hv = hr[mm][bj]; const f32x4 a0 = acc[ai][bj][2 * mp + mm][0], a1 = acc[ai][bj][2 * mp + mm][1]; const f32x4 g0 = gv[mm][bj][0], g1 = gv[mm][bj][1];
                            u32x4 w;
                            w.x = cvt_pk_bf16(bflo(hv.x) + g0[0] * a0[0], bfhi(hv.x) + g0[1] * a0[1]); w.y = cvt_pk_bf16(bflo(hv.y) + g0[2] * a0[2], bfhi(hv.y) + g0[3] * a0[3]);
                            w.z = cvt_pk_bf16(bflo(hv.z) + g1[0] * a1[0], bfhi(hv.z) + g1[1] * a1[1]); w.w = cvt_pk_bf16(bflo(hv.w) + g1[2] * a1[2], bfhi(hv.w) + g1[3] * a1[3]);
                            *(u32x4*)(H + (size_t)t * D + col0 + bj * 128) = w; } } }
                asm volatile("" ::: "memory"); }
    }
};

__device__ __forceinline__ void tr_tile(const float* src, int ldn, int k0, int n0, int nvalid, bf16_t* dst, int ldk, int drow0, LAS float* tile, int kd0 = -1, const float* kscale = nullptr) {
    const int tid = launder_tid();
    if (kd0 < 0) kd0 = k0;
    { const int n = tid & 63; const int kq = tid >> 6; float tv[8], ts[8];
#pragma unroll
      for (int it = 0; it < 8; ++it) { const int kk = kq + 8 * it; tv[it] = (n < nvalid) ? src[(size_t)(k0 + kk) * ldn + n0 + n] : 0.f; ts[it] = kscale ? kscale[kk] : 1.f; }
#pragma unroll
      for (int it = 0; it < 8; ++it) tile[(kq + 8 * it) * 65 + n] = tv[it] * ts[it]; }
    __syncthreads();
    { const int k8 = tid & 7, n = tid >> 3;
      if (n < nvalid) { const LAS float* s = tile + (k8 * 8) * 65 + n;
          u32x4 o; o.x = cvt_pk_bf16(s[0], s[65]); o.y = cvt_pk_bf16(s[2 * 65], s[3 * 65]); o.z = cvt_pk_bf16(s[4 * 65], s[5 * 65]); o.w = cvt_pk_bf16(s[6 * 65], s[7 * 65]);
          *(u32x4*)(dst + (size_t)(drow0 + n) * ldk + kd0 + k8 * 8) = o; } }
    __syncthreads();
}
constexpr int WPREP_ITEMS_PER_LAYER = 16 * 41 + 256 + 1024 + 1024 + 1024;
__device__ __forceinline__ void phase_wprep(CP p, unsigned char* lds, int it0, int it1, int bidx, int nblk, int b0 = 0, int b1 = 0, int c0 = 0, int c1 = 0) {
    LAS float* tile = (LAS float*)(LAS unsigned char*)lds;
    constexpr int I_IN = 16 * 41, I_OUT = 256, I_G = 1024, I_U = 1024, I_D = 1024, I_L = I_IN + I_OUT + I_G + I_U + I_D;
    const int na = it1 - it0, nbb = b1 - b0, ncc = c1 - c0;
    for (int vi = bidx; vi < na + nbb + ncc; vi += nblk) {
        const int it = vi < na ? it0 + vi : (vi < na + nbb ? b0 + (vi - na) : c0 + (vi - na - nbb));
        const int l = it / I_L; int r = it - l * I_L;
        if (r < I_IN) { const int kt = r / 41, ntl = r % 41; const int n0 = ntl * 64; const int nv = (DIN - n0) < 64 ? (DIN - n0) : 64;
            const int dr = n0 < 512 ? (n0 >> 7) * 256 + (n0 & 127) : (n0 < 1024 ? ((n0 - 512) >> 7) * 256 + 128 + ((n0 - 512) & 127) : n0);
            tr_tile(p->w_in + (size_t)l * 1024 * DIN, DIN, kt * 64, n0, nv, (bf16_t*)(p->ws + WS_WTIN) + (size_t)l * DIN * 1024, 1024, dr, tile); continue; }
        r -= I_IN;
        if (r < I_OUT) { const int kt = r >> 4, ntl = r & 15;
            tr_tile(p->w_out + (size_t)l * 1024 * 1024, 1024, kt * 64, ntl * 64, 64, (bf16_t*)(p->ws + WS_WTOUT) + (size_t)l * 1024 * 1024, 1024, ntl * 64, tile,
                    (kt * 64 + 512) & 1023, kt >= 8 ? p->ssd_norm_g + l * 512 + (kt * 64 - 512) : nullptr); continue; }
        r -= I_OUT;
        if (r < I_G + I_U) { const int up = r >= I_G; if (up) r -= I_G; const int e = r >> 6, q = r & 63, kt = q >> 2, ntl = q & 3; const int n0 = ntl * 64;
            const float* src = (up ? p->w_up : p->w_gate) + (size_t)(l * 16 + e) * 1024 * 256;
            tr_tile(src, 256, kt * 64, n0, 64, (bf16_t*)(p->ws + WS_WTGU) + (size_t)(l * 16 + e) * 512 * 1024, 1024, (n0 >> 7) * 256 + (n0 & 127) + (up ? 128 : 0), tile); continue; }
        r -= I_G + I_U;
        { const int e = r >> 6, q = r & 63, kt = q >> 4, ntl = q & 15;
          tr_tile(p->w_down + (size_t)(l * 16 + e) * 256 * 1024, 1024, kt * 64, ntl * 64, 64, (bf16_t*)(p->ws + WS_WTD) + (size_t)(l * 16 + e) * 1024 * 256, 256, ntl * 64, tile); }
    }
}
__device__ __forceinline__ void phase_adaln(CP p, unsigned char* lds, int bid, int nb) {
    LAS float* sc = (LAS float*)(LAS unsigned char*)lds;
    LAS float* red = sc + 3 * 1024;
    const int tid = launder_tid();
    for (int idx = tid; idx < 3 * 1024; idx += NTHREADS) { const int v = idx >> 10, k = idx & 1023; const float cv = (v < 2) ? p->c[v * 1024 + k] : p->c_ctx[k]; sc[idx] = siluf_(cv); }
    __syncthreads();
    float* mod = (float*)(p->ws + WS_MOD);
    for (int it = bid; it < 2 * 96; it += nb) {
        const int l = it / 96, n0 = (it % 96) * 64;
        const int c4 = tid & 15, kr = tid >> 4;
        f32x4 a0 = {0, 0, 0, 0}, a1 = {0, 0, 0, 0}, a2 = {0, 0, 0, 0};
        const float* w = p->w_ada + (size_t)l * 1024 * 6144 + n0 + c4 * 4;
#pragma unroll 4
        for (int k = kr; k < 1024; k += 32) { const f32x4 w4 = *(const f32x4*)(w + (size_t)k * 6144); a0 += sc[k] * w4; a1 += sc[1024 + k] * w4; a2 += sc[2048 + k] * w4; }
        *(LAS f32x4*)(red + (kr * 3 + 0) * 64 + c4 * 4) = a0; *(LAS f32x4*)(red + (kr * 3 + 1) * 64 + c4 * 4) = a1; *(LAS f32x4*)(red + (kr * 3 + 2) * 64 + c4 * 4) = a2;
        __syncthreads();
        if (tid < 192) { const int v = tid >> 6, cc = tid & 63; float s = 0.f;
            for (int q = 0; q < 32; ++q) s += red[(q * 3 + v) * 64 + cc];
            mod[((size_t)l * 3 + v) * 6144 + n0 + cc] = s + p->b_ada[l * 6144 + n0 + cc]; }
        __syncthreads();
    }
}
__device__ __forceinline__ void moe_table(CP p, int l, LAS int* tab) {
    const int* gcount = (const int*)(p->ws + WS_CTL) + l * 32;
    if (threadIdx.x == 0) { int acc = 0; for (int q = 0; q < NCLS; ++q) { const int cn = gcount[q]; tab[q] = acc; tab[32 + q] = cn; acc += (cn + 255) >> 8; } tab[24] = acc; }
    __syncthreads();
}
__device__ __forceinline__ void moe_yload(CP p, int pos, int lane, const LAS int* tab, u32x2 (&yv)[4]) {
    const int slot = tab[pos >> 16] * 256 + (pos & 0xffff);
    const bf16_t* y = (const bf16_t*)(p->ws + WS_Y) + (size_t)slot * 1024;
#pragma unroll
    for (int j = 0; j < 4; ++j) yv[j] = *(const u32x2*)(y + 4 * lane + 256 * j);
}
__device__ __forceinline__ void moe_yadd(CP p, int lm, int v, int lane, const u32x2 (&yv)[4], f32x4 (&xv)[4]) {
    const float* gate = (const float*)(p->ws + WS_MOD) + ((size_t)lm * 3 + v) * 6144 + 5 * 1024;
#pragma unroll
    for (int j = 0; j < 4; ++j) { const int k = 4 * lane + 256 * j; const f32x4 g4 = *(const f32x4*)(gate + k);
        xv[j][0] += g4[0] * bflo(yv[j].x); xv[j][1] += g4[1] * bfhi(yv[j].x); xv[j][2] += g4[2] * bflo(yv[j].y); xv[j][3] += g4[3] * bfhi(yv[j].y); }
}
typedef _Float16 f16x8 __attribute__((ext_vector_type(8)));
typedef _Float16 f16x2 __attribute__((ext_vector_type(2)));
constexpr int ST_H16 = 2064;
__device__ __forceinline__ unsigned pack_f16(float a, float b) { f16x2 h; h[0] = (_Float16)a; h[1] = (_Float16)b; return __builtin_bit_cast(unsigned, h); }
__device__ __forceinline__ void phase_r1(CP p, int l, unsigned char* lds_, int bid, int nb) {
    LAS unsigned char* lds = (LAS unsigned char*)lds_;
    LAS unsigned char* Wh = lds;
    LAS unsigned char* Xh = Wh + 16 * ST_H16;
    LAS float* gm = (LAS float*)(Xh + 16 * ST_H16);
    LAS float* sh = gm + 3 * 1024;
    LAS float* part = sh + 3 * 1024;
    const int tid = launder_tid(); const int lane = tid & 63, wave = __builtin_amdgcn_readfirstlane(tid >> 6);
    const float* mod = (const float*)(p->ws + WS_MOD) + (size_t)l * 3 * 6144;
    const float* win = p->w_in + (size_t)l * 1024 * DIN;
#pragma unroll
    for (int hb = 0; hb < 2; ++hb) { float tmp[16];
#pragma unroll
        for (int it = 0; it < 16; ++it) { const int idx = tid + NTHREADS * (16 * hb + it); tmp[it] = win[(size_t)(idx >> 4) * DIN + NPROJ + (idx & 15)]; }
#pragma unroll
        for (int it = 0; it < 16; ++it) { const int idx = tid + NTHREADS * (16 * hb + it); *(LAS _Float16*)(Wh + (idx & 15) * ST_H16 + (idx >> 4) * 2) = (_Float16)tmp[it]; } }
    { float t0[6], t1[6], t2[6];
#pragma unroll
      for (int it = 0; it < 6; ++it) { const int idx = tid + NTHREADS * it; const int v = idx >> 10, k = idx & 1023; t0[it] = p->g_mix[l * 1024 + k]; t1[it] = mod[v * 6144 + 1024 + k]; t2[it] = mod[v * 6144 + k]; }
#pragma unroll
      for (int it = 0; it < 6; ++it) { const int idx = tid + NTHREADS * it; gm[idx] = t0[it] * (1.f + t1[it]); sh[idx] = t2[it]; } }
    __syncthreads();
    bf16_t* HX = (bf16_t*)(p->ws + WS_HX); float* DT = (float*)(p->ws + WS_DT);
    const int rpb = (R + nb - 1) / nb, r0 = bid * rpb, r1 = (r0 + rpb) < R ? (r0 + rpb) : R;
    RowRaw xn[2];
#pragma unroll
    for (int q = 0; q < 2; ++q) if (r0 + 2 * wave + q < r1) row_load(p, l, r0 + 2 * wave + q, lane, xn[q]);
#pragma unroll 1
    for (int t0r = r0; t0r < r1; t0r += 16) {
        f32x4 xv[2][4];
#pragma unroll
        for (int q = 0; q < 2; ++q) row_cvt(l, xn[q], xv[q]);
#pragma unroll
        for (int q = 0; q < 2; ++q) if (t0r + 16 + 2 * wave + q < r1) row_load(p, l, t0r + 16 + 2 * wave + q, lane, xn[q]);
#pragma unroll
        for (int q = 0; q < 2; ++q) { const int rr = t0r + 2 * wave + q; const bool ok = rr < r1; const int v = row_v(ok ? rr : r0);
            if (l == 0 && ok) { u32x2* hw = (u32x2*)((bf16_t*)(p->ws + WS_H) + (size_t)rr * D);
#pragma unroll
                for (int j = 0; j < 4; ++j) { u32x2 o; o.x = cvt_pk_bf16(xv[q][j][0], xv[q][j][1]); o.y = cvt_pk_bf16(xv[q][j][2], xv[q][j][3]); hw[lane + 64 * j] = o; } }
            float ss = 0.f;
#pragma unroll
            for (int j = 0; j < 4; ++j) ss += xv[q][j][0] * xv[q][j][0] + xv[q][j][1] * xv[q][j][1] + xv[q][j][2] * xv[q][j][2] + xv[q][j][3] * xv[q][j][3];
            ss = wave_sum(ss); const float rs = ok ? __builtin_amdgcn_rsqf(ss * (1.f / 1024.f) + 1e-6f) : 0.f;
#pragma unroll
            for (int j = 0; j < 4; ++j) { const int k = 4 * lane + 256 * j; const f32x4 g4 = *(const LAS f32x4*)(gm + v * 1024 + k), s4 = *(const LAS f32x4*)(sh + v * 1024 + k);
                f32x4 hv = xv[q][j] * rs * g4 + s4; if (!ok) hv = hv * 0.f;
                u32x2 o; o.x = cvt_pk_bf16(hv[0], hv[1]); o.y = cvt_pk_bf16(hv[2], hv[3]);
                if (ok) *(u32x2*)(HX + (size_t)rr * 1024 + k) = o;
                u32x2 h16; h16.x = pack_f16(hv[0], hv[1]); h16.y = pack_f16(hv[2], hv[3]);
                *(LAS u32x2*)(Xh + (2 * wave + q) * ST_H16 + k * 2) = h16; } }
        __syncthreads();
        {
            f32x4 acc0 = {0.f, 0.f, 0.f, 0.f};
#pragma unroll
            for (int s4 = 0; s4 < 4; ++s4) { const int kb = (128 * wave + 32 * s4 + 8 * (lane >> 4)) * 2;
                const f16x8 a = *(const LAS f16x8*)(Xh + (lane & 15) * ST_H16 + kb);
                const f16x8 b0 = *(const LAS f16x8*)(Wh + (lane & 15) * ST_H16 + kb);
                acc0 = __builtin_amdgcn_mfma_f32_16x16x32_f16(a, b0, acc0, 0, 0, 0); }
#pragma unroll
            for (int e = 0; e < 4; ++e) part[(wave * 16 + 4 * (lane >> 4) + e) * 16 + (lane & 15)] = acc0[e];
        }
        __syncthreads();
        if (tid < 256) { const int row = tid >> 4, n = tid & 15; const int rr = t0r + row;
            float sacc = p->dt_bias[l * 16 + n];
#pragma unroll
            for (int w = 0; w < 8; ++w) sacc += part[(w * 16 + row) * 16 + n];
            if (rr < r1) DT[(size_t)rr * 16 + n] = softplusf_(sacc); }
    }
    __syncthreads();
}
typedef float f32x16 __attribute__((ext_vector_type(16)));
typedef short s16x4 __attribute__((ext_vector_type(4)));
constexpr int ST_ROW = 272;
constexpr int ST_TR128 = 320;
constexpr int ST_TR64 = 192;
constexpr int ST_MT = 328;
constexpr int NCHUNK = SEG / 128;

#define DPP_MOV(v, ctrl, rm, bm) __builtin_bit_cast(float, __builtin_amdgcn_update_dpp(0, __builtin_bit_cast(int, (v)), (ctrl), (rm), (bm), true))
__device__ __forceinline__ float wave_incl_scan(float v, int) {
    float s = v + DPP_MOV(v, 0x111, 0xF, 0xF) + DPP_MOV(v, 0x112, 0xF, 0xF) + DPP_MOV(v, 0x113, 0xF, 0xF);
    s += DPP_MOV(s, 0x114, 0xF, 0xE);
    s += DPP_MOV(s, 0x118, 0xF, 0xC);
    s += DPP_MOV(s, 0x142, 0xA, 0xF);
    s += DPP_MOV(s, 0x143, 0xC, 0xF);
    return s;
}
__device__ __forceinline__ bf16x8 row_frag(const LAS unsigned char* tile, int stride, int row0, int k0, int lane) {
    return *(const LAS bf16x8*)(tile + (row0 + (lane & 31)) * stride + (k0 + 8 * (lane >> 5)) * 2);
}
__device__ __forceinline__ bf16x8 tr_frag(const LAS unsigned char* tile, int stride, int k0, int c0, int lane) {
    const int g = lane >> 4, li = lane & 15, q = li >> 2, pp = li & 3;
    const LAS unsigned char* a0 = tile + (k0 + 8 * (g >> 1) + q) * stride + (c0 + 16 * (g & 1) + 4 * pp) * 2;
    const s16x4 lo = __builtin_amdgcn_ds_read_tr16_b64_v4i16((LAS s16x4*)a0);
    const s16x4 hi = __builtin_amdgcn_ds_read_tr16_b64_v4i16((LAS s16x4*)(a0 + 4 * stride));
    return __builtin_shufflevector(lo, hi, 0, 1, 2, 3, 4, 5, 6, 7);
}
__device__ __forceinline__ u32x4 pack8(const float (&v)[8]) { u32x4 r; r.x = cvt_pk_bf16(v[0], v[1]); r.y = cvt_pk_bf16(v[2], v[3]); r.z = cvt_pk_bf16(v[4], v[5]); r.w = cvt_pk_bf16(v[6], v[7]); return r; }
__device__ __forceinline__ u32x4 pack8s(const float (&v)[8], float sc) { u32x4 r; r.x = cvt_pk_bf16(v[0] * sc, v[1] * sc); r.y = cvt_pk_bf16(v[2] * sc, v[3] * sc); r.z = cvt_pk_bf16(v[4] * sc, v[5] * sc); r.w = cvt_pk_bf16(v[6] * sc, v[7] * sc); return r; }

__device__ __forceinline__ void conv_load(const bf16_t* proj, int row0, int rq, int xch, bool lo_ok, bool hi_ok, u32x4 (&raw)[8]) {
    const bf16_t* base = proj + (size_t)(row0 + 4 * rq) * NPROJ + 1536 + xch;
    unsigned zz; asm volatile("v_mov_b32 %0, 0" : "=v"(zz));
#pragma unroll
    for (int j = 0; j < 8; ++j) {
        if (j < 2) { const bool ok = (rq > 0) || lo_ok; const u32x4 v = *(const u32x4*)(ok ? base + (j - 2) * NPROJ : base);
            raw[j].x = ok ? v.x : zz; raw[j].y = ok ? v.y : zz; raw[j].z = ok ? v.z : zz; raw[j].w = ok ? v.w : zz; }
        else if (j >= 6) { const bool ok = (rq < 31) || hi_ok; const u32x4 v = *(const u32x4*)(ok ? base + (j - 2) * NPROJ : base);
            raw[j].x = ok ? v.x : zz; raw[j].y = ok ? v.y : zz; raw[j].z = ok ? v.z : zz; raw[j].w = ok ? v.w : zz; }
        else raw[j] = *(const u32x4*)(base + (j - 2) * NPROJ);
    }
}
__device__ __forceinline__ void conv_compute(const u32x4 (&raw)[8], const LAS float* wl, int nchl, int wch, float (&o)[4][8]) {
    float w[5][8], bs[8];
#pragma unroll
    for (int j = 0; j < 5; ++j) { const f32x4 w0 = *(const LAS f32x4*)(wl + j * nchl + wch), w1 = *(const LAS f32x4*)(wl + j * nchl + wch + 4);
        w[j][0] = w0[0]; w[j][1] = w0[1]; w[j][2] = w0[2]; w[j][3] = w0[3]; w[j][4] = w1[0]; w[j][5] = w1[1]; w[j][6] = w1[2]; w[j][7] = w1[3]; }
    { const f32x4 b0 = *(const LAS f32x4*)(wl + 5 * nchl + wch), b1 = *(const LAS f32x4*)(wl + 5 * nchl + wch + 4); bs[0] = b0[0]; bs[1] = b0[1]; bs[2] = b0[2]; bs[3] = b0[3]; bs[4] = b1[0]; bs[5] = b1[1]; bs[6] = b1[2]; bs[7] = b1[3]; }
#pragma unroll
    for (int i = 0; i < 4; ++i)
#pragma unroll
        for (int e = 0; e < 8; ++e) o[i][e] = bs[e];
#pragma unroll
    for (int j = 0; j < 8; ++j) {
        float xv[8] = {bflo(raw[j].x), bfhi(raw[j].x), bflo(raw[j].y), bfhi(raw[j].y), bflo(raw[j].z), bfhi(raw[j].z), bflo(raw[j].w), bfhi(raw[j].w)};
#pragma unroll
        for (int i = 0; i < 4; ++i) { const int tap = j - i; if (tap >= 0 && tap < 5) {
#pragma unroll
                for (int e = 0; e < 8; ++e) o[i][e] += w[tap][e] * xv[e]; } }
    }
#pragma unroll
    for (int i = 0; i < 4; ++i)
#pragma unroll
        for (int e = 0; e < 8; ++e) o[i][e] = siluf_(o[i][e]);
}
__device__ __forceinline__ void head_cums(CP p, int l, int row0, int h, int dir, int lane, LAS float* hv) {
    const float A = -expf(p->a_log[l * 16 + dir * 8 + h]);
    const float* DT = (const float*)(p->ws + WS_DT);
    const float d0 = DT[(size_t)(row0 + 2 * lane) * 16 + dir * 8 + h], d1 = DT[(size_t)(row0 + 2 * lane + 1) * 16 + dir * 8 + h];
    const float x0 = d0 * A, x1 = d1 * A;
    const float incl = wave_incl_scan(x0 + x1, lane);
    const float total = __builtin_bit_cast(float, __builtin_amdgcn_readlane(__builtin_bit_cast(int, incl), 63));
    float c0, c1;
    if (dir == 0) { c1 = incl; c0 = incl - x1; } else { c0 = total - (incl - x1 - x0); c1 = total - (incl - x1); }
    hv[dir * 128 + 2 * lane] = c0; hv[dir * 128 + 2 * lane + 1] = c1;
    hv[256 + dir * 128 + 2 * lane] = d0; hv[256 + dir * 128 + 2 * lane + 1] = d1;
    if (lane == 0) hv[512 + dir] = total;
}
__device__ __forceinline__ bf16x8 scale_frag(bf16x8 f, const f32x4 w0, const f32x4 w1) {
    const u32x4 u = __builtin_bit_cast(u32x4, f);
    u32x4 r;
    r.x = cvt_pk_bf16(bflo(u.x) * w0[0], bfhi(u.x) * w0[1]); r.y = cvt_pk_bf16(bflo(u.y) * w0[2], bfhi(u.y) * w0[3]);
    r.z = cvt_pk_bf16(bflo(u.z) * w1[0], bfhi(u.z) * w1[1]); r.w = cvt_pk_bf16(bflo(u.w) * w1[2], bfhi(u.w) * w1[3]);
    return __builtin_bit_cast(bf16x8, r);
}
constexpr int ST_X256 = 576;

__device__ __forceinline__ void phase_c1(CP p, int l, unsigned char* lds_, int bid, int nb) {
    LAS unsigned char* lds = (LAS unsigned char*)lds_;
    LAS unsigned char* tile = lds;
    LAS float* wl = (LAS float*)(lds + 73216);
    const int tid = launder_tid();
    const bf16_t* proj = (const bf16_t*)(p->ws + WS_PROJ); bf16_t* mix = (bf16_t*)(p->ws + WS_HX);
    const int NU = 256 + 512 + (l == DEPTH - 1 ? 0 : 16);
    const int heavy = (nb > 64 && (NB * NCHUNK * 2) % nb < nb / 4) ? (NB * NCHUNK * 2) % nb : 0;
    const int ustart = bid < heavy ? NU : (bid - heavy), ustep = nb - heavy;
#pragma unroll 1
    for (int u = ustart; u < NU; u += ustep) {
        int S, LEN, LSH, pstride, sstride, tok0, ch0;
        if (u < 256) { const int b = u >> 7, cs = (u >> 2) & 31, cc = u & 3; S = 2; LEN = 256; LSH = 8; pstride = 64; sstride = 1; tok0 = b * SEG + CTXL + 2 * cs; ch0 = 256 + 64 * cc; }
        else if (u < 768) { const int v = u - 256; const int b = v >> 8, rg = (v >> 2) & 63, cc = v & 3; S = 4; LEN = 64; LSH = 6; pstride = 1; sstride = 64; tok0 = b * SEG + CTXL + 256 * rg; ch0 = 64 * cc; }
        else { const int v = u - 768; const int b = v >> 3, cc = v & 7; S = 1; LEN = 256; LSH = 8; pstride = 1; sstride = 0; tok0 = b * SEG; ch0 = 64 * cc; }
        const int LP = LEN + 30;
        { float tw[4];
#pragma unroll
          for (int it = 0; it < 4; ++it) { const int i = tid + NTHREADS * it; const int j = i >> 6, c = i & 63; tw[it] = j < 31 ? p->conv_w[((size_t)l * 31 + j) * 512 + ch0 + c] : p->conv_b[l * 512 + ch0 + c]; }
#pragma unroll
          for (int it = 0; it < 4; ++it) wl[tid + NTHREADS * it] = tw[it]; }
        for (int i = tid; i < S * 30 * 8; i += NTHREADS) { const int pc = i & 7, q = (i >> 3) % 30, sq = (i >> 3) / 30; const int pos = q < 15 ? q : LEN + q;
            unsigned zz; asm volatile("v_mov_b32 %0, 0" : "=v"(zz));
            *(LAS u32x4*)(tile + ((sq * LP + pos) * 64 + pc * 8) * 2) = (u32x4){zz, zz, zz, zz}; }
        for (int ib = 0; ib < S * LEN * 8; ib += 4 * NTHREADS) {
            u32x4 uv[4];
#pragma unroll
            for (int q = 0; q < 4; ++q) { const int i = ib + tid + NTHREADS * q; const int pc = i & 7, t = i >> 3; const int sq = t >> LSH, pos = t & (LEN - 1);
                const bf16_t* src = proj + (size_t)(tok0 + sq * sstride + pos * pstride) * NPROJ + ch0 + pc * 8;
                uv[q] = *(const u32x4*)src; }
#pragma unroll
            for (int q = 0; q < 4; ++q) { const int i = ib + tid + NTHREADS * q; const int pc = i & 7, t = i >> 3; const int sq = t >> LSH, pos = t & (LEN - 1);
                const u32x4 o = uv[q];
                *(LAS u32x4*)(tile + ((sq * LP + 15 + pos) * 64 + pc * 8) * 2) = o; }
        }
        __syncthreads();
        const int noct = S * LEN / 8;
#pragma unroll 1
        for (int it = tid; it < noct * 32; it += NTHREADS) {
            const int cp = it & 31, oc = it >> 5; const int sq = oc >> (LSH - 3), p0 = (oc & ((LEN >> 3) - 1)) * 8;
            const LAS unsigned* base = (const LAS unsigned*)(tile + ((sq * LP + p0) * 64) * 2) + cp;
            float i0[38], i1[38];
#pragma unroll
            for (int k = 0; k < 38; ++k) { const unsigned w = base[k * 32]; i0[k] = bflo(w); i1[k] = bfhi(w); }
            float a0[8], a1[8];
            { const float b0 = wl[31 * 64 + 2 * cp], b1 = wl[31 * 64 + 2 * cp + 1];
#pragma unroll
              for (int i = 0; i < 8; ++i) { a0[i] = b0; a1[i] = b1; } }
#pragma unroll
            for (int j = 0; j < 31; ++j) { typedef float f32x2 __attribute__((ext_vector_type(2))); const f32x2 wj = *(const LAS f32x2*)(wl + j * 64 + 2 * cp); const float w0 = wj[0], w1 = wj[1];
#pragma unroll
                for (int i = 0; i < 8; ++i) { a0[i] += w0 * i0[i + j]; a1[i] += w1 * i1[i + j]; } }
#pragma unroll
            for (int i = 0; i < 8; ++i) { const int tok = tok0 + sq * sstride + (p0 + i) * pstride;
                *(unsigned*)(mix + (size_t)tok * 1024 + 512 + ch0 + 2 * cp) = cvt_pk_bf16(a0[i], a1[i]); }
        }
        __syncthreads();
    }
}
__device__ __forceinline__ void phase_c1_ln(CP p, int l, int bid, int nb) {
    const int tid = launder_tid(); const int lane = tid & 63, wave = tid >> 6;
    bf16_t* mix = (bf16_t*)(p->ws + WS_HX);
    const f32x4 g0 = *(const f32x4*)(p->conv_ln_g + l * 512 + lane * 8), g1 = *(const f32x4*)(p->conv_ln_g + l * 512 + lane * 8 + 4);
    const f32x4 b0 = *(const f32x4*)(p->conv_ln_b + l * 512 + lane * 8), b1 = *(const f32x4*)(p->conv_ln_b + l * 512 + lane * 8 + 4);
    const float gg[8] = {g0[0], g0[1], g0[2], g0[3], g1[0], g1[1], g1[2], g1[3]}, bb[8] = {b0[0], b0[1], b0[2], b0[3], b1[0], b1[1], b1[2], b1[3]};
    u32x4 vn = {0u, 0u, 0u, 0u};
    if (bid * 8 + wave < R) vn = *(const u32x4*)(mix + (size_t)(bid * 8 + wave) * 1024 + 512 + lane * 8);
    for (int r = bid * 8 + wave; r < R; r += nb * 8) {
        u32x4* ptr = (u32x4*)(mix + (size_t)r * 1024 + 512 + lane * 8);
        const u32x4 v = vn;
        if (r + nb * 8 < R) vn = *(const u32x4*)(mix + (size_t)(r + nb * 8) * 1024 + 512 + lane * 8);
        float y[8] = {bflo(v.x), bfhi(v.x), bflo(v.y), bfhi(v.y), bflo(v.z), bfhi(v.z), bflo(v.w), bfhi(v.w)};
        float s = 0.f;
#pragma unroll
        for (int e = 0; e < 8; ++e) s += y[e];
        const float mu = wave_sum(s) * (1.f / 512.f);
        float q = 0.f;
#pragma unroll
        for (int e = 0; e < 8; ++e) { y[e] -= mu; q += y[e] * y[e]; }
        const float rstd = rsqrtf(wave_sum(q) * (1.f / 512.f) + 1e-5f);
        float o[8];
#pragma unroll
        for (int e = 0; e < 8; ++e) o[e] = siluf_(y[e] * rstd * gg[e] + bb[e]);
        *ptr = pack8(o);
    }
}
__device__ __forceinline__ void phase_s1(CP p, int l, unsigned char* lds_, int bid, int nb) {
    LAS unsigned char* lds = (LAS unsigned char*)lds_;
    LAS unsigned char* Bs = lds;
    LAS unsigned char* Xs = lds + 128 * ST_TR128;
    LAS float* wv = (LAS float*)(Xs + 128 * ST_X256);
    LAS float* hvs = wv + 8 * 128;
    LAS float* cwl = hvs + 4 * 520;
    const int tid = launder_tid(); const int lane = tid & 63, wave = __builtin_amdgcn_readfirstlane(tid >> 6);
    const bf16_t* proj = (const bf16_t*)(p->ws + WS_PROJ);
    const float* cw = p->ssd_conv_w + (size_t)l * 5 * 1024; const float* cbias = p->ssd_conv_b + (size_t)l * 1024;
    bf16_t* Sg = (bf16_t*)(p->ws + WS_S); float* DEC = (float*)(p->ws + WS_DEC);
    int cur_g = -1;
#pragma unroll 1
    for (int u = bid; u < NB * NCHUNK * 2; u += nb) {
        const int g = u & 1, c = (u >> 1) % NCHUNK, b = (u >> 1) / NCHUNK;
        const int row0 = b * SEG + c * 128;
        const bool lo_ok = !(c == 0 || c == 2), hi_ok = !(c == 1 || c == NCHUNK - 1);
        if (g != cur_g) { cur_g = g;
            float tw[5];
#pragma unroll
            for (int it = 0; it < 5; ++it) { const int i = tid + NTHREADS * it; const int j = i / 384, lc = i - j * 384; const int gch = lc < 128 ? 512 + g * 128 + lc : g * 256 + (lc - 128);
                tw[it] = i < 6 * 384 ? (j < 5 ? cw[j * 1024 + gch] : cbias[gch]) : 0.f; }
#pragma unroll
            for (int it = 0; it < 5; ++it) { const int i = tid + NTHREADS * it; if (i < 6 * 384) cwl[i] = tw[it]; } }
        const int hh = wave >> 1, dir = wave & 1, h = 4 * g + hh;
        u32x4 rb[8], rx0[8], rx1[8];
        conv_load(proj, row0, tid >> 4, 512 + g * 128 + (tid & 15) * 8, lo_ok, hi_ok, rb);
        conv_load(proj, row0, tid >> 5, g * 256 + (tid & 31) * 8, lo_ok, hi_ok, rx0);
        conv_load(proj, row0, (tid >> 5) + 16, g * 256 + (tid & 31) * 8, lo_ok, hi_ok, rx1);
        head_cums(p, l, row0, h, dir, lane, hvs + hh * 520);
        __syncthreads();
        {
            const LAS float* hv = hvs + hh * 520; const float tot = hv[512 + dir];
#pragma unroll
            for (int q = 0; q < 2; ++q) { const int lr = lane + 64 * q; wv[wave * 128 + lr] = __expf(tot - hv[dir * 128 + lr]) * hv[256 + dir * 128 + lr]; }
            if (lane == 0) DEC[((size_t)(b * 2 + dir) * NCHUNK + c) * 8 + h] = __expf(tot);
        }
        { float o[4][8];
          conv_compute(rb, cwl, 384, (tid & 15) * 8, o);
#pragma unroll
          for (int i = 0; i < 4; ++i) *(LAS u32x4*)(Bs + (4 * (tid >> 4) + i) * ST_TR128 + (tid & 15) * 16) = pack8(o[i]);
          conv_compute(rx0, cwl, 384, 128 + (tid & 31) * 8, o);
#pragma unroll
          for (int i = 0; i < 4; ++i) *(LAS u32x4*)(Xs + (4 * (tid >> 5) + i) * ST_X256 + (tid & 31) * 16) = pack8(o[i]);
          conv_compute(rx1, cwl, 384, 128 + (tid & 31) * 8, o);
#pragma unroll
          for (int i = 0; i < 4; ++i) *(LAS u32x4*)(Xs + (4 * ((tid >> 5) + 16) + i) * ST_X256 + (tid & 31) * 16) = pack8(o[i]); }
        __syncthreads();
        {
            f32x16 acc[2][4];
#pragma unroll
            for (int t = 0; t < 2; ++t)
#pragma unroll
                for (int q = 0; q < 4; ++q)
#pragma unroll
                    for (int e = 0; e < 16; ++e) acc[t][q][e] = 0.f;
#pragma unroll 2
            for (int kk = 0; kk < 8; ++kk) {
                const LAS float* wp = wv + wave * 128 + 16 * kk + 8 * (lane >> 5);
                const f32x4 w0 = *(const LAS f32x4*)wp, w1 = *(const LAS f32x4*)(wp + 4);
                bf16x8 af[2];
#pragma unroll
                for (int t = 0; t < 2; ++t) af[t] = scale_frag(tr_frag(Xs, ST_X256, 16 * kk, hh * 64 + 32 * t, lane), w0, w1);
#pragma unroll
                for (int q = 0; q < 4; ++q) { const bf16x8 bf = tr_frag(Bs, ST_TR128, 16 * kk, 32 * q, lane);
#pragma unroll
                    for (int t = 0; t < 2; ++t) acc[t][q] = __builtin_amdgcn_mfma_f32_32x32x16_bf16(bf, af[t], acc[t][q], 0, 0, 0); }
            }
            bf16_t* So = Sg + ((size_t)((b * 2 + dir) * NCHUNK + c) * 8 + h) * 8192 + (size_t)(lane & 31) * 128 + 4 * (lane >> 5);
#pragma unroll
            for (int t = 0; t < 2; ++t)
#pragma unroll
                for (int q = 0; q < 4; ++q)
#pragma unroll
                    for (int rg = 0; rg < 4; ++rg) { u32x2 pk; pk.x = cvt_pk_bf16(acc[t][q][4 * rg], acc[t][q][4 * rg + 1]); pk.y = cvt_pk_bf16(acc[t][q][4 * rg + 2], acc[t][q][4 * rg + 3]);
                        *(u32x2*)(So + (size_t)(32 * t) * 128 + 32 * q + 8 * rg) = pk; }
        }
        __syncthreads();
    }
}
__device__ __forceinline__ void phase_s2(CP p, int bid, int nb) {
    const int tid = launder_tid();
    const bf16_t* Sg = (const bf16_t*)(p->ws + WS_S); const float* DEC = (const float*)(p->ws + WS_DEC); bf16_t* HP = (bf16_t*)(p->ws + WS_HP);
    for (int idx = bid * NTHREADS + tid; idx < 2 * 2 * 8 * 64 * 64; idx += nb * NTHREADS) {
        const int n2 = idx & 63, pr = (idx >> 6) & 63, h = (idx >> 12) & 7, dir = (idx >> 15) & 1, b = idx >> 16;
        const size_t inner = (size_t)h * 8192 + pr * 128 + 2 * n2;
        const size_t cbase = (size_t)(b * 2 + dir) * NCHUNK;
        float s0 = 0.f, s1 = 0.f;
#pragma unroll 26
        for (int step = 0; step < NCHUNK; ++step) {
            const int c = dir == 0 ? step : (step < 2 ? 1 - step : NCHUNK + 1 - step);
            const size_t off = (cbase + c) * 65536 + inner;
            const unsigned sv = *(const unsigned*)(Sg + off); const float d = DEC[(cbase + c) * 8 + h];
            *(unsigned*)(HP + off) = cvt_pk_bf16(s0, s1);
            s0 = s0 * d + bflo(sv); s1 = s1 * d + bfhi(sv);
        }
    }
}
__device__ __forceinline__ void phase_s3(CP p, int l, unsigned char* lds_, int bid, int nb) {
    LAS unsigned char* lds = (LAS unsigned char*)lds_;
    LAS unsigned char* Cs = lds;
    LAS unsigned char* Bs = Cs + 128 * ST_ROW;
    LAS unsigned char* Mt = Bs;
    LAS unsigned char* Xs = Bs + 128 * ST_MT;
    LAS unsigned char* Hf = Xs + 128 * ST_TR64;
    LAS unsigned char* Hb = Hf + 64 * ST_ROW;
    LAS float* hvs = (LAS float*)(Hb + 64 * ST_ROW);
    LAS float* ssqp = hvs + 4 * 776;
    LAS float* cwl = ssqp + 256;
    const int tid0 = launder_tid(); const int wave = __builtin_amdgcn_readfirstlane(tid0 >> 6);
    const bf16_t* proj = (const bf16_t*)(p->ws + WS_PROJ); bf16_t* mix = (bf16_t*)(p->ws + WS_HX);
    const float* cw = p->ssd_conv_w + (size_t)l * 5 * 1024; const float* cbias = p->ssd_conv_b + (size_t)l * 1024;
    const bf16_t* HP = (const bf16_t*)(p->ws + WS_HP); float* SSQ = (float*)(p->ws + WS_SSQ);
    int cur_g = -1;
    const int cskip = (l == DEPTH - 1) ? 2 : 0, cpb = NCHUNK - cskip;
    const int nunits = NB * cpb * 2, nfull = nunits - nunits % nb, nitems = nfull + (nunits - nfull) * 4;
#pragma unroll 1
    for (int it = bid; it < nitems; it += nb) {
        const int u = it < nfull ? it : nfull + ((it - nfull) >> 2);
        const int hh_lo = it < nfull ? 0 : ((it - nfull) & 3), hh_hi = it < nfull ? 4 : hh_lo + 1;
        const int g = u & 1, c = cskip + (u >> 1) % cpb, b = (u >> 1) / cpb;
        int tid = tid0; asm volatile("" : "+v"(tid));
        const int lane = tid & 63;
        const int row0 = b * SEG + c * 128;
        const bool lo_ok = !(c == 0 || c == 2), hi_ok = !(c == 1 || c == NCHUNK - 1);
        if (g != cur_g) { cur_g = g;
            float tw[6];
#pragma unroll
            for (int it = 0; it < 6; ++it) { const int i = tid + NTHREADS * it; const int j = i >> 9, lc = i & 511; const int gch = lc < 128 ? 768 + g * 128 + lc : (lc < 256 ? 512 + g * 128 + (lc - 128) : g * 256 + (lc - 256));
                tw[it] = j < 5 ? cw[j * 1024 + gch] : cbias[gch]; }
#pragma unroll
            for (int it = 0; it < 6; ++it) cwl[tid + NTHREADS * it] = tw[it]; }
        u32x4 rx[8];
        {
            u32x4 r0[8], r1[8];
            const int cg = tid & 31; const int gch = (cg < 16 ? 768 : 512) + g * 128 + (cg & 15) * 8;
            conv_load(proj, row0, tid >> 5, gch, lo_ok, hi_ok, r0);
            conv_load(proj, row0, (tid >> 5) + 16, gch, lo_ok, hi_ok, r1);
            head_cums(p, l, row0, 4 * g + (wave >> 1), wave & 1, lane, hvs + (wave >> 1) * 776);
            { LAS float* hvw = hvs + (wave >> 1) * 776; const int dr = wave & 1;
              hvw[520 + dr * 128 + 2 * lane] = __expf(hvw[dr * 128 + 2 * lane]); hvw[520 + dr * 128 + 2 * lane + 1] = __expf(hvw[dr * 128 + 2 * lane + 1]); }
            __syncthreads();
            float o[4][8];
            LAS unsigned char* dst = (cg < 16 ? Cs : Bs) + (cg & 15) * 16;
            conv_compute(r0, cwl, 512, cg * 8, o);
#pragma unroll
            for (int i = 0; i < 4; ++i) *(LAS u32x4*)(dst + (4 * (tid >> 5) + i) * ST_ROW) = pack8(o[i]);
            asm volatile("" ::: "memory");
            if (tid < 256) conv_load(proj, row0, tid >> 3, g * 256 + hh_lo * 64 + (tid & 7) * 8, lo_ok, hi_ok, rx);
            conv_compute(r1, cwl, 512, cg * 8, o);
#pragma unroll
            for (int i = 0; i < 4; ++i) *(LAS u32x4*)(dst + (4 * ((tid >> 5) + 16) + i) * ST_ROW) = pack8(o[i]);
            if (tid < 256) { conv_compute(rx, cwl, 512, 256 + hh_lo * 64 + (tid & 7) * 8, o);
#pragma unroll
                for (int i = 0; i < 4; ++i) *(LAS u32x4*)(Xs + (4 * (tid >> 3) + i) * ST_TR64 + (tid & 7) * 16) = pack8(o[i]); }
        }
        __syncthreads();
        const int lb = wave >> 1, hs = wave & 1;
        int ln = lane; asm volatile("" : "+v"(ln));
        f32x16 gacc[2];
#pragma unroll
        for (int t = 0; t < 2; ++t)
#pragma unroll
            for (int e = 0; e < 16; ++e) gacc[t][e] = 0.f;
#pragma unroll
        for (int kk = 0; kk < 8; ++kk) { const bf16x8 af = row_frag(Cs, ST_ROW, 32 * lb, 16 * kk, lane);
#pragma unroll
            for (int t = 0; t < 2; ++t) { const bf16x8 bf = row_frag(Bs, ST_ROW, 64 * hs + 32 * t, 16 * kk, lane);
                gacc[t] = __builtin_amdgcn_mfma_f32_32x32x16_bf16(af, bf, gacc[t], 0, 0, 0); } }
        u32x4 hreg[4];
        { const bf16_t* hp0 = HP + ((size_t)(b * 2 * NCHUNK + c) * 8 + 4 * g + hh_lo) * 8192;
#pragma unroll
          for (int q = 0; q < 4; ++q) { const int it = tid + 512 * q; hreg[q] = *(const u32x4*)(hp0 + (size_t)(it >> 10) * NCHUNK * 8 * 8192 + (it & 1023) * 8); } }
        __syncthreads();
#pragma unroll 1
        for (int hh = hh_lo; hh < hh_hi; ++hh) {
            const int h = 4 * g + hh; const LAS float* hv = hvs + hh * 776;
            asm volatile("" : "+v"(ln));
            const int ph = hs, pc = 32 * ph + (ln & 31);
#pragma unroll
            for (int t = 0; t < 2; ++t) {
                const int st = 2 * hs + t;
                const int sc = 32 * st + (ln & 31);
                const float cfs = hv[sc], cbs = hv[128 + sc], dfs = hv[256 + sc], dbs = hv[384 + sc];
#pragma unroll
                for (int rg = 0; rg < 4; ++rg) {
                    const int l0 = 32 * lb + 8 * rg + 4 * (ln >> 5);
                    float m[4];
                    if (st < lb) {
                        const f32x4 cfl = *(const LAS f32x4*)(hv + l0);
#pragma unroll
                        for (int e = 0; e < 4; ++e) m[e] = gacc[t][4 * rg + e] * (__expf(cfl[e] - cfs) * dfs);
                    } else if (st > lb) {
                        const f32x4 cbl = *(const LAS f32x4*)(hv + 128 + l0);
#pragma unroll
                        for (int e = 0; e < 4; ++e) m[e] = gacc[t][4 * rg + e] * (__expf(cbl[e] - cbs) * dbs);
                    } else {
                        const f32x4 cfl = *(const LAS f32x4*)(hv + l0), cbl = *(const LAS f32x4*)(hv + 128 + l0);
#pragma unroll
                        for (int e = 0; e < 4; ++e) { const int lr = l0 + e;
                            const float ff = lr >= sc ? __expf(cfl[e] - cfs) * dfs : 0.f;
                            const float fb = lr <= sc ? __expf(cbl[e] - cbs) * dbs : 0.f;
                            m[e] = gacc[t][4 * rg + e] * (ff + fb); }
                    }
                    u32x2 pk; pk.x = cvt_pk_bf16(m[0], m[1]); pk.y = cvt_pk_bf16(m[2], m[3]);
                    *(LAS u32x2*)(Mt + sc * ST_MT + l0 * 2) = pk;
                }
            }
#pragma unroll
            for (int q = 0; q < 4; ++q) { const int it = tid + 512 * q; const int q2 = it & 1023;
                *(LAS u32x4*)(((it >> 10) ? Hb : Hf) + (q2 >> 4) * ST_ROW + (q2 & 15) * 16) = hreg[q]; }
            if (hh + 1 < hh_hi) {
                const bf16_t* hp0 = HP + ((size_t)(b * 2 * NCHUNK + c) * 8 + h + 1) * 8192;
#pragma unroll
                for (int q = 0; q < 4; ++q) { const int it = tid + 512 * q; hreg[q] = *(const u32x4*)(hp0 + (size_t)(it >> 10) * NCHUNK * 8 * 8192 + (it & 1023) * 8); }
                if (tid < 256) conv_load(proj, row0, tid >> 3, g * 256 + (hh + 1) * 64 + (tid & 7) * 8, lo_ok, hi_ok, rx);
            }
            unsigned zraw[8];
#pragma unroll
            for (int ri = 0; ri < 16; ri += 2) { const int lr = 32 * lb + 8 * (ri >> 2) + 4 * (ln >> 5) + (ri & 3);
                const bf16_t* zp = proj + (size_t)(row0 + lr) * NPROJ + 1024 + h * 64 + pc;
                zraw[ri >> 1] = (unsigned)zp[0] | ((unsigned)zp[NPROJ] << 16); }
            __syncthreads();
            f32x16 ad, af_, ab_;
#pragma unroll
            for (int e = 0; e < 16; ++e) { ad[e] = 0.f; af_[e] = 0.f; ab_[e] = 0.f; }
#pragma unroll
            for (int kk = 0; kk < 8; ++kk) {
                const bf16x8 am = tr_frag(Mt, ST_MT, 16 * kk, 32 * lb, lane);
                const bf16x8 bx = tr_frag(Xs, ST_TR64, 16 * kk, 32 * ph, lane);
                ad = __builtin_amdgcn_mfma_f32_32x32x16_bf16(am, bx, ad, 0, 0, 0);
                const bf16x8 ac = row_frag(Cs, ST_ROW, 32 * lb, 16 * kk, lane);
                const bf16x8 bhf = row_frag(Hf, ST_ROW, 32 * ph, 16 * kk, lane);
                const bf16x8 bhb = row_frag(Hb, ST_ROW, 32 * ph, 16 * kk, lane);
                af_ = __builtin_amdgcn_mfma_f32_32x32x16_bf16(ac, bhf, af_, 0, 0, 0);
                ab_ = __builtin_amdgcn_mfma_f32_32x32x16_bf16(ac, bhb, ab_, 0, 0, 0);
            }
            const float dsk = p->d_skip[l * 8 + h];
#pragma unroll
            for (int rg = 0; rg < 4; ++rg) {
                const int l0 = 32 * lb + 8 * rg + 4 * (ln >> 5);
                const f32x4 efl = *(const LAS f32x4*)(hv + 520 + l0), ebl = *(const LAS f32x4*)(hv + 648 + l0);
#pragma unroll
                for (int e = 0; e < 4; ++e) { const int lr = l0 + e; const int ri = 4 * rg + e;
                    const float xs = bf2f(*(const LAS bf16_t*)(Xs + lr * ST_TR64 + pc * 2));
                    const float y = ad[ri] + efl[e] * af_[ri] + ebl[e] * ab_[ri] + dsk * xs;
                    const float z = (ri & 1) ? bfhi(zraw[ri >> 1]) : bflo(zraw[ri >> 1]);
                    const float val = y * z;
                    mix[(size_t)(row0 + lr) * 1024 + h * 64 + pc] = f2bf(val);
                    const float sq = half_sum32(val * val);
                    if ((ln & 31) == 31) ssqp[ph * 128 + lr] = sq;
                }
            }
            __syncthreads();
            if (tid < 128) SSQ[(size_t)(row0 + tid) * 8 + h] = ssqp[tid] + ssqp[128 + tid];
            if (hh + 1 < hh_hi && tid < 256) { float o[4][8];
                conv_compute(rx, cwl, 512, 256 + (hh + 1) * 64 + (tid & 7) * 8, o);
#pragma unroll
                for (int i = 0; i < 4; ++i) *(LAS u32x4*)(Xs + (4 * (tid >> 3) + i) * ST_TR64 + (tid & 7) * 16) = pack8(o[i]); }
        }
        __syncthreads();
    }
}
__device__ __forceinline__ void phase_r2(CP p, int l, unsigned char* lds_, int bid, int nb) {
    LAS unsigned char* lds = (LAS unsigned char*)lds_;
    LAS unsigned char* Wh = lds;
    LAS unsigned char* Xh = Wh + 32 * ST_H16;
    LAS float* gm = (LAS float*)(Xh + 16 * ST_H16);
    LAS float* sh = gm + 3 * 1024;
    LAS float* part = sh + 3 * 1024;
    LAS float* lgs = part + 8 * 16 * 32;
    LAS int* lcnt = (LAS int*)(lgs + 16 * 32);
    LAS int* lcls = lcnt + 64;
    LAS int* lrank = lcls + 512;
    LAS float* lcwa = (LAS float*)(lrank + 512);
    LAS float* lcwb = lcwa + 512;
    const int tid = launder_tid(); const int lane = tid & 63, wave = __builtin_amdgcn_readfirstlane(tid >> 6);
    const float* mod = (const float*)(p->ws + WS_MOD) + (size_t)l * 3 * 6144;
    {
        float tmp[8];
#pragma unroll
        for (int it = 0; it < 8; ++it) tmp[it] = p->w_rg[(size_t)l * 4096 + tid + NTHREADS * it];
#pragma unroll
        for (int it = 0; it < 8; ++it) { const int idx = tid + NTHREADS * it; *(LAS _Float16*)(Wh + (idx & 3) * ST_H16 + (idx >> 2) * 2) = (_Float16)tmp[it]; } }
#pragma unroll
    for (int hb = 0; hb < 2; ++hb) { float tmp[16];
#pragma unroll
        for (int it = 0; it < 16; ++it) tmp[it] = p->w_re[(size_t)l * 16384 + tid + NTHREADS * (16 * hb + it)];
#pragma unroll
        for (int it = 0; it < 16; ++it) { const int idx = tid + NTHREADS * (16 * hb + it); *(LAS _Float16*)(Wh + (4 + (idx & 15)) * ST_H16 + (idx >> 4) * 2) = (_Float16)tmp[it]; } }
    { unsigned zz; asm volatile("v_mov_b32 %0, 0" : "=v"(zz));
      for (int i = tid; i < 12 * 128; i += NTHREADS) { const int rw = 20 + i / 128, c16 = i % 128; *(LAS u32x4*)(Wh + rw * ST_H16 + c16 * 16) = (u32x4){zz, zz, zz, zz}; } }
    { float t0[6], t1[6], t2[6];
#pragma unroll
      for (int it = 0; it < 6; ++it) { const int idx = tid + NTHREADS * it; const int v = idx >> 10, k = idx & 1023; t0[it] = p->g_ffn[l * 1024 + k]; t1[it] = mod[v * 6144 + 4 * 1024 + k]; t2[it] = mod[v * 6144 + 3 * 1024 + k]; }
#pragma unroll
      for (int it = 0; it < 6; ++it) { const int idx = tid + NTHREADS * it; gm[idx] = t0[it] * (1.f + t1[it]); sh[idx] = t2[it]; } }
    if (tid < 64) lcnt[tid] = 0;
    __syncthreads();
    bf16_t* HM = (bf16_t*)(p->ws + WS_HX); float* CWLA = (float*)(p->ws + WS_CWLA); float* CWLB = (float*)(p->ws + WS_CWLB);
    int* gcount = (int*)(p->ws + WS_CTL) + l * 32; int* LIST = (int*)(p->ws + WS_LIST);
    const int rpb = (R + nb - 1) / nb, r0 = bid * rpb, r1 = (r0 + rpb) < R ? (r0 + rpb) : R;
    RowRaw xn[2];
#pragma unroll
    for (int q = 0; q < 2; ++q) if (r0 + 2 * wave + q < r1) row_load(p, 1, r0 + 2 * wave + q, lane, xn[q]);
#pragma unroll 1
    for (int t0r = r0; t0r < r1; t0r += 16) {
        f32x4 xv[2][4];
#pragma unroll
        for (int q = 0; q < 2; ++q) row_cvt(1, xn[q], xv[q]);
#pragma unroll
        for (int q = 0; q < 2; ++q) if (t0r + 16 + 2 * wave + q < r1) row_load(p, 1, t0r + 16 + 2 * wave + q, lane, xn[q]);
#pragma unroll
        for (int q = 0; q < 2; ++q) { const int rr = t0r + 2 * wave + q; const bool ok = rr < r1; const int v = row_v(ok ? rr : r0);
            float ss = 0.f;
#pragma unroll
            for (int j = 0; j < 4; ++j) ss += xv[q][j][0] * xv[q][j][0] + xv[q][j][1] * xv[q][j][1] + xv[q][j][2] * xv[q][j][2] + xv[q][j][3] * xv[q][j][3];
            ss = wave_sum(ss); const float rs = ok ? __builtin_amdgcn_rsqf(ss * (1.f / 1024.f) + 1e-6f) : 0.f;
#pragma unroll
            for (int j = 0; j < 4; ++j) { const int k = 4 * lane + 256 * j; const f32x4 g4 = *(const LAS f32x4*)(gm + v * 1024 + k), s4 = *(const LAS f32x4*)(sh + v * 1024 + k);
                f32x4 hv = xv[q][j] * rs * g4 + s4; if (!ok) hv = hv * 0.f;
                u32x2 o; o.x = cvt_pk_bf16(hv[0], hv[1]); o.y = cvt_pk_bf16(hv[2], hv[3]);
                if (ok) *(u32x2*)(HM + (size_t)rr * 1024 + k) = o;
                u32x2 h16; h16.x = pack_f16(hv[0], hv[1]); h16.y = pack_f16(hv[2], hv[3]);
                *(LAS u32x2*)(Xh + (2 * wave + q) * ST_H16 + k * 2) = h16; } }
        __syncthreads();
        {
            f32x4 acc0 = {0.f, 0.f, 0.f, 0.f}, acc1 = {0.f, 0.f, 0.f, 0.f};
#pragma unroll
            for (int s4 = 0; s4 < 4; ++s4) { const int kb = (128 * wave + 32 * s4 + 8 * (lane >> 4)) * 2;
                const f16x8 a = *(const LAS f16x8*)(Xh + (lane & 15) * ST_H16 + kb);
                const f16x8 b0 = *(const LAS f16x8*)(Wh + (lane & 15) * ST_H16 + kb), b1 = *(const LAS f16x8*)(Wh + (16 + (lane & 15)) * ST_H16 + kb);
                acc0 = __builtin_amdgcn_mfma_f32_16x16x32_f16(a, b0, acc0, 0, 0, 0);
                acc1 = __builtin_amdgcn_mfma_f32_16x16x32_f16(a, b1, acc1, 0, 0, 0); }
#pragma unroll
            for (int e = 0; e < 4; ++e) { const int row = 4 * (lane >> 4) + e; part[(wave * 16 + row) * 32 + (lane & 15)] = acc0[e]; part[(wave * 16 + row) * 32 + 16 + (lane & 15)] = acc1[e]; }
        }
        __syncthreads();
        if (tid < 320) { const int row = tid / 20, n = tid - row * 20; float sacc = n < 4 ? p->b_rg[l * 4 + n] : p->b_re[l * 16 + n - 4];
#pragma unroll
            for (int w = 0; w < 8; ++w) sacc += part[(w * 16 + row) * 32 + n];
            lgs[row * 32 + n] = sacc; }
        __syncthreads();
        if (tid < 16) { const int rr = t0r + tid;
            if (rr < r1) {
                if (l == DEPTH - 1 && row_v(rr) == 2) lcls[rr - r0] = -1;
                else {
                    float lg[20];
#pragma unroll
                    for (int n = 0; n < 20; ++n) lg[n] = lgs[tid * 32 + n];
                    int gsel = 0; float gmax = lg[0];
#pragma unroll
                    for (int t = 1; t < 4; ++t) if (lg[t] > gmax) { gmax = lg[t]; gsel = t; }
                    float gden = 0.f;
#pragma unroll
                    for (int t = 0; t < 4; ++t) gden += __expf(lg[t] - gmax);
                    const float gprob = 1.f / gden;
                    float el[4];
#pragma unroll
                    for (int t = 0; t < 4; ++t) el[t] = gsel == 0 ? lg[4 + t] : (gsel == 1 ? lg[8 + t] : (gsel == 2 ? lg[12 + t] : lg[16 + t]));
                    int i0 = 0; float m0 = el[0];
#pragma unroll
                    for (int t = 1; t < 4; ++t) if (el[t] > m0) { m0 = el[t]; i0 = t; }
                    int i1 = -1; float m1 = -3.0e38f;
#pragma unroll
                    for (int t = 0; t < 4; ++t) if (t != i0 && el[t] > m1) { m1 = el[t]; i1 = t; }
                    const float w0 = gprob / (1.f + __expf(m1 - m0)), w1 = gprob - w0;
                    const int ea = i0 < i1 ? i0 : i1, eb = i0 < i1 ? i1 : i0;
                    const float cwa = i0 < i1 ? w0 : w1, cwb = i0 < i1 ? w1 : w0;
                    const int pidx = ea == 0 ? eb - 1 : (ea == 1 ? eb + 1 : 5);
                    const int cls = gsel * 6 + pidx;
                    const int rank = __hip_atomic_fetch_add(&lcnt[cls], 1, __ATOMIC_RELAXED, __HIP_MEMORY_SCOPE_WORKGROUP);
                    lcls[rr - r0] = cls; lrank[rr - r0] = rank; lcwa[rr - r0] = cwa; lcwb[rr - r0] = cwb;
                } } }
    }
    __syncthreads();
    if (tid < NCLS) lcnt[32 + tid] = atomicAdd(&gcount[tid], lcnt[tid]);
    __syncthreads();
    for (int idx = tid; idx < r1 - r0; idx += NTHREADS) { const int cl = lcls[idx]; if (cl < 0) continue; const int pos = lcnt[32 + cl] + lrank[idx]; const size_t li = (size_t)cl * R + pos;
        LIST[li] = r0 + idx; CWLA[li] = lcwa[idx]; CWLB[li] = lcwb[idx]; }
    __syncthreads();
}
__device__ __forceinline__ void phase_final(CP p, unsigned char* lds, int bid, int nb) {
    const int tid = launder_tid(); const int lane = tid & 63, wave = tid >> 6;
    const int qstep = nb * 8;
    RowRaw xn;
    { const int q = bid * 8 + wave; if (q < NB * SEQ) { const int b = q >= SEQ ? 1 : 0; row_load(p, 1, b * SEG + CTXL + (q - b * SEQ), lane, xn); } }
    for (int q = bid * 8 + wave; q < NB * SEQ; q += qstep) {
        f32x4* hr = (f32x4*)(p->out + (size_t)q * D);
        f32x4 xv[4]; float ss = 0.f;
        row_cvt(1, xn, xv);
        { const int qn = q + qstep; if (qn < NB * SEQ) { const int bn = qn >= SEQ ? 1 : 0; row_load(p, 1, bn * SEG + CTXL + (qn - bn * SEQ), lane, xn); } }
#pragma unroll
        for (int j = 0; j < 4; ++j) ss += xv[j][0] * xv[j][0] + xv[j][1] * xv[j][1] + xv[j][2] * xv[j][2] + xv[j][3] * xv[j][3];
        ss = wave_sum(ss); const float rs = rsqrtf(ss * (1.f / 1024.f) + 1e-6f);
#pragma unroll
        for (int j = 0; j < 4; ++j) { const f32x4 g4 = *(const f32x4*)(p->g_final + 4 * lane + 256 * j); hr[lane + 64 * j] = xv[j] * rs * g4; }
    }
}


#define XB_TMO      128
#define XB_XCNT(j)  (256  + 64 * (j))
#define XB_XSUB(j)  (1280 + 64 * (j))
#define XB_XGEN(j)  (2304 + 64 * (j))
#define XB_TOP      3328
#define XB_TOPGEN   3392
#define XCD_BAR_WORDS 3456
#define XB_SPIN_CAP (1u << 22)
__device__ __forceinline__ unsigned xb_ld(unsigned* p) { return __hip_atomic_load(p, __ATOMIC_RELAXED, __HIP_MEMORY_SCOPE_AGENT); }
__device__ __forceinline__ unsigned xb_add(unsigned* p, unsigned v) { return __hip_atomic_fetch_add(p, v, __ATOMIC_RELAXED, __HIP_MEMORY_SCOPE_AGENT); }
__device__ __forceinline__ unsigned xb_xcc_id() { return (unsigned)__builtin_amdgcn_s_getreg((3 << 11) | 20) & 0xFu; }
#define XB_SPIN(cond, bar) do { unsigned _sp = 0; while (cond) { __builtin_amdgcn_s_sleep(1); \
    if ((++_sp & 255u) == 0u) { if (xb_ld(&(bar)[XB_TMO])) break; if (_sp > XB_SPIN_CAP) { atomicAdd(&(bar)[XB_TMO], 1u); break; } } } } while (0)
struct XcdBarrier { unsigned* bar; unsigned x; volatile LAS unsigned* st; };
__device__ __forceinline__ XcdBarrier xcd_barrier_post(unsigned* bar, volatile LAS unsigned* st) {
    XcdBarrier b; b.bar = bar; b.x = xb_xcc_id(); b.st = st;
    if (threadIdx.x == 0) (void)xb_add(&bar[XB_XCNT(b.x)], 1u);
    return b;
}
__device__ __forceinline__ void xcd_barrier_complete(unsigned* bar, unsigned x, unsigned& nloc, unsigned& nx) {
    const unsigned G = gridDim.x * gridDim.y * gridDim.z;
    unsigned sum, cnt, mine, sp = 0u;
    for (;;) {
        sum = 0u; cnt = 0u; mine = 0u;
#pragma unroll
        for (unsigned j = 0; j < 16; ++j) { const unsigned c = xb_ld(&bar[XB_XCNT(j)]); sum += c; cnt += (c > 0u) ? 1u : 0u; mine = (j == x) ? c : mine; }
        if (sum == G) break;
        __builtin_amdgcn_s_sleep(1);
        if ((++sp & 255u) == 0u) { if (xb_ld(&bar[XB_TMO])) break; if (sp > XB_SPIN_CAP) { atomicAdd(&bar[XB_TMO], 1u); break; } }
    }
    nloc = mine > 0u ? mine : 1u; nx = cnt > 0u ? cnt : 1u;
}
__device__ __forceinline__ void xcd_barrier(const XcdBarrier& b) {
    asm volatile("s_waitcnt vmcnt(0)" ::: "memory");
    __syncthreads();
    if (threadIdx.x == 0) {
        unsigned* bar = b.bar;
        __builtin_amdgcn_s_waitcnt(0);
        unsigned nloc = b.st[0], nx = b.st[1];
        if (nloc == 0u) { xcd_barrier_complete(bar, b.x, nloc, nx); b.st[0] = nloc; b.st[1] = nx; }
        const unsigned old = xb_add(&bar[XB_XSUB(b.x)], 1u);
        const unsigned gen = old / nloc;
        if (old + 1u == (gen + 1u) * nloc) {
            __builtin_amdgcn_fence(__ATOMIC_RELEASE, "agent");
            asm volatile("s_waitcnt vmcnt(0)" ::: "memory");
            const unsigned og = xb_add(&bar[XB_TOP], 1u);
            const unsigned tg = og / nx;
            if (og + 1u == (tg + 1u) * nx) xb_add(&bar[XB_TOPGEN], 1u);
            else XB_SPIN(xb_ld(&bar[XB_TOPGEN]) == tg, bar);
            __builtin_amdgcn_fence(__ATOMIC_ACQUIRE, "agent");
            xb_add(&bar[XB_XGEN(b.x)], 1u);
            asm volatile("s_waitcnt vmcnt(0)" ::: "memory");
        } else {
            XB_SPIN(xb_ld(&bar[XB_XGEN(b.x)]) == gen, bar);
            __builtin_amdgcn_fence(__ATOMIC_ACQUIRE, "agent");
            asm volatile("s_waitcnt vmcnt(0)" ::: "memory");
        }
    }
    __syncthreads();
}

#ifndef TIMING_A
#define TIMING_A -1
#endif
#ifndef TIMING_B
#define TIMING_B -1
#endif
#ifndef PHASE_MASK
#define PHASE_MASK 0xFFFFF
#endif
#define PM(i) ((PHASE_MASK >> (i)) & 1)
#ifndef REPEAT_MASK
#define REPEAT_MASK 0
#endif
#define RP(i) for (int rep_ = 0; rep_ < 1 + ((REPEAT_MASK >> (i)) & 1); ++rep_)
constexpr int PH_PER_LAYER = 9, NPHASES = 1 + DEPTH * PH_PER_LAYER + 1;
__global__ void __launch_bounds__(NTHREADS, 2) mk_fwd(Args args) {
    extern __shared__ __attribute__((aligned(16))) unsigned char lds[];
    cg::grid_group grid = cg::this_grid();
    const __attribute__((address_space(4))) Args* ap = (const __attribute__((address_space(4))) Args*)__builtin_amdgcn_kernarg_segment_ptr();
    const int lo = ap->lo, hi = ap->hi;
    LAS unsigned char* ldsl = (LAS unsigned char*)lds;
    volatile LAS unsigned* xbst = (volatile LAS unsigned*)(ldsl + LDS_BYTES - 16);
    if (threadIdx.x < 4) xbst[threadIdx.x] = 0u;
    __syncthreads();
    (void)xcd_barrier_post((unsigned*)(ap->p.ws + WS_BAR), xbst);
    if (TIMING_A >= 0 && blockIdx.x == 0 && threadIdx.x == 0) ((unsigned long long*)(ap->p.ws + WS_TS))[lo] = __builtin_amdgcn_s_memrealtime();
    for (int ph = lo; ph < hi; ++ph) {
        CP p = launder(&ap->p);
        int bid = blockIdx.x, nb = gridDim.x; asm volatile("" : "+s"(bid), "+s"(nb));
        if (ph == 0) { if (PM(0)) RP(0) phase_wprep(p, lds, 0, 912, bid, nb); if (PM(1)) RP(1) phase_adaln(p, lds, bid, nb); }
        else if (ph == NPHASES - 1) { if (PM(12)) phase_final(p, lds, bid, nb); }
        else {
            const int l = (ph - 1) / PH_PER_LAYER, s = (ph - 1) % PH_PER_LAYER;
            if (s == 0) { if (PM(2)) RP(2) { if (rep_ == 0 || l == 0) phase_r1(p, l, lds, bid, nb); } }
            else if (s == 1) { if (PM(3)) RP(3) {
                pg8::DenseSched S; S.init(p->ws + WS_HX, (const bf16_t*)(p->ws + WS_WTIN) + (size_t)l * DIN * 1024, R, NPROJ, 1024, 1024, 1024, nb, bid);
                EpiProj E{(bf16_t*)(p->ws + WS_PROJ)};
                pg8::gemm_phase<EpiProj, pg8::DenseSched, false>(ldsl, 1024, 1024, 1024, S, E);
                {
                    const int extra = S.nwg % nb; const int L1 = WPREP_ITEMS_PER_LAYER;
                    const int a0 = l == 0 ? 912 : L1 + 656, a1 = l == 0 ? 2960 : L1 + 2960;
                    if (l <= 1 && DEPTH == 2) { if (extra > 0 && bid >= extra) phase_wprep(p, lds, a0, a1, bid - extra, nb - extra); else if (extra == 0) phase_wprep(p, lds, a0, a1, bid, nb); } }
            } }
            else if (s == 2) { if (PM(4)) RP(4) phase_c1(p, l, lds, bid, nb); if (PM(5)) RP(5) phase_s1(p, l, lds, bid, nb); }
            else if (s == 3) { if (PM(6)) RP(6) phase_s2(p, bid, nb); }
            else if (s == 4) { if (PM(7)) RP(7) phase_s3(p, l, lds, bid, nb);
                if (PM(4)) {
                    const int cpb = NCHUNK - ((l == DEPTH - 1) ? 2 : 0), nunits = NB * cpb * 2, tail = (nunits % nb) * 4;
                    if (tail > 0 && tail < nb) { if (bid >= tail) phase_c1_ln(p, l, bid - tail, nb - tail); } else phase_c1_ln(p, l, bid, nb); } }
            else if (s == 5) { if (PM(8)) RP(8) { if (rep_ == 0 || l == 0) {
                pg8::DenseSched S; S.init(p->ws + WS_HX, (const bf16_t*)(p->ws + WS_WTOUT) + (size_t)l * 1024 * 1024, R, 1024, 1024, 1024, 1024, nb, bid, l == DEPTH - 1);
                EpiResid<0> E{p->ctx, p->x, (bf16_t*)(p->ws + WS_H), (const float*)(p->ws + WS_MOD) + (size_t)l * 3 * 6144, (const float*)(p->ws + WS_SSQ)};
                pg8::gemm_phase<EpiResid<0>, pg8::DenseSched, false>(ldsl, 1024, 1024, 1024, S, E);
                if (l == 0 && DEPTH == 2 && rep_ == 0) { const int extra = S.nwg % nb; const int L1 = WPREP_ITEMS_PER_LAYER;
                    if (extra > 0 && bid >= extra) phase_wprep(p, lds, 2960, 3984, bid - extra, nb - extra, L1, L1 + 656, L1 + 2960, L1 + 3984);
                    else if (extra == 0) phase_wprep(p, lds, 2960, 3984, bid, nb, L1, L1 + 656, L1 + 2960, L1 + 3984); }
            } } }
            else if (s == 6) { if (PM(9)) phase_r2(p, l, lds, bid, nb); }
            else if (s == 7) { if (PM(10)) {
                LAS int* tab = (LAS int*)(ldsl + MISC_OFF); moe_table(p, l, tab);
                unsigned* ready = (unsigned*)(p->ws + WS_M1CNT) + l * 192;
                { MoeSched S{tab, (const int*)(p->ws + WS_LIST), (const char*)(p->ws + WS_HX), (const char*)(p->ws + WS_WTGU), 0, l, nb, bid, ready, 0};
                  EpiUp E{(bf16_t*)(p->ws + WS_HID), (const float*)(p->ws + WS_CWLA), (const float*)(p->ws + WS_CWLB), ready};
                  pg8::gemm_phase<EpiUp, MoeSched, true>(ldsl, 1024, 1024, 1024, S, E); }
                { const int total = __builtin_amdgcn_readfirstlane(tab[24]) * 4; const int extra = __builtin_amdgcn_readfirstlane(total % nb);
                  MoeSched S{tab, (const int*)(p->ws + WS_LIST), (const char*)(p->ws + WS_HID), (const char*)(p->ws + WS_WTD), 1, l, nb, bid, ready, (total >= nb && total - extra >= nb) ? extra : 0};
                  EpiDown E{(bf16_t*)(p->ws + WS_H), (const int*)(p->ws + WS_LIST), (const float*)(p->ws + WS_MOD) + (size_t)l * 3 * 6144 + 5 * 1024};
                  pg8::gemm_phase<EpiDown, MoeSched, false>(ldsl, 512, 256, 512, S, E); }
            } }
            else { }
        }
        if (ph + 1 < hi && !(ph > 0 && ph < NPHASES - 1 && (ph - 1) % PH_PER_LAYER == 7)) { if (hi < 0) grid.sync();   else { XcdBarrier xb; xb.bar = (unsigned*)(launder(&ap->p)->ws + WS_BAR); xb.x = xb_xcc_id(); xb.st = (volatile LAS unsigned*)(ldsl + LDS_BYTES - 16); xcd_barrier(xb); }
            if (TIMING_A >= 0 && blockIdx.x == 0 && threadIdx.x == 0) ((unsigned long long*)(launder(&ap->p)->ws + WS_TS))[ph + 1] = __builtin_amdgcn_s_memrealtime(); }
    }
#if TIMING_A >= 0
    {
        XcdBarrier xb; xb.bar = (unsigned*)(launder(&ap->p)->ws + WS_BAR); xb.x = xb_xcc_id(); xb.st = (volatile LAS unsigned*)(ldsl + LDS_BYTES - 16); xcd_barrier(xb);
        if (blockIdx.x == 0 && threadIdx.x == 0) ((unsigned long long*)(launder(&ap->p)->ws + WS_TS))[hi] = __builtin_amdgcn_s_memrealtime();
        xcd_barrier(xb);
        const unsigned long long* ts = (const unsigned long long*)(launder(&ap->p)->ws + WS_TS);
        const float ta = (float)(ts[TIMING_A + 1] - ts[TIMING_A]) * 0.01f, tb = (float)(ts[TIMING_B + 1] - ts[TIMING_B]) * 0.01f;
        float* o = launder(&ap->p)->out; const float sc = 1.f + ta * 0.001f;
        for (size_t i = (size_t)blockIdx.x * NTHREADS + threadIdx.x; i < (size_t)NB * SEQ * D; i += (size_t)gridDim.x * NTHREADS) o[i] = o[i] * sc + (i == 0 ? tb * 0.1f : 0.f);
    }
#endif
}

extern "C" void kernel_launch(void* const* d_in, const int* in_sizes, int n_in, void* d_out, int out_size, void* d_ws, size_t ws_size, hipStream_t stream) {
    static int grid = 0;
    if (grid == 0) {
        if (n_in != 28 || ws_size < WS_END) { fprintf(stderr, "kernel_launch: unexpected n_in %d or ws_size %zu (< %zu)\n", n_in, ws_size, (size_t)WS_END); grid = -1; return; }
        int dev = 0, cus = 0, per_cu = 0;
        hipGetDevice(&dev); hipDeviceGetAttribute(&cus, hipDeviceAttributeMultiprocessorCount, dev);
        if (hipFuncSetAttribute((const void*)mk_fwd, hipFuncAttributeMaxDynamicSharedMemorySize, LDS_BYTES) != hipSuccess) { fprintf(stderr, "kernel_launch: hipFuncSetAttribute failed\n"); grid = -1; return; }
        if (hipOccupancyMaxActiveBlocksPerMultiprocessor(&per_cu, (const void*)mk_fwd, NTHREADS, LDS_BYTES) != hipSuccess || per_cu < 1) { fprintf(stderr, "kernel_launch: occupancy query says %d\n", per_cu); (void)hipGetLastError(); grid = -1; return; }
        grid = cus;
    }
    if (grid < 0) return;
    (void)hipMemsetAsync((char*)d_ws + WS_CTL, 0, WS_CTL_BYTES, stream);
    Args a{};
    const float** pp = (const float**)&a.p;
    for (int i = 0; i < 28; ++i) pp[i] = (const float*)d_in[i];
    a.p.out = (float*)d_out; a.p.ws = (unsigned char*)d_ws;
#if PER_PHASE_LAUNCH
    for (int ph = 0; ph < NPHASES; ++ph) {
        a.lo = ph; a.hi = ph + 1; void* kargs[] = {&a};
        hipError_t e = hipLaunchCooperativeKernel((const void*)mk_fwd, dim3(grid), dim3(NTHREADS), kargs, LDS_BYTES, stream);
        if (e != hipSuccess) { fprintf(stderr, "kernel_launch: launch of phase %d failed: %s\n", ph, hipGetErrorString(e)); break; }
    }
#else
    a.lo = 0; a.hi = NPHASES; void* kargs[] = {&a};
    hipError_t e = hipLaunchCooperativeKernel((const void*)mk_fwd, dim3(grid), dim3(NTHREADS), kargs, LDS_BYTES, stream);
    if (e != hipSuccess) fprintf(stderr, "kernel_launch: cooperative launch failed: %s (grid %d)\n", hipGetErrorString(e), grid);
#endif
}
```

```cpp
#include <hip/hip_runtime.h>
#include <hip/hip_cooperative_groups.h>
#include <cstdio>
namespace cg = cooperative_groups;

#ifndef PER_PHASE_LAUNCH
#define PER_PHASE_LAUNCH 0
#endif

#ifndef S3REP
#define S3REP 0
#endif
#define S3R(i) for (int r3_ = 0; r3_ < 1 + ((S3REP >> (i)) & 1); ++r3_)
#define LAS __attribute__((address_space(3)))
typedef unsigned short bf16_t;
typedef short bf16x8 __attribute__((ext_vector_type(8)));
typedef float f32x4 __attribute__((ext_vector_type(4)));
typedef unsigned u32x4 __attribute__((ext_vector_type(4)));
typedef unsigned u32x2 __attribute__((ext_vector_type(2)));

constexpr int D = 1024, NB = 2, SEQ = 16384, CTXL = 256, SEG = SEQ + CTXL, R = NB * SEG, DEPTH = 2;
constexpr int NPROJ = 2560, DIN = 2576;
constexpr int NTHREADS = 512;
constexpr int LDS_BYTES = 163840;
constexpr int MISC_OFF = 131072;
constexpr int NCLS = 24;

constexpr size_t al256(size_t x) { return (x + 255) & ~size_t(255); }
constexpr size_t WS_CTL = 0;
constexpr size_t WS_M1CNT = 20480;
constexpr size_t WS_TS = 2048;
constexpr size_t WS_BAR = 4096;
constexpr size_t WS_CTL_BYTES = 32768;
constexpr size_t WS_MOD = WS_CTL_BYTES;
constexpr size_t WS_WTIN = WS_MOD + al256((size_t)2 * 3 * 6144 * 4);
constexpr size_t WS_WTOUT = WS_WTIN + al256((size_t)2 * DIN * 1024 * 2);
constexpr size_t WS_WTGU = WS_WTOUT + al256((size_t)2 * 1024 * 1024 * 2);
constexpr size_t WS_WTD = WS_WTGU + al256((size_t)2 * 16 * 512 * 1024 * 2);
constexpr size_t WS_H = WS_WTD + al256((size_t)2 * 16 * 1024 * 256 * 2);
constexpr size_t WS_HX = WS_H + al256((size_t)R * 1024 * 2);
constexpr size_t WS_PROJ = WS_HX + al256((size_t)R * 1024 * 2);
constexpr size_t WS_DT = WS_PROJ + al256((size_t)R * NPROJ * 2);
constexpr size_t WS_POS = WS_DT + al256((size_t)R * 16 * 4);
constexpr size_t WS_LIST = WS_POS + al256((size_t)2 * R * 4);
constexpr size_t WS_CWLA = WS_LIST + al256((size_t)NCLS * R * 4);
constexpr size_t WS_CWLB = WS_CWLA + al256((size_t)NCLS * R * 4);
constexpr size_t WS_BIG = WS_CWLB + al256((size_t)NCLS * R * 4);
constexpr size_t WS_Y = WS_PROJ;
constexpr size_t WS_S = WS_BIG;
constexpr size_t WS_HP = WS_S + al256((size_t)2 * 2 * 130 * 8 * 8192 * 2);
constexpr size_t WS_DEC = WS_HP + al256((size_t)2 * 2 * 130 * 8 * 8192 * 2);
constexpr size_t WS_SSQ = WS_DEC + al256((size_t)2 * 2 * 130 * 8 * 4);
constexpr size_t WS_HID = WS_S;
constexpr size_t WS_END = WS_SSQ + al256((size_t)R * 8 * 4);
static_assert((size_t)(R + NCLS * 256) * 512 * 2 <= (size_t)2 * 2 * 130 * 8 * 8192 * 2, "hid alias");
static_assert(WS_END <= (size_t)512 * 1024 * 1024, "workspace");

struct Params {
    const float *x, *c, *ctx, *c_ctx, *w_ada, *b_ada, *g_mix, *g_ffn, *w_in, *conv_w, *conv_b, *conv_ln_g, *conv_ln_b, *ssd_conv_w, *ssd_conv_b,
        *dt_bias, *a_log, *d_skip, *ssd_norm_g, *w_out, *w_rg, *b_rg, *w_re, *b_re, *w_gate, *w_up, *w_down, *g_final;
    float* out; unsigned char* ws;
};
struct Args { Params p; int lo, hi; };
typedef const __attribute__((address_space(4))) Params* CP;
__device__ __forceinline__ CP launder(CP p) { asm volatile("" : "+s"(p)); return p; }
__device__ __forceinline__ int launder_tid() { int t = threadIdx.x; asm volatile("" : "+v"(t)); return t; }

__device__ __forceinline__ unsigned cvt_pk_bf16(float lo, float hi) { unsigned r; asm("v_cvt_pk_bf16_f32 %0, %1, %2" : "=v"(r) : "v"(lo), "v"(hi)); return r; }
__device__ __forceinline__ float bf2f(unsigned b) { return __uint_as_float(b << 16); }
__device__ __forceinline__ float bflo(unsigned w) { return __uint_as_float(w << 16); }
__device__ __forceinline__ float bfhi(unsigned w) { return __uint_as_float(w & 0xffff0000u); }
__device__ __forceinline__ bf16_t f2bf(float f) { return (bf16_t)(cvt_pk_bf16(f, 0.f) & 0xffffu); }
#define DPP_ADD(v, ctrl, rm) ((v) + __builtin_bit_cast(float, __builtin_amdgcn_update_dpp(0, __builtin_bit_cast(int, (v)), (ctrl), (rm), 0xF, true)))
__device__ __forceinline__ float row_sum16(float v) {
    v = DPP_ADD(v, 0xB1, 0xF);
    v = DPP_ADD(v, 0x4E, 0xF);
    v = DPP_ADD(v, 0x141, 0xF);
    v = DPP_ADD(v, 0x140, 0xF);
    return v;
}
__device__ __forceinline__ float half_sum32(float v) { v = row_sum16(v); v = DPP_ADD(v, 0x142, 0xA); return v; }
__device__ __forceinline__ float wave_sum(float v) {
    v = half_sum32(v); v = DPP_ADD(v, 0x143, 0xC);
    return __builtin_bit_cast(float, __builtin_amdgcn_readlane(__builtin_bit_cast(int, v), 63));
}
__device__ __forceinline__ float sigmoidf_(float x) { return __builtin_amdgcn_rcpf(1.f + __builtin_amdgcn_exp2f(x * -1.44269504089f)); }
__device__ __forceinline__ float siluf_(float x) { return x * __builtin_amdgcn_rcpf(1.f + __builtin_amdgcn_exp2f(x * -1.44269504089f)); }
__device__ __forceinline__ float softplusf_(float x) { return fmaxf(x, 0.f) + __logf(1.f + __expf(-fabsf(x))); }

__device__ __forceinline__ int row_b(int r) { return r >= SEG ? 1 : 0; }
__device__ __forceinline__ int row_i(int r) { return r >= SEG ? r - SEG : r; }
__device__ __forceinline__ int row_v(int r) { const int i = row_i(r); return i < CTXL ? 2 : row_b(r); }
__device__ __forceinline__ const float* xin_ptr(const float* ctx, const float* x, int r) {
    const int b = row_b(r), i = row_i(r);
    return i < CTXL ? ctx + (size_t)(b * CTXL + i) * D : x + (size_t)(b * SEQ + i - CTXL) * D;
}
struct RowRaw { f32x4 f[4]; u32x2 h[4]; };
__device__ __forceinline__ void row_load(CP p, int l, int r, int lane, RowRaw& rr) {
    if (l == 0) { const f32x4* hr = (const f32x4*)xin_ptr(p->ctx, p->x, r);
#pragma unroll
        for (int j = 0; j < 4; ++j) rr.f[j] = hr[lane + 64 * j]; }
    else { const u32x2* hr = (const u32x2*)((const bf16_t*)(p->ws + WS_H) + (size_t)r * D);
#pragma unroll
        for (int j = 0; j < 4; ++j) rr.h[j] = hr[lane + 64 * j]; }
}
__device__ __forceinline__ void row_cvt(int l, const RowRaw& rr, f32x4 (&xv)[4]) {
#pragma unroll
    for (int j = 0; j < 4; ++j) xv[j] = l == 0 ? rr.f[j] : (f32x4){bflo(rr.h[j].x), bfhi(rr.h[j].x), bflo(rr.h[j].y), bfhi(rr.h[j].y)};
}
namespace pg8 {
constexpr int BM = 256, BK = 64, HALF = 128, HTB = HALF * BK * 2, STAGE_BYTES = 8 * HTB, NXCD = 8, WGM = 8;
__device__ __forceinline__ int lds_byte(int r, int c) { const int st = (r >> 4) * 2 + (c >> 5), rr = r & 15, cc = c & 31, ob = rr * 64 + cc * 2; return st * 1024 + (ob ^ (((ob >> 9) & 1) << 5)); }
__device__ __forceinline__ void stage_rc(int b, int& Rr, int& Cc) { const int st = b / 1024, sb = b % 1024, swz = sb ^ (((sb >> 9) & 1) << 5); Rr = (st >> 1) * 16 + swz / 64; Cc = (st & 1) * 32 + (swz % 64) / 2; }
__device__ __forceinline__ int perm32(int rho) { const int n = rho >> 4, i = rho & 15; return 8 * (i >> 2) + 4 * n + (i & 3); }

struct Unit {
    const char* a0;
    const char* b0;
    const char* b1;
    int i0, i1, i2, i3, i4, pad;
};

template <class Epi, class Sched, bool GATHER>
__device__ __forceinline__ void gemm_phase(LAS unsigned char* lds, const int lda, const int ldb, const int K, const Sched& S, const Epi& E) {
    const int tid = launder_tid(); const int wid = __builtin_amdgcn_readfirstlane(tid >> 6), lane = tid & 63, wr = wid >> 2, wc = wid & 3, fr = lane & 15, fq = lane >> 4;
    const int nt = K / BK, ks = nt >> 1;
    int Rr[2], Cc[2];
    unsigned voffB[2];
#pragma unroll
    for (int i = 0; i < 2; ++i) { stage_rc(tid * 16 + i * 8192, Rr[i], Cc[i]); const int Rb = Epi::PERM ? ((Rr[i] & ~31) + perm32(Rr[i] & 31)) : Rr[i];
        voffB[i] = (unsigned)(Rb * ldb + Cc[i]) * 2u; }
    const size_t kstep = (size_t)(BK * 2);
    const size_t hstepB = (size_t)HALF * ldb * 2;
    const unsigned ldsw = (unsigned)wid * 1024u;
    const unsigned ldsbase = (unsigned)(unsigned long)lds;
    const int aoff = lds_byte(wr * 64 + fr, fq * 8), boff = lds_byte(wc * 32 + fr, fq * 8);
#define PG8_SA(b, h) (((b) * 2 + (h)) * HTB)
#define PG8_SB(b, h) ((4 + (b) * 2 + (h)) * HTB)
#define PG8_STAGE2(bufoff, gbase, v0, v1) do { unsigned keep_; \
        asm volatile("s_mov_b32 %0, m0\n\ts_mov_b32 m0, %1\n\ts_nop 4\n\tglobal_load_lds_dwordx4 %2, %4\n\ts_add_u32 m0, m0, 0x2000\n\ts_nop 0\n\tglobal_load_lds_dwordx4 %3, %4\n\ts_mov_b32 m0, %0" \
            : "=&s"(keep_) : "s"(ldsbase + (unsigned)(bufoff) + ldsw), "v"(v0), "v"(v1), "s"(gbase) : "memory", "scc"); } while (0)
#define PG8_LDA(dst, b, h) do { _Pragma("unroll") for (int m = 0; m < 4; ++m) _Pragma("unroll") for (int k = 0; k < 2; ++k) dst[m][k] = *(const LAS bf16x8*)(lds + PG8_SA(b, h) + aoff + m * 2048 + k * 1024); } while (0)
#define PG8_LDB(dst, b, h) do { _Pragma("unroll") for (int n = 0; n < 2; ++n) _Pragma("unroll") for (int k = 0; k < 2; ++k) dst[n][k] = *(const LAS bf16x8*)(lds + PG8_SB(b, h) + boff + n * 2048 + k * 1024); } while (0)
#define PG8_MMA(ai, bj, At, Bt) do { __builtin_amdgcn_s_setprio(1); _Pragma("unroll") for (int m = 0; m < 4; ++m) _Pragma("unroll") for (int n = 0; n < 2; ++n) _Pragma("unroll") for (int k = 0; k < 2; ++k) \
        acc[ai][bj][m][n] = __builtin_amdgcn_mfma_f32_16x16x32_bf16(Bt[n][k], At[m][k], acc[ai][bj][m][n], 0, 0, 0); __builtin_amdgcn_s_setprio(0); } while (0)
#define PG8_WAIT_V(n) asm volatile("s_waitcnt vmcnt(" #n ")" ::: "memory")
#define PG8_WAIT_L(n) asm volatile("s_waitcnt lgkmcnt(" #n ")" ::: "memory")
#define PG8_BAR __builtin_amdgcn_s_barrier()
#define PG8_SCHED __builtin_amdgcn_sched_barrier(0)
#define PG8_BP(u, tt) ((tt) < ks ? (u).b0 + (size_t)(tt) * kstep : (u).b1 + (size_t)((tt) - ks) * kstep)
    Unit cur, nxt; int ui = 0;
    if (!S.get(0, cur)) return;
    S.a_ready(cur);
    unsigned c00, c01, c10, c11, n00, n01, n10, n11;
    if (GATHER) {
        c00 = (unsigned)(S.arow(cur, Rr[0]) * lda + Cc[0]) * 2u; c01 = (unsigned)(S.arow(cur, Rr[1]) * lda + Cc[1]) * 2u;
        c10 = (unsigned)(S.arow(cur, HALF + Rr[0]) * lda + Cc[0]) * 2u; c11 = (unsigned)(S.arow(cur, HALF + Rr[1]) * lda + Cc[1]) * 2u;
    } else {
        c00 = (unsigned)(Rr[0] * lda + Cc[0]) * 2u; c01 = (unsigned)(Rr[1] * lda + Cc[1]) * 2u;
        c10 = (unsigned)((HALF + Rr[0]) * lda + Cc[0]) * 2u; c11 = (unsigned)((HALF + Rr[1]) * lda + Cc[1]) * 2u;
    }
    n00 = c00; n01 = c01; n10 = c10; n11 = c11;
    f32x4 acc[2][2][4][2];
    float zr; asm volatile("v_mov_b32 %0, 0" : "=v"(zr));
#pragma unroll
    for (int a = 0; a < 2; ++a)
#pragma unroll
        for (int b = 0; b < 2; ++b)
#pragma unroll
            for (int m = 0; m < 4; ++m)
#pragma unroll
                for (int n = 0; n < 2; ++n) acc[a][b][m][n] = (f32x4){zr, zr, zr, zr};
    bf16x8 At[4][2], B0[2][2], B1[2][2];
    const char* cA = cur.a0;
    {
        const char* pb0 = PG8_BP(cur, 0); const char* pb1 = PG8_BP(cur, 1);
        PG8_STAGE2(PG8_SB(0, 0), pb0, voffB[0], voffB[1]); PG8_STAGE2(PG8_SA(0, 0), cA, c00, c01);
        PG8_STAGE2(PG8_SB(0, 1), pb0 + hstepB, voffB[0], voffB[1]); PG8_STAGE2(PG8_SA(0, 1), cA, c10, c11);
        if (wr == 1) PG8_BAR;
        PG8_WAIT_V(4); PG8_BAR;
        PG8_STAGE2(PG8_SB(1, 0), pb1, voffB[0], voffB[1]); PG8_STAGE2(PG8_SA(1, 0), cA + kstep, c00, c01);
        PG8_STAGE2(PG8_SB(1, 1), pb1 + hstepB, voffB[0], voffB[1]);
        PG8_WAIT_V(6); PG8_BAR;
    }
    for (;;) {
        const bool has_next = S.get(ui + 1, nxt);
        if (!has_next) nxt = cur;
        LAS int* tokb = (LAS int*)(lds + MISC_OFF + 1024) + ((ui + 1) & 1) * 256;
        if (GATHER) {
            n00 = c00; n01 = c01; n10 = c10; n11 = c11;
            if (has_next && wid == 0) {
                const char* src = (const char*)S.rows_ptr(nxt); unsigned keep_;
                asm volatile("s_mov_b32 %0, m0\n\ts_mov_b32 m0, %1\n\ts_nop 4\n\tglobal_load_lds_dwordx4 %2, %3\n\ts_mov_b32 m0, %0"
                    : "=&s"(keep_) : "s"((unsigned)(unsigned long)tokb), "v"((unsigned)lane * 16u), "s"(src) : "memory");
            }
        }
        const char* nA = nxt.a0;
#pragma unroll 1
        for (int t = 0; t < nt; t += 2) {
            const bool last = (t == nt - 2);
            if (last && has_next) S.a_ready(nxt);
            const char* a1 = cA + (size_t)(t + 1) * kstep;
            const char* a2 = last ? nA : cA + (size_t)(t + 2) * kstep;
            const char* a3 = a2 + kstep;
            const char* b2 = last ? PG8_BP(nxt, 0) : PG8_BP(cur, t + 2);
            const char* b3 = last ? PG8_BP(nxt, 1) : PG8_BP(cur, t + 3);
            if (GATHER) { if (last && has_next) {
                const int lim = S.rows_valid(nxt) - 1;
                const int i0 = Rr[0] < lim ? Rr[0] : lim, i1 = Rr[1] < lim ? Rr[1] : lim, i2 = (HALF + Rr[0]) < lim ? (HALF + Rr[0]) : lim, i3 = (HALF + Rr[1]) < lim ? (HALF + Rr[1]) : lim;
                n00 = (unsigned)(tokb[i0] * lda + Cc[0]) * 2u; n01 = (unsigned)(tokb[i1] * lda + Cc[1]) * 2u;
                n10 = (unsigned)(tokb[i2] * lda + Cc[0]) * 2u; n11 = (unsigned)(tokb[i3] * lda + Cc[1]) * 2u; } }
            const unsigned s00 = last ? n00 : c00, s01 = last ? n01 : c01, s10 = last ? n10 : c10, s11 = last ? n11 : c11;
            if constexpr (Epi::MIDSCALE) { if (t == ks) E.midscale(acc, cur, wr, wc, fr, fq); }
            PG8_LDB(B0, 0, 0); PG8_SCHED; PG8_LDA(At, 0, 0); PG8_STAGE2(PG8_SA(1, 1), a1, c10, c11);
            PG8_WAIT_L(8); PG8_BAR; PG8_WAIT_L(0); PG8_MMA(0, 0, At, B0); PG8_BAR; PG8_SCHED;
            PG8_LDB(B1, 0, 1); PG8_STAGE2(PG8_SB(0, 0), b2, voffB[0], voffB[1]);
            PG8_BAR; PG8_WAIT_L(0); PG8_MMA(0, 1, At, B1); PG8_BAR;
            PG8_LDA(At, 0, 1); PG8_STAGE2(PG8_SA(0, 0), a2, s00, s01);
            PG8_BAR; PG8_WAIT_L(0); PG8_MMA(1, 0, At, B0); PG8_BAR; PG8_SCHED;
            PG8_STAGE2(PG8_SB(0, 1), b2 + hstepB, voffB[0], voffB[1]);
            PG8_WAIT_V(6); PG8_BAR; PG8_MMA(1, 1, At, B1); PG8_BAR;
            PG8_LDB(B0, 1, 0); PG8_SCHED; PG8_LDA(At, 1, 0); PG8_STAGE2(PG8_SA(0, 1), a2, s10, s11);
            PG8_WAIT_L(8); PG8_BAR; PG8_WAIT_L(0); PG8_MMA(0, 0, At, B0); PG8_BAR; PG8_SCHED;
            PG8_LDB(B1, 1, 1); PG8_STAGE2(PG8_SB(1, 0), b3, voffB[0], voffB[1]);
            PG8_BAR; PG8_WAIT_L(0); PG8_MMA(0, 1, At, B1); PG8_BAR;
            PG8_LDA(At, 1, 1); PG8_STAGE2(PG8_SA(1, 0), a3, s00, s01);
            PG8_BAR; PG8_WAIT_L(0); PG8_MMA(1, 0, At, B0); PG8_BAR; PG8_SCHED;
            PG8_STAGE2(PG8_SB(1, 1), b3 + hstepB, voffB[0], voffB[1]);
            PG8_WAIT_V(6); PG8_BAR; PG8_MMA(1, 1, At, B1); PG8_BAR;
        }
        E(acc, cur, wr, wc, fr, fq);
        if (!has_next) break;
        asm volatile("v_mov_b32 %0, 0" : "=v"(zr));
#pragma unroll
        for (int a = 0; a < 2; ++a)
#pragma unroll
            for (int b = 0; b < 2; ++b)
#pragma unroll
                for (int m = 0; m < 4; ++m)
#pragma unroll
                    for (int n = 0; n < 2; ++n) acc[a][b][m][n] = (f32x4){zr, zr, zr, zr};
        cur = nxt; cA = nA; ++ui; c00 = n00; c01 = n01; c10 = n10; c11 = n11;
    }
    PG8_WAIT_V(0);
    if (wr == 0) PG8_BAR;
    PG8_BAR;
#undef PG8_SA
#undef PG8_SB
#undef PG8_STAGE2
#undef PG8_LDA
#undef PG8_LDB
#undef PG8_MMA
#undef PG8_WAIT_V
#undef PG8_WAIT_L
#undef PG8_BAR
#undef PG8_SCHED
#undef PG8_BP
}

struct DenseSched {
    const char* A; const char* Bt; int lda, ldb, K; int nM, nN, nwg, G, c, skipctx;
    __device__ __forceinline__ void init(const void* A_, const void* Bt_, int M, int N, int K_, int lda_, int ldb_, int G_, int c_, int skipctx_ = 0) {
        A = (const char*)A_; Bt = (const char*)Bt_; lda = lda_; ldb = ldb_; K = K_; nM = M / BM - 2 * skipctx_; nN = N / BM; nwg = nM * nN; G = G_; c = c_; skipctx = skipctx_; }
    __device__ __forceinline__ bool get(int i, Unit& u) const {
        const long L = (long)i * G + c; if (L >= nwg) return false;
        int wgid = (int)L; { const int q = nwg / NXCD, r = nwg % NXCD, xcd = wgid % NXCD, off = wgid / NXCD; wgid = (xcd < r ? xcd * (q + 1) : r * (q + 1) + (xcd - r) * q) + off; }
        const int nig = WGM * nN, gid = wgid / nig, fm = gid * WGM, gsz = (nM - fm) < WGM ? (nM - fm) : WGM;
        int pm = fm + ((wgid % nig) % gsz); const int pn = (wgid % nig) / gsz;
        if (skipctx) pm += 1 + (pm >= 64 ? 1 : 0);
        u.a0 = A + (size_t)pm * BM * lda * 2; u.b0 = Bt + (size_t)pn * BM * ldb * 2; u.b1 = u.b0 + (size_t)(K / BK / 2) * BK * 2;
        u.i0 = pm; u.i1 = pn; u.i2 = 0; u.i3 = 0; u.i4 = 0; u.pad = 0; return true;
    }
    __device__ __forceinline__ void a_ready(const Unit&) const {}
    __device__ __forceinline__ int arow(const Unit&, int rl) const { return rl; }
    __device__ __forceinline__ const int* rows_ptr(const Unit&) const { return nullptr; }
    __device__ __forceinline__ int rows_valid(const Unit&) const { return 256; }
};
}

struct EpiProj {
    static constexpr bool PERM = true, MIDSCALE = false;
    bf16_t* O;
    __device__ __forceinline__ void operator()(const f32x4 (&acc)[2][2][4][2], const pg8::Unit& u, int wr, int wc, int fr, int fq) const {
        const int pn = u.i1;
        const int row0 = u.i0 * 256 + wr * 64 + fr;
        if (pn < 4) {
            const int col0 = pn * 128 + wc * 32 + 8 * fq;
#pragma unroll
            for (int ai = 0; ai < 2; ++ai)
#pragma unroll
                for (int m = 0; m < 4; ++m) { const f32x4 u0 = acc[ai][0][m][0], u1 = acc[ai][0][m][1], g0 = acc[ai][1][m][0], g1 = acc[ai][1][m][1];
                    u32x4 w; w.x = cvt_pk_bf16(u0[0] * sigmoidf_(g0[0]), u0[1] * sigmoidf_(g0[1])); w.y = cvt_pk_bf16(u0[2] * sigmoidf_(g0[2]), u0[3] * sigmoidf_(g0[3]));
                    w.z = cvt_pk_bf16(u1[0] * sigmoidf_(g1[0]), u1[1] * sigmoidf_(g1[1])); w.w = cvt_pk_bf16(u1[2] * sigmoidf_(g1[2]), u1[3] * sigmoidf_(g1[3]));
                    *(u32x4*)(O + (size_t)(row0 + ai * 128 + m * 16) * NPROJ + col0) = w; }
        } else {
            const int col0 = pn * 256 + wc * 32 + 8 * fq; const bool sl = pn < 6;
#pragma unroll
            for (int ai = 0; ai < 2; ++ai)
#pragma unroll
                for (int m = 0; m < 4; ++m) { bf16_t* rowp = O + (size_t)(row0 + ai * 128 + m * 16) * NPROJ + col0;
#pragma unroll
                    for (int bj = 0; bj < 2; ++bj) { f32x4 v0 = acc[ai][bj][m][0], v1 = acc[ai][bj][m][1];
                        if (sl) {
#pragma unroll
                            for (int e = 0; e < 4; ++e) { v0[e] = siluf_(v0[e]); v1[e] = siluf_(v1[e]); } }
                        u32x4 w; w.x = cvt_pk_bf16(v0[0], v0[1]); w.y = cvt_pk_bf16(v0[2], v0[3]); w.z = cvt_pk_bf16(v1[0], v1[1]); w.w = cvt_pk_bf16(v1[2], v1[3]);
                        *(u32x4*)(rowp + bj * 128) = w; } }
        }
    }
};
template <int L0> struct EpiResid {
    static constexpr bool PERM = true, MIDSCALE = true;
    const float* inc; const float* inx; bf16_t* H; const float* modl; const float* ssq;
    __device__ __forceinline__ void midscale(f32x4 (&acc)[2][2][4][2], const pg8::Unit& u, int wr, int wc, int fr, int fq) const {
        typedef float f32x2 __attribute__((ext_vector_type(2)));
        const int r0 = u.i0 * 256 + wr * 64 + fr;
        f32x2 part[2][4];
#pragma unroll
        for (int ai = 0; ai < 2; ++ai)
#pragma unroll
            for (int m = 0; m < 4; ++m) part[ai][m] = *(const f32x2*)(ssq + (size_t)(r0 + ai * 128 + m * 16) * 8 + 2 * fq);
#pragma unroll
        for (int ai = 0; ai < 2; ++ai)
#pragma unroll
            for (int m = 0; m < 4; ++m) { float sq = part[ai][m][0] + part[ai][m][1];
                sq += __shfl_xor(sq, 16); sq += __shfl_xor(sq, 32);
                const float rs = rsqrtf(sq * (1.f / 512.f) + 1e-6f);
#pragma unroll
                for (int bj = 0; bj < 2; ++bj)
#pragma unroll
                    for (int n = 0; n < 2; ++n) acc[ai][bj][m][n] *= rs; }
    }
    __device__ __forceinline__ void operator()(const f32x4 (&acc)[2][2][4][2], const pg8::Unit& u, int wr, int wc, int fr, int fq) const {
        const int r0 = u.i0 * 256;
        const int v = row_v(r0);
        const float* gate = modl + (size_t)v * 6144 + 2 * 1024;
        const float* xin = xin_ptr(inc, inx, r0);
        const int rl0 = wr * 64 + fr, col0 = u.i1 * 256 + wc * 32 + 8 * fq;
        f32x4 gv[2][2];
#pragma unroll
        for (int bj = 0; bj < 2; ++bj)
#pragma unroll
            for (int n = 0; n < 2; ++n) gv[bj][n] = *(const f32x4*)(gate + col0 + bj * 128 + 4 * n);
#pragma unroll
        for (int ai = 0; ai < 2; ++ai) {
            u32x4 hr[4][2];
#pragma unroll
            for (int m = 0; m < 4; ++m)
#pragma unroll
                for (int bj = 0; bj < 2; ++bj) hr[m][bj] = *(const u32x4*)(H + (size_t)(r0 + rl0 + ai * 128 + m * 16) * D + col0 + bj * 128);
#pragma unroll
            for (int m = 0; m < 4; ++m)
#pragma unroll
                for (int bj = 0; bj < 2; ++bj) { const u32x4 hv = hr[m][bj]; const f32x4 a0 = acc[ai][bj][m][0], a1 = acc[ai][bj][m][1]; const f32x4 g0 = gv[bj][0], g1 = gv[bj][1];
                    u32x4 w;
                    w.x = cvt_pk_bf16(bflo(hv.x) + g0[0] * a0[0], bfhi(hv.x) + g0[1] * a0[1]); w.y = cvt_pk_bf16(bflo(hv.y) + g0[2] * a0[2], bfhi(hv.y) + g0[3] * a0[3]);
                    w.z = cvt_pk_bf16(bflo(hv.z) + g1[0] * a1[0], bfhi(hv.z) + g1[1] * a1[1]); w.w = cvt_pk_bf16(bflo(hv.w) + g1[2] * a1[2], bfhi(hv.w) + g1[3] * a1[3]);
                    *(u32x4*)(H + (size_t)(r0 + rl0 + ai * 128 + m * 16) * D + col0 + bj * 128) = w; }
            asm volatile("" ::: "memory"); }
    }
};

__device__ __forceinline__ const char* uniform_ptr(const char* q) {
    const unsigned long long v = (unsigned long long)q;
    const unsigned lo = __builtin_amdgcn_readfirstlane((unsigned)v), hi = __builtin_amdgcn_readfirstlane((unsigned)(v >> 32));
    return (const char*)(((unsigned long long)hi << 32) | lo);
}
struct MoeSched {
    const LAS int* tab;
    const int* list;
    const char* A; const char* W; int mode  , l, G, c;
    unsigned* ready;
    __device__ __forceinline__ void a_ready(const pg8::Unit& u) const {
        if (mode == 0) return;
        if (threadIdx.x < 64) {
            unsigned* w = ready + u.i4; unsigned spins = 0;
            while ((unsigned)__builtin_amdgcn_readfirstlane((int)__hip_atomic_load(w, __ATOMIC_RELAXED, __HIP_MEMORY_SCOPE_AGENT)) < 32u) {
                __builtin_amdgcn_s_sleep(2); if (++spins > (1u << 22)) break; }
            __builtin_amdgcn_fence(__ATOMIC_ACQUIRE, "agent");
            asm volatile("s_waitcnt vmcnt(0)" ::: "memory");
        }
        asm volatile("" ::: "memory"); __builtin_amdgcn_s_barrier(); asm volatile("" ::: "memory");
    }
    int late;
    __device__ __forceinline__ bool get(int i, pg8::Unit& u) const {
        const int total = __builtin_amdgcn_readfirstlane(tab[24]) * 4;
        int L;
        if (mode == 0 || late == 0) L = i * G + c;
        else if (c < late) { if (i > 0) return false; L = c; }
        else L = late + (c - late) + i * (G - late);
        if (L >= total) return false;
        const int tl = L >> 2, pn = L & 3;
        int cls = 0;
#pragma unroll 1
        for (int q = 1; q < NCLS; ++q) { const int tq = __builtin_amdgcn_readfirstlane(tab[q]); if (tq <= tl) cls = q; }
        const int j = tl - __builtin_amdgcn_readfirstlane(tab[cls]), cnt = __builtin_amdgcn_readfirstlane(tab[32 + cls]);
        const int g = cls / 6, pidx = cls - g * 6;
        const int ea = (pidx >= 3) + (pidx >= 5), eb = pidx < 3 ? pidx + 1 : (pidx < 5 ? pidx - 1 : 3);
        if (mode == 0) {
            const int e = 4 * g + (pn < 2 ? ea : eb);
            u.a0 = A;
            u.b0 = W + ((size_t)(l * 16 + e) * 512 + (size_t)(pn & 1) * 256) * 1024 * 2; u.b1 = u.b0 + (size_t)8 * 128;
        } else {
            u.a0 = A + (size_t)tl * 256 * 512 * 2;
            u.b0 = W + ((size_t)(l * 16 + 4 * g + ea) * 1024 + (size_t)pn * 256) * 256 * 2;
            u.b1 = W + ((size_t)(l * 16 + 4 * g + eb) * 1024 + (size_t)pn * 256) * 256 * 2;
        }
        u.a0 = uniform_ptr(u.a0); u.b0 = uniform_ptr(u.b0); u.b1 = uniform_ptr(u.b1);
        u.i0 = cls; u.i1 = j; u.i2 = pn; u.i3 = cnt; u.i4 = tl; u.pad = 0; return true;
    }
    __device__ __forceinline__ int arow(const pg8::Unit& u, int rl) const {
        int idx = u.i1 * 256 + rl; idx = idx < u.i3 ? idx : u.i3 - 1;
        return list[(size_t)u.i0 * R + idx];
    }
    __device__ __forceinline__ const int* rows_ptr(const pg8::Unit& u) const { return list + (size_t)u.i0 * R + u.i1 * 256; }
    __device__ __forceinline__ int rows_valid(const pg8::Unit& u) const { return u.i3 - u.i1 * 256; }
};
struct EpiUp {
    static constexpr bool PERM = true, MIDSCALE = false;
    bf16_t* hid; const float* cwla; const float* cwlb; unsigned* ready;
    __device__ __forceinline__ void operator()(const f32x4 (&acc)[2][2][4][2], const pg8::Unit& u, int wr, int wc, int fr, int fq) const {
        const int cls = u.i0, j = u.i1, pn = u.i2, cnt = u.i3, tl = u.i4;
        const float* cw = (pn < 2) ? cwla : cwlb;
        const int colbase = (pn >> 1) * 256 + (pn & 1) * 128 + wc * 32 + 8 * fq;
        float wrow[2][4];
#pragma unroll
        for (int ai = 0; ai < 2; ++ai)
#pragma unroll
            for (int m = 0; m < 4; ++m) { const int idx = j * 256 + ai * 128 + wr * 64 + m * 16 + fr; wrow[ai][m] = idx < cnt ? cw[(size_t)cls * R + idx] : 0.f; }
#pragma unroll
        for (int ai = 0; ai < 2; ++ai)
#pragma unroll
            for (int m = 0; m < 4; ++m) {
                const int rl = ai * 128 + wr * 64 + m * 16 + fr; const int idx = j * 256 + rl; const bool valid = idx < cnt;
                const float w = wrow[ai][m];
                const f32x4 g0 = acc[ai][0][m][0], g1 = acc[ai][0][m][1], u0 = acc[ai][1][m][0], u1 = acc[ai][1][m][1];
                float o[8];
#pragma unroll
                for (int e = 0; e < 4; ++e) { o[e] = w * siluf_(g0[e]) * u0[e]; o[4 + e] = w * siluf_(g1[e]) * u1[e]; }
                if (!valid) {
#pragma unroll
                    for (int e = 0; e < 8; ++e) o[e] = 0.f; }
                u32x4 pk; pk.x = cvt_pk_bf16(o[0], o[1]); pk.y = cvt_pk_bf16(o[2], o[3]); pk.z = cvt_pk_bf16(o[4], o[5]); pk.w = cvt_pk_bf16(o[6], o[7]);
                { bf16_t* dstp = hid + ((size_t)tl * 256 + rl) * 512 + colbase;
                  asm volatile("global_store_dwordx4 %0, %1, off sc1\n\ts_nop 1" :: "v"(dstp), "v"(pk) : "memory"); }
            }
        asm volatile("s_waitcnt vmcnt(0)" ::: "memory");
        if ((threadIdx.x & 63) == 0) __hip_atomic_fetch_add(ready + tl, 1u, __ATOMIC_RELAXED, __HIP_MEMORY_SCOPE_AGENT);
    }
};
struct EpiDown {
    static constexpr bool PERM = true, MIDSCALE = false;
    bf16_t* H; const int* list; const LAS float* gl;
    __device__ __forceinline__ void operator()(const f32x4 (&acc)[2][2][4][2], const pg8::Unit& u, int wr, int wc, int fr, int fq) const {
        const int cls = u.i0, j = u.i1, pn = u.i2, cnt = u.i3;
        const int col0 = pn * 256 + wc * 32 + 8 * fq;
        int tok[2][4];
#pragma unroll
        for (int ai = 0; ai < 2; ++ai)
#pragma unroll
            for (int m = 0; m < 4; ++m) { const int idx = j * 256 + ai * 128 + wr * 64 + m * 16 + fr; tok[ai][m] = idx < cnt ? list[(size_t)cls * R + idx] : -1; }
#pragma unroll
        for (int ai = 0; ai < 2; ++ai)
#pragma unroll
          for (int mp = 0; mp < 2; ++mp) {
            u32x4 hr[2][2];
#pragma unroll
            for (int mm = 0; mm < 2; ++mm) { const int t = tok[ai][2 * mp + mm]; const bf16_t* hp = H + (size_t)(t < 0 ? 0 : t) * D + col0;
#pragma unroll
                for (int bj = 0; bj < 2; ++bj) hr[mm][bj] = *(const u32x4*)(hp + bj * 128); }
#pragma unroll
            for (int mm = 0; mm < 2; ++mm) { const int m = 2 * mp + mm; const int t = tok[ai][m];
                if (t >= 0) { const LAS float* gp = gl + row_v(t) * 1024 + col0;
#pragma unroll
                    for (int bj = 0; bj < 2; ++bj) { const u32x4 hv = hr[mm][bj]; const f32x4 a0 = acc[ai][bj][m][0], a1 = acc[ai][bj][m][1];
                        const f32x4 g0 = *(const LAS f32x4*)(gp + bj * 128), g1 = *(const LAS f32x4*)(gp + bj * 128 + 4);
                        u32x4 w;
                        w.x = cvt_pk_bf16(bflo(hv.x) + g0[0] * a0[0], bfhi(hv.x) + g0[1] * a0[1]); w.y = cvt_pk_bf16(bflo(hv.y) + g0[2] * a0[2], bfhi(hv.y) + g0[3] * a0[3]);
                        w.z = cvt_pk_bf16(bflo(hv.z) + g1[0] * a1[0], bfhi(hv.z) + g1[1] * a1[1]); w.w = cvt_pk_bf16(bflo(hv.w) + g1[2] * a1[2], bfhi(hv.w) + g1[3] * a1[3]);
                        *(u32x4*)(H + (size_t)t * D + col0 + bj * 128) = w; } } }
            asm volatile("" ::: "memory"); }
    }
};

__device__ __forceinline__ void tr_tile(const float* src, int ldn, int k0, int n0, int nvalid, bf16_t* dst, int ldk, int drow0, LAS float* tile, int kd0 = -1, const float* kscale = nullptr) {
    const int tid = launder_tid();
    if (kd0 < 0) kd0 = k0;
    { const int n = tid & 63; const int kq = tid >> 6; float tv[8], ts[8];
#pragma unroll
      for (int it = 0; it < 8; ++it) { const int kk = kq + 8 * it; tv[it] = (n < nvalid) ? src[(size_t)(k0 + kk) * ldn + n0 + n] : 0.f; ts[it] = kscale ? kscale[kk] : 1.f; }
#pragma unroll
      for (int it = 0; it < 8; ++it) tile[(kq + 8 * it) * 65 + n] = tv[it] * ts[it]; }
    __syncthreads();
    { const int k8 = tid & 7, n = tid >> 3;
      if (n < nvalid) { const LAS float* s = tile + (k8 * 8) * 65 + n;
          u32x4 o; o.x = cvt_pk_bf16(s[0], s[65]); o.y = cvt_pk_bf16(s[2 * 65], s[3 * 65]); o.z = cvt_pk_bf16(s[4 * 65], s[5 * 65]); o.w = cvt_pk_bf16(s[6 * 65], s[7 * 65]);
          *(u32x4*)(dst + (size_t)(drow0 + n) * ldk + kd0 + k8 * 8) = o; } }
    __syncthreads();
}
constexpr int WPREP_ITEMS_PER_LAYER = 16 * 41 + 256 + 1024 + 1024 + 1024;
__device__ __forceinline__ void phase_wprep(CP p, unsigned char* lds, int it0, int it1, int bidx, int nblk, int b0 = 0, int b1 = 0, int c0 = 0, int c1 = 0) {
    LAS float* tile = (LAS float*)(LAS unsigned char*)lds;
    constexpr int I_IN = 16 * 41, I_OUT = 256, I_G = 1024, I_U = 1024, I_D = 1024, I_L = I_IN + I_OUT + I_G + I_U + I_D;
    const int na = it1 - it0, nbb = b1 - b0, ncc = c1 - c0;
    for (int vi = bidx; vi < na + nbb + ncc; vi += nblk) {
        const int it = vi < na ? it0 + vi : (vi < na + nbb ? b0 + (vi - na) : c0 + (vi - na - nbb));
        const int l = it / I_L; int r = it - l * I_L;
        if (r < I_IN) { const int kt = r / 41, ntl = r % 41; const int n0 = ntl * 64; const int nv = (DIN - n0) < 64 ? (DIN - n0) : 64;
            const int dr = n0 < 512 ? (n0 >> 7) * 256 + (n0 & 127) : (n0 < 1024 ? ((n0 - 512) >> 7) * 256 + 128 + ((n0 - 512) & 127) : n0);
            tr_tile(p->w_in + (size_t)l * 1024 * DIN, DIN, kt * 64, n0, nv, (bf16_t*)(p->ws + WS_WTIN) + (size_t)l * DIN * 1024, 1024, dr, tile); continue; }
        r -= I_IN;
        if (r < I_OUT) { const int kt = r >> 4, ntl = r & 15;
            tr_tile(p->w_out + (size_t)l * 1024 * 1024, 1024, kt * 64, ntl * 64, 64, (bf16_t*)(p->ws + WS_WTOUT) + (size_t)l * 1024 * 1024, 1024, ntl * 64, tile,
                    (kt * 64 + 512) & 1023, kt >= 8 ? p->ssd_norm_g + l * 512 + (kt * 64 - 512) : nullptr); continue; }
        r -= I_OUT;
        if (r < I_G + I_U) { const int up = r >= I_G; if (up) r -= I_G; const int e = r >> 6, q = r & 63, kt = q >> 2, ntl = q & 3; const int n0 = ntl * 64;
            const float* src = (up ? p->w_up : p->w_gate) + (size_t)(l * 16 + e) * 1024 * 256;
            tr_tile(src, 256, kt * 64, n0, 64, (bf16_t*)(p->ws + WS_WTGU) + (size_t)(l * 16 + e) * 512 * 1024, 1024, (n0 >> 7) * 256 + (n0 & 127) + (up ? 128 : 0), tile); continue; }
        r -= I_G + I_U;
        { const int e = r >> 6, q = r & 63, kt = q >> 4, ntl = q & 15;
          tr_tile(p->w_down + (size_t)(l * 16 + e) * 256 * 1024, 1024, kt * 64, ntl * 64, 64, (bf16_t*)(p->ws + WS_WTD) + (size_t)(l * 16 + e) * 1024 * 256, 256, ntl * 64, tile); }
    }
}
__device__ __forceinline__ void phase_adaln(CP p, unsigned char* lds, int bid, int nb) {
    LAS float* sc = (LAS float*)(LAS unsigned char*)lds;
    LAS float* red = sc + 3 * 1024;
    const int tid = launder_tid();
    for (int idx = tid; idx < 3 * 1024; idx += NTHREADS) { const int v = idx >> 10, k = idx & 1023; const float cv = (v < 2) ? p->c[v * 1024 + k] : p->c_ctx[k]; sc[idx] = siluf_(cv); }
    __syncthreads();
    float* mod = (float*)(p->ws + WS_MOD);
    for (int it = bid; it < 2 * 96; it += nb) {
        const int l = it / 96, n0 = (it % 96) * 64;
        const int c4 = tid & 15, kr = tid >> 4;
        f32x4 a0 = {0, 0, 0, 0}, a1 = {0, 0, 0, 0}, a2 = {0, 0, 0, 0};
        const float* w = p->w_ada + (size_t)l * 1024 * 6144 + n0 + c4 * 4;
#pragma unroll 4
        for (int k = kr; k < 1024; k += 32) { const f32x4 w4 = *(const f32x4*)(w + (size_t)k * 6144); a0 += sc[k] * w4; a1 += sc[1024 + k] * w4; a2 += sc[2048 + k] * w4; }
        *(LAS f32x4*)(red + (kr * 3 + 0) * 64 + c4 * 4) = a0; *(LAS f32x4*)(red + (kr * 3 + 1) * 64 + c4 * 4) = a1; *(LAS f32x4*)(red + (kr * 3 + 2) * 64 + c4 * 4) = a2;
        __syncthreads();
        if (tid < 192) { const int v = tid >> 6, cc = tid & 63; float s = 0.f;
            for (int q = 0; q < 32; ++q) s += red[(q * 3 + v) * 64 + cc];
            mod[((size_t)l * 3 + v) * 6144 + n0 + cc] = s + p->b_ada[l * 6144 + n0 + cc]; }
        __syncthreads();
    }
}
__device__ __forceinline__ void moe_table(CP p, int l, LAS int* tab) {
    const int* gcount = (const int*)(p->ws + WS_CTL) + l * 32;
    if (threadIdx.x == 0) { int acc = 0; for (int q = 0; q < NCLS; ++q) { const int cn = gcount[q]; tab[q] = acc; tab[32 + q] = cn; acc += (cn + 255) >> 8; } tab[24] = acc; }
    __syncthreads();
}
typedef _Float16 f16x8 __attribute__((ext_vector_type(8)));
typedef _Float16 f16x2 __attribute__((ext_vector_type(2)));
constexpr int ST_H16 = 2064;
__device__ __forceinline__ unsigned pack_f16(float a, float b) { f16x2 h; h[0] = (_Float16)a; h[1] = (_Float16)b; return __builtin_bit_cast(unsigned, h); }
__device__ __forceinline__ void phase_r1(CP p, int l, unsigned char* lds_, int bid, int nb) {
    LAS unsigned char* lds = (LAS unsigned char*)lds_;
    LAS unsigned char* Wh = lds;
    LAS unsigned char* Xh = Wh + 16 * ST_H16;
    LAS float* gm = (LAS float*)(Xh + 16 * ST_H16);
    LAS float* sh = gm + 3 * 1024;
    LAS float* part = sh + 3 * 1024;
    const int tid = launder_tid(); const int lane = tid & 63, wave = __builtin_amdgcn_readfirstlane(tid >> 6);
    const float* mod = (const float*)(p->ws + WS_MOD) + (size_t)l * 3 * 6144;
    const float* win = p->w_in + (size_t)l * 1024 * DIN;
#pragma unroll
    for (int hb = 0; hb < 2; ++hb) { float tmp[16];
#pragma unroll
        for (int it = 0; it < 16; ++it) { const int idx = tid + NTHREADS * (16 * hb + it); tmp[it] = win[(size_t)(idx >> 4) * DIN + NPROJ + (idx & 15)]; }
#pragma unroll
        for (int it = 0; it < 16; ++it) { const int idx = tid + NTHREADS * (16 * hb + it); *(LAS _Float16*)(Wh + (idx & 15) * ST_H16 + (idx >> 4) * 2) = (_Float16)tmp[it]; } }
    { float t0[6], t1[6], t2[6];
#pragma unroll
      for (int it = 0; it < 6; ++it) { const int idx = tid + NTHREADS * it; const int v = idx >> 10, k = idx & 1023; t0[it] = p->g_mix[l * 1024 + k]; t1[it] = mod[v * 6144 + 1024 + k]; t2[it] = mod[v * 6144 + k]; }
#pragma unroll
      for (int it = 0; it < 6; ++it) { const int idx = tid + NTHREADS * it; gm[idx] = t0[it] * (1.f + t1[it]); sh[idx] = t2[it]; } }
    __syncthreads();
    bf16_t* HX = (bf16_t*)(p->ws + WS_HX); float* DT = (float*)(p->ws + WS_DT);
    const int rpb = (R + nb - 1) / nb, r0 = bid * rpb, r1 = (r0 + rpb) < R ? (r0 + rpb) : R;
    RowRaw xn[2];
#pragma unroll
    for (int q = 0; q < 2; ++q) if (r0 + 2 * wave + q < r1) row_load(p, l, r0 + 2 * wave + q, lane, xn[q]);
#pragma unroll 1
    for (int t0r = r0; t0r < r1; t0r += 16) {
        f32x4 xv[2][4];
#pragma unroll
        for (int q = 0; q < 2; ++q) row_cvt(l, xn[q], xv[q]);
#pragma unroll
        for (int q = 0; q < 2; ++q) if (t0r + 16 + 2 * wave + q < r1) row_load(p, l, t0r + 16 + 2 * wave + q, lane, xn[q]);
#pragma unroll
        for (int q = 0; q < 2; ++q) { const int rr = t0r + 2 * wave + q; const bool ok = rr < r1; const int v = row_v(ok ? rr : r0);
            if (l == 0 && ok) { u32x2* hw = (u32x2*)((bf16_t*)(p->ws + WS_H) + (size_t)rr * D);
#pragma unroll
                for (int j = 0; j < 4; ++j) { u32x2 o; o.x = cvt_pk_bf16(xv[q][j][0], xv[q][j][1]); o.y = cvt_pk_bf16(xv[q][j][2], xv[q][j][3]); hw[lane + 64 * j] = o; } }
            float ss = 0.f;
#pragma unroll
            for (int j = 0; j < 4; ++j) ss += xv[q][j][0] * xv[q][j][0] + xv[q][j][1] * xv[q][j][1] + xv[q][j][2] * xv[q][j][2] + xv[q][j][3] * xv[q][j][3];
            ss = wave_sum(ss); const float rs = ok ? __builtin_amdgcn_rsqf(ss * (1.f / 1024.f) + 1e-6f) : 0.f;
#pragma unroll
            for (int j = 0; j < 4; ++j) { const int k = 4 * lane + 256 * j; const f32x4 g4 = *(const LAS f32x4*)(gm + v * 1024 + k), s4 = *(const LAS f32x4*)(sh + v * 1024 + k);
                f32x4 hv = xv[q][j] * rs * g4 + s4; if (!ok) hv = hv * 0.f;
                u32x2 o; o.x = cvt_pk_bf16(hv[0], hv[1]); o.y = cvt_pk_bf16(hv[2], hv[3]);
                if (ok) *(u32x2*)(HX + (size_t)rr * 1024 + k) = o;
                u32x2 h16; h16.x = pack_f16(hv[0], hv[1]); h16.y = pack_f16(hv[2], hv[3]);
                *(LAS u32x2*)(Xh + (2 * wave + q) * ST_H16 + k * 2) = h16; } }
        __syncthreads();
        {
            f32x4 acc0 = {0.f, 0.f, 0.f, 0.f};
#pragma unroll
            for (int s4 = 0; s4 < 4; ++s4) { const int kb = (128 * wave + 32 * s4 + 8 * (lane >> 4)) * 2;
                const f16x8 a = *(const LAS f16x8*)(Xh + (lane & 15) * ST_H16 + kb);
                const f16x8 b0 = *(const LAS f16x8*)(Wh + (lane & 15) * ST_H16 + kb);
                acc0 = __builtin_amdgcn_mfma_f32_16x16x32_f16(a, b0, acc0, 0, 0, 0); }
#pragma unroll
            for (int e = 0; e < 4; ++e) part[(wave * 16 + 4 * (lane >> 4) + e) * 16 + (lane & 15)] = acc0[e];
        }
        __syncthreads();
        if (tid < 256) { const int row = tid >> 4, n = tid & 15; const int rr = t0r + row;
            float sacc = p->dt_bias[l * 16 + n];
#pragma unroll
            for (int w = 0; w < 8; ++w) sacc += part[(w * 16 + row) * 16 + n];
            if (rr < r1) DT[(size_t)rr * 16 + n] = softplusf_(sacc); }
    }
    __syncthreads();
}
typedef float f32x16 __attribute__((ext_vector_type(16)));
typedef short s16x4 __attribute__((ext_vector_type(4)));
constexpr int ST_ROW = 272;
constexpr int ST_TR128 = 320;
constexpr int ST_TR64 = 192;
constexpr int ST_MT = 328;
constexpr int NCHUNK = SEG / 128;

#define DPP_MOV(v, ctrl, rm, bm) __builtin_bit_cast(float, __builtin_amdgcn_update_dpp(0, __builtin_bit_cast(int, (v)), (ctrl), (rm), (bm), true))
__device__ __forceinline__ float wave_incl_scan(float v, int) {
    float s = v + DPP_MOV(v, 0x111, 0xF, 0xF) + DPP_MOV(v, 0x112, 0xF, 0xF) + DPP_MOV(v, 0x113, 0xF, 0xF);
    s += DPP_MOV(s, 0x114, 0xF, 0xE);
    s += DPP_MOV(s, 0x118, 0xF, 0xC);
    s += DPP_MOV(s, 0x142, 0xA, 0xF);
    s += DPP_MOV(s, 0x143, 0xC, 0xF);
    return s;
}
__device__ __forceinline__ bf16x8 row_frag(const LAS unsigned char* tile, int stride, int row0, int k0, int lane) {
    return *(const LAS bf16x8*)(tile + (row0 + (lane & 31)) * stride + (k0 + 8 * (lane >> 5)) * 2);
}
__device__ __forceinline__ bf16x8 tr_frag(const LAS unsigned char* tile, int stride, int k0, int c0, int lane) {
    const int g = lane >> 4, li = lane & 15, q = li >> 2, pp = li & 3;
    const LAS unsigned char* a0 = tile + (k0 + 8 * (g >> 1) + q) * stride + (c0 + 16 * (g & 1) + 4 * pp) * 2;
    const s16x4 lo = __builtin_amdgcn_ds_read_tr16_b64_v4i16((LAS s16x4*)a0);
    const s16x4 hi = __builtin_amdgcn_ds_read_tr16_b64_v4i16((LAS s16x4*)(a0 + 4 * stride));
    return __builtin_shufflevector(lo, hi, 0, 1, 2, 3, 4, 5, 6, 7);
}
__device__ __forceinline__ u32x4 pack8(const float (&v)[8]) { u32x4 r; r.x = cvt_pk_bf16(v[0], v[1]); r.y = cvt_pk_bf16(v[2], v[3]); r.z = cvt_pk_bf16(v[4], v[5]); r.w = cvt_pk_bf16(v[6], v[7]); return r; }
__device__ __forceinline__ u32x4 pack8s(const float (&v)[8], float sc) { u32x4 r; r.x = cvt_pk_bf16(v[0] * sc, v[1] * sc); r.y = cvt_pk_bf16(v[2] * sc, v[3] * sc); r.z = cvt_pk_bf16(v[4] * sc, v[5] * sc); r.w = cvt_pk_bf16(v[6] * sc, v[7] * sc); return r; }

__device__ __forceinline__ void conv_load(const bf16_t* proj, int row0, int rq, int xch, bool lo_ok, bool hi_ok, u32x4 (&raw)[8]) {
    const bf16_t* base = proj + (size_t)(row0 + 4 * rq) * NPROJ + 1536 + xch;
    unsigned zz; asm volatile("v_mov_b32 %0, 0" : "=v"(zz));
#pragma unroll
    for (int j = 0; j < 8; ++j) {
        if (j < 2) { const bool ok = (rq > 0) || lo_ok; const u32x4 v = *(const u32x4*)(ok ? base + (j - 2) * NPROJ : base);
            raw[j].x = ok ? v.x : zz; raw[j].y = ok ? v.y : zz; raw[j].z = ok ? v.z : zz; raw[j].w = ok ? v.w : zz; }
        else if (j >= 6) { const bool ok = (rq < 31) || hi_ok; const u32x4 v = *(const u32x4*)(ok ? base + (j - 2) * NPROJ : base);
            raw[j].x = ok ? v.x : zz; raw[j].y = ok ? v.y : zz; raw[j].z = ok ? v.z : zz; raw[j].w = ok ? v.w : zz; }
        else raw[j] = *(const u32x4*)(base + (j - 2) * NPROJ);
    }
}
__device__ __forceinline__ void conv_compute(const u32x4 (&raw)[8], const LAS float* wl, int nchl, int wch, float (&o)[4][8]) {
    float w[5][8], bs[8];
#pragma unroll
    for (int j = 0; j < 5; ++j) { const f32x4 w0 = *(const LAS f32x4*)(wl + j * nchl + wch), w1 = *(const LAS f32x4*)(wl + j * nchl + wch + 4);
        w[j][0] = w0[0]; w[j][1] = w0[1]; w[j][2] = w0[2]; w[j][3] = w0[3]; w[j][4] = w1[0]; w[j][5] = w1[1]; w[j][6] = w1[2]; w[j][7] = w1[3]; }
    { const f32x4 b0 = *(const LAS f32x4*)(wl + 5 * nchl + wch), b1 = *(const LAS f32x4*)(wl + 5 * nchl + wch + 4); bs[0] = b0[0]; bs[1] = b0[1]; bs[2] = b0[2]; bs[3] = b0[3]; bs[4] = b1[0]; bs[5] = b1[1]; bs[6] = b1[2]; bs[7] = b1[3]; }
#pragma unroll
    for (int i = 0; i < 4; ++i)
#pragma unroll
        for (int e = 0; e < 8; ++e) o[i][e] = bs[e];
#pragma unroll
    for (int j = 0; j < 8; ++j) {
        float xv[8] = {bflo(raw[j].x), bfhi(raw[j].x), bflo(raw[j].y), bfhi(raw[j].y), bflo(raw[j].z), bfhi(raw[j].z), bflo(raw[j].w), bfhi(raw[j].w)};
#pragma unroll
        for (int i = 0; i < 4; ++i) { const int tap = j - i; if (tap >= 0 && tap < 5) {
#pragma unroll
                for (int e = 0; e < 8; ++e) o[i][e] += w[tap][e] * xv[e]; } }
    }
#pragma unroll
    for (int i = 0; i < 4; ++i)
#pragma unroll
        for (int e = 0; e < 8; ++e) o[i][e] = siluf_(o[i][e]);
}
__device__ __forceinline__ void head_cums(CP p, int l, int row0, int h, int dir, int lane, LAS float* hv) {
    const float A = -expf(p->a_log[l * 16 + dir * 8 + h]);
    const float* DT = (const float*)(p->ws + WS_DT);
    const float d0 = DT[(size_t)(row0 + 2 * lane) * 16 + dir * 8 + h], d1 = DT[(size_t)(row0 + 2 * lane + 1) * 16 + dir * 8 + h];
    const float x0 = d0 * A, x1 = d1 * A;
    const float incl = wave_incl_scan(x0 + x1, lane);
    const float total = __builtin_bit_cast(float, __builtin_amdgcn_readlane(__builtin_bit_cast(int, incl), 63));
    float c0, c1;
    if (dir == 0) { c1 = incl; c0 = incl - x1; } else { c0 = total - (incl - x1 - x0); c1 = total - (incl - x1); }
    hv[dir * 128 + 2 * lane] = c0; hv[dir * 128 + 2 * lane + 1] = c1;
    hv[256 + dir * 128 + 2 * lane] = d0; hv[256 + dir * 128 + 2 * lane + 1] = d1;
    if (lane == 0) hv[512 + dir] = total;
}
__device__ __forceinline__ bf16x8 scale_frag(bf16x8 f, const f32x4 w0, const f32x4 w1) {
    const u32x4 u = __builtin_bit_cast(u32x4, f);
    u32x4 r;
    r.x = cvt_pk_bf16(bflo(u.x) * w0[0], bfhi(u.x) * w0[1]); r.y = cvt_pk_bf16(bflo(u.y) * w0[2], bfhi(u.y) * w0[3]);
    r.z = cvt_pk_bf16(bflo(u.z) * w1[0], bfhi(u.z) * w1[1]); r.w = cvt_pk_bf16(bflo(u.w) * w1[2], bfhi(u.w) * w1[3]);
    return __builtin_bit_cast(bf16x8, r);
}
constexpr int ST_X256 = 576;

__device__ __forceinline__ void phase_c1(CP p, int l, unsigned char* lds_, int bid, int nb) {
    LAS unsigned char* lds = (LAS unsigned char*)lds_;
    LAS unsigned char* tile = lds;
    LAS float* wl = (LAS float*)(lds + 73216);
    const int tid = launder_tid();
    const bf16_t* proj = (const bf16_t*)(p->ws + WS_PROJ); bf16_t* mix = (bf16_t*)(p->ws + WS_HX);
    const int NU = 256 + 512 + (l == DEPTH - 1 ? 0 : 16);
    const int heavy = (nb > 64 && (NB * NCHUNK * 2) % nb < nb / 4) ? (NB * NCHUNK * 2) % nb : 0;
    const int ustart = bid < heavy ? NU : (bid - heavy), ustep = nb - heavy;
#pragma unroll 1
    for (int u = ustart; u < NU; u += ustep) {
        int S, LEN, LSH, pstride, sstride, tok0, ch0;
        if (u < 256) { const int b = u >> 7, cs = (u >> 2) & 31, cc = u & 3; S = 2; LEN = 256; LSH = 8; pstride = 64; sstride = 1; tok0 = b * SEG + CTXL + 2 * cs; ch0 = 256 + 64 * cc; }
        else if (u < 768) { const int v = u - 256; const int b = v >> 8, rg = (v >> 2) & 63, cc = v & 3; S = 4; LEN = 64; LSH = 6; pstride = 1; sstride = 64; tok0 = b * SEG + CTXL + 256 * rg; ch0 = 64 * cc; }
        else { const int v = u - 768; const int b = v >> 3, cc = v & 7; S = 1; LEN = 256; LSH = 8; pstride = 1; sstride = 0; tok0 = b * SEG; ch0 = 64 * cc; }
        const int LP = LEN + 30;
        { float tw[4];
#pragma unroll
          for (int it = 0; it < 4; ++it) { const int i = tid + NTHREADS * it; const int j = i >> 6, c = i & 63; tw[it] = j < 31 ? p->conv_w[((size_t)l * 31 + j) * 512 + ch0 + c] : p->conv_b[l * 512 + ch0 + c]; }
#pragma unroll
          for (int it = 0; it < 4; ++it) wl[tid + NTHREADS * it] = tw[it]; }
        for (int i = tid; i < S * 30 * 8; i += NTHREADS) { const int pc = i & 7, q = (i >> 3) % 30, sq = (i >> 3) / 30; const int pos = q < 15 ? q : LEN + q;
            unsigned zz; asm volatile("v_mov_b32 %0, 0" : "=v"(zz));
            *(LAS u32x4*)(tile + ((sq * LP + pos) * 64 + pc * 8) * 2) = (u32x4){zz, zz, zz, zz}; }
        for (int ib = 0; ib < S * LEN * 8; ib += 4 * NTHREADS) {
            u32x4 uv[4];
#pragma unroll
            for (int q = 0; q < 4; ++q) { const int i = ib + tid + NTHREADS * q; const int pc = i & 7, t = i >> 3; const int sq = t >> LSH, pos = t & (LEN - 1);
                const bf16_t* src = proj + (size_t)(tok0 + sq * sstride + pos * pstride) * NPROJ + ch0 + pc * 8;
                uv[q] = *(const u32x4*)src; }
#pragma unroll
            for (int q = 0; q < 4; ++q) { const int i = ib + tid + NTHREADS * q; const int pc = i & 7, t = i >> 3; const int sq = t >> LSH, pos = t & (LEN - 1);
                const u32x4 o = uv[q];
                *(LAS u32x4*)(tile + ((sq * LP + 15 + pos) * 64 + pc * 8) * 2) = o; }
        }
        __syncthreads();
        const int noct = S * LEN / 8;
#pragma unroll 1
        for (int it = tid; it < noct * 32; it += NTHREADS) {
            const int cp = it & 31, oc = it >> 5; const int sq = oc >> (LSH - 3), p0 = (oc & ((LEN >> 3) - 1)) * 8;
            const LAS unsigned* base = (const LAS unsigned*)(tile + ((sq * LP + p0) * 64) * 2) + cp;
            float i0[38], i1[38];
#pragma unroll
            for (int k = 0; k < 38; ++k) { const unsigned w = base[k * 32]; i0[k] = bflo(w); i1[k] = bfhi(w); }
            float a0[8], a1[8];
            { const float b0 = wl[31 * 64 + 2 * cp], b1 = wl[31 * 64 + 2 * cp + 1];
#pragma unroll
              for (int i = 0; i < 8; ++i) { a0[i] = b0; a1[i] = b1; } }
#pragma unroll
            for (int j = 0; j < 31; ++j) { typedef float f32x2 __attribute__((ext_vector_type(2))); const f32x2 wj = *(const LAS f32x2*)(wl + j * 64 + 2 * cp); const float w0 = wj[0], w1 = wj[1];
#pragma unroll
                for (int i = 0; i < 8; ++i) { a0[i] += w0 * i0[i + j]; a1[i] += w1 * i1[i + j]; } }
#pragma unroll
            for (int i = 0; i < 8; ++i) { const int tok = tok0 + sq * sstride + (p0 + i) * pstride;
                *(unsigned*)(mix + (size_t)tok * 1024 + 512 + ch0 + 2 * cp) = cvt_pk_bf16(a0[i], a1[i]); }
        }
        __syncthreads();
    }
}
__device__ __forceinline__ void phase_c1_ln(CP p, int l, int bid, int nb) {
    const int tid = launder_tid(); const int lane = tid & 63, wave = tid >> 6;
    bf16_t* mix = (bf16_t*)(p->ws + WS_HX);
    const f32x4 g0 = *(const f32x4*)(p->conv_ln_g + l * 512 + lane * 8), g1 = *(const f32x4*)(p->conv_ln_g + l * 512 + lane * 8 + 4);
    const f32x4 b0 = *(const f32x4*)(p->conv_ln_b + l * 512 + lane * 8), b1 = *(const f32x4*)(p->conv_ln_b + l * 512 + lane * 8 + 4);
    const float gg[8] = {g0[0], g0[1], g0[2], g0[3], g1[0], g1[1], g1[2], g1[3]}, bb[8] = {b0[0], b0[1], b0[2], b0[3], b1[0], b1[1], b1[2], b1[3]};
    u32x4 vn = {0u, 0u, 0u, 0u};
    if (bid * 8 + wave < R) vn = *(const u32x4*)(mix + (size_t)(bid * 8 + wave) * 1024 + 512 + lane * 8);
    for (int r = bid * 8 + wave; r < R; r += nb * 8) {
        u32x4* ptr = (u32x4*)(mix + (size_t)r * 1024 + 512 + lane * 8);
        const u32x4 v = vn;
        if (r + nb * 8 < R) vn = *(const u32x4*)(mix + (size_t)(r + nb * 8) * 1024 + 512 + lane * 8);
        float y[8] = {bflo(v.x), bfhi(v.x), bflo(v.y), bfhi(v.y), bflo(v.z), bfhi(v.z), bflo(v.w), bfhi(v.w)};
        float s = 0.f;
#pragma unroll
        for (int e = 0; e < 8; ++e) s += y[e];
        const float mu = wave_sum(s) * (1.f / 512.f);
        float q = 0.f;
#pragma unroll
        for (int e = 0; e < 8; ++e) { y[e] -= mu; q += y[e] * y[e]; }
        const float rstd = rsqrtf(wave_sum(q) * (1.f / 512.f) + 1e-5f);
        float o[8];
#pragma unroll
        for (int e = 0; e < 8; ++e) o[e] = siluf_(y[e] * rstd * gg[e] + bb[e]);
        *ptr = pack8(o);
    }
}
__device__ __forceinline__ void phase_s1(CP p, int l, unsigned char* lds_, int bid, int nb) {
    LAS unsigned char* lds = (LAS unsigned char*)lds_;
    LAS unsigned char* Bs = lds;
    LAS unsigned char* Xs = lds + 128 * ST_TR128;
    LAS float* wv = (LAS float*)(Xs + 128 * ST_X256);
    LAS float* hvs = wv + 8 * 128;
    LAS float* cwl = hvs + 4 * 520;
    const int tid = launder_tid(); const int lane = tid & 63, wave = __builtin_amdgcn_readfirstlane(tid >> 6);
    const bf16_t* proj = (const bf16_t*)(p->ws + WS_PROJ);
    const float* cw = p->ssd_conv_w + (size_t)l * 5 * 1024; const float* cbias = p->ssd_conv_b + (size_t)l * 1024;
    bf16_t* Sg = (bf16_t*)(p->ws + WS_S); float* DEC = (float*)(p->ws + WS_DEC);
    int cur_g = -1;
#pragma unroll 1
    for (int u = bid; u < NB * NCHUNK * 2; u += nb) {
        const int g = u & 1, c = (u >> 1) % NCHUNK, b = (u >> 1) / NCHUNK;
        const int row0 = b * SEG + c * 128;
        const bool lo_ok = !(c == 0 || c == 2), hi_ok = !(c == 1 || c == NCHUNK - 1);
        if (g != cur_g) { cur_g = g;
            float tw[5];
#pragma unroll
            for (int it = 0; it < 5; ++it) { const int i = tid + NTHREADS * it; const int j = i / 384, lc = i - j * 384; const int gch = lc < 128 ? 512 + g * 128 + lc : g * 256 + (lc - 128);
                tw[it] = i < 6 * 384 ? (j < 5 ? cw[j * 1024 + gch] : cbias[gch]) : 0.f; }
#pragma unroll
            for (int it = 0; it < 5; ++it) { const int i = tid + NTHREADS * it; if (i < 6 * 384) cwl[i] = tw[it]; } }
        const int hh = wave >> 1, dir = wave & 1, h = 4 * g + hh;
        u32x4 rb[8], rx0[8], rx1[8];
        conv_load(proj, row0, tid >> 4, 512 + g * 128 + (tid & 15) * 8, lo_ok, hi_ok, rb);
        conv_load(proj, row0, tid >> 5, g * 256 + (tid & 31) * 8, lo_ok, hi_ok, rx0);
        conv_load(proj, row0, (tid >> 5) + 16, g * 256 + (tid & 31) * 8, lo_ok, hi_ok, rx1);
        head_cums(p, l, row0, h, dir, lane, hvs + hh * 520);
        __syncthreads();
        {
            const LAS float* hv = hvs + hh * 520; const float tot = hv[512 + dir];
#pragma unroll
            for (int q = 0; q < 2; ++q) { const int lr = lane + 64 * q; wv[wave * 128 + lr] = __expf(tot - hv[dir * 128 + lr]) * hv[256 + dir * 128 + lr]; }
            if (lane == 0) DEC[((size_t)(b * 2 + dir) * NCHUNK + c) * 8 + h] = __expf(tot);
        }
        { float o[4][8];
          conv_compute(rb, cwl, 384, (tid & 15) * 8, o);
#pragma unroll
          for (int i = 0; i < 4; ++i) *(LAS u32x4*)(Bs + (4 * (tid >> 4) + i) * ST_TR128 + (tid & 15) * 16) = pack8(o[i]);
          conv_compute(rx0, cwl, 384, 128 + (tid & 31) * 8, o);
#pragma unroll
          for (int i = 0; i < 4; ++i) *(LAS u32x4*)(Xs + (4 * (tid >> 5) + i) * ST_X256 + (tid & 31) * 16) = pack8(o[i]);
          conv_compute(rx1, cwl, 384, 128 + (tid & 31) * 8, o);
#pragma unroll
          for (int i = 0; i < 4; ++i) *(LAS u32x4*)(Xs + (4 * ((tid >> 5) + 16) + i) * ST_X256 + (tid & 31) * 16) = pack8(o[i]); }
        __syncthreads();
        {
            f32x16 acc[2][4];
#pragma unroll
            for (int t = 0; t < 2; ++t)
#pragma unroll
                for (int q = 0; q < 4; ++q)
#pragma unroll
                    for (int e = 0; e < 16; ++e) acc[t][q][e] = 0.f;
            {
                bf16x8 ar[2][2], br[2][4];
#pragma unroll
                for (int t = 0; t < 2; ++t) ar[0][t] = tr_frag(Xs, ST_X256, 0, hh * 64 + 32 * t, lane);
#pragma unroll
                for (int q = 0; q < 4; ++q) br[0][q] = tr_frag(Bs, ST_TR128, 0, 32 * q, lane);
#pragma unroll 2
                for (int kk = 0; kk < 8; ++kk) { const int c_ = kk & 1, n_ = c_ ^ 1;
                    const LAS float* wp = wv + wave * 128 + 16 * kk + 8 * (lane >> 5);
                    const f32x4 w0 = *(const LAS f32x4*)wp, w1 = *(const LAS f32x4*)(wp + 4);
                    if (kk < 7) {
#pragma unroll
                        for (int t = 0; t < 2; ++t) ar[n_][t] = tr_frag(Xs, ST_X256, 16 * (kk + 1), hh * 64 + 32 * t, lane);
#pragma unroll
                        for (int q = 0; q < 4; ++q) br[n_][q] = tr_frag(Bs, ST_TR128, 16 * (kk + 1), 32 * q, lane); }
                    bf16x8 af[2];
#pragma unroll
                    for (int t = 0; t < 2; ++t) af[t] = scale_frag(ar[c_][t], w0, w1);
#pragma unroll
                    for (int q = 0; q < 4; ++q)
#pragma unroll
                        for (int t = 0; t < 2; ++t) acc[t][q] = __builtin_amdgcn_mfma_f32_32x32x16_bf16(br[c_][q], af[t], acc[t][q], 0, 0, 0);
                }
            }
            bf16_t* So = Sg + ((size_t)((b * 2 + dir) * NCHUNK + c) * 8 + h) * 8192 + (size_t)(lane & 31) * 128 + 4 * (lane >> 5);
#pragma unroll
            for (int t = 0; t < 2; ++t)
#pragma unroll
                for (int q = 0; q < 4; ++q)
#pragma unroll
                    for (int rg = 0; rg < 4; ++rg) { u32x2 pk; pk.x = cvt_pk_bf16(acc[t][q][4 * rg], acc[t][q][4 * rg + 1]); pk.y = cvt_pk_bf16(acc[t][q][4 * rg + 2], acc[t][q][4 * rg + 3]);
                        *(u32x2*)(So + (size_t)(32 * t) * 128 + 32 * q + 8 * rg) = pk; }
        }
        __syncthreads();
    }
}
__device__ __forceinline__ void phase_s2(CP p, int bid, int nb) {
    const int tid = launder_tid();
    const bf16_t* Sg = (const bf16_t*)(p->ws + WS_S); const float* DEC = (const float*)(p->ws + WS_DEC); bf16_t* HP = (bf16_t*)(p->ws + WS_HP);
    for (int idx = bid * NTHREADS + tid; idx < 2 * 2 * 8 * 64 * 64; idx += nb * NTHREADS) {
        const int n2 = idx & 63, pr = (idx >> 6) & 63, h = (idx >> 12) & 7, dir = (idx >> 15) & 1, b = idx >> 16;
        const size_t inner = (size_t)h * 8192 + pr * 128 + 2 * n2;
        const size_t cbase = (size_t)(b * 2 + dir) * NCHUNK;
        float s0 = 0.f, s1 = 0.f;
#pragma unroll 26
        for (int step = 0; step < NCHUNK; ++step) {
            const int c = dir == 0 ? step : (step < 2 ? 1 - step : NCHUNK + 1 - step);
            const size_t off = (cbase + c) * 65536 + inner;
            const unsigned sv = *(const unsigned*)(Sg + off); const float d = DEC[(cbase + c) * 8 + h];
            *(unsigned*)(HP + off) = cvt_pk_bf16(s0, s1);
            s0 = s0 * d + bflo(sv); s1 = s1 * d + bfhi(sv);
        }
    }
}
__device__ __forceinline__ void phase_s3(CP p, int l, unsigned char* lds_, int bid, int nb) {
    LAS unsigned char* lds = (LAS unsigned char*)lds_;
    LAS unsigned char* Cs = lds;
    LAS unsigned char* Bs = Cs + 128 * ST_ROW;
    LAS unsigned char* Mt = Bs;
    LAS unsigned char* Xs = Bs + 128 * ST_MT;
    LAS unsigned char* Hf = Xs + 128 * ST_TR64;
    LAS unsigned char* Hb = Hf + 64 * ST_ROW;
    LAS float* hvs = (LAS float*)(Hb + 64 * ST_ROW);
    LAS float* ssqp = hvs + 4 * 776;
    LAS float* cwl = ssqp + 256;
    const int tid0 = launder_tid(); const int wave = __builtin_amdgcn_readfirstlane(tid0 >> 6);
    const bf16_t* proj = (const bf16_t*)(p->ws + WS_PROJ); bf16_t* mix = (bf16_t*)(p->ws + WS_HX);
    const float* cw = p->ssd_conv_w + (size_t)l * 5 * 1024; const float* cbias = p->ssd_conv_b + (size_t)l * 1024;
    const bf16_t* HP = (const bf16_t*)(p->ws + WS_HP); float* SSQ = (float*)(p->ws + WS_SSQ);
    int cur_g = -1;
    const int cskip = (l == DEPTH - 1) ? 2 : 0, cpb = NCHUNK - cskip;
    const int nunits = NB * cpb * 2, nfull = nunits - nunits % nb, nitems = nfull + (nunits - nfull) * 4;
#pragma unroll 1
    for (int it = bid; it < nitems; it += nb) {
        const int u = it < nfull ? it : nfull + ((it - nfull) >> 2);
        const int hh_lo = it < nfull ? 0 : ((it - nfull) & 3), hh_hi = it < nfull ? 4 : hh_lo + 1;
        const int g = u & 1, c = cskip + (u >> 1) % cpb, b = (u >> 1) / cpb;
        int tid = tid0; asm volatile("" : "+v"(tid));
        const int lane = tid & 63;
        const int row0 = b * SEG + c * 128;
        const bool lo_ok = !(c == 0 || c == 2), hi_ok = !(c == 1 || c == NCHUNK - 1);
        if (g != cur_g) { cur_g = g;
            float tw[6];
#pragma unroll
            for (int it = 0; it < 6; ++it) { const int i = tid + NTHREADS * it; const int j = i >> 9, lc = i & 511; const int gch = lc < 128 ? 768 + g * 128 + lc : (lc < 256 ? 512 + g * 128 + (lc - 128) : g * 256 + (lc - 256));
                tw[it] = j < 5 ? cw[j * 1024 + gch] : cbias[gch]; }
#pragma unroll
            for (int it = 0; it < 6; ++it) cwl[tid + NTHREADS * it] = tw[it]; }
        u32x4 rx[8];
        {
            u32x4 r0[8], r1[8];
            const int cg = tid & 31; const int gch = (cg < 16 ? 768 : 512) + g * 128 + (cg & 15) * 8;
            conv_load(proj, row0, tid >> 5, gch, lo_ok, hi_ok, r0);
            conv_load(proj, row0, (tid >> 5) + 16, gch, lo_ok, hi_ok, r1);
            head_cums(p, l, row0, 4 * g + (wave >> 1), wave & 1, lane, hvs + (wave >> 1) * 776);
            { LAS float* hvw = hvs + (wave >> 1) * 776; const int dr = wave & 1;
              hvw[520 + dr * 128 + 2 * lane] = __expf(hvw[dr * 128 + 2 * lane]); hvw[520 + dr * 128 + 2 * lane + 1] = __expf(hvw[dr * 128 + 2 * lane + 1]); }
            __syncthreads();
            float o[4][8];
            LAS unsigned char* dst = (cg < 16 ? Cs : Bs) + (cg & 15) * 16;
            conv_compute(r0, cwl, 512, cg * 8, o);
#pragma unroll
            for (int i = 0; i < 4; ++i) *(LAS u32x4*)(dst + (4 * (tid >> 5) + i) * ST_ROW) = pack8(o[i]);
            asm volatile("" ::: "memory");
            if (tid < 256) conv_load(proj, row0, tid >> 3, g * 256 + hh_lo * 64 + (tid & 7) * 8, lo_ok, hi_ok, rx);
            conv_compute(r1, cwl, 512, cg * 8, o);
#pragma unroll
            for (int i = 0; i < 4; ++i) *(LAS u32x4*)(dst + (4 * ((tid >> 5) + 16) + i) * ST_ROW) = pack8(o[i]);
            if (tid < 256) { conv_compute(rx, cwl, 512, 256 + hh_lo * 64 + (tid & 7) * 8, o);
#pragma unroll
                for (int i = 0; i < 4; ++i) *(LAS u32x4*)(Xs + (4 * (tid >> 3) + i) * ST_TR64 + (tid & 7) * 16) = pack8(o[i]); }
        }
        __syncthreads();
        const int lb = wave >> 1, hs = wave & 1;
        int ln = lane; asm volatile("" : "+v"(ln));
        f32x16 gacc[2];
#pragma unroll
        for (int t = 0; t < 2; ++t)
#pragma unroll
            for (int e = 0; e < 16; ++e) gacc[t][e] = 0.f;
#pragma unroll
        for (int kk = 0; kk < 8; ++kk) { const bf16x8 af = row_frag(Cs, ST_ROW, 32 * lb, 16 * kk, lane);
#pragma unroll
            for (int t = 0; t < 2; ++t) { const bf16x8 bf = row_frag(Bs, ST_ROW, 64 * hs + 32 * t, 16 * kk, lane);
                gacc[t] = __builtin_amdgcn_mfma_f32_32x32x16_bf16(af, bf, gacc[t], 0, 0, 0); } }
        u32x4 hreg[4];
        { const bf16_t* hp0 = HP + ((size_t)(b * 2 * NCHUNK + c) * 8 + 4 * g + hh_lo) * 8192;
#pragma unroll
          for (int q = 0; q < 4; ++q) { const int it = tid + 512 * q; hreg[q] = *(const u32x4*)(hp0 + (size_t)(it >> 10) * NCHUNK * 8 * 8192 + (it & 1023) * 8); } }
        __syncthreads();
#pragma unroll 1
        for (int hh = hh_lo; hh < hh_hi; ++hh) {
            const int h = 4 * g + hh; const LAS float* hv = hvs + hh * 776;
            asm volatile("" : "+v"(ln));
            const int ph = hs, pc = 32 * ph + (ln & 31);
            unsigned zraw[8];
#pragma unroll
            for (int ri = 0; ri < 16; ri += 2) { const int lr = 32 * lb + 8 * (ri >> 2) + 4 * (ln >> 5) + (ri & 3);
                const bf16_t* zp = proj + (size_t)(row0 + lr) * NPROJ + 1024 + h * 64 + pc;
                zraw[ri >> 1] = (unsigned)zp[0] | ((unsigned)zp[NPROJ] << 16); }
#pragma unroll
            for (int t = 0; t < 2; ++t) {
                const int st = 2 * hs + t;
                const int sc = 32 * st + (ln & 31);
                const float cfs = hv[sc], cbs = hv[128 + sc], dfs = hv[256 + sc], dbs = hv[384 + sc];
#pragma unroll
                for (int rg = 0; rg < 4; ++rg) {
                    const int l0 = 32 * lb + 8 * rg + 4 * (ln >> 5);
                    float m[4];
                    if (st < lb) {
                        const f32x4 cfl = *(const LAS f32x4*)(hv + l0);
#pragma unroll
                        for (int e = 0; e < 4; ++e) m[e] = gacc[t][4 * rg + e] * (__expf(cfl[e] - cfs) * dfs);
                    } else if (st > lb) {
                        const f32x4 cbl = *(const LAS f32x4*)(hv + 128 + l0);
#pragma unroll
                        for (int e = 0; e < 4; ++e) m[e] = gacc[t][4 * rg + e] * (__expf(cbl[e] - cbs) * dbs);
                    } else {
                        const f32x4 cfl = *(const LAS f32x4*)(hv + l0), cbl = *(const LAS f32x4*)(hv + 128 + l0);
#pragma unroll
                        for (int e = 0; e < 4; ++e) { const int lr = l0 + e;
                            const float ff = lr >= sc ? __expf(cfl[e] - cfs) * dfs : 0.f;
                            const float fb = lr <= sc ? __expf(cbl[e] - cbs) * dbs : 0.f;
                            m[e] = gacc[t][4 * rg + e] * (ff + fb); }
                    }
                    u32x2 pk; pk.x = cvt_pk_bf16(m[0], m[1]); pk.y = cvt_pk_bf16(m[2], m[3]);
                    *(LAS u32x2*)(Mt + sc * ST_MT + l0 * 2) = pk;
                }
            }
#pragma unroll
            for (int q = 0; q < 4; ++q) { const int it = tid + 512 * q; const int q2 = it & 1023;
                *(LAS u32x4*)(((it >> 10) ? Hb : Hf) + (q2 >> 4) * ST_ROW + (q2 & 15) * 16) = hreg[q]; }
            if (hh + 1 < hh_hi) {
                const bf16_t* hp0 = HP + ((size_t)(b * 2 * NCHUNK + c) * 8 + h + 1) * 8192;
#pragma unroll
                for (int q = 0; q < 4; ++q) { const int it = tid + 512 * q; hreg[q] = *(const u32x4*)(hp0 + (size_t)(it >> 10) * NCHUNK * 8 * 8192 + (it & 1023) * 8); }
                if (tid < 256) conv_load(proj, row0, tid >> 3, g * 256 + (hh + 1) * 64 + (tid & 7) * 8, lo_ok, hi_ok, rx);
            }
            __syncthreads();
            f32x16 ad, af_, ab_;
#pragma unroll
            for (int e = 0; e < 16; ++e) { ad[e] = 0.f; af_[e] = 0.f; ab_[e] = 0.f; }
            {
                bf16x8 am[2], bx[2], ac[2], bhf[2], bhb[2];
                am[0] = tr_frag(Mt, ST_MT, 0, 32 * lb, lane); bx[0] = tr_frag(Xs, ST_TR64, 0, 32 * ph, lane);
                ac[0] = row_frag(Cs, ST_ROW, 32 * lb, 0, lane); bhf[0] = row_frag(Hf, ST_ROW, 32 * ph, 0, lane); bhb[0] = row_frag(Hb, ST_ROW, 32 * ph, 0, lane);
#pragma unroll
                for (int kk = 0; kk < 8; ++kk) { const int c = kk & 1, n = c ^ 1;
                    if (kk < 7) { am[n] = tr_frag(Mt, ST_MT, 16 * (kk + 1), 32 * lb, lane); bx[n] = tr_frag(Xs, ST_TR64, 16 * (kk + 1), 32 * ph, lane);
                        ac[n] = row_frag(Cs, ST_ROW, 32 * lb, 16 * (kk + 1), lane); bhf[n] = row_frag(Hf, ST_ROW, 32 * ph, 16 * (kk + 1), lane); bhb[n] = row_frag(Hb, ST_ROW, 32 * ph, 16 * (kk + 1), lane); }
                    ad = __builtin_amdgcn_mfma_f32_32x32x16_bf16(am[c], bx[c], ad, 0, 0, 0);
                    af_ = __builtin_amdgcn_mfma_f32_32x32x16_bf16(ac[c], bhf[c], af_, 0, 0, 0);
                    ab_ = __builtin_amdgcn_mfma_f32_32x32x16_bf16(ac[c], bhb[c], ab_, 0, 0, 0); }
            }
            const float dsk = p->d_skip[l * 8 + h];
#pragma unroll
            for (int rg = 0; rg < 4; ++rg) {
                const int l0 = 32 * lb + 8 * rg + 4 * (ln >> 5);
                const f32x4 efl = *(const LAS f32x4*)(hv + 520 + l0), ebl = *(const LAS f32x4*)(hv + 648 + l0);
#pragma unroll
                for (int e = 0; e < 4; ++e) { const int lr = l0 + e; const int ri = 4 * rg + e;
                    const float xs = bf2f(*(const LAS bf16_t*)(Xs + lr * ST_TR64 + pc * 2));
                    const float y = ad[ri] + efl[e] * af_[ri] + ebl[e] * ab_[ri] + dsk * xs;
                    const float z = (ri & 1) ? bfhi(zraw[ri >> 1]) : bflo(zraw[ri >> 1]);
                    const float val = y * z;
                    mix[(size_t)(row0 + lr) * 1024 + h * 64 + pc] = f2bf(val);
                    const float sq = half_sum32(val * val);
                    if ((ln & 31) == 31) ssqp[ph * 128 + lr] = sq;
                }
            }
            __syncthreads();
            if (tid < 128) SSQ[(size_t)(row0 + tid) * 8 + h] = ssqp[tid] + ssqp[128 + tid];
            if (hh + 1 < hh_hi && tid < 256) { float o[4][8];
                conv_compute(rx, cwl, 512, 256 + (hh + 1) * 64 + (tid & 7) * 8, o);
#pragma unroll
                for (int i = 0; i < 4; ++i) *(LAS u32x4*)(Xs + (4 * (tid >> 3) + i) * ST_TR64 + (tid & 7) * 16) = pack8(o[i]); }
        }
        __syncthreads();
    }
}
__device__ __forceinline__ void phase_r2(CP p, int l, unsigned char* lds_, int bid, int nb) {
    LAS unsigned char* lds = (LAS unsigned char*)lds_;
    LAS unsigned char* Wh = lds;
    LAS unsigned char* Xh = Wh + 32 * ST_H16;
    LAS float* gm = (LAS float*)(Xh + 16 * ST_H16);
    LAS float* sh = gm + 3 * 1024;
    LAS float* part = sh + 3 * 1024;
    LAS float* lgs = part + 8 * 16 * 32;
    LAS int* lcnt = (LAS int*)(lgs + 16 * 32);
    LAS int* lcls = lcnt + 64;
    LAS int* lrank = lcls + 512;
    LAS float* lcwa = (LAS float*)(lrank + 512);
    LAS float* lcwb = lcwa + 512;
    const int tid = launder_tid(); const int lane = tid & 63, wave = __builtin_amdgcn_readfirstlane(tid >> 6);
    const float* mod = (const float*)(p->ws + WS_MOD) + (size_t)l * 3 * 6144;
    {
        float tmp[8];
#pragma unroll
        for (int it = 0; it < 8; ++it) tmp[it] = p->w_rg[(size_t)l * 4096 + tid + NTHREADS * it];
#pragma unroll
        for (int it = 0; it < 8; ++it) { const int idx = tid + NTHREADS * it; *(LAS _Float16*)(Wh + (idx & 3) * ST_H16 + (idx >> 2) * 2) = (_Float16)tmp[it]; } }
#pragma unroll
    for (int hb = 0; hb < 2; ++hb) { float tmp[16];
#pragma unroll
        for (int it = 0; it < 16; ++it) tmp[it] = p->w_re[(size_t)l * 16384 + tid + NTHREADS * (16 * hb + it)];
#pragma unroll
        for (int it = 0; it < 16; ++it) { const int idx = tid + NTHREADS * (16 * hb + it); *(LAS _Float16*)(Wh + (4 + (idx & 15)) * ST_H16 + (idx >> 4) * 2) = (_Float16)tmp[it]; } }
    { unsigned zz; asm volatile("v_mov_b32 %0, 0" : "=v"(zz));
      for (int i = tid; i < 12 * 128; i += NTHREADS) { const int rw = 20 + i / 128, c16 = i % 128; *(LAS u32x4*)(Wh + rw * ST_H16 + c16 * 16) = (u32x4){zz, zz, zz, zz}; } }
    { float t0[6], t1[6], t2[6];
#pragma unroll
      for (int it = 0; it < 6; ++it) { const int idx = tid + NTHREADS * it; const int v = idx >> 10, k = idx & 1023; t0[it] = p->g_ffn[l * 1024 + k]; t1[it] = mod[v * 6144 + 4 * 1024 + k]; t2[it] = mod[v * 6144 + 3 * 1024 + k]; }
#pragma unroll
      for (int it = 0; it < 6; ++it) { const int idx = tid + NTHREADS * it; gm[idx] = t0[it] * (1.f + t1[it]); sh[idx] = t2[it]; } }
    if (tid < 64) lcnt[tid] = 0;
    __syncthreads();
    bf16_t* HM = (bf16_t*)(p->ws + WS_HX); float* CWLA = (float*)(p->ws + WS_CWLA); float* CWLB = (float*)(p->ws + WS_CWLB);
    int* gcount = (int*)(p->ws + WS_CTL) + l * 32; int* LIST = (int*)(p->ws + WS_LIST);
    const int rpb = (R + nb - 1) / nb, r0 = bid * rpb, r1 = (r0 + rpb) < R ? (r0 + rpb) : R;
    RowRaw xn[2];
#pragma unroll
    for (int q = 0; q < 2; ++q) if (r0 + 2 * wave + q < r1) row_load(p, 1, r0 + 2 * wave + q, lane, xn[q]);
#pragma unroll 1
    for (int t0r = r0; t0r < r1; t0r += 16) {
        f32x4 xv[2][4];
#pragma unroll
        for (int q = 0; q < 2; ++q) row_cvt(1, xn[q], xv[q]);
#pragma unroll
        for (int q = 0; q < 2; ++q) if (t0r + 16 + 2 * wave + q < r1) row_load(p, 1, t0r + 16 + 2 * wave + q, lane, xn[q]);
#pragma unroll
        for (int q = 0; q < 2; ++q) { const int rr = t0r + 2 * wave + q; const bool ok = rr < r1; const int v = row_v(ok ? rr : r0);
            float ss = 0.f;
#pragma unroll
            for (int j = 0; j < 4; ++j) ss += xv[q][j][0] * xv[q][j][0] + xv[q][j][1] * xv[q][j][1] + xv[q][j][2] * xv[q][j][2] + xv[q][j][3] * xv[q][j][3];
            ss = wave_sum(ss); const float rs = ok ? __builtin_amdgcn_rsqf(ss * (1.f / 1024.f) + 1e-6f) : 0.f;
#pragma unroll
            for (int j = 0; j < 4; ++j) { const int k = 4 * lane + 256 * j; const f32x4 g4 = *(const LAS f32x4*)(gm + v * 1024 + k), s4 = *(const LAS f32x4*)(sh + v * 1024 + k);
                f32x4 hv = xv[q][j] * rs * g4 + s4; if (!ok) hv = hv * 0.f;
                u32x2 o; o.x = cvt_pk_bf16(hv[0], hv[1]); o.y = cvt_pk_bf16(hv[2], hv[3]);
                if (ok) *(u32x2*)(HM + (size_t)rr * 1024 + k) = o;
                u32x2 h16; h16.x = pack_f16(hv[0], hv[1]); h16.y = pack_f16(hv[2], hv[3]);
                *(LAS u32x2*)(Xh + (2 * wave + q) * ST_H16 + k * 2) = h16; } }
        __syncthreads();
        {
            f32x4 acc0 = {0.f, 0.f, 0.f, 0.f}, acc1 = {0.f, 0.f, 0.f, 0.f};
#pragma unroll
            for (int s4 = 0; s4 < 4; ++s4) { const int kb = (128 * wave + 32 * s4 + 8 * (lane >> 4)) * 2;
                const f16x8 a = *(const LAS f16x8*)(Xh + (lane & 15) * ST_H16 + kb);
                const f16x8 b0 = *(const LAS f16x8*)(Wh + (lane & 15) * ST_H16 + kb), b1 = *(const LAS f16x8*)(Wh + (16 + (lane & 15)) * ST_H16 + kb);
                acc0 = __builtin_amdgcn_mfma_f32_16x16x32_f16(a, b0, acc0, 0, 0, 0);
                acc1 = __builtin_amdgcn_mfma_f32_16x16x32_f16(a, b1, acc1, 0, 0, 0); }
#pragma unroll
            for (int e = 0; e < 4; ++e) { const int row = 4 * (lane >> 4) + e; part[(wave * 16 + row) * 32 + (lane & 15)] = acc0[e]; part[(wave * 16 + row) * 32 + 16 + (lane & 15)] = acc1[e]; }
        }
        __syncthreads();
        if (tid < 320) { const int row = tid / 20, n = tid - row * 20; float sacc = n < 4 ? p->b_rg[l * 4 + n] : p->b_re[l * 16 + n - 4];
#pragma unroll
            for (int w = 0; w < 8; ++w) sacc += part[(w * 16 + row) * 32 + n];
            lgs[row * 32 + n] = sacc; }
        __syncthreads();
        if (tid < 16) { const int rr = t0r + tid;
            if (rr < r1) {
                if (l == DEPTH - 1 && row_v(rr) == 2) lcls[rr - r0] = -1;
                else {
                    float lg[20];
#pragma unroll
                    for (int n = 0; n < 20; ++n) lg[n] = lgs[tid * 32 + n];
                    int gsel = 0; float gmax = lg[0];
#pragma unroll
                    for (int t = 1; t < 4; ++t) if (lg[t] > gmax) { gmax = lg[t]; gsel = t; }
                    float gden = 0.f;
#pragma unroll
                    for (int t = 0; t < 4; ++t) gden += __expf(lg[t] - gmax);
                    const float gprob = 1.f / gden;
                    float el[4];
#pragma unroll
                    for (int t = 0; t < 4; ++t) el[t] = gsel == 0 ? lg[4 + t] : (gsel == 1 ? lg[8 + t] : (gsel == 2 ? lg[12 + t] : lg[16 + t]));
                    int i0 = 0; float m0 = el[0];
#pragma unroll
                    for (int t = 1; t < 4; ++t) if (el[t] > m0) { m0 = el[t]; i0 = t; }
                    int i1 = -1; float m1 = -3.0e38f;
#pragma unroll
                    for (int t = 0; t < 4; ++t) if (t != i0 && el[t] > m1) { m1 = el[t]; i1 = t; }
                    const float w0 = gprob / (1.f + __expf(m1 - m0)), w1 = gprob - w0;
                    const int ea = i0 < i1 ? i0 : i1, eb = i0 < i1 ? i1 : i0;
                    const float cwa = i0 < i1 ? w0 : w1, cwb = i0 < i1 ? w1 : w0;
                    const int pidx = ea == 0 ? eb - 1 : (ea == 1 ? eb + 1 : 5);
                    const int cls = gsel * 6 + pidx;
                    const int rank = __hip_atomic_fetch_add(&lcnt[cls], 1, __ATOMIC_RELAXED, __HIP_MEMORY_SCOPE_WORKGROUP);
                    lcls[rr - r0] = cls; lrank[rr - r0] = rank; lcwa[rr - r0] = cwa; lcwb[rr - r0] = cwb;
                } } }
    }
    __syncthreads();
    if (tid < NCLS) lcnt[32 + tid] = atomicAdd(&gcount[tid], lcnt[tid]);
    __syncthreads();
    for (int idx = tid; idx < r1 - r0; idx += NTHREADS) { const int cl = lcls[idx]; if (cl < 0) continue; const int pos = lcnt[32 + cl] + lrank[idx]; const size_t li = (size_t)cl * R + pos;
        LIST[li] = r0 + idx; CWLA[li] = lcwa[idx]; CWLB[li] = lcwb[idx]; }
    __syncthreads();
}
__device__ __forceinline__ void phase_final(CP p, unsigned char* lds, int bid, int nb) {
    const int tid = launder_tid(); const int lane = tid & 63, wave = tid >> 6;
    const int qstep = nb * 8;
    RowRaw xn;
    { const int q = bid * 8 + wave; if (q < NB * SEQ) { const int b = q >= SEQ ? 1 : 0; row_load(p, 1, b * SEG + CTXL + (q - b * SEQ), lane, xn); } }
    for (int q = bid * 8 + wave; q < NB * SEQ; q += qstep) {
        f32x4* hr = (f32x4*)(p->out + (size_t)q * D);
        f32x4 xv[4]; float ss = 0.f;
        row_cvt(1, xn, xv);
        { const int qn = q + qstep; if (qn < NB * SEQ) { const int bn = qn >= SEQ ? 1 : 0; row_load(p, 1, bn * SEG + CTXL + (qn - bn * SEQ), lane, xn); } }
#pragma unroll
        for (int j = 0; j < 4; ++j) ss += xv[j][0] * xv[j][0] + xv[j][1] * xv[j][1] + xv[j][2] * xv[j][2] + xv[j][3] * xv[j][3];
        ss = wave_sum(ss); const float rs = rsqrtf(ss * (1.f / 1024.f) + 1e-6f);
#pragma unroll
        for (int j = 0; j < 4; ++j) { const f32x4 g4 = *(const f32x4*)(p->g_final + 4 * lane + 256 * j); hr[lane + 64 * j] = xv[j] * rs * g4; }
    }
}


#define XB_TMO      128
#define XB_XCNT(j)  (256  + 64 * (j))
#define XB_XSUB(j)  (1280 + 64 * (j))
#define XB_XGEN(j)  (2304 + 64 * (j))
#define XB_TOP      3328
#define XB_TOPGEN   3392
#define XCD_BAR_WORDS 3456
#define XB_SPIN_CAP (1u << 22)
__device__ __forceinline__ unsigned xb_ld(unsigned* p) { return __hip_atomic_load(p, __ATOMIC_RELAXED, __HIP_MEMORY_SCOPE_AGENT); }
__device__ __forceinline__ unsigned xb_add(unsigned* p, unsigned v) { return __hip_atomic_fetch_add(p, v, __ATOMIC_RELAXED, __HIP_MEMORY_SCOPE_AGENT); }
__device__ __forceinline__ unsigned xb_xcc_id() { return (unsigned)__builtin_amdgcn_s_getreg((3 << 11) | 20) & 0xFu; }
#define XB_SPIN(cond, bar) do { unsigned _sp = 0; while (cond) { __builtin_amdgcn_s_sleep(1); \
    if ((++_sp & 255u) == 0u) { if (xb_ld(&(bar)[XB_TMO])) break; if (_sp > XB_SPIN_CAP) { atomicAdd(&(bar)[XB_TMO], 1u); break; } } } } while (0)
struct XcdBarrier { unsigned* bar; unsigned x; volatile LAS unsigned* st; };
__device__ __forceinline__ XcdBarrier xcd_barrier_post(unsigned* bar, volatile LAS unsigned* st) {
    XcdBarrier b; b.bar = bar; b.x = xb_xcc_id(); b.st = st;
    if (threadIdx.x == 0) (void)xb_add(&bar[XB_XCNT(b.x)], 1u);
    return b;
}
__device__ __forceinline__ void xcd_barrier_complete(unsigned* bar, unsigned x, unsigned& nloc, unsigned& nx) {
    const unsigned G = gridDim.x * gridDim.y * gridDim.z;
    unsigned sum, cnt, mine, sp = 0u;
    for (;;) {
        sum = 0u; cnt = 0u; mine = 0u;
#pragma unroll
        for (unsigned j = 0; j < 16; ++j) { const unsigned c = xb_ld(&bar[XB_XCNT(j)]); sum += c; cnt += (c > 0u) ? 1u : 0u; mine = (j == x) ? c : mine; }
        if (sum == G) break;
        __builtin_amdgcn_s_sleep(1);
        if ((++sp & 255u) == 0u) { if (xb_ld(&bar[XB_TMO])) break; if (sp > XB_SPIN_CAP) { atomicAdd(&bar[XB_TMO], 1u); break; } }
    }
    nloc = mine > 0u ? mine : 1u; nx = cnt > 0u ? cnt : 1u;
}
__device__ __forceinline__ void xcd_barrier(const XcdBarrier& b) {
    asm volatile("s_waitcnt vmcnt(0)" ::: "memory");
    __syncthreads();
    if (threadIdx.x == 0) {
        unsigned* bar = b.bar;
        __builtin_amdgcn_s_waitcnt(0);
        unsigned nloc = b.st[0], nx = b.st[1];
        if (nloc == 0u) { xcd_barrier_complete(bar, b.x, nloc, nx); b.st[0] = nloc; b.st[1] = nx; }
        const unsigned old = xb_add(&bar[XB_XSUB(b.x)], 1u);
        const unsigned gen = old / nloc;
        if (old + 1u == (gen + 1u) * nloc) {
            __builtin_amdgcn_fence(__ATOMIC_RELEASE, "agent");
            asm volatile("s_waitcnt vmcnt(0)" ::: "memory");
            const unsigned og = xb_add(&bar[XB_TOP], 1u);
            const unsigned tg = og / nx;
            if (og + 1u == (tg + 1u) * nx) xb_add(&bar[XB_TOPGEN], 1u);
            else XB_SPIN(xb_ld(&bar[XB_TOPGEN]) == tg, bar);
            __builtin_amdgcn_fence(__ATOMIC_ACQUIRE, "agent");
            xb_add(&bar[XB_XGEN(b.x)], 1u);
            asm volatile("s_waitcnt vmcnt(0)" ::: "memory");
        } else {
            XB_SPIN(xb_ld(&bar[XB_XGEN(b.x)]) == gen, bar);
            __builtin_amdgcn_fence(__ATOMIC_ACQUIRE, "agent");
            asm volatile("s_waitcnt vmcnt(0)" ::: "memory");
        }
    }
    __syncthreads();
}

#ifndef TIMING_A
#define TIMING_A -1
#endif
#ifndef TIMING_B
#define TIMING_B -1
#endif
#ifndef PHASE_MASK
#define PHASE_MASK 0xFFFFF
#endif
#define PM(i) ((PHASE_MASK >> (i)) & 1)
#ifndef REPEAT_MASK
#define REPEAT_MASK 0
#endif
#define RP(i) for (int rep_ = 0; rep_ < 1 + ((REPEAT_MASK >> (i)) & 1); ++rep_)
constexpr int PH_PER_LAYER = 9, NPHASES = 1 + DEPTH * PH_PER_LAYER + 1;
__global__ void __launch_bounds__(NTHREADS, 2) mk_fwd(Args args) {
    extern __shared__ __attribute__((aligned(16))) unsigned char lds[];
    cg::grid_group grid = cg::this_grid();
    const __attribute__((address_space(4))) Args* ap = (const __attribute__((address_space(4))) Args*)__builtin_amdgcn_kernarg_segment_ptr();
    const int lo = ap->lo, hi = ap->hi;
    LAS unsigned char* ldsl = (LAS unsigned char*)lds;
    volatile LAS unsigned* xbst = (volatile LAS unsigned*)(ldsl + LDS_BYTES - 16);
    if (threadIdx.x < 4) xbst[threadIdx.x] = 0u;
    __syncthreads();
    (void)xcd_barrier_post((unsigned*)(ap->p.ws + WS_BAR), xbst);
    if (TIMING_A >= 0 && blockIdx.x == 0 && threadIdx.x == 0) ((unsigned long long*)(ap->p.ws + WS_TS))[lo] = __builtin_amdgcn_s_memrealtime();
    for (int ph = lo; ph < hi; ++ph) {
        CP p = launder(&ap->p);
        int bid = blockIdx.x, nb = gridDim.x; asm volatile("" : "+s"(bid), "+s"(nb));
        if (ph == 0) { if (PM(0)) RP(0) phase_wprep(p, lds, 0, 912, bid, nb); if (PM(1)) RP(1) phase_adaln(p, lds, bid, nb); }
        else if (ph == NPHASES - 1) { if (PM(12)) phase_final(p, lds, bid, nb); }
        else {
            const int l = (ph - 1) / PH_PER_LAYER, s = (ph - 1) % PH_PER_LAYER;
            if (s == 0) { if (PM(2)) RP(2) { if (rep_ == 0 || l == 0) phase_r1(p, l, lds, bid, nb); } }
            else if (s == 1) { if (PM(3)) RP(3) {
                pg8::DenseSched S; S.init(p->ws + WS_HX, (const bf16_t*)(p->ws + WS_WTIN) + (size_t)l * DIN * 1024, R, NPROJ, 1024, 1024, 1024, nb, bid);
                EpiProj E{(bf16_t*)(p->ws + WS_PROJ)};
                pg8::gemm_phase<EpiProj, pg8::DenseSched, false>(ldsl, 1024, 1024, 1024, S, E);
                {
                    const int extra = S.nwg % nb; const int L1 = WPREP_ITEMS_PER_LAYER;
                    const int a0 = l == 0 ? 912 : L1 + 656, a1 = l == 0 ? 2960 : L1 + 2960;
                    if (l <= 1 && DEPTH == 2) { if (extra > 0 && bid >= extra) phase_wprep(p, lds, a0, a1, bid - extra, nb - extra); else if (extra == 0) phase_wprep(p, lds, a0, a1, bid, nb); } }
            } }
            else if (s == 2) { if (PM(4)) RP(4) phase_c1(p, l, lds, bid, nb); if (PM(5)) RP(5) phase_s1(p, l, lds, bid, nb); }
            else if (s == 3) { if (PM(6)) RP(6) phase_s2(p, bid, nb); }
            else if (s == 4) { if (PM(7)) RP(7) phase_s3(p, l, lds, bid, nb);
                if (PM(4)) {
                    const int cpb = NCHUNK - ((l == DEPTH - 1) ? 2 : 0), nunits = NB * cpb * 2, tail = (nunits % nb) * 4;
                    if (tail > 0 && tail < nb) { if (bid >= tail) phase_c1_ln(p, l, bid - tail, nb - tail); } else phase_c1_ln(p, l, bid, nb); } }
            else if (s == 5) { if (PM(8)) RP(8) { if (rep_ == 0 || l == 0) {
                pg8::DenseSched S; S.init(p->ws + WS_HX, (const bf16_t*)(p->ws + WS_WTOUT) + (size_t)l * 1024 * 1024, R, 1024, 1024, 1024, 1024, nb, bid, l == DEPTH - 1);
                EpiResid<0> E{p->ctx, p->x, (bf16_t*)(p->ws + WS_H), (const float*)(p->ws + WS_MOD) + (size_t)l * 3 * 6144, (const float*)(p->ws + WS_SSQ)};
                pg8::gemm_phase<EpiResid<0>, pg8::DenseSched, false>(ldsl, 1024, 1024, 1024, S, E);
                if (l == 0 && DEPTH == 2 && rep_ == 0) { const int extra = S.nwg % nb; const int L1 = WPREP_ITEMS_PER_LAYER;
                    if (extra > 0 && bid >= extra) phase_wprep(p, lds, 2960, 3984, bid - extra, nb - extra, L1, L1 + 656, L1 + 2960, L1 + 3984);
                    else if (extra == 0) phase_wprep(p, lds, 2960, 3984, bid, nb, L1, L1 + 656, L1 + 2960, L1 + 3984); }
            } } }
            else if (s == 6) { if (PM(9)) phase_r2(p, l, lds, bid, nb); }
            else if (s == 7) { if (PM(10)) {
                LAS int* tab = (LAS int*)(ldsl + MISC_OFF);
                LAS float* gl = (LAS float*)(ldsl + MISC_OFF + 4096);
                { const float* modl = (const float*)(p->ws + WS_MOD) + (size_t)l * 3 * 6144 + 5 * 1024; float tg[6]; const int tt = launder_tid();
#pragma unroll
                  for (int it = 0; it < 6; ++it) { const int i = tt + NTHREADS * it; tg[it] = modl[(size_t)(i >> 10) * 6144 + (i & 1023)]; }
#pragma unroll
                  for (int it = 0; it < 6; ++it) gl[tt + NTHREADS * it] = tg[it]; }
                moe_table(p, l, tab);
                unsigned* ready = (unsigned*)(p->ws + WS_M1CNT) + l * 192;
                { MoeSched S{tab, (const int*)(p->ws + WS_LIST), (const char*)(p->ws + WS_HX), (const char*)(p->ws + WS_WTGU), 0, l, nb, bid, ready, 0};
                  EpiUp E{(bf16_t*)(p->ws + WS_HID), (const float*)(p->ws + WS_CWLA), (const float*)(p->ws + WS_CWLB), ready};
                  pg8::gemm_phase<EpiUp, MoeSched, true>(ldsl, 1024, 1024, 1024, S, E); }
                { const int total = __builtin_amdgcn_readfirstlane(tab[24]) * 4; const int extra = __builtin_amdgcn_readfirstlane(total % nb);
                  MoeSched S{tab, (const int*)(p->ws + WS_LIST), (const char*)(p->ws + WS_HID), (const char*)(p->ws + WS_WTD), 1, l, nb, bid, ready, (total >= nb && total - extra >= nb) ? extra : 0};
                  EpiDown E{(bf16_t*)(p->ws + WS_H), (const int*)(p->ws + WS_LIST), gl};
                  pg8::gemm_phase<EpiDown, MoeSched, false>(ldsl, 512, 256, 512, S, E); }
            } }
            else { }
        }
        if (ph + 1 < hi && !(ph > 0 && ph < NPHASES - 1 && (ph - 1) % PH_PER_LAYER == 7)) { if (hi < 0) grid.sync();   else { XcdBarrier xb; xb.bar = (unsigned*)(launder(&ap->p)->ws + WS_BAR); xb.x = xb_xcc_id(); xb.st = (volatile LAS unsigned*)(ldsl + LDS_BYTES - 16); xcd_barrier(xb); }
            if (TIMING_A >= 0 && blockIdx.x == 0 && threadIdx.x == 0) ((unsigned long long*)(launder(&ap->p)->ws + WS_TS))[ph + 1] = __builtin_amdgcn_s_memrealtime(); }
    }
#if TIMING_A >= 0
    {
        XcdBarrier xb; xb.bar = (unsigned*)(launder(&ap->p)->ws + WS_BAR); xb.x = xb_xcc_id(); xb.st = (volatile LAS unsigned*)(ldsl + LDS_BYTES - 16); xcd_barrier(xb);
        if (blockIdx.x == 0 && threadIdx.x == 0) ((unsigned long long*)(launder(&ap->p)->ws + WS_TS))[hi] = __builtin_amdgcn_s_memrealtime();
        xcd_barrier(xb);
        const unsigned long long* ts = (const unsigned long long*)(launder(&ap->p)->ws + WS_TS);
        const float ta = (float)(ts[TIMING_A + 1] - ts[TIMING_A]) * 0.01f, tb = (float)(ts[TIMING_B + 1] - ts[TIMING_B]) * 0.01f;
        float* o = launder(&ap->p)->out; const float sc = 1.f + ta * 0.001f;
        for (size_t i = (size_t)blockIdx.x * NTHREADS + threadIdx.x; i < (size_t)NB * SEQ * D; i += (size_t)gridDim.x * NTHREADS) o[i] = o[i] * sc + (i == 0 ? tb * 0.1f : 0.f);
    }
#endif
}

extern "C" void kernel_launch(void* const* d_in, const int* in_sizes, int n_in, void* d_out, int out_size, void* d_ws, size_t ws_size, hipStream_t stream) {
    static int grid = 0;
    if (grid == 0) {
        if (n_in != 28 || ws_size < WS_END) { fprintf(stderr, "kernel_launch: unexpected n_in %d or ws_size %zu (< %zu)\n", n_in, ws_size, (size_t)WS_END); grid = -1; return; }
        int dev = 0, cus = 0, per_cu = 0;
        hipGetDevice(&dev); hipDeviceGetAttribute(&cus, hipDeviceAttributeMultiprocessorCount, dev);
        if (hipFuncSetAttribute((const void*)mk_fwd, hipFuncAttributeMaxDynamicSharedMemorySize, LDS_BYTES) != hipSuccess) { fprintf(stderr, "kernel_launch: hipFuncSetAttribute failed\n"); grid = -1; return; }
        if (hipOccupancyMaxActiveBlocksPerMultiprocessor(&per_cu, (const void*)mk_fwd, NTHREADS, LDS_BYTES) != hipSuccess || per_cu < 1) { fprintf(stderr, "kernel_launch: occupancy query says %d\n", per_cu); (void)hipGetLastError(); grid = -1; return; }
        grid = cus;
    }
    if (grid < 0) return;
    (void)hipMemsetAsync((char*)d_ws + WS_CTL, 0, WS_CTL_BYTES, stream);
    Args a{};
    const float** pp = (const float**)&a.p;
    for (int i = 0; i < 28; ++i) pp[i] = (const float*)d_in[i];
    a.p.out = (float*)d_out; a.p.ws = (unsigned char*)d_ws;
#if PER_PHASE_LAUNCH
    for (int ph = 0; ph < NPHASES; ++ph) {
        a.lo = ph; a.hi = ph + 1; void* kargs[] = {&a};
        hipError_t e = hipLaunchCooperativeKernel((const void*)mk_fwd, dim3(grid), dim3(NTHREADS), kargs, LDS_BYTES, stream);
        if (e != hipSuccess) { fprintf(stderr, "kernel_launch: launch of phase %d failed: %s\n", ph, hipGetErrorString(e)); break; }
    }
#else
    a.lo = 0; a.hi = NPHASES; void* kargs[] = {&a};
    hipError_t e = hipLaunchCooperativeKernel((const void*)mk_fwd, dim3(grid), dim3(NTHREADS), kargs, LDS_BYTES, stream);
    if (e != hipSuccess) fprintf(stderr, "kernel_launch: cooperative launch failed: %s (grid %d)\n", hipGetErrorString(e), grid);
#endif
}
```

```cpp
#include <hip/hip_runtime.h>
#include <hip/hip_cooperative_groups.h>
#include <cstdio>
namespace cg = cooperative_groups;

#ifndef PER_PHASE_LAUNCH
#define PER_PHASE_LAUNCH 0
#endif

#ifndef S3REP
#define S3REP 0
#endif
#define S3R(i) for (int r3_ = 0; r3_ < 1 + ((S3REP >> (i)) & 1); ++r3_)
#define LAS __attribute__((address_space(3)))
typedef unsigned short bf16_t;
typedef short bf16x8 __attribute__((ext_vector_type(8)));
typedef float f32x4 __attribute__((ext_vector_type(4)));
typedef unsigned u32x4 __attribute__((ext_vector_type(4)));
typedef unsigned u32x2 __attribute__((ext_vector_type(2)));

constexpr int D = 1024, NB = 2, SEQ = 16384, CTXL = 256, SEG = SEQ + CTXL, R = NB * SEG, DEPTH = 2;
constexpr int NPROJ = 2560, DIN = 2576;
constexpr int NTHREADS = 512;
constexpr int LDS_BYTES = 163840;
constexpr int MISC_OFF = 131072;
constexpr int NCLS = 24;

constexpr size_t al256(size_t x) { return (x + 255) & ~size_t(255); }
constexpr size_t WS_CTL = 0;
constexpr size_t WS_M1CNT = 20480;
constexpr size_t WS_TS = 2048;
constexpr size_t WS_BAR = 4096;
constexpr size_t WS_CTL_BYTES = 32768;
constexpr size_t WS_MOD = WS_CTL_BYTES;
constexpr size_t WS_WTIN = WS_MOD + al256((size_t)2 * 3 * 6144 * 4);
constexpr size_t WS_WTOUT = WS_WTIN + al256((size_t)2 * DIN * 1024 * 2);
constexpr size_t WS_WTGU = WS_WTOUT + al256((size_t)2 * 1024 * 1024 * 2);
constexpr size_t WS_WTD = WS_WTGU + al256((size_t)2 * 16 * 512 * 1024 * 2);
constexpr size_t WS_H = WS_WTD + al256((size_t)2 * 16 * 1024 * 256 * 2);
constexpr size_t WS_HX = WS_H + al256((size_t)R * 1024 * 2);
constexpr size_t WS_PROJ = WS_HX + al256((size_t)R * 1024 * 2);
constexpr size_t WS_DT = WS_PROJ + al256((size_t)R * NPROJ * 2);
constexpr size_t WS_POS = WS_DT + al256((size_t)R * 16 * 4);
constexpr size_t WS_LIST = WS_POS + al256((size_t)2 * R * 4);
constexpr size_t WS_CWLA = WS_LIST + al256((size_t)NCLS * R * 4);
constexpr size_t WS_CWLB = WS_CWLA + al256((size_t)NCLS * R * 4);
constexpr size_t WS_BIG = WS_CWLB + al256((size_t)NCLS * R * 4);
constexpr size_t WS_Y = WS_PROJ;
constexpr size_t WS_S = WS_BIG;
constexpr size_t WS_HP = WS_S + al256((size_t)2 * 2 * 130 * 8 * 8192 * 2);
constexpr size_t WS_DEC = WS_HP + al256((size_t)2 * 2 * 130 * 8 * 8192 * 2);
constexpr size_t WS_SSQ = WS_DEC + al256((size_t)2 * 2 * 130 * 8 * 4);
constexpr size_t WS_HID = WS_S;
constexpr size_t WS_END = WS_SSQ + al256((size_t)R * 8 * 4);
static_assert((size_t)(R + NCLS * 256) * 512 * 2 <= (size_t)2 * 2 * 130 * 8 * 8192 * 2, "hid alias");
static_assert(WS_END <= (size_t)512 * 1024 * 1024, "workspace");

struct Params {
    const float *x, *c, *ctx, *c_ctx, *w_ada, *b_ada, *g_mix, *g_ffn, *w_in, *conv_w, *conv_b, *conv_ln_g, *conv_ln_b, *ssd_conv_w, *ssd_conv_b,
        *dt_bias, *a_log, *d_skip, *ssd_norm_g, *w_out, *w_rg, *b_rg, *w_re, *b_re, *w_gate, *w_up, *w_down, *g_final;
    float* out; unsigned char* ws;
};
struct Args { Params p; int lo, hi; };
typedef const __attribute__((address_space(4))) Params* CP;
__device__ __forceinline__ CP launder(CP p) { asm volatile("" : "+s"(p)); return p; }
__device__ __forceinline__ int launder_tid() { int t = threadIdx.x; asm volatile("" : "+v"(t)); return t; }

__device__ __forceinline__ unsigned cvt_pk_bf16(float lo, float hi) { unsigned r; asm("v_cvt_pk_bf16_f32 %0, %1, %2" : "=v"(r) : "v"(lo), "v"(hi)); return r; }
__device__ __forceinline__ float bf2f(unsigned b) { return __uint_as_float(b << 16); }
__device__ __forceinline__ float bflo(unsigned w) { return __uint_as_float(w << 16); }
__device__ __forceinline__ float bfhi(unsigned w) { return __uint_as_float(w & 0xffff0000u); }
__device__ __forceinline__ bf16_t f2bf(float f) { return (bf16_t)(cvt_pk_bf16(f, 0.f) & 0xffffu); }
#define DPP_ADD(v, ctrl, rm) ((v) + __builtin_bit_cast(float, __builtin_amdgcn_update_dpp(0, __builtin_bit_cast(int, (v)), (ctrl), (rm), 0xF, true)))
__device__ __forceinline__ float row_sum16(float v) {
    v = DPP_ADD(v, 0xB1, 0xF);
    v = DPP_ADD(v, 0x4E, 0xF);
    v = DPP_ADD(v, 0x141, 0xF);
    v = DPP_ADD(v, 0x140, 0xF);
    return v;
}
__device__ __forceinline__ float half_sum32(float v) { v = row_sum16(v); v = DPP_ADD(v, 0x142, 0xA); return v; }
__device__ __forceinline__ float wave_sum(float v) {
    v = half_sum32(v); v = DPP_ADD(v, 0x143, 0xC);
    return __builtin_bit_cast(float, __builtin_amdgcn_readlane(__builtin_bit_cast(int, v), 63));
}
__device__ __forceinline__ float sigmoidf_(float x) { return __builtin_amdgcn_rcpf(1.f + __builtin_amdgcn_exp2f(x * -1.44269504089f)); }
__device__ __forceinline__ float siluf_(float x) { return x * __builtin_amdgcn_rcpf(1.f + __builtin_amdgcn_exp2f(x * -1.44269504089f)); }
__device__ __forceinline__ float softplusf_(float x) { return fmaxf(x, 0.f) + __logf(1.f + __expf(-fabsf(x))); }

__device__ __forceinline__ int row_b(int r) { return r >= SEG ? 1 : 0; }
__device__ __forceinline__ int row_i(int r) { return r >= SEG ? r - SEG : r; }
__device__ __forceinline__ int row_v(int r) { const int i = row_i(r); return i < CTXL ? 2 : row_b(r); }
__device__ __forceinline__ const float* xin_ptr(const float* ctx, const float* x, int r) {
    const int b = row_b(r), i = row_i(r);
    return i < CTXL ? ctx + (size_t)(b * CTXL + i) * D : x + (size_t)(b * SEQ + i - CTXL) * D;
}
struct RowRaw { f32x4 f[4]; u32x2 h[4]; };
__device__ __forceinline__ void row_load(CP p, int l, int r, int lane, RowRaw& rr) {
    if (l == 0) { const f32x4* hr = (const f32x4*)xin_ptr(p->ctx, p->x, r);
#pragma unroll
        for (int j = 0; j < 4; ++j) rr.f[j] = __builtin_nontemporal_load(hr + lane + 64 * j); }
    else { const u32x2* hr = (const u32x2*)((const bf16_t*)(p->ws + WS_H) + (size_t)r * D);
#pragma unroll
        for (int j = 0; j < 4; ++j) rr.h[j] = hr[lane + 64 * j]; }
}
__device__ __forceinline__ void row_cvt(int l, const RowRaw& rr, f32x4 (&xv)[4]) {
#pragma unroll
    for (int j = 0; j < 4; ++j) xv[j] = l == 0 ? rr.f[j] : (f32x4){bflo(rr.h[j].x), bfhi(rr.h[j].x), bflo(rr.h[j].y), bfhi(rr.h[j].y)};
}
namespace pg8 {
constexpr int BM = 256, BK = 64, HALF = 128, HTB = HALF * BK * 2, STAGE_BYTES = 8 * HTB, NXCD = 8, WGM = 8;
__device__ __forceinline__ int lds_byte(int r, int c) { const int st = (r >> 4) * 2 + (c >> 5), rr = r & 15, cc = c & 31, ob = rr * 64 + cc * 2; return st * 1024 + (ob ^ (((ob >> 9) & 1) << 5)); }
__device__ __forceinline__ void stage_rc(int b, int& Rr, int& Cc) { const int st = b / 1024, sb = b % 1024, swz = sb ^ (((sb >> 9) & 1) << 5); Rr = (st >> 1) * 16 + swz / 64; Cc = (st & 1) * 32 + (swz % 64) / 2; }
__device__ __forceinline__ int perm32(int rho) { const int n = rho >> 4, i = rho & 15; return 8 * (i >> 2) + 4 * n + (i & 3); }

struct Unit {
    const char* a0;
    const char* b0;
    const char* b1;
    int i0, i1, i2, i3, i4, pad;
};

template <class Epi, class Sched, bool GATHER>
__device__ __forceinline__ void gemm_phase(LAS unsigned char* lds, const int lda, const int ldb, const int K, const Sched& S, const Epi& E) {
    const int tid = launder_tid(); const int wid = __builtin_amdgcn_readfirstlane(tid >> 6), lane = tid & 63, wr = wid >> 2, wc = wid & 3, fr = lane & 15, fq = lane >> 4;
    const int nt = K / BK, ks = nt >> 1;
    int Rr[2], Cc[2];
    unsigned voffB[2];
#pragma unroll
    for (int i = 0; i < 2; ++i) { stage_rc(tid * 16 + i * 8192, Rr[i], Cc[i]); const int Rb = Epi::PERM ? ((Rr[i] & ~31) + perm32(Rr[i] & 31)) : Rr[i];
        voffB[i] = (unsigned)(Rb * ldb + Cc[i]) * 2u; }
    const size_t kstep = (size_t)(BK * 2);
    const size_t hstepB = (size_t)HALF * ldb * 2;
    const unsigned ldsw = (unsigned)wid * 1024u;
    const unsigned ldsbase = (unsigned)(unsigned long)lds;
    const int aoff = lds_byte(wr * 64 + fr, fq * 8), boff = lds_byte(wc * 32 + fr, fq * 8);
#define PG8_SA(b, h) (((b) * 2 + (h)) * HTB)
#define PG8_SB(b, h) ((4 + (b) * 2 + (h)) * HTB)
#define PG8_STAGE2(bufoff, gbase, v0, v1) do { unsigned keep_; \
        asm volatile("s_mov_b32 %0, m0\n\ts_mov_b32 m0, %1\n\ts_nop 4\n\tglobal_load_lds_dwordx4 %2, %4\n\ts_add_u32 m0, m0, 0x2000\n\ts_nop 0\n\tglobal_load_lds_dwordx4 %3, %4\n\ts_mov_b32 m0, %0" \
            : "=&s"(keep_) : "s"(ldsbase + (unsigned)(bufoff) + ldsw), "v"(v0), "v"(v1), "s"(gbase) : "memory", "scc"); } while (0)
#define PG8_LDA(dst, b, h) do { _Pragma("unroll") for (int m = 0; m < 4; ++m) _Pragma("unroll") for (int k = 0; k < 2; ++k) dst[m][k] = *(const LAS bf16x8*)(lds + PG8_SA(b, h) + aoff + m * 2048 + k * 1024); } while (0)
#define PG8_LDB(dst, b, h) do { _Pragma("unroll") for (int n = 0; n < 2; ++n) _Pragma("unroll") for (int k = 0; k < 2; ++k) dst[n][k] = *(const LAS bf16x8*)(lds + PG8_SB(b, h) + boff + n * 2048 + k * 1024); } while (0)
#define PG8_MMA(ai, bj, At, Bt) do { __builtin_amdgcn_s_setprio(1); _Pragma("unroll") for (int m = 0; m < 4; ++m) _Pragma("unroll") for (int n = 0; n < 2; ++n) _Pragma("unroll") for (int k = 0; k < 2; ++k) \
        acc[ai][bj][m][n] = __builtin_amdgcn_mfma_f32_16x16x32_bf16(Bt[n][k], At[m][k], acc[ai][bj][m][n], 0, 0, 0); __builtin_amdgcn_s_setprio(0); } while (0)
#define PG8_WAIT_V(n) asm volatile("s_waitcnt vmcnt(" #n ")" ::: "memory")
#define PG8_WAIT_L(n) asm volatile("s_waitcnt lgkmcnt(" #n ")" ::: "memory")
#define PG8_BAR __builtin_amdgcn_s_barrier()
#define PG8_SCHED __builtin_amdgcn_sched_barrier(0)
#define PG8_BP(u, tt) ((tt) < ks ? (u).b0 + (size_t)(tt) * kstep : (u).b1 + (size_t)((tt) - ks) * kstep)
    Unit cur, nxt; int ui = 0;
    if (!S.get(0, cur)) return;
    S.a_ready(cur);
    unsigned c00, c01, c10, c11, n00, n01, n10, n11;
    if (GATHER) {
        c00 = (unsigned)(S.arow(cur, Rr[0]) * lda + Cc[0]) * 2u; c01 = (unsigned)(S.arow(cur, Rr[1]) * lda + Cc[1]) * 2u;
        c10 = (unsigned)(S.arow(cur, HALF + Rr[0]) * lda + Cc[0]) * 2u; c11 = (unsigned)(S.arow(cur, HALF + Rr[1]) * lda + Cc[1]) * 2u;
    } else {
        c00 = (unsigned)(Rr[0] * lda + Cc[0]) * 2u; c01 = (unsigned)(Rr[1] * lda + Cc[1]) * 2u;
        c10 = (unsigned)((HALF + Rr[0]) * lda + Cc[0]) * 2u; c11 = (unsigned)((HALF + Rr[1]) * lda + Cc[1]) * 2u;
    }
    n00 = c00; n01 = c01; n10 = c10; n11 = c11;
    f32x4 acc[2][2][4][2];
    float zr; asm volatile("v_mov_b32 %0, 0" : "=v"(zr));
#pragma unroll
    for (int a = 0; a < 2; ++a)
#pragma unroll
        for (int b = 0; b < 2; ++b)
#pragma unroll
            for (int m = 0; m < 4; ++m)
#pragma unroll
                for (int n = 0; n < 2; ++n) acc[a][b][m][n] = (f32x4){zr, zr, zr, zr};
    bf16x8 At[4][2], B0[2][2], B1[2][2];
    const char* cA = cur.a0;
    {
        const char* pb0 = PG8_BP(cur, 0); const char* pb1 = PG8_BP(cur, 1);
        PG8_STAGE2(PG8_SB(0, 0), pb0, voffB[0], voffB[1]); PG8_STAGE2(PG8_SA(0, 0), cA, c00, c01);
        PG8_STAGE2(PG8_SB(0, 1), pb0 + hstepB, voffB[0], voffB[1]); PG8_STAGE2(PG8_SA(0, 1), cA, c10, c11);
        if (wr == 1) PG8_BAR;
        PG8_WAIT_V(4); PG8_BAR;
        PG8_STAGE2(PG8_SB(1, 0), pb1, voffB[0], voffB[1]); PG8_STAGE2(PG8_SA(1, 0), cA + kstep, c00, c01);
        PG8_STAGE2(PG8_SB(1, 1), pb1 + hstepB, voffB[0], voffB[1]);
        PG8_WAIT_V(6); PG8_BAR;
    }
    for (;;) {
        const bool has_next = S.get(ui + 1, nxt);
        if (!has_next) nxt = cur;
        LAS int* tokb = (LAS int*)(lds + MISC_OFF + 1024) + ((ui + 1) & 1) * 256;
        if (GATHER) {
            n00 = c00; n01 = c01; n10 = c10; n11 = c11;
            if (has_next && wid == 0) {
                const char* src = (const char*)S.rows_ptr(nxt); unsigned keep_;
                asm volatile("s_mov_b32 %0, m0\n\ts_mov_b32 m0, %1\n\ts_nop 4\n\tglobal_load_lds_dwordx4 %2, %3\n\ts_mov_b32 m0, %0"
                    : "=&s"(keep_) : "s"((unsigned)(unsigned long)tokb), "v"((unsigned)lane * 16u), "s"(src) : "memory");
            }
        }
        const char* nA = nxt.a0;
#pragma unroll 1
        for (int t = 0; t < nt; t += 2) {
            const bool last = (t == nt - 2);
            if (last && has_next) S.a_ready(nxt);
            const char* a1 = cA + (size_t)(t + 1) * kstep;
            const char* a2 = last ? nA : cA + (size_t)(t + 2) * kstep;
            const char* a3 = a2 + kstep;
            const char* b2 = last ? PG8_BP(nxt, 0) : PG8_BP(cur, t + 2);
            const char* b3 = last ? PG8_BP(nxt, 1) : PG8_BP(cur, t + 3);
            if (GATHER) { if (last && has_next) {
                const int lim = S.rows_valid(nxt) - 1;
                const int i0 = Rr[0] < lim ? Rr[0] : lim, i1 = Rr[1] < lim ? Rr[1] : lim, i2 = (HALF + Rr[0]) < lim ? (HALF + Rr[0]) : lim, i3 = (HALF + Rr[1]) < lim ? (HALF + Rr[1]) : lim;
                n00 = (unsigned)(tokb[i0] * lda + Cc[0]) * 2u; n01 = (unsigned)(tokb[i1] * lda + Cc[1]) * 2u;
                n10 = (unsigned)(tokb[i2] * lda + Cc[0]) * 2u; n11 = (unsigned)(tokb[i3] * lda + Cc[1]) * 2u; } }
            const unsigned s00 = last ? n00 : c00, s01 = last ? n01 : c01, s10 = last ? n10 : c10, s11 = last ? n11 : c11;
            if constexpr (Epi::MIDSCALE) { if (t == ks) E.midscale(acc, cur, wr, wc, fr, fq); }
            PG8_LDB(B0, 0, 0); PG8_SCHED; PG8_LDA(At, 0, 0); PG8_STAGE2(PG8_SA(1, 1), a1, c10, c11);
            PG8_WAIT_L(8); PG8_BAR; PG8_WAIT_L(0); PG8_MMA(0, 0, At, B0); PG8_BAR; PG8_SCHED;
            PG8_LDB(B1, 0, 1); PG8_STAGE2(PG8_SB(0, 0), b2, voffB[0], voffB[1]);
            PG8_BAR; PG8_WAIT_L(0); PG8_MMA(0, 1, At, B1); PG8_BAR;
            PG8_LDA(At, 0, 1); PG8_STAGE2(PG8_SA(0, 0), a2, s00, s01);
            PG8_BAR; PG8_WAIT_L(0); PG8_MMA(1, 0, At, B0); PG8_BAR; PG8_SCHED;
            PG8_STAGE2(PG8_SB(0, 1), b2 + hstepB, voffB[0], voffB[1]);
            PG8_WAIT_V(6); PG8_BAR; PG8_MMA(1, 1, At, B1); PG8_BAR;
            PG8_LDB(B0, 1, 0); PG8_SCHED; PG8_LDA(At, 1, 0); PG8_STAGE2(PG8_SA(0, 1), a2, s10, s11);
            PG8_WAIT_L(8); PG8_BAR; PG8_WAIT_L(0); PG8_MMA(0, 0, At, B0); PG8_BAR; PG8_SCHED;
            PG8_LDB(B1, 1, 1); PG8_STAGE2(PG8_SB(1, 0), b3, voffB[0], voffB[1]);
            PG8_BAR; PG8_WAIT_L(0); PG8_MMA(0, 1, At, B1); PG8_BAR;
            PG8_LDA(At, 1, 1); PG8_STAGE2(PG8_SA(1, 0), a3, s00, s01);
            PG8_BAR; PG8_WAIT_L(0); PG8_MMA(1, 0, At, B0); PG8_BAR; PG8_SCHED;
            PG8_STAGE2(PG8_SB(1, 1), b3 + hstepB, voffB[0], voffB[1]);
            PG8_WAIT_V(6); PG8_BAR; PG8_MMA(1, 1, At, B1); PG8_BAR;
        }
        E(acc, cur, wr, wc, fr, fq);
        if (!has_next) break;
        asm volatile("v_mov_b32 %0, 0" : "=v"(zr));
#pragma unroll
        for (int a = 0; a < 2; ++a)
#pragma unroll
            for (int b = 0; b < 2; ++b)
#pragma unroll
                for (int m = 0; m < 4; ++m)
#pragma unroll
                    for (int n = 0; n < 2; ++n) acc[a][b][m][n] = (f32x4){zr, zr, zr, zr};
        cur = nxt; cA = nA; ++ui; c00 = n00; c01 = n01; c10 = n10; c11 = n11;
    }
    PG8_WAIT_V(0);
    if (wr == 0) PG8_BAR;
    PG8_BAR;
#undef PG8_SA
#undef PG8_SB
#undef PG8_STAGE2
#undef PG8_LDA
#undef PG8_LDB
#undef PG8_MMA
#undef PG8_WAIT_V
#undef PG8_WAIT_L
#undef PG8_BAR
#undef PG8_SCHED
#undef PG8_BP
}

struct DenseSched {
    const char* A; const char* Bt; int lda, ldb, K; int nM, nN, nwg, G, c, skipctx;
    __device__ __forceinline__ void init(const void* A_, const void* Bt_, int M, int N, int K_, int lda_, int ldb_, int G_, int c_, int skipctx_ = 0) {
        A = (const char*)A_; Bt = (const char*)Bt_; lda = lda_; ldb = ldb_; K = K_; nM = M / BM - 2 * skipctx_; nN = N / BM; nwg = nM * nN; G = G_; c = c_; skipctx = skipctx_; }
    __device__ __forceinline__ bool get(int i, Unit& u) const {
        const long L = (long)i * G + c; if (L >= nwg) return false;
        int wgid = (int)L; { const int q = nwg / NXCD, r = nwg % NXCD, xcd = wgid % NXCD, off = wgid / NXCD; wgid = (xcd < r ? xcd * (q + 1) : r * (q + 1) + (xcd - r) * q) + off; }
        const int nig = WGM * nN, gid = wgid / nig, fm = gid * WGM, gsz = (nM - fm) < WGM ? (nM - fm) : WGM;
        int pm = fm + ((wgid % nig) % gsz); const int pn = (wgid % nig) / gsz;
        if (skipctx) pm += 1 + (pm >= 64 ? 1 : 0);
        u.a0 = A + (size_t)pm * BM * lda * 2; u.b0 = Bt + (size_t)pn * BM * ldb * 2; u.b1 = u.b0 + (size_t)(K / BK / 2) * BK * 2;
        u.i0 = pm; u.i1 = pn; u.i2 = 0; u.i3 = 0; u.i4 = 0; u.pad = 0; return true;
    }
    __device__ __forceinline__ void a_ready(const Unit&) const {}
    __device__ __forceinline__ int arow(const Unit&, int rl) const { return rl; }
    __device__ __forceinline__ const int* rows_ptr(const Unit&) const { return nullptr; }
    __device__ __forceinline__ int rows_valid(const Unit&) const { return 256; }
};
}

struct EpiProj {
    static constexpr bool PERM = true, MIDSCALE = false;
    bf16_t* O;
    __device__ __forceinline__ void operator()(const f32x4 (&acc)[2][2][4][2], const pg8::Unit& u, int wr, int wc, int fr, int fq) const {
        const int pn = u.i1;
        const int row0 = u.i0 * 256 + wr * 64 + fr;
        if (pn < 4) {
            const int col0 = pn * 128 + wc * 32 + 8 * fq;
#pragma unroll
            for (int ai = 0; ai < 2; ++ai)
#pragma unroll
                for (int m = 0; m < 4; ++m) { const f32x4 u0 = acc[ai][0][m][0], u1 = acc[ai][0][m][1], g0 = acc[ai][1][m][0], g1 = acc[ai][1][m][1];
                    u32x4 w; w.x = cvt_pk_bf16(u0[0] * sigmoidf_(g0[0]), u0[1] * sigmoidf_(g0[1])); w.y = cvt_pk_bf16(u0[2] * sigmoidf_(g0[2]), u0[3] * sigmoidf_(g0[3]));
                    w.z = cvt_pk_bf16(u1[0] * sigmoidf_(g1[0]), u1[1] * sigmoidf_(g1[1])); w.w = cvt_pk_bf16(u1[2] * sigmoidf_(g1[2]), u1[3] * sigmoidf_(g1[3]));
                    __builtin_nontemporal_store(w, (u32x4*)(O + (size_t)(row0 + ai * 128 + m * 16) * NPROJ + col0)); }
        } else {
            const int col0 = pn * 256 + wc * 32 + 8 * fq; const bool sl = pn < 6;
#pragma unroll
            for (int ai = 0; ai < 2; ++ai)
#pragma unroll
                for (int m = 0; m < 4; ++m) { bf16_t* rowp = O + (size_t)(row0 + ai * 128 + m * 16) * NPROJ + col0;
#pragma unroll
                    for (int bj = 0; bj < 2; ++bj) { f32x4 v0 = acc[ai][bj][m][0], v1 = acc[ai][bj][m][1];
                        if (sl) {
#pragma unroll
                            for (int e = 0; e < 4; ++e) { v0[e] = siluf_(v0[e]); v1[e] = siluf_(v1[e]); } }
                        u32x4 w; w.x = cvt_pk_bf16(v0[0], v0[1]); w.y = cvt_pk_bf16(v0[2], v0[3]); w.z = cvt_pk_bf16(v1[0], v1[1]); w.w = cvt_pk_bf16(v1[2], v1[3]);
                        __builtin_nontemporal_store(w, (u32x4*)(rowp + bj * 128)); } }
        }
    }
};
template <int L0> struct EpiResid {
    static constexpr bool PERM = true, MIDSCALE = true;
    const float* inc; const float* inx; bf16_t* H; const float* modl; const float* ssq;
    __device__ __forceinline__ void midscale(f32x4 (&acc)[2][2][4][2], const pg8::Unit& u, int wr, int wc, int fr, int fq) const {
        typedef float f32x2 __attribute__((ext_vector_type(2)));
        const int r0 = u.i0 * 256 + wr * 64 + fr;
        f32x2 part[2][4];
#pragma unroll
        for (int ai = 0; ai < 2; ++ai)
#pragma unroll
            for (int m = 0; m < 4; ++m) part[ai][m] = *(const f32x2*)(ssq + (size_t)(r0 + ai * 128 + m * 16) * 8 + 2 * fq);
#pragma unroll
        for (int ai = 0; ai < 2; ++ai)
#pragma unroll
            for (int m = 0; m < 4; ++m) { float sq = part[ai][m][0] + part[ai][m][1];
                sq += __shfl_xor(sq, 16); sq += __shfl_xor(sq, 32);
                const float rs = rsqrtf(sq * (1.f / 512.f) + 1e-6f);
#pragma unroll
                for (int bj = 0; bj < 2; ++bj)
#pragma unroll
                    for (int n = 0; n < 2; ++n) acc[ai][bj][m][n] *= rs; }
    }
    __device__ __forceinline__ void operator()(const f32x4 (&acc)[2][2][4][2], const pg8::Unit& u, int wr, int wc, int fr, int fq) const {
        const int r0 = u.i0 * 256;
        const int v = row_v(r0);
        const float* gate = modl + (size_t)v * 6144 + 2 * 1024;
        const float* xin = xin_ptr(inc, inx, r0);
        const int rl0 = wr * 64 + fr, col0 = u.i1 * 256 + wc * 32 + 8 * fq;
        f32x4 gv[2][2];
#pragma unroll
        for (int bj = 0; bj < 2; ++bj)
#pragma unroll
            for (int n = 0; n < 2; ++n) gv[bj][n] = *(const f32x4*)(gate + col0 + bj * 128 + 4 * n);
#pragma unroll
        for (int ai = 0; ai < 2; ++ai) {
            u32x4 hr[4][2];
#pragma unroll
            for (int m = 0; m < 4; ++m)
#pragma unroll
                for (int bj = 0; bj < 2; ++bj) hr[m][bj] = *(const u32x4*)(H + (size_t)(r0 + rl0 + ai * 128 + m * 16) * D + col0 + bj * 128);
#pragma unroll
            for (int m = 0; m < 4; ++m)
#pragma unroll
                for (int bj = 0; bj < 2; ++bj) { const u32x4 hv = hr[m][bj]; const f32x4 a0 = acc[ai][bj][m][0], a1 = acc[ai][bj][m][1]; const f32x4 g0 = gv[bj][0], g1 = gv[bj][1];
                    u32x4 w;
                    w.x = cvt_pk_bf16(bflo(hv.x) + g0[0] * a0[0], bfhi(hv.x) + g0[1] * a0[1]); w.y = cvt_pk_bf16(bflo(hv.y) + g0[2] * a0[2], bfhi(hv.y) + g0[3] * a0[3]);
                    w.z = cvt_pk_bf16(bflo(hv.z) + g1[0] * a1[0], bfhi(hv.z) + g1[1] * a1[1]); w.w = cvt_pk_bf16(bflo(hv.w) + g1[2] * a1[2], bfhi(hv.w) + g1[3] * a1[3]);
                    *(u32x4*)(H + (size_t)(r0 + rl0 + ai * 128 + m * 16) * D + col0 + bj * 128) = w; }
            asm volatile("" ::: "memory"); }
    }
};

__device__ __forceinline__ const char* uniform_ptr(const char* q) {
    const unsigned long long v = (unsigned long long)q;
    const unsigned lo = __builtin_amdgcn_readfirstlane((unsigned)v), hi = __builtin_amdgcn_readfirstlane((unsigned)(v >> 32));
    return (const char*)(((unsigned long long)hi << 32) | lo);
}
struct MoeSched {
    const LAS int* tab;
    const int* list;
    const char* A; const char* W; int mode  , l, G, c;
    unsigned* ready;
    __device__ __forceinline__ void a_ready(const pg8::Unit& u) const {
        if (mode == 0) return;
        if (threadIdx.x < 64) {
            unsigned* w = ready + u.i4; unsigned spins = 0;
            while ((unsigned)__builtin_amdgcn_readfirstlane((int)__hip_atomic_load(w, __ATOMIC_RELAXED, __HIP_MEMORY_SCOPE_AGENT)) < 32u) {
                __builtin_amdgcn_s_sleep(2); if (++spins > (1u << 22)) break; }
            __builtin_amdgcn_fence(__ATOMIC_ACQUIRE, "agent");
            asm volatile("s_waitcnt vmcnt(0)" ::: "memory");
        }
        asm volatile("" ::: "memory"); __builtin_amdgcn_s_barrier(); asm volatile("" ::: "memory");
    }
    int late;
    __device__ __forceinline__ bool get(int i, pg8::Unit& u) const {
        const int total = __builtin_amdgcn_readfirstlane(tab[24]) * 4;
        int L;
        if (mode == 0 || late == 0) L = i * G + c;
        else if (c < late) { if (i > 0) return false; L = c; }
        else L = late + (c - late) + i * (G - late);
        if (L >= total) return false;
        const int tl = L >> 2, pn = L & 3;
        int cls = 0;
#pragma unroll 1
        for (int q = 1; q < NCLS; ++q) { const int tq = __builtin_amdgcn_readfirstlane(tab[q]); if (tq <= tl) cls = q; }
        const int j = tl - __builtin_amdgcn_readfirstlane(tab[cls]), cnt = __builtin_amdgcn_readfirstlane(tab[32 + cls]);
        const int g = cls / 6, pidx = cls - g * 6;
        const int ea = (pidx >= 3) + (pidx >= 5), eb = pidx < 3 ? pidx + 1 : (pidx < 5 ? pidx - 1 : 3);
        if (mode == 0) {
            const int e = 4 * g + (pn < 2 ? ea : eb);
            u.a0 = A;
            u.b0 = W + ((size_t)(l * 16 + e) * 512 + (size_t)(pn & 1) * 256) * 1024 * 2; u.b1 = u.b0 + (size_t)8 * 128;
        } else {
            u.a0 = A + (size_t)tl * 256 * 512 * 2;
            u.b0 = W + ((size_t)(l * 16 + 4 * g + ea) * 1024 + (size_t)pn * 256) * 256 * 2;
            u.b1 = W + ((size_t)(l * 16 + 4 * g + eb) * 1024 + (size_t)pn * 256) * 256 * 2;
        }
        u.a0 = uniform_ptr(u.a0); u.b0 = uniform_ptr(u.b0); u.b1 = uniform_ptr(u.b1);
        u.i0 = cls; u.i1 = j; u.i2 = pn; u.i3 = cnt; u.i4 = tl; u.pad = 0; return true;
    }
    __device__ __forceinline__ int arow(const pg8::Unit& u, int rl) const {
        int idx = u.i1 * 256 + rl; idx = idx < u.i3 ? idx : u.i3 - 1;
        return list[(size_t)u.i0 * R + idx];
    }
    __device__ __forceinline__ const int* rows_ptr(const pg8::Unit& u) const { return list + (size_t)u.i0 * R + u.i1 * 256; }
    __device__ __forceinline__ int rows_valid(const pg8::Unit& u) const { return u.i3 - u.i1 * 256; }
};
struct EpiUp {
    static constexpr bool PERM = true, MIDSCALE = false;
    bf16_t* hid; const float* cwla; const float* cwlb; unsigned* ready;
    __device__ __forceinline__ void operator()(const f32x4 (&acc)[2][2][4][2], const pg8::Unit& u, int wr, int wc, int fr, int fq) const {
        const int cls = u.i0, j = u.i1, pn = u.i2, cnt = u.i3, tl = u.i4;
        const float* cw = (pn < 2) ? cwla : cwlb;
        const int colbase = (pn >> 1) * 256 + (pn & 1) * 128 + wc * 32 + 8 * fq;
        float wrow[2][4];
#pragma unroll
        for (int ai = 0; ai < 2; ++ai)
#pragma unroll
            for (int m = 0; m < 4; ++m) { const int idx = j * 256 + ai * 128 + wr * 64 + m * 16 + fr; wrow[ai][m] = idx < cnt ? cw[(size_t)cls * R + idx] : 0.f; }
#pragma unroll
        for (int ai = 0; ai < 2; ++ai)
#pragma unroll
            for (int m = 0; m < 4; ++m) {
                const int rl = ai * 128 + wr * 64 + m * 16 + fr; const int idx = j * 256 + rl; const bool valid = idx < cnt;
                const float w = wrow[ai][m];
                const f32x4 g0 = acc[ai][0][m][0], g1 = acc[ai][0][m][1], u0 = acc[ai][1][m][0], u1 = acc[ai][1][m][1];
                float o[8];
#pragma unroll
                for (int e = 0; e < 4; ++e) { o[e] = w * siluf_(g0[e]) * u0[e]; o[4 + e] = w * siluf_(g1[e]) * u1[e]; }
                if (!valid) {
#pragma unroll
                    for (int e = 0; e < 8; ++e) o[e] = 0.f; }
                u32x4 pk; pk.x = cvt_pk_bf16(o[0], o[1]); pk.y = cvt_pk_bf16(o[2], o[3]); pk.z = cvt_pk_bf16(o[4], o[5]); pk.w = cvt_pk_bf16(o[6], o[7]);
                { bf16_t* dstp = hid + ((size_t)tl * 256 + rl) * 512 + colbase;
                  asm volatile("global_store_dwordx4 %0, %1, off sc1\n\ts_nop 1" :: "v"(dstp), "v"(pk) : "memory"); }
            }
        asm volatile("s_waitcnt vmcnt(0)" ::: "memory");
        if ((threadIdx.x & 63) == 0) __hip_atomic_fetch_add(ready + tl, 1u, __ATOMIC_RELAXED, __HIP_MEMORY_SCOPE_AGENT);
    }
};
struct EpiDown {
    static constexpr bool PERM = true, MIDSCALE = false;
    bf16_t* H; const int* list; const LAS float* gl;
    __device__ __forceinline__ void operator()(const f32x4 (&acc)[2][2][4][2], const pg8::Unit& u, int wr, int wc, int fr, int fq) const {
        const int cls = u.i0, j = u.i1, pn = u.i2, cnt = u.i3;
        const int col0 = pn * 256 + wc * 32 + 8 * fq;
        int tok[2][4];
#pragma unroll
        for (int ai = 0; ai < 2; ++ai)
#pragma unroll
            for (int m = 0; m < 4; ++m) { const int idx = j * 256 + ai * 128 + wr * 64 + m * 16 + fr; tok[ai][m] = idx < cnt ? list[(size_t)cls * R + idx] : -1; }
#pragma unroll
        for (int ai = 0; ai < 2; ++ai)
#pragma unroll
          for (int mp = 0; mp < 2; ++mp) {
            u32x4 hr[2][2];
#pragma unroll
            for (int mm = 0; mm < 2; ++mm) { const int t = tok[ai][2 * mp + mm]; const bf16_t* hp = H + (size_t)(t < 0 ? 0 : t) * D + col0;
#pragma unroll
                for (int bj = 0; bj < 2; ++bj) hr[mm][bj] = *(const u32x4*)(hp + bj * 128); }
#pragma unroll
            for (int mm = 0; mm < 2; ++mm) { const int m = 2 * mp + mm; const int t = tok[ai][m];
                if (t >= 0) { const LAS float* gp = gl + row_v(t) * 1024 + col0;
#pragma unroll
                    for (int bj = 0; bj < 2; ++bj) { const u32x4 hv = hr[mm][bj]; const f32x4 a0 = acc[ai][bj][m][0], a1 = acc[ai][bj][m][1];
                        const f32x4 g0 = *(const LAS f32x4*)(gp + bj * 128), g1 = *(const LAS f32x4*)(gp + bj * 128 + 4);
                        u32x4 w;
                        w.x = cvt_pk_bf16(bflo(hv.x) + g0[0] * a0[0], bfhi(hv.x) + g0[1] * a0[1]); w.y = cvt_pk_bf16(bflo(hv.y) + g0[2] * a0[2], bfhi(hv.y) + g0[3] * a0[3]);
                        w.z = cvt_pk_bf16(bflo(hv.z) + g1[0] * a1[0], bfhi(hv.z) + g1[1] * a1[1]); w.w = cvt_pk_bf16(bflo(hv.w) + g1[2] * a1[2], bfhi(hv.w) + g1[3] * a1[3]);
                        *(u32x4*)(H + (size_t)t * D + col0 + bj * 128) = w; } } }
            asm volatile("" ::: "memory"); }
    }
};

__device__ __forceinline__ void tr_tile(const float* src, int ldn, int k0, int n0, int nvalid, bf16_t* dst, int ldk, int drow0, LAS float* tile, int kd0 = -1, const float* kscale = nullptr) {
    const int tid = launder_tid();
    if (kd0 < 0) kd0 = k0;
    { const int n = tid & 63; const int kq = tid >> 6; float tv[8], ts[8];
#pragma unroll
      for (int it = 0; it < 8; ++it) { const int kk = kq + 8 * it; tv[it] = (n < nvalid) ? src[(size_t)(k0 + kk) * ldn + n0 + n] : 0.f; ts[it] = kscale ? kscale[kk] : 1.f; }
#pragma unroll
      for (int it = 0; it < 8; ++it) tile[(kq + 8 * it) * 65 + n] = tv[it] * ts[it]; }
    __syncthreads();
    { const int k8 = tid & 7, n = tid >> 3;
      if (n < nvalid) { const LAS float* s = tile + (k8 * 8) * 65 + n;
          u32x4 o; o.x = cvt_pk_bf16(s[0], s[65]); o.y = cvt_pk_bf16(s[2 * 65], s[3 * 65]); o.z = cvt_pk_bf16(s[4 * 65], s[5 * 65]); o.w = cvt_pk_bf16(s[6 * 65], s[7 * 65]);
          *(u32x4*)(dst + (size_t)(drow0 + n) * ldk + kd0 + k8 * 8) = o; } }
    __syncthreads();
}
constexpr int WPREP_ITEMS_PER_LAYER = 16 * 41 + 256 + 1024 + 1024 + 1024;
__device__ __forceinline__ void phase_wprep(CP p, unsigned char* lds, int it0, int it1, int bidx, int nblk, int b0 = 0, int b1 = 0, int c0 = 0, int c1 = 0) {
    LAS float* tile = (LAS float*)(LAS unsigned char*)lds;
    constexpr int I_IN = 16 * 41, I_OUT = 256, I_G = 1024, I_U = 1024, I_D = 1024, I_L = I_IN + I_OUT + I_G + I_U + I_D;
    const int na = it1 - it0, nbb = b1 - b0, ncc = c1 - c0;
    for (int vi = bidx; vi < na + nbb + ncc; vi += nblk) {
        const int it = vi < na ? it0 + vi : (vi < na + nbb ? b0 + (vi - na) : c0 + (vi - na - nbb));
        const int l = it / I_L; int r = it - l * I_L;
        if (r < I_IN) { const int kt = r / 41, ntl = r % 41; const int n0 = ntl * 64; const int nv = (DIN - n0) < 64 ? (DIN - n0) : 64;
            const int dr = n0 < 512 ? (n0 >> 7) * 256 + (n0 & 127) : (n0 < 1024 ? ((n0 - 512) >> 7) * 256 + 128 + ((n0 - 512) & 127) : n0);
            tr_tile(p->w_in + (size_t)l * 1024 * DIN, DIN, kt * 64, n0, nv, (bf16_t*)(p->ws + WS_WTIN) + (size_t)l * DIN * 1024, 1024, dr, tile); continue; }
        r -= I_IN;
        if (r < I_OUT) { const int kt = r >> 4, ntl = r & 15;
            tr_tile(p->w_out + (size_t)l * 1024 * 1024, 1024, kt * 64, ntl * 64, 64, (bf16_t*)(p->ws + WS_WTOUT) + (size_t)l * 1024 * 1024, 1024, ntl * 64, tile,
                    (kt * 64 + 512) & 1023, kt >= 8 ? p->ssd_norm_g + l * 512 + (kt * 64 - 512) : nullptr); continue; }
        r -= I_OUT;
        if (r < I_G + I_U) { const int up = r >= I_G; if (up) r -= I_G; const int e = r >> 6, q = r & 63, kt = q >> 2, ntl = q & 3; const int n0 = ntl * 64;
            const float* src = (up ? p->w_up : p->w_gate) + (size_t)(l * 16 + e) * 1024 * 256;
            tr_tile(src, 256, kt * 64, n0, 64, (bf16_t*)(p->ws + WS_WTGU) + (size_t)(l * 16 + e) * 512 * 1024, 1024, (n0 >> 7) * 256 + (n0 & 127) + (up ? 128 : 0), tile); continue; }
        r -= I_G + I_U;
        { const int e = r >> 6, q = r & 63, kt = q >> 4, ntl = q & 15;
          tr_tile(p->w_down + (size_t)(l * 16 + e) * 256 * 1024, 1024, kt * 64, ntl * 64, 64, (bf16_t*)(p->ws + WS_WTD) + (size_t)(l * 16 + e) * 1024 * 256, 256, ntl * 64, tile); }
    }
}
__device__ __forceinline__ void phase_adaln(CP p, unsigned char* lds, int bid, int nb) {
    LAS float* sc = (LAS float*)(LAS unsigned char*)lds;
    LAS float* red = sc + 3 * 1024;
    const int tid = launder_tid();
    for (int idx = tid; idx < 3 * 1024; idx += NTHREADS) { const int v = idx >> 10, k = idx & 1023; const float cv = (v < 2) ? p->c[v * 1024 + k] : p->c_ctx[k]; sc[idx] = siluf_(cv); }
    __syncthreads();
    float* mod = (float*)(p->ws + WS_MOD);
    for (int it = bid; it < 2 * 96; it += nb) {
        const int l = it / 96, n0 = (it % 96) * 64;
        const int c4 = tid & 15, kr = tid >> 4;
        f32x4 a0 = {0, 0, 0, 0}, a1 = {0, 0, 0, 0}, a2 = {0, 0, 0, 0};
        const float* w = p->w_ada + (size_t)l * 1024 * 6144 + n0 + c4 * 4;
#pragma unroll 4
        for (int k = kr; k < 1024; k += 32) { const f32x4 w4 = *(const f32x4*)(w + (size_t)k * 6144); a0 += sc[k] * w4; a1 += sc[1024 + k] * w4; a2 += sc[2048 + k] * w4; }
        *(LAS f32x4*)(red + (kr * 3 + 0) * 64 + c4 * 4) = a0; *(LAS f32x4*)(red + (kr * 3 + 1) * 64 + c4 * 4) = a1; *(LAS f32x4*)(red + (kr * 3 + 2) * 64 + c4 * 4) = a2;
        __syncthreads();
        if (tid < 192) { const int v = tid >> 6, cc = tid & 63; float s = 0.f;
            for (int q = 0; q < 32; ++q) s += red[(q * 3 + v) * 64 + cc];
            mod[((size_t)l * 3 + v) * 6144 + n0 + cc] = s + p->b_ada[l * 6144 + n0 + cc]; }
        __syncthreads();
    }
}
__device__ __forceinline__ void moe_table(CP p, int l, LAS int* tab) {
    const int* gcount = (const int*)(p->ws + WS_CTL) + l * 32;
    if (threadIdx.x == 0) { int acc = 0; for (int q = 0; q < NCLS; ++q) { const int cn = gcount[q]; tab[q] = acc; tab[32 + q] = cn; acc += (cn + 255) >> 8; } tab[24] = acc; }
    __syncthreads();
}
typedef _Float16 f16x8 __attribute__((ext_vector_type(8)));
typedef _Float16 f16x2 __attribute__((ext_vector_type(2)));
constexpr int ST_H16 = 2064;
__device__ __forceinline__ unsigned pack_f16(float a, float b) { f16x2 h; h[0] = (_Float16)a; h[1] = (_Float16)b; return __builtin_bit_cast(unsigned, h); }
__device__ __forceinline__ void phase_r1(CP p, int l, unsigned char* lds_, int bid, int nb) {
    LAS unsigned char* lds = (LAS unsigned char*)lds_;
    LAS unsigned char* Wh = lds;
    LAS unsigned char* Xh = Wh + 16 * ST_H16;
    LAS float* gm = (LAS float*)(Xh + 16 * ST_H16);
    LAS float* sh = gm + 3 * 1024;
    LAS float* part = sh + 3 * 1024;
    const int tid = launder_tid(); const int lane = tid & 63, wave = __builtin_amdgcn_readfirstlane(tid >> 6);
    const float* mod = (const float*)(p->ws + WS_MOD) + (size_t)l * 3 * 6144;
    const float* win = p->w_in + (size_t)l * 1024 * DIN;
#pragma unroll
    for (int hb = 0; hb < 2; ++hb) { float tmp[16];
#pragma unroll
        for (int it = 0; it < 16; ++it) { const int idx = tid + NTHREADS * (16 * hb + it); tmp[it] = win[(size_t)(idx >> 4) * DIN + NPROJ + (idx & 15)]; }
#pragma unroll
        for (int it = 0; it < 16; ++it) { const int idx = tid + NTHREADS * (16 * hb + it); *(LAS _Float16*)(Wh + (idx & 15) * ST_H16 + (idx >> 4) * 2) = (_Float16)tmp[it]; } }
    { float t0[6], t1[6], t2[6];
#pragma unroll
      for (int it = 0; it < 6; ++it) { const int idx = tid + NTHREADS * it; const int v = idx >> 10, k = idx & 1023; t0[it] = p->g_mix[l * 1024 + k]; t1[it] = mod[v * 6144 + 1024 + k]; t2[it] = mod[v * 6144 + k]; }
#pragma unroll
      for (int it = 0; it < 6; ++it) { const int idx = tid + NTHREADS * it; gm[idx] = t0[it] * (1.f + t1[it]); sh[idx] = t2[it]; } }
    __syncthreads();
    bf16_t* HX = (bf16_t*)(p->ws + WS_HX); float* DT = (float*)(p->ws + WS_DT);
    const int rpb = (R + nb - 1) / nb, r0 = bid * rpb, r1 = (r0 + rpb) < R ? (r0 + rpb) : R;
    RowRaw xn[2];
#pragma unroll
    for (int q = 0; q < 2; ++q) if (r0 + 2 * wave + q < r1) row_load(p, l, r0 + 2 * wave + q, lane, xn[q]);
#pragma unroll 1
    for (int t0r = r0; t0r < r1; t0r += 16) {
        f32x4 xv[2][4];
#pragma unroll
        for (int q = 0; q < 2; ++q) row_cvt(l, xn[q], xv[q]);
#pragma unroll
        for (int q = 0; q < 2; ++q) if (t0r + 16 + 2 * wave + q < r1) row_load(p, l, t0r + 16 + 2 * wave + q, lane, xn[q]);
#pragma unroll
        for (int q = 0; q < 2; ++q) { const int rr = t0r + 2 * wave + q; const bool ok = rr < r1; const int v = row_v(ok ? rr : r0);
            if (l == 0 && ok) { u32x2* hw = (u32x2*)((bf16_t*)(p->ws + WS_H) + (size_t)rr * D);
#pragma unroll
                for (int j = 0; j < 4; ++j) { u32x2 o; o.x = cvt_pk_bf16(xv[q][j][0], xv[q][j][1]); o.y = cvt_pk_bf16(xv[q][j][2], xv[q][j][3]); hw[lane + 64 * j] = o; } }
            float ss = 0.f;
#pragma unroll
            for (int j = 0; j < 4; ++j) ss += xv[q][j][0] * xv[q][j][0] + xv[q][j][1] * xv[q][j][1] + xv[q][j][2] * xv[q][j][2] + xv[q][j][3] * xv[q][j][3];
            ss = wave_sum(ss); const float rs = ok ? __builtin_amdgcn_rsqf(ss * (1.f / 1024.f) + 1e-6f) : 0.f;
#pragma unroll
            for (int j = 0; j < 4; ++j) { const int k = 4 * lane + 256 * j; const f32x4 g4 = *(const LAS f32x4*)(gm + v * 1024 + k), s4 = *(const LAS f32x4*)(sh + v * 1024 + k);
                f32x4 hv = xv[q][j] * rs * g4 + s4; if (!ok) hv = hv * 0.f;
                u32x2 o; o.x = cvt_pk_bf16(hv[0], hv[1]); o.y = cvt_pk_bf16(hv[2], hv[3]);
                if (ok) *(u32x2*)(HX + (size_t)rr * 1024 + k) = o;
                u32x2 h16; h16.x = pack_f16(hv[0], hv[1]); h16.y = pack_f16(hv[2], hv[3]);
                *(LAS u32x2*)(Xh + (2 * wave + q) * ST_H16 + k * 2) = h16; } }
        __syncthreads();
        {
            f32x4 acc0 = {0.f, 0.f, 0.f, 0.f};
#pragma unroll
            for (int s4 = 0; s4 < 4; ++s4) { const int kb = (128 * wave + 32 * s4 + 8 * (lane >> 4)) * 2;
                const f16x8 a = *(const LAS f16x8*)(Xh + (lane & 15) * ST_H16 + kb);
                const f16x8 b0 = *(const LAS f16x8*)(Wh + (lane & 15) * ST_H16 + kb);
                acc0 = __builtin_amdgcn_mfma_f32_16x16x32_f16(a, b0, acc0, 0, 0, 0); }
#pragma unroll
            for (int e = 0; e < 4; ++e) part[(wave * 16 + 4 * (lane >> 4) + e) * 16 + (lane & 15)] = acc0[e];
        }
        __syncthreads();
        if (tid < 256) { const int row = tid >> 4, n = tid & 15; const int rr = t0r + row;
            float sacc = p->dt_bias[l * 16 + n];
#pragma unroll
            for (int w = 0; w < 8; ++w) sacc += part[(w * 16 + row) * 16 + n];
            if (rr < r1) DT[(size_t)rr * 16 + n] = softplusf_(sacc); }
    }
    __syncthreads();
}
typedef float f32x16 __attribute__((ext_vector_type(16)));
typedef short s16x4 __attribute__((ext_vector_type(4)));
constexpr int ST_ROW = 272;
constexpr int ST_TR128 = 320;
constexpr int ST_TR64 = 192;
constexpr int ST_MT = 328;
constexpr int NCHUNK = SEG / 128;

#define DPP_MOV(v, ctrl, rm, bm) __builtin_bit_cast(float, __builtin_amdgcn_update_dpp(0, __builtin_bit_cast(int, (v)), (ctrl), (rm), (bm), true))
__device__ __forceinline__ float wave_incl_scan(float v, int) {
    float s = v + DPP_MOV(v, 0x111, 0xF, 0xF) + DPP_MOV(v, 0x112, 0xF, 0xF) + DPP_MOV(v, 0x113, 0xF, 0xF);
    s += DPP_MOV(s, 0x114, 0xF, 0xE);
    s += DPP_MOV(s, 0x118, 0xF, 0xC);
    s += DPP_MOV(s, 0x142, 0xA, 0xF);
    s += DPP_MOV(s, 0x143, 0xC, 0xF);
    return s;
}
__device__ __forceinline__ bf16x8 row_frag(const LAS unsigned char* tile, int stride, int row0, int k0, int lane) {
    return *(const LAS bf16x8*)(tile + (row0 + (lane & 31)) * stride + (k0 + 8 * (lane >> 5)) * 2);
}
__device__ __forceinline__ bf16x8 tr_frag(const LAS unsigned char* tile, int stride, int k0, int c0, int lane) {
    const int g = lane >> 4, li = lane & 15, q = li >> 2, pp = li & 3;
    const LAS unsigned char* a0 = tile + (k0 + 8 * (g >> 1) + q) * stride + (c0 + 16 * (g & 1) + 4 * pp) * 2;
    const s16x4 lo = __builtin_amdgcn_ds_read_tr16_b64_v4i16((LAS s16x4*)a0);
    const s16x4 hi = __builtin_amdgcn_ds_read_tr16_b64_v4i16((LAS s16x4*)(a0 + 4 * stride));
    return __builtin_shufflevector(lo, hi, 0, 1, 2, 3, 4, 5, 6, 7);
}
__device__ __forceinline__ u32x4 pack8(const float (&v)[8]) { u32x4 r; r.x = cvt_pk_bf16(v[0], v[1]); r.y = cvt_pk_bf16(v[2], v[3]); r.z = cvt_pk_bf16(v[4], v[5]); r.w = cvt_pk_bf16(v[6], v[7]); return r; }
__device__ __forceinline__ u32x4 pack8s(const float (&v)[8], float sc) { u32x4 r; r.x = cvt_pk_bf16(v[0] * sc, v[1] * sc); r.y = cvt_pk_bf16(v[2] * sc, v[3] * sc); r.z = cvt_pk_bf16(v[4] * sc, v[5] * sc); r.w = cvt_pk_bf16(v[6] * sc, v[7] * sc); return r; }

__device__ __forceinline__ void conv_load(const bf16_t* proj, int row0, int rq, int xch, bool lo_ok, bool hi_ok, u32x4 (&raw)[8]) {
    const bf16_t* base = proj + (size_t)(row0 + 4 * rq) * NPROJ + 1536 + xch;
    const bool okl = (rq > 0) || lo_ok, okh = (rq < 31) || hi_ok;
#pragma unroll
    for (int j = 0; j < 8; ++j) raw[j] = *(const u32x4*)((j < 2 ? okl : (j >= 6 ? okh : true)) ? base + (j - 2) * NPROJ : base);
}
__device__ __forceinline__ void conv_compute(const u32x4 (&raw)[8], const LAS float* wl, int nchl, int wch, float (&o)[4][8], bool zl = false, bool zh = false) {
    float w[5][8], bs[8];
#pragma unroll
    for (int j = 0; j < 5; ++j) { const f32x4 w0 = *(const LAS f32x4*)(wl + j * nchl + wch), w1 = *(const LAS f32x4*)(wl + j * nchl + wch + 4);
        w[j][0] = w0[0]; w[j][1] = w0[1]; w[j][2] = w0[2]; w[j][3] = w0[3]; w[j][4] = w1[0]; w[j][5] = w1[1]; w[j][6] = w1[2]; w[j][7] = w1[3]; }
    { const f32x4 b0 = *(const LAS f32x4*)(wl + 5 * nchl + wch), b1 = *(const LAS f32x4*)(wl + 5 * nchl + wch + 4); bs[0] = b0[0]; bs[1] = b0[1]; bs[2] = b0[2]; bs[3] = b0[3]; bs[4] = b1[0]; bs[5] = b1[1]; bs[6] = b1[2]; bs[7] = b1[3]; }
#pragma unroll
    for (int i = 0; i < 4; ++i)
#pragma unroll
        for (int e = 0; e < 8; ++e) o[i][e] = bs[e];
    const float fl = zl ? 0.f : 1.f, fh = zh ? 0.f : 1.f;
#pragma unroll
    for (int j = 0; j < 8; ++j) {
        float xv[8] = {bflo(raw[j].x), bfhi(raw[j].x), bflo(raw[j].y), bfhi(raw[j].y), bflo(raw[j].z), bfhi(raw[j].z), bflo(raw[j].w), bfhi(raw[j].w)};
        if (j < 2) {
#pragma unroll
            for (int e = 0; e < 8; ++e) xv[e] *= fl; }
        if (j >= 6) {
#pragma unroll
            for (int e = 0; e < 8; ++e) xv[e] *= fh; }
#pragma unroll
        for (int i = 0; i < 4; ++i) { const int tap = j - i; if (tap >= 0 && tap < 5) {
#pragma unroll
                for (int e = 0; e < 8; ++e) o[i][e] += w[tap][e] * xv[e]; } }
    }
#pragma unroll
    for (int i = 0; i < 4; ++i)
#pragma unroll
        for (int e = 0; e < 8; ++e) o[i][e] = siluf_(o[i][e]);
}
__device__ __forceinline__ void conv_load4(const bf16_t* proj, int row0, int rq, int xch, bool lo_ok, bool hi_ok, u32x2 (&raw)[8]) {
    const bf16_t* base = proj + (size_t)(row0 + 4 * rq) * NPROJ + 1536 + xch;
    const bool okl = (rq > 0) || lo_ok, okh = (rq < 31) || hi_ok;
#pragma unroll
    for (int j = 0; j < 8; ++j) raw[j] = *(const u32x2*)((j < 2 ? okl : (j >= 6 ? okh : true)) ? base + (j - 2) * NPROJ : base);
}
__device__ __forceinline__ void conv_compute4(const u32x2 (&raw)[8], const LAS float* wl, int nchl, int wch, float (&o)[4][4], bool zl, bool zh) {
    f32x4 w[5];
#pragma unroll
    for (int j = 0; j < 5; ++j) w[j] = *(const LAS f32x4*)(wl + j * nchl + wch);
    const f32x4 bs = *(const LAS f32x4*)(wl + 5 * nchl + wch);
#pragma unroll
    for (int i = 0; i < 4; ++i)
#pragma unroll
        for (int e = 0; e < 4; ++e) o[i][e] = bs[e];
    const float fl = zl ? 0.f : 1.f, fh = zh ? 0.f : 1.f;
#pragma unroll
    for (int j = 0; j < 8; ++j) {
        float xv[4] = {bflo(raw[j].x), bfhi(raw[j].x), bflo(raw[j].y), bfhi(raw[j].y)};
        if (j < 2) {
#pragma unroll
            for (int e = 0; e < 4; ++e) xv[e] *= fl; }
        if (j >= 6) {
#pragma unroll
            for (int e = 0; e < 4; ++e) xv[e] *= fh; }
#pragma unroll
        for (int i = 0; i < 4; ++i) { const int tap = j - i; if (tap >= 0 && tap < 5) {
#pragma unroll
                for (int e = 0; e < 4; ++e) o[i][e] += w[tap][e] * xv[e]; } }
    }
#pragma unroll
    for (int i = 0; i < 4; ++i)
#pragma unroll
        for (int e = 0; e < 4; ++e) o[i][e] = siluf_(o[i][e]);
}
__device__ __forceinline__ void head_cums(CP p, int l, int row0, int h, int dir, int lane, LAS float* hv, const LAS float* atab) {
    const float A = atab[dir * 8 + h];
    const float* DT = (const float*)(p->ws + WS_DT);
    const float d0 = DT[(size_t)(row0 + 2 * lane) * 16 + dir * 8 + h], d1 = DT[(size_t)(row0 + 2 * lane + 1) * 16 + dir * 8 + h];
    const float x0 = d0 * A, x1 = d1 * A;
    const float incl = wave_incl_scan(x0 + x1, lane);
    const float total = __builtin_bit_cast(float, __builtin_amdgcn_readlane(__builtin_bit_cast(int, incl), 63));
    float c0, c1;
    if (dir == 0) { c1 = incl; c0 = incl - x1; } else { c0 = total - (incl - x1 - x0); c1 = total - (incl - x1); }
    hv[dir * 128 + 2 * lane] = c0; hv[dir * 128 + 2 * lane + 1] = c1;
    hv[256 + dir * 128 + 2 * lane] = d0; hv[256 + dir * 128 + 2 * lane + 1] = d1;
    if (lane == 0) hv[512 + dir] = total;
}
__device__ __forceinline__ bf16x8 scale_frag(bf16x8 f, const f32x4 w0, const f32x4 w1) {
    const u32x4 u = __builtin_bit_cast(u32x4, f);
    u32x4 r;
    r.x = cvt_pk_bf16(bflo(u.x) * w0[0], bfhi(u.x) * w0[1]); r.y = cvt_pk_bf16(bflo(u.y) * w0[2], bfhi(u.y) * w0[3]);
    r.z = cvt_pk_bf16(bflo(u.z) * w1[0], bfhi(u.z) * w1[1]); r.w = cvt_pk_bf16(bflo(u.w) * w1[2], bfhi(u.w) * w1[3]);
    return __builtin_bit_cast(bf16x8, r);
}
constexpr int ST_X256 = 576;

__device__ __forceinline__ void phase_c1(CP p, int l, unsigned char* lds_, int bid, int nb) {
    LAS unsigned char* lds = (LAS unsigned char*)lds_;
    LAS unsigned char* tile = lds;
    LAS float* wl = (LAS float*)(lds + 73216);
    const int tid = launder_tid();
    const bf16_t* proj = (const bf16_t*)(p->ws + WS_PROJ); bf16_t* mix = (bf16_t*)(p->ws + WS_HX);
    const int NU = 256 + 512 + (l == DEPTH - 1 ? 0 : 16);
    const int heavy = (nb > 64 && (NB * NCHUNK * 2) % nb < nb / 4) ? (NB * NCHUNK * 2) % nb : 0;
    const int ustart = bid < heavy ? NU : (bid - heavy), ustep = nb - heavy;
#pragma unroll 1
    for (int u = ustart; u < NU; u += ustep) {
        int S, LEN, LSH, pstride, sstride, tok0, ch0;
        if (u < 256) { const int b = u >> 7, cs = (u >> 2) & 31, cc = u & 3; S = 2; LEN = 256; LSH = 8; pstride = 64; sstride = 1; tok0 = b * SEG + CTXL + 2 * cs; ch0 = 256 + 64 * cc; }
        else if (u < 768) { const int v = u - 256; const int b = v >> 8, rg = (v >> 2) & 63, cc = v & 3; S = 4; LEN = 64; LSH = 6; pstride = 1; sstride = 64; tok0 = b * SEG + CTXL + 256 * rg; ch0 = 64 * cc; }
        else { const int v = u - 768; const int b = v >> 3, cc = v & 7; S = 1; LEN = 256; LSH = 8; pstride = 1; sstride = 0; tok0 = b * SEG; ch0 = 64 * cc; }
        const int LP = LEN + 30;
        { float tw[4];
#pragma unroll
          for (int it = 0; it < 4; ++it) { const int i = tid + NTHREADS * it; const int j = i >> 6, c = i & 63; tw[it] = j < 31 ? p->conv_w[((size_t)l * 31 + j) * 512 + ch0 + c] : p->conv_b[l * 512 + ch0 + c]; }
#pragma unroll
          for (int it = 0; it < 4; ++it) wl[tid + NTHREADS * it] = tw[it]; }
        for (int i = tid; i < S * 30 * 8; i += NTHREADS) { const int pc = i & 7, q = (i >> 3) % 30, sq = (i >> 3) / 30; const int pos = q < 15 ? q : LEN + q;
            unsigned zz; asm volatile("v_mov_b32 %0, 0" : "=v"(zz));
            *(LAS u32x4*)(tile + ((sq * LP + pos) * 64 + pc * 8) * 2) = (u32x4){zz, zz, zz, zz}; }
        for (int ib = 0; ib < S * LEN * 8; ib += 4 * NTHREADS) {
            u32x4 uv[4];
#pragma unroll
            for (int q = 0; q < 4; ++q) { const int i = ib + tid + NTHREADS * q; const int pc = i & 7, t = i >> 3; const int sq = t >> LSH, pos = t & (LEN - 1);
                const bf16_t* src = proj + (size_t)(tok0 + sq * sstride + pos * pstride) * NPROJ + ch0 + pc * 8;
                uv[q] = __builtin_nontemporal_load((const u32x4*)src); }
#pragma unroll
            for (int q = 0; q < 4; ++q) { const int i = ib + tid + NTHREADS * q; const int pc = i & 7, t = i >> 3; const int sq = t >> LSH, pos = t & (LEN - 1);
                const u32x4 o = uv[q];
                *(LAS u32x4*)(tile + ((sq * LP + 15 + pos) * 64 + pc * 8) * 2) = o; }
        }
        __syncthreads();
        const int noct = S * LEN / 8;
#pragma unroll 1
        for (int it = tid; it < noct * 32; it += NTHREADS) {
            const int cp = it & 31, oc = it >> 5; const int sq = oc >> (LSH - 3), p0 = (oc & ((LEN >> 3) - 1)) * 8;
            const LAS unsigned* base = (const LAS unsigned*)(tile + ((sq * LP + p0) * 64) * 2) + cp;
            float i0[38], i1[38];
#pragma unroll
            for (int k = 0; k < 38; ++k) { const unsigned w = base[k * 32]; i0[k] = bflo(w); i1[k] = bfhi(w); }
            float a0[8], a1[8];
            { const float b0 = wl[31 * 64 + 2 * cp], b1 = wl[31 * 64 + 2 * cp + 1];
#pragma unroll
              for (int i = 0; i < 8; ++i) { a0[i] = b0; a1[i] = b1; } }
#pragma unroll
            for (int j = 0; j < 31; ++j) { typedef float f32x2 __attribute__((ext_vector_type(2))); const f32x2 wj = *(const LAS f32x2*)(wl + j * 64 + 2 * cp); const float w0 = wj[0], w1 = wj[1];
#pragma unroll
                for (int i = 0; i < 8; ++i) { a0[i] += w0 * i0[i + j]; a1[i] += w1 * i1[i + j]; } }
#pragma unroll
            for (int i = 0; i < 8; ++i) { const int tok = tok0 + sq * sstride + (p0 + i) * pstride;
                *(unsigned*)(mix + (size_t)tok * 1024 + 512 + ch0 + 2 * cp) = cvt_pk_bf16(a0[i], a1[i]); }
        }
        __syncthreads();
    }
}
__device__ __forceinline__ void phase_c1_ln(CP p, int l, int bid, int nb) {
    const int tid = launder_tid(); const int lane = tid & 63, wave = tid >> 6;
    bf16_t* mix = (bf16_t*)(p->ws + WS_HX);
    const f32x4 g0 = *(const f32x4*)(p->conv_ln_g + l * 512 + lane * 8), g1 = *(const f32x4*)(p->conv_ln_g + l * 512 + lane * 8 + 4);
    const f32x4 b0 = *(const f32x4*)(p->conv_ln_b + l * 512 + lane * 8), b1 = *(const f32x4*)(p->conv_ln_b + l * 512 + lane * 8 + 4);
    const float gg[8] = {g0[0], g0[1], g0[2], g0[3], g1[0], g1[1], g1[2], g1[3]}, bb[8] = {b0[0], b0[1], b0[2], b0[3], b1[0], b1[1], b1[2], b1[3]};
    u32x4 vn = {0u, 0u, 0u, 0u};
    if (bid * 8 + wave < R) vn = *(const u32x4*)(mix + (size_t)(bid * 8 + wave) * 1024 + 512 + lane * 8);
    for (int r = bid * 8 + wave; r < R; r += nb * 8) {
        u32x4* ptr = (u32x4*)(mix + (size_t)r * 1024 + 512 + lane * 8);
        const u32x4 v = vn;
        if (r + nb * 8 < R) vn = *(const u32x4*)(mix + (size_t)(r + nb * 8) * 1024 + 512 + lane * 8);
        float y[8] = {bflo(v.x), bfhi(v.x), bflo(v.y), bfhi(v.y), bflo(v.z), bfhi(v.z), bflo(v.w), bfhi(v.w)};
        float s = 0.f;
#pragma unroll
        for (int e = 0; e < 8; ++e) s += y[e];
        const float mu = wave_sum(s) * (1.f / 512.f);
        float q = 0.f;
#pragma unroll
        for (int e = 0; e < 8; ++e) { y[e] -= mu; q += y[e] * y[e]; }
        const float rstd = rsqrtf(wave_sum(q) * (1.f / 512.f) + 1e-5f);
        float o[8];
#pragma unroll
        for (int e = 0; e < 8; ++e) o[e] = siluf_(y[e] * rstd * gg[e] + bb[e]);
        *ptr = pack8(o);
    }
}
__device__ __forceinline__ void phase_s1(CP p, int l, unsigned char* lds_, int bid, int nb) {
    LAS unsigned char* lds = (LAS unsigned char*)lds_;
    LAS unsigned char* Bs = lds;
    LAS unsigned char* Xs = lds + 128 * ST_TR128;
    LAS float* wv = (LAS float*)(Xs + 128 * ST_X256);
    LAS float* hvs = wv + 8 * 128;
    LAS float* cwl = hvs + 4 * 520;
    LAS float* atab = cwl + 6 * 384;
    const int tid = launder_tid(); const int lane = tid & 63, wave = __builtin_amdgcn_readfirstlane(tid >> 6);
    const bf16_t* proj = (const bf16_t*)(p->ws + WS_PROJ);
    const float* cw = p->ssd_conv_w + (size_t)l * 5 * 1024; const float* cbias = p->ssd_conv_b + (size_t)l * 1024;
    bf16_t* Sg = (bf16_t*)(p->ws + WS_S); float* DEC = (float*)(p->ws + WS_DEC);
    if (tid < 16) atab[tid] = -expf(p->a_log[l * 16 + tid]);
    __syncthreads();
    int cur_g = -1;
#pragma unroll 1
    for (int u = bid; u < NB * NCHUNK * 2; u += nb) {
        const int g = u & 1, c = (u >> 1) % NCHUNK, b = (u >> 1) / NCHUNK;
        const int row0 = b * SEG + c * 128;
        const bool lo_ok = !(c == 0 || c == 2), hi_ok = !(c == 1 || c == NCHUNK - 1);
        if (g != cur_g) { cur_g = g;
            float tw[5];
#pragma unroll
            for (int it = 0; it < 5; ++it) { const int i = tid + NTHREADS * it; const int j = i / 384, lc = i - j * 384; const int gch = lc < 128 ? 512 + g * 128 + lc : g * 256 + (lc - 128);
                tw[it] = i < 6 * 384 ? (j < 5 ? cw[j * 1024 + gch] : cbias[gch]) : 0.f; }
#pragma unroll
            for (int it = 0; it < 5; ++it) { const int i = tid + NTHREADS * it; if (i < 6 * 384) cwl[i] = tw[it]; } }
        const int hh = wave >> 1, dir = wave & 1, h = 4 * g + hh;
        u32x4 rb[8], rx0[8], rx1[8];
        conv_load(proj, row0, tid >> 4, 512 + g * 128 + (tid & 15) * 8, lo_ok, hi_ok, rb);
        conv_load(proj, row0, tid >> 5, g * 256 + (tid & 31) * 8, lo_ok, hi_ok, rx0);
        conv_load(proj, row0, (tid >> 5) + 16, g * 256 + (tid & 31) * 8, lo_ok, hi_ok, rx1);
        head_cums(p, l, row0, h, dir, lane, hvs + hh * 520, atab);
        __syncthreads();
        {
            const LAS float* hv = hvs + hh * 520; const float tot = hv[512 + dir];
#pragma unroll
            for (int q = 0; q < 2; ++q) { const int lr = lane + 64 * q; wv[wave * 128 + lr] = __expf(tot - hv[dir * 128 + lr]) * hv[256 + dir * 128 + lr]; }
            if (lane == 0) DEC[((size_t)(b * 2 + dir) * NCHUNK + c) * 8 + h] = __expf(tot);
        }
        { float o[4][8];
          conv_compute(rb, cwl, 384, (tid & 15) * 8, o, (tid >> 4) == 0 && !lo_ok, (tid >> 4) == 31 && !hi_ok);
#pragma unroll
          for (int i = 0; i < 4; ++i) *(LAS u32x4*)(Bs + (4 * (tid >> 4) + i) * ST_TR128 + (tid & 15) * 16) = pack8(o[i]);
          conv_compute(rx0, cwl, 384, 128 + (tid & 31) * 8, o, (tid >> 5) == 0 && !lo_ok, false);
#pragma unroll
          for (int i = 0; i < 4; ++i) *(LAS u32x4*)(Xs + (4 * (tid >> 5) + i) * ST_X256 + (tid & 31) * 16) = pack8(o[i]);
          conv_compute(rx1, cwl, 384, 128 + (tid & 31) * 8, o, false, (tid >> 5) == 15 && !hi_ok);
#pragma unroll
          for (int i = 0; i < 4; ++i) *(LAS u32x4*)(Xs + (4 * ((tid >> 5) + 16) + i) * ST_X256 + (tid & 31) * 16) = pack8(o[i]); }
        __syncthreads();
        {
            f32x16 acc[2][4];
#pragma unroll
            for (int t = 0; t < 2; ++t)
#pragma unroll
                for (int q = 0; q < 4; ++q)
#pragma unroll
                    for (int e = 0; e < 16; ++e) acc[t][q][e] = 0.f;
            {
                bf16x8 ar[2][2], br[2][4];
#pragma unroll
                for (int t = 0; t < 2; ++t) ar[0][t] = tr_frag(Xs, ST_X256, 0, hh * 64 + 32 * t, lane);
#pragma unroll
                for (int q = 0; q < 4; ++q) br[0][q] = tr_frag(Bs, ST_TR128, 0, 32 * q, lane);
#pragma unroll 2
                for (int kk = 0; kk < 8; ++kk) { const int c_ = kk & 1, n_ = c_ ^ 1;
                    const LAS float* wp = wv + wave * 128 + 16 * kk + 8 * (lane >> 5);
                    const f32x4 w0 = *(const LAS f32x4*)wp, w1 = *(const LAS f32x4*)(wp + 4);
                    if (kk < 7) {
#pragma unroll
                        for (int t = 0; t < 2; ++t) ar[n_][t] = tr_frag(Xs, ST_X256, 16 * (kk + 1), hh * 64 + 32 * t, lane);
#pragma unroll
                        for (int q = 0; q < 4; ++q) br[n_][q] = tr_frag(Bs, ST_TR128, 16 * (kk + 1), 32 * q, lane); }
                    bf16x8 af[2];
#pragma unroll
                    for (int t = 0; t < 2; ++t) af[t] = scale_frag(ar[c_][t], w0, w1);
#pragma unroll
                    for (int q = 0; q < 4; ++q)
#pragma unroll
                        for (int t = 0; t < 2; ++t) acc[t][q] = __builtin_amdgcn_mfma_f32_32x32x16_bf16(br[c_][q], af[t], acc[t][q], 0, 0, 0);
                }
            }
            bf16_t* So = Sg + ((size_t)((b * 2 + dir) * NCHUNK + c) * 8 + h) * 8192 + (size_t)(lane & 31) * 128 + 4 * (lane >> 5);
#pragma unroll
            for (int t = 0; t < 2; ++t)
#pragma unroll
                for (int q = 0; q < 4; ++q)
#pragma unroll
                    for (int rg = 0; rg < 4; ++rg) { u32x2 pk; pk.x = cvt_pk_bf16(acc[t][q][4 * rg], acc[t][q][4 * rg + 1]); pk.y = cvt_pk_bf16(acc[t][q][4 * rg + 2], acc[t][q][4 * rg + 3]);
                        *(u32x2*)(So + (size_t)(32 * t) * 128 + 32 * q + 8 * rg) = pk; }
        }
        __syncthreads();
    }
}
__device__ __forceinline__ void phase_s2(CP p, int bid, int nb) {
    const int tid = launder_tid();
    const bf16_t* Sg = (const bf16_t*)(p->ws + WS_S); const float* DEC = (const float*)(p->ws + WS_DEC); bf16_t* HP = (bf16_t*)(p->ws + WS_HP);
    for (int idx = bid * NTHREADS + tid; idx < 2 * 2 * 8 * 64 * 64; idx += nb * NTHREADS) {
        const int n2 = idx & 63, pr = (idx >> 6) & 63, h = (idx >> 12) & 7, dir = (idx >> 15) & 1, b = idx >> 16;
        const size_t inner = (size_t)h * 8192 + pr * 128 + 2 * n2;
        const size_t cbase = (size_t)(b * 2 + dir) * NCHUNK;
        float s0 = 0.f, s1 = 0.f;
#pragma unroll 26
        for (int step = 0; step < NCHUNK; ++step) {
            const int c = dir == 0 ? step : (step < 2 ? 1 - step : NCHUNK + 1 - step);
            const size_t off = (cbase + c) * 65536 + inner;
            const unsigned sv = __builtin_nontemporal_load((const unsigned*)(Sg + off)); const float d = DEC[(cbase + c) * 8 + h];
            *(unsigned*)(HP + off) = cvt_pk_bf16(s0, s1);
            s0 = s0 * d + bflo(sv); s1 = s1 * d + bfhi(sv);
        }
    }
}
__device__ __forceinline__ void phase_s3(CP p, int l, unsigned char* lds_, int bid, int nb) {
    LAS unsigned char* lds = (LAS unsigned char*)lds_;
    LAS unsigned char* Cs = lds;
    LAS unsigned char* Bs = Cs + 128 * ST_ROW;
    LAS unsigned char* Mt = Bs;
    LAS unsigned char* Xs = Bs + 128 * ST_MT;
    LAS unsigned char* Hf = Xs + 128 * ST_TR64;
    LAS unsigned char* Hb = Hf + 64 * ST_ROW;
    LAS float* hvs = (LAS float*)(Hb + 64 * ST_ROW);
    LAS float* ssqp = hvs + 4 * 776;
    LAS float* cwl = ssqp + 256;
    LAS float* atab = cwl + 6 * 512;
    const int tid0 = launder_tid(); const int wave = __builtin_amdgcn_readfirstlane(tid0 >> 6);
    const bf16_t* proj = (const bf16_t*)(p->ws + WS_PROJ); bf16_t* mix = (bf16_t*)(p->ws + WS_HX);
    const float* cw = p->ssd_conv_w + (size_t)l * 5 * 1024; const float* cbias = p->ssd_conv_b + (size_t)l * 1024;
    const bf16_t* HP = (const bf16_t*)(p->ws + WS_HP); float* SSQ = (float*)(p->ws + WS_SSQ);
    if (tid0 < 16) atab[tid0] = -expf(p->a_log[l * 16 + tid0]); else if (tid0 < 24) atab[tid0] = p->d_skip[l * 8 + tid0 - 16];
    __syncthreads();
    int cur_g = -1;
    const int cskip = (l == DEPTH - 1) ? 2 : 0, cpb = NCHUNK - cskip;
    const int nunits = NB * cpb * 2, nfull = nunits - nunits % nb, nitems = nfull + (nunits - nfull) * 4;
#pragma unroll 1
    for (int it = bid; it < nitems; it += nb) {
        const int u = it < nfull ? it : nfull + ((it - nfull) >> 2);
        const int hh_lo = it < nfull ? 0 : ((it - nfull) & 3), hh_hi = it < nfull ? 4 : hh_lo + 1;
        const int g = u & 1, c = cskip + (u >> 1) % cpb, b = (u >> 1) / cpb;
        int tid = tid0; asm volatile("" : "+v"(tid));
        const int lane = tid & 63;
        const int row0 = b * SEG + c * 128;
        const bool lo_ok = !(c == 0 || c == 2), hi_ok = !(c == 1 || c == NCHUNK - 1);
        if (g != cur_g) { cur_g = g;
            float tw[6];
#pragma unroll
            for (int it = 0; it < 6; ++it) { const int i = tid + NTHREADS * it; const int j = i >> 9, lc = i & 511; const int gch = lc < 128 ? 768 + g * 128 + lc : (lc < 256 ? 512 + g * 128 + (lc - 128) : g * 256 + (lc - 256));
                tw[it] = j < 5 ? cw[j * 1024 + gch] : cbias[gch]; }
#pragma unroll
            for (int it = 0; it < 6; ++it) cwl[tid + NTHREADS * it] = tw[it]; }
        u32x2 rx[8];
        {
            u32x4 r0[8], r1[8];
            const int cg = tid & 31; const int gch = (cg < 16 ? 768 : 512) + g * 128 + (cg & 15) * 8;
            conv_load(proj, row0, tid >> 5, gch, lo_ok, hi_ok, r0);
            conv_load(proj, row0, (tid >> 5) + 16, gch, lo_ok, hi_ok, r1);
            head_cums(p, l, row0, 4 * g + (wave >> 1), wave & 1, lane, hvs + (wave >> 1) * 776, atab);
            { LAS float* hvw = hvs + (wave >> 1) * 776; const int dr = wave & 1;
              hvw[520 + dr * 128 + 2 * lane] = __expf(hvw[dr * 128 + 2 * lane]); hvw[520 + dr * 128 + 2 * lane + 1] = __expf(hvw[dr * 128 + 2 * lane + 1]); }
            __syncthreads();
            float o[4][8];
            LAS unsigned char* dst = (cg < 16 ? Cs : Bs) + (cg & 15) * 16;
            conv_compute(r0, cwl, 512, cg * 8, o, (tid >> 5) == 0 && !lo_ok, false);
#pragma unroll
            for (int i = 0; i < 4; ++i) *(LAS u32x4*)(dst + (4 * (tid >> 5) + i) * ST_ROW) = pack8(o[i]);
            asm volatile("" ::: "memory");
            conv_load4(proj, row0, tid >> 4, g * 256 + hh_lo * 64 + (tid & 15) * 4, lo_ok, hi_ok, rx);
            conv_compute(r1, cwl, 512, cg * 8, o, false, (tid >> 5) == 15 && !hi_ok);
#pragma unroll
            for (int i = 0; i < 4; ++i) *(LAS u32x4*)(dst + (4 * ((tid >> 5) + 16) + i) * ST_ROW) = pack8(o[i]);
            { float o4[4][4]; conv_compute4(rx, cwl, 512, 256 + hh_lo * 64 + (tid & 15) * 4, o4, (tid >> 4) == 0 && !lo_ok, (tid >> 4) == 31 && !hi_ok);
#pragma unroll
              for (int i = 0; i < 4; ++i) { u32x2 pk; pk.x = cvt_pk_bf16(o4[i][0], o4[i][1]); pk.y = cvt_pk_bf16(o4[i][2], o4[i][3]); *(LAS u32x2*)(Xs + (4 * (tid >> 4) + i) * ST_TR64 + (tid & 15) * 8) = pk; } }
        }
        __syncthreads();
        const int lb = wave >> 1, hs = wave & 1;
        int ln = lane; asm volatile("" : "+v"(ln));
        f32x16 gacc[2];
#pragma unroll
        for (int t = 0; t < 2; ++t)
#pragma unroll
            for (int e = 0; e < 16; ++e) gacc[t][e] = 0.f;
#pragma unroll
        for (int kk = 0; kk < 8; ++kk) { const bf16x8 af = row_frag(Cs, ST_ROW, 32 * lb, 16 * kk, lane);
#pragma unroll
            for (int t = 0; t < 2; ++t) { const bf16x8 bf = row_frag(Bs, ST_ROW, 64 * hs + 32 * t, 16 * kk, lane);
                gacc[t] = __builtin_amdgcn_mfma_f32_32x32x16_bf16(af, bf, gacc[t], 0, 0, 0); } }
        u32x4 hreg[4];
        { const bf16_t* hp0 = HP + ((size_t)(b * 2 * NCHUNK + c) * 8 + 4 * g + hh_lo) * 8192;
#pragma unroll
          for (int q = 0; q < 4; ++q) { const int it = tid + 512 * q; hreg[q] = __builtin_nontemporal_load((const u32x4*)(hp0 + (size_t)(it >> 10) * NCHUNK * 8 * 8192 + (it & 1023) * 8)); } }
        __syncthreads();
#pragma unroll 1
        for (int hh = hh_lo; hh < hh_hi; ++hh) {
            const int h = 4 * g + hh; const LAS float* hv = hvs + hh * 776;
            asm volatile("" : "+v"(ln));
            const int ph = hs, pc = 32 * ph + (ln & 31);
            unsigned zraw[8];
#pragma unroll
            for (int ri = 0; ri < 16; ri += 2) { const int lr = 32 * lb + 8 * (ri >> 2) + 4 * (ln >> 5) + (ri & 3);
                const bf16_t* zp = proj + (size_t)(row0 + lr) * NPROJ + 1024 + h * 64 + pc;
                zraw[ri >> 1] = (unsigned)zp[0] | ((unsigned)zp[NPROJ] << 16); }
#pragma unroll
            for (int t = 0; t < 2; ++t) {
                const int st = 2 * hs + t;
                const int sc = 32 * st + (ln & 31);
                const float cfs = hv[sc], cbs = hv[128 + sc], dfs = hv[256 + sc], dbs = hv[384 + sc];
#pragma unroll
                for (int rg = 0; rg < 4; ++rg) {
                    const int l0 = 32 * lb + 8 * rg + 4 * (ln >> 5);
                    float m[4];
                    if (st < lb) {
                        const f32x4 cfl = *(const LAS f32x4*)(hv + l0);
#pragma unroll
                        for (int e = 0; e < 4; ++e) m[e] = gacc[t][4 * rg + e] * (__expf(cfl[e] - cfs) * dfs);
                    } else if (st > lb) {
                        const f32x4 cbl = *(const LAS f32x4*)(hv + 128 + l0);
#pragma unroll
                        for (int e = 0; e < 4; ++e) m[e] = gacc[t][4 * rg + e] * (__expf(cbl[e] - cbs) * dbs);
                    } else {
                        const f32x4 cfl = *(const LAS f32x4*)(hv + l0), cbl = *(const LAS f32x4*)(hv + 128 + l0);
#pragma unroll
                        for (int e = 0; e < 4; ++e) { const int lr = l0 + e;
                            const float ff = lr >= sc ? __expf(cfl[e] - cfs) * dfs : 0.f;
                            const float fb = lr <= sc ? __expf(cbl[e] - cbs) * dbs : 0.f;
                            m[e] = gacc[t][4 * rg + e] * (ff + fb); }
                    }
                    u32x2 pk; pk.x = cvt_pk_bf16(m[0], m[1]); pk.y = cvt_pk_bf16(m[2], m[3]);
                    *(LAS u32x2*)(Mt + sc * ST_MT + l0 * 2) = pk;
                }
            }
#pragma unroll
            for (int q = 0; q < 4; ++q) { const int it = tid + 512 * q; const int q2 = it & 1023;
                *(LAS u32x4*)(((it >> 10) ? Hb : Hf) + (q2 >> 4) * ST_ROW + (q2 & 15) * 16) = hreg[q]; }
            if (hh + 1 < hh_hi) {
                const bf16_t* hp0 = HP + ((size_t)(b * 2 * NCHUNK + c) * 8 + h + 1) * 8192;
#pragma unroll
                for (int q = 0; q < 4; ++q) { const int it = tid + 512 * q; hreg[q] = __builtin_nontemporal_load((const u32x4*)(hp0 + (size_t)(it >> 10) * NCHUNK * 8 * 8192 + (it & 1023) * 8)); }
                conv_load4(proj, row0, tid >> 4, g * 256 + (hh + 1) * 64 + (tid & 15) * 4, lo_ok, hi_ok, rx);
            }
            __syncthreads();
            f32x16 ad, af_, ab_;
#pragma unroll
            for (int e = 0; e < 16; ++e) { ad[e] = 0.f; af_[e] = 0.f; ab_[e] = 0.f; }
            {
                bf16x8 am[2], bx[2], ac[2], bhf[2], bhb[2];
                am[0] = tr_frag(Mt, ST_MT, 0, 32 * lb, lane); bx[0] = tr_frag(Xs, ST_TR64, 0, 32 * ph, lane);
                ac[0] = row_frag(Cs, ST_ROW, 32 * lb, 0, lane); bhf[0] = row_frag(Hf, ST_ROW, 32 * ph, 0, lane); bhb[0] = row_frag(Hb, ST_ROW, 32 * ph, 0, lane);
#pragma unroll
                for (int kk = 0; kk < 8; ++kk) { const int c = kk & 1, n = c ^ 1;
                    if (kk < 7) { am[n] = tr_frag(Mt, ST_MT, 16 * (kk + 1), 32 * lb, lane); bx[n] = tr_frag(Xs, ST_TR64, 16 * (kk + 1), 32 * ph, lane);
                        ac[n] = row_frag(Cs, ST_ROW, 32 * lb, 16 * (kk + 1), lane); bhf[n] = row_frag(Hf, ST_ROW, 32 * ph, 16 * (kk + 1), lane); bhb[n] = row_frag(Hb, ST_ROW, 32 * ph, 16 * (kk + 1), lane); }
                    ad = __builtin_amdgcn_mfma_f32_32x32x16_bf16(am[c], bx[c], ad, 0, 0, 0);
                    af_ = __builtin_amdgcn_mfma_f32_32x32x16_bf16(ac[c], bhf[c], af_, 0, 0, 0);
                    ab_ = __builtin_amdgcn_mfma_f32_32x32x16_bf16(ac[c], bhb[c], ab_, 0, 0, 0); }
            }
            const float dsk = atab[16 + h];
#pragma unroll
            for (int rg = 0; rg < 4; ++rg) {
                const int l0 = 32 * lb + 8 * rg + 4 * (ln >> 5);
                const f32x4 efl = *(const LAS f32x4*)(hv + 520 + l0), ebl = *(const LAS f32x4*)(hv + 648 + l0);
#pragma unroll
                for (int e = 0; e < 4; ++e) { const int lr = l0 + e; const int ri = 4 * rg + e;
                    const float xs = bf2f(*(const LAS bf16_t*)(Xs + lr * ST_TR64 + pc * 2));
                    const float y = ad[ri] + efl[e] * af_[ri] + ebl[e] * ab_[ri] + dsk * xs;
                    const float z = (ri & 1) ? bfhi(zraw[ri >> 1]) : bflo(zraw[ri >> 1]);
                    const float val = y * z;
                    mix[(size_t)(row0 + lr) * 1024 + h * 64 + pc] = f2bf(val);
                    const float sq = half_sum32(val * val);
                    if ((ln & 31) == 31) ssqp[ph * 128 + lr] = sq;
                }
            }
            __syncthreads();
            if (tid < 128) SSQ[(size_t)(row0 + tid) * 8 + h] = ssqp[tid] + ssqp[128 + tid];
            if (hh + 1 < hh_hi) { float o4[4][4];
                conv_compute4(rx, cwl, 512, 256 + (hh + 1) * 64 + (tid & 15) * 4, o4, (tid >> 4) == 0 && !lo_ok, (tid >> 4) == 31 && !hi_ok);
#pragma unroll
                for (int i = 0; i < 4; ++i) { u32x2 pk; pk.x = cvt_pk_bf16(o4[i][0], o4[i][1]); pk.y = cvt_pk_bf16(o4[i][2], o4[i][3]); *(LAS u32x2*)(Xs + (4 * (tid >> 4) + i) * ST_TR64 + (tid & 15) * 8) = pk; } }
        }
        __syncthreads();
    }
}
__device__ __forceinline__ void phase_r2(CP p, int l, unsigned char* lds_, int bid, int nb) {
    LAS unsigned char* lds = (LAS unsigned char*)lds_;
    LAS unsigned char* Wh = lds;
    LAS unsigned char* Xh = Wh + 32 * ST_H16;
    LAS float* gm = (LAS float*)(Xh + 16 * ST_H16);
    LAS float* sh = gm + 3 * 1024;
    LAS float* part = sh + 3 * 1024;
    LAS float* lgs = part + 8 * 16 * 32;
    LAS int* lcnt = (LAS int*)(lgs + 16 * 32);
    LAS int* lcls = lcnt + 64;
    LAS int* lrank = lcls + 512;
    LAS float* lcwa = (LAS float*)(lrank + 512);
    LAS float* lcwb = lcwa + 512;
    const int tid = launder_tid(); const int lane = tid & 63, wave = __builtin_amdgcn_readfirstlane(tid >> 6);
    const float* mod = (const float*)(p->ws + WS_MOD) + (size_t)l * 3 * 6144;
    {
        float tmp[8];
#pragma unroll
        for (int it = 0; it < 8; ++it) tmp[it] = p->w_rg[(size_t)l * 4096 + tid + NTHREADS * it];
#pragma unroll
        for (int it = 0; it < 8; ++it) { const int idx = tid + NTHREADS * it; *(LAS _Float16*)(Wh + (idx & 3) * ST_H16 + (idx >> 2) * 2) = (_Float16)tmp[it]; } }
#pragma unroll
    for (int hb = 0; hb < 2; ++hb) { float tmp[16];
#pragma unroll
        for (int it = 0; it < 16; ++it) tmp[it] = p->w_re[(size_t)l * 16384 + tid + NTHREADS * (16 * hb + it)];
#pragma unroll
        for (int it = 0; it < 16; ++it) { const int idx = tid + NTHREADS * (16 * hb + it); *(LAS _Float16*)(Wh + (4 + (idx & 15)) * ST_H16 + (idx >> 4) * 2) = (_Float16)tmp[it]; } }
    { unsigned zz; asm volatile("v_mov_b32 %0, 0" : "=v"(zz));
      for (int i = tid; i < 12 * 128; i += NTHREADS) { const int rw = 20 + i / 128, c16 = i % 128; *(LAS u32x4*)(Wh + rw * ST_H16 + c16 * 16) = (u32x4){zz, zz, zz, zz}; } }
    { float t0[6], t1[6], t2[6];
#pragma unroll
      for (int it = 0; it < 6; ++it) { const int idx = tid + NTHREADS * it; const int v = idx >> 10, k = idx & 1023; t0[it] = p->g_ffn[l * 1024 + k]; t1[it] = mod[v * 6144 + 4 * 1024 + k]; t2[it] = mod[v * 6144 + 3 * 1024 + k]; }
#pragma unroll
      for (int it = 0; it < 6; ++it) { const int idx = tid + NTHREADS * it; gm[idx] = t0[it] * (1.f + t1[it]); sh[idx] = t2[it]; } }
    if (tid < 64) lcnt[tid] = 0;
    __syncthreads();
    bf16_t* HM = (bf16_t*)(p->ws + WS_HX); float* CWLA = (float*)(p->ws + WS_CWLA); float* CWLB = (float*)(p->ws + WS_CWLB);
    int* gcount = (int*)(p->ws + WS_CTL) + l * 32; int* LIST = (int*)(p->ws + WS_LIST);
    const int rpb = (R + nb - 1) / nb, r0 = bid * rpb, r1 = (r0 + rpb) < R ? (r0 + rpb) : R;
    RowRaw xn[2];
#pragma unroll
    for (int q = 0; q < 2; ++q) if (r0 + 2 * wave + q < r1) row_load(p, 1, r0 + 2 * wave + q, lane, xn[q]);
#pragma unroll 1
    for (int t0r = r0; t0r < r1; t0r += 16) {
        f32x4 xv[2][4];
#pragma unroll
        for (int q = 0; q < 2; ++q) row_cvt(1, xn[q], xv[q]);
#pragma unroll
        for (int q = 0; q < 2; ++q) if (t0r + 16 + 2 * wave + q < r1) row_load(p, 1, t0r + 16 + 2 * wave + q, lane, xn[q]);
#pragma unroll
        for (int q = 0; q < 2; ++q) { const int rr = t0r + 2 * wave + q; const bool ok = rr < r1; const int v = row_v(ok ? rr : r0);
            float ss = 0.f;
#pragma unroll
            for (int j = 0; j < 4; ++j) ss += xv[q][j][0] * xv[q][j][0] + xv[q][j][1] * xv[q][j][1] + xv[q][j][2] * xv[q][j][2] + xv[q][j][3] * xv[q][j][3];
            ss = wave_sum(ss); const float rs = ok ? __builtin_amdgcn_rsqf(ss * (1.f / 1024.f) + 1e-6f) : 0.f;
#pragma unroll
            for (int j = 0; j < 4; ++j) { const int k = 4 * lane + 256 * j; const f32x4 g4 = *(const LAS f32x4*)(gm + v * 1024 + k), s4 = *(const LAS f32x4*)(sh + v * 1024 + k);
                f32x4 hv = xv[q][j] * rs * g4 + s4; if (!ok) hv = hv * 0.f;
                u32x2 o; o.x = cvt_pk_bf16(hv[0], hv[1]); o.y = cvt_pk_bf16(hv[2], hv[3]);
                if (ok) *(u32x2*)(HM + (size_t)rr * 1024 + k) = o;
                u32x2 h16; h16.x = pack_f16(hv[0], hv[1]); h16.y = pack_f16(hv[2], hv[3]);
                *(LAS u32x2*)(Xh + (2 * wave + q) * ST_H16 + k * 2) = h16; } }
        __syncthreads();
        {
            f32x4 acc0 = {0.f, 0.f, 0.f, 0.f}, acc1 = {0.f, 0.f, 0.f, 0.f};
#pragma unroll
            for (int s4 = 0; s4 < 4; ++s4) { const int kb = (128 * wave + 32 * s4 + 8 * (lane >> 4)) * 2;
                const f16x8 a = *(const LAS f16x8*)(Xh + (lane & 15) * ST_H16 + kb);
                const f16x8 b0 = *(const LAS f16x8*)(Wh + (lane & 15) * ST_H16 + kb), b1 = *(const LAS f16x8*)(Wh + (16 + (lane & 15)) * ST_H16 + kb);
                acc0 = __builtin_amdgcn_mfma_f32_16x16x32_f16(a, b0, acc0, 0, 0, 0);
                acc1 = __builtin_amdgcn_mfma_f32_16x16x32_f16(a, b1, acc1, 0, 0, 0); }
#pragma unroll
            for (int e = 0; e < 4; ++e) { const int row = 4 * (lane >> 4) + e; part[(wave * 16 + row) * 32 + (lane & 15)] = acc0[e]; part[(wave * 16 + row) * 32 + 16 + (lane & 15)] = acc1[e]; }
        }
        __syncthreads();
        if (tid < 320) { const int row = tid / 20, n = tid - row * 20; float sacc = n < 4 ? p->b_rg[l * 4 + n] : p->b_re[l * 16 + n - 4];
#pragma unroll
            for (int w = 0; w < 8; ++w) sacc += part[(w * 16 + row) * 32 + n];
            lgs[row * 32 + n] = sacc; }
        __syncthreads();
        if (tid < 16) { const int rr = t0r + tid;
            if (rr < r1) {
                if (l == DEPTH - 1 && row_v(rr) == 2) lcls[rr - r0] = -1;
                else {
                    float lg[20];
#pragma unroll
                    for (int n = 0; n < 20; ++n) lg[n] = lgs[tid * 32 + n];
                    int gsel = 0; float gmax = lg[0];
#pragma unroll
                    for (int t = 1; t < 4; ++t) if (lg[t] > gmax) { gmax = lg[t]; gsel = t; }
                    float gden = 0.f;
#pragma unroll
                    for (int t = 0; t < 4; ++t) gden += __expf(lg[t] - gmax);
                    const float gprob = 1.f / gden;
                    float el[4];
#pragma unroll
                    for (int t = 0; t < 4; ++t) el[t] = gsel == 0 ? lg[4 + t] : (gsel == 1 ? lg[8 + t] : (gsel == 2 ? lg[12 + t] : lg[16 + t]));
                    int i0 = 0; float m0 = el[0];
#pragma unroll
                    for (int t = 1; t < 4; ++t) if (el[t] > m0) { m0 = el[t]; i0 = t; }
                    int i1 = -1; float m1 = -3.0e38f;
#pragma unroll
                    for (int t = 0; t < 4; ++t) if (t != i0 && el[t] > m1) { m1 = el[t]; i1 = t; }
                    const float w0 = gprob / (1.f + __expf(m1 - m0)), w1 = gprob - w0;
                    const int ea = i0 < i1 ? i0 : i1, eb = i0 < i1 ? i1 : i0;
                    const float cwa = i0 < i1 ? w0 : w1, cwb = i0 < i1 ? w1 : w0;
                    const int pidx = ea == 0 ? eb - 1 : (ea == 1 ? eb + 1 : 5);
                    const int cls = gsel * 6 + pidx;
                    const int rank = __hip_atomic_fetch_add(&lcnt[cls], 1, __ATOMIC_RELAXED, __HIP_MEMORY_SCOPE_WORKGROUP);
                    lcls[rr - r0] = cls; lrank[rr - r0] = rank; lcwa[rr - r0] = cwa; lcwb[rr - r0] = cwb;
                } } }
    }
    __syncthreads();
    if (tid < NCLS) lcnt[32 + tid] = atomicAdd(&gcount[tid], lcnt[tid]);
    __syncthreads();
    for (int idx = tid; idx < r1 - r0; idx += NTHREADS) { const int cl = lcls[idx]; if (cl < 0) continue; const int pos = lcnt[32 + cl] + lrank[idx]; const size_t li = (size_t)cl * R + pos;
        LIST[li] = r0 + idx; CWLA[li] = lcwa[idx]; CWLB[li] = lcwb[idx]; }
    __syncthreads();
}
__device__ __forceinline__ void phase_final(CP p, unsigned char* lds, int bid, int nb) {
    const int tid = launder_tid(); const int lane = tid & 63, wave = tid >> 6;
    const int qstep = nb * 8;
    RowRaw xn;
    { const int q = bid * 8 + wave; if (q < NB * SEQ) { const int b = q >= SEQ ? 1 : 0; row_load(p, 1, b * SEG + CTXL + (q - b * SEQ), lane, xn); } }
    for (int q = bid * 8 + wave; q < NB * SEQ; q += qstep) {
        f32x4* hr = (f32x4*)(p->out + (size_t)q * D);
        f32x4 xv[4]; float ss = 0.f;
        row_cvt(1, xn, xv);
        { const int qn = q + qstep; if (qn < NB * SEQ) { const int bn = qn >= SEQ ? 1 : 0; row_load(p, 1, bn * SEG + CTXL + (qn - bn * SEQ), lane, xn); } }
#pragma unroll
        for (int j = 0; j < 4; ++j) ss += xv[j][0] * xv[j][0] + xv[j][1] * xv[j][1] + xv[j][2] * xv[j][2] + xv[j][3] * xv[j][3];
        ss = wave_sum(ss); const float rs = rsqrtf(ss * (1.f / 1024.f) + 1e-6f);
#pragma unroll
        for (int j = 0; j < 4; ++j) { const f32x4 g4 = *(const f32x4*)(p->g_final + 4 * lane + 256 * j); hr[lane + 64 * j] = xv[j] * rs * g4; }
    }
}


#define XB_TMO      128
#define XB_XCNT(j)  (256  + 64 * (j))
#define XB_XSUB(j)  (1280 + 64 * (j))
#define XB_XGEN(j)  (2304 + 64 * (j))
#define XB_TOP      3328
#define XB_TOPGEN   3392
#define XCD_BAR_WORDS 3456
#define XB_SPIN_CAP (1u << 22)
__device__ __forceinline__ unsigned xb_ld(unsigned* p) { return __hip_atomic_load(p, __ATOMIC_RELAXED, __HIP_MEMORY_SCOPE_AGENT); }
__device__ __forceinline__ unsigned xb_add(unsigned* p, unsigned v) { return __hip_atomic_fetch_add(p, v, __ATOMIC_RELAXED, __HIP_MEMORY_SCOPE_AGENT); }
__device__ __forceinline__ unsigned xb_xcc_id() { return (unsigned)__builtin_amdgcn_s_getreg((3 << 11) | 20) & 0xFu; }
#define XB_SPIN(cond, bar) do { unsigned _sp = 0; while (cond) { __builtin_amdgcn_s_sleep(1); \
    if ((++_sp & 255u) == 0u) { if (xb_ld(&(bar)[XB_TMO])) break; if (_sp > XB_SPIN_CAP) { atomicAdd(&(bar)[XB_TMO], 1u); break; } } } } while (0)
struct XcdBarrier { unsigned* bar; unsigned x; volatile LAS unsigned* st; };
__device__ __forceinline__ XcdBarrier xcd_barrier_post(unsigned* bar, volatile LAS unsigned* st) {
    XcdBarrier b; b.bar = bar; b.x = xb_xcc_id(); b.st = st;
    if (threadIdx.x == 0) (void)xb_add(&bar[XB_XCNT(b.x)], 1u);
    return b;
}
__device__ __forceinline__ void xcd_barrier_complete(unsigned* bar, unsigned x, unsigned& nloc, unsigned& nx) {
    const unsigned G = gridDim.x * gridDim.y * gridDim.z;
    unsigned sum, cnt, mine, sp = 0u;
    for (;;) {
        sum = 0u; cnt = 0u; mine = 0u;
#pragma unroll
        for (unsigned j = 0; j < 16; ++j) { const unsigned c = xb_ld(&bar[XB_XCNT(j)]); sum += c; cnt += (c > 0u) ? 1u : 0u; mine = (j == x) ? c : mine; }
        if (sum == G) break;
        __builtin_amdgcn_s_sleep(1);
        if ((++sp & 255u) == 0u) { if (xb_ld(&bar[XB_TMO])) break; if (sp > XB_SPIN_CAP) { atomicAdd(&bar[XB_TMO], 1u); break; } }
    }
    nloc = mine > 0u ? mine : 1u; nx = cnt > 0u ? cnt : 1u;
}
__device__ __forceinline__ void xcd_barrier(const XcdBarrier& b) {
    asm volatile("s_waitcnt vmcnt(0)" ::: "memory");
    __syncthreads();
    if (threadIdx.x == 0) {
        unsigned* bar = b.bar;
        __builtin_amdgcn_s_waitcnt(0);
        unsigned nloc = b.st[0], nx = b.st[1];
        if (nloc == 0u) { xcd_barrier_complete(bar, b.x, nloc, nx); b.st[0] = nloc; b.st[1] = nx; }
        const unsigned old = xb_add(&bar[XB_XSUB(b.x)], 1u);
        const unsigned gen = old / nloc;
        if (old + 1u == (gen + 1u) * nloc) {
            __builtin_amdgcn_fence(__ATOMIC_RELEASE, "agent");
            asm volatile("s_waitcnt vmcnt(0)" ::: "memory");
            const unsigned og = xb_add(&bar[XB_TOP], 1u);
            const unsigned tg = og / nx;
            if (og + 1u == (tg + 1u) * nx) xb_add(&bar[XB_TOPGEN], 1u);
            else XB_SPIN(xb_ld(&bar[XB_TOPGEN]) == tg, bar);
            __builtin_amdgcn_fence(__ATOMIC_ACQUIRE, "agent");
            xb_add(&bar[XB_XGEN(b.x)], 1u);
            asm volatile("s_waitcnt vmcnt(0)" ::: "memory");
        } else {
            XB_SPIN(xb_ld(&bar[XB_XGEN(b.x)]) == gen, bar);
            __builtin_amdgcn_fence(__ATOMIC_ACQUIRE, "agent");
            asm volatile("s_waitcnt vmcnt(0)" ::: "memory");
        }
    }
    __syncthreads();
}

#ifndef TIMING_A
#define TIMING_A -1
#endif
#ifndef TIMING_B
#define TIMING_B -1
#endif
#ifndef PHASE_MASK
#define PHASE_MASK 0xFFFFF
#endif
#define PM(i) ((PHASE_MASK >> (i)) & 1)
#ifndef REPEAT_MASK
#define REPEAT_MASK 0
#endif
#define RP(i) for (int rep_ = 0; rep_ < 1 + ((REPEAT_MASK >> (i)) & 1); ++rep_)
constexpr int PH_PER_LAYER = 9, NPHASES = 1 + DEPTH * PH_PER_LAYER + 1;
__global__ void __launch_bounds__(NTHREADS, 2) mk_fwd(Args args) {
    extern __shared__ __attribute__((aligned(16))) unsigned char lds[];
    cg::grid_group grid = cg::this_grid();
    const __attribute__((address_space(4))) Args* ap = (const __attribute__((address_space(4))) Args*)__builtin_amdgcn_kernarg_segment_ptr();
    const int lo = ap->lo, hi = ap->hi;
    LAS unsigned char* ldsl = (LAS unsigned char*)lds;
    volatile LAS unsigned* xbst = (volatile LAS unsigned*)(ldsl + LDS_BYTES - 16);
    if (threadIdx.x < 4) xbst[threadIdx.x] = 0u;
    __syncthreads();
    (void)xcd_barrier_post((unsigned*)(ap->p.ws + WS_BAR), xbst);
    if (TIMING_A >= 0 && blockIdx.x == 0 && threadIdx.x == 0) ((unsigned long long*)(ap->p.ws + WS_TS))[lo] = __builtin_amdgcn_s_memrealtime();
    for (int ph = lo; ph < hi; ++ph) {
        CP p = launder(&ap->p);
        int bid = blockIdx.x, nb = gridDim.x; asm volatile("" : "+s"(bid), "+s"(nb));
        if (ph == 0) { if (PM(0)) RP(0) phase_wprep(p, lds, 0, 912, bid, nb); if (PM(1)) RP(1) phase_adaln(p, lds, bid, nb); }
        else if (ph == NPHASES - 1) { if (PM(12)) phase_final(p, lds, bid, nb); }
        else {
            const int l = (ph - 1) / PH_PER_LAYER, s = (ph - 1) % PH_PER_LAYER;
            if (s == 0) { if (PM(2)) RP(2) { if (rep_ == 0 || l == 0) phase_r1(p, l, lds, bid, nb); } }
            else if (s == 1) { if (PM(3)) RP(3) {
                pg8::DenseSched S; S.init(p->ws + WS_HX, (const bf16_t*)(p->ws + WS_WTIN) + (size_t)l * DIN * 1024, R, NPROJ, 1024, 1024, 1024, nb, bid);
                EpiProj E{(bf16_t*)(p->ws + WS_PROJ)};
                pg8::gemm_phase<EpiProj, pg8::DenseSched, false>(ldsl, 1024, 1024, 1024, S, E);
                {
                    const int extra = S.nwg % nb; const int L1 = WPREP_ITEMS_PER_LAYER;
                    const int a0 = l == 0 ? 912 : L1 + 656, a1 = l == 0 ? 2960 : L1 + 2960;
                    if (l <= 1 && DEPTH == 2) { if (extra > 0 && bid >= extra) phase_wprep(p, lds, a0, a1, bid - extra, nb - extra); else if (extra == 0) phase_wprep(p, lds, a0, a1, bid, nb); } }
            } }
            else if (s == 2) { if (PM(4)) RP(4) phase_c1(p, l, lds, bid, nb); if (PM(5)) RP(5) phase_s1(p, l, lds, bid, nb); }
            else if (s == 3) { if (PM(6)) RP(6) phase_s2(p, bid, nb); }
            else if (s == 4) { if (PM(7)) RP(7) phase_s3(p, l, lds, bid, nb);
                if (PM(4)) {
                    const int cpb = NCHUNK - ((l == DEPTH - 1) ? 2 : 0), nunits = NB * cpb * 2, tail = (nunits % nb) * 4;
                    if (tail > 0 && tail < nb) { if (bid >= tail) phase_c1_ln(p, l, bid - tail, nb - tail); } else phase_c1_ln(p, l, bid, nb); } }
            else if (s == 5) { if (PM(8)) RP(8) { if (rep_ == 0 || l == 0) {
                pg8::DenseSched S; S.init(p->ws + WS_HX, (const bf16_t*)(p->ws + WS_WTOUT) + (size_t)l * 1024 * 1024, R, 1024, 1024, 1024, 1024, nb, bid, l == DEPTH - 1);
                EpiResid<0> E{p->ctx, p->x, (bf16_t*)(p->ws + WS_H), (const float*)(p->ws + WS_MOD) + (size_t)l * 3 * 6144, (const float*)(p->ws + WS_SSQ)};
                pg8::gemm_phase<EpiResid<0>, pg8::DenseSched, false>(ldsl, 1024, 1024, 1024, S, E);
                if (l == 0 && DEPTH == 2 && rep_ == 0) { const int extra = S.nwg % nb; const int L1 = WPREP_ITEMS_PER_LAYER;
                    if (extra > 0 && bid >= extra) phase_wprep(p, lds, 2960, 3984, bid - extra, nb - extra, L1, L1 + 656, L1 + 2960, L1 + 3984);
                    else if (extra == 0) phase_wprep(p, lds, 2960, 3984, bid, nb, L1, L1 + 656, L1 + 2960, L1 + 3984); }
            } } }
            else if (s == 6) { if (PM(9)) phase_r2(p, l, lds, bid, nb); }
            else if (s == 7) { if (PM(10)) {
                LAS int* tab = (LAS int*)(ldsl + MISC_OFF);
                LAS float* gl = (LAS float*)(ldsl + MISC_OFF + 4096);
                { const float* modl = (const float*)(p->ws + WS_MOD) + (size_t)l * 3 * 6144 + 5 * 1024; float tg[6]; const int tt = launder_tid();
#pragma unroll
                  for (int it = 0; it < 6; ++it) { const int i = tt + NTHREADS * it; tg[it] = modl[(size_t)(i >> 10) * 6144 + (i & 1023)]; }
#pragma unroll
                  for (int it = 0; it < 6; ++it) gl[tt + NTHREADS * it] = tg[it]; }
                moe_table(p, l, tab);
                unsigned* ready = (unsigned*)(p->ws + WS_M1CNT) + l * 192;
                { MoeSched S{tab, (const int*)(p->ws + WS_LIST), (const char*)(p->ws + WS_HX), (const char*)(p->ws + WS_WTGU), 0, l, nb, bid, ready, 0};
                  EpiUp E{(bf16_t*)(p->ws + WS_HID), (const float*)(p->ws + WS_CWLA), (const float*)(p->ws + WS_CWLB), ready};
                  pg8::gemm_phase<EpiUp, MoeSched, true>(ldsl, 1024, 1024, 1024, S, E); }
                { const int total = __builtin_amdgcn_readfirstlane(tab[24]) * 4; const int extra = __builtin_amdgcn_readfirstlane(total % nb);
                  MoeSched S{tab, (const int*)(p->ws + WS_LIST), (const char*)(p->ws + WS_HID), (const char*)(p->ws + WS_WTD), 1, l, nb, bid, ready, (total >= nb && total - extra >= nb) ? extra : 0};
                  EpiDown E{(bf16_t*)(p->ws + WS_H), (const int*)(p->ws + WS_LIST), gl};
                  pg8::gemm_phase<EpiDown, MoeSched, false>(ldsl, 512, 256, 512, S, E); }
            } }
            else { }
        }
        if (ph + 1 < hi && !(ph > 0 && ph < NPHASES - 1 && (ph - 1) % PH_PER_LAYER == 7)) { if (hi < 0) grid.sync();   else { XcdBarrier xb; xb.bar = (unsigned*)(launder(&ap->p)->ws + WS_BAR); xb.x = xb_xcc_id(); xb.st = (volatile LAS unsigned*)(ldsl + LDS_BYTES - 16); xcd_barrier(xb); }
            if (TIMING_A >= 0 && blockIdx.x == 0 && threadIdx.x == 0) ((unsigned long long*)(launder(&ap->p)->ws + WS_TS))[ph + 1] = __builtin_amdgcn_s_memrealtime(); }
    }
#if TIMING_A >= 0
    {
        XcdBarrier xb; xb.bar = (unsigned*)(launder(&ap->p)->ws + WS_BAR); xb.x = xb_xcc_id(); xb.st = (volatile LAS unsigned*)(ldsl + LDS_BYTES - 16); xcd_barrier(xb);
        if (blockIdx.x == 0 && threadIdx.x == 0) ((unsigned long long*)(launder(&ap->p)->ws + WS_TS))[hi] = __builtin_amdgcn_s_memrealtime();
        xcd_barrier(xb);
        const unsigned long long* ts = (const unsigned long long*)(launder(&ap->p)->ws + WS_TS);
        const float ta = (float)(ts[TIMING_A + 1] - ts[TIMING_A]) * 0.01f, tb = (float)(ts[TIMING_B + 1] - ts[TIMING_B]) * 0.01f;
        float* o = launder(&ap->p)->out; const float sc = 1.f + ta * 0.001f;
        for (size_t i = (size_t)blockIdx.x * NTHREADS + threadIdx.x; i < (size_t)NB * SEQ * D; i += (size_t)gridDim.x * NTHREADS) o[i] = o[i] * sc + (i == 0 ? tb * 0.1f : 0.f);
    }
#endif
}

extern "C" void kernel_launch(void* const* d_in, const int* in_sizes, int n_in, void* d_out, int out_size, void* d_ws, size_t ws_size, hipStream_t stream) {
    static int grid = 0;
    if (grid == 0) {
        if (n_in != 28 || ws_size < WS_END) { fprintf(stderr, "kernel_launch: unexpected n_in %d or ws_size %zu (< %zu)\n", n_in, ws_size, (size_t)WS_END); grid = -1; return; }
        int dev = 0, cus = 0, per_cu = 0;
        hipGetDevice(&dev); hipDeviceGetAttribute(&cus, hipDeviceAttributeMultiprocessorCount, dev);
        if (hipFuncSetAttribute((const void*)mk_fwd, hipFuncAttributeMaxDynamicSharedMemorySize, LDS_BYTES) != hipSuccess) { fprintf(stderr, "kernel_launch: hipFuncSetAttribute failed\n"); grid = -1; return; }
        if (hipOccupancyMaxActiveBlocksPerMultiprocessor(&per_cu, (const void*)mk_fwd, NTHREADS, LDS_BYTES) != hipSuccess || per_cu < 1) { fprintf(stderr, "kernel_launch: occupancy query says %d\n", per_cu); (void)hipGetLastError(); grid = -1; return; }
        grid = cus;
    }
    if (grid < 0) return;
    (void)hipMemsetAsync((char*)d_ws + WS_CTL, 0, WS_CTL_BYTES, stream);
    Args a{};
    const float** pp = (const float**)&a.p;
    for (int i = 0; i < 28; ++i) pp[i] = (const float*)d_in[i];
    a.p.out = (float*)d_out; a.p.ws = (unsigned char*)d_ws;
#if PER_PHASE_LAUNCH
    for (int ph = 0; ph < NPHASES; ++ph) {
        a.lo = ph; a.hi = ph + 1; void* kargs[] = {&a};
        hipError_t e = hipLaunchCooperativeKernel((const void*)mk_fwd, dim3(grid), dim3(NTHREADS), kargs, LDS_BYTES, stream);
        if (e != hipSuccess) { fprintf(stderr, "kernel_launch: launch of phase %d failed: %s\n", ph, hipGetErrorString(e)); break; }
    }
#else
    a.lo = 0; a.hi = NPHASES; void* kargs[] = {&a};
    hipError_t e = hipLaunchCooperativeKernel((const void*)mk_fwd, dim3(grid), dim3(NTHREADS), kargs, LDS_BYTES, stream);
    if (e != hipSuccess) fprintf(stderr, "kernel_launch: cooperative launch failed: %s (grid %d)\n", hipGetErrorString(e), grid);
#endif
}
```

```cpp
#include <hip/hip_runtime.h>
#include <hip/hip_cooperative_groups.h>
#include <cstdio>
namespace cg = cooperative_groups;

#ifndef PER_PHASE_LAUNCH
#define PER_PHASE_LAUNCH 0
#endif

#ifndef S3REP
#define S3REP 0
#endif
#define S3R(i) for (int r3_ = 0; r3_ < 1 + ((S3REP >> (i)) & 1); ++r3_)
#define LAS __attribute__((address_space(3)))
typedef unsigned short bf16_t;
typedef short bf16x8 __attribute__((ext_vector_type(8)));
typedef float f32x4 __attribute__((ext_vector_type(4)));
typedef unsigned u32x4 __attribute__((ext_vector_type(4)));
typedef unsigned u32x2 __attribute__((ext_vector_type(2)));

constexpr int D = 1024, NB = 2, SEQ = 16384, CTXL = 256, SEG = SEQ + CTXL, R = NB * SEG, DEPTH = 2;
constexpr int NPROJ = 2560, DIN = 2576;
constexpr int NTHREADS = 512;
constexpr int LDS_BYTES = 163840;
constexpr int MISC_OFF = 131072;
constexpr int NCLS = 24;

constexpr size_t al256(size_t x) { return (x + 255) & ~size_t(255); }
constexpr size_t WS_CTL = 0;
constexpr size_t WS_M1CNT = 20480;
constexpr size_t WS_TS = 2048;
constexpr size_t WS_BAR = 4096;
constexpr size_t WS_CTL_BYTES = 32768;
constexpr size_t WS_MOD = WS_CTL_BYTES;
constexpr size_t WS_WTIN = WS_MOD + al256((size_t)2 * 3 * 6144 * 4);
constexpr size_t WS_WTOUT = WS_WTIN + al256((size_t)2 * DIN * 1024 * 2);
constexpr size_t WS_WTGU = WS_WTOUT + al256((size_t)2 * 1024 * 1024 * 2);
constexpr size_t WS_WTD = WS_WTGU + al256((size_t)2 * 16 * 512 * 1024 * 2);
constexpr size_t WS_H = WS_WTD + al256((size_t)2 * 16 * 1024 * 256 * 2);
constexpr size_t WS_HX = WS_H + al256((size_t)R * 1024 * 2);
constexpr size_t WS_PROJ = WS_HX + al256((size_t)R * 1024 * 2);
constexpr size_t WS_DT = WS_PROJ + al256((size_t)R * NPROJ * 2);
constexpr size_t WS_POS = WS_DT + al256((size_t)R * 16 * 4);
constexpr size_t WS_LIST = WS_POS + al256((size_t)2 * R * 4);
constexpr size_t WS_CWLA = WS_LIST + al256((size_t)NCLS * R * 4);
constexpr size_t WS_CWLB = WS_CWLA + al256((size_t)NCLS * R * 4);
constexpr size_t WS_BIG = WS_CWLB + al256((size_t)NCLS * R * 4);
constexpr size_t WS_Y = WS_PROJ;
constexpr size_t WS_S = WS_BIG;
constexpr size_t WS_HP = WS_S + al256((size_t)2 * 2 * 130 * 8 * 8192 * 2);
constexpr size_t WS_DEC = WS_HP + al256((size_t)2 * 2 * 130 * 8 * 8192 * 2);
constexpr size_t WS_SSQ = WS_DEC + al256((size_t)2 * 2 * 130 * 8 * 4);
constexpr size_t WS_HID = WS_S;
constexpr size_t WS_END = WS_SSQ + al256((size_t)R * 8 * 4);
static_assert((size_t)(R + NCLS * 256) * 512 * 2 <= (size_t)2 * 2 * 130 * 8 * 8192 * 2, "hid alias");
static_assert(WS_END <= (size_t)512 * 1024 * 1024, "workspace");

struct Params {
    const float *x, *c, *ctx, *c_ctx, *w_ada, *b_ada, *g_mix, *g_ffn, *w_in, *conv_w, *conv_b, *conv_ln_g, *conv_ln_b, *ssd_conv_w, *ssd_conv_b,
        *dt_bias, *a_log, *d_skip, *ssd_norm_g, *w_out, *w_rg, *b_rg, *w_re, *b_re, *w_gate, *w_up, *w_down, *g_final;
    float* out; unsigned char* ws;
};
struct Args { Params p; int lo, hi; };
typedef const __attribute__((address_space(4))) Params* CP;
__device__ __forceinline__ CP launder(CP p) { asm volatile("" : "+s"(p)); return p; }
__device__ __forceinline__ int launder_tid() { int t = threadIdx.x; asm volatile("" : "+v"(t)); return t; }

__device__ __forceinline__ unsigned cvt_pk_bf16(float lo, float hi) { unsigned r; asm("v_cvt_pk_bf16_f32 %0, %1, %2" : "=v"(r) : "v"(lo), "v"(hi)); return r; }
__device__ __forceinline__ float bf2f(unsigned b) { return __uint_as_float(b << 16); }
__device__ __forceinline__ float bflo(unsigned w) { return __uint_as_float(w << 16); }
__device__ __forceinline__ float bfhi(unsigned w) { return __uint_as_float(w & 0xffff0000u); }
__device__ __forceinline__ bf16_t f2bf(float f) { return (bf16_t)(cvt_pk_bf16(f, 0.f) & 0xffffu); }
#define DPP_ADD(v, ctrl, rm) ((v) + __builtin_bit_cast(float, __builtin_amdgcn_update_dpp(0, __builtin_bit_cast(int, (v)), (ctrl), (rm), 0xF, true)))
__device__ __forceinline__ float row_sum16(float v) {
    v = DPP_ADD(v, 0xB1, 0xF);
    v = DPP_ADD(v, 0x4E, 0xF);
    v = DPP_ADD(v, 0x141, 0xF);
    v = DPP_ADD(v, 0x140, 0xF);
    return v;
}
__device__ __forceinline__ float half_sum32(float v) { v = row_sum16(v); v = DPP_ADD(v, 0x142, 0xA); return v; }
__device__ __forceinline__ float wave_sum(float v) {
    v = half_sum32(v); v = DPP_ADD(v, 0x143, 0xC);
    return __builtin_bit_cast(float, __builtin_amdgcn_readlane(__builtin_bit_cast(int, v), 63));
}
__device__ __forceinline__ float sigmoidf_(float x) { return __builtin_amdgcn_rcpf(1.f + __builtin_amdgcn_exp2f(x * -1.44269504089f)); }
__device__ __forceinline__ float siluf_(float x) { return x * __builtin_amdgcn_rcpf(1.f + __builtin_amdgcn_exp2f(x * -1.44269504089f)); }
__device__ __forceinline__ float softplusf_(float x) { return fmaxf(x, 0.f) + __logf(1.f + __expf(-fabsf(x))); }

__device__ __forceinline__ int row_b(int r) { return r >= SEG ? 1 : 0; }
__device__ __forceinline__ int row_i(int r) { return r >= SEG ? r - SEG : r; }
__device__ __forceinline__ int row_v(int r) { const int i = row_i(r); return i < CTXL ? 2 : row_b(r); }
__device__ __forceinline__ const float* xin_ptr(const float* ctx, const float* x, int r) {
    const int b = row_b(r), i = row_i(r);
    return i < CTXL ? ctx + (size_t)(b * CTXL + i) * D : x + (size_t)(b * SEQ + i - CTXL) * D;
}
struct RowRaw { f32x4 f[4]; u32x2 h[4]; };
__device__ __forceinline__ void row_load(CP p, int l, int r, int lane, RowRaw& rr) {
    if (l == 0) { const f32x4* hr = (const f32x4*)xin_ptr(p->ctx, p->x, r);
#pragma unroll
        for (int j = 0; j < 4; ++j) rr.f[j] = __builtin_nontemporal_load(hr + lane + 64 * j); }
    else { const u32x2* hr = (const u32x2*)((const bf16_t*)(p->ws + WS_H) + (size_t)r * D);
#pragma unroll
        for (int j = 0; j < 4; ++j) rr.h[j] = hr[lane + 64 * j]; }
}
__device__ __forceinline__ void row_cvt(int l, const RowRaw& rr, f32x4 (&xv)[4]) {
#pragma unroll
    for (int j = 0; j < 4; ++j) xv[j] = l == 0 ? rr.f[j] : (f32x4){bflo(rr.h[j].x), bfhi(rr.h[j].x), bflo(rr.h[j].y), bfhi(rr.h[j].y)};
}
namespace pg8 {
constexpr int BM = 256, BK = 64, HALF = 128, HTB = HALF * BK * 2, STAGE_BYTES = 8 * HTB, NXCD = 8, WGM = 8;
__device__ __forceinline__ int lds_byte(int r, int c) { const int st = (r >> 4) * 2 + (c >> 5), rr = r & 15, cc = c & 31, ob = rr * 64 + cc * 2; return st * 1024 + (ob ^ (((ob >> 9) & 1) << 5)); }
__device__ __forceinline__ void stage_rc(int b, int& Rr, int& Cc) { const int st = b / 1024, sb = b % 1024, swz = sb ^ (((sb >> 9) & 1) << 5); Rr = (st >> 1) * 16 + swz / 64; Cc = (st & 1) * 32 + (swz % 64) / 2; }
__device__ __forceinline__ int perm32(int rho) { const int n = rho >> 4, i = rho & 15; return 8 * (i >> 2) + 4 * n + (i & 3); }

struct Unit {
    const char* a0;
    const char* b0;
    const char* b1;
    int i0, i1, i2, i3, i4, pad;
};

template <class Epi, class Sched, bool GATHER>
__device__ __forceinline__ void gemm_phase(LAS unsigned char* lds, const int lda, const int ldb, const int K, const Sched& S, const Epi& E) {
    const int tid = launder_tid(); const int wid = __builtin_amdgcn_readfirstlane(tid >> 6), lane = tid & 63, wr = wid >> 2, wc = wid & 3, fr = lane & 15, fq = lane >> 4;
    const int nt = K / BK, ks = nt >> 1;
    int Rr[2], Cc[2];
    unsigned voffB[2];
#pragma unroll
    for (int i = 0; i < 2; ++i) { stage_rc(tid * 16 + i * 8192, Rr[i], Cc[i]); const int Rb = Epi::PERM ? ((Rr[i] & ~31) + perm32(Rr[i] & 31)) : Rr[i];
        voffB[i] = (unsigned)(Rb * ldb + Cc[i]) * 2u; }
    const size_t kstep = (size_t)(BK * 2);
    const size_t hstepB = (size_t)HALF * ldb * 2;
    const unsigned ldsw = (unsigned)wid * 1024u;
    const unsigned ldsbase = (unsigned)(unsigned long)lds;
    const int aoff = lds_byte(wr * 64 + fr, fq * 8), boff = lds_byte(wc * 32 + fr, fq * 8);
#define PG8_SA(b, h) (((b) * 2 + (h)) * HTB)
#define PG8_SB(b, h) ((4 + (b) * 2 + (h)) * HTB)
#define PG8_STAGE2(bufoff, gbase, v0, v1) do { unsigned keep_; \
        asm volatile("s_mov_b32 %0, m0\n\ts_mov_b32 m0, %1\n\ts_nop 4\n\tglobal_load_lds_dwordx4 %2, %4\n\ts_add_u32 m0, m0, 0x2000\n\ts_nop 0\n\tglobal_load_lds_dwordx4 %3, %4\n\ts_mov_b32 m0, %0" \
            : "=&s"(keep_) : "s"(ldsbase + (unsigned)(bufoff) + ldsw), "v"(v0), "v"(v1), "s"(gbase) : "memory", "scc"); } while (0)
#define PG8_LDA(dst, b, h) do { _Pragma("unroll") for (int m = 0; m < 4; ++m) _Pragma("unroll") for (int k = 0; k < 2; ++k) dst[m][k] = *(const LAS bf16x8*)(lds + PG8_SA(b, h) + aoff + m * 2048 + k * 1024); } while (0)
#define PG8_LDB(dst, b, h) do { _Pragma("unroll") for (int n = 0; n < 2; ++n) _Pragma("unroll") for (int k = 0; k < 2; ++k) dst[n][k] = *(const LAS bf16x8*)(lds + PG8_SB(b, h) + boff + n * 2048 + k * 1024); } while (0)
#define PG8_MMA(ai, bj, At, Bt) do { __builtin_amdgcn_s_setprio(1); _Pragma("unroll") for (int m = 0; m < 4; ++m) _Pragma("unroll") for (int n = 0; n < 2; ++n) _Pragma("unroll") for (int k = 0; k < 2; ++k) \
        acc[ai][bj][m][n] = __builtin_amdgcn_mfma_f32_16x16x32_bf16(Bt[n][k], At[m][k], acc[ai][bj][m][n], 0, 0, 0); __builtin_amdgcn_s_setprio(0); } while (0)
#define PG8_WAIT_V(n) asm volatile("s_waitcnt vmcnt(" #n ")" ::: "memory")
#define PG8_WAIT_L(n) asm volatile("s_waitcnt lgkmcnt(" #n ")" ::: "memory")
#define PG8_BAR __builtin_amdgcn_s_barrier()
#define PG8_SCHED __builtin_amdgcn_sched_barrier(0)
#define PG8_BP(u, tt) ((tt) < ks ? (u).b0 + (size_t)(tt) * kstep : (u).b1 + (size_t)((tt) - ks) * kstep)
    Unit cur, nxt; int ui = 0;
    if (!S.get(0, cur)) return;
    S.a_ready(cur);
    unsigned c00, c01, c10, c11, n00, n01, n10, n11;
    if (GATHER) {
        c00 = (unsigned)(S.arow(cur, Rr[0]) * lda + Cc[0]) * 2u; c01 = (unsigned)(S.arow(cur, Rr[1]) * lda + Cc[1]) * 2u;
        c10 = (unsigned)(S.arow(cur, HALF + Rr[0]) * lda + Cc[0]) * 2u; c11 = (unsigned)(S.arow(cur, HALF + Rr[1]) * lda + Cc[1]) * 2u;
    } else {
        c00 = (unsigned)(Rr[0] * lda + Cc[0]) * 2u; c01 = (unsigned)(Rr[1] * lda + Cc[1]) * 2u;
        c10 = (unsigned)((HALF + Rr[0]) * lda + Cc[0]) * 2u; c11 = (unsigned)((HALF + Rr[1]) * lda + Cc[1]) * 2u;
    }
    n00 = c00; n01 = c01; n10 = c10; n11 = c11;
    f32x4 acc[2][2][4][2];
    float zr; asm volatile("v_mov_b32 %0, 0" : "=v"(zr));
#pragma unroll
    for (int a = 0; a < 2; ++a)
#pragma unroll
        for (int b = 0; b < 2; ++b)
#pragma unroll
            for (int m = 0; m < 4; ++m)
#pragma unroll
                for (int n = 0; n < 2; ++n) acc[a][b][m][n] = (f32x4){zr, zr, zr, zr};
    bf16x8 At[4][2], B0[2][2], B1[2][2];
    const char* cA = cur.a0;
    {
        const char* pb0 = PG8_BP(cur, 0); const char* pb1 = PG8_BP(cur, 1);
        PG8_STAGE2(PG8_SB(0, 0), pb0, voffB[0], voffB[1]); PG8_STAGE2(PG8_SA(0, 0), cA, c00, c01);
        PG8_STAGE2(PG8_SB(0, 1), pb0 + hstepB, voffB[0], voffB[1]); PG8_STAGE2(PG8_SA(0, 1), cA, c10, c11);
        if (wr == 1) PG8_BAR;
        PG8_WAIT_V(4); PG8_BAR;
        PG8_STAGE2(PG8_SB(1, 0), pb1, voffB[0], voffB[1]); PG8_STAGE2(PG8_SA(1, 0), cA + kstep, c00, c01);
        PG8_STAGE2(PG8_SB(1, 1), pb1 + hstepB, voffB[0], voffB[1]);
        PG8_WAIT_V(6); PG8_BAR;
    }
    for (;;) {
        const bool has_next = S.get(ui + 1, nxt);
        if (!has_next) nxt = cur;
        LAS int* tokb = (LAS int*)(lds + MISC_OFF + 1024) + ((ui + 1) & 1) * 256;
        if (GATHER) {
            n00 = c00; n01 = c01; n10 = c10; n11 = c11;
            if (has_next && wid == 0) {
                const char* src = (const char*)S.rows_ptr(nxt); unsigned keep_;
                asm volatile("s_mov_b32 %0, m0\n\ts_mov_b32 m0, %1\n\ts_nop 4\n\tglobal_load_lds_dwordx4 %2, %3\n\ts_mov_b32 m0, %0"
                    : "=&s"(keep_) : "s"((unsigned)(unsigned long)tokb), "v"((unsigned)lane * 16u), "s"(src) : "memory");
            }
        }
        const char* nA = nxt.a0;
#pragma unroll 1
        for (int t = 0; t < nt; t += 2) {
            const bool last = (t == nt - 2);
            if (last && has_next) S.a_ready(nxt);
            const char* a1 = cA + (size_t)(t + 1) * kstep;
            const char* a2 = last ? nA : cA + (size_t)(t + 2) * kstep;
            const char* a3 = a2 + kstep;
            const char* b2 = last ? PG8_BP(nxt, 0) : PG8_BP(cur, t + 2);
            const char* b3 = last ? PG8_BP(nxt, 1) : PG8_BP(cur, t + 3);
            if (GATHER) { if (last && has_next) {
                const int lim = S.rows_valid(nxt) - 1;
                const int i0 = Rr[0] < lim ? Rr[0] : lim, i1 = Rr[1] < lim ? Rr[1] : lim, i2 = (HALF + Rr[0]) < lim ? (HALF + Rr[0]) : lim, i3 = (HALF + Rr[1]) < lim ? (HALF + Rr[1]) : lim;
                n00 = (unsigned)(tokb[i0] * lda + Cc[0]) * 2u; n01 = (unsigned)(tokb[i1] * lda + Cc[1]) * 2u;
                n10 = (unsigned)(tokb[i2] * lda + Cc[0]) * 2u; n11 = (unsigned)(tokb[i3] * lda + Cc[1]) * 2u; } }
            const unsigned s00 = last ? n00 : c00, s01 = last ? n01 : c01, s10 = last ? n10 : c10, s11 = last ? n11 : c11;
            if constexpr (Epi::MIDSCALE) { if (t == ks) E.midscale(acc, cur, wr, wc, fr, fq); }
            PG8_LDB(B0, 0, 0); PG8_SCHED; PG8_LDA(At, 0, 0); PG8_STAGE2(PG8_SA(1, 1), a1, c10, c11);
            PG8_WAIT_L(8); PG8_BAR; PG8_WAIT_L(0); PG8_MMA(0, 0, At, B0); PG8_BAR; PG8_SCHED;
            PG8_LDB(B1, 0, 1); PG8_STAGE2(PG8_SB(0, 0), b2, voffB[0], voffB[1]);
            PG8_BAR; PG8_WAIT_L(0); PG8_MMA(0, 1, At, B1); PG8_BAR;
            PG8_LDA(At, 0, 1); PG8_STAGE2(PG8_SA(0, 0), a2, s00, s01);
            PG8_BAR; PG8_WAIT_L(0); PG8_MMA(1, 0, At, B0); PG8_BAR; PG8_SCHED;
            PG8_STAGE2(PG8_SB(0, 1), b2 + hstepB, voffB[0], voffB[1]);
            PG8_WAIT_V(6); PG8_BAR; PG8_MMA(1, 1, At, B1); PG8_BAR;
            PG8_LDB(B0, 1, 0); PG8_SCHED; PG8_LDA(At, 1, 0); PG8_STAGE2(PG8_SA(0, 1), a2, s10, s11);
            PG8_WAIT_L(8); PG8_BAR; PG8_WAIT_L(0); PG8_MMA(0, 0, At, B0); PG8_BAR; PG8_SCHED;
            PG8_LDB(B1, 1, 1); PG8_STAGE2(PG8_SB(1, 0), b3, voffB[0], voffB[1]);
            PG8_BAR; PG8_WAIT_L(0); PG8_MMA(0, 1, At, B1); PG8_BAR;
            PG8_LDA(At, 1, 1); PG8_STAGE2(PG8_SA(1, 0), a3, s00, s01);
            PG8_BAR; PG8_WAIT_L(0); PG8_MMA(1, 0, At, B0); PG8_BAR; PG8_SCHED;
            PG8_STAGE2(PG8_SB(1, 1), b3 + hstepB, voffB[0], voffB[1]);
            PG8_WAIT_V(6); PG8_BAR; PG8_MMA(1, 1, At, B1); PG8_BAR;
        }
        E(acc, cur, wr, wc, fr, fq);
        if (!has_next) break;
        asm volatile("v_mov_b32 %0, 0" : "=v"(zr));
#pragma unroll
        for (int a = 0; a < 2; ++a)
#pragma unroll
            for (int b = 0; b < 2; ++b)
#pragma unroll
                for (int m = 0; m < 4; ++m)
#pragma unroll
                    for (int n = 0; n < 2; ++n) acc[a][b][m][n] = (f32x4){zr, zr, zr, zr};
        cur = nxt; cA = nA; ++ui; c00 = n00; c01 = n01; c10 = n10; c11 = n11;
    }
    PG8_WAIT_V(0);
    if (wr == 0) PG8_BAR;
    PG8_BAR;
#undef PG8_SA
#undef PG8_SB
#undef PG8_STAGE2
#undef PG8_LDA
#undef PG8_LDB
#undef PG8_MMA
#undef PG8_WAIT_V
#undef PG8_WAIT_L
#undef PG8_BAR
#undef PG8_SCHED
#undef PG8_BP
}

struct DenseSched {
    const char* A; const char* Bt; int lda, ldb, K; int nM, nN, nwg, G, c, skipctx;
    __device__ __forceinline__ void init(const void* A_, const void* Bt_, int M, int N, int K_, int lda_, int ldb_, int G_, int c_, int skipctx_ = 0) {
        A = (const char*)A_; Bt = (const char*)Bt_; lda = lda_; ldb = ldb_; K = K_; nM = M / BM - 2 * skipctx_; nN = N / BM; nwg = nM * nN; G = G_; c = c_; skipctx = skipctx_; }
    __device__ __forceinline__ bool get(int i, Unit& u) const {
        const long L = (long)i * G + c; if (L >= nwg) return false;
        int wgid = (int)L; { const int q = nwg / NXCD, r = nwg % NXCD, xcd = wgid % NXCD, off = wgid / NXCD; wgid = (xcd < r ? xcd * (q + 1) : r * (q + 1) + (xcd - r) * q) + off; }
        const int nig = WGM * nN, gid = wgid / nig, fm = gid * WGM, gsz = (nM - fm) < WGM ? (nM - fm) : WGM;
        int pm = fm + ((wgid % nig) % gsz); const int pn = (wgid % nig) / gsz;
        if (skipctx) pm += 1 + (pm >= 64 ? 1 : 0);
        u.a0 = A + (size_t)pm * BM * lda * 2; u.b0 = Bt + (size_t)pn * BM * ldb * 2; u.b1 = u.b0 + (size_t)(K / BK / 2) * BK * 2;
        u.i0 = pm; u.i1 = pn; u.i2 = 0; u.i3 = 0; u.i4 = 0; u.pad = 0; return true;
    }
    __device__ __forceinline__ void a_ready(const Unit&) const {}
    __device__ __forceinline__ int arow(const Unit&, int rl) const { return rl; }
    __device__ __forceinline__ const int* rows_ptr(const Unit&) const { return nullptr; }
    __device__ __forceinline__ int rows_valid(const Unit&) const { return 256; }
};
}

struct EpiProj {
    static constexpr bool PERM = true, MIDSCALE = false;
    bf16_t* O;
    __device__ __forceinline__ void operator()(const f32x4 (&acc)[2][2][4][2], const pg8::Unit& u, int wr, int wc, int fr, int fq) const {
        const int pn = u.i1;
        const int row0 = u.i0 * 256 + wr * 64 + fr;
        if (pn < 4) {
            const int col0 = pn * 128 + wc * 32 + 8 * fq;
#pragma unroll
            for (int ai = 0; ai < 2; ++ai)
#pragma unroll
                for (int m = 0; m < 4; ++m) { const f32x4 u0 = acc[ai][0][m][0], u1 = acc[ai][0][m][1], g0 = acc[ai][1][m][0], g1 = acc[ai][1][m][1];
                    u32x4 w; w.x = cvt_pk_bf16(u0[0] * sigmoidf_(g0[0]), u0[1] * sigmoidf_(g0[1])); w.y = cvt_pk_bf16(u0[2] * sigmoidf_(g0[2]), u0[3] * sigmoidf_(g0[3]));
                    w.z = cvt_pk_bf16(u1[0] * sigmoidf_(g1[0]), u1[1] * sigmoidf_(g1[1])); w.w = cvt_pk_bf16(u1[2] * sigmoidf_(g1[2]), u1[3] * sigmoidf_(g1[3]));
                    __builtin_nontemporal_store(w, (u32x4*)(O + (size_t)(row0 + ai * 128 + m * 16) * NPROJ + col0)); }
        } else {
            const int col0 = pn * 256 + wc * 32 + 8 * fq; const bool sl = pn < 6;
#pragma unroll
            for (int ai = 0; ai < 2; ++ai)
#pragma unroll
                for (int m = 0; m < 4; ++m) { bf16_t* rowp = O + (size_t)(row0 + ai * 128 + m * 16) * NPROJ + col0;
#pragma unroll
                    for (int bj = 0; bj < 2; ++bj) { f32x4 v0 = acc[ai][bj][m][0], v1 = acc[ai][bj][m][1];
                        if (sl) {
#pragma unroll
                            for (int e = 0; e < 4; ++e) { v0[e] = siluf_(v0[e]); v1[e] = siluf_(v1[e]); } }
                        u32x4 w; w.x = cvt_pk_bf16(v0[0], v0[1]); w.y = cvt_pk_bf16(v0[2], v0[3]); w.z = cvt_pk_bf16(v1[0], v1[1]); w.w = cvt_pk_bf16(v1[2], v1[3]);
                        __builtin_nontemporal_store(w, (u32x4*)(rowp + bj * 128)); } }
        }
    }
};
template <int L0> struct EpiResid {
    static constexpr bool PERM = true, MIDSCALE = true;
    const float* inc; const float* inx; bf16_t* H; const float* modl; const float* ssq;
    __device__ __forceinline__ void midscale(f32x4 (&acc)[2][2][4][2], const pg8::Unit& u, int wr, int wc, int fr, int fq) const {
        typedef float f32x2 __attribute__((ext_vector_type(2)));
        const int r0 = u.i0 * 256 + wr * 64 + fr;
        f32x2 part[2][4];
#pragma unroll
        for (int ai = 0; ai < 2; ++ai)
#pragma unroll
            for (int m = 0; m < 4; ++m) part[ai][m] = *(const f32x2*)(ssq + (size_t)(r0 + ai * 128 + m * 16) * 8 + 2 * fq);
#pragma unroll
        for (int ai = 0; ai < 2; ++ai)
#pragma unroll
            for (int m = 0; m < 4; ++m) { float sq = part[ai][m][0] + part[ai][m][1];
                sq += __shfl_xor(sq, 16); sq += __shfl_xor(sq, 32);
                const float rs = rsqrtf(sq * (1.f / 512.f) + 1e-6f);
#pragma unroll
                for (int bj = 0; bj < 2; ++bj)
#pragma unroll
                    for (int n = 0; n < 2; ++n) acc[ai][bj][m][n] *= rs; }
    }
    __device__ __forceinline__ void operator()(const f32x4 (&acc)[2][2][4][2], const pg8::Unit& u, int wr, int wc, int fr, int fq) const {
        const int r0 = u.i0 * 256;
        const int v = row_v(r0);
        const float* gate = modl + (size_t)v * 6144 + 2 * 1024;
        const float* xin = xin_ptr(inc, inx, r0);
        const int rl0 = wr * 64 + fr, col0 = u.i1 * 256 + wc * 32 + 8 * fq;
        f32x4 gv[2][2];
#pragma unroll
        for (int bj = 0; bj < 2; ++bj)
#pragma unroll
            for (int n = 0; n < 2; ++n) gv[bj][n] = *(const f32x4*)(gate + col0 + bj * 128 + 4 * n);
#pragma unroll
        for (int ai = 0; ai < 2; ++ai) {
            u32x4 hr[4][2];
#pragma unroll
            for (int m = 0; m < 4; ++m)
#pragma unroll
                for (int bj = 0; bj < 2; ++bj) hr[m][bj] = *(const u32x4*)(H + (size_t)(r0 + rl0 + ai * 128 + m * 16) * D + col0 + bj * 128);
#pragma unroll
            for (int m = 0; m < 4; ++m)
#pragma unroll
                for (int bj = 0; bj < 2; ++bj) { const u32x4 hv = hr[m][bj]; const f32x4 a0 = acc[ai][bj][m][0], a1 = acc[ai][bj][m][1]; const f32x4 g0 = gv[bj][0], g1 = gv[bj][1];
                    u32x4 w;
                    w.x = cvt_pk_bf16(bflo(hv.x) + g0[0] * a0[0], bfhi(hv.x) + g0[1] * a0[1]); w.y = cvt_pk_bf16(bflo(hv.y) + g0[2] * a0[2], bfhi(hv.y) + g0[3] * a0[3]);
                    w.z = cvt_pk_bf16(bflo(hv.z) + g1[0] * a1[0], bfhi(hv.z) + g1[1] * a1[1]); w.w = cvt_pk_bf16(bflo(hv.w) + g1[2] * a1[2], bfhi(hv.w) + g1[3] * a1[3]);
                    *(u32x4*)(H + (size_t)(r0 + rl0 + ai * 128 + m * 16) * D + col0 + bj * 128) = w; }
            asm volatile("" ::: "memory"); }
    }
};

__device__ __forceinline__ const char* uniform_ptr(const char* q) {
    const unsigned long long v = (unsigned long long)q;
    const unsigned lo = __builtin_amdgcn_readfirstlane((unsigned)v), hi = __builtin_amdgcn_readfirstlane((unsigned)(v >> 32));
    return (const char*)(((unsigned long long)hi << 32) | lo);
}
struct MoeSched {
    const LAS int* tab;
    const int* list;
    const char* A; const char* W; int mode  , l, G, c;
    unsigned* ready;
    __device__ __forceinline__ void a_ready(const pg8::Unit& u) const {
        if (mode == 0) return;
        if (threadIdx.x < 64) {
            unsigned* w = ready + u.i4; unsigned spins = 0;
            while ((unsigned)__builtin_amdgcn_readfirstlane((int)__hip_atomic_load(w, __ATOMIC_RELAXED, __HIP_MEMORY_SCOPE_AGENT)) < 32u) {
                __builtin_amdgcn_s_sleep(2); if (++spins > (1u << 22)) break; }
            __builtin_amdgcn_fence(__ATOMIC_ACQUIRE, "agent");
            asm volatile("s_waitcnt vmcnt(0)" ::: "memory");
        }
        asm volatile("" ::: "memory"); __builtin_amdgcn_s_barrier(); asm volatile("" ::: "memory");
    }
    int late;
    __device__ __forceinline__ bool get(int i, pg8::Unit& u) const {
        const int total = __builtin_amdgcn_readfirstlane(tab[24]) * 4;
        int L;
        if (mode == 0 || late == 0) L = i * G + c;
        else if (c < late) { if (i > 0) return false; L = c; }
        else L = late + (c - late) + i * (G - late);
        if (L >= total) return false;
        const int tl = L >> 2, pn = L & 3;
        int cls = 0;
#pragma unroll 1
        for (int q = 1; q < NCLS; ++q) { const int tq = __builtin_amdgcn_readfirstlane(tab[q]); if (tq <= tl) cls = q; }
        const int j = tl - __builtin_amdgcn_readfirstlane(tab[cls]), cnt = __builtin_amdgcn_readfirstlane(tab[32 + cls]);
        const int g = cls / 6, pidx = cls - g * 6;
        const int ea = (pidx >= 3) + (pidx >= 5), eb = pidx < 3 ? pidx + 1 : (pidx < 5 ? pidx - 1 : 3);
        if (mode == 0) {
            const int e = 4 * g + (pn < 2 ? ea : eb);
            u.a0 = A;
            u.b0 = W + ((size_t)(l * 16 + e) * 512 + (size_t)(pn & 1) * 256) * 1024 * 2; u.b1 = u.b0 + (size_t)8 * 128;
        } else {
            u.a0 = A + (size_t)tl * 256 * 512 * 2;
            u.b0 = W + ((size_t)(l * 16 + 4 * g + ea) * 1024 + (size_t)pn * 256) * 256 * 2;
            u.b1 = W + ((size_t)(l * 16 + 4 * g + eb) * 1024 + (size_t)pn * 256) * 256 * 2;
        }
        u.a0 = uniform_ptr(u.a0); u.b0 = uniform_ptr(u.b0); u.b1 = uniform_ptr(u.b1);
        u.i0 = cls; u.i1 = j; u.i2 = pn; u.i3 = cnt; u.i4 = tl; u.pad = 0; return true;
    }
    __device__ __forceinline__ int arow(const pg8::Unit& u, int rl) const {
        int idx = u.i1 * 256 + rl; idx = idx < u.i3 ? idx : u.i3 - 1;
        return list[(size_t)u.i0 * R + idx];
    }
    __device__ __forceinline__ const int* rows_ptr(const pg8::Unit& u) const { return list + (size_t)u.i0 * R + u.i1 * 256; }
    __device__ __forceinline__ int rows_valid(const pg8::Unit& u) const { return u.i3 - u.i1 * 256; }
};
struct EpiUp {
    static constexpr bool PERM = true, MIDSCALE = false;
    bf16_t* hid; const float* cwla; const float* cwlb; unsigned* ready;
    __device__ __forceinline__ void operator()(const f32x4 (&acc)[2][2][4][2], const pg8::Unit& u, int wr, int wc, int fr, int fq) const {
        const int cls = u.i0, j = u.i1, pn = u.i2, cnt = u.i3, tl = u.i4;
        const float* cw = (pn < 2) ? cwla : cwlb;
        const int colbase = (pn >> 1) * 256 + (pn & 1) * 128 + wc * 32 + 8 * fq;
        float wrow[2][4];
#pragma unroll
        for (int ai = 0; ai < 2; ++ai)
#pragma unroll
            for (int m = 0; m < 4; ++m) { const int idx = j * 256 + ai * 128 + wr * 64 + m * 16 + fr; wrow[ai][m] = idx < cnt ? cw[(size_t)cls * R + idx] : 0.f; }
#pragma unroll
        for (int ai = 0; ai < 2; ++ai)
#pragma unroll
            for (int m = 0; m < 4; ++m) {
                const int rl = ai * 128 + wr * 64 + m * 16 + fr; const int idx = j * 256 + rl; const bool valid = idx < cnt;
                const float w = wrow[ai][m];
                const f32x4 g0 = acc[ai][0][m][0], g1 = acc[ai][0][m][1], u0 = acc[ai][1][m][0], u1 = acc[ai][1][m][1];
                float o[8];
#pragma unroll
                for (int e = 0; e < 4; ++e) { o[e] = w * siluf_(g0[e]) * u0[e]; o[4 + e] = w * siluf_(g1[e]) * u1[e]; }
                if (!valid) {
#pragma unroll
                    for (int e = 0; e < 8; ++e) o[e] = 0.f; }
                u32x4 pk; pk.x = cvt_pk_bf16(o[0], o[1]); pk.y = cvt_pk_bf16(o[2], o[3]); pk.z = cvt_pk_bf16(o[4], o[5]); pk.w = cvt_pk_bf16(o[6], o[7]);
                { bf16_t* dstp = hid + ((size_t)tl * 256 + rl) * 512 + colbase;
                  asm volatile("global_store_dwordx4 %0, %1, off sc1\n\ts_nop 1" :: "v"(dstp), "v"(pk) : "memory"); }
            }
        asm volatile("s_waitcnt vmcnt(0)" ::: "memory");
        if ((threadIdx.x & 63) == 0) __hip_atomic_fetch_add(ready + tl, 1u, __ATOMIC_RELAXED, __HIP_MEMORY_SCOPE_AGENT);
    }
};
struct EpiDown {
    static constexpr bool PERM = true, MIDSCALE = false;
    bf16_t* H; const int* list; const LAS float* gl;
    __device__ __forceinline__ void operator()(const f32x4 (&acc)[2][2][4][2], const pg8::Unit& u, int wr, int wc, int fr, int fq) const {
        const int cls = u.i0, j = u.i1, pn = u.i2, cnt = u.i3;
        const int col0 = pn * 256 + wc * 32 + 8 * fq;
        int tok[2][4];
#pragma unroll
        for (int ai = 0; ai < 2; ++ai)
#pragma unroll
            for (int m = 0; m < 4; ++m) { const int idx = j * 256 + ai * 128 + wr * 64 + m * 16 + fr; tok[ai][m] = idx < cnt ? list[(size_t)cls * R + idx] : -1; }
#pragma unroll
        for (int ai = 0; ai < 2; ++ai)
#pragma unroll
          for (int mp = 0; mp < 2; ++mp) {
            u32x4 hr[2][2];
#pragma unroll
            for (int mm = 0; mm < 2; ++mm) { const int t = tok[ai][2 * mp + mm]; const bf16_t* hp = H + (size_t)(t < 0 ? 0 : t) * D + col0;
#pragma unroll
                for (int bj = 0; bj < 2; ++bj) hr[mm][bj] = *(const u32x4*)(hp + bj * 128); }
#pragma unroll
            for (int mm = 0; mm < 2; ++mm) { const int m = 2 * mp + mm; const int t = tok[ai][m];
                if (t >= 0) { const LAS float* gp = gl + row_v(t) * 1024 + col0;
#pragma unroll
                    for (int bj = 0; bj < 2; ++bj) { const u32x4 hv = hr[mm][bj]; const f32x4 a0 = acc[ai][bj][m][0], a1 = acc[ai][bj][m][1];
                        const f32x4 g0 = *(const LAS f32x4*)(gp + bj * 128), g1 = *(const LAS f32x4*)(gp + bj * 128 + 4);
                        u32x4 w;
                        w.x = cvt_pk_bf16(bflo(hv.x) + g0[0] * a0[0], bfhi(hv.x) + g0[1] * a0[1]); w.y = cvt_pk_bf16(bflo(hv.y) + g0[2] * a0[2], bfhi(hv.y) + g0[3] * a0[3]);
                        w.z = cvt_pk_bf16(bflo(hv.z) + g1[0] * a1[0], bfhi(hv.z) + g1[1] * a1[1]); w.w = cvt_pk_bf16(bflo(hv.w) + g1[2] * a1[2], bfhi(hv.w) + g1[3] * a1[3]);
                        *(u32x4*)(H + (size_t)t * D + col0 + bj * 128) = w; } } }
            asm volatile("" ::: "memory"); }
    }
};

__device__ __forceinline__ void tr_tile(const float* src, int ldn, int k0, int n0, int nvalid, bf16_t* dst, int ldk, int drow0, LAS float* tile, int kd0 = -1, const float* kscale = nullptr) {
    const int tid = launder_tid();
    if (kd0 < 0) kd0 = k0;
    { const int n = tid & 63; const int kq = tid >> 6; float tv[8], ts[8];
#pragma unroll
      for (int it = 0; it < 8; ++it) { const int kk = kq + 8 * it; tv[it] = (n < nvalid) ? src[(size_t)(k0 + kk) * ldn + n0 + n] : 0.f; ts[it] = kscale ? kscale[kk] : 1.f; }
#pragma unroll
      for (int it = 0; it < 8; ++it) tile[(kq + 8 * it) * 65 + n] = tv[it] * ts[it]; }
    __syncthreads();
    { const int k8 = tid & 7, n = tid >> 3;
      if (n < nvalid) { const LAS float* s = tile + (k8 * 8) * 65 + n;
          u32x4 o; o.x = cvt_pk_bf16(s[0], s[65]); o.y = cvt_pk_bf16(s[2 * 65], s[3 * 65]); o.z = cvt_pk_bf16(s[4 * 65], s[5 * 65]); o.w = cvt_pk_bf16(s[6 * 65], s[7 * 65]);
          *(u32x4*)(dst + (size_t)(drow0 + n) * ldk + kd0 + k8 * 8) = o; } }
    __syncthreads();
}
constexpr int WPREP_ITEMS_PER_LAYER = 16 * 41 + 256 + 1024 + 1024 + 1024;
__device__ __forceinline__ void phase_wprep(CP p, unsigned char* lds, int it0, int it1, int bidx, int nblk, int b0 = 0, int b1 = 0, int c0 = 0, int c1 = 0) {
    LAS float* tile = (LAS float*)(LAS unsigned char*)lds;
    constexpr int I_IN = 16 * 41, I_OUT = 256, I_G = 1024, I_U = 1024, I_D = 1024, I_L = I_IN + I_OUT + I_G + I_U + I_D;
    const int na = it1 - it0, nbb = b1 - b0, ncc = c1 - c0;
    for (int vi = bidx; vi < na + nbb + ncc; vi += nblk) {
        const int it = vi < na ? it0 + vi : (vi < na + nbb ? b0 + (vi - na) : c0 + (vi - na - nbb));
        const int l = it / I_L; int r = it - l * I_L;
        if (r < I_IN) { const int kt = r / 41, ntl = r % 41; const int n0 = ntl * 64; const int nv = (DIN - n0) < 64 ? (DIN - n0) : 64;
            const int dr = n0 < 512 ? (n0 >> 7) * 256 + (n0 & 127) : (n0 < 1024 ? ((n0 - 512) >> 7) * 256 + 128 + ((n0 - 512) & 127) : n0);
            tr_tile(p->w_in + (size_t)l * 1024 * DIN, DIN, kt * 64, n0, nv, (bf16_t*)(p->ws + WS_WTIN) + (size_t)l * DIN * 1024, 1024, dr, tile); continue; }
        r -= I_IN;
        if (r < I_OUT) { const int kt = r >> 4, ntl = r & 15;
            tr_tile(p->w_out + (size_t)l * 1024 * 1024, 1024, kt * 64, ntl * 64, 64, (bf16_t*)(p->ws + WS_WTOUT) + (size_t)l * 1024 * 1024, 1024, ntl * 64, tile,
                    (kt * 64 + 512) & 1023, kt >= 8 ? p->ssd_norm_g + l * 512 + (kt * 64 - 512) : nullptr); continue; }
        r -= I_OUT;
        if (r < I_G + I_U) { const int up = r >= I_G; if (up) r -= I_G; const int e = r >> 6, q = r & 63, kt = q >> 2, ntl = q & 3; const int n0 = ntl * 64;
            const float* src = (up ? p->w_up : p->w_gate) + (size_t)(l * 16 + e) * 1024 * 256;
            tr_tile(src, 256, kt * 64, n0, 64, (bf16_t*)(p->ws + WS_WTGU) + (size_t)(l * 16 + e) * 512 * 1024, 1024, (n0 >> 7) * 256 + (n0 & 127) + (up ? 128 : 0), tile); continue; }
        r -= I_G + I_U;
        { const int e = r >> 6, q = r & 63, kt = q >> 4, ntl = q & 15;
          tr_tile(p->w_down + (size_t)(l * 16 + e) * 256 * 1024, 1024, kt * 64, ntl * 64, 64, (bf16_t*)(p->ws + WS_WTD) + (size_t)(l * 16 + e) * 1024 * 256, 256, ntl * 64, tile); }
    }
}
__device__ __forceinline__ void phase_adaln(CP p, unsigned char* lds, int bid, int nb) {
    LAS float* sc = (LAS float*)(LAS unsigned char*)lds;
    LAS float* red = sc + 3 * 1024;
    const int tid = launder_tid();
    for (int idx = tid; idx < 3 * 1024; idx += NTHREADS) { const int v = idx >> 10, k = idx & 1023; const float cv = (v < 2) ? p->c[v * 1024 + k] : p->c_ctx[k]; sc[idx] = siluf_(cv); }
    __syncthreads();
    float* mod = (float*)(p->ws + WS_MOD);
    for (int it = bid; it < 2 * 96; it += nb) {
        const int l = it / 96, n0 = (it % 96) * 64;
        const int c4 = tid & 15, kr = tid >> 4;
        f32x4 a0 = {0, 0, 0, 0}, a1 = {0, 0, 0, 0}, a2 = {0, 0, 0, 0};
        const float* w = p->w_ada + (size_t)l * 1024 * 6144 + n0 + c4 * 4;
#pragma unroll 4
        for (int k = kr; k < 1024; k += 32) { const f32x4 w4 = *(const f32x4*)(w + (size_t)k * 6144); a0 += sc[k] * w4; a1 += sc[1024 + k] * w4; a2 += sc[2048 + k] * w4; }
        *(LAS f32x4*)(red + (kr * 3 + 0) * 64 + c4 * 4) = a0; *(LAS f32x4*)(red + (kr * 3 + 1) * 64 + c4 * 4) = a1; *(LAS f32x4*)(red + (kr * 3 + 2) * 64 + c4 * 4) = a2;
        __syncthreads();
        if (tid < 192) { const int v = tid >> 6, cc = tid & 63; float s = 0.f;
            for (int q = 0; q < 32; ++q) s += red[(q * 3 + v) * 64 + cc];
            mod[((size_t)l * 3 + v) * 6144 + n0 + cc] = s + p->b_ada[l * 6144 + n0 + cc]; }
        __syncthreads();
    }
}
__device__ __forceinline__ void moe_table(CP p, int l, LAS int* tab) {
    const int* gcount = (const int*)(p->ws + WS_CTL) + l * 32;
    if (threadIdx.x == 0) { int acc = 0; for (int q = 0; q < NCLS; ++q) { const int cn = gcount[q]; tab[q] = acc; tab[32 + q] = cn; acc += (cn + 255) >> 8; } tab[24] = acc; }
    __syncthreads();
}
typedef _Float16 f16x8 __attribute__((ext_vector_type(8)));
typedef _Float16 f16x2 __attribute__((ext_vector_type(2)));
constexpr int ST_H16 = 2064;
__device__ __forceinline__ unsigned pack_f16(float a, float b) { f16x2 h; h[0] = (_Float16)a; h[1] = (_Float16)b; return __builtin_bit_cast(unsigned, h); }
__device__ __forceinline__ void phase_r1(CP p, int l, unsigned char* lds_, int bid, int nb) {
    LAS unsigned char* lds = (LAS unsigned char*)lds_;
    LAS unsigned char* Wh = lds;
    LAS unsigned char* Xh = Wh + 16 * ST_H16;
    LAS float* gm = (LAS float*)(Xh + 16 * ST_H16);
    LAS float* sh = gm + 3 * 1024;
    LAS float* part = sh + 3 * 1024;
    const int tid = launder_tid(); const int lane = tid & 63, wave = __builtin_amdgcn_readfirstlane(tid >> 6);
    const float* mod = (const float*)(p->ws + WS_MOD) + (size_t)l * 3 * 6144;
    const float* win = p->w_in + (size_t)l * 1024 * DIN;
#pragma unroll
    for (int hb = 0; hb < 2; ++hb) { float tmp[16];
#pragma unroll
        for (int it = 0; it < 16; ++it) { const int idx = tid + NTHREADS * (16 * hb + it); tmp[it] = win[(size_t)(idx >> 4) * DIN + NPROJ + (idx & 15)]; }
#pragma unroll
        for (int it = 0; it < 16; ++it) { const int idx = tid + NTHREADS * (16 * hb + it); *(LAS _Float16*)(Wh + (idx & 15) * ST_H16 + (idx >> 4) * 2) = (_Float16)tmp[it]; } }
    { float t0[6], t1[6], t2[6];
#pragma unroll
      for (int it = 0; it < 6; ++it) { const int idx = tid + NTHREADS * it; const int v = idx >> 10, k = idx & 1023; t0[it] = p->g_mix[l * 1024 + k]; t1[it] = mod[v * 6144 + 1024 + k]; t2[it] = mod[v * 6144 + k]; }
#pragma unroll
      for (int it = 0; it < 6; ++it) { const int idx = tid + NTHREADS * it; gm[idx] = t0[it] * (1.f + t1[it]); sh[idx] = t2[it]; } }
    __syncthreads();
    bf16_t* HX = (bf16_t*)(p->ws + WS_HX); float* DT = (float*)(p->ws + WS_DT);
    const int rpb = (R + nb - 1) / nb, r0 = bid * rpb, r1 = (r0 + rpb) < R ? (r0 + rpb) : R;
    RowRaw xn[2];
#pragma unroll
    for (int q = 0; q < 2; ++q) if (r0 + 2 * wave + q < r1) row_load(p, l, r0 + 2 * wave + q, lane, xn[q]);
#pragma unroll 1
    for (int t0r = r0; t0r < r1; t0r += 16) {
        f32x4 xv[2][4];
#pragma unroll
        for (int q = 0; q < 2; ++q) row_cvt(l, xn[q], xv[q]);
#pragma unroll
        for (int q = 0; q < 2; ++q) if (t0r + 16 + 2 * wave + q < r1) row_load(p, l, t0r + 16 + 2 * wave + q, lane, xn[q]);
#pragma unroll
        for (int q = 0; q < 2; ++q) { const int rr = t0r + 2 * wave + q; const bool ok = rr < r1; const int v = row_v(ok ? rr : r0);
            if (l == 0 && ok) { u32x2* hw = (u32x2*)((bf16_t*)(p->ws + WS_H) + (size_t)rr * D);
#pragma unroll
                for (int j = 0; j < 4; ++j) { u32x2 o; o.x = cvt_pk_bf16(xv[q][j][0], xv[q][j][1]); o.y = cvt_pk_bf16(xv[q][j][2], xv[q][j][3]); hw[lane + 64 * j] = o; } }
            float ss = 0.f;
#pragma unroll
            for (int j = 0; j < 4; ++j) ss += xv[q][j][0] * xv[q][j][0] + xv[q][j][1] * xv[q][j][1] + xv[q][j][2] * xv[q][j][2] + xv[q][j][3] * xv[q][j][3];
            ss = wave_sum(ss); const float rs = ok ? __builtin_amdgcn_rsqf(ss * (1.f / 1024.f) + 1e-6f) : 0.f;
#pragma unroll
            for (int j = 0; j < 4; ++j) { const int k = 4 * lane + 256 * j; const f32x4 g4 = *(const LAS f32x4*)(gm + v * 1024 + k), s4 = *(const LAS f32x4*)(sh + v * 1024 + k);
                f32x4 hv = xv[q][j] * rs * g4 + s4; if (!ok) hv = hv * 0.f;
                u32x2 o; o.x = cvt_pk_bf16(hv[0], hv[1]); o.y = cvt_pk_bf16(hv[2], hv[3]);
                if (ok) *(u32x2*)(HX + (size_t)rr * 1024 + k) = o;
                u32x2 h16; h16.x = pack_f16(hv[0], hv[1]); h16.y = pack_f16(hv[2], hv[3]);
                *(LAS u32x2*)(Xh + (2 * wave + q) * ST_H16 + k * 2) = h16; } }
        __syncthreads();
        {
            f32x4 acc0 = {0.f, 0.f, 0.f, 0.f};
#pragma unroll
            for (int s4 = 0; s4 < 4; ++s4) { const int kb = (128 * wave + 32 * s4 + 8 * (lane >> 4)) * 2;
                const f16x8 a = *(const LAS f16x8*)(Xh + (lane & 15) * ST_H16 + kb);
                const f16x8 b0 = *(const LAS f16x8*)(Wh + (lane & 15) * ST_H16 + kb);
                acc0 = __builtin_amdgcn_mfma_f32_16x16x32_f16(a, b0, acc0, 0, 0, 0); }
#pragma unroll
            for (int e = 0; e < 4; ++e) part[(wave * 16 + 4 * (lane >> 4) + e) * 16 + (lane & 15)] = acc0[e];
        }
        __syncthreads();
        if (tid < 256) { const int row = tid >> 4, n = tid & 15; const int rr = t0r + row;
            float sacc = p->dt_bias[l * 16 + n];
#pragma unroll
            for (int w = 0; w < 8; ++w) sacc += part[(w * 16 + row) * 16 + n];
            if (rr < r1) DT[(size_t)rr * 16 + n] = softplusf_(sacc); }
    }
    __syncthreads();
}
typedef float f32x16 __attribute__((ext_vector_type(16)));
typedef short s16x4 __attribute__((ext_vector_type(4)));
constexpr int ST_ROW = 272;
constexpr int ST_TR128 = 320;
constexpr int ST_TR64 = 192;
constexpr int ST_MT = 328;
constexpr int NCHUNK = SEG / 128;

#define DPP_MOV(v, ctrl, rm, bm) __builtin_bit_cast(float, __builtin_amdgcn_update_dpp(0, __builtin_bit_cast(int, (v)), (ctrl), (rm), (bm), true))
__device__ __forceinline__ float wave_incl_scan(float v, int) {
    float s = v + DPP_MOV(v, 0x111, 0xF, 0xF) + DPP_MOV(v, 0x112, 0xF, 0xF) + DPP_MOV(v, 0x113, 0xF, 0xF);
    s += DPP_MOV(s, 0x114, 0xF, 0xE);
    s += DPP_MOV(s, 0x118, 0xF, 0xC);
    s += DPP_MOV(s, 0x142, 0xA, 0xF);
    s += DPP_MOV(s, 0x143, 0xC, 0xF);
    return s;
}
__device__ __forceinline__ bf16x8 row_frag(const LAS unsigned char* tile, int stride, int row0, int k0, int lane) {
    return *(const LAS bf16x8*)(tile + (row0 + (lane & 31)) * stride + (k0 + 8 * (lane >> 5)) * 2);
}
__device__ __forceinline__ bf16x8 tr_frag(const LAS unsigned char* tile, int stride, int k0, int c0, int lane) {
    const int g = lane >> 4, li = lane & 15, q = li >> 2, pp = li & 3;
    const LAS unsigned char* a0 = tile + (k0 + 8 * (g >> 1) + q) * stride + (c0 + 16 * (g & 1) + 4 * pp) * 2;
    const s16x4 lo = __builtin_amdgcn_ds_read_tr16_b64_v4i16((LAS s16x4*)a0);
    const s16x4 hi = __builtin_amdgcn_ds_read_tr16_b64_v4i16((LAS s16x4*)(a0 + 4 * stride));
    return __builtin_shufflevector(lo, hi, 0, 1, 2, 3, 4, 5, 6, 7);
}
__device__ __forceinline__ u32x4 pack8(const float (&v)[8]) { u32x4 r; r.x = cvt_pk_bf16(v[0], v[1]); r.y = cvt_pk_bf16(v[2], v[3]); r.z = cvt_pk_bf16(v[4], v[5]); r.w = cvt_pk_bf16(v[6], v[7]); return r; }
__device__ __forceinline__ u32x4 pack8s(const float (&v)[8], float sc) { u32x4 r; r.x = cvt_pk_bf16(v[0] * sc, v[1] * sc); r.y = cvt_pk_bf16(v[2] * sc, v[3] * sc); r.z = cvt_pk_bf16(v[4] * sc, v[5] * sc); r.w = cvt_pk_bf16(v[6] * sc, v[7] * sc); return r; }

__device__ __forceinline__ void conv_load(const bf16_t* proj, int row0, int rq, int xch, bool lo_ok, bool hi_ok, u32x4 (&raw)[8]) {
    const bf16_t* base = proj + (size_t)(row0 + 4 * rq) * NPROJ + 1536 + xch;
    const bool okl = (rq > 0) || lo_ok, okh = (rq < 31) || hi_ok;
#pragma unroll
    for (int j = 0; j < 8; ++j) raw[j] = *(const u32x4*)((j < 2 ? okl : (j >= 6 ? okh : true)) ? base + (j - 2) * NPROJ : base);
}
__device__ __forceinline__ void conv_compute(const u32x4 (&raw)[8], const LAS float* wl, int nchl, int wch, float (&o)[4][8], bool zl = false, bool zh = false) {
    float w[5][8], bs[8];
#pragma unroll
    for (int j = 0; j < 5; ++j) { const f32x4 w0 = *(const LAS f32x4*)(wl + j * nchl + wch), w1 = *(const LAS f32x4*)(wl + j * nchl + wch + 4);
        w[j][0] = w0[0]; w[j][1] = w0[1]; w[j][2] = w0[2]; w[j][3] = w0[3]; w[j][4] = w1[0]; w[j][5] = w1[1]; w[j][6] = w1[2]; w[j][7] = w1[3]; }
    { const f32x4 b0 = *(const LAS f32x4*)(wl + 5 * nchl + wch), b1 = *(const LAS f32x4*)(wl + 5 * nchl + wch + 4); bs[0] = b0[0]; bs[1] = b0[1]; bs[2] = b0[2]; bs[3] = b0[3]; bs[4] = b1[0]; bs[5] = b1[1]; bs[6] = b1[2]; bs[7] = b1[3]; }
#pragma unroll
    for (int i = 0; i < 4; ++i)
#pragma unroll
        for (int e = 0; e < 8; ++e) o[i][e] = bs[e];
    const float fl = zl ? 0.f : 1.f, fh = zh ? 0.f : 1.f;
#pragma unroll
    for (int j = 0; j < 8; ++j) {
        float xv[8] = {bflo(raw[j].x), bfhi(raw[j].x), bflo(raw[j].y), bfhi(raw[j].y), bflo(raw[j].z), bfhi(raw[j].z), bflo(raw[j].w), bfhi(raw[j].w)};
        if (j < 2) {
#pragma unroll
            for (int e = 0; e < 8; ++e) xv[e] *= fl; }
        if (j >= 6) {
#pragma unroll
            for (int e = 0; e < 8; ++e) xv[e] *= fh; }
#pragma unroll
        for (int i = 0; i < 4; ++i) { const int tap = j - i; if (tap >= 0 && tap < 5) {
#pragma unroll
                for (int e = 0; e < 8; ++e) o[i][e] += w[tap][e] * xv[e]; } }
    }
#pragma unroll
    for (int i = 0; i < 4; ++i)
#pragma unroll
        for (int e = 0; e < 8; ++e) o[i][e] = siluf_(o[i][e]);
}
__device__ __forceinline__ void conv_load4(const bf16_t* proj, int row0, int rq, int xch, bool lo_ok, bool hi_ok, u32x2 (&raw)[8]) {
    const bf16_t* base = proj + (size_t)(row0 + 4 * rq) * NPROJ + 1536 + xch;
    const bool okl = (rq > 0) || lo_ok, okh = (rq < 31) || hi_ok;
#pragma unroll
    for (int j = 0; j < 8; ++j) raw[j] = *(const u32x2*)((j < 2 ? okl : (j >= 6 ? okh : true)) ? base + (j - 2) * NPROJ : base);
}
__device__ __forceinline__ void conv_compute4(const u32x2 (&raw)[8], const LAS float* wl, int nchl, int wch, float (&o)[4][4], bool zl, bool zh) {
    f32x4 w[5];
#pragma unroll
    for (int j = 0; j < 5; ++j) w[j] = *(const LAS f32x4*)(wl + j * nchl + wch);
    const f32x4 bs = *(const LAS f32x4*)(wl + 5 * nchl + wch);
#pragma unroll
    for (int i = 0; i < 4; ++i)
#pragma unroll
        for (int e = 0; e < 4; ++e) o[i][e] = bs[e];
    const float fl = zl ? 0.f : 1.f, fh = zh ? 0.f : 1.f;
#pragma unroll
    for (int j = 0; j < 8; ++j) {
        float xv[4] = {bflo(raw[j].x), bfhi(raw[j].x), bflo(raw[j].y), bfhi(raw[j].y)};
        if (j < 2) {
#pragma unroll
            for (int e = 0; e < 4; ++e) xv[e] *= fl; }
        if (j >= 6) {
#pragma unroll
            for (int e = 0; e < 4; ++e) xv[e] *= fh; }
#pragma unroll
        for (int i = 0; i < 4; ++i) { const int tap = j - i; if (tap >= 0 && tap < 5) {
#pragma unroll
                for (int e = 0; e < 4; ++e) o[i][e] += w[tap][e] * xv[e]; } }
    }
#pragma unroll
    for (int i = 0; i < 4; ++i)
#pragma unroll
        for (int e = 0; e < 4; ++e) o[i][e] = siluf_(o[i][e]);
}
__device__ __forceinline__ void head_cums(CP p, int l, int row0, int h, int dir, int lane, LAS float* hv, const LAS float* atab) {
    const float A = atab[dir * 8 + h];
    const float* DT = (const float*)(p->ws + WS_DT);
    const float d0 = DT[(size_t)(row0 + 2 * lane) * 16 + dir * 8 + h], d1 = DT[(size_t)(row0 + 2 * lane + 1) * 16 + dir * 8 + h];
    const float x0 = d0 * A, x1 = d1 * A;
    const float incl = wave_incl_scan(x0 + x1, lane);
    const float total = __builtin_bit_cast(float, __builtin_amdgcn_readlane(__builtin_bit_cast(int, incl), 63));
    float c0, c1;
    if (dir == 0) { c1 = incl; c0 = incl - x1; } else { c0 = total - (incl - x1 - x0); c1 = total - (incl - x1); }
    hv[dir * 128 + 2 * lane] = c0; hv[dir * 128 + 2 * lane + 1] = c1;
    hv[256 + dir * 128 + 2 * lane] = d0; hv[256 + dir * 128 + 2 * lane + 1] = d1;
    if (lane == 0) hv[512 + dir] = total;
}
__device__ __forceinline__ bf16x8 scale_frag(bf16x8 f, const f32x4 w0, const f32x4 w1) {
    const u32x4 u = __builtin_bit_cast(u32x4, f);
    u32x4 r;
    r.x = cvt_pk_bf16(bflo(u.x) * w0[0], bfhi(u.x) * w0[1]); r.y = cvt_pk_bf16(bflo(u.y) * w0[2], bfhi(u.y) * w0[3]);
    r.z = cvt_pk_bf16(bflo(u.z) * w1[0], bfhi(u.z) * w1[1]); r.w = cvt_pk_bf16(bflo(u.w) * w1[2], bfhi(u.w) * w1[3]);
    return __builtin_bit_cast(bf16x8, r);
}
constexpr int ST_X256 = 576;

__device__ __forceinline__ void phase_c1(CP p, int l, unsigned char* lds_, int bid, int nb) {
    LAS unsigned char* lds = (LAS unsigned char*)lds_;
    LAS unsigned char* tile = lds;
    LAS float* wl = (LAS float*)(lds + 73216);
    const int tid = launder_tid();
    const bf16_t* proj = (const bf16_t*)(p->ws + WS_PROJ); bf16_t* mix = (bf16_t*)(p->ws + WS_HX);
    const int NU = 256 + 512 + (l == DEPTH - 1 ? 0 : 16);
    const int heavy = (nb > 64 && (NB * NCHUNK * 2) % nb < nb / 4) ? (NB * NCHUNK * 2) % nb : 0;
    const int ustart = bid < heavy ? NU : (bid - heavy), ustep = nb - heavy;
#pragma unroll 1
    for (int u = ustart; u < NU; u += ustep) {
        int S, LEN, LSH, pstride, sstride, tok0, ch0;
        if (u < 256) { const int b = u >> 7, cs = (u >> 2) & 31, cc = u & 3; S = 2; LEN = 256; LSH = 8; pstride = 64; sstride = 1; tok0 = b * SEG + CTXL + 2 * cs; ch0 = 256 + 64 * cc; }
        else if (u < 768) { const int v = u - 256; const int b = v >> 8, rg = (v >> 2) & 63, cc = v & 3; S = 4; LEN = 64; LSH = 6; pstride = 1; sstride = 64; tok0 = b * SEG + CTXL + 256 * rg; ch0 = 64 * cc; }
        else { const int v = u - 768; const int b = v >> 3, cc = v & 7; S = 1; LEN = 256; LSH = 8; pstride = 1; sstride = 0; tok0 = b * SEG; ch0 = 64 * cc; }
        const int LP = LEN + 30;
        { float tw[4];
#pragma unroll
          for (int it = 0; it < 4; ++it) { const int i = tid + NTHREADS * it; const int j = i >> 6, c = i & 63; tw[it] = j < 31 ? p->conv_w[((size_t)l * 31 + j) * 512 + ch0 + c] : p->conv_b[l * 512 + ch0 + c]; }
#pragma unroll
          for (int it = 0; it < 4; ++it) wl[tid + NTHREADS * it] = tw[it]; }
        for (int i = tid; i < S * 30 * 8; i += NTHREADS) { const int pc = i & 7, q = (i >> 3) % 30, sq = (i >> 3) / 30; const int pos = q < 15 ? q : LEN + q;
            unsigned zz; asm volatile("v_mov_b32 %0, 0" : "=v"(zz));
            *(LAS u32x4*)(tile + ((sq * LP + pos) * 64 + pc * 8) * 2) = (u32x4){zz, zz, zz, zz}; }
        for (int ib = 0; ib < S * LEN * 8; ib += 4 * NTHREADS) {
            u32x4 uv[4];
#pragma unroll
            for (int q = 0; q < 4; ++q) { const int i = ib + tid + NTHREADS * q; const int pc = i & 7, t = i >> 3; const int sq = t >> LSH, pos = t & (LEN - 1);
                const bf16_t* src = proj + (size_t)(tok0 + sq * sstride + pos * pstride) * NPROJ + ch0 + pc * 8;
                uv[q] = __builtin_nontemporal_load((const u32x4*)src); }
#pragma unroll
            for (int q = 0; q < 4; ++q) { const int i = ib + tid + NTHREADS * q; const int pc = i & 7, t = i >> 3; const int sq = t >> LSH, pos = t & (LEN - 1);
                const u32x4 o = uv[q];
                *(LAS u32x4*)(tile + ((sq * LP + 15 + pos) * 64 + pc * 8) * 2) = o; }
        }
        __syncthreads();
        const int noct = S * LEN / 8;
#pragma unroll 1
        for (int it = tid; it < noct * 32; it += NTHREADS) {
            const int cp = it & 31, oc = it >> 5; const int sq = oc >> (LSH - 3), p0 = (oc & ((LEN >> 3) - 1)) * 8;
            const LAS unsigned* base = (const LAS unsigned*)(tile + ((sq * LP + p0) * 64) * 2) + cp;
            float i0[38], i1[38];
#pragma unroll
            for (int k = 0; k < 38; ++k) { const unsigned w = base[k * 32]; i0[k] = bflo(w); i1[k] = bfhi(w); }
            float a0[8], a1[8];
            { const float b0 = wl[31 * 64 + 2 * cp], b1 = wl[31 * 64 + 2 * cp + 1];
#pragma unroll
              for (int i = 0; i < 8; ++i) { a0[i] = b0; a1[i] = b1; } }
#pragma unroll
            for (int j = 0; j < 31; ++j) { typedef float f32x2 __attribute__((ext_vector_type(2))); const f32x2 wj = *(const LAS f32x2*)(wl + j * 64 + 2 * cp); const float w0 = wj[0], w1 = wj[1];
#pragma unroll
                for (int i = 0; i < 8; ++i) { a0[i] += w0 * i0[i + j]; a1[i] += w1 * i1[i + j]; } }
#pragma unroll
            for (int i = 0; i < 8; ++i) { const int tok = tok0 + sq * sstride + (p0 + i) * pstride;
                *(unsigned*)(mix + (size_t)tok * 1024 + 512 + ch0 + 2 * cp) = cvt_pk_bf16(a0[i], a1[i]); }
        }
        __syncthreads();
    }
}
__device__ __forceinline__ void phase_c1_ln(CP p, int l, int bid, int nb) {
    const int tid = launder_tid(); const int lane = tid & 63, wave = tid >> 6;
    bf16_t* mix = (bf16_t*)(p->ws + WS_HX);
    const f32x4 g0 = *(const f32x4*)(p->conv_ln_g + l * 512 + lane * 8), g1 = *(const f32x4*)(p->conv_ln_g + l * 512 + lane * 8 + 4);
    const f32x4 b0 = *(const f32x4*)(p->conv_ln_b + l * 512 + lane * 8), b1 = *(const f32x4*)(p->conv_ln_b + l * 512 + lane * 8 + 4);
    const float gg[8] = {g0[0], g0[1], g0[2], g0[3], g1[0], g1[1], g1[2], g1[3]}, bb[8] = {b0[0], b0[1], b0[2], b0[3], b1[0], b1[1], b1[2], b1[3]};
    u32x4 vn = {0u, 0u, 0u, 0u};
    if (bid * 8 + wave < R) vn = *(const u32x4*)(mix + (size_t)(bid * 8 + wave) * 1024 + 512 + lane * 8);
    for (int r = bid * 8 + wave; r < R; r += nb * 8) {
        u32x4* ptr = (u32x4*)(mix + (size_t)r * 1024 + 512 + lane * 8);
        const u32x4 v = vn;
        if (r + nb * 8 < R) vn = *(const u32x4*)(mix + (size_t)(r + nb * 8) * 1024 + 512 + lane * 8);
        float y[8] = {bflo(v.x), bfhi(v.x), bflo(v.y), bfhi(v.y), bflo(v.z), bfhi(v.z), bflo(v.w), bfhi(v.w)};
        float s = 0.f;
#pragma unroll
        for (int e = 0; e < 8; ++e) s += y[e];
        const float mu = wave_sum(s) * (1.f / 512.f);
        float q = 0.f;
#pragma unroll
        for (int e = 0; e < 8; ++e) { y[e] -= mu; q += y[e] * y[e]; }
        const float rstd = rsqrtf(wave_sum(q) * (1.f / 512.f) + 1e-5f);
        float o[8];
#pragma unroll
        for (int e = 0; e < 8; ++e) o[e] = siluf_(y[e] * rstd * gg[e] + bb[e]);
        *ptr = pack8(o);
    }
}
__device__ __forceinline__ void phase_s1(CP p, int l, unsigned char* lds_, int bid, int nb) {
    LAS unsigned char* lds = (LAS unsigned char*)lds_;
    LAS unsigned char* Bs = lds;
    LAS unsigned char* Xs = lds + 128 * ST_TR128;
    LAS float* wv = (LAS float*)(Xs + 128 * ST_X256);
    LAS float* hvs = wv + 8 * 128;
    LAS float* cwl = hvs + 4 * 520;
    LAS float* atab = cwl + 6 * 384;
    const int tid = launder_tid(); const int lane = tid & 63, wave = __builtin_amdgcn_readfirstlane(tid >> 6);
    const bf16_t* proj = (const bf16_t*)(p->ws + WS_PROJ);
    const float* cw = p->ssd_conv_w + (size_t)l * 5 * 1024; const float* cbias = p->ssd_conv_b + (size_t)l * 1024;
    bf16_t* Sg = (bf16_t*)(p->ws + WS_S); float* DEC = (float*)(p->ws + WS_DEC);
    if (tid < 16) atab[tid] = -expf(p->a_log[l * 16 + tid]);
    __syncthreads();
    int cur_g = -1;
#pragma unroll 1
    for (int u = bid; u < NB * NCHUNK * 2; u += nb) {
        const int g = u & 1, c = (u >> 1) % NCHUNK, b = (u >> 1) / NCHUNK;
        const int row0 = b * SEG + c * 128;
        const bool lo_ok = !(c == 0 || c == 2), hi_ok = !(c == 1 || c == NCHUNK - 1);
        if (g != cur_g) { cur_g = g;
            float tw[5];
#pragma unroll
            for (int it = 0; it < 5; ++it) { const int i = tid + NTHREADS * it; const int j = i / 384, lc = i - j * 384; const int gch = lc < 128 ? 512 + g * 128 + lc : g * 256 + (lc - 128);
                tw[it] = i < 6 * 384 ? (j < 5 ? cw[j * 1024 + gch] : cbias[gch]) : 0.f; }
#pragma unroll
            for (int it = 0; it < 5; ++it) { const int i = tid + NTHREADS * it; if (i < 6 * 384) cwl[i] = tw[it]; } }
        const int hh = wave >> 1, dir = wave & 1, h = 4 * g + hh;
        u32x4 rb[8], rx0[8], rx1[8];
        conv_load(proj, row0, tid >> 4, 512 + g * 128 + (tid & 15) * 8, lo_ok, hi_ok, rb);
        conv_load(proj, row0, tid >> 5, g * 256 + (tid & 31) * 8, lo_ok, hi_ok, rx0);
        conv_load(proj, row0, (tid >> 5) + 16, g * 256 + (tid & 31) * 8, lo_ok, hi_ok, rx1);
        head_cums(p, l, row0, h, dir, lane, hvs + hh * 520, atab);
        __syncthreads();
        {
            const LAS float* hv = hvs + hh * 520; const float tot = hv[512 + dir];
#pragma unroll
            for (int q = 0; q < 2; ++q) { const int lr = lane + 64 * q; wv[wave * 128 + lr] = __expf(tot - hv[dir * 128 + lr]) * hv[256 + dir * 128 + lr]; }
            if (lane == 0) DEC[((size_t)(b * 2 + dir) * NCHUNK + c) * 8 + h] = __expf(tot);
        }
        { float o[4][8];
          conv_compute(rb, cwl, 384, (tid & 15) * 8, o, (tid >> 4) == 0 && !lo_ok, (tid >> 4) == 31 && !hi_ok);
#pragma unroll
          for (int i = 0; i < 4; ++i) *(LAS u32x4*)(Bs + (4 * (tid >> 4) + i) * ST_TR128 + (tid & 15) * 16) = pack8(o[i]);
          conv_compute(rx0, cwl, 384, 128 + (tid & 31) * 8, o, (tid >> 5) == 0 && !lo_ok, false);
#pragma unroll
          for (int i = 0; i < 4; ++i) *(LAS u32x4*)(Xs + (4 * (tid >> 5) + i) * ST_X256 + (tid & 31) * 16) = pack8(o[i]);
          conv_compute(rx1, cwl, 384, 128 + (tid & 31) * 8, o, false, (tid >> 5) == 15 && !hi_ok);
#pragma unroll
          for (int i = 0; i < 4; ++i) *(LAS u32x4*)(Xs + (4 * ((tid >> 5) + 16) + i) * ST_X256 + (tid & 31) * 16) = pack8(o[i]); }
        __syncthreads();
        {
            f32x16 acc[2][4];
#pragma unroll
            for (int t = 0; t < 2; ++t)
#pragma unroll
                for (int q = 0; q < 4; ++q)
#pragma unroll
                    for (int e = 0; e < 16; ++e) acc[t][q][e] = 0.f;
            {
                bf16x8 ar[2][2], br[2][4];
#pragma unroll
                for (int t = 0; t < 2; ++t) ar[0][t] = tr_frag(Xs, ST_X256, 0, hh * 64 + 32 * t, lane);
#pragma unroll
                for (int q = 0; q < 4; ++q) br[0][q] = tr_frag(Bs, ST_TR128, 0, 32 * q, lane);
#pragma unroll 2
                for (int kk = 0; kk < 8; ++kk) { const int c_ = kk & 1, n_ = c_ ^ 1;
                    const LAS float* wp = wv + wave * 128 + 16 * kk + 8 * (lane >> 5);
                    const f32x4 w0 = *(const LAS f32x4*)wp, w1 = *(const LAS f32x4*)(wp + 4);
                    if (kk < 7) {
#pragma unroll
                        for (int t = 0; t < 2; ++t) ar[n_][t] = tr_frag(Xs, ST_X256, 16 * (kk + 1), hh * 64 + 32 * t, lane);
#pragma unroll
                        for (int q = 0; q < 4; ++q) br[n_][q] = tr_frag(Bs, ST_TR128, 16 * (kk + 1), 32 * q, lane); }
                    bf16x8 af[2];
#pragma unroll
                    for (int t = 0; t < 2; ++t) af[t] = scale_frag(ar[c_][t], w0, w1);
#pragma unroll
                    for (int q = 0; q < 4; ++q)
#pragma unroll
                        for (int t = 0; t < 2; ++t) acc[t][q] = __builtin_amdgcn_mfma_f32_32x32x16_bf16(br[c_][q], af[t], acc[t][q], 0, 0, 0);
                }
            }
            bf16_t* So = Sg + ((size_t)((b * 2 + dir) * NCHUNK + c) * 8 + h) * 8192 + (size_t)(lane & 31) * 128 + 4 * (lane >> 5);
#pragma unroll
            for (int t = 0; t < 2; ++t)
#pragma unroll
                for (int q = 0; q < 4; ++q)
#pragma unroll
                    for (int rg = 0; rg < 4; ++rg) { u32x2 pk; pk.x = cvt_pk_bf16(acc[t][q][4 * rg], acc[t][q][4 * rg + 1]); pk.y = cvt_pk_bf16(acc[t][q][4 * rg + 2], acc[t][q][4 * rg + 3]);
                        *(u32x2*)(So + (size_t)(32 * t) * 128 + 32 * q + 8 * rg) = pk; }
        }
        __syncthreads();
    }
}
__device__ __forceinline__ void phase_s2(CP p, int bid, int nb) {
    const int tid = launder_tid();
    const bf16_t* Sg = (const bf16_t*)(p->ws + WS_S); const float* DEC = (const float*)(p->ws + WS_DEC); bf16_t* HP = (bf16_t*)(p->ws + WS_HP);
    for (int idx = bid * NTHREADS + tid; idx < 2 * 2 * 8 * 64 * 64; idx += nb * NTHREADS) {
        const int n2 = idx & 63, pr = (idx >> 6) & 63, h = (idx >> 12) & 7, dir = (idx >> 15) & 1, b = idx >> 16;
        const size_t inner = (size_t)h * 8192 + pr * 128 + 2 * n2;
        const size_t cbase = (size_t)(b * 2 + dir) * NCHUNK;
        float s0 = 0.f, s1 = 0.f;
#pragma unroll 26
        for (int step = 0; step < NCHUNK; ++step) {
            const int c = dir == 0 ? step : (step < 2 ? 1 - step : NCHUNK + 1 - step);
            const size_t off = (cbase + c) * 65536 + inner;
            const unsigned sv = __builtin_nontemporal_load((const unsigned*)(Sg + off)); const float d = DEC[(cbase + c) * 8 + h];
            *(unsigned*)(HP + off) = cvt_pk_bf16(s0, s1);
            s0 = s0 * d + bflo(sv); s1 = s1 * d + bfhi(sv);
        }
    }
}
__device__ __forceinline__ void phase_s3(CP p, int l, unsigned char* lds_, int bid, int nb) {
    LAS unsigned char* lds = (LAS unsigned char*)lds_;
    LAS unsigned char* Cs = lds;
    LAS unsigned char* Bs = Cs + 128 * ST_ROW;
    LAS unsigned char* Mt = Bs;
    LAS unsigned char* Xs = Bs + 128 * ST_MT;
    LAS unsigned char* Hf = Xs + 128 * ST_TR64;
    LAS unsigned char* Hb = Hf + 64 * ST_ROW;
    LAS float* hvs = (LAS float*)(Hb + 64 * ST_ROW);
    LAS float* ssqp = hvs + 4 * 776;
    LAS float* cwl = ssqp + 256;
    LAS float* atab = cwl + 6 * 512;
    const int tid0 = launder_tid(); const int wave = __builtin_amdgcn_readfirstlane(tid0 >> 6);
    const bf16_t* proj = (const bf16_t*)(p->ws + WS_PROJ); bf16_t* mix = (bf16_t*)(p->ws + WS_HX);
    const float* cw = p->ssd_conv_w + (size_t)l * 5 * 1024; const float* cbias = p->ssd_conv_b + (size_t)l * 1024;
    const bf16_t* HP = (const bf16_t*)(p->ws + WS_HP); float* SSQ = (float*)(p->ws + WS_SSQ);
    if (tid0 < 16) atab[tid0] = -expf(p->a_log[l * 16 + tid0]); else if (tid0 < 24) atab[tid0] = p->d_skip[l * 8 + tid0 - 16];
    __syncthreads();
    int cur_g = -1;
    const int cskip = (l == DEPTH - 1) ? 2 : 0, cpb = NCHUNK - cskip;
    const int nunits = NB * cpb * 2, nfull = nunits - nunits % nb, nitems = nfull + (nunits - nfull) * 4;
#pragma unroll 1
    for (int it = bid; it < nitems; it += nb) {
        const int u = it < nfull ? it : nfull + ((it - nfull) >> 2);
        const int hh_lo = it < nfull ? 0 : ((it - nfull) & 3), hh_hi = it < nfull ? 4 : hh_lo + 1;
        const int g = u & 1, c = cskip + (u >> 1) % cpb, b = (u >> 1) / cpb;
        int tid = tid0; asm volatile("" : "+v"(tid));
        const int lane = tid & 63;
        const int row0 = b * SEG + c * 128;
        const bool lo_ok = !(c == 0 || c == 2), hi_ok = !(c == 1 || c == NCHUNK - 1);
        if (g != cur_g) { cur_g = g;
            float tw[6];
#pragma unroll
            for (int it = 0; it < 6; ++it) { const int i = tid + NTHREADS * it; const int j = i >> 9, lc = i & 511; const int gch = lc < 128 ? 768 + g * 128 + lc : (lc < 256 ? 512 + g * 128 + (lc - 128) : g * 256 + (lc - 256));
                tw[it] = j < 5 ? cw[j * 1024 + gch] : cbias[gch]; }
#pragma unroll
            for (int it = 0; it < 6; ++it) cwl[tid + NTHREADS * it] = tw[it]; }
        u32x2 rx[8];
        {
            u32x4 r0[8], r1[8];
            const int cg = tid & 31; const int gch = (cg < 16 ? 768 : 512) + g * 128 + (cg & 15) * 8;
            conv_load(proj, row0, tid >> 5, gch, lo_ok, hi_ok, r0);
            conv_load(proj, row0, (tid >> 5) + 16, gch, lo_ok, hi_ok, r1);
            head_cums(p, l, row0, 4 * g + (wave >> 1), wave & 1, lane, hvs + (wave >> 1) * 776, atab);
            { LAS float* hvw = hvs + (wave >> 1) * 776; const int dr = wave & 1;
              hvw[520 + dr * 128 + 2 * lane] = __expf(hvw[dr * 128 + 2 * lane]); hvw[520 + dr * 128 + 2 * lane + 1] = __expf(hvw[dr * 128 + 2 * lane + 1]); }
            __syncthreads();
            float o[4][8];
            LAS unsigned char* dst = (cg < 16 ? Cs : Bs) + (cg & 15) * 16;
            conv_compute(r0, cwl, 512, cg * 8, o, (tid >> 5) == 0 && !lo_ok, false);
#pragma unroll
            for (int i = 0; i < 4; ++i) *(LAS u32x4*)(dst + (4 * (tid >> 5) + i) * ST_ROW) = pack8(o[i]);
            asm volatile("" ::: "memory");
            conv_load4(proj, row0, tid >> 4, g * 256 + hh_lo * 64 + (tid & 15) * 4, lo_ok, hi_ok, rx);
            conv_compute(r1, cwl, 512, cg * 8, o, false, (tid >> 5) == 15 && !hi_ok);
#pragma unroll
            for (int i = 0; i < 4; ++i) *(LAS u32x4*)(dst + (4 * ((tid >> 5) + 16) + i) * ST_ROW) = pack8(o[i]);
            { float o4[4][4]; conv_compute4(rx, cwl, 512, 256 + hh_lo * 64 + (tid & 15) * 4, o4, (tid >> 4) == 0 && !lo_ok, (tid >> 4) == 31 && !hi_ok);
#pragma unroll
              for (int i = 0; i < 4; ++i) { u32x2 pk; pk.x = cvt_pk_bf16(o4[i][0], o4[i][1]); pk.y = cvt_pk_bf16(o4[i][2], o4[i][3]); *(LAS u32x2*)(Xs + (4 * (tid >> 4) + i) * ST_TR64 + (tid & 15) * 8) = pk; } }
        }
        __syncthreads();
        const int lb = wave >> 1, hs = wave & 1;
        int ln = lane; asm volatile("" : "+v"(ln));
        f32x16 gacc[2];
#pragma unroll
        for (int t = 0; t < 2; ++t)
#pragma unroll
            for (int e = 0; e < 16; ++e) gacc[t][e] = 0.f;
#pragma unroll
        for (int kk = 0; kk < 8; ++kk) { const bf16x8 af = row_frag(Cs, ST_ROW, 32 * lb, 16 * kk, lane);
#pragma unroll
            for (int t = 0; t < 2; ++t) { const bf16x8 bf = row_frag(Bs, ST_ROW, 64 * hs + 32 * t, 16 * kk, lane);
                gacc[t] = __builtin_amdgcn_mfma_f32_32x32x16_bf16(af, bf, gacc[t], 0, 0, 0); } }
        u32x4 hreg[4];
        { const bf16_t* hp0 = HP + ((size_t)(b * 2 * NCHUNK + c) * 8 + 4 * g + hh_lo) * 8192;
#pragma unroll
          for (int q = 0; q < 4; ++q) { const int it = tid + 512 * q; hreg[q] = __builtin_nontemporal_load((const u32x4*)(hp0 + (size_t)(it >> 10) * NCHUNK * 8 * 8192 + (it & 1023) * 8)); } }
        __syncthreads();
#pragma unroll 1
        for (int hh = hh_lo; hh < hh_hi; ++hh) {
            const int h = 4 * g + hh; const LAS float* hv = hvs + hh * 776;
            asm volatile("" : "+v"(ln));
            const int ph = hs;
            const int lrw = 32 * lb + (ln & 31), pq = 32 * ph + 4 * (ln >> 5);
            u32x2 zraw[4];
#pragma unroll
            for (int rg = 0; rg < 4; ++rg) zraw[rg] = *(const u32x2*)(proj + (size_t)(row0 + lrw) * NPROJ + 1024 + h * 64 + pq + 8 * rg);
#pragma unroll
            for (int t = 0; t < 2; ++t) {
                const int st = 2 * hs + t;
                const int sc = 32 * st + (ln & 31);
                const float cfs = hv[sc], cbs = hv[128 + sc], dfs = hv[256 + sc], dbs = hv[384 + sc];
#pragma unroll
                for (int rg = 0; rg < 4; ++rg) {
                    const int l0 = 32 * lb + 8 * rg + 4 * (ln >> 5);
                    float m[4];
                    if (st < lb) {
                        const f32x4 cfl = *(const LAS f32x4*)(hv + l0);
#pragma unroll
                        for (int e = 0; e < 4; ++e) m[e] = gacc[t][4 * rg + e] * (__expf(cfl[e] - cfs) * dfs);
                    } else if (st > lb) {
                        const f32x4 cbl = *(const LAS f32x4*)(hv + 128 + l0);
#pragma unroll
                        for (int e = 0; e < 4; ++e) m[e] = gacc[t][4 * rg + e] * (__expf(cbl[e] - cbs) * dbs);
                    } else {
                        const f32x4 cfl = *(const LAS f32x4*)(hv + l0), cbl = *(const LAS f32x4*)(hv + 128 + l0);
#pragma unroll
                        for (int e = 0; e < 4; ++e) { const int lr = l0 + e;
                            const float ff = lr >= sc ? __expf(cfl[e] - cfs) * dfs : 0.f;
                            const float fb = lr <= sc ? __expf(cbl[e] - cbs) * dbs : 0.f;
                            m[e] = gacc[t][4 * rg + e] * (ff + fb); }
                    }
                    u32x2 pk; pk.x = cvt_pk_bf16(m[0], m[1]); pk.y = cvt_pk_bf16(m[2], m[3]);
                    *(LAS u32x2*)(Mt + sc * ST_MT + l0 * 2) = pk;
                }
            }
#pragma unroll
            for (int q = 0; q < 4; ++q) { const int it = tid + 512 * q; const int q2 = it & 1023;
                *(LAS u32x4*)(((it >> 10) ? Hb : Hf) + (q2 >> 4) * ST_ROW + (q2 & 15) * 16) = hreg[q]; }
            if (hh + 1 < hh_hi) {
                const bf16_t* hp0 = HP + ((size_t)(b * 2 * NCHUNK + c) * 8 + h + 1) * 8192;
#pragma unroll
                for (int q = 0; q < 4; ++q) { const int it = tid + 512 * q; hreg[q] = __builtin_nontemporal_load((const u32x4*)(hp0 + (size_t)(it >> 10) * NCHUNK * 8 * 8192 + (it & 1023) * 8)); }
                conv_load4(proj, row0, tid >> 4, g * 256 + (hh + 1) * 64 + (tid & 15) * 4, lo_ok, hi_ok, rx);
            }
            __syncthreads();
            f32x16 ad, af_, ab_;
#pragma unroll
            for (int e = 0; e < 16; ++e) { ad[e] = 0.f; af_[e] = 0.f; ab_[e] = 0.f; }
            {
                bf16x8 am[2], bx[2], ac[2], bhf[2], bhb[2];
                am[0] = tr_frag(Mt, ST_MT, 0, 32 * lb, lane); bx[0] = tr_frag(Xs, ST_TR64, 0, 32 * ph, lane);
                ac[0] = row_frag(Cs, ST_ROW, 32 * lb, 0, lane); bhf[0] = row_frag(Hf, ST_ROW, 32 * ph, 0, lane); bhb[0] = row_frag(Hb, ST_ROW, 32 * ph, 0, lane);
#pragma unroll
                for (int kk = 0; kk < 8; ++kk) { const int c = kk & 1, n = c ^ 1;
                    if (kk < 7) { am[n] = tr_frag(Mt, ST_MT, 16 * (kk + 1), 32 * lb, lane); bx[n] = tr_frag(Xs, ST_TR64, 16 * (kk + 1), 32 * ph, lane);
                        ac[n] = row_frag(Cs, ST_ROW, 32 * lb, 16 * (kk + 1), lane); bhf[n] = row_frag(Hf, ST_ROW, 32 * ph, 16 * (kk + 1), lane); bhb[n] = row_frag(Hb, ST_ROW, 32 * ph, 16 * (kk + 1), lane); }
                    ad = __builtin_amdgcn_mfma_f32_32x32x16_bf16(bx[c], am[c], ad, 0, 0, 0);
                    af_ = __builtin_amdgcn_mfma_f32_32x32x16_bf16(bhf[c], ac[c], af_, 0, 0, 0);
                    ab_ = __builtin_amdgcn_mfma_f32_32x32x16_bf16(bhb[c], ac[c], ab_, 0, 0, 0); }
            }
            const float dsk = atab[16 + h];
            { const float ef = hv[520 + lrw], eb = hv[648 + lrw];
              float sq = 0.f;
#pragma unroll
              for (int rg = 0; rg < 4; ++rg) {
                const u32x2 xr = *(const LAS u32x2*)(Xs + lrw * ST_TR64 + (pq + 8 * rg) * 2);
                const float xs[4] = {bflo(xr.x), bfhi(xr.x), bflo(xr.y), bfhi(xr.y)};
                const float zz[4] = {bflo(zraw[rg].x), bfhi(zraw[rg].x), bflo(zraw[rg].y), bfhi(zraw[rg].y)};
                float v[4];
#pragma unroll
                for (int e = 0; e < 4; ++e) { const int ri = 4 * rg + e;
                    const float y = ad[ri] + ef * af_[ri] + eb * ab_[ri] + dsk * xs[e];
                    v[e] = y * zz[e];
                    sq += v[e] * v[e]; }
                u32x2 pk; pk.x = cvt_pk_bf16(v[0], v[1]); pk.y = cvt_pk_bf16(v[2], v[3]);
                *(u32x2*)(mix + (size_t)(row0 + lrw) * 1024 + h * 64 + pq + 8 * rg) = pk;
              }
              sq += __shfl_xor(sq, 32);
              if (ln < 32) ssqp[ph * 128 + lrw] = sq; }
            __syncthreads();
            if (tid < 128) SSQ[(size_t)(row0 + tid) * 8 + h] = ssqp[tid] + ssqp[128 + tid];
            if (hh + 1 < hh_hi) { float o4[4][4];
                conv_compute4(rx, cwl, 512, 256 + (hh + 1) * 64 + (tid & 15) * 4, o4, (tid >> 4) == 0 && !lo_ok, (tid >> 4) == 31 && !hi_ok);
#pragma unroll
                for (int i = 0; i < 4; ++i) { u32x2 pk; pk.x = cvt_pk_bf16(o4[i][0], o4[i][1]); pk.y = cvt_pk_bf16(o4[i][2], o4[i][3]); *(LAS u32x2*)(Xs + (4 * (tid >> 4) + i) * ST_TR64 + (tid & 15) * 8) = pk; } }
        }
        __syncthreads();
    }
}
__device__ __forceinline__ void phase_r2(CP p, int l, unsigned char* lds_, int bid, int nb) {
    LAS unsigned char* lds = (LAS unsigned char*)lds_;
    LAS unsigned char* Wh = lds;
    LAS unsigned char* Xh = Wh + 32 * ST_H16;
    LAS float* gm = (LAS float*)(Xh + 16 * ST_H16);
    LAS float* sh = gm + 3 * 1024;
    LAS float* part = sh + 3 * 1024;
    LAS float* lgs = part + 8 * 16 * 32;
    LAS int* lcnt = (LAS int*)(lgs + 16 * 32);
    LAS int* lcls = lcnt + 64;
    LAS int* lrank = lcls + 512;
    LAS float* lcwa = (LAS float*)(lrank + 512);
    LAS float* lcwb = lcwa + 512;
    const int tid = launder_tid(); const int lane = tid & 63, wave = __builtin_amdgcn_readfirstlane(tid >> 6);
    const float* mod = (const float*)(p->ws + WS_MOD) + (size_t)l * 3 * 6144;
    {
        float tmp[8];
#pragma unroll
        for (int it = 0; it < 8; ++it) tmp[it] = p->w_rg[(size_t)l * 4096 + tid + NTHREADS * it];
#pragma unroll
        for (int it = 0; it < 8; ++it) { const int idx = tid + NTHREADS * it; *(LAS _Float16*)(Wh + (idx & 3) * ST_H16 + (idx >> 2) * 2) = (_Float16)tmp[it]; } }
#pragma unroll
    for (int hb = 0; hb < 2; ++hb) { float tmp[16];
#pragma unroll
        for (int it = 0; it < 16; ++it) tmp[it] = p->w_re[(size_t)l * 16384 + tid + NTHREADS * (16 * hb + it)];
#pragma unroll
        for (int it = 0; it < 16; ++it) { const int idx = tid + NTHREADS * (16 * hb + it); *(LAS _Float16*)(Wh + (4 + (idx & 15)) * ST_H16 + (idx >> 4) * 2) = (_Float16)tmp[it]; } }
    { unsigned zz; asm volatile("v_mov_b32 %0, 0" : "=v"(zz));
      for (int i = tid; i < 12 * 128; i += NTHREADS) { const int rw = 20 + i / 128, c16 = i % 128; *(LAS u32x4*)(Wh + rw * ST_H16 + c16 * 16) = (u32x4){zz, zz, zz, zz}; } }
    { float t0[6], t1[6], t2[6];
#pragma unroll
      for (int it = 0; it < 6; ++it) { const int idx = tid + NTHREADS * it; const int v = idx >> 10, k = idx & 1023; t0[it] = p->g_ffn[l * 1024 + k]; t1[it] = mod[v * 6144 + 4 * 1024 + k]; t2[it] = mod[v * 6144 + 3 * 1024 + k]; }
#pragma unroll
      for (int it = 0; it < 6; ++it) { const int idx = tid + NTHREADS * it; gm[idx] = t0[it] * (1.f + t1[it]); sh[idx] = t2[it]; } }
    if (tid < 64) lcnt[tid] = 0;
    __syncthreads();
    bf16_t* HM = (bf16_t*)(p->ws + WS_HX); float* CWLA = (float*)(p->ws + WS_CWLA); float* CWLB = (float*)(p->ws + WS_CWLB);
    int* gcount = (int*)(p->ws + WS_CTL) + l * 32; int* LIST = (int*)(p->ws + WS_LIST);
    const int rpb = (R + nb - 1) / nb, r0 = bid * rpb, r1 = (r0 + rpb) < R ? (r0 + rpb) : R;
    RowRaw xn[2];
#pragma unroll
    for (int q = 0; q < 2; ++q) if (r0 + 2 * wave + q < r1) row_load(p, 1, r0 + 2 * wave + q, lane, xn[q]);
#pragma unroll 1
    for (int t0r = r0; t0r < r1; t0r += 16) {
        f32x4 xv[2][4];
#pragma unroll
        for (int q = 0; q < 2; ++q) row_cvt(1, xn[q], xv[q]);
#pragma unroll
        for (int q = 0; q < 2; ++q) if (t0r + 16 + 2 * wave + q < r1) row_load(p, 1, t0r + 16 + 2 * wave + q, lane, xn[q]);
#pragma unroll
        for (int q = 0; q < 2; ++q) { const int rr = t0r + 2 * wave + q; const bool ok = rr < r1; const int v = row_v(ok ? rr : r0);
            float ss = 0.f;
#pragma unroll
            for (int j = 0; j < 4; ++j) ss += xv[q][j][0] * xv[q][j][0] + xv[q][j][1] * xv[q][j][1] + xv[q][j][2] * xv[q][j][2] + xv[q][j][3] * xv[q][j][3];
            ss = wave_sum(ss); const float rs = ok ? __builtin_amdgcn_rsqf(ss * (1.f / 1024.f) + 1e-6f) : 0.f;
#pragma unroll
            for (int j = 0; j < 4; ++j) { const int k = 4 * lane + 256 * j; const f32x4 g4 = *(const LAS f32x4*)(gm + v * 1024 + k), s4 = *(const LAS f32x4*)(sh + v * 1024 + k);
                f32x4 hv = xv[q][j] * rs * g4 + s4; if (!ok) hv = hv * 0.f;
                u32x2 o; o.x = cvt_pk_bf16(hv[0], hv[1]); o.y = cvt_pk_bf16(hv[2], hv[3]);
                if (ok) *(u32x2*)(HM + (size_t)rr * 1024 + k) = o;
                u32x2 h16; h16.x = pack_f16(hv[0], hv[1]); h16.y = pack_f16(hv[2], hv[3]);
                *(LAS u32x2*)(Xh + (2 * wave + q) * ST_H16 + k * 2) = h16; } }
        __syncthreads();
        {
            f32x4 acc0 = {0.f, 0.f, 0.f, 0.f}, acc1 = {0.f, 0.f, 0.f, 0.f};
#pragma unroll
            for (int s4 = 0; s4 < 4; ++s4) { const int kb = (128 * wave + 32 * s4 + 8 * (lane >> 4)) * 2;
                const f16x8 a = *(const LAS f16x8*)(Xh + (lane & 15) * ST_H16 + kb);
                const f16x8 b0 = *(const LAS f16x8*)(Wh + (lane & 15) * ST_H16 + kb), b1 = *(const LAS f16x8*)(Wh + (16 + (lane & 15)) * ST_H16 + kb);
                acc0 = __builtin_amdgcn_mfma_f32_16x16x32_f16(a, b0, acc0, 0, 0, 0);
                acc1 = __builtin_amdgcn_mfma_f32_16x16x32_f16(a, b1, acc1, 0, 0, 0); }
#pragma unroll
            for (int e = 0; e < 4; ++e) { const int row = 4 * (lane >> 4) + e; part[(wave * 16 + row) * 32 + (lane & 15)] = acc0[e]; part[(wave * 16 + row) * 32 + 16 + (lane & 15)] = acc1[e]; }
        }
        __syncthreads();
        if (tid < 320) { const int row = tid / 20, n = tid - row * 20; float sacc = n < 4 ? p->b_rg[l * 4 + n] : p->b_re[l * 16 + n - 4];
#pragma unroll
            for (int w = 0; w < 8; ++w) sacc += part[(w * 16 + row) * 32 + n];
            lgs[row * 32 + n] = sacc; }
        __syncthreads();
        if (tid < 16) { const int rr = t0r + tid;
            if (rr < r1) {
                if (l == DEPTH - 1 && row_v(rr) == 2) lcls[rr - r0] = -1;
                else {
                    float lg[20];
#pragma unroll
                    for (int n = 0; n < 20; ++n) lg[n] = lgs[tid * 32 + n];
                    int gsel = 0; float gmax = lg[0];
#pragma unroll
                    for (int t = 1; t < 4; ++t) if (lg[t] > gmax) { gmax = lg[t]; gsel = t; }
                    float gden = 0.f;
#pragma unroll
                    for (int t = 0; t < 4; ++t) gden += __expf(lg[t] - gmax);
                    const float gprob = 1.f / gden;
                    float el[4];
#pragma unroll
                    for (int t = 0; t < 4; ++t) el[t] = gsel == 0 ? lg[4 + t] : (gsel == 1 ? lg[8 + t] : (gsel == 2 ? lg[12 + t] : lg[16 + t]));
                    int i0 = 0; float m0 = el[0];
#pragma unroll
                    for (int t = 1; t < 4; ++t) if (el[t] > m0) { m0 = el[t]; i0 = t; }
                    int i1 = -1; float m1 = -3.0e38f;
#pragma unroll
                    for (int t = 0; t < 4; ++t) if (t != i0 && el[t] > m1) { m1 = el[t]; i1 = t; }
                    const float w0 = gprob / (1.f + __expf(m1 - m0)), w1 = gprob - w0;
                    const int ea = i0 < i1 ? i0 : i1, eb = i0 < i1 ? i1 : i0;
                    const float cwa = i0 < i1 ? w0 : w1, cwb = i0 < i1 ? w1 : w0;
                    const int pidx = ea == 0 ? eb - 1 : (ea == 1 ? eb + 1 : 5);
                    const int cls = gsel * 6 + pidx;
                    const int rank = __hip_atomic_fetch_add(&lcnt[cls], 1, __ATOMIC_RELAXED, __HIP_MEMORY_SCOPE_WORKGROUP);
                    lcls[rr - r0] = cls; lrank[rr - r0] = rank; lcwa[rr - r0] = cwa; lcwb[rr - r0] = cwb;
                } } }
    }
    __syncthreads();
    if (tid < NCLS) lcnt[32 + tid] = atomicAdd(&gcount[tid], lcnt[tid]);
    __syncthreads();
    for (int idx = tid; idx < r1 - r0; idx += NTHREADS) { const int cl = lcls[idx]; if (cl < 0) continue; const int pos = lcnt[32 + cl] + lrank[idx]; const size_t li = (size_t)cl * R + pos;
        LIST[li] = r0 + idx; CWLA[li] = lcwa[idx]; CWLB[li] = lcwb[idx]; }
    __syncthreads();
}
__device__ __forceinline__ void phase_final(CP p, unsigned char* lds, int bid, int nb) {
    const int tid = launder_tid(); const int lane = tid & 63, wave = tid >> 6;
    const int qstep = nb * 8;
    RowRaw xn;
    { const int q = bid * 8 + wave; if (q < NB * SEQ) { const int b = q >= SEQ ? 1 : 0; row_load(p, 1, b * SEG + CTXL + (q - b * SEQ), lane, xn); } }
    for (int q = bid * 8 + wave; q < NB * SEQ; q += qstep) {
        f32x4* hr = (f32x4*)(p->out + (size_t)q * D);
        f32x4 xv[4]; float ss = 0.f;
        row_cvt(1, xn, xv);
        { const int qn = q + qstep; if (qn < NB * SEQ) { const int bn = qn >= SEQ ? 1 : 0; row_load(p, 1, bn * SEG + CTXL + (qn - bn * SEQ), lane, xn); } }
#pragma unroll
        for (int j = 0; j < 4; ++j) ss += xv[j][0] * xv[j][0] + xv[j][1] * xv[j][1] + xv[j][2] * xv[j][2] + xv[j][3] * xv[j][3];
        ss = wave_sum(ss); const float rs = rsqrtf(ss * (1.f / 1024.f) + 1e-6f);
#pragma unroll
        for (int j = 0; j < 4; ++j) { const f32x4 g4 = *(const f32x4*)(p->g_final + 4 * lane + 256 * j); hr[lane + 64 * j] = xv[j] * rs * g4; }
    }
}


#define XB_TMO      128
#define XB_XCNT(j)  (256  + 64 * (j))
#define XB_XSUB(j)  (1280 + 64 * (j))
#define XB_XGEN(j)  (2304 + 64 * (j))
#define XB_TOP      3328
#define XB_TOPGEN   3392
#define XCD_BAR_WORDS 3456
#define XB_SPIN_CAP (1u << 22)
__device__ __forceinline__ unsigned xb_ld(unsigned* p) { return __hip_atomic_load(p, __ATOMIC_RELAXED, __HIP_MEMORY_SCOPE_AGENT); }
__device__ __forceinline__ unsigned xb_add(unsigned* p, unsigned v) { return __hip_atomic_fetch_add(p, v, __ATOMIC_RELAXED, __HIP_MEMORY_SCOPE_AGENT); }
__device__ __forceinline__ unsigned xb_xcc_id() { return (unsigned)__builtin_amdgcn_s_getreg((3 << 11) | 20) & 0xFu; }
#define XB_SPIN(cond, bar) do { unsigned _sp = 0; while (cond) { __builtin_amdgcn_s_sleep(1); \
    if ((++_sp & 255u) == 0u) { if (xb_ld(&(bar)[XB_TMO])) break; if (_sp > XB_SPIN_CAP) { atomicAdd(&(bar)[XB_TMO], 1u); break; } } } } while (0)
struct XcdBarrier { unsigned* bar; unsigned x; volatile LAS unsigned* st; };
__device__ __forceinline__ XcdBarrier xcd_barrier_post(unsigned* bar, volatile LAS unsigned* st) {
    XcdBarrier b; b.bar = bar; b.x = xb_xcc_id(); b.st = st;
    if (threadIdx.x == 0) (void)xb_add(&bar[XB_XCNT(b.x)], 1u);
    return b;
}
__device__ __forceinline__ void xcd_barrier_complete(unsigned* bar, unsigned x, unsigned& nloc, unsigned& nx) {
    const unsigned G = gridDim.x * gridDim.y * gridDim.z;
    unsigned sum, cnt, mine, sp = 0u;
    for (;;) {
        sum = 0u; cnt = 0u; mine = 0u;
#pragma unroll
        for (unsigned j = 0; j < 16; ++j) { const unsigned c = xb_ld(&bar[XB_XCNT(j)]); sum += c; cnt += (c > 0u) ? 1u : 0u; mine = (j == x) ? c : mine; }
        if (sum == G) break;
        __builtin_amdgcn_s_sleep(1);
        if ((++sp & 255u) == 0u) { if (xb_ld(&bar[XB_TMO])) break; if (sp > XB_SPIN_CAP) { atomicAdd(&bar[XB_TMO], 1u); break; } }
    }
    nloc = mine > 0u ? mine : 1u; nx = cnt > 0u ? cnt : 1u;
}
__device__ __forceinline__ void xcd_barrier(const XcdBarrier& b) {
    asm volatile("s_waitcnt vmcnt(0)" ::: "memory");
    __syncthreads();
    if (threadIdx.x == 0) {
        unsigned* bar = b.bar;
        __builtin_amdgcn_s_waitcnt(0);
        unsigned nloc = b.st[0], nx = b.st[1];
        if (nloc == 0u) { xcd_barrier_complete(bar, b.x, nloc, nx); b.st[0] = nloc; b.st[1] = nx; }
        const unsigned old = xb_add(&bar[XB_XSUB(b.x)], 1u);
        const unsigned gen = old / nloc;
        if (old + 1u == (gen + 1u) * nloc) {
            __builtin_amdgcn_fence(__ATOMIC_RELEASE, "agent");
            asm volatile("s_waitcnt vmcnt(0)" ::: "memory");
            const unsigned og = xb_add(&bar[XB_TOP], 1u);
            const unsigned tg = og / nx;
            if (og + 1u == (tg + 1u) * nx) xb_add(&bar[XB_TOPGEN], 1u);
            else XB_SPIN(xb_ld(&bar[XB_TOPGEN]) == tg, bar);
            __builtin_amdgcn_fence(__ATOMIC_ACQUIRE, "agent");
            xb_add(&bar[XB_XGEN(b.x)], 1u);
            asm volatile("s_waitcnt vmcnt(0)" ::: "memory");
        } else {
            XB_SPIN(xb_ld(&bar[XB_XGEN(b.x)]) == gen, bar);
            __builtin_amdgcn_fence(__ATOMIC_ACQUIRE, "agent");
            asm volatile("s_waitcnt vmcnt(0)" ::: "memory");
        }
    }
    __syncthreads();
}

#ifndef TIMING_A
#define TIMING_A -1
#endif
#ifndef TIMING_B
#define TIMING_B -1
#endif
#ifndef PHASE_MASK
#define PHASE_MASK 0xFFFFF
#endif
#define PM(i) ((PHASE_MASK >> (i)) & 1)
#ifndef REPEAT_MASK
#define REPEAT_MASK 0
#endif
#define RP(i) for (int rep_ = 0; rep_ < 1 + ((REPEAT_MASK >> (i)) & 1); ++rep_)
constexpr int PH_PER_LAYER = 9, NPHASES = 1 + DEPTH * PH_PER_LAYER + 1;
__global__ void __launch_bounds__(NTHREADS, 2) mk_fwd(Args args) {
    extern __shared__ __attribute__((aligned(16))) unsigned char lds[];
    cg::grid_group grid = cg::this_grid();
    const __attribute__((address_space(4))) Args* ap = (const __attribute__((address_space(4))) Args*)__builtin_amdgcn_kernarg_segment_ptr();
    const int lo = ap->lo, hi = ap->hi;
    LAS unsigned char* ldsl = (LAS unsigned char*)lds;
    volatile LAS unsigned* xbst = (volatile LAS unsigned*)(ldsl + LDS_BYTES - 16);
    if (threadIdx.x < 4) xbst[threadIdx.x] = 0u;
    __syncthreads();
    (void)xcd_barrier_post((unsigned*)(ap->p.ws + WS_BAR), xbst);
    if (TIMING_A >= 0 && blockIdx.x == 0 && threadIdx.x == 0) ((unsigned long long*)(ap->p.ws + WS_TS))[lo] = __builtin_amdgcn_s_memrealtime();
    for (int ph = lo; ph < hi; ++ph) {
        CP p = launder(&ap->p);
        int bid = blockIdx.x, nb = gridDim.x; asm volatile("" : "+s"(bid), "+s"(nb));
        if (ph == 0) { if (PM(0)) RP(0) phase_wprep(p, lds, 0, 912, bid, nb); if (PM(1)) RP(1) phase_adaln(p, lds, bid, nb); }
        else if (ph == NPHASES - 1) { if (PM(12)) phase_final(p, lds, bid, nb); }
        else {
            const int l = (ph - 1) / PH_PER_LAYER, s = (ph - 1) % PH_PER_LAYER;
            if (s == 0) { if (PM(2)) RP(2) { if (rep_ == 0 || l == 0) phase_r1(p, l, lds, bid, nb); } }
            else if (s == 1) { if (PM(3)) RP(3) {
                pg8::DenseSched S; S.init(p->ws + WS_HX, (const bf16_t*)(p->ws + WS_WTIN) + (size_t)l * DIN * 1024, R, NPROJ, 1024, 1024, 1024, nb, bid);
                EpiProj E{(bf16_t*)(p->ws + WS_PROJ)};
                pg8::gemm_phase<EpiProj, pg8::DenseSched, false>(ldsl, 1024, 1024, 1024, S, E);
                {
                    const int extra = S.nwg % nb; const int L1 = WPREP_ITEMS_PER_LAYER;
                    const int a0 = l == 0 ? 912 : L1 + 656, a1 = l == 0 ? 2960 : L1 + 2960;
                    if (l <= 1 && DEPTH == 2) { if (extra > 0 && bid >= extra) phase_wprep(p, lds, a0, a1, bid - extra, nb - extra); else if (extra == 0) phase_wprep(p, lds, a0, a1, bid, nb); } }
            } }
            else if (s == 2) { if (PM(4)) RP(4) phase_c1(p, l, lds, bid, nb); if (PM(5)) RP(5) phase_s1(p, l, lds, bid, nb); }
            else if (s == 3) { if (PM(6)) RP(6) phase_s2(p, bid, nb); }
            else if (s == 4) { if (PM(7)) RP(7) phase_s3(p, l, lds, bid, nb);
                if (PM(4)) {
                    const int cpb = NCHUNK - ((l == DEPTH - 1) ? 2 : 0), nunits = NB * cpb * 2, tail = (nunits % nb) * 4;
                    if (tail > 0 && tail < nb) { if (bid >= tail) phase_c1_ln(p, l, bid - tail, nb - tail); } else phase_c1_ln(p, l, bid, nb); } }
            else if (s == 5) { if (PM(8)) RP(8) { if (rep_ == 0 || l == 0) {
                pg8::DenseSched S; S.init(p->ws + WS_HX, (const bf16_t*)(p->ws + WS_WTOUT) + (size_t)l * 1024 * 1024, R, 1024, 1024, 1024, 1024, nb, bid, l == DEPTH - 1);
                EpiResid<0> E{p->ctx, p->x, (bf16_t*)(p->ws + WS_H), (const float*)(p->ws + WS_MOD) + (size_t)l * 3 * 6144, (const float*)(p->ws + WS_SSQ)};
                pg8::gemm_phase<EpiResid<0>, pg8::DenseSched, false>(ldsl, 1024, 1024, 1024, S, E);
                if (l == 0 && DEPTH == 2 && rep_ == 0) { const int extra = S.nwg % nb; const int L1 = WPREP_ITEMS_PER_LAYER;
                    if (extra > 0 && bid >= extra) phase_wprep(p, lds, 2960, 3984, bid - extra, nb - extra, L1, L1 + 656, L1 + 2960, L1 + 3984);
                    else if (extra == 0) phase_wprep(p, lds, 2960, 3984, bid, nb, L1, L1 + 656, L1 + 2960, L1 + 3984); }
            } } }
            else if (s == 6) { if (PM(9)) phase_r2(p, l, lds, bid, nb); }
            else if (s == 7) { if (PM(10)) {
                LAS int* tab = (LAS int*)(ldsl + MISC_OFF);
                LAS float* gl = (LAS float*)(ldsl + MISC_OFF + 4096);
                { const float* modl = (const float*)(p->ws + WS_MOD) + (size_t)l * 3 * 6144 + 5 * 1024; float tg[6]; const int tt = launder_tid();
#pragma unroll
                  for (int it = 0; it < 6; ++it) { const int i = tt + NTHREADS * it; tg[it] = modl[(size_t)(i >> 10) * 6144 + (i & 1023)]; }
#pragma unroll
                  for (int it = 0; it < 6; ++it) gl[tt + NTHREADS * it] = tg[it]; }
                moe_table(p, l, tab);
                unsigned* ready = (unsigned*)(p->ws + WS_M1CNT) + l * 192;
                { MoeSched S{tab, (const int*)(p->ws + WS_LIST), (const char*)(p->ws + WS_HX), (const char*)(p->ws + WS_WTGU), 0, l, nb, bid, ready, 0};
                  EpiUp E{(bf16_t*)(p->ws + WS_HID), (const float*)(p->ws + WS_CWLA), (const float*)(p->ws + WS_CWLB), ready};
                  pg8::gemm_phase<EpiUp, MoeSched, true>(ldsl, 1024, 1024, 1024, S, E); }
                { const int total = __builtin_amdgcn_readfirstlane(tab[24]) * 4; const int extra = __builtin_amdgcn_readfirstlane(total % nb);
                  MoeSched S{tab, (const int*)(p->ws + WS_LIST), (const char*)(p->ws + WS_HID), (const char*)(p->ws + WS_WTD), 1, l, nb, bid, ready, (total >= nb && total - extra >= nb) ? extra : 0};
                  EpiDown E{(bf16_t*)(p->ws + WS_H), (const int*)(p->ws + WS_LIST), gl};
                  pg8::gemm_phase<EpiDown, MoeSched, false>(ldsl, 512, 256, 512, S, E); }
            } }
            else { }
        }
        if (ph + 1 < hi && !(ph > 0 && ph < NPHASES - 1 && (ph - 1) % PH_PER_LAYER == 7)) { if (hi < 0) grid.sync();   else { XcdBarrier xb; xb.bar = (unsigned*)(launder(&ap->p)->ws + WS_BAR); xb.x = xb_xcc_id(); xb.st = (volatile LAS unsigned*)(ldsl + LDS_BYTES - 16); xcd_barrier(xb); }
            if (TIMING_A >= 0 && blockIdx.x == 0 && threadIdx.x == 0) ((unsigned long long*)(launder(&ap->p)->ws + WS_TS))[ph + 1] = __builtin_amdgcn_s_memrealtime(); }
    }
#if TIMING_A >= 0
    {
        XcdBarrier xb; xb.bar = (unsigned*)(launder(&ap->p)->ws + WS_BAR); xb.x = xb_xcc_id(); xb.st = (volatile LAS unsigned*)(ldsl + LDS_BYTES - 16); xcd_barrier(xb);
        if (blockIdx.x == 0 && threadIdx.x == 0) ((unsigned long long*)(launder(&ap->p)->ws + WS_TS))[hi] = __builtin_amdgcn_s_memrealtime();
        xcd_barrier(xb);
        const unsigned long long* ts = (const unsigned long long*)(launder(&ap->p)->ws + WS_TS);
        const float ta = (float)(ts[TIMING_A + 1] - ts[TIMING_A]) * 0.01f, tb = (float)(ts[TIMING_B + 1] - ts[TIMING_B]) * 0.01f;
        float* o = launder(&ap->p)->out; const float sc = 1.f + ta * 0.001f;
        for (size_t i = (size_t)blockIdx.x * NTHREADS + threadIdx.x; i < (size_t)NB * SEQ * D; i += (size_t)gridDim.x * NTHREADS) o[i] = o[i] * sc + (i == 0 ? tb * 0.1f : 0.f);
    }
#endif
}

extern "C" void kernel_launch(void* const* d_in, const int* in_sizes, int n_in, void* d_out, int out_size, void* d_ws, size_t ws_size, hipStream_t stream) {
    static int grid = 0;
    if (grid == 0) {
        if (n_in != 28 || ws_size < WS_END) { fprintf(stderr, "kernel_launch: unexpected n_in %d or ws_size %zu (< %zu)\n", n_in, ws_size, (size_t)WS_END); grid = -1; return; }
        int dev = 0, cus = 0, per_cu = 0;
        hipGetDevice(&dev); hipDeviceGetAttribute(&cus, hipDeviceAttributeMultiprocessorCount, dev);
        if (hipFuncSetAttribute((const void*)mk_fwd, hipFuncAttributeMaxDynamicSharedMemorySize, LDS_BYTES) != hipSuccess) { fprintf(stderr, "kernel_launch: hipFuncSetAttribute failed\n"); grid = -1; return; }
        if (hipOccupancyMaxActiveBlocksPerMultiprocessor(&per_cu, (const void*)mk_fwd, NTHREADS, LDS_BYTES) != hipSuccess || per_cu < 1) { fprintf(stderr, "kernel_launch: occupancy query says %d\n", per_cu); (void)hipGetLastError(); grid = -1; return; }
        grid = cus;
    }
    if (grid < 0) return;
    (void)hipMemsetAsync((char*)d_ws + WS_CTL, 0, WS_CTL_BYTES, stream);
    Args a{};
    const float** pp = (const float**)&a.p;
    for (int i = 0; i < 28; ++i) pp[i] = (const float*)d_in[i];
    a.p.out = (float*)d_out; a.p.ws = (unsigned char*)d_ws;
#if PER_PHASE_LAUNCH
    for (int ph = 0; ph < NPHASES; ++ph) {
        a.lo = ph; a.hi = ph + 1; void* kargs[] = {&a};
        hipError_t e = hipLaunchCooperativeKernel((const void*)mk_fwd, dim3(grid), dim3(NTHREADS), kargs, LDS_BYTES, stream);
        if (e != hipSuccess) { fprintf(stderr, "kernel_launch: launch of phase %d failed: %s\n", ph, hipGetErrorString(e)); break; }
    }
#else
    a.lo = 0; a.hi = NPHASES; void* kargs[] = {&a};
    hipError_t e = hipLaunchCooperativeKernel((const void*)mk_fwd, dim3(grid), dim3(NTHREADS), kargs, LDS_BYTES, stream);
    if (e != hipSuccess) fprintf(stderr, "kernel_launch: cooperative launch failed: %s (grid %d)\n", hipGetErrorString(e), grid);
#endif
}
```

```cpp
#include <hip/hip_runtime.h>
#include <hip/hip_cooperative_groups.h>
#include <cstdio>
namespace cg = cooperative_groups;

#ifndef PER_PHASE_LAUNCH
#define PER_PHASE_LAUNCH 0
#endif

#ifndef S3REP
#define S3REP 0
#endif
#define S3R(i) for (int r3_ = 0; r3_ < 1 + ((S3REP >> (i)) & 1); ++r3_)
#define LAS __attribute__((address_space(3)))
typedef unsigned short bf16_t;
typedef short bf16x8 __attribute__((ext_vector_type(8)));
typedef float f32x4 __attribute__((ext_vector_type(4)));
typedef unsigned u32x4 __attribute__((ext_vector_type(4)));
typedef unsigned u32x2 __attribute__((ext_vector_type(2)));

constexpr int D = 1024, NB = 2, SEQ = 16384, CTXL = 256, SEG = SEQ + CTXL, R = NB * SEG, DEPTH = 2;
constexpr int NPROJ = 2560, DIN = 2576;
constexpr int NTHREADS = 512;
constexpr int LDS_BYTES = 163840;
constexpr int MISC_OFF = 131072;
constexpr int NCLS = 24;

constexpr size_t al256(size_t x) { return (x + 255) & ~size_t(255); }
constexpr size_t WS_CTL = 0;
constexpr size_t WS_M1CNT = 20480;
constexpr size_t WS_TS = 2048;
constexpr size_t WS_BAR = 4096;
constexpr size_t WS_CTL_BYTES = 32768;
constexpr size_t WS_MOD = WS_CTL_BYTES;
constexpr size_t WS_WTIN = WS_MOD + al256((size_t)2 * 3 * 6144 * 4);
constexpr size_t WS_WTOUT = WS_WTIN + al256((size_t)2 * DIN * 1024 * 2);
constexpr size_t WS_WTGU = WS_WTOUT + al256((size_t)2 * 1024 * 1024 * 2);
constexpr size_t WS_WTD = WS_WTGU + al256((size_t)2 * 16 * 512 * 1024 * 2);
constexpr size_t WS_H = WS_WTD + al256((size_t)2 * 16 * 1024 * 256 * 2);
constexpr size_t WS_HX = WS_H + al256((size_t)R * 1024 * 2);
constexpr size_t WS_PROJ = WS_HX + al256((size_t)R * 1024 * 2);
constexpr size_t WS_DT = WS_PROJ + al256((size_t)R * NPROJ * 2);
constexpr size_t WS_POS = WS_DT + al256((size_t)R * 16 * 4);
constexpr size_t WS_LIST = WS_POS + al256((size_t)2 * R * 4);
constexpr size_t WS_CWLA = WS_LIST + al256((size_t)NCLS * R * 4);
constexpr size_t WS_CWLB = WS_CWLA + al256((size_t)NCLS * R * 4);
constexpr size_t WS_BIG = WS_CWLB + al256((size_t)NCLS * R * 4);
constexpr size_t WS_Y = WS_PROJ;
constexpr size_t WS_S = WS_BIG;
constexpr size_t WS_HP = WS_S + al256((size_t)2 * 2 * 130 * 8 * 8192 * 2);
constexpr size_t WS_DEC = WS_HP + al256((size_t)2 * 2 * 130 * 8 * 8192 * 2);
constexpr size_t WS_SSQ = WS_DEC + al256((size_t)2 * 2 * 130 * 8 * 4);
constexpr size_t WS_HID = WS_S;
constexpr size_t WS_END = WS_SSQ + al256((size_t)R * 8 * 4);
static_assert((size_t)(R + NCLS * 256) * 512 * 2 <= (size_t)2 * 2 * 130 * 8 * 8192 * 2, "hid alias");
static_assert(WS_END <= (size_t)512 * 1024 * 1024, "workspace");

struct Params {
    const float *x, *c, *ctx, *c_ctx, *w_ada, *b_ada, *g_mix, *g_ffn, *w_in, *conv_w, *conv_b, *conv_ln_g, *conv_ln_b, *ssd_conv_w, *ssd_conv_b,
        *dt_bias, *a_log, *d_skip, *ssd_norm_g, *w_out, *w_rg, *b_rg, *w_re, *b_re, *w_gate, *w_up, *w_down, *g_final;
    float* out; unsigned char* ws;
};
struct Args { Params p; int lo, hi; };
typedef const __attribute__((address_space(4))) Params* CP;
__device__ __forceinline__ CP launder(CP p) { asm volatile("" : "+s"(p)); return p; }
__device__ __forceinline__ int launder_tid() { int t = threadIdx.x; asm volatile("" : "+v"(t)); return t; }

__device__ __forceinline__ unsigned cvt_pk_bf16(float lo, float hi) { unsigned r; asm("v_cvt_pk_bf16_f32 %0, %1, %2" : "=v"(r) : "v"(lo), "v"(hi)); return r; }
__device__ __forceinline__ float bf2f(unsigned b) { return __uint_as_float(b << 16); }
__device__ __forceinline__ float bflo(unsigned w) { return __uint_as_float(w << 16); }
__device__ __forceinline__ float bfhi(unsigned w) { return __uint_as_float(w & 0xffff0000u); }
__device__ __forceinline__ bf16_t f2bf(float f) { return (bf16_t)(cvt_pk_bf16(f, 0.f) & 0xffffu); }
#define DPP_ADD(v, ctrl, rm) ((v) + __builtin_bit_cast(float, __builtin_amdgcn_update_dpp(0, __builtin_bit_cast(int, (v)), (ctrl), (rm), 0xF, true)))
__device__ __forceinline__ float row_sum16(float v) {
    v = DPP_ADD(v, 0xB1, 0xF);
    v = DPP_ADD(v, 0x4E, 0xF);
    v = DPP_ADD(v, 0x141, 0xF);
    v = DPP_ADD(v, 0x140, 0xF);
    return v;
}
__device__ __forceinline__ float half_sum32(float v) { v = row_sum16(v); v = DPP_ADD(v, 0x142, 0xA); return v; }
__device__ __forceinline__ float wave_sum(float v) {
    v = half_sum32(v); v = DPP_ADD(v, 0x143, 0xC);
    return __builtin_bit_cast(float, __builtin_amdgcn_readlane(__builtin_bit_cast(int, v), 63));
}
__device__ __forceinline__ float sigmoidf_(float x) { return __builtin_amdgcn_rcpf(1.f + __builtin_amdgcn_exp2f(x * -1.44269504089f)); }
__device__ __forceinline__ float siluf_(float x) { return x * __builtin_amdgcn_rcpf(1.f + __builtin_amdgcn_exp2f(x * -1.44269504089f)); }
__device__ __forceinline__ float softplusf_(float x) { return fmaxf(x, 0.f) + __logf(1.f + __expf(-fabsf(x))); }

__device__ __forceinline__ int row_b(int r) { return r >= SEG ? 1 : 0; }
__device__ __forceinline__ int row_i(int r) { return r >= SEG ? r - SEG : r; }
__device__ __forceinline__ int row_v(int r) { const int i = row_i(r); return i < CTXL ? 2 : row_b(r); }
__device__ __forceinline__ const float* xin_ptr(const float* ctx, const float* x, int r) {
    const int b = row_b(r), i = row_i(r);
    return i < CTXL ? ctx + (size_t)(b * CTXL + i) * D : x + (size_t)(b * SEQ + i - CTXL) * D;
}
struct RowRaw { f32x4 f[4]; u32x2 h[4]; };
__device__ __forceinline__ void row_load(CP p, int l, int r, int lane, RowRaw& rr) {
    if (l == 0) { const f32x4* hr = (const f32x4*)xin_ptr(p->ctx, p->x, r);
#pragma unroll
        for (int j = 0; j < 4; ++j) rr.f[j] = __builtin_nontemporal_load(hr + lane + 64 * j); }
    else { const u32x2* hr = (const u32x2*)((const bf16_t*)(p->ws + WS_H) + (size_t)r * D);
#pragma unroll
        for (int j = 0; j < 4; ++j) rr.h[j] = hr[lane + 64 * j]; }
}
__device__ __forceinline__ void row_cvt(int l, const RowRaw& rr, f32x4 (&xv)[4]) {
#pragma unroll
    for (int j = 0; j < 4; ++j) xv[j] = l == 0 ? rr.f[j] : (f32x4){bflo(rr.h[j].x), bfhi(rr.h[j].x), bflo(rr.h[j].y), bfhi(rr.h[j].y)};
}
namespace pg8 {
constexpr int BM = 256, BK = 64, HALF = 128, HTB = HALF * BK * 2, STAGE_BYTES = 8 * HTB, NXCD = 8, WGM = 8;
__device__ __forceinline__ int lds_byte(int r, int c) { const int st = (r >> 4) * 2 + (c >> 5), rr = r & 15, cc = c & 31, ob = rr * 64 + cc * 2; return st * 1024 + (ob ^ (((ob >> 9) & 1) << 5)); }
__device__ __forceinline__ void stage_rc(int b, int& Rr, int& Cc) { const int st = b / 1024, sb = b % 1024, swz = sb ^ (((sb >> 9) & 1) << 5); Rr = (st >> 1) * 16 + swz / 64; Cc = (st & 1) * 32 + (swz % 64) / 2; }
__device__ __forceinline__ int perm32(int rho) { const int n = rho >> 4, i = rho & 15; return 8 * (i >> 2) + 4 * n + (i & 3); }

struct Unit {
    const char* a0;
    const char* b0;
    const char* b1;
    int i0, i1, i2, i3, i4, pad;
};

template <class Epi, class Sched, bool GATHER>
__device__ __forceinline__ void gemm_phase(LAS unsigned char* lds, const int lda, const int ldb, const int K, const Sched& S, const Epi& E) {
    const int tid = launder_tid(); const int wid = __builtin_amdgcn_readfirstlane(tid >> 6), lane = tid & 63, wr = wid >> 2, wc = wid & 3, fr = lane & 15, fq = lane >> 4;
    const int nt = K / BK, ks = nt >> 1;
    int Rr[2], Cc[2];
    unsigned voffB[2];
#pragma unroll
    for (int i = 0; i < 2; ++i) { stage_rc(tid * 16 + i * 8192, Rr[i], Cc[i]); const int Rb = Epi::PERM ? ((Rr[i] & ~31) + perm32(Rr[i] & 31)) : Rr[i];
        voffB[i] = (unsigned)(Rb * ldb + Cc[i]) * 2u; }
    const size_t kstep = (size_t)(BK * 2);
    const size_t hstepB = (size_t)HALF * ldb * 2;
    const unsigned ldsw = (unsigned)wid * 1024u;
    const unsigned ldsbase = (unsigned)(unsigned long)lds;
    const int aoff = lds_byte(wr * 64 + fr, fq * 8), boff = lds_byte(wc * 32 + fr, fq * 8);
#define PG8_SA(b, h) (((b) * 2 + (h)) * HTB)
#define PG8_SB(b, h) ((4 + (b) * 2 + (h)) * HTB)
#define PG8_STAGE2(bufoff, gbase, v0, v1) do { unsigned keep_; \
        asm volatile("s_mov_b32 %0, m0\n\ts_mov_b32 m0, %1\n\ts_nop 4\n\tglobal_load_lds_dwordx4 %2, %4\n\ts_add_u32 m0, m0, 0x2000\n\ts_nop 0\n\tglobal_load_lds_dwordx4 %3, %4\n\ts_mov_b32 m0, %0" \
            : "=&s"(keep_) : "s"(ldsbase + (unsigned)(bufoff) + ldsw), "v"(v0), "v"(v1), "s"(gbase) : "memory", "scc"); } while (0)
#define PG8_LDA(dst, b, h) do { _Pragma("unroll") for (int m = 0; m < 4; ++m) _Pragma("unroll") for (int k = 0; k < 2; ++k) dst[m][k] = *(const LAS bf16x8*)(lds + PG8_SA(b, h) + aoff + m * 2048 + k * 1024); } while (0)
#define PG8_LDB(dst, b, h) do { _Pragma("unroll") for (int n = 0; n < 2; ++n) _Pragma("unroll") for (int k = 0; k < 2; ++k) dst[n][k] = *(const LAS bf16x8*)(lds + PG8_SB(b, h) + boff + n * 2048 + k * 1024); } while (0)
#define PG8_MMA(ai, bj, At, Bt) do { __builtin_amdgcn_s_setprio(1); _Pragma("unroll") for (int m = 0; m < 4; ++m) _Pragma("unroll") for (int n = 0; n < 2; ++n) _Pragma("unroll") for (int k = 0; k < 2; ++k) \
        acc[ai][bj][m][n] = __builtin_amdgcn_mfma_f32_16x16x32_bf16(Bt[n][k], At[m][k], acc[ai][bj][m][n], 0, 0, 0); __builtin_amdgcn_s_setprio(0); } while (0)
#define PG8_WAIT_V(n) asm volatile("s_waitcnt vmcnt(" #n ")" ::: "memory")
#define PG8_WAIT_L(n) asm volatile("s_waitcnt lgkmcnt(" #n ")" ::: "memory")
#define PG8_BAR __builtin_amdgcn_s_barrier()
#define PG8_SCHED __builtin_amdgcn_sched_barrier(0)
#define PG8_BP(u, tt) ((tt) < ks ? (u).b0 + (size_t)(tt) * kstep : (u).b1 + (size_t)((tt) - ks) * kstep)
    Unit cur, nxt; int ui = 0;
    if (!S.get(0, cur)) return;
    S.a_ready(cur);
    unsigned c00, c01, c10, c11, n00, n01, n10, n11;
    if (GATHER) {
        c00 = (unsigned)(S.arow(cur, Rr[0]) * lda + Cc[0]) * 2u; c01 = (unsigned)(S.arow(cur, Rr[1]) * lda + Cc[1]) * 2u;
        c10 = (unsigned)(S.arow(cur, HALF + Rr[0]) * lda + Cc[0]) * 2u; c11 = (unsigned)(S.arow(cur, HALF + Rr[1]) * lda + Cc[1]) * 2u;
    } else {
        c00 = (unsigned)(Rr[0] * lda + Cc[0]) * 2u; c01 = (unsigned)(Rr[1] * lda + Cc[1]) * 2u;
        c10 = (unsigned)((HALF + Rr[0]) * lda + Cc[0]) * 2u; c11 = (unsigned)((HALF + Rr[1]) * lda + Cc[1]) * 2u;
    }
    n00 = c00; n01 = c01; n10 = c10; n11 = c11;
    f32x4 acc[2][2][4][2];
    float zr; asm volatile("v_mov_b32 %0, 0" : "=v"(zr));
#pragma unroll
    for (int a = 0; a < 2; ++a)
#pragma unroll
        for (int b = 0; b < 2; ++b)
#pragma unroll
            for (int m = 0; m < 4; ++m)
#pragma unroll
                for (int n = 0; n < 2; ++n) acc[a][b][m][n] = (f32x4){zr, zr, zr, zr};
    bf16x8 At[4][2], B0[2][2], B1[2][2];
    const char* cA = cur.a0;
    {
        const char* pb0 = PG8_BP(cur, 0); const char* pb1 = PG8_BP(cur, 1);
        PG8_STAGE2(PG8_SB(0, 0), pb0, voffB[0], voffB[1]); PG8_STAGE2(PG8_SA(0, 0), cA, c00, c01);
        PG8_STAGE2(PG8_SB(0, 1), pb0 + hstepB, voffB[0], voffB[1]); PG8_STAGE2(PG8_SA(0, 1), cA, c10, c11);
        if (wr == 1) PG8_BAR;
        PG8_WAIT_V(4); PG8_BAR;
        PG8_STAGE2(PG8_SB(1, 0), pb1, voffB[0], voffB[1]); PG8_STAGE2(PG8_SA(1, 0), cA + kstep, c00, c01);
        PG8_STAGE2(PG8_SB(1, 1), pb1 + hstepB, voffB[0], voffB[1]);
        PG8_WAIT_V(6); PG8_BAR;
    }
    for (;;) {
        const bool has_next = S.get(ui + 1, nxt);
        if (!has_next) nxt = cur;
        LAS int* tokb = (LAS int*)(lds + MISC_OFF + 1024) + ((ui + 1) & 1) * 256;
        if (GATHER) {
            n00 = c00; n01 = c01; n10 = c10; n11 = c11;
            if (has_next && wid == 0) {
                const char* src = (const char*)S.rows_ptr(nxt); unsigned keep_;
                asm volatile("s_mov_b32 %0, m0\n\ts_mov_b32 m0, %1\n\ts_nop 4\n\tglobal_load_lds_dwordx4 %2, %3\n\ts_mov_b32 m0, %0"
                    : "=&s"(keep_) : "s"((unsigned)(unsigned long)tokb), "v"((unsigned)lane * 16u), "s"(src) : "memory");
            }
        }
        const char* nA = nxt.a0;
#pragma unroll 1
        for (int t = 0; t < nt; t += 2) {
            const bool last = (t == nt - 2);
            if (last && has_next) S.a_ready(nxt);
            const char* a1 = cA + (size_t)(t + 1) * kstep;
            const char* a2 = last ? nA : cA + (size_t)(t + 2) * kstep;
            const char* a3 = a2 + kstep;
            const char* b2 = last ? PG8_BP(nxt, 0) : PG8_BP(cur, t + 2);
            const char* b3 = last ? PG8_BP(nxt, 1) : PG8_BP(cur, t + 3);
            if (GATHER) { if (last && has_next) {
                const int lim = S.rows_valid(nxt) - 1;
                const int i0 = Rr[0] < lim ? Rr[0] : lim, i1 = Rr[1] < lim ? Rr[1] : lim, i2 = (HALF + Rr[0]) < lim ? (HALF + Rr[0]) : lim, i3 = (HALF + Rr[1]) < lim ? (HALF + Rr[1]) : lim;
                n00 = (unsigned)(tokb[i0] * lda + Cc[0]) * 2u; n01 = (unsigned)(tokb[i1] * lda + Cc[1]) * 2u;
                n10 = (unsigned)(tokb[i2] * lda + Cc[0]) * 2u; n11 = (unsigned)(tokb[i3] * lda + Cc[1]) * 2u; } }
            const unsigned s00 = last ? n00 : c00, s01 = last ? n01 : c01, s10 = last ? n10 : c10, s11 = last ? n11 : c11;
            if constexpr (Epi::MIDSCALE) { if (t == ks) E.midscale(acc, cur, wr, wc, fr, fq); }
            PG8_LDB(B0, 0, 0); PG8_SCHED; PG8_LDA(At, 0, 0); PG8_STAGE2(PG8_SA(1, 1), a1, c10, c11);
            PG8_WAIT_L(8); PG8_BAR; PG8_WAIT_L(0); PG8_MMA(0, 0, At, B0); PG8_BAR; PG8_SCHED;
            PG8_LDB(B1, 0, 1); PG8_STAGE2(PG8_SB(0, 0), b2, voffB[0], voffB[1]);
            PG8_BAR; PG8_WAIT_L(0); PG8_MMA(0, 1, At, B1); PG8_BAR;
            PG8_LDA(At, 0, 1); PG8_STAGE2(PG8_SA(0, 0), a2, s00, s01);
            PG8_BAR; PG8_WAIT_L(0); PG8_MMA(1, 0, At, B0); PG8_BAR; PG8_SCHED;
            PG8_STAGE2(PG8_SB(0, 1), b2 + hstepB, voffB[0], voffB[1]);
            PG8_WAIT_V(6); PG8_BAR; PG8_MMA(1, 1, At, B1); PG8_BAR;
            PG8_LDB(B0, 1, 0); PG8_SCHED; PG8_LDA(At, 1, 0); PG8_STAGE2(PG8_SA(0, 1), a2, s10, s11);
            PG8_WAIT_L(8); PG8_BAR; PG8_WAIT_L(0); PG8_MMA(0, 0, At, B0); PG8_BAR; PG8_SCHED;
            PG8_LDB(B1, 1, 1); PG8_STAGE2(PG8_SB(1, 0), b3, voffB[0], voffB[1]);
            PG8_BAR; PG8_WAIT_L(0); PG8_MMA(0, 1, At, B1); PG8_BAR;
            PG8_LDA(At, 1, 1); PG8_STAGE2(PG8_SA(1, 0), a3, s00, s01);
            PG8_BAR; PG8_WAIT_L(0); PG8_MMA(1, 0, At, B0); PG8_BAR; PG8_SCHED;
            PG8_STAGE2(PG8_SB(1, 1), b3 + hstepB, voffB[0], voffB[1]);
            PG8_WAIT_V(6); PG8_BAR; PG8_MMA(1, 1, At, B1); PG8_BAR;
        }
        E(acc, cur, wr, wc, fr, fq);
        if (!has_next) break;
        asm volatile("v_mov_b32 %0, 0" : "=v"(zr));
#pragma unroll
        for (int a = 0; a < 2; ++a)
#pragma unroll
            for (int b = 0; b < 2; ++b)
#pragma unroll
                for (int m = 0; m < 4; ++m)
#pragma unroll
                    for (int n = 0; n < 2; ++n) acc[a][b][m][n] = (f32x4){zr, zr, zr, zr};
        cur = nxt; cA = nA; ++ui; c00 = n00; c01 = n01; c10 = n10; c11 = n11;
    }
    PG8_WAIT_V(0);
    if (wr == 0) PG8_BAR;
    PG8_BAR;
#undef PG8_SA
#undef PG8_SB
#undef PG8_STAGE2
#undef PG8_LDA
#undef PG8_LDB
#undef PG8_MMA
#undef PG8_WAIT_V
#undef PG8_WAIT_L
#undef PG8_BAR
#undef PG8_SCHED
#undef PG8_BP
}

struct DenseSched {
    const char* A; const char* Bt; int lda, ldb, K; int nM, nN, nwg, G, c, skipctx;
    __device__ __forceinline__ void init(const void* A_, const void* Bt_, int M, int N, int K_, int lda_, int ldb_, int G_, int c_, int skipctx_ = 0) {
        A = (const char*)A_; Bt = (const char*)Bt_; lda = lda_; ldb = ldb_; K = K_; nM = M / BM - 2 * skipctx_; nN = N / BM; nwg = nM * nN; G = G_; c = c_; skipctx = skipctx_; }
    __device__ __forceinline__ bool get(int i, Unit& u) const {
        const long L = (long)i * G + c; if (L >= nwg) return false;
        int wgid = (int)L; { const int q = nwg / NXCD, r = nwg % NXCD, xcd = wgid % NXCD, off = wgid / NXCD; wgid = (xcd < r ? xcd * (q + 1) : r * (q + 1) + (xcd - r) * q) + off; }
        const int nig = WGM * nN, gid = wgid / nig, fm = gid * WGM, gsz = (nM - fm) < WGM ? (nM - fm) : WGM;
        int pm = fm + ((wgid % nig) % gsz); const int pn = (wgid % nig) / gsz;
        if (skipctx) pm += 1 + (pm >= 64 ? 1 : 0);
        u.a0 = A + (size_t)pm * BM * lda * 2; u.b0 = Bt + (size_t)pn * BM * ldb * 2; u.b1 = u.b0 + (size_t)(K / BK / 2) * BK * 2;
        u.i0 = pm; u.i1 = pn; u.i2 = 0; u.i3 = 0; u.i4 = 0; u.pad = 0; return true;
    }
    __device__ __forceinline__ void a_ready(const Unit&) const {}
    __device__ __forceinline__ int arow(const Unit&, int rl) const { return rl; }
    __device__ __forceinline__ const int* rows_ptr(const Unit&) const { return nullptr; }
    __device__ __forceinline__ int rows_valid(const Unit&) const { return 256; }
};
}

struct EpiProj {
    static constexpr bool PERM = true, MIDSCALE = false;
    bf16_t* O;
    __device__ __forceinline__ void operator()(const f32x4 (&acc)[2][2][4][2], const pg8::Unit& u, int wr, int wc, int fr, int fq) const {
        const int pn = u.i1;
        const int row0 = u.i0 * 256 + wr * 64 + fr;
        if (pn < 4) {
            const int col0 = pn * 128 + wc * 32 + 8 * fq;
#pragma unroll
            for (int ai = 0; ai < 2; ++ai)
#pragma unroll
                for (int m = 0; m < 4; ++m) { const f32x4 u0 = acc[ai][0][m][0], u1 = acc[ai][0][m][1], g0 = acc[ai][1][m][0], g1 = acc[ai][1][m][1];
                    u32x4 w; w.x = cvt_pk_bf16(u0[0] * sigmoidf_(g0[0]), u0[1] * sigmoidf_(g0[1])); w.y = cvt_pk_bf16(u0[2] * sigmoidf_(g0[2]), u0[3] * sigmoidf_(g0[3]));
                    w.z = cvt_pk_bf16(u1[0] * sigmoidf_(g1[0]), u1[1] * sigmoidf_(g1[1])); w.w = cvt_pk_bf16(u1[2] * sigmoidf_(g1[2]), u1[3] * sigmoidf_(g1[3]));
                    __builtin_nontemporal_store(w, (u32x4*)(O + (size_t)(row0 + ai * 128 + m * 16) * NPROJ + col0)); }
        } else {
            const int col0 = pn * 256 + wc * 32 + 8 * fq; const bool sl = pn < 6;
#pragma unroll
            for (int ai = 0; ai < 2; ++ai)
#pragma unroll
                for (int m = 0; m < 4; ++m) { bf16_t* rowp = O + (size_t)(row0 + ai * 128 + m * 16) * NPROJ + col0;
#pragma unroll
                    for (int bj = 0; bj < 2; ++bj) { f32x4 v0 = acc[ai][bj][m][0], v1 = acc[ai][bj][m][1];
                        if (sl) {
#pragma unroll
                            for (int e = 0; e < 4; ++e) { v0[e] = siluf_(v0[e]); v1[e] = siluf_(v1[e]); } }
                        u32x4 w; w.x = cvt_pk_bf16(v0[0], v0[1]); w.y = cvt_pk_bf16(v0[2], v0[3]); w.z = cvt_pk_bf16(v1[0], v1[1]); w.w = cvt_pk_bf16(v1[2], v1[3]);
                        __builtin_nontemporal_store(w, (u32x4*)(rowp + bj * 128)); } }
        }
    }
};
template <int L0> struct EpiResid {
    static constexpr bool PERM = true, MIDSCALE = true;
    const float* inc; const float* inx; bf16_t* H; const float* modl; const float* ssq;
    __device__ __forceinline__ void midscale(f32x4 (&acc)[2][2][4][2], const pg8::Unit& u, int wr, int wc, int fr, int fq) const {
        typedef float f32x2 __attribute__((ext_vector_type(2)));
        const int r0 = u.i0 * 256 + wr * 64 + fr;
        f32x2 part[2][4];
#pragma unroll
        for (int ai = 0; ai < 2; ++ai)
#pragma unroll
            for (int m = 0; m < 4; ++m) part[ai][m] = *(const f32x2*)(ssq + (size_t)(r0 + ai * 128 + m * 16) * 8 + 2 * fq);
#pragma unroll
        for (int ai = 0; ai < 2; ++ai)
#pragma unroll
            for (int m = 0; m < 4; ++m) { float sq = part[ai][m][0] + part[ai][m][1];
                sq += __shfl_xor(sq, 16); sq += __shfl_xor(sq, 32);
                const float rs = rsqrtf(sq * (1.f / 512.f) + 1e-6f);
#pragma unroll
                for (int bj = 0; bj < 2; ++bj)
#pragma unroll
                    for (int n = 0; n < 2; ++n) acc[ai][bj][m][n] *= rs; }
    }
    __device__ __forceinline__ void operator()(const f32x4 (&acc)[2][2][4][2], const pg8::Unit& u, int wr, int wc, int fr, int fq) const {
        const int r0 = u.i0 * 256;
        const int v = row_v(r0);
        const float* gate = modl + (size_t)v * 6144 + 2 * 1024;
        const float* xin = xin_ptr(inc, inx, r0);
        const int rl0 = wr * 64 + fr, col0 = u.i1 * 256 + wc * 32 + 8 * fq;
        f32x4 gv[2][2];
#pragma unroll
        for (int bj = 0; bj < 2; ++bj)
#pragma unroll
            for (int n = 0; n < 2; ++n) gv[bj][n] = *(const f32x4*)(gate + col0 + bj * 128 + 4 * n);
#pragma unroll
        for (int ai = 0; ai < 2; ++ai) {
            u32x4 hr[4][2];
#pragma unroll
            for (int m = 0; m < 4; ++m)
#pragma unroll
                for (int bj = 0; bj < 2; ++bj) hr[m][bj] = *(const u32x4*)(H + (size_t)(r0 + rl0 + ai * 128 + m * 16) * D + col0 + bj * 128);
#pragma unroll
            for (int m = 0; m < 4; ++m)
#pragma unroll
                for (int bj = 0; bj < 2; ++bj) { const u32x4 hv = hr[m][bj]; const f32x4 a0 = acc[ai][bj][m][0], a1 = acc[ai][bj][m][1]; const f32x4 g0 = gv[bj][0], g1 = gv[bj][1];
                    u32x4 w;
                    w.x = cvt_pk_bf16(bflo(hv.x) + g0[0] * a0[0], bfhi(hv.x) + g0[1] * a0[1]); w.y = cvt_pk_bf16(bflo(hv.y) + g0[2] * a0[2], bfhi(hv.y) + g0[3] * a0[3]);
                    w.z = cvt_pk_bf16(bflo(hv.z) + g1[0] * a1[0], bfhi(hv.z) + g1[1] * a1[1]); w.w = cvt_pk_bf16(bflo(hv.w) + g1[2] * a1[2], bfhi(hv.w) + g1[3] * a1[3]);
                    *(u32x4*)(H + (size_t)(r0 + rl0 + ai * 128 + m * 16) * D + col0 + bj * 128) = w; }
            asm volatile("" ::: "memory"); }
    }
};

__device__ __forceinline__ const char* uniform_ptr(const char* q) {
    const unsigned long long v = (unsigned long long)q;
    const unsigned lo = __builtin_amdgcn_readfirstlane((unsigned)v), hi = __builtin_amdgcn_readfirstlane((unsigned)(v >> 32));
    return (const char*)(((unsigned long long)hi << 32) | lo);
}
struct MoeSched {
    const LAS int* tab;
    const int* list;
    const char* A; const char* W; int mode  , l, G, c;
    unsigned* ready;
    __device__ __forceinline__ void a_ready(const pg8::Unit& u) const {
        if (mode == 0) return;
        if (threadIdx.x < 64) {
            unsigned* w = ready + u.i4; unsigned spins = 0;
            while ((unsigned)__builtin_amdgcn_readfirstlane((int)__hip_atomic_load(w, __ATOMIC_RELAXED, __HIP_MEMORY_SCOPE_AGENT)) < 32u) {
                __builtin_amdgcn_s_sleep(2); if (++spins > (1u << 22)) break; }
            __builtin_amdgcn_fence(__ATOMIC_ACQUIRE, "agent");
            asm volatile("s_waitcnt vmcnt(0)" ::: "memory");
        }
        asm volatile("" ::: "memory"); __builtin_amdgcn_s_barrier(); asm volatile("" ::: "memory");
    }
    int late;
    __device__ __forceinline__ bool get(int i, pg8::Unit& u) const {
        const int total = __builtin_amdgcn_readfirstlane(tab[24]) * 4;
        int L;
        if (mode == 0 || late == 0) L = i * G + c;
        else if (c < late) { if (i > 0) return false; L = c; }
        else L = late + (c - late) + i * (G - late);
        if (L >= total) return false;
        const int tl = L >> 2, pn = L & 3;
        int cls = 0;
#pragma unroll 1
        for (int q = 1; q < NCLS; ++q) { const int tq = __builtin_amdgcn_readfirstlane(tab[q]); if (tq <= tl) cls = q; }
        const int j = tl - __builtin_amdgcn_readfirstlane(tab[cls]), cnt = __builtin_amdgcn_readfirstlane(tab[32 + cls]);
        const int g = cls / 6, pidx = cls - g * 6;
        const int ea = (pidx >= 3) + (pidx >= 5), eb = pidx < 3 ? pidx + 1 : (pidx < 5 ? pidx - 1 : 3);
        if (mode == 0) {
            const int e = 4 * g + (pn < 2 ? ea : eb);
            u.a0 = A;
            u.b0 = W + ((size_t)(l * 16 + e) * 512 + (size_t)(pn & 1) * 256) * 1024 * 2; u.b1 = u.b0 + (size_t)8 * 128;
        } else {
            u.a0 = A + (size_t)tl * 256 * 512 * 2;
            u.b0 = W + ((size_t)(l * 16 + 4 * g + ea) * 1024 + (size_t)pn * 256) * 256 * 2;
            u.b1 = W + ((size_t)(l * 16 + 4 * g + eb) * 1024 + (size_t)pn * 256) * 256 * 2;
        }
        u.a0 = uniform_ptr(u.a0); u.b0 = uniform_ptr(u.b0); u.b1 = uniform_ptr(u.b1);
        u.i0 = cls; u.i1 = j; u.i2 = pn; u.i3 = cnt; u.i4 = tl; u.pad = 0; return true;
    }
    __device__ __forceinline__ int arow(const pg8::Unit& u, int rl) const {
        int idx = u.i1 * 256 + rl; idx = idx < u.i3 ? idx : u.i3 - 1;
        return list[(size_t)u.i0 * R + idx];
    }
    __device__ __forceinline__ const int* rows_ptr(const pg8::Unit& u) const { return list + (size_t)u.i0 * R + u.i1 * 256; }
    __device__ __forceinline__ int rows_valid(const pg8::Unit& u) const { return u.i3 - u.i1 * 256; }
};
struct EpiUp {
    static constexpr bool PERM = true, MIDSCALE = false;
    bf16_t* hid; const float* cwla; const float* cwlb; unsigned* ready;
    __device__ __forceinline__ void operator()(const f32x4 (&acc)[2][2][4][2], const pg8::Unit& u, int wr, int wc, int fr, int fq) const {
        const int cls = u.i0, j = u.i1, pn = u.i2, cnt = u.i3, tl = u.i4;
        const float* cw = (pn < 2) ? cwla : cwlb;
        const int colbase = (pn >> 1) * 256 + (pn & 1) * 128 + wc * 32 + 8 * fq;
        float wrow[2][4];
#pragma unroll
        for (int ai = 0; ai < 2; ++ai)
#pragma unroll
            for (int m = 0; m < 4; ++m) { const int idx = j * 256 + ai * 128 + wr * 64 + m * 16 + fr; wrow[ai][m] = idx < cnt ? cw[(size_t)cls * R + idx] : 0.f; }
#pragma unroll
        for (int ai = 0; ai < 2; ++ai)
#pragma unroll
            for (int m = 0; m < 4; ++m) {
                const int rl = ai * 128 + wr * 64 + m * 16 + fr; const int idx = j * 256 + rl; const bool valid = idx < cnt;
                const float w = wrow[ai][m];
                const f32x4 g0 = acc[ai][0][m][0], g1 = acc[ai][0][m][1], u0 = acc[ai][1][m][0], u1 = acc[ai][1][m][1];
                float o[8];
#pragma unroll
                for (int e = 0; e < 4; ++e) { o[e] = w * siluf_(g0[e]) * u0[e]; o[4 + e] = w * siluf_(g1[e]) * u1[e]; }
                if (!valid) {
#pragma unroll
                    for (int e = 0; e < 8; ++e) o[e] = 0.f; }
                u32x4 pk; pk.x = cvt_pk_bf16(o[0], o[1]); pk.y = cvt_pk_bf16(o[2], o[3]); pk.z = cvt_pk_bf16(o[4], o[5]); pk.w = cvt_pk_bf16(o[6], o[7]);
                { bf16_t* dstp = hid + ((size_t)tl * 256 + rl) * 512 + colbase;
                  asm volatile("global_store_dwordx4 %0, %1, off sc1\n\ts_nop 1" :: "v"(dstp), "v"(pk) : "memory"); }
            }
        asm volatile("s_waitcnt vmcnt(0)" ::: "memory");
        if ((threadIdx.x & 63) == 0) __hip_atomic_fetch_add(ready + tl, 1u, __ATOMIC_RELAXED, __HIP_MEMORY_SCOPE_AGENT);
    }
};
struct EpiDown {
    static constexpr bool PERM = true, MIDSCALE = false;
    bf16_t* H; const int* list; const LAS float* gl;
    __device__ __forceinline__ void operator()(const f32x4 (&acc)[2][2][4][2], const pg8::Unit& u, int wr, int wc, int fr, int fq) const {
        const int cls = u.i0, j = u.i1, pn = u.i2, cnt = u.i3;
        const int col0 = pn * 256 + wc * 32 + 8 * fq;
        int tok[2][4];
#pragma unroll
        for (int ai = 0; ai < 2; ++ai)
#pragma unroll
            for (int m = 0; m < 4; ++m) { const int idx = j * 256 + ai * 128 + wr * 64 + m * 16 + fr; tok[ai][m] = idx < cnt ? list[(size_t)cls * R + idx] : -1; }
#pragma unroll
        for (int ai = 0; ai < 2; ++ai)
#pragma unroll
          for (int mp = 0; mp < 2; ++mp) {
            u32x4 hr[2][2];
#pragma unroll
            for (int mm = 0; mm < 2; ++mm) { const int t = tok[ai][2 * mp + mm]; const bf16_t* hp = H + (size_t)(t < 0 ? 0 : t) * D + col0;
#pragma unroll
                for (int bj = 0; bj < 2; ++bj) hr[mm][bj] = *(const u32x4*)(hp + bj * 128); }
#pragma unroll
            for (int mm = 0; mm < 2; ++mm) { const int m = 2 * mp + mm; const int t = tok[ai][m];
                if (t >= 0) { const LAS float* gp = gl + row_v(t) * 1024 + col0;
#pragma unroll
                    for (int bj = 0; bj < 2; ++bj) { const u32x4 hv = hr[mm][bj]; const f32x4 a0 = acc[ai][bj][m][0], a1 = acc[ai][bj][m][1];
                        const f32x4 g0 = *(const LAS f32x4*)(gp + bj * 128), g1 = *(const LAS f32x4*)(gp + bj * 128 + 4);
                        u32x4 w;
                        w.x = cvt_pk_bf16(bflo(hv.x) + g0[0] * a0[0], bfhi(hv.x) + g0[1] * a0[1]); w.y = cvt_pk_bf16(bflo(hv.y) + g0[2] * a0[2], bfhi(hv.y) + g0[3] * a0[3]);
                        w.z = cvt_pk_bf16(bflo(hv.z) + g1[0] * a1[0], bfhi(hv.z) + g1[1] * a1[1]); w.w = cvt_pk_bf16(bflo(hv.w) + g1[2] * a1[2], bfhi(hv.w) + g1[3] * a1[3]);
                        *(u32x4*)(H + (size_t)t * D + col0 + bj * 128) = w; } } }
            asm volatile("" ::: "memory"); }
    }
};

__device__ __forceinline__ void tr_tile(const float* src, int ldn, int k0, int n0, int nvalid, bf16_t* dst, int ldk, int drow0, LAS float* tile, int kd0 = -1, const float* kscale = nullptr) {
    const int tid = launder_tid();
    if (kd0 < 0) kd0 = k0;
    { const int n = tid & 63; const int kq = tid >> 6; float tv[8], ts[8];
#pragma unroll
      for (int it = 0; it < 8; ++it) { const int kk = kq + 8 * it; tv[it] = (n < nvalid) ? src[(size_t)(k0 + kk) * ldn + n0 + n] : 0.f; ts[it] = kscale ? kscale[kk] : 1.f; }
#pragma unroll
      for (int it = 0; it < 8; ++it) tile[(kq + 8 * it) * 65 + n] = tv[it] * ts[it]; }
    __syncthreads();
    { const int k8 = tid & 7, n = tid >> 3;
      if (n < nvalid) { const LAS float* s = tile + (k8 * 8) * 65 + n;
          u32x4 o; o.x = cvt_pk_bf16(s[0], s[65]); o.y = cvt_pk_bf16(s[2 * 65], s[3 * 65]); o.z = cvt_pk_bf16(s[4 * 65], s[5 * 65]); o.w = cvt_pk_bf16(s[6 * 65], s[7 * 65]);
          *(u32x4*)(dst + (size_t)(drow0 + n) * ldk + kd0 + k8 * 8) = o; } }
    __syncthreads();
}
constexpr int WPREP_ITEMS_PER_LAYER = 16 * 41 + 256 + 1024 + 1024 + 1024;
__device__ __forceinline__ void phase_wprep(CP p, unsigned char* lds, int it0, int it1, int bidx, int nblk, int b0 = 0, int b1 = 0, int c0 = 0, int c1 = 0) {
    LAS float* tile = (LAS float*)(LAS unsigned char*)lds;
    constexpr int I_IN = 16 * 41, I_OUT = 256, I_G = 1024, I_U = 1024, I_D = 1024, I_L = I_IN + I_OUT + I_G + I_U + I_D;
    const int na = it1 - it0, nbb = b1 - b0, ncc = c1 - c0;
    for (int vi = bidx; vi < na + nbb + ncc; vi += nblk) {
        const int it = vi < na ? it0 + vi : (vi < na + nbb ? b0 + (vi - na) : c0 + (vi - na - nbb));
        const int l = it / I_L; int r = it - l * I_L;
        if (r < I_IN) { const int kt = r / 41, ntl = r % 41; const int n0 = ntl * 64; const int nv = (DIN - n0) < 64 ? (DIN - n0) : 64;
            const int dr = n0 < 512 ? (n0 >> 7) * 256 + (n0 & 127) : (n0 < 1024 ? ((n0 - 512) >> 7) * 256 + 128 + ((n0 - 512) & 127) : n0);
            tr_tile(p->w_in + (size_t)l * 1024 * DIN, DIN, kt * 64, n0, nv, (bf16_t*)(p->ws + WS_WTIN) + (size_t)l * DIN * 1024, 1024, dr, tile); continue; }
        r -= I_IN;
        if (r < I_OUT) { const int kt = r >> 4, ntl = r & 15;
            tr_tile(p->w_out + (size_t)l * 1024 * 1024, 1024, kt * 64, ntl * 64, 64, (bf16_t*)(p->ws + WS_WTOUT) + (size_t)l * 1024 * 1024, 1024, ntl * 64, tile,
                    (kt * 64 + 512) & 1023, kt >= 8 ? p->ssd_norm_g + l * 512 + (kt * 64 - 512) : nullptr); continue; }
        r -= I_OUT;
        if (r < I_G + I_U) { const int up = r >= I_G; if (up) r -= I_G; const int e = r >> 6, q = r & 63, kt = q >> 2, ntl = q & 3; const int n0 = ntl * 64;
            const float* src = (up ? p->w_up : p->w_gate) + (size_t)(l * 16 + e) * 1024 * 256;
            tr_tile(src, 256, kt * 64, n0, 64, (bf16_t*)(p->ws + WS_WTGU) + (size_t)(l * 16 + e) * 512 * 1024, 1024, (n0 >> 7) * 256 + (n0 & 127) + (up ? 128 : 0), tile); continue; }
        r -= I_G + I_U;
        { const int e = r >> 6, q = r & 63, kt = q >> 4, ntl = q & 15;
          tr_tile(p->w_down + (size_t)(l * 16 + e) * 256 * 1024, 1024, kt * 64, ntl * 64, 64, (bf16_t*)(p->ws + WS_WTD) + (size_t)(l * 16 + e) * 1024 * 256, 256, ntl * 64, tile); }
    }
}
__device__ __forceinline__ void phase_adaln(CP p, unsigned char* lds, int bid, int nb) {
    LAS float* sc = (LAS float*)(LAS unsigned char*)lds;
    LAS float* red = sc + 3 * 1024;
    const int tid = launder_tid();
    for (int idx = tid; idx < 3 * 1024; idx += NTHREADS) { const int v = idx >> 10, k = idx & 1023; const float cv = (v < 2) ? p->c[v * 1024 + k] : p->c_ctx[k]; sc[idx] = siluf_(cv); }
    __syncthreads();
    float* mod = (float*)(p->ws + WS_MOD);
    for (int it = bid; it < 2 * 96; it += nb) {
        const int l = it / 96, n0 = (it % 96) * 64;
        const int c4 = tid & 15, kr = tid >> 4;
        f32x4 a0 = {0, 0, 0, 0}, a1 = {0, 0, 0, 0}, a2 = {0, 0, 0, 0};
        const float* w = p->w_ada + (size_t)l * 1024 * 6144 + n0 + c4 * 4;
#pragma unroll 4
        for (int k = kr; k < 1024; k += 32) { const f32x4 w4 = *(const f32x4*)(w + (size_t)k * 6144); a0 += sc[k] * w4; a1 += sc[1024 + k] * w4; a2 += sc[2048 + k] * w4; }
        *(LAS f32x4*)(red + (kr * 3 + 0) * 64 + c4 * 4) = a0; *(LAS f32x4*)(red + (kr * 3 + 1) * 64 + c4 * 4) = a1; *(LAS f32x4*)(red + (kr * 3 + 2) * 64 + c4 * 4) = a2;
        __syncthreads();
        if (tid < 192) { const int v = tid >> 6, cc = tid & 63; float s = 0.f;
            for (int q = 0; q < 32; ++q) s += red[(q * 3 + v) * 64 + cc];
            mod[((size_t)l * 3 + v) * 6144 + n0 + cc] = s + p->b_ada[l * 6144 + n0 + cc]; }
        __syncthreads();
    }
}
__device__ __forceinline__ void moe_table(CP p, int l, LAS int* tab) {
    const int* gcount = (const int*)(p->ws + WS_CTL) + l * 32;
    if (threadIdx.x == 0) { int acc = 0; for (int q = 0; q < NCLS; ++q) { const int cn = gcount[q]; tab[q] = acc; tab[32 + q] = cn; acc += (cn + 255) >> 8; } tab[24] = acc; }
    __syncthreads();
}
typedef _Float16 f16x8 __attribute__((ext_vector_type(8)));
typedef _Float16 f16x2 __attribute__((ext_vector_type(2)));
constexpr int ST_H16 = 2064;
__device__ __forceinline__ unsigned pack_f16(float a, float b) { f16x2 h; h[0] = (_Float16)a; h[1] = (_Float16)b; return __builtin_bit_cast(unsigned, h); }
__device__ __forceinline__ void phase_r1(CP p, int l, unsigned char* lds_, int bid, int nb) {
    LAS unsigned char* lds = (LAS unsigned char*)lds_;
    LAS unsigned char* Wh = lds;
    LAS unsigned char* Xh = Wh + 16 * ST_H16;
    LAS float* gm = (LAS float*)(Xh + 16 * ST_H16);
    LAS float* sh = gm + 3 * 1024;
    LAS float* part = sh + 3 * 1024;
    const int tid = launder_tid(); const int lane = tid & 63, wave = __builtin_amdgcn_readfirstlane(tid >> 6);
    const float* mod = (const float*)(p->ws + WS_MOD) + (size_t)l * 3 * 6144;
    const float* win = p->w_in + (size_t)l * 1024 * DIN;
#pragma unroll
    for (int hb = 0; hb < 2; ++hb) { float tmp[16];
#pragma unroll
        for (int it = 0; it < 16; ++it) { const int idx = tid + NTHREADS * (16 * hb + it); tmp[it] = win[(size_t)(idx >> 4) * DIN + NPROJ + (idx & 15)]; }
#pragma unroll
        for (int it = 0; it < 16; ++it) { const int idx = tid + NTHREADS * (16 * hb + it); *(LAS _Float16*)(Wh + (idx & 15) * ST_H16 + (idx >> 4) * 2) = (_Float16)tmp[it]; } }
    { float t0[6], t1[6], t2[6];
#pragma unroll
      for (int it = 0; it < 6; ++it) { const int idx = tid + NTHREADS * it; const int v = idx >> 10, k = idx & 1023; t0[it] = p->g_mix[l * 1024 + k]; t1[it] = mod[v * 6144 + 1024 + k]; t2[it] = mod[v * 6144 + k]; }
#pragma unroll
      for (int it = 0; it < 6; ++it) { const int idx = tid + NTHREADS * it; gm[idx] = t0[it] * (1.f + t1[it]); sh[idx] = t2[it]; } }
    __syncthreads();
    bf16_t* HX = (bf16_t*)(p->ws + WS_HX); float* DT = (float*)(p->ws + WS_DT);
    const int rpb = (R + nb - 1) / nb, r0 = bid * rpb, r1 = (r0 + rpb) < R ? (r0 + rpb) : R;
    RowRaw xn[2];
#pragma unroll
    for (int q = 0; q < 2; ++q) if (r0 + 2 * wave + q < r1) row_load(p, l, r0 + 2 * wave + q, lane, xn[q]);
#pragma unroll 1
    for (int t0r = r0; t0r < r1; t0r += 16) {
        f32x4 xv[2][4];
#pragma unroll
        for (int q = 0; q < 2; ++q) row_cvt(l, xn[q], xv[q]);
#pragma unroll
        for (int q = 0; q < 2; ++q) if (t0r + 16 + 2 * wave + q < r1) row_load(p, l, t0r + 16 + 2 * wave + q, lane, xn[q]);
#pragma unroll
        for (int q = 0; q < 2; ++q) { const int rr = t0r + 2 * wave + q; const bool ok = rr < r1; const int v = row_v(ok ? rr : r0);
            if (l == 0 && ok) { u32x2* hw = (u32x2*)((bf16_t*)(p->ws + WS_H) + (size_t)rr * D);
#pragma unroll
                for (int j = 0; j < 4; ++j) { u32x2 o; o.x = cvt_pk_bf16(xv[q][j][0], xv[q][j][1]); o.y = cvt_pk_bf16(xv[q][j][2], xv[q][j][3]); hw[lane + 64 * j] = o; } }
            float ss = 0.f;
#pragma unroll
            for (int j = 0; j < 4; ++j) ss += xv[q][j][0] * xv[q][j][0] + xv[q][j][1] * xv[q][j][1] + xv[q][j][2] * xv[q][j][2] + xv[q][j][3] * xv[q][j][3];
            ss = wave_sum(ss); const float rs = ok ? __builtin_amdgcn_rsqf(ss * (1.f / 1024.f) + 1e-6f) : 0.f;
#pragma unroll
            for (int j = 0; j < 4; ++j) { const int k = 4 * lane + 256 * j; const f32x4 g4 = *(const LAS f32x4*)(gm + v * 1024 + k), s4 = *(const LAS f32x4*)(sh + v * 1024 + k);
                f32x4 hv = xv[q][j] * rs * g4 + s4; if (!ok) hv = hv * 0.f;
                u32x2 o; o.x = cvt_pk_bf16(hv[0], hv[1]); o.y = cvt_pk_bf16(hv[2], hv[3]);
                if (ok) *(u32x2*)(HX + (size_t)rr * 1024 + k) = o;
                u32x2 h16; h16.x = pack_f16(hv[0], hv[1]); h16.y = pack_f16(hv[2], hv[3]);
                *(LAS u32x2*)(Xh + (2 * wave + q) * ST_H16 + k * 2) = h16; } }
        __syncthreads();
        {
            f32x4 acc0 = {0.f, 0.f, 0.f, 0.f};
#pragma unroll
            for (int s4 = 0; s4 < 4; ++s4) { const int kb = (128 * wave + 32 * s4 + 8 * (lane >> 4)) * 2;
                const f16x8 a = *(const LAS f16x8*)(Xh + (lane & 15) * ST_H16 + kb);
                const f16x8 b0 = *(const LAS f16x8*)(Wh + (lane & 15) * ST_H16 + kb);
                acc0 = __builtin_amdgcn_mfma_f32_16x16x32_f16(a, b0, acc0, 0, 0, 0); }
#pragma unroll
            for (int e = 0; e < 4; ++e) part[(wave * 16 + 4 * (lane >> 4) + e) * 16 + (lane & 15)] = acc0[e];
        }
        __syncthreads();
        if (tid < 256) { const int row = tid >> 4, n = tid & 15; const int rr = t0r + row;
            float sacc = p->dt_bias[l * 16 + n];
#pragma unroll
            for (int w = 0; w < 8; ++w) sacc += part[(w * 16 + row) * 16 + n];
            if (rr < r1) DT[(size_t)rr * 16 + n] = softplusf_(sacc); }
    }
    __syncthreads();
}
typedef float f32x16 __attribute__((ext_vector_type(16)));
typedef short s16x4 __attribute__((ext_vector_type(4)));
constexpr int ST_ROW = 272;
constexpr int ST_TR128 = 320;
constexpr int ST_TR64 = 192;
constexpr int ST_MT = 328;
constexpr int NCHUNK = SEG / 128;

#define DPP_MOV(v, ctrl, rm, bm) __builtin_bit_cast(float, __builtin_amdgcn_update_dpp(0, __builtin_bit_cast(int, (v)), (ctrl), (rm), (bm), true))
__device__ __forceinline__ float wave_incl_scan(float v, int) {
    float s = v + DPP_MOV(v, 0x111, 0xF, 0xF) + DPP_MOV(v, 0x112, 0xF, 0xF) + DPP_MOV(v, 0x113, 0xF, 0xF);
    s += DPP_MOV(s, 0x114, 0xF, 0xE);
    s += DPP_MOV(s, 0x118, 0xF, 0xC);
    s += DPP_MOV(s, 0x142, 0xA, 0xF);
    s += DPP_MOV(s, 0x143, 0xC, 0xF);
    return s;
}
__device__ __forceinline__ bf16x8 row_frag(const LAS unsigned char* tile, int stride, int row0, int k0, int lane) {
    return *(const LAS bf16x8*)(tile + (row0 + (lane & 31)) * stride + (k0 + 8 * (lane >> 5)) * 2);
}
__device__ __forceinline__ bf16x8 tr_frag(const LAS unsigned char* tile, int stride, int k0, int c0, int lane) {
    const int g = lane >> 4, li = lane & 15, q = li >> 2, pp = li & 3;
    const LAS unsigned char* a0 = tile + (k0 + 8 * (g >> 1) + q) * stride + (c0 + 16 * (g & 1) + 4 * pp) * 2;
    const s16x4 lo = __builtin_amdgcn_ds_read_tr16_b64_v4i16((LAS s16x4*)a0);
    const s16x4 hi = __builtin_amdgcn_ds_read_tr16_b64_v4i16((LAS s16x4*)(a0 + 4 * stride));
    return __builtin_shufflevector(lo, hi, 0, 1, 2, 3, 4, 5, 6, 7);
}
__device__ __forceinline__ u32x4 pack8(const float (&v)[8]) { u32x4 r; r.x = cvt_pk_bf16(v[0], v[1]); r.y = cvt_pk_bf16(v[2], v[3]); r.z = cvt_pk_bf16(v[4], v[5]); r.w = cvt_pk_bf16(v[6], v[7]); return r; }
__device__ __forceinline__ u32x4 pack8s(const float (&v)[8], float sc) { u32x4 r; r.x = cvt_pk_bf16(v[0] * sc, v[1] * sc); r.y = cvt_pk_bf16(v[2] * sc, v[3] * sc); r.z = cvt_pk_bf16(v[4] * sc, v[5] * sc); r.w = cvt_pk_bf16(v[6] * sc, v[7] * sc); return r; }

__device__ __forceinline__ void conv_load(const bf16_t* proj, int row0, int rq, int xch, bool lo_ok, bool hi_ok, u32x4 (&raw)[8]) {
    const bf16_t* base = proj + (size_t)(row0 + 4 * rq) * NPROJ + 1536 + xch;
    const bool okl = (rq > 0) || lo_ok, okh = (rq < 31) || hi_ok;
#pragma unroll
    for (int j = 0; j < 8; ++j) raw[j] = *(const u32x4*)((j < 2 ? okl : (j >= 6 ? okh : true)) ? base + (j - 2) * NPROJ : base);
}
__device__ __forceinline__ void conv_compute(const u32x4 (&raw)[8], const LAS float* wl, int nchl, int wch, float (&o)[4][8], bool zl = false, bool zh = false) {
    float w[5][8], bs[8];
#pragma unroll
    for (int j = 0; j < 5; ++j) { const f32x4 w0 = *(const LAS f32x4*)(wl + j * nchl + wch), w1 = *(const LAS f32x4*)(wl + j * nchl + wch + 4);
        w[j][0] = w0[0]; w[j][1] = w0[1]; w[j][2] = w0[2]; w[j][3] = w0[3]; w[j][4] = w1[0]; w[j][5] = w1[1]; w[j][6] = w1[2]; w[j][7] = w1[3]; }
    { const f32x4 b0 = *(const LAS f32x4*)(wl + 5 * nchl + wch), b1 = *(const LAS f32x4*)(wl + 5 * nchl + wch + 4); bs[0] = b0[0]; bs[1] = b0[1]; bs[2] = b0[2]; bs[3] = b0[3]; bs[4] = b1[0]; bs[5] = b1[1]; bs[6] = b1[2]; bs[7] = b1[3]; }
#pragma unroll
    for (int i = 0; i < 4; ++i)
#pragma unroll
        for (int e = 0; e < 8; ++e) o[i][e] = bs[e];
    const float fl = zl ? 0.f : 1.f, fh = zh ? 0.f : 1.f;
#pragma unroll
    for (int j = 0; j < 8; ++j) {
        float xv[8] = {bflo(raw[j].x), bfhi(raw[j].x), bflo(raw[j].y), bfhi(raw[j].y), bflo(raw[j].z), bfhi(raw[j].z), bflo(raw[j].w), bfhi(raw[j].w)};
        if (j < 2) {
#pragma unroll
            for (int e = 0; e < 8; ++e) xv[e] *= fl; }
        if (j >= 6) {
#pragma unroll
            for (int e = 0; e < 8; ++e) xv[e] *= fh; }
#pragma unroll
        for (int i = 0; i < 4; ++i) { const int tap = j - i; if (tap >= 0 && tap < 5) {
#pragma unroll
                for (int e = 0; e < 8; ++e) o[i][e] += w[tap][e] * xv[e]; } }
    }
#pragma unroll
    for (int i = 0; i < 4; ++i)
#pragma unroll
        for (int e = 0; e < 8; ++e) o[i][e] = siluf_(o[i][e]);
}
__device__ __forceinline__ void conv_load4(const bf16_t* proj, int row0, int rq, int xch, bool lo_ok, bool hi_ok, u32x2 (&raw)[8]) {
    const bf16_t* base = proj + (size_t)(row0 + 4 * rq) * NPROJ + 1536 + xch;
    const bool okl = (rq > 0) || lo_ok, okh = (rq < 31) || hi_ok;
#pragma unroll
    for (int j = 0; j < 8; ++j) raw[j] = *(const u32x2*)((j < 2 ? okl : (j >= 6 ? okh : true)) ? base + (j - 2) * NPROJ : base);
}
__device__ __forceinline__ void conv_compute4(const u32x2 (&raw)[8], const LAS float* wl, int nchl, int wch, float (&o)[4][4], bool zl, bool zh) {
    f32x4 w[5];
#pragma unroll
    for (int j = 0; j < 5; ++j) w[j] = *(const LAS f32x4*)(wl + j * nchl + wch);
    const f32x4 bs = *(const LAS f32x4*)(wl + 5 * nchl + wch);
#pragma unroll
    for (int i = 0; i < 4; ++i)
#pragma unroll
        for (int e = 0; e < 4; ++e) o[i][e] = bs[e];
    const float fl = zl ? 0.f : 1.f, fh = zh ? 0.f : 1.f;
#pragma unroll
    for (int j = 0; j < 8; ++j) {
        float xv[4] = {bflo(raw[j].x), bfhi(raw[j].x), bflo(raw[j].y), bfhi(raw[j].y)};
        if (j < 2) {
#pragma unroll
            for (int e = 0; e < 4; ++e) xv[e] *= fl; }
        if (j >= 6) {
#pragma unroll
            for (int e = 0; e < 4; ++e) xv[e] *= fh; }
#pragma unroll
        for (int i = 0; i < 4; ++i) { const int tap = j - i; if (tap >= 0 && tap < 5) {
#pragma unroll
                for (int e = 0; e < 4; ++e) o[i][e] += w[tap][e] * xv[e]; } }
    }
#pragma unroll
    for (int i = 0; i < 4; ++i)
#pragma unroll
        for (int e = 0; e < 4; ++e) o[i][e] = siluf_(o[i][e]);
}
__device__ __forceinline__ void head_cums(CP p, int l, int row0, int h, int dir, int lane, LAS float* hv, const LAS float* atab) {
    const float A = atab[dir * 8 + h];
    const float* DT = (const float*)(p->ws + WS_DT);
    const float d0 = DT[(size_t)(row0 + 2 * lane) * 16 + dir * 8 + h], d1 = DT[(size_t)(row0 + 2 * lane + 1) * 16 + dir * 8 + h];
    const float x0 = d0 * A, x1 = d1 * A;
    const float incl = wave_incl_scan(x0 + x1, lane);
    const float total = __builtin_bit_cast(float, __builtin_amdgcn_readlane(__builtin_bit_cast(int, incl), 63));
    float c0, c1;
    if (dir == 0) { c1 = incl; c0 = incl - x1; } else { c0 = total - (incl - x1 - x0); c1 = total - (incl - x1); }
    hv[dir * 128 + 2 * lane] = c0; hv[dir * 128 + 2 * lane + 1] = c1;
    hv[256 + dir * 128 + 2 * lane] = d0; hv[256 + dir * 128 + 2 * lane + 1] = d1;
    if (lane == 0) hv[512 + dir] = total;
}
__device__ __forceinline__ bf16x8 scale_frag(bf16x8 f, const f32x4 w0, const f32x4 w1) {
    const u32x4 u = __builtin_bit_cast(u32x4, f);
    u32x4 r;
    r.x = cvt_pk_bf16(bflo(u.x) * w0[0], bfhi(u.x) * w0[1]); r.y = cvt_pk_bf16(bflo(u.y) * w0[2], bfhi(u.y) * w0[3]);
    r.z = cvt_pk_bf16(bflo(u.z) * w1[0], bfhi(u.z) * w1[1]); r.w = cvt_pk_bf16(bflo(u.w) * w1[2], bfhi(u.w) * w1[3]);
    return __builtin_bit_cast(bf16x8, r);
}
constexpr int ST_X256 = 576;

__device__ __forceinline__ void phase_c1(CP p, int l, unsigned char* lds_, int bid, int nb) {
    LAS unsigned char* lds = (LAS unsigned char*)lds_;
    LAS unsigned char* tile = lds;
    LAS float* wl = (LAS float*)(lds + 73216);
    const int tid = launder_tid();
    const bf16_t* proj = (const bf16_t*)(p->ws + WS_PROJ); bf16_t* mix = (bf16_t*)(p->ws + WS_HX);
    const int NU = 256 + 512 + (l == DEPTH - 1 ? 0 : 16);
    const int heavy = (nb > 64 && (NB * NCHUNK * 2) % nb < nb / 4) ? (NB * NCHUNK * 2) % nb : 0;
    const int ustart = bid < heavy ? NU : (bid - heavy), ustep = nb - heavy;
#pragma unroll 1
    for (int u = ustart; u < NU; u += ustep) {
        int S, LEN, LSH, pstride, sstride, tok0, ch0;
        if (u < 256) { const int b = u >> 7, cs = (u >> 2) & 31, cc = u & 3; S = 2; LEN = 256; LSH = 8; pstride = 64; sstride = 1; tok0 = b * SEG + CTXL + 2 * cs; ch0 = 256 + 64 * cc; }
        else if (u < 768) { const int v = u - 256; const int b = v >> 8, rg = (v >> 2) & 63, cc = v & 3; S = 4; LEN = 64; LSH = 6; pstride = 1; sstride = 64; tok0 = b * SEG + CTXL + 256 * rg; ch0 = 64 * cc; }
        else { const int v = u - 768; const int b = v >> 3, cc = v & 7; S = 1; LEN = 256; LSH = 8; pstride = 1; sstride = 0; tok0 = b * SEG; ch0 = 64 * cc; }
        const int LP = LEN + 30;
        { float tw[4];
#pragma unroll
          for (int it = 0; it < 4; ++it) { const int i = tid + NTHREADS * it; const int j = i >> 6, c = i & 63; tw[it] = j < 31 ? p->conv_w[((size_t)l * 31 + j) * 512 + ch0 + c] : p->conv_b[l * 512 + ch0 + c]; }
#pragma unroll
          for (int it = 0; it < 4; ++it) wl[tid + NTHREADS * it] = tw[it]; }
        for (int i = tid; i < S * 30 * 8; i += NTHREADS) { const int pc = i & 7, q = (i >> 3) % 30, sq = (i >> 3) / 30; const int pos = q < 15 ? q : LEN + q;
            unsigned zz; asm volatile("v_mov_b32 %0, 0" : "=v"(zz));
            *(LAS u32x4*)(tile + ((sq * LP + pos) * 64 + pc * 8) * 2) = (u32x4){zz, zz, zz, zz}; }
        for (int ib = 0; ib < S * LEN * 8; ib += 4 * NTHREADS) {
            u32x4 uv[4];
#pragma unroll
            for (int q = 0; q < 4; ++q) { const int i = ib + tid + NTHREADS * q; const int pc = i & 7, t = i >> 3; const int sq = t >> LSH, pos = t & (LEN - 1);
                const bf16_t* src = proj + (size_t)(tok0 + sq * sstride + pos * pstride) * NPROJ + ch0 + pc * 8;
                uv[q] = __builtin_nontemporal_load((const u32x4*)src); }
#pragma unroll
            for (int q = 0; q < 4; ++q) { const int i = ib + tid + NTHREADS * q; const int pc = i & 7, t = i >> 3; const int sq = t >> LSH, pos = t & (LEN - 1);
                const u32x4 o = uv[q];
                *(LAS u32x4*)(tile + ((sq * LP + 15 + pos) * 64 + pc * 8) * 2) = o; }
        }
        __syncthreads();
        const int noct = S * LEN / 8;
#pragma unroll 1
        for (int it = tid; it < noct * 32; it += NTHREADS) {
            const int cp = it & 31, oc = it >> 5; const int sq = oc >> (LSH - 3), p0 = (oc & ((LEN >> 3) - 1)) * 8;
            const LAS unsigned* base = (const LAS unsigned*)(tile + ((sq * LP + p0) * 64) * 2) + cp;
            float i0[38], i1[38];
#pragma unroll
            for (int k = 0; k < 38; ++k) { const unsigned w = base[k * 32]; i0[k] = bflo(w); i1[k] = bfhi(w); }
            float a0[8], a1[8];
            { const float b0 = wl[31 * 64 + 2 * cp], b1 = wl[31 * 64 + 2 * cp + 1];
#pragma unroll
              for (int i = 0; i < 8; ++i) { a0[i] = b0; a1[i] = b1; } }
#pragma unroll
            for (int j = 0; j < 31; ++j) { typedef float f32x2 __attribute__((ext_vector_type(2))); const f32x2 wj = *(const LAS f32x2*)(wl + j * 64 + 2 * cp); const float w0 = wj[0], w1 = wj[1];
#pragma unroll
                for (int i = 0; i < 8; ++i) { a0[i] += w0 * i0[i + j]; a1[i] += w1 * i1[i + j]; } }
#pragma unroll
            for (int i = 0; i < 8; ++i) { const int tok = tok0 + sq * sstride + (p0 + i) * pstride;
                *(unsigned*)(mix + (size_t)tok * 1024 + 512 + ch0 + 2 * cp) = cvt_pk_bf16(a0[i], a1[i]); }
        }
        __syncthreads();
    }
}
__device__ __forceinline__ void phase_c1_ln(CP p, int l, int bid, int nb) {
    const int tid = launder_tid(); const int lane = tid & 63, wave = tid >> 6;
    bf16_t* mix = (bf16_t*)(p->ws + WS_HX);
    const f32x4 g0 = *(const f32x4*)(p->conv_ln_g + l * 512 + lane * 8), g1 = *(const f32x4*)(p->conv_ln_g + l * 512 + lane * 8 + 4);
    const f32x4 b0 = *(const f32x4*)(p->conv_ln_b + l * 512 + lane * 8), b1 = *(const f32x4*)(p->conv_ln_b + l * 512 + lane * 8 + 4);
    const float gg[8] = {g0[0], g0[1], g0[2], g0[3], g1[0], g1[1], g1[2], g1[3]}, bb[8] = {b0[0], b0[1], b0[2], b0[3], b1[0], b1[1], b1[2], b1[3]};
    u32x4 vn = {0u, 0u, 0u, 0u};
    if (bid * 8 + wave < R) vn = *(const u32x4*)(mix + (size_t)(bid * 8 + wave) * 1024 + 512 + lane * 8);
    for (int r = bid * 8 + wave; r < R; r += nb * 8) {
        u32x4* ptr = (u32x4*)(mix + (size_t)r * 1024 + 512 + lane * 8);
        const u32x4 v = vn;
        if (r + nb * 8 < R) vn = *(const u32x4*)(mix + (size_t)(r + nb * 8) * 1024 + 512 + lane * 8);
        float y[8] = {bflo(v.x), bfhi(v.x), bflo(v.y), bfhi(v.y), bflo(v.z), bfhi(v.z), bflo(v.w), bfhi(v.w)};
        float s = 0.f;
#pragma unroll
        for (int e = 0; e < 8; ++e) s += y[e];
        const float mu = wave_sum(s) * (1.f / 512.f);
        float q = 0.f;
#pragma unroll
        for (int e = 0; e < 8; ++e) { y[e] -= mu; q += y[e] * y[e]; }
        const float rstd = rsqrtf(wave_sum(q) * (1.f / 512.f) + 1e-5f);
        float o[8];
#pragma unroll
        for (int e = 0; e < 8; ++e) o[e] = siluf_(y[e] * rstd * gg[e] + bb[e]);
        *ptr = pack8(o);
    }
}
__device__ __forceinline__ void phase_s1(CP p, int l, unsigned char* lds_, int bid, int nb) {
    LAS unsigned char* lds = (LAS unsigned char*)lds_;
    LAS unsigned char* Bs = lds;
    LAS unsigned char* Xs = lds + 128 * ST_TR128;
    LAS float* wv = (LAS float*)(Xs + 128 * ST_X256);
    LAS float* hvs = wv + 8 * 128;
    LAS float* cwl = hvs + 4 * 520;
    LAS float* atab = cwl + 6 * 384;
    const int tid = launder_tid(); const int lane = tid & 63, wave = __builtin_amdgcn_readfirstlane(tid >> 6);
    const bf16_t* proj = (const bf16_t*)(p->ws + WS_PROJ);
    const float* cw = p->ssd_conv_w + (size_t)l * 5 * 1024; const float* cbias = p->ssd_conv_b + (size_t)l * 1024;
    bf16_t* Sg = (bf16_t*)(p->ws + WS_S); float* DEC = (float*)(p->ws + WS_DEC);
    if (tid < 16) atab[tid] = -expf(p->a_log[l * 16 + tid]);
    __syncthreads();
    int cur_g = -1;
#pragma unroll 1
    for (int u = bid; u < NB * NCHUNK * 2; u += nb) {
        const int g = u & 1, c = (u >> 1) % NCHUNK, b = (u >> 1) / NCHUNK;
        const int row0 = b * SEG + c * 128;
        const bool lo_ok = !(c == 0 || c == 2), hi_ok = !(c == 1 || c == NCHUNK - 1);
        if (g != cur_g) { cur_g = g;
            float tw[5];
#pragma unroll
            for (int it = 0; it < 5; ++it) { const int i = tid + NTHREADS * it; const int j = i / 384, lc = i - j * 384; const int gch = lc < 128 ? 512 + g * 128 + lc : g * 256 + (lc - 128);
                tw[it] = i < 6 * 384 ? (j < 5 ? cw[j * 1024 + gch] : cbias[gch]) : 0.f; }
#pragma unroll
            for (int it = 0; it < 5; ++it) { const int i = tid + NTHREADS * it; if (i < 6 * 384) cwl[i] = tw[it]; } }
        const int hh = wave >> 1, dir = wave & 1, h = 4 * g + hh;
        u32x4 rb[8], rx0[8], rx1[8];
        conv_load(proj, row0, tid >> 4, 512 + g * 128 + (tid & 15) * 8, lo_ok, hi_ok, rb);
        conv_load(proj, row0, tid >> 5, g * 256 + (tid & 31) * 8, lo_ok, hi_ok, rx0);
        conv_load(proj, row0, (tid >> 5) + 16, g * 256 + (tid & 31) * 8, lo_ok, hi_ok, rx1);
        head_cums(p, l, row0, h, dir, lane, hvs + hh * 520, atab);
        __syncthreads();
        {
            const LAS float* hv = hvs + hh * 520; const float tot = hv[512 + dir];
#pragma unroll
            for (int q = 0; q < 2; ++q) { const int lr = lane + 64 * q; wv[wave * 128 + lr] = __expf(tot - hv[dir * 128 + lr]) * hv[256 + dir * 128 + lr]; }
            if (lane == 0) DEC[((size_t)(b * 2 + dir) * NCHUNK + c) * 8 + h] = __expf(tot);
        }
        { float o[4][8];
          conv_compute(rb, cwl, 384, (tid & 15) * 8, o, (tid >> 4) == 0 && !lo_ok, (tid >> 4) == 31 && !hi_ok);
#pragma unroll
          for (int i = 0; i < 4; ++i) *(LAS u32x4*)(Bs + (4 * (tid >> 4) + i) * ST_TR128 + (tid & 15) * 16) = pack8(o[i]);
          conv_compute(rx0, cwl, 384, 128 + (tid & 31) * 8, o, (tid >> 5) == 0 && !lo_ok, false);
#pragma unroll
          for (int i = 0; i < 4; ++i) *(LAS u32x4*)(Xs + (4 * (tid >> 5) + i) * ST_X256 + (tid & 31) * 16) = pack8(o[i]);
          conv_compute(rx1, cwl, 384, 128 + (tid & 31) * 8, o, false, (tid >> 5) == 15 && !hi_ok);
#pragma unroll
          for (int i = 0; i < 4; ++i) *(LAS u32x4*)(Xs + (4 * ((tid >> 5) + 16) + i) * ST_X256 + (tid & 31) * 16) = pack8(o[i]); }
        __syncthreads();
        {
            f32x16 acc[2][4];
#pragma unroll
            for (int t = 0; t < 2; ++t)
#pragma unroll
                for (int q = 0; q < 4; ++q)
#pragma unroll
                    for (int e = 0; e < 16; ++e) acc[t][q][e] = 0.f;
            {
                bf16x8 ar[2][2], br[2][4];
#pragma unroll
                for (int t = 0; t < 2; ++t) ar[0][t] = tr_frag(Xs, ST_X256, 0, hh * 64 + 32 * t, lane);
#pragma unroll
                for (int q = 0; q < 4; ++q) br[0][q] = tr_frag(Bs, ST_TR128, 0, 32 * q, lane);
#pragma unroll 2
                for (int kk = 0; kk < 8; ++kk) { const int c_ = kk & 1, n_ = c_ ^ 1;
                    const LAS float* wp = wv + wave * 128 + 16 * kk + 8 * (lane >> 5);
                    const f32x4 w0 = *(const LAS f32x4*)wp, w1 = *(const LAS f32x4*)(wp + 4);
                    if (kk < 7) {
#pragma unroll
                        for (int t = 0; t < 2; ++t) ar[n_][t] = tr_frag(Xs, ST_X256, 16 * (kk + 1), hh * 64 + 32 * t, lane);
#pragma unroll
                        for (int q = 0; q < 4; ++q) br[n_][q] = tr_frag(Bs, ST_TR128, 16 * (kk + 1), 32 * q, lane); }
                    bf16x8 af[2];
#pragma unroll
                    for (int t = 0; t < 2; ++t) af[t] = scale_frag(ar[c_][t], w0, w1);
#pragma unroll
                    for (int q = 0; q < 4; ++q)
#pragma unroll
                        for (int t = 0; t < 2; ++t) acc[t][q] = __builtin_amdgcn_mfma_f32_32x32x16_bf16(br[c_][q], af[t], acc[t][q], 0, 0, 0);
                }
            }
            bf16_t* So = Sg + ((size_t)((b * 2 + dir) * NCHUNK + c) * 8 + h) * 8192 + (size_t)lane * 8;
#pragma unroll
            for (int t = 0; t < 2; ++t)
#pragma unroll
                for (int q = 0; q < 4; ++q)
#pragma unroll
                    for (int j = 0; j < 2; ++j) { u32x4 pk; pk.x = cvt_pk_bf16(acc[t][q][8 * j], acc[t][q][8 * j + 1]); pk.y = cvt_pk_bf16(acc[t][q][8 * j + 2], acc[t][q][8 * j + 3]);
                        pk.z = cvt_pk_bf16(acc[t][q][8 * j + 4], acc[t][q][8 * j + 5]); pk.w = cvt_pk_bf16(acc[t][q][8 * j + 6], acc[t][q][8 * j + 7]);
                        *(u32x4*)(So + ((t * 4 + q) * 2 + j) * 512) = pk; }
        }
        __syncthreads();
    }
}
__device__ __forceinline__ void phase_s2(CP p, int bid, int nb) {
    const int tid = launder_tid();
    const bf16_t* Sg = (const bf16_t*)(p->ws + WS_S); const float* DEC = (const float*)(p->ws + WS_DEC); bf16_t* HP = (bf16_t*)(p->ws + WS_HP);
    for (int idx = bid * NTHREADS + tid; idx < 2 * 2 * 8 * 64 * 64; idx += nb * NTHREADS) {
        const int n2 = idx & 63, pr = (idx >> 6) & 63, h = (idx >> 12) & 7, dir = (idx >> 15) & 1, b = idx >> 16;
        const size_t inner = (size_t)h * 8192 + pr * 128 + 2 * n2;
        const size_t cbase = (size_t)(b * 2 + dir) * NCHUNK;
        float s0 = 0.f, s1 = 0.f;
#pragma unroll 26
        for (int step = 0; step < NCHUNK; ++step) {
            const int c = dir == 0 ? step : (step < 2 ? 1 - step : NCHUNK + 1 - step);
            const size_t off = (cbase + c) * 65536 + inner;
            const unsigned sv = __builtin_nontemporal_load((const unsigned*)(Sg + off)); const float d = DEC[(cbase + c) * 8 + h];
            *(unsigned*)(HP + off) = cvt_pk_bf16(s0, s1);
            s0 = s0 * d + bflo(sv); s1 = s1 * d + bfhi(sv);
        }
    }
}
__device__ __forceinline__ void phase_s3(CP p, int l, unsigned char* lds_, int bid, int nb) {
    LAS unsigned char* lds = (LAS unsigned char*)lds_;
    LAS unsigned char* Cs = lds;
    LAS unsigned char* Bs = Cs + 128 * ST_ROW;
    LAS unsigned char* Mt = Bs;
    LAS unsigned char* Xs = Bs + 128 * ST_MT;
    LAS unsigned char* Hf = Xs + 128 * ST_TR64;
    LAS unsigned char* Hb = Hf + 64 * ST_ROW;
    LAS float* hvs = (LAS float*)(Hb + 64 * ST_ROW);
    LAS float* ssqp = hvs + 4 * 776;
    LAS float* cwl = ssqp + 256;
    LAS float* atab = cwl + 6 * 512;
    const int tid0 = launder_tid(); const int wave = __builtin_amdgcn_readfirstlane(tid0 >> 6);
    const bf16_t* proj = (const bf16_t*)(p->ws + WS_PROJ); bf16_t* mix = (bf16_t*)(p->ws + WS_HX);
    const float* cw = p->ssd_conv_w + (size_t)l * 5 * 1024; const float* cbias = p->ssd_conv_b + (size_t)l * 1024;
    const bf16_t* HP = (const bf16_t*)(p->ws + WS_HP); float* SSQ = (float*)(p->ws + WS_SSQ);
    if (tid0 < 16) atab[tid0] = -expf(p->a_log[l * 16 + tid0]); else if (tid0 < 24) atab[tid0] = p->d_skip[l * 8 + tid0 - 16];
    __syncthreads();
    int cur_g = -1;
    const int cskip = (l == DEPTH - 1) ? 2 : 0, cpb = NCHUNK - cskip;
    const int nunits = NB * cpb * 2, nfull = nunits - nunits % nb, nitems = nfull + (nunits - nfull) * 4;
#pragma unroll 1
    for (int it = bid; it < nitems; it += nb) {
        const int u = it < nfull ? it : nfull + ((it - nfull) >> 2);
        const int hh_lo = it < nfull ? 0 : ((it - nfull) & 3), hh_hi = it < nfull ? 4 : hh_lo + 1;
        const int g = u & 1, c = cskip + (u >> 1) % cpb, b = (u >> 1) / cpb;
        int tid = tid0; asm volatile("" : "+v"(tid));
        const int lane = tid & 63;
        const int row0 = b * SEG + c * 128;
        const bool lo_ok = !(c == 0 || c == 2), hi_ok = !(c == 1 || c == NCHUNK - 1);
        if (g != cur_g) { cur_g = g;
            float tw[6];
#pragma unroll
            for (int it = 0; it < 6; ++it) { const int i = tid + NTHREADS * it; const int j = i >> 9, lc = i & 511; const int gch = lc < 128 ? 768 + g * 128 + lc : (lc < 256 ? 512 + g * 128 + (lc - 128) : g * 256 + (lc - 256));
                tw[it] = j < 5 ? cw[j * 1024 + gch] : cbias[gch]; }
#pragma unroll
            for (int it = 0; it < 6; ++it) cwl[tid + NTHREADS * it] = tw[it]; }
        u32x2 rx[8];
        {
            u32x4 r0[8], r1[8];
            const int cg = tid & 31; const int gch = (cg < 16 ? 768 : 512) + g * 128 + (cg & 15) * 8;
            conv_load(proj, row0, tid >> 5, gch, lo_ok, hi_ok, r0);
            conv_load(proj, row0, (tid >> 5) + 16, gch, lo_ok, hi_ok, r1);
            head_cums(p, l, row0, 4 * g + (wave >> 1), wave & 1, lane, hvs + (wave >> 1) * 776, atab);
            { LAS float* hvw = hvs + (wave >> 1) * 776; const int dr = wave & 1;
              hvw[520 + dr * 128 + 2 * lane] = __expf(hvw[dr * 128 + 2 * lane]); hvw[520 + dr * 128 + 2 * lane + 1] = __expf(hvw[dr * 128 + 2 * lane + 1]); }
            __syncthreads();
            float o[4][8];
            LAS unsigned char* dst = (cg < 16 ? Cs : Bs) + (cg & 15) * 16;
            conv_compute(r0, cwl, 512, cg * 8, o, (tid >> 5) == 0 && !lo_ok, false);
#pragma unroll
            for (int i = 0; i < 4; ++i) *(LAS u32x4*)(dst + (4 * (tid >> 5) + i) * ST_ROW) = pack8(o[i]);
            asm volatile("" ::: "memory");
            conv_load4(proj, row0, tid >> 4, g * 256 + hh_lo * 64 + (tid & 15) * 4, lo_ok, hi_ok, rx);
            conv_compute(r1, cwl, 512, cg * 8, o, false, (tid >> 5) == 15 && !hi_ok);
#pragma unroll
            for (int i = 0; i < 4; ++i) *(LAS u32x4*)(dst + (4 * ((tid >> 5) + 16) + i) * ST_ROW) = pack8(o[i]);
            { float o4[4][4]; conv_compute4(rx, cwl, 512, 256 + hh_lo * 64 + (tid & 15) * 4, o4, (tid >> 4) == 0 && !lo_ok, (tid >> 4) == 31 && !hi_ok);
#pragma unroll
              for (int i = 0; i < 4; ++i) { u32x2 pk; pk.x = cvt_pk_bf16(o4[i][0], o4[i][1]); pk.y = cvt_pk_bf16(o4[i][2], o4[i][3]); *(LAS u32x2*)(Xs + (4 * (tid >> 4) + i) * ST_TR64 + (tid & 15) * 8) = pk; } }
        }
        __syncthreads();
        const int lb = wave >> 1, hs = wave & 1;
        int ln = lane; asm volatile("" : "+v"(ln));
        f32x16 gacc[2];
#pragma unroll
        for (int t = 0; t < 2; ++t)
#pragma unroll
            for (int e = 0; e < 16; ++e) gacc[t][e] = 0.f;
#pragma unroll
        for (int kk = 0; kk < 8; ++kk) { const bf16x8 af = row_frag(Cs, ST_ROW, 32 * lb, 16 * kk, lane);
#pragma unroll
            for (int t = 0; t < 2; ++t) { const bf16x8 bf = row_frag(Bs, ST_ROW, 64 * hs + 32 * t, 16 * kk, lane);
                gacc[t] = __builtin_amdgcn_mfma_f32_32x32x16_bf16(af, bf, gacc[t], 0, 0, 0); } }
        u32x4 hreg[4];
        { const bf16_t* hp0 = HP + ((size_t)(b * 2 * NCHUNK + c) * 8 + 4 * g + hh_lo) * 8192;
#pragma unroll
          for (int q = 0; q < 4; ++q) { const int it = tid + 512 * q; hreg[q] = __builtin_nontemporal_load((const u32x4*)(hp0 + (size_t)(it >> 10) * NCHUNK * 8 * 8192 + (it & 1023) * 8)); } }
        __syncthreads();
#pragma unroll 1
        for (int hh = hh_lo; hh < hh_hi; ++hh) {
            const int h = 4 * g + hh; const LAS float* hv = hvs + hh * 776;
            asm volatile("" : "+v"(ln));
            const int ph = hs;
            const int lrw = 32 * lb + (ln & 31), pq = 32 * ph + 4 * (ln >> 5);
            u32x2 zraw[4];
#pragma unroll
            for (int rg = 0; rg < 4; ++rg) zraw[rg] = *(const u32x2*)(proj + (size_t)(row0 + lrw) * NPROJ + 1024 + h * 64 + pq + 8 * rg);
#pragma unroll
            for (int t = 0; t < 2; ++t) {
                const int st = 2 * hs + t;
                const int sc = 32 * st + (ln & 31);
                const float cfs = hv[sc], cbs = hv[128 + sc], dfs = hv[256 + sc], dbs = hv[384 + sc];
#pragma unroll
                for (int rg = 0; rg < 4; ++rg) {
                    const int l0 = 32 * lb + 8 * rg + 4 * (ln >> 5);
                    float m[4];
                    if (st < lb) {
                        const f32x4 cfl = *(const LAS f32x4*)(hv + l0);
#pragma unroll
                        for (int e = 0; e < 4; ++e) m[e] = gacc[t][4 * rg + e] * (__expf(cfl[e] - cfs) * dfs);
                    } else if (st > lb) {
                        const f32x4 cbl = *(const LAS f32x4*)(hv + 128 + l0);
#pragma unroll
                        for (int e = 0; e < 4; ++e) m[e] = gacc[t][4 * rg + e] * (__expf(cbl[e] - cbs) * dbs);
                    } else {
                        const f32x4 cfl = *(const LAS f32x4*)(hv + l0), cbl = *(const LAS f32x4*)(hv + 128 + l0);
#pragma unroll
                        for (int e = 0; e < 4; ++e) { const int lr = l0 + e;
                            const float ff = lr >= sc ? __expf(cfl[e] - cfs) * dfs : 0.f;
                            const float fb = lr <= sc ? __expf(cbl[e] - cbs) * dbs : 0.f;
                            m[e] = gacc[t][4 * rg + e] * (ff + fb); }
                    }
                    u32x2 pk; pk.x = cvt_pk_bf16(m[0], m[1]); pk.y = cvt_pk_bf16(m[2], m[3]);
                    *(LAS u32x2*)(Mt + sc * ST_MT + l0 * 2) = pk;
                }
            }
#pragma unroll
            for (int q = 0; q < 4; ++q) { const int it = tid + 512 * q; const int q2 = it & 1023;
                LAS unsigned char* dst = ((it >> 10) ? Hb : Hf) + (32 * (q2 >> 9) + (q2 & 31)) * ST_ROW + (32 * ((q2 >> 7) & 3) + 16 * ((q2 >> 6) & 1) + 4 * ((q2 >> 5) & 1)) * 2;
                *(LAS u32x2*)dst = (u32x2){hreg[q].x, hreg[q].y}; *(LAS u32x2*)(dst + 16) = (u32x2){hreg[q].z, hreg[q].w}; }
            if (hh + 1 < hh_hi) {
                const bf16_t* hp0 = HP + ((size_t)(b * 2 * NCHUNK + c) * 8 + h + 1) * 8192;
#pragma unroll
                for (int q = 0; q < 4; ++q) { const int it = tid + 512 * q; hreg[q] = __builtin_nontemporal_load((const u32x4*)(hp0 + (size_t)(it >> 10) * NCHUNK * 8 * 8192 + (it & 1023) * 8)); }
                conv_load4(proj, row0, tid >> 4, g * 256 + (hh + 1) * 64 + (tid & 15) * 4, lo_ok, hi_ok, rx);
            }
            __syncthreads();
            f32x16 ad, af_, ab_;
#pragma unroll
            for (int e = 0; e < 16; ++e) { ad[e] = 0.f; af_[e] = 0.f; ab_[e] = 0.f; }
            {
                bf16x8 am[2], bx[2], ac[2], bhf[2], bhb[2];
                am[0] = tr_frag(Mt, ST_MT, 0, 32 * lb, lane); bx[0] = tr_frag(Xs, ST_TR64, 0, 32 * ph, lane);
                ac[0] = row_frag(Cs, ST_ROW, 32 * lb, 0, lane); bhf[0] = row_frag(Hf, ST_ROW, 32 * ph, 0, lane); bhb[0] = row_frag(Hb, ST_ROW, 32 * ph, 0, lane);
#pragma unroll
                for (int kk = 0; kk < 8; ++kk) { const int c = kk & 1, n = c ^ 1;
                    if (kk < 7) { am[n] = tr_frag(Mt, ST_MT, 16 * (kk + 1), 32 * lb, lane); bx[n] = tr_frag(Xs, ST_TR64, 16 * (kk + 1), 32 * ph, lane);
                        ac[n] = row_frag(Cs, ST_ROW, 32 * lb, 16 * (kk + 1), lane); bhf[n] = row_frag(Hf, ST_ROW, 32 * ph, 16 * (kk + 1), lane); bhb[n] = row_frag(Hb, ST_ROW, 32 * ph, 16 * (kk + 1), lane); }
                    ad = __builtin_amdgcn_mfma_f32_32x32x16_bf16(bx[c], am[c], ad, 0, 0, 0);
                    af_ = __builtin_amdgcn_mfma_f32_32x32x16_bf16(bhf[c], ac[c], af_, 0, 0, 0);
                    ab_ = __builtin_amdgcn_mfma_f32_32x32x16_bf16(bhb[c], ac[c], ab_, 0, 0, 0); }
            }
            const float dsk = atab[16 + h];
            { const float ef = hv[520 + lrw], eb = hv[648 + lrw];
              float sq = 0.f;
#pragma unroll
              for (int rg = 0; rg < 4; ++rg) {
                const u32x2 xr = *(const LAS u32x2*)(Xs + lrw * ST_TR64 + (pq + 8 * rg) * 2);
                const float xs[4] = {bflo(xr.x), bfhi(xr.x), bflo(xr.y), bfhi(xr.y)};
                const float zz[4] = {bflo(zraw[rg].x), bfhi(zraw[rg].x), bflo(zraw[rg].y), bfhi(zraw[rg].y)};
                float v[4];
#pragma unroll
                for (int e = 0; e < 4; ++e) { const int ri = 4 * rg + e;
                    const float y = ad[ri] + ef * af_[ri] + eb * ab_[ri] + dsk * xs[e];
                    v[e] = y * zz[e];
                    sq += v[e] * v[e]; }
                u32x2 pk; pk.x = cvt_pk_bf16(v[0], v[1]); pk.y = cvt_pk_bf16(v[2], v[3]);
                *(u32x2*)(mix + (size_t)(row0 + lrw) * 1024 + h * 64 + pq + 8 * rg) = pk;
              }
              sq += __shfl_xor(sq, 32);
              if (ln < 32) ssqp[ph * 128 + lrw] = sq; }
            __syncthreads();
            if (tid < 128) SSQ[(size_t)(row0 + tid) * 8 + h] = ssqp[tid] + ssqp[128 + tid];
            if (hh + 1 < hh_hi) { float o4[4][4];
                conv_compute4(rx, cwl, 512, 256 + (hh + 1) * 64 + (tid & 15) * 4, o4, (tid >> 4) == 0 && !lo_ok, (tid >> 4) == 31 && !hi_ok);
#pragma unroll
                for (int i = 0; i < 4; ++i) { u32x2 pk; pk.x = cvt_pk_bf16(o4[i][0], o4[i][1]); pk.y = cvt_pk_bf16(o4[i][2], o4[i][3]); *(LAS u32x2*)(Xs + (4 * (tid >> 4) + i) * ST_TR64 + (tid & 15) * 8) = pk; } }
        }
        __syncthreads();
    }
}
__device__ __forceinline__ void phase_r2(CP p, int l, unsigned char* lds_, int bid, int nb) {
    LAS unsigned char* lds = (LAS unsigned char*)lds_;
    LAS unsigned char* Wh = lds;
    LAS unsigned char* Xh = Wh + 32 * ST_H16;
    LAS float* gm = (LAS float*)(Xh + 16 * ST_H16);
    LAS float* sh = gm + 3 * 1024;
    LAS float* part = sh + 3 * 1024;
    LAS float* lgs = part + 8 * 16 * 32;
    LAS int* lcnt = (LAS int*)(lgs + 16 * 32);
    LAS int* lcls = lcnt + 64;
    LAS int* lrank = lcls + 512;
    LAS float* lcwa = (LAS float*)(lrank + 512);
    LAS float* lcwb = lcwa + 512;
    const int tid = launder_tid(); const int lane = tid & 63, wave = __builtin_amdgcn_readfirstlane(tid >> 6);
    const float* mod = (const float*)(p->ws + WS_MOD) + (size_t)l * 3 * 6144;
    {
        float tmp[8];
#pragma unroll
        for (int it = 0; it < 8; ++it) tmp[it] = p->w_rg[(size_t)l * 4096 + tid + NTHREADS * it];
#pragma unroll
        for (int it = 0; it < 8; ++it) { const int idx = tid + NTHREADS * it; *(LAS _Float16*)(Wh + (idx & 3) * ST_H16 + (idx >> 2) * 2) = (_Float16)tmp[it]; } }
#pragma unroll
    for (int hb = 0; hb < 2; ++hb) { float tmp[16];
#pragma unroll
        for (int it = 0; it < 16; ++it) tmp[it] = p->w_re[(size_t)l * 16384 + tid + NTHREADS * (16 * hb + it)];
#pragma unroll
        for (int it = 0; it < 16; ++it) { const int idx = tid + NTHREADS * (16 * hb + it); *(LAS _Float16*)(Wh + (4 + (idx & 15)) * ST_H16 + (idx >> 4) * 2) = (_Float16)tmp[it]; } }
    { unsigned zz; asm volatile("v_mov_b32 %0, 0" : "=v"(zz));
      for (int i = tid; i < 12 * 128; i += NTHREADS) { const int rw = 20 + i / 128, c16 = i % 128; *(LAS u32x4*)(Wh + rw * ST_H16 + c16 * 16) = (u32x4){zz, zz, zz, zz}; } }
    { float t0[6], t1[6], t2[6];
#pragma unroll
      for (int it = 0; it < 6; ++it) { const int idx = tid + NTHREADS * it; const int v = idx >> 10, k = idx & 1023; t0[it] = p->g_ffn[l * 1024 + k]; t1[it] = mod[v * 6144 + 4 * 1024 + k]; t2[it] = mod[v * 6144 + 3 * 1024 + k]; }
#pragma unroll
      for (int it = 0; it < 6; ++it) { const int idx = tid + NTHREADS * it; gm[idx] = t0[it] * (1.f + t1[it]); sh[idx] = t2[it]; } }
    if (tid < 64) lcnt[tid] = 0;
    __syncthreads();
    bf16_t* HM = (bf16_t*)(p->ws + WS_HX); float* CWLA = (float*)(p->ws + WS_CWLA); float* CWLB = (float*)(p->ws + WS_CWLB);
    int* gcount = (int*)(p->ws + WS_CTL) + l * 32; int* LIST = (int*)(p->ws + WS_LIST);
    const int rpb = (R + nb - 1) / nb, r0 = bid * rpb, r1 = (r0 + rpb) < R ? (r0 + rpb) : R;
    RowRaw xn[2];
#pragma unroll
    for (int q = 0; q < 2; ++q) if (r0 + 2 * wave + q < r1) row_load(p, 1, r0 + 2 * wave + q, lane, xn[q]);
#pragma unroll 1
    for (int t0r = r0; t0r < r1; t0r += 16) {
        f32x4 xv[2][4];
#pragma unroll
        for (int q = 0; q < 2; ++q) row_cvt(1, xn[q], xv[q]);
#pragma unroll
        for (int q = 0; q < 2; ++q) if (t0r + 16 + 2 * wave + q < r1) row_load(p, 1, t0r + 16 + 2 * wave + q, lane, xn[q]);
#pragma unroll
        for (int q = 0; q < 2; ++q) { const int rr = t0r + 2 * wave + q; const bool ok = rr < r1; const int v = row_v(ok ? rr : r0);
            float ss = 0.f;
#pragma unroll
            for (int j = 0; j < 4; ++j) ss += xv[q][j][0] * xv[q][j][0] + xv[q][j][1] * xv[q][j][1] + xv[q][j][2] * xv[q][j][2] + xv[q][j][3] * xv[q][j][3];
            ss = wave_sum(ss); const float rs = ok ? __builtin_amdgcn_rsqf(ss * (1.f / 1024.f) + 1e-6f) : 0.f;
#pragma unroll
            for (int j = 0; j < 4; ++j) { const int k = 4 * lane + 256 * j; const f32x4 g4 = *(const LAS f32x4*)(gm + v * 1024 + k), s4 = *(const LAS f32x4*)(sh + v * 1024 + k);
                f32x4 hv = xv[q][j] * rs * g4 + s4; if (!ok) hv = hv * 0.f;
                u32x2 o; o.x = cvt_pk_bf16(hv[0], hv[1]); o.y = cvt_pk_bf16(hv[2], hv[3]);
                if (ok) *(u32x2*)(HM + (size_t)rr * 1024 + k) = o;
                u32x2 h16; h16.x = pack_f16(hv[0], hv[1]); h16.y = pack_f16(hv[2], hv[3]);
                *(LAS u32x2*)(Xh + (2 * wave + q) * ST_H16 + k * 2) = h16; } }
        __syncthreads();
        {
            f32x4 acc0 = {0.f, 0.f, 0.f, 0.f}, acc1 = {0.f, 0.f, 0.f, 0.f};
#pragma unroll
            for (int s4 = 0; s4 < 4; ++s4) { const int kb = (128 * wave + 32 * s4 + 8 * (lane >> 4)) * 2;
                const f16x8 a = *(const LAS f16x8*)(Xh + (lane & 15) * ST_H16 + kb);
                const f16x8 b0 = *(const LAS f16x8*)(Wh + (lane & 15) * ST_H16 + kb), b1 = *(const LAS f16x8*)(Wh + (16 + (lane & 15)) * ST_H16 + kb);
                acc0 = __builtin_amdgcn_mfma_f32_16x16x32_f16(a, b0, acc0, 0, 0, 0);
                acc1 = __builtin_amdgcn_mfma_f32_16x16x32_f16(a, b1, acc1, 0, 0, 0); }
#pragma unroll
            for (int e = 0; e < 4; ++e) { const int row = 4 * (lane >> 4) + e; part[(wave * 16 + row) * 32 + (lane & 15)] = acc0[e]; part[(wave * 16 + row) * 32 + 16 + (lane & 15)] = acc1[e]; }
        }
        __syncthreads();
        if (tid < 320) { const int row = tid / 20, n = tid - row * 20; float sacc = n < 4 ? p->b_rg[l * 4 + n] : p->b_re[l * 16 + n - 4];
#pragma unroll
            for (int w = 0; w < 8; ++w) sacc += part[(w * 16 + row) * 32 + n];
            lgs[row * 32 + n] = sacc; }
        __syncthreads();
        if (tid < 16) { const int rr = t0r + tid;
            if (rr < r1) {
                if (l == DEPTH - 1 && row_v(rr) == 2) lcls[rr - r0] = -1;
                else {
                    float lg[20];
#pragma unroll
                    for (int n = 0; n < 20; ++n) lg[n] = lgs[tid * 32 + n];
                    int gsel = 0; float gmax = lg[0];
#pragma unroll
                    for (int t = 1; t < 4; ++t) if (lg[t] > gmax) { gmax = lg[t]; gsel = t; }
                    float gden = 0.f;
#pragma unroll
                    for (int t = 0; t < 4; ++t) gden += __expf(lg[t] - gmax);
                    const float gprob = 1.f / gden;
                    float el[4];
#pragma unroll
                    for (int t = 0; t < 4; ++t) el[t] = gsel == 0 ? lg[4 + t] : (gsel == 1 ? lg[8 + t] : (gsel == 2 ? lg[12 + t] : lg[16 + t]));
                    int i0 = 0; float m0 = el[0];
#pragma unroll
                    for (int t = 1; t < 4; ++t) if (el[t] > m0) { m0 = el[t]; i0 = t; }
                    int i1 = -1; float m1 = -3.0e38f;
#pragma unroll
                    for (int t = 0; t < 4; ++t) if (t != i0 && el[t] > m1) { m1 = el[t]; i1 = t; }
                    const float w0 = gprob / (1.f + __expf(m1 - m0)), w1 = gprob - w0;
                    const int ea = i0 < i1 ? i0 : i1, eb = i0 < i1 ? i1 : i0;
                    const float cwa = i0 < i1 ? w0 : w1, cwb = i0 < i1 ? w1 : w0;
                    const int pidx = ea == 0 ? eb - 1 : (ea == 1 ? eb + 1 : 5);
                    const int cls = gsel * 6 + pidx;
                    const int rank = __hip_atomic_fetch_add(&lcnt[cls], 1, __ATOMIC_RELAXED, __HIP_MEMORY_SCOPE_WORKGROUP);
                    lcls[rr - r0] = cls; lrank[rr - r0] = rank; lcwa[rr - r0] = cwa; lcwb[rr - r0] = cwb;
                } } }
    }
    __syncthreads();
    if (tid < NCLS) lcnt[32 + tid] = atomicAdd(&gcount[tid], lcnt[tid]);
    __syncthreads();
    for (int idx = tid; idx < r1 - r0; idx += NTHREADS) { const int cl = lcls[idx]; if (cl < 0) continue; const int pos = lcnt[32 + cl] + lrank[idx]; const size_t li = (size_t)cl * R + pos;
        LIST[li] = r0 + idx; CWLA[li] = lcwa[idx]; CWLB[li] = lcwb[idx]; }
    __syncthreads();
}
__device__ __forceinline__ void phase_final(CP p, unsigned char* lds, int bid, int nb) {
    const int tid = launder_tid(); const int lane = tid & 63, wave = tid >> 6;
    const int qstep = nb * 8;
    RowRaw xn;
    { const int q = bid * 8 + wave; if (q < NB * SEQ) { const int b = q >= SEQ ? 1 : 0; row_load(p, 1, b * SEG + CTXL + (q - b * SEQ), lane, xn); } }
    for (int q = bid * 8 + wave; q < NB * SEQ; q += qstep) {
        f32x4* hr = (f32x4*)(p->out + (size_t)q * D);
        f32x4 xv[4]; float ss = 0.f;
        row_cvt(1, xn, xv);
        { const int qn = q + qstep; if (qn < NB * SEQ) { const int bn = qn >= SEQ ? 1 : 0; row_load(p, 1, bn * SEG + CTXL + (qn - bn * SEQ), lane, xn); } }
#pragma unroll
        for (int j = 0; j < 4; ++j) ss += xv[j][0] * xv[j][0] + xv[j][1] * xv[j][1] + xv[j][2] * xv[j][2] + xv[j][3] * xv[j][3];
        ss = wave_sum(ss); const float rs = rsqrtf(ss * (1.f / 1024.f) + 1e-6f);
#pragma unroll
        for (int j = 0; j < 4; ++j) { const f32x4 g4 = *(const f32x4*)(p->g_final + 4 * lane + 256 * j); hr[lane + 64 * j] = xv[j] * rs * g4; }
    }
}


#define XB_TMO      128
#define XB_XCNT(j)  (256  + 64 * (j))
#define XB_XSUB(j)  (1280 + 64 * (j))
#define XB_XGEN(j)  (2304 + 64 * (j))
#define XB_TOP      3328
#define XB_TOPGEN   3392
#define XCD_BAR_WORDS 3456
#define XB_SPIN_CAP (1u << 22)
__device__ __forceinline__ unsigned xb_ld(unsigned* p) { return __hip_atomic_load(p, __ATOMIC_RELAXED, __HIP_MEMORY_SCOPE_AGENT); }
__device__ __forceinline__ unsigned xb_add(unsigned* p, unsigned v) { return __hip_atomic_fetch_add(p, v, __ATOMIC_RELAXED, __HIP_MEMORY_SCOPE_AGENT); }
__device__ __forceinline__ unsigned xb_xcc_id() { return (unsigned)__builtin_amdgcn_s_getreg((3 << 11) | 20) & 0xFu; }
#define XB_SPIN(cond, bar) do { unsigned _sp = 0; while (cond) { __builtin_amdgcn_s_sleep(1); \
    if ((++_sp & 255u) == 0u) { if (xb_ld(&(bar)[XB_TMO])) break; if (_sp > XB_SPIN_CAP) { atomicAdd(&(bar)[XB_TMO], 1u); break; } } } } while (0)
struct XcdBarrier { unsigned* bar; unsigned x; volatile LAS unsigned* st; };
__device__ __forceinline__ XcdBarrier xcd_barrier_post(unsigned* bar, volatile LAS unsigned* st) {
    XcdBarrier b; b.bar = bar; b.x = xb_xcc_id(); b.st = st;
    if (threadIdx.x == 0) (void)xb_add(&bar[XB_XCNT(b.x)], 1u);
    return b;
}
__device__ __forceinline__ void xcd_barrier_complete(unsigned* bar, unsigned x, unsigned& nloc, unsigned& nx) {
    const unsigned G = gridDim.x * gridDim.y * gridDim.z;
    unsigned sum, cnt, mine, sp = 0u;
    for (;;) {
        sum = 0u; cnt = 0u; mine = 0u;
#pragma unroll
        for (unsigned j = 0; j < 16; ++j) { const unsigned c = xb_ld(&bar[XB_XCNT(j)]); sum += c; cnt += (c > 0u) ? 1u : 0u; mine = (j == x) ? c : mine; }
        if (sum == G) break;
        __builtin_amdgcn_s_sleep(1);
        if ((++sp & 255u) == 0u) { if (xb_ld(&bar[XB_TMO])) break; if (sp > XB_SPIN_CAP) { atomicAdd(&bar[XB_TMO], 1u); break; } }
    }
    nloc = mine > 0u ? mine : 1u; nx = cnt > 0u ? cnt : 1u;
}
__device__ __forceinline__ void xcd_barrier(const XcdBarrier& b) {
    asm volatile("s_waitcnt vmcnt(0)" ::: "memory");
    __syncthreads();
    if (threadIdx.x == 0) {
        unsigned* bar = b.bar;
        __builtin_amdgcn_s_waitcnt(0);
        unsigned nloc = b.st[0], nx = b.st[1];
        if (nloc == 0u) { xcd_barrier_complete(bar, b.x, nloc, nx); b.st[0] = nloc; b.st[1] = nx; }
        const unsigned old = xb_add(&bar[XB_XSUB(b.x)], 1u);
        const unsigned gen = old / nloc;
        if (old + 1u == (gen + 1u) * nloc) {
            __builtin_amdgcn_fence(__ATOMIC_RELEASE, "agent");
            asm volatile("s_waitcnt vmcnt(0)" ::: "memory");
            const unsigned og = xb_add(&bar[XB_TOP], 1u);
            const unsigned tg = og / nx;
            if (og + 1u == (tg + 1u) * nx) xb_add(&bar[XB_TOPGEN], 1u);
            else XB_SPIN(xb_ld(&bar[XB_TOPGEN]) == tg, bar);
            __builtin_amdgcn_fence(__ATOMIC_ACQUIRE, "agent");
            xb_add(&bar[XB_XGEN(b.x)], 1u);
            asm volatile("s_waitcnt vmcnt(0)" ::: "memory");
        } else {
            XB_SPIN(xb_ld(&bar[XB_XGEN(b.x)]) == gen, bar);
            __builtin_amdgcn_fence(__ATOMIC_ACQUIRE, "agent");
            asm volatile("s_waitcnt vmcnt(0)" ::: "memory");
        }
    }
    __syncthreads();
}

#ifndef TIMING_A
#define TIMING_A -1
#endif
#ifndef TIMING_B
#define TIMING_B -1
#endif
#ifndef PHASE_MASK
#define PHASE_MASK 0xFFFFF
#endif
#define PM(i) ((PHASE_MASK >> (i)) & 1)
#ifndef REPEAT_MASK
#define REPEAT_MASK 0
#endif
#define RP(i) for (int rep_ = 0; rep_ < 1 + ((REPEAT_MASK >> (i)) & 1); ++rep_)
constexpr int PH_PER_LAYER = 9, NPHASES = 1 + DEPTH * PH_PER_LAYER + 1;
__global__ void __launch_bounds__(NTHREADS, 2) mk_fwd(Args args) {
    extern __shared__ __attribute__((aligned(16))) unsigned char lds[];
    cg::grid_group grid = cg::this_grid();
    const __attribute__((address_space(4))) Args* ap = (const __attribute__((address_space(4))) Args*)__builtin_amdgcn_kernarg_segment_ptr();
    const int lo = ap->lo, hi = ap->hi;
    LAS unsigned char* ldsl = (LAS unsigned char*)lds;
    volatile LAS unsigned* xbst = (volatile LAS unsigned*)(ldsl + LDS_BYTES - 16);
    if (threadIdx.x < 4) xbst[threadIdx.x] = 0u;
    __syncthreads();
    (void)xcd_barrier_post((unsigned*)(ap->p.ws + WS_BAR), xbst);
    if (TIMING_A >= 0 && blockIdx.x == 0 && threadIdx.x == 0) ((unsigned long long*)(ap->p.ws + WS_TS))[lo] = __builtin_amdgcn_s_memrealtime();
    for (int ph = lo; ph < hi; ++ph) {
        CP p = launder(&ap->p);
        int bid = blockIdx.x, nb = gridDim.x; asm volatile("" : "+s"(bid), "+s"(nb));
        if (ph == 0) { if (PM(0)) RP(0) phase_wprep(p, lds, 0, 912, bid, nb); if (PM(1)) RP(1) phase_adaln(p, lds, bid, nb); }
        else if (ph == NPHASES - 1) { if (PM(12)) phase_final(p, lds, bid, nb); }
        else {
            const int l = (ph - 1) / PH_PER_LAYER, s = (ph - 1) % PH_PER_LAYER;
            if (s == 0) { if (PM(2)) RP(2) { if (rep_ == 0 || l == 0) phase_r1(p, l, lds, bid, nb); } }
            else if (s == 1) { if (PM(3)) RP(3) {
                pg8::DenseSched S; S.init(p->ws + WS_HX, (const bf16_t*)(p->ws + WS_WTIN) + (size_t)l * DIN * 1024, R, NPROJ, 1024, 1024, 1024, nb, bid);
                EpiProj E{(bf16_t*)(p->ws + WS_PROJ)};
                pg8::gemm_phase<EpiProj, pg8::DenseSched, false>(ldsl, 1024, 1024, 1024, S, E);
                {
                    const int extra = S.nwg % nb; const int L1 = WPREP_ITEMS_PER_LAYER;
                    const int a0 = l == 0 ? 912 : L1 + 656, a1 = l == 0 ? 2960 : L1 + 2960;
                    if (l <= 1 && DEPTH == 2) { if (extra > 0 && bid >= extra) phase_wprep(p, lds, a0, a1, bid - extra, nb - extra); else if (extra == 0) phase_wprep(p, lds, a0, a1, bid, nb); } }
            } }
            else if (s == 2) { if (PM(4)) RP(4) phase_c1(p, l, lds, bid, nb); if (PM(5)) RP(5) phase_s1(p, l, lds, bid, nb); }
            else if (s == 3) { if (PM(6)) RP(6) phase_s2(p, bid, nb); }
            else if (s == 4) { if (PM(7)) RP(7) phase_s3(p, l, lds, bid, nb);
                if (PM(4)) {
                    const int cpb = NCHUNK - ((l == DEPTH - 1) ? 2 : 0), nunits = NB * cpb * 2, tail = (nunits % nb) * 4;
                    if (tail > 0 && tail < nb) { if (bid >= tail) phase_c1_ln(p, l, bid - tail, nb - tail); } else phase_c1_ln(p, l, bid, nb); } }
            else if (s == 5) { if (PM(8)) RP(8) { if (rep_ == 0 || l == 0) {
                pg8::DenseSched S; S.init(p->ws + WS_HX, (const bf16_t*)(p->ws + WS_WTOUT) + (size_t)l * 1024 * 1024, R, 1024, 1024, 1024, 1024, nb, bid, l == DEPTH - 1);
                EpiResid<0> E{p->ctx, p->x, (bf16_t*)(p->ws + WS_H), (const float*)(p->ws + WS_MOD) + (size_t)l * 3 * 6144, (const float*)(p->ws + WS_SSQ)};
                pg8::gemm_phase<EpiResid<0>, pg8::DenseSched, false>(ldsl, 1024, 1024, 1024, S, E);
                if (l == 0 && DEPTH == 2 && rep_ == 0) { const int extra = S.nwg % nb; const int L1 = WPREP_ITEMS_PER_LAYER;
                    if (extra > 0 && bid >= extra) phase_wprep(p, lds, 2960, 3984, bid - extra, nb - extra, L1, L1 + 656, L1 + 2960, L1 + 3984);
                    else if (extra == 0) phase_wprep(p, lds, 2960, 3984, bid, nb, L1, L1 + 656, L1 + 2960, L1 + 3984); }
            } } }
            else if (s == 6) { if (PM(9)) phase_r2(p, l, lds, bid, nb); }
            else if (s == 7) { if (PM(10)) {
                LAS int* tab = (LAS int*)(ldsl + MISC_OFF);
                LAS float* gl = (LAS float*)(ldsl + MISC_OFF + 4096);
                { const float* modl = (const float*)(p->ws + WS_MOD) + (size_t)l * 3 * 6144 + 5 * 1024; float tg[6]; const int tt = launder_tid();
#pragma unroll
                  for (int it = 0; it < 6; ++it) { const int i = tt + NTHREADS * it; tg[it] = modl[(size_t)(i >> 10) * 6144 + (i & 1023)]; }
#pragma unroll
                  for (int it = 0; it < 6; ++it) gl[tt + NTHREADS * it] = tg[it]; }
                moe_table(p, l, tab);
                unsigned* ready = (unsigned*)(p->ws + WS_M1CNT) + l * 192;
                { MoeSched S{tab, (const int*)(p->ws + WS_LIST), (const char*)(p->ws + WS_HX), (const char*)(p->ws + WS_WTGU), 0, l, nb, bid, ready, 0};
                  EpiUp E{(bf16_t*)(p->ws + WS_HID), (const float*)(p->ws + WS_CWLA), (const float*)(p->ws + WS_CWLB), ready};
                  pg8::gemm_phase<EpiUp, MoeSched, true>(ldsl, 1024, 1024, 1024, S, E); }
                { const int total = __builtin_amdgcn_readfirstlane(tab[24]) * 4; const int extra = __builtin_amdgcn_readfirstlane(total % nb);
                  MoeSched S{tab, (const int*)(p->ws + WS_LIST), (const char*)(p->ws + WS_HID), (const char*)(p->ws + WS_WTD), 1, l, nb, bid, ready, (total >= nb && total - extra >= nb) ? extra : 0};
                  EpiDown E{(bf16_t*)(p->ws + WS_H), (const int*)(p->ws + WS_LIST), gl};
                  pg8::gemm_phase<EpiDown, MoeSched, false>(ldsl, 512, 256, 512, S, E); }
            } }
            else { }
        }
        if (ph + 1 < hi && !(ph > 0 && ph < NPHASES - 1 && (ph - 1) % PH_PER_LAYER == 7)) { if (hi < 0) grid.sync();   else { XcdBarrier xb; xb.bar = (unsigned*)(launder(&ap->p)->ws + WS_BAR); xb.x = xb_xcc_id(); xb.st = (volatile LAS unsigned*)(ldsl + LDS_BYTES - 16); xcd_barrier(xb); }
            if (TIMING_A >= 0 && blockIdx.x == 0 && threadIdx.x == 0) ((unsigned long long*)(launder(&ap->p)->ws + WS_TS))[ph + 1] = __builtin_amdgcn_s_memrealtime(); }
    }
#if TIMING_A >= 0
    {
        XcdBarrier xb; xb.bar = (unsigned*)(launder(&ap->p)->ws + WS_BAR); xb.x = xb_xcc_id(); xb.st = (volatile LAS unsigned*)(ldsl + LDS_BYTES - 16); xcd_barrier(xb);
        if (blockIdx.x == 0 && threadIdx.x == 0) ((unsigned long long*)(launder(&ap->p)->ws + WS_TS))[hi] = __builtin_amdgcn_s_memrealtime();
        xcd_barrier(xb);
        const unsigned long long* ts = (const unsigned long long*)(launder(&ap->p)->ws + WS_TS);
        const float ta = (float)(ts[TIMING_A + 1] - ts[TIMING_A]) * 0.01f, tb = (float)(ts[TIMING_B + 1] - ts[TIMING_B]) * 0.01f;
        float* o = launder(&ap->p)->out; const float sc = 1.f + ta * 0.001f;
        for (size_t i = (size_t)blockIdx.x * NTHREADS + threadIdx.x; i < (size_t)NB * SEQ * D; i += (size_t)gridDim.x * NTHREADS) o[i] = o[i] * sc + (i == 0 ? tb * 0.1f : 0.f);
    }
#endif
}

extern "C" void kernel_launch(void* const* d_in, const int* in_sizes, int n_in, void* d_out, int out_size, void* d_ws, size_t ws_size, hipStream_t stream) {
    static int grid = 0;
    if (grid == 0) {
        if (n_in != 28 || ws_size < WS_END) { fprintf(stderr, "kernel_launch: unexpected n_in %d or ws_size %zu (< %zu)\n", n_in, ws_size, (size_t)WS_END); grid = -1; return; }
        int dev = 0, cus = 0, per_cu = 0;
        hipGetDevice(&dev); hipDeviceGetAttribute(&cus, hipDeviceAttributeMultiprocessorCount, dev);
        if (hipFuncSetAttribute((const void*)mk_fwd, hipFuncAttributeMaxDynamicSharedMemorySize, LDS_BYTES) != hipSuccess) { fprintf(stderr, "kernel_launch: hipFuncSetAttribute failed\n"); grid = -1; return; }
        if (hipOccupancyMaxActiveBlocksPerMultiprocessor(&per_cu, (const void*)mk_fwd, NTHREADS, LDS_BYTES) != hipSuccess || per_cu < 1) { fprintf(stderr, "kernel_launch: occupancy query says %d\n", per_cu); (void)hipGetLastError(); grid = -1; return; }
        grid = cus;
    }
    if (grid < 0) return;
    (void)hipMemsetAsync((char*)d_ws + WS_CTL, 0, WS_CTL_BYTES, stream);
    Args a{};
    const float** pp = (const float**)&a.p;
    for (int i = 0; i < 28; ++i) pp[i] = (const float*)d_in[i];
    a.p.out = (float*)d_out; a.p.ws = (unsigned char*)d_ws;
#if PER_PHASE_LAUNCH
    for (int ph = 0; ph < NPHASES; ++ph) {
        a.lo = ph; a.hi = ph + 1; void* kargs[] = {&a};
        hipError_t e = hipLaunchCooperativeKernel((const void*)mk_fwd, dim3(grid), dim3(NTHREADS), kargs, LDS_BYTES, stream);
        if (e != hipSuccess) { fprintf(stderr, "kernel_launch: launch of phase %d failed: %s\n", ph, hipGetErrorString(e)); break; }
    }
#else
    a.lo = 0; a.hi = NPHASES; void* kargs[] = {&a};
    hipError_t e = hipLaunchCooperativeKernel((const void*)mk_fwd, dim3(grid), dim3(NTHREADS), kargs, LDS_BYTES, stream);
    if (e != hipSuccess) fprintf(stderr, "kernel_launch: cooperative launch failed: %s (grid %d)\n", hipGetErrorString(e), grid);
#endif
}
```

```cpp
#include <hip/hip_runtime.h>
#include <hip/hip_cooperative_groups.h>
#include <cstdio>
namespace cg = cooperative_groups;

#ifndef PER_PHASE_LAUNCH
#define PER_PHASE_LAUNCH 0
#endif

#ifndef S3REP
#define S3REP 0
#endif
#define S3R(i) for (int r3_ = 0; r3_ < 1 + ((S3REP >> (i)) & 1); ++r3_)
#define LAS __attribute__((address_space(3)))
typedef unsigned short bf16_t;
typedef short bf16x8 __attribute__((ext_vector_type(8)));
typedef float f32x4 __attribute__((ext_vector_type(4)));
typedef unsigned u32x4 __attribute__((ext_vector_type(4)));
typedef unsigned u32x2 __attribute__((ext_vector_type(2)));

constexpr int D = 1024, NB = 2, SEQ = 16384, CTXL = 256, SEG = SEQ + CTXL, R = NB * SEG, DEPTH = 2;
constexpr int NPROJ = 2560, DIN = 2576;
constexpr int NTHREADS = 512;
constexpr int LDS_BYTES = 163840;
constexpr int MISC_OFF = 131072;
constexpr int NCLS = 24;

constexpr size_t al256(size_t x) { return (x + 255) & ~size_t(255); }
constexpr size_t WS_CTL = 0;
constexpr size_t WS_M1CNT = 20480;
constexpr size_t WS_TS = 2048;
constexpr size_t WS_BAR = 4096;
constexpr size_t WS_CTL_BYTES = 32768;
constexpr size_t WS_MOD = WS_CTL_BYTES;
constexpr size_t WS_WTIN = WS_MOD + al256((size_t)2 * 3 * 6144 * 4);
constexpr size_t WS_WTOUT = WS_WTIN + al256((size_t)2 * DIN * 1024 * 2);
constexpr size_t WS_WTGU = WS_WTOUT + al256((size_t)2 * 1024 * 1024 * 2);
constexpr size_t WS_WTD = WS_WTGU + al256((size_t)2 * 16 * 512 * 1024 * 2);
constexpr size_t WS_H = WS_WTD + al256((size_t)2 * 16 * 1024 * 256 * 2);
constexpr size_t WS_HX = WS_H + al256((size_t)R * 1024 * 2);
constexpr size_t WS_PROJ = WS_HX + al256((size_t)R * 1024 * 2);
constexpr size_t WS_DT = WS_PROJ + al256((size_t)R * NPROJ * 2);
constexpr size_t WS_POS = WS_DT + al256((size_t)R * 16 * 4);
constexpr size_t WS_LIST = WS_POS + al256((size_t)2 * R * 4);
constexpr size_t WS_CWLA = WS_LIST + al256((size_t)NCLS * R * 4);
constexpr size_t WS_CWLB = WS_CWLA + al256((size_t)NCLS * R * 4);
constexpr size_t WS_BIG = WS_CWLB + al256((size_t)NCLS * R * 4);
constexpr size_t WS_Y = WS_PROJ;
constexpr size_t WS_S = WS_BIG;
constexpr size_t WS_HP = WS_S + al256((size_t)2 * 2 * 130 * 8 * 8192 * 2);
constexpr size_t WS_DEC = WS_HP + al256((size_t)2 * 2 * 130 * 8 * 8192 * 2);
constexpr size_t WS_SSQ = WS_DEC + al256((size_t)2 * 2 * 130 * 8 * 4);
constexpr size_t WS_HID = WS_S;
constexpr size_t WS_END = WS_SSQ + al256((size_t)R * 8 * 4);
static_assert((size_t)(R + NCLS * 256) * 512 * 2 <= (size_t)2 * 2 * 130 * 8 * 8192 * 2, "hid alias");
static_assert(WS_END <= (size_t)512 * 1024 * 1024, "workspace");

struct Params {
    const float *x, *c, *ctx, *c_ctx, *w_ada, *b_ada, *g_mix, *g_ffn, *w_in, *conv_w, *conv_b, *conv_ln_g, *conv_ln_b, *ssd_conv_w, *ssd_conv_b,
        *dt_bias, *a_log, *d_skip, *ssd_norm_g, *w_out, *w_rg, *b_rg, *w_re, *b_re, *w_gate, *w_up, *w_down, *g_final;
    float* out; unsigned char* ws;
};
struct Args { Params p; int lo, hi; };
typedef const __attribute__((address_space(4))) Params* CP;
__device__ __forceinline__ CP launder(CP p) { asm volatile("" : "+s"(p)); return p; }
__device__ __forceinline__ int launder_tid() { int t = threadIdx.x; asm volatile("" : "+v"(t)); return t; }

__device__ __forceinline__ unsigned cvt_pk_bf16(float lo, float hi) { unsigned r; asm("v_cvt_pk_bf16_f32 %0, %1, %2" : "=v"(r) : "v"(lo), "v"(hi)); return r; }
__device__ __forceinline__ float bf2f(unsigned b) { return __uint_as_float(b << 16); }
__device__ __forceinline__ float bflo(unsigned w) { return __uint_as_float(w << 16); }
__device__ __forceinline__ float bfhi(unsigned w) { return __uint_as_float(w & 0xffff0000u); }
__device__ __forceinline__ bf16_t f2bf(float f) { return (bf16_t)(cvt_pk_bf16(f, 0.f) & 0xffffu); }
#define DPP_ADD(v, ctrl, rm) ((v) + __builtin_bit_cast(float, __builtin_amdgcn_update_dpp(0, __builtin_bit_cast(int, (v)), (ctrl), (rm), 0xF, true)))
__device__ __forceinline__ float row_sum16(float v) {
    v = DPP_ADD(v, 0xB1, 0xF);
    v = DPP_ADD(v, 0x4E, 0xF);
    v = DPP_ADD(v, 0x141, 0xF);
    v = DPP_ADD(v, 0x140, 0xF);
    return v;
}
__device__ __forceinline__ float half_sum32(float v) { v = row_sum16(v); v = DPP_ADD(v, 0x142, 0xA); return v; }
__device__ __forceinline__ float wave_sum(float v) {
    v = half_sum32(v); v = DPP_ADD(v, 0x143, 0xC);
    return __builtin_bit_cast(float, __builtin_amdgcn_readlane(__builtin_bit_cast(int, v), 63));
}
__device__ __forceinline__ float sigmoidf_(float x) { return __builtin_amdgcn_rcpf(1.f + __builtin_amdgcn_exp2f(x * -1.44269504089f)); }
__device__ __forceinline__ float siluf_(float x) { return x * __builtin_amdgcn_rcpf(1.f + __builtin_amdgcn_exp2f(x * -1.44269504089f)); }
__device__ __forceinline__ float softplusf_(float x) { return fmaxf(x, 0.f) + __logf(1.f + __expf(-fabsf(x))); }

__device__ __forceinline__ int row_b(int r) { return r >= SEG ? 1 : 0; }
__device__ __forceinline__ int row_i(int r) { return r >= SEG ? r - SEG : r; }
__device__ __forceinline__ int row_v(int r) { const int i = row_i(r); return i < CTXL ? 2 : row_b(r); }
__device__ __forceinline__ const float* xin_ptr(const float* ctx, const float* x, int r) {
    const int b = row_b(r), i = row_i(r);
    return i < CTXL ? ctx + (size_t)(b * CTXL + i) * D : x + (size_t)(b * SEQ + i - CTXL) * D;
}
struct RowRaw { f32x4 f[4]; u32x2 h[4]; };
__device__ __forceinline__ void row_load(CP p, int l, int r, int lane, RowRaw& rr) {
    if (l == 0) { const f32x4* hr = (const f32x4*)xin_ptr(p->ctx, p->x, r);
#pragma unroll
        for (int j = 0; j < 4; ++j) rr.f[j] = __builtin_nontemporal_load(hr + lane + 64 * j); }
    else { const u32x2* hr = (const u32x2*)((const bf16_t*)(p->ws + WS_H) + (size_t)r * D);
#pragma unroll
        for (int j = 0; j < 4; ++j) rr.h[j] = hr[lane + 64 * j]; }
}
__device__ __forceinline__ void row_cvt(int l, const RowRaw& rr, f32x4 (&xv)[4]) {
#pragma unroll
    for (int j = 0; j < 4; ++j) xv[j] = l == 0 ? rr.f[j] : (f32x4){bflo(rr.h[j].x), bfhi(rr.h[j].x), bflo(rr.h[j].y), bfhi(rr.h[j].y)};
}
namespace pg8 {
constexpr int BM = 256, BK = 64, HALF = 128, HTB = HALF * BK * 2, STAGE_BYTES = 8 * HTB, NXCD = 8, WGM = 8;
__device__ __forceinline__ int lds_byte(int r, int c) { const int st = (r >> 4) * 2 + (c >> 5), rr = r & 15, cc = c & 31, ob = rr * 64 + cc * 2; return st * 1024 + (ob ^ (((ob >> 9) & 1) << 5)); }
__device__ __forceinline__ void stage_rc(int b, int& Rr, int& Cc) { const int st = b / 1024, sb = b % 1024, swz = sb ^ (((sb >> 9) & 1) << 5); Rr = (st >> 1) * 16 + swz / 64; Cc = (st & 1) * 32 + (swz % 64) / 2; }
__device__ __forceinline__ int perm32(int rho) { const int n = rho >> 4, i = rho & 15; return 8 * (i >> 2) + 4 * n + (i & 3); }

struct Unit {
    const char* a0;
    const char* b0;
    const char* b1;
    int i0, i1, i2, i3, i4, pad;
};

template <class Epi, class Sched, bool GATHER>
__device__ __forceinline__ void gemm_phase(LAS unsigned char* lds, const int lda, const int ldb, const int K, const Sched& S, const Epi& E) {
    const int tid = launder_tid(); const int wid = __builtin_amdgcn_readfirstlane(tid >> 6), lane = tid & 63, wr = wid >> 2, wc = wid & 3, fr = lane & 15, fq = lane >> 4;
    const int nt = K / BK, ks = nt >> 1;
    int Rr[2], Cc[2];
    unsigned voffB[2];
#pragma unroll
    for (int i = 0; i < 2; ++i) { stage_rc(tid * 16 + i * 8192, Rr[i], Cc[i]); const int Rb = Epi::PERM ? ((Rr[i] & ~31) + perm32(Rr[i] & 31)) : Rr[i];
        voffB[i] = (unsigned)(Rb * ldb + Cc[i]) * 2u; }
    const size_t kstep = (size_t)(BK * 2);
    const size_t hstepB = (size_t)HALF * ldb * 2;
    const unsigned ldsw = (unsigned)wid * 1024u;
    const unsigned ldsbase = (unsigned)(unsigned long)lds;
    const int aoff = lds_byte(wr * 64 + fr, fq * 8), boff = lds_byte(wc * 32 + fr, fq * 8);
#define PG8_SA(b, h) (((b) * 2 + (h)) * HTB)
#define PG8_SB(b, h) ((4 + (b) * 2 + (h)) * HTB)
#define PG8_STAGE2(bufoff, gbase, v0, v1) do { unsigned keep_; \
        asm volatile("s_mov_b32 %0, m0\n\ts_mov_b32 m0, %1\n\ts_nop 4\n\tglobal_load_lds_dwordx4 %2, %4\n\ts_add_u32 m0, m0, 0x2000\n\ts_nop 0\n\tglobal_load_lds_dwordx4 %3, %4\n\ts_mov_b32 m0, %0" \
            : "=&s"(keep_) : "s"(ldsbase + (unsigned)(bufoff) + ldsw), "v"(v0), "v"(v1), "s"(gbase) : "memory", "scc"); } while (0)
#define PG8_LDA(dst, b, h) do { _Pragma("unroll") for (int m = 0; m < 4; ++m) _Pragma("unroll") for (int k = 0; k < 2; ++k) dst[m][k] = *(const LAS bf16x8*)(lds + PG8_SA(b, h) + aoff + m * 2048 + k * 1024); } while (0)
#define PG8_LDB(dst, b, h) do { _Pragma("unroll") for (int n = 0; n < 2; ++n) _Pragma("unroll") for (int k = 0; k < 2; ++k) dst[n][k] = *(const LAS bf16x8*)(lds + PG8_SB(b, h) + boff + n * 2048 + k * 1024); } while (0)
#define PG8_MMA(ai, bj, At, Bt) do { __builtin_amdgcn_s_setprio(1); _Pragma("unroll") for (int m = 0; m < 4; ++m) _Pragma("unroll") for (int n = 0; n < 2; ++n) _Pragma("unroll") for (int k = 0; k < 2; ++k) \
        acc[ai][bj][m][n] = __builtin_amdgcn_mfma_f32_16x16x32_bf16(Bt[n][k], At[m][k], acc[ai][bj][m][n], 0, 0, 0); __builtin_amdgcn_s_setprio(0); } while (0)
#define PG8_WAIT_V(n) asm volatile("s_waitcnt vmcnt(" #n ")" ::: "memory")
#define PG8_WAIT_L(n) asm volatile("s_waitcnt lgkmcnt(" #n ")" ::: "memory")
#define PG8_BAR __builtin_amdgcn_s_barrier()
#define PG8_SCHED __builtin_amdgcn_sched_barrier(0)
#define PG8_BP(u, tt) ((tt) < ks ? (u).b0 + (size_t)(tt) * kstep : (u).b1 + (size_t)((tt) - ks) * kstep)
    Unit cur, nxt; int ui = 0;
    if (!S.get(0, cur)) return;
    S.a_ready(cur);
    unsigned c00, c01, c10, c11, n00, n01, n10, n11;
    if (GATHER) {
        c00 = (unsigned)(S.arow(cur, Rr[0]) * lda + Cc[0]) * 2u; c01 = (unsigned)(S.arow(cur, Rr[1]) * lda + Cc[1]) * 2u;
        c10 = (unsigned)(S.arow(cur, HALF + Rr[0]) * lda + Cc[0]) * 2u; c11 = (unsigned)(S.arow(cur, HALF + Rr[1]) * lda + Cc[1]) * 2u;
    } else {
        c00 = (unsigned)(Rr[0] * lda + Cc[0]) * 2u; c01 = (unsigned)(Rr[1] * lda + Cc[1]) * 2u;
        c10 = (unsigned)((HALF + Rr[0]) * lda + Cc[0]) * 2u; c11 = (unsigned)((HALF + Rr[1]) * lda + Cc[1]) * 2u;
    }
    n00 = c00; n01 = c01; n10 = c10; n11 = c11;
    f32x4 acc[2][2][4][2];
    float zr; asm volatile("v_mov_b32 %0, 0" : "=v"(zr));
#pragma unroll
    for (int a = 0; a < 2; ++a)
#pragma unroll
        for (int b = 0; b < 2; ++b)
#pragma unroll
            for (int m = 0; m < 4; ++m)
#pragma unroll
                for (int n = 0; n < 2; ++n) acc[a][b][m][n] = (f32x4){zr, zr, zr, zr};
    bf16x8 At[4][2], B0[2][2], B1[2][2];
    const char* cA = cur.a0;
    {
        const char* pb0 = PG8_BP(cur, 0); const char* pb1 = PG8_BP(cur, 1);
        PG8_STAGE2(PG8_SB(0, 0), pb0, voffB[0], voffB[1]); PG8_STAGE2(PG8_SA(0, 0), cA, c00, c01);
        PG8_STAGE2(PG8_SB(0, 1), pb0 + hstepB, voffB[0], voffB[1]); PG8_STAGE2(PG8_SA(0, 1), cA, c10, c11);
        if (wr == 1) PG8_BAR;
        PG8_WAIT_V(4); PG8_BAR;
        PG8_STAGE2(PG8_SB(1, 0), pb1, voffB[0], voffB[1]); PG8_STAGE2(PG8_SA(1, 0), cA + kstep, c00, c01);
        PG8_STAGE2(PG8_SB(1, 1), pb1 + hstepB, voffB[0], voffB[1]);
        PG8_WAIT_V(6); PG8_BAR;
    }
    for (;;) {
        const bool has_next = S.get(ui + 1, nxt);
        if (!has_next) nxt = cur;
        LAS int* tokb = (LAS int*)(lds + MISC_OFF + 1024) + ((ui + 1) & 1) * 256;
        if (GATHER) {
            n00 = c00; n01 = c01; n10 = c10; n11 = c11;
            if (has_next && wid == 0) {
                const char* src = (const char*)S.rows_ptr(nxt); unsigned keep_;
                asm volatile("s_mov_b32 %0, m0\n\ts_mov_b32 m0, %1\n\ts_nop 4\n\tglobal_load_lds_dwordx4 %2, %3\n\ts_mov_b32 m0, %0"
                    : "=&s"(keep_) : "s"((unsigned)(unsigned long)tokb), "v"((unsigned)lane * 16u), "s"(src) : "memory");
            }
        }
        const char* nA = nxt.a0;
#pragma unroll 1
        for (int t = 0; t < nt; t += 2) {
            const bool last = (t == nt - 2);
            if (last && has_next) S.a_ready(nxt);
            const char* a1 = cA + (size_t)(t + 1) * kstep;
            const char* a2 = last ? nA : cA + (size_t)(t + 2) * kstep;
            const char* a3 = a2 + kstep;
            const char* b2 = last ? PG8_BP(nxt, 0) : PG8_BP(cur, t + 2);
            const char* b3 = last ? PG8_BP(nxt, 1) : PG8_BP(cur, t + 3);
            if (GATHER) { if (last && has_next) {
                const int lim = S.rows_valid(nxt) - 1;
                const int i0 = Rr[0] < lim ? Rr[0] : lim, i1 = Rr[1] < lim ? Rr[1] : lim, i2 = (HALF + Rr[0]) < lim ? (HALF + Rr[0]) : lim, i3 = (HALF + Rr[1]) < lim ? (HALF + Rr[1]) : lim;
                n00 = (unsigned)(tokb[i0] * lda + Cc[0]) * 2u; n01 = (unsigned)(tokb[i1] * lda + Cc[1]) * 2u;
                n10 = (unsigned)(tokb[i2] * lda + Cc[0]) * 2u; n11 = (unsigned)(tokb[i3] * lda + Cc[1]) * 2u; } }
            const unsigned s00 = last ? n00 : c00, s01 = last ? n01 : c01, s10 = last ? n10 : c10, s11 = last ? n11 : c11;
            if constexpr (Epi::MIDSCALE) { if (t == ks) E.midscale(acc, cur, wr, wc, fr, fq); }
            PG8_LDB(B0, 0, 0); PG8_SCHED; PG8_LDA(At, 0, 0); PG8_STAGE2(PG8_SA(1, 1), a1, c10, c11);
            PG8_WAIT_L(8); PG8_BAR; PG8_WAIT_L(0); PG8_MMA(0, 0, At, B0); PG8_BAR; PG8_SCHED;
            PG8_LDB(B1, 0, 1); PG8_STAGE2(PG8_SB(0, 0), b2, voffB[0], voffB[1]);
            PG8_BAR; PG8_WAIT_L(0); PG8_MMA(0, 1, At, B1); PG8_BAR;
            PG8_LDA(At, 0, 1); PG8_STAGE2(PG8_SA(0, 0), a2, s00, s01);
            PG8_BAR; PG8_WAIT_L(0); PG8_MMA(1, 0, At, B0); PG8_BAR; PG8_SCHED;
            PG8_STAGE2(PG8_SB(0, 1), b2 + hstepB, voffB[0], voffB[1]);
            PG8_WAIT_V(6); PG8_BAR; PG8_MMA(1, 1, At, B1); PG8_BAR;
            PG8_LDB(B0, 1, 0); PG8_SCHED; PG8_LDA(At, 1, 0); PG8_STAGE2(PG8_SA(0, 1), a2, s10, s11);
            PG8_WAIT_L(8); PG8_BAR; PG8_WAIT_L(0); PG8_MMA(0, 0, At, B0); PG8_BAR; PG8_SCHED;
            PG8_LDB(B1, 1, 1); PG8_STAGE2(PG8_SB(1, 0), b3, voffB[0], voffB[1]);
            PG8_BAR; PG8_WAIT_L(0); PG8_MMA(0, 1, At, B1); PG8_BAR;
            PG8_LDA(At, 1, 1); PG8_STAGE2(PG8_SA(1, 0), a3, s00, s01);
            PG8_BAR; PG8_WAIT_L(0); PG8_MMA(1, 0, At, B0); PG8_BAR; PG8_SCHED;
            PG8_STAGE2(PG8_SB(1, 1), b3 + hstepB, voffB[0], voffB[1]);
            PG8_WAIT_V(6); PG8_BAR; PG8_MMA(1, 1, At, B1); PG8_BAR;
        }
        E(acc, cur, wr, wc, fr, fq);
        if (!has_next) break;
        asm volatile("v_mov_b32 %0, 0" : "=v"(zr));
#pragma unroll
        for (int a = 0; a < 2; ++a)
#pragma unroll
            for (int b = 0; b < 2; ++b)
#pragma unroll
                for (int m = 0; m < 4; ++m)
#pragma unroll
                    for (int n = 0; n < 2; ++n) acc[a][b][m][n] = (f32x4){zr, zr, zr, zr};
        cur = nxt; cA = nA; ++ui; c00 = n00; c01 = n01; c10 = n10; c11 = n11;
    }
    PG8_WAIT_V(0);
    if (wr == 0) PG8_BAR;
    PG8_BAR;
#undef PG8_SA
#undef PG8_SB
#undef PG8_STAGE2
#undef PG8_LDA
#undef PG8_LDB
#undef PG8_MMA
#undef PG8_WAIT_V
#undef PG8_WAIT_L
#undef PG8_BAR
#undef PG8_SCHED
#undef PG8_BP
}

struct DenseSched {
    const char* A; const char* Bt; int lda, ldb, K; int nM, nN, nwg, G, c, skipctx;
    __device__ __forceinline__ void init(const void* A_, const void* Bt_, int M, int N, int K_, int lda_, int ldb_, int G_, int c_, int skipctx_ = 0) {
        A = (const char*)A_; Bt = (const char*)Bt_; lda = lda_; ldb = ldb_; K = K_; nM = M / BM - 2 * skipctx_; nN = N / BM; nwg = nM * nN; G = G_; c = c_; skipctx = skipctx_; }
    __device__ __forceinline__ bool get(int i, Unit& u) const {
        const long L = (long)i * G + c; if (L >= nwg) return false;
        int wgid = (int)L; { const int q = nwg / NXCD, r = nwg % NXCD, xcd = wgid % NXCD, off = wgid / NXCD; wgid = (xcd < r ? xcd * (q + 1) : r * (q + 1) + (xcd - r) * q) + off; }
        const int nig = WGM * nN, gid = wgid / nig, fm = gid * WGM, gsz = (nM - fm) < WGM ? (nM - fm) : WGM;
        int pm = fm + ((wgid % nig) % gsz); const int pn = (wgid % nig) / gsz;
        if (skipctx) pm += 1 + (pm >= 64 ? 1 : 0);
        u.a0 = A + (size_t)pm * BM * lda * 2; u.b0 = Bt + (size_t)pn * BM * ldb * 2; u.b1 = u.b0 + (size_t)(K / BK / 2) * BK * 2;
        u.i0 = pm; u.i1 = pn; u.i2 = 0; u.i3 = 0; u.i4 = 0; u.pad = 0; return true;
    }
    __device__ __forceinline__ void a_ready(const Unit&) const {}
    __device__ __forceinline__ int arow(const Unit&, int rl) const { return rl; }
    __device__ __forceinline__ const int* rows_ptr(const Unit&) const { return nullptr; }
    __device__ __forceinline__ int rows_valid(const Unit&) const { return 256; }
};
}

struct EpiProj {
    static constexpr bool PERM = true, MIDSCALE = false;
    bf16_t* O;
    __device__ __forceinline__ void operator()(const f32x4 (&acc)[2][2][4][2], const pg8::Unit& u, int wr, int wc, int fr, int fq) const {
        const int pn = u.i1;
        const int row0 = u.i0 * 256 + wr * 64 + fr;
        if (pn < 4) {
            const int col0 = pn * 128 + wc * 32 + 8 * fq;
#pragma unroll
            for (int ai = 0; ai < 2; ++ai)
#pragma unroll
                for (int m = 0; m < 4; ++m) { const f32x4 u0 = acc[ai][0][m][0], u1 = acc[ai][0][m][1], g0 = acc[ai][1][m][0], g1 = acc[ai][1][m][1];
                    u32x4 w; w.x = cvt_pk_bf16(u0[0] * sigmoidf_(g0[0]), u0[1] * sigmoidf_(g0[1])); w.y = cvt_pk_bf16(u0[2] * sigmoidf_(g0[2]), u0[3] * sigmoidf_(g0[3]));
                    w.z = cvt_pk_bf16(u1[0] * sigmoidf_(g1[0]), u1[1] * sigmoidf_(g1[1])); w.w = cvt_pk_bf16(u1[2] * sigmoidf_(g1[2]), u1[3] * sigmoidf_(g1[3]));
                    __builtin_nontemporal_store(w, (u32x4*)(O + (size_t)(row0 + ai * 128 + m * 16) * NPROJ + col0)); }
        } else {
            const int col0 = pn * 256 + wc * 32 + 8 * fq; const bool sl = pn < 6;
#pragma unroll
            for (int ai = 0; ai < 2; ++ai)
#pragma unroll
                for (int m = 0; m < 4; ++m) { bf16_t* rowp = O + (size_t)(row0 + ai * 128 + m * 16) * NPROJ + col0;
#pragma unroll
                    for (int bj = 0; bj < 2; ++bj) { f32x4 v0 = acc[ai][bj][m][0], v1 = acc[ai][bj][m][1];
                        if (sl) {
#pragma unroll
                            for (int e = 0; e < 4; ++e) { v0[e] = siluf_(v0[e]); v1[e] = siluf_(v1[e]); } }
                        u32x4 w; w.x = cvt_pk_bf16(v0[0], v0[1]); w.y = cvt_pk_bf16(v0[2], v0[3]); w.z = cvt_pk_bf16(v1[0], v1[1]); w.w = cvt_pk_bf16(v1[2], v1[3]);
                        __builtin_nontemporal_store(w, (u32x4*)(rowp + bj * 128)); } }
        }
    }
};
template <int L0> struct EpiResid {
    static constexpr bool PERM = true, MIDSCALE = true;
    const float* inc; const float* inx; bf16_t* H; const float* modl; const float* ssq;
    __device__ __forceinline__ void midscale(f32x4 (&acc)[2][2][4][2], const pg8::Unit& u, int wr, int wc, int fr, int fq) const {
        typedef float f32x2 __attribute__((ext_vector_type(2)));
        const int r0 = u.i0 * 256 + wr * 64 + fr;
        f32x2 part[2][4];
#pragma unroll
        for (int ai = 0; ai < 2; ++ai)
#pragma unroll
            for (int m = 0; m < 4; ++m) part[ai][m] = *(const f32x2*)(ssq + (size_t)(r0 + ai * 128 + m * 16) * 8 + 2 * fq);
#pragma unroll
        for (int ai = 0; ai < 2; ++ai)
#pragma unroll
            for (int m = 0; m < 4; ++m) { float sq = part[ai][m][0] + part[ai][m][1];
                sq += __shfl_xor(sq, 16); sq += __shfl_xor(sq, 32);
                const float rs = rsqrtf(sq * (1.f / 512.f) + 1e-6f);
#pragma unroll
                for (int bj = 0; bj < 2; ++bj)
#pragma unroll
                    for (int n = 0; n < 2; ++n) acc[ai][bj][m][n] *= rs; }
    }
    __device__ __forceinline__ void operator()(const f32x4 (&acc)[2][2][4][2], const pg8::Unit& u, int wr, int wc, int fr, int fq) const {
        const int r0 = u.i0 * 256;
        const int v = row_v(r0);
        const float* gate = modl + (size_t)v * 6144 + 2 * 1024;
        const float* xin = xin_ptr(inc, inx, r0);
        const int rl0 = wr * 64 + fr, col0 = u.i1 * 256 + wc * 32 + 8 * fq;
        f32x4 gv[2][2];
#pragma unroll
        for (int bj = 0; bj < 2; ++bj)
#pragma unroll
            for (int n = 0; n < 2; ++n) gv[bj][n] = *(const f32x4*)(gate + col0 + bj * 128 + 4 * n);
#pragma unroll
        for (int ai = 0; ai < 2; ++ai) {
            u32x4 hr[4][2];
#pragma unroll
            for (int m = 0; m < 4; ++m)
#pragma unroll
                for (int bj = 0; bj < 2; ++bj) hr[m][bj] = *(const u32x4*)(H + (size_t)(r0 + rl0 + ai * 128 + m * 16) * D + col0 + bj * 128);
#pragma unroll
            for (int m = 0; m < 4; ++m)
#pragma unroll
                for (int bj = 0; bj < 2; ++bj) { const u32x4 hv = hr[m][bj]; const f32x4 a0 = acc[ai][bj][m][0], a1 = acc[ai][bj][m][1]; const f32x4 g0 = gv[bj][0], g1 = gv[bj][1];
                    u32x4 w;
                    w.x = cvt_pk_bf16(bflo(hv.x) + g0[0] * a0[0], bfhi(hv.x) + g0[1] * a0[1]); w.y = cvt_pk_bf16(bflo(hv.y) + g0[2] * a0[2], bfhi(hv.y) + g0[3] * a0[3]);
                    w.z = cvt_pk_bf16(bflo(hv.z) + g1[0] * a1[0], bfhi(hv.z) + g1[1] * a1[1]); w.w = cvt_pk_bf16(bflo(hv.w) + g1[2] * a1[2], bfhi(hv.w) + g1[3] * a1[3]);
                    *(u32x4*)(H + (size_t)(r0 + rl0 + ai * 128 + m * 16) * D + col0 + bj * 128) = w; }
            asm volatile("" ::: "memory"); }
    }
};

__device__ __forceinline__ const char* uniform_ptr(const char* q) {
    const unsigned long long v = (unsigned long long)q;
    const unsigned lo = __builtin_amdgcn_readfirstlane((unsigned)v), hi = __builtin_amdgcn_readfirstlane((unsigned)(v >> 32));
    return (const char*)(((unsigned long long)hi << 32) | lo);
}
struct MoeSched {
    const LAS int* tab;
    const int* list;
    const char* A; const char* W; int mode  , l, G, c;
    unsigned* ready;
    __device__ __forceinline__ void a_ready(const pg8::Unit& u) const {
        if (mode == 0) return;
        if (threadIdx.x < 64) {
            unsigned* w = ready + u.i4; unsigned spins = 0;
            while ((unsigned)__builtin_amdgcn_readfirstlane((int)__hip_atomic_load(w, __ATOMIC_RELAXED, __HIP_MEMORY_SCOPE_AGENT)) < 32u) {
                __builtin_amdgcn_s_sleep(2); if (++spins > (1u << 22)) break; }
            __builtin_amdgcn_fence(__ATOMIC_ACQUIRE, "agent");
            asm volatile("s_waitcnt vmcnt(0)" ::: "memory");
        }
        asm volatile("" ::: "memory"); __builtin_amdgcn_s_barrier(); asm volatile("" ::: "memory");
    }
    int late;
    __device__ __forceinline__ bool get(int i, pg8::Unit& u) const {
        const int total = __builtin_amdgcn_readfirstlane(tab[24]) * 4;
        int L;
        if (mode == 0 || late == 0) L = i * G + c;
        else if (c < late) { if (i > 0) return false; L = c; }
        else L = late + (c - late) + i * (G - late);
        if (L >= total) return false;
        const int tl = L >> 2, pn = L & 3;
        int cls = 0;
#pragma unroll 1
        for (int q = 1; q < NCLS; ++q) { const int tq = __builtin_amdgcn_readfirstlane(tab[q]); if (tq <= tl) cls = q; }
        const int j = tl - __builtin_amdgcn_readfirstlane(tab[cls]), cnt = __builtin_amdgcn_readfirstlane(tab[32 + cls]);
        const int g = cls / 6, pidx = cls - g * 6;
        const int ea = (pidx >= 3) + (pidx >= 5), eb = pidx < 3 ? pidx + 1 : (pidx < 5 ? pidx - 1 : 3);
        if (mode == 0) {
            const int e = 4 * g + (pn < 2 ? ea : eb);
            u.a0 = A;
            u.b0 = W + ((size_t)(l * 16 + e) * 512 + (size_t)(pn & 1) * 256) * 1024 * 2; u.b1 = u.b0 + (size_t)8 * 128;
        } else {
            u.a0 = A + (size_t)tl * 256 * 512 * 2;
            u.b0 = W + ((size_t)(l * 16 + 4 * g + ea) * 1024 + (size_t)pn * 256) * 256 * 2;
            u.b1 = W + ((size_t)(l * 16 + 4 * g + eb) * 1024 + (size_t)pn * 256) * 256 * 2;
        }
        u.a0 = uniform_ptr(u.a0); u.b0 = uniform_ptr(u.b0); u.b1 = uniform_ptr(u.b1);
        u.i0 = cls; u.i1 = j; u.i2 = pn; u.i3 = cnt; u.i4 = tl; u.pad = 0; return true;
    }
    __device__ __forceinline__ int arow(const pg8::Unit& u, int rl) const {
        int idx = u.i1 * 256 + rl; idx = idx < u.i3 ? idx : u.i3 - 1;
        return list[(size_t)u.i0 * R + idx];
    }
    __device__ __forceinline__ const int* rows_ptr(const pg8::Unit& u) const { return list + (size_t)u.i0 * R + u.i1 * 256; }
    __device__ __forceinline__ int rows_valid(const pg8::Unit& u) const { return u.i3 - u.i1 * 256; }
};
struct EpiUp {
    static constexpr bool PERM = true, MIDSCALE = false;
    bf16_t* hid; const float* cwla; const float* cwlb; unsigned* ready;
    __device__ __forceinline__ void operator()(const f32x4 (&acc)[2][2][4][2], const pg8::Unit& u, int wr, int wc, int fr, int fq) const {
        const int cls = u.i0, j = u.i1, pn = u.i2, cnt = u.i3, tl = u.i4;
        const float* cw = (pn < 2) ? cwla : cwlb;
        const int colbase = (pn >> 1) * 256 + (pn & 1) * 128 + wc * 32 + 8 * fq;
        float wrow[2][4];
#pragma unroll
        for (int ai = 0; ai < 2; ++ai)
#pragma unroll
            for (int m = 0; m < 4; ++m) { const int idx = j * 256 + ai * 128 + wr * 64 + m * 16 + fr; wrow[ai][m] = idx < cnt ? cw[(size_t)cls * R + idx] : 0.f; }
#pragma unroll
        for (int ai = 0; ai < 2; ++ai)
#pragma unroll
            for (int m = 0; m < 4; ++m) {
                const int rl = ai * 128 + wr * 64 + m * 16 + fr; const int idx = j * 256 + rl; const bool valid = idx < cnt;
                const float w = wrow[ai][m];
                const f32x4 g0 = acc[ai][0][m][0], g1 = acc[ai][0][m][1], u0 = acc[ai][1][m][0], u1 = acc[ai][1][m][1];
                float o[8];
#pragma unroll
                for (int e = 0; e < 4; ++e) { o[e] = w * siluf_(g0[e]) * u0[e]; o[4 + e] = w * siluf_(g1[e]) * u1[e]; }
                if (!valid) {
#pragma unroll
                    for (int e = 0; e < 8; ++e) o[e] = 0.f; }
                u32x4 pk; pk.x = cvt_pk_bf16(o[0], o[1]); pk.y = cvt_pk_bf16(o[2], o[3]); pk.z = cvt_pk_bf16(o[4], o[5]); pk.w = cvt_pk_bf16(o[6], o[7]);
                { bf16_t* dstp = hid + ((size_t)tl * 256 + rl) * 512 + colbase;
                  asm volatile("global_store_dwordx4 %0, %1, off sc1\n\ts_nop 1" :: "v"(dstp), "v"(pk) : "memory"); }
            }
        asm volatile("s_waitcnt vmcnt(0)" ::: "memory");
        if ((threadIdx.x & 63) == 0) __hip_atomic_fetch_add(ready + tl, 1u, __ATOMIC_RELAXED, __HIP_MEMORY_SCOPE_AGENT);
    }
};
struct EpiDown {
    static constexpr bool PERM = true, MIDSCALE = false;
    bf16_t* H; const int* list; const LAS float* gl;
    __device__ __forceinline__ void operator()(const f32x4 (&acc)[2][2][4][2], const pg8::Unit& u, int wr, int wc, int fr, int fq) const {
        const int cls = u.i0, j = u.i1, pn = u.i2, cnt = u.i3;
        const int col0 = pn * 256 + wc * 32 + 8 * fq;
        int tok[2][4];
#pragma unroll
        for (int ai = 0; ai < 2; ++ai)
#pragma unroll
            for (int m = 0; m < 4; ++m) { const int idx = j * 256 + ai * 128 + wr * 64 + m * 16 + fr; tok[ai][m] = idx < cnt ? list[(size_t)cls * R + idx] : -1; }
        u32x4 hr[2][2][2];
#define EPD_LOAD(bt) do { _Pragma("unroll") for (int mm = 0; mm < 2; ++mm) { const int t = tok[(bt) >> 1][2 * ((bt) & 1) + mm]; const bf16_t* hp = H + (size_t)(t < 0 ? 0 : t) * D + col0; \
            _Pragma("unroll") for (int bj = 0; bj < 2; ++bj) hr[(bt) & 1][mm][bj] = *(const u32x4*)(hp + bj * 128); } } while (0)
        EPD_LOAD(0);
#pragma unroll
        for (int bt = 0; bt < 4; ++bt) { const int ai = bt >> 1, mp = bt & 1;
            if (bt + 1 < 4) EPD_LOAD(bt + 1);
#pragma unroll
            for (int mm = 0; mm < 2; ++mm) { const int m = 2 * mp + mm; const int t = tok[ai][m];
                if (t >= 0) { const LAS float* gp = gl + row_v(t) * 1024 + col0;
#pragma unroll
                    for (int bj = 0; bj < 2; ++bj) { const u32x4 hv = hr[bt & 1][mm][bj]; const f32x4 a0 = acc[ai][bj][m][0], a1 = acc[ai][bj][m][1];
                        const f32x4 g0 = *(const LAS f32x4*)(gp + bj * 128), g1 = *(const LAS f32x4*)(gp + bj * 128 + 4);
                        u32x4 w;
                        w.x = cvt_pk_bf16(bflo(hv.x) + g0[0] * a0[0], bfhi(hv.x) + g0[1] * a0[1]); w.y = cvt_pk_bf16(bflo(hv.y) + g0[2] * a0[2], bfhi(hv.y) + g0[3] * a0[3]);
                        w.z = cvt_pk_bf16(bflo(hv.z) + g1[0] * a1[0], bfhi(hv.z) + g1[1] * a1[1]); w.w = cvt_pk_bf16(bflo(hv.w) + g1[2] * a1[2], bfhi(hv.w) + g1[3] * a1[3]);
                        *(u32x4*)(H + (size_t)t * D + col0 + bj * 128) = w; } } }
            asm volatile("" ::: "memory"); }
#undef EPD_LOAD
    }
};

__device__ __forceinline__ void tr_tile(const float* src, int ldn, int k0, int n0, int nvalid, bf16_t* dst, int ldk, int drow0, LAS float* tile, int kd0 = -1, const float* kscale = nullptr) {
    const int tid = launder_tid();
    if (kd0 < 0) kd0 = k0;
    { const int n = tid & 63; const int kq = tid >> 6; float tv[8], ts[8];
#pragma unroll
      for (int it = 0; it < 8; ++it) { const int kk = kq + 8 * it; tv[it] = (n < nvalid) ? src[(size_t)(k0 + kk) * ldn + n0 + n] : 0.f; ts[it] = kscale ? kscale[kk] : 1.f; }
#pragma unroll
      for (int it = 0; it < 8; ++it) tile[(kq + 8 * it) * 65 + n] = tv[it] * ts[it]; }
    __syncthreads();
    { const int k8 = tid & 7, n = tid >> 3;
      if (n < nvalid) { const LAS float* s = tile + (k8 * 8) * 65 + n;
          u32x4 o; o.x = cvt_pk_bf16(s[0], s[65]); o.y = cvt_pk_bf16(s[2 * 65], s[3 * 65]); o.z = cvt_pk_bf16(s[4 * 65], s[5 * 65]); o.w = cvt_pk_bf16(s[6 * 65], s[7 * 65]);
          *(u32x4*)(dst + (size_t)(drow0 + n) * ldk + kd0 + k8 * 8) = o; } }
    __syncthreads();
}
constexpr int WPREP_ITEMS_PER_LAYER = 16 * 41 + 256 + 1024 + 1024 + 1024;
__device__ __forceinline__ void phase_wprep(CP p, unsigned char* lds, int it0, int it1, int bidx, int nblk, int b0 = 0, int b1 = 0, int c0 = 0, int c1 = 0) {
    LAS float* tile = (LAS float*)(LAS unsigned char*)lds;
    constexpr int I_IN = 16 * 41, I_OUT = 256, I_G = 1024, I_U = 1024, I_D = 1024, I_L = I_IN + I_OUT + I_G + I_U + I_D;
    const int na = it1 - it0, nbb = b1 - b0, ncc = c1 - c0;
    for (int vi = bidx; vi < na + nbb + ncc; vi += nblk) {
        const int it = vi < na ? it0 + vi : (vi < na + nbb ? b0 + (vi - na) : c0 + (vi - na - nbb));
        const int l = it / I_L; int r = it - l * I_L;
        if (r < I_IN) { const int kt = r / 41, ntl = r % 41; const int n0 = ntl * 64; const int nv = (DIN - n0) < 64 ? (DIN - n0) : 64;
            const int dr = n0 < 512 ? (n0 >> 7) * 256 + (n0 & 127) : (n0 < 1024 ? ((n0 - 512) >> 7) * 256 + 128 + ((n0 - 512) & 127) : n0);
            tr_tile(p->w_in + (size_t)l * 1024 * DIN, DIN, kt * 64, n0, nv, (bf16_t*)(p->ws + WS_WTIN) + (size_t)l * DIN * 1024, 1024, dr, tile); continue; }
        r -= I_IN;
        if (r < I_OUT) { const int kt = r >> 4, ntl = r & 15;
            tr_tile(p->w_out + (size_t)l * 1024 * 1024, 1024, kt * 64, ntl * 64, 64, (bf16_t*)(p->ws + WS_WTOUT) + (size_t)l * 1024 * 1024, 1024, ntl * 64, tile,
                    (kt * 64 + 512) & 1023, kt >= 8 ? p->ssd_norm_g + l * 512 + (kt * 64 - 512) : nullptr); continue; }
        r -= I_OUT;
        if (r < I_G + I_U) { const int up = r >= I_G; if (up) r -= I_G; const int e = r >> 6, q = r & 63, kt = q >> 2, ntl = q & 3; const int n0 = ntl * 64;
            const float* src = (up ? p->w_up : p->w_gate) + (size_t)(l * 16 + e) * 1024 * 256;
            tr_tile(src, 256, kt * 64, n0, 64, (bf16_t*)(p->ws + WS_WTGU) + (size_t)(l * 16 + e) * 512 * 1024, 1024, (n0 >> 7) * 256 + (n0 & 127) + (up ? 128 : 0), tile); continue; }
        r -= I_G + I_U;
        { const int e = r >> 6, q = r & 63, kt = q >> 4, ntl = q & 15;
          tr_tile(p->w_down + (size_t)(l * 16 + e) * 256 * 1024, 1024, kt * 64, ntl * 64, 64, (bf16_t*)(p->ws + WS_WTD) + (size_t)(l * 16 + e) * 1024 * 256, 256, ntl * 64, tile); }
    }
}
__device__ __forceinline__ void phase_adaln(CP p, unsigned char* lds, int bid, int nb) {
    LAS float* sc = (LAS float*)(LAS unsigned char*)lds;
    LAS float* red = sc + 3 * 1024;
    const int tid = launder_tid();
    for (int idx = tid; idx < 3 * 1024; idx += NTHREADS) { const int v = idx >> 10, k = idx & 1023; const float cv = (v < 2) ? p->c[v * 1024 + k] : p->c_ctx[k]; sc[idx] = siluf_(cv); }
    __syncthreads();
    float* mod = (float*)(p->ws + WS_MOD);
    for (int it = bid; it < 2 * 96; it += nb) {
        const int l = it / 96, n0 = (it % 96) * 64;
        const int c4 = tid & 15, kr = tid >> 4;
        f32x4 a0 = {0, 0, 0, 0}, a1 = {0, 0, 0, 0}, a2 = {0, 0, 0, 0};
        const float* w = p->w_ada + (size_t)l * 1024 * 6144 + n0 + c4 * 4;
#pragma unroll 4
        for (int k = kr; k < 1024; k += 32) { const f32x4 w4 = *(const f32x4*)(w + (size_t)k * 6144); a0 += sc[k] * w4; a1 += sc[1024 + k] * w4; a2 += sc[2048 + k] * w4; }
        *(LAS f32x4*)(red + (kr * 3 + 0) * 64 + c4 * 4) = a0; *(LAS f32x4*)(red + (kr * 3 + 1) * 64 + c4 * 4) = a1; *(LAS f32x4*)(red + (kr * 3 + 2) * 64 + c4 * 4) = a2;
        __syncthreads();
        if (tid < 192) { const int v = tid >> 6, cc = tid & 63; float s = 0.f;
            for (int q = 0; q < 32; ++q) s += red[(q * 3 + v) * 64 + cc];
            mod[((size_t)l * 3 + v) * 6144 + n0 + cc] = s + p->b_ada[l * 6144 + n0 + cc]; }
        __syncthreads();
    }
}
__device__ __forceinline__ void moe_table(CP p, int l, LAS int* tab) {
    const int* gcount = (const int*)(p->ws + WS_CTL) + l * 32;
    if (threadIdx.x == 0) { int acc = 0; for (int q = 0; q < NCLS; ++q) { const int cn = gcount[q]; tab[q] = acc; tab[32 + q] = cn; acc += (cn + 255) >> 8; } tab[24] = acc; }
    __syncthreads();
}
typedef _Float16 f16x8 __attribute__((ext_vector_type(8)));
typedef _Float16 f16x2 __attribute__((ext_vector_type(2)));
constexpr int ST_H16 = 2064;
__device__ __forceinline__ unsigned pack_f16(float a, float b) { f16x2 h; h[0] = (_Float16)a; h[1] = (_Float16)b; return __builtin_bit_cast(unsigned, h); }
__device__ __forceinline__ void phase_r1(CP p, int l, unsigned char* lds_, int bid, int nb) {
    LAS unsigned char* lds = (LAS unsigned char*)lds_;
    LAS unsigned char* Wh = lds;
    LAS unsigned char* Xh = Wh + 16 * ST_H16;
    LAS float* gm = (LAS float*)(Xh + 16 * ST_H16);
    LAS float* sh = gm + 3 * 1024;
    LAS float* part = sh + 3 * 1024;
    const int tid = launder_tid(); const int lane = tid & 63, wave = __builtin_amdgcn_readfirstlane(tid >> 6);
    const float* mod = (const float*)(p->ws + WS_MOD) + (size_t)l * 3 * 6144;
    const float* win = p->w_in + (size_t)l * 1024 * DIN;
#pragma unroll
    for (int hb = 0; hb < 2; ++hb) { float tmp[16];
#pragma unroll
        for (int it = 0; it < 16; ++it) { const int idx = tid + NTHREADS * (16 * hb + it); tmp[it] = win[(size_t)(idx >> 4) * DIN + NPROJ + (idx & 15)]; }
#pragma unroll
        for (int it = 0; it < 16; ++it) { const int idx = tid + NTHREADS * (16 * hb + it); *(LAS _Float16*)(Wh + (idx & 15) * ST_H16 + (idx >> 4) * 2) = (_Float16)tmp[it]; } }
    { float t0[6], t1[6], t2[6];
#pragma unroll
      for (int it = 0; it < 6; ++it) { const int idx = tid + NTHREADS * it; const int v = idx >> 10, k = idx & 1023; t0[it] = p->g_mix[l * 1024 + k]; t1[it] = mod[v * 6144 + 1024 + k]; t2[it] = mod[v * 6144 + k]; }
#pragma unroll
      for (int it = 0; it < 6; ++it) { const int idx = tid + NTHREADS * it; gm[idx] = t0[it] * (1.f + t1[it]); sh[idx] = t2[it]; } }
    __syncthreads();
    bf16_t* HX = (bf16_t*)(p->ws + WS_HX); float* DT = (float*)(p->ws + WS_DT);
    const int rpb = (R + nb - 1) / nb, r0 = bid * rpb, r1 = (r0 + rpb) < R ? (r0 + rpb) : R;
    RowRaw xn[2];
#pragma unroll
    for (int q = 0; q < 2; ++q) if (r0 + 2 * wave + q < r1) row_load(p, l, r0 + 2 * wave + q, lane, xn[q]);
#pragma unroll 1
    for (int t0r = r0; t0r < r1; t0r += 16) {
        f32x4 xv[2][4];
#pragma unroll
        for (int q = 0; q < 2; ++q) row_cvt(l, xn[q], xv[q]);
#pragma unroll
        for (int q = 0; q < 2; ++q) if (t0r + 16 + 2 * wave + q < r1) row_load(p, l, t0r + 16 + 2 * wave + q, lane, xn[q]);
#pragma unroll
        for (int q = 0; q < 2; ++q) { const int rr = t0r + 2 * wave + q; const bool ok = rr < r1; const int v = row_v(ok ? rr : r0);
            if (l == 0 && ok) { u32x2* hw = (u32x2*)((bf16_t*)(p->ws + WS_H) + (size_t)rr * D);
#pragma unroll
                for (int j = 0; j < 4; ++j) { u32x2 o; o.x = cvt_pk_bf16(xv[q][j][0], xv[q][j][1]); o.y = cvt_pk_bf16(xv[q][j][2], xv[q][j][3]); hw[lane + 64 * j] = o; } }
            float ss = 0.f;
#pragma unroll
            for (int j = 0; j < 4; ++j) ss += xv[q][j][0] * xv[q][j][0] + xv[q][j][1] * xv[q][j][1] + xv[q][j][2] * xv[q][j][2] + xv[q][j][3] * xv[q][j][3];
            ss = wave_sum(ss); const float rs = ok ? __builtin_amdgcn_rsqf(ss * (1.f / 1024.f) + 1e-6f) : 0.f;
#pragma unroll
            for (int j = 0; j < 4; ++j) { const int k = 4 * lane + 256 * j; const f32x4 g4 = *(const LAS f32x4*)(gm + v * 1024 + k), s4 = *(const LAS f32x4*)(sh + v * 1024 + k);
                f32x4 hv = xv[q][j] * rs * g4 + s4; if (!ok) hv = hv * 0.f;
                u32x2 o; o.x = cvt_pk_bf16(hv[0], hv[1]); o.y = cvt_pk_bf16(hv[2], hv[3]);
                if (ok) *(u32x2*)(HX + (size_t)rr * 1024 + k) = o;
                u32x2 h16; h16.x = pack_f16(hv[0], hv[1]); h16.y = pack_f16(hv[2], hv[3]);
                *(LAS u32x2*)(Xh + (2 * wave + q) * ST_H16 + k * 2) = h16; } }
        __syncthreads();
        {
            f32x4 acc0 = {0.f, 0.f, 0.f, 0.f};
#pragma unroll
            for (int s4 = 0; s4 < 4; ++s4) { const int kb = (128 * wave + 32 * s4 + 8 * (lane >> 4)) * 2;
                const f16x8 a = *(const LAS f16x8*)(Xh + (lane & 15) * ST_H16 + kb);
                const f16x8 b0 = *(const LAS f16x8*)(Wh + (lane & 15) * ST_H16 + kb);
                acc0 = __builtin_amdgcn_mfma_f32_16x16x32_f16(a, b0, acc0, 0, 0, 0); }
#pragma unroll
            for (int e = 0; e < 4; ++e) part[(wave * 16 + 4 * (lane >> 4) + e) * 16 + (lane & 15)] = acc0[e];
        }
        __syncthreads();
        if (tid < 256) { const int row = tid >> 4, n = tid & 15; const int rr = t0r + row;
            float sacc = p->dt_bias[l * 16 + n];
#pragma unroll
            for (int w = 0; w < 8; ++w) sacc += part[(w * 16 + row) * 16 + n];
            if (rr < r1) DT[(size_t)n * R + rr] = softplusf_(sacc); }
    }
    __syncthreads();
}
typedef float f32x16 __attribute__((ext_vector_type(16)));
typedef short s16x4 __attribute__((ext_vector_type(4)));
constexpr int ST_ROW = 272;
constexpr int ST_TR128 = 320;
constexpr int ST_TR64 = 192;
constexpr int ST_MT = 328;
constexpr int NCHUNK = SEG / 128;

#define DPP_MOV(v, ctrl, rm, bm) __builtin_bit_cast(float, __builtin_amdgcn_update_dpp(0, __builtin_bit_cast(int, (v)), (ctrl), (rm), (bm), true))
__device__ __forceinline__ float wave_incl_scan(float v, int) {
    float s = v + DPP_MOV(v, 0x111, 0xF, 0xF) + DPP_MOV(v, 0x112, 0xF, 0xF) + DPP_MOV(v, 0x113, 0xF, 0xF);
    s += DPP_MOV(s, 0x114, 0xF, 0xE);
    s += DPP_MOV(s, 0x118, 0xF, 0xC);
    s += DPP_MOV(s, 0x142, 0xA, 0xF);
    s += DPP_MOV(s, 0x143, 0xC, 0xF);
    return s;
}
__device__ __forceinline__ bf16x8 row_frag(const LAS unsigned char* tile, int stride, int row0, int k0, int lane) {
    return *(const LAS bf16x8*)(tile + (row0 + (lane & 31)) * stride + (k0 + 8 * (lane >> 5)) * 2);
}
__device__ __forceinline__ bf16x8 tr_frag(const LAS unsigned char* tile, int stride, int k0, int c0, int lane) {
    const int g = lane >> 4, li = lane & 15, q = li >> 2, pp = li & 3;
    const LAS unsigned char* a0 = tile + (k0 + 8 * (g >> 1) + q) * stride + (c0 + 16 * (g & 1) + 4 * pp) * 2;
    const s16x4 lo = __builtin_amdgcn_ds_read_tr16_b64_v4i16((LAS s16x4*)a0);
    const s16x4 hi = __builtin_amdgcn_ds_read_tr16_b64_v4i16((LAS s16x4*)(a0 + 4 * stride));
    return __builtin_shufflevector(lo, hi, 0, 1, 2, 3, 4, 5, 6, 7);
}
__device__ __forceinline__ u32x4 pack8(const float (&v)[8]) { u32x4 r; r.x = cvt_pk_bf16(v[0], v[1]); r.y = cvt_pk_bf16(v[2], v[3]); r.z = cvt_pk_bf16(v[4], v[5]); r.w = cvt_pk_bf16(v[6], v[7]); return r; }
__device__ __forceinline__ u32x4 pack8s(const float (&v)[8], float sc) { u32x4 r; r.x = cvt_pk_bf16(v[0] * sc, v[1] * sc); r.y = cvt_pk_bf16(v[2] * sc, v[3] * sc); r.z = cvt_pk_bf16(v[4] * sc, v[5] * sc); r.w = cvt_pk_bf16(v[6] * sc, v[7] * sc); return r; }

__device__ __forceinline__ void conv_load(const bf16_t* proj, int row0, int rq, int xch, bool lo_ok, bool hi_ok, u32x4 (&raw)[8]) {
    const bf16_t* base = proj + (size_t)(row0 + 4 * rq) * NPROJ + 1536 + xch;
    const bool okl = (rq > 0) || lo_ok, okh = (rq < 31) || hi_ok;
#pragma unroll
    for (int j = 0; j < 8; ++j) raw[j] = *(const u32x4*)((j < 2 ? okl : (j >= 6 ? okh : true)) ? base + (j - 2) * NPROJ : base);
}
__device__ __forceinline__ void conv_compute(const u32x4 (&raw)[8], const LAS float* wl, int nchl, int wch, float (&o)[4][8], bool zl = false, bool zh = false) {
    float w[5][8], bs[8];
#pragma unroll
    for (int j = 0; j < 5; ++j) { const f32x4 w0 = *(const LAS f32x4*)(wl + j * nchl + wch), w1 = *(const LAS f32x4*)(wl + j * nchl + wch + 4);
        w[j][0] = w0[0]; w[j][1] = w0[1]; w[j][2] = w0[2]; w[j][3] = w0[3]; w[j][4] = w1[0]; w[j][5] = w1[1]; w[j][6] = w1[2]; w[j][7] = w1[3]; }
    { const f32x4 b0 = *(const LAS f32x4*)(wl + 5 * nchl + wch), b1 = *(const LAS f32x4*)(wl + 5 * nchl + wch + 4); bs[0] = b0[0]; bs[1] = b0[1]; bs[2] = b0[2]; bs[3] = b0[3]; bs[4] = b1[0]; bs[5] = b1[1]; bs[6] = b1[2]; bs[7] = b1[3]; }
#pragma unroll
    for (int i = 0; i < 4; ++i)
#pragma unroll
        for (int e = 0; e < 8; ++e) o[i][e] = bs[e];
    const float fl = zl ? 0.f : 1.f, fh = zh ? 0.f : 1.f;
#pragma unroll
    for (int j = 0; j < 8; ++j) {
        float xv[8] = {bflo(raw[j].x), bfhi(raw[j].x), bflo(raw[j].y), bfhi(raw[j].y), bflo(raw[j].z), bfhi(raw[j].z), bflo(raw[j].w), bfhi(raw[j].w)};
        if (j < 2) {
#pragma unroll
            for (int e = 0; e < 8; ++e) xv[e] *= fl; }
        if (j >= 6) {
#pragma unroll
            for (int e = 0; e < 8; ++e) xv[e] *= fh; }
#pragma unroll
        for (int i = 0; i < 4; ++i) { const int tap = j - i; if (tap >= 0 && tap < 5) {
#pragma unroll
                for (int e = 0; e < 8; ++e) o[i][e] += w[tap][e] * xv[e]; } }
    }
#pragma unroll
    for (int i = 0; i < 4; ++i)
#pragma unroll
        for (int e = 0; e < 8; ++e) o[i][e] = siluf_(o[i][e]);
}
__device__ __forceinline__ void conv_load4(const bf16_t* proj, int row0, int rq, int xch, bool lo_ok, bool hi_ok, u32x2 (&raw)[8]) {
    const bf16_t* base = proj + (size_t)(row0 + 4 * rq) * NPROJ + 1536 + xch;
    const bool okl = (rq > 0) || lo_ok, okh = (rq < 31) || hi_ok;
#pragma unroll
    for (int j = 0; j < 8; ++j) raw[j] = *(const u32x2*)((j < 2 ? okl : (j >= 6 ? okh : true)) ? base + (j - 2) * NPROJ : base);
}
__device__ __forceinline__ void conv_compute4(const u32x2 (&raw)[8], const LAS float* wl, int nchl, int wch, float (&o)[4][4], bool zl, bool zh) {
    f32x4 w[5];
#pragma unroll
    for (int j = 0; j < 5; ++j) w[j] = *(const LAS f32x4*)(wl + j * nchl + wch);
    const f32x4 bs = *(const LAS f32x4*)(wl + 5 * nchl + wch);
#pragma unroll
    for (int i = 0; i < 4; ++i)
#pragma unroll
        for (int e = 0; e < 4; ++e) o[i][e] = bs[e];
    const float fl = zl ? 0.f : 1.f, fh = zh ? 0.f : 1.f;
#pragma unroll
    for (int j = 0; j < 8; ++j) {
        float xv[4] = {bflo(raw[j].x), bfhi(raw[j].x), bflo(raw[j].y), bfhi(raw[j].y)};
        if (j < 2) {
#pragma unroll
            for (int e = 0; e < 4; ++e) xv[e] *= fl; }
        if (j >= 6) {
#pragma unroll
            for (int e = 0; e < 4; ++e) xv[e] *= fh; }
#pragma unroll
        for (int i = 0; i < 4; ++i) { const int tap = j - i; if (tap >= 0 && tap < 5) {
#pragma unroll
                for (int e = 0; e < 4; ++e) o[i][e] += w[tap][e] * xv[e]; } }
    }
#pragma unroll
    for (int i = 0; i < 4; ++i)
#pragma unroll
        for (int e = 0; e < 4; ++e) o[i][e] = siluf_(o[i][e]);
}
__device__ __forceinline__ void head_cums(CP p, int l, int row0, int h, int dir, int lane, LAS float* hv, const LAS float* atab) {
    const float A = atab[dir * 8 + h];
    const float* DT = (const float*)(p->ws + WS_DT);
    typedef float f32x2 __attribute__((ext_vector_type(2)));
    const f32x2 dd = *(const f32x2*)(DT + (size_t)(dir * 8 + h) * R + row0 + 2 * lane); const float d0 = dd[0], d1 = dd[1];
    const float x0 = d0 * A, x1 = d1 * A;
    const float incl = wave_incl_scan(x0 + x1, lane);
    const float total = __builtin_bit_cast(float, __builtin_amdgcn_readlane(__builtin_bit_cast(int, incl), 63));
    float c0, c1;
    if (dir == 0) { c1 = incl; c0 = incl - x1; } else { c0 = total - (incl - x1 - x0); c1 = total - (incl - x1); }
    hv[dir * 128 + 2 * lane] = c0; hv[dir * 128 + 2 * lane + 1] = c1;
    hv[256 + dir * 128 + 2 * lane] = d0; hv[256 + dir * 128 + 2 * lane + 1] = d1;
    if (lane == 0) hv[512 + dir] = total;
}
__device__ __forceinline__ bf16x8 scale_frag(bf16x8 f, const f32x4 w0, const f32x4 w1) {
    const u32x4 u = __builtin_bit_cast(u32x4, f);
    u32x4 r;
    r.x = cvt_pk_bf16(bflo(u.x) * w0[0], bfhi(u.x) * w0[1]); r.y = cvt_pk_bf16(bflo(u.y) * w0[2], bfhi(u.y) * w0[3]);
    r.z = cvt_pk_bf16(bflo(u.z) * w1[0], bfhi(u.z) * w1[1]); r.w = cvt_pk_bf16(bflo(u.w) * w1[2], bfhi(u.w) * w1[3]);
    return __builtin_bit_cast(bf16x8, r);
}
constexpr int ST_X256 = 576;

__device__ __forceinline__ void phase_c1(CP p, int l, unsigned char* lds_, int bid, int nb) {
    LAS unsigned char* lds = (LAS unsigned char*)lds_;
    LAS unsigned char* tile = lds;
    LAS float* wl = (LAS float*)(lds + 73216);
    const int tid = launder_tid();
    const bf16_t* proj = (const bf16_t*)(p->ws + WS_PROJ); bf16_t* mix = (bf16_t*)(p->ws + WS_HX);
    const int NU = 256 + 512 + (l == DEPTH - 1 ? 0 : 16);
    const int heavy = (nb > 64 && (NB * NCHUNK * 2) % nb < nb / 4) ? (NB * NCHUNK * 2) % nb : 0;
    const int ustart = bid < heavy ? NU : (bid - heavy), ustep = nb - heavy;
#pragma unroll 1
    for (int u = ustart; u < NU; u += ustep) {
        int S, LEN, LSH, pstride, sstride, tok0, ch0;
        if (u < 256) { const int b = u >> 7, cs = (u >> 2) & 31, cc = u & 3; S = 2; LEN = 256; LSH = 8; pstride = 64; sstride = 1; tok0 = b * SEG + CTXL + 2 * cs; ch0 = 256 + 64 * cc; }
        else if (u < 768) { const int v = u - 256; const int b = v >> 8, rg = (v >> 2) & 63, cc = v & 3; S = 4; LEN = 64; LSH = 6; pstride = 1; sstride = 64; tok0 = b * SEG + CTXL + 256 * rg; ch0 = 64 * cc; }
        else { const int v = u - 768; const int b = v >> 3, cc = v & 7; S = 1; LEN = 256; LSH = 8; pstride = 1; sstride = 0; tok0 = b * SEG; ch0 = 64 * cc; }
        const int LP = LEN + 30;
        { float tw[4];
#pragma unroll
          for (int it = 0; it < 4; ++it) { const int i = tid + NTHREADS * it; const int j = i >> 6, c = i & 63; tw[it] = j < 31 ? p->conv_w[((size_t)l * 31 + j) * 512 + ch0 + c] : p->conv_b[l * 512 + ch0 + c]; }
#pragma unroll
          for (int it = 0; it < 4; ++it) wl[tid + NTHREADS * it] = tw[it]; }
        for (int i = tid; i < S * 30 * 8; i += NTHREADS) { const int pc = i & 7, q = (i >> 3) % 30, sq = (i >> 3) / 30; const int pos = q < 15 ? q : LEN + q;
            unsigned zz; asm volatile("v_mov_b32 %0, 0" : "=v"(zz));
            *(LAS u32x4*)(tile + ((sq * LP + pos) * 64 + pc * 8) * 2) = (u32x4){zz, zz, zz, zz}; }
        for (int ib = 0; ib < S * LEN * 8; ib += 4 * NTHREADS) {
            u32x4 uv[4];
#pragma unroll
            for (int q = 0; q < 4; ++q) { const int i = ib + tid + NTHREADS * q; const int pc = i & 7, t = i >> 3; const int sq = t >> LSH, pos = t & (LEN - 1);
                const bf16_t* src = proj + (size_t)(tok0 + sq * sstride + pos * pstride) * NPROJ + ch0 + pc * 8;
                uv[q] = __builtin_nontemporal_load((const u32x4*)src); }
#pragma unroll
            for (int q = 0; q < 4; ++q) { const int i = ib + tid + NTHREADS * q; const int pc = i & 7, t = i >> 3; const int sq = t >> LSH, pos = t & (LEN - 1);
                const u32x4 o = uv[q];
                *(LAS u32x4*)(tile + ((sq * LP + 15 + pos) * 64 + pc * 8) * 2) = o; }
        }
        __syncthreads();
        const int noct = S * LEN / 8;
#pragma unroll 1
        for (int it = tid; it < noct * 32; it += NTHREADS) {
            const int cp = it & 31, oc = it >> 5; const int sq = oc >> (LSH - 3), p0 = (oc & ((LEN >> 3) - 1)) * 8;
            const LAS unsigned* base = (const LAS unsigned*)(tile + ((sq * LP + p0) * 64) * 2) + cp;
            float i0[38], i1[38];
#pragma unroll
            for (int k = 0; k < 38; ++k) { const unsigned w = base[k * 32]; i0[k] = bflo(w); i1[k] = bfhi(w); }
            float a0[8], a1[8];
            { const float b0 = wl[31 * 64 + 2 * cp], b1 = wl[31 * 64 + 2 * cp + 1];
#pragma unroll
              for (int i = 0; i < 8; ++i) { a0[i] = b0; a1[i] = b1; } }
#pragma unroll
            for (int j = 0; j < 31; ++j) { typedef float f32x2 __attribute__((ext_vector_type(2))); const f32x2 wj = *(const LAS f32x2*)(wl + j * 64 + 2 * cp); const float w0 = wj[0], w1 = wj[1];
#pragma unroll
                for (int i = 0; i < 8; ++i) { a0[i] += w0 * i0[i + j]; a1[i] += w1 * i1[i + j]; } }
#pragma unroll
            for (int i = 0; i < 8; ++i) { const int tok = tok0 + sq * sstride + (p0 + i) * pstride;
                *(unsigned*)(mix + (size_t)tok * 1024 + 512 + ch0 + 2 * cp) = cvt_pk_bf16(a0[i], a1[i]); }
        }
        __syncthreads();
    }
}
__device__ __forceinline__ void phase_c1_ln(CP p, int l, int bid, int nb) {
    const int tid = launder_tid(); const int lane = tid & 63, wave = tid >> 6;
    bf16_t* mix = (bf16_t*)(p->ws + WS_HX);
    const f32x4 g0 = *(const f32x4*)(p->conv_ln_g + l * 512 + lane * 8), g1 = *(const f32x4*)(p->conv_ln_g + l * 512 + lane * 8 + 4);
    const f32x4 b0 = *(const f32x4*)(p->conv_ln_b + l * 512 + lane * 8), b1 = *(const f32x4*)(p->conv_ln_b + l * 512 + lane * 8 + 4);
    const float gg[8] = {g0[0], g0[1], g0[2], g0[3], g1[0], g1[1], g1[2], g1[3]}, bb[8] = {b0[0], b0[1], b0[2], b0[3], b1[0], b1[1], b1[2], b1[3]};
    u32x4 vn = {0u, 0u, 0u, 0u};
    if (bid * 8 + wave < R) vn = *(const u32x4*)(mix + (size_t)(bid * 8 + wave) * 1024 + 512 + lane * 8);
    for (int r = bid * 8 + wave; r < R; r += nb * 8) {
        u32x4* ptr = (u32x4*)(mix + (size_t)r * 1024 + 512 + lane * 8);
        const u32x4 v = vn;
        if (r + nb * 8 < R) vn = *(const u32x4*)(mix + (size_t)(r + nb * 8) * 1024 + 512 + lane * 8);
        float y[8] = {bflo(v.x), bfhi(v.x), bflo(v.y), bfhi(v.y), bflo(v.z), bfhi(v.z), bflo(v.w), bfhi(v.w)};
        float s = 0.f;
#pragma unroll
        for (int e = 0; e < 8; ++e) s += y[e];
        const float mu = wave_sum(s) * (1.f / 512.f);
        float q = 0.f;
#pragma unroll
        for (int e = 0; e < 8; ++e) { y[e] -= mu; q += y[e] * y[e]; }
        const float rstd = rsqrtf(wave_sum(q) * (1.f / 512.f) + 1e-5f);
        float o[8];
#pragma unroll
        for (int e = 0; e < 8; ++e) o[e] = siluf_(y[e] * rstd * gg[e] + bb[e]);
        *ptr = pack8(o);
    }
}
__device__ __forceinline__ void phase_s1(CP p, int l, unsigned char* lds_, int bid, int nb) {
    LAS unsigned char* lds = (LAS unsigned char*)lds_;
    LAS unsigned char* Bs = lds;
    LAS unsigned char* Xs = lds + 128 * ST_TR128;
    LAS float* wv = (LAS float*)(Xs + 128 * ST_X256);
    LAS float* hvs = wv + 8 * 128;
    LAS float* cwl = hvs + 4 * 520;
    LAS float* atab = cwl + 6 * 384;
    const int tid = launder_tid(); const int lane = tid & 63, wave = __builtin_amdgcn_readfirstlane(tid >> 6);
    const bf16_t* proj = (const bf16_t*)(p->ws + WS_PROJ);
    const float* cw = p->ssd_conv_w + (size_t)l * 5 * 1024; const float* cbias = p->ssd_conv_b + (size_t)l * 1024;
    bf16_t* Sg = (bf16_t*)(p->ws + WS_S); float* DEC = (float*)(p->ws + WS_DEC);
    if (tid < 16) atab[tid] = -expf(p->a_log[l * 16 + tid]);
    __syncthreads();
    int cur_g = -1;
#pragma unroll 1
    for (int u = bid; u < NB * NCHUNK * 2; u += nb) {
        const int g = u & 1, c = (u >> 1) % NCHUNK, b = (u >> 1) / NCHUNK;
        const int row0 = b * SEG + c * 128;
        const bool lo_ok = !(c == 0 || c == 2), hi_ok = !(c == 1 || c == NCHUNK - 1);
        if (g != cur_g) { cur_g = g;
            float tw[5];
#pragma unroll
            for (int it = 0; it < 5; ++it) { const int i = tid + NTHREADS * it; const int j = i / 384, lc = i - j * 384; const int gch = lc < 128 ? 512 + g * 128 + lc : g * 256 + (lc - 128);
                tw[it] = i < 6 * 384 ? (j < 5 ? cw[j * 1024 + gch] : cbias[gch]) : 0.f; }
#pragma unroll
            for (int it = 0; it < 5; ++it) { const int i = tid + NTHREADS * it; if (i < 6 * 384) cwl[i] = tw[it]; } }
        const int hh = wave >> 1, dir = wave & 1, h = 4 * g + hh;
        u32x4 rb[8], rx0[8], rx1[8];
        conv_load(proj, row0, tid >> 4, 512 + g * 128 + (tid & 15) * 8, lo_ok, hi_ok, rb);
        conv_load(proj, row0, tid >> 5, g * 256 + (tid & 31) * 8, lo_ok, hi_ok, rx0);
        conv_load(proj, row0, (tid >> 5) + 16, g * 256 + (tid & 31) * 8, lo_ok, hi_ok, rx1);
        head_cums(p, l, row0, h, dir, lane, hvs + hh * 520, atab);
        __syncthreads();
        {
            const LAS float* hv = hvs + hh * 520; const float tot = hv[512 + dir];
#pragma unroll
            for (int q = 0; q < 2; ++q) { const int lr = lane + 64 * q; wv[wave * 128 + lr] = __expf(tot - hv[dir * 128 + lr]) * hv[256 + dir * 128 + lr]; }
            if (lane == 0) DEC[((size_t)(b * 2 + dir) * NCHUNK + c) * 8 + h] = __expf(tot);
        }
        { float o[4][8];
          conv_compute(rb, cwl, 384, (tid & 15) * 8, o, (tid >> 4) == 0 && !lo_ok, (tid >> 4) == 31 && !hi_ok);
#pragma unroll
          for (int i = 0; i < 4; ++i) *(LAS u32x4*)(Bs + (4 * (tid >> 4) + i) * ST_TR128 + (tid & 15) * 16) = pack8(o[i]);
          conv_compute(rx0, cwl, 384, 128 + (tid & 31) * 8, o, (tid >> 5) == 0 && !lo_ok, false);
#pragma unroll
          for (int i = 0; i < 4; ++i) *(LAS u32x4*)(Xs + (4 * (tid >> 5) + i) * ST_X256 + (tid & 31) * 16) = pack8(o[i]);
          conv_compute(rx1, cwl, 384, 128 + (tid & 31) * 8, o, false, (tid >> 5) == 15 && !hi_ok);
#pragma unroll
          for (int i = 0; i < 4; ++i) *(LAS u32x4*)(Xs + (4 * ((tid >> 5) + 16) + i) * ST_X256 + (tid & 31) * 16) = pack8(o[i]); }
        __syncthreads();
        {
            f32x16 acc[2][4];
#pragma unroll
            for (int t = 0; t < 2; ++t)
#pragma unroll
                for (int q = 0; q < 4; ++q)
#pragma unroll
                    for (int e = 0; e < 16; ++e) acc[t][q][e] = 0.f;
            {
                bf16x8 ar[2][2], br[2][4];
#pragma unroll
                for (int t = 0; t < 2; ++t) ar[0][t] = tr_frag(Xs, ST_X256, 0, hh * 64 + 32 * t, lane);
#pragma unroll
                for (int q = 0; q < 4; ++q) br[0][q] = tr_frag(Bs, ST_TR128, 0, 32 * q, lane);
#pragma unroll 2
                for (int kk = 0; kk < 8; ++kk) { const int c_ = kk & 1, n_ = c_ ^ 1;
                    const LAS float* wp = wv + wave * 128 + 16 * kk + 8 * (lane >> 5);
                    const f32x4 w0 = *(const LAS f32x4*)wp, w1 = *(const LAS f32x4*)(wp + 4);
                    if (kk < 7) {
#pragma unroll
                        for (int t = 0; t < 2; ++t) ar[n_][t] = tr_frag(Xs, ST_X256, 16 * (kk + 1), hh * 64 + 32 * t, lane);
#pragma unroll
                        for (int q = 0; q < 4; ++q) br[n_][q] = tr_frag(Bs, ST_TR128, 16 * (kk + 1), 32 * q, lane); }
                    bf16x8 af[2];
#pragma unroll
                    for (int t = 0; t < 2; ++t) af[t] = scale_frag(ar[c_][t], w0, w1);
#pragma unroll
                    for (int q = 0; q < 4; ++q)
#pragma unroll
                        for (int t = 0; t < 2; ++t) acc[t][q] = __builtin_amdgcn_mfma_f32_32x32x16_bf16(br[c_][q], af[t], acc[t][q], 0, 0, 0);
                }
            }
            bf16_t* So = Sg + ((size_t)((b * 2 + dir) * NCHUNK + c) * 8 + h) * 8192 + (size_t)lane * 8;
#pragma unroll
            for (int t = 0; t < 2; ++t)
#pragma unroll
                for (int q = 0; q < 4; ++q)
#pragma unroll
                    for (int j = 0; j < 2; ++j) { u32x4 pk; pk.x = cvt_pk_bf16(acc[t][q][8 * j], acc[t][q][8 * j + 1]); pk.y = cvt_pk_bf16(acc[t][q][8 * j + 2], acc[t][q][8 * j + 3]);
                        pk.z = cvt_pk_bf16(acc[t][q][8 * j + 4], acc[t][q][8 * j + 5]); pk.w = cvt_pk_bf16(acc[t][q][8 * j + 6], acc[t][q][8 * j + 7]);
                        *(u32x4*)(So + ((t * 4 + q) * 2 + j) * 512) = pk; }
        }
        __syncthreads();
    }
}
__device__ __forceinline__ void phase_s2(CP p, int bid, int nb) {
    const int tid = launder_tid();
    const bf16_t* Sg = (const bf16_t*)(p->ws + WS_S); const float* DEC = (const float*)(p->ws + WS_DEC); bf16_t* HP = (bf16_t*)(p->ws + WS_HP);
    for (int idx = bid * NTHREADS + tid; idx < 2 * 2 * 8 * 64 * 64; idx += nb * NTHREADS) {
        const int n2 = idx & 63, pr = (idx >> 6) & 63, h = (idx >> 12) & 7, dir = (idx >> 15) & 1, b = idx >> 16;
        const size_t inner = (size_t)h * 8192 + pr * 128 + 2 * n2;
        const size_t cbase = (size_t)(b * 2 + dir) * NCHUNK;
        float s0 = 0.f, s1 = 0.f;
#pragma unroll 26
        for (int step = 0; step < NCHUNK; ++step) {
            const int c = dir == 0 ? step : (step < 2 ? 1 - step : NCHUNK + 1 - step);
            const size_t off = (cbase + c) * 65536 + inner;
            const unsigned sv = __builtin_nontemporal_load((const unsigned*)(Sg + off)); const float d = DEC[(cbase + c) * 8 + h];
            *(unsigned*)(HP + off) = cvt_pk_bf16(s0, s1);
            s0 = s0 * d + bflo(sv); s1 = s1 * d + bfhi(sv);
        }
    }
}
__device__ __forceinline__ void phase_s3(CP p, int l, unsigned char* lds_, int bid, int nb) {
    LAS unsigned char* lds = (LAS unsigned char*)lds_;
    LAS unsigned char* Cs = lds;
    LAS unsigned char* Bs = Cs + 128 * ST_ROW;
    LAS unsigned char* Mt = Bs;
    LAS unsigned char* Xs = Bs + 128 * ST_MT;
    LAS unsigned char* Hf = Xs + 128 * ST_TR64;
    LAS unsigned char* Hb = Hf + 64 * ST_ROW;
    LAS float* hvs = (LAS float*)(Hb + 64 * ST_ROW);
    LAS float* ssqp = hvs + 4 * 776;
    LAS float* cwl = ssqp + 256;
    LAS float* atab = cwl + 6 * 512;
    const int tid0 = launder_tid(); const int wave = __builtin_amdgcn_readfirstlane(tid0 >> 6);
    const bf16_t* proj = (const bf16_t*)(p->ws + WS_PROJ); bf16_t* mix = (bf16_t*)(p->ws + WS_HX);
    const float* cw = p->ssd_conv_w + (size_t)l * 5 * 1024; const float* cbias = p->ssd_conv_b + (size_t)l * 1024;
    const bf16_t* HP = (const bf16_t*)(p->ws + WS_HP); float* SSQ = (float*)(p->ws + WS_SSQ);
    if (tid0 < 16) atab[tid0] = -expf(p->a_log[l * 16 + tid0]); else if (tid0 < 24) atab[tid0] = p->d_skip[l * 8 + tid0 - 16];
    __syncthreads();
    int cur_g = -1;
    const int cskip = (l == DEPTH - 1) ? 2 : 0, cpb = NCHUNK - cskip;
    const int nunits = NB * cpb * 2, nfull = nunits - nunits % nb, nitems = nfull + (nunits - nfull) * 4;
#pragma unroll 1
    for (int it = bid; it < nitems; it += nb) {
        const int u = it < nfull ? it : nfull + ((it - nfull) >> 2);
        const int hh_lo = it < nfull ? 0 : ((it - nfull) & 3), hh_hi = it < nfull ? 4 : hh_lo + 1;
        const int g = u & 1, c = cskip + (u >> 1) % cpb, b = (u >> 1) / cpb;
        int tid = tid0; asm volatile("" : "+v"(tid));
        const int lane = tid & 63;
        const int row0 = b * SEG + c * 128;
        const bool lo_ok = !(c == 0 || c == 2), hi_ok = !(c == 1 || c == NCHUNK - 1);
        if (g != cur_g) { cur_g = g;
            float tw[6];
#pragma unroll
            for (int it = 0; it < 6; ++it) { const int i = tid + NTHREADS * it; const int j = i >> 9, lc = i & 511; const int gch = lc < 128 ? 768 + g * 128 + lc : (lc < 256 ? 512 + g * 128 + (lc - 128) : g * 256 + (lc - 256));
                tw[it] = j < 5 ? cw[j * 1024 + gch] : cbias[gch]; }
#pragma unroll
            for (int it = 0; it < 6; ++it) cwl[tid + NTHREADS * it] = tw[it]; }
        u32x2 rx[8];
        {
            u32x4 r0[8], r1[8];
            const int cg = tid & 31; const int gch = (cg < 16 ? 768 : 512) + g * 128 + (cg & 15) * 8;
            conv_load(proj, row0, tid >> 5, gch, lo_ok, hi_ok, r0);
            conv_load(proj, row0, (tid >> 5) + 16, gch, lo_ok, hi_ok, r1);
            head_cums(p, l, row0, 4 * g + (wave >> 1), wave & 1, lane, hvs + (wave >> 1) * 776, atab);
            { LAS float* hvw = hvs + (wave >> 1) * 776; const int dr = wave & 1;
              hvw[520 + dr * 128 + 2 * lane] = __expf(hvw[dr * 128 + 2 * lane]); hvw[520 + dr * 128 + 2 * lane + 1] = __expf(hvw[dr * 128 + 2 * lane + 1]); }
            __syncthreads();
            float o[4][8];
            LAS unsigned char* dst = (cg < 16 ? Cs : Bs) + (cg & 15) * 16;
            conv_compute(r0, cwl, 512, cg * 8, o, (tid >> 5) == 0 && !lo_ok, false);
#pragma unroll
            for (int i = 0; i < 4; ++i) *(LAS u32x4*)(dst + (4 * (tid >> 5) + i) * ST_ROW) = pack8(o[i]);
            asm volatile("" ::: "memory");
            conv_load4(proj, row0, tid >> 4, g * 256 + hh_lo * 64 + (tid & 15) * 4, lo_ok, hi_ok, rx);
            conv_compute(r1, cwl, 512, cg * 8, o, false, (tid >> 5) == 15 && !hi_ok);
#pragma unroll
            for (int i = 0; i < 4; ++i) *(LAS u32x4*)(dst + (4 * ((tid >> 5) + 16) + i) * ST_ROW) = pack8(o[i]);
            { float o4[4][4]; conv_compute4(rx, cwl, 512, 256 + hh_lo * 64 + (tid & 15) * 4, o4, (tid >> 4) == 0 && !lo_ok, (tid >> 4) == 31 && !hi_ok);
#pragma unroll
              for (int i = 0; i < 4; ++i) { u32x2 pk; pk.x = cvt_pk_bf16(o4[i][0], o4[i][1]); pk.y = cvt_pk_bf16(o4[i][2], o4[i][3]); *(LAS u32x2*)(Xs + (4 * (tid >> 4) + i) * ST_TR64 + (tid & 15) * 8) = pk; } }
        }
        __syncthreads();
        const int lb = wave >> 1, hs = wave & 1;
        int ln = lane; asm volatile("" : "+v"(ln));
        f32x16 gacc[2];
#pragma unroll
        for (int t = 0; t < 2; ++t)
#pragma unroll
            for (int e = 0; e < 16; ++e) gacc[t][e] = 0.f;
#pragma unroll
        for (int kk = 0; kk < 8; ++kk) { const bf16x8 af = row_frag(Cs, ST_ROW, 32 * lb, 16 * kk, lane);
#pragma unroll
            for (int t = 0; t < 2; ++t) { const bf16x8 bf = row_frag(Bs, ST_ROW, 64 * hs + 32 * t, 16 * kk, lane);
                gacc[t] = __builtin_amdgcn_mfma_f32_32x32x16_bf16(af, bf, gacc[t], 0, 0, 0); } }
        u32x4 hreg[4];
        { const bf16_t* hp0 = HP + ((size_t)(b * 2 * NCHUNK + c) * 8 + 4 * g + hh_lo) * 8192;
#pragma unroll
          for (int q = 0; q < 4; ++q) { const int it = tid + 512 * q; hreg[q] = __builtin_nontemporal_load((const u32x4*)(hp0 + (size_t)(it >> 10) * NCHUNK * 8 * 8192 + (it & 1023) * 8)); } }
        __syncthreads();
#pragma unroll 1
        for (int hh = hh_lo; hh < hh_hi; ++hh) {
            const int h = 4 * g + hh; const LAS float* hv = hvs + hh * 776;
            asm volatile("" : "+v"(ln));
            const int ph = hs;
            const int lrw = 32 * lb + (ln & 31), pq = 32 * ph + 4 * (ln >> 5);
            u32x2 zraw[4];
#pragma unroll
            for (int rg = 0; rg < 4; ++rg) zraw[rg] = *(const u32x2*)(proj + (size_t)(row0 + lrw) * NPROJ + 1024 + h * 64 + pq + 8 * rg);
#pragma unroll
            for (int t = 0; t < 2; ++t) {
                const int st = 2 * hs + t;
                const int sc = 32 * st + (ln & 31);
                const float cfs = hv[sc], cbs = hv[128 + sc], dfs = hv[256 + sc], dbs = hv[384 + sc];
#pragma unroll
                for (int rg = 0; rg < 4; ++rg) {
                    const int l0 = 32 * lb + 8 * rg + 4 * (ln >> 5);
                    float m[4];
                    if (st < lb) {
                        const f32x4 cfl = *(const LAS f32x4*)(hv + l0);
#pragma unroll
                        for (int e = 0; e < 4; ++e) m[e] = gacc[t][4 * rg + e] * (__expf(cfl[e] - cfs) * dfs);
                    } else if (st > lb) {
                        const f32x4 cbl = *(const LAS f32x4*)(hv + 128 + l0);
#pragma unroll
                        for (int e = 0; e < 4; ++e) m[e] = gacc[t][4 * rg + e] * (__expf(cbl[e] - cbs) * dbs);
                    } else {
                        const f32x4 cfl = *(const LAS f32x4*)(hv + l0), cbl = *(const LAS f32x4*)(hv + 128 + l0);
#pragma unroll
                        for (int e = 0; e < 4; ++e) { const int lr = l0 + e;
                            const float ff = lr >= sc ? __expf(cfl[e] - cfs) * dfs : 0.f;
                            const float fb = lr <= sc ? __expf(cbl[e] - cbs) * dbs : 0.f;
                            m[e] = gacc[t][4 * rg + e] * (ff + fb); }
                    }
                    u32x2 pk; pk.x = cvt_pk_bf16(m[0], m[1]); pk.y = cvt_pk_bf16(m[2], m[3]);
                    *(LAS u32x2*)(Mt + sc * ST_MT + l0 * 2) = pk;
                }
            }
#pragma unroll
            for (int q = 0; q < 4; ++q) { const int it = tid + 512 * q; const int q2 = it & 1023;
                LAS unsigned char* dst = ((it >> 10) ? Hb : Hf) + (32 * (q2 >> 9) + (q2 & 31)) * ST_ROW + (32 * ((q2 >> 7) & 3) + 16 * ((q2 >> 6) & 1) + 4 * ((q2 >> 5) & 1)) * 2;
                *(LAS u32x2*)dst = (u32x2){hreg[q].x, hreg[q].y}; *(LAS u32x2*)(dst + 16) = (u32x2){hreg[q].z, hreg[q].w}; }
            if (hh + 1 < hh_hi) {
                const bf16_t* hp0 = HP + ((size_t)(b * 2 * NCHUNK + c) * 8 + h + 1) * 8192;
#pragma unroll
                for (int q = 0; q < 4; ++q) { const int it = tid + 512 * q; hreg[q] = __builtin_nontemporal_load((const u32x4*)(hp0 + (size_t)(it >> 10) * NCHUNK * 8 * 8192 + (it & 1023) * 8)); }
                conv_load4(proj, row0, tid >> 4, g * 256 + (hh + 1) * 64 + (tid & 15) * 4, lo_ok, hi_ok, rx);
            }
            __syncthreads();
            f32x16 ad, af_, ab_;
#pragma unroll
            for (int e = 0; e < 16; ++e) { ad[e] = 0.f; af_[e] = 0.f; ab_[e] = 0.f; }
            {
                bf16x8 am[2], bx[2], ac[2], bhf[2], bhb[2];
                am[0] = tr_frag(Mt, ST_MT, 0, 32 * lb, lane); bx[0] = tr_frag(Xs, ST_TR64, 0, 32 * ph, lane);
                ac[0] = row_frag(Cs, ST_ROW, 32 * lb, 0, lane); bhf[0] = row_frag(Hf, ST_ROW, 32 * ph, 0, lane); bhb[0] = row_frag(Hb, ST_ROW, 32 * ph, 0, lane);
#pragma unroll
                for (int kk = 0; kk < 8; ++kk) { const int c = kk & 1, n = c ^ 1;
                    if (kk < 7) { am[n] = tr_frag(Mt, ST_MT, 16 * (kk + 1), 32 * lb, lane); bx[n] = tr_frag(Xs, ST_TR64, 16 * (kk + 1), 32 * ph, lane);
                        ac[n] = row_frag(Cs, ST_ROW, 32 * lb, 16 * (kk + 1), lane); bhf[n] = row_frag(Hf, ST_ROW, 32 * ph, 16 * (kk + 1), lane); bhb[n] = row_frag(Hb, ST_ROW, 32 * ph, 16 * (kk + 1), lane); }
                    ad = __builtin_amdgcn_mfma_f32_32x32x16_bf16(bx[c], am[c], ad, 0, 0, 0);
                    af_ = __builtin_amdgcn_mfma_f32_32x32x16_bf16(bhf[c], ac[c], af_, 0, 0, 0);
                    ab_ = __builtin_amdgcn_mfma_f32_32x32x16_bf16(bhb[c], ac[c], ab_, 0, 0, 0); }
            }
            const float dsk = atab[16 + h];
            { const float ef = hv[520 + lrw], eb = hv[648 + lrw];
              float sq = 0.f;
#pragma unroll
              for (int rg = 0; rg < 4; ++rg) {
                const u32x2 xr = *(const LAS u32x2*)(Xs + lrw * ST_TR64 + (pq + 8 * rg) * 2);
                const float xs[4] = {bflo(xr.x), bfhi(xr.x), bflo(xr.y), bfhi(xr.y)};
                const float zz[4] = {bflo(zraw[rg].x), bfhi(zraw[rg].x), bflo(zraw[rg].y), bfhi(zraw[rg].y)};
                float v[4];
#pragma unroll
                for (int e = 0; e < 4; ++e) { const int ri = 4 * rg + e;
                    const float y = ad[ri] + ef * af_[ri] + eb * ab_[ri] + dsk * xs[e];
                    v[e] = y * zz[e];
                    sq += v[e] * v[e]; }
                u32x2 pk; pk.x = cvt_pk_bf16(v[0], v[1]); pk.y = cvt_pk_bf16(v[2], v[3]);
                *(u32x2*)(mix + (size_t)(row0 + lrw) * 1024 + h * 64 + pq + 8 * rg) = pk;
              }
              sq += __shfl_xor(sq, 32);
              if (ln < 32) ssqp[ph * 128 + lrw] = sq; }
            __syncthreads();
            if (tid < 128) SSQ[(size_t)(row0 + tid) * 8 + h] = ssqp[tid] + ssqp[128 + tid];
            if (hh + 1 < hh_hi) { float o4[4][4];
                conv_compute4(rx, cwl, 512, 256 + (hh + 1) * 64 + (tid & 15) * 4, o4, (tid >> 4) == 0 && !lo_ok, (tid >> 4) == 31 && !hi_ok);
#pragma unroll
                for (int i = 0; i < 4; ++i) { u32x2 pk; pk.x = cvt_pk_bf16(o4[i][0], o4[i][1]); pk.y = cvt_pk_bf16(o4[i][2], o4[i][3]); *(LAS u32x2*)(Xs + (4 * (tid >> 4) + i) * ST_TR64 + (tid & 15) * 8) = pk; } }
        }
        __syncthreads();
    }
}
__device__ __forceinline__ void phase_r2(CP p, int l, unsigned char* lds_, int bid, int nb) {
    LAS unsigned char* lds = (LAS unsigned char*)lds_;
    LAS unsigned char* Wh = lds;
    LAS unsigned char* Xh = Wh + 32 * ST_H16;
    LAS float* gm = (LAS float*)(Xh + 16 * ST_H16);
    LAS float* sh = gm + 3 * 1024;
    LAS float* part = sh + 3 * 1024;
    LAS float* lgs = part + 8 * 16 * 32;
    LAS int* lcnt = (LAS int*)(lgs + 16 * 32);
    LAS int* lcls = lcnt + 64;
    LAS int* lrank = lcls + 512;
    LAS float* lcwa = (LAS float*)(lrank + 512);
    LAS float* lcwb = lcwa + 512;
    const int tid = launder_tid(); const int lane = tid & 63, wave = __builtin_amdgcn_readfirstlane(tid >> 6);
    const float* mod = (const float*)(p->ws + WS_MOD) + (size_t)l * 3 * 6144;
    {
        float tmp[8];
#pragma unroll
        for (int it = 0; it < 8; ++it) tmp[it] = p->w_rg[(size_t)l * 4096 + tid + NTHREADS * it];
#pragma unroll
        for (int it = 0; it < 8; ++it) { const int idx = tid + NTHREADS * it; *(LAS _Float16*)(Wh + (idx & 3) * ST_H16 + (idx >> 2) * 2) = (_Float16)tmp[it]; } }
#pragma unroll
    for (int hb = 0; hb < 2; ++hb) { float tmp[16];
#pragma unroll
        for (int it = 0; it < 16; ++it) tmp[it] = p->w_re[(size_t)l * 16384 + tid + NTHREADS * (16 * hb + it)];
#pragma unroll
        for (int it = 0; it < 16; ++it) { const int idx = tid + NTHREADS * (16 * hb + it); *(LAS _Float16*)(Wh + (4 + (idx & 15)) * ST_H16 + (idx >> 4) * 2) = (_Float16)tmp[it]; } }
    { unsigned zz; asm volatile("v_mov_b32 %0, 0" : "=v"(zz));
      for (int i = tid; i < 12 * 128; i += NTHREADS) { const int rw = 20 + i / 128, c16 = i % 128; *(LAS u32x4*)(Wh + rw * ST_H16 + c16 * 16) = (u32x4){zz, zz, zz, zz}; } }
    { float t0[6], t1[6], t2[6];
#pragma unroll
      for (int it = 0; it < 6; ++it) { const int idx = tid + NTHREADS * it; const int v = idx >> 10, k = idx & 1023; t0[it] = p->g_ffn[l * 1024 + k]; t1[it] = mod[v * 6144 + 4 * 1024 + k]; t2[it] = mod[v * 6144 + 3 * 1024 + k]; }
#pragma unroll
      for (int it = 0; it < 6; ++it) { const int idx = tid + NTHREADS * it; gm[idx] = t0[it] * (1.f + t1[it]); sh[idx] = t2[it]; } }
    if (tid < 64) lcnt[tid] = 0;
    __syncthreads();
    bf16_t* HM = (bf16_t*)(p->ws + WS_HX); float* CWLA = (float*)(p->ws + WS_CWLA); float* CWLB = (float*)(p->ws + WS_CWLB);
    int* gcount = (int*)(p->ws + WS_CTL) + l * 32; int* LIST = (int*)(p->ws + WS_LIST);
    const int rpb = (R + nb - 1) / nb, r0 = bid * rpb, r1 = (r0 + rpb) < R ? (r0 + rpb) : R;
    RowRaw xn[2];
#pragma unroll
    for (int q = 0; q < 2; ++q) if (r0 + 2 * wave + q < r1) row_load(p, 1, r0 + 2 * wave + q, lane, xn[q]);
#pragma unroll 1
    for (int t0r = r0; t0r < r1; t0r += 16) {
        f32x4 xv[2][4];
#pragma unroll
        for (int q = 0; q < 2; ++q) row_cvt(1, xn[q], xv[q]);
#pragma unroll
        for (int q = 0; q < 2; ++q) if (t0r + 16 + 2 * wave + q < r1) row_load(p, 1, t0r + 16 + 2 * wave + q, lane, xn[q]);
#pragma unroll
        for (int q = 0; q < 2; ++q) { const int rr = t0r + 2 * wave + q; const bool ok = rr < r1; const int v = row_v(ok ? rr : r0);
            float ss = 0.f;
#pragma unroll
            for (int j = 0; j < 4; ++j) ss += xv[q][j][0] * xv[q][j][0] + xv[q][j][1] * xv[q][j][1] + xv[q][j][2] * xv[q][j][2] + xv[q][j][3] * xv[q][j][3];
            ss = wave_sum(ss); const float rs = ok ? __builtin_amdgcn_rsqf(ss * (1.f / 1024.f) + 1e-6f) : 0.f;
#pragma unroll
            for (int j = 0; j < 4; ++j) { const int k = 4 * lane + 256 * j; const f32x4 g4 = *(const LAS f32x4*)(gm + v * 1024 + k), s4 = *(const LAS f32x4*)(sh + v * 1024 + k);
                f32x4 hv = xv[q][j] * rs * g4 + s4; if (!ok) hv = hv * 0.f;
                u32x2 o; o.x = cvt_pk_bf16(hv[0], hv[1]); o.y = cvt_pk_bf16(hv[2], hv[3]);
                if (ok) *(u32x2*)(HM + (size_t)rr * 1024 + k) = o;
                u32x2 h16; h16.x = pack_f16(hv[0], hv[1]); h16.y = pack_f16(hv[2], hv[3]);
                *(LAS u32x2*)(Xh + (2 * wave + q) * ST_H16 + k * 2) = h16; } }
        __syncthreads();
        {
            f32x4 acc0 = {0.f, 0.f, 0.f, 0.f}, acc1 = {0.f, 0.f, 0.f, 0.f};
#pragma unroll
            for (int s4 = 0; s4 < 4; ++s4) { const int kb = (128 * wave + 32 * s4 + 8 * (lane >> 4)) * 2;
                const f16x8 a = *(const LAS f16x8*)(Xh + (lane & 15) * ST_H16 + kb);
                const f16x8 b0 = *(const LAS f16x8*)(Wh + (lane & 15) * ST_H16 + kb), b1 = *(const LAS f16x8*)(Wh + (16 + (lane & 15)) * ST_H16 + kb);
                acc0 = __builtin_amdgcn_mfma_f32_16x16x32_f16(a, b0, acc0, 0, 0, 0);
                acc1 = __builtin_amdgcn_mfma_f32_16x16x32_f16(a, b1, acc1, 0, 0, 0); }
#pragma unroll
            for (int e = 0; e < 4; ++e) { const int row = 4 * (lane >> 4) + e; part[(wave * 16 + row) * 32 + (lane & 15)] = acc0[e]; part[(wave * 16 + row) * 32 + 16 + (lane & 15)] = acc1[e]; }
        }
        __syncthreads();
        if (tid < 320) { const int row = tid / 20, n = tid - row * 20; float sacc = n < 4 ? p->b_rg[l * 4 + n] : p->b_re[l * 16 + n - 4];
#pragma unroll
            for (int w = 0; w < 8; ++w) sacc += part[(w * 16 + row) * 32 + n];
            lgs[row * 32 + n] = sacc; }
        __syncthreads();
        if (tid < 16) { const int rr = t0r + tid;
            if (rr < r1) {
                if (l == DEPTH - 1 && row_v(rr) == 2) lcls[rr - r0] = -1;
                else {
                    float lg[20];
#pragma unroll
                    for (int n = 0; n < 20; ++n) lg[n] = lgs[tid * 32 + n];
                    int gsel = 0; float gmax = lg[0];
#pragma unroll
                    for (int t = 1; t < 4; ++t) if (lg[t] > gmax) { gmax = lg[t]; gsel = t; }
                    float gden = 0.f;
#pragma unroll
                    for (int t = 0; t < 4; ++t) gden += __expf(lg[t] - gmax);
                    const float gprob = 1.f / gden;
                    float el[4];
#pragma unroll
                    for (int t = 0; t < 4; ++t) el[t] = gsel == 0 ? lg[4 + t] : (gsel == 1 ? lg[8 + t] : (gsel == 2 ? lg[12 + t] : lg[16 + t]));
                    int i0 = 0; float m0 = el[0];
#pragma unroll
                    for (int t = 1; t < 4; ++t) if (el[t] > m0) { m0 = el[t]; i0 = t; }
                    int i1 = -1; float m1 = -3.0e38f;
#pragma unroll
                    for (int t = 0; t < 4; ++t) if (t != i0 && el[t] > m1) { m1 = el[t]; i1 = t; }
                    const float w0 = gprob / (1.f + __expf(m1 - m0)), w1 = gprob - w0;
                    const int ea = i0 < i1 ? i0 : i1, eb = i0 < i1 ? i1 : i0;
                    const float cwa = i0 < i1 ? w0 : w1, cwb = i0 < i1 ? w1 : w0;
                    const int pidx = ea == 0 ? eb - 1 : (ea == 1 ? eb + 1 : 5);
                    const int cls = gsel * 6 + pidx;
                    const int rank = __hip_atomic_fetch_add(&lcnt[cls], 1, __ATOMIC_RELAXED, __HIP_MEMORY_SCOPE_WORKGROUP);
                    lcls[rr - r0] = cls; lrank[rr - r0] = rank; lcwa[rr - r0] = cwa; lcwb[rr - r0] = cwb;
                } } }
    }
    __syncthreads();
    if (tid < NCLS) lcnt[32 + tid] = atomicAdd(&gcount[tid], lcnt[tid]);
    __syncthreads();
    for (int idx = tid; idx < r1 - r0; idx += NTHREADS) { const int cl = lcls[idx]; if (cl < 0) continue; const int pos = lcnt[32 + cl] + lrank[idx]; const size_t li = (size_t)cl * R + pos;
        LIST[li] = r0 + idx; CWLA[li] = lcwa[idx]; CWLB[li] = lcwb[idx]; }
    __syncthreads();
}
__device__ __forceinline__ void phase_final(CP p, unsigned char* lds, int bid, int nb) {
    const int tid = launder_tid(); const int lane = tid & 63, wave = tid >> 6;
    const int qstep = nb * 8;
    RowRaw xn;
    { const int q = bid * 8 + wave; if (q < NB * SEQ) { const int b = q >= SEQ ? 1 : 0; row_load(p, 1, b * SEG + CTXL + (q - b * SEQ), lane, xn); } }
    for (int q = bid * 8 + wave; q < NB * SEQ; q += qstep) {
        f32x4* hr = (f32x4*)(p->out + (size_t)q * D);
        f32x4 xv[4]; float ss = 0.f;
        row_cvt(1, xn, xv);
        { const int qn = q + qstep; if (qn < NB * SEQ) { const int bn = qn >= SEQ ? 1 : 0; row_load(p, 1, bn * SEG + CTXL + (qn - bn * SEQ), lane, xn); } }
#pragma unroll
        for (int j = 0; j < 4; ++j) ss += xv[j][0] * xv[j][0] + xv[j][1] * xv[j][1] + xv[j][2] * xv[j][2] + xv[j][3] * xv[j][3];
        ss = wave_sum(ss); const float rs = rsqrtf(ss * (1.f / 1024.f) + 1e-6f);
#pragma unroll
        for (int j = 0; j < 4; ++j) { const f32x4 g4 = *(const f32x4*)(p->g_final + 4 * lane + 256 * j); hr[lane + 64 * j] = xv[j] * rs * g4; }
    }
}


#define XB_TMO      128
#define XB_XCNT(j)  (256  + 64 * (j))
#define XB_XSUB(j)  (1280 + 64 * (j))
#define XB_XGEN(j)  (2304 + 64 * (j))
#define XB_TOP      3328
#define XB_TOPGEN   3392
#define XCD_BAR_WORDS 3456
#define XB_SPIN_CAP (1u << 22)
__device__ __forceinline__ unsigned xb_ld(unsigned* p) { return __hip_atomic_load(p, __ATOMIC_RELAXED, __HIP_MEMORY_SCOPE_AGENT); }
__device__ __forceinline__ unsigned xb_add(unsigned* p, unsigned v) { return __hip_atomic_fetch_add(p, v, __ATOMIC_RELAXED, __HIP_MEMORY_SCOPE_AGENT); }
__device__ __forceinline__ unsigned xb_xcc_id() { return (unsigned)__builtin_amdgcn_s_getreg((3 << 11) | 20) & 0xFu; }
#define XB_SPIN(cond, bar) do { unsigned _sp = 0; while (cond) { __builtin_amdgcn_s_sleep(1); \
    if ((++_sp & 255u) == 0u) { if (xb_ld(&(bar)[XB_TMO])) break; if (_sp > XB_SPIN_CAP) { atomicAdd(&(bar)[XB_TMO], 1u); break; } } } } while (0)
struct XcdBarrier { unsigned* bar; unsigned x; volatile LAS unsigned* st; };
__device__ __forceinline__ XcdBarrier xcd_barrier_post(unsigned* bar, volatile LAS unsigned* st) {
    XcdBarrier b; b.bar = bar; b.x = xb_xcc_id(); b.st = st;
    if (threadIdx.x == 0) (void)xb_add(&bar[XB_XCNT(b.x)], 1u);
    return b;
}
__device__ __forceinline__ void xcd_barrier_complete(unsigned* bar, unsigned x, unsigned& nloc, unsigned& nx) {
    const unsigned G = gridDim.x * gridDim.y * gridDim.z;
    unsigned sum, cnt, mine, sp = 0u;
    for (;;) {
        sum = 0u; cnt = 0u; mine = 0u;
#pragma unroll
        for (unsigned j = 0; j < 16; ++j) { const unsigned c = xb_ld(&bar[XB_XCNT(j)]); sum += c; cnt += (c > 0u) ? 1u : 0u; mine = (j == x) ? c : mine; }
        if (sum == G) break;
        __builtin_amdgcn_s_sleep(1);
        if ((++sp & 255u) == 0u) { if (xb_ld(&bar[XB_TMO])) break; if (sp > XB_SPIN_CAP) { atomicAdd(&bar[XB_TMO], 1u); break; } }
    }
    nloc = mine > 0u ? mine : 1u; nx = cnt > 0u ? cnt : 1u;
}
__device__ __forceinline__ void xcd_barrier(const XcdBarrier& b) {
    asm volatile("s_waitcnt vmcnt(0)" ::: "memory");
    __syncthreads();
    if (threadIdx.x == 0) {
        unsigned* bar = b.bar;
        __builtin_amdgcn_s_waitcnt(0);
        unsigned nloc = b.st[0], nx = b.st[1];
        if (nloc == 0u) { xcd_barrier_complete(bar, b.x, nloc, nx); b.st[0] = nloc; b.st[1] = nx; }
        const unsigned old = xb_add(&bar[XB_XSUB(b.x)], 1u);
        const unsigned gen = old / nloc;
        if (old + 1u == (gen + 1u) * nloc) {
            __builtin_amdgcn_fence(__ATOMIC_RELEASE, "agent");
            asm volatile("s_waitcnt vmcnt(0)" ::: "memory");
            const unsigned og = xb_add(&bar[XB_TOP], 1u);
            const unsigned tg = og / nx;
            if (og + 1u == (tg + 1u) * nx) xb_add(&bar[XB_TOPGEN], 1u);
            else XB_SPIN(xb_ld(&bar[XB_TOPGEN]) == tg, bar);
            __builtin_amdgcn_fence(__ATOMIC_ACQUIRE, "agent");
            xb_add(&bar[XB_XGEN(b.x)], 1u);
            asm volatile("s_waitcnt vmcnt(0)" ::: "memory");
        } else {
            asm volatile("buffer_inv sc1" ::: "memory");
            XB_SPIN(xb_ld(&bar[XB_XGEN(b.x)]) == gen, bar);
            asm volatile("s_waitcnt vmcnt(0)" ::: "memory");
        }
    }
    __syncthreads();
}

#ifndef TIMING_A
#define TIMING_A -1
#endif
#ifndef TIMING_B
#define TIMING_B -1
#endif
#ifndef PHASE_MASK
#define PHASE_MASK 0xFFFFF
#endif
#define PM(i) ((PHASE_MASK >> (i)) & 1)
#ifndef REPEAT_MASK
#define REPEAT_MASK 0
#endif
#define RP(i) for (int rep_ = 0; rep_ < 1 + ((REPEAT_MASK >> (i)) & 1); ++rep_)
constexpr int PH_PER_LAYER = 9, NPHASES = 1 + DEPTH * PH_PER_LAYER + 1;
__global__ void __launch_bounds__(NTHREADS, 2) mk_fwd(Args args) {
    extern __shared__ __attribute__((aligned(16))) unsigned char lds[];
    cg::grid_group grid = cg::this_grid();
    const __attribute__((address_space(4))) Args* ap = (const __attribute__((address_space(4))) Args*)__builtin_amdgcn_kernarg_segment_ptr();
    const int lo = ap->lo, hi = ap->hi;
    LAS unsigned char* ldsl = (LAS unsigned char*)lds;
    volatile LAS unsigned* xbst = (volatile LAS unsigned*)(ldsl + LDS_BYTES - 16);
    if (threadIdx.x < 4) xbst[threadIdx.x] = 0u;
    __syncthreads();
    (void)xcd_barrier_post((unsigned*)(ap->p.ws + WS_BAR), xbst);
    if (TIMING_A >= 0 && blockIdx.x == 0 && threadIdx.x == 0) ((unsigned long long*)(ap->p.ws + WS_TS))[lo] = __builtin_amdgcn_s_memrealtime();
    for (int ph = lo; ph < hi; ++ph) {
        CP p = launder(&ap->p);
        int bid = blockIdx.x, nb = gridDim.x; asm volatile("" : "+s"(bid), "+s"(nb));
        if (ph == 0) { if (PM(0)) RP(0) phase_wprep(p, lds, 0, 912, bid, nb); if (PM(1)) RP(1) phase_adaln(p, lds, bid, nb); }
        else if (ph == NPHASES - 1) { if (PM(12)) phase_final(p, lds, bid, nb); }
        else {
            const int l = (ph - 1) / PH_PER_LAYER, s = (ph - 1) % PH_PER_LAYER;
            if (s == 0) { if (PM(2)) RP(2) { if (rep_ == 0 || l == 0) phase_r1(p, l, lds, bid, nb); } }
            else if (s == 1) { if (PM(3)) RP(3) {
                pg8::DenseSched S; S.init(p->ws + WS_HX, (const bf16_t*)(p->ws + WS_WTIN) + (size_t)l * DIN * 1024, R, NPROJ, 1024, 1024, 1024, nb, bid);
                EpiProj E{(bf16_t*)(p->ws + WS_PROJ)};
                pg8::gemm_phase<EpiProj, pg8::DenseSched, false>(ldsl, 1024, 1024, 1024, S, E);
                {
                    const int extra = S.nwg % nb; const int L1 = WPREP_ITEMS_PER_LAYER;
                    const int a0 = l == 0 ? 912 : L1 + 656, a1 = l == 0 ? 2960 : L1 + 2960;
                    if (l <= 1 && DEPTH == 2) { if (extra > 0 && bid >= extra) phase_wprep(p, lds, a0, a1, bid - extra, nb - extra); else if (extra == 0) phase_wprep(p, lds, a0, a1, bid, nb); } }
            } }
            else if (s == 2) { if (PM(4)) RP(4) phase_c1(p, l, lds, bid, nb); if (PM(5)) RP(5) phase_s1(p, l, lds, bid, nb); }
            else if (s == 3) { if (PM(6)) RP(6) phase_s2(p, bid, nb); }
            else if (s == 4) { if (PM(7)) RP(7) phase_s3(p, l, lds, bid, nb);
                if (PM(4)) {
                    const int cpb = NCHUNK - ((l == DEPTH - 1) ? 2 : 0), nunits = NB * cpb * 2, tail = (nunits % nb) * 4;
                    if (tail > 0 && tail < nb) { if (bid >= tail) phase_c1_ln(p, l, bid - tail, nb - tail); } else phase_c1_ln(p, l, bid, nb); } }
            else if (s == 5) { if (PM(8)) RP(8) { if (rep_ == 0 || l == 0) {
                pg8::DenseSched S; S.init(p->ws + WS_HX, (const bf16_t*)(p->ws + WS_WTOUT) + (size_t)l * 1024 * 1024, R, 1024, 1024, 1024, 1024, nb, bid, l == DEPTH - 1);
                EpiResid<0> E{p->ctx, p->x, (bf16_t*)(p->ws + WS_H), (const float*)(p->ws + WS_MOD) + (size_t)l * 3 * 6144, (const float*)(p->ws + WS_SSQ)};
                pg8::gemm_phase<EpiResid<0>, pg8::DenseSched, false>(ldsl, 1024, 1024, 1024, S, E);
                if (l == 0 && DEPTH == 2 && rep_ == 0) { const int extra = S.nwg % nb; const int L1 = WPREP_ITEMS_PER_LAYER;
                    if (extra > 0 && bid >= extra) phase_wprep(p, lds, 2960, 3984, bid - extra, nb - extra, L1, L1 + 656, L1 + 2960, L1 + 3984);
                    else if (extra == 0) phase_wprep(p, lds, 2960, 3984, bid, nb, L1, L1 + 656, L1 + 2960, L1 + 3984); }
            } } }
            else if (s == 6) { if (PM(9)) phase_r2(p, l, lds, bid, nb); }
            else if (s == 7) { if (PM(10)) {
                LAS int* tab = (LAS int*)(ldsl + MISC_OFF);
                LAS float* gl = (LAS float*)(ldsl + MISC_OFF + 4096);
                { const float* modl = (const float*)(p->ws + WS_MOD) + (size_t)l * 3 * 6144 + 5 * 1024; float tg[6]; const int tt = launder_tid();
#pragma unroll
                  for (int it = 0; it < 6; ++it) { const int i = tt + NTHREADS * it; tg[it] = modl[(size_t)(i >> 10) * 6144 + (i & 1023)]; }
#pragma unroll
                  for (int it = 0; it < 6; ++it) gl[tt + NTHREADS * it] = tg[it]; }
                moe_table(p, l, tab);
                unsigned* ready = (unsigned*)(p->ws + WS_M1CNT) + l * 192;
                { MoeSched S{tab, (const int*)(p->ws + WS_LIST), (const char*)(p->ws + WS_HX), (const char*)(p->ws + WS_WTGU), 0, l, nb, bid, ready, 0};
                  EpiUp E{(bf16_t*)(p->ws + WS_HID), (const float*)(p->ws + WS_CWLA), (const float*)(p->ws + WS_CWLB), ready};
                  pg8::gemm_phase<EpiUp, MoeSched, true>(ldsl, 1024, 1024, 1024, S, E); }
                { const int total = __builtin_amdgcn_readfirstlane(tab[24]) * 4; const int extra = __builtin_amdgcn_readfirstlane(total % nb);
                  MoeSched S{tab, (const int*)(p->ws + WS_LIST), (const char*)(p->ws + WS_HID), (const char*)(p->ws + WS_WTD), 1, l, nb, bid, ready, (total >= nb && total - extra >= nb) ? extra : 0};
                  EpiDown E{(bf16_t*)(p->ws + WS_H), (const int*)(p->ws + WS_LIST), gl};
                  pg8::gemm_phase<EpiDown, MoeSched, false>(ldsl, 512, 256, 512, S, E); }
            } }
            else { }
        }
        if (ph + 1 < hi && !(ph > 0 && ph < NPHASES - 1 && (ph - 1) % PH_PER_LAYER == 7)) { if (hi < 0) grid.sync();   else { XcdBarrier xb; xb.bar = (unsigned*)(launder(&ap->p)->ws + WS_BAR); xb.x = xb_xcc_id(); xb.st = (volatile LAS unsigned*)(ldsl + LDS_BYTES - 16); xcd_barrier(xb); }
            if (TIMING_A >= 0 && blockIdx.x == 0 && threadIdx.x == 0) ((unsigned long long*)(launder(&ap->p)->ws + WS_TS))[ph + 1] = __builtin_amdgcn_s_memrealtime(); }
    }
#if TIMING_A >= 0
    {
        XcdBarrier xb; xb.bar = (unsigned*)(launder(&ap->p)->ws + WS_BAR); xb.x = xb_xcc_id(); xb.st = (volatile LAS unsigned*)(ldsl + LDS_BYTES - 16); xcd_barrier(xb);
        if (blockIdx.x == 0 && threadIdx.x == 0) ((unsigned long long*)(launder(&ap->p)->ws + WS_TS))[hi] = __builtin_amdgcn_s_memrealtime();
        xcd_barrier(xb);
        const unsigned long long* ts = (const unsigned long long*)(launder(&ap->p)->ws + WS_TS);
        const float ta = (float)(ts[TIMING_A + 1] - ts[TIMING_A]) * 0.01f, tb = (float)(ts[TIMING_B + 1] - ts[TIMING_B]) * 0.01f;
        float* o = launder(&ap->p)->out; const float sc = 1.f + ta * 0.001f;
        for (size_t i = (size_t)blockIdx.x * NTHREADS + threadIdx.x; i < (size_t)NB * SEQ * D; i += (size_t)gridDim.x * NTHREADS) o[i] = o[i] * sc + (i == 0 ? tb * 0.1f : 0.f);
    }
#endif
}

extern "C" void kernel_launch(void* const* d_in, const int* in_sizes, int n_in, void* d_out, int out_size, void* d_ws, size_t ws_size, hipStream_t stream) {
    static int grid = 0;
    if (grid == 0) {
        if (n_in != 28 || ws_size < WS_END) { fprintf(stderr, "kernel_launch: unexpected n_in %d or ws_size %zu (< %zu)\n", n_in, ws_size, (size_t)WS_END); grid = -1; return; }
        int dev = 0, cus = 0, per_cu = 0;
        hipGetDevice(&dev); hipDeviceGetAttribute(&cus, hipDeviceAttributeMultiprocessorCount, dev);
        if (hipFuncSetAttribute((const void*)mk_fwd, hipFuncAttributeMaxDynamicSharedMemorySize, LDS_BYTES) != hipSuccess) { fprintf(stderr, "kernel_launch: hipFuncSetAttribute failed\n"); grid = -1; return; }
        if (hipOccupancyMaxActiveBlocksPerMultiprocessor(&per_cu, (const void*)mk_fwd, NTHREADS, LDS_BYTES) != hipSuccess || per_cu < 1) { fprintf(stderr, "kernel_launch: occupancy query says %d\n", per_cu); (void)hipGetLastError(); grid = -1; return; }
        grid = cus;
    }
    if (grid < 0) return;
    (void)hipMemsetAsync((char*)d_ws + WS_CTL, 0, WS_CTL_BYTES, stream);
    Args a{};
    const float** pp = (const float**)&a.p;
    for (int i = 0; i < 28; ++i) pp[i] = (const float*)d_in[i];
    a.p.out = (float*)d_out; a.p.ws = (unsigned char*)d_ws;
#if PER_PHASE_LAUNCH
    for (int ph = 0; ph < NPHASES; ++ph) {
        a.lo = ph; a.hi = ph + 1; void* kargs[] = {&a};
        hipError_t e = hipLaunchCooperativeKernel((const void*)mk_fwd, dim3(grid), dim3(NTHREADS), kargs, LDS_BYTES, stream);
        if (e != hipSuccess) { fprintf(stderr, "kernel_launch: launch of phase %d failed: %s\n", ph, hipGetErrorString(e)); break; }
    }
#else
    a.lo = 0; a.hi = NPHASES; void* kargs[] = {&a};
    hipError_t e = hipLaunchCooperativeKernel((const void*)mk_fwd, dim3(grid), dim3(NTHREADS), kargs, LDS_BYTES, stream);
    if (e != hipSuccess) fprintf(stderr, "kernel_launch: cooperative launch failed: %s (grid %d)\n", hipGetErrorString(e), grid);
#endif
}
```

```cpp
#include <hip/hip_runtime.h>
#include <hip/hip_cooperative_groups.h>
#include <cstdio>
namespace cg = cooperative_groups;

#ifndef PER_PHASE_LAUNCH
#define PER_PHASE_LAUNCH 0
#endif

#ifndef S3REP
#define S3REP 0
#endif
#define S3R(i) for (int r3_ = 0; r3_ < 1 + ((S3REP >> (i)) & 1); ++r3_)
#define LAS __attribute__((address_space(3)))
typedef unsigned short bf16_t;
typedef short bf16x8 __attribute__((ext_vector_type(8)));
typedef float f32x4 __attribute__((ext_vector_type(4)));
typedef unsigned u32x4 __attribute__((ext_vector_type(4)));
typedef unsigned u32x2 __attribute__((ext_vector_type(2)));

constexpr int D = 1024, NB = 2, SEQ = 16384, CTXL = 256, SEG = SEQ + CTXL, R = NB * SEG, DEPTH = 2;
constexpr int NPROJ = 2560, DIN = 2576;
constexpr int NTHREADS = 512;
constexpr int LDS_BYTES = 163840;
constexpr int MISC_OFF = 131072;
constexpr int NCLS = 24;

constexpr size_t al256(size_t x) { return (x + 255) & ~size_t(255); }
constexpr size_t WS_CTL = 0;
constexpr size_t WS_M1CNT = 20480;
constexpr size_t WS_TS = 2048;
constexpr size_t WS_BAR = 4096;
constexpr size_t WS_CTL_BYTES = 32768;
constexpr size_t WS_MOD = WS_CTL_BYTES;
constexpr size_t WS_WTIN = WS_MOD + al256((size_t)2 * 3 * 6144 * 4);
constexpr size_t WS_WTOUT = WS_WTIN + al256((size_t)2 * DIN * 1024 * 2);
constexpr size_t WS_WTGU = WS_WTOUT + al256((size_t)2 * 1024 * 1024 * 2);
constexpr size_t WS_WTD = WS_WTGU + al256((size_t)2 * 16 * 512 * 1024 * 2);
constexpr size_t WS_H = WS_WTD + al256((size_t)2 * 16 * 1024 * 256 * 2);
constexpr size_t WS_HX = WS_H + al256((size_t)R * 1024 * 2);
constexpr size_t WS_PROJ = WS_HX + al256((size_t)R * 1024 * 2);
constexpr size_t WS_DT = WS_PROJ + al256((size_t)R * NPROJ * 2);
constexpr size_t WS_POS = WS_DT + al256((size_t)R * 16 * 4);
constexpr size_t WS_LIST = WS_POS + al256((size_t)2 * R * 4);
constexpr size_t WS_CWLA = WS_LIST + al256((size_t)NCLS * R * 4);
constexpr size_t WS_CWLB = WS_CWLA + al256((size_t)NCLS * R * 4);
constexpr size_t WS_BIG = WS_CWLB + al256((size_t)NCLS * R * 4);
constexpr size_t WS_Y = WS_PROJ;
constexpr size_t WS_S = WS_BIG;
constexpr size_t WS_HP = WS_S + al256((size_t)2 * 2 * 130 * 8 * 8192 * 2);
constexpr size_t WS_DEC = WS_HP + al256((size_t)2 * 2 * 130 * 8 * 8192 * 2);
constexpr size_t WS_SSQ = WS_DEC + al256((size_t)2 * 2 * 130 * 8 * 4);
constexpr size_t WS_HID = WS_S;
constexpr size_t WS_END = WS_SSQ + al256((size_t)R * 8 * 4);
static_assert((size_t)(R + NCLS * 256) * 512 * 2 <= (size_t)2 * 2 * 130 * 8 * 8192 * 2, "hid alias");
static_assert(WS_END <= (size_t)512 * 1024 * 1024, "workspace");

struct Params {
    const float *x, *c, *ctx, *c_ctx, *w_ada, *b_ada, *g_mix, *g_ffn, *w_in, *conv_w, *conv_b, *conv_ln_g, *conv_ln_b, *ssd_conv_w, *ssd_conv_b,
        *dt_bias, *a_log, *d_skip, *ssd_norm_g, *w_out, *w_rg, *b_rg, *w_re, *b_re, *w_gate, *w_up, *w_down, *g_final;
    float* out; unsigned char* ws;
};
struct Args { Params p; int lo, hi; };
typedef const __attribute__((address_space(4))) Params* CP;
__device__ __forceinline__ CP launder(CP p) { asm volatile("" : "+s"(p)); return p; }
__device__ __forceinline__ int launder_tid() { int t = threadIdx.x; asm volatile("" : "+v"(t)); return t; }

__device__ __forceinline__ unsigned cvt_pk_bf16(float lo, float hi) { unsigned r; asm("v_cvt_pk_bf16_f32 %0, %1, %2" : "=v"(r) : "v"(lo), "v"(hi)); return r; }
__device__ __forceinline__ float bf2f(unsigned b) { return __uint_as_float(b << 16); }
__device__ __forceinline__ float bflo(unsigned w) { return __uint_as_float(w << 16); }
__device__ __forceinline__ float bfhi(unsigned w) { return __uint_as_float(w & 0xffff0000u); }
__device__ __forceinline__ bf16_t f2bf(float f) { return (bf16_t)(cvt_pk_bf16(f, 0.f) & 0xffffu); }
#define DPP_ADD(v, ctrl, rm) ((v) + __builtin_bit_cast(float, __builtin_amdgcn_update_dpp(0, __builtin_bit_cast(int, (v)), (ctrl), (rm), 0xF, true)))
__device__ __forceinline__ float row_sum16(float v) {
    v = DPP_ADD(v, 0xB1, 0xF);
    v = DPP_ADD(v, 0x4E, 0xF);
    v = DPP_ADD(v, 0x141, 0xF);
    v = DPP_ADD(v, 0x140, 0xF);
    return v;
}
__device__ __forceinline__ float half_sum32(float v) { v = row_sum16(v); v = DPP_ADD(v, 0x142, 0xA); return v; }
__device__ __forceinline__ float wave_sum(float v) {
    v = half_sum32(v); v = DPP_ADD(v, 0x143, 0xC);
    return __builtin_bit_cast(float, __builtin_amdgcn_readlane(__builtin_bit_cast(int, v), 63));
}
__device__ __forceinline__ float sigmoidf_(float x) { return __builtin_amdgcn_rcpf(1.f + __builtin_amdgcn_exp2f(x * -1.44269504089f)); }
__device__ __forceinline__ float siluf_(float x) { return x * __builtin_amdgcn_rcpf(1.f + __builtin_amdgcn_exp2f(x * -1.44269504089f)); }
__device__ __forceinline__ float softplusf_(float x) { return fmaxf(x, 0.f) + __logf(1.f + __expf(-fabsf(x))); }

__device__ __forceinline__ int row_b(int r) { return r >= SEG ? 1 : 0; }
__device__ __forceinline__ int row_i(int r) { return r >= SEG ? r - SEG : r; }
__device__ __forceinline__ int row_v(int r) { const int i = row_i(r); return i < CTXL ? 2 : row_b(r); }
__device__ __forceinline__ const float* xin_ptr(const float* ctx, const float* x, int r) {
    const int b = row_b(r), i = row_i(r);
    return i < CTXL ? ctx + (size_t)(b * CTXL + i) * D : x + (size_t)(b * SEQ + i - CTXL) * D;
}
struct RowRaw { f32x4 f[4]; u32x2 h[4]; };
__device__ __forceinline__ void row_load(CP p, int l, int r, int lane, RowRaw& rr) {
    if (l == 0) { const f32x4* hr = (const f32x4*)xin_ptr(p->ctx, p->x, r);
#pragma unroll
        for (int j = 0; j < 4; ++j) rr.f[j] = __builtin_nontemporal_load(hr + lane + 64 * j); }
    else { const u32x2* hr = (const u32x2*)((const bf16_t*)(p->ws + WS_H) + (size_t)r * D);
#pragma unroll
        for (int j = 0; j < 4; ++j) rr.h[j] = hr[lane + 64 * j]; }
}
__device__ __forceinline__ void row_cvt(int l, const RowRaw& rr, f32x4 (&xv)[4]) {
#pragma unroll
    for (int j = 0; j < 4; ++j) xv[j] = l == 0 ? rr.f[j] : (f32x4){bflo(rr.h[j].x), bfhi(rr.h[j].x), bflo(rr.h[j].y), bfhi(rr.h[j].y)};
}
namespace pg8 {
constexpr int BM = 256, BK = 64, HALF = 128, HTB = HALF * BK * 2, STAGE_BYTES = 8 * HTB, NXCD = 8, WGM = 8;
__device__ __forceinline__ int lds_byte(int r, int c) { const int st = (r >> 4) * 2 + (c >> 5), rr = r & 15, cc = c & 31, ob = rr * 64 + cc * 2; return st * 1024 + (ob ^ (((ob >> 9) & 1) << 5)); }
__device__ __forceinline__ void stage_rc(int b, int& Rr, int& Cc) { const int st = b / 1024, sb = b % 1024, swz = sb ^ (((sb >> 9) & 1) << 5); Rr = (st >> 1) * 16 + swz / 64; Cc = (st & 1) * 32 + (swz % 64) / 2; }
__device__ __forceinline__ int perm32(int rho) { const int n = rho >> 4, i = rho & 15; return 8 * (i >> 2) + 4 * n + (i & 3); }

struct Unit {
    const char* a0;
    const char* b0;
    const char* b1;
    int i0, i1, i2, i3, i4, pad;
};

template <class Epi, class Sched, bool GATHER>
__device__ __forceinline__ void gemm_phase(LAS unsigned char* lds, const int lda, const int ldb, const int K, const Sched& S, const Epi& E) {
    const int tid = launder_tid(); const int wid = __builtin_amdgcn_readfirstlane(tid >> 6), lane = tid & 63, wr = wid >> 2, wc = wid & 3, fr = lane & 15, fq = lane >> 4;
    const int nt = K / BK, ks = nt >> 1;
    int Rr[2], Cc[2];
    unsigned voffB[2];
#pragma unroll
    for (int i = 0; i < 2; ++i) { stage_rc(tid * 16 + i * 8192, Rr[i], Cc[i]); const int Rb = Epi::PERM ? ((Rr[i] & ~31) + perm32(Rr[i] & 31)) : Rr[i];
        voffB[i] = (unsigned)(Rb * ldb + Cc[i]) * 2u; }
    const size_t kstep = (size_t)(BK * 2);
    const size_t hstepB = (size_t)HALF * ldb * 2;
    const unsigned ldsw = (unsigned)wid * 1024u;
    const unsigned ldsbase = (unsigned)(unsigned long)lds;
    const int aoff = lds_byte(wr * 64 + fr, fq * 8), boff = lds_byte(wc * 32 + fr, fq * 8);
#define PG8_SA(b, h) (((b) * 2 + (h)) * HTB)
#define PG8_SB(b, h) ((4 + (b) * 2 + (h)) * HTB)
#define PG8_STAGE2(bufoff, gbase, v0, v1) do { unsigned keep_; \
        asm volatile("s_mov_b32 %0, m0\n\ts_mov_b32 m0, %1\n\ts_nop 4\n\tglobal_load_lds_dwordx4 %2, %4\n\ts_add_u32 m0, m0, 0x2000\n\ts_nop 0\n\tglobal_load_lds_dwordx4 %3, %4\n\ts_mov_b32 m0, %0" \
            : "=&s"(keep_) : "s"(ldsbase + (unsigned)(bufoff) + ldsw), "v"(v0), "v"(v1), "s"(gbase) : "memory", "scc"); } while (0)
#define PG8_LDA(dst, b, h) do { _Pragma("unroll") for (int m = 0; m < 4; ++m) _Pragma("unroll") for (int k = 0; k < 2; ++k) dst[m][k] = *(const LAS bf16x8*)(lds + PG8_SA(b, h) + aoff + m * 2048 + k * 1024); } while (0)
#define PG8_LDB(dst, b, h) do { _Pragma("unroll") for (int n = 0; n < 2; ++n) _Pragma("unroll") for (int k = 0; k < 2; ++k) dst[n][k] = *(const LAS bf16x8*)(lds + PG8_SB(b, h) + boff + n * 2048 + k * 1024); } while (0)
#define PG8_MMA(ai, bj, At, Bt) do { __builtin_amdgcn_s_setprio(1); _Pragma("unroll") for (int m = 0; m < 4; ++m) _Pragma("unroll") for (int n = 0; n < 2; ++n) _Pragma("unroll") for (int k = 0; k < 2; ++k) \
        acc[ai][bj][m][n] = __builtin_amdgcn_mfma_f32_16x16x32_bf16(Bt[n][k], At[m][k], acc[ai][bj][m][n], 0, 0, 0); __builtin_amdgcn_s_setprio(0); } while (0)
#define PG8_WAIT_V(n) asm volatile("s_waitcnt vmcnt(" #n ")" ::: "memory")
#define PG8_WAIT_L(n) asm volatile("s_waitcnt lgkmcnt(" #n ")" ::: "memory")
#define PG8_BAR __builtin_amdgcn_s_barrier()
#define PG8_SCHED __builtin_amdgcn_sched_barrier(0)
#define PG8_BP(u, tt) ((tt) < ks ? (u).b0 + (size_t)(tt) * kstep : (u).b1 + (size_t)((tt) - ks) * kstep)
    Unit cur, nxt; int ui = 0;
    if (!S.get(0, cur)) return;
    S.a_ready(cur);
    unsigned c00, c01, c10, c11, n00, n01, n10, n11;
    if (GATHER) {
        c00 = (unsigned)(S.arow(cur, Rr[0]) * lda + Cc[0]) * 2u; c01 = (unsigned)(S.arow(cur, Rr[1]) * lda + Cc[1]) * 2u;
        c10 = (unsigned)(S.arow(cur, HALF + Rr[0]) * lda + Cc[0]) * 2u; c11 = (unsigned)(S.arow(cur, HALF + Rr[1]) * lda + Cc[1]) * 2u;
    } else {
        c00 = (unsigned)(Rr[0] * lda + Cc[0]) * 2u; c01 = (unsigned)(Rr[1] * lda + Cc[1]) * 2u;
        c10 = (unsigned)((HALF + Rr[0]) * lda + Cc[0]) * 2u; c11 = (unsigned)((HALF + Rr[1]) * lda + Cc[1]) * 2u;
    }
    n00 = c00; n01 = c01; n10 = c10; n11 = c11;
    f32x4 acc[2][2][4][2];
    float zr; asm volatile("v_mov_b32 %0, 0" : "=v"(zr));
#pragma unroll
    for (int a = 0; a < 2; ++a)
#pragma unroll
        for (int b = 0; b < 2; ++b)
#pragma unroll
            for (int m = 0; m < 4; ++m)
#pragma unroll
                for (int n = 0; n < 2; ++n) acc[a][b][m][n] = (f32x4){zr, zr, zr, zr};
    bf16x8 At[4][2], B0[2][2], B1[2][2];
    const char* cA = cur.a0;
    {
        const char* pb0 = PG8_BP(cur, 0); const char* pb1 = PG8_BP(cur, 1);
        PG8_STAGE2(PG8_SB(0, 0), pb0, voffB[0], voffB[1]); PG8_STAGE2(PG8_SA(0, 0), cA, c00, c01);
        PG8_STAGE2(PG8_SB(0, 1), pb0 + hstepB, voffB[0], voffB[1]); PG8_STAGE2(PG8_SA(0, 1), cA, c10, c11);
        if (wr == 1) PG8_BAR;
        PG8_WAIT_V(4); PG8_BAR;
        PG8_STAGE2(PG8_SB(1, 0), pb1, voffB[0], voffB[1]); PG8_STAGE2(PG8_SA(1, 0), cA + kstep, c00, c01);
        PG8_STAGE2(PG8_SB(1, 1), pb1 + hstepB, voffB[0], voffB[1]);
        PG8_WAIT_V(6); PG8_BAR;
    }
    for (;;) {
        const bool has_next = S.get(ui + 1, nxt);
        if (!has_next) nxt = cur;
        LAS int* tokb = (LAS int*)(lds + MISC_OFF + 1024) + ((ui + 1) & 1) * 256;
        if (GATHER) {
            n00 = c00; n01 = c01; n10 = c10; n11 = c11;
            if (has_next && wid == 0) {
                const char* src = (const char*)S.rows_ptr(nxt); unsigned keep_;
                asm volatile("s_mov_b32 %0, m0\n\ts_mov_b32 m0, %1\n\ts_nop 4\n\tglobal_load_lds_dwordx4 %2, %3\n\ts_mov_b32 m0, %0"
                    : "=&s"(keep_) : "s"((unsigned)(unsigned long)tokb), "v"((unsigned)lane * 16u), "s"(src) : "memory");
            }
        }
        const char* nA = nxt.a0;
#pragma unroll 1
        for (int t = 0; t < nt; t += 2) {
            const bool last = (t == nt - 2);
            if (last && has_next) S.a_ready(nxt);
            const char* a1 = cA + (size_t)(t + 1) * kstep;
            const char* a2 = last ? nA : cA + (size_t)(t + 2) * kstep;
            const char* a3 = a2 + kstep;
            const char* b2 = last ? PG8_BP(nxt, 0) : PG8_BP(cur, t + 2);
            const char* b3 = last ? PG8_BP(nxt, 1) : PG8_BP(cur, t + 3);
            if (GATHER) { if (last && has_next) {
                const int lim = S.rows_valid(nxt) - 1;
                const int i0 = Rr[0] < lim ? Rr[0] : lim, i1 = Rr[1] < lim ? Rr[1] : lim, i2 = (HALF + Rr[0]) < lim ? (HALF + Rr[0]) : lim, i3 = (HALF + Rr[1]) < lim ? (HALF + Rr[1]) : lim;
                n00 = (unsigned)(tokb[i0] * lda + Cc[0]) * 2u; n01 = (unsigned)(tokb[i1] * lda + Cc[1]) * 2u;
                n10 = (unsigned)(tokb[i2] * lda + Cc[0]) * 2u; n11 = (unsigned)(tokb[i3] * lda + Cc[1]) * 2u; } }
            const unsigned s00 = last ? n00 : c00, s01 = last ? n01 : c01, s10 = last ? n10 : c10, s11 = last ? n11 : c11;
            if constexpr (Epi::MIDSCALE) { if (t == ks) E.midscale(acc, cur, wr, wc, fr, fq); }
            PG8_LDB(B0, 0, 0); PG8_SCHED; PG8_LDA(At, 0, 0); PG8_STAGE2(PG8_SA(1, 1), a1, c10, c11);
            PG8_WAIT_L(8); PG8_BAR; PG8_WAIT_L(0); PG8_MMA(0, 0, At, B0); PG8_BAR; PG8_SCHED;
            PG8_LDB(B1, 0, 1); PG8_STAGE2(PG8_SB(0, 0), b2, voffB[0], voffB[1]);
            PG8_BAR; PG8_WAIT_L(0); PG8_MMA(0, 1, At, B1); PG8_BAR;
            PG8_LDA(At, 0, 1); PG8_STAGE2(PG8_SA(0, 0), a2, s00, s01);
            PG8_BAR; PG8_WAIT_L(0); PG8_MMA(1, 0, At, B0); PG8_BAR; PG8_SCHED;
            PG8_STAGE2(PG8_SB(0, 1), b2 + hstepB, voffB[0], voffB[1]);
            PG8_WAIT_V(6); PG8_BAR; PG8_MMA(1, 1, At, B1); PG8_BAR;
            PG8_LDB(B0, 1, 0); PG8_SCHED; PG8_LDA(At, 1, 0); PG8_STAGE2(PG8_SA(0, 1), a2, s10, s11);
            PG8_WAIT_L(8); PG8_BAR; PG8_WAIT_L(0); PG8_MMA(0, 0, At, B0); PG8_BAR; PG8_SCHED;
            PG8_LDB(B1, 1, 1); PG8_STAGE2(PG8_SB(1, 0), b3, voffB[0], voffB[1]);
            PG8_BAR; PG8_WAIT_L(0); PG8_MMA(0, 1, At, B1); PG8_BAR;
            PG8_LDA(At, 1, 1); PG8_STAGE2(PG8_SA(1, 0), a3, s00, s01);
            PG8_BAR; PG8_WAIT_L(0); PG8_MMA(1, 0, At, B0); PG8_BAR; PG8_SCHED;
            PG8_STAGE2(PG8_SB(1, 1), b3 + hstepB, voffB[0], voffB[1]);
            PG8_WAIT_V(6); PG8_BAR; PG8_MMA(1, 1, At, B1); PG8_BAR;
        }
        E(acc, cur, wr, wc, fr, fq);
        if (!has_next) break;
        asm volatile("v_mov_b32 %0, 0" : "=v"(zr));
#pragma unroll
        for (int a = 0; a < 2; ++a)
#pragma unroll
            for (int b = 0; b < 2; ++b)
#pragma unroll
                for (int m = 0; m < 4; ++m)
#pragma unroll
                    for (int n = 0; n < 2; ++n) acc[a][b][m][n] = (f32x4){zr, zr, zr, zr};
        cur = nxt; cA = nA; ++ui; c00 = n00; c01 = n01; c10 = n10; c11 = n11;
    }
    PG8_WAIT_V(0);
    if (wr == 0) PG8_BAR;
    PG8_BAR;
#undef PG8_SA
#undef PG8_SB
#undef PG8_STAGE2
#undef PG8_LDA
#undef PG8_LDB
#undef PG8_MMA
#undef PG8_WAIT_V
#undef PG8_WAIT_L
#undef PG8_BAR
#undef PG8_SCHED
#undef PG8_BP
}

struct DenseSched {
    const char* A; const char* Bt; int lda, ldb, K; int nM, nN, nwg, G, c, skipctx;
    __device__ __forceinline__ void init(const void* A_, const void* Bt_, int M, int N, int K_, int lda_, int ldb_, int G_, int c_, int skipctx_ = 0) {
        A = (const char*)A_; Bt = (const char*)Bt_; lda = lda_; ldb = ldb_; K = K_; nM = M / BM - 2 * skipctx_; nN = N / BM; nwg = nM * nN; G = G_; c = c_; skipctx = skipctx_; }
    __device__ __forceinline__ bool get(int i, Unit& u) const {
        const long L = (long)i * G + c; if (L >= nwg) return false;
        int wgid = (int)L; { const int q = nwg / NXCD, r = nwg % NXCD, xcd = wgid % NXCD, off = wgid / NXCD; wgid = (xcd < r ? xcd * (q + 1) : r * (q + 1) + (xcd - r) * q) + off; }
        const int nig = WGM * nN, gid = wgid / nig, fm = gid * WGM, gsz = (nM - fm) < WGM ? (nM - fm) : WGM;
        int pm = fm + ((wgid % nig) % gsz); const int pn = (wgid % nig) / gsz;
        if (skipctx) pm += 1 + (pm >= 64 ? 1 : 0);
        u.a0 = A + (size_t)pm * BM * lda * 2; u.b0 = Bt + (size_t)pn * BM * ldb * 2; u.b1 = u.b0 + (size_t)(K / BK / 2) * BK * 2;
        u.i0 = pm; u.i1 = pn; u.i2 = 0; u.i3 = 0; u.i4 = 0; u.pad = 0; return true;
    }
    __device__ __forceinline__ void a_ready(const Unit&) const {}
    __device__ __forceinline__ int arow(const Unit&, int rl) const { return rl; }
    __device__ __forceinline__ const int* rows_ptr(const Unit&) const { return nullptr; }
    __device__ __forceinline__ int rows_valid(const Unit&) const { return 256; }
};
}

struct EpiProj {
    static constexpr bool PERM = true, MIDSCALE = false;
    bf16_t* O;
    __device__ __forceinline__ void operator()(const f32x4 (&acc)[2][2][4][2], const pg8::Unit& u, int wr, int wc, int fr, int fq) const {
        const int pn = u.i1;
        const int row0 = u.i0 * 256 + wr * 64 + fr;
        if (pn < 4) {
            const int col0 = pn * 128 + wc * 32 + 8 * fq;
#pragma unroll
            for (int ai = 0; ai < 2; ++ai)
#pragma unroll
                for (int m = 0; m < 4; ++m) { const f32x4 u0 = acc[ai][0][m][0], u1 = acc[ai][0][m][1], g0 = acc[ai][1][m][0], g1 = acc[ai][1][m][1];
                    u32x4 w; w.x = cvt_pk_bf16(u0[0] * sigmoidf_(g0[0]), u0[1] * sigmoidf_(g0[1])); w.y = cvt_pk_bf16(u0[2] * sigmoidf_(g0[2]), u0[3] * sigmoidf_(g0[3]));
                    w.z = cvt_pk_bf16(u1[0] * sigmoidf_(g1[0]), u1[1] * sigmoidf_(g1[1])); w.w = cvt_pk_bf16(u1[2] * sigmoidf_(g1[2]), u1[3] * sigmoidf_(g1[3]));
                    __builtin_nontemporal_store(w, (u32x4*)(O + (size_t)(row0 + ai * 128 + m * 16) * NPROJ + col0)); }
        } else {
            const int col0 = pn * 256 + wc * 32 + 8 * fq; const bool sl = pn < 6;
#pragma unroll
            for (int ai = 0; ai < 2; ++ai)
#pragma unroll
                for (int m = 0; m < 4; ++m) { bf16_t* rowp = O + (size_t)(row0 + ai * 128 + m * 16) * NPROJ + col0;
#pragma unroll
                    for (int bj = 0; bj < 2; ++bj) { f32x4 v0 = acc[ai][bj][m][0], v1 = acc[ai][bj][m][1];
                        if (sl) {
#pragma unroll
                            for (int e = 0; e < 4; ++e) { v0[e] = siluf_(v0[e]); v1[e] = siluf_(v1[e]); } }
                        u32x4 w; w.x = cvt_pk_bf16(v0[0], v0[1]); w.y = cvt_pk_bf16(v0[2], v0[3]); w.z = cvt_pk_bf16(v1[0], v1[1]); w.w = cvt_pk_bf16(v1[2], v1[3]);
                        __builtin_nontemporal_store(w, (u32x4*)(rowp + bj * 128)); } }
        }
    }
};
template <int L0> struct EpiResid {
    static constexpr bool PERM = true, MIDSCALE = true;
    const float* inc; const float* inx; bf16_t* H; const float* modl; const float* ssq;
    __device__ __forceinline__ void midscale(f32x4 (&acc)[2][2][4][2], const pg8::Unit& u, int wr, int wc, int fr, int fq) const {
        typedef float f32x2 __attribute__((ext_vector_type(2)));
        const int r0 = u.i0 * 256 + wr * 64 + fr;
        f32x2 part[2][4];
#pragma unroll
        for (int ai = 0; ai < 2; ++ai)
#pragma unroll
            for (int m = 0; m < 4; ++m) part[ai][m] = *(const f32x2*)(ssq + (size_t)(r0 + ai * 128 + m * 16) * 8 + 2 * fq);
#pragma unroll
        for (int ai = 0; ai < 2; ++ai)
#pragma unroll
            for (int m = 0; m < 4; ++m) { float sq = part[ai][m][0] + part[ai][m][1];
                sq += __shfl_xor(sq, 16); sq += __shfl_xor(sq, 32);
                const float rs = rsqrtf(sq * (1.f / 512.f) + 1e-6f);
#pragma unroll
                for (int bj = 0; bj < 2; ++bj)
#pragma unroll
                    for (int n = 0; n < 2; ++n) acc[ai][bj][m][n] *= rs; }
    }
    __device__ __forceinline__ void operator()(const f32x4 (&acc)[2][2][4][2], const pg8::Unit& u, int wr, int wc, int fr, int fq) const {
        const int r0 = u.i0 * 256;
        const int v = row_v(r0);
        const float* gate = modl + (size_t)v * 6144 + 2 * 1024;
        const float* xin = xin_ptr(inc, inx, r0);
        const int rl0 = wr * 64 + fr, col0 = u.i1 * 256 + wc * 32 + 8 * fq;
        f32x4 gv[2][2];
#pragma unroll
        for (int bj = 0; bj < 2; ++bj)
#pragma unroll
            for (int n = 0; n < 2; ++n) gv[bj][n] = *(const f32x4*)(gate + col0 + bj * 128 + 4 * n);
#pragma unroll
        for (int ai = 0; ai < 2; ++ai) {
            u32x4 hr[4][2];
#pragma unroll
            for (int m = 0; m < 4; ++m)
#pragma unroll
                for (int bj = 0; bj < 2; ++bj) hr[m][bj] = *(const u32x4*)(H + (size_t)(r0 + rl0 + ai * 128 + m * 16) * D + col0 + bj * 128);
#pragma unroll
            for (int m = 0; m < 4; ++m)
#pragma unroll
                for (int bj = 0; bj < 2; ++bj) { const u32x4 hv = hr[m][bj]; const f32x4 a0 = acc[ai][bj][m][0], a1 = acc[ai][bj][m][1]; const f32x4 g0 = gv[bj][0], g1 = gv[bj][1];
                    u32x4 w;
                    w.x = cvt_pk_bf16(bflo(hv.x) + g0[0] * a0[0], bfhi(hv.x) + g0[1] * a0[1]); w.y = cvt_pk_bf16(bflo(hv.y) + g0[2] * a0[2], bfhi(hv.y) + g0[3] * a0[3]);
                    w.z = cvt_pk_bf16(bflo(hv.z) + g1[0] * a1[0], bfhi(hv.z) + g1[1] * a1[1]); w.w = cvt_pk_bf16(bflo(hv.w) + g1[2] * a1[2], bfhi(hv.w) + g1[3] * a1[3]);
                    *(u32x4*)(H + (size_t)(r0 + rl0 + ai * 128 + m * 16) * D + col0 + bj * 128) = w; }
            asm volatile("" ::: "memory"); }
    }
};

__device__ __forceinline__ const char* uniform_ptr(const char* q) {
    const unsigned long long v = (unsigned long long)q;
    const unsigned lo = __builtin_amdgcn_readfirstlane((unsigned)v), hi = __builtin_amdgcn_readfirstlane((unsigned)(v >> 32));
    return (const char*)(((unsigned long long)hi << 32) | lo);
}
struct MoeSched {
    const LAS int* tab;
    const int* list;
    const char* A; const char* W; int mode  , l, G, c;
    unsigned* ready;
    __device__ __forceinline__ void a_ready(const pg8::Unit& u) const {
        if (mode == 0) return;
        if (threadIdx.x < 64) {
            unsigned* w = ready + u.i4; unsigned spins = 0;
            while ((unsigned)__builtin_amdgcn_readfirstlane((int)__hip_atomic_load(w, __ATOMIC_RELAXED, __HIP_MEMORY_SCOPE_AGENT)) < 32u) {
                __builtin_amdgcn_s_sleep(2); if (++spins > (1u << 22)) break; }
            __builtin_amdgcn_fence(__ATOMIC_ACQUIRE, "agent");
            asm volatile("s_waitcnt vmcnt(0)" ::: "memory");
        }
        asm volatile("" ::: "memory"); __builtin_amdgcn_s_barrier(); asm volatile("" ::: "memory");
    }
    int late;
    __device__ __forceinline__ bool get(int i, pg8::Unit& u) const {
        const int total = __builtin_amdgcn_readfirstlane(tab[24]) * 4;
        int L;
        if (mode == 0 || late == 0) L = i * G + c;
        else if (c < late) { if (i > 0) return false; L = c; }
        else L = late + (c - late) + i * (G - late);
        if (L >= total) return false;
        const int tl = L >> 2, pn = L & 3;
        int cls = 0;
#pragma unroll 1
        for (int q = 1; q < NCLS; ++q) { const int tq = __builtin_amdgcn_readfirstlane(tab[q]); if (tq <= tl) cls = q; }
        const int j = tl - __builtin_amdgcn_readfirstlane(tab[cls]), cnt = __builtin_amdgcn_readfirstlane(tab[32 + cls]);
        const int g = cls / 6, pidx = cls - g * 6;
        const int ea = (pidx >= 3) + (pidx >= 5), eb = pidx < 3 ? pidx + 1 : (pidx < 5 ? pidx - 1 : 3);
        if (mode == 0) {
            const int e = 4 * g + (pn < 2 ? ea : eb);
            u.a0 = A;
            u.b0 = W + ((size_t)(l * 16 + e) * 512 + (size_t)(pn & 1) * 256) * 1024 * 2; u.b1 = u.b0 + (size_t)8 * 128;
        } else {
            u.a0 = A + (size_t)tl * 256 * 512 * 2;
            u.b0 = W + ((size_t)(l * 16 + 4 * g + ea) * 1024 + (size_t)pn * 256) * 256 * 2;
            u.b1 = W + ((size_t)(l * 16 + 4 * g + eb) * 1024 + (size_t)pn * 256) * 256 * 2;
        }
        u.a0 = uniform_ptr(u.a0); u.b0 = uniform_ptr(u.b0); u.b1 = uniform_ptr(u.b1);
        u.i0 = cls; u.i1 = j; u.i2 = pn; u.i3 = cnt; u.i4 = tl; u.pad = 0; return true;
    }
    __device__ __forceinline__ int arow(const pg8::Unit& u, int rl) const {
        int idx = u.i1 * 256 + rl; idx = idx < u.i3 ? idx : u.i3 - 1;
        return list[(size_t)u.i0 * R + idx];
    }
    __device__ __forceinline__ const int* rows_ptr(const pg8::Unit& u) const { return list + (size_t)u.i0 * R + u.i1 * 256; }
    __device__ __forceinline__ int rows_valid(const pg8::Unit& u) const { return u.i3 - u.i1 * 256; }
};
struct EpiUp {
    static constexpr bool PERM = true, MIDSCALE = false;
    bf16_t* hid; const float* cwla; const float* cwlb; unsigned* ready;
    __device__ __forceinline__ void operator()(const f32x4 (&acc)[2][2][4][2], const pg8::Unit& u, int wr, int wc, int fr, int fq) const {
        const int cls = u.i0, j = u.i1, pn = u.i2, cnt = u.i3, tl = u.i4;
        const float* cw = (pn < 2) ? cwla : cwlb;
        const int colbase = (pn >> 1) * 256 + (pn & 1) * 128 + wc * 32 + 8 * fq;
        float wrow[2][4];
#pragma unroll
        for (int ai = 0; ai < 2; ++ai)
#pragma unroll
            for (int m = 0; m < 4; ++m) { const int idx = j * 256 + ai * 128 + wr * 64 + m * 16 + fr; wrow[ai][m] = idx < cnt ? cw[(size_t)cls * R + idx] : 0.f; }
#pragma unroll
        for (int ai = 0; ai < 2; ++ai)
#pragma unroll
            for (int m = 0; m < 4; ++m) {
                const int rl = ai * 128 + wr * 64 + m * 16 + fr; const int idx = j * 256 + rl; const bool valid = idx < cnt;
                const float w = wrow[ai][m];
                const f32x4 g0 = acc[ai][0][m][0], g1 = acc[ai][0][m][1], u0 = acc[ai][1][m][0], u1 = acc[ai][1][m][1];
                float o[8];
#pragma unroll
                for (int e = 0; e < 4; ++e) { o[e] = w * siluf_(g0[e]) * u0[e]; o[4 + e] = w * siluf_(g1[e]) * u1[e]; }
                if (!valid) {
#pragma unroll
                    for (int e = 0; e < 8; ++e) o[e] = 0.f; }
                u32x4 pk; pk.x = cvt_pk_bf16(o[0], o[1]); pk.y = cvt_pk_bf16(o[2], o[3]); pk.z = cvt_pk_bf16(o[4], o[5]); pk.w = cvt_pk_bf16(o[6], o[7]);
                { bf16_t* dstp = hid + ((size_t)tl * 256 + rl) * 512 + colbase;
                  asm volatile("global_store_dwordx4 %0, %1, off sc1\n\ts_nop 1" :: "v"(dstp), "v"(pk) : "memory"); }
            }
        asm volatile("s_waitcnt vmcnt(0)" ::: "memory");
        if ((threadIdx.x & 63) == 0) __hip_atomic_fetch_add(ready + tl, 1u, __ATOMIC_RELAXED, __HIP_MEMORY_SCOPE_AGENT);
    }
};
struct EpiDown {
    static constexpr bool PERM = true, MIDSCALE = false;
    bf16_t* H; const int* list; const LAS float* gl;
    __device__ __forceinline__ void operator()(const f32x4 (&acc)[2][2][4][2], const pg8::Unit& u, int wr, int wc, int fr, int fq) const {
        const int cls = u.i0, j = u.i1, pn = u.i2, cnt = u.i3;
        const int col0 = pn * 256 + wc * 32 + 8 * fq;
        int tok[2][4];
#pragma unroll
        for (int ai = 0; ai < 2; ++ai)
#pragma unroll
            for (int m = 0; m < 4; ++m) { const int idx = j * 256 + ai * 128 + wr * 64 + m * 16 + fr; tok[ai][m] = idx < cnt ? list[(size_t)cls * R + idx] : -1; }
        u32x4 hr[2][2][2];
#define EPD_LOAD(bt) do { _Pragma("unroll") for (int mm = 0; mm < 2; ++mm) { const int t = tok[(bt) >> 1][2 * ((bt) & 1) + mm]; const bf16_t* hp = H + (size_t)(t < 0 ? 0 : t) * D + col0; \
            _Pragma("unroll") for (int bj = 0; bj < 2; ++bj) hr[(bt) & 1][mm][bj] = *(const u32x4*)(hp + bj * 128); } } while (0)
        EPD_LOAD(0);
#pragma unroll
        for (int bt = 0; bt < 4; ++bt) { const int ai = bt >> 1, mp = bt & 1;
            if (bt + 1 < 4) EPD_LOAD(bt + 1);
#pragma unroll
            for (int mm = 0; mm < 2; ++mm) { const int m = 2 * mp + mm; const int t = tok[ai][m];
                if (t >= 0) { const LAS float* gp = gl + row_v(t) * 1024 + col0;
#pragma unroll
                    for (int bj = 0; bj < 2; ++bj) { const u32x4 hv = hr[bt & 1][mm][bj]; const f32x4 a0 = acc[ai][bj][m][0], a1 = acc[ai][bj][m][1];
                        const f32x4 g0 = *(const LAS f32x4*)(gp + bj * 128), g1 = *(const LAS f32x4*)(gp + bj * 128 + 4);
                        u32x4 w;
                        w.x = cvt_pk_bf16(bflo(hv.x) + g0[0] * a0[0], bfhi(hv.x) + g0[1] * a0[1]); w.y = cvt_pk_bf16(bflo(hv.y) + g0[2] * a0[2], bfhi(hv.y) + g0[3] * a0[3]);
                        w.z = cvt_pk_bf16(bflo(hv.z) + g1[0] * a1[0], bfhi(hv.z) + g1[1] * a1[1]); w.w = cvt_pk_bf16(bflo(hv.w) + g1[2] * a1[2], bfhi(hv.w) + g1[3] * a1[3]);
                        *(u32x4*)(H + (size_t)t * D + col0 + bj * 128) = w; } } }
            asm volatile("" ::: "memory"); }
#undef EPD_LOAD
    }
};

__device__ __forceinline__ void tr_tile(const float* src, int ldn, int k0, int n0, int nvalid, bf16_t* dst, int ldk, int drow0, LAS float* tile, int kd0 = -1, const float* kscale = nullptr) {
    const int tid = launder_tid();
    if (kd0 < 0) kd0 = k0;
    { const int n = tid & 63; const int kq = tid >> 6; float tv[8], ts[8];
#pragma unroll
      for (int it = 0; it < 8; ++it) { const int kk = kq + 8 * it; tv[it] = (n < nvalid) ? src[(size_t)(k0 + kk) * ldn + n0 + n] : 0.f; ts[it] = kscale ? kscale[kk] : 1.f; }
#pragma unroll
      for (int it = 0; it < 8; ++it) tile[(kq + 8 * it) * 65 + n] = tv[it] * ts[it]; }
    __syncthreads();
    { const int k8 = tid & 7, n = tid >> 3;
      if (n < nvalid) { const LAS float* s = tile + (k8 * 8) * 65 + n;
          u32x4 o; o.x = cvt_pk_bf16(s[0], s[65]); o.y = cvt_pk_bf16(s[2 * 65], s[3 * 65]); o.z = cvt_pk_bf16(s[4 * 65], s[5 * 65]); o.w = cvt_pk_bf16(s[6 * 65], s[7 * 65]);
          *(u32x4*)(dst + (size_t)(drow0 + n) * ldk + kd0 + k8 * 8) = o; } }
    __syncthreads();
}
constexpr int WPREP_ITEMS_PER_LAYER = 16 * 41 + 256 + 1024 + 1024 + 1024;
__device__ __forceinline__ void phase_wprep(CP p, unsigned char* lds, int it0, int it1, int bidx, int nblk, int b0 = 0, int b1 = 0, int c0 = 0, int c1 = 0) {
    LAS float* tile = (LAS float*)(LAS unsigned char*)lds;
    constexpr int I_IN = 16 * 41, I_OUT = 256, I_G = 1024, I_U = 1024, I_D = 1024, I_L = I_IN + I_OUT + I_G + I_U + I_D;
    const int na = it1 - it0, nbb = b1 - b0, ncc = c1 - c0;
    for (int vi = bidx; vi < na + nbb + ncc; vi += nblk) {
        const int it = vi < na ? it0 + vi : (vi < na + nbb ? b0 + (vi - na) : c0 + (vi - na - nbb));
        const int l = it / I_L; int r = it - l * I_L;
        if (r < I_IN) { const int kt = r / 41, ntl = r % 41; const int n0 = ntl * 64; const int nv = (DIN - n0) < 64 ? (DIN - n0) : 64;
            const int dr = n0 < 512 ? (n0 >> 7) * 256 + (n0 & 127) : (n0 < 1024 ? ((n0 - 512) >> 7) * 256 + 128 + ((n0 - 512) & 127) : n0);
            tr_tile(p->w_in + (size_t)l * 1024 * DIN, DIN, kt * 64, n0, nv, (bf16_t*)(p->ws + WS_WTIN) + (size_t)l * DIN * 1024, 1024, dr, tile); continue; }
        r -= I_IN;
        if (r < I_OUT) { const int kt = r >> 4, ntl = r & 15;
            tr_tile(p->w_out + (size_t)l * 1024 * 1024, 1024, kt * 64, ntl * 64, 64, (bf16_t*)(p->ws + WS_WTOUT) + (size_t)l * 1024 * 1024, 1024, ntl * 64, tile,
                    (kt * 64 + 512) & 1023, kt >= 8 ? p->ssd_norm_g + l * 512 + (kt * 64 - 512) : nullptr); continue; }
        r -= I_OUT;
        if (r < I_G + I_U) { const int up = r >= I_G; if (up) r -= I_G; const int e = r >> 6, q = r & 63, kt = q >> 2, ntl = q & 3; const int n0 = ntl * 64;
            const float* src = (up ? p->w_up : p->w_gate) + (size_t)(l * 16 + e) * 1024 * 256;
            tr_tile(src, 256, kt * 64, n0, 64, (bf16_t*)(p->ws + WS_WTGU) + (size_t)(l * 16 + e) * 512 * 1024, 1024, (n0 >> 7) * 256 + (n0 & 127) + (up ? 128 : 0), tile); continue; }
        r -= I_G + I_U;
        { const int e = r >> 6, q = r & 63, kt = q >> 4, ntl = q & 15;
          tr_tile(p->w_down + (size_t)(l * 16 + e) * 256 * 1024, 1024, kt * 64, ntl * 64, 64, (bf16_t*)(p->ws + WS_WTD) + (size_t)(l * 16 + e) * 1024 * 256, 256, ntl * 64, tile); }
    }
}
__device__ __forceinline__ void phase_adaln(CP p, unsigned char* lds, int bid, int nb) {
    LAS float* sc = (LAS float*)(LAS unsigned char*)lds;
    LAS float* red = sc + 3 * 1024;
    const int tid = launder_tid();
    for (int idx = tid; idx < 3 * 1024; idx += NTHREADS) { const int v = idx >> 10, k = idx & 1023; const float cv = (v < 2) ? p->c[v * 1024 + k] : p->c_ctx[k]; sc[idx] = siluf_(cv); }
    __syncthreads();
    float* mod = (float*)(p->ws + WS_MOD);
    for (int it = bid; it < 2 * 96; it += nb) {
        const int l = it / 96, n0 = (it % 96) * 64;
        const int c4 = tid & 15, kr = tid >> 4;
        f32x4 a0 = {0, 0, 0, 0}, a1 = {0, 0, 0, 0}, a2 = {0, 0, 0, 0};
        const float* w = p->w_ada + (size_t)l * 1024 * 6144 + n0 + c4 * 4;
#pragma unroll 4
        for (int k = kr; k < 1024; k += 32) { const f32x4 w4 = *(const f32x4*)(w + (size_t)k * 6144); a0 += sc[k] * w4; a1 += sc[1024 + k] * w4; a2 += sc[2048 + k] * w4; }
        *(LAS f32x4*)(red + (kr * 3 + 0) * 64 + c4 * 4) = a0; *(LAS f32x4*)(red + (kr * 3 + 1) * 64 + c4 * 4) = a1; *(LAS f32x4*)(red + (kr * 3 + 2) * 64 + c4 * 4) = a2;
        __syncthreads();
        if (tid < 192) { const int v = tid >> 6, cc = tid & 63; float s = 0.f;
            for (int q = 0; q < 32; ++q) s += red[(q * 3 + v) * 64 + cc];
            mod[((size_t)l * 3 + v) * 6144 + n0 + cc] = s + p->b_ada[l * 6144 + n0 + cc]; }
        __syncthreads();
    }
}
__device__ __forceinline__ void moe_table(CP p, int l, LAS int* tab) {
    const int* gcount = (const int*)(p->ws + WS_CTL) + l * 32;
    if (threadIdx.x == 0) { int acc = 0; for (int q = 0; q < NCLS; ++q) { const int cn = gcount[q]; tab[q] = acc; tab[32 + q] = cn; acc += (cn + 255) >> 8; } tab[24] = acc; }
    __syncthreads();
}
typedef _Float16 f16x8 __attribute__((ext_vector_type(8)));
typedef _Float16 f16x2 __attribute__((ext_vector_type(2)));
constexpr int ST_H16 = 2064;
__device__ __forceinline__ unsigned pack_f16(float a, float b) { f16x2 h; h[0] = (_Float16)a; h[1] = (_Float16)b; return __builtin_bit_cast(unsigned, h); }
__device__ __forceinline__ void phase_r1(CP p, int l, unsigned char* lds_, int bid, int nb) {
    LAS unsigned char* lds = (LAS unsigned char*)lds_;
    LAS unsigned char* Wh = lds;
    LAS unsigned char* Xh = Wh + 16 * ST_H16;
    LAS float* gm = (LAS float*)(Xh + 16 * ST_H16);
    LAS float* sh = gm + 3 * 1024;
    LAS float* part = sh + 3 * 1024;
    const int tid = launder_tid(); const int lane = tid & 63, wave = __builtin_amdgcn_readfirstlane(tid >> 6);
    const float* mod = (const float*)(p->ws + WS_MOD) + (size_t)l * 3 * 6144;
    const float* win = p->w_in + (size_t)l * 1024 * DIN;
#pragma unroll
    for (int hb = 0; hb < 2; ++hb) { float tmp[16];
#pragma unroll
        for (int it = 0; it < 16; ++it) { const int idx = tid + NTHREADS * (16 * hb + it); tmp[it] = win[(size_t)(idx >> 4) * DIN + NPROJ + (idx & 15)]; }
#pragma unroll
        for (int it = 0; it < 16; ++it) { const int idx = tid + NTHREADS * (16 * hb + it); *(LAS _Float16*)(Wh + (idx & 15) * ST_H16 + (idx >> 4) * 2) = (_Float16)tmp[it]; } }
    { float t0[6], t1[6], t2[6];
#pragma unroll
      for (int it = 0; it < 6; ++it) { const int idx = tid + NTHREADS * it; const int v = idx >> 10, k = idx & 1023; t0[it] = p->g_mix[l * 1024 + k]; t1[it] = mod[v * 6144 + 1024 + k]; t2[it] = mod[v * 6144 + k]; }
#pragma unroll
      for (int it = 0; it < 6; ++it) { const int idx = tid + NTHREADS * it; gm[idx] = t0[it] * (1.f + t1[it]); sh[idx] = t2[it]; } }
    __syncthreads();
    bf16_t* HX = (bf16_t*)(p->ws + WS_HX); float* DT = (float*)(p->ws + WS_DT);
    const int rpb = (R + nb - 1) / nb, r0 = bid * rpb, r1 = (r0 + rpb) < R ? (r0 + rpb) : R;
    RowRaw xn[2];
#pragma unroll
    for (int q = 0; q < 2; ++q) if (r0 + 2 * wave + q < r1) row_load(p, l, r0 + 2 * wave + q, lane, xn[q]);
#pragma unroll 1
    for (int t0r = r0; t0r < r1; t0r += 16) {
        f32x4 xv[2][4];
#pragma unroll
        for (int q = 0; q < 2; ++q) row_cvt(l, xn[q], xv[q]);
#pragma unroll
        for (int q = 0; q < 2; ++q) if (t0r + 16 + 2 * wave + q < r1) row_load(p, l, t0r + 16 + 2 * wave + q, lane, xn[q]);
#pragma unroll
        for (int q = 0; q < 2; ++q) { const int rr = t0r + 2 * wave + q; const bool ok = rr < r1; const int v = row_v(ok ? rr : r0);
            if (l == 0 && ok) { u32x2* hw = (u32x2*)((bf16_t*)(p->ws + WS_H) + (size_t)rr * D);
#pragma unroll
                for (int j = 0; j < 4; ++j) { u32x2 o; o.x = cvt_pk_bf16(xv[q][j][0], xv[q][j][1]); o.y = cvt_pk_bf16(xv[q][j][2], xv[q][j][3]); hw[lane + 64 * j] = o; } }
            float ss = 0.f;
#pragma unroll
            for (int j = 0; j < 4; ++j) ss += xv[q][j][0] * xv[q][j][0] + xv[q][j][1] * xv[q][j][1] + xv[q][j][2] * xv[q][j][2] + xv[q][j][3] * xv[q][j][3];
            ss = wave_sum(ss); const float rs = ok ? __builtin_amdgcn_rsqf(ss * (1.f / 1024.f) + 1e-6f) : 0.f;
#pragma unroll
            for (int j = 0; j < 4; ++j) { const int k = 4 * lane + 256 * j; const f32x4 g4 = *(const LAS f32x4*)(gm + v * 1024 + k), s4 = *(const LAS f32x4*)(sh + v * 1024 + k);
                f32x4 hv = xv[q][j] * rs * g4 + s4; if (!ok) hv = hv * 0.f;
                u32x2 o; o.x = cvt_pk_bf16(hv[0], hv[1]); o.y = cvt_pk_bf16(hv[2], hv[3]);
                if (ok) *(u32x2*)(HX + (size_t)rr * 1024 + k) = o;
                u32x2 h16; h16.x = pack_f16(hv[0], hv[1]); h16.y = pack_f16(hv[2], hv[3]);
                *(LAS u32x2*)(Xh + (2 * wave + q) * ST_H16 + k * 2) = h16; } }
        __syncthreads();
        {
            f32x4 acc0 = {0.f, 0.f, 0.f, 0.f};
#pragma unroll
            for (int s4 = 0; s4 < 4; ++s4) { const int kb = (128 * wave + 32 * s4 + 8 * (lane >> 4)) * 2;
                const f16x8 a = *(const LAS f16x8*)(Xh + (lane & 15) * ST_H16 + kb);
                const f16x8 b0 = *(const LAS f16x8*)(Wh + (lane & 15) * ST_H16 + kb);
                acc0 = __builtin_amdgcn_mfma_f32_16x16x32_f16(a, b0, acc0, 0, 0, 0); }
#pragma unroll
            for (int e = 0; e < 4; ++e) part[(wave * 16 + 4 * (lane >> 4) + e) * 16 + (lane & 15)] = acc0[e];
        }
        __syncthreads();
        if (tid < 256) { const int row = tid >> 4, n = tid & 15; const int rr = t0r + row;
            float sacc = p->dt_bias[l * 16 + n];
#pragma unroll
            for (int w = 0; w < 8; ++w) sacc += part[(w * 16 + row) * 16 + n];
            if (rr < r1) DT[(size_t)n * R + rr] = softplusf_(sacc); }
    }
    __syncthreads();
}
typedef float f32x16 __attribute__((ext_vector_type(16)));
typedef short s16x4 __attribute__((ext_vector_type(4)));
constexpr int ST_ROW = 272;
constexpr int ST_TR128 = 320;
constexpr int ST_TR64 = 192;
constexpr int ST_MT = 328;
constexpr int NCHUNK = SEG / 128;

#define DPP_MOV(v, ctrl, rm, bm) __builtin_bit_cast(float, __builtin_amdgcn_update_dpp(0, __builtin_bit_cast(int, (v)), (ctrl), (rm), (bm), true))
__device__ __forceinline__ float wave_incl_scan(float v, int) {
    float s = v + DPP_MOV(v, 0x111, 0xF, 0xF) + DPP_MOV(v, 0x112, 0xF, 0xF) + DPP_MOV(v, 0x113, 0xF, 0xF);
    s += DPP_MOV(s, 0x114, 0xF, 0xE);
    s += DPP_MOV(s, 0x118, 0xF, 0xC);
    s += DPP_MOV(s, 0x142, 0xA, 0xF);
    s += DPP_MOV(s, 0x143, 0xC, 0xF);
    return s;
}
__device__ __forceinline__ bf16x8 row_frag(const LAS unsigned char* tile, int stride, int row0, int k0, int lane) {
    return *(const LAS bf16x8*)(tile + (row0 + (lane & 31)) * stride + (k0 + 8 * (lane >> 5)) * 2);
}
__device__ __forceinline__ bf16x8 tr_frag(const LAS unsigned char* tile, int stride, int k0, int c0, int lane) {
    const int g = lane >> 4, li = lane & 15, q = li >> 2, pp = li & 3;
    const LAS unsigned char* a0 = tile + (k0 + 8 * (g >> 1) + q) * stride + (c0 + 16 * (g & 1) + 4 * pp) * 2;
    const s16x4 lo = __builtin_amdgcn_ds_read_tr16_b64_v4i16((LAS s16x4*)a0);
    const s16x4 hi = __builtin_amdgcn_ds_read_tr16_b64_v4i16((LAS s16x4*)(a0 + 4 * stride));
    return __builtin_shufflevector(lo, hi, 0, 1, 2, 3, 4, 5, 6, 7);
}
__device__ __forceinline__ u32x4 pack8(const float (&v)[8]) { u32x4 r; r.x = cvt_pk_bf16(v[0], v[1]); r.y = cvt_pk_bf16(v[2], v[3]); r.z = cvt_pk_bf16(v[4], v[5]); r.w = cvt_pk_bf16(v[6], v[7]); return r; }
__device__ __forceinline__ u32x4 pack8s(const float (&v)[8], float sc) { u32x4 r; r.x = cvt_pk_bf16(v[0] * sc, v[1] * sc); r.y = cvt_pk_bf16(v[2] * sc, v[3] * sc); r.z = cvt_pk_bf16(v[4] * sc, v[5] * sc); r.w = cvt_pk_bf16(v[6] * sc, v[7] * sc); return r; }

__device__ __forceinline__ void conv_load(const bf16_t* proj, int row0, int rq, int xch, bool lo_ok, bool hi_ok, u32x4 (&raw)[8]) {
    const bf16_t* base = proj + (size_t)(row0 + 4 * rq) * NPROJ + 1536 + xch;
    const bool okl = (rq > 0) || lo_ok, okh = (rq < 31) || hi_ok;
#pragma unroll
    for (int j = 0; j < 8; ++j) raw[j] = *(const u32x4*)((j < 2 ? okl : (j >= 6 ? okh : true)) ? base + (j - 2) * NPROJ : base);
}
__device__ __forceinline__ void conv_compute(const u32x4 (&raw)[8], const LAS float* wl, int nchl, int wch, float (&o)[4][8], bool zl = false, bool zh = false) {
    float w[5][8], bs[8];
#pragma unroll
    for (int j = 0; j < 5; ++j) { const f32x4 w0 = *(const LAS f32x4*)(wl + j * nchl + wch), w1 = *(const LAS f32x4*)(wl + j * nchl + wch + 4);
        w[j][0] = w0[0]; w[j][1] = w0[1]; w[j][2] = w0[2]; w[j][3] = w0[3]; w[j][4] = w1[0]; w[j][5] = w1[1]; w[j][6] = w1[2]; w[j][7] = w1[3]; }
    { const f32x4 b0 = *(const LAS f32x4*)(wl + 5 * nchl + wch), b1 = *(const LAS f32x4*)(wl + 5 * nchl + wch + 4); bs[0] = b0[0]; bs[1] = b0[1]; bs[2] = b0[2]; bs[3] = b0[3]; bs[4] = b1[0]; bs[5] = b1[1]; bs[6] = b1[2]; bs[7] = b1[3]; }
#pragma unroll
    for (int i = 0; i < 4; ++i)
#pragma unroll
        for (int e = 0; e < 8; ++e) o[i][e] = bs[e];
    const float fl = zl ? 0.f : 1.f, fh = zh ? 0.f : 1.f;
#pragma unroll
    for (int j = 0; j < 8; ++j) {
        float xv[8] = {bflo(raw[j].x), bfhi(raw[j].x), bflo(raw[j].y), bfhi(raw[j].y), bflo(raw[j].z), bfhi(raw[j].z), bflo(raw[j].w), bfhi(raw[j].w)};
        if (j < 2) {
#pragma unroll
            for (int e = 0; e < 8; ++e) xv[e] *= fl; }
        if (j >= 6) {
#pragma unroll
            for (int e = 0; e < 8; ++e) xv[e] *= fh; }
#pragma unroll
        for (int i = 0; i < 4; ++i) { const int tap = j - i; if (tap >= 0 && tap < 5) {
#pragma unroll
                for (int e = 0; e < 8; ++e) o[i][e] += w[tap][e] * xv[e]; } }
    }
#pragma unroll
    for (int i = 0; i < 4; ++i)
#pragma unroll
        for (int e = 0; e < 8; ++e) o[i][e] = siluf_(o[i][e]);
}
__device__ __forceinline__ void conv_load4(const bf16_t* proj, int row0, int rq, int xch, bool lo_ok, bool hi_ok, u32x2 (&raw)[8]) {
    const bf16_t* base = proj + (size_t)(row0 + 4 * rq) * NPROJ + 1536 + xch;
    const bool okl = (rq > 0) || lo_ok, okh = (rq < 31) || hi_ok;
#pragma unroll
    for (int j = 0; j < 8; ++j) raw[j] = *(const u32x2*)((j < 2 ? okl : (j >= 6 ? okh : true)) ? base + (j - 2) * NPROJ : base);
}
__device__ __forceinline__ void conv_compute4(const u32x2 (&raw)[8], const LAS float* wl, int nchl, int wch, float (&o)[4][4], bool zl, bool zh) {
    f32x4 w[5];
#pragma unroll
    for (int j = 0; j < 5; ++j) w[j] = *(const LAS f32x4*)(wl + j * nchl + wch);
    const f32x4 bs = *(const LAS f32x4*)(wl + 5 * nchl + wch);
#pragma unroll
    for (int i = 0; i < 4; ++i)
#pragma unroll
        for (int e = 0; e < 4; ++e) o[i][e] = bs[e];
    const float fl = zl ? 0.f : 1.f, fh = zh ? 0.f : 1.f;
#pragma unroll
    for (int j = 0; j < 8; ++j) {
        float xv[4] = {bflo(raw[j].x), bfhi(raw[j].x), bflo(raw[j].y), bfhi(raw[j].y)};
        if (j < 2) {
#pragma unroll
            for (int e = 0; e < 4; ++e) xv[e] *= fl; }
        if (j >= 6) {
#pragma unroll
            for (int e = 0; e < 4; ++e) xv[e] *= fh; }
#pragma unroll
        for (int i = 0; i < 4; ++i) { const int tap = j - i; if (tap >= 0 && tap < 5) {
#pragma unroll
                for (int e = 0; e < 4; ++e) o[i][e] += w[tap][e] * xv[e]; } }
    }
#pragma unroll
    for (int i = 0; i < 4; ++i)
#pragma unroll
        for (int e = 0; e < 4; ++e) o[i][e] = siluf_(o[i][e]);
}
__device__ __forceinline__ void head_cums(CP p, int l, int row0, int h, int dir, int lane, LAS float* hv, const LAS float* atab) {
    const float A = atab[dir * 8 + h];
    const float* DT = (const float*)(p->ws + WS_DT);
    typedef float f32x2 __attribute__((ext_vector_type(2)));
    const f32x2 dd = *(const f32x2*)(DT + (size_t)(dir * 8 + h) * R + row0 + 2 * lane); const float d0 = dd[0], d1 = dd[1];
    const float x0 = d0 * A, x1 = d1 * A;
    const float incl = wave_incl_scan(x0 + x1, lane);
    const float total = __builtin_bit_cast(float, __builtin_amdgcn_readlane(__builtin_bit_cast(int, incl), 63));
    float c0, c1;
    if (dir == 0) { c1 = incl; c0 = incl - x1; } else { c0 = total - (incl - x1 - x0); c1 = total - (incl - x1); }
    hv[dir * 128 + 2 * lane] = c0; hv[dir * 128 + 2 * lane + 1] = c1;
    hv[256 + dir * 128 + 2 * lane] = d0; hv[256 + dir * 128 + 2 * lane + 1] = d1;
    if (lane == 0) hv[512 + dir] = total;
}
__device__ __forceinline__ bf16x8 scale_frag(bf16x8 f, const f32x4 w0, const f32x4 w1) {
    const u32x4 u = __builtin_bit_cast(u32x4, f);
    u32x4 r;
    r.x = cvt_pk_bf16(bflo(u.x) * w0[0], bfhi(u.x) * w0[1]); r.y = cvt_pk_bf16(bflo(u.y) * w0[2], bfhi(u.y) * w0[3]);
    r.z = cvt_pk_bf16(bflo(u.z) * w1[0], bfhi(u.z) * w1[1]); r.w = cvt_pk_bf16(bflo(u.w) * w1[2], bfhi(u.w) * w1[3]);
    return __builtin_bit_cast(bf16x8, r);
}
constexpr int ST_X256 = 576;

__device__ __forceinline__ void phase_c1(CP p, int l, unsigned char* lds_, int bid, int nb) {
    LAS unsigned char* lds = (LAS unsigned char*)lds_;
    LAS unsigned char* tile = lds;
    LAS float* wl = (LAS float*)(lds + 73216);
    const int tid = launder_tid();
    const bf16_t* proj = (const bf16_t*)(p->ws + WS_PROJ); bf16_t* mix = (bf16_t*)(p->ws + WS_HX);
    const int NU = 256 + 512 + (l == DEPTH - 1 ? 0 : 16);
    const int heavy = (nb > 64 && (NB * NCHUNK * 2) % nb < nb / 4) ? (NB * NCHUNK * 2) % nb : 0;
    const int ustart = bid < heavy ? NU : (bid - heavy), ustep = nb - heavy;
#pragma unroll 1
    for (int u = ustart; u < NU; u += ustep) {
        int S, LEN, LSH, pstride, sstride, tok0, ch0;
        if (u < 256) { const int b = u >> 7, cs = (u >> 2) & 31, cc = u & 3; S = 2; LEN = 256; LSH = 8; pstride = 64; sstride = 1; tok0 = b * SEG + CTXL + 2 * cs; ch0 = 256 + 64 * cc; }
        else if (u < 768) { const int v = u - 256; const int b = v >> 8, rg = (v >> 2) & 63, cc = v & 3; S = 4; LEN = 64; LSH = 6; pstride = 1; sstride = 64; tok0 = b * SEG + CTXL + 256 * rg; ch0 = 64 * cc; }
        else { const int v = u - 768; const int b = v >> 3, cc = v & 7; S = 1; LEN = 256; LSH = 8; pstride = 1; sstride = 0; tok0 = b * SEG; ch0 = 64 * cc; }
        const int LP = LEN + 30;
        { float tw[4];
#pragma unroll
          for (int it = 0; it < 4; ++it) { const int i = tid + NTHREADS * it; const int j = i >> 6, c = i & 63; tw[it] = j < 31 ? p->conv_w[((size_t)l * 31 + j) * 512 + ch0 + c] : p->conv_b[l * 512 + ch0 + c]; }
#pragma unroll
          for (int it = 0; it < 4; ++it) wl[tid + NTHREADS * it] = tw[it]; }
        for (int i = tid; i < S * 30 * 8; i += NTHREADS) { const int pc = i & 7, q = (i >> 3) % 30, sq = (i >> 3) / 30; const int pos = q < 15 ? q : LEN + q;
            unsigned zz; asm volatile("v_mov_b32 %0, 0" : "=v"(zz));
            *(LAS u32x4*)(tile + ((sq * LP + pos) * 64 + pc * 8) * 2) = (u32x4){zz, zz, zz, zz}; }
        for (int ib = 0; ib < S * LEN * 8; ib += 4 * NTHREADS) {
            u32x4 uv[4];
#pragma unroll
            for (int q = 0; q < 4; ++q) { const int i = ib + tid + NTHREADS * q; const int pc = i & 7, t = i >> 3; const int sq = t >> LSH, pos = t & (LEN - 1);
                const bf16_t* src = proj + (size_t)(tok0 + sq * sstride + pos * pstride) * NPROJ + ch0 + pc * 8;
                uv[q] = __builtin_nontemporal_load((const u32x4*)src); }
#pragma unroll
            for (int q = 0; q < 4; ++q) { const int i = ib + tid + NTHREADS * q; const int pc = i & 7, t = i >> 3; const int sq = t >> LSH, pos = t & (LEN - 1);
                const u32x4 o = uv[q];
                *(LAS u32x4*)(tile + ((sq * LP + 15 + pos) * 64 + pc * 8) * 2) = o; }
        }
        __syncthreads();
        const int noct = S * LEN / 8;
#pragma unroll 1
        for (int it = tid; it < noct * 32; it += NTHREADS) {
            const int cp = it & 31, oc = it >> 5; const int sq = oc >> (LSH - 3), p0 = (oc & ((LEN >> 3) - 1)) * 8;
            const LAS unsigned* base = (const LAS unsigned*)(tile + ((sq * LP + p0) * 64) * 2) + cp;
            float i0[38], i1[38];
#pragma unroll
            for (int k = 0; k < 38; ++k) { const unsigned w = base[k * 32]; i0[k] = bflo(w); i1[k] = bfhi(w); }
            float a0[8], a1[8];
            { const float b0 = wl[31 * 64 + 2 * cp], b1 = wl[31 * 64 + 2 * cp + 1];
#pragma unroll
              for (int i = 0; i < 8; ++i) { a0[i] = b0; a1[i] = b1; } }
#pragma unroll
            for (int j = 0; j < 31; ++j) { typedef float f32x2 __attribute__((ext_vector_type(2))); const f32x2 wj = *(const LAS f32x2*)(wl + j * 64 + 2 * cp); const float w0 = wj[0], w1 = wj[1];
#pragma unroll
                for (int i = 0; i < 8; ++i) { a0[i] += w0 * i0[i + j]; a1[i] += w1 * i1[i + j]; } }
#pragma unroll
            for (int i = 0; i < 8; ++i) { const int tok = tok0 + sq * sstride + (p0 + i) * pstride;
                *(unsigned*)(mix + (size_t)tok * 1024 + 512 + ch0 + 2 * cp) = cvt_pk_bf16(a0[i], a1[i]); }
        }
        __syncthreads();
    }
}
__device__ __forceinline__ void phase_c1_ln(CP p, int l, int bid, int nb) {
    const int tid = launder_tid(); const int lane = tid & 63, wave = tid >> 6;
    bf16_t* mix = (bf16_t*)(p->ws + WS_HX);
    const f32x4 g0 = *(const f32x4*)(p->conv_ln_g + l * 512 + lane * 8), g1 = *(const f32x4*)(p->conv_ln_g + l * 512 + lane * 8 + 4);
    const f32x4 b0 = *(const f32x4*)(p->conv_ln_b + l * 512 + lane * 8), b1 = *(const f32x4*)(p->conv_ln_b + l * 512 + lane * 8 + 4);
    const float gg[8] = {g0[0], g0[1], g0[2], g0[3], g1[0], g1[1], g1[2], g1[3]}, bb[8] = {b0[0], b0[1], b0[2], b0[3], b1[0], b1[1], b1[2], b1[3]};
    const int rstep = nb * 8;
    u32x4 vn[4];
#pragma unroll
    for (int j = 0; j < 4; ++j) { const int r = bid * 8 + wave + j * rstep; vn[j] = (u32x4){0u, 0u, 0u, 0u}; if (r < R) vn[j] = *(const u32x4*)(mix + (size_t)r * 1024 + 512 + lane * 8); }
#pragma unroll 1
    for (int rb = bid * 8 + wave; rb < R; rb += 4 * rstep) {
        u32x4 vc[4];
#pragma unroll
        for (int j = 0; j < 4; ++j) vc[j] = vn[j];
#pragma unroll
        for (int j = 0; j < 4; ++j) { const int r = rb + (4 + j) * rstep; if (r < R) vn[j] = *(const u32x4*)(mix + (size_t)r * 1024 + 512 + lane * 8); }
#pragma unroll
        for (int j = 0; j < 4; ++j) { const int r = rb + j * rstep;
            if (r < R) {
                const u32x4 v = vc[j];
                float y[8] = {bflo(v.x), bfhi(v.x), bflo(v.y), bfhi(v.y), bflo(v.z), bfhi(v.z), bflo(v.w), bfhi(v.w)};
                float s = 0.f;
#pragma unroll
                for (int e = 0; e < 8; ++e) s += y[e];
                const float mu = wave_sum(s) * (1.f / 512.f);
                float q = 0.f;
#pragma unroll
                for (int e = 0; e < 8; ++e) { y[e] -= mu; q += y[e] * y[e]; }
                const float rstd = rsqrtf(wave_sum(q) * (1.f / 512.f) + 1e-5f);
                float o[8];
#pragma unroll
                for (int e = 0; e < 8; ++e) o[e] = siluf_(y[e] * rstd * gg[e] + bb[e]);
                *(u32x4*)(mix + (size_t)r * 1024 + 512 + lane * 8) = pack8(o); } }
    }
}
__device__ __forceinline__ void phase_s1(CP p, int l, unsigned char* lds_, int bid, int nb) {
    LAS unsigned char* lds = (LAS unsigned char*)lds_;
    LAS unsigned char* Bs = lds;
    LAS unsigned char* Xs = lds + 128 * ST_TR128;
    LAS float* wv = (LAS float*)(Xs + 128 * ST_X256);
    LAS float* hvs = wv + 8 * 128;
    LAS float* cwl = hvs + 4 * 520;
    LAS float* atab = cwl + 6 * 384;
    const int tid = launder_tid(); const int lane = tid & 63, wave = __builtin_amdgcn_readfirstlane(tid >> 6);
    const bf16_t* proj = (const bf16_t*)(p->ws + WS_PROJ);
    const float* cw = p->ssd_conv_w + (size_t)l * 5 * 1024; const float* cbias = p->ssd_conv_b + (size_t)l * 1024;
    bf16_t* Sg = (bf16_t*)(p->ws + WS_S); float* DEC = (float*)(p->ws + WS_DEC);
    if (tid < 16) atab[tid] = -expf(p->a_log[l * 16 + tid]);
    __syncthreads();
    int cur_g = -1;
#pragma unroll 1
    for (int u = bid; u < NB * NCHUNK * 2; u += nb) {
        const int g = u & 1, c = (u >> 1) % NCHUNK, b = (u >> 1) / NCHUNK;
        const int row0 = b * SEG + c * 128;
        const bool lo_ok = !(c == 0 || c == 2), hi_ok = !(c == 1 || c == NCHUNK - 1);
        if (g != cur_g) { cur_g = g;
            float tw[5];
#pragma unroll
            for (int it = 0; it < 5; ++it) { const int i = tid + NTHREADS * it; const int j = i / 384, lc = i - j * 384; const int gch = lc < 128 ? 512 + g * 128 + lc : g * 256 + (lc - 128);
                tw[it] = i < 6 * 384 ? (j < 5 ? cw[j * 1024 + gch] : cbias[gch]) : 0.f; }
#pragma unroll
            for (int it = 0; it < 5; ++it) { const int i = tid + NTHREADS * it; if (i < 6 * 384) cwl[i] = tw[it]; } }
        const int hh = wave >> 1, dir = wave & 1, h = 4 * g + hh;
        u32x4 rb[8], rx0[8], rx1[8];
        conv_load(proj, row0, tid >> 4, 512 + g * 128 + (tid & 15) * 8, lo_ok, hi_ok, rb);
        conv_load(proj, row0, tid >> 5, g * 256 + (tid & 31) * 8, lo_ok, hi_ok, rx0);
        conv_load(proj, row0, (tid >> 5) + 16, g * 256 + (tid & 31) * 8, lo_ok, hi_ok, rx1);
        head_cums(p, l, row0, h, dir, lane, hvs + hh * 520, atab);
        __syncthreads();
        {
            const LAS float* hv = hvs + hh * 520; const float tot = hv[512 + dir];
#pragma unroll
            for (int q = 0; q < 2; ++q) { const int lr = lane + 64 * q; wv[wave * 128 + lr] = __expf(tot - hv[dir * 128 + lr]) * hv[256 + dir * 128 + lr]; }
            if (lane == 0) DEC[((size_t)(b * 2 + dir) * NCHUNK + c) * 8 + h] = __expf(tot);
        }
        { float o[4][8];
          conv_compute(rb, cwl, 384, (tid & 15) * 8, o, (tid >> 4) == 0 && !lo_ok, (tid >> 4) == 31 && !hi_ok);
#pragma unroll
          for (int i = 0; i < 4; ++i) *(LAS u32x4*)(Bs + (4 * (tid >> 4) + i) * ST_TR128 + (tid & 15) * 16) = pack8(o[i]);
          conv_compute(rx0, cwl, 384, 128 + (tid & 31) * 8, o, (tid >> 5) == 0 && !lo_ok, false);
#pragma unroll
          for (int i = 0; i < 4; ++i) *(LAS u32x4*)(Xs + (4 * (tid >> 5) + i) * ST_X256 + (tid & 31) * 16) = pack8(o[i]);
          conv_compute(rx1, cwl, 384, 128 + (tid & 31) * 8, o, false, (tid >> 5) == 15 && !hi_ok);
#pragma unroll
          for (int i = 0; i < 4; ++i) *(LAS u32x4*)(Xs + (4 * ((tid >> 5) + 16) + i) * ST_X256 + (tid & 31) * 16) = pack8(o[i]); }
        __syncthreads();
        {
            f32x16 acc[2][4];
#pragma unroll
            for (int t = 0; t < 2; ++t)
#pragma unroll
                for (int q = 0; q < 4; ++q)
#pragma unroll
                    for (int e = 0; e < 16; ++e) acc[t][q][e] = 0.f;
            {
                bf16x8 ar[2][2], br[2][4];
#pragma unroll
                for (int t = 0; t < 2; ++t) ar[0][t] = tr_frag(Xs, ST_X256, 0, hh * 64 + 32 * t, lane);
#pragma unroll
                for (int q = 0; q < 4; ++q) br[0][q] = tr_frag(Bs, ST_TR128, 0, 32 * q, lane);
#pragma unroll 2
                for (int kk = 0; kk < 8; ++kk) { const int c_ = kk & 1, n_ = c_ ^ 1;
                    const LAS float* wp = wv + wave * 128 + 16 * kk + 8 * (lane >> 5);
                    const f32x4 w0 = *(const LAS f32x4*)wp, w1 = *(const LAS f32x4*)(wp + 4);
                    if (kk < 7) {
#pragma unroll
                        for (int t = 0; t < 2; ++t) ar[n_][t] = tr_frag(Xs, ST_X256, 16 * (kk + 1), hh * 64 + 32 * t, lane);
#pragma unroll
                        for (int q = 0; q < 4; ++q) br[n_][q] = tr_frag(Bs, ST_TR128, 16 * (kk + 1), 32 * q, lane); }
                    bf16x8 af[2];
#pragma unroll
                    for (int t = 0; t < 2; ++t) af[t] = scale_frag(ar[c_][t], w0, w1);
#pragma unroll
                    for (int q = 0; q < 4; ++q)
#pragma unroll
                        for (int t = 0; t < 2; ++t) acc[t][q] = __builtin_amdgcn_mfma_f32_32x32x16_bf16(br[c_][q], af[t], acc[t][q], 0, 0, 0);
                }
            }
            bf16_t* So = Sg + ((size_t)((b * 2 + dir) * NCHUNK + c) * 8 + h) * 8192 + (size_t)lane * 8;
#pragma unroll
            for (int t = 0; t < 2; ++t)
#pragma unroll
                for (int q = 0; q < 4; ++q)
#pragma unroll
                    for (int j = 0; j < 2; ++j) { u32x4 pk; pk.x = cvt_pk_bf16(acc[t][q][8 * j], acc[t][q][8 * j + 1]); pk.y = cvt_pk_bf16(acc[t][q][8 * j + 2], acc[t][q][8 * j + 3]);
                        pk.z = cvt_pk_bf16(acc[t][q][8 * j + 4], acc[t][q][8 * j + 5]); pk.w = cvt_pk_bf16(acc[t][q][8 * j + 6], acc[t][q][8 * j + 7]);
                        *(u32x4*)(So + ((t * 4 + q) * 2 + j) * 512) = pk; }
        }
        __syncthreads();
    }
}
__device__ __forceinline__ void phase_s2(CP p, int bid, int nb) {
    const int tid = launder_tid();
    const bf16_t* Sg = (const bf16_t*)(p->ws + WS_S); const float* DEC = (const float*)(p->ws + WS_DEC); bf16_t* HP = (bf16_t*)(p->ws + WS_HP);
    for (int idx = bid * NTHREADS + tid; idx < 2 * 2 * 8 * 64 * 64; idx += nb * NTHREADS) {
        const int n2 = idx & 63, pr = (idx >> 6) & 63, h = (idx >> 12) & 7, dir = (idx >> 15) & 1, b = idx >> 16;
        const size_t inner = (size_t)h * 8192 + pr * 128 + 2 * n2;
        const size_t cbase = (size_t)(b * 2 + dir) * NCHUNK;
        float s0 = 0.f, s1 = 0.f;
#pragma unroll 26
        for (int step = 0; step < NCHUNK; ++step) {
            const int c = dir == 0 ? step : (step < 2 ? 1 - step : NCHUNK + 1 - step);
            const size_t off = (cbase + c) * 65536 + inner;
            const unsigned sv = __builtin_nontemporal_load((const unsigned*)(Sg + off)); const float d = DEC[(cbase + c) * 8 + h];
            *(unsigned*)(HP + off) = cvt_pk_bf16(s0, s1);
            s0 = s0 * d + bflo(sv); s1 = s1 * d + bfhi(sv);
        }
    }
}
__device__ __forceinline__ void phase_s3(CP p, int l, unsigned char* lds_, int bid, int nb) {
    LAS unsigned char* lds = (LAS unsigned char*)lds_;
    LAS unsigned char* Cs = lds;
    LAS unsigned char* Bs = Cs + 128 * ST_ROW;
    LAS unsigned char* Mt = Bs;
    LAS unsigned char* Xs = Bs + 128 * ST_MT;
    LAS unsigned char* Hf = Xs + 128 * ST_TR64;
    LAS unsigned char* Hb = Hf + 64 * ST_ROW;
    LAS float* hvs = (LAS float*)(Hb + 64 * ST_ROW);
    LAS float* ssqp = hvs + 4 * 776;
    LAS float* cwl = ssqp + 256;
    LAS float* atab = cwl + 6 * 512;
    const int tid0 = launder_tid(); const int wave = __builtin_amdgcn_readfirstlane(tid0 >> 6);
    const bf16_t* proj = (const bf16_t*)(p->ws + WS_PROJ); bf16_t* mix = (bf16_t*)(p->ws + WS_HX);
    const float* cw = p->ssd_conv_w + (size_t)l * 5 * 1024; const float* cbias = p->ssd_conv_b + (size_t)l * 1024;
    const bf16_t* HP = (const bf16_t*)(p->ws + WS_HP); float* SSQ = (float*)(p->ws + WS_SSQ);
    if (tid0 < 16) atab[tid0] = -expf(p->a_log[l * 16 + tid0]); else if (tid0 < 24) atab[tid0] = p->d_skip[l * 8 + tid0 - 16];
    __syncthreads();
    int cur_g = -1;
    const int cskip = (l == DEPTH - 1) ? 2 : 0, cpb = NCHUNK - cskip;
    const int nunits = NB * cpb * 2, nfull = nunits - nunits % nb, nitems = nfull + (nunits - nfull) * 4;
#pragma unroll 1
    for (int it = bid; it < nitems; it += nb) {
        const int u = it < nfull ? it : nfull + ((it - nfull) >> 2);
        const int hh_lo = it < nfull ? 0 : ((it - nfull) & 3), hh_hi = it < nfull ? 4 : hh_lo + 1;
        const int g = u & 1, c = cskip + (u >> 1) % cpb, b = (u >> 1) / cpb;
        int tid = tid0; asm volatile("" : "+v"(tid));
        const int lane = tid & 63;
        const int row0 = b * SEG + c * 128;
        const bool lo_ok = !(c == 0 || c == 2), hi_ok = !(c == 1 || c == NCHUNK - 1);
        if (g != cur_g) { cur_g = g;
            float tw[6];
#pragma unroll
            for (int it = 0; it < 6; ++it) { const int i = tid + NTHREADS * it; const int j = i >> 9, lc = i & 511; const int gch = lc < 128 ? 768 + g * 128 + lc : (lc < 256 ? 512 + g * 128 + (lc - 128) : g * 256 + (lc - 256));
                tw[it] = j < 5 ? cw[j * 1024 + gch] : cbias[gch]; }
#pragma unroll
            for (int it = 0; it < 6; ++it) cwl[tid + NTHREADS * it] = tw[it]; }
        u32x2 rx[8];
        {
            u32x4 r0[8], r1[8];
            const int cg = tid & 31; const int gch = (cg < 16 ? 768 : 512) + g * 128 + (cg & 15) * 8;
            conv_load(proj, row0, tid >> 5, gch, lo_ok, hi_ok, r0);
            conv_load(proj, row0, (tid >> 5) + 16, gch, lo_ok, hi_ok, r1);
            head_cums(p, l, row0, 4 * g + (wave >> 1), wave & 1, lane, hvs + (wave >> 1) * 776, atab);
            { LAS float* hvw = hvs + (wave >> 1) * 776; const int dr = wave & 1;
              hvw[520 + dr * 128 + 2 * lane] = __expf(hvw[dr * 128 + 2 * lane]); hvw[520 + dr * 128 + 2 * lane + 1] = __expf(hvw[dr * 128 + 2 * lane + 1]); }
            __syncthreads();
            float o[4][8];
            LAS unsigned char* dst = (cg < 16 ? Cs : Bs) + (cg & 15) * 16;
            conv_compute(r0, cwl, 512, cg * 8, o, (tid >> 5) == 0 && !lo_ok, false);
#pragma unroll
            for (int i = 0; i < 4; ++i) *(LAS u32x4*)(dst + (4 * (tid >> 5) + i) * ST_ROW) = pack8(o[i]);
            asm volatile("" ::: "memory");
            conv_load4(proj, row0, tid >> 4, g * 256 + hh_lo * 64 + (tid & 15) * 4, lo_ok, hi_ok, rx);
            conv_compute(r1, cwl, 512, cg * 8, o, false, (tid >> 5) == 15 && !hi_ok);
#pragma unroll
            for (int i = 0; i < 4; ++i) *(LAS u32x4*)(dst + (4 * ((tid >> 5) + 16) + i) * ST_ROW) = pack8(o[i]);
            { float o4[4][4]; conv_compute4(rx, cwl, 512, 256 + hh_lo * 64 + (tid & 15) * 4, o4, (tid >> 4) == 0 && !lo_ok, (tid >> 4) == 31 && !hi_ok);
#pragma unroll
              for (int i = 0; i < 4; ++i) { u32x2 pk; pk.x = cvt_pk_bf16(o4[i][0], o4[i][1]); pk.y = cvt_pk_bf16(o4[i][2], o4[i][3]); *(LAS u32x2*)(Xs + (4 * (tid >> 4) + i) * ST_TR64 + (tid & 15) * 8) = pk; } }
        }
        __syncthreads();
        const int lb = wave >> 1, hs = wave & 1;
        int ln = lane; asm volatile("" : "+v"(ln));
        f32x16 gacc[2];
#pragma unroll
        for (int t = 0; t < 2; ++t)
#pragma unroll
            for (int e = 0; e < 16; ++e) gacc[t][e] = 0.f;
#pragma unroll
        for (int kk = 0; kk < 8; ++kk) { const bf16x8 af = row_frag(Cs, ST_ROW, 32 * lb, 16 * kk, lane);
#pragma unroll
            for (int t = 0; t < 2; ++t) { const bf16x8 bf = row_frag(Bs, ST_ROW, 64 * hs + 32 * t, 16 * kk, lane);
                gacc[t] = __builtin_amdgcn_mfma_f32_32x32x16_bf16(af, bf, gacc[t], 0, 0, 0); } }
        u32x4 hreg[4];
        { const bf16_t* hp0 = HP + ((size_t)(b * 2 * NCHUNK + c) * 8 + 4 * g + hh_lo) * 8192;
#pragma unroll
          for (int q = 0; q < 4; ++q) { const int it = tid + 512 * q; hreg[q] = __builtin_nontemporal_load((const u32x4*)(hp0 + (size_t)(it >> 10) * NCHUNK * 8 * 8192 + (it & 1023) * 8)); } }
        __syncthreads();
#pragma unroll 1
        for (int hh = hh_lo; hh < hh_hi; ++hh) {
            const int h = 4 * g + hh; const LAS float* hv = hvs + hh * 776;
            asm volatile("" : "+v"(ln));
            const int ph = hs;
            const int lrw = 32 * lb + (ln & 31), pq = 32 * ph + 4 * (ln >> 5);
            u32x2 zraw[4];
#pragma unroll
            for (int rg = 0; rg < 4; ++rg) zraw[rg] = *(const u32x2*)(proj + (size_t)(row0 + lrw) * NPROJ + 1024 + h * 64 + pq + 8 * rg);
#pragma unroll
            for (int t = 0; t < 2; ++t) {
                const int st = 2 * hs + t;
                const int sc = 32 * st + (ln & 31);
                const float cfs = hv[sc], cbs = hv[128 + sc], dfs = hv[256 + sc], dbs = hv[384 + sc];
#pragma unroll
                for (int rg = 0; rg < 4; ++rg) {
                    const int l0 = 32 * lb + 8 * rg + 4 * (ln >> 5);
                    float m[4];
                    if (st < lb) {
                        const f32x4 cfl = *(const LAS f32x4*)(hv + l0);
#pragma unroll
                        for (int e = 0; e < 4; ++e) m[e] = gacc[t][4 * rg + e] * (__expf(cfl[e] - cfs) * dfs);
                    } else if (st > lb) {
                        const f32x4 cbl = *(const LAS f32x4*)(hv + 128 + l0);
#pragma unroll
                        for (int e = 0; e < 4; ++e) m[e] = gacc[t][4 * rg + e] * (__expf(cbl[e] - cbs) * dbs);
                    } else {
                        const f32x4 cfl = *(const LAS f32x4*)(hv + l0), cbl = *(const LAS f32x4*)(hv + 128 + l0);
#pragma unroll
                        for (int e = 0; e < 4; ++e) { const int lr = l0 + e;
                            const float ff = lr >= sc ? __expf(cfl[e] - cfs) * dfs : 0.f;
                            const float fb = lr <= sc ? __expf(cbl[e] - cbs) * dbs : 0.f;
                            m[e] = gacc[t][4 * rg + e] * (ff + fb); }
                    }
                    u32x2 pk; pk.x = cvt_pk_bf16(m[0], m[1]); pk.y = cvt_pk_bf16(m[2], m[3]);
                    *(LAS u32x2*)(Mt + sc * ST_MT + l0 * 2) = pk;
                }
            }
#pragma unroll
            for (int q = 0; q < 4; ++q) { const int it = tid + 512 * q; const int q2 = it & 1023;
                LAS unsigned char* dst = ((it >> 10) ? Hb : Hf) + (32 * (q2 >> 9) + (q2 & 31)) * ST_ROW + (32 * ((q2 >> 7) & 3) + 16 * ((q2 >> 6) & 1) + 4 * ((q2 >> 5) & 1)) * 2;
                *(LAS u32x2*)dst = (u32x2){hreg[q].x, hreg[q].y}; *(LAS u32x2*)(dst + 16) = (u32x2){hreg[q].z, hreg[q].w}; }
            if (hh + 1 < hh_hi) {
                const bf16_t* hp0 = HP + ((size_t)(b * 2 * NCHUNK + c) * 8 + h + 1) * 8192;
#pragma unroll
                for (int q = 0; q < 4; ++q) { const int it = tid + 512 * q; hreg[q] = __builtin_nontemporal_load((const u32x4*)(hp0 + (size_t)(it >> 10) * NCHUNK * 8 * 8192 + (it & 1023) * 8)); }
                conv_load4(proj, row0, tid >> 4, g * 256 + (hh + 1) * 64 + (tid & 15) * 4, lo_ok, hi_ok, rx);
            }
            __syncthreads();
            f32x16 ad, af_, ab_;
#pragma unroll
            for (int e = 0; e < 16; ++e) { ad[e] = 0.f; af_[e] = 0.f; ab_[e] = 0.f; }
            {
                bf16x8 am[2], bx[2], ac[2], bhf[2], bhb[2];
                am[0] = tr_frag(Mt, ST_MT, 0, 32 * lb, lane); bx[0] = tr_frag(Xs, ST_TR64, 0, 32 * ph, lane);
                ac[0] = row_frag(Cs, ST_ROW, 32 * lb, 0, lane); bhf[0] = row_frag(Hf, ST_ROW, 32 * ph, 0, lane); bhb[0] = row_frag(Hb, ST_ROW, 32 * ph, 0, lane);
#pragma unroll
                for (int kk = 0; kk < 8; ++kk) { const int c = kk & 1, n = c ^ 1;
                    if (kk < 7) { am[n] = tr_frag(Mt, ST_MT, 16 * (kk + 1), 32 * lb, lane); bx[n] = tr_frag(Xs, ST_TR64, 16 * (kk + 1), 32 * ph, lane);
                        ac[n] = row_frag(Cs, ST_ROW, 32 * lb, 16 * (kk + 1), lane); bhf[n] = row_frag(Hf, ST_ROW, 32 * ph, 16 * (kk + 1), lane); bhb[n] = row_frag(Hb, ST_ROW, 32 * ph, 16 * (kk + 1), lane); }
                    ad = __builtin_amdgcn_mfma_f32_32x32x16_bf16(bx[c], am[c], ad, 0, 0, 0);
                    af_ = __builtin_amdgcn_mfma_f32_32x32x16_bf16(bhf[c], ac[c], af_, 0, 0, 0);
                    ab_ = __builtin_amdgcn_mfma_f32_32x32x16_bf16(bhb[c], ac[c], ab_, 0, 0, 0); }
            }
            const float dsk = atab[16 + h];
            { const float ef = hv[520 + lrw], eb = hv[648 + lrw];
              float sq = 0.f;
#pragma unroll
              for (int rg = 0; rg < 4; ++rg) {
                const u32x2 xr = *(const LAS u32x2*)(Xs + lrw * ST_TR64 + (pq + 8 * rg) * 2);
                const float xs[4] = {bflo(xr.x), bfhi(xr.x), bflo(xr.y), bfhi(xr.y)};
                const float zz[4] = {bflo(zraw[rg].x), bfhi(zraw[rg].x), bflo(zraw[rg].y), bfhi(zraw[rg].y)};
                float v[4];
#pragma unroll
                for (int e = 0; e < 4; ++e) { const int ri = 4 * rg + e;
                    const float y = ad[ri] + ef * af_[ri] + eb * ab_[ri] + dsk * xs[e];
                    v[e] = y * zz[e];
                    sq += v[e] * v[e]; }
                u32x2 pk; pk.x = cvt_pk_bf16(v[0], v[1]); pk.y = cvt_pk_bf16(v[2], v[3]);
                *(u32x2*)(mix + (size_t)(row0 + lrw) * 1024 + h * 64 + pq + 8 * rg) = pk;
              }
              sq += __shfl_xor(sq, 32);
              if (ln < 32) ssqp[ph * 128 + lrw] = sq; }
            __syncthreads();
            if (tid < 128) SSQ[(size_t)(row0 + tid) * 8 + h] = ssqp[tid] + ssqp[128 + tid];
            if (hh + 1 < hh_hi) { float o4[4][4];
                conv_compute4(rx, cwl, 512, 256 + (hh + 1) * 64 + (tid & 15) * 4, o4, (tid >> 4) == 0 && !lo_ok, (tid >> 4) == 31 && !hi_ok);
#pragma unroll
                for (int i = 0; i < 4; ++i) { u32x2 pk; pk.x = cvt_pk_bf16(o4[i][0], o4[i][1]); pk.y = cvt_pk_bf16(o4[i][2], o4[i][3]); *(LAS u32x2*)(Xs + (4 * (tid >> 4) + i) * ST_TR64 + (tid & 15) * 8) = pk; } }
        }
        __syncthreads();
    }
}
__device__ __forceinline__ void phase_r2(CP p, int l, unsigned char* lds_, int bid, int nb) {
    LAS unsigned char* lds = (LAS unsigned char*)lds_;
    LAS unsigned char* Wh = lds;
    LAS unsigned char* Xh = Wh + 32 * ST_H16;
    LAS float* gm = (LAS float*)(Xh + 16 * ST_H16);
    LAS float* sh = gm + 3 * 1024;
    LAS float* part = sh + 3 * 1024;
    LAS float* lgs = part + 8 * 16 * 32;
    LAS int* lcnt = (LAS int*)(lgs + 16 * 32);
    LAS int* lcls = lcnt + 64;
    LAS int* lrank = lcls + 512;
    LAS float* lcwa = (LAS float*)(lrank + 512);
    LAS float* lcwb = lcwa + 512;
    const int tid = launder_tid(); const int lane = tid & 63, wave = __builtin_amdgcn_readfirstlane(tid >> 6);
    const float* mod = (const float*)(p->ws + WS_MOD) + (size_t)l * 3 * 6144;
    {
        float tmp[8];
#pragma unroll
        for (int it = 0; it < 8; ++it) tmp[it] = p->w_rg[(size_t)l * 4096 + tid + NTHREADS * it];
#pragma unroll
        for (int it = 0; it < 8; ++it) { const int idx = tid + NTHREADS * it; *(LAS _Float16*)(Wh + (idx & 3) * ST_H16 + (idx >> 2) * 2) = (_Float16)tmp[it]; } }
#pragma unroll
    for (int hb = 0; hb < 2; ++hb) { float tmp[16];
#pragma unroll
        for (int it = 0; it < 16; ++it) tmp[it] = p->w_re[(size_t)l * 16384 + tid + NTHREADS * (16 * hb + it)];
#pragma unroll
        for (int it = 0; it < 16; ++it) { const int idx = tid + NTHREADS * (16 * hb + it); *(LAS _Float16*)(Wh + (4 + (idx & 15)) * ST_H16 + (idx >> 4) * 2) = (_Float16)tmp[it]; } }
    { unsigned zz; asm volatile("v_mov_b32 %0, 0" : "=v"(zz));
      for (int i = tid; i < 12 * 128; i += NTHREADS) { const int rw = 20 + i / 128, c16 = i % 128; *(LAS u32x4*)(Wh + rw * ST_H16 + c16 * 16) = (u32x4){zz, zz, zz, zz}; } }
    { float t0[6], t1[6], t2[6];
#pragma unroll
      for (int it = 0; it < 6; ++it) { const int idx = tid + NTHREADS * it; const int v = idx >> 10, k = idx & 1023; t0[it] = p->g_ffn[l * 1024 + k]; t1[it] = mod[v * 6144 + 4 * 1024 + k]; t2[it] = mod[v * 6144 + 3 * 1024 + k]; }
#pragma unroll
      for (int it = 0; it < 6; ++it) { const int idx = tid + NTHREADS * it; gm[idx] = t0[it] * (1.f + t1[it]); sh[idx] = t2[it]; } }
    if (tid < 64) lcnt[tid] = 0;
    __syncthreads();
    bf16_t* HM = (bf16_t*)(p->ws + WS_HX); float* CWLA = (float*)(p->ws + WS_CWLA); float* CWLB = (float*)(p->ws + WS_CWLB);
    int* gcount = (int*)(p->ws + WS_CTL) + l * 32; int* LIST = (int*)(p->ws + WS_LIST);
    const int rpb = (R + nb - 1) / nb, r0 = bid * rpb, r1 = (r0 + rpb) < R ? (r0 + rpb) : R;
    RowRaw xn[2];
#pragma unroll
    for (int q = 0; q < 2; ++q) if (r0 + 2 * wave + q < r1) row_load(p, 1, r0 + 2 * wave + q, lane, xn[q]);
#pragma unroll 1
    for (int t0r = r0; t0r < r1; t0r += 16) {
        f32x4 xv[2][4];
#pragma unroll
        for (int q = 0; q < 2; ++q) row_cvt(1, xn[q], xv[q]);
#pragma unroll
        for (int q = 0; q < 2; ++q) if (t0r + 16 + 2 * wave + q < r1) row_load(p, 1, t0r + 16 + 2 * wave + q, lane, xn[q]);
#pragma unroll
        for (int q = 0; q < 2; ++q) { const int rr = t0r + 2 * wave + q; const bool ok = rr < r1; const int v = row_v(ok ? rr : r0);
            float ss = 0.f;
#pragma unroll
            for (int j = 0; j < 4; ++j) ss += xv[q][j][0] * xv[q][j][0] + xv[q][j][1] * xv[q][j][1] + xv[q][j][2] * xv[q][j][2] + xv[q][j][3] * xv[q][j][3];
            ss = wave_sum(ss); const float rs = ok ? __builtin_amdgcn_rsqf(ss * (1.f / 1024.f) + 1e-6f) : 0.f;
#pragma unroll
            for (int j = 0; j < 4; ++j) { const int k = 4 * lane + 256 * j; const f32x4 g4 = *(const LAS f32x4*)(gm + v * 1024 + k), s4 = *(const LAS f32x4*)(sh + v * 1024 + k);
                f32x4 hv = xv[q][j] * rs * g4 + s4; if (!ok) hv = hv * 0.f;
                u32x2 o; o.x = cvt_pk_bf16(hv[0], hv[1]); o.y = cvt_pk_bf16(hv[2], hv[3]);
                if (ok) *(u32x2*)(HM + (size_t)rr * 1024 + k) = o;
                u32x2 h16; h16.x = pack_f16(hv[0], hv[1]); h16.y = pack_f16(hv[2], hv[3]);
                *(LAS u32x2*)(Xh + (2 * wave + q) * ST_H16 + k * 2) = h16; } }
        __syncthreads();
        {
            f32x4 acc0 = {0.f, 0.f, 0.f, 0.f}, acc1 = {0.f, 0.f, 0.f, 0.f};
#pragma unroll
            for (int s4 = 0; s4 < 4; ++s4) { const int kb = (128 * wave + 32 * s4 + 8 * (lane >> 4)) * 2;
                const f16x8 a = *(const LAS f16x8*)(Xh + (lane & 15) * ST_H16 + kb);
                const f16x8 b0 = *(const LAS f16x8*)(Wh + (lane & 15) * ST_H16 + kb), b1 = *(const LAS f16x8*)(Wh + (16 + (lane & 15)) * ST_H16 + kb);
                acc0 = __builtin_amdgcn_mfma_f32_16x16x32_f16(a, b0, acc0, 0, 0, 0);
                acc1 = __builtin_amdgcn_mfma_f32_16x16x32_f16(a, b1, acc1, 0, 0, 0); }
#pragma unroll
            for (int e = 0; e < 4; ++e) { const int row = 4 * (lane >> 4) + e; part[(wave * 16 + row) * 32 + (lane & 15)] = acc0[e]; part[(wave * 16 + row) * 32 + 16 + (lane & 15)] = acc1[e]; }
        }
        __syncthreads();
        if (tid < 320) { const int row = tid / 20, n = tid - row * 20; float sacc = n < 4 ? p->b_rg[l * 4 + n] : p->b_re[l * 16 + n - 4];
#pragma unroll
            for (int w = 0; w < 8; ++w) sacc += part[(w * 16 + row) * 32 + n];
            lgs[row * 32 + n] = sacc; }
        __syncthreads();
        if (tid < 16) { const int rr = t0r + tid;
            if (rr < r1) {
                if (l == DEPTH - 1 && row_v(rr) == 2) lcls[rr - r0] = -1;
                else {
                    float lg[20];
#pragma unroll
                    for (int n = 0; n < 20; ++n) lg[n] = lgs[tid * 32 + n];
                    int gsel = 0; float gmax = lg[0];
#pragma unroll
                    for (int t = 1; t < 4; ++t) if (lg[t] > gmax) { gmax = lg[t]; gsel = t; }
                    float gden = 0.f;
#pragma unroll
                    for (int t = 0; t < 4; ++t) gden += __expf(lg[t] - gmax);
                    const float gprob = 1.f / gden;
                    float el[4];
#pragma unroll
                    for (int t = 0; t < 4; ++t) el[t] = gsel == 0 ? lg[4 + t] : (gsel == 1 ? lg[8 + t] : (gsel == 2 ? lg[12 + t] : lg[16 + t]));
                    int i0 = 0; float m0 = el[0];
#pragma unroll
                    for (int t = 1; t < 4; ++t) if (el[t] > m0) { m0 = el[t]; i0 = t; }
                    int i1 = -1; float m1 = -3.0e38f;
#pragma unroll
                    for (int t = 0; t < 4; ++t) if (t != i0 && el[t] > m1) { m1 = el[t]; i1 = t; }
                    const float w0 = gprob / (1.f + __expf(m1 - m0)), w1 = gprob - w0;
                    const int ea = i0 < i1 ? i0 : i1, eb = i0 < i1 ? i1 : i0;
                    const float cwa = i0 < i1 ? w0 : w1, cwb = i0 < i1 ? w1 : w0;
                    const int pidx = ea == 0 ? eb - 1 : (ea == 1 ? eb + 1 : 5);
                    const int cls = gsel * 6 + pidx;
                    const int rank = __hip_atomic_fetch_add(&lcnt[cls], 1, __ATOMIC_RELAXED, __HIP_MEMORY_SCOPE_WORKGROUP);
                    lcls[rr - r0] = cls; lrank[rr - r0] = rank; lcwa[rr - r0] = cwa; lcwb[rr - r0] = cwb;
                } } }
    }
    __syncthreads();
    if (tid < NCLS) lcnt[32 + tid] = atomicAdd(&gcount[tid], lcnt[tid]);
    __syncthreads();
    for (int idx = tid; idx < r1 - r0; idx += NTHREADS) { const int cl = lcls[idx]; if (cl < 0) continue; const int pos = lcnt[32 + cl] + lrank[idx]; const size_t li = (size_t)cl * R + pos;
        LIST[li] = r0 + idx; CWLA[li] = lcwa[idx]; CWLB[li] = lcwb[idx]; }
    __syncthreads();
}
__device__ __forceinline__ void phase_final(CP p, unsigned char* lds, int bid, int nb) {
    const int tid = launder_tid(); const int lane = tid & 63, wave = tid >> 6;
    const int qstep = nb * 8;
    RowRaw xn[2];
#pragma unroll
    for (int j = 0; j < 2; ++j) { const int q = bid * 8 + wave + j * qstep; if (q < NB * SEQ) { const int b = q >= SEQ ? 1 : 0; row_load(p, 1, b * SEG + CTXL + (q - b * SEQ), lane, xn[j]); } }
#pragma unroll 1
    for (int qb = bid * 8 + wave; qb < NB * SEQ; qb += 2 * qstep) {
        f32x4 xv[2][4];
#pragma unroll
        for (int j = 0; j < 2; ++j) row_cvt(1, xn[j], xv[j]);
#pragma unroll
        for (int j = 0; j < 2; ++j) { const int qn = qb + (2 + j) * qstep; if (qn < NB * SEQ) { const int bn = qn >= SEQ ? 1 : 0; row_load(p, 1, bn * SEG + CTXL + (qn - bn * SEQ), lane, xn[j]); } }
#pragma unroll
        for (int j = 0; j < 2; ++j) { const int q = qb + j * qstep;
            if (q < NB * SEQ) {
                f32x4* hr = (f32x4*)(p->out + (size_t)q * D);
                float ss = 0.f;
#pragma unroll
                for (int i = 0; i < 4; ++i) ss += xv[j][i][0] * xv[j][i][0] + xv[j][i][1] * xv[j][i][1] + xv[j][i][2] * xv[j][i][2] + xv[j][i][3] * xv[j][i][3];
                ss = wave_sum(ss); const float rs = rsqrtf(ss * (1.f / 1024.f) + 1e-6f);
#pragma unroll
                for (int i = 0; i < 4; ++i) { const f32x4 g4 = *(const f32x4*)(p->g_final + 4 * lane + 256 * i); hr[lane + 64 * i] = xv[j][i] * rs * g4; } } }
    }
}

#define XB_TMO      128
#define XB_XCNT(j)  (256  + 64 * (j))
#define XB_XSUB(j)  (1280 + 64 * (j))
#define XB_XGEN(j)  (2304 + 64 * (j))
#define XB_TOP      3328
#define XB_TOPGEN   3392
#define XCD_BAR_WORDS 3456
#define XB_SPIN_CAP (1u << 22)
__device__ __forceinline__ unsigned xb_ld(unsigned* p) { return __hip_atomic_load(p, __ATOMIC_RELAXED, __HIP_MEMORY_SCOPE_AGENT); }
__device__ __forceinline__ unsigned xb_add(unsigned* p, unsigned v) { return __hip_atomic_fetch_add(p, v, __ATOMIC_RELAXED, __HIP_MEMORY_SCOPE_AGENT); }
__device__ __forceinline__ unsigned xb_xcc_id() { return (unsigned)__builtin_amdgcn_s_getreg((3 << 11) | 20) & 0xFu; }
#define XB_SPIN(cond, bar) do { unsigned _sp = 0; while (cond) { __builtin_amdgcn_s_sleep(1); \
    if ((++_sp & 255u) == 0u) { if (xb_ld(&(bar)[XB_TMO])) break; if (_sp > XB_SPIN_CAP) { atomicAdd(&(bar)[XB_TMO], 1u); break; } } } } while (0)
struct XcdBarrier { unsigned* bar; unsigned x; volatile LAS unsigned* st; };
__device__ __forceinline__ XcdBarrier xcd_barrier_post(unsigned* bar, volatile LAS unsigned* st) {
    XcdBarrier b; b.bar = bar; b.x = xb_xcc_id(); b.st = st;
    if (threadIdx.x == 0) (void)xb_add(&bar[XB_XCNT(b.x)], 1u);
    return b;
}
__device__ __forceinline__ void xcd_barrier_complete(unsigned* bar, unsigned x, unsigned& nloc, unsigned& nx) {
    const unsigned G = gridDim.x * gridDim.y * gridDim.z;
    unsigned sum, cnt, mine, sp = 0u;
    for (;;) {
        sum = 0u; cnt = 0u; mine = 0u;
#pragma unroll
        for (unsigned j = 0; j < 16; ++j) { const unsigned c = xb_ld(&bar[XB_XCNT(j)]); sum += c; cnt += (c > 0u) ? 1u : 0u; mine = (j == x) ? c : mine; }
        if (sum == G) break;
        __builtin_amdgcn_s_sleep(1);
        if ((++sp & 255u) == 0u) { if (xb_ld(&bar[XB_TMO])) break; if (sp > XB_SPIN_CAP) { atomicAdd(&bar[XB_TMO], 1u); break; } }
    }
    nloc = mine > 0u ? mine : 1u; nx = cnt > 0u ? cnt : 1u;
}
__device__ __forceinline__ void xcd_barrier(const XcdBarrier& b) {
    asm volatile("s_waitcnt vmcnt(0)" ::: "memory");
    __syncthreads();
    if (threadIdx.x == 0) {
        unsigned* bar = b.bar;
        __builtin_amdgcn_s_waitcnt(0);
        unsigned nloc = b.st[0], nx = b.st[1];
        if (nloc == 0u) { xcd_barrier_complete(bar, b.x, nloc, nx); b.st[0] = nloc; b.st[1] = nx; }
        const unsigned old = xb_add(&bar[XB_XSUB(b.x)], 1u);
        const unsigned gen = old / nloc;
        if (old + 1u == (gen + 1u) * nloc) {
            __builtin_amdgcn_fence(__ATOMIC_RELEASE, "agent");
            asm volatile("s_waitcnt vmcnt(0)" ::: "memory");
            const unsigned og = xb_add(&bar[XB_TOP], 1u);
            const unsigned tg = og / nx;
            if (og + 1u == (tg + 1u) * nx) xb_add(&bar[XB_TOPGEN], 1u);
            else XB_SPIN(xb_ld(&bar[XB_TOPGEN]) == tg, bar);
            __builtin_amdgcn_fence(__ATOMIC_ACQUIRE, "agent");
            xb_add(&bar[XB_XGEN(b.x)], 1u);
            asm volatile("s_waitcnt vmcnt(0)" ::: "memory");
        } else {
            asm volatile("buffer_inv sc1" ::: "memory");
            XB_SPIN(xb_ld(&bar[XB_XGEN(b.x)]) == gen, bar);
            asm volatile("s_waitcnt vmcnt(0)" ::: "memory");
        }
    }
    __syncthreads();
}

#ifndef TIMING_A
#define TIMING_A -1
#endif
#ifndef TIMING_B
#define TIMING_B -1
#endif
#ifndef PHASE_MASK
#define PHASE_MASK 0xFFFFF
#endif
#define PM(i) ((PHASE_MASK >> (i)) & 1)
#ifndef REPEAT_MASK
#define REPEAT_MASK 0
#endif
#define RP(i) for (int rep_ = 0; rep_ < 1 + ((REPEAT_MASK >> (i)) & 1); ++rep_)
constexpr int PH_PER_LAYER = 9, NPHASES = 1 + DEPTH * PH_PER_LAYER + 1;
__global__ void __launch_bounds__(NTHREADS, 2) mk_fwd(Args args) {
    extern __shared__ __attribute__((aligned(16))) unsigned char lds[];
    cg::grid_group grid = cg::this_grid();
    const __attribute__((address_space(4))) Args* ap = (const __attribute__((address_space(4))) Args*)__builtin_amdgcn_kernarg_segment_ptr();
    const int lo = ap->lo, hi = ap->hi;
    LAS unsigned char* ldsl = (LAS unsigned char*)lds;
    volatile LAS unsigned* xbst = (volatile LAS unsigned*)(ldsl + LDS_BYTES - 16);
    if (threadIdx.x < 4) xbst[threadIdx.x] = 0u;
    __syncthreads();
    (void)xcd_barrier_post((unsigned*)(ap->p.ws + WS_BAR), xbst);
    if (TIMING_A >= 0 && blockIdx.x == 0 && threadIdx.x == 0) ((unsigned long long*)(ap->p.ws + WS_TS))[lo] = __builtin_amdgcn_s_memrealtime();
    for (int ph = lo; ph < hi; ++ph) {
        CP p = launder(&ap->p);
        int bid = blockIdx.x, nb = gridDim.x; asm volatile("" : "+s"(bid), "+s"(nb));
        if (ph == 0) { if (PM(0)) RP(0) phase_wprep(p, lds, 0, 912, bid, nb); if (PM(1)) RP(1) phase_adaln(p, lds, bid, nb); }
        else if (ph == NPHASES - 1) { if (PM(12)) phase_final(p, lds, bid, nb); }
        else {
            const int l = (ph - 1) / PH_PER_LAYER, s = (ph - 1) % PH_PER_LAYER;
            if (s == 0) { if (PM(2)) RP(2) { if (rep_ == 0 || l == 0) phase_r1(p, l, lds, bid, nb); } }
            else if (s == 1) { if (PM(3)) RP(3) {
                pg8::DenseSched S; S.init(p->ws + WS_HX, (const bf16_t*)(p->ws + WS_WTIN) + (size_t)l * DIN * 1024, R, NPROJ, 1024, 1024, 1024, nb, bid);
                EpiProj E{(bf16_t*)(p->ws + WS_PROJ)};
                pg8::gemm_phase<EpiProj, pg8::DenseSched, false>(ldsl, 1024, 1024, 1024, S, E);
                {
                    const int extra = S.nwg % nb; const int L1 = WPREP_ITEMS_PER_LAYER;
                    const int a0 = l == 0 ? 912 : L1 + 656, a1 = l == 0 ? 2960 : L1 + 2960;
                    if (l <= 1 && DEPTH == 2) { if (extra > 0 && bid >= extra) phase_wprep(p, lds, a0, a1, bid - extra, nb - extra); else if (extra == 0) phase_wprep(p, lds, a0, a1, bid, nb); } }
            } }
            else if (s == 2) { if (PM(4)) RP(4) phase_c1(p, l, lds, bid, nb); if (PM(5)) RP(5) phase_s1(p, l, lds, bid, nb); }
            else if (s == 3) { if (PM(6)) RP(6) phase_s2(p, bid, nb); }
            else if (s == 4) { if (PM(7)) RP(7) phase_s3(p, l, lds, bid, nb);
                if (PM(4)) {
                    const int cpb = NCHUNK - ((l == DEPTH - 1) ? 2 : 0), nunits = NB * cpb * 2, tail = (nunits % nb) * 4;
                    if (tail > 0 && tail < nb) { if (bid >= tail) phase_c1_ln(p, l, bid - tail, nb - tail); } else phase_c1_ln(p, l, bid, nb); } }
            else if (s == 5) { if (PM(8)) RP(8) { if (rep_ == 0 || l == 0) {
                pg8::DenseSched S; S.init(p->ws + WS_HX, (const bf16_t*)(p->ws + WS_WTOUT) + (size_t)l * 1024 * 1024, R, 1024, 1024, 1024, 1024, nb, bid, l == DEPTH - 1);
                EpiResid<0> E{p->ctx, p->x, (bf16_t*)(p->ws + WS_H), (const float*)(p->ws + WS_MOD) + (size_t)l * 3 * 6144, (const float*)(p->ws + WS_SSQ)};
                pg8::gemm_phase<EpiResid<0>, pg8::DenseSched, false>(ldsl, 1024, 1024, 1024, S, E);
                if (l == 0 && DEPTH == 2 && rep_ == 0) { const int extra = S.nwg % nb; const int L1 = WPREP_ITEMS_PER_LAYER;
                    if (extra > 0 && bid >= extra) phase_wprep(p, lds, 2960, 3984, bid - extra, nb - extra, L1, L1 + 656, L1 + 2960, L1 + 3984);
                    else if (extra == 0) phase_wprep(p, lds, 2960, 3984, bid, nb, L1, L1 + 656, L1 + 2960, L1 + 3984); }
            } } }
            else if (s == 6) { if (PM(9)) phase_r2(p, l, lds, bid, nb); }
            else if (s == 7) { if (PM(10)) {
                LAS int* tab = (LAS int*)(ldsl + MISC_OFF);
                LAS float* gl = (LAS float*)(ldsl + MISC_OFF + 4096);
                { const float* modl = (const float*)(p->ws + WS_MOD) + (size_t)l * 3 * 6144 + 5 * 1024; float tg[6]; const int tt = launder_tid();
#pragma unroll
                  for (int it = 0; it < 6; ++it) { const int i = tt + NTHREADS * it; tg[it] = modl[(size_t)(i >> 10) * 6144 + (i & 1023)]; }
#pragma unroll
                  for (int it = 0; it < 6; ++it) gl[tt + NTHREADS * it] = tg[it]; }
                moe_table(p, l, tab);
                unsigned* ready = (unsigned*)(p->ws + WS_M1CNT) + l * 192;
                { MoeSched S{tab, (const int*)(p->ws + WS_LIST), (const char*)(p->ws + WS_HX), (const char*)(p->ws + WS_WTGU), 0, l, nb, bid, ready, 0};
                  EpiUp E{(bf16_t*)(p->ws + WS_HID), (const float*)(p->ws + WS_CWLA), (const float*)(p->ws + WS_CWLB), ready};
                  pg8::gemm_phase<EpiUp, MoeSched, true>(ldsl, 1024, 1024, 1024, S, E); }
                { const int total = __builtin_amdgcn_readfirstlane(tab[24]) * 4; const int extra = __builtin_amdgcn_readfirstlane(total % nb);
                  MoeSched S{tab, (const int*)(p->ws + WS_LIST), (const char*)(p->ws + WS_HID), (const char*)(p->ws + WS_WTD), 1, l, nb, bid, ready, (total >= nb && total - extra >= nb) ? extra : 0};
                  EpiDown E{(bf16_t*)(p->ws + WS_H), (const int*)(p->ws + WS_LIST), gl};
                  pg8::gemm_phase<EpiDown, MoeSched, false>(ldsl, 512, 256, 512, S, E); }
            } }
            else { }
        }
        if (ph + 1 < hi && !(ph > 0 && ph < NPHASES - 1 && (ph - 1) % PH_PER_LAYER == 7)) { if (hi < 0) grid.sync();   else { XcdBarrier xb; xb.bar = (unsigned*)(launder(&ap->p)->ws + WS_BAR); xb.x = xb_xcc_id(); xb.st = (volatile LAS unsigned*)(ldsl + LDS_BYTES - 16); xcd_barrier(xb); }
            if (TIMING_A >= 0 && blockIdx.x == 0 && threadIdx.x == 0) ((unsigned long long*)(launder(&ap->p)->ws + WS_TS))[ph + 1] = __builtin_amdgcn_s_memrealtime(); }
    }
#if TIMING_A >= 0
    {
        XcdBarrier xb; xb.bar = (unsigned*)(launder(&ap->p)->ws + WS_BAR); xb.x = xb_xcc_id(); xb.st = (volatile LAS unsigned*)(ldsl + LDS_BYTES - 16); xcd_barrier(xb);
        if (blockIdx.x == 0 && threadIdx.x == 0) ((unsigned long long*)(launder(&ap->p)->ws + WS_TS))[hi] = __builtin_amdgcn_s_memrealtime();
        xcd_barrier(xb);
        const unsigned long long* ts = (const unsigned long long*)(launder(&ap->p)->ws + WS_TS);
        const float ta = (float)(ts[TIMING_A + 1] - ts[TIMING_A]) * 0.01f, tb = (float)(ts[TIMING_B + 1] - ts[TIMING_B]) * 0.01f;
        float* o = launder(&ap->p)->out; const float sc = 1.f + ta * 0.001f;
        for (size_t i = (size_t)blockIdx.x * NTHREADS + threadIdx.x; i < (size_t)NB * SEQ * D; i += (size_t)gridDim.x * NTHREADS) o[i] = o[i] * sc + (i == 0 ? tb * 0.1f : 0.f);
    }
#endif
}

extern "C" void kernel_launch(void* const* d_in, const int* in_sizes, int n_in, void* d_out, int out_size, void* d_ws, size_t ws_size, hipStream_t stream) {
    static int grid = 0;
    if (grid == 0) {
        if (n_in != 28 || ws_size < WS_END) { fprintf(stderr, "kernel_launch: unexpected n_in %d or ws_size %zu (< %zu)\n", n_in, ws_size, (size_t)WS_END); grid = -1; return; }
        int dev = 0, cus = 0, per_cu = 0;
        hipGetDevice(&dev); hipDeviceGetAttribute(&cus, hipDeviceAttributeMultiprocessorCount, dev);
        if (hipFuncSetAttribute((const void*)mk_fwd, hipFuncAttributeMaxDynamicSharedMemorySize, LDS_BYTES) != hipSuccess) { fprintf(stderr, "kernel_launch: hipFuncSetAttribute failed\n"); grid = -1; return; }
        if (hipOccupancyMaxActiveBlocksPerMultiprocessor(&per_cu, (const void*)mk_fwd, NTHREADS, LDS_BYTES) != hipSuccess || per_cu < 1) { fprintf(stderr, "kernel_launch: occupancy query says %d\n", per_cu); (void)hipGetLastError(); grid = -1; return; }
        grid = cus;
    }
    if (grid < 0) return;
    (void)hipMemsetAsync((char*)d_ws + WS_CTL, 0, WS_CTL_BYTES, stream);
    Args a{};
    const float** pp = (const float**)&a.p;
    for (int i = 0; i < 28; ++i) pp[i] = (const float*)d_in[i];
    a.p.out = (float*)d_out; a.p.ws = (unsigned char*)d_ws;
#if PER_PHASE_LAUNCH
    for (int ph = 0; ph < NPHASES; ++ph) {
        a.lo = ph; a.hi = ph + 1; void* kargs[] = {&a};
        hipError_t e = hipLaunchCooperativeKernel((const void*)mk_fwd, dim3(grid), dim3(NTHREADS), kargs, LDS_BYTES, stream);
        if (e != hipSuccess) { fprintf(stderr, "kernel_launch: launch of phase %d failed: %s\n", ph, hipGetErrorString(e)); break; }
    }
#else
    a.lo = 0; a.hi = NPHASES; void* kargs[] = {&a};
    hipError_t e = hipLaunchCooperativeKernel((const void*)mk_fwd, dim3(grid), dim3(NTHREADS), kargs, LDS_BYTES, stream);
    if (e != hipSuccess) fprintf(stderr, "kernel_launch: cooperative launch failed: %s (grid %d)\n", hipGetErrorString(e), grid);
#endif
}
```

```cpp
#include <hip/hip_runtime.h>
#include <hip/hip_cooperative_groups.h>
#include <cstdio>
namespace cg = cooperative_groups;

#ifndef PER_PHASE_LAUNCH
#define PER_PHASE_LAUNCH 0
#endif

#ifndef S3REP
#define S3REP 0
#endif
#define S3R(i) for (int r3_ = 0; r3_ < 1 + ((S3REP >> (i)) & 1); ++r3_)
#define LAS __attribute__((address_space(3)))
typedef unsigned short bf16_t;
typedef short bf16x8 __attribute__((ext_vector_type(8)));
typedef float f32x4 __attribute__((ext_vector_type(4)));
typedef unsigned u32x4 __attribute__((ext_vector_type(4)));
typedef unsigned u32x2 __attribute__((ext_vector_type(2)));

constexpr int D = 1024, NB = 2, SEQ = 16384, CTXL = 256, SEG = SEQ + CTXL, R = NB * SEG, DEPTH = 2;
constexpr int NPROJ = 2560, DIN = 2576;
constexpr int NTHREADS = 512;
constexpr int LDS_BYTES = 163840;
constexpr int MISC_OFF = 131072;
constexpr int NCLS = 24;

constexpr size_t al256(size_t x) { return (x + 255) & ~size_t(255); }
constexpr size_t WS_CTL = 0;
constexpr size_t WS_M1CNT = 20480;
constexpr size_t WS_TS = 2048;
constexpr size_t WS_BAR = 4096;
constexpr size_t WS_CTL_BYTES = 32768;
constexpr size_t WS_MOD = WS_CTL_BYTES;
constexpr size_t WS_WTIN = WS_MOD + al256((size_t)2 * 3 * 6144 * 4);
constexpr size_t WS_WTOUT = WS_WTIN + al256((size_t)2 * DIN * 1024 * 2);
constexpr size_t WS_WTGU = WS_WTOUT + al256((size_t)2 * 1024 * 1024 * 2);
constexpr size_t WS_WTD = WS_WTGU + al256((size_t)2 * 16 * 512 * 1024 * 2);
constexpr size_t WS_H = WS_WTD + al256((size_t)2 * 16 * 1024 * 256 * 2);
constexpr size_t WS_HX = WS_H + al256((size_t)R * 1024 * 2);
constexpr size_t WS_PROJ = WS_HX + al256((size_t)R * 1024 * 2);
constexpr size_t WS_DT = WS_PROJ + al256((size_t)R * NPROJ * 2);
constexpr size_t WS_POS = WS_DT + al256((size_t)R * 16 * 4);
constexpr size_t WS_LIST = WS_POS + al256((size_t)2 * R * 4);
constexpr size_t WS_CWLA = WS_LIST + al256((size_t)NCLS * R * 4);
constexpr size_t WS_CWLB = WS_CWLA + al256((size_t)NCLS * R * 4);
constexpr size_t WS_BIG = WS_CWLB + al256((size_t)NCLS * R * 4);
constexpr size_t WS_Y = WS_PROJ;
constexpr size_t WS_S = WS_BIG;
constexpr size_t WS_HP = WS_S + al256((size_t)2 * 2 * 130 * 8 * 8192 * 2);
constexpr size_t WS_DEC = WS_HP + al256((size_t)2 * 2 * 130 * 8 * 8192 * 2);
constexpr size_t WS_SSQ = WS_DEC + al256((size_t)2 * 2 * 130 * 8 * 4);
constexpr size_t WS_HID = WS_S;
constexpr size_t WS_END = WS_SSQ + al256((size_t)R * 8 * 4);
static_assert((size_t)(R + NCLS * 256) * 512 * 2 <= (size_t)2 * 2 * 130 * 8 * 8192 * 2, "hid alias");
static_assert(WS_END <= (size_t)512 * 1024 * 1024, "workspace");

struct Params {
    const float *x, *c, *ctx, *c_ctx, *w_ada, *b_ada, *g_mix, *g_ffn, *w_in, *conv_w, *conv_b, *conv_ln_g, *conv_ln_b, *ssd_conv_w, *ssd_conv_b,
        *dt_bias, *a_log, *d_skip, *ssd_norm_g, *w_out, *w_rg, *b_rg, *w_re, *b_re, *w_gate, *w_up, *w_down, *g_final;
    float* out; unsigned char* ws;
};
struct Args { Params p; int lo, hi; };
typedef const __attribute__((address_space(4))) Params* CP;
__device__ __forceinline__ CP launder(CP p) { asm volatile("" : "+s"(p)); return p; }
__device__ __forceinline__ int launder_tid() { int t = threadIdx.x; asm volatile("" : "+v"(t)); return t; }

__device__ __forceinline__ unsigned cvt_pk_bf16(float lo, float hi) { unsigned r; asm("v_cvt_pk_bf16_f32 %0, %1, %2" : "=v"(r) : "v"(lo), "v"(hi)); return r; }
__device__ __forceinline__ float bf2f(unsigned b) { return __uint_as_float(b << 16); }
__device__ __forceinline__ float bflo(unsigned w) { return __uint_as_float(w << 16); }
__device__ __forceinline__ float bfhi(unsigned w) { return __uint_as_float(w & 0xffff0000u); }
__device__ __forceinline__ bf16_t f2bf(float f) { return (bf16_t)(cvt_pk_bf16(f, 0.f) & 0xffffu); }
#define DPP_ADD(v, ctrl, rm) ((v) + __builtin_bit_cast(float, __builtin_amdgcn_update_dpp(0, __builtin_bit_cast(int, (v)), (ctrl), (rm), 0xF, true)))
__device__ __forceinline__ float row_sum16(float v) {
    v = DPP_ADD(v, 0xB1, 0xF);
    v = DPP_ADD(v, 0x4E, 0xF);
    v = DPP_ADD(v, 0x141, 0xF);
    v = DPP_ADD(v, 0x140, 0xF);
    return v;
}
__device__ __forceinline__ float half_sum32(float v) { v = row_sum16(v); v = DPP_ADD(v, 0x142, 0xA); return v; }
__device__ __forceinline__ float wave_sum(float v) {
    v = half_sum32(v); v = DPP_ADD(v, 0x143, 0xC);
    return __builtin_bit_cast(float, __builtin_amdgcn_readlane(__builtin_bit_cast(int, v), 63));
}
__device__ __forceinline__ float sigmoidf_(float x) { return __builtin_amdgcn_rcpf(1.f + __builtin_amdgcn_exp2f(x * -1.44269504089f)); }
__device__ __forceinline__ float siluf_(float x) { return x * __builtin_amdgcn_rcpf(1.f + __builtin_amdgcn_exp2f(x * -1.44269504089f)); }
__device__ __forceinline__ float softplusf_(float x) { return fmaxf(x, 0.f) + __logf(1.f + __expf(-fabsf(x))); }

__device__ __forceinline__ int row_b(int r) { return r >= SEG ? 1 : 0; }
__device__ __forceinline__ int row_i(int r) { return r >= SEG ? r - SEG : r; }
__device__ __forceinline__ int row_v(int r) { const int i = row_i(r); return i < CTXL ? 2 : row_b(r); }
__device__ __forceinline__ const float* xin_ptr(const float* ctx, const float* x, int r) {
    const int b = row_b(r), i = row_i(r);
    return i < CTXL ? ctx + (size_t)(b * CTXL + i) * D : x + (size_t)(b * SEQ + i - CTXL) * D;
}
struct RowRaw { f32x4 f[4]; u32x2 h[4]; };
__device__ __forceinline__ void row_load(CP p, int l, int r, int lane, RowRaw& rr) {
    if (l == 0) { const f32x4* hr = (const f32x4*)xin_ptr(p->ctx, p->x, r);
#pragma unroll
        for (int j = 0; j < 4; ++j) rr.f[j] = __builtin_nontemporal_load(hr + lane + 64 * j); }
    else { const u32x2* hr = (const u32x2*)((const bf16_t*)(p->ws + WS_H) + (size_t)r * D);
#pragma unroll
        for (int j = 0; j < 4; ++j) rr.h[j] = hr[lane + 64 * j]; }
}
__device__ __forceinline__ void row_cvt(int l, const RowRaw& rr, f32x4 (&xv)[4]) {
#pragma unroll
    for (int j = 0; j < 4; ++j) xv[j] = l == 0 ? rr.f[j] : (f32x4){bflo(rr.h[j].x), bfhi(rr.h[j].x), bflo(rr.h[j].y), bfhi(rr.h[j].y)};
}
__device__ __forceinline__ const char* uniform_ptr(const char* q) {
    const unsigned long long v = (unsigned long long)q;
    const unsigned lo = __builtin_amdgcn_readfirstlane((unsigned)v), hi = __builtin_amdgcn_readfirstlane((unsigned)(v >> 32));
    return (const char*)(((unsigned long long)hi << 32) | lo);
}
namespace pg8 {
constexpr int BM = 256, BK = 64, HALF = 128, HTB = HALF * BK * 2, STAGE_BYTES = 8 * HTB, NXCD = 8, WGM = 8;
__device__ __forceinline__ int lds_byte(int r, int c) { const int st = (r >> 4) * 2 + (c >> 5), rr = r & 15, cc = c & 31, ob = rr * 64 + cc * 2; return st * 1024 + (ob ^ (((ob >> 9) & 1) << 5)); }
__device__ __forceinline__ void stage_rc(int b, int& Rr, int& Cc) { const int st = b / 1024, sb = b % 1024, swz = sb ^ (((sb >> 9) & 1) << 5); Rr = (st >> 1) * 16 + swz / 64; Cc = (st & 1) * 32 + (swz % 64) / 2; }
__device__ __forceinline__ int perm32(int rho) { const int n = rho >> 4, i = rho & 15; return 8 * (i >> 2) + 4 * n + (i & 3); }

struct Unit {
    const char* a0;
    const char* b0;
    const char* b1;
    int i0, i1, i2, i3, i4, pad;
};

template <class Epi, class Sched, bool GATHER>
__device__ __forceinline__ void gemm_phase(LAS unsigned char* lds, const int lda, const int ldb, const int K, const Sched& S, const Epi& E) {
    const int tid = launder_tid(); const int wid = __builtin_amdgcn_readfirstlane(tid >> 6), lane = tid & 63, wr = wid >> 2, wc = wid & 3, fr = lane & 15, fq = lane >> 4;
    const int nt = K / BK, ks = nt >> 1;
    int Rr[2], Cc[2];
    unsigned voffB[2];
#pragma unroll
    for (int i = 0; i < 2; ++i) { stage_rc(tid * 16 + i * 8192, Rr[i], Cc[i]); const int Rb = Epi::PERM ? ((Rr[i] & ~31) + perm32(Rr[i] & 31)) : Rr[i];
        voffB[i] = (unsigned)(Rb * ldb + Cc[i]) * 2u; }
    const size_t kstep = (size_t)(BK * 2);
    const size_t hstepB = (size_t)HALF * ldb * 2;
    const unsigned ldsw = (unsigned)wid * 1024u;
    const unsigned ldsbase = (unsigned)(unsigned long)lds;
    const int aoff = lds_byte(wr * 64 + fr, fq * 8), boff = lds_byte(wc * 32 + fr, fq * 8);
#define PG8_SA(b, h) (((b) * 2 + (h)) * HTB)
#define PG8_SB(b, h) ((4 + (b) * 2 + (h)) * HTB)
#define PG8_STAGE2(bufoff, gbase, v0, v1) do { unsigned keep_; \
        asm volatile("s_mov_b32 %0, m0\n\ts_mov_b32 m0, %1\n\ts_nop 4\n\tglobal_load_lds_dwordx4 %2, %4\n\ts_add_u32 m0, m0, 0x2000\n\ts_nop 0\n\tglobal_load_lds_dwordx4 %3, %4\n\ts_mov_b32 m0, %0" \
            : "=&s"(keep_) : "s"(ldsbase + (unsigned)(bufoff) + ldsw), "v"(v0), "v"(v1), "s"(gbase) : "memory", "scc"); } while (0)
#define PG8_LDA(dst, b, h) do { _Pragma("unroll") for (int m = 0; m < 4; ++m) _Pragma("unroll") for (int k = 0; k < 2; ++k) dst[m][k] = *(const LAS bf16x8*)(lds + PG8_SA(b, h) + aoff + m * 2048 + k * 1024); } while (0)
#define PG8_LDB(dst, b, h) do { _Pragma("unroll") for (int n = 0; n < 2; ++n) _Pragma("unroll") for (int k = 0; k < 2; ++k) dst[n][k] = *(const LAS bf16x8*)(lds + PG8_SB(b, h) + boff + n * 2048 + k * 1024); } while (0)
#define PG8_MMA(ai, bj, At, Bt) do { __builtin_amdgcn_s_setprio(1); _Pragma("unroll") for (int m = 0; m < 4; ++m) _Pragma("unroll") for (int n = 0; n < 2; ++n) _Pragma("unroll") for (int k = 0; k < 2; ++k) \
        acc[ai][bj][m][n] = __builtin_amdgcn_mfma_f32_16x16x32_bf16(Bt[n][k], At[m][k], acc[ai][bj][m][n], 0, 0, 0); __builtin_amdgcn_s_setprio(0); } while (0)
#define PG8_WAIT_V(n) asm volatile("s_waitcnt vmcnt(" #n ")" ::: "memory")
#define PG8_WAIT_L(n) asm volatile("s_waitcnt lgkmcnt(" #n ")" ::: "memory")
#define PG8_BAR __builtin_amdgcn_s_barrier()
#define PG8_SCHED __builtin_amdgcn_sched_barrier(0)
#define PG8_BP(u, tt) ((tt) < ks ? (u).b0 + (size_t)(tt) * kstep : (u).b1 + (size_t)((tt) - ks) * kstep)
    Unit cur, nxt; int ui = 0;
    if (!S.get(0, cur)) return;
    S.a_ready(cur);
    if constexpr (Epi::AUXDMA) {
        if (wid == 1) { const char* src = uniform_ptr((const char*)E.aux_ptr(cur)); unsigned keep_;
            asm volatile("s_mov_b32 %0, m0\n\ts_mov_b32 m0, %1\n\ts_nop 4\n\tglobal_load_lds_dwordx4 %2, %3\n\ts_mov_b32 m0, %0"
                : "=&s"(keep_) : "s"(ldsbase + (unsigned)MISC_OFF + 16384u), "v"((unsigned)lane * 16u), "s"(src) : "memory"); } }
    unsigned c00, c01, c10, c11, n00, n01, n10, n11;
    if (GATHER) {
        c00 = (unsigned)(S.arow(cur, Rr[0]) * lda + Cc[0]) * 2u; c01 = (unsigned)(S.arow(cur, Rr[1]) * lda + Cc[1]) * 2u;
        c10 = (unsigned)(S.arow(cur, HALF + Rr[0]) * lda + Cc[0]) * 2u; c11 = (unsigned)(S.arow(cur, HALF + Rr[1]) * lda + Cc[1]) * 2u;
    } else {
        c00 = (unsigned)(Rr[0] * lda + Cc[0]) * 2u; c01 = (unsigned)(Rr[1] * lda + Cc[1]) * 2u;
        c10 = (unsigned)((HALF + Rr[0]) * lda + Cc[0]) * 2u; c11 = (unsigned)((HALF + Rr[1]) * lda + Cc[1]) * 2u;
    }
    n00 = c00; n01 = c01; n10 = c10; n11 = c11;
    f32x4 acc[2][2][4][2];
    float zr; asm volatile("v_mov_b32 %0, 0" : "=v"(zr));
#pragma unroll
    for (int a = 0; a < 2; ++a)
#pragma unroll
        for (int b = 0; b < 2; ++b)
#pragma unroll
            for (int m = 0; m < 4; ++m)
#pragma unroll
                for (int n = 0; n < 2; ++n) acc[a][b][m][n] = (f32x4){zr, zr, zr, zr};
    bf16x8 At[4][2], B0[2][2], B1[2][2];
    typename Epi::Pref pf;
    const char* cA = cur.a0;
    {
        const char* pb0 = PG8_BP(cur, 0); const char* pb1 = PG8_BP(cur, 1);
        PG8_STAGE2(PG8_SB(0, 0), pb0, voffB[0], voffB[1]); PG8_STAGE2(PG8_SA(0, 0), cA, c00, c01);
        PG8_STAGE2(PG8_SB(0, 1), pb0 + hstepB, voffB[0], voffB[1]); PG8_STAGE2(PG8_SA(0, 1), cA, c10, c11);
        if (wr == 1) PG8_BAR;
        PG8_WAIT_V(4); PG8_BAR;
        PG8_STAGE2(PG8_SB(1, 0), pb1, voffB[0], voffB[1]); PG8_STAGE2(PG8_SA(1, 0), cA + kstep, c00, c01);
        PG8_STAGE2(PG8_SB(1, 1), pb1 + hstepB, voffB[0], voffB[1]);
        PG8_WAIT_V(6); PG8_BAR;
    }
    for (;;) {
        const bool has_next = S.get(ui + 1, nxt);
        if (!has_next) nxt = cur;
        LAS int* tokb = (LAS int*)(lds + MISC_OFF + 1024) + ((ui + 1) & 1) * 256;
        if constexpr (Epi::AUXDMA) {
            if (has_next && wid == 1) { const char* src = uniform_ptr((const char*)E.aux_ptr(nxt)); unsigned keep_;
                asm volatile("s_mov_b32 %0, m0\n\ts_mov_b32 m0, %1\n\ts_nop 4\n\tglobal_load_lds_dwordx4 %2, %3\n\ts_mov_b32 m0, %0"
                    : "=&s"(keep_) : "s"(ldsbase + (unsigned)MISC_OFF + 16384u + (unsigned)((ui + 1) % 3) * 1024u), "v"((unsigned)lane * 16u), "s"(src) : "memory"); } }
        if (GATHER) {
            n00 = c00; n01 = c01; n10 = c10; n11 = c11;
            if (has_next && wid == 0) {
                const char* src = (const char*)S.rows_ptr(nxt); unsigned keep_;
                asm volatile("s_mov_b32 %0, m0\n\ts_mov_b32 m0, %1\n\ts_nop 4\n\tglobal_load_lds_dwordx4 %2, %3\n\ts_mov_b32 m0, %0"
                    : "=&s"(keep_) : "s"((unsigned)(unsigned long)tokb), "v"((unsigned)lane * 16u), "s"(src) : "memory");
            }
        }
        const char* nA = nxt.a0;
        if constexpr (Epi::MIDSCALE) {
            const char* src = uniform_ptr(E.mid_src(cur, wid)); unsigned keep_;
            asm volatile("s_mov_b32 %0, m0\n\ts_mov_b32 m0, %1\n\ts_nop 4\n\tglobal_load_lds_dwordx4 %2, %3\n\ts_mov_b32 m0, %0"
                : "=&s"(keep_) : "s"(ldsbase + (unsigned)MISC_OFF + 16384u + ldsw), "v"((unsigned)lane * 16u), "s"(src) : "memory"); }
#pragma unroll 1
        for (int t = 0; t < nt; t += 2) {
            const bool last = (t == nt - 2);
            if constexpr (Epi::PREF) { if (last) { if constexpr (Epi::AUXDMA) E.prefetch(cur, wr, wc, fr, fq, pf, (const LAS float*)(lds + MISC_OFF + 16384 + (ui % 3) * 1024)); else E.prefetch(cur, wr, wc, fr, fq, pf); } }
            if (last && has_next) S.a_ready(nxt);
            const char* a1 = cA + (size_t)(t + 1) * kstep;
            const char* a2 = last ? nA : cA + (size_t)(t + 2) * kstep;
            const char* a3 = a2 + kstep;
            const char* b2 = last ? PG8_BP(nxt, 0) : PG8_BP(cur, t + 2);
            const char* b3 = last ? PG8_BP(nxt, 1) : PG8_BP(cur, t + 3);
            if (GATHER) { if (last && has_next) {
                const int lim = S.rows_valid(nxt) - 1;
                const int i0 = Rr[0] < lim ? Rr[0] : lim, i1 = Rr[1] < lim ? Rr[1] : lim, i2 = (HALF + Rr[0]) < lim ? (HALF + Rr[0]) : lim, i3 = (HALF + Rr[1]) < lim ? (HALF + Rr[1]) : lim;
                n00 = (unsigned)(tokb[i0] * lda + Cc[0]) * 2u; n01 = (unsigned)(tokb[i1] * lda + Cc[1]) * 2u;
                n10 = (unsigned)(tokb[i2] * lda + Cc[0]) * 2u; n11 = (unsigned)(tokb[i3] * lda + Cc[1]) * 2u; } }
            const unsigned s00 = last ? n00 : c00, s01 = last ? n01 : c01, s10 = last ? n10 : c10, s11 = last ? n11 : c11;
            if constexpr (Epi::MIDSCALE) { if (t == ks) E.midscale(acc, cur, wr, wc, fr, fq, (const LAS float*)(lds + MISC_OFF + 16384)); }
            PG8_LDB(B0, 0, 0); PG8_SCHED; PG8_LDA(At, 0, 0); PG8_STAGE2(PG8_SA(1, 1), a1, c10, c11);
            PG8_WAIT_L(8); PG8_BAR; PG8_WAIT_L(0); PG8_MMA(0, 0, At, B0); PG8_BAR; PG8_SCHED;
            PG8_LDB(B1, 0, 1); PG8_STAGE2(PG8_SB(0, 0), b2, voffB[0], voffB[1]);
            PG8_BAR; PG8_WAIT_L(0); PG8_MMA(0, 1, At, B1); PG8_BAR;
            PG8_LDA(At, 0, 1); PG8_STAGE2(PG8_SA(0, 0), a2, s00, s01);
            PG8_BAR; PG8_WAIT_L(0); PG8_MMA(1, 0, At, B0); PG8_BAR; PG8_SCHED;
            PG8_STAGE2(PG8_SB(0, 1), b2 + hstepB, voffB[0], voffB[1]);
            PG8_WAIT_V(6); PG8_BAR; PG8_MMA(1, 1, At, B1); PG8_BAR;
            PG8_LDB(B0, 1, 0); PG8_SCHED; PG8_LDA(At, 1, 0); PG8_STAGE2(PG8_SA(0, 1), a2, s10, s11);
            PG8_WAIT_L(8); PG8_BAR; PG8_WAIT_L(0); PG8_MMA(0, 0, At, B0); PG8_BAR; PG8_SCHED;
            PG8_LDB(B1, 1, 1); PG8_STAGE2(PG8_SB(1, 0), b3, voffB[0], voffB[1]);
            PG8_BAR; PG8_WAIT_L(0); PG8_MMA(0, 1, At, B1); PG8_BAR;
            PG8_LDA(At, 1, 1); PG8_STAGE2(PG8_SA(1, 0), a3, s00, s01);
            PG8_BAR; PG8_WAIT_L(0); PG8_MMA(1, 0, At, B0); PG8_BAR; PG8_SCHED;
            PG8_STAGE2(PG8_SB(1, 1), b3 + hstepB, voffB[0], voffB[1]);
            PG8_WAIT_V(6); PG8_BAR; PG8_MMA(1, 1, At, B1); PG8_BAR;
        }
        if constexpr (Epi::AUXDMA && Epi::PREF) E(acc, cur, wr, wc, fr, fq, pf);
        else if constexpr (Epi::AUXDMA) E(acc, cur, wr, wc, fr, fq, (const LAS float*)(lds + MISC_OFF + 16384 + (ui % 3) * 1024));
        else if constexpr (Epi::PREF) E(acc, cur, wr, wc, fr, fq, pf); else E(acc, cur, wr, wc, fr, fq);
        if (!has_next) break;
        asm volatile("v_mov_b32 %0, 0" : "=v"(zr));
#pragma unroll
        for (int a = 0; a < 2; ++a)
#pragma unroll
            for (int b = 0; b < 2; ++b)
#pragma unroll
                for (int m = 0; m < 4; ++m)
#pragma unroll
                    for (int n = 0; n < 2; ++n) acc[a][b][m][n] = (f32x4){zr, zr, zr, zr};
        cur = nxt; cA = nA; ++ui; c00 = n00; c01 = n01; c10 = n10; c11 = n11;
    }
    PG8_WAIT_V(0);
    if (wr == 0) PG8_BAR;
    PG8_BAR;
#undef PG8_SA
#undef PG8_SB
#undef PG8_STAGE2
#undef PG8_LDA
#undef PG8_LDB
#undef PG8_MMA
#undef PG8_WAIT_V
#undef PG8_WAIT_L
#undef PG8_BAR
#undef PG8_SCHED
#undef PG8_BP
}

struct DenseSched {
    const char* A; const char* Bt; int lda, ldb, K; int nM, nN, nwg, G, c, skipctx;
    __device__ __forceinline__ void init(const void* A_, const void* Bt_, int M, int N, int K_, int lda_, int ldb_, int G_, int c_, int skipctx_ = 0) {
        A = (const char*)A_; Bt = (const char*)Bt_; lda = lda_; ldb = ldb_; K = K_; nM = M / BM - 2 * skipctx_; nN = N / BM; nwg = nM * nN; G = G_; c = c_; skipctx = skipctx_; }
    __device__ __forceinline__ bool get(int i, Unit& u) const {
        const long L = (long)i * G + c; if (L >= nwg) return false;
        int wgid = (int)L; { const int q = nwg / NXCD, r = nwg % NXCD, xcd = wgid % NXCD, off = wgid / NXCD; wgid = (xcd < r ? xcd * (q + 1) : r * (q + 1) + (xcd - r) * q) + off; }
        const int nig = WGM * nN, gid = wgid / nig, fm = gid * WGM, gsz = (nM - fm) < WGM ? (nM - fm) : WGM;
        int pm = fm + ((wgid % nig) % gsz); const int pn = (wgid % nig) / gsz;
        if (skipctx) pm += 1 + (pm >= 64 ? 1 : 0);
        u.a0 = A + (size_t)pm * BM * lda * 2; u.b0 = Bt + (size_t)pn * BM * ldb * 2; u.b1 = u.b0 + (size_t)(K / BK / 2) * BK * 2;
        u.i0 = pm; u.i1 = pn; u.i2 = 0; u.i3 = 0; u.i4 = 0; u.pad = 0; return true;
    }
    __device__ __forceinline__ void a_ready(const Unit&) const {}
    __device__ __forceinline__ int arow(const Unit&, int rl) const { return rl; }
    __device__ __forceinline__ const int* rows_ptr(const Unit&) const { return nullptr; }
    __device__ __forceinline__ int rows_valid(const Unit&) const { return 256; }
};
}

struct EpiProj {
    static constexpr bool PERM = true, MIDSCALE = false, PREF = false, AUXDMA = false; struct Pref {};
    bf16_t* O;
    __device__ __forceinline__ void operator()(const f32x4 (&acc)[2][2][4][2], const pg8::Unit& u, int wr, int wc, int fr, int fq) const {
        const int pn = u.i1;
        const int row0 = u.i0 * 256 + wr * 64 + fr;
        if (pn < 4) {
            const int col0 = pn * 128 + wc * 32 + 8 * fq;
#pragma unroll
            for (int ai = 0; ai < 2; ++ai)
#pragma unroll
                for (int m = 0; m < 4; ++m) { const f32x4 u0 = acc[ai][0][m][0], u1 = acc[ai][0][m][1], g0 = acc[ai][1][m][0], g1 = acc[ai][1][m][1];
                    u32x4 w; w.x = cvt_pk_bf16(u0[0] * sigmoidf_(g0[0]), u0[1] * sigmoidf_(g0[1])); w.y = cvt_pk_bf16(u0[2] * sigmoidf_(g0[2]), u0[3] * sigmoidf_(g0[3]));
                    w.z = cvt_pk_bf16(u1[0] * sigmoidf_(g1[0]), u1[1] * sigmoidf_(g1[1])); w.w = cvt_pk_bf16(u1[2] * sigmoidf_(g1[2]), u1[3] * sigmoidf_(g1[3]));
                    __builtin_nontemporal_store(w, (u32x4*)(O + (size_t)(row0 + ai * 128 + m * 16) * NPROJ + col0)); }
        } else {
            const int col0 = pn * 256 + wc * 32 + 8 * fq; const bool sl = pn < 6;
#pragma unroll
            for (int ai = 0; ai < 2; ++ai)
#pragma unroll
                for (int m = 0; m < 4; ++m) { bf16_t* rowp = O + (size_t)(row0 + ai * 128 + m * 16) * NPROJ + col0;
#pragma unroll
                    for (int bj = 0; bj < 2; ++bj) { f32x4 v0 = acc[ai][bj][m][0], v1 = acc[ai][bj][m][1];
                        if (sl) {
#pragma unroll
                            for (int e = 0; e < 4; ++e) { v0[e] = siluf_(v0[e]); v1[e] = siluf_(v1[e]); } }
                        u32x4 w; w.x = cvt_pk_bf16(v0[0], v0[1]); w.y = cvt_pk_bf16(v0[2], v0[3]); w.z = cvt_pk_bf16(v1[0], v1[1]); w.w = cvt_pk_bf16(v1[2], v1[3]);
                        __builtin_nontemporal_store(w, (u32x4*)(rowp + bj * 128)); } }
        }
    }
};
template <int L0> struct EpiResid {
    static constexpr bool PERM = true, MIDSCALE = true, PREF = true, AUXDMA = false;
    struct Pref { u32x4 h[2][2]; };
    __device__ __forceinline__ void prefetch(const pg8::Unit& u, int wr, int wc, int fr, int fq, Pref& pf) const {
        const int r0 = u.i0 * 256, rl0 = wr * 64 + fr, col0 = u.i1 * 256 + wc * 32 + 8 * fq;
#pragma unroll
        for (int m = 0; m < 2; ++m)
#pragma unroll
            for (int bj = 0; bj < 2; ++bj) pf.h[m][bj] = *(const u32x4*)(H + (size_t)(r0 + rl0 + m * 16) * D + col0 + bj * 128);
    }
    const float* inc; const float* inx; bf16_t* H; const float* modl; const float* ssq;
    __device__ __forceinline__ const char* mid_src(const pg8::Unit& u, int wid) const { return (const char*)(ssq + (size_t)(u.i0 * 256 + wid * 32) * 8); }
    __device__ __forceinline__ void midscale(f32x4 (&acc)[2][2][4][2], const pg8::Unit& u, int wr, int wc, int fr, int fq, const LAS float* sl) const {
#pragma unroll
        for (int ai = 0; ai < 2; ++ai)
#pragma unroll
            for (int m = 0; m < 4; ++m) { const LAS float* rp = sl + (ai * 128 + wr * 64 + m * 16 + fr) * 8;
                const f32x4 s0 = *(const LAS f32x4*)rp, s1 = *(const LAS f32x4*)(rp + 4);
                const float sq = (s0[0] + s0[1]) + (s0[2] + s0[3]) + (s1[0] + s1[1]) + (s1[2] + s1[3]);
                const float rs = rsqrtf(sq * (1.f / 512.f) + 1e-6f);
#pragma unroll
                for (int bj = 0; bj < 2; ++bj)
#pragma unroll
                    for (int n = 0; n < 2; ++n) acc[ai][bj][m][n] *= rs; }
    }
    __device__ __forceinline__ void operator()(const f32x4 (&acc)[2][2][4][2], const pg8::Unit& u, int wr, int wc, int fr, int fq, const Pref& pf) const {
        const int r0 = u.i0 * 256;
        const int v = row_v(r0);
        const float* gate = modl + (size_t)v * 6144 + 2 * 1024;
        const float* xin = xin_ptr(inc, inx, r0);
        const int rl0 = wr * 64 + fr, col0 = u.i1 * 256 + wc * 32 + 8 * fq;
        f32x4 gv[2][2];
#pragma unroll
        for (int bj = 0; bj < 2; ++bj)
#pragma unroll
            for (int n = 0; n < 2; ++n) gv[bj][n] = *(const f32x4*)(gate + col0 + bj * 128 + 4 * n);
#define EPR_LOAD(dst, ai_, mb_) do { _Pragma("unroll") for (int mm = 0; mm < 2; ++mm) _Pragma("unroll") for (int bj = 0; bj < 2; ++bj) \
            dst[mm][bj] = *(const u32x4*)(H + (size_t)(r0 + rl0 + (ai_) * 128 + ((mb_) + mm) * 16) * D + col0 + bj * 128); } while (0)
#define EPR_PROC(src, ai_, mb_) do { _Pragma("unroll") for (int mm = 0; mm < 2; ++mm) _Pragma("unroll") for (int bj = 0; bj < 2; ++bj) { const int m = (mb_) + mm; \
            const u32x4 hv = src[mm][bj]; const f32x4 a0 = acc[ai_][bj][m][0], a1 = acc[ai_][bj][m][1]; const f32x4 g0 = gv[bj][0], g1 = gv[bj][1]; u32x4 w; \
            w.x = cvt_pk_bf16(bflo(hv.x) + g0[0] * a0[0], bfhi(hv.x) + g0[1] * a0[1]); w.y = cvt_pk_bf16(bflo(hv.y) + g0[2] * a0[2], bfhi(hv.y) + g0[3] * a0[3]); \
            w.z = cvt_pk_bf16(bflo(hv.z) + g1[0] * a1[0], bfhi(hv.z) + g1[1] * a1[1]); w.w = cvt_pk_bf16(bflo(hv.w) + g1[2] * a1[2], bfhi(hv.w) + g1[3] * a1[3]); \
            __builtin_nontemporal_store(w, (u32x4*)(H + (size_t)(r0 + rl0 + (ai_) * 128 + m * 16) * D + col0 + bj * 128)); } asm volatile("" ::: "memory"); } while (0)
        u32x4 hA[2][2], hB[2][2], hC[2][2];
        EPR_LOAD(hA, 0, 2); EPR_LOAD(hB, 1, 0);
        EPR_PROC(pf.h, 0, 0);
        EPR_LOAD(hC, 1, 2);
        EPR_PROC(hA, 0, 2);
        EPR_PROC(hB, 1, 0);
        EPR_PROC(hC, 1, 2);
#undef EPR_LOAD
#undef EPR_PROC
    }
};

struct MoeSched {
    const LAS int* tab;
    const int* list;
    const char* A; const char* W; int mode  , l, G, c;
    unsigned* ready;
    __device__ __forceinline__ void a_ready(const pg8::Unit& u) const {
        if (mode == 0) return;
        if (threadIdx.x < 64) {
            unsigned* w = ready + u.i4; unsigned spins = 0;
            while ((unsigned)__builtin_amdgcn_readfirstlane((int)__hip_atomic_load(w, __ATOMIC_RELAXED, __HIP_MEMORY_SCOPE_AGENT)) < 32u) {
                __builtin_amdgcn_s_sleep(2); if (++spins > (1u << 22)) break; }
            __builtin_amdgcn_fence(__ATOMIC_ACQUIRE, "agent");
            asm volatile("s_waitcnt vmcnt(0)" ::: "memory");
        }
        asm volatile("" ::: "memory"); __builtin_amdgcn_s_barrier(); asm volatile("" ::: "memory");
    }
    int late;
    __device__ __forceinline__ bool get(int i, pg8::Unit& u) const {
        const int total = __builtin_amdgcn_readfirstlane(tab[24]) * 4;
        int L;
        if (mode == 0 || late == 0) L = i * G + c;
        else if (c < late) { if (i > 0) return false; L = c; }
        else L = late + (c - late) + i * (G - late);
        if (L >= total) return false;
        const int tl = L >> 2, pn = L & 3;
        int cls = 0;
#pragma unroll 1
        for (int q = 1; q < NCLS; ++q) { const int tq = __builtin_amdgcn_readfirstlane(tab[q]); if (tq <= tl) cls = q; }
        const int j = tl - __builtin_amdgcn_readfirstlane(tab[cls]), cnt = __builtin_amdgcn_readfirstlane(tab[32 + cls]);
        const int g = cls / 6, pidx = cls - g * 6;
        const int ea = (pidx >= 3) + (pidx >= 5), eb = pidx < 3 ? pidx + 1 : (pidx < 5 ? pidx - 1 : 3);
        if (mode == 0) {
            const int e = 4 * g + (pn < 2 ? ea : eb);
            u.a0 = A;
            u.b0 = W + ((size_t)(l * 16 + e) * 512 + (size_t)(pn & 1) * 256) * 1024 * 2; u.b1 = u.b0 + (size_t)8 * 128;
        } else {
            u.a0 = A + (size_t)tl * 256 * 512 * 2;
            u.b0 = W + ((size_t)(l * 16 + 4 * g + ea) * 1024 + (size_t)pn * 256) * 256 * 2;
            u.b1 = W + ((size_t)(l * 16 + 4 * g + eb) * 1024 + (size_t)pn * 256) * 256 * 2;
        }
        u.a0 = uniform_ptr(u.a0); u.b0 = uniform_ptr(u.b0); u.b1 = uniform_ptr(u.b1);
        u.i0 = cls; u.i1 = j; u.i2 = pn; u.i3 = cnt; u.i4 = tl; u.pad = 0; return true;
    }
    __device__ __forceinline__ int arow(const pg8::Unit& u, int rl) const {
        int idx = u.i1 * 256 + rl; idx = idx < u.i3 ? idx : u.i3 - 1;
        return list[(size_t)u.i0 * R + idx];
    }
    __device__ __forceinline__ const int* rows_ptr(const pg8::Unit& u) const { return list + (size_t)u.i0 * R + u.i1 * 256; }
    __device__ __forceinline__ int rows_valid(const pg8::Unit& u) const { return u.i3 - u.i1 * 256; }
};
struct EpiUp {
    static constexpr bool PERM = true, MIDSCALE = false, PREF = false, AUXDMA = true; struct Pref {};
    bf16_t* hid; const float* cwla; const float* cwlb; unsigned* ready;
    __device__ __forceinline__ const float* aux_ptr(const pg8::Unit& u) const { return ((u.i2 < 2) ? cwla : cwlb) + (size_t)u.i0 * R + u.i1 * 256; }
    __device__ __forceinline__ void operator()(const f32x4 (&acc)[2][2][4][2], const pg8::Unit& u, int wr, int wc, int fr, int fq, const LAS float* cwl) const {
        const int j = u.i1, pn = u.i2, cnt = u.i3, tl = u.i4;
        const int colbase = (pn >> 1) * 256 + (pn & 1) * 128 + wc * 32 + 8 * fq;
        float wrow[2][4];
#pragma unroll
        for (int ai = 0; ai < 2; ++ai)
#pragma unroll
            for (int m = 0; m < 4; ++m) { const int rl = ai * 128 + wr * 64 + m * 16 + fr; wrow[ai][m] = (j * 256 + rl) < cnt ? cwl[rl] : 0.f; }
#pragma unroll
        for (int ai = 0; ai < 2; ++ai)
#pragma unroll
            for (int m = 0; m < 4; ++m) {
                const int rl = ai * 128 + wr * 64 + m * 16 + fr; const int idx = j * 256 + rl; const bool valid = idx < cnt;
                const float w = wrow[ai][m];
                const f32x4 g0 = acc[ai][0][m][0], g1 = acc[ai][0][m][1], u0 = acc[ai][1][m][0], u1 = acc[ai][1][m][1];
                float o[8];
#pragma unroll
                for (int e = 0; e < 4; ++e) { o[e] = w * siluf_(g0[e]) * u0[e]; o[4 + e] = w * siluf_(g1[e]) * u1[e]; }
                if (!valid) {
#pragma unroll
                    for (int e = 0; e < 8; ++e) o[e] = 0.f; }
                u32x4 pk; pk.x = cvt_pk_bf16(o[0], o[1]); pk.y = cvt_pk_bf16(o[2], o[3]); pk.z = cvt_pk_bf16(o[4], o[5]); pk.w = cvt_pk_bf16(o[6], o[7]);
                { bf16_t* dstp = hid + ((size_t)tl * 256 + rl) * 512 + colbase;
                  asm volatile("global_store_dwordx4 %0, %1, off sc1\n\ts_nop 1" :: "v"(dstp), "v"(pk) : "memory"); }
            }
        asm volatile("s_waitcnt vmcnt(0)" ::: "memory");
        if ((threadIdx.x & 63) == 0) __hip_atomic_fetch_add(ready + tl, 1u, __ATOMIC_RELAXED, __HIP_MEMORY_SCOPE_AGENT);
    }
};
struct EpiDown {
    static constexpr bool PERM = true, MIDSCALE = false, PREF = true, AUXDMA = true;
    struct Pref { int tok[2][4]; u32x4 h0[2][2]; };
    bf16_t* H; const int* list; const LAS float* gl;
    __device__ __forceinline__ const float* aux_ptr(const pg8::Unit& u) const { return (const float*)(list + (size_t)u.i0 * R + u.i1 * 256); }
    __device__ __forceinline__ void prefetch(const pg8::Unit& u, int wr, int wc, int fr, int fq, Pref& pf, const LAS float* slot) const {
        const int j = u.i1, cnt = u.i3; const LAS int* tl = (const LAS int*)slot;
#pragma unroll
        for (int ai = 0; ai < 2; ++ai)
#pragma unroll
            for (int m = 0; m < 4; ++m) { const int rl = ai * 128 + wr * 64 + m * 16 + fr; pf.tok[ai][m] = (j * 256 + rl) < cnt ? tl[rl] : -1; }
        const int col0 = u.i2 * 256 + wc * 32 + 8 * fq;
#pragma unroll
        for (int mm = 0; mm < 2; ++mm) { const int t = pf.tok[0][mm]; const bf16_t* hp = H + (size_t)(t < 0 ? 0 : t) * D + col0;
#pragma unroll
            for (int bj = 0; bj < 2; ++bj) pf.h0[mm][bj] = *(const u32x4*)(hp + bj * 128); }
    }
    __device__ __forceinline__ void operator()(const f32x4 (&acc)[2][2][4][2], const pg8::Unit& u, int wr, int wc, int fr, int fq, const Pref& pf) const {
        const int pn = u.i2;
        const int col0 = pn * 256 + wc * 32 + 8 * fq;
        int tok[2][4];
#pragma unroll
        for (int ai = 0; ai < 2; ++ai)
#pragma unroll
            for (int m = 0; m < 4; ++m) tok[ai][m] = pf.tok[ai][m];
        u32x4 hr[2][2][2];
#define EPD_LOAD(bt) do { _Pragma("unroll") for (int mm = 0; mm < 2; ++mm) { const int t = tok[(bt) >> 1][2 * ((bt) & 1) + mm]; const bf16_t* hp = H + (size_t)(t < 0 ? 0 : t) * D + col0; \
            _Pragma("unroll") for (int bj = 0; bj < 2; ++bj) hr[(bt) & 1][mm][bj] = *(const u32x4*)(hp + bj * 128); } } while (0)
#pragma unroll
        for (int mm = 0; mm < 2; ++mm)
#pragma unroll
            for (int bj = 0; bj < 2; ++bj) hr[0][mm][bj] = pf.h0[mm][bj];
#pragma unroll
        for (int bt = 0; bt < 4; ++bt) { const int ai = bt >> 1, mp = bt & 1;
            if (bt + 1 < 4) EPD_LOAD(bt + 1);
#pragma unroll
            for (int mm = 0; mm < 2; ++mm) { const int m = 2 * mp + mm; const int t = tok[ai][m];
                if (t >= 0) { const LAS float* gp = gl + row_v(t) * 1024 + col0;
#pragma unroll
                    for (int bj = 0; bj < 2; ++bj) { const u32x4 hv = hr[bt & 1][mm][bj]; const f32x4 a0 = acc[ai][bj][m][0], a1 = acc[ai][bj][m][1];
                        const f32x4 g0 = *(const LAS f32x4*)(gp + bj * 128), g1 = *(const LAS f32x4*)(gp + bj * 128 + 4);
                        u32x4 w;
                        w.x = cvt_pk_bf16(bflo(hv.x) + g0[0] * a0[0], bfhi(hv.x) + g0[1] * a0[1]); w.y = cvt_pk_bf16(bflo(hv.y) + g0[2] * a0[2], bfhi(hv.y) + g0[3] * a0[3]);
                        w.z = cvt_pk_bf16(bflo(hv.z) + g1[0] * a1[0], bfhi(hv.z) + g1[1] * a1[1]); w.w = cvt_pk_bf16(bflo(hv.w) + g1[2] * a1[2], bfhi(hv.w) + g1[3] * a1[3]);
                        *(u32x4*)(H + (size_t)t * D + col0 + bj * 128) = w; } } }
            asm volatile("" ::: "memory"); }
#undef EPD_LOAD
    }
};

__device__ __forceinline__ void tr_tile(const float* src, int ldn, int k0, int n0, int nvalid, bf16_t* dst, int ldk, int drow0, LAS float* tile, int kd0 = -1, const float* kscale = nullptr) {
    const int tid = launder_tid();
    if (kd0 < 0) kd0 = k0;
    { const int n = tid & 63; const int kq = tid >> 6; float tv[8], ts[8];
#pragma unroll
      for (int it = 0; it < 8; ++it) { const int kk = kq + 8 * it; tv[it] = (n < nvalid) ? src[(size_t)(k0 + kk) * ldn + n0 + n] : 0.f; ts[it] = kscale ? kscale[kk] : 1.f; }
#pragma unroll
      for (int it = 0; it < 8; ++it) tile[(kq + 8 * it) * 65 + n] = tv[it] * ts[it]; }
    __syncthreads();
    { const int k8 = tid & 7, n = tid >> 3;
      if (n < nvalid) { const LAS float* s = tile + (k8 * 8) * 65 + n;
          u32x4 o; o.x = cvt_pk_bf16(s[0], s[65]); o.y = cvt_pk_bf16(s[2 * 65], s[3 * 65]); o.z = cvt_pk_bf16(s[4 * 65], s[5 * 65]); o.w = cvt_pk_bf16(s[6 * 65], s[7 * 65]);
          *(u32x4*)(dst + (size_t)(drow0 + n) * ldk + kd0 + k8 * 8) = o; } }
    __syncthreads();
}
constexpr int WPREP_ITEMS_PER_LAYER = 16 * 41 + 256 + 1024 + 1024 + 1024;
__device__ __forceinline__ void phase_wprep(CP p, unsigned char* lds, int it0, int it1, int bidx, int nblk, int b0 = 0, int b1 = 0, int c0 = 0, int c1 = 0) {
    LAS float* tile = (LAS float*)(LAS unsigned char*)lds;
    constexpr int I_IN = 16 * 41, I_OUT = 256, I_G = 1024, I_U = 1024, I_D = 1024, I_L = I_IN + I_OUT + I_G + I_U + I_D;
    const int na = it1 - it0, nbb = b1 - b0, ncc = c1 - c0;
    for (int vi = bidx; vi < na + nbb + ncc; vi += nblk) {
        const int it = vi < na ? it0 + vi : (vi < na + nbb ? b0 + (vi - na) : c0 + (vi - na - nbb));
        const int l = it / I_L; int r = it - l * I_L;
        if (r < I_IN) { const int kt = r / 41, ntl = r % 41; const int n0 = ntl * 64; const int nv = (DIN - n0) < 64 ? (DIN - n0) : 64;
            const int dr = n0 < 512 ? (n0 >> 7) * 256 + (n0 & 127) : (n0 < 1024 ? ((n0 - 512) >> 7) * 256 + 128 + ((n0 - 512) & 127) : n0);
            tr_tile(p->w_in + (size_t)l * 1024 * DIN, DIN, kt * 64, n0, nv, (bf16_t*)(p->ws + WS_WTIN) + (size_t)l * DIN * 1024, 1024, dr, tile); continue; }
        r -= I_IN;
        if (r < I_OUT) { const int kt = r >> 4, ntl = r & 15;
            tr_tile(p->w_out + (size_t)l * 1024 * 1024, 1024, kt * 64, ntl * 64, 64, (bf16_t*)(p->ws + WS_WTOUT) + (size_t)l * 1024 * 1024, 1024, ntl * 64, tile,
                    (kt * 64 + 512) & 1023, kt >= 8 ? p->ssd_norm_g + l * 512 + (kt * 64 - 512) : nullptr); continue; }
        r -= I_OUT;
        if (r < I_G + I_U) { const int up = r >= I_G; if (up) r -= I_G; const int e = r >> 6, q = r & 63, kt = q >> 2, ntl = q & 3; const int n0 = ntl * 64;
            const float* src = (up ? p->w_up : p->w_gate) + (size_t)(l * 16 + e) * 1024 * 256;
            tr_tile(src, 256, kt * 64, n0, 64, (bf16_t*)(p->ws + WS_WTGU) + (size_t)(l * 16 + e) * 512 * 1024, 1024, (n0 >> 7) * 256 + (n0 & 127) + (up ? 128 : 0), tile); continue; }
        r -= I_G + I_U;
        { const int e = r >> 6, q = r & 63, kt = q >> 4, ntl = q & 15;
          tr_tile(p->w_down + (size_t)(l * 16 + e) * 256 * 1024, 1024, kt * 64, ntl * 64, 64, (bf16_t*)(p->ws + WS_WTD) + (size_t)(l * 16 + e) * 1024 * 256, 256, ntl * 64, tile); }
    }
}
__device__ __forceinline__ void phase_adaln(CP p, unsigned char* lds, int bid, int nb, int it0, int it1) {
    LAS float* sc = (LAS float*)(LAS unsigned char*)lds;
    LAS float* red = sc + 3 * 1024;
    const int tid = launder_tid();
    for (int idx = tid; idx < 3 * 1024; idx += NTHREADS) { const int v = idx >> 10, k = idx & 1023; const float cv = (v < 2) ? p->c[v * 1024 + k] : p->c_ctx[k]; sc[idx] = siluf_(cv); }
    __syncthreads();
    float* mod = (float*)(p->ws + WS_MOD);
    for (int it = it0 + bid; it < it1; it += nb) {
        const int l = it / 192, n0 = (it % 192) * 32;
        const int c4 = tid & 7, kr = tid >> 3;
        const float* w = p->w_ada + (size_t)l * 1024 * 6144 + n0 + c4 * 4;
        f32x4 w4[16];
#pragma unroll
        for (int j = 0; j < 16; ++j) w4[j] = *(const f32x4*)(w + (size_t)(kr + 64 * j) * 6144);
        f32x4 a0 = {0, 0, 0, 0}, a1 = {0, 0, 0, 0}, a2 = {0, 0, 0, 0};
#pragma unroll
        for (int j = 0; j < 16; ++j) { const int k = kr + 64 * j; a0 += sc[k] * w4[j]; a1 += sc[1024 + k] * w4[j]; a2 += sc[2048 + k] * w4[j]; }
        *(LAS f32x4*)(red + (kr * 3 + 0) * 32 + c4 * 4) = a0; *(LAS f32x4*)(red + (kr * 3 + 1) * 32 + c4 * 4) = a1; *(LAS f32x4*)(red + (kr * 3 + 2) * 32 + c4 * 4) = a2;
        __syncthreads();
        if (tid < 96) { const int v = tid >> 5, cc = tid & 31; float s = 0.f;
            for (int q = 0; q < 64; ++q) s += red[(q * 3 + v) * 32 + cc];
            mod[((size_t)l * 3 + v) * 6144 + n0 + cc] = s + p->b_ada[l * 6144 + n0 + cc]; }
        __syncthreads();
    }
}
__device__ __forceinline__ void moe_table(CP p, int l, LAS int* tab) {
    const int* gcount = (const int*)(p->ws + WS_CTL) + l * 32;
    if (threadIdx.x == 0) { int acc = 0; for (int q = 0; q < NCLS; ++q) { const int cn = gcount[q]; tab[q] = acc; tab[32 + q] = cn; acc += (cn + 255) >> 8; } tab[24] = acc; }
    __syncthreads();
}
typedef _Float16 f16x8 __attribute__((ext_vector_type(8)));
typedef _Float16 f16x2 __attribute__((ext_vector_type(2)));
constexpr int ST_H16 = 2064;
__device__ __forceinline__ unsigned pack_f16(float a, float b) { f16x2 h; h[0] = (_Float16)a; h[1] = (_Float16)b; return __builtin_bit_cast(unsigned, h); }
__device__ __forceinline__ void phase_r1(CP p, int l, unsigned char* lds_, int bid, int nb) {
    LAS unsigned char* lds = (LAS unsigned char*)lds_;
    LAS unsigned char* Wh = lds;
    LAS unsigned char* Xh = Wh + 16 * ST_H16;
    LAS float* gm = (LAS float*)(Xh + 16 * ST_H16);
    LAS float* sh = gm + 3 * 1024;
    LAS float* part = sh + 3 * 1024;
    const int tid = launder_tid(); const int lane = tid & 63, wave = __builtin_amdgcn_readfirstlane(tid >> 6);
    const float* mod = (const float*)(p->ws + WS_MOD) + (size_t)l * 3 * 6144;
    const float* win = p->w_in + (size_t)l * 1024 * DIN;
#pragma unroll
    for (int hb = 0; hb < 2; ++hb) { float tmp[16];
#pragma unroll
        for (int it = 0; it < 16; ++it) { const int idx = tid + NTHREADS * (16 * hb + it); tmp[it] = win[(size_t)(idx >> 4) * DIN + NPROJ + (idx & 15)]; }
#pragma unroll
        for (int it = 0; it < 16; ++it) { const int idx = tid + NTHREADS * (16 * hb + it); *(LAS _Float16*)(Wh + (idx & 15) * ST_H16 + (idx >> 4) * 2) = (_Float16)tmp[it]; } }
    { float t0[6], t1[6], t2[6];
#pragma unroll
      for (int it = 0; it < 6; ++it) { const int idx = tid + NTHREADS * it; const int v = idx >> 10, k = idx & 1023; t0[it] = p->g_mix[l * 1024 + k]; t1[it] = mod[v * 6144 + 1024 + k]; t2[it] = mod[v * 6144 + k]; }
#pragma unroll
      for (int it = 0; it < 6; ++it) { const int idx = tid + NTHREADS * it; gm[idx] = t0[it] * (1.f + t1[it]); sh[idx] = t2[it]; } }
    __syncthreads();
    bf16_t* HX = (bf16_t*)(p->ws + WS_HX); float* DT = (float*)(p->ws + WS_DT);
    const int rpb = (R + nb - 1) / nb, r0 = bid * rpb, r1 = (r0 + rpb) < R ? (r0 + rpb) : R;
    RowRaw xn[2];
#pragma unroll
    for (int q = 0; q < 2; ++q) if (r0 + 2 * wave + q < r1) row_load(p, l, r0 + 2 * wave + q, lane, xn[q]);
#pragma unroll 1
    for (int t0r = r0; t0r < r1; t0r += 16) {
        f32x4 xv[2][4];
#pragma unroll
        for (int q = 0; q < 2; ++q) row_cvt(l, xn[q], xv[q]);
#pragma unroll
        for (int q = 0; q < 2; ++q) if (t0r + 16 + 2 * wave + q < r1) row_load(p, l, t0r + 16 + 2 * wave + q, lane, xn[q]);
#pragma unroll
        for (int q = 0; q < 2; ++q) { const int rr = t0r + 2 * wave + q; const bool ok = rr < r1; const int v = row_v(ok ? rr : r0);
            if (l == 0 && ok) { u32x2* hw = (u32x2*)((bf16_t*)(p->ws + WS_H) + (size_t)rr * D);
#pragma unroll
                for (int j = 0; j < 4; ++j) { u32x2 o; o.x = cvt_pk_bf16(xv[q][j][0], xv[q][j][1]); o.y = cvt_pk_bf16(xv[q][j][2], xv[q][j][3]); hw[lane + 64 * j] = o; } }
            float ss = 0.f;
#pragma unroll
            for (int j = 0; j < 4; ++j) ss += xv[q][j][0] * xv[q][j][0] + xv[q][j][1] * xv[q][j][1] + xv[q][j][2] * xv[q][j][2] + xv[q][j][3] * xv[q][j][3];
            ss = wave_sum(ss); const float rs = ok ? __builtin_amdgcn_rsqf(ss * (1.f / 1024.f) + 1e-6f) : 0.f;
#pragma unroll
            for (int j = 0; j < 4; ++j) { const int k = 4 * lane + 256 * j; const f32x4 g4 = *(const LAS f32x4*)(gm + v * 1024 + k), s4 = *(const LAS f32x4*)(sh + v * 1024 + k);
                f32x4 hv = xv[q][j] * rs * g4 + s4; if (!ok) hv = hv * 0.f;
                u32x2 o; o.x = cvt_pk_bf16(hv[0], hv[1]); o.y = cvt_pk_bf16(hv[2], hv[3]);
                if (ok) *(u32x2*)(HX + (size_t)rr * 1024 + k) = o;
                u32x2 h16; h16.x = pack_f16(hv[0], hv[1]); h16.y = pack_f16(hv[2], hv[3]);
                *(LAS u32x2*)(Xh + (2 * wave + q) * ST_H16 + k * 2) = h16; } }
        __syncthreads();
        {
            f32x4 acc0 = {0.f, 0.f, 0.f, 0.f};
#pragma unroll
            for (int s4 = 0; s4 < 4; ++s4) { const int kb = (128 * wave + 32 * s4 + 8 * (lane >> 4)) * 2;
                const f16x8 a = *(const LAS f16x8*)(Xh + (lane & 15) * ST_H16 + kb);
                const f16x8 b0 = *(const LAS f16x8*)(Wh + (lane & 15) * ST_H16 + kb);
                acc0 = __builtin_amdgcn_mfma_f32_16x16x32_f16(a, b0, acc0, 0, 0, 0); }
#pragma unroll
            for (int e = 0; e < 4; ++e) part[(wave * 16 + 4 * (lane >> 4) + e) * 16 + (lane & 15)] = acc0[e];
        }
        __syncthreads();
        if (tid < 256) { const int row = tid >> 4, n = tid & 15; const int rr = t0r + row;
            float sacc = p->dt_bias[l * 16 + n];
#pragma unroll
            for (int w = 0; w < 8; ++w) sacc += part[(w * 16 + row) * 16 + n];
            if (rr < r1) DT[(size_t)n * R + rr] = softplusf_(sacc); }
    }
    __syncthreads();
}
typedef float f32x16 __attribute__((ext_vector_type(16)));
typedef short s16x4 __attribute__((ext_vector_type(4)));
constexpr int ST_ROW = 272;
constexpr int ST_TR128 = 320;
constexpr int ST_TR64 = 192;
constexpr int ST_MT = 328;
constexpr int NCHUNK = SEG / 128;

#define DPP_MOV(v, ctrl, rm, bm) __builtin_bit_cast(float, __builtin_amdgcn_update_dpp(0, __builtin_bit_cast(int, (v)), (ctrl), (rm), (bm), true))
__device__ __forceinline__ float wave_incl_scan(float v, int) {
    float s = v + DPP_MOV(v, 0x111, 0xF, 0xF) + DPP_MOV(v, 0x112, 0xF, 0xF) + DPP_MOV(v, 0x113, 0xF, 0xF);
    s += DPP_MOV(s, 0x114, 0xF, 0xE);
    s += DPP_MOV(s, 0x118, 0xF, 0xC);
    s += DPP_MOV(s, 0x142, 0xA, 0xF);
    s += DPP_MOV(s, 0x143, 0xC, 0xF);
    return s;
}
__device__ __forceinline__ bf16x8 row_frag(const LAS unsigned char* tile, int stride, int row0, int k0, int lane) {
    return *(const LAS bf16x8*)(tile + (row0 + (lane & 31)) * stride + (k0 + 8 * (lane >> 5)) * 2);
}
__device__ __forceinline__ bf16x8 tr_frag(const LAS unsigned char* tile, int stride, int k0, int c0, int lane) {
    const int g = lane >> 4, li = lane & 15, q = li >> 2, pp = li & 3;
    const LAS unsigned char* a0 = tile + (k0 + 8 * (g >> 1) + q) * stride + (c0 + 16 * (g & 1) + 4 * pp) * 2;
    const s16x4 lo = __builtin_amdgcn_ds_read_tr16_b64_v4i16((LAS s16x4*)a0);
    const s16x4 hi = __builtin_amdgcn_ds_read_tr16_b64_v4i16((LAS s16x4*)(a0 + 4 * stride));
    return __builtin_shufflevector(lo, hi, 0, 1, 2, 3, 4, 5, 6, 7);
}
__device__ __forceinline__ u32x4 pack8(const float (&v)[8]) { u32x4 r; r.x = cvt_pk_bf16(v[0], v[1]); r.y = cvt_pk_bf16(v[2], v[3]); r.z = cvt_pk_bf16(v[4], v[5]); r.w = cvt_pk_bf16(v[6], v[7]); return r; }
__device__ __forceinline__ u32x4 pack8s(const float (&v)[8], float sc) { u32x4 r; r.x = cvt_pk_bf16(v[0] * sc, v[1] * sc); r.y = cvt_pk_bf16(v[2] * sc, v[3] * sc); r.z = cvt_pk_bf16(v[4] * sc, v[5] * sc); r.w = cvt_pk_bf16(v[6] * sc, v[7] * sc); return r; }

__device__ __forceinline__ void conv_load(const bf16_t* proj, int row0, int rq, int xch, bool lo_ok, bool hi_ok, u32x4 (&raw)[8]) {
    const bf16_t* base = proj + (size_t)(row0 + 4 * rq) * NPROJ + 1536 + xch;
    const bool okl = (rq > 0) || lo_ok, okh = (rq < 31) || hi_ok;
#pragma unroll
    for (int j = 0; j < 8; ++j) raw[j] = *(const u32x4*)((j < 2 ? okl : (j >= 6 ? okh : true)) ? base + (j - 2) * NPROJ : base);
}
__device__ __forceinline__ void conv_compute(const u32x4 (&raw)[8], const LAS float* wl, int nchl, int wch, float (&o)[4][8], bool zl = false, bool zh = false) {
    float w[5][8], bs[8];
#pragma unroll
    for (int j = 0; j < 5; ++j) { const f32x4 w0 = *(const LAS f32x4*)(wl + j * nchl + wch), w1 = *(const LAS f32x4*)(wl + j * nchl + wch + 4);
        w[j][0] = w0[0]; w[j][1] = w0[1]; w[j][2] = w0[2]; w[j][3] = w0[3]; w[j][4] = w1[0]; w[j][5] = w1[1]; w[j][6] = w1[2]; w[j][7] = w1[3]; }
    { const f32x4 b0 = *(const LAS f32x4*)(wl + 5 * nchl + wch), b1 = *(const LAS f32x4*)(wl + 5 * nchl + wch + 4); bs[0] = b0[0]; bs[1] = b0[1]; bs[2] = b0[2]; bs[3] = b0[3]; bs[4] = b1[0]; bs[5] = b1[1]; bs[6] = b1[2]; bs[7] = b1[3]; }
#pragma unroll
    for (int i = 0; i < 4; ++i)
#pragma unroll
        for (int e = 0; e < 8; ++e) o[i][e] = bs[e];
    const float fl = zl ? 0.f : 1.f, fh = zh ? 0.f : 1.f;
#pragma unroll
    for (int j = 0; j < 8; ++j) {
        float xv[8] = {bflo(raw[j].x), bfhi(raw[j].x), bflo(raw[j].y), bfhi(raw[j].y), bflo(raw[j].z), bfhi(raw[j].z), bflo(raw[j].w), bfhi(raw[j].w)};
        if (j < 2) {
#pragma unroll
            for (int e = 0; e < 8; ++e) xv[e] *= fl; }
        if (j >= 6) {
#pragma unroll
            for (int e = 0; e < 8; ++e) xv[e] *= fh; }
#pragma unroll
        for (int i = 0; i < 4; ++i) { const int tap = j - i; if (tap >= 0 && tap < 5) {
#pragma unroll
                for (int e = 0; e < 8; ++e) o[i][e] += w[tap][e] * xv[e]; } }
    }
#pragma unroll
    for (int i = 0; i < 4; ++i)
#pragma unroll
        for (int e = 0; e < 8; ++e) o[i][e] = siluf_(o[i][e]);
}
__device__ __forceinline__ void conv_load4(const bf16_t* proj, int row0, int rq, int xch, bool lo_ok, bool hi_ok, u32x2 (&raw)[8]) {
    const bf16_t* base = proj + (size_t)(row0 + 4 * rq) * NPROJ + 1536 + xch;
    const bool okl = (rq > 0) || lo_ok, okh = (rq < 31) || hi_ok;
#pragma unroll
    for (int j = 0; j < 8; ++j) raw[j] = *(const u32x2*)((j < 2 ? okl : (j >= 6 ? okh : true)) ? base + (j - 2) * NPROJ : base);
}
__device__ __forceinline__ void conv_compute4(const u32x2 (&raw)[8], const LAS float* wl, int nchl, int wch, float (&o)[4][4], bool zl, bool zh) {
    f32x4 w[5];
#pragma unroll
    for (int j = 0; j < 5; ++j) w[j] = *(const LAS f32x4*)(wl + j * nchl + wch);
    const f32x4 bs = *(const LAS f32x4*)(wl + 5 * nchl + wch);
#pragma unroll
    for (int i = 0; i < 4; ++i)
#pragma unroll
        for (int e = 0; e < 4; ++e) o[i][e] = bs[e];
    const float fl = zl ? 0.f : 1.f, fh = zh ? 0.f : 1.f;
#pragma unroll
    for (int j = 0; j < 8; ++j) {
        float xv[4] = {bflo(raw[j].x), bfhi(raw[j].x), bflo(raw[j].y), bfhi(raw[j].y)};
        if (j < 2) {
#pragma unroll
            for (int e = 0; e < 4; ++e) xv[e] *= fl; }
        if (j >= 6) {
#pragma unroll
            for (int e = 0; e < 4; ++e) xv[e] *= fh; }
#pragma unroll
        for (int i = 0; i < 4; ++i) { const int tap = j - i; if (tap >= 0 && tap < 5) {
#pragma unroll
                for (int e = 0; e < 4; ++e) o[i][e] += w[tap][e] * xv[e]; } }
    }
#pragma unroll
    for (int i = 0; i < 4; ++i)
#pragma unroll
        for (int e = 0; e < 4; ++e) o[i][e] = siluf_(o[i][e]);
}
__device__ __forceinline__ void head_cums(CP p, int l, int row0, int h, int dir, int lane, LAS float* hv, const LAS float* atab) {
    const float A = atab[dir * 8 + h];
    const float* DT = (const float*)(p->ws + WS_DT);
    typedef float f32x2 __attribute__((ext_vector_type(2)));
    const f32x2 dd = *(const f32x2*)(DT + (size_t)(dir * 8 + h) * R + row0 + 2 * lane); const float d0 = dd[0], d1 = dd[1];
    const float x0 = d0 * A, x1 = d1 * A;
    const float incl = wave_incl_scan(x0 + x1, lane);
    const float total = __builtin_bit_cast(float, __builtin_amdgcn_readlane(__builtin_bit_cast(int, incl), 63));
    float c0, c1;
    if (dir == 0) { c1 = incl; c0 = incl - x1; } else { c0 = total - (incl - x1 - x0); c1 = total - (incl - x1); }
    hv[dir * 128 + 2 * lane] = c0; hv[dir * 128 + 2 * lane + 1] = c1;
    hv[256 + dir * 128 + 2 * lane] = d0; hv[256 + dir * 128 + 2 * lane + 1] = d1;
    if (lane == 0) hv[512 + dir] = total;
}
__device__ __forceinline__ bf16x8 scale_frag(bf16x8 f, const f32x4 w0, const f32x4 w1) {
    const u32x4 u = __builtin_bit_cast(u32x4, f);
    u32x4 r;
    r.x = cvt_pk_bf16(bflo(u.x) * w0[0], bfhi(u.x) * w0[1]); r.y = cvt_pk_bf16(bflo(u.y) * w0[2], bfhi(u.y) * w0[3]);
    r.z = cvt_pk_bf16(bflo(u.z) * w1[0], bfhi(u.z) * w1[1]); r.w = cvt_pk_bf16(bflo(u.w) * w1[2], bfhi(u.w) * w1[3]);
    return __builtin_bit_cast(bf16x8, r);
}
constexpr int ST_X256 = 576;

__device__ __forceinline__ void phase_c1(CP p, int l, unsigned char* lds_, int bid, int nb) {
    LAS unsigned char* lds = (LAS unsigned char*)lds_;
    LAS unsigned char* tile = lds;
    LAS float* wl = (LAS float*)(lds + 73216);
    const int tid = launder_tid();
    const bf16_t* proj = (const bf16_t*)(p->ws + WS_PROJ); bf16_t* mix = (bf16_t*)(p->ws + WS_HX);
    const int NU = 256 + 512 + (l == DEPTH - 1 ? 0 : 16);
    const int heavy = (nb > 64 && (NB * NCHUNK * 2) % nb < nb / 4) ? (NB * NCHUNK * 2) % nb : 0;
    const int ustart = bid < heavy ? NU : (bid - heavy), ustep = nb - heavy;
#pragma unroll 1
    for (int u = ustart; u < NU; u += ustep) {
        int S, LEN, LSH, pstride, sstride, tok0, ch0;
        if (u < 256) { const int b = u >> 7, cs = (u >> 2) & 31, cc = u & 3; S = 2; LEN = 256; LSH = 8; pstride = 64; sstride = 1; tok0 = b * SEG + CTXL + 2 * cs; ch0 = 256 + 64 * cc; }
        else if (u < 768) { const int v = u - 256; const int b = v >> 8, rg = (v >> 2) & 63, cc = v & 3; S = 4; LEN = 64; LSH = 6; pstride = 1; sstride = 64; tok0 = b * SEG + CTXL + 256 * rg; ch0 = 64 * cc; }
        else { const int v = u - 768; const int b = v >> 3, cc = v & 7; S = 1; LEN = 256; LSH = 8; pstride = 1; sstride = 0; tok0 = b * SEG; ch0 = 64 * cc; }
        const int LP = LEN + 30;
        { float tw[4];
#pragma unroll
          for (int it = 0; it < 4; ++it) { const int i = tid + NTHREADS * it; const int j = i >> 6, c = i & 63; tw[it] = j < 31 ? p->conv_w[((size_t)l * 31 + j) * 512 + ch0 + c] : p->conv_b[l * 512 + ch0 + c]; }
#pragma unroll
          for (int it = 0; it < 4; ++it) wl[tid + NTHREADS * it] = tw[it]; }
        for (int i = tid; i < S * 30 * 8; i += NTHREADS) { const int pc = i & 7, q = (i >> 3) % 30, sq = (i >> 3) / 30; const int pos = q < 15 ? q : LEN + q;
            unsigned zz; asm volatile("v_mov_b32 %0, 0" : "=v"(zz));
            *(LAS u32x4*)(tile + ((sq * LP + pos) * 64 + pc * 8) * 2) = (u32x4){zz, zz, zz, zz}; }
        for (int ib = 0; ib < S * LEN * 8; ib += 4 * NTHREADS) {
            u32x4 uv[4];
#pragma unroll
            for (int q = 0; q < 4; ++q) { const int i = ib + tid + NTHREADS * q; const int pc = i & 7, t = i >> 3; const int sq = t >> LSH, pos = t & (LEN - 1);
                const bf16_t* src = proj + (size_t)(tok0 + sq * sstride + pos * pstride) * NPROJ + ch0 + pc * 8;
                uv[q] = __builtin_nontemporal_load((const u32x4*)src); }
#pragma unroll
            for (int q = 0; q < 4; ++q) { const int i = ib + tid + NTHREADS * q; const int pc = i & 7, t = i >> 3; const int sq = t >> LSH, pos = t & (LEN - 1);
                const u32x4 o = uv[q];
                *(LAS u32x4*)(tile + ((sq * LP + 15 + pos) * 64 + pc * 8) * 2) = o; }
        }
        __syncthreads();
        const int noct = S * LEN / 8;
#pragma unroll 1
        for (int it = tid; it < noct * 32; it += NTHREADS) {
            const int cp = it & 31, oc = it >> 5; const int sq = oc >> (LSH - 3), p0 = (oc & ((LEN >> 3) - 1)) * 8;
            const LAS unsigned* base = (const LAS unsigned*)(tile + ((sq * LP + p0) * 64) * 2) + cp;
            float i0[38], i1[38];
#pragma unroll
            for (int k = 0; k < 38; ++k) { const unsigned w = base[k * 32]; i0[k] = bflo(w); i1[k] = bfhi(w); }
            float a0[8], a1[8];
            { const float b0 = wl[31 * 64 + 2 * cp], b1 = wl[31 * 64 + 2 * cp + 1];
#pragma unroll
              for (int i = 0; i < 8; ++i) { a0[i] = b0; a1[i] = b1; } }
#pragma unroll
            for (int j = 0; j < 31; ++j) { typedef float f32x2 __attribute__((ext_vector_type(2))); const f32x2 wj = *(const LAS f32x2*)(wl + j * 64 + 2 * cp); const float w0 = wj[0], w1 = wj[1];
#pragma unroll
                for (int i = 0; i < 8; ++i) { a0[i] += w0 * i0[i + j]; a1[i] += w1 * i1[i + j]; } }
#pragma unroll
            for (int i = 0; i < 8; ++i) { const int tok = tok0 + sq * sstride + (p0 + i) * pstride;
                *(unsigned*)(mix + (size_t)tok * 1024 + 512 + ch0 + 2 * cp) = cvt_pk_bf16(a0[i], a1[i]); }
        }
        __syncthreads();
    }
}
__device__ __forceinline__ void phase_c1_ln(CP p, int l, int bid, int nb) {
    const int tid = launder_tid(); const int lane = tid & 63, wave = tid >> 6;
    bf16_t* mix = (bf16_t*)(p->ws + WS_HX);
    const f32x4 g0 = *(const f32x4*)(p->conv_ln_g + l * 512 + lane * 8), g1 = *(const f32x4*)(p->conv_ln_g + l * 512 + lane * 8 + 4);
    const f32x4 b0 = *(const f32x4*)(p->conv_ln_b + l * 512 + lane * 8), b1 = *(const f32x4*)(p->conv_ln_b + l * 512 + lane * 8 + 4);
    const float gg[8] = {g0[0], g0[1], g0[2], g0[3], g1[0], g1[1], g1[2], g1[3]}, bb[8] = {b0[0], b0[1], b0[2], b0[3], b1[0], b1[1], b1[2], b1[3]};
    const int rstep = nb * 8;
    u32x4 vn[4];
#pragma unroll
    for (int j = 0; j < 4; ++j) { const int r = bid * 8 + wave + j * rstep; vn[j] = (u32x4){0u, 0u, 0u, 0u}; if (r < R) vn[j] = *(const u32x4*)(mix + (size_t)r * 1024 + 512 + lane * 8); }
#pragma unroll 1
    for (int rb = bid * 8 + wave; rb < R; rb += 4 * rstep) {
        u32x4 vc[4];
#pragma unroll
        for (int j = 0; j < 4; ++j) vc[j] = vn[j];
#pragma unroll
        for (int j = 0; j < 4; ++j) { const int r = rb + (4 + j) * rstep; if (r < R) vn[j] = *(const u32x4*)(mix + (size_t)r * 1024 + 512 + lane * 8); }
#pragma unroll
        for (int j = 0; j < 4; ++j) { const int r = rb + j * rstep;
            if (r < R) {
                const u32x4 v = vc[j];
                float y[8] = {bflo(v.x), bfhi(v.x), bflo(v.y), bfhi(v.y), bflo(v.z), bfhi(v.z), bflo(v.w), bfhi(v.w)};
                float s = 0.f;
#pragma unroll
                for (int e = 0; e < 8; ++e) s += y[e];
                const float mu = wave_sum(s) * (1.f / 512.f);
                float q = 0.f;
#pragma unroll
                for (int e = 0; e < 8; ++e) { y[e] -= mu; q += y[e] * y[e]; }
                const float rstd = rsqrtf(wave_sum(q) * (1.f / 512.f) + 1e-5f);
                float o[8];
#pragma unroll
                for (int e = 0; e < 8; ++e) o[e] = siluf_(y[e] * rstd * gg[e] + bb[e]);
                *(u32x4*)(mix + (size_t)r * 1024 + 512 + lane * 8) = pack8(o); } }
    }
}
__device__ __forceinline__ size_t st_off(int bd, int h, int c, int piece) { return ((size_t)(((bd * 8 + h) * 4 + (piece >> 8)) * NCHUNK + c)) * 2048 + (size_t)(piece & 255) * 8; }
__device__ __forceinline__ void phase_s1(CP p, int l, unsigned char* lds_, int bid, int nb) {
    LAS unsigned char* lds = (LAS unsigned char*)lds_;
    LAS unsigned char* Bs = lds;
    LAS unsigned char* Xs = lds + 128 * ST_TR128;
    LAS float* wv = (LAS float*)(Xs + 128 * ST_X256);
    LAS float* hvs = wv + 8 * 128;
    LAS float* cwl = hvs + 4 * 520;
    LAS float* atab = cwl + 6 * 384;
    const int tid = launder_tid(); const int lane = tid & 63, wave = __builtin_amdgcn_readfirstlane(tid >> 6);
    const bf16_t* proj = (const bf16_t*)(p->ws + WS_PROJ);
    const float* cw = p->ssd_conv_w + (size_t)l * 5 * 1024; const float* cbias = p->ssd_conv_b + (size_t)l * 1024;
    bf16_t* Sg = (bf16_t*)(p->ws + WS_S); float* DEC = (float*)(p->ws + WS_DEC); bf16_t* BACT = (bf16_t*)(p->ws + WS_HP);
    if (tid < 16) atab[tid] = -expf(p->a_log[l * 16 + tid]);
    __syncthreads();
    int cur_g = -1;
#pragma unroll 1
    for (int u = bid; u < NB * NCHUNK * 2; u += nb) {
        const int g = u & 1, c = (u >> 1) % NCHUNK, b = (u >> 1) / NCHUNK;
        const int row0 = b * SEG + c * 128;
        const bool lo_ok = !(c == 0 || c == 2), hi_ok = !(c == 1 || c == NCHUNK - 1);
        if (g != cur_g) { cur_g = g;
            float tw[5];
#pragma unroll
            for (int it = 0; it < 5; ++it) { const int i = tid + NTHREADS * it; const int j = i / 384, lc = i - j * 384; const int gch = lc < 128 ? 512 + g * 128 + lc : g * 256 + (lc - 128);
                tw[it] = i < 6 * 384 ? (j < 5 ? cw[j * 1024 + gch] : cbias[gch]) : 0.f; }
#pragma unroll
            for (int it = 0; it < 5; ++it) { const int i = tid + NTHREADS * it; if (i < 6 * 384) cwl[i] = tw[it]; } }
        const int hh = wave >> 1, dir = wave & 1, h = 4 * g + hh;
        u32x4 rb[8], rx0[8], rx1[8];
        conv_load(proj, row0, tid >> 4, 512 + g * 128 + (tid & 15) * 8, lo_ok, hi_ok, rb);
        conv_load(proj, row0, tid >> 5, g * 256 + (tid & 31) * 8, lo_ok, hi_ok, rx0);
        conv_load(proj, row0, (tid >> 5) + 16, g * 256 + (tid & 31) * 8, lo_ok, hi_ok, rx1);
        head_cums(p, l, row0, h, dir, lane, hvs + hh * 520, atab);
        __syncthreads();
        {
            const LAS float* hv = hvs + hh * 520; const float tot = hv[512 + dir];
#pragma unroll
            for (int q = 0; q < 2; ++q) { const int lr = lane + 64 * q; wv[wave * 128 + lr] = __expf(tot - hv[dir * 128 + lr]) * hv[256 + dir * 128 + lr]; }
            if (lane == 0) DEC[((size_t)(b * 2 + dir) * NCHUNK + c) * 8 + h] = __expf(tot);
        }
        { float o[4][8];
          conv_compute(rb, cwl, 384, (tid & 15) * 8, o, (tid >> 4) == 0 && !lo_ok, (tid >> 4) == 31 && !hi_ok);
#pragma unroll
          for (int i = 0; i < 4; ++i) { const u32x4 pk = pack8(o[i]); *(LAS u32x4*)(Bs + (4 * (tid >> 4) + i) * ST_TR128 + (tid & 15) * 16) = pk;
              *(u32x4*)(BACT + (size_t)(row0 + 4 * (tid >> 4) + i) * 256 + g * 128 + (tid & 15) * 8) = pk; }
          conv_compute(rx0, cwl, 384, 128 + (tid & 31) * 8, o, (tid >> 5) == 0 && !lo_ok, false);
#pragma unroll
          for (int i = 0; i < 4; ++i) *(LAS u32x4*)(Xs + (4 * (tid >> 5) + i) * ST_X256 + (tid & 31) * 16) = pack8(o[i]);
          conv_compute(rx1, cwl, 384, 128 + (tid & 31) * 8, o, false, (tid >> 5) == 15 && !hi_ok);
#pragma unroll
          for (int i = 0; i < 4; ++i) *(LAS u32x4*)(Xs + (4 * ((tid >> 5) + 16) + i) * ST_X256 + (tid & 31) * 16) = pack8(o[i]); }
        __syncthreads();
        {
            f32x16 acc[2][4];
#pragma unroll
            for (int t = 0; t < 2; ++t)
#pragma unroll
                for (int q = 0; q < 4; ++q)
#pragma unroll
                    for (int e = 0; e < 16; ++e) acc[t][q][e] = 0.f;
            {
                bf16x8 ar[2][2], br[2][4];
#pragma unroll
                for (int t = 0; t < 2; ++t) ar[0][t] = tr_frag(Xs, ST_X256, 0, hh * 64 + 32 * t, lane);
#pragma unroll
                for (int q = 0; q < 4; ++q) br[0][q] = tr_frag(Bs, ST_TR128, 0, 32 * q, lane);
#pragma unroll 2
                for (int kk = 0; kk < 8; ++kk) { const int c_ = kk & 1, n_ = c_ ^ 1;
                    const LAS float* wp = wv + wave * 128 + 16 * kk + 8 * (lane >> 5);
                    const f32x4 w0 = *(const LAS f32x4*)wp, w1 = *(const LAS f32x4*)(wp + 4);
                    if (kk < 7) {
#pragma unroll
                        for (int t = 0; t < 2; ++t) ar[n_][t] = tr_frag(Xs, ST_X256, 16 * (kk + 1), hh * 64 + 32 * t, lane);
#pragma unroll
                        for (int q = 0; q < 4; ++q) br[n_][q] = tr_frag(Bs, ST_TR128, 16 * (kk + 1), 32 * q, lane); }
                    bf16x8 af[2];
#pragma unroll
                    for (int t = 0; t < 2; ++t) af[t] = scale_frag(ar[c_][t], w0, w1);
#pragma unroll
                    for (int q = 0; q < 4; ++q)
#pragma unroll
                        for (int t = 0; t < 2; ++t) acc[t][q] = __builtin_amdgcn_mfma_f32_32x32x16_bf16(br[c_][q], af[t], acc[t][q], 0, 0, 0);
                }
            }
            bf16_t* So = Sg + st_off(b * 2 + dir, h, c, 0) + (size_t)lane * 8;
#pragma unroll
            for (int t = 0; t < 2; ++t)
#pragma unroll
                for (int q = 0; q < 4; ++q)
#pragma unroll
                    for (int j = 0; j < 2; ++j) { u32x4 pk; pk.x = cvt_pk_bf16(acc[t][q][8 * j], acc[t][q][8 * j + 1]); pk.y = cvt_pk_bf16(acc[t][q][8 * j + 2], acc[t][q][8 * j + 3]);
                        pk.z = cvt_pk_bf16(acc[t][q][8 * j + 4], acc[t][q][8 * j + 5]); pk.w = cvt_pk_bf16(acc[t][q][8 * j + 6], acc[t][q][8 * j + 7]);
                        *(u32x4*)(So + (size_t)(t * 2 + (q >> 1)) * NCHUNK * 2048 + ((q & 1) * 2 + j) * 512) = pk; }
        }
        __syncthreads();
    }
}
__device__ __forceinline__ void phase_s2(CP p, unsigned char* lds_, int bid, int nb) {
    LAS float* dl = (LAS float*)lds_;
    const int tid = launder_tid();
    const bf16_t* Sg = (const bf16_t*)(p->ws + WS_S); const float* DEC = (const float*)(p->ws + WS_DEC); bf16_t* HP = (bf16_t*)(p->ws + WS_S);
#pragma unroll 1
    for (int P0 = bid * 256; P0 < 2 * 2 * 8 * 1024; P0 += nb * 256) {
        const int blk = P0 >> 10, h = blk & 7, bd = blk >> 3, dir = bd & 1;
        const size_t cbase = (size_t)bd * NCHUNK;
        __syncthreads();
        if (tid < NCHUNK) { const int c = dir == 0 ? tid : (tid < 2 ? 1 - tid : NCHUNK + 1 - tid); dl[tid] = DEC[(cbase + c) * 8 + h]; }
        __syncthreads();
        if (tid < 256) {
            const size_t o0 = st_off(bd, h, 0, (P0 & 1023) + tid);
            const bf16_t* sp = Sg + o0; bf16_t* hp = HP + o0;
            float st[8];
#pragma unroll
            for (int e = 0; e < 8; ++e) st[e] = 0.f;
            u32x4 A[13], B[13];
#define S2_C(step) (dir == 0 ? (step) : ((step) < 2 ? 1 - (step) : NCHUNK + 1 - (step)))
#define S2_LOAD(buf, bt) do { _Pragma("unroll") for (int j = 0; j < 13; ++j) { const int c = S2_C((bt) * 13 + j); buf[j] = *(const u32x4*)(sp + (size_t)c * 2048); } } while (0)
#define S2_PROC(buf, bt) do { _Pragma("unroll") for (int j = 0; j < 13; ++j) { const int c = S2_C((bt) * 13 + j); const float d = dl[(bt) * 13 + j]; const u32x4 sv = buf[j]; \
                *(u32x4*)(hp + (size_t)c * 2048) = pack8(st); \
                st[0] = st[0] * d + bflo(sv.x); st[1] = st[1] * d + bfhi(sv.x); st[2] = st[2] * d + bflo(sv.y); st[3] = st[3] * d + bfhi(sv.y); \
                st[4] = st[4] * d + bflo(sv.z); st[5] = st[5] * d + bfhi(sv.z); st[6] = st[6] * d + bflo(sv.w); st[7] = st[7] * d + bfhi(sv.w); } } while (0)
            S2_LOAD(A, 0);
#pragma unroll 1
            for (int bt = 0; bt < 10; bt += 2) {
                S2_LOAD(B, bt + 1);
                S2_PROC(A, bt);
                if (bt + 2 < 10) S2_LOAD(A, bt + 2);
                S2_PROC(B, bt + 1);
            }
#undef S2_C
#undef S2_LOAD
#undef S2_PROC
        }
    }
}
__device__ __forceinline__ void phase_s3(CP p, int l, unsigned char* lds_, int bid, int nb) {
    LAS unsigned char* lds = (LAS unsigned char*)lds_;
    LAS unsigned char* Cs = lds;
    LAS unsigned char* Bs = Cs + 128 * ST_ROW;
    LAS unsigned char* Mt = Bs;
    LAS unsigned char* Xs = Bs + 128 * ST_MT;
    LAS unsigned char* Hf = Xs + 128 * ST_TR64;
    LAS unsigned char* Hb = Hf + 64 * ST_ROW;
    LAS float* hvs = (LAS float*)(Hb + 64 * ST_ROW);
    LAS float* ssqp = hvs + 4 * 776;
    LAS float* cwl = ssqp + 256;
    LAS float* atab = cwl + 6 * 512;
    const int tid0 = launder_tid(); const int wave = __builtin_amdgcn_readfirstlane(tid0 >> 6);
    const bf16_t* proj = (const bf16_t*)(p->ws + WS_PROJ); bf16_t* mix = (bf16_t*)(p->ws + WS_HX);
    const float* cw = p->ssd_conv_w + (size_t)l * 5 * 1024; const float* cbias = p->ssd_conv_b + (size_t)l * 1024;
    const bf16_t* HP = (const bf16_t*)(p->ws + WS_S)  ; float* SSQ = (float*)(p->ws + WS_SSQ);
    if (tid0 < 16) atab[tid0] = -expf(p->a_log[l * 16 + tid0]); else if (tid0 < 24) atab[tid0] = p->d_skip[l * 8 + tid0 - 16];
    __syncthreads();
    int cur_g = -1;
    const int cskip = (l == DEPTH - 1) ? 2 : 0, cpb = NCHUNK - cskip;
    const int nunits = NB * cpb * 2, nfull = nunits - nunits % nb, nitems = nfull + (nunits - nfull) * 4;
#pragma unroll 1
    for (int it = bid; it < nitems; it += nb) {
        const int u = it < nfull ? it : nfull + ((it - nfull) >> 2);
        const int hh_lo = it < nfull ? 0 : ((it - nfull) & 3), hh_hi = it < nfull ? 4 : hh_lo + 1;
        const int g = u & 1, c = cskip + (u >> 1) % cpb, b = (u >> 1) / cpb;
        int tid = tid0; asm volatile("" : "+v"(tid));
        const int lane = tid & 63;
        const int row0 = b * SEG + c * 128;
        const bool lo_ok = !(c == 0 || c == 2), hi_ok = !(c == 1 || c == NCHUNK - 1);
        if (g != cur_g) { cur_g = g;
            float tw[6];
#pragma unroll
            for (int it = 0; it < 6; ++it) { const int i = tid + NTHREADS * it; const int j = i >> 9, lc = i & 511; const int gch = lc < 128 ? 768 + g * 128 + lc : (lc < 256 ? 512 + g * 128 + (lc - 128) : g * 256 + (lc - 256));
                tw[it] = j < 5 ? cw[j * 1024 + gch] : cbias[gch]; }
#pragma unroll
            for (int it = 0; it < 6; ++it) cwl[tid + NTHREADS * it] = tw[it]; }
        u32x2 rx[8];
        {
            u32x4 r0[8], bact[4];
            const int cg = tid & 15, rq = tid >> 4;
            conv_load(proj, row0, rq, 768 + g * 128 + cg * 8, lo_ok, hi_ok, r0);
            { const bf16_t* BACT = (const bf16_t*)(p->ws + WS_HP);
#pragma unroll
              for (int i = 0; i < 4; ++i) bact[i] = *(const u32x4*)(BACT + (size_t)(row0 + 4 * rq + i) * 256 + g * 128 + cg * 8); }
            head_cums(p, l, row0, 4 * g + (wave >> 1), wave & 1, lane, hvs + (wave >> 1) * 776, atab);
            { LAS float* hvw = hvs + (wave >> 1) * 776; const int dr = wave & 1;
              hvw[520 + dr * 128 + 2 * lane] = __expf(hvw[dr * 128 + 2 * lane]); hvw[520 + dr * 128 + 2 * lane + 1] = __expf(hvw[dr * 128 + 2 * lane + 1]); }
            __syncthreads();
            float o[4][8];
            conv_compute(r0, cwl, 512, cg * 8, o, rq == 0 && !lo_ok, rq == 31 && !hi_ok);
#pragma unroll
            for (int i = 0; i < 4; ++i) *(LAS u32x4*)(Cs + (4 * rq + i) * ST_ROW + cg * 16) = pack8(o[i]);
#pragma unroll
            for (int i = 0; i < 4; ++i) *(LAS u32x4*)(Bs + (4 * rq + i) * ST_ROW + cg * 16) = bact[i];
            asm volatile("" ::: "memory");
            conv_load4(proj, row0, tid >> 4, g * 256 + hh_lo * 64 + (tid & 15) * 4, lo_ok, hi_ok, rx);
            { float o4[4][4]; conv_compute4(rx, cwl, 512, 256 + hh_lo * 64 + (tid & 15) * 4, o4, (tid >> 4) == 0 && !lo_ok, (tid >> 4) == 31 && !hi_ok);
#pragma unroll
              for (int i = 0; i < 4; ++i) { u32x2 pk; pk.x = cvt_pk_bf16(o4[i][0], o4[i][1]); pk.y = cvt_pk_bf16(o4[i][2], o4[i][3]); *(LAS u32x2*)(Xs + (4 * (tid >> 4) + i) * ST_TR64 + (tid & 15) * 8) = pk; } }
        }
        __syncthreads();
        const int lb = wave >> 1, hs = wave & 1;
        int ln = lane; asm volatile("" : "+v"(ln));
        f32x16 gacc[2];
#pragma unroll
        for (int t = 0; t < 2; ++t)
#pragma unroll
            for (int e = 0; e < 16; ++e) gacc[t][e] = 0.f;
#pragma unroll
        for (int kk = 0; kk < 8; ++kk) { const bf16x8 af = row_frag(Cs, ST_ROW, 32 * lb, 16 * kk, lane);
#pragma unroll
            for (int t = 0; t < 2; ++t) { const bf16x8 bf = row_frag(Bs, ST_ROW, 64 * hs + 32 * t, 16 * kk, lane);
                gacc[t] = __builtin_amdgcn_mfma_f32_32x32x16_bf16(af, bf, gacc[t], 0, 0, 0); } }
        u32x4 hreg[4];
        {
#pragma unroll
          for (int q = 0; q < 4; ++q) { const int it = tid + 512 * q; hreg[q] = __builtin_nontemporal_load((const u32x4*)(HP + st_off(b * 2 + (it >> 10), 4 * g + hh_lo, c, it & 1023))); } }
        __syncthreads();
#pragma unroll 1
        for (int hh = hh_lo; hh < hh_hi; ++hh) {
            const int h = 4 * g + hh; const LAS float* hv = hvs + hh * 776;
            asm volatile("" : "+v"(ln));
            const int ph = hs;
            const int lrw = 32 * lb + (ln & 31), pq = 32 * ph + 4 * (ln >> 5);
            u32x2 zraw[4];
#pragma unroll
            for (int rg = 0; rg < 4; ++rg) zraw[rg] = *(const u32x2*)(proj + (size_t)(row0 + lrw) * NPROJ + 1024 + h * 64 + pq + 8 * rg);
#pragma unroll
            for (int t = 0; t < 2; ++t) {
                const int st = 2 * hs + t;
                const int sc = 32 * st + (ln & 31);
                const float cfs = hv[sc], cbs = hv[128 + sc], dfs = hv[256 + sc], dbs = hv[384 + sc];
#pragma unroll
                for (int rg = 0; rg < 4; ++rg) {
                    const int l0 = 32 * lb + 8 * rg + 4 * (ln >> 5);
                    float m[4];
                    if (st < lb) {
                        const f32x4 cfl = *(const LAS f32x4*)(hv + l0);
#pragma unroll
                        for (int e = 0; e < 4; ++e) m[e] = gacc[t][4 * rg + e] * (__expf(cfl[e] - cfs) * dfs);
                    } else if (st > lb) {
                        const f32x4 cbl = *(const LAS f32x4*)(hv + 128 + l0);
#pragma unroll
                        for (int e = 0; e < 4; ++e) m[e] = gacc[t][4 * rg + e] * (__expf(cbl[e] - cbs) * dbs);
                    } else {
                        const f32x4 cfl = *(const LAS f32x4*)(hv + l0), cbl = *(const LAS f32x4*)(hv + 128 + l0);
#pragma unroll
                        for (int e = 0; e < 4; ++e) { const int lr = l0 + e;
                            const float ff = lr >= sc ? __expf(cfl[e] - cfs) * dfs : 0.f;
                            const float fb = lr <= sc ? __expf(cbl[e] - cbs) * dbs : 0.f;
                            m[e] = gacc[t][4 * rg + e] * (ff + fb); }
                    }
                    u32x2 pk; pk.x = cvt_pk_bf16(m[0], m[1]); pk.y = cvt_pk_bf16(m[2], m[3]);
                    *(LAS u32x2*)(Mt + sc * ST_MT + l0 * 2) = pk;
                }
            }
#pragma unroll
            for (int q = 0; q < 4; ++q) { const int it = tid + 512 * q; const int q2 = it & 1023;
                LAS unsigned char* dst = ((it >> 10) ? Hb : Hf) + (32 * (q2 >> 9) + (q2 & 31)) * ST_ROW + (32 * ((q2 >> 7) & 3) + 16 * ((q2 >> 6) & 1) + 4 * ((q2 >> 5) & 1)) * 2;
                *(LAS u32x2*)dst = (u32x2){hreg[q].x, hreg[q].y}; *(LAS u32x2*)(dst + 16) = (u32x2){hreg[q].z, hreg[q].w}; }
            if (hh + 1 < hh_hi) {
#pragma unroll
                for (int q = 0; q < 4; ++q) { const int it = tid + 512 * q; hreg[q] = __builtin_nontemporal_load((const u32x4*)(HP + st_off(b * 2 + (it >> 10), h + 1, c, it & 1023))); }
                conv_load4(proj, row0, tid >> 4, g * 256 + (hh + 1) * 64 + (tid & 15) * 4, lo_ok, hi_ok, rx);
            }
            __syncthreads();
            f32x16 ad, af_, ab_;
#pragma unroll
            for (int e = 0; e < 16; ++e) { ad[e] = 0.f; af_[e] = 0.f; ab_[e] = 0.f; }
            {
                bf16x8 am[2], bx[2], ac[2], bhf[2], bhb[2];
                am[0] = tr_frag(Mt, ST_MT, 0, 32 * lb, lane); bx[0] = tr_frag(Xs, ST_TR64, 0, 32 * ph, lane);
                ac[0] = row_frag(Cs, ST_ROW, 32 * lb, 0, lane); bhf[0] = row_frag(Hf, ST_ROW, 32 * ph, 0, lane); bhb[0] = row_frag(Hb, ST_ROW, 32 * ph, 0, lane);
#pragma unroll
                for (int kk = 0; kk < 8; ++kk) { const int c = kk & 1, n = c ^ 1;
                    if (kk < 7) { am[n] = tr_frag(Mt, ST_MT, 16 * (kk + 1), 32 * lb, lane); bx[n] = tr_frag(Xs, ST_TR64, 16 * (kk + 1), 32 * ph, lane);
                        ac[n] = row_frag(Cs, ST_ROW, 32 * lb, 16 * (kk + 1), lane); bhf[n] = row_frag(Hf, ST_ROW, 32 * ph, 16 * (kk + 1), lane); bhb[n] = row_frag(Hb, ST_ROW, 32 * ph, 16 * (kk + 1), lane); }
                    ad = __builtin_amdgcn_mfma_f32_32x32x16_bf16(bx[c], am[c], ad, 0, 0, 0);
                    af_ = __builtin_amdgcn_mfma_f32_32x32x16_bf16(bhf[c], ac[c], af_, 0, 0, 0);
                    ab_ = __builtin_amdgcn_mfma_f32_32x32x16_bf16(bhb[c], ac[c], ab_, 0, 0, 0); }
            }
            const float dsk = atab[16 + h];
            { const float ef = hv[520 + lrw], eb = hv[648 + lrw];
              float sq = 0.f;
#pragma unroll
              for (int rg = 0; rg < 4; ++rg) {
                const u32x2 xr = *(const LAS u32x2*)(Xs + lrw * ST_TR64 + (pq + 8 * rg) * 2);
                const float xs[4] = {bflo(xr.x), bfhi(xr.x), bflo(xr.y), bfhi(xr.y)};
                const float zz[4] = {bflo(zraw[rg].x), bfhi(zraw[rg].x), bflo(zraw[rg].y), bfhi(zraw[rg].y)};
                float v[4];
#pragma unroll
                for (int e = 0; e < 4; ++e) { const int ri = 4 * rg + e;
                    const float y = ad[ri] + ef * af_[ri] + eb * ab_[ri] + dsk * xs[e];
                    v[e] = y * zz[e];
                    sq += v[e] * v[e]; }
                u32x2 pk; pk.x = cvt_pk_bf16(v[0], v[1]); pk.y = cvt_pk_bf16(v[2], v[3]);
                *(u32x2*)(mix + (size_t)(row0 + lrw) * 1024 + h * 64 + pq + 8 * rg) = pk;
              }
              sq += __shfl_xor(sq, 32);
              if (ln < 32) ssqp[ph * 128 + lrw] = sq; }
            __syncthreads();
            if (tid < 128) SSQ[(size_t)(row0 + tid) * 8 + h] = ssqp[tid] + ssqp[128 + tid];
            if (hh + 1 < hh_hi) { float o4[4][4];
                conv_compute4(rx, cwl, 512, 256 + (hh + 1) * 64 + (tid & 15) * 4, o4, (tid >> 4) == 0 && !lo_ok, (tid >> 4) == 31 && !hi_ok);
#pragma unroll
                for (int i = 0; i < 4; ++i) { u32x2 pk; pk.x = cvt_pk_bf16(o4[i][0], o4[i][1]); pk.y = cvt_pk_bf16(o4[i][2], o4[i][3]); *(LAS u32x2*)(Xs + (4 * (tid >> 4) + i) * ST_TR64 + (tid & 15) * 8) = pk; } }
        }
        __syncthreads();
    }
}
__device__ __forceinline__ void phase_r2(CP p, int l, unsigned char* lds_, int bid, int nb) {
    LAS unsigned char* lds = (LAS unsigned char*)lds_;
    LAS unsigned char* Wh = lds;
    LAS unsigned char* Xh = Wh + 32 * ST_H16;
    LAS float* gm = (LAS float*)(Xh + 16 * ST_H16);
    LAS float* sh = gm + 3 * 1024;
    LAS float* part = sh + 3 * 1024;
    LAS float* lgs = part + 8 * 16 * 32;
    LAS int* lcnt = (LAS int*)(lgs + 16 * 32);
    LAS int* lcls = lcnt + 64;
    LAS int* lrank = lcls + 512;
    LAS float* lcwa = (LAS float*)(lrank + 512);
    LAS float* lcwb = lcwa + 512;
    LAS float* lga = lcwb + 512;
    const int tid = launder_tid(); const int lane = tid & 63, wave = __builtin_amdgcn_readfirstlane(tid >> 6);
    const float* mod = (const float*)(p->ws + WS_MOD) + (size_t)l * 3 * 6144;
    {
        float tmp[8];
#pragma unroll
        for (int it = 0; it < 8; ++it) tmp[it] = p->w_rg[(size_t)l * 4096 + tid + NTHREADS * it];
#pragma unroll
        for (int it = 0; it < 8; ++it) { const int idx = tid + NTHREADS * it; *(LAS _Float16*)(Wh + (idx & 3) * ST_H16 + (idx >> 2) * 2) = (_Float16)tmp[it]; } }
#pragma unroll
    for (int hb = 0; hb < 2; ++hb) { float tmp[16];
#pragma unroll
        for (int it = 0; it < 16; ++it) tmp[it] = p->w_re[(size_t)l * 16384 + tid + NTHREADS * (16 * hb + it)];
#pragma unroll
        for (int it = 0; it < 16; ++it) { const int idx = tid + NTHREADS * (16 * hb + it); *(LAS _Float16*)(Wh + (4 + (idx & 15)) * ST_H16 + (idx >> 4) * 2) = (_Float16)tmp[it]; } }
    { unsigned zz; asm volatile("v_mov_b32 %0, 0" : "=v"(zz));
      for (int i = tid; i < 12 * 128; i += NTHREADS) { const int rw = 20 + i / 128, c16 = i % 128; *(LAS u32x4*)(Wh + rw * ST_H16 + c16 * 16) = (u32x4){zz, zz, zz, zz}; } }
    { float t0[6], t1[6], t2[6];
#pragma unroll
      for (int it = 0; it < 6; ++it) { const int idx = tid + NTHREADS * it; const int v = idx >> 10, k = idx & 1023; t0[it] = p->g_ffn[l * 1024 + k]; t1[it] = mod[v * 6144 + 4 * 1024 + k]; t2[it] = mod[v * 6144 + 3 * 1024 + k]; }
#pragma unroll
      for (int it = 0; it < 6; ++it) { const int idx = tid + NTHREADS * it; gm[idx] = t0[it] * (1.f + t1[it]); sh[idx] = t2[it]; } }
    if (tid < 64) lcnt[tid] = 0;
    __syncthreads();
    bf16_t* HM = (bf16_t*)(p->ws + WS_HX); float* CWLA = (float*)(p->ws + WS_CWLA); float* CWLB = (float*)(p->ws + WS_CWLB);
    int* gcount = (int*)(p->ws + WS_CTL) + l * 32; int* LIST = (int*)(p->ws + WS_LIST);
    const int rpb = (R + nb - 1) / nb, r0 = bid * rpb, r1 = (r0 + rpb) < R ? (r0 + rpb) : R;
    RowRaw xn[2];
#pragma unroll
    for (int q = 0; q < 2; ++q) if (r0 + 2 * wave + q < r1) row_load(p, 1, r0 + 2 * wave + q, lane, xn[q]);
#pragma unroll 1
    for (int t0r = r0; t0r < r1; t0r += 16) {
        f32x4 xv[2][4];
#pragma unroll
        for (int q = 0; q < 2; ++q) row_cvt(1, xn[q], xv[q]);
#pragma unroll
        for (int q = 0; q < 2; ++q) if (t0r + 16 + 2 * wave + q < r1) row_load(p, 1, t0r + 16 + 2 * wave + q, lane, xn[q]);
#pragma unroll
        for (int q = 0; q < 2; ++q) { const int rr = t0r + 2 * wave + q; const bool ok = rr < r1; const int v = row_v(ok ? rr : r0);
            float ss = 0.f;
#pragma unroll
            for (int j = 0; j < 4; ++j) ss += xv[q][j][0] * xv[q][j][0] + xv[q][j][1] * xv[q][j][1] + xv[q][j][2] * xv[q][j][2] + xv[q][j][3] * xv[q][j][3];
            ss = wave_sum(ss); const float rs = ok ? __builtin_amdgcn_rsqf(ss * (1.f / 1024.f) + 1e-6f) : 0.f;
#pragma unroll
            for (int j = 0; j < 4; ++j) { const int k = 4 * lane + 256 * j; const f32x4 g4 = *(const LAS f32x4*)(gm + v * 1024 + k), s4 = *(const LAS f32x4*)(sh + v * 1024 + k);
                f32x4 hv = xv[q][j] * rs * g4 + s4; if (!ok) hv = hv * 0.f;
                u32x2 o; o.x = cvt_pk_bf16(hv[0], hv[1]); o.y = cvt_pk_bf16(hv[2], hv[3]);
                if (ok) *(u32x2*)(HM + (size_t)rr * 1024 + k) = o;
                u32x2 h16; h16.x = pack_f16(hv[0], hv[1]); h16.y = pack_f16(hv[2], hv[3]);
                *(LAS u32x2*)(Xh + (2 * wave + q) * ST_H16 + k * 2) = h16; } }
        __syncthreads();
        {
            f32x4 acc0 = {0.f, 0.f, 0.f, 0.f}, acc1 = {0.f, 0.f, 0.f, 0.f};
#pragma unroll
            for (int s4 = 0; s4 < 4; ++s4) { const int kb = (128 * wave + 32 * s4 + 8 * (lane >> 4)) * 2;
                const f16x8 a = *(const LAS f16x8*)(Xh + (lane & 15) * ST_H16 + kb);
                const f16x8 b0 = *(const LAS f16x8*)(Wh + (lane & 15) * ST_H16 + kb), b1 = *(const LAS f16x8*)(Wh + (16 + (lane & 15)) * ST_H16 + kb);
                acc0 = __builtin_amdgcn_mfma_f32_16x16x32_f16(a, b0, acc0, 0, 0, 0);
                acc1 = __builtin_amdgcn_mfma_f32_16x16x32_f16(a, b1, acc1, 0, 0, 0); }
#pragma unroll
            for (int e = 0; e < 4; ++e) { const int row = 4 * (lane >> 4) + e; part[(wave * 16 + row) * 32 + (lane & 15)] = acc0[e]; part[(wave * 16 + row) * 32 + 16 + (lane & 15)] = acc1[e]; }
        }
        __syncthreads();
        if (tid < 320) { const int row = tid / 20, n = tid - row * 20; float sacc = n < 4 ? p->b_rg[l * 4 + n] : p->b_re[l * 16 + n - 4];
#pragma unroll
            for (int w = 0; w < 8; ++w) sacc += part[(w * 16 + row) * 32 + n];
            lga[(t0r - r0 + row) * 20 + n] = sacc; }
    }
    __syncthreads();
    for (int ridx = tid; ridx < r1 - r0; ridx += NTHREADS) { const int rr = r0 + ridx;
            {
                if (l == DEPTH - 1 && row_v(rr) == 2) lcls[rr - r0] = -1;
                else {
                    float lg[20];
#pragma unroll
                    for (int n = 0; n < 20; ++n) lg[n] = lga[ridx * 20 + n];
                    int gsel = 0; float gmax = lg[0];
#pragma unroll
                    for (int t = 1; t < 4; ++t) if (lg[t] > gmax) { gmax = lg[t]; gsel = t; }
                    float gden = 0.f;
#pragma unroll
                    for (int t = 0; t < 4; ++t) gden += __expf(lg[t] - gmax);
                    const float gprob = 1.f / gden;
                    float el[4];
#pragma unroll
                    for (int t = 0; t < 4; ++t) el[t] = gsel == 0 ? lg[4 + t] : (gsel == 1 ? lg[8 + t] : (gsel == 2 ? lg[12 + t] : lg[16 + t]));
                    int i0 = 0; float m0 = el[0];
#pragma unroll
                    for (int t = 1; t < 4; ++t) if (el[t] > m0) { m0 = el[t]; i0 = t; }
                    int i1 = -1; float m1 = -3.0e38f;
#pragma unroll
                    for (int t = 0; t < 4; ++t) if (t != i0 && el[t] > m1) { m1 = el[t]; i1 = t; }
                    const float w0 = gprob / (1.f + __expf(m1 - m0)), w1 = gprob - w0;
                    const int ea = i0 < i1 ? i0 : i1, eb = i0 < i1 ? i1 : i0;
                    const float cwa = i0 < i1 ? w0 : w1, cwb = i0 < i1 ? w1 : w0;
                    const int pidx = ea == 0 ? eb - 1 : (ea == 1 ? eb + 1 : 5);
                    const int cls = gsel * 6 + pidx;
                    const int rank = __hip_atomic_fetch_add(&lcnt[cls], 1, __ATOMIC_RELAXED, __HIP_MEMORY_SCOPE_WORKGROUP);
                    lcls[rr - r0] = cls; lrank[rr - r0] = rank; lcwa[rr - r0] = cwa; lcwb[rr - r0] = cwb;
                } } }
    __syncthreads();
    if (tid < NCLS) lcnt[32 + tid] = atomicAdd(&gcount[tid], lcnt[tid]);
    __syncthreads();
    for (int idx = tid; idx < r1 - r0; idx += NTHREADS) { const int cl = lcls[idx]; if (cl < 0) continue; const int pos = lcnt[32 + cl] + lrank[idx]; const size_t li = (size_t)cl * R + pos;
        LIST[li] = r0 + idx; CWLA[li] = lcwa[idx]; CWLB[li] = lcwb[idx]; }
    __syncthreads();
}
__device__ __forceinline__ void phase_final(CP p, unsigned char* lds, int bid, int nb) {
    const int tid = launder_tid(); const int lane = tid & 63, wave = tid >> 6;
    const int qstep = nb * 8;
    RowRaw xn[2];
#pragma unroll
    for (int j = 0; j < 2; ++j) { const int q = bid * 8 + wave + j * qstep; if (q < NB * SEQ) { const int b = q >= SEQ ? 1 : 0; row_load(p, 1, b * SEG + CTXL + (q - b * SEQ), lane, xn[j]); } }
#pragma unroll 1
    for (int qb = bid * 8 + wave; qb < NB * SEQ; qb += 2 * qstep) {
        f32x4 xv[2][4];
#pragma unroll
        for (int j = 0; j < 2; ++j) row_cvt(1, xn[j], xv[j]);
#pragma unroll
        for (int j = 0; j < 2; ++j) { const int qn = qb + (2 + j) * qstep; if (qn < NB * SEQ) { const int bn = qn >= SEQ ? 1 : 0; row_load(p, 1, bn * SEG + CTXL + (qn - bn * SEQ), lane, xn[j]); } }
#pragma unroll
        for (int j = 0; j < 2; ++j) { const int q = qb + j * qstep;
            if (q < NB * SEQ) {
                f32x4* hr = (f32x4*)(p->out + (size_t)q * D);
                float ss = 0.f;
#pragma unroll
                for (int i = 0; i < 4; ++i) ss += xv[j][i][0] * xv[j][i][0] + xv[j][i][1] * xv[j][i][1] + xv[j][i][2] * xv[j][i][2] + xv[j][i][3] * xv[j][i][3];
                ss = wave_sum(ss); const float rs = rsqrtf(ss * (1.f / 1024.f) + 1e-6f);
#pragma unroll
                for (int i = 0; i < 4; ++i) { const f32x4 g4 = *(const f32x4*)(p->g_final + 4 * lane + 256 * i); hr[lane + 64 * i] = xv[j][i] * rs * g4; } } }
    }
}

#define XB_TMO      128
#define XB_XCNT(j)  (256  + 64 * (j))
#define XB_XSUB(j)  (1280 + 64 * (j))
#define XB_XGEN(j)  (2304 + 64 * (j))
#define XB_TOP      3328
#define XB_TOPGEN   3392
#define XCD_BAR_WORDS 3456
#define XB_SPIN_CAP (1u << 22)
__device__ __forceinline__ unsigned xb_ld(unsigned* p) { return __hip_atomic_load(p, __ATOMIC_RELAXED, __HIP_MEMORY_SCOPE_AGENT); }
__device__ __forceinline__ unsigned xb_add(unsigned* p, unsigned v) { return __hip_atomic_fetch_add(p, v, __ATOMIC_RELAXED, __HIP_MEMORY_SCOPE_AGENT); }
__device__ __forceinline__ unsigned xb_xcc_id() { return (unsigned)__builtin_amdgcn_s_getreg((3 << 11) | 20) & 0xFu; }
#define XB_SPIN(cond, bar) do { unsigned _sp = 0; while (cond) { __builtin_amdgcn_s_sleep(1); \
    if ((++_sp & 255u) == 0u) { if (xb_ld(&(bar)[XB_TMO])) break; if (_sp > XB_SPIN_CAP) { atomicAdd(&(bar)[XB_TMO], 1u); break; } } } } while (0)
struct XcdBarrier { unsigned* bar; unsigned x; volatile LAS unsigned* st; };
__device__ __forceinline__ XcdBarrier xcd_barrier_post(unsigned* bar, volatile LAS unsigned* st) {
    XcdBarrier b; b.bar = bar; b.x = xb_xcc_id(); b.st = st;
    if (threadIdx.x == 0) (void)xb_add(&bar[XB_XCNT(b.x)], 1u);
    return b;
}
__device__ __forceinline__ void xcd_barrier_complete(unsigned* bar, unsigned x, unsigned& nloc, unsigned& nx) {
    const unsigned G = gridDim.x * gridDim.y * gridDim.z;
    unsigned sum, cnt, mine, sp = 0u;
    for (;;) {
        sum = 0u; cnt = 0u; mine = 0u;
#pragma unroll
        for (unsigned j = 0; j < 16; ++j) { const unsigned c = xb_ld(&bar[XB_XCNT(j)]); sum += c; cnt += (c > 0u) ? 1u : 0u; mine = (j == x) ? c : mine; }
        if (sum == G) break;
        __builtin_amdgcn_s_sleep(1);
        if ((++sp & 255u) == 0u) { if (xb_ld(&bar[XB_TMO])) break; if (sp > XB_SPIN_CAP) { atomicAdd(&bar[XB_TMO], 1u); break; } }
    }
    nloc = mine > 0u ? mine : 1u; nx = cnt > 0u ? cnt : 1u;
}
__device__ __forceinline__ void xcd_barrier(const XcdBarrier& b) {
    asm volatile("s_waitcnt vmcnt(0)" ::: "memory");
    __syncthreads();
    if (threadIdx.x == 0) {
        unsigned* bar = b.bar;
        __builtin_amdgcn_s_waitcnt(0);
        unsigned nloc = b.st[0], nx = b.st[1];
        if (nloc == 0u) { xcd_barrier_complete(bar, b.x, nloc, nx); b.st[0] = nloc; b.st[1] = nx; }
        const unsigned old = xb_add(&bar[XB_XSUB(b.x)], 1u);
        const unsigned gen = old / nloc;
        if (old + 1u == (gen + 1u) * nloc) {
            __builtin_amdgcn_fence(__ATOMIC_RELEASE, "agent");
            asm volatile("s_waitcnt vmcnt(0)" ::: "memory");
            const unsigned og = xb_add(&bar[XB_TOP], 1u);
            const unsigned tg = og / nx;
            if (og + 1u == (tg + 1u) * nx) xb_add(&bar[XB_TOPGEN], 1u);
            else XB_SPIN(xb_ld(&bar[XB_TOPGEN]) == tg, bar);
            __builtin_amdgcn_fence(__ATOMIC_ACQUIRE, "agent");
            xb_add(&bar[XB_XGEN(b.x)], 1u);
            asm volatile("s_waitcnt vmcnt(0)" ::: "memory");
        } else {
            asm volatile("buffer_inv sc1" ::: "memory");
            XB_SPIN(xb_ld(&bar[XB_XGEN(b.x)]) == gen, bar);
            asm volatile("s_waitcnt vmcnt(0)" ::: "memory");
        }
    }
    __syncthreads();
}

#ifndef TIMING_A
#define TIMING_A -1
#endif
#ifndef TIMING_B
#define TIMING_B -1
#endif
#ifndef PHASE_MASK
#define PHASE_MASK 0xFFFFF
#endif
#define PM(i) ((PHASE_MASK >> (i)) & 1)
#ifndef REPEAT_MASK
#define REPEAT_MASK 0
#endif
#define RP(i) for (int rep_ = 0; rep_ < 1 + ((REPEAT_MASK >> (i)) & 1); ++rep_)
constexpr int PH_PER_LAYER = 9, NPHASES = 1 + DEPTH * PH_PER_LAYER + 1;
__global__ void __launch_bounds__(NTHREADS, 2) mk_fwd(Args args) {
    extern __shared__ __attribute__((aligned(16))) unsigned char lds[];
    const __attribute__((address_space(4))) Args* ap = (const __attribute__((address_space(4))) Args*)__builtin_amdgcn_kernarg_segment_ptr();
    const int lo = ap->lo, hi = ap->hi;
    LAS unsigned char* ldsl = (LAS unsigned char*)lds;
    volatile LAS unsigned* xbst = (volatile LAS unsigned*)(ldsl + LDS_BYTES - 16);
    if (threadIdx.x < 4) xbst[threadIdx.x] = 0u;
    __syncthreads();
    (void)xcd_barrier_post((unsigned*)(ap->p.ws + WS_BAR), xbst);
    if (TIMING_A >= 0 && blockIdx.x == 0 && threadIdx.x == 0) ((unsigned long long*)(ap->p.ws + WS_TS))[lo] = __builtin_amdgcn_s_memrealtime();
    for (int ph = lo; ph < hi; ++ph) {
        CP p = launder(&ap->p);
        int bid = blockIdx.x, nb = gridDim.x; asm volatile("" : "+s"(bid), "+s"(nb));
        if (ph == 0) { if (PM(1)) RP(1) phase_adaln(p, lds, bid, nb, 0, DEPTH == 2 ? 192 : 2 * 192); }
        else if (ph == NPHASES - 1) { if (PM(12)) phase_final(p, lds, bid, nb); }
        else {
            const int l = (ph - 1) / PH_PER_LAYER, s = (ph - 1) % PH_PER_LAYER;
            if (s == 0) { if (PM(2)) RP(2) { if (rep_ == 0 || l == 0) phase_r1(p, l, lds, bid, nb); } if (l == 0 && PM(0)) phase_wprep(p, lds, 0, 912, bid, nb); }
            else if (s == 1) { if (PM(3)) RP(3) {
                pg8::DenseSched S; S.init(p->ws + WS_HX, (const bf16_t*)(p->ws + WS_WTIN) + (size_t)l * DIN * 1024, R, NPROJ, 1024, 1024, 1024, nb, bid);
                EpiProj E{(bf16_t*)(p->ws + WS_PROJ)};
                pg8::gemm_phase<EpiProj, pg8::DenseSched, false>(ldsl, 1024, 1024, 1024, S, E);
                {
                    const int extra = S.nwg % nb; const int L1 = WPREP_ITEMS_PER_LAYER;
                    const int a0 = l == 0 ? 912 : L1 + 656, a1 = l == 0 ? 2960 : L1 + 2960;
                    if (l <= 1 && DEPTH == 2) { if (extra > 0 && bid >= extra) phase_wprep(p, lds, a0, a1, bid - extra, nb - extra); else if (extra == 0) phase_wprep(p, lds, a0, a1, bid, nb); }
                    if (l == 0 && DEPTH == 2) { __syncthreads(); if (extra > 0 && bid >= extra) phase_adaln(p, lds, bid - extra, nb - extra, 192, 2 * 192); else if (extra == 0) phase_adaln(p, lds, bid, nb, 192, 2 * 192); } }
            } }
            else if (s == 2) { if (PM(4)) RP(4) phase_c1(p, l, lds, bid, nb); if (PM(5)) RP(5) phase_s1(p, l, lds, bid, nb); }
            else if (s == 3) { if (PM(6)) RP(6) phase_s2(p, lds, bid, nb); }
            else if (s == 4) { if (PM(7)) RP(7) phase_s3(p, l, lds, bid, nb);
                if (PM(4)) {
                    const int cpb = NCHUNK - ((l == DEPTH - 1) ? 2 : 0), nunits = NB * cpb * 2, tail = (nunits % nb) * 4;
                    if (tail > 0 && tail < nb) { if (bid >= tail) phase_c1_ln(p, l, bid - tail, nb - tail); } else phase_c1_ln(p, l, bid, nb); } }
            else if (s == 5) { if (PM(8)) RP(8) { if (rep_ == 0 || l == 0) {
                pg8::DenseSched S; S.init(p->ws + WS_HX, (const bf16_t*)(p->ws + WS_WTOUT) + (size_t)l * 1024 * 1024, R, 1024, 1024, 1024, 1024, nb, bid, l == DEPTH - 1);
                EpiResid<0> E{p->ctx, p->x, (bf16_t*)(p->ws + WS_H), (const float*)(p->ws + WS_MOD) + (size_t)l * 3 * 6144, (const float*)(p->ws + WS_SSQ)};
                pg8::gemm_phase<EpiResid<0>, pg8::DenseSched, false>(ldsl, 1024, 1024, 1024, S, E);
                if (l == 0 && DEPTH == 2 && rep_ == 0) { const int extra = S.nwg % nb; const int L1 = WPREP_ITEMS_PER_LAYER;
                    if (extra > 0 && bid >= extra) phase_wprep(p, lds, 2960, 3984, bid - extra, nb - extra, L1, L1 + 656, L1 + 2960, L1 + 3984);
                    else if (extra == 0) phase_wprep(p, lds, 2960, 3984, bid, nb, L1, L1 + 656, L1 + 2960, L1 + 3984); }
            } } }
            else if (s == 6) { if (PM(9)) phase_r2(p, l, lds, bid, nb); }
            else if (s == 7) { if (PM(10)) {
                LAS int* tab = (LAS int*)(ldsl + MISC_OFF);
                LAS float* gl = (LAS float*)(ldsl + MISC_OFF + 4096);
                { const float* modl = (const float*)(p->ws + WS_MOD) + (size_t)l * 3 * 6144 + 5 * 1024; float tg[6]; const int tt = launder_tid();
#pragma unroll
                  for (int it = 0; it < 6; ++it) { const int i = tt + NTHREADS * it; tg[it] = modl[(size_t)(i >> 10) * 6144 + (i & 1023)]; }
#pragma unroll
                  for (int it = 0; it < 6; ++it) gl[tt + NTHREADS * it] = tg[it]; }
                moe_table(p, l, tab);
                unsigned* ready = (unsigned*)(p->ws + WS_M1CNT) + l * 192;
                { MoeSched S{tab, (const int*)(p->ws + WS_LIST), (const char*)(p->ws + WS_HX), (const char*)(p->ws + WS_WTGU), 0, l, nb, bid, ready, 0};
                  EpiUp E{(bf16_t*)(p->ws + WS_HID), (const float*)(p->ws + WS_CWLA), (const float*)(p->ws + WS_CWLB), ready};
                  pg8::gemm_phase<EpiUp, MoeSched, true>(ldsl, 1024, 1024, 1024, S, E); }
                { const int total = __builtin_amdgcn_readfirstlane(tab[24]) * 4; const int extra = __builtin_amdgcn_readfirstlane(total % nb);
                  MoeSched S{tab, (const int*)(p->ws + WS_LIST), (const char*)(p->ws + WS_HID), (const char*)(p->ws + WS_WTD), 1, l, nb, bid, ready, (total >= nb && total - extra >= nb) ? extra : 0};
                  EpiDown E{(bf16_t*)(p->ws + WS_H), (const int*)(p->ws + WS_LIST), gl};
                  pg8::gemm_phase<EpiDown, MoeSched, false>(ldsl, 512, 256, 512, S, E); }
            } }
            else { }
        }
        if (ph + 1 < hi && !(ph > 0 && ph < NPHASES - 1 && (ph - 1) % PH_PER_LAYER == 7)) { { XcdBarrier xb; xb.bar = (unsigned*)(launder(&ap->p)->ws + WS_BAR); xb.x = xb_xcc_id(); xb.st = (volatile LAS unsigned*)(ldsl + LDS_BYTES - 16); xcd_barrier(xb); }
            if (TIMING_A >= 0 && blockIdx.x == 0 && threadIdx.x == 0) ((unsigned long long*)(launder(&ap->p)->ws + WS_TS))[ph + 1] = __builtin_amdgcn_s_memrealtime(); }
    }
#if TIMING_A >= 0
    {
        XcdBarrier xb; xb.bar = (unsigned*)(launder(&ap->p)->ws + WS_BAR); xb.x = xb_xcc_id(); xb.st = (volatile LAS unsigned*)(ldsl + LDS_BYTES - 16); xcd_barrier(xb);
        if (blockIdx.x == 0 && threadIdx.x == 0) ((unsigned long long*)(launder(&ap->p)->ws + WS_TS))[hi] = __builtin_amdgcn_s_memrealtime();
        xcd_barrier(xb);
        const unsigned long long* ts = (const unsigned long long*)(launder(&ap->p)->ws + WS_TS);
        const float ta = (float)(ts[TIMING_A + 1] - ts[TIMING_A]) * 0.01f, tb = (float)(ts[TIMING_B + 1] - ts[TIMING_B]) * 0.01f;
        float* o = launder(&ap->p)->out; const float sc = 1.f + ta * 0.001f;
        for (size_t i = (size_t)blockIdx.x * NTHREADS + threadIdx.x; i < (size_t)NB * SEQ * D; i += (size_t)gridDim.x * NTHREADS) o[i] = o[i] * sc + (i == 0 ? tb * 0.1f : 0.f);
    }
#endif
}

extern "C" void kernel_launch(void* const* d_in, const int* in_sizes, int n_in, void* d_out, int out_size, void* d_ws, size_t ws_size, hipStream_t stream) {
    static int grid = 0;
    if (grid == 0) {
        if (n_in != 28 || ws_size < WS_END) { fprintf(stderr, "kernel_launch: unexpected n_in %d or ws_size %zu (< %zu)\n", n_in, ws_size, (size_t)WS_END); grid = -1; return; }
        int dev = 0, cus = 0, per_cu = 0;
        hipGetDevice(&dev); hipDeviceGetAttribute(&cus, hipDeviceAttributeMultiprocessorCount, dev);
        if (hipFuncSetAttribute((const void*)mk_fwd, hipFuncAttributeMaxDynamicSharedMemorySize, LDS_BYTES) != hipSuccess) { fprintf(stderr, "kernel_launch: hipFuncSetAttribute failed\n"); grid = -1; return; }
        if (hipOccupancyMaxActiveBlocksPerMultiprocessor(&per_cu, (const void*)mk_fwd, NTHREADS, LDS_BYTES) != hipSuccess || per_cu < 1) { fprintf(stderr, "kernel_launch: occupancy query says %d\n", per_cu); (void)hipGetLastError(); grid = -1; return; }
        if (cus < 208) { fprintf(stderr, "kernel_launch: %d CUs, the row-deferred routing of R2 needs >= 208\n", cus); grid = -1; return; }
        grid = cus;
    }
    if (grid < 0) return;
    (void)hipMemsetAsync((char*)d_ws + WS_CTL, 0, WS_CTL_BYTES, stream);
    Args a{};
    const float** pp = (const float**)&a.p;
    for (int i = 0; i < 28; ++i) pp[i] = (const float*)d_in[i];
    a.p.out = (float*)d_out; a.p.ws = (unsigned char*)d_ws;
#if PER_PHASE_LAUNCH
    for (int ph = 0; ph < NPHASES; ++ph) {
        a.lo = ph; a.hi = ph + 1; void* kargs[] = {&a};
        hipError_t e = hipLaunchCooperativeKernel((const void*)mk_fwd, dim3(grid), dim3(NTHREADS), kargs, LDS_BYTES, stream);
        if (e != hipSuccess) { fprintf(stderr, "kernel_launch: launch of phase %d failed: %s\n", ph, hipGetErrorString(e)); break; }
    }
#else
    a.lo = 0; a.hi = NPHASES; void* kargs[] = {&a};
    hipError_t e = hipLaunchCooperativeKernel((const void*)mk_fwd, dim3(grid), dim3(NTHREADS), kargs, LDS_BYTES, stream);
    if (e != hipSuccess) fprintf(stderr, "kernel_launch: cooperative launch failed: %s (grid %d)\n", hipGetErrorString(e), grid);
#endif
}
```
